# Optimizing an MI355X kernel written in HIP

```python
import jax, jax.numpy as jnp
from jax import lax
import numpy as np

D_MODEL = 1024
BATCH = 4
SEQ = 8192
DEPTH = 2

CHUNK = 64
N_META = 16
EPS = 1e-6

POOL_GROUPS = 4
POOL_WINDOWS = (2, 4, 8, 16)
POOL_WIDTH = D_MODEL // 4
POOL_GDIM = POOL_WIDTH // POOL_GROUPS
CONV_WIDTH = D_MODEL // 4
CONV_KSIZE = 31
FOX_HEADS = 8
FOX_HEAD_DIM = 64
FOX_WIDTH = FOX_HEADS * FOX_HEAD_DIM
Q_BLOCK = 128
N_BRANCH = 3
IN_SPLITS = (POOL_WIDTH, CONV_WIDTH, CONV_WIDTH, FOX_WIDTH, FOX_WIDTH, FOX_WIDTH, FOX_HEADS, N_BRANCH * D_MODEL)
N_IN = sum(IN_SPLITS)
N_GROUPS = 4
EXPERTS_PER_GROUP = 4
N_EXPERTS = N_GROUPS * EXPERTS_PER_GROUP
TOP_K = 2
EXPERT_HIDDEN = D_MODEL // 4

kernel_name = "hybrid_pool_conv_fox_hmoe_meta"


def rms_norm(x, g):
    xf = x.astype(jnp.float32)
    y = xf * lax.rsqrt(jnp.mean(xf * xf, axis=-1, keepdims=True) + EPS)
    return (y * g.astype(jnp.float32)).astype(x.dtype)


def layer_norm(x, g, b):
    xf = x.astype(jnp.float32)
    mu = jnp.mean(xf, axis=-1, keepdims=True)
    var = jnp.mean(jnp.square(xf - mu), axis=-1, keepdims=True)
    y = (xf - mu) * lax.rsqrt(var + EPS)
    return (y * g.astype(jnp.float32) + b.astype(jnp.float32)).astype(x.dtype)


def pool_mixer(a, pool_w, pool_b, pool_scale):
    B_, L, _ = a.shape
    af = a.astype(jnp.float32).reshape(B_, L, POOL_GROUPS, POOL_GDIM)
    cs = jnp.concatenate([jnp.zeros_like(af[:, :1]), jnp.cumsum(af, axis=1)], axis=1)
    t = jnp.arange(L, dtype=jnp.int32)[:, None]
    win = jnp.array(POOL_WINDOWS, dtype=jnp.int32)[None, :]
    lo = jnp.maximum(t + 1 - win, 0)
    cnt = (t + 1 - lo).astype(jnp.float32)
    grp = jnp.arange(POOL_GROUPS, dtype=jnp.int32)[None, :]
    mean = (cs[:, 1:] - cs[:, lo, grp]) / cnt[None, :, :, None]
    diff = mean - af
    y = jnp.einsum('blgc,gcd->blgd', diff, pool_w.astype(jnp.float32)) + pool_b.astype(jnp.float32)
    y = y.reshape(B_, L, POOL_WIDTH) * pool_scale.astype(jnp.float32)
    return y.astype(a.dtype)


def conv_module(bv, bg, conv_w, conv_b, ln_g, ln_b):
    glu = bv * jax.nn.sigmoid(bg)
    y = lax.conv_general_dilated(
        glu, conv_w.astype(glu.dtype)[:, None, :], window_strides=(1,),
        padding=[(CONV_KSIZE - 1, 0)], dimension_numbers=('NWC', 'WIO', 'NWC'),
        feature_group_count=CONV_WIDTH)
    y = y + conv_b.astype(y.dtype)
    y = layer_norm(y, ln_g, ln_b)
    return jax.nn.silu(y)


def forgetting_attention(q, k, v, logf):
    B_, L, H, dh = q.shape
    n_blk = -(-L // Q_BLOCK)
    Lp = n_blk * Q_BLOCK
    pad = Lp - L
    qh = jnp.pad(q.transpose(0, 2, 1, 3), ((0, 0), (0, 0), (0, pad), (0, 0)))
    kh = jnp.pad(k.transpose(0, 2, 1, 3), ((0, 0), (0, 0), (0, pad), (0, 0)))
    vh = jnp.pad(v.transpose(0, 2, 1, 3), ((0, 0), (0, 0), (0, pad), (0, 0)))
    F = jnp.cumsum(jnp.pad(logf.transpose(0, 2, 1), ((0, 0), (0, 0), (0, pad))), axis=-1)
    qb = qh.reshape(B_, H, n_blk, Q_BLOCK, dh).transpose(2, 0, 1, 3, 4)
    Fq = F.reshape(B_, H, n_blk, Q_BLOCK).transpose(2, 0, 1, 3)
    qpos = jnp.arange(Lp, dtype=jnp.int32).reshape(n_blk, Q_BLOCK)
    kpos = jnp.arange(Lp, dtype=jnp.int32)
    scale = FOX_HEAD_DIM ** -0.5

    def block(args):
        qi, Fi, pi = args
        s = jnp.einsum('bhqd,bhkd->bhqk', qi, kh, preferred_element_type=jnp.float32) * scale
        s = s + Fi[..., None] - F[:, :, None, :]
        s = jnp.where(kpos[None, :] <= pi[:, None], s, -jnp.inf)
        p = jax.nn.softmax(s, axis=-1)
        return jnp.einsum('bhqk,bhkd->bhqd', p.astype(vh.dtype), vh)

    o = lax.map(block, (qb, Fq, qpos))
    o = o.transpose(1, 0, 3, 2, 4).reshape(B_, Lp, H * dh)
    return o[:, :L]


def mixer_layer(u, w_in, b_forget, pool_w, pool_b, pool_scale, conv_w, conv_b, conv_ln_g, conv_ln_b,
                w_out_a, w_out_b, w_out_c, w_o):
    B_, L, D = u.shape
    p = u @ w_in
    a, bv, bg, q, k, v, fg, gates = jnp.split(p, [int(i) for i in np.cumsum(IN_SPLITS)[:-1]], axis=-1)
    ya = pool_mixer(a, pool_w, pool_b, pool_scale) @ w_out_a
    yb = conv_module(bv, bg, conv_w, conv_b, conv_ln_g, conv_ln_b) @ w_out_b
    logf = jax.nn.log_sigmoid((fg + b_forget).astype(jnp.float32))
    heads = lambda z: z.reshape(B_, L, FOX_HEADS, FOX_HEAD_DIM)
    yc = forgetting_attention(heads(q), heads(k), heads(v), logf) @ w_out_c
    g = jax.nn.sigmoid(gates.reshape(B_, L, N_BRANCH, D))
    merged = g[:, :, 0] * ya + g[:, :, 1] * yb + g[:, :, 2] * yc
    return merged @ w_o


def hier_moe(h, router_g, router_g_b, router_e, router_e_b, exp_w1, exp_w3, exp_w2):
    B_, L, D = h.shape
    t = h.reshape(B_ * L, D)
    T = t.shape[0]
    glog = (t @ router_g).astype(jnp.float32) + router_g_b.astype(jnp.float32)
    gprob = jax.nn.softmax(glog, axis=-1)
    _, gsel = lax.top_k(glog, 1)
    gw = jnp.take_along_axis(gprob, gsel, axis=-1)
    elog = ((t @ router_e).astype(jnp.float32) + router_e_b.astype(jnp.float32)).reshape(T, N_GROUPS, EXPERTS_PER_GROUP)
    elog_sel = jnp.take_along_axis(elog, gsel[:, :, None], axis=1)[:, 0]
    eprob = jax.nn.softmax(elog_sel, axis=-1)
    top_p, top_i = lax.top_k(eprob, TOP_K)
    top_p = top_p / jnp.sum(top_p, axis=-1, keepdims=True)
    w_grp = jnp.sum(jax.nn.one_hot(top_i, EXPERTS_PER_GROUP, dtype=jnp.float32) * top_p[..., None], axis=1)
    comb = (jax.nn.one_hot(gsel[:, 0], N_GROUPS, dtype=jnp.float32)[:, :, None] * w_grp[:, None, :] * gw[:, :, None])
    comb = comb.reshape(T, N_EXPERTS).astype(t.dtype)
    y = jnp.zeros_like(t)
    for e in range(N_EXPERTS):
        he = jax.nn.silu(t @ exp_w1[e]) * (t @ exp_w3[e])
        y = y + comb[:, e:e + 1] * (he @ exp_w2[e])
    return y.reshape(B_, L, D)


def setup_inputs(seed: int = 0) -> dict:
    key = jax.random.key(seed)
    ks = jax.random.split(key, 32)
    f32 = jnp.float32
    nrm = lambda k, shape, s: (jax.random.normal(k, shape, f32) * s).astype(f32)
    D = D_MODEL
    return {
        "x": nrm(ks[0], (BATCH, SEQ, D), 1.0),
        "meta": nrm(ks[1], (N_META, D), 1.0),
        "norm1_g": 1.0 + nrm(ks[2], (DEPTH, D), 0.02),
        "w_in": nrm(ks[3], (DEPTH, D, N_IN), D ** -0.5),
        "b_forget": jax.random.uniform(ks[4], (DEPTH, FOX_HEADS), f32, 1.0, 6.0),
        "pool_w": nrm(ks[5], (DEPTH, POOL_GROUPS, POOL_GDIM, POOL_GDIM), POOL_GDIM ** -0.5),
        "pool_b": nrm(ks[6], (DEPTH, POOL_GROUPS, POOL_GDIM), 0.01),
        "pool_scale": 1.0 + nrm(ks[7], (DEPTH, POOL_WIDTH), 0.1),
        "conv_w": nrm(ks[8], (DEPTH, CONV_KSIZE, CONV_WIDTH), CONV_KSIZE ** -0.5),
        "conv_b": nrm(ks[9], (DEPTH, CONV_WIDTH), 0.01),
        "conv_ln_g": 1.0 + nrm(ks[10], (DEPTH, CONV_WIDTH), 0.02),
        "conv_ln_b": nrm(ks[11], (DEPTH, CONV_WIDTH), 0.01),
        "w_out_a": nrm(ks[12], (DEPTH, POOL_WIDTH, D), POOL_WIDTH ** -0.5),
        "w_out_b": nrm(ks[13], (DEPTH, CONV_WIDTH, D), CONV_WIDTH ** -0.5),
        "w_out_c": nrm(ks[14], (DEPTH, FOX_WIDTH, D), FOX_WIDTH ** -0.5),
        "w_o": nrm(ks[15], (DEPTH, D, D), D ** -0.5),
        "norm2_g": 1.0 + nrm(ks[16], (DEPTH, D), 0.02),
        "router_g": nrm(ks[17], (DEPTH, D, N_GROUPS), D ** -0.5),
        "router_g_b": nrm(ks[18], (DEPTH, N_GROUPS), 0.01),
        "router_e": nrm(ks[19], (DEPTH, D, N_EXPERTS), D ** -0.5),
        "router_e_b": nrm(ks[20], (DEPTH, N_EXPERTS), 0.01),
        "exp_w1": nrm(ks[21], (DEPTH, N_EXPERTS, D, EXPERT_HIDDEN), D ** -0.5),
        "exp_w3": nrm(ks[22], (DEPTH, N_EXPERTS, D, EXPERT_HIDDEN), D ** -0.5),
        "exp_w2": nrm(ks[23], (DEPTH, N_EXPERTS, EXPERT_HIDDEN, D), EXPERT_HIDDEN ** -0.5),
        "final_g": 1.0 + nrm(ks[24], (D,), 0.02),
    }


def reference(x, meta, norm1_g, w_in, b_forget, pool_w, pool_b, pool_scale, conv_w, conv_b, conv_ln_g,
              conv_ln_b, w_out_a, w_out_b, w_out_c, w_o, norm2_g, router_g, router_g_b, router_e,
              router_e_b, exp_w1, exp_w3, exp_w2, final_g):
    B_ = x.shape[0]
    m = jnp.broadcast_to(meta.astype(x.dtype)[None], (B_, N_META, D_MODEL))
    h = jnp.concatenate([m, x], axis=1)
    for l in range(DEPTH):
        u = rms_norm(h, norm1_g[l])
        h = h + mixer_layer(u, w_in[l], b_forget[l], pool_w[l], pool_b[l], pool_scale[l], conv_w[l],
                            conv_b[l], conv_ln_g[l], conv_ln_b[l], w_out_a[l], w_out_b[l], w_out_c[l], w_o[l])
        v = rms_norm(h, norm2_g[l])
        h = h + hier_moe(v, router_g[l], router_g_b[l], router_e[l], router_e_b[l], exp_w1[l], exp_w3[l], exp_w2[l])
    return rms_norm(h[:, N_META:], final_g)
```

```cpp
#include <hip/hip_runtime.h>
#include <cstdio>
#include <cstdint>

#ifndef N_LAUNCH_MODE
#define N_LAUNCH_MODE 0
#endif

#define GAS __attribute__((address_space(1)))
#define LAS __attribute__((address_space(3)))
typedef unsigned short bf16;
typedef float f32x4 __attribute__((ext_vector_type(4)));
typedef float f32x2 __attribute__((ext_vector_type(2)));
typedef unsigned u32x4 __attribute__((ext_vector_type(4)));
typedef unsigned u32x2 __attribute__((ext_vector_type(2)));
typedef short bf16x8 __attribute__((ext_vector_type(8)));
typedef __bf16 bf16x2v __attribute__((ext_vector_type(2)));

constexpr int D = 1024, NB = 4, SEQ = 8192, NMETA = 16, DEPTH = 2;
constexpr int TX = NB * SEQ;
constexpr int TM = TX + 256;
constexpr int NIN = 5384, N1 = 5376;
constexpr int NHEAD = 8;
constexpr int NCLS = 24;
constexpr int NPOSMAX = TM + NCLS * 256;
constexpr float EPS = 1e-6f;
constexpr float LOG2E = 1.4426950408889634f;
constexpr float C2 = 0.125f * LOG2E;
constexpr int NWAVES = 8;

constexpr size_t U = (size_t)TM * 1024 * 2;
constexpr size_t WS_CTL = 0, CTL_BYTES = 1u << 20;
constexpr size_t WS_H = CTL_BYTES;
constexpr size_t WS_HB = WS_H + 2 * U;
constexpr size_t WS_G = WS_HB + U;
constexpr size_t WS_XS = WS_G;
constexpr size_t WS_Y = WS_XS + (size_t)NPOSMAX * 2048;
constexpr size_t WS_HH = WS_Y + (size_t)NPOSMAX * 2048;
static_assert(WS_HH + (size_t)NPOSMAX * 1024 <= WS_G + 3 * U, "MoE overlay fits the gates region");
constexpr size_t WS_A = WS_G + 3 * U;
constexpr size_t WS_GLU = WS_A + U / 4;
constexpr size_t WS_DIFF = WS_GLU + U / 4;
constexpr size_t WS_BP = WS_DIFF + U / 4;
constexpr size_t WS_W1T = WS_BP + U / 4;
constexpr size_t WS_WAT = WS_W1T + (size_t)N1 * 1024 * 2;
constexpr size_t WS_WBT = WS_WAT + 1024 * 256 * 2;
constexpr size_t WS_WCT = WS_WBT + 1024 * 256 * 2;
constexpr size_t WS_WOT = WS_WCT + 1024 * 512 * 2;
constexpr size_t WS_W13T = WS_WOT + 1024 * 1024 * 2;
constexpr size_t WS_W2T = WS_W13T + (size_t)16 * 512 * 1024 * 2;
constexpr size_t WS_WFG = WS_W2T + (size_t)16 * 1024 * 256 * 2;
constexpr size_t WS_RG = WS_WFG + 8 * 1024 * 4;
constexpr size_t WS_BIASA = WS_RG + 20 * 1024 * 4;
constexpr size_t WS_RSTD1 = WS_BIASA + 4096;
constexpr size_t WS_ROUTE = WS_RSTD1 + (size_t)TM * 4;
constexpr size_t WS_PW = WS_ROUTE + (size_t)TM * 32;
constexpr size_t WS_LFT = WS_PW + (size_t)NPOSMAX * 16;
constexpr size_t WS_LFTM = WS_LFT + (size_t)32 * 8192 * 4;
constexpr size_t WS_END = WS_LFTM + 8 * 256 * 4;
static_assert(WS_END <= (size_t)512 * 1024 * 1024, "d_ws map fits 512 MiB");
constexpr size_t DO_Q = 0, DO_K = U / 2, DO_V = U, DO_MERGED = U / 2;
static_assert(DO_V + U / 2 <= (size_t)TX * 1024 * 4, "d_out scratch");
constexpr int CW_BAR = 4096, CW_GCNT = 16384;

constexpr int RING_BYTES = 131072;
constexpr int LC_BAR = RING_BYTES, LC_CNT = RING_BYTES + 64, LC_BASE = RING_BYTES + 192, LC_PCLS = RING_BYTES + 320, LC_NP = RING_BYTES + 960;
constexpr int LC_PTAB = RING_BYTES + 1024;
constexpr int LDS_BYTES = RING_BYTES + 1024 + 7168;

#define LDS_WAIT() asm volatile("s_waitcnt lgkmcnt(0)" ::: "memory")
#define VM_WAIT() asm volatile("s_waitcnt vmcnt(0)" ::: "memory")
#define LAUNDER_S(p) asm volatile("" : "+s"(p))
#define LAUNDER_V(x) asm volatile("" : "+v"(x))
__device__ __forceinline__ int lane_id_opaque() { int x; asm volatile("v_mbcnt_lo_u32_b32 %0, -1, 0\n\tv_mbcnt_hi_u32_b32 %0, -1, %0" : "=v"(x)); return x; }

__device__ __forceinline__ unsigned f2bf(float f) { unsigned u = __builtin_bit_cast(unsigned, f); return (u + 0x7fffu + ((u >> 16) & 1u)) >> 16; }
__device__ __forceinline__ unsigned pk2(float lo, float hi) { return f2bf(lo) | (f2bf(hi) << 16); }
__device__ __forceinline__ float bflo(unsigned w) { return __builtin_bit_cast(float, w << 16); }
__device__ __forceinline__ float bfhi(unsigned w) { return __builtin_bit_cast(float, w & 0xffff0000u); }
__device__ __forceinline__ float wave_sum(float v) {
#pragma unroll
    for (int o = 1; o < 64; o <<= 1) v += __shfl_xor(v, o);
    return v;
}
__device__ __forceinline__ float sigmoidf_(float x) { return 1.0f / (1.0f + __expf(-x)); }
__device__ __forceinline__ float dot2bf(unsigned a, unsigned b, float acc) { return __builtin_amdgcn_fdot2_f32_bf16(__builtin_bit_cast(bf16x2v, a), __builtin_bit_cast(bf16x2v, b), acc, false); }

namespace pg8 {
constexpr int BM = 256, BK = 64, HALF = 128, HTB = HALF * BK * 2, STAGE_BYTES = 8 * HTB, NXCD = 8, WGM = 8;
__host__ __device__ __forceinline__ int lds_byte(int r, int c) { const int st = (r >> 4) * 2 + (c >> 5), rr = r & 15, cc = c & 31, ob = rr * 64 + cc * 2; return st * 1024 + (ob ^ (((ob >> 9) & 1) << 5)); }
__host__ __device__ __forceinline__ void stage_rc(int b, int& R, int& C) { const int st = b / 1024, sb = b % 1024, swz = sb ^ (((sb >> 9) & 1) << 5); R = (st >> 1) * 16 + swz / 64; C = (st & 1) * 32 + (swz % 64) / 2; }
__host__ __device__ __forceinline__ int perm32(int rho) { const int n = rho >> 4, i = rho & 15; return 8 * (i >> 2) + 4 * n + (i & 3); }

struct Unit { int pm, pn; };
struct Gemm { const bf16* A; int K; int ldb; int ksplit; };

struct StaticOrder {
    int nM, nN, nwg, G, c; const bf16* Bt; size_t btile;
    __device__ void init(int M, int N, int G_, int c_, const bf16* Bt_, int ldb) { nM = M / BM; nN = N / BM; nwg = nM * nN; G = G_; c = c_; Bt = Bt_; btile = (size_t)BM * ldb * 2; }
    __device__ bool next(int i, Unit& u) const {
        const long L = (long)i * G + c; if (L >= nwg) return false;
        int wgid = (int)L; { const int q = nwg / NXCD, r = nwg % NXCD, xcd = wgid % NXCD, off = wgid / NXCD; wgid = (xcd < r ? xcd * (q + 1) : r * (q + 1) + (xcd - r) * q) + off; }
        const int nig = WGM * nN, gid = wgid / nig, fm = gid * WGM, gsz = (nM - fm) < WGM ? (nM - fm) : WGM;
        u.pm = fm + ((wgid % nig) % gsz); u.pn = (wgid % nig) / gsz; return true;
    }
    __device__ __forceinline__ const char* bptr(const Unit& u, int) const { return (const char*)Bt + (size_t)u.pn * btile; }
};

template <class Epi, class Sched, bool ALIGN_EPI = true, bool SP2 = true>
__device__ __forceinline__ void gemm_phase(LAS unsigned char* lds, const Gemm g, const Sched& S, const Epi& E, const int wave_id) {
    const int tid = wave_id * 64 + lane_id_opaque();
    const int wid = __builtin_amdgcn_readfirstlane(tid >> 6), lane = tid & 63, wr = wid >> 2, wc = wid & 3, fr = lane & 15, fq = lane >> 4;
    const int K = g.K, nt = K / BK, ldb = g.ldb, ks = g.ksplit;
    unsigned voffA[2], voffB[2];
#pragma unroll
    for (int i = 0; i < 2; ++i) { int R, C; stage_rc(tid * 16 + i * 8192, R, C); const int Rb = Epi::PERM ? ((R & ~31) + perm32(R & 31)) : R;
        voffA[i] = (unsigned)(R * K + C) * 2u; voffB[i] = (unsigned)(Rb * ldb + C) * 2u; }
    const size_t kstep = (size_t)(BK * 2);
    const size_t hstep = (size_t)HALF * K * 2;
    const size_t hstepB = (size_t)HALF * ldb * 2;
    const size_t tstep = 2 * hstep;
    const unsigned ldsw = (unsigned)wid * 1024u;
    const int aoff = lds_byte(wr * 64 + fr, fq * 8), boff = lds_byte(wc * 32 + fr, fq * 8);
#define PG8_SA(b, h) (((b) * 2 + (h)) * HTB)
#define PG8_SB(b, h) ((4 + (b) * 2 + (h)) * HTB)
#define PG8_STAGE(bufoff, gbase, voff) do { _Pragma("unroll") for (int _i = 0; _i < 2; ++_i) \
        __builtin_amdgcn_global_load_lds((const unsigned*)((const char*)(gbase) + (voff)[_i]), (LAS unsigned*)(lds + (bufoff) + ldsw + _i * 8192), 16, 0, 0); } while (0)
#define PG8_LDA(dst, b, h) do { _Pragma("unroll") for (int m = 0; m < 4; ++m) _Pragma("unroll") for (int k = 0; k < 2; ++k) dst[m][k] = *(const LAS bf16x8*)(lds + PG8_SA(b, h) + aoff + m * 2048 + k * 1024); } while (0)
#define PG8_LDB(dst, b, h) do { _Pragma("unroll") for (int n = 0; n < 2; ++n) _Pragma("unroll") for (int k = 0; k < 2; ++k) dst[n][k] = *(const LAS bf16x8*)(lds + PG8_SB(b, h) + boff + n * 2048 + k * 1024); } while (0)
#define PG8_MMA(ai, bj, At, Bt) do { __builtin_amdgcn_s_setprio(1); _Pragma("unroll") for (int m = 0; m < 4; ++m) _Pragma("unroll") for (int n = 0; n < 2; ++n) _Pragma("unroll") for (int k = 0; k < 2; ++k) \
        acc[ai][bj][m][n] = __builtin_amdgcn_mfma_f32_16x16x32_bf16(Bt[n][k], At[m][k], acc[ai][bj][m][n], 0, 0, 0); __builtin_amdgcn_s_setprio(0); } while (0)
#define PG8_WAIT_V(n) asm volatile("s_waitcnt vmcnt(" #n ")" ::: "memory")
#define PG8_WAIT_L(n) asm volatile("s_waitcnt lgkmcnt(" #n ")" ::: "memory")
#define PG8_BAR __builtin_amdgcn_s_barrier()
#define PG8_SCHED __builtin_amdgcn_sched_barrier(0)
    Unit cur, nxt; int ui = 0;
    if (!S.next(0, cur)) return;
    f32x4 acc[2][2][4][2];
    { float z_ = 0.f; LAUNDER_V(z_);
#pragma unroll
    for (int a = 0; a < 2; ++a)
#pragma unroll
        for (int b = 0; b < 2; ++b)
#pragma unroll
            for (int m = 0; m < 4; ++m)
#pragma unroll
                for (int n = 0; n < 2; ++n) acc[a][b][m][n] = (f32x4){z_, z_, z_, z_}; }
    bf16x8 At[4][2], B0[2][2], B1[2][2];
    const char* cA = (const char*)g.A + (size_t)cur.pm * tstep; const char* cB = S.bptr(cur, 0); const char* cB1 = S.bptr(cur, 1) - (size_t)ks * kstep;
    if constexpr (SP2) {
        PG8_STAGE(PG8_SB(0, 0), cB, voffB); PG8_STAGE(PG8_SB(0, 1), cB + hstepB, voffB); PG8_STAGE(PG8_SA(0, 0), cA, voffA); PG8_STAGE(PG8_SA(0, 1), cA + hstep, voffA);
        if (wr == 1) PG8_BAR;
        PG8_WAIT_V(2); PG8_BAR;
        PG8_STAGE(PG8_SB(1, 0), cB + kstep, voffB); PG8_STAGE(PG8_SA(1, 0), cA + kstep, voffA); PG8_STAGE(PG8_SB(1, 1), cB + hstepB + kstep, voffB);
        PG8_WAIT_V(6); PG8_BAR;
    } else {
        PG8_STAGE(PG8_SB(0, 0), cB, voffB); PG8_STAGE(PG8_SA(0, 0), cA, voffA); PG8_STAGE(PG8_SB(0, 1), cB + hstepB, voffB); PG8_STAGE(PG8_SA(0, 1), cA + hstep, voffA);
        if (wr == 1) PG8_BAR;
        PG8_WAIT_V(4); PG8_BAR;
        PG8_STAGE(PG8_SB(1, 0), cB + kstep, voffB); PG8_STAGE(PG8_SA(1, 0), cA + kstep, voffA); PG8_STAGE(PG8_SB(1, 1), cB + hstepB + kstep, voffB);
        PG8_WAIT_V(6); PG8_BAR;
    }
    for (;;) {
        const bool has_next = S.next(ui + 1, nxt);
        const char* nA = has_next ? (const char*)g.A + (size_t)nxt.pm * tstep : cA; const char* nB = has_next ? S.bptr(nxt, 0) : cB;
        const char* nB1 = has_next ? S.bptr(nxt, 1) - (size_t)ks * kstep : cB1;
        for (int t = 0; t < nt; t += 2) {
            const bool last = (t == nt - 2);
            const char* a1 = cA + (size_t)(t + 1) * kstep;
            const char* bside = (t + 2 < ks) ? cB : cB1;
            const char* a2 = last ? nA : cA + (size_t)(t + 2) * kstep; const char* b2 = last ? nB : bside + (size_t)(t + 2) * kstep;
            const char* a3 = a2 + kstep; const char* b3 = b2 + kstep;
            if constexpr (SP2) {
            PG8_LDB(B0, 0, 0); PG8_LDB(B1, 0, 1); PG8_SCHED; PG8_LDA(At, 0, 0); PG8_STAGE(PG8_SA(1, 1), a1 + hstep, voffA);
            PG8_WAIT_V(8); PG8_WAIT_L(0); PG8_BAR; PG8_MMA(0, 0, At, B0); PG8_MMA(0, 1, At, B1); PG8_BAR; PG8_SCHED;
            PG8_LDA(At, 0, 1); PG8_STAGE(PG8_SB(0, 0), b2, voffB); PG8_STAGE(PG8_SB(0, 1), b2 + hstepB, voffB); PG8_STAGE(PG8_SA(0, 0), a2, voffA);
            PG8_WAIT_V(8); PG8_WAIT_L(0); PG8_BAR; PG8_MMA(1, 0, At, B0); PG8_MMA(1, 1, At, B1); PG8_BAR; PG8_SCHED;
            PG8_LDB(B0, 1, 0); PG8_LDB(B1, 1, 1); PG8_SCHED; PG8_LDA(At, 1, 0); PG8_STAGE(PG8_SA(0, 1), a2 + hstep, voffA);
            PG8_WAIT_V(8); PG8_WAIT_L(0); PG8_BAR; PG8_MMA(0, 0, At, B0); PG8_MMA(0, 1, At, B1); PG8_BAR; PG8_SCHED;
            PG8_LDA(At, 1, 1); PG8_STAGE(PG8_SB(1, 0), b3, voffB); PG8_STAGE(PG8_SB(1, 1), b3 + hstepB, voffB); PG8_STAGE(PG8_SA(1, 0), a3, voffA);
            PG8_WAIT_V(8); PG8_WAIT_L(0); PG8_BAR; PG8_MMA(1, 0, At, B0); PG8_MMA(1, 1, At, B1); PG8_BAR; PG8_SCHED;
            } else {
            PG8_LDB(B0, 0, 0); PG8_SCHED; PG8_LDA(At, 0, 0); PG8_STAGE(PG8_SA(1, 1), a1 + hstep, voffA);
            PG8_WAIT_L(8); PG8_BAR; PG8_WAIT_L(0); PG8_MMA(0, 0, At, B0); PG8_BAR; PG8_SCHED;
            PG8_LDB(B1, 0, 1); PG8_STAGE(PG8_SB(0, 0), b2, voffB);
            PG8_BAR; PG8_WAIT_L(0); PG8_MMA(0, 1, At, B1); PG8_BAR;
            PG8_LDA(At, 0, 1); PG8_STAGE(PG8_SA(0, 0), a2, voffA);
            PG8_BAR; PG8_WAIT_L(0); PG8_MMA(1, 0, At, B0); PG8_BAR; PG8_SCHED;
            PG8_STAGE(PG8_SB(0, 1), b2 + hstepB, voffB);
            PG8_WAIT_V(6); PG8_BAR; PG8_MMA(1, 1, At, B1); PG8_BAR;
            PG8_LDB(B0, 1, 0); PG8_SCHED; PG8_LDA(At, 1, 0); PG8_STAGE(PG8_SA(0, 1), a2 + hstep, voffA);
            PG8_WAIT_L(8); PG8_BAR; PG8_WAIT_L(0); PG8_MMA(0, 0, At, B0); PG8_BAR; PG8_SCHED;
            PG8_LDB(B1, 1, 1); PG8_STAGE(PG8_SB(1, 0), b3, voffB);
            PG8_BAR; PG8_WAIT_L(0); PG8_MMA(0, 1, At, B1); PG8_BAR;
            PG8_LDA(At, 1, 1); PG8_STAGE(PG8_SA(1, 0), a3, voffA);
            PG8_BAR; PG8_WAIT_L(0); PG8_MMA(1, 0, At, B0); PG8_BAR; PG8_SCHED;
            PG8_STAGE(PG8_SB(1, 1), b3 + hstepB, voffB);
            PG8_WAIT_V(6); PG8_BAR; PG8_MMA(1, 1, At, B1); PG8_BAR;
            }
        }
        if constexpr (ALIGN_EPI) { if (wr == 0) PG8_BAR; }
        { const int l2 = lane_id_opaque(); E(acc, cur, wr, wc, l2 & 15, l2 >> 4); }
        if (!has_next) break;
        { float z_ = 0.f; LAUNDER_V(z_);
#pragma unroll
        for (int a = 0; a < 2; ++a)
#pragma unroll
            for (int b = 0; b < 2; ++b)
#pragma unroll
                for (int m = 0; m < 4; ++m)
#pragma unroll
                    for (int n = 0; n < 2; ++n) acc[a][b][m][n] = (f32x4){z_, z_, z_, z_}; }
        cur = nxt; cA = nA; cB = nB; cB1 = nB1; ++ui;
        if constexpr (ALIGN_EPI) { if (wr == 1) PG8_BAR; }
    }
    PG8_WAIT_V(0);
    if constexpr (!ALIGN_EPI) { if (wr == 0) PG8_BAR; }
    PG8_BAR;
#undef PG8_SA
#undef PG8_SB
#undef PG8_STAGE
#undef PG8_LDA
#undef PG8_LDB
#undef PG8_MMA
#undef PG8_WAIT_V
#undef PG8_WAIT_L
#undef PG8_BAR
#undef PG8_SCHED
}
}

typedef f32x4 AccT[2][2][4][2];
__device__ __forceinline__ u32x4 pack8(const f32x4 a, const f32x4 b) { u32x4 w; w.x = pk2(a[0], a[1]); w.y = pk2(a[2], a[3]); w.z = pk2(b[0], b[1]); w.w = pk2(b[2], b[3]); return w; }

struct Epi1 {
    static constexpr bool PERM = true;
    const float* rstd; bf16* A; bf16* GLU; bf16* QKV; bf16* G;
    __device__ __forceinline__ void operator()(const AccT& acc, const pg8::Unit& u, int wr, int wc, int fr, int fq) const {
        const int row0 = u.pm * 256 + wr * 64 + fr, lc0 = wc * 32 + 8 * fq, pn = u.pn;
#pragma unroll
        for (int ai = 0; ai < 2; ++ai)
#pragma unroll
            for (int m = 0; m < 4; ++m) {
                const int row = row0 + ai * 128 + m * 16; const float rs = rstd[row];
                f32x4 v[2][2];
#pragma unroll
                for (int bj = 0; bj < 2; ++bj)
#pragma unroll
                    for (int n = 0; n < 2; ++n) v[bj][n] = acc[ai][bj][m][n] * rs;
                if (pn == 0) {
#pragma unroll
                    for (int bj = 0; bj < 2; ++bj) *(u32x4*)(A + (size_t)row * 256 + bj * 128 + lc0) = pack8(v[bj][0], v[bj][1]);
                } else if (pn <= 2) {
                    f32x4 o[2];
#pragma unroll
                    for (int n = 0; n < 2; ++n)
#pragma unroll
                        for (int j = 0; j < 4; ++j) o[n][j] = v[0][n][j] * sigmoidf_(v[1][n][j]);
                    *(u32x4*)(GLU + (size_t)row * 256 + (pn - 1) * 128 + lc0) = pack8(o[0], o[1]);
                } else if (pn <= 8) {
                    const int t = (pn - 3) >> 1; bf16* base = QKV + (size_t)t * (U / 4); const float sc = t == 0 ? C2 : 1.0f;
#pragma unroll
                    for (int bj = 0; bj < 2; ++bj) *(u32x4*)(base + (size_t)row * 512 + ((pn - 3) & 1) * 256 + bj * 128 + lc0) = pack8(v[bj][0] * sc, v[bj][1] * sc);
                } else {
#pragma unroll
                    for (int bj = 0; bj < 2; ++bj) { f32x4 o[2];
#pragma unroll
                        for (int n = 0; n < 2; ++n)
#pragma unroll
                            for (int j = 0; j < 4; ++j) o[n][j] = sigmoidf_(v[bj][n][j]);
                        *(u32x4*)(G + (size_t)row * 3072 + (pn - 9) * 256 + bj * 128 + lc0) = pack8(o[0], o[1]); }
                }
            }
    }
};
template <int P> struct EpiC {
    static constexpr bool PERM = true;
    const bf16* G; bf16* Mg; const float* bias;
    __device__ __forceinline__ void operator()(const AccT& acc, const pg8::Unit& u, int wr, int wc, int fr, int fq) const {
        const int row0 = u.pm * 256 + wr * 64 + fr, col0 = u.pn * 256 + wc * 32 + 8 * fq;
#pragma unroll
        for (int ai = 0; ai < 2; ++ai)
#pragma unroll
            for (int m = 0; m < 4; ++m) {
                const int row = row0 + ai * 128 + m * 16;
#pragma unroll
                for (int bj = 0; bj < 2; ++bj) {
                    const int col = col0 + bj * 128;
                    const u32x4 gw = *(const u32x4*)(G + (size_t)row * 3072 + P * 1024 + col);
                    f32x4 a0 = acc[ai][bj][m][0], a1 = acc[ai][bj][m][1];
                    if (P == 0) { a0 += *(const f32x4*)(bias + col); a1 += *(const f32x4*)(bias + col + 4); }
                    f32x4 o0, o1;
                    o0[0] = bflo(gw.x) * a0[0]; o0[1] = bfhi(gw.x) * a0[1]; o0[2] = bflo(gw.y) * a0[2]; o0[3] = bfhi(gw.y) * a0[3];
                    o1[0] = bflo(gw.z) * a1[0]; o1[1] = bfhi(gw.z) * a1[1]; o1[2] = bflo(gw.w) * a1[2]; o1[3] = bfhi(gw.w) * a1[3];
                    bf16* mp = Mg + (size_t)row * 1024 + col;
                    if (P != 0) { const u32x4 ow = *(const u32x4*)mp;
                        o0[0] += bflo(ow.x); o0[1] += bfhi(ow.x); o0[2] += bflo(ow.y); o0[3] += bfhi(ow.y);
                        o1[0] += bflo(ow.z); o1[1] += bfhi(ow.z); o1[2] += bflo(ow.w); o1[3] += bfhi(ow.w); }
                    *(u32x4*)mp = pack8(o0, o1);
                }
                asm volatile("" ::: "memory");
            }
    }
};
struct EpiD {
    static constexpr bool PERM = false;
    float* H; bf16* HB;
    __device__ __forceinline__ void operator()(const AccT& acc, const pg8::Unit& u, int wr, int wc, int fr, int fq) const {
        const int row0 = u.pm * 256 + wr * 64 + fr, col0 = u.pn * 256 + wc * 32 + 4 * fq;
#pragma unroll
        for (int ai = 0; ai < 2; ++ai)
#pragma unroll
            for (int m = 0; m < 4; ++m) {
                const size_t off = (size_t)(row0 + ai * 128 + m * 16) * 1024 + col0;
#pragma unroll
                for (int bj = 0; bj < 2; ++bj)
#pragma unroll
                    for (int n = 0; n < 2; ++n) { const size_t o = off + bj * 128 + n * 16; const f32x4 hv = *(const f32x4*)(H + o) + acc[ai][bj][m][n];
                        *(f32x4*)(H + o) = hv; u32x2 w; w.x = pk2(hv[0], hv[1]); w.y = pk2(hv[2], hv[3]); *(u32x2*)(HB + o) = w; }
            }
    }
};
struct EpiA2 {
    static constexpr bool PERM = true;
    const float* PW; bf16* HH;
    __device__ __forceinline__ void operator()(const AccT& acc, const pg8::Unit& u, int wr, int wc, int fr, int fq) const {
        const int row0 = u.pm * 256 + wr * 64 + fr, lc0 = wc * 32 + 8 * fq, side = u.pn >> 1;
#pragma unroll
        for (int ai = 0; ai < 2; ++ai)
#pragma unroll
            for (int m = 0; m < 4; ++m) {
                const int row = row0 + ai * 128 + m * 16; const f32x4 pw = *(const f32x4*)(PW + (size_t)row * 4);
                const float rs = pw[0], cw = side ? pw[2] : pw[1];
                f32x4 o[2];
#pragma unroll
                for (int n = 0; n < 2; ++n)
#pragma unroll
                    for (int j = 0; j < 4; ++j) { const float a1 = acc[ai][0][m][n][j] * rs, a3 = acc[ai][1][m][n][j] * rs; o[n][j] = cw * a1 * sigmoidf_(a1) * a3; }
                *(u32x4*)(HH + (size_t)row * 512 + side * 256 + (u.pn & 1) * 128 + lc0) = pack8(o[0], o[1]);
            }
    }
};
struct EpiB2 {
    static constexpr bool PERM = true;
    bf16* Y;
    __device__ __forceinline__ void operator()(const AccT& acc, const pg8::Unit& u, int wr, int wc, int fr, int fq) const {
        const int row0 = u.pm * 256 + wr * 64 + fr, col0 = u.pn * 256 + wc * 32 + 8 * fq;
#pragma unroll
        for (int ai = 0; ai < 2; ++ai)
#pragma unroll
            for (int m = 0; m < 4; ++m) {
                bf16* rp = Y + (size_t)(row0 + ai * 128 + m * 16) * 1024 + col0;
#pragma unroll
                for (int bj = 0; bj < 2; ++bj) *(u32x4*)(rp + bj * 128) = pack8(acc[ai][bj][m][0], acc[ai][bj][m][1]);
            }
    }
};
struct MoeOrder {
    int NP, G, c, mode; const LAS int* pcls; const bf16* W;
    __device__ bool next(int i, pg8::Unit& u) const { const long L = (long)i * G + c; if (L >= (long)NP * 4) return false; u.pm = (int)(L >> 2); u.pn = (int)(L & 3); return true; }
    __device__ __forceinline__ const char* bptr(const pg8::Unit& u, int side) const {
        const int cls = __builtin_amdgcn_readfirstlane(pcls[u.pm]); const int grp = cls / 6, pr = cls % 6;
        const int ea = pr < 3 ? 0 : (pr < 5 ? 1 : 2), eb = pr < 3 ? pr + 1 : (pr < 5 ? pr - 1 : 3);
        if (mode == 0) { const int e = grp * 4 + (u.pn < 2 ? ea : eb); return (const char*)W + ((size_t)e * 512 + (size_t)(u.pn & 1) * 256) * 1024 * 2; }
        const int e = grp * 4 + (side ? eb : ea); return (const char*)W + ((size_t)e * 1024 + (size_t)u.pn * 256) * 256 * 2;
    }
};

#define XB_TMO      128
#define XB_XCNT(j)  (256  + 64 * (j))
#define XB_XSUB(j)  (1280 + 64 * (j))
#define XB_XGEN(j)  (2304 + 64 * (j))
#define XB_TOP      3328
#define XB_TOPGEN   3392
#define XCD_BAR_WORDS 3456
#define XB_SPIN_CAP (1u << 24)
__device__ __forceinline__ unsigned xb_ld(unsigned* p)              { return __hip_atomic_load(p, __ATOMIC_RELAXED, __HIP_MEMORY_SCOPE_AGENT); }
__device__ __forceinline__ unsigned xb_add(unsigned* p, unsigned v) { return __hip_atomic_fetch_add(p, v, __ATOMIC_RELAXED, __HIP_MEMORY_SCOPE_AGENT); }
__device__ __forceinline__ unsigned xb_xcc_id() { return (unsigned)__builtin_amdgcn_s_getreg((3 << 11) | 20) & 0xFu; }
#define XB_SPIN(cond, bar) do { unsigned _sp = 0; while (cond) { __builtin_amdgcn_s_sleep(1); \
    if ((++_sp & 255u) == 0u) { if (xb_ld(&(bar)[XB_TMO])) break; if (_sp > XB_SPIN_CAP) { atomicAdd(&(bar)[XB_TMO], 1u); break; } } } } while (0)
struct XcdBarrier { unsigned* bar; unsigned x; volatile LAS unsigned* st; };
__device__ __forceinline__ XcdBarrier xcd_barrier_post(unsigned* bar, volatile LAS unsigned* st) {
    XcdBarrier b; b.bar = bar; b.x = xb_xcc_id(); b.st = st;
    if (threadIdx.x == 0) (void)xb_add(&bar[XB_XCNT(b.x)], 1u);
    return b;
}
__device__ __forceinline__ void xcd_barrier_complete(unsigned* bar, unsigned x, unsigned& nloc, unsigned& nx) {
    const unsigned G = gridDim.x * gridDim.y * gridDim.z;
    unsigned sum, cnt, mine, sp = 0u;
    for (;;) {
        sum = 0u; cnt = 0u; mine = 0u;
#pragma unroll
        for (unsigned j = 0; j < 16; ++j) { const unsigned c = xb_ld(&bar[XB_XCNT(j)]); sum += c; cnt += (c > 0u) ? 1u : 0u; mine = (j == x) ? c : mine; }
        if (sum == G) break;
        __builtin_amdgcn_s_sleep(1);
        if ((++sp & 255u) == 0u) { if (xb_ld(&bar[XB_TMO])) break; if (sp > XB_SPIN_CAP) { atomicAdd(&bar[XB_TMO], 1u); break; } }
    }
    nloc = mine > 0u ? mine : 1u; nx = cnt > 0u ? cnt : 1u;
}
__device__ __forceinline__ void xcd_barrier(const XcdBarrier& b) {
    asm volatile("s_waitcnt vmcnt(0)" ::: "memory");
    __syncthreads();
    if (threadIdx.x == 0) {
        unsigned* bar = b.bar;
        __builtin_amdgcn_s_waitcnt(0);
        unsigned nloc = b.st[0], nx = b.st[1];
        if (nloc == 0u) { xcd_barrier_complete(bar, b.x, nloc, nx); b.st[0] = nloc; b.st[1] = nx; }
        const unsigned old = xb_add(&bar[XB_XSUB(b.x)], 1u);
        const unsigned gen = old / nloc;
        if (old + 1u == (gen + 1u) * nloc) {
            __builtin_amdgcn_fence(__ATOMIC_RELEASE, "agent");
            asm volatile("s_waitcnt vmcnt(0)" ::: "memory");
            const unsigned og = xb_add(&bar[XB_TOP], 1u);
            const unsigned tg = og / nx;
            if (og + 1u == (tg + 1u) * nx) xb_add(&bar[XB_TOPGEN], 1u);
            else XB_SPIN(xb_ld(&bar[XB_TOPGEN]) == tg, bar);
            __builtin_amdgcn_fence(__ATOMIC_ACQUIRE, "agent");
            xb_add(&bar[XB_XGEN(b.x)], 1u);
            asm volatile("s_waitcnt vmcnt(0)" ::: "memory");
        } else {
            XB_SPIN(xb_ld(&bar[XB_XGEN(b.x)]) == gen, bar);
            __builtin_amdgcn_fence(__ATOMIC_ACQUIRE, "agent");
            asm volatile("s_waitcnt vmcnt(0)" ::: "memory");
        }
    }
    __syncthreads();
}

struct Params { const float* in[25]; float* out; unsigned char* ws; int ph_lo, ph_hi; };
enum { I_X = 0, I_META, I_N1G, I_WIN, I_BF, I_PW, I_PB, I_PS, I_CW, I_CB, I_LNG, I_LNB, I_WOA, I_WOB, I_WOC, I_WO, I_N2G, I_RGW, I_RGB, I_REW, I_REB, I_W1, I_W3, I_W2, I_FG };

struct Frame {
    LAS unsigned char* lds;
    int tid, lane, wave, vcu, G, bx;
};
__device__ __forceinline__ unsigned long long ptab_get(const Frame& F, int i) { const LAS unsigned* t = (const LAS unsigned*)(F.lds + LC_PTAB) + 2 * i; const unsigned lo = __builtin_amdgcn_readfirstlane(t[0]), hi = __builtin_amdgcn_readfirstlane(t[1]); return ((unsigned long long)hi << 32) | lo; }
#define INP(i) ((const float*)ptab_get(F, (i)))
#define WSP() ((unsigned char*)ptab_get(F, 25))
#define DOP() ((unsigned char*)ptab_get(F, 26))

__device__ __forceinline__ void tr_item(const float* W, int ldw, int scol0, const float* gk, bf16* WT, int ldt, int drow0, int k0, LAS float* scr, int lane) {
#pragma unroll 8
    for (int i = 0; i < 32; ++i) { const int kk = 2 * i + (lane >> 5); float v = W[(size_t)(k0 + kk) * ldw + scol0 + (lane & 31)]; if (gk) v *= gk[k0 + kk]; scr[kk * 33 + (lane & 31)] = v; }
    LDS_WAIT(); asm volatile("" ::: "memory");
    const int c = lane & 7;
#pragma unroll
    for (int j = 0; j < 4; ++j) { const int n = (lane >> 3) + 8 * j; const LAS float* s = scr + (8 * c) * 33 + n;
        u32x4 o; o.x = pk2(s[0 * 33], s[1 * 33]); o.y = pk2(s[2 * 33], s[3 * 33]); o.z = pk2(s[4 * 33], s[5 * 33]); o.w = pk2(s[6 * 33], s[7 * 33]);
        *(u32x4*)(WT + (size_t)(drow0 + n) * ldt + k0 + 8 * c) = o; }
    LDS_WAIT(); asm volatile("" ::: "memory");
}
__device__ __forceinline__ int map1(int n) {
    const int tile = n >> 8, r = n & 255;
    if (tile == 0) return n;
    if (tile <= 2) { const int c = (tile - 1) * 128 + (r & 127); return (r < 128 ? 256 : 512) + c; }
    if (tile <= 8) return n;
    return n + 8;
}
__device__ __forceinline__ void convert_weights(Frame& F, int l) {
    LAS float* scr = (LAS float*)(F.lds + F.wave * 16384);
    const int gw = F.vcu * NWAVES + F.wave, NGW = F.G * NWAVES, lane = F.lane;
    const float* g1 = INP(I_N1G) + (size_t)l * D; const float* g2 = INP(I_N2G) + (size_t)l * D;
    unsigned char* ws = WSP();
    { const float* W = INP(I_WIN) + (size_t)l * D * NIN; bf16* WT = (bf16*)(ws + WS_W1T);
      for (int it = gw; it < 16 * 168; it += NGW) { const int kb = it / 168, nb = it % 168; tr_item(W, NIN, map1(nb * 32), g1, WT, 1024, nb * 32, kb * 64, scr, lane); } }
    { const float* W = INP(I_WOB) + (size_t)l * 256 * D; bf16* WT = (bf16*)(ws + WS_WBT);
      for (int it = gw; it < 4 * 32; it += NGW) { const int kb = it / 32, nb = it % 32; tr_item(W, 1024, nb * 32, nullptr, WT, 256, nb * 32, kb * 64, scr, lane); } }
    { const float* W = INP(I_WOC) + (size_t)l * 512 * D; bf16* WT = (bf16*)(ws + WS_WCT);
      for (int it = gw; it < 8 * 32; it += NGW) { const int kb = it / 32, nb = it % 32; tr_item(W, 1024, nb * 32, nullptr, WT, 512, nb * 32, kb * 64, scr, lane); } }
    { const float* W = INP(I_WO) + (size_t)l * D * D; bf16* WT = (bf16*)(ws + WS_WOT);
      for (int it = gw; it < 16 * 32; it += NGW) { const int kb = it / 32, nb = it % 32; tr_item(W, 1024, nb * 32, nullptr, WT, 1024, nb * 32, kb * 64, scr, lane); } }
    { bf16* WT = (bf16*)(ws + WS_W13T);
      for (int it = gw; it < 16 * 256; it += NGW) { const int e = it >> 8, r = it & 255, kb = r >> 4, nb = r & 15, n0 = nb * 32, jt = n0 >> 8, rr = n0 & 255;
        const float* W = (rr < 128 ? INP(I_W1) : INP(I_W3)) + ((size_t)l * 16 + e) * D * 256;
        tr_item(W, 256, jt * 128 + (rr & 127), g2, WT + (size_t)e * 512 * 1024, 1024, n0, kb * 64, scr, lane); } }
    { bf16* WT = (bf16*)(ws + WS_W2T);
      for (int it = gw; it < 16 * 128; it += NGW) { const int e = it >> 7, r = it & 127, kb = r >> 5, nb = r & 31;
        const float* W = INP(I_W2) + ((size_t)l * 16 + e) * 256 * D;
        tr_item(W, 1024, nb * 32, nullptr, WT + (size_t)e * 1024 * 256, 256, nb * 32, kb * 64, scr, lane); } }
    { const float* pw = INP(I_PW) + (size_t)l * 4 * 64 * 64; const float* ps = INP(I_PS) + (size_t)l * 256; const float* pb = INP(I_PB) + (size_t)l * 256;
      const float* wa = INP(I_WOA) + (size_t)l * 256 * D; bf16* WT = (bf16*)(ws + WS_WAT); float* bias = (float*)(ws + WS_BIASA);
      const int gt = F.vcu * 512 + F.tid, NT = F.G * 512;
      for (int idx = gt; idx < 256 * 1024; idx += NT) { const int n = idx & 1023, kk = idx >> 10, grp = kk >> 6, c = kk & 63; float s = 0.f;
        for (int d = 0; d < 64; ++d) s += pw[(grp * 64 + c) * 64 + d] * ps[grp * 64 + d] * wa[(size_t)(grp * 64 + d) * D + n];
        WT[(size_t)n * 256 + kk] = (bf16)f2bf(s); }
      for (int n = gt; n < 1024; n += NT) { float s = 0.f; for (int d = 0; d < 256; ++d) s += pb[d] * ps[d] * wa[(size_t)d * D + n]; bias[n] = s; }
      float* wfg = (float*)(ws + WS_WFG); const float* win = INP(I_WIN) + (size_t)l * D * NIN;
      for (int idx = gt; idx < 8 * 1024; idx += NT) { const int c = idx >> 10, k = idx & 1023; wfg[idx] = g1[k] * win[(size_t)k * NIN + 2304 + c]; }
      float* rg = (float*)(ws + WS_RG); const float* re = INP(I_REW) + (size_t)l * D * 16; const float* rgw = INP(I_RGW) + (size_t)l * D * 4;
      for (int idx = gt; idx < 20 * 1024; idx += NT) { const int c = idx >> 10, k = idx & 1023; rg[idx] = g2[k] * (c < 16 ? re[(size_t)k * 16 + c] : rgw[(size_t)k * 4 + (c - 16)]); } }
}
__device__ __forceinline__ void init_rows(Frame& F) {
    const int gw = F.vcu * NWAVES + F.wave, NGW = F.G * NWAVES, lane = F.lane;
    float* H = (float*)(WSP() + WS_H); bf16* HB = (bf16*)(WSP() + WS_HB); float* rstd1 = (float*)(WSP() + WS_RSTD1);

#pragma unroll 1
for (int row = gw; row < TM; row += NGW) {
        const float* src = row < TX ? INP(I_X) + (size_t)row * D : (row - TX < NMETA ? INP(I_META) + (size_t)(row - TX) * D : nullptr);
        f32x4 v[4]; float ss = 0.f;
#pragma unroll
        for (int j = 0; j < 4; ++j) { float z_ = 0.f; LAUNDER_V(z_); v[j] = src ? *(const f32x4*)(src + 4 * lane + 256 * j) : (f32x4){z_, z_, z_, z_}; ss += v[j][0] * v[j][0] + v[j][1] * v[j][1] + v[j][2] * v[j][2] + v[j][3] * v[j][3]; }
        ss = wave_sum(ss);
#pragma unroll
        for (int j = 0; j < 4; ++j) { *(f32x4*)(H + (size_t)row * D + 4 * lane + 256 * j) = v[j]; u32x2 w; w.x = pk2(v[j][0], v[j][1]); w.y = pk2(v[j][2], v[j][3]); *(u32x2*)(HB + (size_t)row * D + 4 * lane + 256 * j) = w; }
        if (lane == 0) rstd1[row] = rsqrtf(ss * (1.0f / D) + EPS);
    }
}

__device__ __forceinline__ int srcrow(bool isx, int b, int t) {
    if (t >= 0) return (isx ? b * SEQ : TX) + t;
    if (isx) { const int mm = NMETA + t; return mm >= 0 ? TX + mm : -1; }
    return -1;
}
__device__ __forceinline__ void phase_S(Frame& F, int l) {
    LAS unsigned char* lds = F.lds; const int wave = F.wave;
#pragma unroll 1
    for (int item = F.vcu; item < 516; item += F.G) {
        const bool isx = item < 512; const int row0 = isx ? item * 64 : TX + (item - 512) * 64; const int b = isx ? (item * 64) / SEQ : 0; const int t0 = isx ? (item * 64) % SEQ : (item - 512) * 64;
        { unsigned char* ws = WSP(); LAUNDER_S(ws); int tid = F.tid; LAUNDER_V(tid); const int lane = tid & 63;
          const bf16* HB = (const bf16*)(ws + WS_HB); const float* rstd1 = (const float*)(ws + WS_RSTD1); const float* wfg = (const float*)(ws + WS_WFG);
          float* LFT = (float*)(ws + WS_LFT); float* LFTM = (float*)(ws + WS_LFTM); const float* bfg = INP(I_BF) + l * 8;
          LAS float* W = (LAS float*)lds;
#pragma unroll 1
          for (int i = tid; i < 2048; i += 512) *(LAS f32x4*)(W + 4 * i) = *(const f32x4*)(wfg + 4 * i);
          __syncthreads();
#pragma unroll 1
          for (int rr = wave; rr < 64; rr += 8) { const int row = row0 + rr; float xv[16];
#pragma unroll
            for (int j = 0; j < 2; ++j) { const u32x4 w = *(const u32x4*)(HB + (size_t)row * D + 8 * lane + 512 * j);
                xv[8 * j + 0] = bflo(w.x); xv[8 * j + 1] = bfhi(w.x); xv[8 * j + 2] = bflo(w.y); xv[8 * j + 3] = bfhi(w.y); xv[8 * j + 4] = bflo(w.z); xv[8 * j + 5] = bfhi(w.z); xv[8 * j + 6] = bflo(w.w); xv[8 * j + 7] = bfhi(w.w); }
            float mine = 0.f;
#pragma unroll
            for (int c = 0; c < 8; ++c) { float s = 0.f;
#pragma unroll
                for (int j = 0; j < 2; ++j) { const f32x4 w0 = *(const LAS f32x4*)(W + c * 1024 + 8 * lane + 512 * j), w1 = *(const LAS f32x4*)(W + c * 1024 + 8 * lane + 512 * j + 4);
                    s += xv[8 * j] * w0[0] + xv[8 * j + 1] * w0[1] + xv[8 * j + 2] * w0[2] + xv[8 * j + 3] * w0[3] + xv[8 * j + 4] * w1[0] + xv[8 * j + 5] * w1[1] + xv[8 * j + 6] * w1[2] + xv[8 * j + 7] * w1[3]; }
                s = wave_sum(s); if (lane == c) mine = s; }
            if (lane < 8) { const float xg = mine * rstd1[row] + bfg[lane]; const float lf = fminf(xg, 0.f) - 0.69314718056f * __builtin_amdgcn_logf(1.0f + __expf(-fabsf(xg)));
                if (isx) LFT[(size_t)(b * 8 + lane) * SEQ + t0 + rr] = lf; else LFTM[lane * 256 + t0 + rr] = lf; } }
          __syncthreads(); }
        { unsigned char* ws = WSP(); LAUNDER_S(ws); int tid = F.tid; LAUNDER_V(tid);
          const bf16* Ab = (const bf16*)(ws + WS_A); bf16* DIFF = (bf16*)(ws + WS_DIFF);
          LAS unsigned char* T = lds;
#pragma unroll 1
          for (int i = tid; i < 79 * 32; i += 512) { const int s = i >> 5, ch = i & 31; const int r = srcrow(isx, b, t0 + s - 15);
              unsigned z_ = 0u; LAUNDER_V(z_);
              *(LAS u32x4*)(T + s * 512 + ch * 16) = r >= 0 ? *(const u32x4*)(Ab + (size_t)r * 256 + ch * 8) : (u32x4){z_, z_, z_, z_}; }
          __syncthreads();
#pragma unroll 1
          for (int i = tid; i < 64 * 32; i += 512) { const int r = i >> 5, ch = i & 31, grp = ch >> 3, w = 2 << grp; const int cnt = isx ? w : min(t0 + r + 1, w);
              float s[8];
#pragma unroll
              for (int j = 0; j < 8; ++j) s[j] = 0.f;
#pragma unroll 1
              for (int d = 0; d < cnt; ++d) { const u32x4 v = *(const LAS u32x4*)(T + (15 + r - d) * 512 + ch * 16);
                  s[0] += bflo(v.x); s[1] += bfhi(v.x); s[2] += bflo(v.y); s[3] += bfhi(v.y); s[4] += bflo(v.z); s[5] += bfhi(v.z); s[6] += bflo(v.w); s[7] += bfhi(v.w); }
              const u32x4 a = *(const LAS u32x4*)(T + (15 + r) * 512 + ch * 16); const float ic = 1.0f / (float)cnt;
              u32x4 o; o.x = pk2(s[0] * ic - bflo(a.x), s[1] * ic - bfhi(a.x)); o.y = pk2(s[2] * ic - bflo(a.y), s[3] * ic - bfhi(a.y));
              o.z = pk2(s[4] * ic - bflo(a.z), s[5] * ic - bfhi(a.z)); o.w = pk2(s[6] * ic - bflo(a.w), s[7] * ic - bfhi(a.w));
              *(u32x4*)(DIFF + (size_t)(row0 + r) * 256 + ch * 8) = o; }
          __syncthreads(); }
        { unsigned char* ws = WSP(); LAUNDER_S(ws); int tid = F.tid; LAUNDER_V(tid);
          const bf16* GLU = (const bf16*)(ws + WS_GLU);
          LAS unsigned char* T = lds;
          LAS float* Yt = (LAS float*)(lds + 49152);
#pragma unroll 1
          for (int i = tid; i < 94 * 32; i += 512) { const int s = i >> 5, ch = i & 31; const int r = srcrow(isx, b, t0 + s - 30);
              unsigned z_ = 0u; LAUNDER_V(z_);
              *(LAS u32x4*)(T + s * 512 + ch * 16) = r >= 0 ? *(const u32x4*)(GLU + (size_t)r * 256 + ch * 8) : (u32x4){z_, z_, z_, z_}; }
          __syncthreads();
          { const float* cw = INP(I_CW) + (size_t)l * 31 * 256; const float* cb = INP(I_CB) + l * 256;
            const int cp = tid & 127, strip = tid >> 7; f32x2 wv[31];
#pragma unroll
            for (int j = 0; j < 31; ++j) wv[j] = *(const f32x2*)(cw + j * 256 + 2 * cp);
            const f32x2 bias = *(const f32x2*)(cb + 2 * cp);
#pragma unroll 1
            for (int hh = 0; hh < 2; ++hh) { const int rb = 32 * hh + 8 * strip; f32x2 acc[8];
#pragma unroll
                for (int r = 0; r < 8; ++r) acc[r] = bias;
#pragma unroll
                for (int i = 0; i < 38; ++i) { const unsigned xw = *(const LAS unsigned*)(T + (rb + i) * 512 + cp * 4); const f32x2 xx = {bflo(xw), bfhi(xw)};
#pragma unroll
                    for (int r = 0; r < 8; ++r) { const int j = i - r; if (j >= 0 && j <= 30) acc[r] += wv[j] * xx; } }
#pragma unroll
                for (int r = 0; r < 8; ++r) *(LAS f32x2*)(Yt + (rb + r) * 256 + 2 * cp) = acc[r]; } }
          __syncthreads();
          { unsigned char* ws2 = WSP(); LAUNDER_S(ws2); int tid2 = F.tid; LAUNDER_V(tid2); const int lane = tid2 & 63;
            bf16* BP = (bf16*)(ws2 + WS_BP); const float* lng = INP(I_LNG) + l * 256; const float* lnb = INP(I_LNB) + l * 256;
#pragma unroll 1
            for (int rr = wave; rr < 64; rr += 8) { const f32x4 v = *(const LAS f32x4*)(Yt + rr * 256 + 4 * lane);
              const float mean = wave_sum(v[0] + v[1] + v[2] + v[3]) * (1.0f / 256.0f); const f32x4 dv = v - mean;
              const float var = wave_sum(dv[0] * dv[0] + dv[1] * dv[1] + dv[2] * dv[2] + dv[3] * dv[3]) * (1.0f / 256.0f); const float rs = rsqrtf(var + EPS);
              const f32x4 gg = *(const f32x4*)(lng + 4 * lane), bb = *(const f32x4*)(lnb + 4 * lane); f32x4 o = dv * rs * gg + bb;
#pragma unroll
              for (int j = 0; j < 4; ++j) o[j] = o[j] * sigmoidf_(o[j]);
              u32x2 w; w.x = pk2(o[0], o[1]); w.y = pk2(o[2], o[3]); *(u32x2*)(BP + (size_t)(row0 + rr) * 256 + 4 * lane) = w; } }
          __syncthreads(); }
    }
}

constexpr int AT_FL = 0, AT_K = 34816, AT_VT = AT_K + 8192, AT_SC = AT_VT + 8192;
__device__ __forceinline__ void attn_scan(Frame& F, int b, int h, bool meta_only) {
    LAS float* Fl = (LAS float*)(F.lds + AT_FL); LAS float* sc = (LAS float*)(F.lds + AT_SC);
    const float* LFT = (const float*)(WSP() + WS_LFT); const float* LFTM = (const float*)(WSP() + WS_LFTM);
    const int tid = F.tid, lane = F.lane, wave = F.wave;
    __syncthreads();
    if (tid == 0) { float s = 0.f; for (int m = 0; m < 64; ++m) { if (m < (meta_only ? 64 : NMETA)) { s += LFTM[h * 256 + m]; Fl[m] = s * LOG2E; } else Fl[m] = 0.f; if (m == NMETA - 1) sc[16] = s; } }
    if (meta_only) { for (int i = tid; i < 256; i += 512) Fl[64 + i] = 0.f; __syncthreads(); return; }
    float v[16]; const float* src = LFT + (size_t)(b * 8 + h) * SEQ + 16 * tid;
#pragma unroll
    for (int j = 0; j < 4; ++j) { const f32x4 q = *(const f32x4*)(src + 4 * j); v[4 * j] = q[0]; v[4 * j + 1] = q[1]; v[4 * j + 2] = q[2]; v[4 * j + 3] = q[3]; }
#pragma unroll
    for (int j = 1; j < 16; ++j) v[j] += v[j - 1];
    float incl = v[15];
#pragma unroll
    for (int o = 1; o < 64; o <<= 1) { const float up = __shfl_up(incl, o); if (lane >= o) incl += up; }
    if (lane == 63) sc[wave] = incl;
    __syncthreads();
    float off = sc[16];
    for (int w = 0; w < wave; ++w) off += sc[w];
    off += incl - v[15];
#pragma unroll
    for (int j = 0; j < 16; ++j) Fl[64 + 16 * tid + j] = (off + v[j]) * LOG2E;
    __syncthreads();
}
__device__ __forceinline__ void attn_unit(Frame& F, int qrow0, int qpos0, int ntiles, int kvx0, int h) {
    const int tid = F.tid; const int r = tid >> 1, hf = tid & 1;
    const bf16* Q = (const bf16*)(DOP() + DO_Q); const bf16* Kg = (const bf16*)(DOP() + DO_K); const bf16* Vg = (const bf16*)(DOP() + DO_V); bf16* O = (bf16*)(DOP() + DO_Q);
    LAS float* Fl = (LAS float*)(F.lds + AT_FL); LAS unsigned char* Ks = F.lds + AT_K; LAS bf16* VT = (LAS bf16*)(F.lds + AT_VT);
    const int grow = qrow0 + r, qpos = qpos0 + r;
    unsigned qp[16];
#pragma unroll
    for (int j = 0; j < 4; ++j) { const u32x4 w = *(const u32x4*)(Q + (size_t)grow * 512 + h * 64 + hf * 32 + 8 * j); qp[4 * j] = w.x; qp[4 * j + 1] = w.y; qp[4 * j + 2] = w.z; qp[4 * j + 3] = w.w; }
    const float Fq = Fl[qpos < NMETA ? qpos : qpos + 48];
    float mrun = -1e30f, lrun = 0.f, o[32];
#pragma unroll
    for (int d = 0; d < 32; ++d) o[d] = 0.f;
    const int lrow = tid >> 3, lch = tid & 7;

#pragma unroll 1
for (int i = 0; i < ntiles; ++i) {
        const int krow = (i == 0 ? TX : kvx0 + 64 * (i - 1)) + lrow;
        const u32x4 kw = *(const u32x4*)(Kg + (size_t)krow * 512 + h * 64 + lch * 8);
        const u32x4 vw = *(const u32x4*)(Vg + (size_t)krow * 512 + h * 64 + lch * 8);
        __syncthreads();
        *(LAS u32x4*)(Ks + lrow * 128 + lch * 16) = kw;
        { const unsigned vv[4] = {vw.x, vw.y, vw.z, vw.w};
#pragma unroll
          for (int e = 0; e < 4; ++e) { VT[(lch * 8 + 2 * e) * 64 + lrow] = (bf16)(vv[e] & 0xffffu); VT[(lch * 8 + 2 * e + 1) * 64 + lrow] = (bf16)(vv[e] >> 16); } }
        __syncthreads();
        const int kp0 = i == 0 ? 0 : NMETA + 64 * (i - 1);
        if (kp0 > qpos0 + 255) continue;
#pragma unroll 1
        for (int jg = 0; jg < 4; ++jg) {
            float s[16]; float gmax = -1e30f;
#pragma unroll
            for (int jj = 0; jj < 16; ++jj) { const int j = jg * 16 + jj; float d = 0.f;
#pragma unroll
                for (int c = 0; c < 4; ++c) { const u32x4 kk = *(const LAS u32x4*)(Ks + j * 128 + hf * 64 + c * 16);
                    d = dot2bf(kk.x, qp[4 * c], d); d = dot2bf(kk.y, qp[4 * c + 1], d); d = dot2bf(kk.z, qp[4 * c + 2], d); d = dot2bf(kk.w, qp[4 * c + 3], d); }
                d += __shfl_xor(d, 1);
                const bool valid = (i == 0 ? j < NMETA : true) && (kp0 + j <= qpos);
                s[jj] = valid ? d + Fq - Fl[64 * i + j] : -1e30f; gmax = fmaxf(gmax, s[jj]); }
            const float mn = fmaxf(mrun, gmax), alpha = exp2f(mrun - mn); mrun = mn;
            float ps = 0.f; unsigned pp[8];
#pragma unroll
            for (int jj = 0; jj < 16; jj += 2) { const float p0 = exp2f(s[jj] - mn), p1 = exp2f(s[jj + 1] - mn); ps += p0 + p1; pp[jj >> 1] = pk2(p0, p1); }
            lrun = lrun * alpha + ps;
#pragma unroll
            for (int d = 0; d < 32; ++d) { const u32x4 v0 = *(const LAS u32x4*)(VT + (hf * 32 + d) * 64 + jg * 16), v1 = *(const LAS u32x4*)(VT + (hf * 32 + d) * 64 + jg * 16 + 8);
                float a = o[d] * alpha; a = dot2bf(pp[0], v0.x, a); a = dot2bf(pp[1], v0.y, a); a = dot2bf(pp[2], v0.z, a); a = dot2bf(pp[3], v0.w, a);
                a = dot2bf(pp[4], v1.x, a); a = dot2bf(pp[5], v1.y, a); a = dot2bf(pp[6], v1.z, a); a = dot2bf(pp[7], v1.w, a); o[d] = a; }
        }
    }
    const float il = 1.0f / lrun;
#pragma unroll
    for (int j = 0; j < 4; ++j) { u32x4 w; w.x = pk2(o[8 * j] * il, o[8 * j + 1] * il); w.y = pk2(o[8 * j + 2] * il, o[8 * j + 3] * il); w.z = pk2(o[8 * j + 4] * il, o[8 * j + 5] * il); w.w = pk2(o[8 * j + 6] * il, o[8 * j + 7] * il);
        *(u32x4*)(O + (size_t)grow * 512 + h * 64 + hf * 32 + 8 * j) = w; }
}
__device__ __forceinline__ void phase_B(Frame& F) {
    int cur_bh = -1;
    if (F.G == 256) {
        const int v = F.vcu, bh = v >> 3, s = v & 7, b = bh >> 3, h = bh & 7;
        attn_scan(F, b, h, false);
        for (int i = 0; i < 4; ++i) { const int qb = i == 0 ? s : (i == 1 ? 15 - s : (i == 2 ? 16 + s : 31 - s));
            attn_unit(F, b * SEQ + 256 * qb, NMETA + 256 * qb, 1 + 4 * (qb + 1), b * SEQ, h); }
        if (v < 8) { attn_scan(F, 0, v, true); attn_unit(F, TX, 0, 1, 0, v); }
    } else {
        for (int u = F.vcu; u < 1032; u += F.G) {
            if (u < 1024) { const int bh = u >> 5, qb = u & 31, b = bh >> 3, h = bh & 7; if (bh != cur_bh) { attn_scan(F, b, h, false); cur_bh = bh; }
                attn_unit(F, b * SEQ + 256 * qb, NMETA + 256 * qb, 1 + 4 * (qb + 1), b * SEQ, h); }
            else { attn_scan(F, 0, u - 1024, true); cur_bh = -1; attn_unit(F, TX, 0, 1, 0, u - 1024); }
        }
    }
    __syncthreads();
}

__device__ __forceinline__ void class_tables(Frame& F, int l) {
    LAS int* base = (LAS int*)(F.lds + LC_BASE); LAS int* pcls = (LAS int*)(F.lds + LC_PCLS); LAS int* np = (LAS int*)(F.lds + LC_NP);
    const unsigned* gcnt = (const unsigned*)(WSP() + WS_CTL) + CW_GCNT + l * 64;
    __syncthreads();
    if (F.tid == 0) { int p = 0;
#pragma unroll 1
        for (int c = 0; c < NCLS; ++c) { base[c] = p * 256; int n = (int)__hip_atomic_load(gcnt + c, __ATOMIC_RELAXED, __HIP_MEMORY_SCOPE_AGENT); if (n > TM) n = TM; if (n < 0) n = 0; p += (n + 255) >> 8; }
        if (p > 160) p = 160; base[NCLS] = p * 256; np[0] = p; }
    __syncthreads();
    if (F.tid < 160) { const int mypos = F.tid * 256; int c = 0;
#pragma unroll 1
        for (int k = 1; k < NCLS; ++k) if (base[k] <= mypos) c = k;
        pcls[F.tid] = c; }
    __syncthreads();
}
__device__ __forceinline__ void phase_E1(Frame& F, int l) {
    LAS float* R = (LAS float*)F.lds;
    LAS int* rec = (LAS int*)(F.lds + 81920);
    LAS int* lcnt = (LAS int*)(F.lds + LC_CNT); LAS int* wgb = (LAS int*)(F.lds + LC_BASE);
    const float* rg = (const float*)(WSP() + WS_RG); const float* H = (const float*)(WSP() + WS_H);
    const float* reb = INP(I_REB) + l * 16; const float* rgb = INP(I_RGB) + l * 4;
    unsigned* gcnt = (unsigned*)(WSP() + WS_CTL) + CW_GCNT + l * 64; int* route = (int*)(WSP() + WS_ROUTE);
    const int tid = F.tid, lane = F.lane, wave = F.wave;
    for (int i = tid; i < 5120; i += 512) *(LAS f32x4*)(R + 4 * i) = *(const f32x4*)(rg + 4 * i);
    for (int wg = F.vcu; wg < 256; wg += F.G) {
        if (tid < NCLS) lcnt[tid] = 0;
        __syncthreads();

#pragma unroll 1
for (int rr = wave; rr < 129; rr += 8) { const int row = wg * 129 + rr;
            f32x4 hv[4]; float ss = 0.f;
#pragma unroll
            for (int j = 0; j < 4; ++j) { hv[j] = *(const f32x4*)(H + (size_t)row * D + 4 * lane + 256 * j); ss += hv[j][0] * hv[j][0] + hv[j][1] * hv[j][1] + hv[j][2] * hv[j][2] + hv[j][3] * hv[j][3]; }
            const float rstd2 = rsqrtf(wave_sum(ss) * (1.0f / D) + EPS);
            float lg[20];
#pragma unroll
            for (int c = 0; c < 20; ++c) { float s = 0.f;
#pragma unroll
                for (int j = 0; j < 4; ++j) { const f32x4 w = *(const LAS f32x4*)(R + c * 1024 + 4 * lane + 256 * j); s += hv[j][0] * w[0] + hv[j][1] * w[1] + hv[j][2] * w[2] + hv[j][3] * w[3]; }
                lg[c] = wave_sum(s) * rstd2 + (c < 16 ? reb[c] : rgb[c - 16]); }
            int gsel = 0; float gmax = lg[16];
#pragma unroll
            for (int g = 1; g < 4; ++g) if (lg[16 + g] > gmax) { gmax = lg[16 + g]; gsel = g; }
            float gsum = 0.f;
#pragma unroll
            for (int g = 0; g < 4; ++g) gsum += __expf(lg[16 + g] - gmax);
            const float gwt = 1.0f / gsum;
            float el[4];
#pragma unroll
            for (int e = 0; e < 4; ++e) el[e] = gsel == 0 ? lg[e] : (gsel == 1 ? lg[4 + e] : (gsel == 2 ? lg[8 + e] : lg[12 + e]));
            int t1 = 0; float l1 = el[0];
#pragma unroll
            for (int e = 1; e < 4; ++e) if (el[e] > l1) { l1 = el[e]; t1 = e; }
            int t2 = -1; float l2 = -3.0e38f;
#pragma unroll
            for (int e = 0; e < 4; ++e) if (e != t1 && el[e] > l2) { l2 = el[e]; t2 = e; }
            const float w1 = 1.0f / (1.0f + __expf(l2 - l1)), w2 = 1.0f - w1;
            const int ea = min(t1, t2), eb = max(t1, t2); const float cA = gwt * (t1 == ea ? w1 : w2), cB = gwt * (t1 == ea ? w2 : w1);
            const int pr = ea == 0 ? eb - 1 : (ea == 1 ? eb + 1 : 5); int cls = gsel * 6 + pr; if (!(cls >= 0 && cls < NCLS)) cls = 0;
            if (lane == 0) { const int rank = __hip_atomic_fetch_add(&lcnt[cls], 1, __ATOMIC_RELAXED, __HIP_MEMORY_SCOPE_WORKGROUP); rec[rr * 5] = cls; rec[rr * 5 + 1] = rank; rec[rr * 5 + 2] = __float_as_int(cA); rec[rr * 5 + 3] = __float_as_int(cB); rec[rr * 5 + 4] = __float_as_int(rstd2); }
        }
        __syncthreads();
        if (tid < NCLS) { const int n = lcnt[tid]; wgb[tid] = n > 0 ? (int)atomicAdd(gcnt + tid, (unsigned)n) : 0; }
        __syncthreads();
        for (int rr = tid; rr < 129; rr += 512) { const int row = wg * 129 + rr; const int cls = rec[rr * 5];
            int* rp = route + (size_t)row * 8; rp[0] = cls; rp[1] = wgb[cls] + rec[rr * 5 + 1]; rp[2] = rec[rr * 5 + 2]; rp[3] = rec[rr * 5 + 3]; rp[4] = rec[rr * 5 + 4]; }
        __syncthreads();
    }
}
__device__ __forceinline__ void phase_E1b(Frame& F, int l) {
    class_tables(F, l);
    const LAS int* base = (const LAS int*)(F.lds + LC_BASE);
    const int* route = (const int*)(WSP() + WS_ROUTE); const bf16* HB = (const bf16*)(WSP() + WS_HB); bf16* XS = (bf16*)(WSP() + WS_XS); float* PW = (float*)(WSP() + WS_PW);
    const int gw = F.vcu * NWAVES + F.wave, NGW = F.G * NWAVES, lane = F.lane;

#pragma unroll 1
for (int row = gw; row < TM; row += NGW) { const int* rp = route + (size_t)row * 8; const int cls = rp[0]; const int pos = base[cls] + rp[1];
        if (pos < 0 || pos >= NPOSMAX) continue;
#pragma unroll
        for (int j = 0; j < 2; ++j) *(u32x4*)(XS + (size_t)pos * D + 8 * lane + 512 * j) = *(const u32x4*)(HB + (size_t)row * D + 8 * lane + 512 * j);
        if (lane == 0) { f32x4 w; w[0] = __int_as_float(rp[4]); w[1] = __int_as_float(rp[2]); w[2] = __int_as_float(rp[3]); w[3] = 0.f; *(f32x4*)(PW + (size_t)pos * 4) = w; } }
}
__device__ __forceinline__ void phase_E4(Frame& F, int l) {
    class_tables(F, l);
    const LAS int* base = (const LAS int*)(F.lds + LC_BASE);
    const int* route = (const int*)(WSP() + WS_ROUTE); float* H = (float*)(WSP() + WS_H); bf16* HB = (bf16*)(WSP() + WS_HB); const bf16* Y = (const bf16*)(WSP() + WS_Y);
    float* rstd1 = (float*)(WSP() + WS_RSTD1); const float* fg = INP(I_FG); float* out = (float*)DOP();
    const int gw = F.vcu * NWAVES + F.wave, NGW = F.G * NWAVES, lane = F.lane; const bool lastl = (l == DEPTH - 1);

#pragma unroll 1
for (int row = gw; row < TM; row += NGW) { const int* rp = route + (size_t)row * 8; const int cls = rp[0]; int pos = base[cls] + rp[1]; if (pos < 0 || pos >= NPOSMAX) pos = 0;
        f32x4 hv[2][2]; float ss = 0.f;
#pragma unroll
        for (int j = 0; j < 2; ++j) { const u32x4 yw = *(const u32x4*)(Y + (size_t)pos * D + 8 * lane + 512 * j);
            hv[j][0] = *(const f32x4*)(H + (size_t)row * D + 8 * lane + 512 * j); hv[j][1] = *(const f32x4*)(H + (size_t)row * D + 8 * lane + 512 * j + 4);
            hv[j][0][0] += bflo(yw.x); hv[j][0][1] += bfhi(yw.x); hv[j][0][2] += bflo(yw.y); hv[j][0][3] += bfhi(yw.y);
            hv[j][1][0] += bflo(yw.z); hv[j][1][1] += bfhi(yw.z); hv[j][1][2] += bflo(yw.w); hv[j][1][3] += bfhi(yw.w);
#pragma unroll
            for (int q = 0; q < 2; ++q) ss += hv[j][q][0] * hv[j][q][0] + hv[j][q][1] * hv[j][q][1] + hv[j][q][2] * hv[j][q][2] + hv[j][q][3] * hv[j][q][3]; }
        const float rs = rsqrtf(wave_sum(ss) * (1.0f / D) + EPS);
        if (!lastl) {
#pragma unroll
            for (int j = 0; j < 2; ++j) { *(f32x4*)(H + (size_t)row * D + 8 * lane + 512 * j) = hv[j][0]; *(f32x4*)(H + (size_t)row * D + 8 * lane + 512 * j + 4) = hv[j][1];
                *(u32x4*)(HB + (size_t)row * D + 8 * lane + 512 * j) = pack8(hv[j][0], hv[j][1]); }
            if (lane == 0) rstd1[row] = rs;
        } else if (row < TX) {
#pragma unroll
            for (int j = 0; j < 2; ++j) { const f32x4 g0 = *(const f32x4*)(fg + 8 * lane + 512 * j), g1 = *(const f32x4*)(fg + 8 * lane + 512 * j + 4);
                *(f32x4*)(out + (size_t)row * D + 8 * lane + 512 * j) = hv[j][0] * rs * g0; *(f32x4*)(out + (size_t)row * D + 8 * lane + 512 * j + 4) = hv[j][1] * rs * g1; }
        }
    }
}

#define RELANE() do { const int t_ = wv0 * 64 + lane_id_opaque(); F.tid = t_; F.lane = t_ & 63; F.wave = __builtin_amdgcn_readfirstlane(t_ >> 6); \
    int g_ = gridDim.x; LAUNDER_S(g_); int b_ = blockIdx.x; LAUNDER_S(b_); F.G = g_; F.bx = b_; F.vcu = (g_ % 8 == 0) ? (b_ % 8) * (g_ / 8) + b_ / 8 : b_; ll = l; LAUNDER_S(ll); } while (0)
__global__ void __launch_bounds__(NWAVES * 64, 2) fwd_kernel(Params P) {
    extern __shared__ __attribute__((aligned(16))) unsigned char lds_raw[];
    Frame F;
    F.lds = (LAS unsigned char*)lds_raw;
    F.tid = threadIdx.x; F.lane = F.tid & 63; F.wave = __builtin_amdgcn_readfirstlane(F.tid >> 6);
    F.G = gridDim.x; { const int bx = blockIdx.x; F.vcu = (F.G % 8 == 0) ? (bx % 8) * (F.G / 8) + bx / 8 : bx; }
    if (F.tid == 0) { LAS unsigned long long* pt = (LAS unsigned long long*)(F.lds + LC_PTAB);
#pragma unroll
        for (int i = 0; i < 25; ++i) pt[i] = (unsigned long long)P.in[i];
        pt[25] = (unsigned long long)P.ws; pt[26] = (unsigned long long)P.out; }
    for (int u = F.tid; u < 256; u += NWAVES * 64) ((LAS unsigned*)(F.lds + RING_BYTES))[u] = 0u;
    __syncthreads();
    const int lo = P.ph_lo, hi = P.ph_hi;
    const bool use_bar = (hi - lo) > 1;
    unsigned* barw = (unsigned*)(P.ws + WS_CTL) + CW_BAR;
    XcdBarrier bar; bar.bar = barw; bar.x = 0; bar.st = (volatile LAS unsigned*)(F.lds + LC_BAR);
    if (use_bar) bar = xcd_barrier_post(barw, (volatile LAS unsigned*)(F.lds + LC_BAR));
#ifndef PHASE_MASK
#define PHASE_MASK 0x7ff
#endif
#define EN(j) (((PHASE_MASK) >> (j)) & 1)
#define IN(k) (lo <= (k) && (k) < hi)
#define SEAM(k) do { if (IN(k) && IN((k) + 1)) xcd_barrier(bar); } while (0)

    int l = 0, ll = 0; const int wv0 = __builtin_amdgcn_readfirstlane((int)threadIdx.x >> 6);
    if (EN(0) && IN(0)) { RELANE(); convert_weights(F, 0); RELANE(); init_rows(F); }
    SEAM(0);
    for (l = 0; l < DEPTH; ++l) {
        const int pb = 1 + 10 * l;
        if (EN(1) && IN(pb + 0)) {
            RELANE();
            unsigned char* wsl = WSP(); unsigned char* dol = DOP();
            pg8::Gemm g{(const bf16*)(wsl + WS_HB), 1024, 1024, 1 << 20};
            pg8::StaticOrder S; S.init(TM, N1, F.G, F.bx, (const bf16*)(wsl + WS_W1T), 1024);
            Epi1 E{(const float*)(wsl + WS_RSTD1), (bf16*)(wsl + WS_A), (bf16*)(wsl + WS_GLU), (bf16*)(dol + DO_Q), (bf16*)(wsl + WS_G)};
            pg8::gemm_phase<Epi1, pg8::StaticOrder>(F.lds, g, S, E, F.wave);
        }
        SEAM(pb + 0);
        if (EN(2) && IN(pb + 1)) { RELANE(); phase_S(F, ll); }
        SEAM(pb + 1);
        if (EN(3) && IN(pb + 2)) { RELANE(); phase_B(F); }
        SEAM(pb + 2);
        if (EN(4) && IN(pb + 3)) {
            { RELANE(); unsigned char* wsl = WSP(); unsigned char* dol = DOP();
              pg8::Gemm g{(const bf16*)(wsl + WS_DIFF), 256, 256, 1 << 20}; pg8::StaticOrder S; S.init(TM, 1024, F.G, F.bx, (const bf16*)(wsl + WS_WAT), 256);
              EpiC<0> E{(const bf16*)(wsl + WS_G), (bf16*)(dol + DO_MERGED), (const float*)(wsl + WS_BIASA)}; pg8::gemm_phase<EpiC<0>, pg8::StaticOrder>(F.lds, g, S, E, F.wave); }
            { RELANE(); unsigned char* wsl = WSP(); unsigned char* dol = DOP();
              pg8::Gemm g{(const bf16*)(wsl + WS_BP), 256, 256, 1 << 20}; pg8::StaticOrder S; S.init(TM, 1024, F.G, F.bx, (const bf16*)(wsl + WS_WBT), 256);
              EpiC<1> E{(const bf16*)(wsl + WS_G), (bf16*)(dol + DO_MERGED), nullptr}; pg8::gemm_phase<EpiC<1>, pg8::StaticOrder>(F.lds, g, S, E, F.wave); }
            { RELANE(); unsigned char* wsl = WSP(); unsigned char* dol = DOP();
              pg8::Gemm g{(const bf16*)(dol + DO_Q), 512, 512, 1 << 20}; pg8::StaticOrder S; S.init(TM, 1024, F.G, F.bx, (const bf16*)(wsl + WS_WCT), 512);
              EpiC<2> E{(const bf16*)(wsl + WS_G), (bf16*)(dol + DO_MERGED), nullptr}; pg8::gemm_phase<EpiC<2>, pg8::StaticOrder>(F.lds, g, S, E, F.wave); }
        }
        SEAM(pb + 3);
        if (EN(5) && IN(pb + 4)) {
            RELANE();
            unsigned char* wsl = WSP(); unsigned char* dol = DOP();
            pg8::Gemm g{(const bf16*)(dol + DO_MERGED), 1024, 1024, 1 << 20}; pg8::StaticOrder S; S.init(TM, 1024, F.G, F.bx, (const bf16*)(wsl + WS_WOT), 1024);
            EpiD E{(float*)(wsl + WS_H), (bf16*)(wsl + WS_HB)}; pg8::gemm_phase<EpiD, pg8::StaticOrder>(F.lds, g, S, E, F.wave);
        }
        SEAM(pb + 4);
        if (EN(6) && IN(pb + 5)) { RELANE(); phase_E1(F, ll); }
        SEAM(pb + 5);
        if (EN(7) && IN(pb + 6)) { RELANE(); phase_E1b(F, ll); }
        SEAM(pb + 6);
        if (EN(8) && IN(pb + 7)) {
            RELANE(); class_tables(F, ll);
            unsigned char* wsl = WSP();
            const int NP = __builtin_amdgcn_readfirstlane(*(const LAS int*)(F.lds + LC_NP));
            pg8::Gemm g{(const bf16*)(wsl + WS_XS), 1024, 1024, 1 << 20};
            MoeOrder S{NP, F.G, F.vcu, 0, (const LAS int*)(F.lds + LC_PCLS), (const bf16*)(wsl + WS_W13T)};
            EpiA2 E{(const float*)(wsl + WS_PW), (bf16*)(wsl + WS_HH)}; pg8::gemm_phase<EpiA2, MoeOrder>(F.lds, g, S, E, F.wave);
        }
        SEAM(pb + 7);
        if (EN(9) && IN(pb + 8)) {
            RELANE(); class_tables(F, ll);
            unsigned char* wsl = WSP();
            const int NP = __builtin_amdgcn_readfirstlane(*(const LAS int*)(F.lds + LC_NP));
            pg8::Gemm g{(const bf16*)(wsl + WS_HH), 512, 256, 4};
            MoeOrder S{NP, F.G, F.vcu, 1, (const LAS int*)(F.lds + LC_PCLS), (const bf16*)(wsl + WS_W2T)};
            EpiB2 E{(bf16*)(wsl + WS_Y)}; pg8::gemm_phase<EpiB2, MoeOrder>(F.lds, g, S, E, F.wave);
        }
        SEAM(pb + 8);
        if (EN(10) && IN(pb + 9)) { RELANE(); phase_E4(F, ll); if (l + 1 < DEPTH) { RELANE(); convert_weights(F, ll + 1); } }
        SEAM(pb + 9);
    }
#undef IN
#undef SEAM
}

constexpr int N_PHASES = 1 + 10 * DEPTH;

extern "C" void kernel_launch(void* const* d_in, const int* in_sizes, int n_in, void* d_out, int out_size, void* d_ws, size_t ws_size, hipStream_t stream) {
    static int grid = 0;
    if (grid == 0) {
        if (n_in != 25 || out_size != TX * D || ws_size < WS_END) { fprintf(stderr, "kernel_launch: unexpected shapes: n_in %d out %d ws %zu (need %zu)\n", n_in, out_size, ws_size, (size_t)WS_END); grid = -1; return; }
        int dev = 0, cus = 0, per_cu = 0;
        if (hipGetDevice(&dev) != hipSuccess || hipDeviceGetAttribute(&cus, hipDeviceAttributeMultiprocessorCount, dev) != hipSuccess) { grid = -1; return; }
        if (hipFuncSetAttribute((const void*)fwd_kernel, hipFuncAttributeMaxDynamicSharedMemorySize, LDS_BYTES) != hipSuccess) { fprintf(stderr, "kernel_launch: hipFuncSetAttribute failed\n"); grid = -1; return; }
        if (hipOccupancyMaxActiveBlocksPerMultiprocessor(&per_cu, (const void*)fwd_kernel, NWAVES * 64, LDS_BYTES) != hipSuccess || per_cu < 1) fprintf(stderr, "kernel_launch: occupancy query reports %d\n", per_cu);
        (void)hipGetLastError();
        grid = cus;
    }
    if (grid < 0) return;
    (void)hipMemsetAsync((char*)d_ws + WS_CTL, 0, CTL_BYTES, stream);
    Params p{};
    for (int i = 0; i < 25; ++i) p.in[i] = (const float*)d_in[i];
    p.out = (float*)d_out; p.ws = (unsigned char*)d_ws;
#if N_LAUNCH_MODE == 1
    p.ph_lo = 0; p.ph_hi = N_PHASES;
    hipLaunchKernelGGL(fwd_kernel, dim3(grid), dim3(NWAVES * 64), LDS_BYTES, stream, p);
#else
    for (int ph = 0; ph < N_PHASES; ++ph) { p.ph_lo = ph; p.ph_hi = ph + 1; hipLaunchKernelGGL(fwd_kernel, dim3(grid), dim3(NWAVES * 64), LDS_BYTES, stream, p); }
#endif
}
```

```cpp
#include <hip/hip_runtime.h>
#include <cstdio>
#include <cstdint>

#ifndef N_LAUNCH_MODE
#define N_LAUNCH_MODE 1
#endif

#define GAS __attribute__((address_space(1)))
#define LAS __attribute__((address_space(3)))
typedef unsigned short bf16;
typedef float f32x4 __attribute__((ext_vector_type(4)));
typedef float f32x2 __attribute__((ext_vector_type(2)));
typedef unsigned u32x4 __attribute__((ext_vector_type(4)));
typedef unsigned u32x2 __attribute__((ext_vector_type(2)));
typedef short bf16x8 __attribute__((ext_vector_type(8)));
typedef __bf16 bf16x2v __attribute__((ext_vector_type(2)));

constexpr int D = 1024, NB = 4, SEQ = 8192, NMETA = 16, DEPTH = 2;
constexpr int TX = NB * SEQ;
constexpr int TM = TX + 256;
constexpr int NIN = 5384, N1 = 5376;
constexpr int NHEAD = 8;
constexpr int NCLS = 24;
constexpr int NPOSMAX = TM + NCLS * 256;
constexpr float EPS = 1e-6f;
constexpr float LOG2E = 1.4426950408889634f;
constexpr float C2 = 0.125f * LOG2E;
constexpr int NWAVES = 8;

constexpr size_t U = (size_t)TM * 1024 * 2;
constexpr size_t WS_CTL = 0, CTL_BYTES = 1u << 20;
constexpr size_t WS_H = CTL_BYTES;
constexpr size_t WS_HB = WS_H + 2 * U;
constexpr size_t WS_G = WS_HB + U;
constexpr size_t WS_XS = WS_G;
constexpr size_t WS_Y = WS_XS + (size_t)NPOSMAX * 2048;
constexpr size_t WS_HH = WS_Y + (size_t)NPOSMAX * 2048;
static_assert(WS_HH + (size_t)NPOSMAX * 1024 <= WS_G + 3 * U, "MoE overlay fits the gates region");
constexpr size_t WS_A = WS_G + 3 * U;
constexpr size_t WS_GLU = WS_A + U / 4;
constexpr size_t WS_DIFF = WS_GLU + U / 4;
constexpr size_t WS_BP = WS_DIFF + U / 4;
constexpr size_t WS_W1T = WS_BP + U / 4;
constexpr size_t WS_WAT = WS_W1T + (size_t)N1 * 1024 * 2;
constexpr size_t WS_WBT = WS_WAT + 1024 * 256 * 2;
constexpr size_t WS_WCT = WS_WBT + 1024 * 256 * 2;
constexpr size_t WS_WOT = WS_WCT + 1024 * 512 * 2;
constexpr size_t WS_W13T = WS_WOT + 1024 * 1024 * 2;
constexpr size_t WS_W2T = WS_W13T + (size_t)16 * 512 * 1024 * 2;
constexpr size_t WS_WFG = WS_W2T + (size_t)16 * 1024 * 256 * 2;
constexpr size_t WS_RG = WS_WFG + 8 * 1024 * 4;
constexpr size_t WS_BIASA = WS_RG + 20 * 1024 * 4;
constexpr size_t WS_RSTD1 = WS_BIASA + 4096;
constexpr size_t WS_ROUTE = WS_RSTD1 + (size_t)TM * 4;
constexpr size_t WS_PW = WS_ROUTE + (size_t)TM * 32;
constexpr size_t WS_LFT = WS_PW + (size_t)NPOSMAX * 16;
constexpr size_t WS_LFTM = WS_LFT + (size_t)32 * 8192 * 4;
constexpr size_t WS_END = WS_LFTM + 8 * 256 * 4;
static_assert(WS_END <= (size_t)512 * 1024 * 1024, "d_ws map fits 512 MiB");
constexpr size_t DO_Q = 0, DO_K = U / 2, DO_V = U, DO_MERGED = U / 2;
static_assert(DO_V + U / 2 <= (size_t)TX * 1024 * 4, "d_out scratch");
constexpr int CW_BAR = 4096, CW_GCNT = 16384;

constexpr int RING_BYTES = 131072;
constexpr int LC_BAR = RING_BYTES, LC_CNT = RING_BYTES + 64, LC_BASE = RING_BYTES + 192, LC_PCLS = RING_BYTES + 320, LC_NP = RING_BYTES + 960;
constexpr int LC_PTAB = RING_BYTES + 1024;
constexpr int LDS_BYTES = RING_BYTES + 1024 + 7168;

#define LDS_WAIT() asm volatile("s_waitcnt lgkmcnt(0)" ::: "memory")
#define VM_WAIT() asm volatile("s_waitcnt vmcnt(0)" ::: "memory")
#define LAUNDER_S(p) asm volatile("" : "+s"(p))
#define LAUNDER_V(x) asm volatile("" : "+v"(x))
__device__ __forceinline__ int lane_id_opaque() { int x; asm volatile("v_mbcnt_lo_u32_b32 %0, -1, 0\n\tv_mbcnt_hi_u32_b32 %0, -1, %0" : "=v"(x)); return x; }

__device__ __forceinline__ unsigned f2bf(float f) { unsigned u = __builtin_bit_cast(unsigned, f); return (u + 0x7fffu + ((u >> 16) & 1u)) >> 16; }
__device__ __forceinline__ unsigned pk2(float lo, float hi) { return f2bf(lo) | (f2bf(hi) << 16); }
__device__ __forceinline__ float bflo(unsigned w) { return __builtin_bit_cast(float, w << 16); }
__device__ __forceinline__ float bfhi(unsigned w) { return __builtin_bit_cast(float, w & 0xffff0000u); }
__device__ __forceinline__ float wave_sum(float v) {
#pragma unroll
    for (int o = 1; o < 64; o <<= 1) v += __shfl_xor(v, o);
    return v;
}
__device__ __forceinline__ float sigmoidf_(float x) { return 1.0f / (1.0f + __expf(-x)); }
__device__ __forceinline__ float dot2bf(unsigned a, unsigned b, float acc) { return __builtin_amdgcn_fdot2_f32_bf16(__builtin_bit_cast(bf16x2v, a), __builtin_bit_cast(bf16x2v, b), acc, false); }

namespace pg8 {
constexpr int BM = 256, BK = 64, HALF = 128, HTB = HALF * BK * 2, STAGE_BYTES = 8 * HTB, NXCD = 8, WGM = 8;
__host__ __device__ __forceinline__ int lds_byte(int r, int c) { const int st = (r >> 4) * 2 + (c >> 5), rr = r & 15, cc = c & 31, ob = rr * 64 + cc * 2; return st * 1024 + (ob ^ (((ob >> 9) & 1) << 5)); }
__host__ __device__ __forceinline__ void stage_rc(int b, int& R, int& C) { const int st = b / 1024, sb = b % 1024, swz = sb ^ (((sb >> 9) & 1) << 5); R = (st >> 1) * 16 + swz / 64; C = (st & 1) * 32 + (swz % 64) / 2; }
__host__ __device__ __forceinline__ int perm32(int rho) { const int n = rho >> 4, i = rho & 15; return 8 * (i >> 2) + 4 * n + (i & 3); }

struct Unit { int pm, pn; };
struct Gemm { const bf16* A; int K; int ldb; int ksplit; };

struct StaticOrder {
    int nM, nN, nwg, G, c; const bf16* Bt; size_t btile;
    __device__ void init(int M, int N, int G_, int c_, const bf16* Bt_, int ldb) { nM = M / BM; nN = N / BM; nwg = nM * nN; G = G_; c = c_; Bt = Bt_; btile = (size_t)BM * ldb * 2; }
    __device__ bool next(int i, Unit& u) const {
        const long L = (long)i * G + c; if (L >= nwg) return false;
        int wgid = (int)L; { const int q = nwg / NXCD, r = nwg % NXCD, xcd = wgid % NXCD, off = wgid / NXCD; wgid = (xcd < r ? xcd * (q + 1) : r * (q + 1) + (xcd - r) * q) + off; }
        const int nig = WGM * nN, gid = wgid / nig, fm = gid * WGM, gsz = (nM - fm) < WGM ? (nM - fm) : WGM;
        u.pm = fm + ((wgid % nig) % gsz); u.pn = (wgid % nig) / gsz; return true;
    }
    __device__ __forceinline__ const char* bptr(const Unit& u, int) const { return (const char*)Bt + (size_t)u.pn * btile; }
};

template <class Epi, class Sched, bool ALIGN_EPI = true, bool SP2 = true>
__device__ __forceinline__ void gemm_phase(LAS unsigned char* lds, const Gemm g, const Sched& S, const Epi& E, const int wave_id) {
    const int tid = wave_id * 64 + lane_id_opaque();
    const int wid = __builtin_amdgcn_readfirstlane(tid >> 6), lane = tid & 63, wr = wid >> 2, wc = wid & 3, fr = lane & 15, fq = lane >> 4;
    const int K = g.K, nt = K / BK, ldb = g.ldb, ks = g.ksplit;
    unsigned voffA[2], voffB[2];
#pragma unroll
    for (int i = 0; i < 2; ++i) { int R, C; stage_rc(tid * 16 + i * 8192, R, C); const int Rb = Epi::PERM ? ((R & ~31) + perm32(R & 31)) : R;
        voffA[i] = (unsigned)(R * K + C) * 2u; voffB[i] = (unsigned)(Rb * ldb + C) * 2u; }
    const size_t kstep = (size_t)(BK * 2);
    const size_t hstep = (size_t)HALF * K * 2;
    const size_t hstepB = (size_t)HALF * ldb * 2;
    const size_t tstep = 2 * hstep;
    const unsigned ldsw = (unsigned)wid * 1024u;
    const int aoff = lds_byte(wr * 64 + fr, fq * 8), boff = lds_byte(wc * 32 + fr, fq * 8);
#define PG8_SA(b, h) (((b) * 2 + (h)) * HTB)
#define PG8_SB(b, h) ((4 + (b) * 2 + (h)) * HTB)
#define PG8_STAGE(bufoff, gbase, voff) do { _Pragma("unroll") for (int _i = 0; _i < 2; ++_i) \
        __builtin_amdgcn_global_load_lds((const unsigned*)((const char*)(gbase) + (voff)[_i]), (LAS unsigned*)(lds + (bufoff) + ldsw + _i * 8192), 16, 0, 0); } while (0)
#define PG8_LDA(dst, b, h) do { _Pragma("unroll") for (int m = 0; m < 4; ++m) _Pragma("unroll") for (int k = 0; k < 2; ++k) dst[m][k] = *(const LAS bf16x8*)(lds + PG8_SA(b, h) + aoff + m * 2048 + k * 1024); } while (0)
#define PG8_LDB(dst, b, h) do { _Pragma("unroll") for (int n = 0; n < 2; ++n) _Pragma("unroll") for (int k = 0; k < 2; ++k) dst[n][k] = *(const LAS bf16x8*)(lds + PG8_SB(b, h) + boff + n * 2048 + k * 1024); } while (0)
#define PG8_MMA(ai, bj, At, Bt) do { __builtin_amdgcn_s_setprio(1); _Pragma("unroll") for (int m = 0; m < 4; ++m) _Pragma("unroll") for (int n = 0; n < 2; ++n) _Pragma("unroll") for (int k = 0; k < 2; ++k) \
        acc[ai][bj][m][n] = __builtin_amdgcn_mfma_f32_16x16x32_bf16(Bt[n][k], At[m][k], acc[ai][bj][m][n], 0, 0, 0); __builtin_amdgcn_s_setprio(0); } while (0)
#define PG8_WAIT_V(n) asm volatile("s_waitcnt vmcnt(" #n ")" ::: "memory")
#define PG8_WAIT_L(n) asm volatile("s_waitcnt lgkmcnt(" #n ")" ::: "memory")
#define PG8_BAR __builtin_amdgcn_s_barrier()
#define PG8_SCHED __builtin_amdgcn_sched_barrier(0)
    Unit cur, nxt; int ui = 0;
    if (!S.next(0, cur)) return;
    f32x4 acc[2][2][4][2];
    { float z_ = 0.f; LAUNDER_V(z_);
#pragma unroll
    for (int a = 0; a < 2; ++a)
#pragma unroll
        for (int b = 0; b < 2; ++b)
#pragma unroll
            for (int m = 0; m < 4; ++m)
#pragma unroll
                for (int n = 0; n < 2; ++n) acc[a][b][m][n] = (f32x4){z_, z_, z_, z_}; }
    bf16x8 At[4][2], B0[2][2], B1[2][2];
    const char* cA = (const char*)g.A + (size_t)cur.pm * tstep; const char* cB = S.bptr(cur, 0); const char* cB1 = S.bptr(cur, 1) - (size_t)ks * kstep;
    if constexpr (SP2) {
        PG8_STAGE(PG8_SB(0, 0), cB, voffB); PG8_STAGE(PG8_SB(0, 1), cB + hstepB, voffB); PG8_STAGE(PG8_SA(0, 0), cA, voffA); PG8_STAGE(PG8_SA(0, 1), cA + hstep, voffA);
        if (wr == 1) PG8_BAR;
        PG8_WAIT_V(2); PG8_BAR;
        PG8_STAGE(PG8_SB(1, 0), cB + kstep, voffB); PG8_STAGE(PG8_SA(1, 0), cA + kstep, voffA); PG8_STAGE(PG8_SB(1, 1), cB + hstepB + kstep, voffB);
        PG8_WAIT_V(6); PG8_BAR;
    } else {
        PG8_STAGE(PG8_SB(0, 0), cB, voffB); PG8_STAGE(PG8_SA(0, 0), cA, voffA); PG8_STAGE(PG8_SB(0, 1), cB + hstepB, voffB); PG8_STAGE(PG8_SA(0, 1), cA + hstep, voffA);
        if (wr == 1) PG8_BAR;
        PG8_WAIT_V(4); PG8_BAR;
        PG8_STAGE(PG8_SB(1, 0), cB + kstep, voffB); PG8_STAGE(PG8_SA(1, 0), cA + kstep, voffA); PG8_STAGE(PG8_SB(1, 1), cB + hstepB + kstep, voffB);
        PG8_WAIT_V(6); PG8_BAR;
    }
    for (;;) {
        const bool has_next = S.next(ui + 1, nxt);
        const char* nA = has_next ? (const char*)g.A + (size_t)nxt.pm * tstep : cA; const char* nB = has_next ? S.bptr(nxt, 0) : cB;
        const char* nB1 = has_next ? S.bptr(nxt, 1) - (size_t)ks * kstep : cB1;
        for (int t = 0; t < nt; t += 2) {
            const bool last = (t == nt - 2);
            const char* a1 = cA + (size_t)(t + 1) * kstep;
            const char* bside = (t + 2 < ks) ? cB : cB1;
            const char* a2 = last ? nA : cA + (size_t)(t + 2) * kstep; const char* b2 = last ? nB : bside + (size_t)(t + 2) * kstep;
            const char* a3 = a2 + kstep; const char* b3 = b2 + kstep;
            if constexpr (SP2) {
            PG8_LDB(B0, 0, 0); PG8_LDB(B1, 0, 1); PG8_SCHED; PG8_LDA(At, 0, 0); PG8_STAGE(PG8_SA(1, 1), a1 + hstep, voffA);
            PG8_WAIT_V(8); PG8_WAIT_L(0); PG8_BAR; PG8_MMA(0, 0, At, B0); PG8_MMA(0, 1, At, B1); PG8_BAR; PG8_SCHED;
            PG8_LDA(At, 0, 1); PG8_STAGE(PG8_SB(0, 0), b2, voffB); PG8_STAGE(PG8_SB(0, 1), b2 + hstepB, voffB); PG8_STAGE(PG8_SA(0, 0), a2, voffA);
            PG8_WAIT_V(8); PG8_WAIT_L(0); PG8_BAR; PG8_MMA(1, 0, At, B0); PG8_MMA(1, 1, At, B1); PG8_BAR; PG8_SCHED;
            PG8_LDB(B0, 1, 0); PG8_LDB(B1, 1, 1); PG8_SCHED; PG8_LDA(At, 1, 0); PG8_STAGE(PG8_SA(0, 1), a2 + hstep, voffA);
            PG8_WAIT_V(8); PG8_WAIT_L(0); PG8_BAR; PG8_MMA(0, 0, At, B0); PG8_MMA(0, 1, At, B1); PG8_BAR; PG8_SCHED;
            PG8_LDA(At, 1, 1); PG8_STAGE(PG8_SB(1, 0), b3, voffB); PG8_STAGE(PG8_SB(1, 1), b3 + hstepB, voffB); PG8_STAGE(PG8_SA(1, 0), a3, voffA);
            PG8_WAIT_V(8); PG8_WAIT_L(0); PG8_BAR; PG8_MMA(1, 0, At, B0); PG8_MMA(1, 1, At, B1); PG8_BAR; PG8_SCHED;
            } else {
            PG8_LDB(B0, 0, 0); PG8_SCHED; PG8_LDA(At, 0, 0); PG8_STAGE(PG8_SA(1, 1), a1 + hstep, voffA);
            PG8_WAIT_L(8); PG8_BAR; PG8_WAIT_L(0); PG8_MMA(0, 0, At, B0); PG8_BAR; PG8_SCHED;
            PG8_LDB(B1, 0, 1); PG8_STAGE(PG8_SB(0, 0), b2, voffB);
            PG8_BAR; PG8_WAIT_L(0); PG8_MMA(0, 1, At, B1); PG8_BAR;
            PG8_LDA(At, 0, 1); PG8_STAGE(PG8_SA(0, 0), a2, voffA);
            PG8_BAR; PG8_WAIT_L(0); PG8_MMA(1, 0, At, B0); PG8_BAR; PG8_SCHED;
            PG8_STAGE(PG8_SB(0, 1), b2 + hstepB, voffB);
            PG8_WAIT_V(6); PG8_BAR; PG8_MMA(1, 1, At, B1); PG8_BAR;
            PG8_LDB(B0, 1, 0); PG8_SCHED; PG8_LDA(At, 1, 0); PG8_STAGE(PG8_SA(0, 1), a2 + hstep, voffA);
            PG8_WAIT_L(8); PG8_BAR; PG8_WAIT_L(0); PG8_MMA(0, 0, At, B0); PG8_BAR; PG8_SCHED;
            PG8_LDB(B1, 1, 1); PG8_STAGE(PG8_SB(1, 0), b3, voffB);
            PG8_BAR; PG8_WAIT_L(0); PG8_MMA(0, 1, At, B1); PG8_BAR;
            PG8_LDA(At, 1, 1); PG8_STAGE(PG8_SA(1, 0), a3, voffA);
            PG8_BAR; PG8_WAIT_L(0); PG8_MMA(1, 0, At, B0); PG8_BAR; PG8_SCHED;
            PG8_STAGE(PG8_SB(1, 1), b3 + hstepB, voffB);
            PG8_WAIT_V(6); PG8_BAR; PG8_MMA(1, 1, At, B1); PG8_BAR;
            }
        }
        if constexpr (ALIGN_EPI) { if (wr == 0) PG8_BAR; }
        { const int l2 = lane_id_opaque(); E(acc, cur, wr, wc, l2 & 15, l2 >> 4); }
        if (!has_next) break;
        { float z_ = 0.f; LAUNDER_V(z_);
#pragma unroll
        for (int a = 0; a < 2; ++a)
#pragma unroll
            for (int b = 0; b < 2; ++b)
#pragma unroll
                for (int m = 0; m < 4; ++m)
#pragma unroll
                    for (int n = 0; n < 2; ++n) acc[a][b][m][n] = (f32x4){z_, z_, z_, z_}; }
        cur = nxt; cA = nA; cB = nB; cB1 = nB1; ++ui;
        if constexpr (ALIGN_EPI) { if (wr == 1) PG8_BAR; }
    }
    PG8_WAIT_V(0);
    if constexpr (!ALIGN_EPI) { if (wr == 0) PG8_BAR; }
    PG8_BAR;
#undef PG8_SA
#undef PG8_SB
#undef PG8_STAGE
#undef PG8_LDA
#undef PG8_LDB
#undef PG8_MMA
#undef PG8_WAIT_V
#undef PG8_WAIT_L
#undef PG8_BAR
#undef PG8_SCHED
}
}

typedef f32x4 AccT[2][2][4][2];
__device__ __forceinline__ u32x4 pack8(const f32x4 a, const f32x4 b) { u32x4 w; w.x = pk2(a[0], a[1]); w.y = pk2(a[2], a[3]); w.z = pk2(b[0], b[1]); w.w = pk2(b[2], b[3]); return w; }

struct Epi1 {
    static constexpr bool PERM = true;
    const float* rstd; bf16* A; bf16* GLU; bf16* QKV; bf16* G;
    __device__ __forceinline__ void operator()(const AccT& acc, const pg8::Unit& u, int wr, int wc, int fr, int fq) const {
        const int row0 = u.pm * 256 + wr * 64 + fr, lc0 = wc * 32 + 8 * fq, pn = u.pn;
#pragma unroll
        for (int ai = 0; ai < 2; ++ai)
#pragma unroll
            for (int m = 0; m < 4; ++m) {
                const int row = row0 + ai * 128 + m * 16; const float rs = rstd[row];
                f32x4 v[2][2];
#pragma unroll
                for (int bj = 0; bj < 2; ++bj)
#pragma unroll
                    for (int n = 0; n < 2; ++n) v[bj][n] = acc[ai][bj][m][n] * rs;
                if (pn == 0) {
#pragma unroll
                    for (int bj = 0; bj < 2; ++bj) *(u32x4*)(A + (size_t)row * 256 + bj * 128 + lc0) = pack8(v[bj][0], v[bj][1]);
                } else if (pn <= 2) {
                    f32x4 o[2];
#pragma unroll
                    for (int n = 0; n < 2; ++n)
#pragma unroll
                        for (int j = 0; j < 4; ++j) o[n][j] = v[0][n][j] * sigmoidf_(v[1][n][j]);
                    *(u32x4*)(GLU + (size_t)row * 256 + (pn - 1) * 128 + lc0) = pack8(o[0], o[1]);
                } else if (pn <= 8) {
                    const int t = (pn - 3) >> 1; bf16* base = QKV + (size_t)t * (U / 4); const float sc = t == 0 ? C2 : 1.0f;
#pragma unroll
                    for (int bj = 0; bj < 2; ++bj) *(u32x4*)(base + (size_t)row * 512 + ((pn - 3) & 1) * 256 + bj * 128 + lc0) = pack8(v[bj][0] * sc, v[bj][1] * sc);
                } else {
#pragma unroll
                    for (int bj = 0; bj < 2; ++bj) { f32x4 o[2];
#pragma unroll
                        for (int n = 0; n < 2; ++n)
#pragma unroll
                            for (int j = 0; j < 4; ++j) o[n][j] = sigmoidf_(v[bj][n][j]);
                        *(u32x4*)(G + (size_t)row * 3072 + (pn - 9) * 256 + bj * 128 + lc0) = pack8(o[0], o[1]); }
                }
            }
    }
};
template <int P> struct EpiC {
    static constexpr bool PERM = true;
    const bf16* G; bf16* Mg; const float* bias;
    __device__ __forceinline__ void operator()(const AccT& acc, const pg8::Unit& u, int wr, int wc, int fr, int fq) const {
        const int row0 = u.pm * 256 + wr * 64 + fr, col0 = u.pn * 256 + wc * 32 + 8 * fq;
#pragma unroll
        for (int ai = 0; ai < 2; ++ai)
#pragma unroll
            for (int m = 0; m < 4; ++m) {
                const int row = row0 + ai * 128 + m * 16;
#pragma unroll
                for (int bj = 0; bj < 2; ++bj) {
                    const int col = col0 + bj * 128;
                    const u32x4 gw = *(const u32x4*)(G + (size_t)row * 3072 + P * 1024 + col);
                    f32x4 a0 = acc[ai][bj][m][0], a1 = acc[ai][bj][m][1];
                    if (P == 0) { a0 += *(const f32x4*)(bias + col); a1 += *(const f32x4*)(bias + col + 4); }
                    f32x4 o0, o1;
                    o0[0] = bflo(gw.x) * a0[0]; o0[1] = bfhi(gw.x) * a0[1]; o0[2] = bflo(gw.y) * a0[2]; o0[3] = bfhi(gw.y) * a0[3];
                    o1[0] = bflo(gw.z) * a1[0]; o1[1] = bfhi(gw.z) * a1[1]; o1[2] = bflo(gw.w) * a1[2]; o1[3] = bfhi(gw.w) * a1[3];
                    bf16* mp = Mg + (size_t)row * 1024 + col;
                    if (P != 0) { const u32x4 ow = *(const u32x4*)mp;
                        o0[0] += bflo(ow.x); o0[1] += bfhi(ow.x); o0[2] += bflo(ow.y); o0[3] += bfhi(ow.y);
                        o1[0] += bflo(ow.z); o1[1] += bfhi(ow.z); o1[2] += bflo(ow.w); o1[3] += bfhi(ow.w); }
                    *(u32x4*)mp = pack8(o0, o1);
                }
                asm volatile("" ::: "memory");
            }
    }
};
struct EpiD {
    static constexpr bool PERM = false;
    float* H; bf16* HB;
    __device__ __forceinline__ void operator()(const AccT& acc, const pg8::Unit& u, int wr, int wc, int fr, int fq) const {
        const int row0 = u.pm * 256 + wr * 64 + fr, col0 = u.pn * 256 + wc * 32 + 4 * fq;
#pragma unroll
        for (int ai = 0; ai < 2; ++ai)
#pragma unroll
            for (int m = 0; m < 4; ++m) {
                const size_t off = (size_t)(row0 + ai * 128 + m * 16) * 1024 + col0;
#pragma unroll
                for (int bj = 0; bj < 2; ++bj)
#pragma unroll
                    for (int n = 0; n < 2; ++n) { const size_t o = off + bj * 128 + n * 16; const f32x4 hv = *(const f32x4*)(H + o) + acc[ai][bj][m][n];
                        *(f32x4*)(H + o) = hv; u32x2 w; w.x = pk2(hv[0], hv[1]); w.y = pk2(hv[2], hv[3]); *(u32x2*)(HB + o) = w; }
            }
    }
};
struct EpiA2 {
    static constexpr bool PERM = true;
    const float* PW; bf16* HH;
    __device__ __forceinline__ void operator()(const AccT& acc, const pg8::Unit& u, int wr, int wc, int fr, int fq) const {
        const int row0 = u.pm * 256 + wr * 64 + fr, lc0 = wc * 32 + 8 * fq, side = u.pn >> 1;
#pragma unroll
        for (int ai = 0; ai < 2; ++ai)
#pragma unroll
            for (int m = 0; m < 4; ++m) {
                const int row = row0 + ai * 128 + m * 16; const f32x4 pw = *(const f32x4*)(PW + (size_t)row * 4);
                const float rs = pw[0], cw = side ? pw[2] : pw[1];
                f32x4 o[2];
#pragma unroll
                for (int n = 0; n < 2; ++n)
#pragma unroll
                    for (int j = 0; j < 4; ++j) { const float a1 = acc[ai][0][m][n][j] * rs, a3 = acc[ai][1][m][n][j] * rs; o[n][j] = cw * a1 * sigmoidf_(a1) * a3; }
                *(u32x4*)(HH + (size_t)row * 512 + side * 256 + (u.pn & 1) * 128 + lc0) = pack8(o[0], o[1]);
            }
    }
};
struct EpiB2 {
    static constexpr bool PERM = true;
    bf16* Y;
    __device__ __forceinline__ void operator()(const AccT& acc, const pg8::Unit& u, int wr, int wc, int fr, int fq) const {
        const int row0 = u.pm * 256 + wr * 64 + fr, col0 = u.pn * 256 + wc * 32 + 8 * fq;
#pragma unroll
        for (int ai = 0; ai < 2; ++ai)
#pragma unroll
            for (int m = 0; m < 4; ++m) {
                bf16* rp = Y + (size_t)(row0 + ai * 128 + m * 16) * 1024 + col0;
#pragma unroll
                for (int bj = 0; bj < 2; ++bj) *(u32x4*)(rp + bj * 128) = pack8(acc[ai][bj][m][0], acc[ai][bj][m][1]);
            }
    }
};
struct MoeOrder {
    int NP, G, c, mode; const LAS int* pcls; const bf16* W;
    __device__ bool next(int i, pg8::Unit& u) const { const long L = (long)i * G + c; if (L >= (long)NP * 4) return false; u.pm = (int)(L >> 2); u.pn = (int)(L & 3); return true; }
    __device__ __forceinline__ const char* bptr(const pg8::Unit& u, int side) const {
        const int cls = __builtin_amdgcn_readfirstlane(pcls[u.pm]); const int grp = cls / 6, pr = cls % 6;
        const int ea = pr < 3 ? 0 : (pr < 5 ? 1 : 2), eb = pr < 3 ? pr + 1 : (pr < 5 ? pr - 1 : 3);
        if (mode == 0) { const int e = grp * 4 + (u.pn < 2 ? ea : eb); return (const char*)W + ((size_t)e * 512 + (size_t)(u.pn & 1) * 256) * 1024 * 2; }
        const int e = grp * 4 + (side ? eb : ea); return (const char*)W + ((size_t)e * 1024 + (size_t)u.pn * 256) * 256 * 2;
    }
};

#define XB_TMO      128
#define XB_XCNT(j)  (256  + 64 * (j))
#define XB_XSUB(j)  (1280 + 64 * (j))
#define XB_XGEN(j)  (2304 + 64 * (j))
#define XB_TOP      3328
#define XB_TOPGEN   3392
#define XCD_BAR_WORDS 3456
#define XB_SPIN_CAP (1u << 24)
__device__ __forceinline__ unsigned xb_ld(unsigned* p)              { return __hip_atomic_load(p, __ATOMIC_RELAXED, __HIP_MEMORY_SCOPE_AGENT); }
__device__ __forceinline__ unsigned xb_add(unsigned* p, unsigned v) { return __hip_atomic_fetch_add(p, v, __ATOMIC_RELAXED, __HIP_MEMORY_SCOPE_AGENT); }
__device__ __forceinline__ unsigned xb_xcc_id() { return (unsigned)__builtin_amdgcn_s_getreg((3 << 11) | 20) & 0xFu; }
#define XB_SPIN(cond, bar) do { unsigned _sp = 0; while (cond) { __builtin_amdgcn_s_sleep(1); \
    if ((++_sp & 255u) == 0u) { if (xb_ld(&(bar)[XB_TMO])) break; if (_sp > XB_SPIN_CAP) { atomicAdd(&(bar)[XB_TMO], 1u); break; } } } } while (0)
struct XcdBarrier { unsigned* bar; unsigned x; volatile LAS unsigned* st; };
__device__ __forceinline__ XcdBarrier xcd_barrier_post(unsigned* bar, volatile LAS unsigned* st) {
    XcdBarrier b; b.bar = bar; b.x = xb_xcc_id(); b.st = st;
    if (threadIdx.x == 0) (void)xb_add(&bar[XB_XCNT(b.x)], 1u);
    return b;
}
__device__ __forceinline__ void xcd_barrier_complete(unsigned* bar, unsigned x, unsigned& nloc, unsigned& nx) {
    const unsigned G = gridDim.x * gridDim.y * gridDim.z;
    unsigned sum, cnt, mine, sp = 0u;
    for (;;) {
        sum = 0u; cnt = 0u; mine = 0u;
#pragma unroll
        for (unsigned j = 0; j < 16; ++j) { const unsigned c = xb_ld(&bar[XB_XCNT(j)]); sum += c; cnt += (c > 0u) ? 1u : 0u; mine = (j == x) ? c : mine; }
        if (sum == G) break;
        __builtin_amdgcn_s_sleep(1);
        if ((++sp & 255u) == 0u) { if (xb_ld(&bar[XB_TMO])) break; if (sp > XB_SPIN_CAP) { atomicAdd(&bar[XB_TMO], 1u); break; } }
    }
    nloc = mine > 0u ? mine : 1u; nx = cnt > 0u ? cnt : 1u;
}
__device__ __forceinline__ void xcd_barrier(const XcdBarrier& b) {
    asm volatile("s_waitcnt vmcnt(0)" ::: "memory");
    __syncthreads();
    if (threadIdx.x == 0) {
        unsigned* bar = b.bar;
        __builtin_amdgcn_s_waitcnt(0);
        unsigned nloc = b.st[0], nx = b.st[1];
        if (nloc == 0u) { xcd_barrier_complete(bar, b.x, nloc, nx); b.st[0] = nloc; b.st[1] = nx; }
        const unsigned old = xb_add(&bar[XB_XSUB(b.x)], 1u);
        const unsigned gen = old / nloc;
        if (old + 1u == (gen + 1u) * nloc) {
            __builtin_amdgcn_fence(__ATOMIC_RELEASE, "agent");
            asm volatile("s_waitcnt vmcnt(0)" ::: "memory");
            const unsigned og = xb_add(&bar[XB_TOP], 1u);
            const unsigned tg = og / nx;
            if (og + 1u == (tg + 1u) * nx) xb_add(&bar[XB_TOPGEN], 1u);
            else XB_SPIN(xb_ld(&bar[XB_TOPGEN]) == tg, bar);
            __builtin_amdgcn_fence(__ATOMIC_ACQUIRE, "agent");
            xb_add(&bar[XB_XGEN(b.x)], 1u);
            asm volatile("s_waitcnt vmcnt(0)" ::: "memory");
        } else {
            XB_SPIN(xb_ld(&bar[XB_XGEN(b.x)]) == gen, bar);
            __builtin_amdgcn_fence(__ATOMIC_ACQUIRE, "agent");
            asm volatile("s_waitcnt vmcnt(0)" ::: "memory");
        }
    }
    __syncthreads();
}

struct Params { const float* in[25]; float* out; unsigned char* ws; int ph_lo, ph_hi; };
enum { I_X = 0, I_META, I_N1G, I_WIN, I_BF, I_PW, I_PB, I_PS, I_CW, I_CB, I_LNG, I_LNB, I_WOA, I_WOB, I_WOC, I_WO, I_N2G, I_RGW, I_RGB, I_REW, I_REB, I_W1, I_W3, I_W2, I_FG };

struct Frame {
    LAS unsigned char* lds;
    int tid, lane, wave, vcu, G, bx;
};
__device__ __forceinline__ unsigned long long ptab_get(const Frame& F, int i) { const LAS unsigned* t = (const LAS unsigned*)(F.lds + LC_PTAB) + 2 * i; const unsigned lo = __builtin_amdgcn_readfirstlane(t[0]), hi = __builtin_amdgcn_readfirstlane(t[1]); return ((unsigned long long)hi << 32) | lo; }
#define INP(i) ((const float*)ptab_get(F, (i)))
#define WSP() ((unsigned char*)ptab_get(F, 25))
#define DOP() ((unsigned char*)ptab_get(F, 26))

__device__ __forceinline__ void tr_item(const float* W, int ldw, int scol0, const float* gk, bf16* WT, int ldt, int drow0, int k0, LAS float* scr, int lane) {
#pragma unroll 8
    for (int i = 0; i < 32; ++i) { const int kk = 2 * i + (lane >> 5); float v = W[(size_t)(k0 + kk) * ldw + scol0 + (lane & 31)]; if (gk) v *= gk[k0 + kk]; scr[kk * 33 + (lane & 31)] = v; }
    LDS_WAIT(); asm volatile("" ::: "memory");
    const int c = lane & 7;
#pragma unroll
    for (int j = 0; j < 4; ++j) { const int n = (lane >> 3) + 8 * j; const LAS float* s = scr + (8 * c) * 33 + n;
        u32x4 o; o.x = pk2(s[0 * 33], s[1 * 33]); o.y = pk2(s[2 * 33], s[3 * 33]); o.z = pk2(s[4 * 33], s[5 * 33]); o.w = pk2(s[6 * 33], s[7 * 33]);
        *(u32x4*)(WT + (size_t)(drow0 + n) * ldt + k0 + 8 * c) = o; }
    LDS_WAIT(); asm volatile("" ::: "memory");
}
__device__ __forceinline__ int map1(int n) {
    const int tile = n >> 8, r = n & 255;
    if (tile == 0) return n;
    if (tile <= 2) { const int c = (tile - 1) * 128 + (r & 127); return (r < 128 ? 256 : 512) + c; }
    if (tile <= 8) return n;
    return n + 8;
}
__device__ __forceinline__ void convert_weights(Frame& F, int l) {
    LAS float* scr = (LAS float*)(F.lds + F.wave * 16384);
    const int gw = F.vcu * NWAVES + F.wave, NGW = F.G * NWAVES, lane = F.lane;
    const float* g1 = INP(I_N1G) + (size_t)l * D; const float* g2 = INP(I_N2G) + (size_t)l * D;
    unsigned char* ws = WSP();
    { const float* W = INP(I_WIN) + (size_t)l * D * NIN; bf16* WT = (bf16*)(ws + WS_W1T);
      for (int it = gw; it < 16 * 168; it += NGW) { const int kb = it / 168, nb = it % 168; tr_item(W, NIN, map1(nb * 32), g1, WT, 1024, nb * 32, kb * 64, scr, lane); } }
    { const float* W = INP(I_WOB) + (size_t)l * 256 * D; bf16* WT = (bf16*)(ws + WS_WBT);
      for (int it = gw; it < 4 * 32; it += NGW) { const int kb = it / 32, nb = it % 32; tr_item(W, 1024, nb * 32, nullptr, WT, 256, nb * 32, kb * 64, scr, lane); } }
    { const float* W = INP(I_WOC) + (size_t)l * 512 * D; bf16* WT = (bf16*)(ws + WS_WCT);
      for (int it = gw; it < 8 * 32; it += NGW) { const int kb = it / 32, nb = it % 32; tr_item(W, 1024, nb * 32, nullptr, WT, 512, nb * 32, kb * 64, scr, lane); } }
    { const float* W = INP(I_WO) + (size_t)l * D * D; bf16* WT = (bf16*)(ws + WS_WOT);
      for (int it = gw; it < 16 * 32; it += NGW) { const int kb = it / 32, nb = it % 32; tr_item(W, 1024, nb * 32, nullptr, WT, 1024, nb * 32, kb * 64, scr, lane); } }
    { bf16* WT = (bf16*)(ws + WS_W13T);
      for (int it = gw; it < 16 * 256; it += NGW) { const int e = it >> 8, r = it & 255, kb = r >> 4, nb = r & 15, n0 = nb * 32, jt = n0 >> 8, rr = n0 & 255;
        const float* W = (rr < 128 ? INP(I_W1) : INP(I_W3)) + ((size_t)l * 16 + e) * D * 256;
        tr_item(W, 256, jt * 128 + (rr & 127), g2, WT + (size_t)e * 512 * 1024, 1024, n0, kb * 64, scr, lane); } }
    { bf16* WT = (bf16*)(ws + WS_W2T);
      for (int it = gw; it < 16 * 128; it += NGW) { const int e = it >> 7, r = it & 127, kb = r >> 5, nb = r & 31;
        const float* W = INP(I_W2) + ((size_t)l * 16 + e) * 256 * D;
        tr_item(W, 1024, nb * 32, nullptr, WT + (size_t)e * 1024 * 256, 256, nb * 32, kb * 64, scr, lane); } }
    { const float* pw = INP(I_PW) + (size_t)l * 4 * 64 * 64; const float* ps = INP(I_PS) + (size_t)l * 256; const float* pb = INP(I_PB) + (size_t)l * 256;
      const float* wa = INP(I_WOA) + (size_t)l * 256 * D; bf16* WT = (bf16*)(ws + WS_WAT); float* bias = (float*)(ws + WS_BIASA);
      const int gt = F.vcu * 512 + F.tid, NT = F.G * 512;
      for (int idx = gt; idx < 256 * 1024; idx += NT) { const int n = idx & 1023, kk = idx >> 10, grp = kk >> 6, c = kk & 63; float s = 0.f;
        for (int d = 0; d < 64; ++d) s += pw[(grp * 64 + c) * 64 + d] * ps[grp * 64 + d] * wa[(size_t)(grp * 64 + d) * D + n];
        WT[(size_t)n * 256 + kk] = (bf16)f2bf(s); }
      for (int n = gt; n < 1024; n += NT) { float s = 0.f; for (int d = 0; d < 256; ++d) s += pb[d] * ps[d] * wa[(size_t)d * D + n]; bias[n] = s; }
      float* wfg = (float*)(ws + WS_WFG); const float* win = INP(I_WIN) + (size_t)l * D * NIN;
      for (int idx = gt; idx < 8 * 1024; idx += NT) { const int c = idx >> 10, k = idx & 1023; wfg[idx] = g1[k] * win[(size_t)k * NIN + 2304 + c]; }
      float* rg = (float*)(ws + WS_RG); const float* re = INP(I_REW) + (size_t)l * D * 16; const float* rgw = INP(I_RGW) + (size_t)l * D * 4;
      for (int idx = gt; idx < 20 * 1024; idx += NT) { const int c = idx >> 10, k = idx & 1023; rg[idx] = g2[k] * (c < 16 ? re[(size_t)k * 16 + c] : rgw[(size_t)k * 4 + (c - 16)]); } }
}
__device__ __forceinline__ void init_rows(Frame& F) {
    const int gw = F.vcu * NWAVES + F.wave, NGW = F.G * NWAVES, lane = F.lane;
    float* H = (float*)(WSP() + WS_H); bf16* HB = (bf16*)(WSP() + WS_HB); float* rstd1 = (float*)(WSP() + WS_RSTD1);

#pragma unroll 1
for (int row = gw; row < TM; row += NGW) {
        const float* src = row < TX ? INP(I_X) + (size_t)row * D : (row - TX < NMETA ? INP(I_META) + (size_t)(row - TX) * D : nullptr);
        f32x4 v[4]; float ss = 0.f;
#pragma unroll
        for (int j = 0; j < 4; ++j) { float z_ = 0.f; LAUNDER_V(z_); v[j] = src ? *(const f32x4*)(src + 4 * lane + 256 * j) : (f32x4){z_, z_, z_, z_}; ss += v[j][0] * v[j][0] + v[j][1] * v[j][1] + v[j][2] * v[j][2] + v[j][3] * v[j][3]; }
        ss = wave_sum(ss);
#pragma unroll
        for (int j = 0; j < 4; ++j) { *(f32x4*)(H + (size_t)row * D + 4 * lane + 256 * j) = v[j]; u32x2 w; w.x = pk2(v[j][0], v[j][1]); w.y = pk2(v[j][2], v[j][3]); *(u32x2*)(HB + (size_t)row * D + 4 * lane + 256 * j) = w; }
        if (lane == 0) rstd1[row] = rsqrtf(ss * (1.0f / D) + EPS);
    }
}

__device__ __forceinline__ int srcrow(bool isx, int b, int t) {
    if (t >= 0) return (isx ? b * SEQ : TX) + t;
    if (isx) { const int mm = NMETA + t; return mm >= 0 ? TX + mm : -1; }
    return -1;
}
__device__ __forceinline__ void phase_S(Frame& F, int l) {
    LAS unsigned char* lds = F.lds; const int wave = F.wave;
#pragma unroll 1
    for (int item = F.vcu; item < 516; item += F.G) {
        const bool isx = item < 512; const int row0 = isx ? item * 64 : TX + (item - 512) * 64; const int b = isx ? (item * 64) / SEQ : 0; const int t0 = isx ? (item * 64) % SEQ : (item - 512) * 64;
        { unsigned char* ws = WSP(); LAUNDER_S(ws); int tid = F.tid; LAUNDER_V(tid); const int lane = tid & 63;
          const bf16* HB = (const bf16*)(ws + WS_HB); const float* rstd1 = (const float*)(ws + WS_RSTD1); const float* wfg = (const float*)(ws + WS_WFG);
          float* LFT = (float*)(ws + WS_LFT); float* LFTM = (float*)(ws + WS_LFTM); const float* bfg = INP(I_BF) + l * 8;
          LAS float* W = (LAS float*)lds;
#pragma unroll 1
          for (int i = tid; i < 2048; i += 512) *(LAS f32x4*)(W + 4 * i) = *(const f32x4*)(wfg + 4 * i);
          __syncthreads();
#pragma unroll 1
          for (int rr = wave; rr < 64; rr += 8) { const int row = row0 + rr; float xv[16];
#pragma unroll
            for (int j = 0; j < 2; ++j) { const u32x4 w = *(const u32x4*)(HB + (size_t)row * D + 8 * lane + 512 * j);
                xv[8 * j + 0] = bflo(w.x); xv[8 * j + 1] = bfhi(w.x); xv[8 * j + 2] = bflo(w.y); xv[8 * j + 3] = bfhi(w.y); xv[8 * j + 4] = bflo(w.z); xv[8 * j + 5] = bfhi(w.z); xv[8 * j + 6] = bflo(w.w); xv[8 * j + 7] = bfhi(w.w); }
            float mine = 0.f;
#pragma unroll
            for (int c = 0; c < 8; ++c) { float s = 0.f;
#pragma unroll
                for (int j = 0; j < 2; ++j) { const f32x4 w0 = *(const LAS f32x4*)(W + c * 1024 + 8 * lane + 512 * j), w1 = *(const LAS f32x4*)(W + c * 1024 + 8 * lane + 512 * j + 4);
                    s += xv[8 * j] * w0[0] + xv[8 * j + 1] * w0[1] + xv[8 * j + 2] * w0[2] + xv[8 * j + 3] * w0[3] + xv[8 * j + 4] * w1[0] + xv[8 * j + 5] * w1[1] + xv[8 * j + 6] * w1[2] + xv[8 * j + 7] * w1[3]; }
                s = wave_sum(s); if (lane == c) mine = s; }
            if (lane < 8) { const float xg = mine * rstd1[row] + bfg[lane]; const float lf = fminf(xg, 0.f) - 0.69314718056f * __builtin_amdgcn_logf(1.0f + __expf(-fabsf(xg)));
                if (isx) LFT[(size_t)(b * 8 + lane) * SEQ + t0 + rr] = lf; else LFTM[lane * 256 + t0 + rr] = lf; } }
          __syncthreads(); }
        { unsigned char* ws = WSP(); LAUNDER_S(ws); int tid = F.tid; LAUNDER_V(tid);
          const bf16* Ab = (const bf16*)(ws + WS_A); bf16* DIFF = (bf16*)(ws + WS_DIFF);
          LAS unsigned char* T = lds;
#pragma unroll 1
          for (int i = tid; i < 79 * 32; i += 512) { const int s = i >> 5, ch = i & 31; const int r = srcrow(isx, b, t0 + s - 15);
              unsigned z_ = 0u; LAUNDER_V(z_);
              *(LAS u32x4*)(T + s * 512 + ch * 16) = r >= 0 ? *(const u32x4*)(Ab + (size_t)r * 256 + ch * 8) : (u32x4){z_, z_, z_, z_}; }
          __syncthreads();
#pragma unroll 1
          for (int i = tid; i < 64 * 32; i += 512) { const int r = i >> 5, ch = i & 31, grp = ch >> 3, w = 2 << grp; const int cnt = isx ? w : min(t0 + r + 1, w);
              float s[8];
#pragma unroll
              for (int j = 0; j < 8; ++j) s[j] = 0.f;
#pragma unroll 1
              for (int d = 0; d < cnt; ++d) { const u32x4 v = *(const LAS u32x4*)(T + (15 + r - d) * 512 + ch * 16);
                  s[0] += bflo(v.x); s[1] += bfhi(v.x); s[2] += bflo(v.y); s[3] += bfhi(v.y); s[4] += bflo(v.z); s[5] += bfhi(v.z); s[6] += bflo(v.w); s[7] += bfhi(v.w); }
              const u32x4 a = *(const LAS u32x4*)(T + (15 + r) * 512 + ch * 16); const float ic = 1.0f / (float)cnt;
              u32x4 o; o.x = pk2(s[0] * ic - bflo(a.x), s[1] * ic - bfhi(a.x)); o.y = pk2(s[2] * ic - bflo(a.y), s[3] * ic - bfhi(a.y));
              o.z = pk2(s[4] * ic - bflo(a.z), s[5] * ic - bfhi(a.z)); o.w = pk2(s[6] * ic - bflo(a.w), s[7] * ic - bfhi(a.w));
              *(u32x4*)(DIFF + (size_t)(row0 + r) * 256 + ch * 8) = o; }
          __syncthreads(); }
        { unsigned char* ws = WSP(); LAUNDER_S(ws); int tid = F.tid; LAUNDER_V(tid);
          const bf16* GLU = (const bf16*)(ws + WS_GLU);
          LAS unsigned char* T = lds;
          LAS float* Yt = (LAS float*)(lds + 49152);
#pragma unroll 1
          for (int i = tid; i < 94 * 32; i += 512) { const int s = i >> 5, ch = i & 31; const int r = srcrow(isx, b, t0 + s - 30);
              unsigned z_ = 0u; LAUNDER_V(z_);
              *(LAS u32x4*)(T + s * 512 + ch * 16) = r >= 0 ? *(const u32x4*)(GLU + (size_t)r * 256 + ch * 8) : (u32x4){z_, z_, z_, z_}; }
          __syncthreads();
          { const float* cw = INP(I_CW) + (size_t)l * 31 * 256; const float* cb = INP(I_CB) + l * 256;
            const int cp = tid & 127, strip = tid >> 7; f32x2 wv[31];
#pragma unroll
            for (int j = 0; j < 31; ++j) wv[j] = *(const f32x2*)(cw + j * 256 + 2 * cp);
            const f32x2 bias = *(const f32x2*)(cb + 2 * cp);
#pragma unroll 1
            for (int hh = 0; hh < 2; ++hh) { const int rb = 32 * hh + 8 * strip; f32x2 acc[8];
#pragma unroll
                for (int r = 0; r < 8; ++r) acc[r] = bias;
#pragma unroll
                for (int i = 0; i < 38; ++i) { const unsigned xw = *(const LAS unsigned*)(T + (rb + i) * 512 + cp * 4); const f32x2 xx = {bflo(xw), bfhi(xw)};
#pragma unroll
                    for (int r = 0; r < 8; ++r) { const int j = i - r; if (j >= 0 && j <= 30) acc[r] += wv[j] * xx; } }
#pragma unroll
                for (int r = 0; r < 8; ++r) *(LAS f32x2*)(Yt + (rb + r) * 256 + 2 * cp) = acc[r]; } }
          __syncthreads();
          { unsigned char* ws2 = WSP(); LAUNDER_S(ws2); int tid2 = F.tid; LAUNDER_V(tid2); const int lane = tid2 & 63;
            bf16* BP = (bf16*)(ws2 + WS_BP); const float* lng = INP(I_LNG) + l * 256; const float* lnb = INP(I_LNB) + l * 256;
#pragma unroll 1
            for (int rr = wave; rr < 64; rr += 8) { const f32x4 v = *(const LAS f32x4*)(Yt + rr * 256 + 4 * lane);
              const float mean = wave_sum(v[0] + v[1] + v[2] + v[3]) * (1.0f / 256.0f); const f32x4 dv = v - mean;
              const float var = wave_sum(dv[0] * dv[0] + dv[1] * dv[1] + dv[2] * dv[2] + dv[3] * dv[3]) * (1.0f / 256.0f); const float rs = rsqrtf(var + EPS);
              const f32x4 gg = *(const f32x4*)(lng + 4 * lane), bb = *(const f32x4*)(lnb + 4 * lane); f32x4 o = dv * rs * gg + bb;
#pragma unroll
              for (int j = 0; j < 4; ++j) o[j] = o[j] * sigmoidf_(o[j]);
              u32x2 w; w.x = pk2(o[0], o[1]); w.y = pk2(o[2], o[3]); *(u32x2*)(BP + (size_t)(row0 + rr) * 256 + 4 * lane) = w; } }
          __syncthreads(); }
    }
}

constexpr int AT_FL = 0, AT_K = 34816, AT_VT = AT_K + 8192, AT_SC = AT_VT + 8192;
__device__ __forceinline__ void attn_scan(Frame& F, int b, int h, bool meta_only) {
    LAS float* Fl = (LAS float*)(F.lds + AT_FL); LAS float* sc = (LAS float*)(F.lds + AT_SC);
    const float* LFT = (const float*)(WSP() + WS_LFT); const float* LFTM = (const float*)(WSP() + WS_LFTM);
    const int tid = F.tid, lane = F.lane, wave = F.wave;
    __syncthreads();
    if (tid == 0) { float s = 0.f; for (int m = 0; m < 64; ++m) { if (m < (meta_only ? 64 : NMETA)) { s += LFTM[h * 256 + m]; Fl[m] = s * LOG2E; } else Fl[m] = 0.f; if (m == NMETA - 1) sc[16] = s; } }
    if (meta_only) { for (int i = tid; i < 256; i += 512) Fl[64 + i] = 0.f; __syncthreads(); return; }
    float v[16]; const float* src = LFT + (size_t)(b * 8 + h) * SEQ + 16 * tid;
#pragma unroll
    for (int j = 0; j < 4; ++j) { const f32x4 q = *(const f32x4*)(src + 4 * j); v[4 * j] = q[0]; v[4 * j + 1] = q[1]; v[4 * j + 2] = q[2]; v[4 * j + 3] = q[3]; }
#pragma unroll
    for (int j = 1; j < 16; ++j) v[j] += v[j - 1];
    float incl = v[15];
#pragma unroll
    for (int o = 1; o < 64; o <<= 1) { const float up = __shfl_up(incl, o); if (lane >= o) incl += up; }
    if (lane == 63) sc[wave] = incl;
    __syncthreads();
    float off = sc[16];
    for (int w = 0; w < wave; ++w) off += sc[w];
    off += incl - v[15];
#pragma unroll
    for (int j = 0; j < 16; ++j) Fl[64 + 16 * tid + j] = (off + v[j]) * LOG2E;
    __syncthreads();
}
__device__ __forceinline__ void attn_unit(Frame& F, int qrow0, int qpos0, int ntiles, int kvx0, int h) {
    const int tid = F.tid; const int r = tid >> 1, hf = tid & 1;
    const bf16* Q = (const bf16*)(DOP() + DO_Q); const bf16* Kg = (const bf16*)(DOP() + DO_K); const bf16* Vg = (const bf16*)(DOP() + DO_V); bf16* O = (bf16*)(DOP() + DO_Q);
    LAS float* Fl = (LAS float*)(F.lds + AT_FL); LAS unsigned char* Ks = F.lds + AT_K; LAS bf16* VT = (LAS bf16*)(F.lds + AT_VT);
    const int grow = qrow0 + r, qpos = qpos0 + r;
    unsigned qp[16];
#pragma unroll
    for (int j = 0; j < 4; ++j) { const u32x4 w = *(const u32x4*)(Q + (size_t)grow * 512 + h * 64 + hf * 32 + 8 * j); qp[4 * j] = w.x; qp[4 * j + 1] = w.y; qp[4 * j + 2] = w.z; qp[4 * j + 3] = w.w; }
    const float Fq = Fl[qpos < NMETA ? qpos : qpos + 48];
    float mrun = -1e30f, lrun = 0.f, o[32];
#pragma unroll
    for (int d = 0; d < 32; ++d) o[d] = 0.f;
    const int lrow = tid >> 3, lch = tid & 7;

#pragma unroll 1
for (int i = 0; i < ntiles; ++i) {
        const int krow = (i == 0 ? TX : kvx0 + 64 * (i - 1)) + lrow;
        const u32x4 kw = *(const u32x4*)(Kg + (size_t)krow * 512 + h * 64 + lch * 8);
        const u32x4 vw = *(const u32x4*)(Vg + (size_t)krow * 512 + h * 64 + lch * 8);
        __syncthreads();
        *(LAS u32x4*)(Ks + lrow * 128 + lch * 16) = kw;
        { const unsigned vv[4] = {vw.x, vw.y, vw.z, vw.w};
#pragma unroll
          for (int e = 0; e < 4; ++e) { VT[(lch * 8 + 2 * e) * 64 + lrow] = (bf16)(vv[e] & 0xffffu); VT[(lch * 8 + 2 * e + 1) * 64 + lrow] = (bf16)(vv[e] >> 16); } }
        __syncthreads();
        const int kp0 = i == 0 ? 0 : NMETA + 64 * (i - 1);
        if (kp0 > qpos0 + 255) continue;
#pragma unroll 1
        for (int jg = 0; jg < 4; ++jg) {
            float s[16]; float gmax = -1e30f;
#pragma unroll
            for (int jj = 0; jj < 16; ++jj) { const int j = jg * 16 + jj; float d = 0.f;
#pragma unroll
                for (int c = 0; c < 4; ++c) { const u32x4 kk = *(const LAS u32x4*)(Ks + j * 128 + hf * 64 + c * 16);
                    d = dot2bf(kk.x, qp[4 * c], d); d = dot2bf(kk.y, qp[4 * c + 1], d); d = dot2bf(kk.z, qp[4 * c + 2], d); d = dot2bf(kk.w, qp[4 * c + 3], d); }
                d += __shfl_xor(d, 1);
                const bool valid = (i == 0 ? j < NMETA : true) && (kp0 + j <= qpos);
                s[jj] = valid ? d + Fq - Fl[64 * i + j] : -1e30f; gmax = fmaxf(gmax, s[jj]); }
            const float mn = fmaxf(mrun, gmax), alpha = exp2f(mrun - mn); mrun = mn;
            float ps = 0.f; unsigned pp[8];
#pragma unroll
            for (int jj = 0; jj < 16; jj += 2) { const float p0 = exp2f(s[jj] - mn), p1 = exp2f(s[jj + 1] - mn); ps += p0 + p1; pp[jj >> 1] = pk2(p0, p1); }
            lrun = lrun * alpha + ps;
#pragma unroll
            for (int d = 0; d < 32; ++d) { const u32x4 v0 = *(const LAS u32x4*)(VT + (hf * 32 + d) * 64 + jg * 16), v1 = *(const LAS u32x4*)(VT + (hf * 32 + d) * 64 + jg * 16 + 8);
                float a = o[d] * alpha; a = dot2bf(pp[0], v0.x, a); a = dot2bf(pp[1], v0.y, a); a = dot2bf(pp[2], v0.z, a); a = dot2bf(pp[3], v0.w, a);
                a = dot2bf(pp[4], v1.x, a); a = dot2bf(pp[5], v1.y, a); a = dot2bf(pp[6], v1.z, a); a = dot2bf(pp[7], v1.w, a); o[d] = a; }
        }
    }
    const float il = 1.0f / lrun;
#pragma unroll
    for (int j = 0; j < 4; ++j) { u32x4 w; w.x = pk2(o[8 * j] * il, o[8 * j + 1] * il); w.y = pk2(o[8 * j + 2] * il, o[8 * j + 3] * il); w.z = pk2(o[8 * j + 4] * il, o[8 * j + 5] * il); w.w = pk2(o[8 * j + 6] * il, o[8 * j + 7] * il);
        *(u32x4*)(O + (size_t)grow * 512 + h * 64 + hf * 32 + 8 * j) = w; }
}
__device__ __forceinline__ void phase_B(Frame& F) {
    int cur_bh = -1;
    if (F.G == 256) {
        const int v = F.vcu, bh = v >> 3, s = v & 7, b = bh >> 3, h = bh & 7;
        attn_scan(F, b, h, false);
        for (int i = 0; i < 4; ++i) { const int qb = i == 0 ? s : (i == 1 ? 15 - s : (i == 2 ? 16 + s : 31 - s));
            attn_unit(F, b * SEQ + 256 * qb, NMETA + 256 * qb, 1 + 4 * (qb + 1), b * SEQ, h); }
        if (v < 8) { attn_scan(F, 0, v, true); attn_unit(F, TX, 0, 1, 0, v); }
    } else {
        for (int u = F.vcu; u < 1032; u += F.G) {
            if (u < 1024) { const int bh = u >> 5, qb = u & 31, b = bh >> 3, h = bh & 7; if (bh != cur_bh) { attn_scan(F, b, h, false); cur_bh = bh; }
                attn_unit(F, b * SEQ + 256 * qb, NMETA + 256 * qb, 1 + 4 * (qb + 1), b * SEQ, h); }
            else { attn_scan(F, 0, u - 1024, true); cur_bh = -1; attn_unit(F, TX, 0, 1, 0, u - 1024); }
        }
    }
    __syncthreads();
}

__device__ __forceinline__ void class_tables(Frame& F, int l) {
    LAS int* base = (LAS int*)(F.lds + LC_BASE); LAS int* pcls = (LAS int*)(F.lds + LC_PCLS); LAS int* np = (LAS int*)(F.lds + LC_NP);
    const unsigned* gcnt = (const unsigned*)(WSP() + WS_CTL) + CW_GCNT + l * 64;
    __syncthreads();
    if (F.tid == 0) { int p = 0;
#pragma unroll 1
        for (int c = 0; c < NCLS; ++c) { base[c] = p * 256; int n = (int)__hip_atomic_load(gcnt + c, __ATOMIC_RELAXED, __HIP_MEMORY_SCOPE_AGENT); if (n > TM) n = TM; if (n < 0) n = 0; p += (n + 255) >> 8; }
        if (p > 160) p = 160; base[NCLS] = p * 256; np[0] = p; }
    __syncthreads();
    if (F.tid < 160) { const int mypos = F.tid * 256; int c = 0;
#pragma unroll 1
        for (int k = 1; k < NCLS; ++k) if (base[k] <= mypos) c = k;
        pcls[F.tid] = c; }
    __syncthreads();
}
__device__ __forceinline__ void phase_E1(Frame& F, int l) {
    LAS float* R = (LAS float*)F.lds;
    LAS int* rec = (LAS int*)(F.lds + 81920);
    LAS int* lcnt = (LAS int*)(F.lds + LC_CNT); LAS int* wgb = (LAS int*)(F.lds + LC_BASE);
    const float* rg = (const float*)(WSP() + WS_RG); const float* H = (const float*)(WSP() + WS_H);
    const float* reb = INP(I_REB) + l * 16; const float* rgb = INP(I_RGB) + l * 4;
    unsigned* gcnt = (unsigned*)(WSP() + WS_CTL) + CW_GCNT + l * 64; int* route = (int*)(WSP() + WS_ROUTE);
    const int tid = F.tid, lane = F.lane, wave = F.wave;
    for (int i = tid; i < 5120; i += 512) *(LAS f32x4*)(R + 4 * i) = *(const f32x4*)(rg + 4 * i);
    for (int wg = F.vcu; wg < 256; wg += F.G) {
        if (tid < NCLS) lcnt[tid] = 0;
        __syncthreads();

#pragma unroll 1
for (int rr = wave; rr < 129; rr += 8) { const int row = wg * 129 + rr;
            f32x4 hv[4]; float ss = 0.f;
#pragma unroll
            for (int j = 0; j < 4; ++j) { hv[j] = *(const f32x4*)(H + (size_t)row * D + 4 * lane + 256 * j); ss += hv[j][0] * hv[j][0] + hv[j][1] * hv[j][1] + hv[j][2] * hv[j][2] + hv[j][3] * hv[j][3]; }
            const float rstd2 = rsqrtf(wave_sum(ss) * (1.0f / D) + EPS);
            float lg[20];
#pragma unroll
            for (int c = 0; c < 20; ++c) { float s = 0.f;
#pragma unroll
                for (int j = 0; j < 4; ++j) { const f32x4 w = *(const LAS f32x4*)(R + c * 1024 + 4 * lane + 256 * j); s += hv[j][0] * w[0] + hv[j][1] * w[1] + hv[j][2] * w[2] + hv[j][3] * w[3]; }
                lg[c] = wave_sum(s) * rstd2 + (c < 16 ? reb[c] : rgb[c - 16]); }
            int gsel = 0; float gmax = lg[16];
#pragma unroll
            for (int g = 1; g < 4; ++g) if (lg[16 + g] > gmax) { gmax = lg[16 + g]; gsel = g; }
            float gsum = 0.f;
#pragma unroll
            for (int g = 0; g < 4; ++g) gsum += __expf(lg[16 + g] - gmax);
            const float gwt = 1.0f / gsum;
            float el[4];
#pragma unroll
            for (int e = 0; e < 4; ++e) el[e] = gsel == 0 ? lg[e] : (gsel == 1 ? lg[4 + e] : (gsel == 2 ? lg[8 + e] : lg[12 + e]));
            int t1 = 0; float l1 = el[0];
#pragma unroll
            for (int e = 1; e < 4; ++e) if (el[e] > l1) { l1 = el[e]; t1 = e; }
            int t2 = -1; float l2 = -3.0e38f;
#pragma unroll
            for (int e = 0; e < 4; ++e) if (e != t1 && el[e] > l2) { l2 = el[e]; t2 = e; }
            const float w1 = 1.0f / (1.0f + __expf(l2 - l1)), w2 = 1.0f - w1;
            const int ea = min(t1, t2), eb = max(t1, t2); const float cA = gwt * (t1 == ea ? w1 : w2), cB = gwt * (t1 == ea ? w2 : w1);
            const int pr = ea == 0 ? eb - 1 : (ea == 1 ? eb + 1 : 5); int cls = gsel * 6 + pr; if (!(cls >= 0 && cls < NCLS)) cls = 0;
            if (lane == 0) { const int rank = __hip_atomic_fetch_add(&lcnt[cls], 1, __ATOMIC_RELAXED, __HIP_MEMORY_SCOPE_WORKGROUP); rec[rr * 5] = cls; rec[rr * 5 + 1] = rank; rec[rr * 5 + 2] = __float_as_int(cA); rec[rr * 5 + 3] = __float_as_int(cB); rec[rr * 5 + 4] = __float_as_int(rstd2); }
        }
        __syncthreads();
        if (tid < NCLS) { const int n = lcnt[tid]; wgb[tid] = n > 0 ? (int)atomicAdd(gcnt + tid, (unsigned)n) : 0; }
        __syncthreads();
        for (int rr = tid; rr < 129; rr += 512) { const int row = wg * 129 + rr; const int cls = rec[rr * 5];
            int* rp = route + (size_t)row * 8; rp[0] = cls; rp[1] = wgb[cls] + rec[rr * 5 + 1]; rp[2] = rec[rr * 5 + 2]; rp[3] = rec[rr * 5 + 3]; rp[4] = rec[rr * 5 + 4]; }
        __syncthreads();
    }
}
__device__ __forceinline__ void phase_E1b(Frame& F, int l) {
    class_tables(F, l);
    const LAS int* base = (const LAS int*)(F.lds + LC_BASE);
    const int* route = (const int*)(WSP() + WS_ROUTE); const bf16* HB = (const bf16*)(WSP() + WS_HB); bf16* XS = (bf16*)(WSP() + WS_XS); float* PW = (float*)(WSP() + WS_PW);
    const int gw = F.vcu * NWAVES + F.wave, NGW = F.G * NWAVES, lane = F.lane;

#pragma unroll 1
for (int row = gw; row < TM; row += NGW) { const int* rp = route + (size_t)row * 8; const int cls = rp[0]; const int pos = base[cls] + rp[1];
        if (pos < 0 || pos >= NPOSMAX) continue;
#pragma unroll
        for (int j = 0; j < 2; ++j) *(u32x4*)(XS + (size_t)pos * D + 8 * lane + 512 * j) = *(const u32x4*)(HB + (size_t)row * D + 8 * lane + 512 * j);
        if (lane == 0) { f32x4 w; w[0] = __int_as_float(rp[4]); w[1] = __int_as_float(rp[2]); w[2] = __int_as_float(rp[3]); w[3] = 0.f; *(f32x4*)(PW + (size_t)pos * 4) = w; } }
}
__device__ __forceinline__ void phase_E4(Frame& F, int l) {
    class_tables(F, l);
    const LAS int* base = (const LAS int*)(F.lds + LC_BASE);
    const int* route = (const int*)(WSP() + WS_ROUTE); float* H = (float*)(WSP() + WS_H); bf16* HB = (bf16*)(WSP() + WS_HB); const bf16* Y = (const bf16*)(WSP() + WS_Y);
    float* rstd1 = (float*)(WSP() + WS_RSTD1); const float* fg = INP(I_FG); float* out = (float*)DOP();
    const int gw = F.vcu * NWAVES + F.wave, NGW = F.G * NWAVES, lane = F.lane; const bool lastl = (l == DEPTH - 1);

#pragma unroll 1
for (int row = gw; row < TM; row += NGW) { const int* rp = route + (size_t)row * 8; const int cls = rp[0]; int pos = base[cls] + rp[1]; if (pos < 0 || pos >= NPOSMAX) pos = 0;
        f32x4 hv[2][2]; float ss = 0.f;
#pragma unroll
        for (int j = 0; j < 2; ++j) { const u32x4 yw = *(const u32x4*)(Y + (size_t)pos * D + 8 * lane + 512 * j);
            hv[j][0] = *(const f32x4*)(H + (size_t)row * D + 8 * lane + 512 * j); hv[j][1] = *(const f32x4*)(H + (size_t)row * D + 8 * lane + 512 * j + 4);
            hv[j][0][0] += bflo(yw.x); hv[j][0][1] += bfhi(yw.x); hv[j][0][2] += bflo(yw.y); hv[j][0][3] += bfhi(yw.y);
            hv[j][1][0] += bflo(yw.z); hv[j][1][1] += bfhi(yw.z); hv[j][1][2] += bflo(yw.w); hv[j][1][3] += bfhi(yw.w);
#pragma unroll
            for (int q = 0; q < 2; ++q) ss += hv[j][q][0] * hv[j][q][0] + hv[j][q][1] * hv[j][q][1] + hv[j][q][2] * hv[j][q][2] + hv[j][q][3] * hv[j][q][3]; }
        const float rs = rsqrtf(wave_sum(ss) * (1.0f / D) + EPS);
        if (!lastl) {
#pragma unroll
            for (int j = 0; j < 2; ++j) { *(f32x4*)(H + (size_t)row * D + 8 * lane + 512 * j) = hv[j][0]; *(f32x4*)(H + (size_t)row * D + 8 * lane + 512 * j + 4) = hv[j][1];
                *(u32x4*)(HB + (size_t)row * D + 8 * lane + 512 * j) = pack8(hv[j][0], hv[j][1]); }
            if (lane == 0) rstd1[row] = rs;
        } else if (row < TX) {
#pragma unroll
            for (int j = 0; j < 2; ++j) { const f32x4 g0 = *(const f32x4*)(fg + 8 * lane + 512 * j), g1 = *(const f32x4*)(fg + 8 * lane + 512 * j + 4);
                *(f32x4*)(out + (size_t)row * D + 8 * lane + 512 * j) = hv[j][0] * rs * g0; *(f32x4*)(out + (size_t)row * D + 8 * lane + 512 * j + 4) = hv[j][1] * rs * g1; }
        }
    }
}

#define RELANE() do { const int t_ = wv0 * 64 + lane_id_opaque(); F.tid = t_; F.lane = t_ & 63; F.wave = __builtin_amdgcn_readfirstlane(t_ >> 6); \
    int g_ = gridDim.x; LAUNDER_S(g_); int b_ = blockIdx.x; LAUNDER_S(b_); F.G = g_; F.bx = b_; F.vcu = (g_ % 8 == 0) ? (b_ % 8) * (g_ / 8) + b_ / 8 : b_; ll = l; LAUNDER_S(ll); } while (0)
__global__ void __launch_bounds__(NWAVES * 64, 2) fwd_kernel(Params P) {
    extern __shared__ __attribute__((aligned(16))) unsigned char lds_raw[];
    Frame F;
    F.lds = (LAS unsigned char*)lds_raw;
    F.tid = threadIdx.x; F.lane = F.tid & 63; F.wave = __builtin_amdgcn_readfirstlane(F.tid >> 6);
    F.G = gridDim.x; { const int bx = blockIdx.x; F.vcu = (F.G % 8 == 0) ? (bx % 8) * (F.G / 8) + bx / 8 : bx; }
    if (F.tid == 0) { LAS unsigned long long* pt = (LAS unsigned long long*)(F.lds + LC_PTAB);
#pragma unroll
        for (int i = 0; i < 25; ++i) pt[i] = (unsigned long long)P.in[i];
        pt[25] = (unsigned long long)P.ws; pt[26] = (unsigned long long)P.out; }
    for (int u = F.tid; u < 256; u += NWAVES * 64) ((LAS unsigned*)(F.lds + RING_BYTES))[u] = 0u;
    __syncthreads();
    const int lo = P.ph_lo, hi = P.ph_hi;
    const bool use_bar = (hi - lo) > 1;
    unsigned* barw = (unsigned*)(P.ws + WS_CTL) + CW_BAR;
    XcdBarrier bar; bar.bar = barw; bar.x = 0; bar.st = (volatile LAS unsigned*)(F.lds + LC_BAR);
    if (use_bar) bar = xcd_barrier_post(barw, (volatile LAS unsigned*)(F.lds + LC_BAR));
#ifndef PHASE_MASK
#define PHASE_MASK 0x7ff
#endif
#define EN(j) (((PHASE_MASK) >> (j)) & 1)
#define IN(k) (lo <= (k) && (k) < hi)
#define SEAM(k) do { if (IN(k) && IN((k) + 1)) xcd_barrier(bar); } while (0)

    int l = 0, ll = 0; const int wv0 = __builtin_amdgcn_readfirstlane((int)threadIdx.x >> 6);
    if (EN(0) && IN(0)) { RELANE(); convert_weights(F, 0); RELANE(); init_rows(F); }
    SEAM(0);
    for (l = 0; l < DEPTH; ++l) {
        const int pb = 1 + 10 * l;
        if (EN(1) && IN(pb + 0)) {
            RELANE();
            unsigned char* wsl = WSP(); unsigned char* dol = DOP();
            pg8::Gemm g{(const bf16*)(wsl + WS_HB), 1024, 1024, 1 << 20};
            pg8::StaticOrder S; S.init(TM, N1, F.G, F.bx, (const bf16*)(wsl + WS_W1T), 1024);
            Epi1 E{(const float*)(wsl + WS_RSTD1), (bf16*)(wsl + WS_A), (bf16*)(wsl + WS_GLU), (bf16*)(dol + DO_Q), (bf16*)(wsl + WS_G)};
            pg8::gemm_phase<Epi1, pg8::StaticOrder>(F.lds, g, S, E, F.wave);
        }
        SEAM(pb + 0);
        if (EN(2) && IN(pb + 1)) { RELANE(); phase_S(F, ll); }
        SEAM(pb + 1);
        if (EN(3) && IN(pb + 2)) { RELANE(); phase_B(F); }
        SEAM(pb + 2);
        if (EN(4) && IN(pb + 3)) {
            { RELANE(); unsigned char* wsl = WSP(); unsigned char* dol = DOP();
              pg8::Gemm g{(const bf16*)(wsl + WS_DIFF), 256, 256, 1 << 20}; pg8::StaticOrder S; S.init(TM, 1024, F.G, F.bx, (const bf16*)(wsl + WS_WAT), 256);
              EpiC<0> E{(const bf16*)(wsl + WS_G), (bf16*)(dol + DO_MERGED), (const float*)(wsl + WS_BIASA)}; pg8::gemm_phase<EpiC<0>, pg8::StaticOrder>(F.lds, g, S, E, F.wave); }
            { RELANE(); unsigned char* wsl = WSP(); unsigned char* dol = DOP();
              pg8::Gemm g{(const bf16*)(wsl + WS_BP), 256, 256, 1 << 20}; pg8::StaticOrder S; S.init(TM, 1024, F.G, F.bx, (const bf16*)(wsl + WS_WBT), 256);
              EpiC<1> E{(const bf16*)(wsl + WS_G), (bf16*)(dol + DO_MERGED), nullptr}; pg8::gemm_phase<EpiC<1>, pg8::StaticOrder>(F.lds, g, S, E, F.wave); }
            { RELANE(); unsigned char* wsl = WSP(); unsigned char* dol = DOP();
              pg8::Gemm g{(const bf16*)(dol + DO_Q), 512, 512, 1 << 20}; pg8::StaticOrder S; S.init(TM, 1024, F.G, F.bx, (const bf16*)(wsl + WS_WCT), 512);
              EpiC<2> E{(const bf16*)(wsl + WS_G), (bf16*)(dol + DO_MERGED), nullptr}; pg8::gemm_phase<EpiC<2>, pg8::StaticOrder>(F.lds, g, S, E, F.wave); }
        }
        SEAM(pb + 3);
        if (EN(5) && IN(pb + 4)) {
            RELANE();
            unsigned char* wsl = WSP(); unsigned char* dol = DOP();
            pg8::Gemm g{(const bf16*)(dol + DO_MERGED), 1024, 1024, 1 << 20}; pg8::StaticOrder S; S.init(TM, 1024, F.G, F.bx, (const bf16*)(wsl + WS_WOT), 1024);
            EpiD E{(float*)(wsl + WS_H), (bf16*)(wsl + WS_HB)}; pg8::gemm_phase<EpiD, pg8::StaticOrder>(F.lds, g, S, E, F.wave);
        }
        SEAM(pb + 4);
        if (EN(6) && IN(pb + 5)) { RELANE(); phase_E1(F, ll); }
        SEAM(pb + 5);
        if (EN(7) && IN(pb + 6)) { RELANE(); phase_E1b(F, ll); }
        SEAM(pb + 6);
        if (EN(8) && IN(pb + 7)) {
            RELANE(); class_tables(F, ll);
            unsigned char* wsl = WSP();
            const int NP = __builtin_amdgcn_readfirstlane(*(const LAS int*)(F.lds + LC_NP));
            pg8::Gemm g{(const bf16*)(wsl + WS_XS), 1024, 1024, 1 << 20};
            MoeOrder S{NP, F.G, F.vcu, 0, (const LAS int*)(F.lds + LC_PCLS), (const bf16*)(wsl + WS_W13T)};
            EpiA2 E{(const float*)(wsl + WS_PW), (bf16*)(wsl + WS_HH)}; pg8::gemm_phase<EpiA2, MoeOrder>(F.lds, g, S, E, F.wave);
        }
        SEAM(pb + 7);
        if (EN(9) && IN(pb + 8)) {
            RELANE(); class_tables(F, ll);
            unsigned char* wsl = WSP();
            const int NP = __builtin_amdgcn_readfirstlane(*(const LAS int*)(F.lds + LC_NP));
            pg8::Gemm g{(const bf16*)(wsl + WS_HH), 512, 256, 4};
            MoeOrder S{NP, F.G, F.vcu, 1, (const LAS int*)(F.lds + LC_PCLS), (const bf16*)(wsl + WS_W2T)};
            EpiB2 E{(bf16*)(wsl + WS_Y)}; pg8::gemm_phase<EpiB2, MoeOrder>(F.lds, g, S, E, F.wave);
        }
        SEAM(pb + 8);
        if (EN(10) && IN(pb + 9)) { RELANE(); phase_E4(F, ll); if (l + 1 < DEPTH) { RELANE(); convert_weights(F, ll + 1); } }
        SEAM(pb + 9);
    }
#undef IN
#undef SEAM
}

constexpr int N_PHASES = 1 + 10 * DEPTH;

extern "C" void kernel_launch(void* const* d_in, const int* in_sizes, int n_in, void* d_out, int out_size, void* d_ws, size_t ws_size, hipStream_t stream) {
    static int grid = 0;
    if (grid == 0) {
        if (n_in != 25 || out_size != TX * D || ws_size < WS_END) { fprintf(stderr, "kernel_launch: unexpected shapes: n_in %d out %d ws %zu (need %zu)\n", n_in, out_size, ws_size, (size_t)WS_END); grid = -1; return; }
        int dev = 0, cus = 0, per_cu = 0;
        if (hipGetDevice(&dev) != hipSuccess || hipDeviceGetAttribute(&cus, hipDeviceAttributeMultiprocessorCount, dev) != hipSuccess) { grid = -1; return; }
        if (hipFuncSetAttribute((const void*)fwd_kernel, hipFuncAttributeMaxDynamicSharedMemorySize, LDS_BYTES) != hipSuccess) { fprintf(stderr, "kernel_launch: hipFuncSetAttribute failed\n"); grid = -1; return; }
        if (hipOccupancyMaxActiveBlocksPerMultiprocessor(&per_cu, (const void*)fwd_kernel, NWAVES * 64, LDS_BYTES) != hipSuccess || per_cu < 1) fprintf(stderr, "kernel_launch: occupancy query reports %d\n", per_cu);
        (void)hipGetLastError();
        grid = cus;
    }
    if (grid < 0) return;
    (void)hipMemsetAsync((char*)d_ws + WS_CTL, 0, CTL_BYTES, stream);
    Params p{};
    for (int i = 0; i < 25; ++i) p.in[i] = (const float*)d_in[i];
    p.out = (float*)d_out; p.ws = (unsigned char*)d_ws;
#if N_LAUNCH_MODE == 1
    p.ph_lo = 0; p.ph_hi = N_PHASES;
    hipLaunchKernelGGL(fwd_kernel, dim3(grid), dim3(NWAVES * 64), LDS_BYTES, stream, p);
#else
    for (int ph = 0; ph < N_PHASES; ++ph) { p.ph_lo = ph; p.ph_hi = ph + 1; hipLaunchKernelGGL(fwd_kernel, dim3(grid), dim3(NWAVES * 64), LDS_BYTES, stream, p); }
#endif
}
```

```cpp
#include <hip/hip_runtime.h>
#include <cstdio>
#include <cstdint>

#ifndef N_LAUNCH_MODE
#define N_LAUNCH_MODE 1
#endif

#define GAS __attribute__((address_space(1)))
#define LAS __attribute__((address_space(3)))
typedef unsigned short bf16;
typedef float f32x4 __attribute__((ext_vector_type(4)));
typedef float f32x2 __attribute__((ext_vector_type(2)));
typedef unsigned u32x4 __attribute__((ext_vector_type(4)));
typedef unsigned u32x2 __attribute__((ext_vector_type(2)));
typedef short bf16x8 __attribute__((ext_vector_type(8)));
typedef __bf16 bf16x2v __attribute__((ext_vector_type(2)));

constexpr int D = 1024, NB = 4, SEQ = 8192, NMETA = 16, DEPTH = 2;
constexpr int TX = NB * SEQ;
constexpr int TM = TX + 256;
constexpr int NIN = 5384, N1 = 5376;
constexpr int NHEAD = 8;
constexpr int NCLS = 24;
constexpr int NPOSMAX = TM + NCLS * 256;
constexpr float EPS = 1e-6f;
constexpr float LOG2E = 1.4426950408889634f;
constexpr float C2 = 0.125f * LOG2E;
constexpr int NWAVES = 8;

constexpr size_t U = (size_t)TM * 1024 * 2;
constexpr size_t WS_CTL = 0, CTL_BYTES = 1u << 20;
constexpr size_t WS_H = CTL_BYTES;
constexpr size_t WS_HB = WS_H + 2 * U;
constexpr size_t WS_G = WS_HB + U;
constexpr size_t WS_XS = WS_G;
constexpr size_t WS_Y = WS_XS + (size_t)NPOSMAX * 2048;
constexpr size_t WS_HH = WS_Y + (size_t)NPOSMAX * 2048;
static_assert(WS_HH + (size_t)NPOSMAX * 1024 <= WS_G + 3 * U, "MoE overlay fits the gates region");
constexpr size_t WS_A = WS_G + 3 * U;
constexpr size_t WS_GLU = WS_A + U / 4;
constexpr size_t WS_DIFF = WS_GLU + U / 4;
constexpr size_t WS_BP = WS_DIFF + U / 4;
constexpr size_t WS_W1T = WS_BP + U / 4;
constexpr size_t WS_WAT = WS_W1T + (size_t)N1 * 1024 * 2;
constexpr size_t WS_WBT = WS_WAT + 1024 * 256 * 2;
constexpr size_t WS_WCT = WS_WBT + 1024 * 256 * 2;
constexpr size_t WS_WOT = WS_WCT + 1024 * 512 * 2;
constexpr size_t WS_W13T = WS_WOT + 1024 * 1024 * 2;
constexpr size_t WS_W2T = WS_W13T + (size_t)16 * 512 * 1024 * 2;
constexpr size_t WS_WFG = WS_W2T + (size_t)16 * 1024 * 256 * 2;
constexpr size_t WS_RG = WS_WFG + 8 * 1024 * 4;
constexpr size_t WS_BIASA = WS_RG + 20 * 1024 * 4;
constexpr size_t WS_RSTD1 = WS_BIASA + 4096;
constexpr size_t WS_ROUTE = WS_RSTD1 + (size_t)TM * 4;
constexpr size_t WS_PW = WS_ROUTE + (size_t)TM * 32;
constexpr size_t WS_LFT = WS_PW + (size_t)NPOSMAX * 16;
constexpr size_t WS_LFTM = WS_LFT + (size_t)32 * 8192 * 4;
constexpr size_t WS_END = WS_LFTM + 8 * 256 * 4;
static_assert(WS_END <= (size_t)512 * 1024 * 1024, "d_ws map fits 512 MiB");
constexpr size_t DO_Q = 0, DO_K = U / 2, DO_V = U, DO_MERGED = U / 2;
static_assert(DO_V + U / 2 <= (size_t)TX * 1024 * 4, "d_out scratch");
constexpr int CW_BAR = 4096, CW_GCNT = 16384;

constexpr int RING_BYTES = 131072;
constexpr int LC_BAR = RING_BYTES, LC_CNT = RING_BYTES + 64, LC_BASE = RING_BYTES + 192, LC_PCLS = RING_BYTES + 320, LC_NP = RING_BYTES + 960;
constexpr int LC_PTAB = RING_BYTES + 1024;
constexpr int LDS_BYTES = RING_BYTES + 1024 + 7168;

#define LDS_WAIT() asm volatile("s_waitcnt lgkmcnt(0)" ::: "memory")
#define VM_WAIT() asm volatile("s_waitcnt vmcnt(0)" ::: "memory")
#define LAUNDER_S(p) asm volatile("" : "+s"(p))
#define LAUNDER_V(x) asm volatile("" : "+v"(x))
__device__ __forceinline__ int lane_id_opaque() { int x; asm volatile("v_mbcnt_lo_u32_b32 %0, -1, 0\n\tv_mbcnt_hi_u32_b32 %0, -1, %0" : "=v"(x)); return x; }

__device__ __forceinline__ unsigned f2bf(float f) { unsigned u = __builtin_bit_cast(unsigned, f); return (u + 0x7fffu + ((u >> 16) & 1u)) >> 16; }
__device__ __forceinline__ unsigned pk2(float lo, float hi) { return f2bf(lo) | (f2bf(hi) << 16); }
__device__ __forceinline__ float bflo(unsigned w) { return __builtin_bit_cast(float, w << 16); }
__device__ __forceinline__ float bfhi(unsigned w) { return __builtin_bit_cast(float, w & 0xffff0000u); }
template <int O> __device__ __forceinline__ float lane_xor(float v) {
    if constexpr (O < 32) return __int_as_float(__builtin_amdgcn_ds_swizzle(__float_as_int(v), (O << 10) | 0x1f));
    else { auto rr = __builtin_amdgcn_permlane32_swap(__float_as_uint(v), __float_as_uint(v), false, false); return __uint_as_float(rr[0]) + __uint_as_float(rr[1]) - v; }
}
__device__ __forceinline__ float wave_sum(float v) {
    v += lane_xor<1>(v); v += lane_xor<2>(v); v += lane_xor<4>(v); v += lane_xor<8>(v); v += lane_xor<16>(v);
    auto rr = __builtin_amdgcn_permlane32_swap(__float_as_uint(v), __float_as_uint(v), false, false);
    return __uint_as_float(rr[0]) + __uint_as_float(rr[1]);
}
__device__ __forceinline__ float sigmoidf_(float x) { return 1.0f / (1.0f + __expf(-x)); }
__device__ __forceinline__ float dot2bf(unsigned a, unsigned b, float acc) { return __builtin_amdgcn_fdot2_f32_bf16(__builtin_bit_cast(bf16x2v, a), __builtin_bit_cast(bf16x2v, b), acc, false); }

namespace pg8 {
constexpr int BM = 256, BK = 64, HALF = 128, HTB = HALF * BK * 2, STAGE_BYTES = 8 * HTB, NXCD = 8, WGM = 8;
__host__ __device__ __forceinline__ int lds_byte(int r, int c) { const int st = (r >> 4) * 2 + (c >> 5), rr = r & 15, cc = c & 31, ob = rr * 64 + cc * 2; return st * 1024 + (ob ^ (((ob >> 9) & 1) << 5)); }
__host__ __device__ __forceinline__ void stage_rc(int b, int& R, int& C) { const int st = b / 1024, sb = b % 1024, swz = sb ^ (((sb >> 9) & 1) << 5); R = (st >> 1) * 16 + swz / 64; C = (st & 1) * 32 + (swz % 64) / 2; }
__host__ __device__ __forceinline__ int perm32(int rho) { const int n = rho >> 4, i = rho & 15; return 8 * (i >> 2) + 4 * n + (i & 3); }

struct Unit { int pm, pn; };
struct Gemm { const bf16* A; int K; int ldb; int ksplit; };

struct StaticOrder {
    int nM, nN, nwg, G, c; const bf16* Bt; size_t btile;
    __device__ void init(int M, int N, int G_, int c_, const bf16* Bt_, int ldb) { nM = M / BM; nN = N / BM; nwg = nM * nN; G = G_; c = c_; Bt = Bt_; btile = (size_t)BM * ldb * 2; }
    __device__ bool next(int i, Unit& u) const {
        const long L = (long)i * G + c; if (L >= nwg) return false;
        int wgid = (int)L; { const int q = nwg / NXCD, r = nwg % NXCD, xcd = wgid % NXCD, off = wgid / NXCD; wgid = (xcd < r ? xcd * (q + 1) : r * (q + 1) + (xcd - r) * q) + off; }
        const int nig = WGM * nN, gid = wgid / nig, fm = gid * WGM, gsz = (nM - fm) < WGM ? (nM - fm) : WGM;
        u.pm = fm + ((wgid % nig) % gsz); u.pn = (wgid % nig) / gsz; return true;
    }
    __device__ __forceinline__ const char* bptr(const Unit& u, int) const { return (const char*)Bt + (size_t)u.pn * btile; }
};

template <class Epi, class Sched, bool ALIGN_EPI = true, bool SP2 = true>
__device__ __forceinline__ void gemm_phase(LAS unsigned char* lds, const Gemm g, const Sched& S, const Epi& E, const int wave_id) {
    const int tid = wave_id * 64 + lane_id_opaque();
    const int wid = __builtin_amdgcn_readfirstlane(tid >> 6), lane = tid & 63, wr = wid >> 2, wc = wid & 3, fr = lane & 15, fq = lane >> 4;
    const int K = g.K, nt = K / BK, ldb = g.ldb, ks = g.ksplit;
    unsigned voffA[2], voffB[2];
#pragma unroll
    for (int i = 0; i < 2; ++i) { int R, C; stage_rc(tid * 16 + i * 8192, R, C); const int Rb = Epi::PERM ? ((R & ~31) + perm32(R & 31)) : R;
        voffA[i] = (unsigned)(R * K + C) * 2u; voffB[i] = (unsigned)(Rb * ldb + C) * 2u; }
    const size_t kstep = (size_t)(BK * 2);
    const size_t hstep = (size_t)HALF * K * 2;
    const size_t hstepB = (size_t)HALF * ldb * 2;
    const size_t tstep = 2 * hstep;
    const unsigned ldsw = (unsigned)wid * 1024u;
    const int aoff = lds_byte(wr * 64 + fr, fq * 8), boff = lds_byte(wc * 32 + fr, fq * 8);
#define PG8_SA(b, h) (((b) * 2 + (h)) * HTB)
#define PG8_SB(b, h) ((4 + (b) * 2 + (h)) * HTB)
#define PG8_STAGE(bufoff, gbase, voff) do { _Pragma("unroll") for (int _i = 0; _i < 2; ++_i) \
        __builtin_amdgcn_global_load_lds((const unsigned*)((const char*)(gbase) + (voff)[_i]), (LAS unsigned*)(lds + (bufoff) + ldsw + _i * 8192), 16, 0, 0); } while (0)
#define PG8_LDA(dst, b, h) do { _Pragma("unroll") for (int m = 0; m < 4; ++m) _Pragma("unroll") for (int k = 0; k < 2; ++k) dst[m][k] = *(const LAS bf16x8*)(lds + PG8_SA(b, h) + aoff + m * 2048 + k * 1024); } while (0)
#define PG8_LDB(dst, b, h) do { _Pragma("unroll") for (int n = 0; n < 2; ++n) _Pragma("unroll") for (int k = 0; k < 2; ++k) dst[n][k] = *(const LAS bf16x8*)(lds + PG8_SB(b, h) + boff + n * 2048 + k * 1024); } while (0)
#define PG8_MMA(ai, bj, At, Bt) do { __builtin_amdgcn_s_setprio(1); _Pragma("unroll") for (int m = 0; m < 4; ++m) _Pragma("unroll") for (int n = 0; n < 2; ++n) _Pragma("unroll") for (int k = 0; k < 2; ++k) \
        acc[ai][bj][m][n] = __builtin_amdgcn_mfma_f32_16x16x32_bf16(Bt[n][k], At[m][k], acc[ai][bj][m][n], 0, 0, 0); __builtin_amdgcn_s_setprio(0); } while (0)
#define PG8_WAIT_V(n) asm volatile("s_waitcnt vmcnt(" #n ")" ::: "memory")
#define PG8_WAIT_L(n) asm volatile("s_waitcnt lgkmcnt(" #n ")" ::: "memory")
#define PG8_BAR __builtin_amdgcn_s_barrier()
#define PG8_SCHED __builtin_amdgcn_sched_barrier(0)
    Unit cur, nxt; int ui = 0;
    if (!S.next(0, cur)) return;
    f32x4 acc[2][2][4][2];
    { float z_ = 0.f; LAUNDER_V(z_);
#pragma unroll
    for (int a = 0; a < 2; ++a)
#pragma unroll
        for (int b = 0; b < 2; ++b)
#pragma unroll
            for (int m = 0; m < 4; ++m)
#pragma unroll
                for (int n = 0; n < 2; ++n) acc[a][b][m][n] = (f32x4){z_, z_, z_, z_}; }
    bf16x8 At[4][2], B0[2][2], B1[2][2];
    const char* cA = (const char*)g.A + (size_t)cur.pm * tstep; const char* cB = S.bptr(cur, 0); const char* cB1 = S.bptr(cur, 1) - (size_t)ks * kstep;
    if constexpr (SP2) {
        PG8_STAGE(PG8_SB(0, 0), cB, voffB); PG8_STAGE(PG8_SB(0, 1), cB + hstepB, voffB); PG8_STAGE(PG8_SA(0, 0), cA, voffA); PG8_STAGE(PG8_SA(0, 1), cA + hstep, voffA);
        if (wr == 1) PG8_BAR;
        PG8_WAIT_V(2); PG8_BAR;
        PG8_STAGE(PG8_SB(1, 0), cB + kstep, voffB); PG8_STAGE(PG8_SA(1, 0), cA + kstep, voffA); PG8_STAGE(PG8_SB(1, 1), cB + hstepB + kstep, voffB);
        PG8_WAIT_V(6); PG8_BAR;
    } else {
        PG8_STAGE(PG8_SB(0, 0), cB, voffB); PG8_STAGE(PG8_SA(0, 0), cA, voffA); PG8_STAGE(PG8_SB(0, 1), cB + hstepB, voffB); PG8_STAGE(PG8_SA(0, 1), cA + hstep, voffA);
        if (wr == 1) PG8_BAR;
        PG8_WAIT_V(4); PG8_BAR;
        PG8_STAGE(PG8_SB(1, 0), cB + kstep, voffB); PG8_STAGE(PG8_SA(1, 0), cA + kstep, voffA); PG8_STAGE(PG8_SB(1, 1), cB + hstepB + kstep, voffB);
        PG8_WAIT_V(6); PG8_BAR;
    }
    for (;;) {
        const bool has_next = S.next(ui + 1, nxt);
        const char* nA = has_next ? (const char*)g.A + (size_t)nxt.pm * tstep : cA; const char* nB = has_next ? S.bptr(nxt, 0) : cB;
        const char* nB1 = has_next ? S.bptr(nxt, 1) - (size_t)ks * kstep : cB1;
        for (int t = 0; t < nt; t += 2) {
            const bool last = (t == nt - 2);
            const char* a1 = cA + (size_t)(t + 1) * kstep;
            const char* bside = (t + 2 < ks) ? cB : cB1;
            const char* a2 = last ? nA : cA + (size_t)(t + 2) * kstep; const char* b2 = last ? nB : bside + (size_t)(t + 2) * kstep;
            const char* a3 = a2 + kstep; const char* b3 = b2 + kstep;
            if constexpr (SP2) {
            PG8_LDB(B0, 0, 0); PG8_LDB(B1, 0, 1); PG8_SCHED; PG8_LDA(At, 0, 0); PG8_STAGE(PG8_SA(1, 1), a1 + hstep, voffA);
            PG8_WAIT_V(8); PG8_WAIT_L(0); PG8_BAR; PG8_MMA(0, 0, At, B0); PG8_MMA(0, 1, At, B1); PG8_BAR; PG8_SCHED;
            PG8_LDA(At, 0, 1); PG8_STAGE(PG8_SB(0, 0), b2, voffB); PG8_STAGE(PG8_SB(0, 1), b2 + hstepB, voffB); PG8_STAGE(PG8_SA(0, 0), a2, voffA);
            PG8_WAIT_V(8); PG8_WAIT_L(0); PG8_BAR; PG8_MMA(1, 0, At, B0); PG8_MMA(1, 1, At, B1); PG8_BAR; PG8_SCHED;
            PG8_LDB(B0, 1, 0); PG8_LDB(B1, 1, 1); PG8_SCHED; PG8_LDA(At, 1, 0); PG8_STAGE(PG8_SA(0, 1), a2 + hstep, voffA);
            PG8_WAIT_V(8); PG8_WAIT_L(0); PG8_BAR; PG8_MMA(0, 0, At, B0); PG8_MMA(0, 1, At, B1); PG8_BAR; PG8_SCHED;
            PG8_LDA(At, 1, 1); PG8_STAGE(PG8_SB(1, 0), b3, voffB); PG8_STAGE(PG8_SB(1, 1), b3 + hstepB, voffB); PG8_STAGE(PG8_SA(1, 0), a3, voffA);
            PG8_WAIT_V(8); PG8_WAIT_L(0); PG8_BAR; PG8_MMA(1, 0, At, B0); PG8_MMA(1, 1, At, B1); PG8_BAR; PG8_SCHED;
            } else {
            PG8_LDB(B0, 0, 0); PG8_SCHED; PG8_LDA(At, 0, 0); PG8_STAGE(PG8_SA(1, 1), a1 + hstep, voffA);
            PG8_WAIT_L(8); PG8_BAR; PG8_WAIT_L(0); PG8_MMA(0, 0, At, B0); PG8_BAR; PG8_SCHED;
            PG8_LDB(B1, 0, 1); PG8_STAGE(PG8_SB(0, 0), b2, voffB);
            PG8_BAR; PG8_WAIT_L(0); PG8_MMA(0, 1, At, B1); PG8_BAR;
            PG8_LDA(At, 0, 1); PG8_STAGE(PG8_SA(0, 0), a2, voffA);
            PG8_BAR; PG8_WAIT_L(0); PG8_MMA(1, 0, At, B0); PG8_BAR; PG8_SCHED;
            PG8_STAGE(PG8_SB(0, 1), b2 + hstepB, voffB);
            PG8_WAIT_V(6); PG8_BAR; PG8_MMA(1, 1, At, B1); PG8_BAR;
            PG8_LDB(B0, 1, 0); PG8_SCHED; PG8_LDA(At, 1, 0); PG8_STAGE(PG8_SA(0, 1), a2 + hstep, voffA);
            PG8_WAIT_L(8); PG8_BAR; PG8_WAIT_L(0); PG8_MMA(0, 0, At, B0); PG8_BAR; PG8_SCHED;
            PG8_LDB(B1, 1, 1); PG8_STAGE(PG8_SB(1, 0), b3, voffB);
            PG8_BAR; PG8_WAIT_L(0); PG8_MMA(0, 1, At, B1); PG8_BAR;
            PG8_LDA(At, 1, 1); PG8_STAGE(PG8_SA(1, 0), a3, voffA);
            PG8_BAR; PG8_WAIT_L(0); PG8_MMA(1, 0, At, B0); PG8_BAR; PG8_SCHED;
            PG8_STAGE(PG8_SB(1, 1), b3 + hstepB, voffB);
            PG8_WAIT_V(6); PG8_BAR; PG8_MMA(1, 1, At, B1); PG8_BAR;
            }
        }
        if constexpr (ALIGN_EPI) { if (wr == 0) PG8_BAR; }
        { const int l2 = lane_id_opaque(); E(acc, cur, wr, wc, l2 & 15, l2 >> 4); }
        if (!has_next) break;
        { float z_ = 0.f; LAUNDER_V(z_);
#pragma unroll
        for (int a = 0; a < 2; ++a)
#pragma unroll
            for (int b = 0; b < 2; ++b)
#pragma unroll
                for (int m = 0; m < 4; ++m)
#pragma unroll
                    for (int n = 0; n < 2; ++n) acc[a][b][m][n] = (f32x4){z_, z_, z_, z_}; }
        cur = nxt; cA = nA; cB = nB; cB1 = nB1; ++ui;
        if constexpr (ALIGN_EPI) { if (wr == 1) PG8_BAR; }
    }
    PG8_WAIT_V(0);
    if constexpr (!ALIGN_EPI) { if (wr == 0) PG8_BAR; }
    PG8_BAR;
#undef PG8_SA
#undef PG8_SB
#undef PG8_STAGE
#undef PG8_LDA
#undef PG8_LDB
#undef PG8_MMA
#undef PG8_WAIT_V
#undef PG8_WAIT_L
#undef PG8_BAR
#undef PG8_SCHED
}
}

typedef f32x4 AccT[2][2][4][2];
__device__ __forceinline__ u32x4 pack8(const f32x4 a, const f32x4 b) { u32x4 w; w.x = pk2(a[0], a[1]); w.y = pk2(a[2], a[3]); w.z = pk2(b[0], b[1]); w.w = pk2(b[2], b[3]); return w; }

struct Epi1 {
    static constexpr bool PERM = true;
    const float* rstd; bf16* A; bf16* GLU; bf16* QKV; bf16* G;
    __device__ __forceinline__ void operator()(const AccT& acc, const pg8::Unit& u, int wr, int wc, int fr, int fq) const {
        const int row0 = u.pm * 256 + wr * 64 + fr, lc0 = wc * 32 + 8 * fq, pn = u.pn;
#pragma unroll
        for (int ai = 0; ai < 2; ++ai)
#pragma unroll
            for (int m = 0; m < 4; ++m) {
                const int row = row0 + ai * 128 + m * 16; const float rs = rstd[row];
                f32x4 v[2][2];
#pragma unroll
                for (int bj = 0; bj < 2; ++bj)
#pragma unroll
                    for (int n = 0; n < 2; ++n) v[bj][n] = acc[ai][bj][m][n] * rs;
                if (pn == 0) {
#pragma unroll
                    for (int bj = 0; bj < 2; ++bj) *(u32x4*)(A + (size_t)row * 256 + bj * 128 + lc0) = pack8(v[bj][0], v[bj][1]);
                } else if (pn <= 2) {
                    f32x4 o[2];
#pragma unroll
                    for (int n = 0; n < 2; ++n)
#pragma unroll
                        for (int j = 0; j < 4; ++j) o[n][j] = v[0][n][j] * sigmoidf_(v[1][n][j]);
                    *(u32x4*)(GLU + (size_t)row * 256 + (pn - 1) * 128 + lc0) = pack8(o[0], o[1]);
                } else if (pn <= 8) {
                    const int t = (pn - 3) >> 1; bf16* base = QKV + (size_t)t * (U / 4); const float sc = t == 0 ? C2 : 1.0f;
#pragma unroll
                    for (int bj = 0; bj < 2; ++bj) *(u32x4*)(base + (size_t)row * 512 + ((pn - 3) & 1) * 256 + bj * 128 + lc0) = pack8(v[bj][0] * sc, v[bj][1] * sc);
                } else {
#pragma unroll
                    for (int bj = 0; bj < 2; ++bj) { f32x4 o[2];
#pragma unroll
                        for (int n = 0; n < 2; ++n)
#pragma unroll
                            for (int j = 0; j < 4; ++j) o[n][j] = sigmoidf_(v[bj][n][j]);
                        *(u32x4*)(G + (size_t)row * 3072 + (pn - 9) * 256 + bj * 128 + lc0) = pack8(o[0], o[1]); }
                }
            }
    }
};
template <int P> struct EpiC {
    static constexpr bool PERM = true;
    const bf16* G; bf16* Mg; const float* bias;
    __device__ __forceinline__ void operator()(const AccT& acc, const pg8::Unit& u, int wr, int wc, int fr, int fq) const {
        const int row0 = u.pm * 256 + wr * 64 + fr, col0 = u.pn * 256 + wc * 32 + 8 * fq;
#pragma unroll
        for (int ai = 0; ai < 2; ++ai)
#pragma unroll
            for (int m = 0; m < 4; ++m) {
                const int row = row0 + ai * 128 + m * 16;
#pragma unroll
                for (int bj = 0; bj < 2; ++bj) {
                    const int col = col0 + bj * 128;
                    const u32x4 gw = *(const u32x4*)(G + (size_t)row * 3072 + P * 1024 + col);
                    f32x4 a0 = acc[ai][bj][m][0], a1 = acc[ai][bj][m][1];
                    if (P == 0) { a0 += *(const f32x4*)(bias + col); a1 += *(const f32x4*)(bias + col + 4); }
                    f32x4 o0, o1;
                    o0[0] = bflo(gw.x) * a0[0]; o0[1] = bfhi(gw.x) * a0[1]; o0[2] = bflo(gw.y) * a0[2]; o0[3] = bfhi(gw.y) * a0[3];
                    o1[0] = bflo(gw.z) * a1[0]; o1[1] = bfhi(gw.z) * a1[1]; o1[2] = bflo(gw.w) * a1[2]; o1[3] = bfhi(gw.w) * a1[3];
                    bf16* mp = Mg + (size_t)row * 1024 + col;
                    if (P != 0) { const u32x4 ow = *(const u32x4*)mp;
                        o0[0] += bflo(ow.x); o0[1] += bfhi(ow.x); o0[2] += bflo(ow.y); o0[3] += bfhi(ow.y);
                        o1[0] += bflo(ow.z); o1[1] += bfhi(ow.z); o1[2] += bflo(ow.w); o1[3] += bfhi(ow.w); }
                    *(u32x4*)mp = pack8(o0, o1);
                }
                asm volatile("" ::: "memory");
            }
    }
};
struct EpiD {
    static constexpr bool PERM = false;
    float* H; bf16* HB;
    __device__ __forceinline__ void operator()(const AccT& acc, const pg8::Unit& u, int wr, int wc, int fr, int fq) const {
        const int row0 = u.pm * 256 + wr * 64 + fr, col0 = u.pn * 256 + wc * 32 + 4 * fq;
#pragma unroll
        for (int ai = 0; ai < 2; ++ai)
#pragma unroll
            for (int m = 0; m < 4; ++m) {
                const size_t off = (size_t)(row0 + ai * 128 + m * 16) * 1024 + col0;
#pragma unroll
                for (int bj = 0; bj < 2; ++bj)
#pragma unroll
                    for (int n = 0; n < 2; ++n) { const size_t o = off + bj * 128 + n * 16; const f32x4 hv = *(const f32x4*)(H + o) + acc[ai][bj][m][n];
                        *(f32x4*)(H + o) = hv; u32x2 w; w.x = pk2(hv[0], hv[1]); w.y = pk2(hv[2], hv[3]); *(u32x2*)(HB + o) = w; }
            }
    }
};
struct EpiA2 {
    static constexpr bool PERM = true;
    const float* PW; bf16* HH;
    __device__ __forceinline__ void operator()(const AccT& acc, const pg8::Unit& u, int wr, int wc, int fr, int fq) const {
        const int row0 = u.pm * 256 + wr * 64 + fr, lc0 = wc * 32 + 8 * fq, side = u.pn >> 1;
#pragma unroll
        for (int ai = 0; ai < 2; ++ai)
#pragma unroll
            for (int m = 0; m < 4; ++m) {
                const int row = row0 + ai * 128 + m * 16; const f32x4 pw = *(const f32x4*)(PW + (size_t)row * 4);
                const float rs = pw[0], cw = side ? pw[2] : pw[1];
                f32x4 o[2];
#pragma unroll
                for (int n = 0; n < 2; ++n)
#pragma unroll
                    for (int j = 0; j < 4; ++j) { const float a1 = acc[ai][0][m][n][j] * rs, a3 = acc[ai][1][m][n][j] * rs; o[n][j] = cw * a1 * sigmoidf_(a1) * a3; }
                *(u32x4*)(HH + (size_t)row * 512 + side * 256 + (u.pn & 1) * 128 + lc0) = pack8(o[0], o[1]);
            }
    }
};
struct EpiB2 {
    static constexpr bool PERM = true;
    bf16* Y;
    __device__ __forceinline__ void operator()(const AccT& acc, const pg8::Unit& u, int wr, int wc, int fr, int fq) const {
        const int row0 = u.pm * 256 + wr * 64 + fr, col0 = u.pn * 256 + wc * 32 + 8 * fq;
#pragma unroll
        for (int ai = 0; ai < 2; ++ai)
#pragma unroll
            for (int m = 0; m < 4; ++m) {
                bf16* rp = Y + (size_t)(row0 + ai * 128 + m * 16) * 1024 + col0;
#pragma unroll
                for (int bj = 0; bj < 2; ++bj) *(u32x4*)(rp + bj * 128) = pack8(acc[ai][bj][m][0], acc[ai][bj][m][1]);
            }
    }
};
struct MoeOrder {
    int NP, G, c, mode; const LAS int* pcls; const bf16* W;
    __device__ bool next(int i, pg8::Unit& u) const { const long L = (long)i * G + c; if (L >= (long)NP * 4) return false; u.pm = (int)(L >> 2); u.pn = (int)(L & 3); return true; }
    __device__ __forceinline__ const char* bptr(const pg8::Unit& u, int side) const {
        const int cls = __builtin_amdgcn_readfirstlane(pcls[u.pm]); const int grp = cls / 6, pr = cls % 6;
        const int ea = pr < 3 ? 0 : (pr < 5 ? 1 : 2), eb = pr < 3 ? pr + 1 : (pr < 5 ? pr - 1 : 3);
        if (mode == 0) { const int e = grp * 4 + (u.pn < 2 ? ea : eb); return (const char*)W + ((size_t)e * 512 + (size_t)(u.pn & 1) * 256) * 1024 * 2; }
        const int e = grp * 4 + (side ? eb : ea); return (const char*)W + ((size_t)e * 1024 + (size_t)u.pn * 256) * 256 * 2;
    }
};

#define XB_TMO      128
#define XB_XCNT(j)  (256  + 64 * (j))
#define XB_XSUB(j)  (1280 + 64 * (j))
#define XB_XGEN(j)  (2304 + 64 * (j))
#define XB_TOP      3328
#define XB_TOPGEN   3392
#define XCD_BAR_WORDS 3456
#define XB_SPIN_CAP (1u << 24)
__device__ __forceinline__ unsigned xb_ld(unsigned* p)              { return __hip_atomic_load(p, __ATOMIC_RELAXED, __HIP_MEMORY_SCOPE_AGENT); }
__device__ __forceinline__ unsigned xb_add(unsigned* p, unsigned v) { return __hip_atomic_fetch_add(p, v, __ATOMIC_RELAXED, __HIP_MEMORY_SCOPE_AGENT); }
__device__ __forceinline__ unsigned xb_xcc_id() { return (unsigned)__builtin_amdgcn_s_getreg((3 << 11) | 20) & 0xFu; }
#define XB_SPIN(cond, bar) do { unsigned _sp = 0; while (cond) { __builtin_amdgcn_s_sleep(1); \
    if ((++_sp & 255u) == 0u) { if (xb_ld(&(bar)[XB_TMO])) break; if (_sp > XB_SPIN_CAP) { atomicAdd(&(bar)[XB_TMO], 1u); break; } } } } while (0)
struct XcdBarrier { unsigned* bar; unsigned x; volatile LAS unsigned* st; };
__device__ __forceinline__ XcdBarrier xcd_barrier_post(unsigned* bar, volatile LAS unsigned* st) {
    XcdBarrier b; b.bar = bar; b.x = xb_xcc_id(); b.st = st;
    if (threadIdx.x == 0) (void)xb_add(&bar[XB_XCNT(b.x)], 1u);
    return b;
}
__device__ __forceinline__ void xcd_barrier_complete(unsigned* bar, unsigned x, unsigned& nloc, unsigned& nx) {
    const unsigned G = gridDim.x * gridDim.y * gridDim.z;
    unsigned sum, cnt, mine, sp = 0u;
    for (;;) {
        sum = 0u; cnt = 0u; mine = 0u;
#pragma unroll
        for (unsigned j = 0; j < 16; ++j) { const unsigned c = xb_ld(&bar[XB_XCNT(j)]); sum += c; cnt += (c > 0u) ? 1u : 0u; mine = (j == x) ? c : mine; }
        if (sum == G) break;
        __builtin_amdgcn_s_sleep(1);
        if ((++sp & 255u) == 0u) { if (xb_ld(&bar[XB_TMO])) break; if (sp > XB_SPIN_CAP) { atomicAdd(&bar[XB_TMO], 1u); break; } }
    }
    nloc = mine > 0u ? mine : 1u; nx = cnt > 0u ? cnt : 1u;
}
__device__ __forceinline__ void xcd_barrier(const XcdBarrier& b) {
    asm volatile("s_waitcnt vmcnt(0)" ::: "memory");
    __syncthreads();
    if (threadIdx.x == 0) {
        unsigned* bar = b.bar;
        __builtin_amdgcn_s_waitcnt(0);
        unsigned nloc = b.st[0], nx = b.st[1];
        if (nloc == 0u) { xcd_barrier_complete(bar, b.x, nloc, nx); b.st[0] = nloc; b.st[1] = nx; }
        const unsigned old = xb_add(&bar[XB_XSUB(b.x)], 1u);
        const unsigned gen = old / nloc;
        if (old + 1u == (gen + 1u) * nloc) {
            __builtin_amdgcn_fence(__ATOMIC_RELEASE, "agent");
            asm volatile("s_waitcnt vmcnt(0)" ::: "memory");
            const unsigned og = xb_add(&bar[XB_TOP], 1u);
            const unsigned tg = og / nx;
            if (og + 1u == (tg + 1u) * nx) xb_add(&bar[XB_TOPGEN], 1u);
            else XB_SPIN(xb_ld(&bar[XB_TOPGEN]) == tg, bar);
            __builtin_amdgcn_fence(__ATOMIC_ACQUIRE, "agent");
            xb_add(&bar[XB_XGEN(b.x)], 1u);
            asm volatile("s_waitcnt vmcnt(0)" ::: "memory");
        } else {
            XB_SPIN(xb_ld(&bar[XB_XGEN(b.x)]) == gen, bar);
            __builtin_amdgcn_fence(__ATOMIC_ACQUIRE, "agent");
            asm volatile("s_waitcnt vmcnt(0)" ::: "memory");
        }
    }
    __syncthreads();
}

struct Params { const float* in[25]; float* out; unsigned char* ws; int ph_lo, ph_hi; };
enum { I_X = 0, I_META, I_N1G, I_WIN, I_BF, I_PW, I_PB, I_PS, I_CW, I_CB, I_LNG, I_LNB, I_WOA, I_WOB, I_WOC, I_WO, I_N2G, I_RGW, I_RGB, I_REW, I_REB, I_W1, I_W3, I_W2, I_FG };

struct Frame {
    LAS unsigned char* lds;
    int tid, lane, wave, vcu, G, bx;
};
__device__ __forceinline__ unsigned long long ptab_get(const Frame& F, int i) { const LAS unsigned* t = (const LAS unsigned*)(F.lds + LC_PTAB) + 2 * i; const unsigned lo = __builtin_amdgcn_readfirstlane(t[0]), hi = __builtin_amdgcn_readfirstlane(t[1]); return ((unsigned long long)hi << 32) | lo; }
#define INP(i) ((const float*)(const GAS float*)ptab_get(F, (i)))
#define WSP() ((unsigned char*)(GAS unsigned char*)ptab_get(F, 25))
#define DOP() ((unsigned char*)(GAS unsigned char*)ptab_get(F, 26))

__device__ __forceinline__ void tr_item(const float* W, int ldw, int scol0, const float* gk, bf16* WT, int ldt, int drow0, int k0, LAS float* scr, int lane) {
#pragma unroll 8
    for (int i = 0; i < 32; ++i) { const int kk = 2 * i + (lane >> 5); float v = W[(size_t)(k0 + kk) * ldw + scol0 + (lane & 31)]; if (gk) v *= gk[k0 + kk]; scr[kk * 33 + (lane & 31)] = v; }
    LDS_WAIT(); asm volatile("" ::: "memory");
    const int c = lane & 7;
#pragma unroll
    for (int j = 0; j < 4; ++j) { const int n = (lane >> 3) + 8 * j; const LAS float* s = scr + (8 * c) * 33 + n;
        u32x4 o; o.x = pk2(s[0 * 33], s[1 * 33]); o.y = pk2(s[2 * 33], s[3 * 33]); o.z = pk2(s[4 * 33], s[5 * 33]); o.w = pk2(s[6 * 33], s[7 * 33]);
        *(u32x4*)(WT + (size_t)(drow0 + n) * ldt + k0 + 8 * c) = o; }
    LDS_WAIT(); asm volatile("" ::: "memory");
}
__device__ __forceinline__ int map1(int n) {
    const int tile = n >> 8, r = n & 255;
    if (tile == 0) return n;
    if (tile <= 2) { const int c = (tile - 1) * 128 + (r & 127); return (r < 128 ? 256 : 512) + c; }
    if (tile <= 8) return n;
    return n + 8;
}
__device__ __forceinline__ void convert_weights(Frame& F, int l) {
    LAS float* scr = (LAS float*)(F.lds + F.wave * 16384);
    const int gw = F.vcu * NWAVES + F.wave, NGW = F.G * NWAVES, lane = F.lane;
    const float* g1 = INP(I_N1G) + (size_t)l * D; const float* g2 = INP(I_N2G) + (size_t)l * D;
    unsigned char* ws = WSP();
    { const float* W = INP(I_WIN) + (size_t)l * D * NIN; bf16* WT = (bf16*)(ws + WS_W1T);
      for (int it = gw; it < 16 * 168; it += NGW) { const int kb = it / 168, nb = it % 168; tr_item(W, NIN, map1(nb * 32), g1, WT, 1024, nb * 32, kb * 64, scr, lane); } }
    { const float* W = INP(I_WOB) + (size_t)l * 256 * D; bf16* WT = (bf16*)(ws + WS_WBT);
      for (int it = gw; it < 4 * 32; it += NGW) { const int kb = it / 32, nb = it % 32; tr_item(W, 1024, nb * 32, nullptr, WT, 256, nb * 32, kb * 64, scr, lane); } }
    { const float* W = INP(I_WOC) + (size_t)l * 512 * D; bf16* WT = (bf16*)(ws + WS_WCT);
      for (int it = gw; it < 8 * 32; it += NGW) { const int kb = it / 32, nb = it % 32; tr_item(W, 1024, nb * 32, nullptr, WT, 512, nb * 32, kb * 64, scr, lane); } }
    { const float* W = INP(I_WO) + (size_t)l * D * D; bf16* WT = (bf16*)(ws + WS_WOT);
      for (int it = gw; it < 16 * 32; it += NGW) { const int kb = it / 32, nb = it % 32; tr_item(W, 1024, nb * 32, nullptr, WT, 1024, nb * 32, kb * 64, scr, lane); } }
    { bf16* WT = (bf16*)(ws + WS_W13T);
      for (int it = gw; it < 16 * 256; it += NGW) { const int e = it >> 8, r = it & 255, kb = r >> 4, nb = r & 15, n0 = nb * 32, jt = n0 >> 8, rr = n0 & 255;
        const float* W = (rr < 128 ? INP(I_W1) : INP(I_W3)) + ((size_t)l * 16 + e) * D * 256;
        tr_item(W, 256, jt * 128 + (rr & 127), g2, WT + (size_t)e * 512 * 1024, 1024, n0, kb * 64, scr, lane); } }
    { bf16* WT = (bf16*)(ws + WS_W2T);
      for (int it = gw; it < 16 * 128; it += NGW) { const int e = it >> 7, r = it & 127, kb = r >> 5, nb = r & 31;
        const float* W = INP(I_W2) + ((size_t)l * 16 + e) * 256 * D;
        tr_item(W, 1024, nb * 32, nullptr, WT + (size_t)e * 1024 * 256, 256, nb * 32, kb * 64, scr, lane); } }
    { const float* pw = INP(I_PW) + (size_t)l * 4 * 64 * 64; const float* ps = INP(I_PS) + (size_t)l * 256; const float* pb = INP(I_PB) + (size_t)l * 256;
      const float* wa = INP(I_WOA) + (size_t)l * 256 * D; bf16* WT = (bf16*)(ws + WS_WAT); float* bias = (float*)(ws + WS_BIASA);
      const int gt = F.vcu * 512 + F.tid, NT = F.G * 512;
      for (int idx = gt; idx < 256 * 1024; idx += NT) { const int n = idx & 1023, kk = idx >> 10, grp = kk >> 6, c = kk & 63; float s = 0.f;
        for (int d = 0; d < 64; ++d) s += pw[(grp * 64 + c) * 64 + d] * ps[grp * 64 + d] * wa[(size_t)(grp * 64 + d) * D + n];
        WT[(size_t)n * 256 + kk] = (bf16)f2bf(s); }
      for (int n = gt; n < 1024; n += NT) { float s = 0.f; for (int d = 0; d < 256; ++d) s += pb[d] * ps[d] * wa[(size_t)d * D + n]; bias[n] = s; }
      float* wfg = (float*)(ws + WS_WFG); const float* win = INP(I_WIN) + (size_t)l * D * NIN;
      for (int idx = gt; idx < 8 * 1024; idx += NT) { const int c = idx >> 10, k = idx & 1023; wfg[idx] = g1[k] * win[(size_t)k * NIN + 2304 + c]; }
      float* rg = (float*)(ws + WS_RG); const float* re = INP(I_REW) + (size_t)l * D * 16; const float* rgw = INP(I_RGW) + (size_t)l * D * 4;
      for (int idx = gt; idx < 20 * 1024; idx += NT) { const int c = idx >> 10, k = idx & 1023; rg[idx] = g2[k] * (c < 16 ? re[(size_t)k * 16 + c] : rgw[(size_t)k * 4 + (c - 16)]); } }
}
__device__ __forceinline__ void init_rows(Frame& F) {
    const int gw = F.vcu * NWAVES + F.wave, NGW = F.G * NWAVES, lane = F.lane;
    float* H = (float*)(WSP() + WS_H); bf16* HB = (bf16*)(WSP() + WS_HB); float* rstd1 = (float*)(WSP() + WS_RSTD1);

#pragma unroll 1
for (int row = gw; row < TM; row += NGW) {
        const float* src = row < TX ? INP(I_X) + (size_t)row * D : (row - TX < NMETA ? INP(I_META) + (size_t)(row - TX) * D : nullptr);
        f32x4 v[4]; float ss = 0.f;
#pragma unroll
        for (int j = 0; j < 4; ++j) { float z_ = 0.f; LAUNDER_V(z_); v[j] = src ? *(const f32x4*)(src + 4 * lane + 256 * j) : (f32x4){z_, z_, z_, z_}; ss += v[j][0] * v[j][0] + v[j][1] * v[j][1] + v[j][2] * v[j][2] + v[j][3] * v[j][3]; }
        ss = wave_sum(ss);
#pragma unroll
        for (int j = 0; j < 4; ++j) { *(f32x4*)(H + (size_t)row * D + 4 * lane + 256 * j) = v[j]; u32x2 w; w.x = pk2(v[j][0], v[j][1]); w.y = pk2(v[j][2], v[j][3]); *(u32x2*)(HB + (size_t)row * D + 4 * lane + 256 * j) = w; }
        if (lane == 0) rstd1[row] = rsqrtf(ss * (1.0f / D) + EPS);
    }
}

__device__ __forceinline__ int srcrow(bool isx, int b, int t) {
    if (t >= 0) return (isx ? b * SEQ : TX) + t;
    if (isx) { const int mm = NMETA + t; return mm >= 0 ? TX + mm : -1; }
    return -1;
}
__device__ __forceinline__ void phase_S(Frame& F, int l) {
    LAS unsigned char* lds = F.lds; const int wave = F.wave;
#pragma unroll 1
    for (int item = F.vcu; item < 516; item += F.G) {
        const bool isx = item < 512; const int row0 = isx ? item * 64 : TX + (item - 512) * 64; const int b = isx ? (item * 64) / SEQ : 0; const int t0 = isx ? (item * 64) % SEQ : (item - 512) * 64;
        { unsigned char* ws = WSP(); int tid = F.tid; LAUNDER_V(tid); const int lane = tid & 63;
          const bf16* HB = (const bf16*)(ws + WS_HB); const float* rstd1 = (const float*)(ws + WS_RSTD1); const float* wfg = (const float*)(ws + WS_WFG);
          float* LFT = (float*)(ws + WS_LFT); float* LFTM = (float*)(ws + WS_LFTM); const float* bfg = INP(I_BF) + l * 8;
          LAS float* W = (LAS float*)lds;
#pragma unroll 1
          for (int i = tid; i < 2048; i += 512) *(LAS f32x4*)(W + 4 * i) = *(const f32x4*)(wfg + 4 * i);
          __syncthreads();
#pragma unroll 1
          for (int rr = wave; rr < 64; rr += 8) { const int row = row0 + rr; float xv[16];
#pragma unroll
            for (int j = 0; j < 2; ++j) { const u32x4 w = *(const u32x4*)(HB + (size_t)row * D + 8 * lane + 512 * j);
                xv[8 * j + 0] = bflo(w.x); xv[8 * j + 1] = bfhi(w.x); xv[8 * j + 2] = bflo(w.y); xv[8 * j + 3] = bfhi(w.y); xv[8 * j + 4] = bflo(w.z); xv[8 * j + 5] = bfhi(w.z); xv[8 * j + 6] = bflo(w.w); xv[8 * j + 7] = bfhi(w.w); }
            float mine = 0.f;
#pragma unroll
            for (int c = 0; c < 8; ++c) { float s = 0.f;
#pragma unroll
                for (int j = 0; j < 2; ++j) { const f32x4 w0 = *(const LAS f32x4*)(W + c * 1024 + 8 * lane + 512 * j), w1 = *(const LAS f32x4*)(W + c * 1024 + 8 * lane + 512 * j + 4);
                    s += xv[8 * j] * w0[0] + xv[8 * j + 1] * w0[1] + xv[8 * j + 2] * w0[2] + xv[8 * j + 3] * w0[3] + xv[8 * j + 4] * w1[0] + xv[8 * j + 5] * w1[1] + xv[8 * j + 6] * w1[2] + xv[8 * j + 7] * w1[3]; }
                s = wave_sum(s); if (lane == c) mine = s; }
            if (lane < 8) { const float xg = mine * rstd1[row] + bfg[lane]; const float lf = fminf(xg, 0.f) - 0.69314718056f * __builtin_amdgcn_logf(1.0f + __expf(-fabsf(xg)));
                if (isx) LFT[(size_t)(b * 8 + lane) * SEQ + t0 + rr] = lf; else LFTM[lane * 256 + t0 + rr] = lf; } }
          __syncthreads(); }
        { unsigned char* ws = WSP(); int tid = F.tid; LAUNDER_V(tid);
          const bf16* Ab = (const bf16*)(ws + WS_A); bf16* DIFF = (bf16*)(ws + WS_DIFF);
          LAS unsigned char* T = lds;
#pragma unroll 1
          for (int i = tid; i < 79 * 32; i += 512) { const int s = i >> 5, ch = i & 31; const int r = srcrow(isx, b, t0 + s - 15);
              unsigned z_ = 0u; LAUNDER_V(z_);
              *(LAS u32x4*)(T + s * 512 + ch * 16) = r >= 0 ? *(const u32x4*)(Ab + (size_t)r * 256 + ch * 8) : (u32x4){z_, z_, z_, z_}; }
          __syncthreads();
#pragma unroll 1
          for (int i = tid; i < 64 * 32; i += 512) { const int r = i >> 5, ch = i & 31, grp = ch >> 3, w = 2 << grp; const int cnt = isx ? w : min(t0 + r + 1, w);
              float s[8];
#pragma unroll
              for (int j = 0; j < 8; ++j) s[j] = 0.f;
#pragma unroll 1
              for (int d = 0; d < cnt; ++d) { const u32x4 v = *(const LAS u32x4*)(T + (15 + r - d) * 512 + ch * 16);
                  s[0] += bflo(v.x); s[1] += bfhi(v.x); s[2] += bflo(v.y); s[3] += bfhi(v.y); s[4] += bflo(v.z); s[5] += bfhi(v.z); s[6] += bflo(v.w); s[7] += bfhi(v.w); }
              const u32x4 a = *(const LAS u32x4*)(T + (15 + r) * 512 + ch * 16); const float ic = 1.0f / (float)cnt;
              u32x4 o; o.x = pk2(s[0] * ic - bflo(a.x), s[1] * ic - bfhi(a.x)); o.y = pk2(s[2] * ic - bflo(a.y), s[3] * ic - bfhi(a.y));
              o.z = pk2(s[4] * ic - bflo(a.z), s[5] * ic - bfhi(a.z)); o.w = pk2(s[6] * ic - bflo(a.w), s[7] * ic - bfhi(a.w));
              *(u32x4*)(DIFF + (size_t)(row0 + r) * 256 + ch * 8) = o; }
          __syncthreads(); }
        { unsigned char* ws = WSP(); int tid = F.tid; LAUNDER_V(tid);
          const bf16* GLU = (const bf16*)(ws + WS_GLU);
          LAS unsigned char* T = lds;
          LAS float* Yt = (LAS float*)(lds + 49152);
#pragma unroll 1
          for (int i = tid; i < 94 * 32; i += 512) { const int s = i >> 5, ch = i & 31; const int r = srcrow(isx, b, t0 + s - 30);
              unsigned z_ = 0u; LAUNDER_V(z_);
              *(LAS u32x4*)(T + s * 512 + ch * 16) = r >= 0 ? *(const u32x4*)(GLU + (size_t)r * 256 + ch * 8) : (u32x4){z_, z_, z_, z_}; }
          __syncthreads();
          { const float* cw = INP(I_CW) + (size_t)l * 31 * 256; const float* cb = INP(I_CB) + l * 256;
            const int cp = tid & 127, strip = tid >> 7; f32x2 wv[31];
#pragma unroll
            for (int j = 0; j < 31; ++j) wv[j] = *(const f32x2*)(cw + j * 256 + 2 * cp);
            const f32x2 bias = *(const f32x2*)(cb + 2 * cp);
#pragma unroll 1
            for (int hh = 0; hh < 2; ++hh) { const int rb = 32 * hh + 8 * strip; f32x2 acc[8];
#pragma unroll
                for (int r = 0; r < 8; ++r) acc[r] = bias;
#pragma unroll
                for (int i = 0; i < 38; ++i) { const unsigned xw = *(const LAS unsigned*)(T + (rb + i) * 512 + cp * 4); const f32x2 xx = {bflo(xw), bfhi(xw)};
#pragma unroll
                    for (int r = 0; r < 8; ++r) { const int j = i - r; if (j >= 0 && j <= 30) acc[r] += wv[j] * xx; } }
#pragma unroll
                for (int r = 0; r < 8; ++r) *(LAS f32x2*)(Yt + (rb + r) * 256 + 2 * cp) = acc[r]; } }
          __syncthreads();
          { unsigned char* ws2 = WSP(); int tid2 = F.tid; LAUNDER_V(tid2); const int lane = tid2 & 63;
            bf16* BP = (bf16*)(ws2 + WS_BP); const float* lng = INP(I_LNG) + l * 256; const float* lnb = INP(I_LNB) + l * 256;
#pragma unroll 1
            for (int rr = wave; rr < 64; rr += 8) { const f32x4 v = *(const LAS f32x4*)(Yt + rr * 256 + 4 * lane);
              const float mean = wave_sum(v[0] + v[1] + v[2] + v[3]) * (1.0f / 256.0f); const f32x4 dv = v - mean;
              const float var = wave_sum(dv[0] * dv[0] + dv[1] * dv[1] + dv[2] * dv[2] + dv[3] * dv[3]) * (1.0f / 256.0f); const float rs = rsqrtf(var + EPS);
              const f32x4 gg = *(const f32x4*)(lng + 4 * lane), bb = *(const f32x4*)(lnb + 4 * lane); f32x4 o = dv * rs * gg + bb;
#pragma unroll
              for (int j = 0; j < 4; ++j) o[j] = o[j] * sigmoidf_(o[j]);
              u32x2 w; w.x = pk2(o[0], o[1]); w.y = pk2(o[2], o[3]); *(u32x2*)(BP + (size_t)(row0 + rr) * 256 + 4 * lane) = w; } }
          __syncthreads(); }
    }
}

constexpr int AT_FL = 0, AT_K = 34816, AT_VT = AT_K + 8192, AT_SC = AT_VT + 8192;
__device__ __forceinline__ void attn_scan(Frame& F, int b, int h, bool meta_only, int fl_off, int sc_off) {
    LAS float* Fl = (LAS float*)(F.lds + fl_off); LAS float* sc = (LAS float*)(F.lds + sc_off);
    const float* LFT = (const float*)(WSP() + WS_LFT); const float* LFTM = (const float*)(WSP() + WS_LFTM);
    const int tid = F.tid, lane = F.lane, wave = F.wave;
    __syncthreads();
    if (tid == 0) { float s = 0.f; for (int m = 0; m < 64; ++m) { if (m < (meta_only ? 64 : NMETA)) { s += LFTM[h * 256 + m]; Fl[m] = s * LOG2E; } else Fl[m] = 1e30f; if (m == NMETA - 1) sc[16] = s; } }
    if (meta_only) { for (int i = tid; i < 256; i += 512) Fl[64 + i] = 0.f; __syncthreads(); return; }
    float v[16]; const float* src = LFT + (size_t)(b * 8 + h) * SEQ + 16 * tid;
#pragma unroll
    for (int j = 0; j < 4; ++j) { const f32x4 q = *(const f32x4*)(src + 4 * j); v[4 * j] = q[0]; v[4 * j + 1] = q[1]; v[4 * j + 2] = q[2]; v[4 * j + 3] = q[3]; }
#pragma unroll
    for (int j = 1; j < 16; ++j) v[j] += v[j - 1];
    float incl = v[15];
#pragma unroll
    for (int o = 1; o < 64; o <<= 1) { const float up = __int_as_float(__builtin_amdgcn_ds_bpermute((lane - o) << 2, __float_as_int(incl))); if (lane >= o) incl += up; }
    if (lane == 63) sc[wave] = incl;
    __syncthreads();
    float off = sc[16];
    for (int w = 0; w < wave; ++w) off += sc[w];
    off += incl - v[15];
#pragma unroll
    for (int j = 0; j < 16; ++j) Fl[64 + 16 * tid + j] = (off + v[j]) * LOG2E;
    __syncthreads();
}
__device__ __forceinline__ void attn_unit_naive(Frame& F, int qrow0, int qpos0, int ntiles, int kvx0, int h) {
    const int tid = F.tid; const int r = tid >> 1, hf = tid & 1;
    const bf16* Q = (const bf16*)(DOP() + DO_Q); const bf16* Kg = (const bf16*)(DOP() + DO_K); const bf16* Vg = (const bf16*)(DOP() + DO_V); bf16* O = (bf16*)(DOP() + DO_Q);
    LAS float* Fl = (LAS float*)(F.lds + AT_FL); LAS unsigned char* Ks = F.lds + AT_K; LAS bf16* VT = (LAS bf16*)(F.lds + AT_VT);
    const int grow = qrow0 + r, qpos = qpos0 + r;
    unsigned qp[16];
#pragma unroll
    for (int j = 0; j < 4; ++j) { const u32x4 w = *(const u32x4*)(Q + (size_t)grow * 512 + h * 64 + hf * 32 + 8 * j); qp[4 * j] = w.x; qp[4 * j + 1] = w.y; qp[4 * j + 2] = w.z; qp[4 * j + 3] = w.w; }
    const float Fq = Fl[qpos < NMETA ? qpos : qpos + 48];
    float mrun = -1e30f, lrun = 0.f, o[32];
#pragma unroll
    for (int d = 0; d < 32; ++d) o[d] = 0.f;
    const int lrow = tid >> 3, lch = tid & 7;

#pragma unroll 1
for (int i = 0; i < ntiles; ++i) {
        const int krow = (i == 0 ? TX : kvx0 + 64 * (i - 1)) + lrow;
        const u32x4 kw = *(const u32x4*)(Kg + (size_t)krow * 512 + h * 64 + lch * 8);
        const u32x4 vw = *(const u32x4*)(Vg + (size_t)krow * 512 + h * 64 + lch * 8);
        __syncthreads();
        *(LAS u32x4*)(Ks + lrow * 128 + lch * 16) = kw;
        { const unsigned vv[4] = {vw.x, vw.y, vw.z, vw.w};
#pragma unroll
          for (int e = 0; e < 4; ++e) { VT[(lch * 8 + 2 * e) * 64 + lrow] = (bf16)(vv[e] & 0xffffu); VT[(lch * 8 + 2 * e + 1) * 64 + lrow] = (bf16)(vv[e] >> 16); } }
        __syncthreads();
        const int kp0 = i == 0 ? 0 : NMETA + 64 * (i - 1);
        if (kp0 > qpos0 + 255) continue;
#pragma unroll 1
        for (int jg = 0; jg < 4; ++jg) {
            float s[16]; float gmax = -1e30f;
#pragma unroll
            for (int jj = 0; jj < 16; ++jj) { const int j = jg * 16 + jj; float d = 0.f;
#pragma unroll
                for (int c = 0; c < 4; ++c) { const u32x4 kk = *(const LAS u32x4*)(Ks + j * 128 + hf * 64 + c * 16);
                    d = dot2bf(kk.x, qp[4 * c], d); d = dot2bf(kk.y, qp[4 * c + 1], d); d = dot2bf(kk.z, qp[4 * c + 2], d); d = dot2bf(kk.w, qp[4 * c + 3], d); }
                d += lane_xor<1>(d);
                const bool valid = (i == 0 ? j < NMETA : true) && (kp0 + j <= qpos);
                s[jj] = valid ? d + Fq - Fl[64 * i + j] : -1e30f; gmax = fmaxf(gmax, s[jj]); }
            const float mn = fmaxf(mrun, gmax), alpha = exp2f(mrun - mn); mrun = mn;
            float ps = 0.f; unsigned pp[8];
#pragma unroll
            for (int jj = 0; jj < 16; jj += 2) { const float p0 = exp2f(s[jj] - mn), p1 = exp2f(s[jj + 1] - mn); ps += p0 + p1; pp[jj >> 1] = pk2(p0, p1); }
            lrun = lrun * alpha + ps;
#pragma unroll
            for (int d = 0; d < 32; ++d) { const u32x4 v0 = *(const LAS u32x4*)(VT + (hf * 32 + d) * 64 + jg * 16), v1 = *(const LAS u32x4*)(VT + (hf * 32 + d) * 64 + jg * 16 + 8);
                float a = o[d] * alpha; a = dot2bf(pp[0], v0.x, a); a = dot2bf(pp[1], v0.y, a); a = dot2bf(pp[2], v0.z, a); a = dot2bf(pp[3], v0.w, a);
                a = dot2bf(pp[4], v1.x, a); a = dot2bf(pp[5], v1.y, a); a = dot2bf(pp[6], v1.z, a); a = dot2bf(pp[7], v1.w, a); o[d] = a; }
        }
    }
    const float il = 1.0f / lrun;
#pragma unroll
    for (int j = 0; j < 4; ++j) { u32x4 w; w.x = pk2(o[8 * j] * il, o[8 * j + 1] * il); w.y = pk2(o[8 * j + 2] * il, o[8 * j + 3] * il); w.z = pk2(o[8 * j + 4] * il, o[8 * j + 5] * il); w.w = pk2(o[8 * j + 6] * il, o[8 * j + 7] * il);
        *(u32x4*)(O + (size_t)grow * 512 + h * 64 + hf * 32 + 8 * j) = w; }
}
namespace fa {
using bf16x8v = __attribute__((ext_vector_type(8))) short;
using s16x4 = __attribute__((ext_vector_type(4))) short;
using f32x16 = __attribute__((ext_vector_type(16))) float;
constexpr int DMA = 512;
constexpr int NW = 8, QBLK = 32, QB = 256, KVBLK = 64;
constexpr int NSLOT = 3, SLOTB = 8192;
constexpr int LDS_K = 0, LDS_V = NSLOT * SLOTB, LDS_WS = 2 * NSLOT * SLOTB, LDS_OST = LDS_WS + NW * 64 * 4, LDS_BYTES = LDS_OST + NW * 4096;
constexpr int LDS_FL = 84992;
constexpr int LDS_SCAN = LDS_FL + (64 + 8192) * 4;
static_assert(LDS_SCAN + 128 <= RING_BYTES, "attention LDS");
__device__ __forceinline__ int crow(int r, int hi) { return (r & 3) + 8 * (r >> 2) + 4 * hi; }
#define SBAR() __builtin_amdgcn_sched_barrier(0)
__device__ __forceinline__ void cmask(f32x16& p0, f32x16& p1, int jb, int qrel, int hi) {
    const float NEG = -INFINITY; int kb = 64 * jb + 4 * hi;
#pragma unroll
    for (int r = 0; r < 16; ++r) { int kv = kb + (r & 3) + 8 * (r >> 2); if (kv > qrel) p0[r] = NEG; if (kv + 32 > qrel) p1[r] = NEG; }
}
__device__ __forceinline__ void glds16(const void* gsrc, unsigned lds_dst) { unsigned keep;
    asm volatile("s_mov_b32 %0, m0\n\ts_mov_b32 m0, %2\n\ts_nop 0\n\tglobal_load_lds_dwordx4 %1, off\n\ts_mov_b32 m0, %0" : "=&s"(keep) : "v"(gsrc), "s"(lds_dst) : "memory"); }
__device__ __forceinline__ float max3f(float a, float b, float c) { float r; asm("v_max3_f32 %0, %1, %2, %3" : "=v"(r) : "v"(a), "v"(b), "v"(c)); return r; }
__device__ __forceinline__ float max2f(float a, float b) { float r; asm("v_max_f32_e32 %0, %1, %2" : "=v"(r) : "v"(a), "v"(b)); return r; }
__device__ __forceinline__ float fsub_s(float a, float b) { float r; asm("v_sub_f32_e32 %0, %1, %2" : "=v"(r) : "v"(a), "v"(b)); return r; }
typedef float f32x2_t __attribute__((ext_vector_type(2))); typedef __bf16 bf16x2_t __attribute__((ext_vector_type(2)));
__device__ __forceinline__ unsigned cvtpk_s(float lo, float hi) { f32x2_t v = {lo, hi}; bf16x2_t b = __builtin_convertvector(v, bf16x2_t); return __builtin_bit_cast(unsigned, b); }
#define WAIT_BAR(N) asm volatile("s_waitcnt vmcnt(" #N ") lgkmcnt(0)\n\ts_barrier" ::: "memory")
typedef __attribute__((address_space(3))) const char* lds_cptr;
typedef short v4i16_t __attribute__((ext_vector_type(4)));
__device__ __forceinline__ void cinit(f32x16& p0, f32x16& p1, const LAS float* fk, float a) {
#pragma unroll
    for (int g = 0; g < 4; ++g) { const f32x4 f0 = *(const LAS f32x4*)(fk + 8 * g), f1 = *(const LAS f32x4*)(fk + 32 + 8 * g);
#pragma unroll
        for (int i = 0; i < 4; ++i) { p0[4 * g + i] = a - f0[i]; p1[4 * g + i] = a - f1[i]; } }
}
__device__ __forceinline__ void qkt(f32x16& p0, f32x16& p1, const char* Kslot, const bf16x8v* qr, int r32, int hi) {
    const char* kb = Kslot + hi * 1024 + r32 * 16;
#pragma unroll
    for (int d0 = 0; d0 < 4; ++d0) {
        const bf16x8v b0 = *reinterpret_cast<const bf16x8v*>(kb + d0 * 2048);
        const bf16x8v b1 = *reinterpret_cast<const bf16x8v*>(kb + d0 * 2048 + 512);
        p0 = __builtin_amdgcn_mfma_f32_32x32x16_bf16(b0, qr[d0], p0, 0, 0, 0); p1 = __builtin_amdgcn_mfma_f32_32x32x16_bf16(b1, qr[d0], p1, 0, 0, 0); }
}
__device__ __forceinline__ void kload8(bf16x8v* kf, lds_cptr kp) {
    kf[0] = *(const LAS bf16x8v*)(kp);        kf[1] = *(const LAS bf16x8v*)(kp + 512);
    kf[2] = *(const LAS bf16x8v*)(kp + 2048); kf[3] = *(const LAS bf16x8v*)(kp + 2560);
    kf[4] = *(const LAS bf16x8v*)(kp + 4096); kf[5] = *(const LAS bf16x8v*)(kp + 4608);
    kf[6] = *(const LAS bf16x8v*)(kp + 6144); kf[7] = *(const LAS bf16x8v*)(kp + 6656);
}
__device__ __forceinline__ void kload2(bf16x8v* kf, lds_cptr kp, int j) { kf[2 * j] = *(const LAS bf16x8v*)(kp + j * 2048); kf[2 * j + 1] = *(const LAS bf16x8v*)(kp + j * 2048 + 512); }
__device__ __forceinline__ s16x4 vtr(lds_cptr p) { return __builtin_bit_cast(s16x4, __builtin_amdgcn_ds_read_tr16_b64_v4i16((LAS v4i16_t*)p)); }
__device__ __forceinline__ float rowmax(const f32x16& p0, const f32x16& p1) {
    float a = max3f(p0[0], p0[1], p1[0]), b = max3f(p0[2], p0[3], p1[1]); a = max3f(a, p1[2], p1[3]);
#pragma unroll
    for (int r = 4; r < 16; r += 4) { a = max3f(a, p0[r], p0[r + 1]); b = max3f(b, p0[r + 2], p0[r + 3]); a = max3f(a, p1[r], p1[r + 1]); b = max3f(b, p1[r + 2], p1[r + 3]); }
    const float m = max2f(a, b);
    auto rr = __builtin_amdgcn_permlane32_swap(__float_as_uint(m), __float_as_uint(m), false, false);
    return max2f(__uint_as_float(rr[0]), __uint_as_float(rr[1]));
}
__device__ __forceinline__ void pv(f32x16* o, int vb, bf16x8v pa0, bf16x8v pa1, bf16x8v pa2, bf16x8v pa3) {
#pragma unroll
    for (int d0 = 0; d0 < 2; ++d0) { s16x4 lo[4], hi[4];
#pragma unroll
        for (int ks = 0; ks < 4; ++ks) {
            asm volatile("ds_read_b64_tr_b16 %0,%1 offset:%c2" : "=&v"(lo[ks]) : "v"(vb), "i"(d0 * 4096 + ks * 1024) : "memory");
            asm volatile("ds_read_b64_tr_b16 %0,%1 offset:%c2" : "=&v"(hi[ks]) : "v"(vb), "i"(d0 * 4096 + ks * 1024 + 512) : "memory"); }
        asm volatile("s_waitcnt lgkmcnt(0)" ::: "memory"); SBAR();
#define PK(k) (bf16x8v){lo[k][0], lo[k][1], lo[k][2], lo[k][3], hi[k][0], hi[k][1], hi[k][2], hi[k][3]}
        o[d0] = __builtin_amdgcn_mfma_f32_32x32x16_bf16(pa0, PK(0), o[d0], 0, 0, 0);
        o[d0] = __builtin_amdgcn_mfma_f32_32x32x16_bf16(pa1, PK(1), o[d0], 0, 0, 0);
        o[d0] = __builtin_amdgcn_mfma_f32_32x32x16_bf16(pa2, PK(2), o[d0], 0, 0, 0);
        o[d0] = __builtin_amdgcn_mfma_f32_32x32x16_bf16(pa3, PK(3), o[d0], 0, 0, 0);
#undef PK
    }
}
template <int THRL> __device__ __forceinline__ void attn_unit(int b, int h, int qb, const bf16* Q, const bf16* __restrict__ K, const bf16* __restrict__ V, bf16* O, char* shm, int wid) {
    const int lane = lane_id_opaque(), r32 = lane & 31, hi = lane >> 5;
    const long rowbase = (long)b * SEQ; const int q0 = qb * QB;
    const bf16* Qw = Q + (rowbase + q0 + wid * QBLK) * DMA + h * 64;
    const bf16* Kh = K + rowbase * DMA + h * 64, *Vh = V + rowbase * DMA + h * 64;
    const bf16* Km = K + (long)TX * DMA + h * 64, *Vm = V + (long)TX * DMA + h * 64;
    const unsigned lds0 = (unsigned)(uintptr_t)shm;
    float* wsf = (float*)(shm + LDS_WS) + wid * 64;
    const bf16* ksrc = Kh + (long)lane * DMA + wid * 8;
    const bf16* vsrc = Vh + (long)(16 * (wid & 3) + (lane >> 2)) * DMA + (wid >> 2) * 32 + (lane & 3) * 8;
    const bf16* ksrcm = Km + (long)lane * DMA + wid * 8;
    const bf16* vsrcm = Vm + (long)(16 * (wid & 3) + (lane >> 2)) * DMA + (wid >> 2) * 32 + (lane & 3) * 8;
    const unsigned kdst = lds0 + LDS_K + wid * 1024, vdst = lds0 + LDS_V + wid * 1024;
#define DMA_K(t, slot) glds16(ksrc + (long)((t) - 1) * KVBLK * DMA, (unsigned)__builtin_amdgcn_readfirstlane(kdst + (slot)))
#define DMA_V(t, slot) glds16(vsrc + (long)((t) - 1) * KVBLK * DMA, (unsigned)__builtin_amdgcn_readfirstlane(vdst + (slot)))
    const int vb0 = (int)(lds0 + LDS_V) + ((lane >> 4) & 1) * 32 + (lane & 3) * 8 + (4 * hi + ((lane & 15) >> 2)) * 64;
    const char* Kbase = shm + LDS_K; bf16x8v kf[8];
    const lds_cptr shm3 = (lds_cptr)shm; const lds_cptr kp0 = shm3 + LDS_K + hi * 1024 + r32 * 16; const lds_cptr vp0 = shm3 + LDS_V + ((lane >> 4) & 1) * 32 + (lane & 3) * 8 + (4 * hi + ((lane & 15) >> 2)) * 64;
    const LAS float* Flp = (const LAS float*)(shm3 + LDS_FL) + 4 * hi;
    const int NT = 4 * qb + 5;
    glds16(ksrcm, (unsigned)__builtin_amdgcn_readfirstlane(kdst)); glds16(vsrcm, (unsigned)__builtin_amdgcn_readfirstlane(vdst)); DMA_K(1, SLOTB);
    bf16x8v qr[4];
#pragma unroll
    for (int d0 = 0; d0 < 4; ++d0) qr[d0] = *reinterpret_cast<const bf16x8v*>(&Qw[(long)r32 * DMA + d0 * 16 + hi * 8]);
    float aq = ((const LAS float*)(shm3 + LDS_FL))[64 + q0 + wid * QBLK + r32];
    float l_reg = 0.f; f32x16 o[2]; o[0] = f32x16{}; o[1] = f32x16{};
    const int qrel = wid * QBLK + r32;
#define CMASK(P0, P1, t) do { int jb_ = (t) - (NT - 4); if (jb_ >= 0) cmask(P0, P1, jb_, qrel, hi); } while (0)
    bool resc = false;
#define START(P0, P1) do { const float rm = rowmax(P0, P1); resc = false; \
    { const float dl = rm; aq = fsub_s(aq, dl); \
      _Pragma("unroll") for (int r = 0; r < 16; ++r) { P0[r] = fsub_s(P0[r], dl); P1[r] = fsub_s(P1[r], dl); } } \
    _Pragma("unroll") for (int r = 0; r < 16; ++r) P0[r] = __builtin_amdgcn_exp2f(P0[r]); } while (0)
#define RESC() do { if (resc) { asm volatile("s_waitcnt lgkmcnt(0)" ::: "memory"); \
      _Pragma("unroll") for (int d_ = 0; d_ < 2; ++d_) _Pragma("unroll") for (int r = 0; r < 16; ++r) o[d_][r] *= wsf[crow(r, hi)]; } } while (0)
    f32x16 pA0, pA1, pB0, pB1;
    int sl_prev = 0, sl_cur = 0, sl_next = SLOTB;
#define ROT() do { sl_prev = sl_cur; sl_cur = sl_next; sl_next = (sl_next == (NSLOT - 1) * SLOTB) ? 0 : sl_next + SLOTB; } while (0)
    DMA_K(2, 2 * SLOTB);
    cinit(pA0, pA1, Flp, aq);
    WAIT_BAR(3);
    qkt(pA0, pA1, Kbase, qr, r32, hi); asm volatile("s_nop 15\n\ts_nop 7" : "+v"(pA0), "+v"(pA1));
    START(pA0, pA1);
    _Pragma("unroll") for (int r = 0; r < 16; ++r) pA1[r] = __builtin_amdgcn_exp2f(pA1[r]);
    WAIT_BAR(0);
    DMA_K(3, 0); DMA_V(1, SLOTB);
    ROT();
    kload8(kf, kp0 + sl_cur);
    WAIT_BAR(2);
    s16x4 vlo[8], vhi[8]; u32x4 pw0, pw1, pw2, pw3;
#define PKW(P, B) cvtpk_s(P[B], P[B + 1])
#define PAF(k) __builtin_bit_cast(bf16x8v, pw##k)
#define VFR(i) (bf16x8v){vlo[i][0], vlo[i][1], vlo[i][2], vlo[i][3], vhi[i][0], vhi[i][1], vhi[i][2], vhi[i][3]}
#define PIN(x) asm volatile("" : "+v"(x))
#define MX3(a, b, c) __builtin_fmaxf(__builtin_fmaxf((a), (b)), (c))
#define GAPA(MF, A0, A1, A2, A3, W0, W1, PW) do { MF; sacc += A0; sacc += A1; sacc += A2; sacc += A3; PIN(sacc); W0; W1; PIN(PW); SBAR(); } while (0)
#define EX(v) __builtin_amdgcn_exp2f(v)
#define GAPB(MF, X, B) do { MF; X[B] = EX(X[B]); X[B + 1] = EX(X[B + 1]); X[B + 2] = EX(X[B + 2]); X[B + 3] = EX(X[B + 3]); PIN(X); SBAR(); } while (0)
#define VRD(i) do { vlo[i] = vtr(vp_ + (((i) >> 2) * 4096 + ((i) & 3) * 1024)); vhi[i] = vtr(vp_ + (((i) >> 2) * 4096 + ((i) & 3) * 1024 + 512)); } while (0)
#define KRD(G, j) do { if (G) { kload2(kf, kp0 + sl_next, j); SBAR(); } } while (0)
#define STEP(C0, C1, P0, P1, t, GK, GV, GL) do { SBAR(); \
    cinit(C0, C1, Flp + 64 * (t), aq); SBAR(); \
    const lds_cptr vp_ = vp0 + sl_prev; \
    VRD(0); SBAR(); float sacc = (P0[0] + P0[1]); \
    GAPA(C0 = __builtin_amdgcn_mfma_f32_32x32x16_bf16(kf[0], qr[0], C0, 0, 0, 0), P0[2], P0[3], P0[4], P0[5],     pw0[0] = PKW(P0, 0), pw0[1] = PKW(P0, 2), pw0); \
    VRD(4); SBAR(); GAPA(C1 = __builtin_amdgcn_mfma_f32_32x32x16_bf16(kf[1], qr[0], C1, 0, 0, 0), P0[6], P0[7], P0[8], P0[9],     pw0[2] = PKW(P0, 4), pw0[3] = PKW(P0, 6), pw0); \
    VRD(1); SBAR(); GAPA(C0 = __builtin_amdgcn_mfma_f32_32x32x16_bf16(kf[2], qr[1], C0, 0, 0, 0),   P0[10], P0[11], P0[12], P0[13], pw1[0] = PKW(P0, 8), pw1[1] = PKW(P0, 10), pw1); \
    VRD(5); SBAR(); GAPA(C1 = __builtin_amdgcn_mfma_f32_32x32x16_bf16(kf[3], qr[1], C1, 0, 0, 0),   P0[14], P0[15], P1[0], P1[1],   pw1[2] = PKW(P0, 12), pw1[3] = PKW(P0, 14), pw1); \
    VRD(2); SBAR(); GAPA(C0 = __builtin_amdgcn_mfma_f32_32x32x16_bf16(kf[4], qr[2], C0, 0, 0, 0),   P1[2], P1[3], P1[4], P1[5],     pw2[0] = PKW(P1, 0), pw2[1] = PKW(P1, 2), pw2); \
    VRD(6); SBAR(); GAPA(C1 = __builtin_amdgcn_mfma_f32_32x32x16_bf16(kf[5], qr[2], C1, 0, 0, 0),   P1[6], P1[7], P1[8], P1[9],     pw2[2] = PKW(P1, 4), pw2[3] = PKW(P1, 6), pw2); \
    VRD(3); SBAR(); GAPA(C0 = __builtin_amdgcn_mfma_f32_32x32x16_bf16(kf[6], qr[3], C0, 0, 0, 0),   P1[10], P1[11], P1[12], P1[13], pw3[0] = PKW(P1, 8), pw3[1] = PKW(P1, 10), pw3); \
    VRD(7); SBAR(); GAPA(C1 = __builtin_amdgcn_mfma_f32_32x32x16_bf16(kf[7], qr[3], C1, 0, 0, 0),   P1[14], P1[15], 0.f, 0.f,       pw3[2] = PKW(P1, 12), pw3[3] = PKW(P1, 14), pw3); \
    l_reg += sacc; \
    if (GK) { DMA_K((t) + 3, sl_cur); } if (GV) { DMA_V((t) + 1, sl_next); } \
    CMASK(C0, C1, t); \
    { float a = MX3(C0[0], C0[1], C1[0]), b_ = MX3(C0[2], C0[3], C1[1]); a = MX3(a, C1[2], C1[3]); \
      _Pragma("unroll") for (int r = 4; r < 16; r += 4) { a = MX3(a, C0[r], C0[r + 1]); b_ = MX3(b_, C0[r + 2], C0[r + 3]); a = MX3(a, C1[r], C1[r + 1]); b_ = MX3(b_, C1[r + 2], C1[r + 3]); } \
      float rm = __builtin_fmaxf(a, b_); { auto rr = __builtin_amdgcn_permlane32_swap(__float_as_uint(rm), __float_as_uint(rm), false, false); rm = __builtin_fmaxf(__uint_as_float(rr[0]), __uint_as_float(rr[1])); } \
      resc = false; \
      if (__builtin_expect(__any(rm > (float)THRL), 0)) { const float dl = __builtin_fmaxf(rm, 0.f); aq -= dl; \
        _Pragma("unroll") for (int r = 0; r < 16; ++r) { C0[r] -= dl; C1[r] -= dl; } \
        const float f = __builtin_amdgcn_exp2f(-dl); l_reg *= f; if (hi == 0) wsf[r32] = f; resc = true; } } \
    SBAR(); \
    GAPB(o[0] = __builtin_amdgcn_mfma_f32_32x32x16_bf16(PAF(0), VFR(0), o[0], 0, 0, 0), C0, 0); \
    GAPB(o[1] = __builtin_amdgcn_mfma_f32_32x32x16_bf16(PAF(0), VFR(4), o[1], 0, 0, 0), C0, 4); \
    KRD(GL, 0); GAPB(o[0] = __builtin_amdgcn_mfma_f32_32x32x16_bf16(PAF(1), VFR(1), o[0], 0, 0, 0), C0, 8); \
    KRD(GL, 1); GAPB(o[1] = __builtin_amdgcn_mfma_f32_32x32x16_bf16(PAF(1), VFR(5), o[1], 0, 0, 0), C0, 12); \
    KRD(GL, 2); GAPB(o[0] = __builtin_amdgcn_mfma_f32_32x32x16_bf16(PAF(2), VFR(2), o[0], 0, 0, 0), C1, 0); \
    KRD(GL, 3); GAPB(o[1] = __builtin_amdgcn_mfma_f32_32x32x16_bf16(PAF(2), VFR(6), o[1], 0, 0, 0), C1, 4); \
    GAPB(o[0] = __builtin_amdgcn_mfma_f32_32x32x16_bf16(PAF(3), VFR(3), o[0], 0, 0, 0), C1, 8); \
    GAPB(o[1] = __builtin_amdgcn_mfma_f32_32x32x16_bf16(PAF(3), VFR(7), o[1], 0, 0, 0), C1, 12); \
    } while (0)
    int t = 1;
#undef CMASK
#define CMASK(P0, P1, t) do { } while (0)
    for (; t + 5 < NT; t += 2) {
        STEP(pB0, pB1, pA0, pA1, t, true, true, true);     WAIT_BAR(2); RESC(); ROT();
        STEP(pA0, pA1, pB0, pB1, t + 1, true, true, true); WAIT_BAR(2); RESC(); ROT();
    }
#undef CMASK
#define CMASK(P0, P1, t) do { int jb_ = (t) - (NT - 4); if (jb_ >= 0) cmask(P0, P1, jb_, qrel, hi); } while (0)
#define ENDW(tt) do { if ((tt) + 3 < NT) { WAIT_BAR(2); } else if ((tt) + 2 < NT) { WAIT_BAR(1); } else { WAIT_BAR(0); } } while (0)
    for (; t + 1 < NT; t += 2) {
        STEP(pB0, pB1, pA0, pA1, t, (t + 3 < NT), (t + 1 < NT), (t + 1 < NT));         ENDW(t);     RESC(); ROT();
        STEP(pA0, pA1, pB0, pB1, t + 1, (t + 4 < NT), (t + 2 < NT), (t + 2 < NT));     ENDW(t + 1); RESC(); ROT();
    }
    { float sacc = pA0[0] + pA0[1]; _Pragma("unroll") for (int r = 2; r < 16; ++r) sacc += pA0[r]; _Pragma("unroll") for (int r = 0; r < 16; ++r) sacc += pA1[r]; l_reg += sacc;
      pw0 = (u32x4){PKW(pA0, 0), PKW(pA0, 2), PKW(pA0, 4), PKW(pA0, 6)}; pw1 = (u32x4){PKW(pA0, 8), PKW(pA0, 10), PKW(pA0, 12), PKW(pA0, 14)}; pw2 = (u32x4){PKW(pA1, 0), PKW(pA1, 2), PKW(pA1, 4), PKW(pA1, 6)}; pw3 = (u32x4){PKW(pA1, 8), PKW(pA1, 10), PKW(pA1, 12), PKW(pA1, 14)};
      SBAR(); pv(o, vb0 + sl_prev, PAF(0), PAF(1), PAF(2), PAF(3)); }
#undef PKW
#undef PAF
#undef VFR
#undef PIN
#undef MX3
#undef GAPA
#undef GAPB
#undef EX
#undef VRD
#undef KRD
#undef STEP
#undef ENDW
    { auto rr = __builtin_amdgcn_permlane32_swap(__float_as_uint(l_reg), __float_as_uint(l_reg), false, false); l_reg = __uint_as_float(rr[0]) + __uint_as_float(rr[1]); }
    if (hi == 0) wsf[32 + r32] = l_reg; asm volatile("s_waitcnt lgkmcnt(0)" ::: "memory");
    float rli[16];
#pragma unroll
    for (int r = 0; r < 16; ++r) rli[r] = __builtin_amdgcn_rcpf(wsf[32 + crow(r, hi)]);
    bf16* Ow = O + (rowbase + q0 + wid * QBLK) * DMA + h * 64;
    { bf16* stg = (bf16*)(shm + LDS_OST) + wid * 2048;
#pragma unroll
      for (int r = 0; r < 16; ++r) { const int orow = crow(r, hi);
#pragma unroll
          for (int d0 = 0; d0 < 2; ++d0) stg[orow * 64 + d0 * 32 + r32] = (bf16)f2bf(o[d0][r] * rli[r]); }
      asm volatile("s_waitcnt lgkmcnt(0)" ::: "memory");
#pragma unroll
      for (int i = 0; i < 4; ++i) { const int row = i * 8 + (lane >> 3), ch = lane & 7; const u32x4 v = *(const u32x4*)(stg + row * 64 + ch * 8); *(u32x4*)(Ow + (long)row * DMA + ch * 8) = v; } }
    asm volatile("s_waitcnt lgkmcnt(0)\n\ts_barrier" ::: "memory");
#undef DMA_K
#undef DMA_V
#undef CMASK
#undef START
#undef RESC
#undef ROT
}
#undef SBAR
#undef WAIT_BAR
}
__device__ __forceinline__ void phase_B(Frame& F) {
    if (F.G == 256) {
        const int v = F.vcu, bh = v >> 3, s = v & 7, b = bh >> 3, h = bh & 7;
        attn_scan(F, b, h, false, fa::LDS_FL, fa::LDS_SCAN);
        { unsigned char* dol = DOP(); const bf16* Q = (const bf16*)(dol + DO_Q); const bf16* Kg = (const bf16*)(dol + DO_K); const bf16* Vg = (const bf16*)(dol + DO_V);
#pragma unroll 1
          for (int i = 0; i < 4; ++i) { const int qb = i == 0 ? s : (i == 1 ? 15 - s : (i == 2 ? 16 + s : 31 - s));
              fa::attn_unit<8>(b, h, qb, Q, Kg, Vg, (bf16*)(dol + DO_Q), (char*)F.lds, F.wave); } }
        if (v < 8) { attn_scan(F, 0, v, true, AT_FL, AT_SC); attn_unit_naive(F, TX, 0, 1, 0, v); }
    } else {
        int cur_bh = -1;
        for (int u = F.vcu; u < 1032; u += F.G) {
            if (u < 1024) { const int bh = u >> 5, qb = u & 31, b = bh >> 3, h = bh & 7; if (bh != cur_bh) { attn_scan(F, b, h, false, AT_FL, AT_SC); cur_bh = bh; }
                attn_unit_naive(F, b * SEQ + 256 * qb, NMETA + 256 * qb, 1 + 4 * (qb + 1), b * SEQ, h); }
            else { attn_scan(F, 0, u - 1024, true, AT_FL, AT_SC); cur_bh = -1; attn_unit_naive(F, TX, 0, 1, 0, u - 1024); }
        }
    }
    __syncthreads();
}

__device__ __forceinline__ void class_tables(Frame& F, int l) {
    LAS int* base = (LAS int*)(F.lds + LC_BASE); LAS int* pcls = (LAS int*)(F.lds + LC_PCLS); LAS int* np = (LAS int*)(F.lds + LC_NP);
    const unsigned* gcnt = (const unsigned*)(WSP() + WS_CTL) + CW_GCNT + l * 64;
    __syncthreads();
    if (F.tid == 0) { int p = 0;
#pragma unroll 1
        for (int c = 0; c < NCLS; ++c) { base[c] = p * 256; int n = (int)__hip_atomic_load(gcnt + c, __ATOMIC_RELAXED, __HIP_MEMORY_SCOPE_AGENT); if (n > TM) n = TM; if (n < 0) n = 0; p += (n + 255) >> 8; }
        if (p > 160) p = 160; base[NCLS] = p * 256; np[0] = p; }
    __syncthreads();
    if (F.tid < 160) { const int mypos = F.tid * 256; int c = 0;
#pragma unroll 1
        for (int k = 1; k < NCLS; ++k) if (base[k] <= mypos) c = k;
        pcls[F.tid] = c; }
    __syncthreads();
}
__device__ __forceinline__ void phase_E1(Frame& F, int l) {
    LAS float* R = (LAS float*)F.lds;
    LAS int* rec = (LAS int*)(F.lds + 81920);
    LAS int* lcnt = (LAS int*)(F.lds + LC_CNT); LAS int* wgb = (LAS int*)(F.lds + LC_BASE);
    const float* rg = (const float*)(WSP() + WS_RG); const float* H = (const float*)(WSP() + WS_H);
    const float* reb = INP(I_REB) + l * 16; const float* rgb = INP(I_RGB) + l * 4;
    unsigned* gcnt = (unsigned*)(WSP() + WS_CTL) + CW_GCNT + l * 64; int* route = (int*)(WSP() + WS_ROUTE);
    const int tid = F.tid, lane = F.lane, wave = F.wave;
    for (int i = tid; i < 5120; i += 512) *(LAS f32x4*)(R + 4 * i) = *(const f32x4*)(rg + 4 * i);
    for (int wg = F.vcu; wg < 256; wg += F.G) {
        if (tid < NCLS) lcnt[tid] = 0;
        __syncthreads();

#pragma unroll 1
for (int rr = wave; rr < 129; rr += 8) { const int row = wg * 129 + rr;
            f32x4 hv[4]; float ss = 0.f;
#pragma unroll
            for (int j = 0; j < 4; ++j) { hv[j] = *(const f32x4*)(H + (size_t)row * D + 4 * lane + 256 * j); ss += hv[j][0] * hv[j][0] + hv[j][1] * hv[j][1] + hv[j][2] * hv[j][2] + hv[j][3] * hv[j][3]; }
            const float rstd2 = rsqrtf(wave_sum(ss) * (1.0f / D) + EPS);
            float lg[20];
#pragma unroll
            for (int c = 0; c < 20; ++c) { float s = 0.f;
#pragma unroll
                for (int j = 0; j < 4; ++j) { const f32x4 w = *(const LAS f32x4*)(R + c * 1024 + 4 * lane + 256 * j); s += hv[j][0] * w[0] + hv[j][1] * w[1] + hv[j][2] * w[2] + hv[j][3] * w[3]; }
                lg[c] = wave_sum(s) * rstd2 + (c < 16 ? reb[c] : rgb[c - 16]); }
            int gsel = 0; float gmax = lg[16];
#pragma unroll
            for (int g = 1; g < 4; ++g) if (lg[16 + g] > gmax) { gmax = lg[16 + g]; gsel = g; }
            float gsum = 0.f;
#pragma unroll
            for (int g = 0; g < 4; ++g) gsum += __expf(lg[16 + g] - gmax);
            const float gwt = 1.0f / gsum;
            float el[4];
#pragma unroll
            for (int e = 0; e < 4; ++e) el[e] = gsel == 0 ? lg[e] : (gsel == 1 ? lg[4 + e] : (gsel == 2 ? lg[8 + e] : lg[12 + e]));
            int t1 = 0; float l1 = el[0];
#pragma unroll
            for (int e = 1; e < 4; ++e) if (el[e] > l1) { l1 = el[e]; t1 = e; }
            int t2 = -1; float l2 = -3.0e38f;
#pragma unroll
            for (int e = 0; e < 4; ++e) if (e != t1 && el[e] > l2) { l2 = el[e]; t2 = e; }
            const float w1 = 1.0f / (1.0f + __expf(l2 - l1)), w2 = 1.0f - w1;
            const int ea = min(t1, t2), eb = max(t1, t2); const float cA = gwt * (t1 == ea ? w1 : w2), cB = gwt * (t1 == ea ? w2 : w1);
            const int pr = ea == 0 ? eb - 1 : (ea == 1 ? eb + 1 : 5); int cls = gsel * 6 + pr; if (!(cls >= 0 && cls < NCLS)) cls = 0;
            if (lane == 0) { const int rank = __hip_atomic_fetch_add(&lcnt[cls], 1, __ATOMIC_RELAXED, __HIP_MEMORY_SCOPE_WORKGROUP); rec[rr * 5] = cls; rec[rr * 5 + 1] = rank; rec[rr * 5 + 2] = __float_as_int(cA); rec[rr * 5 + 3] = __float_as_int(cB); rec[rr * 5 + 4] = __float_as_int(rstd2); }
        }
        __syncthreads();
        if (tid < NCLS) { const int n = lcnt[tid]; wgb[tid] = n > 0 ? (int)atomicAdd(gcnt + tid, (unsigned)n) : 0; }
        __syncthreads();
        for (int rr = tid; rr < 129; rr += 512) { const int row = wg * 129 + rr; const int cls = rec[rr * 5];
            int* rp = route + (size_t)row * 8; rp[0] = cls; rp[1] = wgb[cls] + rec[rr * 5 + 1]; rp[2] = rec[rr * 5 + 2]; rp[3] = rec[rr * 5 + 3]; rp[4] = rec[rr * 5 + 4]; }
        __syncthreads();
    }
}
__device__ __forceinline__ void phase_E1b(Frame& F, int l) {
    class_tables(F, l);
    const LAS int* base = (const LAS int*)(F.lds + LC_BASE);
    const int* route = (const int*)(WSP() + WS_ROUTE); const bf16* HB = (const bf16*)(WSP() + WS_HB); bf16* XS = (bf16*)(WSP() + WS_XS); float* PW = (float*)(WSP() + WS_PW);
    const int gw = F.vcu * NWAVES + F.wave, NGW = F.G * NWAVES, lane = F.lane;

#pragma unroll 1
for (int row = gw; row < TM; row += NGW) { const int* rp = route + (size_t)row * 8; const int cls = rp[0]; const int pos = base[cls] + rp[1];
        if (pos < 0 || pos >= NPOSMAX) continue;
#pragma unroll
        for (int j = 0; j < 2; ++j) *(u32x4*)(XS + (size_t)pos * D + 8 * lane + 512 * j) = *(const u32x4*)(HB + (size_t)row * D + 8 * lane + 512 * j);
        if (lane == 0) { f32x4 w; w[0] = __int_as_float(rp[4]); w[1] = __int_as_float(rp[2]); w[2] = __int_as_float(rp[3]); w[3] = 0.f; *(f32x4*)(PW + (size_t)pos * 4) = w; } }
}
__device__ __forceinline__ void phase_E4(Frame& F, int l) {
    class_tables(F, l);
    const LAS int* base = (const LAS int*)(F.lds + LC_BASE);
    const int* route = (const int*)(WSP() + WS_ROUTE); float* H = (float*)(WSP() + WS_H); bf16* HB = (bf16*)(WSP() + WS_HB); const bf16* Y = (const bf16*)(WSP() + WS_Y);
    float* rstd1 = (float*)(WSP() + WS_RSTD1); const float* fg = INP(I_FG); float* out = (float*)DOP();
    const int gw = F.vcu * NWAVES + F.wave, NGW = F.G * NWAVES, lane = F.lane; const bool lastl = (l == DEPTH - 1);

#pragma unroll 1
for (int row = gw; row < TM; row += NGW) { const int* rp = route + (size_t)row * 8; const int cls = rp[0]; int pos = base[cls] + rp[1]; if (pos < 0 || pos >= NPOSMAX) pos = 0;
        f32x4 hv[2][2]; float ss = 0.f;
#pragma unroll
        for (int j = 0; j < 2; ++j) { const u32x4 yw = *(const u32x4*)(Y + (size_t)pos * D + 8 * lane + 512 * j);
            hv[j][0] = *(const f32x4*)(H + (size_t)row * D + 8 * lane + 512 * j); hv[j][1] = *(const f32x4*)(H + (size_t)row * D + 8 * lane + 512 * j + 4);
            hv[j][0][0] += bflo(yw.x); hv[j][0][1] += bfhi(yw.x); hv[j][0][2] += bflo(yw.y); hv[j][0][3] += bfhi(yw.y);
            hv[j][1][0] += bflo(yw.z); hv[j][1][1] += bfhi(yw.z); hv[j][1][2] += bflo(yw.w); hv[j][1][3] += bfhi(yw.w);
#pragma unroll
            for (int q = 0; q < 2; ++q) ss += hv[j][q][0] * hv[j][q][0] + hv[j][q][1] * hv[j][q][1] + hv[j][q][2] * hv[j][q][2] + hv[j][q][3] * hv[j][q][3]; }
        const float rs = rsqrtf(wave_sum(ss) * (1.0f / D) + EPS);
        if (!lastl) {
#pragma unroll
            for (int j = 0; j < 2; ++j) { *(f32x4*)(H + (size_t)row * D + 8 * lane + 512 * j) = hv[j][0]; *(f32x4*)(H + (size_t)row * D + 8 * lane + 512 * j + 4) = hv[j][1];
                *(u32x4*)(HB + (size_t)row * D + 8 * lane + 512 * j) = pack8(hv[j][0], hv[j][1]); }
            if (lane == 0) rstd1[row] = rs;
        } else if (row < TX) {
#pragma unroll
            for (int j = 0; j < 2; ++j) { const f32x4 g0 = *(const f32x4*)(fg + 8 * lane + 512 * j), g1 = *(const f32x4*)(fg + 8 * lane + 512 * j + 4);
                *(f32x4*)(out + (size_t)row * D + 8 * lane + 512 * j) = hv[j][0] * rs * g0; *(f32x4*)(out + (size_t)row * D + 8 * lane + 512 * j + 4) = hv[j][1] * rs * g1; }
        }
    }
}

#define RELANE() do { const int t_ = wv0 * 64 + lane_id_opaque(); F.tid = t_; F.lane = t_ & 63; F.wave = __builtin_amdgcn_readfirstlane(t_ >> 6); \
    int g_ = gridDim.x; LAUNDER_S(g_); int b_ = blockIdx.x; LAUNDER_S(b_); F.G = g_; F.bx = b_; F.vcu = (g_ % 8 == 0) ? (b_ % 8) * (g_ / 8) + b_ / 8 : b_; ll = l; LAUNDER_S(ll); } while (0)
__global__ void __launch_bounds__(NWAVES * 64, 2) fwd_kernel(Params P) {
    extern __shared__ __attribute__((aligned(16))) unsigned char lds_raw[];
    Frame F;
    F.lds = (LAS unsigned char*)lds_raw;
    F.tid = threadIdx.x; F.lane = F.tid & 63; F.wave = __builtin_amdgcn_readfirstlane(F.tid >> 6);
    F.G = gridDim.x; { const int bx = blockIdx.x; F.vcu = (F.G % 8 == 0) ? (bx % 8) * (F.G / 8) + bx / 8 : bx; }
    if (F.tid == 0) { LAS unsigned long long* pt = (LAS unsigned long long*)(F.lds + LC_PTAB);
#pragma unroll
        for (int i = 0; i < 25; ++i) pt[i] = (unsigned long long)P.in[i];
        pt[25] = (unsigned long long)P.ws; pt[26] = (unsigned long long)P.out; }
    for (int u = F.tid; u < 256; u += NWAVES * 64) ((LAS unsigned*)(F.lds + RING_BYTES))[u] = 0u;
    __syncthreads();
    const int lo = P.ph_lo, hi = P.ph_hi;
    const bool use_bar = (hi - lo) > 1;
    unsigned* barw = (unsigned*)(P.ws + WS_CTL) + CW_BAR;
    XcdBarrier bar; bar.bar = barw; bar.x = 0; bar.st = (volatile LAS unsigned*)(F.lds + LC_BAR);
    if (use_bar) bar = xcd_barrier_post(barw, (volatile LAS unsigned*)(F.lds + LC_BAR));
#ifndef PHASE_MASK
#define PHASE_MASK 0x7ff
#endif
#define EN(j) (((PHASE_MASK) >> (j)) & 1)
#define IN(k) (lo <= (k) && (k) < hi)
#define SEAM(k) do { if (IN(k) && IN((k) + 1)) xcd_barrier(bar); } while (0)

    int l = 0, ll = 0; const int wv0 = __builtin_amdgcn_readfirstlane((int)threadIdx.x >> 6);
    if (EN(0) && IN(0)) { RELANE(); convert_weights(F, 0); RELANE(); init_rows(F); }
    SEAM(0);
    for (l = 0; l < DEPTH; ++l) {
        const int pb = 1 + 10 * l;
        if (EN(1) && IN(pb + 0)) {
            RELANE();
            unsigned char* wsl = WSP(); unsigned char* dol = DOP();
            pg8::Gemm g{(const bf16*)(wsl + WS_HB), 1024, 1024, 1 << 20};
            pg8::StaticOrder S; S.init(TM, N1, F.G, F.bx, (const bf16*)(wsl + WS_W1T), 1024);
            Epi1 E{(const float*)(wsl + WS_RSTD1), (bf16*)(wsl + WS_A), (bf16*)(wsl + WS_GLU), (bf16*)(dol + DO_Q), (bf16*)(wsl + WS_G)};
            pg8::gemm_phase<Epi1, pg8::StaticOrder>(F.lds, g, S, E, F.wave);
        }
        SEAM(pb + 0);
        if (EN(2) && IN(pb + 1)) { RELANE(); phase_S(F, ll); }
        SEAM(pb + 1);
        if (EN(3) && IN(pb + 2)) { RELANE(); phase_B(F); }
        SEAM(pb + 2);
        if (EN(4) && IN(pb + 3)) {
            { RELANE(); unsigned char* wsl = WSP(); unsigned char* dol = DOP();
              pg8::Gemm g{(const bf16*)(wsl + WS_DIFF), 256, 256, 1 << 20}; pg8::StaticOrder S; S.init(TM, 1024, F.G, F.bx, (const bf16*)(wsl + WS_WAT), 256);
              EpiC<0> E{(const bf16*)(wsl + WS_G), (bf16*)(dol + DO_MERGED), (const float*)(wsl + WS_BIASA)}; pg8::gemm_phase<EpiC<0>, pg8::StaticOrder>(F.lds, g, S, E, F.wave); }
            { RELANE(); unsigned char* wsl = WSP(); unsigned char* dol = DOP();
              pg8::Gemm g{(const bf16*)(wsl + WS_BP), 256, 256, 1 << 20}; pg8::StaticOrder S; S.init(TM, 1024, F.G, F.bx, (const bf16*)(wsl + WS_WBT), 256);
              EpiC<1> E{(const bf16*)(wsl + WS_G), (bf16*)(dol + DO_MERGED), nullptr}; pg8::gemm_phase<EpiC<1>, pg8::StaticOrder>(F.lds, g, S, E, F.wave); }
            { RELANE(); unsigned char* wsl = WSP(); unsigned char* dol = DOP();
              pg8::Gemm g{(const bf16*)(dol + DO_Q), 512, 512, 1 << 20}; pg8::StaticOrder S; S.init(TM, 1024, F.G, F.bx, (const bf16*)(wsl + WS_WCT), 512);
              EpiC<2> E{(const bf16*)(wsl + WS_G), (bf16*)(dol + DO_MERGED), nullptr}; pg8::gemm_phase<EpiC<2>, pg8::StaticOrder>(F.lds, g, S, E, F.wave); }
        }
        SEAM(pb + 3);
        if (EN(5) && IN(pb + 4)) {
            RELANE();
            unsigned char* wsl = WSP(); unsigned char* dol = DOP();
            pg8::Gemm g{(const bf16*)(dol + DO_MERGED), 1024, 1024, 1 << 20}; pg8::StaticOrder S; S.init(TM, 1024, F.G, F.bx, (const bf16*)(wsl + WS_WOT), 1024);
            EpiD E{(float*)(wsl + WS_H), (bf16*)(wsl + WS_HB)}; pg8::gemm_phase<EpiD, pg8::StaticOrder>(F.lds, g, S, E, F.wave);
        }
        SEAM(pb + 4);
        if (EN(6) && IN(pb + 5)) { RELANE(); phase_E1(F, ll); }
        SEAM(pb + 5);
        if (EN(7) && IN(pb + 6)) { RELANE(); phase_E1b(F, ll); }
        SEAM(pb + 6);
        if (EN(8) && IN(pb + 7)) {
            RELANE(); class_tables(F, ll);
            unsigned char* wsl = WSP();
            const int NP = __builtin_amdgcn_readfirstlane(*(const LAS int*)(F.lds + LC_NP));
            pg8::Gemm g{(const bf16*)(wsl + WS_XS), 1024, 1024, 1 << 20};
            MoeOrder S{NP, F.G, F.vcu, 0, (const LAS int*)(F.lds + LC_PCLS), (const bf16*)(wsl + WS_W13T)};
            EpiA2 E{(const float*)(wsl + WS_PW), (bf16*)(wsl + WS_HH)}; pg8::gemm_phase<EpiA2, MoeOrder>(F.lds, g, S, E, F.wave);
        }
        SEAM(pb + 7);
        if (EN(9) && IN(pb + 8)) {
            RELANE(); class_tables(F, ll);
            unsigned char* wsl = WSP();
            const int NP = __builtin_amdgcn_readfirstlane(*(const LAS int*)(F.lds + LC_NP));
            pg8::Gemm g{(const bf16*)(wsl + WS_HH), 512, 256, 4};
            MoeOrder S{NP, F.G, F.vcu, 1, (const LAS int*)(F.lds + LC_PCLS), (const bf16*)(wsl + WS_W2T)};
            EpiB2 E{(bf16*)(wsl + WS_Y)}; pg8::gemm_phase<EpiB2, MoeOrder>(F.lds, g, S, E, F.wave);
        }
        SEAM(pb + 8);
        if (EN(10) && IN(pb + 9)) { RELANE(); phase_E4(F, ll); if (l + 1 < DEPTH) { RELANE(); convert_weights(F, ll + 1); } }
        SEAM(pb + 9);
    }
#undef IN
#undef SEAM
}

constexpr int N_PHASES = 1 + 10 * DEPTH;

extern "C" void kernel_launch(void* const* d_in, const int* in_sizes, int n_in, void* d_out, int out_size, void* d_ws, size_t ws_size, hipStream_t stream) {
    static int grid = 0;
    if (grid == 0) {
        if (n_in != 25 || out_size != TX * D || ws_size < WS_END) { fprintf(stderr, "kernel_launch: unexpected shapes: n_in %d out %d ws %zu (need %zu)\n", n_in, out_size, ws_size, (size_t)WS_END); grid = -1; return; }
        int dev = 0, cus = 0, per_cu = 0;
        if (hipGetDevice(&dev) != hipSuccess || hipDeviceGetAttribute(&cus, hipDeviceAttributeMultiprocessorCount, dev) != hipSuccess) { grid = -1; return; }
        if (hipFuncSetAttribute((const void*)fwd_kernel, hipFuncAttributeMaxDynamicSharedMemorySize, LDS_BYTES) != hipSuccess) { fprintf(stderr, "kernel_launch: hipFuncSetAttribute failed\n"); grid = -1; return; }
        if (hipOccupancyMaxActiveBlocksPerMultiprocessor(&per_cu, (const void*)fwd_kernel, NWAVES * 64, LDS_BYTES) != hipSuccess || per_cu < 1) fprintf(stderr, "kernel_launch: occupancy query reports %d\n", per_cu);
        (void)hipGetLastError();
        grid = cus;
    }
    if (grid < 0) return;
    (void)hipMemsetAsync((char*)d_ws + WS_CTL, 0, CTL_BYTES, stream);
    Params p{};
    for (int i = 0; i < 25; ++i) p.in[i] = (const float*)d_in[i];
    p.out = (float*)d_out; p.ws = (unsigned char*)d_ws;
#if N_LAUNCH_MODE == 1
    p.ph_lo = 0; p.ph_hi = N_PHASES;
    hipLaunchKernelGGL(fwd_kernel, dim3(grid), dim3(NWAVES * 64), LDS_BYTES, stream, p);
#else
    for (int ph = 0; ph < N_PHASES; ++ph) { p.ph_lo = ph; p.ph_hi = ph + 1; hipLaunchKernelGGL(fwd_kernel, dim3(grid), dim3(NWAVES * 64), LDS_BYTES, stream, p); }
#endif
}
```

```cpp
#include <hip/hip_runtime.h>
#include <cstdio>
#include <cstdint>

#ifndef N_LAUNCH_MODE
#define N_LAUNCH_MODE 1
#endif

#define GAS __attribute__((address_space(1)))
#define LAS __attribute__((address_space(3)))
typedef unsigned short bf16;
typedef float f32x4 __attribute__((ext_vector_type(4)));
typedef float f32x2 __attribute__((ext_vector_type(2)));
typedef unsigned u32x4 __attribute__((ext_vector_type(4)));
typedef unsigned u32x2 __attribute__((ext_vector_type(2)));
typedef short bf16x8 __attribute__((ext_vector_type(8)));
typedef __bf16 bf16x2v __attribute__((ext_vector_type(2)));

constexpr int D = 1024, NB = 4, SEQ = 8192, NMETA = 16, DEPTH = 2;
constexpr int TX = NB * SEQ;
constexpr int TM = TX + 256;
constexpr int NIN = 5384, N1 = 5376;
constexpr int NHEAD = 8;
constexpr int NCLS = 24;
constexpr int NPOSMAX = TM + NCLS * 256;
constexpr float EPS = 1e-6f;
constexpr float LOG2E = 1.4426950408889634f;
constexpr float C2 = 0.125f * LOG2E;
constexpr int NWAVES = 8;

constexpr size_t U = (size_t)TM * 1024 * 2;
constexpr size_t WS_CTL = 0, CTL_BYTES = 1u << 20;
constexpr size_t WS_H = CTL_BYTES;
constexpr size_t WS_HB = WS_H + 2 * U;
constexpr size_t WS_G = WS_HB + U;
constexpr size_t WS_XS = WS_G;
constexpr size_t WS_Y = WS_XS + (size_t)NPOSMAX * 2048;
constexpr size_t WS_HH = WS_Y + (size_t)NPOSMAX * 2048;
static_assert(WS_HH + (size_t)NPOSMAX * 1024 <= WS_G + 3 * U, "MoE overlay fits the gates region");
constexpr size_t WS_A = WS_G + 3 * U;
constexpr size_t WS_GLU = WS_A + U / 4;
constexpr size_t WS_X3 = WS_GLU + U / 4;
constexpr size_t WS_W1T = WS_X3 + U;
constexpr size_t WS_W3CT = WS_W1T + (size_t)N1 * 1024 * 2;
constexpr size_t WS_WOT = WS_W3CT + 1024 * 1024 * 2;
constexpr size_t WS_WFG = WS_WOT + 1024 * 1024 * 2;
constexpr size_t WS_RG = WS_WFG + 8 * 1024 * 4;
constexpr size_t WS_BIASA = WS_RG + 20 * 1024 * 4;
constexpr size_t WS_RSTD1 = WS_BIASA + 4096;
constexpr size_t WS_ROUTE = WS_RSTD1 + (size_t)TM * 4;
constexpr size_t WS_PW = WS_ROUTE + (size_t)TM * 32;
constexpr size_t WS_LFT = WS_PW + (size_t)NPOSMAX * 16;
constexpr size_t WS_LFTM = WS_LFT + (size_t)32 * 8192 * 4;
constexpr size_t WS_END = WS_LFTM + 8 * 256 * 4;
static_assert(WS_END <= (size_t)512 * 1024 * 1024, "d_ws map fits 512 MiB");
constexpr size_t DO_Q = 0, DO_K = U / 2, DO_V = U, DO_MERGED = U / 2;
constexpr size_t DO_W13T = 3 * U / 2;
constexpr size_t DO_W2T = DO_W13T + (size_t)16 * 512 * 1024 * 2;
static_assert(DO_W2T + (size_t)16 * 1024 * 256 * 2 <= (size_t)TX * 1024 * 4, "d_out scratch");
constexpr int CW_BAR = 4096, CW_GCNT = 16384;

constexpr int RING_BYTES = 131072;
constexpr int LC_BAR = RING_BYTES, LC_CNT = RING_BYTES + 64, LC_BASE = RING_BYTES + 192, LC_PCLS = RING_BYTES + 320, LC_NP = RING_BYTES + 960;
constexpr int LC_PTAB = RING_BYTES + 1024;
constexpr int LDS_BYTES = RING_BYTES + 1024 + 7168;

#define LDS_WAIT() asm volatile("s_waitcnt lgkmcnt(0)" ::: "memory")
#define VM_WAIT() asm volatile("s_waitcnt vmcnt(0)" ::: "memory")
#define LAUNDER_S(p) asm volatile("" : "+s"(p))
#define LAUNDER_V(x) asm volatile("" : "+v"(x))
__device__ __forceinline__ int lane_id_opaque() { int x; asm volatile("v_mbcnt_lo_u32_b32 %0, -1, 0\n\tv_mbcnt_hi_u32_b32 %0, -1, %0" : "=v"(x)); return x; }

__device__ __forceinline__ unsigned f2bf(float f) { unsigned u = __builtin_bit_cast(unsigned, f); return (u + 0x7fffu + ((u >> 16) & 1u)) >> 16; }
__device__ __forceinline__ unsigned pk2(float lo, float hi) { f32x2 v = {lo, hi}; bf16x2v b = __builtin_convertvector(v, bf16x2v); return __builtin_bit_cast(unsigned, b); }
__device__ __forceinline__ float bflo(unsigned w) { return __builtin_bit_cast(float, w << 16); }
__device__ __forceinline__ float bfhi(unsigned w) { return __builtin_bit_cast(float, w & 0xffff0000u); }
template <int O> __device__ __forceinline__ float lane_xor(float v) {
    if constexpr (O < 32) return __int_as_float(__builtin_amdgcn_ds_swizzle(__float_as_int(v), (O << 10) | 0x1f));
    else { auto rr = __builtin_amdgcn_permlane32_swap(__float_as_uint(v), __float_as_uint(v), false, false); return __uint_as_float(rr[0]) + __uint_as_float(rr[1]) - v; }
}
__device__ __forceinline__ float wave_sum(float v) {
    v += lane_xor<1>(v); v += lane_xor<2>(v); v += lane_xor<4>(v); v += lane_xor<8>(v); v += lane_xor<16>(v);
    auto rr = __builtin_amdgcn_permlane32_swap(__float_as_uint(v), __float_as_uint(v), false, false);
    return __uint_as_float(rr[0]) + __uint_as_float(rr[1]);
}
__device__ __forceinline__ float sigmoidf_(float x) { return __builtin_amdgcn_rcpf(1.0f + __builtin_amdgcn_exp2f(-LOG2E * x)); }
__device__ __forceinline__ float dot2bf(unsigned a, unsigned b, float acc) { return __builtin_amdgcn_fdot2_f32_bf16(__builtin_bit_cast(bf16x2v, a), __builtin_bit_cast(bf16x2v, b), acc, false); }

namespace pg8 {
constexpr int BM = 256, BK = 64, HALF = 128, HTB = HALF * BK * 2, STAGE_BYTES = 8 * HTB, NXCD = 8, WGM = 8;
__host__ __device__ __forceinline__ int lds_byte(int r, int c) { const int st = (r >> 4) * 2 + (c >> 5), rr = r & 15, cc = c & 31, ob = rr * 64 + cc * 2; return st * 1024 + (ob ^ (((ob >> 9) & 1) << 5)); }
__host__ __device__ __forceinline__ void stage_rc(int b, int& R, int& C) { const int st = b / 1024, sb = b % 1024, swz = sb ^ (((sb >> 9) & 1) << 5); R = (st >> 1) * 16 + swz / 64; C = (st & 1) * 32 + (swz % 64) / 2; }
__host__ __device__ __forceinline__ int perm32(int rho) { const int n = rho >> 4, i = rho & 15; return 8 * (i >> 2) + 4 * n + (i & 3); }

struct Unit { int pm, pn, seg; };
struct Gemm { const bf16* A; int K; int ldb; int ksplit; };

struct StaticOrder {
    int nM, nN, nwg, G, c; const bf16* Bt; size_t btile;
    __device__ void init(int M, int N, int G_, int c_, const bf16* Bt_, int ldb) { nM = M / BM; nN = N / BM; nwg = nM * nN; G = G_; c = c_; Bt = Bt_; btile = (size_t)BM * ldb * 2; }
    __device__ bool next(int i, Unit& u) const {
        const long L = (long)i * G + c; if (L >= nwg) return false;
        int wgid = (int)L; { const int q = nwg / NXCD, r = nwg % NXCD, xcd = wgid % NXCD, off = wgid / NXCD; wgid = (xcd < r ? xcd * (q + 1) : r * (q + 1) + (xcd - r) * q) + off; }
        const int nig = WGM * nN, gid = wgid / nig, fm = gid * WGM, gsz = (nM - fm) < WGM ? (nM - fm) : WGM;
        u.pm = fm + ((wgid % nig) % gsz); u.pn = (wgid % nig) / gsz; u.seg = 0; return true;
    }
    __device__ __forceinline__ const char* bptr(const Unit& u, int) const { return (const char*)Bt + (size_t)u.pn * btile; }
    __device__ __forceinline__ int nt(const Unit&, int ntd) const { return ntd; }
    __device__ __forceinline__ size_t aoff(const Unit&) const { return 0; }
};
struct SegOrder : StaticOrder {
    __device__ bool next(int i, Unit& u) const { const int q = i / 3; if (!StaticOrder::next(q, u)) return false; u.seg = i - 3 * q; return true; }
    __device__ __forceinline__ size_t koff(const Unit& u) const { return u.seg == 0 ? 0 : (u.seg == 1 ? 512 : 1024); }
    __device__ __forceinline__ const char* bptr(const Unit& u, int) const { return (const char*)Bt + (size_t)u.pn * btile + koff(u); }
    __device__ __forceinline__ int nt(const Unit& u, int) const { return u.seg == 2 ? 8 : 4; }
    __device__ __forceinline__ size_t aoff(const Unit& u) const { return koff(u); }
};

template <class Epi, class Sched, bool ALIGN_EPI = true, bool SP2 = true>
__device__ __forceinline__ void gemm_phase(LAS unsigned char* lds, const Gemm g, const Sched& S, const Epi& E, const int wave_id) {
    const int tid = wave_id * 64 + lane_id_opaque();
    const int wid = __builtin_amdgcn_readfirstlane(tid >> 6), lane = tid & 63, wr = wid >> 2, wc = wid & 3, fr = lane & 15, fq = lane >> 4;
    const int K = g.K, nt = K / BK, ldb = g.ldb, ks = g.ksplit;
    unsigned voffA[2], voffB[2];
#pragma unroll
    for (int i = 0; i < 2; ++i) { int R, C; stage_rc(tid * 16 + i * 8192, R, C); const int Rb = Epi::PERM ? ((R & ~31) + perm32(R & 31)) : R;
        voffA[i] = (unsigned)(R * K + C) * 2u; voffB[i] = (unsigned)(Rb * ldb + C) * 2u; }
    const size_t kstep = (size_t)(BK * 2);
    const size_t hstep = (size_t)HALF * K * 2;
    const size_t hstepB = (size_t)HALF * ldb * 2;
    const size_t tstep = 2 * hstep;
    const unsigned ldsw = (unsigned)wid * 1024u;
    const int aoff = lds_byte(wr * 64 + fr, fq * 8), boff = lds_byte(wc * 32 + fr, fq * 8);
#define PG8_SA(b, h) (((b) * 2 + (h)) * HTB)
#define PG8_SB(b, h) ((4 + (b) * 2 + (h)) * HTB)
#define PG8_STAGE(bufoff, gbase, voff) do { _Pragma("unroll") for (int _i = 0; _i < 2; ++_i) \
        __builtin_amdgcn_global_load_lds((const unsigned*)((const char*)(gbase) + (voff)[_i]), (LAS unsigned*)(lds + (bufoff) + ldsw + _i * 8192), 16, 0, 0); } while (0)
#define PG8_LDA(dst, b, h) do { _Pragma("unroll") for (int m = 0; m < 4; ++m) _Pragma("unroll") for (int k = 0; k < 2; ++k) dst[m][k] = *(const LAS bf16x8*)(lds + PG8_SA(b, h) + aoff + m * 2048 + k * 1024); } while (0)
#define PG8_LDB(dst, b, h) do { _Pragma("unroll") for (int n = 0; n < 2; ++n) _Pragma("unroll") for (int k = 0; k < 2; ++k) dst[n][k] = *(const LAS bf16x8*)(lds + PG8_SB(b, h) + boff + n * 2048 + k * 1024); } while (0)
#define PG8_MMA(ai, bj, At, Bt) do { __builtin_amdgcn_s_setprio(1); _Pragma("unroll") for (int m = 0; m < 4; ++m) _Pragma("unroll") for (int n = 0; n < 2; ++n) _Pragma("unroll") for (int k = 0; k < 2; ++k) \
        acc[ai][bj][m][n] = __builtin_amdgcn_mfma_f32_16x16x32_bf16(Bt[n][k], At[m][k], acc[ai][bj][m][n], 0, 0, 0); __builtin_amdgcn_s_setprio(0); } while (0)
#define PG8_WAIT_V(n) asm volatile("s_waitcnt vmcnt(" #n ")" ::: "memory")
#define PG8_WAIT_L(n) asm volatile("s_waitcnt lgkmcnt(" #n ")" ::: "memory")
#define PG8_BAR __builtin_amdgcn_s_barrier()
#define PG8_SCHED __builtin_amdgcn_sched_barrier(0)
    Unit cur, nxt; int ui = 0;
    if (!S.next(0, cur)) return;
    f32x4 acc[2][2][4][2];
    { float z_ = 0.f; LAUNDER_V(z_);
#pragma unroll
    for (int a = 0; a < 2; ++a)
#pragma unroll
        for (int b = 0; b < 2; ++b)
#pragma unroll
            for (int m = 0; m < 4; ++m)
#pragma unroll
                for (int n = 0; n < 2; ++n) acc[a][b][m][n] = (f32x4){z_, z_, z_, z_}; }
    bf16x8 At[4][2], B0[2][2], B1[2][2];
    int ntc = S.nt(cur, nt);
    const char* cA = (const char*)g.A + (size_t)cur.pm * tstep + S.aoff(cur); const char* cB = S.bptr(cur, 0); const char* cB1 = S.bptr(cur, 1) - (size_t)ks * kstep;
    if constexpr (SP2) {
        PG8_STAGE(PG8_SB(0, 0), cB, voffB); PG8_STAGE(PG8_SB(0, 1), cB + hstepB, voffB); PG8_STAGE(PG8_SA(0, 0), cA, voffA); PG8_STAGE(PG8_SA(0, 1), cA + hstep, voffA);
        if (wr == 1) PG8_BAR;
        PG8_WAIT_V(2); PG8_BAR;
        PG8_STAGE(PG8_SB(1, 0), cB + kstep, voffB); PG8_STAGE(PG8_SA(1, 0), cA + kstep, voffA); PG8_STAGE(PG8_SB(1, 1), cB + hstepB + kstep, voffB);
        PG8_WAIT_V(6); PG8_BAR;
    } else {
        PG8_STAGE(PG8_SB(0, 0), cB, voffB); PG8_STAGE(PG8_SA(0, 0), cA, voffA); PG8_STAGE(PG8_SB(0, 1), cB + hstepB, voffB); PG8_STAGE(PG8_SA(0, 1), cA + hstep, voffA);
        if (wr == 1) PG8_BAR;
        PG8_WAIT_V(4); PG8_BAR;
        PG8_STAGE(PG8_SB(1, 0), cB + kstep, voffB); PG8_STAGE(PG8_SA(1, 0), cA + kstep, voffA); PG8_STAGE(PG8_SB(1, 1), cB + hstepB + kstep, voffB);
        PG8_WAIT_V(6); PG8_BAR;
    }
    for (;;) {
        const bool has_next = S.next(ui + 1, nxt);
        const char* nA = has_next ? (const char*)g.A + (size_t)nxt.pm * tstep + S.aoff(nxt) : cA; const char* nB = has_next ? S.bptr(nxt, 0) : cB;
        const char* nB1 = has_next ? S.bptr(nxt, 1) - (size_t)ks * kstep : cB1;
#pragma unroll 1
        for (int t = 0; t < ntc; t += 2) {
            const bool last = (t == ntc - 2);
            const char* a1 = cA + (size_t)(t + 1) * kstep;
            const char* bside = (t + 2 < ks) ? cB : cB1;
            const char* a2 = last ? nA : cA + (size_t)(t + 2) * kstep; const char* b2 = last ? nB : bside + (size_t)(t + 2) * kstep;
            const char* a3 = a2 + kstep; const char* b3 = b2 + kstep;
            if constexpr (SP2) {
            PG8_LDB(B0, 0, 0); PG8_LDB(B1, 0, 1); PG8_SCHED; PG8_LDA(At, 0, 0); PG8_STAGE(PG8_SA(1, 1), a1 + hstep, voffA);
            PG8_WAIT_V(8); PG8_WAIT_L(0); PG8_BAR; PG8_MMA(0, 0, At, B0); PG8_MMA(0, 1, At, B1); PG8_BAR; PG8_SCHED;
            PG8_LDA(At, 0, 1); PG8_STAGE(PG8_SB(0, 0), b2, voffB); PG8_STAGE(PG8_SB(0, 1), b2 + hstepB, voffB); PG8_STAGE(PG8_SA(0, 0), a2, voffA);
            PG8_WAIT_V(8); PG8_WAIT_L(0); PG8_BAR; PG8_MMA(1, 0, At, B0); PG8_MMA(1, 1, At, B1); PG8_BAR; PG8_SCHED;
            PG8_LDB(B0, 1, 0); PG8_LDB(B1, 1, 1); PG8_SCHED; PG8_LDA(At, 1, 0); PG8_STAGE(PG8_SA(0, 1), a2 + hstep, voffA);
            PG8_WAIT_V(8); PG8_WAIT_L(0); PG8_BAR; PG8_MMA(0, 0, At, B0); PG8_MMA(0, 1, At, B1); PG8_BAR; PG8_SCHED;
            PG8_LDA(At, 1, 1); PG8_STAGE(PG8_SB(1, 0), b3, voffB); PG8_STAGE(PG8_SB(1, 1), b3 + hstepB, voffB); PG8_STAGE(PG8_SA(1, 0), a3, voffA);
            PG8_WAIT_V(8); PG8_WAIT_L(0); PG8_BAR; PG8_MMA(1, 0, At, B0); PG8_MMA(1, 1, At, B1); PG8_BAR; PG8_SCHED;
            } else {
            PG8_LDB(B0, 0, 0); PG8_SCHED; PG8_LDA(At, 0, 0); PG8_STAGE(PG8_SA(1, 1), a1 + hstep, voffA);
            PG8_WAIT_L(8); PG8_BAR; PG8_WAIT_L(0); PG8_MMA(0, 0, At, B0); PG8_BAR; PG8_SCHED;
            PG8_LDB(B1, 0, 1); PG8_STAGE(PG8_SB(0, 0), b2, voffB);
            PG8_BAR; PG8_WAIT_L(0); PG8_MMA(0, 1, At, B1); PG8_BAR;
            PG8_LDA(At, 0, 1); PG8_STAGE(PG8_SA(0, 0), a2, voffA);
            PG8_BAR; PG8_WAIT_L(0); PG8_MMA(1, 0, At, B0); PG8_BAR; PG8_SCHED;
            PG8_STAGE(PG8_SB(0, 1), b2 + hstepB, voffB);
            PG8_WAIT_V(6); PG8_BAR; PG8_MMA(1, 1, At, B1); PG8_BAR;
            PG8_LDB(B0, 1, 0); PG8_SCHED; PG8_LDA(At, 1, 0); PG8_STAGE(PG8_SA(0, 1), a2 + hstep, voffA);
            PG8_WAIT_L(8); PG8_BAR; PG8_WAIT_L(0); PG8_MMA(0, 0, At, B0); PG8_BAR; PG8_SCHED;
            PG8_LDB(B1, 1, 1); PG8_STAGE(PG8_SB(1, 0), b3, voffB);
            PG8_BAR; PG8_WAIT_L(0); PG8_MMA(0, 1, At, B1); PG8_BAR;
            PG8_LDA(At, 1, 1); PG8_STAGE(PG8_SA(1, 0), a3, voffA);
            PG8_BAR; PG8_WAIT_L(0); PG8_MMA(1, 0, At, B0); PG8_BAR; PG8_SCHED;
            PG8_STAGE(PG8_SB(1, 1), b3 + hstepB, voffB);
            PG8_WAIT_V(6); PG8_BAR; PG8_MMA(1, 1, At, B1); PG8_BAR;
            }
        }
        if constexpr (ALIGN_EPI) { if (wr == 0) PG8_BAR; }
        { const int l2 = lane_id_opaque(); E(acc, cur, wr, wc, l2 & 15, l2 >> 4); }
        if (!has_next) break;
        if (!E.keep(cur)) { float z_ = 0.f; LAUNDER_V(z_);
#pragma unroll
        for (int a = 0; a < 2; ++a)
#pragma unroll
            for (int b = 0; b < 2; ++b)
#pragma unroll
                for (int m = 0; m < 4; ++m)
#pragma unroll
                    for (int n = 0; n < 2; ++n) acc[a][b][m][n] = (f32x4){z_, z_, z_, z_}; }
        cur = nxt; cA = nA; cB = nB; cB1 = nB1; ++ui; ntc = S.nt(cur, nt);
        if constexpr (ALIGN_EPI) { if (wr == 1) PG8_BAR; }
    }
    PG8_WAIT_V(0);
    if constexpr (!ALIGN_EPI) { if (wr == 0) PG8_BAR; }
    PG8_BAR;
#undef PG8_SA
#undef PG8_SB
#undef PG8_STAGE
#undef PG8_LDA
#undef PG8_LDB
#undef PG8_MMA
#undef PG8_WAIT_V
#undef PG8_WAIT_L
#undef PG8_BAR
#undef PG8_SCHED
}
}

typedef f32x4 AccT[2][2][4][2];
__device__ __forceinline__ u32x4 pack8(const f32x4 a, const f32x4 b) { u32x4 w; w.x = pk2(a[0], a[1]); w.y = pk2(a[2], a[3]); w.z = pk2(b[0], b[1]); w.w = pk2(b[2], b[3]); return w; }

struct Epi1 {
    static constexpr bool PERM = true;
    __device__ __forceinline__ bool keep(const pg8::Unit&) const { return false; }
    const float* rstd; bf16* A; bf16* GLU; bf16* QKV; bf16* G;
    __device__ __forceinline__ void operator()(AccT& acc, const pg8::Unit& u, int wr, int wc, int fr, int fq) const {
        const int row0 = u.pm * 256 + wr * 64 + fr, lc0 = wc * 32 + 8 * fq, pn = u.pn;
#pragma unroll
        for (int ai = 0; ai < 2; ++ai)
#pragma unroll
            for (int m = 0; m < 4; ++m) {
                const int row = row0 + ai * 128 + m * 16; const float rs = rstd[row];
                f32x4 v[2][2];
#pragma unroll
                for (int bj = 0; bj < 2; ++bj)
#pragma unroll
                    for (int n = 0; n < 2; ++n) v[bj][n] = acc[ai][bj][m][n] * rs;
                if (pn == 0) {
#pragma unroll
                    for (int bj = 0; bj < 2; ++bj) *(u32x4*)(A + (size_t)row * 256 + bj * 128 + lc0) = pack8(v[bj][0], v[bj][1]);
                } else if (pn <= 2) {
                    f32x4 o[2];
#pragma unroll
                    for (int n = 0; n < 2; ++n)
#pragma unroll
                        for (int j = 0; j < 4; ++j) o[n][j] = v[0][n][j] * sigmoidf_(v[1][n][j]);
                    *(u32x4*)(GLU + (size_t)row * 256 + (pn - 1) * 128 + lc0) = pack8(o[0], o[1]);
                } else if (pn <= 8) {
                    const int t = (pn - 3) >> 1; bf16* base = QKV + (size_t)t * (U / 4); const float sc = t == 0 ? C2 : 1.0f;
#pragma unroll
                    for (int bj = 0; bj < 2; ++bj) *(u32x4*)(base + (size_t)row * 512 + ((pn - 3) & 1) * 256 + bj * 128 + lc0) = pack8(v[bj][0] * sc, v[bj][1] * sc);
                } else {
#pragma unroll
                    for (int bj = 0; bj < 2; ++bj) { f32x4 o[2];
#pragma unroll
                        for (int n = 0; n < 2; ++n)
#pragma unroll
                            for (int j = 0; j < 4; ++j) o[n][j] = fmaxf(sigmoidf_(v[bj][n][j]), 1e-30f);
                        *(u32x4*)(G + (size_t)row * 3072 + (pn - 9) * 256 + bj * 128 + lc0) = pack8(o[0], o[1]); }
                }
            }
    }
};
struct EpiCS {
    static constexpr bool PERM = true;
    const bf16* G; bf16* Mg; const float* bias;
    __device__ __forceinline__ bool keep(const pg8::Unit& u) const { return u.seg != 2; }
    __device__ __forceinline__ void operator()(AccT& acc, const pg8::Unit& u, int wr, int wc, int fr, int fq) const {
        const int row0 = u.pm * 256 + wr * 64 + fr, col0 = u.pn * 256 + wc * 32 + 8 * fq;
        const bool lastseg = u.seg == 2; const int w = u.seg, wd = lastseg ? 2 : u.seg + 1; const float bsc = u.seg == 0 ? 1.f : 0.f;
        f32x4 bv[2][2];
#pragma unroll
        for (int bj = 0; bj < 2; ++bj) { bv[bj][0] = *(const f32x4*)(bias + col0 + bj * 128) * bsc; bv[bj][1] = *(const f32x4*)(bias + col0 + bj * 128 + 4) * bsc; }
#pragma unroll
        for (int ai = 0; ai < 2; ++ai) {
            u32x4 gn[4][2], gd[4][2];
#pragma unroll
            for (int m = 0; m < 4; ++m) { const bf16* gp = G + (size_t)(row0 + ai * 128 + m * 16) * 3072 + col0;
#pragma unroll
                for (int bj = 0; bj < 2; ++bj) { gn[m][bj] = *(const u32x4*)(gp + w * 1024 + bj * 128); gd[m][bj] = *(const u32x4*)(gp + wd * 1024 + bj * 128); } }
#pragma unroll
            for (int m = 0; m < 4; ++m) { const int row = row0 + ai * 128 + m * 16;
#pragma unroll
                for (int bj = 0; bj < 2; ++bj) {
                    const u32x4 n4 = gn[m][bj], d4 = gd[m][bj];
                    f32x4 a0 = acc[ai][bj][m][0] + bv[bj][0], a1 = acc[ai][bj][m][1] + bv[bj][1];
#define RAT(gnv, gdv) ((gnv) * (lastseg ? 1.0f : __builtin_amdgcn_rcpf(gdv)))
                    a0[0] *= RAT(bflo(n4.x), bflo(d4.x)); a0[1] *= RAT(bfhi(n4.x), bfhi(d4.x)); a0[2] *= RAT(bflo(n4.y), bflo(d4.y)); a0[3] *= RAT(bfhi(n4.y), bfhi(d4.y));
                    a1[0] *= RAT(bflo(n4.z), bflo(d4.z)); a1[1] *= RAT(bfhi(n4.z), bfhi(d4.z)); a1[2] *= RAT(bflo(n4.w), bflo(d4.w)); a1[3] *= RAT(bfhi(n4.w), bfhi(d4.w));
#undef RAT
                    acc[ai][bj][m][0] = a0; acc[ai][bj][m][1] = a1;
                    asm volatile("" : "+v"(acc[ai][bj][m][0]), "+v"(acc[ai][bj][m][1]));
                    if (lastseg) *(u32x4*)(Mg + (size_t)row * 1024 + col0 + bj * 128) = pack8(a0, a1);
                } }
            asm volatile("" ::: "memory");
        }
    }
};
struct EpiD {
    static constexpr bool PERM = false;
    __device__ __forceinline__ bool keep(const pg8::Unit&) const { return false; }
    float* H; bf16* HB;
    __device__ __forceinline__ void operator()(AccT& acc, const pg8::Unit& u, int wr, int wc, int fr, int fq) const {
        const int row0 = u.pm * 256 + wr * 64 + fr, col0 = u.pn * 256 + wc * 32 + 4 * fq;
#pragma unroll
        for (int ai = 0; ai < 2; ++ai)
#pragma unroll
            for (int m = 0; m < 4; ++m) {
                const size_t off = (size_t)(row0 + ai * 128 + m * 16) * 1024 + col0;
#pragma unroll
                for (int bj = 0; bj < 2; ++bj)
#pragma unroll
                    for (int n = 0; n < 2; ++n) { const size_t o = off + bj * 128 + n * 16; const f32x4 hv = *(const f32x4*)(H + o) + acc[ai][bj][m][n];
                        *(f32x4*)(H + o) = hv; u32x2 w; w.x = pk2(hv[0], hv[1]); w.y = pk2(hv[2], hv[3]); *(u32x2*)(HB + o) = w; }
            }
    }
};
struct EpiA2 {
    static constexpr bool PERM = true;
    __device__ __forceinline__ bool keep(const pg8::Unit&) const { return false; }
    const float* PW; bf16* HH;
    __device__ __forceinline__ void operator()(AccT& acc, const pg8::Unit& u, int wr, int wc, int fr, int fq) const {
        const int row0 = u.pm * 256 + wr * 64 + fr, lc0 = wc * 32 + 8 * fq, side = u.pn >> 1;
#pragma unroll
        for (int ai = 0; ai < 2; ++ai)
#pragma unroll
            for (int m = 0; m < 4; ++m) {
                const int row = row0 + ai * 128 + m * 16; const f32x4 pw = *(const f32x4*)(PW + (size_t)row * 4);
                const float rs = pw[0], cw = side ? pw[2] : pw[1];
                f32x4 o[2];
#pragma unroll
                for (int n = 0; n < 2; ++n)
#pragma unroll
                    for (int j = 0; j < 4; ++j) { const float a1 = acc[ai][0][m][n][j] * rs, a3 = acc[ai][1][m][n][j] * rs; o[n][j] = cw * a1 * sigmoidf_(a1) * a3; }
                *(u32x4*)(HH + (size_t)row * 512 + side * 256 + (u.pn & 1) * 128 + lc0) = pack8(o[0], o[1]);
            }
    }
};
struct EpiB2 {
    static constexpr bool PERM = true;
    __device__ __forceinline__ bool keep(const pg8::Unit&) const { return false; }
    bf16* Y;
    __device__ __forceinline__ void operator()(AccT& acc, const pg8::Unit& u, int wr, int wc, int fr, int fq) const {
        const int row0 = u.pm * 256 + wr * 64 + fr, col0 = u.pn * 256 + wc * 32 + 8 * fq;
#pragma unroll
        for (int ai = 0; ai < 2; ++ai)
#pragma unroll
            for (int m = 0; m < 4; ++m) {
                bf16* rp = Y + (size_t)(row0 + ai * 128 + m * 16) * 1024 + col0;
#pragma unroll
                for (int bj = 0; bj < 2; ++bj) *(u32x4*)(rp + bj * 128) = pack8(acc[ai][bj][m][0], acc[ai][bj][m][1]);
            }
    }
};
struct MoeOrder {
    int NP, G, c, mode; const LAS int* pcls; const bf16* W;
    __device__ bool next(int i, pg8::Unit& u) const { const long L = (long)i * G + c; if (L >= (long)NP * 4) return false; u.pm = (int)(L >> 2); u.pn = (int)(L & 3); u.seg = 0; return true; }
    __device__ __forceinline__ int nt(const pg8::Unit&, int ntd) const { return ntd; }
    __device__ __forceinline__ size_t aoff(const pg8::Unit&) const { return 0; }
    __device__ __forceinline__ const char* bptr(const pg8::Unit& u, int side) const {
        const int cls = __builtin_amdgcn_readfirstlane(pcls[u.pm]); const int grp = cls / 6, pr = cls % 6;
        const int ea = pr < 3 ? 0 : (pr < 5 ? 1 : 2), eb = pr < 3 ? pr + 1 : (pr < 5 ? pr - 1 : 3);
        if (mode == 0) { const int e = grp * 4 + (u.pn < 2 ? ea : eb); return (const char*)W + ((size_t)e * 512 + (size_t)(u.pn & 1) * 256) * 1024 * 2; }
        const int e = grp * 4 + (side ? eb : ea); return (const char*)W + ((size_t)e * 1024 + (size_t)u.pn * 256) * 256 * 2;
    }
};

#define XB_TMO      128
#define XB_XCNT(j)  (256  + 64 * (j))
#define XB_XSUB(j)  (1280 + 64 * (j))
#define XB_XGEN(j)  (2304 + 64 * (j))
#define XB_TOP      3328
#define XB_TOPGEN   3392
#define XCD_BAR_WORDS 3456
#define XB_SPIN_CAP (1u << 24)
__device__ __forceinline__ unsigned xb_ld(unsigned* p)              { return __hip_atomic_load(p, __ATOMIC_RELAXED, __HIP_MEMORY_SCOPE_AGENT); }
__device__ __forceinline__ unsigned xb_add(unsigned* p, unsigned v) { return __hip_atomic_fetch_add(p, v, __ATOMIC_RELAXED, __HIP_MEMORY_SCOPE_AGENT); }
__device__ __forceinline__ unsigned xb_xcc_id() { return (unsigned)__builtin_amdgcn_s_getreg((3 << 11) | 20) & 0xFu; }
#define XB_SPIN(cond, bar) do { unsigned _sp = 0; while (cond) { __builtin_amdgcn_s_sleep(1); \
    if ((++_sp & 255u) == 0u) { if (xb_ld(&(bar)[XB_TMO])) break; if (_sp > XB_SPIN_CAP) { atomicAdd(&(bar)[XB_TMO], 1u); break; } } } } while (0)
struct XcdBarrier { unsigned* bar; unsigned x; volatile LAS unsigned* st; };
__device__ __forceinline__ XcdBarrier xcd_barrier_post(unsigned* bar, volatile LAS unsigned* st) {
    XcdBarrier b; b.bar = bar; b.x = xb_xcc_id(); b.st = st;
    if (threadIdx.x == 0) (void)xb_add(&bar[XB_XCNT(b.x)], 1u);
    return b;
}
__device__ __forceinline__ void xcd_barrier_complete(unsigned* bar, unsigned x, unsigned& nloc, unsigned& nx) {
    const unsigned G = gridDim.x * gridDim.y * gridDim.z;
    unsigned sum, cnt, mine, sp = 0u;
    for (;;) {
        sum = 0u; cnt = 0u; mine = 0u;
#pragma unroll
        for (unsigned j = 0; j < 16; ++j) { const unsigned c = xb_ld(&bar[XB_XCNT(j)]); sum += c; cnt += (c > 0u) ? 1u : 0u; mine = (j == x) ? c : mine; }
        if (sum == G) break;
        __builtin_amdgcn_s_sleep(1);
        if ((++sp & 255u) == 0u) { if (xb_ld(&bar[XB_TMO])) break; if (sp > XB_SPIN_CAP) { atomicAdd(&bar[XB_TMO], 1u); break; } }
    }
    nloc = mine > 0u ? mine : 1u; nx = cnt > 0u ? cnt : 1u;
}
__device__ __forceinline__ void xcd_barrier(const XcdBarrier& b) {
    asm volatile("s_waitcnt vmcnt(0)" ::: "memory");
    __syncthreads();
    if (threadIdx.x == 0) {
        unsigned* bar = b.bar;
        __builtin_amdgcn_s_waitcnt(0);
        unsigned nloc = b.st[0], nx = b.st[1];
        if (nloc == 0u) { xcd_barrier_complete(bar, b.x, nloc, nx); b.st[0] = nloc; b.st[1] = nx; }
        const unsigned old = xb_add(&bar[XB_XSUB(b.x)], 1u);
        const unsigned gen = old / nloc;
        if (old + 1u == (gen + 1u) * nloc) {
            __builtin_amdgcn_fence(__ATOMIC_RELEASE, "agent");
            asm volatile("s_waitcnt vmcnt(0)" ::: "memory");
            const unsigned og = xb_add(&bar[XB_TOP], 1u);
            const unsigned tg = og / nx;
            if (og + 1u == (tg + 1u) * nx) xb_add(&bar[XB_TOPGEN], 1u);
            else XB_SPIN(xb_ld(&bar[XB_TOPGEN]) == tg, bar);
            __builtin_amdgcn_fence(__ATOMIC_ACQUIRE, "agent");
            xb_add(&bar[XB_XGEN(b.x)], 1u);
            asm volatile("s_waitcnt vmcnt(0)" ::: "memory");
        } else {
            XB_SPIN(xb_ld(&bar[XB_XGEN(b.x)]) == gen, bar);
            __builtin_amdgcn_fence(__ATOMIC_ACQUIRE, "agent");
            asm volatile("s_waitcnt vmcnt(0)" ::: "memory");
        }
    }
    __syncthreads();
}

struct Params { const float* in[25]; float* out; unsigned char* ws; int ph_lo, ph_hi; };
enum { I_X = 0, I_META, I_N1G, I_WIN, I_BF, I_PW, I_PB, I_PS, I_CW, I_CB, I_LNG, I_LNB, I_WOA, I_WOB, I_WOC, I_WO, I_N2G, I_RGW, I_RGB, I_REW, I_REB, I_W1, I_W3, I_W2, I_FG };

struct Frame {
    LAS unsigned char* lds;
    int tid, lane, wave, vcu, G, bx;
};
__device__ __forceinline__ unsigned long long ptab_get(const Frame& F, int i) { const LAS unsigned* t = (const LAS unsigned*)(F.lds + LC_PTAB) + 2 * i; const unsigned lo = __builtin_amdgcn_readfirstlane(t[0]), hi = __builtin_amdgcn_readfirstlane(t[1]); return ((unsigned long long)hi << 32) | lo; }
#define INP(i) ((const float*)(const GAS float*)ptab_get(F, (i)))
#define WSP() ((unsigned char*)(GAS unsigned char*)ptab_get(F, 25))
#define DOP() ((unsigned char*)(GAS unsigned char*)ptab_get(F, 26))

__device__ __forceinline__ void tr_item(const float* W, int ldw, int scol0, const float* gk, bf16* WT, int ldt, int drow0, int k0, LAS float* scr, int lane) {
#pragma unroll 8
    for (int i = 0; i < 32; ++i) { const int kk = 2 * i + (lane >> 5); float v = W[(size_t)(k0 + kk) * ldw + scol0 + (lane & 31)]; if (gk) v *= gk[k0 + kk]; scr[kk * 33 + (lane & 31)] = v; }
    LDS_WAIT(); asm volatile("" ::: "memory");
    const int c = lane & 7;
#pragma unroll
    for (int j = 0; j < 4; ++j) { const int n = (lane >> 3) + 8 * j; const LAS float* s = scr + (8 * c) * 33 + n;
        u32x4 o; o.x = pk2(s[0 * 33], s[1 * 33]); o.y = pk2(s[2 * 33], s[3 * 33]); o.z = pk2(s[4 * 33], s[5 * 33]); o.w = pk2(s[6 * 33], s[7 * 33]);
        *(u32x4*)(WT + (size_t)(drow0 + n) * ldt + k0 + 8 * c) = o; }
    LDS_WAIT(); asm volatile("" ::: "memory");
}
__device__ __forceinline__ int map1(int n) {
    const int tile = n >> 8, r = n & 255;
    if (tile == 0) return n;
    if (tile <= 2) { const int c = (tile - 1) * 128 + (r & 127); return (r < 128 ? 256 : 512) + c; }
    if (tile <= 8) return n;
    return n + 8;
}
__device__ __forceinline__ void convert_weights(Frame& F, int l) {
    LAS float* scr = (LAS float*)(F.lds + F.wave * 16384);
    const int gw = F.vcu * NWAVES + F.wave, NGW = F.G * NWAVES, lane = F.lane;
    const float* g1 = INP(I_N1G) + (size_t)l * D; const float* g2 = INP(I_N2G) + (size_t)l * D;
    unsigned char* ws = WSP();
    { const float* W = INP(I_WIN) + (size_t)l * D * NIN; bf16* WT = (bf16*)(ws + WS_W1T);
      for (int it = gw; it < 16 * 168; it += NGW) { const int kb = it / 168, nb = it % 168; tr_item(W, NIN, map1(nb * 32), g1, WT, 1024, nb * 32, kb * 64, scr, lane); } }
    { const float* W = INP(I_WOB) + (size_t)l * 256 * D; bf16* WT = (bf16*)(ws + WS_W3CT) + 256;
      for (int it = gw; it < 4 * 32; it += NGW) { const int kb = it / 32, nb = it % 32; tr_item(W, 1024, nb * 32, nullptr, WT, 1024, nb * 32, kb * 64, scr, lane); } }
    { const float* W = INP(I_WOC) + (size_t)l * 512 * D; bf16* WT = (bf16*)(ws + WS_W3CT) + 512;
      for (int it = gw; it < 8 * 32; it += NGW) { const int kb = it / 32, nb = it % 32; tr_item(W, 1024, nb * 32, nullptr, WT, 1024, nb * 32, kb * 64, scr, lane); } }
    { const float* W = INP(I_WO) + (size_t)l * D * D; bf16* WT = (bf16*)(ws + WS_WOT);
      for (int it = gw; it < 16 * 32; it += NGW) { const int kb = it / 32, nb = it % 32; tr_item(W, 1024, nb * 32, nullptr, WT, 1024, nb * 32, kb * 64, scr, lane); } }
    { bf16* WT = (bf16*)(DOP() + DO_W13T);
      for (int it = gw; it < 16 * 256; it += NGW) { const int e = it >> 8, r = it & 255, kb = r >> 4, nb = r & 15, n0 = nb * 32, jt = n0 >> 8, rr = n0 & 255;
        const float* W = (rr < 128 ? INP(I_W1) : INP(I_W3)) + ((size_t)l * 16 + e) * D * 256;
        tr_item(W, 256, jt * 128 + (rr & 127), g2, WT + (size_t)e * 512 * 1024, 1024, n0, kb * 64, scr, lane); } }
    { bf16* WT = (bf16*)(DOP() + DO_W2T);
      for (int it = gw; it < 16 * 128; it += NGW) { const int e = it >> 7, r = it & 127, kb = r >> 5, nb = r & 31;
        const float* W = INP(I_W2) + ((size_t)l * 16 + e) * 256 * D;
        tr_item(W, 1024, nb * 32, nullptr, WT + (size_t)e * 1024 * 256, 256, nb * 32, kb * 64, scr, lane); } }
    { const float* pw = INP(I_PW) + (size_t)l * 4 * 64 * 64; const float* ps = INP(I_PS) + (size_t)l * 256; const float* pb = INP(I_PB) + (size_t)l * 256;
      const float* wa = INP(I_WOA) + (size_t)l * 256 * D; bf16* WT = (bf16*)(ws + WS_W3CT); float* bias = (float*)(ws + WS_BIASA);
      const int gt = F.vcu * 512 + F.tid, NT = F.G * 512;
      for (int idx = gt; idx < 256 * 1024; idx += NT) { const int n = idx & 1023, kk = idx >> 10, grp = kk >> 6, c = kk & 63; float s = 0.f;
        for (int d = 0; d < 64; ++d) s += pw[(grp * 64 + c) * 64 + d] * ps[grp * 64 + d] * wa[(size_t)(grp * 64 + d) * D + n];
        WT[(size_t)n * 1024 + kk] = (bf16)f2bf(s); }
      for (int n = gt; n < 1024; n += NT) { float s = 0.f; for (int d = 0; d < 256; ++d) s += pb[d] * ps[d] * wa[(size_t)d * D + n]; bias[n] = s; }
      float* wfg = (float*)(ws + WS_WFG); const float* win = INP(I_WIN) + (size_t)l * D * NIN;
      for (int idx = gt; idx < 8 * 1024; idx += NT) { const int c = idx >> 10, k = idx & 1023; wfg[idx] = g1[k] * win[(size_t)k * NIN + 2304 + c]; }
      float* rg = (float*)(ws + WS_RG); const float* re = INP(I_REW) + (size_t)l * D * 16; const float* rgw = INP(I_RGW) + (size_t)l * D * 4;
      for (int idx = gt; idx < 20 * 1024; idx += NT) { const int c = idx >> 10, k = idx & 1023; rg[idx] = g2[k] * (c < 16 ? re[(size_t)k * 16 + c] : rgw[(size_t)k * 4 + (c - 16)]); } }
}
__device__ __forceinline__ void init_rows(Frame& F) {
    const int gw = F.vcu * NWAVES + F.wave, NGW = F.G * NWAVES, lane = F.lane;
    float* H = (float*)(WSP() + WS_H); bf16* HB = (bf16*)(WSP() + WS_HB); float* rstd1 = (float*)(WSP() + WS_RSTD1);

#pragma unroll 1
for (int row = gw; row < TM; row += NGW) {
        const float* src = row < TX ? INP(I_X) + (size_t)row * D : (row - TX < NMETA ? INP(I_META) + (size_t)(row - TX) * D : nullptr);
        f32x4 v[4]; float ss = 0.f;
#pragma unroll
        for (int j = 0; j < 4; ++j) { float z_ = 0.f; LAUNDER_V(z_); v[j] = src ? *(const f32x4*)(src + 4 * lane + 256 * j) : (f32x4){z_, z_, z_, z_}; ss += v[j][0] * v[j][0] + v[j][1] * v[j][1] + v[j][2] * v[j][2] + v[j][3] * v[j][3]; }
        ss = wave_sum(ss);
#pragma unroll
        for (int j = 0; j < 4; ++j) { *(f32x4*)(H + (size_t)row * D + 4 * lane + 256 * j) = v[j]; u32x2 w; w.x = pk2(v[j][0], v[j][1]); w.y = pk2(v[j][2], v[j][3]); *(u32x2*)(HB + (size_t)row * D + 4 * lane + 256 * j) = w; }
        if (lane == 0) rstd1[row] = rsqrtf(ss * (1.0f / D) + EPS);
    }
}

__device__ __forceinline__ int srcrow(bool isx, int b, int t) {
    if (t >= 0) return (isx ? b * SEQ : TX) + t;
    if (isx) { const int mm = NMETA + t; return mm >= 0 ? TX + mm : -1; }
    return -1;
}
__device__ __forceinline__ void phase_S(Frame& F, int l) {
    LAS unsigned char* lds = F.lds; const int wave = F.wave;
#pragma unroll 1
    for (int item = F.vcu; item < 516; item += F.G) {
        const bool isx = item < 512; const int row0 = isx ? item * 64 : TX + (item - 512) * 64; const int b = isx ? (item * 64) / SEQ : 0; const int t0 = isx ? (item * 64) % SEQ : (item - 512) * 64;
        { unsigned char* ws = WSP(); int tid = F.tid; LAUNDER_V(tid); const int lane = tid & 63;
          const bf16* HB = (const bf16*)(ws + WS_HB); const float* rstd1 = (const float*)(ws + WS_RSTD1); const float* wfg = (const float*)(ws + WS_WFG);
          float* LFT = (float*)(ws + WS_LFT); float* LFTM = (float*)(ws + WS_LFTM); const float* bfg = INP(I_BF) + l * 8;
          LAS float* W = (LAS float*)lds;
#pragma unroll 1
          for (int i = tid; i < 2048; i += 512) *(LAS f32x4*)(W + 4 * i) = *(const f32x4*)(wfg + 4 * i);
          __syncthreads();
#pragma unroll 1
          for (int rr = wave; rr < 64; rr += 8) { const int row = row0 + rr; float xv[16];
#pragma unroll
            for (int j = 0; j < 2; ++j) { const u32x4 w = *(const u32x4*)(HB + (size_t)row * D + 8 * lane + 512 * j);
                xv[8 * j + 0] = bflo(w.x); xv[8 * j + 1] = bfhi(w.x); xv[8 * j + 2] = bflo(w.y); xv[8 * j + 3] = bfhi(w.y); xv[8 * j + 4] = bflo(w.z); xv[8 * j + 5] = bfhi(w.z); xv[8 * j + 6] = bflo(w.w); xv[8 * j + 7] = bfhi(w.w); }
            float mine = 0.f;
#pragma unroll
            for (int c = 0; c < 8; ++c) { float s = 0.f;
#pragma unroll
                for (int j = 0; j < 2; ++j) { const f32x4 w0 = *(const LAS f32x4*)(W + c * 1024 + 8 * lane + 512 * j), w1 = *(const LAS f32x4*)(W + c * 1024 + 8 * lane + 512 * j + 4);
                    s += xv[8 * j] * w0[0] + xv[8 * j + 1] * w0[1] + xv[8 * j + 2] * w0[2] + xv[8 * j + 3] * w0[3] + xv[8 * j + 4] * w1[0] + xv[8 * j + 5] * w1[1] + xv[8 * j + 6] * w1[2] + xv[8 * j + 7] * w1[3]; }
                s = wave_sum(s); if (lane == c) mine = s; }
            if (lane < 8) { const float xg = mine * rstd1[row] + bfg[lane]; const float lf = fminf(xg, 0.f) - 0.69314718056f * __builtin_amdgcn_logf(1.0f + __expf(-fabsf(xg)));
                if (isx) LFT[(size_t)(b * 8 + lane) * SEQ + t0 + rr] = lf; else LFTM[lane * 256 + t0 + rr] = lf; } }
          __syncthreads(); }
        { unsigned char* ws = WSP(); int tid = F.tid; LAUNDER_V(tid);
          const bf16* Ab = (const bf16*)(ws + WS_A); bf16* DIFF = (bf16*)(ws + WS_X3);
          LAS unsigned char* T = lds;
#pragma unroll 1
          for (int i = tid; i < 79 * 32; i += 512) { const int s = i >> 5, ch = i & 31; const int r = srcrow(isx, b, t0 + s - 15);
              unsigned z_ = 0u; LAUNDER_V(z_);
              *(LAS u32x4*)(T + s * 512 + ch * 16) = r >= 0 ? *(const u32x4*)(Ab + (size_t)r * 256 + ch * 8) : (u32x4){z_, z_, z_, z_}; }
          __syncthreads();
#pragma unroll 1
          for (int i = tid; i < 64 * 32; i += 512) { const int r = i >> 5, ch = i & 31, grp = ch >> 3, w = 2 << grp; const int cnt = isx ? w : min(t0 + r + 1, w);
              float s[8];
#pragma unroll
              for (int j = 0; j < 8; ++j) s[j] = 0.f;
#pragma unroll 1
              for (int d = 0; d < cnt; ++d) { const u32x4 v = *(const LAS u32x4*)(T + (15 + r - d) * 512 + ch * 16);
                  s[0] += bflo(v.x); s[1] += bfhi(v.x); s[2] += bflo(v.y); s[3] += bfhi(v.y); s[4] += bflo(v.z); s[5] += bfhi(v.z); s[6] += bflo(v.w); s[7] += bfhi(v.w); }
              const u32x4 a = *(const LAS u32x4*)(T + (15 + r) * 512 + ch * 16); const float ic = 1.0f / (float)cnt;
              u32x4 o; o.x = pk2(s[0] * ic - bflo(a.x), s[1] * ic - bfhi(a.x)); o.y = pk2(s[2] * ic - bflo(a.y), s[3] * ic - bfhi(a.y));
              o.z = pk2(s[4] * ic - bflo(a.z), s[5] * ic - bfhi(a.z)); o.w = pk2(s[6] * ic - bflo(a.w), s[7] * ic - bfhi(a.w));
              *(u32x4*)(DIFF + (size_t)(row0 + r) * 1024 + ch * 8) = o; }
          __syncthreads(); }
        { unsigned char* ws = WSP(); int tid = F.tid; LAUNDER_V(tid);
          const bf16* GLU = (const bf16*)(ws + WS_GLU);
          LAS unsigned char* T = lds;
          LAS float* Yt = (LAS float*)(lds + 49152);
#pragma unroll 1
          for (int i = tid; i < 94 * 32; i += 512) { const int s = i >> 5, ch = i & 31; const int r = srcrow(isx, b, t0 + s - 30);
              unsigned z_ = 0u; LAUNDER_V(z_);
              *(LAS u32x4*)(T + s * 512 + ch * 16) = r >= 0 ? *(const u32x4*)(GLU + (size_t)r * 256 + ch * 8) : (u32x4){z_, z_, z_, z_}; }
          __syncthreads();
          { const float* cw = INP(I_CW) + (size_t)l * 31 * 256; const float* cb = INP(I_CB) + l * 256;
            const int cp = tid & 127, strip = tid >> 7; f32x2 wv[31];
#pragma unroll
            for (int j = 0; j < 31; ++j) wv[j] = *(const f32x2*)(cw + j * 256 + 2 * cp);
            const f32x2 bias = *(const f32x2*)(cb + 2 * cp);
#pragma unroll 1
            for (int hh = 0; hh < 2; ++hh) { const int rb = 32 * hh + 8 * strip; f32x2 acc[8];
#pragma unroll
                for (int r = 0; r < 8; ++r) acc[r] = bias;
#pragma unroll
                for (int i = 0; i < 38; ++i) { const unsigned xw = *(const LAS unsigned*)(T + (rb + i) * 512 + cp * 4); const f32x2 xx = {bflo(xw), bfhi(xw)};
#pragma unroll
                    for (int r = 0; r < 8; ++r) { const int j = i - r; if (j >= 0 && j <= 30) acc[r] += wv[j] * xx; } }
#pragma unroll
                for (int r = 0; r < 8; ++r) *(LAS f32x2*)(Yt + (rb + r) * 256 + 2 * cp) = acc[r]; } }
          __syncthreads();
          { unsigned char* ws2 = WSP(); int tid2 = F.tid; LAUNDER_V(tid2); const int lane = tid2 & 63;
            bf16* BP = (bf16*)(ws2 + WS_X3) + 256; const float* lng = INP(I_LNG) + l * 256; const float* lnb = INP(I_LNB) + l * 256;
#pragma unroll 1
            for (int rr = wave; rr < 64; rr += 8) { const f32x4 v = *(const LAS f32x4*)(Yt + rr * 256 + 4 * lane);
              const float mean = wave_sum(v[0] + v[1] + v[2] + v[3]) * (1.0f / 256.0f); const f32x4 dv = v - mean;
              const float var = wave_sum(dv[0] * dv[0] + dv[1] * dv[1] + dv[2] * dv[2] + dv[3] * dv[3]) * (1.0f / 256.0f); const float rs = rsqrtf(var + EPS);
              const f32x4 gg = *(const f32x4*)(lng + 4 * lane), bb = *(const f32x4*)(lnb + 4 * lane); f32x4 o = dv * rs * gg + bb;
#pragma unroll
              for (int j = 0; j < 4; ++j) o[j] = o[j] * sigmoidf_(o[j]);
              u32x2 w; w.x = pk2(o[0], o[1]); w.y = pk2(o[2], o[3]); *(u32x2*)(BP + (size_t)(row0 + rr) * 1024 + 4 * lane) = w; } }
          __syncthreads(); }
    }
}

constexpr int AT_FL = 0, AT_K = 34816, AT_VT = AT_K + 8192, AT_SC = AT_VT + 8192;
__device__ __forceinline__ void attn_scan(Frame& F, int b, int h, bool meta_only, int fl_off, int sc_off) {
    LAS float* Fl = (LAS float*)(F.lds + fl_off); LAS float* sc = (LAS float*)(F.lds + sc_off);
    const float* LFT = (const float*)(WSP() + WS_LFT); const float* LFTM = (const float*)(WSP() + WS_LFTM);
    const int tid = F.tid, lane = F.lane, wave = F.wave;
    __syncthreads();
    if (tid == 0) { float s = 0.f; for (int m = 0; m < 64; ++m) { if (m < (meta_only ? 64 : NMETA)) { s += LFTM[h * 256 + m]; Fl[m] = s * LOG2E; } else Fl[m] = 1e30f; if (m == NMETA - 1) sc[16] = s; } }
    if (meta_only) { for (int i = tid; i < 256; i += 512) Fl[64 + i] = 0.f; __syncthreads(); return; }
    float v[16]; const float* src = LFT + (size_t)(b * 8 + h) * SEQ + 16 * tid;
#pragma unroll
    for (int j = 0; j < 4; ++j) { const f32x4 q = *(const f32x4*)(src + 4 * j); v[4 * j] = q[0]; v[4 * j + 1] = q[1]; v[4 * j + 2] = q[2]; v[4 * j + 3] = q[3]; }
#pragma unroll
    for (int j = 1; j < 16; ++j) v[j] += v[j - 1];
    float incl = v[15];
#pragma unroll
    for (int o = 1; o < 64; o <<= 1) { const float up = __int_as_float(__builtin_amdgcn_ds_bpermute((lane - o) << 2, __float_as_int(incl))); if (lane >= o) incl += up; }
    if (lane == 63) sc[wave] = incl;
    __syncthreads();
    float off = sc[16];
    for (int w = 0; w < wave; ++w) off += sc[w];
    off += incl - v[15];
#pragma unroll
    for (int j = 0; j < 16; ++j) Fl[64 + 16 * tid + j] = (off + v[j]) * LOG2E;
    __syncthreads();
}
__device__ __forceinline__ void attn_unit_naive(Frame& F, int qrow0, int qpos0, int ntiles, int kvx0, int h) {
    const int tid = F.tid; const int r = tid >> 1, hf = tid & 1;
    const bf16* Q = (const bf16*)(DOP() + DO_Q); const bf16* Kg = (const bf16*)(DOP() + DO_K); const bf16* Vg = (const bf16*)(DOP() + DO_V); bf16* O = (bf16*)(WSP() + WS_X3) + 512;
    LAS float* Fl = (LAS float*)(F.lds + AT_FL); LAS unsigned char* Ks = F.lds + AT_K; LAS bf16* VT = (LAS bf16*)(F.lds + AT_VT);
    const int grow = qrow0 + r, qpos = qpos0 + r;
    unsigned qp[16];
#pragma unroll
    for (int j = 0; j < 4; ++j) { const u32x4 w = *(const u32x4*)(Q + (size_t)grow * 512 + h * 64 + hf * 32 + 8 * j); qp[4 * j] = w.x; qp[4 * j + 1] = w.y; qp[4 * j + 2] = w.z; qp[4 * j + 3] = w.w; }
    const float Fq = Fl[qpos < NMETA ? qpos : qpos + 48];
    float mrun = -1e30f, lrun = 0.f, o[32];
#pragma unroll
    for (int d = 0; d < 32; ++d) o[d] = 0.f;
    const int lrow = tid >> 3, lch = tid & 7;

#pragma unroll 1
for (int i = 0; i < ntiles; ++i) {
        const int krow = (i == 0 ? TX : kvx0 + 64 * (i - 1)) + lrow;
        const u32x4 kw = *(const u32x4*)(Kg + (size_t)krow * 512 + h * 64 + lch * 8);
        const u32x4 vw = *(const u32x4*)(Vg + (size_t)krow * 512 + h * 64 + lch * 8);
        __syncthreads();
        *(LAS u32x4*)(Ks + lrow * 128 + lch * 16) = kw;
        { const unsigned vv[4] = {vw.x, vw.y, vw.z, vw.w};
#pragma unroll
          for (int e = 0; e < 4; ++e) { VT[(lch * 8 + 2 * e) * 64 + lrow] = (bf16)(vv[e] & 0xffffu); VT[(lch * 8 + 2 * e + 1) * 64 + lrow] = (bf16)(vv[e] >> 16); } }
        __syncthreads();
        const int kp0 = i == 0 ? 0 : NMETA + 64 * (i - 1);
        if (kp0 > qpos0 + 255) continue;
#pragma unroll 1
        for (int jg = 0; jg < 4; ++jg) {
            float s[16]; float gmax = -1e30f;
#pragma unroll
            for (int jj = 0; jj < 16; ++jj) { const int j = jg * 16 + jj; float d = 0.f;
#pragma unroll
                for (int c = 0; c < 4; ++c) { const u32x4 kk = *(const LAS u32x4*)(Ks + j * 128 + hf * 64 + c * 16);
                    d = dot2bf(kk.x, qp[4 * c], d); d = dot2bf(kk.y, qp[4 * c + 1], d); d = dot2bf(kk.z, qp[4 * c + 2], d); d = dot2bf(kk.w, qp[4 * c + 3], d); }
                d += lane_xor<1>(d);
                const bool valid = (i == 0 ? j < NMETA : true) && (kp0 + j <= qpos);
                s[jj] = valid ? d + Fq - Fl[64 * i + j] : -1e30f; gmax = fmaxf(gmax, s[jj]); }
            const float mn = fmaxf(mrun, gmax), alpha = exp2f(mrun - mn); mrun = mn;
            float ps = 0.f; unsigned pp[8];
#pragma unroll
            for (int jj = 0; jj < 16; jj += 2) { const float p0 = exp2f(s[jj] - mn), p1 = exp2f(s[jj + 1] - mn); ps += p0 + p1; pp[jj >> 1] = pk2(p0, p1); }
            lrun = lrun * alpha + ps;
#pragma unroll
            for (int d = 0; d < 32; ++d) { const u32x4 v0 = *(const LAS u32x4*)(VT + (hf * 32 + d) * 64 + jg * 16), v1 = *(const LAS u32x4*)(VT + (hf * 32 + d) * 64 + jg * 16 + 8);
                float a = o[d] * alpha; a = dot2bf(pp[0], v0.x, a); a = dot2bf(pp[1], v0.y, a); a = dot2bf(pp[2], v0.z, a); a = dot2bf(pp[3], v0.w, a);
                a = dot2bf(pp[4], v1.x, a); a = dot2bf(pp[5], v1.y, a); a = dot2bf(pp[6], v1.z, a); a = dot2bf(pp[7], v1.w, a); o[d] = a; }
        }
    }
    const float il = 1.0f / lrun;
#pragma unroll
    for (int j = 0; j < 4; ++j) { u32x4 w; w.x = pk2(o[8 * j] * il, o[8 * j + 1] * il); w.y = pk2(o[8 * j + 2] * il, o[8 * j + 3] * il); w.z = pk2(o[8 * j + 4] * il, o[8 * j + 5] * il); w.w = pk2(o[8 * j + 6] * il, o[8 * j + 7] * il);
        *(u32x4*)(O + (size_t)grow * 1024 + h * 64 + hf * 32 + 8 * j) = w; }
}
namespace fa {
using bf16x8v = __attribute__((ext_vector_type(8))) short;
using s16x4 = __attribute__((ext_vector_type(4))) short;
using f32x16 = __attribute__((ext_vector_type(16))) float;
constexpr int DMA = 512, DMO = 1024;
constexpr int NW = 8, QBLK = 32, QB = 256, KVBLK = 64;
constexpr int NSLOT = 3, SLOTB = 8192;
constexpr int LDS_K = 0, LDS_V = NSLOT * SLOTB, LDS_WS = 2 * NSLOT * SLOTB, LDS_OST = LDS_WS + NW * 64 * 4, LDS_BYTES = LDS_OST + NW * 4096;
constexpr int LDS_FL = 84992;
constexpr int LDS_SCAN = LDS_FL + (64 + 8192) * 4;
static_assert(LDS_SCAN + 128 <= RING_BYTES, "attention LDS");
__device__ __forceinline__ int crow(int r, int hi) { return (r & 3) + 8 * (r >> 2) + 4 * hi; }
#define SBAR() __builtin_amdgcn_sched_barrier(0)
__device__ __forceinline__ void cmask(f32x16& p0, f32x16& p1, int jb, int qrel, int hi) {
    const float NEG = -INFINITY; int kb = 64 * jb + 4 * hi;
#pragma unroll
    for (int r = 0; r < 16; ++r) { int kv = kb + (r & 3) + 8 * (r >> 2); if (kv > qrel) p0[r] = NEG; if (kv + 32 > qrel) p1[r] = NEG; }
}
__device__ __forceinline__ void glds16(const void* gsrc, unsigned lds_dst) { unsigned keep;
    asm volatile("s_mov_b32 %0, m0\n\ts_mov_b32 m0, %2\n\ts_nop 0\n\tglobal_load_lds_dwordx4 %1, off\n\ts_mov_b32 m0, %0" : "=&s"(keep) : "v"(gsrc), "s"(lds_dst) : "memory"); }
__device__ __forceinline__ float max3f(float a, float b, float c) { float r; asm("v_max3_f32 %0, %1, %2, %3" : "=v"(r) : "v"(a), "v"(b), "v"(c)); return r; }
__device__ __forceinline__ float max2f(float a, float b) { float r; asm("v_max_f32_e32 %0, %1, %2" : "=v"(r) : "v"(a), "v"(b)); return r; }
__device__ __forceinline__ float fsub_s(float a, float b) { float r; asm("v_sub_f32_e32 %0, %1, %2" : "=v"(r) : "v"(a), "v"(b)); return r; }
typedef float f32x2_t __attribute__((ext_vector_type(2))); typedef __bf16 bf16x2_t __attribute__((ext_vector_type(2)));
__device__ __forceinline__ unsigned cvtpk_s(float lo, float hi) { f32x2_t v = {lo, hi}; bf16x2_t b = __builtin_convertvector(v, bf16x2_t); return __builtin_bit_cast(unsigned, b); }
#define WAIT_BAR(N) asm volatile("s_waitcnt vmcnt(" #N ") lgkmcnt(0)\n\ts_barrier" ::: "memory")
typedef __attribute__((address_space(3))) const char* lds_cptr;
typedef short v4i16_t __attribute__((ext_vector_type(4)));
__device__ __forceinline__ void cinit(f32x16& p0, f32x16& p1, const LAS float* fk, float a) {
#pragma unroll
    for (int g = 0; g < 4; ++g) { const f32x4 f0 = *(const LAS f32x4*)(fk + 8 * g), f1 = *(const LAS f32x4*)(fk + 32 + 8 * g);
#pragma unroll
        for (int i = 0; i < 4; ++i) { p0[4 * g + i] = a - f0[i]; p1[4 * g + i] = a - f1[i]; } }
}
__device__ __forceinline__ void qkt(f32x16& p0, f32x16& p1, const char* Kslot, const bf16x8v* qr, int r32, int hi) {
    const char* kb = Kslot + hi * 1024 + r32 * 16;
#pragma unroll
    for (int d0 = 0; d0 < 4; ++d0) {
        const bf16x8v b0 = *reinterpret_cast<const bf16x8v*>(kb + d0 * 2048);
        const bf16x8v b1 = *reinterpret_cast<const bf16x8v*>(kb + d0 * 2048 + 512);
        p0 = __builtin_amdgcn_mfma_f32_32x32x16_bf16(b0, qr[d0], p0, 0, 0, 0); p1 = __builtin_amdgcn_mfma_f32_32x32x16_bf16(b1, qr[d0], p1, 0, 0, 0); }
}
__device__ __forceinline__ void kload8(bf16x8v* kf, lds_cptr kp) {
    kf[0] = *(const LAS bf16x8v*)(kp);        kf[1] = *(const LAS bf16x8v*)(kp + 512);
    kf[2] = *(const LAS bf16x8v*)(kp + 2048); kf[3] = *(const LAS bf16x8v*)(kp + 2560);
    kf[4] = *(const LAS bf16x8v*)(kp + 4096); kf[5] = *(const LAS bf16x8v*)(kp + 4608);
    kf[6] = *(const LAS bf16x8v*)(kp + 6144); kf[7] = *(const LAS bf16x8v*)(kp + 6656);
}
__device__ __forceinline__ void kload2(bf16x8v* kf, lds_cptr kp, int j) { kf[2 * j] = *(const LAS bf16x8v*)(kp + j * 2048); kf[2 * j + 1] = *(const LAS bf16x8v*)(kp + j * 2048 + 512); }
__device__ __forceinline__ s16x4 vtr(lds_cptr p) { return __builtin_bit_cast(s16x4, __builtin_amdgcn_ds_read_tr16_b64_v4i16((LAS v4i16_t*)p)); }
__device__ __forceinline__ float rowmax(const f32x16& p0, const f32x16& p1) {
    float a = max3f(p0[0], p0[1], p1[0]), b = max3f(p0[2], p0[3], p1[1]); a = max3f(a, p1[2], p1[3]);
#pragma unroll
    for (int r = 4; r < 16; r += 4) { a = max3f(a, p0[r], p0[r + 1]); b = max3f(b, p0[r + 2], p0[r + 3]); a = max3f(a, p1[r], p1[r + 1]); b = max3f(b, p1[r + 2], p1[r + 3]); }
    const float m = max2f(a, b);
    auto rr = __builtin_amdgcn_permlane32_swap(__float_as_uint(m), __float_as_uint(m), false, false);
    return max2f(__uint_as_float(rr[0]), __uint_as_float(rr[1]));
}
__device__ __forceinline__ void pv(f32x16* o, int vb, bf16x8v pa0, bf16x8v pa1, bf16x8v pa2, bf16x8v pa3) {
#pragma unroll
    for (int d0 = 0; d0 < 2; ++d0) { s16x4 lo[4], hi[4];
#pragma unroll
        for (int ks = 0; ks < 4; ++ks) {
            asm volatile("ds_read_b64_tr_b16 %0,%1 offset:%c2" : "=&v"(lo[ks]) : "v"(vb), "i"(d0 * 4096 + ks * 1024) : "memory");
            asm volatile("ds_read_b64_tr_b16 %0,%1 offset:%c2" : "=&v"(hi[ks]) : "v"(vb), "i"(d0 * 4096 + ks * 1024 + 512) : "memory"); }
        asm volatile("s_waitcnt lgkmcnt(0)" ::: "memory"); SBAR();
#define PK(k) (bf16x8v){lo[k][0], lo[k][1], lo[k][2], lo[k][3], hi[k][0], hi[k][1], hi[k][2], hi[k][3]}
        o[d0] = __builtin_amdgcn_mfma_f32_32x32x16_bf16(pa0, PK(0), o[d0], 0, 0, 0);
        o[d0] = __builtin_amdgcn_mfma_f32_32x32x16_bf16(pa1, PK(1), o[d0], 0, 0, 0);
        o[d0] = __builtin_amdgcn_mfma_f32_32x32x16_bf16(pa2, PK(2), o[d0], 0, 0, 0);
        o[d0] = __builtin_amdgcn_mfma_f32_32x32x16_bf16(pa3, PK(3), o[d0], 0, 0, 0);
#undef PK
    }
}
template <int THRL> __device__ __forceinline__ void attn_unit(int b, int h, int qb, const bf16* Q, const bf16* __restrict__ K, const bf16* __restrict__ V, bf16* O, char* shm, int wid) {
    const int lane = lane_id_opaque(), r32 = lane & 31, hi = lane >> 5;
    const long rowbase = (long)b * SEQ; const int q0 = qb * QB;
    const bf16* Qw = Q + (rowbase + q0 + wid * QBLK) * DMA + h * 64;
    const bf16* Kh = K + rowbase * DMA + h * 64, *Vh = V + rowbase * DMA + h * 64;
    const bf16* Km = K + (long)TX * DMA + h * 64, *Vm = V + (long)TX * DMA + h * 64;
    const unsigned lds0 = (unsigned)(uintptr_t)shm;
    float* wsf = (float*)(shm + LDS_WS) + wid * 64;
    const bf16* ksrc = Kh + (long)lane * DMA + wid * 8;
    const bf16* vsrc = Vh + (long)(16 * (wid & 3) + (lane >> 2)) * DMA + (wid >> 2) * 32 + (lane & 3) * 8;
    const bf16* ksrcm = Km + (long)lane * DMA + wid * 8;
    const bf16* vsrcm = Vm + (long)(16 * (wid & 3) + (lane >> 2)) * DMA + (wid >> 2) * 32 + (lane & 3) * 8;
    const unsigned kdst = lds0 + LDS_K + wid * 1024, vdst = lds0 + LDS_V + wid * 1024;
#define DMA_K(t, slot) glds16(ksrc + (long)((t) - 1) * KVBLK * DMA, (unsigned)__builtin_amdgcn_readfirstlane(kdst + (slot)))
#define DMA_V(t, slot) glds16(vsrc + (long)((t) - 1) * KVBLK * DMA, (unsigned)__builtin_amdgcn_readfirstlane(vdst + (slot)))
    const int vb0 = (int)(lds0 + LDS_V) + ((lane >> 4) & 1) * 32 + (lane & 3) * 8 + (4 * hi + ((lane & 15) >> 2)) * 64;
    const char* Kbase = shm + LDS_K; bf16x8v kf[8];
    const lds_cptr shm3 = (lds_cptr)shm; const lds_cptr kp0 = shm3 + LDS_K + hi * 1024 + r32 * 16; const lds_cptr vp0 = shm3 + LDS_V + ((lane >> 4) & 1) * 32 + (lane & 3) * 8 + (4 * hi + ((lane & 15) >> 2)) * 64;
    const LAS float* Flp = (const LAS float*)(shm3 + LDS_FL) + 4 * hi;
    const int NT = 4 * qb + 5;
    glds16(ksrcm, (unsigned)__builtin_amdgcn_readfirstlane(kdst)); glds16(vsrcm, (unsigned)__builtin_amdgcn_readfirstlane(vdst)); DMA_K(1, SLOTB);
    bf16x8v qr[4];
#pragma unroll
    for (int d0 = 0; d0 < 4; ++d0) qr[d0] = *reinterpret_cast<const bf16x8v*>(&Qw[(long)r32 * DMA + d0 * 16 + hi * 8]);
    float aq = ((const LAS float*)(shm3 + LDS_FL))[64 + q0 + wid * QBLK + r32];
    float l_reg = 0.f; f32x16 o[2]; o[0] = f32x16{}; o[1] = f32x16{};
    const int qrel = wid * QBLK + r32;
#define CMASK(P0, P1, t) do { int jb_ = (t) - (NT - 4); if (jb_ >= 0) cmask(P0, P1, jb_, qrel, hi); } while (0)
    bool resc = false;
#define START(P0, P1) do { const float rm = rowmax(P0, P1); resc = false; \
    { const float dl = rm; aq = fsub_s(aq, dl); \
      _Pragma("unroll") for (int r = 0; r < 16; ++r) { P0[r] = fsub_s(P0[r], dl); P1[r] = fsub_s(P1[r], dl); } } \
    _Pragma("unroll") for (int r = 0; r < 16; ++r) P0[r] = __builtin_amdgcn_exp2f(P0[r]); } while (0)
#define RESC() do { if (resc) { asm volatile("s_waitcnt lgkmcnt(0)" ::: "memory"); \
      _Pragma("unroll") for (int d_ = 0; d_ < 2; ++d_) _Pragma("unroll") for (int r = 0; r < 16; ++r) o[d_][r] *= wsf[crow(r, hi)]; } } while (0)
    f32x16 pA0, pA1, pB0, pB1;
    int sl_prev = 0, sl_cur = 0, sl_next = SLOTB;
#define ROT() do { sl_prev = sl_cur; sl_cur = sl_next; sl_next = (sl_next == (NSLOT - 1) * SLOTB) ? 0 : sl_next + SLOTB; } while (0)
    DMA_K(2, 2 * SLOTB);
    cinit(pA0, pA1, Flp, aq);
    WAIT_BAR(3);
    qkt(pA0, pA1, Kbase, qr, r32, hi); asm volatile("s_nop 15\n\ts_nop 7" : "+v"(pA0), "+v"(pA1));
    START(pA0, pA1);
    _Pragma("unroll") for (int r = 0; r < 16; ++r) pA1[r] = __builtin_amdgcn_exp2f(pA1[r]);
    WAIT_BAR(0);
    DMA_K(3, 0); DMA_V(1, SLOTB);
    ROT();
    kload8(kf, kp0 + sl_cur);
    WAIT_BAR(2);
    s16x4 vlo[8], vhi[8]; u32x4 pw0, pw1, pw2, pw3;
#define PKW(P, B) cvtpk_s(P[B], P[B + 1])
#define PAF(k) __builtin_bit_cast(bf16x8v, pw##k)
#define VFR(i) (bf16x8v){vlo[i][0], vlo[i][1], vlo[i][2], vlo[i][3], vhi[i][0], vhi[i][1], vhi[i][2], vhi[i][3]}
#define PIN(x) asm volatile("" : "+v"(x))
#define MX3(a, b, c) __builtin_fmaxf(__builtin_fmaxf((a), (b)), (c))
#define GAPA(MF, A0, A1, A2, A3, W0, W1, PW) do { MF; sacc += A0; sacc += A1; sacc += A2; sacc += A3; PIN(sacc); W0; W1; PIN(PW); SBAR(); } while (0)
#define EX(v) __builtin_amdgcn_exp2f(v)
#define GAPB(MF, X, B) do { MF; X[B] = EX(X[B]); X[B + 1] = EX(X[B + 1]); X[B + 2] = EX(X[B + 2]); X[B + 3] = EX(X[B + 3]); PIN(X); SBAR(); } while (0)
#define VRD(i) do { vlo[i] = vtr(vp_ + (((i) >> 2) * 4096 + ((i) & 3) * 1024)); vhi[i] = vtr(vp_ + (((i) >> 2) * 4096 + ((i) & 3) * 1024 + 512)); } while (0)
#define KRD(G, j) do { if (G) { kload2(kf, kp0 + sl_next, j); SBAR(); } } while (0)
#define STEP(C0, C1, P0, P1, t, GK, GV, GL) do { SBAR(); \
    cinit(C0, C1, Flp + 64 * (t), aq); SBAR(); \
    const lds_cptr vp_ = vp0 + sl_prev; \
    VRD(0); SBAR(); float sacc = (P0[0] + P0[1]); \
    GAPA(C0 = __builtin_amdgcn_mfma_f32_32x32x16_bf16(kf[0], qr[0], C0, 0, 0, 0), P0[2], P0[3], P0[4], P0[5],     pw0[0] = PKW(P0, 0), pw0[1] = PKW(P0, 2), pw0); \
    VRD(4); SBAR(); GAPA(C1 = __builtin_amdgcn_mfma_f32_32x32x16_bf16(kf[1], qr[0], C1, 0, 0, 0), P0[6], P0[7], P0[8], P0[9],     pw0[2] = PKW(P0, 4), pw0[3] = PKW(P0, 6), pw0); \
    VRD(1); SBAR(); GAPA(C0 = __builtin_amdgcn_mfma_f32_32x32x16_bf16(kf[2], qr[1], C0, 0, 0, 0),   P0[10], P0[11], P0[12], P0[13], pw1[0] = PKW(P0, 8), pw1[1] = PKW(P0, 10), pw1); \
    VRD(5); SBAR(); GAPA(C1 = __builtin_amdgcn_mfma_f32_32x32x16_bf16(kf[3], qr[1], C1, 0, 0, 0),   P0[14], P0[15], P1[0], P1[1],   pw1[2] = PKW(P0, 12), pw1[3] = PKW(P0, 14), pw1); \
    VRD(2); SBAR(); GAPA(C0 = __builtin_amdgcn_mfma_f32_32x32x16_bf16(kf[4], qr[2], C0, 0, 0, 0),   P1[2], P1[3], P1[4], P1[5],     pw2[0] = PKW(P1, 0), pw2[1] = PKW(P1, 2), pw2); \
    VRD(6); SBAR(); GAPA(C1 = __builtin_amdgcn_mfma_f32_32x32x16_bf16(kf[5], qr[2], C1, 0, 0, 0),   P1[6], P1[7], P1[8], P1[9],     pw2[2] = PKW(P1, 4), pw2[3] = PKW(P1, 6), pw2); \
    VRD(3); SBAR(); GAPA(C0 = __builtin_amdgcn_mfma_f32_32x32x16_bf16(kf[6], qr[3], C0, 0, 0, 0),   P1[10], P1[11], P1[12], P1[13], pw3[0] = PKW(P1, 8), pw3[1] = PKW(P1, 10), pw3); \
    VRD(7); SBAR(); GAPA(C1 = __builtin_amdgcn_mfma_f32_32x32x16_bf16(kf[7], qr[3], C1, 0, 0, 0),   P1[14], P1[15], 0.f, 0.f,       pw3[2] = PKW(P1, 12), pw3[3] = PKW(P1, 14), pw3); \
    l_reg += sacc; \
    if (GK) { DMA_K((t) + 3, sl_cur); } if (GV) { DMA_V((t) + 1, sl_next); } \
    CMASK(C0, C1, t); \
    { float a = MX3(C0[0], C0[1], C1[0]), b_ = MX3(C0[2], C0[3], C1[1]); a = MX3(a, C1[2], C1[3]); \
      _Pragma("unroll") for (int r = 4; r < 16; r += 4) { a = MX3(a, C0[r], C0[r + 1]); b_ = MX3(b_, C0[r + 2], C0[r + 3]); a = MX3(a, C1[r], C1[r + 1]); b_ = MX3(b_, C1[r + 2], C1[r + 3]); } \
      float rm = __builtin_fmaxf(a, b_); { auto rr = __builtin_amdgcn_permlane32_swap(__float_as_uint(rm), __float_as_uint(rm), false, false); rm = __builtin_fmaxf(__uint_as_float(rr[0]), __uint_as_float(rr[1])); } \
      resc = false; \
      if (__builtin_expect(__any(rm > (float)THRL), 0)) { const float dl = __builtin_fmaxf(rm, 0.f); aq -= dl; \
        _Pragma("unroll") for (int r = 0; r < 16; ++r) { C0[r] -= dl; C1[r] -= dl; } \
        const float f = __builtin_amdgcn_exp2f(-dl); l_reg *= f; if (hi == 0) wsf[r32] = f; resc = true; } } \
    SBAR(); \
    GAPB(o[0] = __builtin_amdgcn_mfma_f32_32x32x16_bf16(PAF(0), VFR(0), o[0], 0, 0, 0), C0, 0); \
    GAPB(o[1] = __builtin_amdgcn_mfma_f32_32x32x16_bf16(PAF(0), VFR(4), o[1], 0, 0, 0), C0, 4); \
    KRD(GL, 0); GAPB(o[0] = __builtin_amdgcn_mfma_f32_32x32x16_bf16(PAF(1), VFR(1), o[0], 0, 0, 0), C0, 8); \
    KRD(GL, 1); GAPB(o[1] = __builtin_amdgcn_mfma_f32_32x32x16_bf16(PAF(1), VFR(5), o[1], 0, 0, 0), C0, 12); \
    KRD(GL, 2); GAPB(o[0] = __builtin_amdgcn_mfma_f32_32x32x16_bf16(PAF(2), VFR(2), o[0], 0, 0, 0), C1, 0); \
    KRD(GL, 3); GAPB(o[1] = __builtin_amdgcn_mfma_f32_32x32x16_bf16(PAF(2), VFR(6), o[1], 0, 0, 0), C1, 4); \
    GAPB(o[0] = __builtin_amdgcn_mfma_f32_32x32x16_bf16(PAF(3), VFR(3), o[0], 0, 0, 0), C1, 8); \
    GAPB(o[1] = __builtin_amdgcn_mfma_f32_32x32x16_bf16(PAF(3), VFR(7), o[1], 0, 0, 0), C1, 12); \
    } while (0)
    int t = 1;
#undef CMASK
#define CMASK(P0, P1, t) do { } while (0)
    for (; t + 5 < NT; t += 2) {
        STEP(pB0, pB1, pA0, pA1, t, true, true, true);     WAIT_BAR(2); RESC(); ROT();
        STEP(pA0, pA1, pB0, pB1, t + 1, true, true, true); WAIT_BAR(2); RESC(); ROT();
    }
#undef CMASK
#define CMASK(P0, P1, t) do { int jb_ = (t) - (NT - 4); if (jb_ >= 0) cmask(P0, P1, jb_, qrel, hi); } while (0)
#define ENDW(tt) do { if ((tt) + 3 < NT) { WAIT_BAR(2); } else if ((tt) + 2 < NT) { WAIT_BAR(1); } else { WAIT_BAR(0); } } while (0)
    for (; t + 1 < NT; t += 2) {
        STEP(pB0, pB1, pA0, pA1, t, (t + 3 < NT), (t + 1 < NT), (t + 1 < NT));         ENDW(t);     RESC(); ROT();
        STEP(pA0, pA1, pB0, pB1, t + 1, (t + 4 < NT), (t + 2 < NT), (t + 2 < NT));     ENDW(t + 1); RESC(); ROT();
    }
    { float sacc = pA0[0] + pA0[1]; _Pragma("unroll") for (int r = 2; r < 16; ++r) sacc += pA0[r]; _Pragma("unroll") for (int r = 0; r < 16; ++r) sacc += pA1[r]; l_reg += sacc;
      pw0 = (u32x4){PKW(pA0, 0), PKW(pA0, 2), PKW(pA0, 4), PKW(pA0, 6)}; pw1 = (u32x4){PKW(pA0, 8), PKW(pA0, 10), PKW(pA0, 12), PKW(pA0, 14)}; pw2 = (u32x4){PKW(pA1, 0), PKW(pA1, 2), PKW(pA1, 4), PKW(pA1, 6)}; pw3 = (u32x4){PKW(pA1, 8), PKW(pA1, 10), PKW(pA1, 12), PKW(pA1, 14)};
      SBAR(); pv(o, vb0 + sl_prev, PAF(0), PAF(1), PAF(2), PAF(3)); }
#undef PKW
#undef PAF
#undef VFR
#undef PIN
#undef MX3
#undef GAPA
#undef GAPB
#undef EX
#undef VRD
#undef KRD
#undef STEP
#undef ENDW
    { auto rr = __builtin_amdgcn_permlane32_swap(__float_as_uint(l_reg), __float_as_uint(l_reg), false, false); l_reg = __uint_as_float(rr[0]) + __uint_as_float(rr[1]); }
    if (hi == 0) wsf[32 + r32] = l_reg; asm volatile("s_waitcnt lgkmcnt(0)" ::: "memory");
    float rli[16];
#pragma unroll
    for (int r = 0; r < 16; ++r) rli[r] = __builtin_amdgcn_rcpf(wsf[32 + crow(r, hi)]);
    bf16* Ow = O + (rowbase + q0 + wid * QBLK) * DMO + h * 64;
    { bf16* stg = (bf16*)(shm + LDS_OST) + wid * 2048;
#pragma unroll
      for (int r = 0; r < 16; ++r) { const int orow = crow(r, hi);
#pragma unroll
          for (int d0 = 0; d0 < 2; ++d0) stg[orow * 64 + d0 * 32 + r32] = (bf16)f2bf(o[d0][r] * rli[r]); }
      asm volatile("s_waitcnt lgkmcnt(0)" ::: "memory");
#pragma unroll
      for (int i = 0; i < 4; ++i) { const int row = i * 8 + (lane >> 3), ch = lane & 7; const u32x4 v = *(const u32x4*)(stg + row * 64 + ch * 8); *(u32x4*)(Ow + (long)row * DMO + ch * 8) = v; } }
    asm volatile("s_waitcnt lgkmcnt(0)\n\ts_barrier" ::: "memory");
#undef DMA_K
#undef DMA_V
#undef CMASK
#undef START
#undef RESC
#undef ROT
}
#undef SBAR
#undef WAIT_BAR
}
__device__ __forceinline__ void phase_B(Frame& F) {
    if (F.G == 256) {
        const int v = F.vcu, bh = v >> 3, s = v & 7, b = bh >> 3, h = bh & 7;
        attn_scan(F, b, h, false, fa::LDS_FL, fa::LDS_SCAN);
        { unsigned char* dol = DOP(); const bf16* Q = (const bf16*)(dol + DO_Q); const bf16* Kg = (const bf16*)(dol + DO_K); const bf16* Vg = (const bf16*)(dol + DO_V);
#pragma unroll 1
          for (int i = 0; i < 4; ++i) { const int qb = i == 0 ? s : (i == 1 ? 15 - s : (i == 2 ? 16 + s : 31 - s));
              fa::attn_unit<8>(b, h, qb, Q, Kg, Vg, (bf16*)(WSP() + WS_X3) + 512, (char*)F.lds, F.wave); } }
        if (v < 8) { attn_scan(F, 0, v, true, AT_FL, AT_SC); attn_unit_naive(F, TX, 0, 1, 0, v); }
    } else {
        int cur_bh = -1;
        for (int u = F.vcu; u < 1032; u += F.G) {
            if (u < 1024) { const int bh = u >> 5, qb = u & 31, b = bh >> 3, h = bh & 7; if (bh != cur_bh) { attn_scan(F, b, h, false, AT_FL, AT_SC); cur_bh = bh; }
                attn_unit_naive(F, b * SEQ + 256 * qb, NMETA + 256 * qb, 1 + 4 * (qb + 1), b * SEQ, h); }
            else { attn_scan(F, 0, u - 1024, true, AT_FL, AT_SC); cur_bh = -1; attn_unit_naive(F, TX, 0, 1, 0, u - 1024); }
        }
    }
    __syncthreads();
}

__device__ __forceinline__ void class_tables(Frame& F, int l) {
    LAS int* base = (LAS int*)(F.lds + LC_BASE); LAS int* pcls = (LAS int*)(F.lds + LC_PCLS); LAS int* np = (LAS int*)(F.lds + LC_NP);
    const unsigned* gcnt = (const unsigned*)(WSP() + WS_CTL) + CW_GCNT + l * 64;
    __syncthreads();
    if (F.tid == 0) { int p = 0;
#pragma unroll 1
        for (int c = 0; c < NCLS; ++c) { base[c] = p * 256; int n = (int)__hip_atomic_load(gcnt + c, __ATOMIC_RELAXED, __HIP_MEMORY_SCOPE_AGENT); if (n > TM) n = TM; if (n < 0) n = 0; p += (n + 255) >> 8; }
        if (p > 160) p = 160; base[NCLS] = p * 256; np[0] = p; }
    __syncthreads();
    if (F.tid < 160) { const int mypos = F.tid * 256; int c = 0;
#pragma unroll 1
        for (int k = 1; k < NCLS; ++k) if (base[k] <= mypos) c = k;
        pcls[F.tid] = c; }
    __syncthreads();
}
__device__ __forceinline__ void phase_E1(Frame& F, int l) {
    LAS float* R = (LAS float*)F.lds;
    LAS int* rec = (LAS int*)(F.lds + 81920);
    LAS int* lcnt = (LAS int*)(F.lds + LC_CNT); LAS int* wgb = (LAS int*)(F.lds + LC_BASE);
    const float* rg = (const float*)(WSP() + WS_RG); const float* H = (const float*)(WSP() + WS_H);
    const float* reb = INP(I_REB) + l * 16; const float* rgb = INP(I_RGB) + l * 4;
    unsigned* gcnt = (unsigned*)(WSP() + WS_CTL) + CW_GCNT + l * 64; int* route = (int*)(WSP() + WS_ROUTE);
    const int tid = F.tid, lane = F.lane, wave = F.wave;
    for (int i = tid; i < 5120; i += 512) *(LAS f32x4*)(R + 4 * i) = *(const f32x4*)(rg + 4 * i);
    for (int wg = F.vcu; wg < 256; wg += F.G) {
        if (tid < NCLS) lcnt[tid] = 0;
        __syncthreads();

#pragma unroll 1
for (int rr = wave; rr < 129; rr += 8) { const int row = wg * 129 + rr;
            f32x4 hv[4]; float ss = 0.f;
#pragma unroll
            for (int j = 0; j < 4; ++j) { hv[j] = *(const f32x4*)(H + (size_t)row * D + 4 * lane + 256 * j); ss += hv[j][0] * hv[j][0] + hv[j][1] * hv[j][1] + hv[j][2] * hv[j][2] + hv[j][3] * hv[j][3]; }
            const float rstd2 = rsqrtf(wave_sum(ss) * (1.0f / D) + EPS);
            float lg[20];
#pragma unroll
            for (int c = 0; c < 20; ++c) { float s = 0.f;
#pragma unroll
                for (int j = 0; j < 4; ++j) { const f32x4 w = *(const LAS f32x4*)(R + c * 1024 + 4 * lane + 256 * j); s += hv[j][0] * w[0] + hv[j][1] * w[1] + hv[j][2] * w[2] + hv[j][3] * w[3]; }
                lg[c] = wave_sum(s) * rstd2 + (c < 16 ? reb[c] : rgb[c - 16]); }
            int gsel = 0; float gmax = lg[16];
#pragma unroll
            for (int g = 1; g < 4; ++g) if (lg[16 + g] > gmax) { gmax = lg[16 + g]; gsel = g; }
            float gsum = 0.f;
#pragma unroll
            for (int g = 0; g < 4; ++g) gsum += __expf(lg[16 + g] - gmax);
            const float gwt = 1.0f / gsum;
            float el[4];
#pragma unroll
            for (int e = 0; e < 4; ++e) el[e] = gsel == 0 ? lg[e] : (gsel == 1 ? lg[4 + e] : (gsel == 2 ? lg[8 + e] : lg[12 + e]));
            int t1 = 0; float l1 = el[0];
#pragma unroll
            for (int e = 1; e < 4; ++e) if (el[e] > l1) { l1 = el[e]; t1 = e; }
            int t2 = -1; float l2 = -3.0e38f;
#pragma unroll
            for (int e = 0; e < 4; ++e) if (e != t1 && el[e] > l2) { l2 = el[e]; t2 = e; }
            const float w1 = 1.0f / (1.0f + __expf(l2 - l1)), w2 = 1.0f - w1;
            const int ea = min(t1, t2), eb = max(t1, t2); const float cA = gwt * (t1 == ea ? w1 : w2), cB = gwt * (t1 == ea ? w2 : w1);
            const int pr = ea == 0 ? eb - 1 : (ea == 1 ? eb + 1 : 5); int cls = gsel * 6 + pr; if (!(cls >= 0 && cls < NCLS)) cls = 0;
            if (lane == 0) { const int rank = __hip_atomic_fetch_add(&lcnt[cls], 1, __ATOMIC_RELAXED, __HIP_MEMORY_SCOPE_WORKGROUP); rec[rr * 5] = cls; rec[rr * 5 + 1] = rank; rec[rr * 5 + 2] = __float_as_int(cA); rec[rr * 5 + 3] = __float_as_int(cB); rec[rr * 5 + 4] = __float_as_int(rstd2); }
        }
        __syncthreads();
        if (tid < NCLS) { const int n = lcnt[tid]; wgb[tid] = n > 0 ? (int)atomicAdd(gcnt + tid, (unsigned)n) : 0; }
        __syncthreads();
        for (int rr = tid; rr < 129; rr += 512) { const int row = wg * 129 + rr; const int cls = rec[rr * 5];
            int* rp = route + (size_t)row * 8; rp[0] = cls; rp[1] = wgb[cls] + rec[rr * 5 + 1]; rp[2] = rec[rr * 5 + 2]; rp[3] = rec[rr * 5 + 3]; rp[4] = rec[rr * 5 + 4]; }
        __syncthreads();
    }
}
__device__ __forceinline__ void phase_E1b(Frame& F, int l) {
    class_tables(F, l);
    const LAS int* base = (const LAS int*)(F.lds + LC_BASE);
    const int* route = (const int*)(WSP() + WS_ROUTE); const bf16* HB = (const bf16*)(WSP() + WS_HB); bf16* XS = (bf16*)(WSP() + WS_XS); float* PW = (float*)(WSP() + WS_PW);
    const int gw = F.vcu * NWAVES + F.wave, NGW = F.G * NWAVES, lane = F.lane;

#pragma unroll 1
for (int row = gw; row < TM; row += NGW) { const int* rp = route + (size_t)row * 8; const int cls = rp[0]; const int pos = base[cls] + rp[1];
        if (pos < 0 || pos >= NPOSMAX) continue;
#pragma unroll
        for (int j = 0; j < 2; ++j) *(u32x4*)(XS + (size_t)pos * D + 8 * lane + 512 * j) = *(const u32x4*)(HB + (size_t)row * D + 8 * lane + 512 * j);
        if (lane == 0) { f32x4 w; w[0] = __int_as_float(rp[4]); w[1] = __int_as_float(rp[2]); w[2] = __int_as_float(rp[3]); w[3] = 0.f; *(f32x4*)(PW + (size_t)pos * 4) = w; } }
}
__device__ __forceinline__ void phase_E4(Frame& F, int l) {
    class_tables(F, l);
    const LAS int* base = (const LAS int*)(F.lds + LC_BASE);
    const int* route = (const int*)(WSP() + WS_ROUTE); float* H = (float*)(WSP() + WS_H); bf16* HB = (bf16*)(WSP() + WS_HB); const bf16* Y = (const bf16*)(WSP() + WS_Y);
    float* rstd1 = (float*)(WSP() + WS_RSTD1); const float* fg = INP(I_FG); float* out = (float*)DOP();
    const int gw = F.vcu * NWAVES + F.wave, NGW = F.G * NWAVES, lane = F.lane; const bool lastl = (l == DEPTH - 1);

#pragma unroll 1
for (int row = gw; row < TM; row += NGW) { const int* rp = route + (size_t)row * 8; const int cls = rp[0]; int pos = base[cls] + rp[1]; if (pos < 0 || pos >= NPOSMAX) pos = 0;
        f32x4 hv[2][2]; float ss = 0.f;
#pragma unroll
        for (int j = 0; j < 2; ++j) { const u32x4 yw = *(const u32x4*)(Y + (size_t)pos * D + 8 * lane + 512 * j);
            hv[j][0] = *(const f32x4*)(H + (size_t)row * D + 8 * lane + 512 * j); hv[j][1] = *(const f32x4*)(H + (size_t)row * D + 8 * lane + 512 * j + 4);
            hv[j][0][0] += bflo(yw.x); hv[j][0][1] += bfhi(yw.x); hv[j][0][2] += bflo(yw.y); hv[j][0][3] += bfhi(yw.y);
            hv[j][1][0] += bflo(yw.z); hv[j][1][1] += bfhi(yw.z); hv[j][1][2] += bflo(yw.w); hv[j][1][3] += bfhi(yw.w);
#pragma unroll
            for (int q = 0; q < 2; ++q) ss += hv[j][q][0] * hv[j][q][0] + hv[j][q][1] * hv[j][q][1] + hv[j][q][2] * hv[j][q][2] + hv[j][q][3] * hv[j][q][3]; }
        const float rs = rsqrtf(wave_sum(ss) * (1.0f / D) + EPS);
        if (!lastl) {
#pragma unroll
            for (int j = 0; j < 2; ++j) { *(f32x4*)(H + (size_t)row * D + 8 * lane + 512 * j) = hv[j][0]; *(f32x4*)(H + (size_t)row * D + 8 * lane + 512 * j + 4) = hv[j][1];
                *(u32x4*)(HB + (size_t)row * D + 8 * lane + 512 * j) = pack8(hv[j][0], hv[j][1]); }
            if (lane == 0) rstd1[row] = rs;
        } else if (row < TX) {
#pragma unroll
            for (int j = 0; j < 2; ++j) { const f32x4 g0 = *(const f32x4*)(fg + 8 * lane + 512 * j), g1 = *(const f32x4*)(fg + 8 * lane + 512 * j + 4);
                *(f32x4*)(out + (size_t)row * D + 8 * lane + 512 * j) = hv[j][0] * rs * g0; *(f32x4*)(out + (size_t)row * D + 8 * lane + 512 * j + 4) = hv[j][1] * rs * g1; }
        }
    }
}

#define RELANE() do { const int t_ = wv0 * 64 + lane_id_opaque(); F.tid = t_; F.lane = t_ & 63; F.wave = __builtin_amdgcn_readfirstlane(t_ >> 6); \
    int g_ = gridDim.x; LAUNDER_S(g_); int b_ = blockIdx.x; LAUNDER_S(b_); F.G = g_; F.bx = b_; F.vcu = (g_ % 8 == 0) ? (b_ % 8) * (g_ / 8) + b_ / 8 : b_; ll = l; LAUNDER_S(ll); } while (0)
__global__ void __launch_bounds__(NWAVES * 64, 2) fwd_kernel(Params P) {
    extern __shared__ __attribute__((aligned(16))) unsigned char lds_raw[];
    Frame F;
    F.lds = (LAS unsigned char*)lds_raw;
    F.tid = threadIdx.x; F.lane = F.tid & 63; F.wave = __builtin_amdgcn_readfirstlane(F.tid >> 6);
    F.G = gridDim.x; { const int bx = blockIdx.x; F.vcu = (F.G % 8 == 0) ? (bx % 8) * (F.G / 8) + bx / 8 : bx; }
    if (F.tid == 0) { LAS unsigned long long* pt = (LAS unsigned long long*)(F.lds + LC_PTAB);
#pragma unroll
        for (int i = 0; i < 25; ++i) pt[i] = (unsigned long long)P.in[i];
        pt[25] = (unsigned long long)P.ws; pt[26] = (unsigned long long)P.out; }
    for (int u = F.tid; u < 256; u += NWAVES * 64) ((LAS unsigned*)(F.lds + RING_BYTES))[u] = 0u;
    __syncthreads();
    const int lo = P.ph_lo, hi = P.ph_hi;
    const bool use_bar = (hi - lo) > 1;
    unsigned* barw = (unsigned*)(P.ws + WS_CTL) + CW_BAR;
    XcdBarrier bar; bar.bar = barw; bar.x = 0; bar.st = (volatile LAS unsigned*)(F.lds + LC_BAR);
    if (use_bar) bar = xcd_barrier_post(barw, (volatile LAS unsigned*)(F.lds + LC_BAR));
#ifndef PHASE_MASK
#define PHASE_MASK 0x7ff
#endif
#define EN(j) (((PHASE_MASK) >> (j)) & 1)
#ifndef DUP_MASK
#define DUP_MASK 0
#endif
#define NREP(j) ((((DUP_MASK) >> (j)) & 1) ? 2 : 1)
#define IN(k) (lo <= (k) && (k) < hi)
#define SEAM(k) do { if (IN(k) && IN((k) + 1)) xcd_barrier(bar); } while (0)

    int l = 0, ll = 0; const int wv0 = __builtin_amdgcn_readfirstlane((int)threadIdx.x >> 6);
    if (EN(0) && IN(0)) { RELANE(); convert_weights(F, 0); RELANE(); init_rows(F); }
    SEAM(0);
    for (l = 0; l < DEPTH; ++l) {
        const int pb = 1 + 10 * l;
        for (int rep = 0; rep < NREP(1); ++rep)
        if (EN(1) && IN(pb + 0)) {
            RELANE();
            unsigned char* wsl = WSP(); unsigned char* dol = DOP();
            pg8::Gemm g{(const bf16*)(wsl + WS_HB), 1024, 1024, 1 << 20};
            pg8::StaticOrder S; S.init(TM, N1, F.G, F.bx, (const bf16*)(wsl + WS_W1T), 1024);
            Epi1 E{(const float*)(wsl + WS_RSTD1), (bf16*)(wsl + WS_A), (bf16*)(wsl + WS_GLU), (bf16*)(dol + DO_Q), (bf16*)(wsl + WS_G)};
            pg8::gemm_phase<Epi1, pg8::StaticOrder>(F.lds, g, S, E, F.wave);
        }
        SEAM(pb + 0);
        for (int rep = 0; rep < NREP(2); ++rep)
        if (EN(2) && IN(pb + 1)) { RELANE(); phase_S(F, ll); }
        SEAM(pb + 1);
        if (EN(3) && IN(pb + 2)) { RELANE(); phase_B(F); }
        SEAM(pb + 2);
        for (int rep = 0; rep < NREP(4); ++rep)
        if (EN(4) && IN(pb + 3)) {
            RELANE(); unsigned char* wsl = WSP(); unsigned char* dol = DOP();
            pg8::Gemm g{(const bf16*)(wsl + WS_X3), 1024, 1024, 1 << 20}; pg8::SegOrder S; S.init(TM, 1024, F.G, F.bx, (const bf16*)(wsl + WS_W3CT), 1024);
            EpiCS E{(const bf16*)(wsl + WS_G), (bf16*)(dol + DO_MERGED), (const float*)(wsl + WS_BIASA)}; pg8::gemm_phase<EpiCS, pg8::SegOrder>(F.lds, g, S, E, F.wave);
        }
        SEAM(pb + 3);
        if (EN(5) && IN(pb + 4)) {
            RELANE();
            unsigned char* wsl = WSP(); unsigned char* dol = DOP();
            pg8::Gemm g{(const bf16*)(dol + DO_MERGED), 1024, 1024, 1 << 20}; pg8::StaticOrder S; S.init(TM, 1024, F.G, F.bx, (const bf16*)(wsl + WS_WOT), 1024);
            EpiD E{(float*)(wsl + WS_H), (bf16*)(wsl + WS_HB)}; pg8::gemm_phase<EpiD, pg8::StaticOrder>(F.lds, g, S, E, F.wave);
        }
        SEAM(pb + 4);
        if (EN(6) && IN(pb + 5)) { RELANE(); phase_E1(F, ll); }
        SEAM(pb + 5);
        for (int rep = 0; rep < NREP(7); ++rep)
        if (EN(7) && IN(pb + 6)) { RELANE(); phase_E1b(F, ll); }
        SEAM(pb + 6);
        for (int rep = 0; rep < NREP(8); ++rep)
        if (EN(8) && IN(pb + 7)) {
            RELANE(); class_tables(F, ll);
            unsigned char* wsl = WSP();
            const int NP = __builtin_amdgcn_readfirstlane(*(const LAS int*)(F.lds + LC_NP));
            pg8::Gemm g{(const bf16*)(wsl + WS_XS), 1024, 1024, 1 << 20};
            MoeOrder S{NP, F.G, F.vcu, 0, (const LAS int*)(F.lds + LC_PCLS), (const bf16*)(DOP() + DO_W13T)};
            EpiA2 E{(const float*)(wsl + WS_PW), (bf16*)(wsl + WS_HH)}; pg8::gemm_phase<EpiA2, MoeOrder>(F.lds, g, S, E, F.wave);
        }
        SEAM(pb + 7);
        for (int rep = 0; rep < NREP(9); ++rep)
        if (EN(9) && IN(pb + 8)) {
            RELANE(); class_tables(F, ll);
            unsigned char* wsl = WSP();
            const int NP = __builtin_amdgcn_readfirstlane(*(const LAS int*)(F.lds + LC_NP));
            pg8::Gemm g{(const bf16*)(wsl + WS_HH), 512, 256, 4};
            MoeOrder S{NP, F.G, F.vcu, 1, (const LAS int*)(F.lds + LC_PCLS), (const bf16*)(DOP() + DO_W2T)};
            EpiB2 E{(bf16*)(wsl + WS_Y)}; pg8::gemm_phase<EpiB2, MoeOrder>(F.lds, g, S, E, F.wave);
        }
        SEAM(pb + 8);
        if (EN(10) && IN(pb + 9)) { RELANE(); phase_E4(F, ll); if (l + 1 < DEPTH) { RELANE(); convert_weights(F, ll + 1); } }
        SEAM(pb + 9);
    }
#undef IN
#undef SEAM
}

constexpr int N_PHASES = 1 + 10 * DEPTH;

extern "C" void kernel_launch(void* const* d_in, const int* in_sizes, int n_in, void* d_out, int out_size, void* d_ws, size_t ws_size, hipStream_t stream) {
    static int grid = 0;
    if (grid == 0) {
        if (n_in != 25 || out_size != TX * D || ws_size < WS_END) { fprintf(stderr, "kernel_launch: unexpected shapes: n_in %d out %d ws %zu (need %zu)\n", n_in, out_size, ws_size, (size_t)WS_END); grid = -1; return; }
        int dev = 0, cus = 0, per_cu = 0;
        if (hipGetDevice(&dev) != hipSuccess || hipDeviceGetAttribute(&cus, hipDeviceAttributeMultiprocessorCount, dev) != hipSuccess) { grid = -1; return; }
        if (hipFuncSetAttribute((const void*)fwd_kernel, hipFuncAttributeMaxDynamicSharedMemorySize, LDS_BYTES) != hipSuccess) { fprintf(stderr, "kernel_launch: hipFuncSetAttribute failed\n"); grid = -1; return; }
        if (hipOccupancyMaxActiveBlocksPerMultiprocessor(&per_cu, (const void*)fwd_kernel, NWAVES * 64, LDS_BYTES) != hipSuccess || per_cu < 1) fprintf(stderr, "kernel_launch: occupancy query reports %d\n", per_cu);
        (void)hipGetLastError();
        grid = cus;
    }
    if (grid < 0) return;
    (void)hipMemsetAsync((char*)d_ws + WS_CTL, 0, CTL_BYTES, stream);
    Params p{};
    for (int i = 0; i < 25; ++i) p.in[i] = (const float*)d_in[i];
    p.out = (float*)d_out; p.ws = (unsigned char*)d_ws;
#if N_LAUNCH_MODE == 1
    p.ph_lo = 0; p.ph_hi = N_PHASES;
    hipLaunchKernelGGL(fwd_kernel, dim3(grid), dim3(NWAVES * 64), LDS_BYTES, stream, p);
#else
    for (int ph = 0; ph < N_PHASES; ++ph) { p.ph_lo = ph; p.ph_hi = ph + 1; hipLaunchKernelGGL(fwd_kernel, dim3(grid), dim3(NWAVES * 64), LDS_BYTES, stream, p); }
#endif
}
```

```cpp
#include <hip/hip_runtime.h>
#include <cstdio>
#include <cstdint>

#ifndef N_LAUNCH_MODE
#define N_LAUNCH_MODE 1
#endif

#define GAS __attribute__((address_space(1)))
#define LAS __attribute__((address_space(3)))
typedef unsigned short bf16;
typedef float f32x4 __attribute__((ext_vector_type(4)));
typedef float f32x2 __attribute__((ext_vector_type(2)));
typedef unsigned u32x4 __attribute__((ext_vector_type(4)));
typedef unsigned u32x2 __attribute__((ext_vector_type(2)));
typedef short bf16x8 __attribute__((ext_vector_type(8)));
typedef __bf16 bf16x2v __attribute__((ext_vector_type(2)));

constexpr int D = 1024, NB = 4, SEQ = 8192, NMETA = 16, DEPTH = 2;
constexpr int TX = NB * SEQ;
constexpr int TM = TX + 256;
constexpr int NIN = 5384, N1 = 5376;
constexpr int NHEAD = 8;
constexpr int NCLS = 24;
constexpr int NPOSMAX = TM + NCLS * 256;
constexpr float EPS = 1e-6f;
constexpr float LOG2E = 1.4426950408889634f;
constexpr float C2 = 0.125f * LOG2E;
constexpr int NWAVES = 8;

constexpr size_t U = (size_t)TM * 1024 * 2;
constexpr size_t WS_CTL = 0, CTL_BYTES = 1u << 20;
constexpr size_t WS_H = CTL_BYTES;
constexpr size_t WS_HB = WS_H + 2 * U;
constexpr size_t WS_G = WS_HB + U;
constexpr size_t WS_XS = WS_G;
constexpr size_t WS_Y = WS_XS + (size_t)NPOSMAX * 2048;
constexpr size_t WS_HH = WS_Y + (size_t)NPOSMAX * 2048;
static_assert(WS_HH + (size_t)NPOSMAX * 1024 <= WS_G + 3 * U, "MoE overlay fits the gates region");
constexpr size_t WS_A = WS_G + 3 * U;
constexpr size_t WS_GLU = WS_A + U / 4;
constexpr size_t WS_X3 = WS_GLU + U / 4;
constexpr size_t WS_W1T = WS_X3 + U;
constexpr size_t WS_W3CT = WS_W1T + (size_t)N1 * 1024 * 2;
constexpr size_t WS_WOT = WS_W3CT + 1024 * 1024 * 2;
constexpr size_t WS_WFG = WS_WOT + 1024 * 1024 * 2;
constexpr size_t WS_RG = WS_WFG + 8 * 1024 * 4;
constexpr size_t WS_BIASA = WS_RG + 20 * 1024 * 4;
constexpr size_t WS_RSTD1 = WS_BIASA + 4096;
constexpr size_t WS_ROUTE = WS_RSTD1 + (size_t)TM * 4;
constexpr size_t WS_PW = WS_ROUTE + (size_t)TM * 32;
constexpr size_t WS_LFT = WS_PW + (size_t)NPOSMAX * 16;
constexpr size_t WS_LFTM = WS_LFT + (size_t)32 * 8192 * 4;
constexpr size_t WS_END = WS_LFTM + 8 * 256 * 4;
static_assert(WS_END <= (size_t)512 * 1024 * 1024, "d_ws map fits 512 MiB");
constexpr size_t DO_Q = 0, DO_K = U / 2, DO_V = U, DO_MERGED = U / 2;
constexpr size_t DO_W13T = 3 * U / 2;
constexpr size_t DO_W2T = DO_W13T + (size_t)16 * 512 * 1024 * 2;
static_assert(DO_W2T + (size_t)16 * 1024 * 256 * 2 <= (size_t)TX * 1024 * 4, "d_out scratch");
constexpr int CW_BAR = 4096, CW_GCNT = 16384;

constexpr int RING_BYTES = 131072;
constexpr int LC_BAR = RING_BYTES, LC_CNT = RING_BYTES + 64, LC_BASE = RING_BYTES + 192, LC_PCLS = RING_BYTES + 320, LC_NP = RING_BYTES + 960;
constexpr int LC_PTAB = RING_BYTES + 1024;
constexpr int LDS_BYTES = RING_BYTES + 1024 + 7168;

#define LDS_WAIT() asm volatile("s_waitcnt lgkmcnt(0)" ::: "memory")
#define VM_WAIT() asm volatile("s_waitcnt vmcnt(0)" ::: "memory")
#define LAUNDER_S(p) asm volatile("" : "+s"(p))
#define LAUNDER_V(x) asm volatile("" : "+v"(x))
__device__ __forceinline__ int lane_id_opaque() { int x; asm volatile("v_mbcnt_lo_u32_b32 %0, -1, 0\n\tv_mbcnt_hi_u32_b32 %0, -1, %0" : "=v"(x)); return x; }

__device__ __forceinline__ unsigned f2bf(float f) { unsigned u = __builtin_bit_cast(unsigned, f); return (u + 0x7fffu + ((u >> 16) & 1u)) >> 16; }
__device__ __forceinline__ unsigned pk2(float lo, float hi) { f32x2 v = {lo, hi}; bf16x2v b = __builtin_convertvector(v, bf16x2v); return __builtin_bit_cast(unsigned, b); }
__device__ __forceinline__ float bflo(unsigned w) { return __builtin_bit_cast(float, w << 16); }
__device__ __forceinline__ float bfhi(unsigned w) { return __builtin_bit_cast(float, w & 0xffff0000u); }
template <int O> __device__ __forceinline__ float lane_xor(float v) {
    if constexpr (O < 32) return __int_as_float(__builtin_amdgcn_ds_swizzle(__float_as_int(v), (O << 10) | 0x1f));
    else { auto rr = __builtin_amdgcn_permlane32_swap(__float_as_uint(v), __float_as_uint(v), false, false); return __uint_as_float(rr[0]) + __uint_as_float(rr[1]) - v; }
}
__device__ __forceinline__ float wave_sum(float v) {
    v += lane_xor<1>(v); v += lane_xor<2>(v); v += lane_xor<4>(v); v += lane_xor<8>(v); v += lane_xor<16>(v);
    auto rr = __builtin_amdgcn_permlane32_swap(__float_as_uint(v), __float_as_uint(v), false, false);
    return __uint_as_float(rr[0]) + __uint_as_float(rr[1]);
}
__device__ __forceinline__ float sigmoidf_(float x) { return __builtin_amdgcn_rcpf(1.0f + __builtin_amdgcn_exp2f(-LOG2E * x)); }
__device__ __forceinline__ float dot2bf(unsigned a, unsigned b, float acc) { return __builtin_amdgcn_fdot2_f32_bf16(__builtin_bit_cast(bf16x2v, a), __builtin_bit_cast(bf16x2v, b), acc, false); }

namespace pg8 {
constexpr int BM = 256, BK = 64, HALF = 128, HTB = HALF * BK * 2, STAGE_BYTES = 8 * HTB, NXCD = 8, WGM = 8;
__host__ __device__ __forceinline__ int lds_byte(int r, int c) { const int st = (r >> 4) * 2 + (c >> 5), rr = r & 15, cc = c & 31, ob = rr * 64 + cc * 2; return st * 1024 + (ob ^ (((ob >> 9) & 1) << 5)); }
__host__ __device__ __forceinline__ void stage_rc(int b, int& R, int& C) { const int st = b / 1024, sb = b % 1024, swz = sb ^ (((sb >> 9) & 1) << 5); R = (st >> 1) * 16 + swz / 64; C = (st & 1) * 32 + (swz % 64) / 2; }
__host__ __device__ __forceinline__ int perm32(int rho) { const int n = rho >> 4, i = rho & 15; return 8 * (i >> 2) + 4 * n + (i & 3); }

struct Unit { int pm, pn, seg; };
struct Gemm { const bf16* A; int K; int ldb; int ksplit; };

struct StaticOrder {
    int nM, nN, nwg, G, c; const bf16* Bt; size_t btile;
    __device__ void init(int M, int N, int G_, int c_, const bf16* Bt_, int ldb) { nM = M / BM; nN = N / BM; nwg = nM * nN; G = G_; c = c_; Bt = Bt_; btile = (size_t)BM * ldb * 2; }
    __device__ bool next(int i, Unit& u) const {
        const long L = (long)i * G + c; if (L >= nwg) return false;
        int wgid = (int)L; { const int q = nwg / NXCD, r = nwg % NXCD, xcd = wgid % NXCD, off = wgid / NXCD; wgid = (xcd < r ? xcd * (q + 1) : r * (q + 1) + (xcd - r) * q) + off; }
        const int nig = WGM * nN, gid = wgid / nig, fm = gid * WGM, gsz = (nM - fm) < WGM ? (nM - fm) : WGM;
        u.pm = fm + ((wgid % nig) % gsz); u.pn = (wgid % nig) / gsz; u.seg = 0; return true;
    }
    __device__ __forceinline__ const char* bptr(const Unit& u, int) const { return (const char*)Bt + (size_t)u.pn * btile; }
    __device__ __forceinline__ int nt(const Unit&, int ntd) const { return ntd; }
    __device__ __forceinline__ size_t aoff(const Unit&) const { return 0; }
};
struct SegOrder : StaticOrder {
    __device__ bool next(int i, Unit& u) const { const int q = i / 3; if (!StaticOrder::next(q, u)) return false; u.seg = i - 3 * q; return true; }
    __device__ __forceinline__ size_t koff(const Unit& u) const { return u.seg == 0 ? 0 : (u.seg == 1 ? 512 : 1024); }
    __device__ __forceinline__ const char* bptr(const Unit& u, int) const { return (const char*)Bt + (size_t)u.pn * btile + koff(u); }
    __device__ __forceinline__ int nt(const Unit& u, int) const { return u.seg == 2 ? 8 : 4; }
    __device__ __forceinline__ size_t aoff(const Unit& u) const { return koff(u); }
};

template <class Epi, class Sched, bool ALIGN_EPI = true, bool SP2 = true>
__device__ __forceinline__ void gemm_phase(LAS unsigned char* lds, const Gemm g, const Sched& S, const Epi& E, const int wave_id) {
    const int tid = wave_id * 64 + lane_id_opaque();
    const int wid = __builtin_amdgcn_readfirstlane(tid >> 6), lane = tid & 63, wr = wid >> 2, wc = wid & 3, fr = lane & 15, fq = lane >> 4;
    const int K = g.K, nt = K / BK, ldb = g.ldb, ks = g.ksplit;
    unsigned voffA[2], voffB[2];
#pragma unroll
    for (int i = 0; i < 2; ++i) { int R, C; stage_rc(tid * 16 + i * 8192, R, C); const int Rb = Epi::PERM ? ((R & ~31) + perm32(R & 31)) : R;
        voffA[i] = (unsigned)(R * K + C) * 2u; voffB[i] = (unsigned)(Rb * ldb + C) * 2u; }
    const size_t kstep = (size_t)(BK * 2);
    const size_t hstep = (size_t)HALF * K * 2;
    const size_t hstepB = (size_t)HALF * ldb * 2;
    const size_t tstep = 2 * hstep;
    const unsigned ldsw = (unsigned)wid * 1024u;
    const int aoff = lds_byte(wr * 64 + fr, fq * 8), boff = lds_byte(wc * 32 + fr, fq * 8);
#define PG8_SA(b, h) (((b) * 2 + (h)) * HTB)
#define PG8_SB(b, h) ((4 + (b) * 2 + (h)) * HTB)
#define PG8_STAGE(bufoff, gbase, voff) do { _Pragma("unroll") for (int _i = 0; _i < 2; ++_i) \
        __builtin_amdgcn_global_load_lds((const unsigned*)((const char*)(gbase) + (voff)[_i]), (LAS unsigned*)(lds + (bufoff) + ldsw + _i * 8192), 16, 0, 0); } while (0)
#define PG8_LDA(dst, b, h) do { _Pragma("unroll") for (int m = 0; m < 4; ++m) _Pragma("unroll") for (int k = 0; k < 2; ++k) dst[m][k] = *(const LAS bf16x8*)(lds + PG8_SA(b, h) + aoff + m * 2048 + k * 1024); } while (0)
#define PG8_LDB(dst, b, h) do { _Pragma("unroll") for (int n = 0; n < 2; ++n) _Pragma("unroll") for (int k = 0; k < 2; ++k) dst[n][k] = *(const LAS bf16x8*)(lds + PG8_SB(b, h) + boff + n * 2048 + k * 1024); } while (0)
#define PG8_MMA(ai, bj, At, Bt) do { __builtin_amdgcn_s_setprio(1); _Pragma("unroll") for (int m = 0; m < 4; ++m) _Pragma("unroll") for (int n = 0; n < 2; ++n) _Pragma("unroll") for (int k = 0; k < 2; ++k) \
        acc[ai][bj][m][n] = __builtin_amdgcn_mfma_f32_16x16x32_bf16(Bt[n][k], At[m][k], acc[ai][bj][m][n], 0, 0, 0); __builtin_amdgcn_s_setprio(0); } while (0)
#define PG8_WAIT_V(n) asm volatile("s_waitcnt vmcnt(" #n ")" ::: "memory")
#define PG8_WAIT_L(n) asm volatile("s_waitcnt lgkmcnt(" #n ")" ::: "memory")
#define PG8_BAR __builtin_amdgcn_s_barrier()
#define PG8_SCHED __builtin_amdgcn_sched_barrier(0)
    Unit cur, nxt; int ui = 0;
    if (!S.next(0, cur)) return;
    f32x4 acc[2][2][4][2];
    { float z_ = 0.f; LAUNDER_V(z_);
#pragma unroll
    for (int a = 0; a < 2; ++a)
#pragma unroll
        for (int b = 0; b < 2; ++b)
#pragma unroll
            for (int m = 0; m < 4; ++m)
#pragma unroll
                for (int n = 0; n < 2; ++n) acc[a][b][m][n] = (f32x4){z_, z_, z_, z_}; }
    bf16x8 At[4][2], B0[2][2], B1[2][2];
    int ntc = S.nt(cur, nt);
    const char* cA = (const char*)g.A + (size_t)cur.pm * tstep + S.aoff(cur); const char* cB = S.bptr(cur, 0); const char* cB1 = S.bptr(cur, 1) - (size_t)ks * kstep;
    if constexpr (SP2) {
        PG8_STAGE(PG8_SB(0, 0), cB, voffB); PG8_STAGE(PG8_SB(0, 1), cB + hstepB, voffB); PG8_STAGE(PG8_SA(0, 0), cA, voffA); PG8_STAGE(PG8_SA(0, 1), cA + hstep, voffA);
        if (wr == 1) PG8_BAR;
        PG8_WAIT_V(2); PG8_BAR;
        PG8_STAGE(PG8_SB(1, 0), cB + kstep, voffB); PG8_STAGE(PG8_SA(1, 0), cA + kstep, voffA); PG8_STAGE(PG8_SB(1, 1), cB + hstepB + kstep, voffB);
        PG8_WAIT_V(6); PG8_BAR;
    } else {
        PG8_STAGE(PG8_SB(0, 0), cB, voffB); PG8_STAGE(PG8_SA(0, 0), cA, voffA); PG8_STAGE(PG8_SB(0, 1), cB + hstepB, voffB); PG8_STAGE(PG8_SA(0, 1), cA + hstep, voffA);
        if (wr == 1) PG8_BAR;
        PG8_WAIT_V(4); PG8_BAR;
        PG8_STAGE(PG8_SB(1, 0), cB + kstep, voffB); PG8_STAGE(PG8_SA(1, 0), cA + kstep, voffA); PG8_STAGE(PG8_SB(1, 1), cB + hstepB + kstep, voffB);
        PG8_WAIT_V(6); PG8_BAR;
    }
    for (;;) {
        const bool has_next = S.next(ui + 1, nxt);
        const char* nA = has_next ? (const char*)g.A + (size_t)nxt.pm * tstep + S.aoff(nxt) : cA; const char* nB = has_next ? S.bptr(nxt, 0) : cB;
        const char* nB1 = has_next ? S.bptr(nxt, 1) - (size_t)ks * kstep : cB1;
#pragma unroll 1
        for (int t = 0; t < ntc; t += 2) {
            const bool last = (t == ntc - 2);
            const char* a1 = cA + (size_t)(t + 1) * kstep;
            const char* bside = (t + 2 < ks) ? cB : cB1;
            const char* a2 = last ? nA : cA + (size_t)(t + 2) * kstep; const char* b2 = last ? nB : bside + (size_t)(t + 2) * kstep;
            const char* a3 = a2 + kstep; const char* b3 = b2 + kstep;
            if constexpr (SP2) {
            PG8_LDB(B0, 0, 0); PG8_LDB(B1, 0, 1); PG8_SCHED; PG8_LDA(At, 0, 0); PG8_STAGE(PG8_SA(1, 1), a1 + hstep, voffA);
            PG8_WAIT_V(8); PG8_WAIT_L(0); PG8_BAR; PG8_MMA(0, 0, At, B0); PG8_MMA(0, 1, At, B1); PG8_BAR; PG8_SCHED;
            PG8_LDA(At, 0, 1); PG8_STAGE(PG8_SB(0, 0), b2, voffB); PG8_STAGE(PG8_SB(0, 1), b2 + hstepB, voffB); PG8_STAGE(PG8_SA(0, 0), a2, voffA);
            PG8_WAIT_V(8); PG8_WAIT_L(0); PG8_BAR; PG8_MMA(1, 0, At, B0); PG8_MMA(1, 1, At, B1); PG8_BAR; PG8_SCHED;
            PG8_LDB(B0, 1, 0); PG8_LDB(B1, 1, 1); PG8_SCHED; PG8_LDA(At, 1, 0); PG8_STAGE(PG8_SA(0, 1), a2 + hstep, voffA);
            PG8_WAIT_V(8); PG8_WAIT_L(0); PG8_BAR; PG8_MMA(0, 0, At, B0); PG8_MMA(0, 1, At, B1); PG8_BAR; PG8_SCHED;
            PG8_LDA(At, 1, 1); PG8_STAGE(PG8_SB(1, 0), b3, voffB); PG8_STAGE(PG8_SB(1, 1), b3 + hstepB, voffB); PG8_STAGE(PG8_SA(1, 0), a3, voffA);
            PG8_WAIT_V(8); PG8_WAIT_L(0); PG8_BAR; PG8_MMA(1, 0, At, B0); PG8_MMA(1, 1, At, B1); PG8_BAR; PG8_SCHED;
            } else {
            PG8_LDB(B0, 0, 0); PG8_SCHED; PG8_LDA(At, 0, 0); PG8_STAGE(PG8_SA(1, 1), a1 + hstep, voffA);
            PG8_WAIT_L(8); PG8_BAR; PG8_WAIT_L(0); PG8_MMA(0, 0, At, B0); PG8_BAR; PG8_SCHED;
            PG8_LDB(B1, 0, 1); PG8_STAGE(PG8_SB(0, 0), b2, voffB);
            PG8_BAR; PG8_WAIT_L(0); PG8_MMA(0, 1, At, B1); PG8_BAR;
            PG8_LDA(At, 0, 1); PG8_STAGE(PG8_SA(0, 0), a2, voffA);
            PG8_BAR; PG8_WAIT_L(0); PG8_MMA(1, 0, At, B0); PG8_BAR; PG8_SCHED;
            PG8_STAGE(PG8_SB(0, 1), b2 + hstepB, voffB);
            PG8_WAIT_V(6); PG8_BAR; PG8_MMA(1, 1, At, B1); PG8_BAR;
            PG8_LDB(B0, 1, 0); PG8_SCHED; PG8_LDA(At, 1, 0); PG8_STAGE(PG8_SA(0, 1), a2 + hstep, voffA);
            PG8_WAIT_L(8); PG8_BAR; PG8_WAIT_L(0); PG8_MMA(0, 0, At, B0); PG8_BAR; PG8_SCHED;
            PG8_LDB(B1, 1, 1); PG8_STAGE(PG8_SB(1, 0), b3, voffB);
            PG8_BAR; PG8_WAIT_L(0); PG8_MMA(0, 1, At, B1); PG8_BAR;
            PG8_LDA(At, 1, 1); PG8_STAGE(PG8_SA(1, 0), a3, voffA);
            PG8_BAR; PG8_WAIT_L(0); PG8_MMA(1, 0, At, B0); PG8_BAR; PG8_SCHED;
            PG8_STAGE(PG8_SB(1, 1), b3 + hstepB, voffB);
            PG8_WAIT_V(6); PG8_BAR; PG8_MMA(1, 1, At, B1); PG8_BAR;
            }
        }
        if constexpr (ALIGN_EPI) { if (wr == 0) PG8_BAR; }
        { const int l2 = lane_id_opaque(); E(acc, cur, wr, wc, l2 & 15, l2 >> 4); }
        if (!has_next) break;
        if (!E.keep(cur)) { float z_ = 0.f; LAUNDER_V(z_);
#pragma unroll
        for (int a = 0; a < 2; ++a)
#pragma unroll
            for (int b = 0; b < 2; ++b)
#pragma unroll
                for (int m = 0; m < 4; ++m)
#pragma unroll
                    for (int n = 0; n < 2; ++n) acc[a][b][m][n] = (f32x4){z_, z_, z_, z_}; }
        cur = nxt; cA = nA; cB = nB; cB1 = nB1; ++ui; ntc = S.nt(cur, nt);
        if constexpr (ALIGN_EPI) { if (wr == 1) PG8_BAR; }
    }
    PG8_WAIT_V(0);
    if constexpr (!ALIGN_EPI) { if (wr == 0) PG8_BAR; }
    PG8_BAR;
#undef PG8_SA
#undef PG8_SB
#undef PG8_STAGE
#undef PG8_LDA
#undef PG8_LDB
#undef PG8_MMA
#undef PG8_WAIT_V
#undef PG8_WAIT_L
#undef PG8_BAR
#undef PG8_SCHED
}
}

typedef f32x4 AccT[2][2][4][2];
__device__ __forceinline__ u32x4 pack8(const f32x4 a, const f32x4 b) { u32x4 w; w.x = pk2(a[0], a[1]); w.y = pk2(a[2], a[3]); w.z = pk2(b[0], b[1]); w.w = pk2(b[2], b[3]); return w; }

struct Epi1 {
    static constexpr bool PERM = true;
    __device__ __forceinline__ bool keep(const pg8::Unit&) const { return false; }
    const float* rstd; bf16* A; bf16* GLU; bf16* QKV; bf16* G;
    __device__ __forceinline__ void operator()(AccT& acc, const pg8::Unit& u, int wr, int wc, int fr, int fq) const {
        const int row0 = u.pm * 256 + wr * 64 + fr, lc0 = wc * 32 + 8 * fq, pn = u.pn;
#pragma unroll
        for (int ai = 0; ai < 2; ++ai)
#pragma unroll
            for (int m = 0; m < 4; ++m) {
                const int row = row0 + ai * 128 + m * 16; const float rs = rstd[row];
                f32x4 v[2][2];
#pragma unroll
                for (int bj = 0; bj < 2; ++bj)
#pragma unroll
                    for (int n = 0; n < 2; ++n) v[bj][n] = acc[ai][bj][m][n] * rs;
                if (pn == 0) {
#pragma unroll
                    for (int bj = 0; bj < 2; ++bj) *(u32x4*)(A + (size_t)row * 256 + bj * 128 + lc0) = pack8(v[bj][0], v[bj][1]);
                } else if (pn <= 2) {
                    f32x4 o[2];
#pragma unroll
                    for (int n = 0; n < 2; ++n)
#pragma unroll
                        for (int j = 0; j < 4; ++j) o[n][j] = v[0][n][j] * sigmoidf_(v[1][n][j]);
                    *(u32x4*)(GLU + (size_t)row * 256 + (pn - 1) * 128 + lc0) = pack8(o[0], o[1]);
                } else if (pn <= 8) {
                    const int t = (pn - 3) >> 1; bf16* base = QKV + (size_t)t * (U / 4); const float sc = t == 0 ? C2 : 1.0f;
#pragma unroll
                    for (int bj = 0; bj < 2; ++bj) *(u32x4*)(base + (size_t)row * 512 + ((pn - 3) & 1) * 256 + bj * 128 + lc0) = pack8(v[bj][0] * sc, v[bj][1] * sc);
                } else {
#pragma unroll
                    for (int bj = 0; bj < 2; ++bj) { f32x4 o[2];
#pragma unroll
                        for (int n = 0; n < 2; ++n)
#pragma unroll
                            for (int j = 0; j < 4; ++j) o[n][j] = fmaxf(sigmoidf_(v[bj][n][j]), 1e-30f);
                        *(u32x4*)(G + (size_t)row * 3072 + (pn - 9) * 256 + bj * 128 + lc0) = pack8(o[0], o[1]); }
                }
            }
    }
};
struct EpiCS {
    static constexpr bool PERM = true;
    const bf16* G; bf16* Mg; const float* bias;
    __device__ __forceinline__ bool keep(const pg8::Unit& u) const { return u.seg != 2; }
    __device__ __forceinline__ void operator()(AccT& acc, const pg8::Unit& u, int wr, int wc, int fr, int fq) const {
        const int row0 = u.pm * 256 + wr * 64 + fr, col0 = u.pn * 256 + wc * 32 + 8 * fq;
        const bool lastseg = u.seg == 2; const int w = u.seg, wd = lastseg ? 2 : u.seg + 1; const float bsc = u.seg == 0 ? 1.f : 0.f;
        f32x4 bv[2][2];
#pragma unroll
        for (int bj = 0; bj < 2; ++bj) { bv[bj][0] = *(const f32x4*)(bias + col0 + bj * 128) * bsc; bv[bj][1] = *(const f32x4*)(bias + col0 + bj * 128 + 4) * bsc; }
#pragma unroll
        for (int ai = 0; ai < 2; ++ai) {
            u32x4 gn[4][2], gd[4][2];
#pragma unroll
            for (int m = 0; m < 4; ++m) { const bf16* gp = G + (size_t)(row0 + ai * 128 + m * 16) * 3072 + col0;
#pragma unroll
                for (int bj = 0; bj < 2; ++bj) { gn[m][bj] = *(const u32x4*)(gp + w * 1024 + bj * 128); gd[m][bj] = *(const u32x4*)(gp + wd * 1024 + bj * 128); } }
#pragma unroll
            for (int m = 0; m < 4; ++m) { const int row = row0 + ai * 128 + m * 16;
#pragma unroll
                for (int bj = 0; bj < 2; ++bj) {
                    const u32x4 n4 = gn[m][bj], d4 = gd[m][bj];
                    f32x4 a0 = acc[ai][bj][m][0] + bv[bj][0], a1 = acc[ai][bj][m][1] + bv[bj][1];
#define RAT(gnv, gdv) ((gnv) * (lastseg ? 1.0f : __builtin_amdgcn_rcpf(gdv)))
                    a0[0] *= RAT(bflo(n4.x), bflo(d4.x)); a0[1] *= RAT(bfhi(n4.x), bfhi(d4.x)); a0[2] *= RAT(bflo(n4.y), bflo(d4.y)); a0[3] *= RAT(bfhi(n4.y), bfhi(d4.y));
                    a1[0] *= RAT(bflo(n4.z), bflo(d4.z)); a1[1] *= RAT(bfhi(n4.z), bfhi(d4.z)); a1[2] *= RAT(bflo(n4.w), bflo(d4.w)); a1[3] *= RAT(bfhi(n4.w), bfhi(d4.w));
#undef RAT
                    acc[ai][bj][m][0] = a0; acc[ai][bj][m][1] = a1;
                    asm volatile("" : "+v"(acc[ai][bj][m][0]), "+v"(acc[ai][bj][m][1]));
                    if (lastseg) *(u32x4*)(Mg + (size_t)row * 1024 + col0 + bj * 128) = pack8(a0, a1);
                } }
            asm volatile("" ::: "memory");
        }
    }
};
struct EpiD {
    static constexpr bool PERM = false;
    __device__ __forceinline__ bool keep(const pg8::Unit&) const { return false; }
    float* H; bf16* HB;
    __device__ __forceinline__ void operator()(AccT& acc, const pg8::Unit& u, int wr, int wc, int fr, int fq) const {
        const int row0 = u.pm * 256 + wr * 64 + fr, col0 = u.pn * 256 + wc * 32 + 4 * fq;
#pragma unroll
        for (int ai = 0; ai < 2; ++ai)
#pragma unroll
            for (int m = 0; m < 4; ++m) {
                const size_t off = (size_t)(row0 + ai * 128 + m * 16) * 1024 + col0;
#pragma unroll
                for (int bj = 0; bj < 2; ++bj)
#pragma unroll
                    for (int n = 0; n < 2; ++n) { const size_t o = off + bj * 128 + n * 16; const f32x4 hv = *(const f32x4*)(H + o) + acc[ai][bj][m][n];
                        *(f32x4*)(H + o) = hv; u32x2 w; w.x = pk2(hv[0], hv[1]); w.y = pk2(hv[2], hv[3]); *(u32x2*)(HB + o) = w; }
            }
    }
};
struct EpiA2 {
    static constexpr bool PERM = true;
    __device__ __forceinline__ bool keep(const pg8::Unit&) const { return false; }
    const float* PW; bf16* HH;
    __device__ __forceinline__ void operator()(AccT& acc, const pg8::Unit& u, int wr, int wc, int fr, int fq) const {
        const int row0 = u.pm * 256 + wr * 64 + fr, lc0 = wc * 32 + 8 * fq, side = u.pn >> 1;
#pragma unroll
        for (int ai = 0; ai < 2; ++ai)
#pragma unroll
            for (int m = 0; m < 4; ++m) {
                const int row = row0 + ai * 128 + m * 16; const f32x4 pw = *(const f32x4*)(PW + (size_t)row * 4);
                const float rs = pw[0], cw = side ? pw[2] : pw[1];
                f32x4 o[2];
#pragma unroll
                for (int n = 0; n < 2; ++n)
#pragma unroll
                    for (int j = 0; j < 4; ++j) { const float a1 = acc[ai][0][m][n][j] * rs, a3 = acc[ai][1][m][n][j] * rs; o[n][j] = cw * a1 * sigmoidf_(a1) * a3; }
                *(u32x4*)(HH + (size_t)row * 512 + side * 256 + (u.pn & 1) * 128 + lc0) = pack8(o[0], o[1]);
            }
    }
};
struct EpiB2 {
    static constexpr bool PERM = true;
    __device__ __forceinline__ bool keep(const pg8::Unit&) const { return false; }
    bf16* Y;
    __device__ __forceinline__ void operator()(AccT& acc, const pg8::Unit& u, int wr, int wc, int fr, int fq) const {
        const int row0 = u.pm * 256 + wr * 64 + fr, col0 = u.pn * 256 + wc * 32 + 8 * fq;
#pragma unroll
        for (int ai = 0; ai < 2; ++ai)
#pragma unroll
            for (int m = 0; m < 4; ++m) {
                bf16* rp = Y + (size_t)(row0 + ai * 128 + m * 16) * 1024 + col0;
#pragma unroll
                for (int bj = 0; bj < 2; ++bj) *(u32x4*)(rp + bj * 128) = pack8(acc[ai][bj][m][0], acc[ai][bj][m][1]);
            }
    }
};
struct MoeOrder {
    int NP, G, c, mode; const LAS int* pcls; const bf16* W;
    __device__ bool next(int i, pg8::Unit& u) const { const long L = (long)i * G + c; if (L >= (long)NP * 4) return false; u.pm = (int)(L >> 2); u.pn = (int)(L & 3); u.seg = 0; return true; }
    __device__ __forceinline__ int nt(const pg8::Unit&, int ntd) const { return ntd; }
    __device__ __forceinline__ size_t aoff(const pg8::Unit&) const { return 0; }
    __device__ __forceinline__ const char* bptr(const pg8::Unit& u, int side) const {
        const int cls = __builtin_amdgcn_readfirstlane(pcls[u.pm]); const int grp = cls / 6, pr = cls % 6;
        const int ea = pr < 3 ? 0 : (pr < 5 ? 1 : 2), eb = pr < 3 ? pr + 1 : (pr < 5 ? pr - 1 : 3);
        if (mode == 0) { const int e = grp * 4 + (u.pn < 2 ? ea : eb); return (const char*)W + ((size_t)e * 512 + (size_t)(u.pn & 1) * 256) * 1024 * 2; }
        const int e = grp * 4 + (side ? eb : ea); return (const char*)W + ((size_t)e * 1024 + (size_t)u.pn * 256) * 256 * 2;
    }
};

#define XB_TMO      128
#define XB_XCNT(j)  (256  + 64 * (j))
#define XB_XSUB(j)  (1280 + 64 * (j))
#define XB_XGEN(j)  (2304 + 64 * (j))
#define XB_TOP      3328
#define XB_TOPGEN   3392
#define XCD_BAR_WORDS 3456
#define XB_SPIN_CAP (1u << 24)
__device__ __forceinline__ unsigned xb_ld(unsigned* p)              { return __hip_atomic_load(p, __ATOMIC_RELAXED, __HIP_MEMORY_SCOPE_AGENT); }
__device__ __forceinline__ unsigned xb_add(unsigned* p, unsigned v) { return __hip_atomic_fetch_add(p, v, __ATOMIC_RELAXED, __HIP_MEMORY_SCOPE_AGENT); }
__device__ __forceinline__ unsigned xb_xcc_id() { return (unsigned)__builtin_amdgcn_s_getreg((3 << 11) | 20) & 0xFu; }
#define XB_SPIN(cond, bar) do { unsigned _sp = 0; while (cond) { __builtin_amdgcn_s_sleep(1); \
    if ((++_sp & 255u) == 0u) { if (xb_ld(&(bar)[XB_TMO])) break; if (_sp > XB_SPIN_CAP) { atomicAdd(&(bar)[XB_TMO], 1u); break; } } } } while (0)
struct XcdBarrier { unsigned* bar; unsigned x; volatile LAS unsigned* st; };
__device__ __forceinline__ XcdBarrier xcd_barrier_post(unsigned* bar, volatile LAS unsigned* st) {
    XcdBarrier b; b.bar = bar; b.x = xb_xcc_id(); b.st = st;
    if (threadIdx.x == 0) (void)xb_add(&bar[XB_XCNT(b.x)], 1u);
    return b;
}
__device__ __forceinline__ void xcd_barrier_complete(unsigned* bar, unsigned x, unsigned& nloc, unsigned& nx) {
    const unsigned G = gridDim.x * gridDim.y * gridDim.z;
    unsigned sum, cnt, mine, sp = 0u;
    for (;;) {
        sum = 0u; cnt = 0u; mine = 0u;
#pragma unroll
        for (unsigned j = 0; j < 16; ++j) { const unsigned c = xb_ld(&bar[XB_XCNT(j)]); sum += c; cnt += (c > 0u) ? 1u : 0u; mine = (j == x) ? c : mine; }
        if (sum == G) break;
        __builtin_amdgcn_s_sleep(1);
        if ((++sp & 255u) == 0u) { if (xb_ld(&bar[XB_TMO])) break; if (sp > XB_SPIN_CAP) { atomicAdd(&bar[XB_TMO], 1u); break; } }
    }
    nloc = mine > 0u ? mine : 1u; nx = cnt > 0u ? cnt : 1u;
}
__device__ __forceinline__ void xcd_barrier(const XcdBarrier& b) {
    asm volatile("s_waitcnt vmcnt(0)" ::: "memory");
    __syncthreads();
    if (threadIdx.x == 0) {
        unsigned* bar = b.bar;
        __builtin_amdgcn_s_waitcnt(0);
        unsigned nloc = b.st[0], nx = b.st[1];
        if (nloc == 0u) { xcd_barrier_complete(bar, b.x, nloc, nx); b.st[0] = nloc; b.st[1] = nx; }
        const unsigned old = xb_add(&bar[XB_XSUB(b.x)], 1u);
        const unsigned gen = old / nloc;
        if (old + 1u == (gen + 1u) * nloc) {
            __builtin_amdgcn_fence(__ATOMIC_RELEASE, "agent");
            asm volatile("s_waitcnt vmcnt(0)" ::: "memory");
            const unsigned og = xb_add(&bar[XB_TOP], 1u);
            const unsigned tg = og / nx;
            if (og + 1u == (tg + 1u) * nx) xb_add(&bar[XB_TOPGEN], 1u);
            else XB_SPIN(xb_ld(&bar[XB_TOPGEN]) == tg, bar);
            __builtin_amdgcn_fence(__ATOMIC_ACQUIRE, "agent");
            xb_add(&bar[XB_XGEN(b.x)], 1u);
            asm volatile("s_waitcnt vmcnt(0)" ::: "memory");
        } else {
            XB_SPIN(xb_ld(&bar[XB_XGEN(b.x)]) == gen, bar);
            __builtin_amdgcn_fence(__ATOMIC_ACQUIRE, "agent");
            asm volatile("s_waitcnt vmcnt(0)" ::: "memory");
        }
    }
    __syncthreads();
}

struct Params { const float* in[25]; float* out; unsigned char* ws; int ph_lo, ph_hi; };
enum { I_X = 0, I_META, I_N1G, I_WIN, I_BF, I_PW, I_PB, I_PS, I_CW, I_CB, I_LNG, I_LNB, I_WOA, I_WOB, I_WOC, I_WO, I_N2G, I_RGW, I_RGB, I_REW, I_REB, I_W1, I_W3, I_W2, I_FG };

struct Frame {
    LAS unsigned char* lds;
    int tid, lane, wave, vcu, G, bx;
};
__device__ __forceinline__ unsigned long long ptab_get(const Frame& F, int i) { const LAS unsigned* t = (const LAS unsigned*)(F.lds + LC_PTAB) + 2 * i; const unsigned lo = __builtin_amdgcn_readfirstlane(t[0]), hi = __builtin_amdgcn_readfirstlane(t[1]); return ((unsigned long long)hi << 32) | lo; }
#define INP(i) ((const float*)(const GAS float*)ptab_get(F, (i)))
#define WSP() ((unsigned char*)(GAS unsigned char*)ptab_get(F, 25))
#define DOP() ((unsigned char*)(GAS unsigned char*)ptab_get(F, 26))

__device__ __forceinline__ void tr_item(const float* W, int ldw, int scol0, const float* gk, bf16* WT, int ldt, int drow0, int k0, LAS float* scr, int lane) {
#pragma unroll 8
    for (int i = 0; i < 32; ++i) { const int kk = 2 * i + (lane >> 5); float v = W[(size_t)(k0 + kk) * ldw + scol0 + (lane & 31)]; if (gk) v *= gk[k0 + kk]; scr[kk * 33 + (lane & 31)] = v; }
    LDS_WAIT(); asm volatile("" ::: "memory");
    const int c = lane & 7;
#pragma unroll
    for (int j = 0; j < 4; ++j) { const int n = (lane >> 3) + 8 * j; const LAS float* s = scr + (8 * c) * 33 + n;
        u32x4 o; o.x = pk2(s[0 * 33], s[1 * 33]); o.y = pk2(s[2 * 33], s[3 * 33]); o.z = pk2(s[4 * 33], s[5 * 33]); o.w = pk2(s[6 * 33], s[7 * 33]);
        *(u32x4*)(WT + (size_t)(drow0 + n) * ldt + k0 + 8 * c) = o; }
    LDS_WAIT(); asm volatile("" ::: "memory");
}
__device__ __forceinline__ int map1(int n) {
    const int tile = n >> 8, r = n & 255;
    if (tile == 0) return n;
    if (tile <= 2) { const int c = (tile - 1) * 128 + (r & 127); return (r < 128 ? 256 : 512) + c; }
    if (tile <= 8) return n;
    return n + 8;
}
__device__ __forceinline__ void convert_weights(Frame& F, int l) {
    LAS float* scr = (LAS float*)(F.lds + F.wave * 16384);
    const int gw = F.vcu * NWAVES + F.wave, NGW = F.G * NWAVES, lane = F.lane;
    const float* g1 = INP(I_N1G) + (size_t)l * D; const float* g2 = INP(I_N2G) + (size_t)l * D;
    unsigned char* ws = WSP();
    { const float* W = INP(I_WIN) + (size_t)l * D * NIN; bf16* WT = (bf16*)(ws + WS_W1T);
      for (int it = gw; it < 16 * 168; it += NGW) { const int kb = it / 168, nb = it % 168; tr_item(W, NIN, map1(nb * 32), g1, WT, 1024, nb * 32, kb * 64, scr, lane); } }
    { const float* W = INP(I_WOB) + (size_t)l * 256 * D; bf16* WT = (bf16*)(ws + WS_W3CT) + 256;
      for (int it = gw; it < 4 * 32; it += NGW) { const int kb = it / 32, nb = it % 32; tr_item(W, 1024, nb * 32, nullptr, WT, 1024, nb * 32, kb * 64, scr, lane); } }
    { const float* W = INP(I_WOC) + (size_t)l * 512 * D; bf16* WT = (bf16*)(ws + WS_W3CT) + 512;
      for (int it = gw; it < 8 * 32; it += NGW) { const int kb = it / 32, nb = it % 32; tr_item(W, 1024, nb * 32, nullptr, WT, 1024, nb * 32, kb * 64, scr, lane); } }
    { const float* W = INP(I_WO) + (size_t)l * D * D; bf16* WT = (bf16*)(ws + WS_WOT);
      for (int it = gw; it < 16 * 32; it += NGW) { const int kb = it / 32, nb = it % 32; tr_item(W, 1024, nb * 32, nullptr, WT, 1024, nb * 32, kb * 64, scr, lane); } }
    { bf16* WT = (bf16*)(DOP() + DO_W13T);
      for (int it = gw; it < 16 * 256; it += NGW) { const int e = it >> 8, r = it & 255, kb = r >> 4, nb = r & 15, n0 = nb * 32, jt = n0 >> 8, rr = n0 & 255;
        const float* W = (rr < 128 ? INP(I_W1) : INP(I_W3)) + ((size_t)l * 16 + e) * D * 256;
        tr_item(W, 256, jt * 128 + (rr & 127), g2, WT + (size_t)e * 512 * 1024, 1024, n0, kb * 64, scr, lane); } }
    { bf16* WT = (bf16*)(DOP() + DO_W2T);
      for (int it = gw; it < 16 * 128; it += NGW) { const int e = it >> 7, r = it & 127, kb = r >> 5, nb = r & 31;
        const float* W = INP(I_W2) + ((size_t)l * 16 + e) * 256 * D;
        tr_item(W, 1024, nb * 32, nullptr, WT + (size_t)e * 1024 * 256, 256, nb * 32, kb * 64, scr, lane); } }
    { const float* pw = INP(I_PW) + (size_t)l * 4 * 64 * 64; const float* ps = INP(I_PS) + (size_t)l * 256; const float* pb = INP(I_PB) + (size_t)l * 256;
      const float* wa = INP(I_WOA) + (size_t)l * 256 * D; bf16* WT = (bf16*)(ws + WS_W3CT); float* bias = (float*)(ws + WS_BIASA);
      const int gt = F.vcu * 512 + F.tid, NT = F.G * 512;
      for (int idx = gt; idx < 256 * 1024; idx += NT) { const int n = idx & 1023, kk = idx >> 10, grp = kk >> 6, c = kk & 63; float s = 0.f;
        for (int d = 0; d < 64; ++d) s += pw[(grp * 64 + c) * 64 + d] * ps[grp * 64 + d] * wa[(size_t)(grp * 64 + d) * D + n];
        WT[(size_t)n * 1024 + kk] = (bf16)f2bf(s); }
      for (int n = gt; n < 1024; n += NT) { float s = 0.f; for (int d = 0; d < 256; ++d) s += pb[d] * ps[d] * wa[(size_t)d * D + n]; bias[n] = s; }
      float* wfg = (float*)(ws + WS_WFG); const float* win = INP(I_WIN) + (size_t)l * D * NIN;
      for (int idx = gt; idx < 8 * 1024; idx += NT) { const int c = idx >> 10, k = idx & 1023; wfg[idx] = g1[k] * win[(size_t)k * NIN + 2304 + c]; }
      float* rg = (float*)(ws + WS_RG); const float* re = INP(I_REW) + (size_t)l * D * 16; const float* rgw = INP(I_RGW) + (size_t)l * D * 4;
      for (int idx = gt; idx < 20 * 1024; idx += NT) { const int c = idx >> 10, k = idx & 1023; rg[idx] = g2[k] * (c < 16 ? re[(size_t)k * 16 + c] : rgw[(size_t)k * 4 + (c - 16)]); } }
}
__device__ __forceinline__ void init_rows(Frame& F) {
    const int gw = F.vcu * NWAVES + F.wave, NGW = F.G * NWAVES, lane = F.lane;
    float* H = (float*)(WSP() + WS_H); bf16* HB = (bf16*)(WSP() + WS_HB); float* rstd1 = (float*)(WSP() + WS_RSTD1);

#pragma unroll 1
for (int row = gw; row < TM; row += NGW) {
        const float* src = row < TX ? INP(I_X) + (size_t)row * D : (row - TX < NMETA ? INP(I_META) + (size_t)(row - TX) * D : nullptr);
        f32x4 v[4]; float ss = 0.f;
#pragma unroll
        for (int j = 0; j < 4; ++j) { float z_ = 0.f; LAUNDER_V(z_); v[j] = src ? *(const f32x4*)(src + 4 * lane + 256 * j) : (f32x4){z_, z_, z_, z_}; ss += v[j][0] * v[j][0] + v[j][1] * v[j][1] + v[j][2] * v[j][2] + v[j][3] * v[j][3]; }
        ss = wave_sum(ss);
#pragma unroll
        for (int j = 0; j < 4; ++j) { *(f32x4*)(H + (size_t)row * D + 4 * lane + 256 * j) = v[j]; u32x2 w; w.x = pk2(v[j][0], v[j][1]); w.y = pk2(v[j][2], v[j][3]); *(u32x2*)(HB + (size_t)row * D + 4 * lane + 256 * j) = w; }
        if (lane == 0) rstd1[row] = rsqrtf(ss * (1.0f / D) + EPS);
    }
}

__device__ __forceinline__ int srcrow(bool isx, int b, int t) {
    if (t >= 0) return (isx ? b * SEQ : TX) + t;
    if (isx) { const int mm = NMETA + t; return mm >= 0 ? TX + mm : -1; }
    return -1;
}
__device__ __forceinline__ void phase_S(Frame& F, int l) {
    LAS unsigned char* lds = F.lds; const int wave = F.wave;
#pragma unroll 1
    for (int item = F.vcu; item < 516; item += F.G) {
        const bool isx = item < 512; const int row0 = isx ? item * 64 : TX + (item - 512) * 64; const int b = isx ? (item * 64) / SEQ : 0; const int t0 = isx ? (item * 64) % SEQ : (item - 512) * 64;
        { unsigned char* ws = WSP(); int tid = F.tid; LAUNDER_V(tid); const int lane = tid & 63;
          const bf16* HB = (const bf16*)(ws + WS_HB); const float* rstd1 = (const float*)(ws + WS_RSTD1); const float* wfg = (const float*)(ws + WS_WFG);
          float* LFT = (float*)(ws + WS_LFT); float* LFTM = (float*)(ws + WS_LFTM); const float* bfg = INP(I_BF) + l * 8;
          LAS float* W = (LAS float*)lds;
#pragma unroll 1
          for (int i = tid; i < 2048; i += 512) *(LAS f32x4*)(W + 4 * i) = *(const f32x4*)(wfg + 4 * i);
          __syncthreads();
#pragma unroll 1
          for (int rr = wave; rr < 64; rr += 8) { const int row = row0 + rr; float xv[16];
#pragma unroll
            for (int j = 0; j < 2; ++j) { const u32x4 w = *(const u32x4*)(HB + (size_t)row * D + 8 * lane + 512 * j);
                xv[8 * j + 0] = bflo(w.x); xv[8 * j + 1] = bfhi(w.x); xv[8 * j + 2] = bflo(w.y); xv[8 * j + 3] = bfhi(w.y); xv[8 * j + 4] = bflo(w.z); xv[8 * j + 5] = bfhi(w.z); xv[8 * j + 6] = bflo(w.w); xv[8 * j + 7] = bfhi(w.w); }
            float mine = 0.f;
#pragma unroll
            for (int c = 0; c < 8; ++c) { float s = 0.f;
#pragma unroll
                for (int j = 0; j < 2; ++j) { const f32x4 w0 = *(const LAS f32x4*)(W + c * 1024 + 8 * lane + 512 * j), w1 = *(const LAS f32x4*)(W + c * 1024 + 8 * lane + 512 * j + 4);
                    s += xv[8 * j] * w0[0] + xv[8 * j + 1] * w0[1] + xv[8 * j + 2] * w0[2] + xv[8 * j + 3] * w0[3] + xv[8 * j + 4] * w1[0] + xv[8 * j + 5] * w1[1] + xv[8 * j + 6] * w1[2] + xv[8 * j + 7] * w1[3]; }
                s = wave_sum(s); if (lane == c) mine = s; }
            if (lane < 8) { const float xg = mine * rstd1[row] + bfg[lane]; const float lf = fminf(xg, 0.f) - 0.69314718056f * __builtin_amdgcn_logf(1.0f + __expf(-fabsf(xg)));
                if (isx) LFT[(size_t)(b * 8 + lane) * SEQ + t0 + rr] = lf; else LFTM[lane * 256 + t0 + rr] = lf; } }
          __syncthreads(); }
        { unsigned char* ws = WSP(); int tid = F.tid; LAUNDER_V(tid);
          const bf16* Ab = (const bf16*)(ws + WS_A); bf16* DIFF = (bf16*)(ws + WS_X3);
          LAS unsigned char* T = lds;
#pragma unroll 1
          for (int i = tid; i < 79 * 32; i += 512) { const int s = i >> 5, ch = i & 31; const int r = srcrow(isx, b, t0 + s - 15);
              unsigned z_ = 0u; LAUNDER_V(z_);
              *(LAS u32x4*)(T + s * 512 + ch * 16) = r >= 0 ? *(const u32x4*)(Ab + (size_t)r * 256 + ch * 8) : (u32x4){z_, z_, z_, z_}; }
          __syncthreads();
#pragma unroll 1
          for (int i = tid; i < 64 * 32; i += 512) { const int r = i >> 5, ch = i & 31, grp = ch >> 3, w = 2 << grp; const int cnt = isx ? w : min(t0 + r + 1, w);
              float s[8];
#pragma unroll
              for (int j = 0; j < 8; ++j) s[j] = 0.f;
#pragma unroll 1
              for (int d = 0; d < cnt; ++d) { const u32x4 v = *(const LAS u32x4*)(T + (15 + r - d) * 512 + ch * 16);
                  s[0] += bflo(v.x); s[1] += bfhi(v.x); s[2] += bflo(v.y); s[3] += bfhi(v.y); s[4] += bflo(v.z); s[5] += bfhi(v.z); s[6] += bflo(v.w); s[7] += bfhi(v.w); }
              const u32x4 a = *(const LAS u32x4*)(T + (15 + r) * 512 + ch * 16); const float ic = 1.0f / (float)cnt;
              u32x4 o; o.x = pk2(s[0] * ic - bflo(a.x), s[1] * ic - bfhi(a.x)); o.y = pk2(s[2] * ic - bflo(a.y), s[3] * ic - bfhi(a.y));
              o.z = pk2(s[4] * ic - bflo(a.z), s[5] * ic - bfhi(a.z)); o.w = pk2(s[6] * ic - bflo(a.w), s[7] * ic - bfhi(a.w));
              *(u32x4*)(DIFF + (size_t)(row0 + r) * 1024 + ch * 8) = o; }
          __syncthreads(); }
        { unsigned char* ws = WSP(); int tid = F.tid; LAUNDER_V(tid);
          const bf16* GLU = (const bf16*)(ws + WS_GLU);
          LAS unsigned char* T = lds;
          LAS float* Yt = (LAS float*)(lds + 49152);
#pragma unroll 1
          for (int i = tid; i < 94 * 32; i += 512) { const int s = i >> 5, ch = i & 31; const int r = srcrow(isx, b, t0 + s - 30);
              unsigned z_ = 0u; LAUNDER_V(z_);
              *(LAS u32x4*)(T + s * 512 + ch * 16) = r >= 0 ? *(const u32x4*)(GLU + (size_t)r * 256 + ch * 8) : (u32x4){z_, z_, z_, z_}; }
          __syncthreads();
          { const float* cw = INP(I_CW) + (size_t)l * 31 * 256; const float* cb = INP(I_CB) + l * 256;
            const int cp = tid & 127, strip = tid >> 7; f32x2 wv[31];
#pragma unroll
            for (int j = 0; j < 31; ++j) wv[j] = *(const f32x2*)(cw + j * 256 + 2 * cp);
            const f32x2 bias = *(const f32x2*)(cb + 2 * cp);
#pragma unroll 1
            for (int hh = 0; hh < 2; ++hh) { const int rb = 32 * hh + 8 * strip; f32x2 acc[8];
#pragma unroll
                for (int r = 0; r < 8; ++r) acc[r] = bias;
#pragma unroll
                for (int i = 0; i < 38; ++i) { const unsigned xw = *(const LAS unsigned*)(T + (rb + i) * 512 + cp * 4); const f32x2 xx = {bflo(xw), bfhi(xw)};
#pragma unroll
                    for (int r = 0; r < 8; ++r) { const int j = i - r; if (j >= 0 && j <= 30) acc[r] += wv[j] * xx; } }
#pragma unroll
                for (int r = 0; r < 8; ++r) *(LAS f32x2*)(Yt + (rb + r) * 256 + 2 * cp) = acc[r]; } }
          __syncthreads();
          { unsigned char* ws2 = WSP(); int tid2 = F.tid; LAUNDER_V(tid2); const int lane = tid2 & 63;
            bf16* BP = (bf16*)(ws2 + WS_X3) + 256; const float* lng = INP(I_LNG) + l * 256; const float* lnb = INP(I_LNB) + l * 256;
#pragma unroll 1
            for (int rr = wave; rr < 64; rr += 8) { const f32x4 v = *(const LAS f32x4*)(Yt + rr * 256 + 4 * lane);
              const float mean = wave_sum(v[0] + v[1] + v[2] + v[3]) * (1.0f / 256.0f); const f32x4 dv = v - mean;
              const float var = wave_sum(dv[0] * dv[0] + dv[1] * dv[1] + dv[2] * dv[2] + dv[3] * dv[3]) * (1.0f / 256.0f); const float rs = rsqrtf(var + EPS);
              const f32x4 gg = *(const f32x4*)(lng + 4 * lane), bb = *(const f32x4*)(lnb + 4 * lane); f32x4 o = dv * rs * gg + bb;
#pragma unroll
              for (int j = 0; j < 4; ++j) o[j] = o[j] * sigmoidf_(o[j]);
              u32x2 w; w.x = pk2(o[0], o[1]); w.y = pk2(o[2], o[3]); *(u32x2*)(BP + (size_t)(row0 + rr) * 1024 + 4 * lane) = w; } }
          __syncthreads(); }
    }
}

constexpr int AT_FL = 0, AT_K = 34816, AT_VT = AT_K + 8192, AT_SC = AT_VT + 8192;
__device__ __forceinline__ void attn_scan(Frame& F, int b, int h, bool meta_only, int fl_off, int sc_off) {
    LAS float* Fl = (LAS float*)(F.lds + fl_off); LAS float* sc = (LAS float*)(F.lds + sc_off);
    const float* LFT = (const float*)(WSP() + WS_LFT); const float* LFTM = (const float*)(WSP() + WS_LFTM);
    const int tid = F.tid, lane = F.lane, wave = F.wave;
    __syncthreads();
    if (tid == 0) { float s = 0.f; for (int m = 0; m < 64; ++m) { if (m < (meta_only ? 64 : NMETA)) { s += LFTM[h * 256 + m]; Fl[m] = s * LOG2E; } else Fl[m] = 1e30f; if (m == NMETA - 1) sc[16] = s; } }
    if (meta_only) { for (int i = tid; i < 256; i += 512) Fl[64 + i] = 0.f; __syncthreads(); return; }
    float v[16]; const float* src = LFT + (size_t)(b * 8 + h) * SEQ + 16 * tid;
#pragma unroll
    for (int j = 0; j < 4; ++j) { const f32x4 q = *(const f32x4*)(src + 4 * j); v[4 * j] = q[0]; v[4 * j + 1] = q[1]; v[4 * j + 2] = q[2]; v[4 * j + 3] = q[3]; }
#pragma unroll
    for (int j = 1; j < 16; ++j) v[j] += v[j - 1];
    float incl = v[15];
#pragma unroll
    for (int o = 1; o < 64; o <<= 1) { const float up = __int_as_float(__builtin_amdgcn_ds_bpermute((lane - o) << 2, __float_as_int(incl))); if (lane >= o) incl += up; }
    if (lane == 63) sc[wave] = incl;
    __syncthreads();
    float off = sc[16];
    for (int w = 0; w < wave; ++w) off += sc[w];
    off += incl - v[15];
#pragma unroll
    for (int j = 0; j < 16; ++j) Fl[64 + 16 * tid + j] = (off + v[j]) * LOG2E;
    __syncthreads();
}
__device__ __forceinline__ void attn_unit_naive(Frame& F, int qrow0, int qpos0, int ntiles, int kvx0, int h) {
    const int tid = F.tid; const int r = tid >> 1, hf = tid & 1;
    const bf16* Q = (const bf16*)(DOP() + DO_Q); const bf16* Kg = (const bf16*)(DOP() + DO_K); const bf16* Vg = (const bf16*)(DOP() + DO_V); bf16* O = (bf16*)(WSP() + WS_X3) + 512;
    LAS float* Fl = (LAS float*)(F.lds + AT_FL); LAS unsigned char* Ks = F.lds + AT_K; LAS bf16* VT = (LAS bf16*)(F.lds + AT_VT);
    const int grow = qrow0 + r, qpos = qpos0 + r;
    unsigned qp[16];
#pragma unroll
    for (int j = 0; j < 4; ++j) { const u32x4 w = *(const u32x4*)(Q + (size_t)grow * 512 + h * 64 + hf * 32 + 8 * j); qp[4 * j] = w.x; qp[4 * j + 1] = w.y; qp[4 * j + 2] = w.z; qp[4 * j + 3] = w.w; }
    const float Fq = Fl[qpos < NMETA ? qpos : qpos + 48];
    float mrun = -1e30f, lrun = 0.f, o[32];
#pragma unroll
    for (int d = 0; d < 32; ++d) o[d] = 0.f;
    const int lrow = tid >> 3, lch = tid & 7;

#pragma unroll 1
for (int i = 0; i < ntiles; ++i) {
        const int krow = (i == 0 ? TX : kvx0 + 64 * (i - 1)) + lrow;
        const u32x4 kw = *(const u32x4*)(Kg + (size_t)krow * 512 + h * 64 + lch * 8);
        const u32x4 vw = *(const u32x4*)(Vg + (size_t)krow * 512 + h * 64 + lch * 8);
        __syncthreads();
        *(LAS u32x4*)(Ks + lrow * 128 + lch * 16) = kw;
        { const unsigned vv[4] = {vw.x, vw.y, vw.z, vw.w};
#pragma unroll
          for (int e = 0; e < 4; ++e) { VT[(lch * 8 + 2 * e) * 64 + lrow] = (bf16)(vv[e] & 0xffffu); VT[(lch * 8 + 2 * e + 1) * 64 + lrow] = (bf16)(vv[e] >> 16); } }
        __syncthreads();
        const int kp0 = i == 0 ? 0 : NMETA + 64 * (i - 1);
        if (kp0 > qpos0 + 255) continue;
#pragma unroll 1
        for (int jg = 0; jg < 4; ++jg) {
            float s[16]; float gmax = -1e30f;
#pragma unroll
            for (int jj = 0; jj < 16; ++jj) { const int j = jg * 16 + jj; float d = 0.f;
#pragma unroll
                for (int c = 0; c < 4; ++c) { const u32x4 kk = *(const LAS u32x4*)(Ks + j * 128 + hf * 64 + c * 16);
                    d = dot2bf(kk.x, qp[4 * c], d); d = dot2bf(kk.y, qp[4 * c + 1], d); d = dot2bf(kk.z, qp[4 * c + 2], d); d = dot2bf(kk.w, qp[4 * c + 3], d); }
                d += lane_xor<1>(d);
                const bool valid = (i == 0 ? j < NMETA : true) && (kp0 + j <= qpos);
                s[jj] = valid ? d + Fq - Fl[64 * i + j] : -1e30f; gmax = fmaxf(gmax, s[jj]); }
            const float mn = fmaxf(mrun, gmax), alpha = exp2f(mrun - mn); mrun = mn;
            float ps = 0.f; unsigned pp[8];
#pragma unroll
            for (int jj = 0; jj < 16; jj += 2) { const float p0 = exp2f(s[jj] - mn), p1 = exp2f(s[jj + 1] - mn); ps += p0 + p1; pp[jj >> 1] = pk2(p0, p1); }
            lrun = lrun * alpha + ps;
#pragma unroll
            for (int d = 0; d < 32; ++d) { const u32x4 v0 = *(const LAS u32x4*)(VT + (hf * 32 + d) * 64 + jg * 16), v1 = *(const LAS u32x4*)(VT + (hf * 32 + d) * 64 + jg * 16 + 8);
                float a = o[d] * alpha; a = dot2bf(pp[0], v0.x, a); a = dot2bf(pp[1], v0.y, a); a = dot2bf(pp[2], v0.z, a); a = dot2bf(pp[3], v0.w, a);
                a = dot2bf(pp[4], v1.x, a); a = dot2bf(pp[5], v1.y, a); a = dot2bf(pp[6], v1.z, a); a = dot2bf(pp[7], v1.w, a); o[d] = a; }
        }
    }
    const float il = 1.0f / lrun;
#pragma unroll
    for (int j = 0; j < 4; ++j) { u32x4 w; w.x = pk2(o[8 * j] * il, o[8 * j + 1] * il); w.y = pk2(o[8 * j + 2] * il, o[8 * j + 3] * il); w.z = pk2(o[8 * j + 4] * il, o[8 * j + 5] * il); w.w = pk2(o[8 * j + 6] * il, o[8 * j + 7] * il);
        *(u32x4*)(O + (size_t)grow * 1024 + h * 64 + hf * 32 + 8 * j) = w; }
}
namespace fa {
using bf16x8v = __attribute__((ext_vector_type(8))) short;
using s16x4 = __attribute__((ext_vector_type(4))) short;
using f32x16 = __attribute__((ext_vector_type(16))) float;
constexpr int DMA = 512, DMO = 1024;
constexpr int NW = 8, QBLK = 32, QB = 256, KVBLK = 64;
constexpr int NSLOT = 3, SLOTB = 8192;
constexpr int LDS_K = 0, LDS_V = NSLOT * SLOTB, LDS_WS = 2 * NSLOT * SLOTB, LDS_OST = LDS_WS + NW * 64 * 4, LDS_BYTES = LDS_OST + NW * 4096;
constexpr int LDS_FL = 84992;
constexpr int LDS_SCAN = LDS_FL + (64 + 8192) * 4;
static_assert(LDS_SCAN + 128 <= RING_BYTES, "attention LDS");
__device__ __forceinline__ int crow(int r, int hi) { return (r & 3) + 8 * (r >> 2) + 4 * hi; }
#define SBAR() __builtin_amdgcn_sched_barrier(0)
__device__ __forceinline__ void cmask(f32x16& p0, f32x16& p1, int jb, int qrel, int hi) {
    const float NEG = -INFINITY; int kb = 64 * jb + 4 * hi;
#pragma unroll
    for (int r = 0; r < 16; ++r) { int kv = kb + (r & 3) + 8 * (r >> 2); if (kv > qrel) p0[r] = NEG; if (kv + 32 > qrel) p1[r] = NEG; }
}
__device__ __forceinline__ void glds16(const void* gsrc, unsigned lds_dst) { unsigned keep;
    asm volatile("s_mov_b32 %0, m0\n\ts_mov_b32 m0, %2\n\ts_nop 0\n\tglobal_load_lds_dwordx4 %1, off\n\ts_mov_b32 m0, %0" : "=&s"(keep) : "v"(gsrc), "s"(lds_dst) : "memory"); }
__device__ __forceinline__ float max3f(float a, float b, float c) { float r; asm("v_max3_f32 %0, %1, %2, %3" : "=v"(r) : "v"(a), "v"(b), "v"(c)); return r; }
__device__ __forceinline__ float max2f(float a, float b) { float r; asm("v_max_f32_e32 %0, %1, %2" : "=v"(r) : "v"(a), "v"(b)); return r; }
__device__ __forceinline__ float fsub_s(float a, float b) { float r; asm("v_sub_f32_e32 %0, %1, %2" : "=v"(r) : "v"(a), "v"(b)); return r; }
typedef float f32x2_t __attribute__((ext_vector_type(2))); typedef __bf16 bf16x2_t __attribute__((ext_vector_type(2)));
__device__ __forceinline__ unsigned cvtpk_s(float lo, float hi) { f32x2_t v = {lo, hi}; bf16x2_t b = __builtin_convertvector(v, bf16x2_t); return __builtin_bit_cast(unsigned, b); }
#define WAIT_BAR(N) asm volatile("s_waitcnt vmcnt(" #N ") lgkmcnt(0)\n\ts_barrier" ::: "memory")
typedef __attribute__((address_space(3))) const char* lds_cptr;
typedef short v4i16_t __attribute__((ext_vector_type(4)));
__device__ __forceinline__ void cinit(f32x16& p0, f32x16& p1, const LAS float* fk, float a) {
#pragma unroll
    for (int g = 0; g < 4; ++g) { const f32x4 f0 = *(const LAS f32x4*)(fk + 8 * g), f1 = *(const LAS f32x4*)(fk + 32 + 8 * g);
#pragma unroll
        for (int i = 0; i < 4; ++i) { p0[4 * g + i] = a - f0[i]; p1[4 * g + i] = a - f1[i]; } }
}
__device__ __forceinline__ void qkt(f32x16& p0, f32x16& p1, const char* Kslot, const bf16x8v* qr, int r32, int hi) {
    const char* kb = Kslot + hi * 1024 + r32 * 16;
#pragma unroll
    for (int d0 = 0; d0 < 4; ++d0) {
        const bf16x8v b0 = *reinterpret_cast<const bf16x8v*>(kb + d0 * 2048);
        const bf16x8v b1 = *reinterpret_cast<const bf16x8v*>(kb + d0 * 2048 + 512);
        p0 = __builtin_amdgcn_mfma_f32_32x32x16_bf16(b0, qr[d0], p0, 0, 0, 0); p1 = __builtin_amdgcn_mfma_f32_32x32x16_bf16(b1, qr[d0], p1, 0, 0, 0); }
}
__device__ __forceinline__ void kload8(bf16x8v* kf, lds_cptr kp) {
    kf[0] = *(const LAS bf16x8v*)(kp);        kf[1] = *(const LAS bf16x8v*)(kp + 512);
    kf[2] = *(const LAS bf16x8v*)(kp + 2048); kf[3] = *(const LAS bf16x8v*)(kp + 2560);
    kf[4] = *(const LAS bf16x8v*)(kp + 4096); kf[5] = *(const LAS bf16x8v*)(kp + 4608);
    kf[6] = *(const LAS bf16x8v*)(kp + 6144); kf[7] = *(const LAS bf16x8v*)(kp + 6656);
}
__device__ __forceinline__ void kload2(bf16x8v* kf, lds_cptr kp, int j) { kf[2 * j] = *(const LAS bf16x8v*)(kp + j * 2048); kf[2 * j + 1] = *(const LAS bf16x8v*)(kp + j * 2048 + 512); }
__device__ __forceinline__ s16x4 vtr(lds_cptr p) { return __builtin_bit_cast(s16x4, __builtin_amdgcn_ds_read_tr16_b64_v4i16((LAS v4i16_t*)p)); }
__device__ __forceinline__ float rowmax(const f32x16& p0, const f32x16& p1) {
    float a = max3f(p0[0], p0[1], p1[0]), b = max3f(p0[2], p0[3], p1[1]); a = max3f(a, p1[2], p1[3]);
#pragma unroll
    for (int r = 4; r < 16; r += 4) { a = max3f(a, p0[r], p0[r + 1]); b = max3f(b, p0[r + 2], p0[r + 3]); a = max3f(a, p1[r], p1[r + 1]); b = max3f(b, p1[r + 2], p1[r + 3]); }
    const float m = max2f(a, b);
    auto rr = __builtin_amdgcn_permlane32_swap(__float_as_uint(m), __float_as_uint(m), false, false);
    return max2f(__uint_as_float(rr[0]), __uint_as_float(rr[1]));
}
__device__ __forceinline__ void pv(f32x16* o, int vb, bf16x8v pa0, bf16x8v pa1, bf16x8v pa2, bf16x8v pa3) {
#pragma unroll
    for (int d0 = 0; d0 < 2; ++d0) { s16x4 lo[4], hi[4];
#pragma unroll
        for (int ks = 0; ks < 4; ++ks) {
            asm volatile("ds_read_b64_tr_b16 %0,%1 offset:%c2" : "=&v"(lo[ks]) : "v"(vb), "i"(d0 * 4096 + ks * 1024) : "memory");
            asm volatile("ds_read_b64_tr_b16 %0,%1 offset:%c2" : "=&v"(hi[ks]) : "v"(vb), "i"(d0 * 4096 + ks * 1024 + 512) : "memory"); }
        asm volatile("s_waitcnt lgkmcnt(0)" ::: "memory"); SBAR();
#define PK(k) (bf16x8v){lo[k][0], lo[k][1], lo[k][2], lo[k][3], hi[k][0], hi[k][1], hi[k][2], hi[k][3]}
        o[d0] = __builtin_amdgcn_mfma_f32_32x32x16_bf16(pa0, PK(0), o[d0], 0, 0, 0);
        o[d0] = __builtin_amdgcn_mfma_f32_32x32x16_bf16(pa1, PK(1), o[d0], 0, 0, 0);
        o[d0] = __builtin_amdgcn_mfma_f32_32x32x16_bf16(pa2, PK(2), o[d0], 0, 0, 0);
        o[d0] = __builtin_amdgcn_mfma_f32_32x32x16_bf16(pa3, PK(3), o[d0], 0, 0, 0);
#undef PK
    }
}
template <int THRL> __device__ __forceinline__ void attn_unit(int b, int h, int qb, const bf16* Q, const bf16* __restrict__ K, const bf16* __restrict__ V, bf16* O, char* shm, int wid) {
    const int lane = lane_id_opaque(), r32 = lane & 31, hi = lane >> 5;
    const long rowbase = (long)b * SEQ; const int q0 = qb * QB;
    const bf16* Qw = Q + (rowbase + q0 + wid * QBLK) * DMA + h * 64;
    const bf16* Kh = K + rowbase * DMA + h * 64, *Vh = V + rowbase * DMA + h * 64;
    const bf16* Km = K + (long)TX * DMA + h * 64, *Vm = V + (long)TX * DMA + h * 64;
    const unsigned lds0 = (unsigned)(uintptr_t)shm;
    float* wsf = (float*)(shm + LDS_WS) + wid * 64;
    const bf16* ksrc = Kh + (long)lane * DMA + wid * 8;
    const bf16* vsrc = Vh + (long)(16 * (wid & 3) + (lane >> 2)) * DMA + (wid >> 2) * 32 + (lane & 3) * 8;
    const bf16* ksrcm = Km + (long)lane * DMA + wid * 8;
    const bf16* vsrcm = Vm + (long)(16 * (wid & 3) + (lane >> 2)) * DMA + (wid >> 2) * 32 + (lane & 3) * 8;
    const unsigned kdst = lds0 + LDS_K + wid * 1024, vdst = lds0 + LDS_V + wid * 1024;
#define DMA_K(t, slot) glds16(ksrc + (long)((t) - 1) * KVBLK * DMA, (unsigned)__builtin_amdgcn_readfirstlane(kdst + (slot)))
#define DMA_V(t, slot) glds16(vsrc + (long)((t) - 1) * KVBLK * DMA, (unsigned)__builtin_amdgcn_readfirstlane(vdst + (slot)))
    const int vb0 = (int)(lds0 + LDS_V) + ((lane >> 4) & 1) * 32 + (lane & 3) * 8 + (4 * hi + ((lane & 15) >> 2)) * 64;
    const char* Kbase = shm + LDS_K; bf16x8v kf[8];
    const lds_cptr shm3 = (lds_cptr)shm; const lds_cptr kp0 = shm3 + LDS_K + hi * 1024 + r32 * 16; const lds_cptr vp0 = shm3 + LDS_V + ((lane >> 4) & 1) * 32 + (lane & 3) * 8 + (4 * hi + ((lane & 15) >> 2)) * 64;
    const LAS float* Flp = (const LAS float*)(shm3 + LDS_FL) + 4 * hi;
    const int NT = 4 * qb + 5;
    glds16(ksrcm, (unsigned)__builtin_amdgcn_readfirstlane(kdst)); glds16(vsrcm, (unsigned)__builtin_amdgcn_readfirstlane(vdst)); DMA_K(1, SLOTB);
    bf16x8v qr[4];
#pragma unroll
    for (int d0 = 0; d0 < 4; ++d0) qr[d0] = *reinterpret_cast<const bf16x8v*>(&Qw[(long)r32 * DMA + d0 * 16 + hi * 8]);
    float aq = ((const LAS float*)(shm3 + LDS_FL))[64 + q0 + wid * QBLK + r32];
    float l_reg = 0.f; f32x16 o[2]; o[0] = f32x16{}; o[1] = f32x16{};
    const int qrel = wid * QBLK + r32;
#define CMASK(P0, P1, t) do { int jb_ = (t) - (NT - 4); if (jb_ >= 0) cmask(P0, P1, jb_, qrel, hi); } while (0)
    bool resc = false;
#define START(P0, P1) do { const float rm = rowmax(P0, P1); resc = false; \
    { const float dl = max2f(rm, 0.f); aq = fsub_s(aq, dl);        \
      _Pragma("unroll") for (int r = 0; r < 16; ++r) { P0[r] = fsub_s(P0[r], dl); P1[r] = fsub_s(P1[r], dl); } } \
    _Pragma("unroll") for (int r = 0; r < 16; ++r) P0[r] = __builtin_amdgcn_exp2f(P0[r]); } while (0)
#define RESC() do { if (resc) { asm volatile("s_waitcnt lgkmcnt(0)" ::: "memory"); \
      _Pragma("unroll") for (int d_ = 0; d_ < 2; ++d_) _Pragma("unroll") for (int r = 0; r < 16; ++r) o[d_][r] *= wsf[crow(r, hi)]; } } while (0)
    f32x16 pA0, pA1, pB0, pB1;
    int sl_prev = 0, sl_cur = 0, sl_next = SLOTB;
#define ROT() do { sl_prev = sl_cur; sl_cur = sl_next; sl_next = (sl_next == (NSLOT - 1) * SLOTB) ? 0 : sl_next + SLOTB; } while (0)
    DMA_K(2, 2 * SLOTB);
    cinit(pA0, pA1, Flp, aq);
    WAIT_BAR(3);
    qkt(pA0, pA1, Kbase, qr, r32, hi); asm volatile("s_nop 15\n\ts_nop 7" : "+v"(pA0), "+v"(pA1));
    START(pA0, pA1);
    _Pragma("unroll") for (int r = 0; r < 16; ++r) pA1[r] = __builtin_amdgcn_exp2f(pA1[r]);
    WAIT_BAR(0);
    DMA_K(3, 0); DMA_V(1, SLOTB);
    ROT();
    kload8(kf, kp0 + sl_cur);
    WAIT_BAR(2);
    s16x4 vlo[8], vhi[8]; u32x4 pw0, pw1, pw2, pw3;
#define PKW(P, B) cvtpk_s(P[B], P[B + 1])
#define PAF(k) __builtin_bit_cast(bf16x8v, pw##k)
#define VFR(i) (bf16x8v){vlo[i][0], vlo[i][1], vlo[i][2], vlo[i][3], vhi[i][0], vhi[i][1], vhi[i][2], vhi[i][3]}
#define PIN(x) asm volatile("" : "+v"(x))
#define MX3(a, b, c) __builtin_fmaxf(__builtin_fmaxf((a), (b)), (c))
#define GAPA(MF, A0, A1, A2, A3, W0, W1, PW) do { MF; sacc += A0; sacc += A1; sacc += A2; sacc += A3; PIN(sacc); W0; W1; PIN(PW); SBAR(); } while (0)
#define EX(v) __builtin_amdgcn_exp2f(v)
#define GAPB(MF, X, B) do { MF; X[B] = EX(X[B]); X[B + 1] = EX(X[B + 1]); X[B + 2] = EX(X[B + 2]); X[B + 3] = EX(X[B + 3]); PIN(X); SBAR(); } while (0)
#define VRD(i) do { vlo[i] = vtr(vp_ + (((i) >> 2) * 4096 + ((i) & 3) * 1024)); vhi[i] = vtr(vp_ + (((i) >> 2) * 4096 + ((i) & 3) * 1024 + 512)); } while (0)
#define KRD(G, j) do { if (G) { kload2(kf, kp0 + sl_next, j); SBAR(); } } while (0)
#define STEP(C0, C1, P0, P1, t, GK, GV, GL) do { SBAR(); \
    cinit(C0, C1, Flp + 64 * (t), aq); SBAR(); \
    const lds_cptr vp_ = vp0 + sl_prev; \
    VRD(0); SBAR(); float sacc = (P0[0] + P0[1]); \
    GAPA(C0 = __builtin_amdgcn_mfma_f32_32x32x16_bf16(kf[0], qr[0], C0, 0, 0, 0), P0[2], P0[3], P0[4], P0[5],     pw0[0] = PKW(P0, 0), pw0[1] = PKW(P0, 2), pw0); \
    VRD(4); SBAR(); GAPA(C1 = __builtin_amdgcn_mfma_f32_32x32x16_bf16(kf[1], qr[0], C1, 0, 0, 0), P0[6], P0[7], P0[8], P0[9],     pw0[2] = PKW(P0, 4), pw0[3] = PKW(P0, 6), pw0); \
    VRD(1); SBAR(); GAPA(C0 = __builtin_amdgcn_mfma_f32_32x32x16_bf16(kf[2], qr[1], C0, 0, 0, 0),   P0[10], P0[11], P0[12], P0[13], pw1[0] = PKW(P0, 8), pw1[1] = PKW(P0, 10), pw1); \
    VRD(5); SBAR(); GAPA(C1 = __builtin_amdgcn_mfma_f32_32x32x16_bf16(kf[3], qr[1], C1, 0, 0, 0),   P0[14], P0[15], P1[0], P1[1],   pw1[2] = PKW(P0, 12), pw1[3] = PKW(P0, 14), pw1); \
    VRD(2); SBAR(); GAPA(C0 = __builtin_amdgcn_mfma_f32_32x32x16_bf16(kf[4], qr[2], C0, 0, 0, 0),   P1[2], P1[3], P1[4], P1[5],     pw2[0] = PKW(P1, 0), pw2[1] = PKW(P1, 2), pw2); \
    VRD(6); SBAR(); GAPA(C1 = __builtin_amdgcn_mfma_f32_32x32x16_bf16(kf[5], qr[2], C1, 0, 0, 0),   P1[6], P1[7], P1[8], P1[9],     pw2[2] = PKW(P1, 4), pw2[3] = PKW(P1, 6), pw2); \
    VRD(3); SBAR(); GAPA(C0 = __builtin_amdgcn_mfma_f32_32x32x16_bf16(kf[6], qr[3], C0, 0, 0, 0),   P1[10], P1[11], P1[12], P1[13], pw3[0] = PKW(P1, 8), pw3[1] = PKW(P1, 10), pw3); \
    VRD(7); SBAR(); GAPA(C1 = __builtin_amdgcn_mfma_f32_32x32x16_bf16(kf[7], qr[3], C1, 0, 0, 0),   P1[14], P1[15], 0.f, 0.f,       pw3[2] = PKW(P1, 12), pw3[3] = PKW(P1, 14), pw3); \
    l_reg += sacc; \
    if (GK) { DMA_K((t) + 3, sl_cur); } if (GV) { DMA_V((t) + 1, sl_next); } \
    CMASK(C0, C1, t); \
    { float a = MX3(C0[0], C0[1], C1[0]), b_ = MX3(C0[2], C0[3], C1[1]); a = MX3(a, C1[2], C1[3]); \
      _Pragma("unroll") for (int r = 4; r < 16; r += 4) { a = MX3(a, C0[r], C0[r + 1]); b_ = MX3(b_, C0[r + 2], C0[r + 3]); a = MX3(a, C1[r], C1[r + 1]); b_ = MX3(b_, C1[r + 2], C1[r + 3]); } \
      float rm = __builtin_fmaxf(a, b_); { auto rr = __builtin_amdgcn_permlane32_swap(__float_as_uint(rm), __float_as_uint(rm), false, false); rm = __builtin_fmaxf(__uint_as_float(rr[0]), __uint_as_float(rr[1])); } \
      resc = false; \
      if (__builtin_expect(__any(rm > (float)THRL), 0)) { const float dl = __builtin_fmaxf(rm, 0.f); aq -= dl; \
        _Pragma("unroll") for (int r = 0; r < 16; ++r) { C0[r] -= dl; C1[r] -= dl; } \
        const float f = __builtin_amdgcn_exp2f(-dl); l_reg *= f; if (hi == 0) wsf[r32] = f; resc = true; } } \
    SBAR(); \
    GAPB(o[0] = __builtin_amdgcn_mfma_f32_32x32x16_bf16(PAF(0), VFR(0), o[0], 0, 0, 0), C0, 0); \
    GAPB(o[1] = __builtin_amdgcn_mfma_f32_32x32x16_bf16(PAF(0), VFR(4), o[1], 0, 0, 0), C0, 4); \
    KRD(GL, 0); GAPB(o[0] = __builtin_amdgcn_mfma_f32_32x32x16_bf16(PAF(1), VFR(1), o[0], 0, 0, 0), C0, 8); \
    KRD(GL, 1); GAPB(o[1] = __builtin_amdgcn_mfma_f32_32x32x16_bf16(PAF(1), VFR(5), o[1], 0, 0, 0), C0, 12); \
    KRD(GL, 2); GAPB(o[0] = __builtin_amdgcn_mfma_f32_32x32x16_bf16(PAF(2), VFR(2), o[0], 0, 0, 0), C1, 0); \
    KRD(GL, 3); GAPB(o[1] = __builtin_amdgcn_mfma_f32_32x32x16_bf16(PAF(2), VFR(6), o[1], 0, 0, 0), C1, 4); \
    GAPB(o[0] = __builtin_amdgcn_mfma_f32_32x32x16_bf16(PAF(3), VFR(3), o[0], 0, 0, 0), C1, 8); \
    GAPB(o[1] = __builtin_amdgcn_mfma_f32_32x32x16_bf16(PAF(3), VFR(7), o[1], 0, 0, 0), C1, 12); \
    } while (0)
    int t = 1;
#undef CMASK
#define CMASK(P0, P1, t) do { } while (0)
    for (; t + 5 < NT; t += 2) {
        STEP(pB0, pB1, pA0, pA1, t, true, true, true);     WAIT_BAR(2); RESC(); ROT();
        STEP(pA0, pA1, pB0, pB1, t + 1, true, true, true); WAIT_BAR(2); RESC(); ROT();
    }
#undef CMASK
#define CMASK(P0, P1, t) do { int jb_ = (t) - (NT - 4); if (jb_ >= 0) cmask(P0, P1, jb_, qrel, hi); } while (0)
#define ENDW(tt) do { if ((tt) + 3 < NT) { WAIT_BAR(2); } else if ((tt) + 2 < NT) { WAIT_BAR(1); } else { WAIT_BAR(0); } } while (0)
    for (; t + 1 < NT; t += 2) {
        STEP(pB0, pB1, pA0, pA1, t, (t + 3 < NT), (t + 1 < NT), (t + 1 < NT));         ENDW(t);     RESC(); ROT();
        STEP(pA0, pA1, pB0, pB1, t + 1, (t + 4 < NT), (t + 2 < NT), (t + 2 < NT));     ENDW(t + 1); RESC(); ROT();
    }
    { float sacc = pA0[0] + pA0[1]; _Pragma("unroll") for (int r = 2; r < 16; ++r) sacc += pA0[r]; _Pragma("unroll") for (int r = 0; r < 16; ++r) sacc += pA1[r]; l_reg += sacc;
      pw0 = (u32x4){PKW(pA0, 0), PKW(pA0, 2), PKW(pA0, 4), PKW(pA0, 6)}; pw1 = (u32x4){PKW(pA0, 8), PKW(pA0, 10), PKW(pA0, 12), PKW(pA0, 14)}; pw2 = (u32x4){PKW(pA1, 0), PKW(pA1, 2), PKW(pA1, 4), PKW(pA1, 6)}; pw3 = (u32x4){PKW(pA1, 8), PKW(pA1, 10), PKW(pA1, 12), PKW(pA1, 14)};
      SBAR(); pv(o, vb0 + sl_prev, PAF(0), PAF(1), PAF(2), PAF(3)); }
#undef PKW
#undef PAF
#undef VFR
#undef PIN
#undef MX3
#undef GAPA
#undef GAPB
#undef EX
#undef VRD
#undef KRD
#undef STEP
#undef ENDW
    { auto rr = __builtin_amdgcn_permlane32_swap(__float_as_uint(l_reg), __float_as_uint(l_reg), false, false); l_reg = __uint_as_float(rr[0]) + __uint_as_float(rr[1]); }
    if (hi == 0) wsf[32 + r32] = l_reg; asm volatile("s_waitcnt lgkmcnt(0)" ::: "memory");
    float rli[16];
#pragma unroll
    for (int r = 0; r < 16; ++r) rli[r] = __builtin_amdgcn_rcpf(wsf[32 + crow(r, hi)]);
    bf16* Ow = O + (rowbase + q0 + wid * QBLK) * DMO + h * 64;
    { bf16* stg = (bf16*)(shm + LDS_OST) + wid * 2048;
#pragma unroll
      for (int r = 0; r < 16; ++r) { const int orow = crow(r, hi);
#pragma unroll
          for (int d0 = 0; d0 < 2; ++d0) stg[orow * 64 + d0 * 32 + r32] = (bf16)f2bf(o[d0][r] * rli[r]); }
      asm volatile("s_waitcnt lgkmcnt(0)" ::: "memory");
#pragma unroll
      for (int i = 0; i < 4; ++i) { const int row = i * 8 + (lane >> 3), ch = lane & 7; const u32x4 v = *(const u32x4*)(stg + row * 64 + ch * 8); *(u32x4*)(Ow + (long)row * DMO + ch * 8) = v; } }
    asm volatile("s_waitcnt lgkmcnt(0)\n\ts_barrier" ::: "memory");
#undef DMA_K
#undef DMA_V
#undef CMASK
#undef START
#undef RESC
#undef ROT
}
#undef SBAR
#undef WAIT_BAR
}
__device__ __forceinline__ void phase_B(Frame& F) {
    if (F.G == 256) {
        const int v = F.vcu, bh = v >> 3, s = v & 7, b = bh >> 3, h = bh & 7;
        attn_scan(F, b, h, false, fa::LDS_FL, fa::LDS_SCAN);
        { unsigned char* dol = DOP(); const bf16* Q = (const bf16*)(dol + DO_Q); const bf16* Kg = (const bf16*)(dol + DO_K); const bf16* Vg = (const bf16*)(dol + DO_V);
#pragma unroll 1
          for (int i = 0; i < 4; ++i) { const int qb = i == 0 ? s : (i == 1 ? 15 - s : (i == 2 ? 16 + s : 31 - s));
              fa::attn_unit<8>(b, h, qb, Q, Kg, Vg, (bf16*)(WSP() + WS_X3) + 512, (char*)F.lds, F.wave); } }
        if (v < 8) { attn_scan(F, 0, v, true, AT_FL, AT_SC); attn_unit_naive(F, TX, 0, 1, 0, v); }
    } else {
        int cur_bh = -1;
        for (int u = F.vcu; u < 1032; u += F.G) {
            if (u < 1024) { const int bh = u >> 5, qb = u & 31, b = bh >> 3, h = bh & 7; if (bh != cur_bh) { attn_scan(F, b, h, false, AT_FL, AT_SC); cur_bh = bh; }
                attn_unit_naive(F, b * SEQ + 256 * qb, NMETA + 256 * qb, 1 + 4 * (qb + 1), b * SEQ, h); }
            else { attn_scan(F, 0, u - 1024, true, AT_FL, AT_SC); cur_bh = -1; attn_unit_naive(F, TX, 0, 1, 0, u - 1024); }
        }
    }
    __syncthreads();
}

__device__ __forceinline__ void class_tables(Frame& F, int l) {
    LAS int* base = (LAS int*)(F.lds + LC_BASE); LAS int* pcls = (LAS int*)(F.lds + LC_PCLS); LAS int* np = (LAS int*)(F.lds + LC_NP);
    const unsigned* gcnt = (const unsigned*)(WSP() + WS_CTL) + CW_GCNT + l * 64;
    __syncthreads();
    if (F.tid == 0) { int p = 0;
#pragma unroll 1
        for (int c = 0; c < NCLS; ++c) { base[c] = p * 256; int n = (int)__hip_atomic_load(gcnt + c, __ATOMIC_RELAXED, __HIP_MEMORY_SCOPE_AGENT); if (n > TM) n = TM; if (n < 0) n = 0; p += (n + 255) >> 8; }
        if (p > 160) p = 160; base[NCLS] = p * 256; np[0] = p; }
    __syncthreads();
    if (F.tid < 160) { const int mypos = F.tid * 256; int c = 0;
#pragma unroll 1
        for (int k = 1; k < NCLS; ++k) if (base[k] <= mypos) c = k;
        pcls[F.tid] = c; }
    __syncthreads();
}
__device__ __forceinline__ void phase_E1(Frame& F, int l) {
    LAS float* R = (LAS float*)F.lds;
    LAS int* rec = (LAS int*)(F.lds + 81920);
    LAS int* lcnt = (LAS int*)(F.lds + LC_CNT); LAS int* wgb = (LAS int*)(F.lds + LC_BASE);
    const float* rg = (const float*)(WSP() + WS_RG); const float* H = (const float*)(WSP() + WS_H);
    const float* reb = INP(I_REB) + l * 16; const float* rgb = INP(I_RGB) + l * 4;
    unsigned* gcnt = (unsigned*)(WSP() + WS_CTL) + CW_GCNT + l * 64; int* route = (int*)(WSP() + WS_ROUTE);
    const int tid = F.tid, lane = F.lane, wave = F.wave;
    for (int i = tid; i < 5120; i += 512) *(LAS f32x4*)(R + 4 * i) = *(const f32x4*)(rg + 4 * i);
    for (int wg = F.vcu; wg < 256; wg += F.G) {
        if (tid < NCLS) lcnt[tid] = 0;
        __syncthreads();

#pragma unroll 1
for (int rr = wave; rr < 129; rr += 8) { const int row = wg * 129 + rr;
            f32x4 hv[4]; float ss = 0.f;
#pragma unroll
            for (int j = 0; j < 4; ++j) { hv[j] = *(const f32x4*)(H + (size_t)row * D + 4 * lane + 256 * j); ss += hv[j][0] * hv[j][0] + hv[j][1] * hv[j][1] + hv[j][2] * hv[j][2] + hv[j][3] * hv[j][3]; }
            const float rstd2 = rsqrtf(wave_sum(ss) * (1.0f / D) + EPS);
            float lg[20];
#pragma unroll
            for (int c = 0; c < 20; ++c) { float s = 0.f;
#pragma unroll
                for (int j = 0; j < 4; ++j) { const f32x4 w = *(const LAS f32x4*)(R + c * 1024 + 4 * lane + 256 * j); s += hv[j][0] * w[0] + hv[j][1] * w[1] + hv[j][2] * w[2] + hv[j][3] * w[3]; }
                lg[c] = wave_sum(s) * rstd2 + (c < 16 ? reb[c] : rgb[c - 16]); }
            int gsel = 0; float gmax = lg[16];
#pragma unroll
            for (int g = 1; g < 4; ++g) if (lg[16 + g] > gmax) { gmax = lg[16 + g]; gsel = g; }
            float gsum = 0.f;
#pragma unroll
            for (int g = 0; g < 4; ++g) gsum += __expf(lg[16 + g] - gmax);
            const float gwt = 1.0f / gsum;
            float el[4];
#pragma unroll
            for (int e = 0; e < 4; ++e) el[e] = gsel == 0 ? lg[e] : (gsel == 1 ? lg[4 + e] : (gsel == 2 ? lg[8 + e] : lg[12 + e]));
            int t1 = 0; float l1 = el[0];
#pragma unroll
            for (int e = 1; e < 4; ++e) if (el[e] > l1) { l1 = el[e]; t1 = e; }
            int t2 = -1; float l2 = -3.0e38f;
#pragma unroll
            for (int e = 0; e < 4; ++e) if (e != t1 && el[e] > l2) { l2 = el[e]; t2 = e; }
            const float w1 = 1.0f / (1.0f + __expf(l2 - l1)), w2 = 1.0f - w1;
            const int ea = min(t1, t2), eb = max(t1, t2); const float cA = gwt * (t1 == ea ? w1 : w2), cB = gwt * (t1 == ea ? w2 : w1);
            const int pr = ea == 0 ? eb - 1 : (ea == 1 ? eb + 1 : 5); int cls = gsel * 6 + pr; if (!(cls >= 0 && cls < NCLS)) cls = 0;
            if (lane == 0) { const int rank = __hip_atomic_fetch_add(&lcnt[cls], 1, __ATOMIC_RELAXED, __HIP_MEMORY_SCOPE_WORKGROUP); rec[rr * 5] = cls; rec[rr * 5 + 1] = rank; rec[rr * 5 + 2] = __float_as_int(cA); rec[rr * 5 + 3] = __float_as_int(cB); rec[rr * 5 + 4] = __float_as_int(rstd2); }
        }
        __syncthreads();
        if (tid < NCLS) { const int n = lcnt[tid]; wgb[tid] = n > 0 ? (int)atomicAdd(gcnt + tid, (unsigned)n) : 0; }
        __syncthreads();
        for (int rr = tid; rr < 129; rr += 512) { const int row = wg * 129 + rr; const int cls = rec[rr * 5];
            int* rp = route + (size_t)row * 8; rp[0] = cls; rp[1] = wgb[cls] + rec[rr * 5 + 1]; rp[2] = rec[rr * 5 + 2]; rp[3] = rec[rr * 5 + 3]; rp[4] = rec[rr * 5 + 4]; }
        __syncthreads();
    }
}
__device__ __forceinline__ void phase_E1b(Frame& F, int l) {
    class_tables(F, l);
    const LAS int* base = (const LAS int*)(F.lds + LC_BASE);
    const int* route = (const int*)(WSP() + WS_ROUTE); const bf16* HB = (const bf16*)(WSP() + WS_HB); bf16* XS = (bf16*)(WSP() + WS_XS); float* PW = (float*)(WSP() + WS_PW);
    const int gw = F.vcu * NWAVES + F.wave, NGW = F.G * NWAVES, lane = F.lane;

#pragma unroll 1
for (int row = gw; row < TM; row += NGW) { const int* rp = route + (size_t)row * 8; const int cls = rp[0]; const int pos = base[cls] + rp[1];
        if (pos < 0 || pos >= NPOSMAX) continue;
#pragma unroll
        for (int j = 0; j < 2; ++j) *(u32x4*)(XS + (size_t)pos * D + 8 * lane + 512 * j) = *(const u32x4*)(HB + (size_t)row * D + 8 * lane + 512 * j);
        if (lane == 0) { f32x4 w; w[0] = __int_as_float(rp[4]); w[1] = __int_as_float(rp[2]); w[2] = __int_as_float(rp[3]); w[3] = 0.f; *(f32x4*)(PW + (size_t)pos * 4) = w; } }
}
__device__ __forceinline__ void phase_E4(Frame& F, int l) {
    class_tables(F, l);
    const LAS int* base = (const LAS int*)(F.lds + LC_BASE);
    const int* route = (const int*)(WSP() + WS_ROUTE); float* H = (float*)(WSP() + WS_H); bf16* HB = (bf16*)(WSP() + WS_HB); const bf16* Y = (const bf16*)(WSP() + WS_Y);
    float* rstd1 = (float*)(WSP() + WS_RSTD1); const float* fg = INP(I_FG); float* out = (float*)DOP();
    const int gw = F.vcu * NWAVES + F.wave, NGW = F.G * NWAVES, lane = F.lane; const bool lastl = (l == DEPTH - 1);

#pragma unroll 1
for (int row = gw; row < TM; row += NGW) { const int* rp = route + (size_t)row * 8; const int cls = rp[0]; int pos = base[cls] + rp[1]; if (pos < 0 || pos >= NPOSMAX) pos = 0;
        f32x4 hv[2][2]; float ss = 0.f;
#pragma unroll
        for (int j = 0; j < 2; ++j) { const u32x4 yw = *(const u32x4*)(Y + (size_t)pos * D + 8 * lane + 512 * j);
            hv[j][0] = *(const f32x4*)(H + (size_t)row * D + 8 * lane + 512 * j); hv[j][1] = *(const f32x4*)(H + (size_t)row * D + 8 * lane + 512 * j + 4);
            hv[j][0][0] += bflo(yw.x); hv[j][0][1] += bfhi(yw.x); hv[j][0][2] += bflo(yw.y); hv[j][0][3] += bfhi(yw.y);
            hv[j][1][0] += bflo(yw.z); hv[j][1][1] += bfhi(yw.z); hv[j][1][2] += bflo(yw.w); hv[j][1][3] += bfhi(yw.w);
#pragma unroll
            for (int q = 0; q < 2; ++q) ss += hv[j][q][0] * hv[j][q][0] + hv[j][q][1] * hv[j][q][1] + hv[j][q][2] * hv[j][q][2] + hv[j][q][3] * hv[j][q][3]; }
        const float rs = rsqrtf(wave_sum(ss) * (1.0f / D) + EPS);
        if (!lastl) {
#pragma unroll
            for (int j = 0; j < 2; ++j) { *(f32x4*)(H + (size_t)row * D + 8 * lane + 512 * j) = hv[j][0]; *(f32x4*)(H + (size_t)row * D + 8 * lane + 512 * j + 4) = hv[j][1];
                *(u32x4*)(HB + (size_t)row * D + 8 * lane + 512 * j) = pack8(hv[j][0], hv[j][1]); }
            if (lane == 0) rstd1[row] = rs;
        } else if (row < TX) {
#pragma unroll
            for (int j = 0; j < 2; ++j) { const f32x4 g0 = *(const f32x4*)(fg + 8 * lane + 512 * j), g1 = *(const f32x4*)(fg + 8 * lane + 512 * j + 4);
                *(f32x4*)(out + (size_t)row * D + 8 * lane + 512 * j) = hv[j][0] * rs * g0; *(f32x4*)(out + (size_t)row * D + 8 * lane + 512 * j + 4) = hv[j][1] * rs * g1; }
        }
    }
}

#define RELANE() do { const int t_ = wv0 * 64 + lane_id_opaque(); F.tid = t_; F.lane = t_ & 63; F.wave = __builtin_amdgcn_readfirstlane(t_ >> 6); \
    int g_ = gridDim.x; LAUNDER_S(g_); int b_ = blockIdx.x; LAUNDER_S(b_); F.G = g_; F.bx = b_; F.vcu = (g_ % 8 == 0) ? (b_ % 8) * (g_ / 8) + b_ / 8 : b_; ll = l; LAUNDER_S(ll); } while (0)
__global__ void __launch_bounds__(NWAVES * 64, 2) fwd_kernel(Params P) {
    extern __shared__ __attribute__((aligned(16))) unsigned char lds_raw[];
    Frame F;
    F.lds = (LAS unsigned char*)lds_raw;
    F.tid = threadIdx.x; F.lane = F.tid & 63; F.wave = __builtin_amdgcn_readfirstlane(F.tid >> 6);
    F.G = gridDim.x; { const int bx = blockIdx.x; F.vcu = (F.G % 8 == 0) ? (bx % 8) * (F.G / 8) + bx / 8 : bx; }
    if (F.tid == 0) { LAS unsigned long long* pt = (LAS unsigned long long*)(F.lds + LC_PTAB);
#pragma unroll
        for (int i = 0; i < 25; ++i) pt[i] = (unsigned long long)P.in[i];
        pt[25] = (unsigned long long)P.ws; pt[26] = (unsigned long long)P.out; }
    for (int u = F.tid; u < 256; u += NWAVES * 64) ((LAS unsigned*)(F.lds + RING_BYTES))[u] = 0u;
    __syncthreads();
    const int lo = P.ph_lo, hi = P.ph_hi;
    const bool use_bar = (hi - lo) > 1;
    unsigned* barw = (unsigned*)(P.ws + WS_CTL) + CW_BAR;
    XcdBarrier bar; bar.bar = barw; bar.x = 0; bar.st = (volatile LAS unsigned*)(F.lds + LC_BAR);
    if (use_bar) bar = xcd_barrier_post(barw, (volatile LAS unsigned*)(F.lds + LC_BAR));
#ifndef PHASE_MASK
#define PHASE_MASK 0x7ff
#endif
#define EN(j) (((PHASE_MASK) >> (j)) & 1)
#ifndef DUP_MASK
#define DUP_MASK 0
#endif
#define NREP(j) ((((DUP_MASK) >> (j)) & 1) ? 2 : 1)
#define IN(k) (lo <= (k) && (k) < hi)
#define SEAM(k) do { if (IN(k) && IN((k) + 1)) xcd_barrier(bar); } while (0)

    int l = 0, ll = 0; const int wv0 = __builtin_amdgcn_readfirstlane((int)threadIdx.x >> 6);
    if (EN(0) && IN(0)) { RELANE(); convert_weights(F, 0); RELANE(); init_rows(F); }
    SEAM(0);
    for (l = 0; l < DEPTH; ++l) {
        const int pb = 1 + 10 * l;
        for (int rep = 0; rep < NREP(1); ++rep)
        if (EN(1) && IN(pb + 0)) {
            RELANE();
            unsigned char* wsl = WSP(); unsigned char* dol = DOP();
            pg8::Gemm g{(const bf16*)(wsl + WS_HB), 1024, 1024, 1 << 20};
            pg8::StaticOrder S; S.init(TM, N1, F.G, F.bx, (const bf16*)(wsl + WS_W1T), 1024);
            Epi1 E{(const float*)(wsl + WS_RSTD1), (bf16*)(wsl + WS_A), (bf16*)(wsl + WS_GLU), (bf16*)(dol + DO_Q), (bf16*)(wsl + WS_G)};
            pg8::gemm_phase<Epi1, pg8::StaticOrder>(F.lds, g, S, E, F.wave);
        }
        SEAM(pb + 0);
        for (int rep = 0; rep < NREP(2); ++rep)
        if (EN(2) && IN(pb + 1)) { RELANE(); phase_S(F, ll); }
        SEAM(pb + 1);
        for (int rep = 0; rep < NREP(3); ++rep)
        if (EN(3) && IN(pb + 2)) { RELANE(); phase_B(F); }
        SEAM(pb + 2);
        for (int rep = 0; rep < NREP(4); ++rep)
        if (EN(4) && IN(pb + 3)) {
            RELANE(); unsigned char* wsl = WSP(); unsigned char* dol = DOP();
            pg8::Gemm g{(const bf16*)(wsl + WS_X3), 1024, 1024, 1 << 20}; pg8::SegOrder S; S.init(TM, 1024, F.G, F.bx, (const bf16*)(wsl + WS_W3CT), 1024);
            EpiCS E{(const bf16*)(wsl + WS_G), (bf16*)(dol + DO_MERGED), (const float*)(wsl + WS_BIASA)}; pg8::gemm_phase<EpiCS, pg8::SegOrder>(F.lds, g, S, E, F.wave);
        }
        SEAM(pb + 3);
        if (EN(5) && IN(pb + 4)) {
            RELANE();
            unsigned char* wsl = WSP(); unsigned char* dol = DOP();
            pg8::Gemm g{(const bf16*)(dol + DO_MERGED), 1024, 1024, 1 << 20}; pg8::StaticOrder S; S.init(TM, 1024, F.G, F.bx, (const bf16*)(wsl + WS_WOT), 1024);
            EpiD E{(float*)(wsl + WS_H), (bf16*)(wsl + WS_HB)}; pg8::gemm_phase<EpiD, pg8::StaticOrder>(F.lds, g, S, E, F.wave);
        }
        SEAM(pb + 4);
        if (EN(6) && IN(pb + 5)) { RELANE(); phase_E1(F, ll); }
        SEAM(pb + 5);
        for (int rep = 0; rep < NREP(7); ++rep)
        if (EN(7) && IN(pb + 6)) { RELANE(); phase_E1b(F, ll); }
        SEAM(pb + 6);
        for (int rep = 0; rep < NREP(8); ++rep)
        if (EN(8) && IN(pb + 7)) {
            RELANE(); class_tables(F, ll);
            unsigned char* wsl = WSP();
            const int NP = __builtin_amdgcn_readfirstlane(*(const LAS int*)(F.lds + LC_NP));
            pg8::Gemm g{(const bf16*)(wsl + WS_XS), 1024, 1024, 1 << 20};
            MoeOrder S{NP, F.G, F.vcu, 0, (const LAS int*)(F.lds + LC_PCLS), (const bf16*)(DOP() + DO_W13T)};
            EpiA2 E{(const float*)(wsl + WS_PW), (bf16*)(wsl + WS_HH)}; pg8::gemm_phase<EpiA2, MoeOrder>(F.lds, g, S, E, F.wave);
        }
        SEAM(pb + 7);
        for (int rep = 0; rep < NREP(9); ++rep)
        if (EN(9) && IN(pb + 8)) {
            RELANE(); class_tables(F, ll);
            unsigned char* wsl = WSP();
            const int NP = __builtin_amdgcn_readfirstlane(*(const LAS int*)(F.lds + LC_NP));
            pg8::Gemm g{(const bf16*)(wsl + WS_HH), 512, 256, 4};
            MoeOrder S{NP, F.G, F.vcu, 1, (const LAS int*)(F.lds + LC_PCLS), (const bf16*)(DOP() + DO_W2T)};
            EpiB2 E{(bf16*)(wsl + WS_Y)}; pg8::gemm_phase<EpiB2, MoeOrder>(F.lds, g, S, E, F.wave);
        }
        SEAM(pb + 8);
        if (EN(10) && IN(pb + 9)) { RELANE(); phase_E4(F, ll); if (l + 1 < DEPTH) { RELANE(); convert_weights(F, ll + 1); } }
        SEAM(pb + 9);
    }
#undef IN
#undef SEAM
}

constexpr int N_PHASES = 1 + 10 * DEPTH;

extern "C" void kernel_launch(void* const* d_in, const int* in_sizes, int n_in, void* d_out, int out_size, void* d_ws, size_t ws_size, hipStream_t stream) {
    static int grid = 0;
    if (grid == 0) {
        if (n_in != 25 || out_size != TX * D || ws_size < WS_END) { fprintf(stderr, "kernel_launch: unexpected shapes: n_in %d out %d ws %zu (need %zu)\n", n_in, out_size, ws_size, (size_t)WS_END); grid = -1; return; }
        int dev = 0, cus = 0, per_cu = 0;
        if (hipGetDevice(&dev) != hipSuccess || hipDeviceGetAttribute(&cus, hipDeviceAttributeMultiprocessorCount, dev) != hipSuccess) { grid = -1; return; }
        if (hipFuncSetAttribute((const void*)fwd_kernel, hipFuncAttributeMaxDynamicSharedMemorySize, LDS_BYTES) != hipSuccess) { fprintf(stderr, "kernel_launch: hipFuncSetAttribute failed\n"); grid = -1; return; }
        if (hipOccupancyMaxActiveBlocksPerMultiprocessor(&per_cu, (const void*)fwd_kernel, NWAVES * 64, LDS_BYTES) != hipSuccess || per_cu < 1) fprintf(stderr, "kernel_launch: occupancy query reports %d\n", per_cu);
        (void)hipGetLastError();
        grid = cus;
    }
    if (grid < 0) return;
    (void)hipMemsetAsync((char*)d_ws + WS_CTL, 0, CTL_BYTES, stream);
    Params p{};
    for (int i = 0; i < 25; ++i) p.in[i] = (const float*)d_in[i];
    p.out = (float*)d_out; p.ws = (unsigned char*)d_ws;
#if N_LAUNCH_MODE == 1
    p.ph_lo = 0; p.ph_hi = N_PHASES;
    hipLaunchKernelGGL(fwd_kernel, dim3(grid), dim3(NWAVES * 64), LDS_BYTES, stream, p);
#else
    for (int ph = 0; ph < N_PHASES; ++ph) { p.ph_lo = ph; p.ph_hi = ph + 1; hipLaunchKernelGGL(fwd_kernel, dim3(grid), dim3(NWAVES * 64), LDS_BYTES, stream, p); }
#endif
}
```

```cpp
#include <hip/hip_runtime.h>
#include <cstdio>
#include <cstdint>

#ifndef N_LAUNCH_MODE
#define N_LAUNCH_MODE 1
#endif

#define GAS __attribute__((address_space(1)))
#define LAS __attribute__((address_space(3)))
typedef unsigned short bf16;
typedef float f32x4 __attribute__((ext_vector_type(4)));
typedef float f32x2 __attribute__((ext_vector_type(2)));
typedef unsigned u32x4 __attribute__((ext_vector_type(4)));
typedef unsigned u32x2 __attribute__((ext_vector_type(2)));
typedef short bf16x8 __attribute__((ext_vector_type(8)));
typedef __bf16 bf16x2v __attribute__((ext_vector_type(2)));

constexpr int D = 1024, NB = 4, SEQ = 8192, NMETA = 16, DEPTH = 2;
constexpr int TX = NB * SEQ;
constexpr int TM = TX + 64;
constexpr int TR = TX + NMETA;
constexpr int NIN = 5384, N1 = 5376;
constexpr int NHEAD = 8;
constexpr int NCLS = 24;
constexpr int NPOSMAX = TX + 256 + NCLS * 256;
constexpr float EPS = 1e-6f;
constexpr float LOG2E = 1.4426950408889634f;
constexpr float C2 = 0.125f * LOG2E;
constexpr int NWAVES = 8;

constexpr size_t U = (size_t)TM * 1024 * 2;
constexpr size_t WS_CTL = 0, CTL_BYTES = 1u << 20;
constexpr size_t WS_H = CTL_BYTES;
constexpr size_t WS_HB = WS_H + 2 * U;
constexpr size_t WS_G = WS_HB + U;
constexpr size_t WS_XS = WS_G;
constexpr size_t WS_Y = WS_XS + (size_t)NPOSMAX * 2048;
constexpr size_t WS_HH = WS_Y + (size_t)NPOSMAX * 2048;
static_assert(WS_HH + (size_t)NPOSMAX * 1024 <= WS_G + 3 * U, "MoE overlay fits the gates region");
constexpr size_t WS_A = WS_G + 3 * U;
constexpr size_t WS_GLU = WS_A + U / 4;
constexpr size_t WS_X3 = WS_GLU + U / 4;
constexpr size_t WS_W1T = WS_X3 + U;
constexpr size_t WS_W3CT = WS_W1T + (size_t)N1 * 1024 * 2;
constexpr size_t WS_WOT = WS_W3CT + 1024 * 1024 * 2;
constexpr size_t WS_WFG = WS_WOT + 1024 * 1024 * 2;
constexpr size_t WS_RG = WS_WFG + 8 * 1024 * 4;
constexpr size_t WS_BIASA = WS_RG + 20 * 1024 * 4;
constexpr size_t WS_RSTD1 = WS_BIASA + 4096;
constexpr size_t WS_ROUTE = WS_RSTD1 + (size_t)TM * 4;
constexpr size_t WS_PW = WS_ROUTE + (size_t)TM * 32;
constexpr size_t WS_LFT = WS_PW + (size_t)NPOSMAX * 16;
constexpr size_t WS_LFTM = WS_LFT + (size_t)32 * 8192 * 4;
constexpr size_t WS_END = WS_LFTM + 8 * 256 * 4;
static_assert(WS_END <= (size_t)512 * 1024 * 1024, "d_ws map fits 512 MiB");
constexpr size_t DO_Q = 0, DO_K = U / 2, DO_V = U, DO_MERGED = U / 2;
constexpr size_t DO_W13T = 3 * U / 2;
constexpr size_t DO_W2T = DO_W13T + (size_t)16 * 512 * 1024 * 2;
static_assert(DO_W2T + (size_t)16 * 1024 * 256 * 2 <= (size_t)TX * 1024 * 4, "d_out scratch");
constexpr int CW_BAR = 4096, CW_GCNT = 16384;

constexpr int RING_BYTES = 131072;
constexpr int LC_BAR = RING_BYTES, LC_CNT = RING_BYTES + 64, LC_BASE = RING_BYTES + 192, LC_PCLS = RING_BYTES + 320, LC_NP = RING_BYTES + 960;
constexpr int LC_PTAB = RING_BYTES + 1024;
constexpr int LDS_BYTES = RING_BYTES + 1024 + 7168;

#define LDS_WAIT() asm volatile("s_waitcnt lgkmcnt(0)" ::: "memory")
#define VM_WAIT() asm volatile("s_waitcnt vmcnt(0)" ::: "memory")
#define LAUNDER_S(p) asm volatile("" : "+s"(p))
#define LAUNDER_V(x) asm volatile("" : "+v"(x))
__device__ __forceinline__ int lane_id_opaque() { int x; asm volatile("v_mbcnt_lo_u32_b32 %0, -1, 0\n\tv_mbcnt_hi_u32_b32 %0, -1, %0" : "=v"(x)); return x; }

__device__ __forceinline__ unsigned f2bf(float f) { unsigned u = __builtin_bit_cast(unsigned, f); return (u + 0x7fffu + ((u >> 16) & 1u)) >> 16; }
__device__ __forceinline__ unsigned pk2(float lo, float hi) { f32x2 v = {lo, hi}; bf16x2v b = __builtin_convertvector(v, bf16x2v); return __builtin_bit_cast(unsigned, b); }
__device__ __forceinline__ float bflo(unsigned w) { return __builtin_bit_cast(float, w << 16); }
__device__ __forceinline__ float bfhi(unsigned w) { return __builtin_bit_cast(float, w & 0xffff0000u); }
template <int O> __device__ __forceinline__ float lane_xor(float v) {
    if constexpr (O < 32) return __int_as_float(__builtin_amdgcn_ds_swizzle(__float_as_int(v), (O << 10) | 0x1f));
    else { auto rr = __builtin_amdgcn_permlane32_swap(__float_as_uint(v), __float_as_uint(v), false, false); return __uint_as_float(rr[0]) + __uint_as_float(rr[1]) - v; }
}
__device__ __forceinline__ float wave_sum(float v) {
    v += lane_xor<1>(v); v += lane_xor<2>(v); v += lane_xor<4>(v); v += lane_xor<8>(v); v += lane_xor<16>(v);
    auto rr = __builtin_amdgcn_permlane32_swap(__float_as_uint(v), __float_as_uint(v), false, false);
    return __uint_as_float(rr[0]) + __uint_as_float(rr[1]);
}
__device__ __forceinline__ float sigmoidf_(float x) { return __builtin_amdgcn_rcpf(1.0f + __builtin_amdgcn_exp2f(-LOG2E * x)); }
__device__ __forceinline__ float dot2bf(unsigned a, unsigned b, float acc) { return __builtin_amdgcn_fdot2_f32_bf16(__builtin_bit_cast(bf16x2v, a), __builtin_bit_cast(bf16x2v, b), acc, false); }

namespace pg8 {
constexpr int BM = 256, BK = 64, HALF = 128, HTB = HALF * BK * 2, STAGE_BYTES = 8 * HTB, NXCD = 8, WGM = 8;
__host__ __device__ __forceinline__ int lds_byte(int r, int c) { const int st = (r >> 4) * 2 + (c >> 5), rr = r & 15, cc = c & 31, ob = rr * 64 + cc * 2; return st * 1024 + (ob ^ (((ob >> 9) & 1) << 5)); }
__host__ __device__ __forceinline__ void stage_rc(int b, int& R, int& C) { const int st = b / 1024, sb = b % 1024, swz = sb ^ (((sb >> 9) & 1) << 5); R = (st >> 1) * 16 + swz / 64; C = (st & 1) * 32 + (swz % 64) / 2; }
__host__ __device__ __forceinline__ int perm32(int rho) { const int n = rho >> 4, i = rho & 15; return 8 * (i >> 2) + 4 * n + (i & 3); }

struct Unit { int pm, pn, seg; };
struct Gemm { const bf16* A; int K; int ldb; int ksplit; };

struct StaticOrder {
    int nM, nN, nwg, G, c; const bf16* Bt; size_t btile;
    __device__ void init(int M, int N, int G_, int c_, const bf16* Bt_, int ldb) { nM = M / BM; nN = N / BM; nwg = nM * nN; G = G_; c = c_; Bt = Bt_; btile = (size_t)BM * ldb * 2; }
    __device__ bool next(int i, Unit& u) const {
        const long L = (long)i * G + c; if (L >= nwg) return false;
        int wgid = (int)L; { const int q = nwg / NXCD, r = nwg % NXCD, xcd = wgid % NXCD, off = wgid / NXCD; wgid = (xcd < r ? xcd * (q + 1) : r * (q + 1) + (xcd - r) * q) + off; }
        const int nig = WGM * nN, gid = wgid / nig, fm = gid * WGM, gsz = (nM - fm) < WGM ? (nM - fm) : WGM;
        u.pm = fm + ((wgid % nig) % gsz); u.pn = (wgid % nig) / gsz; u.seg = 0; return true;
    }
    __device__ __forceinline__ const char* bptr(const Unit& u, int) const { return (const char*)Bt + (size_t)u.pn * btile; }
    __device__ __forceinline__ int nt(const Unit&, int ntd) const { return ntd; }
    __device__ __forceinline__ size_t aoff(const Unit&) const { return 0; }
};
struct SegOrder : StaticOrder {
    __device__ bool next(int i, Unit& u) const { const int q = i / 3; if (!StaticOrder::next(q, u)) return false; u.seg = i - 3 * q; return true; }
    __device__ __forceinline__ size_t koff(const Unit& u) const { return u.seg == 0 ? 0 : (u.seg == 1 ? 512 : 1024); }
    __device__ __forceinline__ const char* bptr(const Unit& u, int) const { return (const char*)Bt + (size_t)u.pn * btile + koff(u); }
    __device__ __forceinline__ int nt(const Unit& u, int) const { return u.seg == 2 ? 8 : 4; }
    __device__ __forceinline__ size_t aoff(const Unit& u) const { return koff(u); }
};

template <class Epi, class Sched, bool ALIGN_EPI = true, bool SP2 = true>
__device__ __forceinline__ void gemm_phase(LAS unsigned char* lds, const Gemm g, const Sched& S, const Epi& E, const int wave_id) {
    const int tid = wave_id * 64 + lane_id_opaque();
    const int wid = __builtin_amdgcn_readfirstlane(tid >> 6), lane = tid & 63, wr = wid >> 2, wc = wid & 3, fr = lane & 15, fq = lane >> 4;
    const int K = g.K, nt = K / BK, ldb = g.ldb, ks = g.ksplit;
    unsigned voffA[2], voffB[2];
#pragma unroll
    for (int i = 0; i < 2; ++i) { int R, C; stage_rc(tid * 16 + i * 8192, R, C); const int Rb = Epi::PERM ? ((R & ~31) + perm32(R & 31)) : R;
        voffA[i] = (unsigned)(R * K + C) * 2u; voffB[i] = (unsigned)(Rb * ldb + C) * 2u; }
    const size_t kstep = (size_t)(BK * 2);
    const size_t hstep = (size_t)HALF * K * 2;
    const size_t hstepB = (size_t)HALF * ldb * 2;
    const size_t tstep = 2 * hstep;
    const unsigned ldsw = (unsigned)wid * 1024u;
    const int aoff = lds_byte(wr * 64 + fr, fq * 8), boff = lds_byte(wc * 32 + fr, fq * 8);
#define PG8_SA(b, h) (((b) * 2 + (h)) * HTB)
#define PG8_SB(b, h) ((4 + (b) * 2 + (h)) * HTB)
#define PG8_STAGE(bufoff, gbase, voff) do { _Pragma("unroll") for (int _i = 0; _i < 2; ++_i) \
        __builtin_amdgcn_global_load_lds((const unsigned*)((const char*)(gbase) + (voff)[_i]), (LAS unsigned*)(lds + (bufoff) + ldsw + _i * 8192), 16, 0, 0); } while (0)
#define PG8_LDA(dst, b, h) do { _Pragma("unroll") for (int m = 0; m < 4; ++m) _Pragma("unroll") for (int k = 0; k < 2; ++k) dst[m][k] = *(const LAS bf16x8*)(lds + PG8_SA(b, h) + aoff + m * 2048 + k * 1024); } while (0)
#define PG8_LDB(dst, b, h) do { _Pragma("unroll") for (int n = 0; n < 2; ++n) _Pragma("unroll") for (int k = 0; k < 2; ++k) dst[n][k] = *(const LAS bf16x8*)(lds + PG8_SB(b, h) + boff + n * 2048 + k * 1024); } while (0)
#define PG8_MMA(ai, bj, At, Bt) do { __builtin_amdgcn_s_setprio(1); _Pragma("unroll") for (int m = 0; m < 4; ++m) _Pragma("unroll") for (int n = 0; n < 2; ++n) _Pragma("unroll") for (int k = 0; k < 2; ++k) \
        acc[ai][bj][m][n] = __builtin_amdgcn_mfma_f32_16x16x32_bf16(Bt[n][k], At[m][k], acc[ai][bj][m][n], 0, 0, 0); __builtin_amdgcn_s_setprio(0); } while (0)
#define PG8_WAIT_V(n) asm volatile("s_waitcnt vmcnt(" #n ")" ::: "memory")
#define PG8_WAIT_L(n) asm volatile("s_waitcnt lgkmcnt(" #n ")" ::: "memory")
#define PG8_BAR __builtin_amdgcn_s_barrier()
#define PG8_SCHED __builtin_amdgcn_sched_barrier(0)
    Unit cur, nxt; int ui = 0;
    if (!S.next(0, cur)) return;
    f32x4 acc[2][2][4][2];
    { float z_ = 0.f; LAUNDER_V(z_);
#pragma unroll
    for (int a = 0; a < 2; ++a)
#pragma unroll
        for (int b = 0; b < 2; ++b)
#pragma unroll
            for (int m = 0; m < 4; ++m)
#pragma unroll
                for (int n = 0; n < 2; ++n) acc[a][b][m][n] = (f32x4){z_, z_, z_, z_}; }
    bf16x8 At[4][2], B0[2][2], B1[2][2];
    int ntc = S.nt(cur, nt);
    const char* cA = (const char*)g.A + (size_t)cur.pm * tstep + S.aoff(cur); const char* cB = S.bptr(cur, 0); const char* cB1 = S.bptr(cur, 1) - (size_t)ks * kstep;
    if constexpr (SP2) {
        PG8_STAGE(PG8_SB(0, 0), cB, voffB); PG8_STAGE(PG8_SB(0, 1), cB + hstepB, voffB); PG8_STAGE(PG8_SA(0, 0), cA, voffA); PG8_STAGE(PG8_SA(0, 1), cA + hstep, voffA);
        if (wr == 1) PG8_BAR;
        PG8_WAIT_V(2); PG8_BAR;
        PG8_STAGE(PG8_SB(1, 0), cB + kstep, voffB); PG8_STAGE(PG8_SA(1, 0), cA + kstep, voffA); PG8_STAGE(PG8_SB(1, 1), cB + hstepB + kstep, voffB);
        PG8_WAIT_V(6); PG8_BAR;
    } else {
        PG8_STAGE(PG8_SB(0, 0), cB, voffB); PG8_STAGE(PG8_SA(0, 0), cA, voffA); PG8_STAGE(PG8_SB(0, 1), cB + hstepB, voffB); PG8_STAGE(PG8_SA(0, 1), cA + hstep, voffA);
        if (wr == 1) PG8_BAR;
        PG8_WAIT_V(4); PG8_BAR;
        PG8_STAGE(PG8_SB(1, 0), cB + kstep, voffB); PG8_STAGE(PG8_SA(1, 0), cA + kstep, voffA); PG8_STAGE(PG8_SB(1, 1), cB + hstepB + kstep, voffB);
        PG8_WAIT_V(6); PG8_BAR;
    }
    for (;;) {
        const bool has_next = S.next(ui + 1, nxt);
        const char* nA = has_next ? (const char*)g.A + (size_t)nxt.pm * tstep + S.aoff(nxt) : cA; const char* nB = has_next ? S.bptr(nxt, 0) : cB;
        const char* nB1 = has_next ? S.bptr(nxt, 1) - (size_t)ks * kstep : cB1;
#pragma unroll 1
        for (int t = 0; t < ntc; t += 2) {
            const bool last = (t == ntc - 2);
            const char* a1 = cA + (size_t)(t + 1) * kstep;
            const char* bside = (t + 2 < ks) ? cB : cB1;
            const char* a2 = last ? nA : cA + (size_t)(t + 2) * kstep; const char* b2 = last ? nB : bside + (size_t)(t + 2) * kstep;
            const char* a3 = a2 + kstep; const char* b3 = b2 + kstep;
            if constexpr (SP2) {
            PG8_LDB(B0, 0, 0); PG8_LDB(B1, 0, 1); PG8_SCHED; PG8_LDA(At, 0, 0); PG8_STAGE(PG8_SA(1, 1), a1 + hstep, voffA);
            PG8_WAIT_V(8); PG8_WAIT_L(0); PG8_BAR; PG8_MMA(0, 0, At, B0); PG8_MMA(0, 1, At, B1); PG8_BAR; PG8_SCHED;
            PG8_LDA(At, 0, 1); PG8_STAGE(PG8_SB(0, 0), b2, voffB); PG8_STAGE(PG8_SB(0, 1), b2 + hstepB, voffB); PG8_STAGE(PG8_SA(0, 0), a2, voffA);
            PG8_WAIT_V(8); PG8_WAIT_L(0); PG8_BAR; PG8_MMA(1, 0, At, B0); PG8_MMA(1, 1, At, B1); PG8_BAR; PG8_SCHED;
            PG8_LDB(B0, 1, 0); PG8_LDB(B1, 1, 1); PG8_SCHED; PG8_LDA(At, 1, 0); PG8_STAGE(PG8_SA(0, 1), a2 + hstep, voffA);
            PG8_WAIT_V(8); PG8_WAIT_L(0); PG8_BAR; PG8_MMA(0, 0, At, B0); PG8_MMA(0, 1, At, B1); PG8_BAR; PG8_SCHED;
            PG8_LDA(At, 1, 1); PG8_STAGE(PG8_SB(1, 0), b3, voffB); PG8_STAGE(PG8_SB(1, 1), b3 + hstepB, voffB); PG8_STAGE(PG8_SA(1, 0), a3, voffA);
            PG8_WAIT_V(8); PG8_WAIT_L(0); PG8_BAR; PG8_MMA(1, 0, At, B0); PG8_MMA(1, 1, At, B1); PG8_BAR; PG8_SCHED;
            } else {
            PG8_LDB(B0, 0, 0); PG8_SCHED; PG8_LDA(At, 0, 0); PG8_STAGE(PG8_SA(1, 1), a1 + hstep, voffA);
            PG8_WAIT_L(8); PG8_BAR; PG8_WAIT_L(0); PG8_MMA(0, 0, At, B0); PG8_BAR; PG8_SCHED;
            PG8_LDB(B1, 0, 1); PG8_STAGE(PG8_SB(0, 0), b2, voffB);
            PG8_BAR; PG8_WAIT_L(0); PG8_MMA(0, 1, At, B1); PG8_BAR;
            PG8_LDA(At, 0, 1); PG8_STAGE(PG8_SA(0, 0), a2, voffA);
            PG8_BAR; PG8_WAIT_L(0); PG8_MMA(1, 0, At, B0); PG8_BAR; PG8_SCHED;
            PG8_STAGE(PG8_SB(0, 1), b2 + hstepB, voffB);
            PG8_WAIT_V(6); PG8_BAR; PG8_MMA(1, 1, At, B1); PG8_BAR;
            PG8_LDB(B0, 1, 0); PG8_SCHED; PG8_LDA(At, 1, 0); PG8_STAGE(PG8_SA(0, 1), a2 + hstep, voffA);
            PG8_WAIT_L(8); PG8_BAR; PG8_WAIT_L(0); PG8_MMA(0, 0, At, B0); PG8_BAR; PG8_SCHED;
            PG8_LDB(B1, 1, 1); PG8_STAGE(PG8_SB(1, 0), b3, voffB);
            PG8_BAR; PG8_WAIT_L(0); PG8_MMA(0, 1, At, B1); PG8_BAR;
            PG8_LDA(At, 1, 1); PG8_STAGE(PG8_SA(1, 0), a3, voffA);
            PG8_BAR; PG8_WAIT_L(0); PG8_MMA(1, 0, At, B0); PG8_BAR; PG8_SCHED;
            PG8_STAGE(PG8_SB(1, 1), b3 + hstepB, voffB);
            PG8_WAIT_V(6); PG8_BAR; PG8_MMA(1, 1, At, B1); PG8_BAR;
            }
        }
        if constexpr (ALIGN_EPI) { if (wr == 0) PG8_BAR; }
        { const int l2 = lane_id_opaque(); E(acc, cur, wr, wc, l2 & 15, l2 >> 4); }
        if (!has_next) break;
        if (!E.keep(cur)) { float z_ = 0.f; LAUNDER_V(z_);
#pragma unroll
        for (int a = 0; a < 2; ++a)
#pragma unroll
            for (int b = 0; b < 2; ++b)
#pragma unroll
                for (int m = 0; m < 4; ++m)
#pragma unroll
                    for (int n = 0; n < 2; ++n) acc[a][b][m][n] = (f32x4){z_, z_, z_, z_}; }
        cur = nxt; cA = nA; cB = nB; cB1 = nB1; ++ui; ntc = S.nt(cur, nt);
        if constexpr (ALIGN_EPI) { if (wr == 1) PG8_BAR; }
    }
    PG8_WAIT_V(0);
    if constexpr (!ALIGN_EPI) { if (wr == 0) PG8_BAR; }
    PG8_BAR;
#undef PG8_SA
#undef PG8_SB
#undef PG8_STAGE
#undef PG8_LDA
#undef PG8_LDB
#undef PG8_MMA
#undef PG8_WAIT_V
#undef PG8_WAIT_L
#undef PG8_BAR
#undef PG8_SCHED
}
}

typedef f32x4 AccT[2][2][4][2];
__device__ __forceinline__ u32x4 pack8(const f32x4 a, const f32x4 b) { u32x4 w; w.x = pk2(a[0], a[1]); w.y = pk2(a[2], a[3]); w.z = pk2(b[0], b[1]); w.w = pk2(b[2], b[3]); return w; }

struct Epi1 {
    static constexpr bool PERM = true;
    __device__ __forceinline__ bool keep(const pg8::Unit&) const { return false; }
    const float* rstd; bf16* A; bf16* GLU; bf16* QKV; bf16* G;
    __device__ __forceinline__ void operator()(AccT& acc, const pg8::Unit& u, int wr, int wc, int fr, int fq) const { run<false>(acc, u, wr, wc, fr, fq); }
    template <bool SK> __device__ __forceinline__ void run(AccT& acc, const pg8::Unit& u, int wr, int wc, int fr, int fq) const {
        const int row0 = u.pm * 256 + wr * 64 + fr, lc0 = wc * 32 + 8 * fq, pn = u.pn;
#pragma unroll
        for (int ai = 0; ai < (SK ? 1 : 2); ++ai)
#pragma unroll
            for (int m = 0; m < (SK ? 1 : 4); ++m) {
                const int row = row0 + ai * 128 + m * 16; const float rs = rstd[row];
                f32x4 v[2][2];
#pragma unroll
                for (int bj = 0; bj < 2; ++bj)
#pragma unroll
                    for (int n = 0; n < 2; ++n) v[bj][n] = acc[ai][bj][m][n] * rs;
                if (pn == 0) {
#pragma unroll
                    for (int bj = 0; bj < 2; ++bj) *(u32x4*)(A + (size_t)row * 256 + bj * 128 + lc0) = pack8(v[bj][0], v[bj][1]);
                } else if (pn <= 2) {
                    f32x4 o[2];
#pragma unroll
                    for (int n = 0; n < 2; ++n)
#pragma unroll
                        for (int j = 0; j < 4; ++j) o[n][j] = v[0][n][j] * sigmoidf_(v[1][n][j]);
                    *(u32x4*)(GLU + (size_t)row * 256 + (pn - 1) * 128 + lc0) = pack8(o[0], o[1]);
                } else if (pn <= 8) {
                    const int t = (pn - 3) >> 1; bf16* base = QKV + (size_t)t * (U / 4); const float sc = t == 0 ? C2 : 1.0f;
#pragma unroll
                    for (int bj = 0; bj < 2; ++bj) *(u32x4*)(base + (size_t)row * 512 + ((pn - 3) & 1) * 256 + bj * 128 + lc0) = pack8(v[bj][0] * sc, v[bj][1] * sc);
                } else {
#pragma unroll
                    for (int bj = 0; bj < 2; ++bj) { f32x4 o[2];
#pragma unroll
                        for (int n = 0; n < 2; ++n)
#pragma unroll
                            for (int j = 0; j < 4; ++j) o[n][j] = fmaxf(sigmoidf_(v[bj][n][j]), 1e-30f);
                        *(u32x4*)(G + (size_t)row * 3072 + (pn - 9) * 256 + bj * 128 + lc0) = pack8(o[0], o[1]); }
                }
            }
    }
};
struct EpiCS {
    static constexpr bool PERM = true;
    const bf16* G; bf16* Mg; const float* bias;
    __device__ __forceinline__ bool keep(const pg8::Unit& u) const { return u.seg != 2; }
    __device__ __forceinline__ void operator()(AccT& acc, const pg8::Unit& u, int wr, int wc, int fr, int fq) const { run<false>(acc, u, wr, wc, fr, fq); }
    template <bool SK> __device__ __forceinline__ void run(AccT& acc, const pg8::Unit& u, int wr, int wc, int fr, int fq) const {
        const int row0 = u.pm * 256 + wr * 64 + fr, col0 = u.pn * 256 + wc * 32 + 8 * fq;
        const bool lastseg = u.seg == 2; const int w = u.seg, wd = lastseg ? 2 : u.seg + 1; const float bsc = u.seg == 0 ? 1.f : 0.f;
        f32x4 bv[2][2];
#pragma unroll
        for (int bj = 0; bj < 2; ++bj) { bv[bj][0] = *(const f32x4*)(bias + col0 + bj * 128) * bsc; bv[bj][1] = *(const f32x4*)(bias + col0 + bj * 128 + 4) * bsc; }
#pragma unroll
        for (int ai = 0; ai < (SK ? 1 : 2); ++ai) {
            u32x4 gn[4][2], gd[4][2];
#pragma unroll
            for (int m = 0; m < (SK ? 1 : 4); ++m) { const bf16* gp = G + (size_t)(row0 + ai * 128 + m * 16) * 3072 + col0;
#pragma unroll
                for (int bj = 0; bj < 2; ++bj) { gn[m][bj] = *(const u32x4*)(gp + w * 1024 + bj * 128); gd[m][bj] = *(const u32x4*)(gp + wd * 1024 + bj * 128); } }
#pragma unroll
            for (int m = 0; m < (SK ? 1 : 4); ++m) { const int row = row0 + ai * 128 + m * 16;
#pragma unroll
                for (int bj = 0; bj < 2; ++bj) {
                    const u32x4 n4 = gn[m][bj], d4 = gd[m][bj];
                    f32x4 a0 = acc[ai][bj][m][0] + bv[bj][0], a1 = acc[ai][bj][m][1] + bv[bj][1];
#define RAT(gnv, gdv) ((gnv) * (lastseg ? 1.0f : __builtin_amdgcn_rcpf(gdv)))
                    a0[0] *= RAT(bflo(n4.x), bflo(d4.x)); a0[1] *= RAT(bfhi(n4.x), bfhi(d4.x)); a0[2] *= RAT(bflo(n4.y), bflo(d4.y)); a0[3] *= RAT(bfhi(n4.y), bfhi(d4.y));
                    a1[0] *= RAT(bflo(n4.z), bflo(d4.z)); a1[1] *= RAT(bfhi(n4.z), bfhi(d4.z)); a1[2] *= RAT(bflo(n4.w), bflo(d4.w)); a1[3] *= RAT(bfhi(n4.w), bfhi(d4.w));
#undef RAT
                    acc[ai][bj][m][0] = a0; acc[ai][bj][m][1] = a1;
                    asm volatile("" : "+v"(acc[ai][bj][m][0]), "+v"(acc[ai][bj][m][1]));
                    if (lastseg) *(u32x4*)(Mg + (size_t)row * 1024 + col0 + bj * 128) = pack8(a0, a1);
                } }
            asm volatile("" ::: "memory");
        }
    }
};
struct EpiD {
    static constexpr bool PERM = false;
    __device__ __forceinline__ bool keep(const pg8::Unit&) const { return false; }
    float* H; bf16* HB;
    __device__ __forceinline__ void operator()(AccT& acc, const pg8::Unit& u, int wr, int wc, int fr, int fq) const { run<false>(acc, u, wr, wc, fr, fq); }
    template <bool SK> __device__ __forceinline__ void run(AccT& acc, const pg8::Unit& u, int wr, int wc, int fr, int fq) const {
        const int row0 = u.pm * 256 + wr * 64 + fr, col0 = u.pn * 256 + wc * 32 + 4 * fq;
#pragma unroll
        for (int ai = 0; ai < (SK ? 1 : 2); ++ai)
#pragma unroll
            for (int m = 0; m < (SK ? 1 : 4); ++m) {
                const size_t off = (size_t)(row0 + ai * 128 + m * 16) * 1024 + col0;
#pragma unroll
                for (int bj = 0; bj < 2; ++bj)
#pragma unroll
                    for (int n = 0; n < 2; ++n) { const size_t o = off + bj * 128 + n * 16; const f32x4 hv = *(const f32x4*)(H + o) + acc[ai][bj][m][n];
                        *(f32x4*)(H + o) = hv; u32x2 w; w.x = pk2(hv[0], hv[1]); w.y = pk2(hv[2], hv[3]); *(u32x2*)(HB + o) = w; }
            }
    }
};
struct EpiA2 {
    static constexpr bool PERM = true;
    __device__ __forceinline__ bool keep(const pg8::Unit&) const { return false; }
    const float* PW; bf16* HH;
    __device__ __forceinline__ void operator()(AccT& acc, const pg8::Unit& u, int wr, int wc, int fr, int fq) const {
        const int row0 = u.pm * 256 + wr * 64 + fr, lc0 = wc * 32 + 8 * fq, side = u.pn >> 1;
#pragma unroll
        for (int ai = 0; ai < 2; ++ai)
#pragma unroll
            for (int m = 0; m < 4; ++m) {
                const int row = row0 + ai * 128 + m * 16; const f32x4 pw = *(const f32x4*)(PW + (size_t)row * 4);
                const float rs = pw[0], cw = side ? pw[2] : pw[1];
                f32x4 o[2];
#pragma unroll
                for (int n = 0; n < 2; ++n)
#pragma unroll
                    for (int j = 0; j < 4; ++j) { const float a1 = acc[ai][0][m][n][j] * rs, a3 = acc[ai][1][m][n][j] * rs; o[n][j] = cw * a1 * sigmoidf_(a1) * a3; }
                *(u32x4*)(HH + (size_t)row * 512 + side * 256 + (u.pn & 1) * 128 + lc0) = pack8(o[0], o[1]);
            }
    }
};
struct EpiB2 {
    static constexpr bool PERM = true;
    __device__ __forceinline__ bool keep(const pg8::Unit&) const { return false; }
    bf16* Y;
    __device__ __forceinline__ void operator()(AccT& acc, const pg8::Unit& u, int wr, int wc, int fr, int fq) const { run<false>(acc, u, wr, wc, fr, fq); }
    template <bool SK> __device__ __forceinline__ void run(AccT& acc, const pg8::Unit& u, int wr, int wc, int fr, int fq) const {
        const int row0 = u.pm * 256 + wr * 64 + fr, col0 = u.pn * 256 + wc * 32 + 8 * fq;
#pragma unroll
        for (int ai = 0; ai < (SK ? 1 : 2); ++ai)
#pragma unroll
            for (int m = 0; m < (SK ? 1 : 4); ++m) {
                bf16* rp = Y + (size_t)(row0 + ai * 128 + m * 16) * 1024 + col0;
#pragma unroll
                for (int bj = 0; bj < 2; ++bj) *(u32x4*)(rp + bj * 128) = pack8(acc[ai][bj][m][0], acc[ai][bj][m][1]);
            }
    }
};
struct MoeOrder {
    int NP, G, c, mode; const LAS int* pcls; const bf16* W;
    __device__ bool next(int i, pg8::Unit& u) const { const long L = (long)i * G + c; if (L >= (long)NP * 4) return false; u.pm = (int)(L >> 2); u.pn = (int)(L & 3); u.seg = 0; return true; }
    __device__ __forceinline__ int nt(const pg8::Unit&, int ntd) const { return ntd; }
    __device__ __forceinline__ size_t aoff(const pg8::Unit&) const { return 0; }
    __device__ __forceinline__ const char* bptr(const pg8::Unit& u, int side) const {
        const int cls = __builtin_amdgcn_readfirstlane(pcls[u.pm]); const int grp = cls / 6, pr = cls % 6;
        const int ea = pr < 3 ? 0 : (pr < 5 ? 1 : 2), eb = pr < 3 ? pr + 1 : (pr < 5 ? pr - 1 : 3);
        if (mode == 0) { const int e = grp * 4 + (u.pn < 2 ? ea : eb); return (const char*)W + ((size_t)e * 512 + (size_t)(u.pn & 1) * 256) * 1024 * 2; }
        const int e = grp * 4 + (side ? eb : ea); return (const char*)W + ((size_t)e * 1024 + (size_t)u.pn * 256) * 256 * 2;
    }
};

template <bool PERM> __device__ __forceinline__ void skinny_k(AccT& acc, const bf16* A, int lda, const bf16* Bt, int ldb, int K, int wc, int fr, int fq) {
    const bf16* ap = A + (size_t)fr * lda + 8 * fq;
    const bf16* bp[2][2];
#pragma unroll
    for (int bj = 0; bj < 2; ++bj)
#pragma unroll
        for (int n = 0; n < 2; ++n) { const int col = 128 * bj + 32 * wc + (PERM ? 8 * (fr >> 2) + 4 * n + (fr & 3) : 16 * n + fr); bp[bj][n] = Bt + (size_t)col * ldb + 8 * fq; }
#pragma unroll 4
    for (int k0 = 0; k0 < K; k0 += 32) {
        const bf16x8 a = *(const bf16x8*)(ap + k0);
#pragma unroll
        for (int bj = 0; bj < 2; ++bj)
#pragma unroll
            for (int n = 0; n < 2; ++n) { const bf16x8 b = *(const bf16x8*)(bp[bj][n] + k0); acc[0][bj][0][n] = __builtin_amdgcn_mfma_f32_16x16x32_bf16(b, a, acc[0][bj][0][n], 0, 0, 0); }
    }
}
__device__ __forceinline__ void skinny_zero(AccT& acc) {
#pragma unroll
    for (int bj = 0; bj < 2; ++bj)
#pragma unroll
        for (int n = 0; n < 2; ++n) acc[0][bj][0][n] = (f32x4){0.f, 0.f, 0.f, 0.f};
}

#define XB_TMO      128
#define XB_XCNT(j)  (256  + 64 * (j))
#define XB_XSUB(j)  (1280 + 64 * (j))
#define XB_XGEN(j)  (2304 + 64 * (j))
#define XB_TOP      3328
#define XB_TOPGEN   3392
#define XCD_BAR_WORDS 3456
#define XB_SPIN_CAP (1u << 24)
__device__ __forceinline__ unsigned xb_ld(unsigned* p)              { return __hip_atomic_load(p, __ATOMIC_RELAXED, __HIP_MEMORY_SCOPE_AGENT); }
__device__ __forceinline__ unsigned xb_add(unsigned* p, unsigned v) { return __hip_atomic_fetch_add(p, v, __ATOMIC_RELAXED, __HIP_MEMORY_SCOPE_AGENT); }
__device__ __forceinline__ unsigned xb_xcc_id() { return (unsigned)__builtin_amdgcn_s_getreg((3 << 11) | 20) & 0xFu; }
#define XB_SPIN(cond, bar) do { unsigned _sp = 0; while (cond) { __builtin_amdgcn_s_sleep(1); \
    if ((++_sp & 255u) == 0u) { if (xb_ld(&(bar)[XB_TMO])) break; if (_sp > XB_SPIN_CAP) { atomicAdd(&(bar)[XB_TMO], 1u); break; } } } } while (0)
struct XcdBarrier { unsigned* bar; unsigned x; volatile LAS unsigned* st; };
__device__ __forceinline__ XcdBarrier xcd_barrier_post(unsigned* bar, volatile LAS unsigned* st) {
    XcdBarrier b; b.bar = bar; b.x = xb_xcc_id(); b.st = st;
    if (threadIdx.x == 0) (void)xb_add(&bar[XB_XCNT(b.x)], 1u);
    return b;
}
__device__ __forceinline__ void xcd_barrier_complete(unsigned* bar, unsigned x, unsigned& nloc, unsigned& nx) {
    const unsigned G = gridDim.x * gridDim.y * gridDim.z;
    unsigned sum, cnt, mine, sp = 0u;
    for (;;) {
        sum = 0u; cnt = 0u; mine = 0u;
#pragma unroll
        for (unsigned j = 0; j < 16; ++j) { const unsigned c = xb_ld(&bar[XB_XCNT(j)]); sum += c; cnt += (c > 0u) ? 1u : 0u; mine = (j == x) ? c : mine; }
        if (sum == G) break;
        __builtin_amdgcn_s_sleep(1);
        if ((++sp & 255u) == 0u) { if (xb_ld(&bar[XB_TMO])) break; if (sp > XB_SPIN_CAP) { atomicAdd(&bar[XB_TMO], 1u); break; } }
    }
    nloc = mine > 0u ? mine : 1u; nx = cnt > 0u ? cnt : 1u;
}
__device__ __forceinline__ void xcd_barrier(const XcdBarrier& b) {
    asm volatile("s_waitcnt vmcnt(0)" ::: "memory");
    __syncthreads();
    if (threadIdx.x == 0) {
        unsigned* bar = b.bar;
        __builtin_amdgcn_s_waitcnt(0);
        unsigned nloc = b.st[0], nx = b.st[1];
        if (nloc == 0u) { xcd_barrier_complete(bar, b.x, nloc, nx); b.st[0] = nloc; b.st[1] = nx; }
        const unsigned old = xb_add(&bar[XB_XSUB(b.x)], 1u);
        const unsigned gen = old / nloc;
        if (old + 1u == (gen + 1u) * nloc) {
            __builtin_amdgcn_fence(__ATOMIC_RELEASE, "agent");
            asm volatile("s_waitcnt vmcnt(0)" ::: "memory");
            const unsigned og = xb_add(&bar[XB_TOP], 1u);
            const unsigned tg = og / nx;
            if (og + 1u == (tg + 1u) * nx) xb_add(&bar[XB_TOPGEN], 1u);
            else XB_SPIN(xb_ld(&bar[XB_TOPGEN]) == tg, bar);
            __builtin_amdgcn_fence(__ATOMIC_ACQUIRE, "agent");
            xb_add(&bar[XB_XGEN(b.x)], 1u);
            asm volatile("s_waitcnt vmcnt(0)" ::: "memory");
        } else {
            XB_SPIN(xb_ld(&bar[XB_XGEN(b.x)]) == gen, bar);
            __builtin_amdgcn_fence(__ATOMIC_ACQUIRE, "agent");
            asm volatile("s_waitcnt vmcnt(0)" ::: "memory");
        }
    }
    __syncthreads();
}

struct Params { const float* in[25]; float* out; unsigned char* ws; int ph_lo, ph_hi; };
enum { I_X = 0, I_META, I_N1G, I_WIN, I_BF, I_PW, I_PB, I_PS, I_CW, I_CB, I_LNG, I_LNB, I_WOA, I_WOB, I_WOC, I_WO, I_N2G, I_RGW, I_RGB, I_REW, I_REB, I_W1, I_W3, I_W2, I_FG };

struct Frame {
    LAS unsigned char* lds;
    int tid, lane, wave, vcu, G, bx;
};
__device__ __forceinline__ unsigned long long ptab_get(const Frame& F, int i) { const LAS unsigned* t = (const LAS unsigned*)(F.lds + LC_PTAB) + 2 * i; const unsigned lo = __builtin_amdgcn_readfirstlane(t[0]), hi = __builtin_amdgcn_readfirstlane(t[1]); return ((unsigned long long)hi << 32) | lo; }
#define INP(i) ((const float*)(const GAS float*)ptab_get(F, (i)))
#define WSP() ((unsigned char*)(GAS unsigned char*)ptab_get(F, 25))
#define DOP() ((unsigned char*)(GAS unsigned char*)ptab_get(F, 26))

__device__ __forceinline__ void tr_item(const float* W, int ldw, int scol0, const float* gk, bf16* WT, int ldt, int drow0, int k0, LAS float* scr, int lane) {
#pragma unroll
    for (int i = 0; i < 32; ++i) { const int kk = 2 * i + (lane >> 5); float v = W[(size_t)(k0 + kk) * ldw + scol0 + (lane & 31)]; if (gk) v *= gk[k0 + kk]; scr[kk * 33 + (lane & 31)] = v; }
    LDS_WAIT(); asm volatile("" ::: "memory");
    const int c = lane & 7;
#pragma unroll
    for (int j = 0; j < 4; ++j) { const int n = (lane >> 3) + 8 * j; const LAS float* s = scr + (8 * c) * 33 + n;
        u32x4 o; o.x = pk2(s[0 * 33], s[1 * 33]); o.y = pk2(s[2 * 33], s[3 * 33]); o.z = pk2(s[4 * 33], s[5 * 33]); o.w = pk2(s[6 * 33], s[7 * 33]);
        *(u32x4*)(WT + (size_t)(drow0 + n) * ldt + k0 + 8 * c) = o; }
    LDS_WAIT(); asm volatile("" ::: "memory");
}
__device__ __forceinline__ int map1(int n) {
    const int tile = n >> 8, r = n & 255;
    if (tile == 0) return n;
    if (tile <= 2) { const int c = (tile - 1) * 128 + (r & 127); return (r < 128 ? 256 : 512) + c; }
    if (tile <= 8) return n;
    return n + 8;
}
__device__ __forceinline__ void convert_weights(Frame& F, int l) {
    LAS float* scr = (LAS float*)(F.lds + F.wave * 16384);
    const int gw = F.vcu * NWAVES + F.wave, NGW = F.G * NWAVES, lane = F.lane;
    const float* g1 = INP(I_N1G) + (size_t)l * D; const float* g2 = INP(I_N2G) + (size_t)l * D;
    unsigned char* ws = WSP();
    { const float* W = INP(I_WIN) + (size_t)l * D * NIN; bf16* WT = (bf16*)(ws + WS_W1T);
      for (int it = gw; it < 16 * 168; it += NGW) { const int kb = it / 168, nb = it % 168; tr_item(W, NIN, map1(nb * 32), g1, WT, 1024, nb * 32, kb * 64, scr, lane); } }
    { const float* W = INP(I_WOB) + (size_t)l * 256 * D; bf16* WT = (bf16*)(ws + WS_W3CT) + 256;
      for (int it = gw; it < 4 * 32; it += NGW) { const int kb = it / 32, nb = it % 32; tr_item(W, 1024, nb * 32, nullptr, WT, 1024, nb * 32, kb * 64, scr, lane); } }
    { const float* W = INP(I_WOC) + (size_t)l * 512 * D; bf16* WT = (bf16*)(ws + WS_W3CT) + 512;
      for (int it = gw; it < 8 * 32; it += NGW) { const int kb = it / 32, nb = it % 32; tr_item(W, 1024, nb * 32, nullptr, WT, 1024, nb * 32, kb * 64, scr, lane); } }
    { const float* W = INP(I_WO) + (size_t)l * D * D; bf16* WT = (bf16*)(ws + WS_WOT);
      for (int it = gw; it < 16 * 32; it += NGW) { const int kb = it / 32, nb = it % 32; tr_item(W, 1024, nb * 32, nullptr, WT, 1024, nb * 32, kb * 64, scr, lane); } }
    { bf16* WT = (bf16*)(DOP() + DO_W13T);
      for (int it = gw; it < 16 * 256; it += NGW) { const int e = it >> 8, r = it & 255, kb = r >> 4, nb = r & 15, n0 = nb * 32, jt = n0 >> 8, rr = n0 & 255;
        const float* W = (rr < 128 ? INP(I_W1) : INP(I_W3)) + ((size_t)l * 16 + e) * D * 256;
        tr_item(W, 256, jt * 128 + (rr & 127), g2, WT + (size_t)e * 512 * 1024, 1024, n0, kb * 64, scr, lane); } }
    { bf16* WT = (bf16*)(DOP() + DO_W2T);
      for (int it = gw; it < 16 * 128; it += NGW) { const int e = it >> 7, r = it & 127, kb = r >> 5, nb = r & 31;
        const float* W = INP(I_W2) + ((size_t)l * 16 + e) * 256 * D;
        tr_item(W, 1024, nb * 32, nullptr, WT + (size_t)e * 1024 * 256, 256, nb * 32, kb * 64, scr, lane); } }
    { const float* pw = INP(I_PW) + (size_t)l * 4 * 64 * 64; const float* ps = INP(I_PS) + (size_t)l * 256; const float* pb = INP(I_PB) + (size_t)l * 256;
      const float* wa = INP(I_WOA) + (size_t)l * 256 * D; bf16* WT = (bf16*)(ws + WS_W3CT); float* bias = (float*)(ws + WS_BIASA);
      const int gt = F.vcu * 512 + F.tid, NT = F.G * 512;
      for (int idx = gt; idx < 256 * 1024; idx += NT) { const int n = idx & 1023, kk = idx >> 10, grp = kk >> 6, c = kk & 63; float s = 0.f;
        for (int d = 0; d < 64; ++d) s += pw[(grp * 64 + c) * 64 + d] * ps[grp * 64 + d] * wa[(size_t)(grp * 64 + d) * D + n];
        WT[(size_t)n * 1024 + kk] = (bf16)f2bf(s); }
      for (int n = gt; n < 1024; n += NT) { float s = 0.f; for (int d = 0; d < 256; ++d) s += pb[d] * ps[d] * wa[(size_t)d * D + n]; bias[n] = s; }
      float* wfg = (float*)(ws + WS_WFG); const float* win = INP(I_WIN) + (size_t)l * D * NIN;
      for (int idx = gt; idx < 8 * 1024; idx += NT) { const int c = idx >> 10, k = idx & 1023; wfg[idx] = g1[k] * win[(size_t)k * NIN + 2304 + c]; }
      float* rg = (float*)(ws + WS_RG); const float* re = INP(I_REW) + (size_t)l * D * 16; const float* rgw = INP(I_RGW) + (size_t)l * D * 4;
      for (int idx = gt; idx < 20 * 1024; idx += NT) { const int c = idx >> 10, k = idx & 1023; rg[idx] = g2[k] * (c < 16 ? re[(size_t)k * 16 + c] : rgw[(size_t)k * 4 + (c - 16)]); } }
}
__device__ __forceinline__ void init_rows(Frame& F) {
    const int gw = F.vcu * NWAVES + F.wave, NGW = F.G * NWAVES, lane = F.lane;
    float* H = (float*)(WSP() + WS_H); bf16* HB = (bf16*)(WSP() + WS_HB); float* rstd1 = (float*)(WSP() + WS_RSTD1);

#pragma unroll 1
for (int row = gw; row < TR; row += NGW) {
        const float* src = row < TX ? INP(I_X) + (size_t)row * D : (row - TX < NMETA ? INP(I_META) + (size_t)(row - TX) * D : nullptr);
        f32x4 v[4]; float ss = 0.f;
#pragma unroll
        for (int j = 0; j < 4; ++j) { float z_ = 0.f; LAUNDER_V(z_); v[j] = src ? *(const f32x4*)(src + 4 * lane + 256 * j) : (f32x4){z_, z_, z_, z_}; ss += v[j][0] * v[j][0] + v[j][1] * v[j][1] + v[j][2] * v[j][2] + v[j][3] * v[j][3]; }
        ss = wave_sum(ss);
#pragma unroll
        for (int j = 0; j < 4; ++j) { u32x2 w; w.x = pk2(v[j][0], v[j][1]); w.y = pk2(v[j][2], v[j][3]); *(u32x2*)(HB + (size_t)row * D + 4 * lane + 256 * j) = w; }
        if (lane == 0) rstd1[row] = rsqrtf(ss * (1.0f / D) + EPS);
    }
    { bf16* Kb = (bf16*)(DOP() + DO_K) + (size_t)TR * 512; bf16* Vb = (bf16*)(DOP() + DO_V) + (size_t)TR * 512; const int gt = F.vcu * 512 + F.tid;
      if (gt < 48 * 64) { *(u32x4*)(Kb + (size_t)gt * 8) = (u32x4){0u, 0u, 0u, 0u}; *(u32x4*)(Vb + (size_t)gt * 8) = (u32x4){0u, 0u, 0u, 0u}; } }
}

__device__ __forceinline__ int srcrow(bool isx, int b, int t) {
    if (t >= 0) return (isx ? b * SEQ : TX) + t;
    if (isx) { const int mm = NMETA + t; return mm >= 0 ? TX + mm : -1; }
    return -1;
}
__device__ __forceinline__ void phase_S(Frame& F, int l) {
    LAS unsigned char* lds = F.lds; const int wave = F.wave;
#pragma unroll 1
    for (int item = F.vcu; item < 513; item += F.G) {
        const bool isx = item < 512; const int row0 = isx ? item * 64 : TX + (item - 512) * 64; const int b = isx ? (item * 64) / SEQ : 0; const int t0 = isx ? (item * 64) % SEQ : (item - 512) * 64;
        { unsigned char* ws = WSP(); int tid = F.tid; LAUNDER_V(tid); const int lane = tid & 63;
          const bf16* HB = (const bf16*)(ws + WS_HB); const float* rstd1 = (const float*)(ws + WS_RSTD1); const float* wfg = (const float*)(ws + WS_WFG);
          float* LFT = (float*)(ws + WS_LFT); float* LFTM = (float*)(ws + WS_LFTM); const float* bfg = INP(I_BF) + l * 8;
          LAS float* W = (LAS float*)lds;
#pragma unroll 1
          for (int i = tid; i < 2048; i += 512) *(LAS f32x4*)(W + 4 * i) = *(const f32x4*)(wfg + 4 * i);
          __syncthreads();
#pragma unroll 1
          for (int rr = wave; rr < 64; rr += 8) { const int row = row0 + rr; float xv[16];
#pragma unroll
            for (int j = 0; j < 2; ++j) { const u32x4 w = *(const u32x4*)(HB + (size_t)row * D + 8 * lane + 512 * j);
                xv[8 * j + 0] = bflo(w.x); xv[8 * j + 1] = bfhi(w.x); xv[8 * j + 2] = bflo(w.y); xv[8 * j + 3] = bfhi(w.y); xv[8 * j + 4] = bflo(w.z); xv[8 * j + 5] = bfhi(w.z); xv[8 * j + 6] = bflo(w.w); xv[8 * j + 7] = bfhi(w.w); }
            float mine = 0.f;
#pragma unroll
            for (int c = 0; c < 8; ++c) { float s = 0.f;
#pragma unroll
                for (int j = 0; j < 2; ++j) { const f32x4 w0 = *(const LAS f32x4*)(W + c * 1024 + 8 * lane + 512 * j), w1 = *(const LAS f32x4*)(W + c * 1024 + 8 * lane + 512 * j + 4);
                    s += xv[8 * j] * w0[0] + xv[8 * j + 1] * w0[1] + xv[8 * j + 2] * w0[2] + xv[8 * j + 3] * w0[3] + xv[8 * j + 4] * w1[0] + xv[8 * j + 5] * w1[1] + xv[8 * j + 6] * w1[2] + xv[8 * j + 7] * w1[3]; }
                s = wave_sum(s); if (lane == c) mine = s; }
            if (lane < 8 && row < TR) { const float xg = mine * rstd1[row] + bfg[lane]; const float lf = fminf(xg, 0.f) - 0.69314718056f * __builtin_amdgcn_logf(1.0f + __expf(-fabsf(xg)));
                if (isx) LFT[(size_t)(b * 8 + lane) * SEQ + t0 + rr] = lf; else LFTM[lane * 256 + t0 + rr] = lf; } }
          __syncthreads(); }
        { unsigned char* ws = WSP(); int tid = F.tid; LAUNDER_V(tid);
          const bf16* Ab = (const bf16*)(ws + WS_A); bf16* DIFF = (bf16*)(ws + WS_X3);
          LAS unsigned char* T = lds;
#pragma unroll 1
          for (int i = tid; i < 79 * 32; i += 512) { const int s = i >> 5, ch = i & 31; const int r = srcrow(isx, b, t0 + s - 15);
              unsigned z_ = 0u; LAUNDER_V(z_);
              *(LAS u32x4*)(T + s * 512 + ch * 16) = r >= 0 ? *(const u32x4*)(Ab + (size_t)r * 256 + ch * 8) : (u32x4){z_, z_, z_, z_}; }
          __syncthreads();
#pragma unroll 1
          for (int i = tid; i < 64 * 32; i += 512) { const int r = i >> 5, ch = i & 31, grp = ch >> 3, w = 2 << grp; const int cnt = isx ? w : min(t0 + r + 1, w);
              float s[8];
#pragma unroll
              for (int j = 0; j < 8; ++j) s[j] = 0.f;
#pragma unroll 1
              for (int d = 0; d < cnt; ++d) { const u32x4 v = *(const LAS u32x4*)(T + (15 + r - d) * 512 + ch * 16);
                  s[0] += bflo(v.x); s[1] += bfhi(v.x); s[2] += bflo(v.y); s[3] += bfhi(v.y); s[4] += bflo(v.z); s[5] += bfhi(v.z); s[6] += bflo(v.w); s[7] += bfhi(v.w); }
              const u32x4 a = *(const LAS u32x4*)(T + (15 + r) * 512 + ch * 16); const float ic = 1.0f / (float)cnt;
              u32x4 o; o.x = pk2(s[0] * ic - bflo(a.x), s[1] * ic - bfhi(a.x)); o.y = pk2(s[2] * ic - bflo(a.y), s[3] * ic - bfhi(a.y));
              o.z = pk2(s[4] * ic - bflo(a.z), s[5] * ic - bfhi(a.z)); o.w = pk2(s[6] * ic - bflo(a.w), s[7] * ic - bfhi(a.w));
              if (row0 + r < TR) *(u32x4*)(DIFF + (size_t)(row0 + r) * 1024 + ch * 8) = o; }
          __syncthreads(); }
        { unsigned char* ws = WSP(); int tid = F.tid; LAUNDER_V(tid);
          const bf16* GLU = (const bf16*)(ws + WS_GLU);
          LAS unsigned char* T = lds;
          LAS float* Yt = (LAS float*)(lds + 49152);
#pragma unroll 1
          for (int i = tid; i < 94 * 32; i += 512) { const int s = i >> 5, ch = i & 31; const int r = srcrow(isx, b, t0 + s - 30);
              unsigned z_ = 0u; LAUNDER_V(z_);
              *(LAS u32x4*)(T + s * 512 + ch * 16) = r >= 0 ? *(const u32x4*)(GLU + (size_t)r * 256 + ch * 8) : (u32x4){z_, z_, z_, z_}; }
          __syncthreads();
          { const float* cw = INP(I_CW) + (size_t)l * 31 * 256; const float* cb = INP(I_CB) + l * 256;
            const int cp = tid & 127, strip = tid >> 7; f32x2 wv[31];
#pragma unroll
            for (int j = 0; j < 31; ++j) wv[j] = *(const f32x2*)(cw + j * 256 + 2 * cp);
            const f32x2 bias = *(const f32x2*)(cb + 2 * cp);
#pragma unroll 1
            for (int hh = 0; hh < 2; ++hh) { const int rb = 32 * hh + 8 * strip; f32x2 acc[8];
#pragma unroll
                for (int r = 0; r < 8; ++r) acc[r] = bias;
#pragma unroll
                for (int i = 0; i < 38; ++i) { const unsigned xw = *(const LAS unsigned*)(T + (rb + i) * 512 + cp * 4); const f32x2 xx = {bflo(xw), bfhi(xw)};
#pragma unroll
                    for (int r = 0; r < 8; ++r) { const int j = i - r; if (j >= 0 && j <= 30) acc[r] += wv[j] * xx; } }
#pragma unroll
                for (int r = 0; r < 8; ++r) *(LAS f32x2*)(Yt + (rb + r) * 256 + 2 * cp) = acc[r]; } }
          __syncthreads();
          { unsigned char* ws2 = WSP(); int tid2 = F.tid; LAUNDER_V(tid2); const int lane = tid2 & 63;
            bf16* BP = (bf16*)(ws2 + WS_X3) + 256; const float* lng = INP(I_LNG) + l * 256; const float* lnb = INP(I_LNB) + l * 256;
#pragma unroll 1
            for (int rr = wave; rr < 64; rr += 8) { const f32x4 v = *(const LAS f32x4*)(Yt + rr * 256 + 4 * lane);
              const float mean = wave_sum(v[0] + v[1] + v[2] + v[3]) * (1.0f / 256.0f); const f32x4 dv = v - mean;
              const float var = wave_sum(dv[0] * dv[0] + dv[1] * dv[1] + dv[2] * dv[2] + dv[3] * dv[3]) * (1.0f / 256.0f); const float rs = rsqrtf(var + EPS);
              const f32x4 gg = *(const f32x4*)(lng + 4 * lane), bb = *(const f32x4*)(lnb + 4 * lane); f32x4 o = dv * rs * gg + bb;
#pragma unroll
              for (int j = 0; j < 4; ++j) o[j] = o[j] * sigmoidf_(o[j]);
              u32x2 w; w.x = pk2(o[0], o[1]); w.y = pk2(o[2], o[3]); if (row0 + rr < TR) *(u32x2*)(BP + (size_t)(row0 + rr) * 1024 + 4 * lane) = w; } }
          __syncthreads(); }
    }
}

constexpr int AT_FL = 0, AT_K = 34816, AT_VT = AT_K + 8192, AT_SC = AT_VT + 8192;
__device__ __forceinline__ void attn_scan(Frame& F, int b, int h, bool meta_only, int fl_off, int sc_off) {
    LAS float* Fl = (LAS float*)(F.lds + fl_off); LAS float* sc = (LAS float*)(F.lds + sc_off);
    const float* LFT = (const float*)(WSP() + WS_LFT); const float* LFTM = (const float*)(WSP() + WS_LFTM);
    const int tid = F.tid, lane = F.lane, wave = F.wave;
    __syncthreads();
    if (tid == 0) { float s = 0.f; for (int m = 0; m < 64; ++m) { if (m < NMETA) { s += LFTM[h * 256 + m]; Fl[m] = s * LOG2E; } else Fl[m] = 1e30f; if (m == NMETA - 1) sc[16] = s; } }
    if (meta_only) { for (int i = tid; i < 256; i += 512) Fl[64 + i] = 0.f; __syncthreads(); return; }
    float v[16]; const float* src = LFT + (size_t)(b * 8 + h) * SEQ + 16 * tid;
#pragma unroll
    for (int j = 0; j < 4; ++j) { const f32x4 q = *(const f32x4*)(src + 4 * j); v[4 * j] = q[0]; v[4 * j + 1] = q[1]; v[4 * j + 2] = q[2]; v[4 * j + 3] = q[3]; }
#pragma unroll
    for (int j = 1; j < 16; ++j) v[j] += v[j - 1];
    float incl = v[15];
#pragma unroll
    for (int o = 1; o < 64; o <<= 1) { const float up = __int_as_float(__builtin_amdgcn_ds_bpermute((lane - o) << 2, __float_as_int(incl))); if (lane >= o) incl += up; }
    if (lane == 63) sc[wave] = incl;
    __syncthreads();
    float off = sc[16];
    for (int w = 0; w < wave; ++w) off += sc[w];
    off += incl - v[15];
#pragma unroll
    for (int j = 0; j < 16; ++j) Fl[64 + 16 * tid + j] = (off + v[j]) * LOG2E;
    __syncthreads();
}
__device__ __forceinline__ void attn_unit_naive(Frame& F, int qrow0, int qpos0, int ntiles, int kvx0, int h, int nq) {
    const int tid = F.tid; const int hf = tid & 1; const bool live = (tid >> 1) < nq; const int r = live ? (tid >> 1) : 0;
    const bf16* Q = (const bf16*)(DOP() + DO_Q); const bf16* Kg = (const bf16*)(DOP() + DO_K); const bf16* Vg = (const bf16*)(DOP() + DO_V); bf16* O = (bf16*)(WSP() + WS_X3) + 512;
    LAS float* Fl = (LAS float*)(F.lds + AT_FL); LAS unsigned char* Ks = F.lds + AT_K; LAS bf16* VT = (LAS bf16*)(F.lds + AT_VT);
    const int grow = qrow0 + r, qpos = qpos0 + r;
    unsigned qp[16];
#pragma unroll
    for (int j = 0; j < 4; ++j) { const u32x4 w = *(const u32x4*)(Q + (size_t)grow * 512 + h * 64 + hf * 32 + 8 * j); qp[4 * j] = w.x; qp[4 * j + 1] = w.y; qp[4 * j + 2] = w.z; qp[4 * j + 3] = w.w; }
    const float Fq = Fl[qpos < NMETA ? qpos : qpos + 48];
    float mrun = -1e30f, lrun = 0.f, o[32];
#pragma unroll
    for (int d = 0; d < 32; ++d) o[d] = 0.f;
    const int lrow = tid >> 3, lch = tid & 7;

#pragma unroll 1
for (int i = 0; i < ntiles; ++i) {
        const int krow = (i == 0 ? TX : kvx0 + 64 * (i - 1)) + lrow;
        const u32x4 kw = *(const u32x4*)(Kg + (size_t)krow * 512 + h * 64 + lch * 8);
        const u32x4 vw = *(const u32x4*)(Vg + (size_t)krow * 512 + h * 64 + lch * 8);
        __syncthreads();
        *(LAS u32x4*)(Ks + lrow * 128 + lch * 16) = kw;
        { const unsigned vv[4] = {vw.x, vw.y, vw.z, vw.w};
#pragma unroll
          for (int e = 0; e < 4; ++e) { VT[(lch * 8 + 2 * e) * 64 + lrow] = (bf16)(vv[e] & 0xffffu); VT[(lch * 8 + 2 * e + 1) * 64 + lrow] = (bf16)(vv[e] >> 16); } }
        __syncthreads();
        const int kp0 = i == 0 ? 0 : NMETA + 64 * (i - 1);
        if (kp0 > qpos0 + 255) continue;
#pragma unroll 1
        for (int jg = 0; jg < 4; ++jg) {
            float s[16]; float gmax = -1e30f;
#pragma unroll
            for (int jj = 0; jj < 16; ++jj) { const int j = jg * 16 + jj; float d = 0.f;
#pragma unroll
                for (int c = 0; c < 4; ++c) { const u32x4 kk = *(const LAS u32x4*)(Ks + j * 128 + hf * 64 + c * 16);
                    d = dot2bf(kk.x, qp[4 * c], d); d = dot2bf(kk.y, qp[4 * c + 1], d); d = dot2bf(kk.z, qp[4 * c + 2], d); d = dot2bf(kk.w, qp[4 * c + 3], d); }
                d += lane_xor<1>(d);
                const bool valid = (i == 0 ? j < NMETA : true) && (kp0 + j <= qpos);
                s[jj] = valid ? d + Fq - Fl[64 * i + j] : -1e30f; gmax = fmaxf(gmax, s[jj]); }
            const float mn = fmaxf(mrun, gmax), alpha = exp2f(mrun - mn); mrun = mn;
            float ps = 0.f; unsigned pp[8];
#pragma unroll
            for (int jj = 0; jj < 16; jj += 2) { const float p0 = exp2f(s[jj] - mn), p1 = exp2f(s[jj + 1] - mn); ps += p0 + p1; pp[jj >> 1] = pk2(p0, p1); }
            lrun = lrun * alpha + ps;
#pragma unroll
            for (int d = 0; d < 32; ++d) { const u32x4 v0 = *(const LAS u32x4*)(VT + (hf * 32 + d) * 64 + jg * 16), v1 = *(const LAS u32x4*)(VT + (hf * 32 + d) * 64 + jg * 16 + 8);
                float a = o[d] * alpha; a = dot2bf(pp[0], v0.x, a); a = dot2bf(pp[1], v0.y, a); a = dot2bf(pp[2], v0.z, a); a = dot2bf(pp[3], v0.w, a);
                a = dot2bf(pp[4], v1.x, a); a = dot2bf(pp[5], v1.y, a); a = dot2bf(pp[6], v1.z, a); a = dot2bf(pp[7], v1.w, a); o[d] = a; }
        }
    }
    const float il = 1.0f / lrun;
    if (live)
#pragma unroll
    for (int j = 0; j < 4; ++j) { u32x4 w; w.x = pk2(o[8 * j] * il, o[8 * j + 1] * il); w.y = pk2(o[8 * j + 2] * il, o[8 * j + 3] * il); w.z = pk2(o[8 * j + 4] * il, o[8 * j + 5] * il); w.w = pk2(o[8 * j + 6] * il, o[8 * j + 7] * il);
        *(u32x4*)(O + (size_t)grow * 1024 + h * 64 + hf * 32 + 8 * j) = w; }
}
namespace fa {
using bf16x8v = __attribute__((ext_vector_type(8))) short;
using s16x4 = __attribute__((ext_vector_type(4))) short;
using f32x16 = __attribute__((ext_vector_type(16))) float;
constexpr int DMA = 512, DMO = 1024;
constexpr int NW = 8, QBLK = 32, QB = 256, KVBLK = 64;
constexpr int NSLOT = 3, SLOTB = 8192;
constexpr int LDS_K = 0, LDS_V = NSLOT * SLOTB, LDS_WS = 2 * NSLOT * SLOTB, LDS_OST = LDS_WS + NW * 64 * 4, LDS_BYTES = LDS_OST + NW * 4096;
constexpr int LDS_FL = 84992;
constexpr int LDS_SCAN = LDS_FL + (64 + 8192) * 4;
static_assert(LDS_SCAN + 128 <= RING_BYTES, "attention LDS");
__device__ __forceinline__ int crow(int r, int hi) { return (r & 3) + 8 * (r >> 2) + 4 * hi; }
#define SBAR() __builtin_amdgcn_sched_barrier(0)
__device__ __forceinline__ void cmask(f32x16& p0, f32x16& p1, int jb, int qrel, int hi) {
    const float NEG = -INFINITY; int kb = 64 * jb + 4 * hi;
#pragma unroll
    for (int r = 0; r < 16; ++r) { int kv = kb + (r & 3) + 8 * (r >> 2); if (kv > qrel) p0[r] = NEG; if (kv + 32 > qrel) p1[r] = NEG; }
}
__device__ __forceinline__ void glds16(const void* gsrc, unsigned lds_dst) { unsigned keep;
    asm volatile("s_mov_b32 %0, m0\n\ts_mov_b32 m0, %2\n\ts_nop 0\n\tglobal_load_lds_dwordx4 %1, off\n\ts_mov_b32 m0, %0" : "=&s"(keep) : "v"(gsrc), "s"(lds_dst) : "memory"); }
__device__ __forceinline__ float max3f(float a, float b, float c) { float r; asm("v_max3_f32 %0, %1, %2, %3" : "=v"(r) : "v"(a), "v"(b), "v"(c)); return r; }
__device__ __forceinline__ float max2f(float a, float b) { float r; asm("v_max_f32_e32 %0, %1, %2" : "=v"(r) : "v"(a), "v"(b)); return r; }
__device__ __forceinline__ float fsub_s(float a, float b) { float r; asm("v_sub_f32_e32 %0, %1, %2" : "=v"(r) : "v"(a), "v"(b)); return r; }
typedef float f32x2_t __attribute__((ext_vector_type(2))); typedef __bf16 bf16x2_t __attribute__((ext_vector_type(2)));
__device__ __forceinline__ unsigned cvtpk_s(float lo, float hi) { f32x2_t v = {lo, hi}; bf16x2_t b = __builtin_convertvector(v, bf16x2_t); return __builtin_bit_cast(unsigned, b); }
#define WAIT_BAR(N) asm volatile("s_waitcnt vmcnt(" #N ") lgkmcnt(0)\n\ts_barrier" ::: "memory")
typedef __attribute__((address_space(3))) const char* lds_cptr;
typedef short v4i16_t __attribute__((ext_vector_type(4)));
__device__ __forceinline__ void cinit(f32x16& p0, f32x16& p1, const LAS float* fk, float a) {
#pragma unroll
    for (int g = 0; g < 4; ++g) { const f32x4 f0 = *(const LAS f32x4*)(fk + 8 * g), f1 = *(const LAS f32x4*)(fk + 32 + 8 * g);
#pragma unroll
        for (int i = 0; i < 4; ++i) { p0[4 * g + i] = a - f0[i]; p1[4 * g + i] = a - f1[i]; } }
}
__device__ __forceinline__ void qkt(f32x16& p0, f32x16& p1, const char* Kslot, const bf16x8v* qr, int r32, int hi) {
    const char* kb = Kslot + hi * 1024 + r32 * 16;
#pragma unroll
    for (int d0 = 0; d0 < 4; ++d0) {
        const bf16x8v b0 = *reinterpret_cast<const bf16x8v*>(kb + d0 * 2048);
        const bf16x8v b1 = *reinterpret_cast<const bf16x8v*>(kb + d0 * 2048 + 512);
        p0 = __builtin_amdgcn_mfma_f32_32x32x16_bf16(b0, qr[d0], p0, 0, 0, 0); p1 = __builtin_amdgcn_mfma_f32_32x32x16_bf16(b1, qr[d0], p1, 0, 0, 0); }
}
__device__ __forceinline__ void kload8(bf16x8v* kf, lds_cptr kp) {
    kf[0] = *(const LAS bf16x8v*)(kp);        kf[1] = *(const LAS bf16x8v*)(kp + 512);
    kf[2] = *(const LAS bf16x8v*)(kp + 2048); kf[3] = *(const LAS bf16x8v*)(kp + 2560);
    kf[4] = *(const LAS bf16x8v*)(kp + 4096); kf[5] = *(const LAS bf16x8v*)(kp + 4608);
    kf[6] = *(const LAS bf16x8v*)(kp + 6144); kf[7] = *(const LAS bf16x8v*)(kp + 6656);
}
__device__ __forceinline__ void kload2(bf16x8v* kf, lds_cptr kp, int j) { kf[2 * j] = *(const LAS bf16x8v*)(kp + j * 2048); kf[2 * j + 1] = *(const LAS bf16x8v*)(kp + j * 2048 + 512); }
__device__ __forceinline__ s16x4 vtr(lds_cptr p) { return __builtin_bit_cast(s16x4, __builtin_amdgcn_ds_read_tr16_b64_v4i16((LAS v4i16_t*)p)); }
__device__ __forceinline__ float rowmax(const f32x16& p0, const f32x16& p1) {
    float a = max3f(p0[0], p0[1], p1[0]), b = max3f(p0[2], p0[3], p1[1]); a = max3f(a, p1[2], p1[3]);
#pragma unroll
    for (int r = 4; r < 16; r += 4) { a = max3f(a, p0[r], p0[r + 1]); b = max3f(b, p0[r + 2], p0[r + 3]); a = max3f(a, p1[r], p1[r + 1]); b = max3f(b, p1[r + 2], p1[r + 3]); }
    const float m = max2f(a, b);
    auto rr = __builtin_amdgcn_permlane32_swap(__float_as_uint(m), __float_as_uint(m), false, false);
    return max2f(__uint_as_float(rr[0]), __uint_as_float(rr[1]));
}
__device__ __forceinline__ void pv(f32x16* o, int vb, bf16x8v pa0, bf16x8v pa1, bf16x8v pa2, bf16x8v pa3) {
#pragma unroll
    for (int d0 = 0; d0 < 2; ++d0) { s16x4 lo[4], hi[4];
#pragma unroll
        for (int ks = 0; ks < 4; ++ks) {
            asm volatile("ds_read_b64_tr_b16 %0,%1 offset:%c2" : "=&v"(lo[ks]) : "v"(vb), "i"(d0 * 4096 + ks * 1024) : "memory");
            asm volatile("ds_read_b64_tr_b16 %0,%1 offset:%c2" : "=&v"(hi[ks]) : "v"(vb), "i"(d0 * 4096 + ks * 1024 + 512) : "memory"); }
        asm volatile("s_waitcnt lgkmcnt(0)" ::: "memory"); SBAR();
#define PK(k) (bf16x8v){lo[k][0], lo[k][1], lo[k][2], lo[k][3], hi[k][0], hi[k][1], hi[k][2], hi[k][3]}
        o[d0] = __builtin_amdgcn_mfma_f32_32x32x16_bf16(pa0, PK(0), o[d0], 0, 0, 0);
        o[d0] = __builtin_amdgcn_mfma_f32_32x32x16_bf16(pa1, PK(1), o[d0], 0, 0, 0);
        o[d0] = __builtin_amdgcn_mfma_f32_32x32x16_bf16(pa2, PK(2), o[d0], 0, 0, 0);
        o[d0] = __builtin_amdgcn_mfma_f32_32x32x16_bf16(pa3, PK(3), o[d0], 0, 0, 0);
#undef PK
    }
}
template <int THRL> __device__ __forceinline__ void attn_unit(int b, int h, int qb, const bf16* Q, const bf16* __restrict__ K, const bf16* __restrict__ V, bf16* O, char* shm, int wid) {
    const int lane = lane_id_opaque(), r32 = lane & 31, hi = lane >> 5;
    const long rowbase = (long)b * SEQ; const int q0 = qb * QB;
    const bf16* Qw = Q + (rowbase + q0 + wid * QBLK) * DMA + h * 64;
    const bf16* Kh = K + rowbase * DMA + h * 64, *Vh = V + rowbase * DMA + h * 64;
    const bf16* Km = K + (long)TX * DMA + h * 64, *Vm = V + (long)TX * DMA + h * 64;
    const unsigned lds0 = (unsigned)(uintptr_t)shm;
    float* wsf = (float*)(shm + LDS_WS) + wid * 64;
    const bf16* ksrc = Kh + (long)lane * DMA + wid * 8;
    const bf16* vsrc = Vh + (long)(16 * (wid & 3) + (lane >> 2)) * DMA + (wid >> 2) * 32 + (lane & 3) * 8;
    const bf16* ksrcm = Km + (long)lane * DMA + wid * 8;
    const bf16* vsrcm = Vm + (long)(16 * (wid & 3) + (lane >> 2)) * DMA + (wid >> 2) * 32 + (lane & 3) * 8;
    const unsigned kdst = lds0 + LDS_K + wid * 1024, vdst = lds0 + LDS_V + wid * 1024;
#define DMA_K(t, slot) glds16(ksrc + (long)((t) - 1) * KVBLK * DMA, (unsigned)__builtin_amdgcn_readfirstlane(kdst + (slot)))
#define DMA_V(t, slot) glds16(vsrc + (long)((t) - 1) * KVBLK * DMA, (unsigned)__builtin_amdgcn_readfirstlane(vdst + (slot)))
    const int vb0 = (int)(lds0 + LDS_V) + ((lane >> 4) & 1) * 32 + (lane & 3) * 8 + (4 * hi + ((lane & 15) >> 2)) * 64;
    const char* Kbase = shm + LDS_K; bf16x8v kf[8];
    const lds_cptr shm3 = (lds_cptr)shm; const lds_cptr kp0 = shm3 + LDS_K + hi * 1024 + r32 * 16; const lds_cptr vp0 = shm3 + LDS_V + ((lane >> 4) & 1) * 32 + (lane & 3) * 8 + (4 * hi + ((lane & 15) >> 2)) * 64;
    const LAS float* Flp = (const LAS float*)(shm3 + LDS_FL) + 4 * hi;
    const int NT = 4 * qb + 5;
    glds16(ksrcm, (unsigned)__builtin_amdgcn_readfirstlane(kdst)); glds16(vsrcm, (unsigned)__builtin_amdgcn_readfirstlane(vdst)); DMA_K(1, SLOTB);
    bf16x8v qr[4];
#pragma unroll
    for (int d0 = 0; d0 < 4; ++d0) qr[d0] = *reinterpret_cast<const bf16x8v*>(&Qw[(long)r32 * DMA + d0 * 16 + hi * 8]);
    float aq = ((const LAS float*)(shm3 + LDS_FL))[64 + q0 + wid * QBLK + r32];
    float l_reg = 0.f; f32x16 o[2]; o[0] = f32x16{}; o[1] = f32x16{};
    const int qrel = wid * QBLK + r32;
#define CMASK(P0, P1, t) do { int jb_ = (t) - (NT - 4); if (jb_ >= 0) cmask(P0, P1, jb_, qrel, hi); } while (0)
    bool resc = false;
#define START(P0, P1) do { const float rm = rowmax(P0, P1); resc = false; \
    { const float dl = max2f(rm, 0.f); aq = fsub_s(aq, dl);        \
      _Pragma("unroll") for (int r = 0; r < 16; ++r) { P0[r] = fsub_s(P0[r], dl); P1[r] = fsub_s(P1[r], dl); } } \
    _Pragma("unroll") for (int r = 0; r < 16; ++r) P0[r] = __builtin_amdgcn_exp2f(P0[r]); } while (0)
#define RESC() do { if (resc) { asm volatile("s_waitcnt lgkmcnt(0)" ::: "memory"); \
      _Pragma("unroll") for (int d_ = 0; d_ < 2; ++d_) _Pragma("unroll") for (int r = 0; r < 16; ++r) o[d_][r] *= wsf[crow(r, hi)]; } } while (0)
    f32x16 pA0, pA1, pB0, pB1;
    int sl_prev = 0, sl_cur = 0, sl_next = SLOTB;
#define ROT() do { sl_prev = sl_cur; sl_cur = sl_next; sl_next = (sl_next == (NSLOT - 1) * SLOTB) ? 0 : sl_next + SLOTB; } while (0)
    DMA_K(2, 2 * SLOTB);
    cinit(pA0, pA1, Flp, aq);
    WAIT_BAR(3);
    qkt(pA0, pA1, Kbase, qr, r32, hi); asm volatile("s_nop 15\n\ts_nop 7" : "+v"(pA0), "+v"(pA1));
    START(pA0, pA1);
    _Pragma("unroll") for (int r = 0; r < 16; ++r) pA1[r] = __builtin_amdgcn_exp2f(pA1[r]);
    WAIT_BAR(0);
    DMA_K(3, 0); DMA_V(1, SLOTB);
    ROT();
    kload8(kf, kp0 + sl_cur);
    WAIT_BAR(2);
    s16x4 vlo[8], vhi[8]; u32x4 pw0, pw1, pw2, pw3;
#define PKW(P, B) cvtpk_s(P[B], P[B + 1])
#define PAF(k) __builtin_bit_cast(bf16x8v, pw##k)
#define VFR(i) (bf16x8v){vlo[i][0], vlo[i][1], vlo[i][2], vlo[i][3], vhi[i][0], vhi[i][1], vhi[i][2], vhi[i][3]}
#define PIN(x) asm volatile("" : "+v"(x))
#define MX3(a, b, c) __builtin_fmaxf(__builtin_fmaxf((a), (b)), (c))
#define GAPA(MF, A0, A1, A2, A3, W0, W1, PW) do { MF; sacc += A0; sacc += A1; sacc += A2; sacc += A3; PIN(sacc); W0; W1; PIN(PW); SBAR(); } while (0)
#define EX(v) __builtin_amdgcn_exp2f(v)
#define GAPB(MF, X, B) do { MF; X[B] = EX(X[B]); X[B + 1] = EX(X[B + 1]); X[B + 2] = EX(X[B + 2]); X[B + 3] = EX(X[B + 3]); PIN(X); SBAR(); } while (0)
#define VRD(i) do { vlo[i] = vtr(vp_ + (((i) >> 2) * 4096 + ((i) & 3) * 1024)); vhi[i] = vtr(vp_ + (((i) >> 2) * 4096 + ((i) & 3) * 1024 + 512)); } while (0)
#define KRD(G, j) do { if (G) { kload2(kf, kp0 + sl_next, j); SBAR(); } } while (0)
#define STEP(C0, C1, P0, P1, t, GK, GV, GL) do { SBAR(); \
    cinit(C0, C1, Flp + 64 * (t), aq); SBAR(); \
    const lds_cptr vp_ = vp0 + sl_prev; \
    VRD(0); SBAR(); float sacc = (P0[0] + P0[1]); \
    GAPA(C0 = __builtin_amdgcn_mfma_f32_32x32x16_bf16(kf[0], qr[0], C0, 0, 0, 0), P0[2], P0[3], P0[4], P0[5],     pw0[0] = PKW(P0, 0), pw0[1] = PKW(P0, 2), pw0); \
    VRD(4); SBAR(); GAPA(C1 = __builtin_amdgcn_mfma_f32_32x32x16_bf16(kf[1], qr[0], C1, 0, 0, 0), P0[6], P0[7], P0[8], P0[9],     pw0[2] = PKW(P0, 4), pw0[3] = PKW(P0, 6), pw0); \
    VRD(1); SBAR(); GAPA(C0 = __builtin_amdgcn_mfma_f32_32x32x16_bf16(kf[2], qr[1], C0, 0, 0, 0),   P0[10], P0[11], P0[12], P0[13], pw1[0] = PKW(P0, 8), pw1[1] = PKW(P0, 10), pw1); \
    VRD(5); SBAR(); GAPA(C1 = __builtin_amdgcn_mfma_f32_32x32x16_bf16(kf[3], qr[1], C1, 0, 0, 0),   P0[14], P0[15], P1[0], P1[1],   pw1[2] = PKW(P0, 12), pw1[3] = PKW(P0, 14), pw1); \
    VRD(2); SBAR(); GAPA(C0 = __builtin_amdgcn_mfma_f32_32x32x16_bf16(kf[4], qr[2], C0, 0, 0, 0),   P1[2], P1[3], P1[4], P1[5],     pw2[0] = PKW(P1, 0), pw2[1] = PKW(P1, 2), pw2); \
    VRD(6); SBAR(); GAPA(C1 = __builtin_amdgcn_mfma_f32_32x32x16_bf16(kf[5], qr[2], C1, 0, 0, 0),   P1[6], P1[7], P1[8], P1[9],     pw2[2] = PKW(P1, 4), pw2[3] = PKW(P1, 6), pw2); \
    VRD(3); SBAR(); GAPA(C0 = __builtin_amdgcn_mfma_f32_32x32x16_bf16(kf[6], qr[3], C0, 0, 0, 0),   P1[10], P1[11], P1[12], P1[13], pw3[0] = PKW(P1, 8), pw3[1] = PKW(P1, 10), pw3); \
    VRD(7); SBAR(); GAPA(C1 = __builtin_amdgcn_mfma_f32_32x32x16_bf16(kf[7], qr[3], C1, 0, 0, 0),   P1[14], P1[15], 0.f, 0.f,       pw3[2] = PKW(P1, 12), pw3[3] = PKW(P1, 14), pw3); \
    l_reg += sacc; \
    if (GK) { DMA_K((t) + 3, sl_cur); } if (GV) { DMA_V((t) + 1, sl_next); } \
    CMASK(C0, C1, t); \
    { float a = MX3(C0[0], C0[1], C1[0]), b_ = MX3(C0[2], C0[3], C1[1]); a = MX3(a, C1[2], C1[3]); \
      _Pragma("unroll") for (int r = 4; r < 16; r += 4) { a = MX3(a, C0[r], C0[r + 1]); b_ = MX3(b_, C0[r + 2], C0[r + 3]); a = MX3(a, C1[r], C1[r + 1]); b_ = MX3(b_, C1[r + 2], C1[r + 3]); } \
      float rm = __builtin_fmaxf(a, b_); { auto rr = __builtin_amdgcn_permlane32_swap(__float_as_uint(rm), __float_as_uint(rm), false, false); rm = __builtin_fmaxf(__uint_as_float(rr[0]), __uint_as_float(rr[1])); } \
      resc = false; \
      if (__builtin_expect(__any(rm > (float)THRL), 0)) { const float dl = __builtin_fmaxf(rm, 0.f); aq -= dl; \
        _Pragma("unroll") for (int r = 0; r < 16; ++r) { C0[r] -= dl; C1[r] -= dl; } \
        const float f = __builtin_amdgcn_exp2f(-dl); l_reg *= f; if (hi == 0) wsf[r32] = f; resc = true; } } \
    SBAR(); \
    GAPB(o[0] = __builtin_amdgcn_mfma_f32_32x32x16_bf16(PAF(0), VFR(0), o[0], 0, 0, 0), C0, 0); \
    GAPB(o[1] = __builtin_amdgcn_mfma_f32_32x32x16_bf16(PAF(0), VFR(4), o[1], 0, 0, 0), C0, 4); \
    KRD(GL, 0); GAPB(o[0] = __builtin_amdgcn_mfma_f32_32x32x16_bf16(PAF(1), VFR(1), o[0], 0, 0, 0), C0, 8); \
    KRD(GL, 1); GAPB(o[1] = __builtin_amdgcn_mfma_f32_32x32x16_bf16(PAF(1), VFR(5), o[1], 0, 0, 0), C0, 12); \
    KRD(GL, 2); GAPB(o[0] = __builtin_amdgcn_mfma_f32_32x32x16_bf16(PAF(2), VFR(2), o[0], 0, 0, 0), C1, 0); \
    KRD(GL, 3); GAPB(o[1] = __builtin_amdgcn_mfma_f32_32x32x16_bf16(PAF(2), VFR(6), o[1], 0, 0, 0), C1, 4); \
    GAPB(o[0] = __builtin_amdgcn_mfma_f32_32x32x16_bf16(PAF(3), VFR(3), o[0], 0, 0, 0), C1, 8); \
    GAPB(o[1] = __builtin_amdgcn_mfma_f32_32x32x16_bf16(PAF(3), VFR(7), o[1], 0, 0, 0), C1, 12); \
    } while (0)
    int t = 1;
#undef CMASK
#define CMASK(P0, P1, t) do { } while (0)
    for (; t + 5 < NT; t += 2) {
        STEP(pB0, pB1, pA0, pA1, t, true, true, true);     WAIT_BAR(2); RESC(); ROT();
        STEP(pA0, pA1, pB0, pB1, t + 1, true, true, true); WAIT_BAR(2); RESC(); ROT();
    }
#undef CMASK
#define CMASK(P0, P1, t) do { int jb_ = (t) - (NT - 4); if (jb_ >= 0) cmask(P0, P1, jb_, qrel, hi); } while (0)
#define ENDW(tt) do { if ((tt) + 3 < NT) { WAIT_BAR(2); } else if ((tt) + 2 < NT) { WAIT_BAR(1); } else { WAIT_BAR(0); } } while (0)
    for (; t + 1 < NT; t += 2) {
        STEP(pB0, pB1, pA0, pA1, t, (t + 3 < NT), (t + 1 < NT), (t + 1 < NT));         ENDW(t);     RESC(); ROT();
        STEP(pA0, pA1, pB0, pB1, t + 1, (t + 4 < NT), (t + 2 < NT), (t + 2 < NT));     ENDW(t + 1); RESC(); ROT();
    }
    { float sacc = pA0[0] + pA0[1]; _Pragma("unroll") for (int r = 2; r < 16; ++r) sacc += pA0[r]; _Pragma("unroll") for (int r = 0; r < 16; ++r) sacc += pA1[r]; l_reg += sacc;
      pw0 = (u32x4){PKW(pA0, 0), PKW(pA0, 2), PKW(pA0, 4), PKW(pA0, 6)}; pw1 = (u32x4){PKW(pA0, 8), PKW(pA0, 10), PKW(pA0, 12), PKW(pA0, 14)}; pw2 = (u32x4){PKW(pA1, 0), PKW(pA1, 2), PKW(pA1, 4), PKW(pA1, 6)}; pw3 = (u32x4){PKW(pA1, 8), PKW(pA1, 10), PKW(pA1, 12), PKW(pA1, 14)};
      SBAR(); pv(o, vb0 + sl_prev, PAF(0), PAF(1), PAF(2), PAF(3)); }
#undef PKW
#undef PAF
#undef VFR
#undef PIN
#undef MX3
#undef GAPA
#undef GAPB
#undef EX
#undef VRD
#undef KRD
#undef STEP
#undef ENDW
    { auto rr = __builtin_amdgcn_permlane32_swap(__float_as_uint(l_reg), __float_as_uint(l_reg), false, false); l_reg = __uint_as_float(rr[0]) + __uint_as_float(rr[1]); }
    if (hi == 0) wsf[32 + r32] = l_reg; asm volatile("s_waitcnt lgkmcnt(0)" ::: "memory");
    float rli[16];
#pragma unroll
    for (int r = 0; r < 16; ++r) rli[r] = __builtin_amdgcn_rcpf(wsf[32 + crow(r, hi)]);
    bf16* Ow = O + (rowbase + q0 + wid * QBLK) * DMO + h * 64;
    { bf16* stg = (bf16*)(shm + LDS_OST) + wid * 2048;
#pragma unroll
      for (int r = 0; r < 16; ++r) { const int orow = crow(r, hi);
#pragma unroll
          for (int d0 = 0; d0 < 2; ++d0) stg[orow * 64 + d0 * 32 + r32] = (bf16)f2bf(o[d0][r] * rli[r]); }
      asm volatile("s_waitcnt lgkmcnt(0)" ::: "memory");
#pragma unroll
      for (int i = 0; i < 4; ++i) { const int row = i * 8 + (lane >> 3), ch = lane & 7; const u32x4 v = *(const u32x4*)(stg + row * 64 + ch * 8); *(u32x4*)(Ow + (long)row * DMO + ch * 8) = v; } }
    asm volatile("s_waitcnt lgkmcnt(0)\n\ts_barrier" ::: "memory");
#undef DMA_K
#undef DMA_V
#undef CMASK
#undef START
#undef RESC
#undef ROT
}
#undef SBAR
#undef WAIT_BAR
}
__device__ __forceinline__ void phase_B(Frame& F) {
    if (F.G == 256) {
        const int v = F.vcu, bh = v >> 3, s = v & 7, b = bh >> 3, h = bh & 7;
        attn_scan(F, b, h, false, fa::LDS_FL, fa::LDS_SCAN);
        { unsigned char* dol = DOP(); const bf16* Q = (const bf16*)(dol + DO_Q); const bf16* Kg = (const bf16*)(dol + DO_K); const bf16* Vg = (const bf16*)(dol + DO_V);
#pragma unroll 1
          for (int i = 0; i < 4; ++i) { const int qb = i == 0 ? s : (i == 1 ? 15 - s : (i == 2 ? 16 + s : 31 - s));
              fa::attn_unit<8>(b, h, qb, Q, Kg, Vg, (bf16*)(WSP() + WS_X3) + 512, (char*)F.lds, F.wave); } }
        if (v < 8) { attn_scan(F, 0, v, true, AT_FL, AT_SC); attn_unit_naive(F, TX, 0, 1, 0, v, NMETA); }
    } else {
        int cur_bh = -1;
        for (int u = F.vcu; u < 1032; u += F.G) {
            if (u < 1024) { const int bh = u >> 5, qb = u & 31, b = bh >> 3, h = bh & 7; if (bh != cur_bh) { attn_scan(F, b, h, false, AT_FL, AT_SC); cur_bh = bh; }
                attn_unit_naive(F, b * SEQ + 256 * qb, NMETA + 256 * qb, 1 + 4 * (qb + 1), b * SEQ, h, 256); }
            else { attn_scan(F, 0, u - 1024, true, AT_FL, AT_SC); cur_bh = -1; attn_unit_naive(F, TX, 0, 1, 0, u - 1024, NMETA); }
        }
    }
    __syncthreads();
}

__device__ __forceinline__ void class_tables(Frame& F, int l) {
    LAS int* base = (LAS int*)(F.lds + LC_BASE); LAS int* pcls = (LAS int*)(F.lds + LC_PCLS); LAS int* np = (LAS int*)(F.lds + LC_NP);
    const unsigned* gcnt = (const unsigned*)(WSP() + WS_CTL) + CW_GCNT + l * 64;
    __syncthreads();
    if (F.tid == 0) { int p = 0;
#pragma unroll 1
        for (int c = 0; c < NCLS; ++c) { base[c] = p * 256; int n = (int)__hip_atomic_load(gcnt + c, __ATOMIC_RELAXED, __HIP_MEMORY_SCOPE_AGENT); if (n > TR) n = TR; if (n < 0) n = 0; p += (n + 255) >> 8; }
        if (p > 160) p = 160; base[NCLS] = p * 256; np[0] = p; }
    __syncthreads();
    if (F.tid < 160) { const int mypos = F.tid * 256; int c = 0;
#pragma unroll 1
        for (int k = 1; k < NCLS; ++k) if (base[k] <= mypos) c = k;
        pcls[F.tid] = c; }
    __syncthreads();
}
constexpr int RPITCH = 1032;
__device__ __forceinline__ void phase_E1(Frame& F, int l) {
    LAS bf16* Rhi = (LAS bf16*)F.lds; LAS bf16* Rlo = Rhi + 20 * RPITCH;
    LAS int* rec = (LAS int*)(F.lds + 83968);
    LAS int* lcnt = (LAS int*)(F.lds + LC_CNT); LAS int* wgb = (LAS int*)(F.lds + LC_BASE);
    const float* rg = (const float*)(WSP() + WS_RG);
    const float* reb = INP(I_REB) + l * 16; const float* rgb = INP(I_RGB) + l * 4;
    unsigned* gcnt = (unsigned*)(WSP() + WS_CTL) + CW_GCNT + l * 64; int* route = (int*)(WSP() + WS_ROUTE);
    const int tid = F.tid, lane = F.lane, wave = F.wave, fr = lane & 15, fq = lane >> 4;
#pragma unroll 1
    for (int i = tid; i < 20 * 1024; i += 512) { const float v = rg[i]; const unsigned hw = pk2(v, 0.f) & 0xffffu; const float hf = __builtin_bit_cast(float, hw << 16);
        const int c = i >> 10, k = i & 1023; Rhi[c * RPITCH + k] = (bf16)hw; Rlo[c * RPITCH + k] = (bf16)(pk2(v - hf, 0.f) & 0xffffu); }
#pragma unroll 1
    for (int wg = F.vcu; wg < 256; wg += F.G) {
        if (tid < NCLS) lcnt[tid] = 0;
        __syncthreads();
        const int ngrp = wg == 0 ? 9 : 8;
#pragma unroll 1
        for (int grp = wave; grp < ngrp; grp += 8) {
            const int row = grp < 8 ? wg * 128 + grp * 16 + fr : TX + fr;
            const float* hsrc = l == 0 ? (row < TX ? INP(I_X) + (size_t)row * D : INP(I_META) + (size_t)(row - TX) * D) : (const float*)(WSP() + WS_H) + (size_t)row * D;
            float* hdst = (float*)(WSP() + WS_H) + (size_t)row * D; bf16* hbdst = (bf16*)(WSP() + WS_HB) + (size_t)row * D; const bf16* dsrc = (const bf16*)(WSP() + WS_X3) + (size_t)row * D;
            const LAS bf16* bh0 = Rhi + fr * RPITCH + 8 * fq; const LAS bf16* bl0 = Rlo + fr * RPITCH + 8 * fq;
            const LAS bf16* bh1 = Rhi + (16 + (fr & 3)) * RPITCH + 8 * fq; const LAS bf16* bl1 = Rlo + (16 + (fr & 3)) * RPITCH + 8 * fq;
            f32x4 acc0 = {0.f, 0.f, 0.f, 0.f}, acc1 = {0.f, 0.f, 0.f, 0.f}; float ss = 0.f;
#pragma unroll 2
            for (int s = 0; s < 32; ++s) { const int k = 32 * s + 8 * fq;
                f32x4 h0 = *(const f32x4*)(hsrc + k), h1 = *(const f32x4*)(hsrc + k + 4); const u32x4 dv = *(const u32x4*)(dsrc + k);
                h0[0] += bflo(dv.x); h0[1] += bfhi(dv.x); h0[2] += bflo(dv.y); h0[3] += bfhi(dv.y); h1[0] += bflo(dv.z); h1[1] += bfhi(dv.z); h1[2] += bflo(dv.w); h1[3] += bfhi(dv.w);
                ss += (h0[0] * h0[0] + h0[1] * h0[1]) + (h0[2] * h0[2] + h0[3] * h0[3]) + (h1[0] * h1[0] + h1[1] * h1[1]) + (h1[2] * h1[2] + h1[3] * h1[3]);
                *(f32x4*)(hdst + k) = h0; *(f32x4*)(hdst + k + 4) = h1;
                const u32x4 hw = pack8(h0, h1); *(u32x4*)(hbdst + k) = hw;
                f32x4 r0, r1; r0[0] = h0[0] - bflo(hw.x); r0[1] = h0[1] - bfhi(hw.x); r0[2] = h0[2] - bflo(hw.y); r0[3] = h0[3] - bfhi(hw.y);
                r1[0] = h1[0] - bflo(hw.z); r1[1] = h1[1] - bfhi(hw.z); r1[2] = h1[2] - bflo(hw.w); r1[3] = h1[3] - bfhi(hw.w);
                const u32x4 lw = pack8(r0, r1);
                const bf16x8 ah = __builtin_bit_cast(bf16x8, hw), al = __builtin_bit_cast(bf16x8, lw);
                const bf16x8 wh0 = *(const LAS bf16x8*)(bh0 + 32 * s), wl0 = *(const LAS bf16x8*)(bl0 + 32 * s);
                bf16x8 wh1 = *(const LAS bf16x8*)(bh1 + 32 * s), wl1 = *(const LAS bf16x8*)(bl1 + 32 * s);
                if (fr >= 4) { wh1 = (bf16x8){0, 0, 0, 0, 0, 0, 0, 0}; wl1 = wh1; }
                acc0 = __builtin_amdgcn_mfma_f32_16x16x32_bf16(wh0, ah, acc0, 0, 0, 0); acc0 = __builtin_amdgcn_mfma_f32_16x16x32_bf16(wh0, al, acc0, 0, 0, 0); acc0 = __builtin_amdgcn_mfma_f32_16x16x32_bf16(wl0, ah, acc0, 0, 0, 0);
                acc1 = __builtin_amdgcn_mfma_f32_16x16x32_bf16(wh1, ah, acc1, 0, 0, 0); acc1 = __builtin_amdgcn_mfma_f32_16x16x32_bf16(wh1, al, acc1, 0, 0, 0); acc1 = __builtin_amdgcn_mfma_f32_16x16x32_bf16(wl1, ah, acc1, 0, 0, 0);
            }
            ss += lane_xor<16>(ss); ss += lane_xor<32>(ss);
            const float rstd2 = rsqrtf(ss * (1.0f / D) + EPS);
            float gl[4];
#pragma unroll
            for (int g = 0; g < 4; ++g) gl[g] = __int_as_float(__builtin_amdgcn_ds_bpermute(fr << 2, __float_as_int(acc1[g]))) * rstd2 + rgb[g];
            int gsel = 0; float gmax = gl[0];
#pragma unroll
            for (int g = 1; g < 4; ++g) if (gl[g] > gmax) { gmax = gl[g]; gsel = g; }
            float gsum = 0.f;
#pragma unroll
            for (int g = 0; g < 4; ++g) gsum += __expf(gl[g] - gmax);
            const float gwt = 1.0f / gsum;
            if (fq == gsel) {
                float el[4];
#pragma unroll
                for (int e = 0; e < 4; ++e) el[e] = acc0[e] * rstd2 + reb[gsel * 4 + e];
                int t1 = 0; float l1 = el[0];
#pragma unroll
                for (int e = 1; e < 4; ++e) if (el[e] > l1) { l1 = el[e]; t1 = e; }
                int t2 = -1; float l2 = -3.0e38f;
#pragma unroll
                for (int e = 0; e < 4; ++e) if (e != t1 && el[e] > l2) { l2 = el[e]; t2 = e; }
                const float w1 = 1.0f / (1.0f + __expf(l2 - l1)), w2 = 1.0f - w1;
                const int ea = min(t1, t2), eb = max(t1, t2); const float cA = gwt * (t1 == ea ? w1 : w2), cB = gwt * (t1 == ea ? w2 : w1);
                const int pr = ea == 0 ? eb - 1 : (ea == 1 ? eb + 1 : 5); int cls = gsel * 6 + pr; if (!(cls >= 0 && cls < NCLS)) cls = 0;
                const int rank = __hip_atomic_fetch_add(&lcnt[cls], 1, __ATOMIC_RELAXED, __HIP_MEMORY_SCOPE_WORKGROUP); const int rr = grp * 16 + fr;
                rec[rr * 5] = cls; rec[rr * 5 + 1] = rank; rec[rr * 5 + 2] = __float_as_int(cA); rec[rr * 5 + 3] = __float_as_int(cB); rec[rr * 5 + 4] = __float_as_int(rstd2);
            }
        }
        __syncthreads();
        if (tid < NCLS) { const int n = lcnt[tid]; wgb[tid] = n > 0 ? (int)atomicAdd(gcnt + tid, (unsigned)n) : 0; }
        __syncthreads();
        const int nrw = ngrp * 16;
        for (int rr = tid; rr < nrw; rr += 512) { const int row = rr < 128 ? wg * 128 + rr : TX + (rr - 128); const int cls = rec[rr * 5];
            int* rp = route + (size_t)row * 8; rp[0] = cls; rp[1] = wgb[cls] + rec[rr * 5 + 1]; rp[2] = rec[rr * 5 + 2]; rp[3] = rec[rr * 5 + 3]; rp[4] = rec[rr * 5 + 4]; }
        __syncthreads();
    }
}
__device__ __forceinline__ void phase_E1b(Frame& F, int l) {
    class_tables(F, l);
    const LAS int* base = (const LAS int*)(F.lds + LC_BASE);
    const int* route = (const int*)(WSP() + WS_ROUTE); const bf16* HB = (const bf16*)(WSP() + WS_HB); bf16* XS = (bf16*)(WSP() + WS_XS); float* PW = (float*)(WSP() + WS_PW);
    const int gw = F.vcu * NWAVES + F.wave, NGW = F.G * NWAVES, lane = F.lane;

#pragma unroll 1
for (int row = gw; row < TR; row += NGW) { const int* rp = route + (size_t)row * 8; const int cls = rp[0]; const int pos = base[cls] + rp[1];
        if (pos < 0 || pos >= NPOSMAX) continue;
#pragma unroll
        for (int j = 0; j < 2; ++j) *(u32x4*)(XS + (size_t)pos * D + 8 * lane + 512 * j) = *(const u32x4*)(HB + (size_t)row * D + 8 * lane + 512 * j);
        if (lane == 0) { f32x4 w; w[0] = __int_as_float(rp[4]); w[1] = __int_as_float(rp[2]); w[2] = __int_as_float(rp[3]); w[3] = 0.f; *(f32x4*)(PW + (size_t)pos * 4) = w; } }
}
__device__ __forceinline__ void phase_E4(Frame& F, int l) {
    class_tables(F, l);
    const LAS int* base = (const LAS int*)(F.lds + LC_BASE);
    const int* route = (const int*)(WSP() + WS_ROUTE); float* H = (float*)(WSP() + WS_H); bf16* HB = (bf16*)(WSP() + WS_HB); const bf16* Y = (const bf16*)(WSP() + WS_Y);
    float* rstd1 = (float*)(WSP() + WS_RSTD1); const float* fg = INP(I_FG); float* out = (float*)DOP();
    const int gw = F.vcu * NWAVES + F.wave, NGW = F.G * NWAVES, lane = F.lane; const bool lastl = (l == DEPTH - 1);

#pragma unroll 1
for (int row = gw; row < TR; row += NGW) { const int* rp = route + (size_t)row * 8; const int cls = rp[0]; int pos = base[cls] + rp[1]; if (pos < 0 || pos >= NPOSMAX) pos = 0;
        f32x4 hv[2][2]; float ss = 0.f;
#pragma unroll
        for (int j = 0; j < 2; ++j) { const u32x4 yw = *(const u32x4*)(Y + (size_t)pos * D + 8 * lane + 512 * j);
            hv[j][0] = *(const f32x4*)(H + (size_t)row * D + 8 * lane + 512 * j); hv[j][1] = *(const f32x4*)(H + (size_t)row * D + 8 * lane + 512 * j + 4);
            hv[j][0][0] += bflo(yw.x); hv[j][0][1] += bfhi(yw.x); hv[j][0][2] += bflo(yw.y); hv[j][0][3] += bfhi(yw.y);
            hv[j][1][0] += bflo(yw.z); hv[j][1][1] += bfhi(yw.z); hv[j][1][2] += bflo(yw.w); hv[j][1][3] += bfhi(yw.w);
#pragma unroll
            for (int q = 0; q < 2; ++q) ss += hv[j][q][0] * hv[j][q][0] + hv[j][q][1] * hv[j][q][1] + hv[j][q][2] * hv[j][q][2] + hv[j][q][3] * hv[j][q][3]; }
        const float rs = rsqrtf(wave_sum(ss) * (1.0f / D) + EPS);
        if (!lastl) {
#pragma unroll
            for (int j = 0; j < 2; ++j) { *(f32x4*)(H + (size_t)row * D + 8 * lane + 512 * j) = hv[j][0]; *(f32x4*)(H + (size_t)row * D + 8 * lane + 512 * j + 4) = hv[j][1];
                *(u32x4*)(HB + (size_t)row * D + 8 * lane + 512 * j) = pack8(hv[j][0], hv[j][1]); }
            if (lane == 0) rstd1[row] = rs;
        } else if (row < TX) {
#pragma unroll
            for (int j = 0; j < 2; ++j) { const f32x4 g0 = *(const f32x4*)(fg + 8 * lane + 512 * j), g1 = *(const f32x4*)(fg + 8 * lane + 512 * j + 4);
                *(f32x4*)(out + (size_t)row * D + 8 * lane + 512 * j) = hv[j][0] * rs * g0; *(f32x4*)(out + (size_t)row * D + 8 * lane + 512 * j + 4) = hv[j][1] * rs * g1; }
        }
    }
}

#define RELANE() do { const int t_ = wv0 * 64 + lane_id_opaque(); F.tid = t_; F.lane = t_ & 63; F.wave = __builtin_amdgcn_readfirstlane(t_ >> 6); \
    int g_ = gridDim.x; LAUNDER_S(g_); int b_ = blockIdx.x; LAUNDER_S(b_); F.G = g_; F.bx = b_; F.vcu = (g_ % 8 == 0) ? (b_ % 8) * (g_ / 8) + b_ / 8 : b_; ll = l; LAUNDER_S(ll); } while (0)
__global__ void __launch_bounds__(NWAVES * 64, 2) fwd_kernel(Params P) {
    extern __shared__ __attribute__((aligned(16))) unsigned char lds_raw[];
    Frame F;
    F.lds = (LAS unsigned char*)lds_raw;
    F.tid = threadIdx.x; F.lane = F.tid & 63; F.wave = __builtin_amdgcn_readfirstlane(F.tid >> 6);
    F.G = gridDim.x; { const int bx = blockIdx.x; F.vcu = (F.G % 8 == 0) ? (bx % 8) * (F.G / 8) + bx / 8 : bx; }
    if (F.tid == 0) { LAS unsigned long long* pt = (LAS unsigned long long*)(F.lds + LC_PTAB);
#pragma unroll
        for (int i = 0; i < 25; ++i) pt[i] = (unsigned long long)P.in[i];
        pt[25] = (unsigned long long)P.ws; pt[26] = (unsigned long long)P.out; }
    for (int u = F.tid; u < 256; u += NWAVES * 64) ((LAS unsigned*)(F.lds + RING_BYTES))[u] = 0u;
    __syncthreads();
    const int lo = P.ph_lo, hi = P.ph_hi;
    const bool use_bar = (hi - lo) > 1;
    unsigned* barw = (unsigned*)(P.ws + WS_CTL) + CW_BAR;
    XcdBarrier bar; bar.bar = barw; bar.x = 0; bar.st = (volatile LAS unsigned*)(F.lds + LC_BAR);
    if (use_bar) bar = xcd_barrier_post(barw, (volatile LAS unsigned*)(F.lds + LC_BAR));
#ifndef PHASE_MASK
#define PHASE_MASK 0x7ff
#endif
#define EN(j) (((PHASE_MASK) >> (j)) & 1)
#ifndef DUP_MASK
#define DUP_MASK 0
#endif
#define NREP(j) ((((DUP_MASK) >> (j)) & 1) ? 2 : 1)
#define IN(k) (lo <= (k) && (k) < hi)
#define SEAM(k) do { if (IN(k) && IN((k) + 1)) xcd_barrier(bar); } while (0)

    int l = 0, ll = 0; const int wv0 = __builtin_amdgcn_readfirstlane((int)threadIdx.x >> 6);
    if (EN(0) && IN(0)) { RELANE(); convert_weights(F, 0); RELANE(); init_rows(F); }
    SEAM(0);
    for (l = 0; l < DEPTH; ++l) {
        const int pb = 1 + 10 * l;
        for (int rep = 0; rep < NREP(1); ++rep)
        if (EN(1) && IN(pb + 0)) {
            RELANE();
            unsigned char* wsl = WSP(); unsigned char* dol = DOP();
            pg8::Gemm g{(const bf16*)(wsl + WS_HB), 1024, 1024, 1 << 20};
            pg8::StaticOrder S; S.init(TX, N1, F.G, F.bx, (const bf16*)(wsl + WS_W1T), 1024);
            Epi1 E{(const float*)(wsl + WS_RSTD1), (bf16*)(wsl + WS_A), (bf16*)(wsl + WS_GLU), (bf16*)(dol + DO_Q), (bf16*)(wsl + WS_G)};
            pg8::gemm_phase<Epi1, pg8::StaticOrder>(F.lds, g, S, E, F.wave);
            if (F.bx >= 128 && F.bx < 128 + 21 && F.wave < 4) {
                const int pn = F.bx - 128, l2 = lane_id_opaque(); AccT acc; skinny_zero(acc);
                skinny_k<true>(acc, (const bf16*)(wsl + WS_HB) + (size_t)TX * 1024, 1024, (const bf16*)(wsl + WS_W1T) + (size_t)pn * 256 * 1024, 1024, 1024, F.wave, l2 & 15, l2 >> 4);
                E.run<true>(acc, pg8::Unit{128, pn, 0}, 0, F.wave, l2 & 15, l2 >> 4);
            }
        }
        SEAM(pb + 0);
        for (int rep = 0; rep < NREP(2); ++rep)
        if (EN(2) && IN(pb + 1)) { RELANE(); phase_S(F, ll); }
        SEAM(pb + 1);
        for (int rep = 0; rep < NREP(3); ++rep)
        if (EN(3) && IN(pb + 2)) { RELANE(); phase_B(F); }
        SEAM(pb + 2);
        for (int rep = 0; rep < NREP(4); ++rep)
        if (EN(4) && IN(pb + 3)) {
            RELANE(); unsigned char* wsl = WSP(); unsigned char* dol = DOP();
            pg8::Gemm g{(const bf16*)(wsl + WS_X3), 1024, 1024, 1 << 20}; pg8::SegOrder S; S.init(TX, 1024, F.G, F.bx, (const bf16*)(wsl + WS_W3CT), 1024);
            EpiCS E{(const bf16*)(wsl + WS_G), (bf16*)(dol + DO_MERGED), (const float*)(wsl + WS_BIASA)}; pg8::gemm_phase<EpiCS, pg8::SegOrder>(F.lds, g, S, E, F.wave);
            if (F.bx >= 16 && F.bx < 20 && F.wave < 4) {
                const int pn = F.bx - 16, l2 = lane_id_opaque(); AccT acc; skinny_zero(acc);
#pragma unroll 1
                for (int seg = 0; seg < 3; ++seg) { const size_t ko = seg == 0 ? 0 : (seg == 1 ? 256 : 512);
                    skinny_k<true>(acc, (const bf16*)(wsl + WS_X3) + (size_t)TX * 1024 + ko, 1024, (const bf16*)(wsl + WS_W3CT) + (size_t)pn * 256 * 1024 + ko, 1024, seg == 2 ? 512 : 256, F.wave, l2 & 15, l2 >> 4);
                    E.run<true>(acc, pg8::Unit{128, pn, seg}, 0, F.wave, l2 & 15, l2 >> 4); }
            }
        }
        SEAM(pb + 3);
        if (EN(5) && IN(pb + 4)) {
            RELANE();
            unsigned char* wsl = WSP(); unsigned char* dol = DOP();
            pg8::Gemm g{(const bf16*)(dol + DO_MERGED), 1024, 1024, 1 << 20}; pg8::StaticOrder S; S.init(TX, 1024, F.G, F.bx, (const bf16*)(wsl + WS_WOT), 1024);
            EpiB2 E{(bf16*)(wsl + WS_X3)}; pg8::gemm_phase<EpiB2, pg8::StaticOrder>(F.lds, g, S, E, F.wave);
            if (F.bx >= 16 && F.bx < 20 && F.wave < 4) {
                const int pn = F.bx - 16, l2 = lane_id_opaque(); AccT acc; skinny_zero(acc);
                skinny_k<true>(acc, (const bf16*)(dol + DO_MERGED) + (size_t)TX * 1024, 1024, (const bf16*)(wsl + WS_WOT) + (size_t)pn * 256 * 1024, 1024, 1024, F.wave, l2 & 15, l2 >> 4);
                E.run<true>(acc, pg8::Unit{128, pn, 0}, 0, F.wave, l2 & 15, l2 >> 4);
            }
        }
        SEAM(pb + 4);
        if (EN(6) && IN(pb + 5)) { RELANE(); phase_E1(F, ll); }
        SEAM(pb + 5);
        for (int rep = 0; rep < NREP(7); ++rep)
        if (EN(7) && IN(pb + 6)) { RELANE(); phase_E1b(F, ll); }
        SEAM(pb + 6);
        for (int rep = 0; rep < NREP(8); ++rep)
        if (EN(8) && IN(pb + 7)) {
            RELANE(); class_tables(F, ll);
            unsigned char* wsl = WSP();
            const int NP = __builtin_amdgcn_readfirstlane(*(const LAS int*)(F.lds + LC_NP));
            pg8::Gemm g{(const bf16*)(wsl + WS_XS), 1024, 1024, 1 << 20};
            MoeOrder S{NP, F.G, F.vcu, 0, (const LAS int*)(F.lds + LC_PCLS), (const bf16*)(DOP() + DO_W13T)};
            EpiA2 E{(const float*)(wsl + WS_PW), (bf16*)(wsl + WS_HH)}; pg8::gemm_phase<EpiA2, MoeOrder>(F.lds, g, S, E, F.wave);
        }
        SEAM(pb + 7);
        for (int rep = 0; rep < NREP(9); ++rep)
        if (EN(9) && IN(pb + 8)) {
            RELANE(); class_tables(F, ll);
            unsigned char* wsl = WSP();
            const int NP = __builtin_amdgcn_readfirstlane(*(const LAS int*)(F.lds + LC_NP));
            pg8::Gemm g{(const bf16*)(wsl + WS_HH), 512, 256, 4};
            MoeOrder S{NP, F.G, F.vcu, 1, (const LAS int*)(F.lds + LC_PCLS), (const bf16*)(DOP() + DO_W2T)};
            EpiB2 E{(bf16*)(wsl + WS_Y)}; pg8::gemm_phase<EpiB2, MoeOrder>(F.lds, g, S, E, F.wave);
        }
        SEAM(pb + 8);
        if (EN(10) && IN(pb + 9)) { RELANE(); phase_E4(F, ll); if (l + 1 < DEPTH) { RELANE(); convert_weights(F, ll + 1); } }
        SEAM(pb + 9);
    }
#undef IN
#undef SEAM
}

constexpr int N_PHASES = 1 + 10 * DEPTH;

extern "C" void kernel_launch(void* const* d_in, const int* in_sizes, int n_in, void* d_out, int out_size, void* d_ws, size_t ws_size, hipStream_t stream) {
    static int grid = 0;
    if (grid == 0) {
        if (n_in != 25 || out_size != TX * D || ws_size < WS_END) { fprintf(stderr, "kernel_launch: unexpected shapes: n_in %d out %d ws %zu (need %zu)\n", n_in, out_size, ws_size, (size_t)WS_END); grid = -1; return; }
        int dev = 0, cus = 0, per_cu = 0;
        if (hipGetDevice(&dev) != hipSuccess || hipDeviceGetAttribute(&cus, hipDeviceAttributeMultiprocessorCount, dev) != hipSuccess) { grid = -1; return; }
        if (hipFuncSetAttribute((const void*)fwd_kernel, hipFuncAttributeMaxDynamicSharedMemorySize, LDS_BYTES) != hipSuccess) { fprintf(stderr, "kernel_launch: hipFuncSetAttribute failed\n"); grid = -1; return; }
        if (hipOccupancyMaxActiveBlocksPerMultiprocessor(&per_cu, (const void*)fwd_kernel, NWAVES * 64, LDS_BYTES) != hipSuccess || per_cu < 1) fprintf(stderr, "kernel_launch: occupancy query reports %d\n", per_cu);
        (void)hipGetLastError();
        grid = cus;
    }
    if (grid < 0) return;
    (void)hipMemsetAsync((char*)d_ws + WS_CTL, 0, CTL_BYTES, stream);
    Params p{};
    for (int i = 0; i < 25; ++i) p.in[i] = (const float*)d_in[i];
    p.out = (float*)d_out; p.ws = (unsigned char*)d_ws;
#if N_LAUNCH_MODE == 1
    p.ph_lo = 0; p.ph_hi = N_PHASES;
    hipLaunchKernelGGL(fwd_kernel, dim3(grid), dim3(NWAVES * 64), LDS_BYTES, stream, p);
#else
    for (int ph = 0; ph < N_PHASES; ++ph) { p.ph_lo = ph; p.ph_hi = ph + 1; hipLaunchKernelGGL(fwd_kernel, dim3(grid), dim3(NWAVES * 64), LDS_BYTES, stream, p); }
#endif
}
```

```cpp
#include <hip/hip_runtime.h>
#include <cstdio>
#include <cstdint>

#ifndef N_LAUNCH_MODE
#define N_LAUNCH_MODE 1
#endif

#define GAS __attribute__((address_space(1)))
#define LAS __attribute__((address_space(3)))
typedef unsigned short bf16;
typedef float f32x4 __attribute__((ext_vector_type(4)));
typedef float f32x2 __attribute__((ext_vector_type(2)));
typedef unsigned u32x4 __attribute__((ext_vector_type(4)));
typedef unsigned u32x2 __attribute__((ext_vector_type(2)));
typedef short bf16x8 __attribute__((ext_vector_type(8)));
typedef __bf16 bf16x2v __attribute__((ext_vector_type(2)));

constexpr int D = 1024, NB = 4, SEQ = 8192, NMETA = 16, DEPTH = 2;
constexpr int TX = NB * SEQ;
constexpr int TM = TX + 64;
constexpr int TR = TX + NMETA;
constexpr int NIN = 5384, N1 = 5376;
constexpr int NHEAD = 8;
constexpr int NCLS = 24;
constexpr int NPOSMAX = TX + 256 + NCLS * 256;
constexpr float EPS = 1e-6f;
constexpr float LOG2E = 1.4426950408889634f;
constexpr float C2 = 0.125f * LOG2E;
constexpr int NWAVES = 8;

constexpr size_t U = (size_t)TM * 1024 * 2;
constexpr size_t WS_CTL = 0, CTL_BYTES = 1u << 20;
constexpr size_t WS_H = CTL_BYTES;
constexpr size_t WS_HB = WS_H + 2 * U;
constexpr size_t WS_G = WS_HB + U;
constexpr size_t WS_XS = WS_G;
constexpr size_t WS_Y = WS_XS + (size_t)NPOSMAX * 2048;
constexpr size_t WS_HH = WS_Y + (size_t)NPOSMAX * 2048;
static_assert(WS_HH + (size_t)NPOSMAX * 1024 <= WS_G + 3 * U, "MoE overlay fits the gates region");
constexpr size_t WS_A = WS_G + 3 * U;
constexpr size_t WS_GLU = WS_A + U / 4;
constexpr size_t WS_X3 = WS_GLU + U / 4;
constexpr size_t WS_W1T = WS_X3 + U;
constexpr size_t WS_W3CT = WS_W1T + (size_t)N1 * 1024 * 2;
constexpr size_t WS_WOT = WS_W3CT + 1024 * 1024 * 2;
constexpr size_t WS_WFG = WS_WOT + 1024 * 1024 * 2;
constexpr size_t WS_RG = WS_WFG + 8 * 1024 * 4;
constexpr size_t WS_BIASA = WS_RG + 20 * 1024 * 4;
constexpr size_t WS_RSTD1 = WS_BIASA + 4096;
constexpr size_t WS_ROUTE = WS_RSTD1 + (size_t)TM * 4;
constexpr size_t WS_PW = WS_ROUTE + (size_t)TM * 32;
constexpr size_t WS_LFT = WS_PW + (size_t)NPOSMAX * 16;
constexpr size_t WS_LFTM = WS_LFT + (size_t)32 * 8192 * 4;
constexpr size_t WS_END = WS_LFTM + 8 * 256 * 4;
static_assert(WS_END <= (size_t)512 * 1024 * 1024, "d_ws map fits 512 MiB");
constexpr size_t DO_Q = 0, DO_K = U / 2, DO_V = U, DO_MERGED = U / 2;
constexpr size_t DO_W13T = 3 * U / 2;
constexpr size_t DO_W2T = DO_W13T + (size_t)16 * 512 * 1024 * 2;
static_assert(DO_W2T + (size_t)16 * 1024 * 256 * 2 <= (size_t)TX * 1024 * 4, "d_out scratch");
constexpr int CW_BAR = 4096, CW_GCNT = 16384;

constexpr int RING_BYTES = 131072;
constexpr int LC_BAR = RING_BYTES, LC_CNT = RING_BYTES + 64, LC_BASE = RING_BYTES + 192, LC_PCLS = RING_BYTES + 320, LC_NP = RING_BYTES + 960;
constexpr int LC_PTAB = RING_BYTES + 1024;
constexpr int LDS_BYTES = RING_BYTES + 1024 + 7168;

#define LDS_WAIT() asm volatile("s_waitcnt lgkmcnt(0)" ::: "memory")
#define VM_WAIT() asm volatile("s_waitcnt vmcnt(0)" ::: "memory")
#define LAUNDER_S(p) asm volatile("" : "+s"(p))
#define LAUNDER_V(x) asm volatile("" : "+v"(x))
__device__ __forceinline__ int lane_id_opaque() { int x; asm volatile("v_mbcnt_lo_u32_b32 %0, -1, 0\n\tv_mbcnt_hi_u32_b32 %0, -1, %0" : "=v"(x)); return x; }

__device__ __forceinline__ unsigned f2bf(float f) { unsigned u = __builtin_bit_cast(unsigned, f); return (u + 0x7fffu + ((u >> 16) & 1u)) >> 16; }
__device__ __forceinline__ unsigned pk2(float lo, float hi) { f32x2 v = {lo, hi}; bf16x2v b = __builtin_convertvector(v, bf16x2v); return __builtin_bit_cast(unsigned, b); }
__device__ __forceinline__ float bflo(unsigned w) { return __builtin_bit_cast(float, w << 16); }
__device__ __forceinline__ float bfhi(unsigned w) { return __builtin_bit_cast(float, w & 0xffff0000u); }
template <int O> __device__ __forceinline__ float lane_xor(float v) {
    if constexpr (O < 32) return __int_as_float(__builtin_amdgcn_ds_swizzle(__float_as_int(v), (O << 10) | 0x1f));
    else { auto rr = __builtin_amdgcn_permlane32_swap(__float_as_uint(v), __float_as_uint(v), false, false); return __uint_as_float(rr[0]) + __uint_as_float(rr[1]) - v; }
}
__device__ __forceinline__ float wave_sum(float v) {
    v += lane_xor<1>(v); v += lane_xor<2>(v); v += lane_xor<4>(v); v += lane_xor<8>(v); v += lane_xor<16>(v);
    auto rr = __builtin_amdgcn_permlane32_swap(__float_as_uint(v), __float_as_uint(v), false, false);
    return __uint_as_float(rr[0]) + __uint_as_float(rr[1]);
}
__device__ __forceinline__ float sigmoidf_(float x) { return __builtin_amdgcn_rcpf(1.0f + __builtin_amdgcn_exp2f(-LOG2E * x)); }
__device__ __forceinline__ float dot2bf(unsigned a, unsigned b, float acc) { return __builtin_amdgcn_fdot2_f32_bf16(__builtin_bit_cast(bf16x2v, a), __builtin_bit_cast(bf16x2v, b), acc, false); }

namespace pg8 {
constexpr int BM = 256, BK = 64, HALF = 128, HTB = HALF * BK * 2, STAGE_BYTES = 8 * HTB, NXCD = 8, WGM = 8;
__host__ __device__ __forceinline__ int lds_byte(int r, int c) { const int st = (r >> 4) * 2 + (c >> 5), rr = r & 15, cc = c & 31, ob = rr * 64 + cc * 2; return st * 1024 + (ob ^ (((ob >> 9) & 1) << 5)); }
__host__ __device__ __forceinline__ void stage_rc(int b, int& R, int& C) { const int st = b / 1024, sb = b % 1024, swz = sb ^ (((sb >> 9) & 1) << 5); R = (st >> 1) * 16 + swz / 64; C = (st & 1) * 32 + (swz % 64) / 2; }
__host__ __device__ __forceinline__ int perm32(int rho) { const int n = rho >> 4, i = rho & 15; return 8 * (i >> 2) + 4 * n + (i & 3); }

struct Unit { int pm, pn, seg; };
struct Gemm { const bf16* A; int K; int ldb; int ksplit; };

struct StaticOrder {
    int nM, nN, nwg, G, c; const bf16* Bt; size_t btile;
    __device__ void init(int M, int N, int G_, int c_, const bf16* Bt_, int ldb) { nM = M / BM; nN = N / BM; nwg = nM * nN; G = G_; c = c_; Bt = Bt_; btile = (size_t)BM * ldb * 2; }
    __device__ bool next(int i, Unit& u) const {
        const long L = (long)i * G + c; if (L >= nwg) return false;
        int wgid = (int)L; { const int q = nwg / NXCD, r = nwg % NXCD, xcd = wgid % NXCD, off = wgid / NXCD; wgid = (xcd < r ? xcd * (q + 1) : r * (q + 1) + (xcd - r) * q) + off; }
        const int nig = WGM * nN, gid = wgid / nig, fm = gid * WGM, gsz = (nM - fm) < WGM ? (nM - fm) : WGM;
        u.pm = fm + ((wgid % nig) % gsz); u.pn = (wgid % nig) / gsz; u.seg = 0; return true;
    }
    __device__ __forceinline__ const char* bptr(const Unit& u, int) const { return (const char*)Bt + (size_t)u.pn * btile; }
    __device__ __forceinline__ int nt(const Unit&, int ntd) const { return ntd; }
    __device__ __forceinline__ size_t aoff(const Unit&) const { return 0; }
};
struct SegOrder : StaticOrder {
    __device__ bool next(int i, Unit& u) const { const int q = i / 3; if (!StaticOrder::next(q, u)) return false; u.seg = i - 3 * q; return true; }
    __device__ __forceinline__ size_t koff(const Unit& u) const { return u.seg == 0 ? 0 : (u.seg == 1 ? 512 : 1024); }
    __device__ __forceinline__ const char* bptr(const Unit& u, int) const { return (const char*)Bt + (size_t)u.pn * btile + koff(u); }
    __device__ __forceinline__ int nt(const Unit& u, int) const { return u.seg == 2 ? 8 : 4; }
    __device__ __forceinline__ size_t aoff(const Unit& u) const { return koff(u); }
};

template <class Epi, class Sched, bool ALIGN_EPI = true, bool SP2 = true>
__device__ __forceinline__ void gemm_phase(LAS unsigned char* lds, const Gemm g, const Sched& S, const Epi& E, const int wave_id) {
    const int tid = wave_id * 64 + lane_id_opaque();
    const int wid = __builtin_amdgcn_readfirstlane(tid >> 6), lane = tid & 63, wr = wid >> 2, wc = wid & 3, fr = lane & 15, fq = lane >> 4;
    const int K = g.K, nt = K / BK, ldb = g.ldb, ks = g.ksplit;
    unsigned voffA[2], voffB[2];
#pragma unroll
    for (int i = 0; i < 2; ++i) { int R, C; stage_rc(tid * 16 + i * 8192, R, C); const int Rb = Epi::PERM ? ((R & ~31) + perm32(R & 31)) : R;
        voffA[i] = (unsigned)(R * K + C) * 2u; voffB[i] = (unsigned)(Rb * ldb + C) * 2u; }
    const size_t kstep = (size_t)(BK * 2);
    const size_t hstep = (size_t)HALF * K * 2;
    const size_t hstepB = (size_t)HALF * ldb * 2;
    const size_t tstep = 2 * hstep;
    const unsigned ldsw = (unsigned)wid * 1024u;
    const int aoff = lds_byte(wr * 64 + fr, fq * 8), boff = lds_byte(wc * 32 + fr, fq * 8);
#define PG8_SA(b, h) (((b) * 2 + (h)) * HTB)
#define PG8_SB(b, h) ((4 + (b) * 2 + (h)) * HTB)
#define PG8_STAGE(bufoff, gbase, voff) do { _Pragma("unroll") for (int _i = 0; _i < 2; ++_i) \
        __builtin_amdgcn_global_load_lds((const unsigned*)((const char*)(gbase) + (voff)[_i]), (LAS unsigned*)(lds + (bufoff) + ldsw + _i * 8192), 16, 0, 0); } while (0)
#define PG8_LDA(dst, b, h) do { _Pragma("unroll") for (int m = 0; m < 4; ++m) _Pragma("unroll") for (int k = 0; k < 2; ++k) dst[m][k] = *(const LAS bf16x8*)(lds + PG8_SA(b, h) + aoff + m * 2048 + k * 1024); } while (0)
#define PG8_LDB(dst, b, h) do { _Pragma("unroll") for (int n = 0; n < 2; ++n) _Pragma("unroll") for (int k = 0; k < 2; ++k) dst[n][k] = *(const LAS bf16x8*)(lds + PG8_SB(b, h) + boff + n * 2048 + k * 1024); } while (0)
#define PG8_MMA(ai, bj, At, Bt) do { __builtin_amdgcn_s_setprio(1); _Pragma("unroll") for (int m = 0; m < 4; ++m) _Pragma("unroll") for (int n = 0; n < 2; ++n) _Pragma("unroll") for (int k = 0; k < 2; ++k) \
        acc[ai][bj][m][n] = __builtin_amdgcn_mfma_f32_16x16x32_bf16(Bt[n][k], At[m][k], acc[ai][bj][m][n], 0, 0, 0); __builtin_amdgcn_s_setprio(0); } while (0)
#define PG8_WAIT_V(n) asm volatile("s_waitcnt vmcnt(" #n ")" ::: "memory")
#define PG8_WAIT_L(n) asm volatile("s_waitcnt lgkmcnt(" #n ")" ::: "memory")
#define PG8_BAR __builtin_amdgcn_s_barrier()
#define PG8_SCHED __builtin_amdgcn_sched_barrier(0)
    Unit cur, nxt; int ui = 0;
    if (!S.next(0, cur)) return;
    f32x4 acc[2][2][4][2];
    { float z_ = 0.f; LAUNDER_V(z_);
#pragma unroll
    for (int a = 0; a < 2; ++a)
#pragma unroll
        for (int b = 0; b < 2; ++b)
#pragma unroll
            for (int m = 0; m < 4; ++m)
#pragma unroll
                for (int n = 0; n < 2; ++n) acc[a][b][m][n] = (f32x4){z_, z_, z_, z_}; }
    bf16x8 At[4][2], B0[2][2], B1[2][2];
    int ntc = S.nt(cur, nt);
    const char* cA = (const char*)g.A + (size_t)cur.pm * tstep + S.aoff(cur); const char* cB = S.bptr(cur, 0); const char* cB1 = S.bptr(cur, 1) - (size_t)ks * kstep;
    if constexpr (SP2) {
        PG8_STAGE(PG8_SB(0, 0), cB, voffB); PG8_STAGE(PG8_SB(0, 1), cB + hstepB, voffB); PG8_STAGE(PG8_SA(0, 0), cA, voffA); PG8_STAGE(PG8_SA(0, 1), cA + hstep, voffA);
        if (wr == 1) PG8_BAR;
        PG8_WAIT_V(2); PG8_BAR;
        PG8_STAGE(PG8_SB(1, 0), cB + kstep, voffB); PG8_STAGE(PG8_SA(1, 0), cA + kstep, voffA); PG8_STAGE(PG8_SB(1, 1), cB + hstepB + kstep, voffB);
        PG8_WAIT_V(6); PG8_BAR;
    } else {
        PG8_STAGE(PG8_SB(0, 0), cB, voffB); PG8_STAGE(PG8_SA(0, 0), cA, voffA); PG8_STAGE(PG8_SB(0, 1), cB + hstepB, voffB); PG8_STAGE(PG8_SA(0, 1), cA + hstep, voffA);
        if (wr == 1) PG8_BAR;
        PG8_WAIT_V(4); PG8_BAR;
        PG8_STAGE(PG8_SB(1, 0), cB + kstep, voffB); PG8_STAGE(PG8_SA(1, 0), cA + kstep, voffA); PG8_STAGE(PG8_SB(1, 1), cB + hstepB + kstep, voffB);
        PG8_WAIT_V(6); PG8_BAR;
    }
    for (;;) {
        const bool has_next = S.next(ui + 1, nxt);
        const char* nA = has_next ? (const char*)g.A + (size_t)nxt.pm * tstep + S.aoff(nxt) : cA; const char* nB = has_next ? S.bptr(nxt, 0) : cB;
        const char* nB1 = has_next ? S.bptr(nxt, 1) - (size_t)ks * kstep : cB1;
#pragma unroll 1
        for (int t = 0; t < ntc; t += 2) {
            const bool last = (t == ntc - 2);
            const char* a1 = cA + (size_t)(t + 1) * kstep;
            const char* bside = (t + 2 < ks) ? cB : cB1;
            const char* a2 = last ? nA : cA + (size_t)(t + 2) * kstep; const char* b2 = last ? nB : bside + (size_t)(t + 2) * kstep;
            const char* a3 = a2 + kstep; const char* b3 = b2 + kstep;
            if constexpr (SP2) {
            PG8_LDB(B0, 0, 0); PG8_LDB(B1, 0, 1); PG8_SCHED; PG8_LDA(At, 0, 0); PG8_STAGE(PG8_SA(1, 1), a1 + hstep, voffA);
            PG8_WAIT_V(8); PG8_WAIT_L(0); PG8_BAR; PG8_MMA(0, 0, At, B0); PG8_MMA(0, 1, At, B1); PG8_BAR; PG8_SCHED;
            PG8_LDA(At, 0, 1); PG8_STAGE(PG8_SB(0, 0), b2, voffB); PG8_STAGE(PG8_SB(0, 1), b2 + hstepB, voffB); PG8_STAGE(PG8_SA(0, 0), a2, voffA);
            PG8_WAIT_V(8); PG8_WAIT_L(0); PG8_BAR; PG8_MMA(1, 0, At, B0); PG8_MMA(1, 1, At, B1); PG8_BAR; PG8_SCHED;
            PG8_LDB(B0, 1, 0); PG8_LDB(B1, 1, 1); PG8_SCHED; PG8_LDA(At, 1, 0); PG8_STAGE(PG8_SA(0, 1), a2 + hstep, voffA);
            PG8_WAIT_V(8); PG8_WAIT_L(0); PG8_BAR; PG8_MMA(0, 0, At, B0); PG8_MMA(0, 1, At, B1); PG8_BAR; PG8_SCHED;
            PG8_LDA(At, 1, 1); PG8_STAGE(PG8_SB(1, 0), b3, voffB); PG8_STAGE(PG8_SB(1, 1), b3 + hstepB, voffB); PG8_STAGE(PG8_SA(1, 0), a3, voffA);
            PG8_WAIT_V(8); PG8_WAIT_L(0); PG8_BAR; PG8_MMA(1, 0, At, B0); PG8_MMA(1, 1, At, B1); PG8_BAR; PG8_SCHED;
            } else {
            PG8_LDB(B0, 0, 0); PG8_SCHED; PG8_LDA(At, 0, 0); PG8_STAGE(PG8_SA(1, 1), a1 + hstep, voffA);
            PG8_WAIT_L(8); PG8_BAR; PG8_WAIT_L(0); PG8_MMA(0, 0, At, B0); PG8_BAR; PG8_SCHED;
            PG8_LDB(B1, 0, 1); PG8_STAGE(PG8_SB(0, 0), b2, voffB);
            PG8_BAR; PG8_WAIT_L(0); PG8_MMA(0, 1, At, B1); PG8_BAR;
            PG8_LDA(At, 0, 1); PG8_STAGE(PG8_SA(0, 0), a2, voffA);
            PG8_BAR; PG8_WAIT_L(0); PG8_MMA(1, 0, At, B0); PG8_BAR; PG8_SCHED;
            PG8_STAGE(PG8_SB(0, 1), b2 + hstepB, voffB);
            PG8_WAIT_V(6); PG8_BAR; PG8_MMA(1, 1, At, B1); PG8_BAR;
            PG8_LDB(B0, 1, 0); PG8_SCHED; PG8_LDA(At, 1, 0); PG8_STAGE(PG8_SA(0, 1), a2 + hstep, voffA);
            PG8_WAIT_L(8); PG8_BAR; PG8_WAIT_L(0); PG8_MMA(0, 0, At, B0); PG8_BAR; PG8_SCHED;
            PG8_LDB(B1, 1, 1); PG8_STAGE(PG8_SB(1, 0), b3, voffB);
            PG8_BAR; PG8_WAIT_L(0); PG8_MMA(0, 1, At, B1); PG8_BAR;
            PG8_LDA(At, 1, 1); PG8_STAGE(PG8_SA(1, 0), a3, voffA);
            PG8_BAR; PG8_WAIT_L(0); PG8_MMA(1, 0, At, B0); PG8_BAR; PG8_SCHED;
            PG8_STAGE(PG8_SB(1, 1), b3 + hstepB, voffB);
            PG8_WAIT_V(6); PG8_BAR; PG8_MMA(1, 1, At, B1); PG8_BAR;
            }
        }
        if constexpr (ALIGN_EPI) { if (wr == 0) PG8_BAR; }
        { const int l2 = lane_id_opaque(); E(acc, cur, wr, wc, l2 & 15, l2 >> 4); }
        if (!has_next) break;
        if (!E.keep(cur)) { float z_ = 0.f; LAUNDER_V(z_);
#pragma unroll
        for (int a = 0; a < 2; ++a)
#pragma unroll
            for (int b = 0; b < 2; ++b)
#pragma unroll
                for (int m = 0; m < 4; ++m)
#pragma unroll
                    for (int n = 0; n < 2; ++n) acc[a][b][m][n] = (f32x4){z_, z_, z_, z_}; }
        cur = nxt; cA = nA; cB = nB; cB1 = nB1; ++ui; ntc = S.nt(cur, nt);
        if constexpr (ALIGN_EPI) { if (wr == 1) PG8_BAR; }
    }
    PG8_WAIT_V(0);
    if constexpr (!ALIGN_EPI) { if (wr == 0) PG8_BAR; }
    PG8_BAR;
#undef PG8_SA
#undef PG8_SB
#undef PG8_STAGE
#undef PG8_LDA
#undef PG8_LDB
#undef PG8_MMA
#undef PG8_WAIT_V
#undef PG8_WAIT_L
#undef PG8_BAR
#undef PG8_SCHED
}
}

typedef f32x4 AccT[2][2][4][2];
__device__ __forceinline__ u32x4 pack8(const f32x4 a, const f32x4 b) { u32x4 w; w.x = pk2(a[0], a[1]); w.y = pk2(a[2], a[3]); w.z = pk2(b[0], b[1]); w.w = pk2(b[2], b[3]); return w; }

struct Epi1 {
    static constexpr bool PERM = true;
    __device__ __forceinline__ bool keep(const pg8::Unit&) const { return false; }
    const float* rstd; bf16* A; bf16* GLU; bf16* QKV; bf16* G;
    __device__ __forceinline__ void operator()(AccT& acc, const pg8::Unit& u, int wr, int wc, int fr, int fq) const { run<false>(acc, u, wr, wc, fr, fq); }
    template <bool SK> __device__ __forceinline__ void run(AccT& acc, const pg8::Unit& u, int wr, int wc, int fr, int fq) const {
        const int row0 = u.pm * 256 + wr * 64 + fr, lc0 = wc * 32 + 8 * fq, pn = u.pn;
#pragma unroll
        for (int ai = 0; ai < (SK ? 1 : 2); ++ai)
#pragma unroll
            for (int m = 0; m < (SK ? 1 : 4); ++m) {
                const int row = row0 + ai * 128 + m * 16; const float rs = rstd[row];
                f32x4 v[2][2];
#pragma unroll
                for (int bj = 0; bj < 2; ++bj)
#pragma unroll
                    for (int n = 0; n < 2; ++n) v[bj][n] = acc[ai][bj][m][n] * rs;
                if (pn == 0) {
#pragma unroll
                    for (int bj = 0; bj < 2; ++bj) *(u32x4*)(A + (size_t)row * 256 + bj * 128 + lc0) = pack8(v[bj][0], v[bj][1]);
                } else if (pn <= 2) {
                    f32x4 o[2];
#pragma unroll
                    for (int n = 0; n < 2; ++n)
#pragma unroll
                        for (int j = 0; j < 4; ++j) o[n][j] = v[0][n][j] * sigmoidf_(v[1][n][j]);
                    *(u32x4*)(GLU + (size_t)row * 256 + (pn - 1) * 128 + lc0) = pack8(o[0], o[1]);
                } else if (pn <= 8) {
                    const int t = (pn - 3) >> 1; bf16* base = QKV + (size_t)t * (U / 4); const float sc = t == 0 ? C2 : 1.0f;
#pragma unroll
                    for (int bj = 0; bj < 2; ++bj) *(u32x4*)(base + (size_t)row * 512 + ((pn - 3) & 1) * 256 + bj * 128 + lc0) = pack8(v[bj][0] * sc, v[bj][1] * sc);
                } else {
#pragma unroll
                    for (int bj = 0; bj < 2; ++bj) { f32x4 o[2];
#pragma unroll
                        for (int n = 0; n < 2; ++n)
#pragma unroll
                            for (int j = 0; j < 4; ++j) o[n][j] = fmaxf(sigmoidf_(v[bj][n][j]), 1e-30f);
                        *(u32x4*)(G + (size_t)row * 3072 + (pn - 9) * 256 + bj * 128 + lc0) = pack8(o[0], o[1]); }
                }
            }
    }
};
struct EpiCS {
    static constexpr bool PERM = true;
    const bf16* G; bf16* Mg; const float* bias;
    __device__ __forceinline__ bool keep(const pg8::Unit& u) const { return u.seg != 2; }
    __device__ __forceinline__ void operator()(AccT& acc, const pg8::Unit& u, int wr, int wc, int fr, int fq) const { run<false>(acc, u, wr, wc, fr, fq); }
    template <bool SK> __device__ __forceinline__ void run(AccT& acc, const pg8::Unit& u, int wr, int wc, int fr, int fq) const {
        const int row0 = u.pm * 256 + wr * 64 + fr, col0 = u.pn * 256 + wc * 32 + 8 * fq;
        const bool lastseg = u.seg == 2; const int w = u.seg, wd = lastseg ? 2 : u.seg + 1; const float bsc = u.seg == 0 ? 1.f : 0.f;
        f32x4 bv[2][2];
#pragma unroll
        for (int bj = 0; bj < 2; ++bj) { bv[bj][0] = *(const f32x4*)(bias + col0 + bj * 128) * bsc; bv[bj][1] = *(const f32x4*)(bias + col0 + bj * 128 + 4) * bsc; }
#pragma unroll
        for (int ai = 0; ai < (SK ? 1 : 2); ++ai) {
            u32x4 gn[4][2], gd[4][2];
#pragma unroll
            for (int m = 0; m < (SK ? 1 : 4); ++m) { const bf16* gp = G + (size_t)(row0 + ai * 128 + m * 16) * 3072 + col0;
#pragma unroll
                for (int bj = 0; bj < 2; ++bj) { gn[m][bj] = *(const u32x4*)(gp + w * 1024 + bj * 128); gd[m][bj] = *(const u32x4*)(gp + wd * 1024 + bj * 128); } }
#pragma unroll
            for (int m = 0; m < (SK ? 1 : 4); ++m) { const int row = row0 + ai * 128 + m * 16;
#pragma unroll
                for (int bj = 0; bj < 2; ++bj) {
                    const u32x4 n4 = gn[m][bj], d4 = gd[m][bj];
                    f32x4 a0 = acc[ai][bj][m][0] + bv[bj][0], a1 = acc[ai][bj][m][1] + bv[bj][1];
#define RAT(gnv, gdv) ((gnv) * (lastseg ? 1.0f : __builtin_amdgcn_rcpf(gdv)))
                    a0[0] *= RAT(bflo(n4.x), bflo(d4.x)); a0[1] *= RAT(bfhi(n4.x), bfhi(d4.x)); a0[2] *= RAT(bflo(n4.y), bflo(d4.y)); a0[3] *= RAT(bfhi(n4.y), bfhi(d4.y));
                    a1[0] *= RAT(bflo(n4.z), bflo(d4.z)); a1[1] *= RAT(bfhi(n4.z), bfhi(d4.z)); a1[2] *= RAT(bflo(n4.w), bflo(d4.w)); a1[3] *= RAT(bfhi(n4.w), bfhi(d4.w));
#undef RAT
                    acc[ai][bj][m][0] = a0; acc[ai][bj][m][1] = a1;
                    asm volatile("" : "+v"(acc[ai][bj][m][0]), "+v"(acc[ai][bj][m][1]));
                    if (lastseg) *(u32x4*)(Mg + (size_t)row * 1024 + col0 + bj * 128) = pack8(a0, a1);
                } }
            asm volatile("" ::: "memory");
        }
    }
};
struct EpiD {
    static constexpr bool PERM = false;
    __device__ __forceinline__ bool keep(const pg8::Unit&) const { return false; }
    float* H; bf16* HB;
    __device__ __forceinline__ void operator()(AccT& acc, const pg8::Unit& u, int wr, int wc, int fr, int fq) const { run<false>(acc, u, wr, wc, fr, fq); }
    template <bool SK> __device__ __forceinline__ void run(AccT& acc, const pg8::Unit& u, int wr, int wc, int fr, int fq) const {
        const int row0 = u.pm * 256 + wr * 64 + fr, col0 = u.pn * 256 + wc * 32 + 4 * fq;
#pragma unroll
        for (int ai = 0; ai < (SK ? 1 : 2); ++ai)
#pragma unroll
            for (int m = 0; m < (SK ? 1 : 4); ++m) {
                const size_t off = (size_t)(row0 + ai * 128 + m * 16) * 1024 + col0;
#pragma unroll
                for (int bj = 0; bj < 2; ++bj)
#pragma unroll
                    for (int n = 0; n < 2; ++n) { const size_t o = off + bj * 128 + n * 16; const f32x4 hv = *(const f32x4*)(H + o) + acc[ai][bj][m][n];
                        *(f32x4*)(H + o) = hv; u32x2 w; w.x = pk2(hv[0], hv[1]); w.y = pk2(hv[2], hv[3]); *(u32x2*)(HB + o) = w; }
            }
    }
};
struct EpiA2 {
    static constexpr bool PERM = true;
    __device__ __forceinline__ bool keep(const pg8::Unit&) const { return false; }
    const float* PW; bf16* HH;
    __device__ __forceinline__ void operator()(AccT& acc, const pg8::Unit& u, int wr, int wc, int fr, int fq) const {
        const int row0 = u.pm * 256 + wr * 64 + fr, lc0 = wc * 32 + 8 * fq, side = u.pn >> 1;
#pragma unroll
        for (int ai = 0; ai < 2; ++ai)
#pragma unroll
            for (int m = 0; m < 4; ++m) {
                const int row = row0 + ai * 128 + m * 16; const f32x4 pw = *(const f32x4*)(PW + (size_t)row * 4);
                const float rs = pw[0], cw = side ? pw[2] : pw[1];
                f32x4 o[2];
#pragma unroll
                for (int n = 0; n < 2; ++n)
#pragma unroll
                    for (int j = 0; j < 4; ++j) { const float a1 = acc[ai][0][m][n][j] * rs, a3 = acc[ai][1][m][n][j] * rs; o[n][j] = cw * a1 * sigmoidf_(a1) * a3; }
                *(u32x4*)(HH + (size_t)row * 512 + side * 256 + (u.pn & 1) * 128 + lc0) = pack8(o[0], o[1]);
            }
    }
};
struct EpiB2 {
    static constexpr bool PERM = true;
    __device__ __forceinline__ bool keep(const pg8::Unit&) const { return false; }
    bf16* Y;
    __device__ __forceinline__ void operator()(AccT& acc, const pg8::Unit& u, int wr, int wc, int fr, int fq) const { run<false>(acc, u, wr, wc, fr, fq); }
    template <bool SK> __device__ __forceinline__ void run(AccT& acc, const pg8::Unit& u, int wr, int wc, int fr, int fq) const {
        const int row0 = u.pm * 256 + wr * 64 + fr, col0 = u.pn * 256 + wc * 32 + 8 * fq;
#pragma unroll
        for (int ai = 0; ai < (SK ? 1 : 2); ++ai)
#pragma unroll
            for (int m = 0; m < (SK ? 1 : 4); ++m) {
                bf16* rp = Y + (size_t)(row0 + ai * 128 + m * 16) * 1024 + col0;
#pragma unroll
                for (int bj = 0; bj < 2; ++bj) *(u32x4*)(rp + bj * 128) = pack8(acc[ai][bj][m][0], acc[ai][bj][m][1]);
            }
    }
};
struct MoeOrder {
    int NP, G, c, mode; const LAS int* pcls; const bf16* W;
    __device__ bool next(int i, pg8::Unit& u) const { const long L = (long)i * G + c; if (L >= (long)NP * 4) return false; u.pm = (int)(L >> 2); u.pn = (int)(L & 3); u.seg = 0; return true; }
    __device__ __forceinline__ int nt(const pg8::Unit&, int ntd) const { return ntd; }
    __device__ __forceinline__ size_t aoff(const pg8::Unit&) const { return 0; }
    __device__ __forceinline__ const char* bptr(const pg8::Unit& u, int side) const {
        const int cls = __builtin_amdgcn_readfirstlane(pcls[u.pm]); const int grp = cls / 6, pr = cls % 6;
        const int ea = pr < 3 ? 0 : (pr < 5 ? 1 : 2), eb = pr < 3 ? pr + 1 : (pr < 5 ? pr - 1 : 3);
        if (mode == 0) { const int e = grp * 4 + (u.pn < 2 ? ea : eb); return (const char*)W + ((size_t)e * 512 + (size_t)(u.pn & 1) * 256) * 1024 * 2; }
        const int e = grp * 4 + (side ? eb : ea); return (const char*)W + ((size_t)e * 1024 + (size_t)u.pn * 256) * 256 * 2;
    }
};

template <bool PERM> __device__ __forceinline__ void skinny_k(AccT& acc, const bf16* A, int lda, const bf16* Bt, int ldb, int K, int wc, int fr, int fq) {
    const bf16* ap = A + (size_t)fr * lda + 8 * fq;
    const bf16* bp[2][2];
#pragma unroll
    for (int bj = 0; bj < 2; ++bj)
#pragma unroll
        for (int n = 0; n < 2; ++n) { const int col = 128 * bj + 32 * wc + (PERM ? 8 * (fr >> 2) + 4 * n + (fr & 3) : 16 * n + fr); bp[bj][n] = Bt + (size_t)col * ldb + 8 * fq; }
#pragma unroll 4
    for (int k0 = 0; k0 < K; k0 += 32) {
        const bf16x8 a = *(const bf16x8*)(ap + k0);
#pragma unroll
        for (int bj = 0; bj < 2; ++bj)
#pragma unroll
            for (int n = 0; n < 2; ++n) { const bf16x8 b = *(const bf16x8*)(bp[bj][n] + k0); acc[0][bj][0][n] = __builtin_amdgcn_mfma_f32_16x16x32_bf16(b, a, acc[0][bj][0][n], 0, 0, 0); }
    }
}
__device__ __forceinline__ void skinny_zero(AccT& acc) {
#pragma unroll
    for (int bj = 0; bj < 2; ++bj)
#pragma unroll
        for (int n = 0; n < 2; ++n) acc[0][bj][0][n] = (f32x4){0.f, 0.f, 0.f, 0.f};
}

#define XB_TMO      128
#define XB_XCNT(j)  (256  + 64 * (j))
#define XB_XSUB(j)  (1280 + 64 * (j))
#define XB_XGEN(j)  (2304 + 64 * (j))
#define XB_TOP      3328
#define XB_TOPGEN   3392
#define XCD_BAR_WORDS 3456
#define XB_SPIN_CAP (1u << 24)
__device__ __forceinline__ unsigned xb_ld(unsigned* p)              { return __hip_atomic_load(p, __ATOMIC_RELAXED, __HIP_MEMORY_SCOPE_AGENT); }
__device__ __forceinline__ unsigned xb_add(unsigned* p, unsigned v) { return __hip_atomic_fetch_add(p, v, __ATOMIC_RELAXED, __HIP_MEMORY_SCOPE_AGENT); }
__device__ __forceinline__ unsigned xb_xcc_id() { return (unsigned)__builtin_amdgcn_s_getreg((3 << 11) | 20) & 0xFu; }
#define XB_SPIN(cond, bar) do { unsigned _sp = 0; while (cond) { __builtin_amdgcn_s_sleep(1); \
    if ((++_sp & 255u) == 0u) { if (xb_ld(&(bar)[XB_TMO])) break; if (_sp > XB_SPIN_CAP) { atomicAdd(&(bar)[XB_TMO], 1u); break; } } } } while (0)
struct XcdBarrier { unsigned* bar; unsigned x; volatile LAS unsigned* st; };
__device__ __forceinline__ XcdBarrier xcd_barrier_post(unsigned* bar, volatile LAS unsigned* st) {
    XcdBarrier b; b.bar = bar; b.x = xb_xcc_id(); b.st = st;
    if (threadIdx.x == 0) (void)xb_add(&bar[XB_XCNT(b.x)], 1u);
    return b;
}
__device__ __forceinline__ void xcd_barrier_complete(unsigned* bar, unsigned x, unsigned& nloc, unsigned& nx) {
    const unsigned G = gridDim.x * gridDim.y * gridDim.z;
    unsigned sum, cnt, mine, sp = 0u;
    for (;;) {
        sum = 0u; cnt = 0u; mine = 0u;
#pragma unroll
        for (unsigned j = 0; j < 16; ++j) { const unsigned c = xb_ld(&bar[XB_XCNT(j)]); sum += c; cnt += (c > 0u) ? 1u : 0u; mine = (j == x) ? c : mine; }
        if (sum == G) break;
        __builtin_amdgcn_s_sleep(1);
        if ((++sp & 255u) == 0u) { if (xb_ld(&bar[XB_TMO])) break; if (sp > XB_SPIN_CAP) { atomicAdd(&bar[XB_TMO], 1u); break; } }
    }
    nloc = mine > 0u ? mine : 1u; nx = cnt > 0u ? cnt : 1u;
}
__device__ __forceinline__ void xcd_barrier(const XcdBarrier& b) {
    asm volatile("s_waitcnt vmcnt(0)" ::: "memory");
    __syncthreads();
    if (threadIdx.x == 0) {
        unsigned* bar = b.bar;
        __builtin_amdgcn_s_waitcnt(0);
        unsigned nloc = b.st[0], nx = b.st[1];
        if (nloc == 0u) { xcd_barrier_complete(bar, b.x, nloc, nx); b.st[0] = nloc; b.st[1] = nx; }
        const unsigned old = xb_add(&bar[XB_XSUB(b.x)], 1u);
        const unsigned gen = old / nloc;
        if (old + 1u == (gen + 1u) * nloc) {
            __builtin_amdgcn_fence(__ATOMIC_RELEASE, "agent");
            asm volatile("s_waitcnt vmcnt(0)" ::: "memory");
            const unsigned og = xb_add(&bar[XB_TOP], 1u);
            const unsigned tg = og / nx;
            if (og + 1u == (tg + 1u) * nx) xb_add(&bar[XB_TOPGEN], 1u);
            else XB_SPIN(xb_ld(&bar[XB_TOPGEN]) == tg, bar);
            __builtin_amdgcn_fence(__ATOMIC_ACQUIRE, "agent");
            xb_add(&bar[XB_XGEN(b.x)], 1u);
            asm volatile("s_waitcnt vmcnt(0)" ::: "memory");
        } else {
            XB_SPIN(xb_ld(&bar[XB_XGEN(b.x)]) == gen, bar);
            __builtin_amdgcn_fence(__ATOMIC_ACQUIRE, "agent");
            asm volatile("s_waitcnt vmcnt(0)" ::: "memory");
        }
    }
    __syncthreads();
}

struct Params { const float* in[25]; float* out; unsigned char* ws; int ph_lo, ph_hi; };
enum { I_X = 0, I_META, I_N1G, I_WIN, I_BF, I_PW, I_PB, I_PS, I_CW, I_CB, I_LNG, I_LNB, I_WOA, I_WOB, I_WOC, I_WO, I_N2G, I_RGW, I_RGB, I_REW, I_REB, I_W1, I_W3, I_W2, I_FG };

struct Frame {
    LAS unsigned char* lds;
    int tid, lane, wave, vcu, G, bx;
};
__device__ __forceinline__ unsigned long long ptab_get(const Frame& F, int i) { const LAS unsigned* t = (const LAS unsigned*)(F.lds + LC_PTAB) + 2 * i; const unsigned lo = __builtin_amdgcn_readfirstlane(t[0]), hi = __builtin_amdgcn_readfirstlane(t[1]); return ((unsigned long long)hi << 32) | lo; }
#define INP(i) ((const float*)(const GAS float*)ptab_get(F, (i)))
#define WSP() ((unsigned char*)(GAS unsigned char*)ptab_get(F, 25))
#define DOP() ((unsigned char*)(GAS unsigned char*)ptab_get(F, 26))

__device__ __forceinline__ void tr_item(const float* W, int ldw, int scol0, const float* gk, bf16* WT, int ldt, int drow0, int k0, LAS float* scr, int lane) {
    const int n4 = (lane & 7) * 4, kr = lane >> 3;
    f32x4 v[8];
#pragma unroll
    for (int i = 0; i < 8; ++i) v[i] = *(const f32x4*)(W + (size_t)(k0 + 8 * i + kr) * ldw + scol0 + n4);
#pragma unroll
    for (int i = 0; i < 8; ++i) { const int kk = 8 * i + kr; const float g = gk ? gk[k0 + kk] : 1.0f; LAS float* d = scr + kk * 33 + n4; d[0] = v[i][0] * g; d[1] = v[i][1] * g; d[2] = v[i][2] * g; d[3] = v[i][3] * g; }
    LDS_WAIT(); asm volatile("" ::: "memory");
    const int c = lane & 7;
#pragma unroll
    for (int j = 0; j < 4; ++j) { const int n = (lane >> 3) + 8 * j; const LAS float* s = scr + (8 * c) * 33 + n;
        u32x4 o; o.x = pk2(s[0 * 33], s[1 * 33]); o.y = pk2(s[2 * 33], s[3 * 33]); o.z = pk2(s[4 * 33], s[5 * 33]); o.w = pk2(s[6 * 33], s[7 * 33]);
        *(u32x4*)(WT + (size_t)(drow0 + n) * ldt + k0 + 8 * c) = o; }
    LDS_WAIT(); asm volatile("" ::: "memory");
}
__device__ __forceinline__ int map1(int n) {
    const int tile = n >> 8, r = n & 255;
    if (tile == 0) return n;
    if (tile <= 2) { const int c = (tile - 1) * 128 + (r & 127); return (r < 128 ? 256 : 512) + c; }
    if (tile <= 8) return n;
    return n + 8;
}
__device__ __forceinline__ void convert_weights(Frame& F, int l) {
    LAS float* scr = (LAS float*)(F.lds + F.wave * 16384);
    const int gw = F.vcu * NWAVES + F.wave, NGW = F.G * NWAVES, lane = F.lane;
    const float* g1 = INP(I_N1G) + (size_t)l * D; const float* g2 = INP(I_N2G) + (size_t)l * D;
    unsigned char* ws = WSP();
#pragma unroll 1
    for (int it0 = gw; it0 < 9728; it0 += NGW) { int it = it0;
        if (it < 2688) { const int kb = it / 168, nb = it % 168; tr_item(INP(I_WIN) + (size_t)l * D * NIN, NIN, map1(nb * 32), g1, (bf16*)(ws + WS_W1T), 1024, nb * 32, kb * 64, scr, lane); continue; } it -= 2688;
        if (it < 128) { const int kb = it / 32, nb = it % 32; tr_item(INP(I_WOB) + (size_t)l * 256 * D, 1024, nb * 32, nullptr, (bf16*)(ws + WS_W3CT) + 256, 1024, nb * 32, kb * 64, scr, lane); continue; } it -= 128;
        if (it < 256) { const int kb = it / 32, nb = it % 32; tr_item(INP(I_WOC) + (size_t)l * 512 * D, 1024, nb * 32, nullptr, (bf16*)(ws + WS_W3CT) + 512, 1024, nb * 32, kb * 64, scr, lane); continue; } it -= 256;
        if (it < 512) { const int kb = it / 32, nb = it % 32; tr_item(INP(I_WO) + (size_t)l * D * D, 1024, nb * 32, nullptr, (bf16*)(ws + WS_WOT), 1024, nb * 32, kb * 64, scr, lane); continue; } it -= 512;
        if (it < 4096) { const int e = it >> 8, r = it & 255, kb = r >> 4, nb = r & 15, n0 = nb * 32, jt = n0 >> 8, rr = n0 & 255;
            const float* W = (rr < 128 ? INP(I_W1) : INP(I_W3)) + ((size_t)l * 16 + e) * D * 256;
            tr_item(W, 256, jt * 128 + (rr & 127), g2, (bf16*)(DOP() + DO_W13T) + (size_t)e * 512 * 1024, 1024, n0, kb * 64, scr, lane); continue; } it -= 4096;
        { const int e = it >> 7, r = it & 127, kb = r >> 5, nb = r & 31;
            tr_item(INP(I_W2) + ((size_t)l * 16 + e) * 256 * D, 1024, nb * 32, nullptr, (bf16*)(DOP() + DO_W2T) + (size_t)e * 1024 * 256, 256, nb * 32, kb * 64, scr, lane); }
    }
    { const float* pw = INP(I_PW) + (size_t)l * 4 * 64 * 64; const float* ps = INP(I_PS) + (size_t)l * 256; const float* pb = INP(I_PB) + (size_t)l * 256;
      const float* wa = INP(I_WOA) + (size_t)l * 256 * D; bf16* WT = (bf16*)(ws + WS_W3CT); float* bias = (float*)(ws + WS_BIASA);
      const int gt = F.vcu * 512 + F.tid, NT = F.G * 512;
      for (int idx = gt; idx < 256 * 1024; idx += NT) { const int n = idx & 1023, kk = idx >> 10, grp = kk >> 6, c = kk & 63; float s = 0.f;
#pragma unroll 16
        for (int d = 0; d < 64; ++d) s += pw[(grp * 64 + c) * 64 + d] * ps[grp * 64 + d] * wa[(size_t)(grp * 64 + d) * D + n];
        WT[(size_t)n * 1024 + kk] = (bf16)f2bf(s); }
      for (int n = gw; n < 1024; n += NGW) { float s = 0.f;
#pragma unroll
        for (int j = 0; j < 4; ++j) { const int d = lane + 64 * j; s += pb[d] * ps[d] * wa[(size_t)d * D + n]; }
        s = wave_sum(s); if (lane == 0) bias[n] = s; }
      float* wfg = (float*)(ws + WS_WFG); const float* win = INP(I_WIN) + (size_t)l * D * NIN;
      for (int idx = gt; idx < 8 * 1024; idx += NT) { const int c = idx >> 10, k = idx & 1023; wfg[idx] = g1[k] * win[(size_t)k * NIN + 2304 + c]; }
      float* rg = (float*)(ws + WS_RG); const float* re = INP(I_REW) + (size_t)l * D * 16; const float* rgw = INP(I_RGW) + (size_t)l * D * 4;
      for (int idx = gt; idx < 20 * 1024; idx += NT) { const int c = idx >> 10, k = idx & 1023; rg[idx] = g2[k] * (c < 16 ? re[(size_t)k * 16 + c] : rgw[(size_t)k * 4 + (c - 16)]); } }
}
__device__ __forceinline__ void init_rows(Frame& F) {
    const int gw = F.vcu * NWAVES + F.wave, NGW = F.G * NWAVES, lane = F.lane;
    float* H = (float*)(WSP() + WS_H); bf16* HB = (bf16*)(WSP() + WS_HB); float* rstd1 = (float*)(WSP() + WS_RSTD1);

#pragma unroll 1
for (int row = gw; row < TR; row += NGW) {
        const float* src = row < TX ? INP(I_X) + (size_t)row * D : (row - TX < NMETA ? INP(I_META) + (size_t)(row - TX) * D : nullptr);
        f32x4 v[4]; float ss = 0.f;
#pragma unroll
        for (int j = 0; j < 4; ++j) { float z_ = 0.f; LAUNDER_V(z_); v[j] = src ? *(const f32x4*)(src + 4 * lane + 256 * j) : (f32x4){z_, z_, z_, z_}; ss += v[j][0] * v[j][0] + v[j][1] * v[j][1] + v[j][2] * v[j][2] + v[j][3] * v[j][3]; }
        ss = wave_sum(ss);
#pragma unroll
        for (int j = 0; j < 4; ++j) { u32x2 w; w.x = pk2(v[j][0], v[j][1]); w.y = pk2(v[j][2], v[j][3]); *(u32x2*)(HB + (size_t)row * D + 4 * lane + 256 * j) = w; }
        if (lane == 0) rstd1[row] = rsqrtf(ss * (1.0f / D) + EPS);
    }
    { bf16* Kb = (bf16*)(DOP() + DO_K) + (size_t)TR * 512; bf16* Vb = (bf16*)(DOP() + DO_V) + (size_t)TR * 512; const int gt = F.vcu * 512 + F.tid;
      if (gt < 48 * 64) { *(u32x4*)(Kb + (size_t)gt * 8) = (u32x4){0u, 0u, 0u, 0u}; *(u32x4*)(Vb + (size_t)gt * 8) = (u32x4){0u, 0u, 0u, 0u}; } }
}

__device__ __forceinline__ int srcrow(bool isx, int b, int t) {
    if (t >= 0) return (isx ? b * SEQ : TX) + t;
    if (isx) { const int mm = NMETA + t; return mm >= 0 ? TX + mm : -1; }
    return -1;
}
__device__ __forceinline__ void phase_S(Frame& F, int l) {
    LAS unsigned char* lds = F.lds; const int wave = F.wave;
#pragma unroll 1
    for (int item = F.vcu; item < 513; item += F.G) {
        const bool isx = item < 512; const int row0 = isx ? item * 64 : TX + (item - 512) * 64; const int b = isx ? (item * 64) / SEQ : 0; const int t0 = isx ? (item * 64) % SEQ : (item - 512) * 64; const int nrows = isx ? 64 : NMETA;
        { unsigned char* ws = WSP(); int tid = F.tid; LAUNDER_V(tid); const int lane = tid & 63;
          const bf16* HB = (const bf16*)(ws + WS_HB); const float* rstd1 = (const float*)(ws + WS_RSTD1); const float* wfg = (const float*)(ws + WS_WFG);
          float* LFT = (float*)(ws + WS_LFT); float* LFTM = (float*)(ws + WS_LFTM); const float* bfg = INP(I_BF) + l * 8;
          LAS float* W = (LAS float*)lds;
#pragma unroll 1
          for (int i = tid; i < 2048; i += 512) *(LAS f32x4*)(W + 4 * i) = *(const f32x4*)(wfg + 4 * i);
          __syncthreads();
#pragma unroll 1
          for (int rr = wave; rr < nrows; rr += 8) { const int row = row0 + rr; float xv[16];
#pragma unroll
            for (int j = 0; j < 2; ++j) { const u32x4 w = *(const u32x4*)(HB + (size_t)row * D + 8 * lane + 512 * j);
                xv[8 * j + 0] = bflo(w.x); xv[8 * j + 1] = bfhi(w.x); xv[8 * j + 2] = bflo(w.y); xv[8 * j + 3] = bfhi(w.y); xv[8 * j + 4] = bflo(w.z); xv[8 * j + 5] = bfhi(w.z); xv[8 * j + 6] = bflo(w.w); xv[8 * j + 7] = bfhi(w.w); }
            float mine = 0.f;
#pragma unroll
            for (int c = 0; c < 8; ++c) { float s = 0.f;
#pragma unroll
                for (int j = 0; j < 2; ++j) { const f32x4 w0 = *(const LAS f32x4*)(W + c * 1024 + 8 * lane + 512 * j), w1 = *(const LAS f32x4*)(W + c * 1024 + 8 * lane + 512 * j + 4);
                    s += xv[8 * j] * w0[0] + xv[8 * j + 1] * w0[1] + xv[8 * j + 2] * w0[2] + xv[8 * j + 3] * w0[3] + xv[8 * j + 4] * w1[0] + xv[8 * j + 5] * w1[1] + xv[8 * j + 6] * w1[2] + xv[8 * j + 7] * w1[3]; }
                s = wave_sum(s); if (lane == c) mine = s; }
            if (lane < 8 && row < TR) { const float xg = mine * rstd1[row] + bfg[lane]; const float lf = fminf(xg, 0.f) - 0.69314718056f * __builtin_amdgcn_logf(1.0f + __expf(-fabsf(xg)));
                if (isx) LFT[(size_t)(b * 8 + lane) * SEQ + t0 + rr] = lf; else LFTM[lane * 256 + t0 + rr] = lf; } }
          __syncthreads(); }
        { unsigned char* ws = WSP(); int tid = F.tid; LAUNDER_V(tid);
          const bf16* Ab = (const bf16*)(ws + WS_A); bf16* DIFF = (bf16*)(ws + WS_X3);
          LAS unsigned char* T = lds;
#pragma unroll 1
          for (int i = tid; i < (15 + nrows) * 32; i += 512) { const int s = i >> 5, ch = i & 31; const int r = srcrow(isx, b, t0 + s - 15);
              unsigned z_ = 0u; LAUNDER_V(z_);
              *(LAS u32x4*)(T + s * 512 + ch * 16) = r >= 0 ? *(const u32x4*)(Ab + (size_t)r * 256 + ch * 8) : (u32x4){z_, z_, z_, z_}; }
          __syncthreads();
#pragma unroll 1
          for (int i = tid; i < nrows * 32; i += 512) { const int r = i >> 5, ch = i & 31, grp = ch >> 3, w = 2 << grp; const int cnt = isx ? w : min(t0 + r + 1, w);
              float s[8];
#pragma unroll
              for (int j = 0; j < 8; ++j) s[j] = 0.f;
#pragma unroll 1
              for (int d = 0; d < cnt; ++d) { const u32x4 v = *(const LAS u32x4*)(T + (15 + r - d) * 512 + ch * 16);
                  s[0] += bflo(v.x); s[1] += bfhi(v.x); s[2] += bflo(v.y); s[3] += bfhi(v.y); s[4] += bflo(v.z); s[5] += bfhi(v.z); s[6] += bflo(v.w); s[7] += bfhi(v.w); }
              const u32x4 a = *(const LAS u32x4*)(T + (15 + r) * 512 + ch * 16); const float ic = 1.0f / (float)cnt;
              u32x4 o; o.x = pk2(s[0] * ic - bflo(a.x), s[1] * ic - bfhi(a.x)); o.y = pk2(s[2] * ic - bflo(a.y), s[3] * ic - bfhi(a.y));
              o.z = pk2(s[4] * ic - bflo(a.z), s[5] * ic - bfhi(a.z)); o.w = pk2(s[6] * ic - bflo(a.w), s[7] * ic - bfhi(a.w));
              if (row0 + r < TR) *(u32x4*)(DIFF + (size_t)(row0 + r) * 1024 + ch * 8) = o; }
          __syncthreads(); }
        { unsigned char* ws = WSP(); int tid = F.tid; LAUNDER_V(tid);
          const bf16* GLU = (const bf16*)(ws + WS_GLU);
          LAS unsigned char* T = lds;
          LAS float* Yt = (LAS float*)(lds + 49152);
#pragma unroll 1
          for (int i = tid; i < (isx ? 94 : 62) * 32; i += 512) { const int s = i >> 5, ch = i & 31; const int r = srcrow(isx, b, t0 + s - 30);
              unsigned z_ = 0u; LAUNDER_V(z_);
              *(LAS u32x4*)(T + s * 512 + ch * 16) = r >= 0 ? *(const u32x4*)(GLU + (size_t)r * 256 + ch * 8) : (u32x4){z_, z_, z_, z_}; }
          __syncthreads();
          { const float* cw = INP(I_CW) + (size_t)l * 31 * 256; const float* cb = INP(I_CB) + l * 256;
            const int cp = tid & 127, strip = tid >> 7; f32x2 wv[31];
#pragma unroll
            for (int j = 0; j < 31; ++j) wv[j] = *(const f32x2*)(cw + j * 256 + 2 * cp);
            const f32x2 bias = *(const f32x2*)(cb + 2 * cp);
#pragma unroll 1
            for (int hh = 0; hh < (isx ? 2 : 1); ++hh) { const int rb = 32 * hh + 8 * strip; f32x2 acc[8];
#pragma unroll
                for (int r = 0; r < 8; ++r) acc[r] = bias;
#pragma unroll
                for (int i = 0; i < 38; ++i) { const unsigned xw = *(const LAS unsigned*)(T + (rb + i) * 512 + cp * 4); const f32x2 xx = {bflo(xw), bfhi(xw)};
#pragma unroll
                    for (int r = 0; r < 8; ++r) { const int j = i - r; if (j >= 0 && j <= 30) acc[r] += wv[j] * xx; } }
#pragma unroll
                for (int r = 0; r < 8; ++r) *(LAS f32x2*)(Yt + (rb + r) * 256 + 2 * cp) = acc[r]; } }
          __syncthreads();
          { unsigned char* ws2 = WSP(); int tid2 = F.tid; LAUNDER_V(tid2); const int lane = tid2 & 63;
            bf16* BP = (bf16*)(ws2 + WS_X3) + 256; const float* lng = INP(I_LNG) + l * 256; const float* lnb = INP(I_LNB) + l * 256;
#pragma unroll 1
            for (int rr = wave; rr < nrows; rr += 8) { const f32x4 v = *(const LAS f32x4*)(Yt + rr * 256 + 4 * lane);
              const float mean = wave_sum(v[0] + v[1] + v[2] + v[3]) * (1.0f / 256.0f); const f32x4 dv = v - mean;
              const float var = wave_sum(dv[0] * dv[0] + dv[1] * dv[1] + dv[2] * dv[2] + dv[3] * dv[3]) * (1.0f / 256.0f); const float rs = rsqrtf(var + EPS);
              const f32x4 gg = *(const f32x4*)(lng + 4 * lane), bb = *(const f32x4*)(lnb + 4 * lane); f32x4 o = dv * rs * gg + bb;
#pragma unroll
              for (int j = 0; j < 4; ++j) o[j] = o[j] * sigmoidf_(o[j]);
              u32x2 w; w.x = pk2(o[0], o[1]); w.y = pk2(o[2], o[3]); if (row0 + rr < TR) *(u32x2*)(BP + (size_t)(row0 + rr) * 1024 + 4 * lane) = w; } }
          __syncthreads(); }
    }
}

constexpr int AT_FL = 0, AT_K = 34816, AT_VT = AT_K + 8192, AT_SC = AT_VT + 8192;
__device__ __forceinline__ void attn_scan(Frame& F, int b, int h, bool meta_only, int fl_off, int sc_off) {
    LAS float* Fl = (LAS float*)(F.lds + fl_off); LAS float* sc = (LAS float*)(F.lds + sc_off);
    const float* LFT = (const float*)(WSP() + WS_LFT); const float* LFTM = (const float*)(WSP() + WS_LFTM);
    const int tid = F.tid, lane = F.lane, wave = F.wave;
    __syncthreads();
    if (tid == 0) { float s = 0.f; for (int m = 0; m < 64; ++m) { if (m < NMETA) { s += LFTM[h * 256 + m]; Fl[m] = s * LOG2E; } else Fl[m] = 1e30f; if (m == NMETA - 1) sc[16] = s; } }
    if (meta_only) { for (int i = tid; i < 256; i += 512) Fl[64 + i] = 0.f; __syncthreads(); return; }
    float v[16]; const float* src = LFT + (size_t)(b * 8 + h) * SEQ + 16 * tid;
#pragma unroll
    for (int j = 0; j < 4; ++j) { const f32x4 q = *(const f32x4*)(src + 4 * j); v[4 * j] = q[0]; v[4 * j + 1] = q[1]; v[4 * j + 2] = q[2]; v[4 * j + 3] = q[3]; }
#pragma unroll
    for (int j = 1; j < 16; ++j) v[j] += v[j - 1];
    float incl = v[15];
#pragma unroll
    for (int o = 1; o < 64; o <<= 1) { const float up = __int_as_float(__builtin_amdgcn_ds_bpermute((lane - o) << 2, __float_as_int(incl))); if (lane >= o) incl += up; }
    if (lane == 63) sc[wave] = incl;
    __syncthreads();
    float off = sc[16];
    for (int w = 0; w < wave; ++w) off += sc[w];
    off += incl - v[15];
#pragma unroll
    for (int j = 0; j < 16; ++j) Fl[64 + 16 * tid + j] = (off + v[j]) * LOG2E;
    __syncthreads();
}
__device__ __forceinline__ void attn_unit_naive(Frame& F, int qrow0, int qpos0, int ntiles, int kvx0, int h, int nq) {
    const int tid = F.tid; const int hf = tid & 1; const bool live = (tid >> 1) < nq; const int r = live ? (tid >> 1) : 0;
    const bf16* Q = (const bf16*)(DOP() + DO_Q); const bf16* Kg = (const bf16*)(DOP() + DO_K); const bf16* Vg = (const bf16*)(DOP() + DO_V); bf16* O = (bf16*)(WSP() + WS_X3) + 512;
    LAS float* Fl = (LAS float*)(F.lds + AT_FL); LAS unsigned char* Ks = F.lds + AT_K; LAS bf16* VT = (LAS bf16*)(F.lds + AT_VT);
    const int grow = qrow0 + r, qpos = qpos0 + r;
    unsigned qp[16];
#pragma unroll
    for (int j = 0; j < 4; ++j) { const u32x4 w = *(const u32x4*)(Q + (size_t)grow * 512 + h * 64 + hf * 32 + 8 * j); qp[4 * j] = w.x; qp[4 * j + 1] = w.y; qp[4 * j + 2] = w.z; qp[4 * j + 3] = w.w; }
    const float Fq = Fl[qpos < NMETA ? qpos : qpos + 48];
    float mrun = -1e30f, lrun = 0.f, o[32];
#pragma unroll
    for (int d = 0; d < 32; ++d) o[d] = 0.f;
    const int lrow = tid >> 3, lch = tid & 7;

#pragma unroll 1
for (int i = 0; i < ntiles; ++i) {
        const int krow = (i == 0 ? TX : kvx0 + 64 * (i - 1)) + lrow;
        const u32x4 kw = *(const u32x4*)(Kg + (size_t)krow * 512 + h * 64 + lch * 8);
        const u32x4 vw = *(const u32x4*)(Vg + (size_t)krow * 512 + h * 64 + lch * 8);
        __syncthreads();
        *(LAS u32x4*)(Ks + lrow * 128 + lch * 16) = kw;
        { const unsigned vv[4] = {vw.x, vw.y, vw.z, vw.w};
#pragma unroll
          for (int e = 0; e < 4; ++e) { VT[(lch * 8 + 2 * e) * 64 + lrow] = (bf16)(vv[e] & 0xffffu); VT[(lch * 8 + 2 * e + 1) * 64 + lrow] = (bf16)(vv[e] >> 16); } }
        __syncthreads();
        const int kp0 = i == 0 ? 0 : NMETA + 64 * (i - 1);
        if (kp0 > qpos0 + 255) continue;
#pragma unroll 1
        for (int jg = 0; jg < 4; ++jg) {
            float s[16]; float gmax = -1e30f;
#pragma unroll
            for (int jj = 0; jj < 16; ++jj) { const int j = jg * 16 + jj; float d = 0.f;
#pragma unroll
                for (int c = 0; c < 4; ++c) { const u32x4 kk = *(const LAS u32x4*)(Ks + j * 128 + hf * 64 + c * 16);
                    d = dot2bf(kk.x, qp[4 * c], d); d = dot2bf(kk.y, qp[4 * c + 1], d); d = dot2bf(kk.z, qp[4 * c + 2], d); d = dot2bf(kk.w, qp[4 * c + 3], d); }
                d += lane_xor<1>(d);
                const bool valid = (i == 0 ? j < NMETA : true) && (kp0 + j <= qpos);
                s[jj] = valid ? d + Fq - Fl[64 * i + j] : -1e30f; gmax = fmaxf(gmax, s[jj]); }
            const float mn = fmaxf(mrun, gmax), alpha = exp2f(mrun - mn); mrun = mn;
            float ps = 0.f; unsigned pp[8];
#pragma unroll
            for (int jj = 0; jj < 16; jj += 2) { const float p0 = exp2f(s[jj] - mn), p1 = exp2f(s[jj + 1] - mn); ps += p0 + p1; pp[jj >> 1] = pk2(p0, p1); }
            lrun = lrun * alpha + ps;
#pragma unroll
            for (int d = 0; d < 32; ++d) { const u32x4 v0 = *(const LAS u32x4*)(VT + (hf * 32 + d) * 64 + jg * 16), v1 = *(const LAS u32x4*)(VT + (hf * 32 + d) * 64 + jg * 16 + 8);
                float a = o[d] * alpha; a = dot2bf(pp[0], v0.x, a); a = dot2bf(pp[1], v0.y, a); a = dot2bf(pp[2], v0.z, a); a = dot2bf(pp[3], v0.w, a);
                a = dot2bf(pp[4], v1.x, a); a = dot2bf(pp[5], v1.y, a); a = dot2bf(pp[6], v1.z, a); a = dot2bf(pp[7], v1.w, a); o[d] = a; }
        }
    }
    const float il = 1.0f / lrun;
    if (live)
#pragma unroll
    for (int j = 0; j < 4; ++j) { u32x4 w; w.x = pk2(o[8 * j] * il, o[8 * j + 1] * il); w.y = pk2(o[8 * j + 2] * il, o[8 * j + 3] * il); w.z = pk2(o[8 * j + 4] * il, o[8 * j + 5] * il); w.w = pk2(o[8 * j + 6] * il, o[8 * j + 7] * il);
        *(u32x4*)(O + (size_t)grow * 1024 + h * 64 + hf * 32 + 8 * j) = w; }
}
namespace fa {
using bf16x8v = __attribute__((ext_vector_type(8))) short;
using s16x4 = __attribute__((ext_vector_type(4))) short;
using f32x16 = __attribute__((ext_vector_type(16))) float;
constexpr int DMA = 512, DMO = 1024;
constexpr int NW = 8, QBLK = 32, QB = 256, KVBLK = 64;
constexpr int NSLOT = 3, SLOTB = 8192;
constexpr int LDS_K = 0, LDS_V = NSLOT * SLOTB, LDS_WS = 2 * NSLOT * SLOTB, LDS_OST = LDS_WS + NW * 64 * 4, LDS_BYTES = LDS_OST + NW * 4096;
constexpr int LDS_FL = 84992;
constexpr int LDS_SCAN = LDS_FL + (64 + 8192) * 4;
static_assert(LDS_SCAN + 128 <= RING_BYTES, "attention LDS");
__device__ __forceinline__ int crow(int r, int hi) { return (r & 3) + 8 * (r >> 2) + 4 * hi; }
#define SBAR() __builtin_amdgcn_sched_barrier(0)
__device__ __forceinline__ void cmask(f32x16& p0, f32x16& p1, int jb, int qrel, int hi) {
    const float NEG = -INFINITY; int kb = 64 * jb + 4 * hi;
#pragma unroll
    for (int r = 0; r < 16; ++r) { int kv = kb + (r & 3) + 8 * (r >> 2); if (kv > qrel) p0[r] = NEG; if (kv + 32 > qrel) p1[r] = NEG; }
}
__device__ __forceinline__ void glds16(const void* gsrc, unsigned lds_dst) { unsigned keep;
    asm volatile("s_mov_b32 %0, m0\n\ts_mov_b32 m0, %2\n\ts_nop 0\n\tglobal_load_lds_dwordx4 %1, off\n\ts_mov_b32 m0, %0" : "=&s"(keep) : "v"(gsrc), "s"(lds_dst) : "memory"); }
__device__ __forceinline__ float max3f(float a, float b, float c) { float r; asm("v_max3_f32 %0, %1, %2, %3" : "=v"(r) : "v"(a), "v"(b), "v"(c)); return r; }
__device__ __forceinline__ float max2f(float a, float b) { float r; asm("v_max_f32_e32 %0, %1, %2" : "=v"(r) : "v"(a), "v"(b)); return r; }
__device__ __forceinline__ float fsub_s(float a, float b) { float r; asm("v_sub_f32_e32 %0, %1, %2" : "=v"(r) : "v"(a), "v"(b)); return r; }
typedef float f32x2_t __attribute__((ext_vector_type(2))); typedef __bf16 bf16x2_t __attribute__((ext_vector_type(2)));
__device__ __forceinline__ unsigned cvtpk_s(float lo, float hi) { f32x2_t v = {lo, hi}; bf16x2_t b = __builtin_convertvector(v, bf16x2_t); return __builtin_bit_cast(unsigned, b); }
#define WAIT_BAR(N) asm volatile("s_waitcnt vmcnt(" #N ") lgkmcnt(0)\n\ts_barrier" ::: "memory")
typedef __attribute__((address_space(3))) const char* lds_cptr;
typedef short v4i16_t __attribute__((ext_vector_type(4)));
__device__ __forceinline__ void cinit(f32x16& p0, f32x16& p1, const LAS float* fk, float a) {
#pragma unroll
    for (int g = 0; g < 4; ++g) { const f32x4 f0 = *(const LAS f32x4*)(fk + 8 * g), f1 = *(const LAS f32x4*)(fk + 32 + 8 * g);
#pragma unroll
        for (int i = 0; i < 4; ++i) { p0[4 * g + i] = a - f0[i]; p1[4 * g + i] = a - f1[i]; } }
}
__device__ __forceinline__ void qkt(f32x16& p0, f32x16& p1, const char* Kslot, const bf16x8v* qr, int r32, int hi) {
    const char* kb = Kslot + hi * 1024 + r32 * 16;
#pragma unroll
    for (int d0 = 0; d0 < 4; ++d0) {
        const bf16x8v b0 = *reinterpret_cast<const bf16x8v*>(kb + d0 * 2048);
        const bf16x8v b1 = *reinterpret_cast<const bf16x8v*>(kb + d0 * 2048 + 512);
        p0 = __builtin_amdgcn_mfma_f32_32x32x16_bf16(b0, qr[d0], p0, 0, 0, 0); p1 = __builtin_amdgcn_mfma_f32_32x32x16_bf16(b1, qr[d0], p1, 0, 0, 0); }
}
__device__ __forceinline__ void kload8(bf16x8v* kf, lds_cptr kp) {
    kf[0] = *(const LAS bf16x8v*)(kp);        kf[1] = *(const LAS bf16x8v*)(kp + 512);
    kf[2] = *(const LAS bf16x8v*)(kp + 2048); kf[3] = *(const LAS bf16x8v*)(kp + 2560);
    kf[4] = *(const LAS bf16x8v*)(kp + 4096); kf[5] = *(const LAS bf16x8v*)(kp + 4608);
    kf[6] = *(const LAS bf16x8v*)(kp + 6144); kf[7] = *(const LAS bf16x8v*)(kp + 6656);
}
__device__ __forceinline__ void kload2(bf16x8v* kf, lds_cptr kp, int j) { kf[2 * j] = *(const LAS bf16x8v*)(kp + j * 2048); kf[2 * j + 1] = *(const LAS bf16x8v*)(kp + j * 2048 + 512); }
__device__ __forceinline__ s16x4 vtr(lds_cptr p) { return __builtin_bit_cast(s16x4, __builtin_amdgcn_ds_read_tr16_b64_v4i16((LAS v4i16_t*)p)); }
__device__ __forceinline__ float rowmax(const f32x16& p0, const f32x16& p1) {
    float a = max3f(p0[0], p0[1], p1[0]), b = max3f(p0[2], p0[3], p1[1]); a = max3f(a, p1[2], p1[3]);
#pragma unroll
    for (int r = 4; r < 16; r += 4) { a = max3f(a, p0[r], p0[r + 1]); b = max3f(b, p0[r + 2], p0[r + 3]); a = max3f(a, p1[r], p1[r + 1]); b = max3f(b, p1[r + 2], p1[r + 3]); }
    const float m = max2f(a, b);
    auto rr = __builtin_amdgcn_permlane32_swap(__float_as_uint(m), __float_as_uint(m), false, false);
    return max2f(__uint_as_float(rr[0]), __uint_as_float(rr[1]));
}
__device__ __forceinline__ void pv(f32x16* o, int vb, bf16x8v pa0, bf16x8v pa1, bf16x8v pa2, bf16x8v pa3) {
#pragma unroll
    for (int d0 = 0; d0 < 2; ++d0) { s16x4 lo[4], hi[4];
#pragma unroll
        for (int ks = 0; ks < 4; ++ks) {
            asm volatile("ds_read_b64_tr_b16 %0,%1 offset:%c2" : "=&v"(lo[ks]) : "v"(vb), "i"(d0 * 4096 + ks * 1024) : "memory");
            asm volatile("ds_read_b64_tr_b16 %0,%1 offset:%c2" : "=&v"(hi[ks]) : "v"(vb), "i"(d0 * 4096 + ks * 1024 + 512) : "memory"); }
        asm volatile("s_waitcnt lgkmcnt(0)" ::: "memory"); SBAR();
#define PK(k) (bf16x8v){lo[k][0], lo[k][1], lo[k][2], lo[k][3], hi[k][0], hi[k][1], hi[k][2], hi[k][3]}
        o[d0] = __builtin_amdgcn_mfma_f32_32x32x16_bf16(pa0, PK(0), o[d0], 0, 0, 0);
        o[d0] = __builtin_amdgcn_mfma_f32_32x32x16_bf16(pa1, PK(1), o[d0], 0, 0, 0);
        o[d0] = __builtin_amdgcn_mfma_f32_32x32x16_bf16(pa2, PK(2), o[d0], 0, 0, 0);
        o[d0] = __builtin_amdgcn_mfma_f32_32x32x16_bf16(pa3, PK(3), o[d0], 0, 0, 0);
#undef PK
    }
}
template <int THRL> __device__ __forceinline__ void attn_unit(int b, int h, int qb, const bf16* Q, const bf16* __restrict__ K, const bf16* __restrict__ V, bf16* O, char* shm, int wid) {
    const int lane = lane_id_opaque(), r32 = lane & 31, hi = lane >> 5;
    const long rowbase = (long)b * SEQ; const int q0 = qb * QB;
    const bf16* Qw = Q + (rowbase + q0 + wid * QBLK) * DMA + h * 64;
    const bf16* Kh = K + rowbase * DMA + h * 64, *Vh = V + rowbase * DMA + h * 64;
    const bf16* Km = K + (long)TX * DMA + h * 64, *Vm = V + (long)TX * DMA + h * 64;
    const unsigned lds0 = (unsigned)(uintptr_t)shm;
    float* wsf = (float*)(shm + LDS_WS) + wid * 64;
    const bf16* ksrc = Kh + (long)lane * DMA + wid * 8;
    const bf16* vsrc = Vh + (long)(16 * (wid & 3) + (lane >> 2)) * DMA + (wid >> 2) * 32 + (lane & 3) * 8;
    const bf16* ksrcm = Km + (long)lane * DMA + wid * 8;
    const bf16* vsrcm = Vm + (long)(16 * (wid & 3) + (lane >> 2)) * DMA + (wid >> 2) * 32 + (lane & 3) * 8;
    const unsigned kdst = lds0 + LDS_K + wid * 1024, vdst = lds0 + LDS_V + wid * 1024;
#define DMA_K(t, slot) glds16(ksrc + (long)((t) - 1) * KVBLK * DMA, (unsigned)__builtin_amdgcn_readfirstlane(kdst + (slot)))
#define DMA_V(t, slot) glds16(vsrc + (long)((t) - 1) * KVBLK * DMA, (unsigned)__builtin_amdgcn_readfirstlane(vdst + (slot)))
    const int vb0 = (int)(lds0 + LDS_V) + ((lane >> 4) & 1) * 32 + (lane & 3) * 8 + (4 * hi + ((lane & 15) >> 2)) * 64;
    const char* Kbase = shm + LDS_K; bf16x8v kf[8];
    const lds_cptr shm3 = (lds_cptr)shm; const lds_cptr kp0 = shm3 + LDS_K + hi * 1024 + r32 * 16; const lds_cptr vp0 = shm3 + LDS_V + ((lane >> 4) & 1) * 32 + (lane & 3) * 8 + (4 * hi + ((lane & 15) >> 2)) * 64;
    const LAS float* Flp = (const LAS float*)(shm3 + LDS_FL) + 4 * hi;
    const int NT = 4 * qb + 5;
    glds16(ksrcm, (unsigned)__builtin_amdgcn_readfirstlane(kdst)); glds16(vsrcm, (unsigned)__builtin_amdgcn_readfirstlane(vdst)); DMA_K(1, SLOTB);
    bf16x8v qr[4];
#pragma unroll
    for (int d0 = 0; d0 < 4; ++d0) qr[d0] = *reinterpret_cast<const bf16x8v*>(&Qw[(long)r32 * DMA + d0 * 16 + hi * 8]);
    float aq = ((const LAS float*)(shm3 + LDS_FL))[64 + q0 + wid * QBLK + r32];
    float l_reg = 0.f; f32x16 o[2]; o[0] = f32x16{}; o[1] = f32x16{};
    const int qrel = wid * QBLK + r32;
#define CMASK(P0, P1, t) do { int jb_ = (t) - (NT - 4); if (jb_ >= 0) cmask(P0, P1, jb_, qrel, hi); } while (0)
    bool resc = false;
#define START(P0, P1) do { const float rm = rowmax(P0, P1); resc = false; \
    { const float dl = max2f(rm, 0.f); aq = fsub_s(aq, dl);        \
      _Pragma("unroll") for (int r = 0; r < 16; ++r) { P0[r] = fsub_s(P0[r], dl); P1[r] = fsub_s(P1[r], dl); } } \
    _Pragma("unroll") for (int r = 0; r < 16; ++r) P0[r] = __builtin_amdgcn_exp2f(P0[r]); } while (0)
#define RESC() do { if (resc) { asm volatile("s_waitcnt lgkmcnt(0)" ::: "memory"); \
      _Pragma("unroll") for (int d_ = 0; d_ < 2; ++d_) _Pragma("unroll") for (int r = 0; r < 16; ++r) o[d_][r] *= wsf[crow(r, hi)]; } } while (0)
    f32x16 pA0, pA1, pB0, pB1;
    int sl_prev = 0, sl_cur = 0, sl_next = SLOTB;
#define ROT() do { sl_prev = sl_cur; sl_cur = sl_next; sl_next = (sl_next == (NSLOT - 1) * SLOTB) ? 0 : sl_next + SLOTB; } while (0)
    DMA_K(2, 2 * SLOTB);
    cinit(pA0, pA1, Flp, aq);
    WAIT_BAR(3);
    qkt(pA0, pA1, Kbase, qr, r32, hi); asm volatile("s_nop 15\n\ts_nop 7" : "+v"(pA0), "+v"(pA1));
    START(pA0, pA1);
    _Pragma("unroll") for (int r = 0; r < 16; ++r) pA1[r] = __builtin_amdgcn_exp2f(pA1[r]);
    WAIT_BAR(0);
    DMA_K(3, 0); DMA_V(1, SLOTB);
    ROT();
    kload8(kf, kp0 + sl_cur);
    WAIT_BAR(2);
    s16x4 vlo[8], vhi[8]; u32x4 pw0, pw1, pw2, pw3;
#define PKW(P, B) cvtpk_s(P[B], P[B + 1])
#define PAF(k) __builtin_bit_cast(bf16x8v, pw##k)
#define VFR(i) (bf16x8v){vlo[i][0], vlo[i][1], vlo[i][2], vlo[i][3], vhi[i][0], vhi[i][1], vhi[i][2], vhi[i][3]}
#define PIN(x) asm volatile("" : "+v"(x))
#define MX3(a, b, c) __builtin_fmaxf(__builtin_fmaxf((a), (b)), (c))
#define GAPA(MF, A0, A1, A2, A3, W0, W1, PW) do { MF; sacc += A0; sacc += A1; sacc += A2; sacc += A3; PIN(sacc); W0; W1; PIN(PW); SBAR(); } while (0)
#define EX(v) __builtin_amdgcn_exp2f(v)
#define GAPB(MF, X, B) do { MF; X[B] = EX(X[B]); X[B + 1] = EX(X[B + 1]); X[B + 2] = EX(X[B + 2]); X[B + 3] = EX(X[B + 3]); PIN(X); SBAR(); } while (0)
#define VRD(i) do { vlo[i] = vtr(vp_ + (((i) >> 2) * 4096 + ((i) & 3) * 1024)); vhi[i] = vtr(vp_ + (((i) >> 2) * 4096 + ((i) & 3) * 1024 + 512)); } while (0)
#define KRD(G, j) do { if (G) { kload2(kf, kp0 + sl_next, j); SBAR(); } } while (0)
#define STEP(C0, C1, P0, P1, t, GK, GV, GL) do { SBAR(); \
    cinit(C0, C1, Flp + 64 * (t), aq); SBAR(); \
    const lds_cptr vp_ = vp0 + sl_prev; \
    VRD(0); SBAR(); float sacc = (P0[0] + P0[1]); \
    GAPA(C0 = __builtin_amdgcn_mfma_f32_32x32x16_bf16(kf[0], qr[0], C0, 0, 0, 0), P0[2], P0[3], P0[4], P0[5],     pw0[0] = PKW(P0, 0), pw0[1] = PKW(P0, 2), pw0); \
    VRD(4); SBAR(); GAPA(C1 = __builtin_amdgcn_mfma_f32_32x32x16_bf16(kf[1], qr[0], C1, 0, 0, 0), P0[6], P0[7], P0[8], P0[9],     pw0[2] = PKW(P0, 4), pw0[3] = PKW(P0, 6), pw0); \
    VRD(1); SBAR(); GAPA(C0 = __builtin_amdgcn_mfma_f32_32x32x16_bf16(kf[2], qr[1], C0, 0, 0, 0),   P0[10], P0[11], P0[12], P0[13], pw1[0] = PKW(P0, 8), pw1[1] = PKW(P0, 10), pw1); \
    VRD(5); SBAR(); GAPA(C1 = __builtin_amdgcn_mfma_f32_32x32x16_bf16(kf[3], qr[1], C1, 0, 0, 0),   P0[14], P0[15], P1[0], P1[1],   pw1[2] = PKW(P0, 12), pw1[3] = PKW(P0, 14), pw1); \
    VRD(2); SBAR(); GAPA(C0 = __builtin_amdgcn_mfma_f32_32x32x16_bf16(kf[4], qr[2], C0, 0, 0, 0),   P1[2], P1[3], P1[4], P1[5],     pw2[0] = PKW(P1, 0), pw2[1] = PKW(P1, 2), pw2); \
    VRD(6); SBAR(); GAPA(C1 = __builtin_amdgcn_mfma_f32_32x32x16_bf16(kf[5], qr[2], C1, 0, 0, 0),   P1[6], P1[7], P1[8], P1[9],     pw2[2] = PKW(P1, 4), pw2[3] = PKW(P1, 6), pw2); \
    VRD(3); SBAR(); GAPA(C0 = __builtin_amdgcn_mfma_f32_32x32x16_bf16(kf[6], qr[3], C0, 0, 0, 0),   P1[10], P1[11], P1[12], P1[13], pw3[0] = PKW(P1, 8), pw3[1] = PKW(P1, 10), pw3); \
    VRD(7); SBAR(); GAPA(C1 = __builtin_amdgcn_mfma_f32_32x32x16_bf16(kf[7], qr[3], C1, 0, 0, 0),   P1[14], P1[15], 0.f, 0.f,       pw3[2] = PKW(P1, 12), pw3[3] = PKW(P1, 14), pw3); \
    l_reg += sacc; \
    if (GK) { DMA_K((t) + 3, sl_cur); } if (GV) { DMA_V((t) + 1, sl_next); } \
    CMASK(C0, C1, t); \
    { float a = MX3(C0[0], C0[1], C1[0]), b_ = MX3(C0[2], C0[3], C1[1]); a = MX3(a, C1[2], C1[3]); \
      _Pragma("unroll") for (int r = 4; r < 16; r += 4) { a = MX3(a, C0[r], C0[r + 1]); b_ = MX3(b_, C0[r + 2], C0[r + 3]); a = MX3(a, C1[r], C1[r + 1]); b_ = MX3(b_, C1[r + 2], C1[r + 3]); } \
      float rm = __builtin_fmaxf(a, b_); { auto rr = __builtin_amdgcn_permlane32_swap(__float_as_uint(rm), __float_as_uint(rm), false, false); rm = __builtin_fmaxf(__uint_as_float(rr[0]), __uint_as_float(rr[1])); } \
      resc = false; \
      if (__builtin_expect(__any(rm > (float)THRL), 0)) { const float dl = __builtin_fmaxf(rm, 0.f); aq -= dl; \
        _Pragma("unroll") for (int r = 0; r < 16; ++r) { C0[r] -= dl; C1[r] -= dl; } \
        const float f = __builtin_amdgcn_exp2f(-dl); l_reg *= f; if (hi == 0) wsf[r32] = f; resc = true; } } \
    SBAR(); \
    GAPB(o[0] = __builtin_amdgcn_mfma_f32_32x32x16_bf16(PAF(0), VFR(0), o[0], 0, 0, 0), C0, 0); \
    GAPB(o[1] = __builtin_amdgcn_mfma_f32_32x32x16_bf16(PAF(0), VFR(4), o[1], 0, 0, 0), C0, 4); \
    KRD(GL, 0); GAPB(o[0] = __builtin_amdgcn_mfma_f32_32x32x16_bf16(PAF(1), VFR(1), o[0], 0, 0, 0), C0, 8); \
    KRD(GL, 1); GAPB(o[1] = __builtin_amdgcn_mfma_f32_32x32x16_bf16(PAF(1), VFR(5), o[1], 0, 0, 0), C0, 12); \
    KRD(GL, 2); GAPB(o[0] = __builtin_amdgcn_mfma_f32_32x32x16_bf16(PAF(2), VFR(2), o[0], 0, 0, 0), C1, 0); \
    KRD(GL, 3); GAPB(o[1] = __builtin_amdgcn_mfma_f32_32x32x16_bf16(PAF(2), VFR(6), o[1], 0, 0, 0), C1, 4); \
    GAPB(o[0] = __builtin_amdgcn_mfma_f32_32x32x16_bf16(PAF(3), VFR(3), o[0], 0, 0, 0), C1, 8); \
    GAPB(o[1] = __builtin_amdgcn_mfma_f32_32x32x16_bf16(PAF(3), VFR(7), o[1], 0, 0, 0), C1, 12); \
    } while (0)
    int t = 1;
#undef CMASK
#define CMASK(P0, P1, t) do { } while (0)
    for (; t + 5 < NT; t += 2) {
        STEP(pB0, pB1, pA0, pA1, t, true, true, true);     WAIT_BAR(2); RESC(); ROT();
        STEP(pA0, pA1, pB0, pB1, t + 1, true, true, true); WAIT_BAR(2); RESC(); ROT();
    }
#undef CMASK
#define CMASK(P0, P1, t) do { int jb_ = (t) - (NT - 4); if (jb_ >= 0) cmask(P0, P1, jb_, qrel, hi); } while (0)
#define ENDW(tt) do { if ((tt) + 3 < NT) { WAIT_BAR(2); } else if ((tt) + 2 < NT) { WAIT_BAR(1); } else { WAIT_BAR(0); } } while (0)
    for (; t + 1 < NT; t += 2) {
        STEP(pB0, pB1, pA0, pA1, t, (t + 3 < NT), (t + 1 < NT), (t + 1 < NT));         ENDW(t);     RESC(); ROT();
        STEP(pA0, pA1, pB0, pB1, t + 1, (t + 4 < NT), (t + 2 < NT), (t + 2 < NT));     ENDW(t + 1); RESC(); ROT();
    }
    { float sacc = pA0[0] + pA0[1]; _Pragma("unroll") for (int r = 2; r < 16; ++r) sacc += pA0[r]; _Pragma("unroll") for (int r = 0; r < 16; ++r) sacc += pA1[r]; l_reg += sacc;
      pw0 = (u32x4){PKW(pA0, 0), PKW(pA0, 2), PKW(pA0, 4), PKW(pA0, 6)}; pw1 = (u32x4){PKW(pA0, 8), PKW(pA0, 10), PKW(pA0, 12), PKW(pA0, 14)}; pw2 = (u32x4){PKW(pA1, 0), PKW(pA1, 2), PKW(pA1, 4), PKW(pA1, 6)}; pw3 = (u32x4){PKW(pA1, 8), PKW(pA1, 10), PKW(pA1, 12), PKW(pA1, 14)};
      SBAR(); pv(o, vb0 + sl_prev, PAF(0), PAF(1), PAF(2), PAF(3)); }
#undef PKW
#undef PAF
#undef VFR
#undef PIN
#undef MX3
#undef GAPA
#undef GAPB
#undef EX
#undef VRD
#undef KRD
#undef STEP
#undef ENDW
    { auto rr = __builtin_amdgcn_permlane32_swap(__float_as_uint(l_reg), __float_as_uint(l_reg), false, false); l_reg = __uint_as_float(rr[0]) + __uint_as_float(rr[1]); }
    if (hi == 0) wsf[32 + r32] = l_reg; asm volatile("s_waitcnt lgkmcnt(0)" ::: "memory");
    float rli[16];
#pragma unroll
    for (int r = 0; r < 16; ++r) rli[r] = __builtin_amdgcn_rcpf(wsf[32 + crow(r, hi)]);
    bf16* Ow = O + (rowbase + q0 + wid * QBLK) * DMO + h * 64;
    { bf16* stg = (bf16*)(shm + LDS_OST) + wid * 2048;
#pragma unroll
      for (int r = 0; r < 16; ++r) { const int orow = crow(r, hi);
#pragma unroll
          for (int d0 = 0; d0 < 2; ++d0) stg[orow * 64 + d0 * 32 + r32] = (bf16)f2bf(o[d0][r] * rli[r]); }
      asm volatile("s_waitcnt lgkmcnt(0)" ::: "memory");
#pragma unroll
      for (int i = 0; i < 4; ++i) { const int row = i * 8 + (lane >> 3), ch = lane & 7; const u32x4 v = *(const u32x4*)(stg + row * 64 + ch * 8); *(u32x4*)(Ow + (long)row * DMO + ch * 8) = v; } }
    asm volatile("s_waitcnt lgkmcnt(0)\n\ts_barrier" ::: "memory");
#undef DMA_K
#undef DMA_V
#undef CMASK
#undef START
#undef RESC
#undef ROT
}
#undef SBAR
#undef WAIT_BAR
}
__device__ __forceinline__ void phase_B(Frame& F) {
    if (F.G == 256) {
        const int v = F.vcu, bh = v >> 3, s = v & 7, b = bh >> 3, h = bh & 7;
        attn_scan(F, b, h, false, fa::LDS_FL, fa::LDS_SCAN);
        { unsigned char* dol = DOP(); const bf16* Q = (const bf16*)(dol + DO_Q); const bf16* Kg = (const bf16*)(dol + DO_K); const bf16* Vg = (const bf16*)(dol + DO_V);
#pragma unroll 1
          for (int i = 0; i < 4; ++i) { const int qb = i == 0 ? s : (i == 1 ? 15 - s : (i == 2 ? 16 + s : 31 - s));
              fa::attn_unit<8>(b, h, qb, Q, Kg, Vg, (bf16*)(WSP() + WS_X3) + 512, (char*)F.lds, F.wave); } }
        if (v < 8) { attn_scan(F, 0, v, true, AT_FL, AT_SC); attn_unit_naive(F, TX, 0, 1, 0, v, NMETA); }
    } else {
        int cur_bh = -1;
        for (int u = F.vcu; u < 1032; u += F.G) {
            if (u < 1024) { const int bh = u >> 5, qb = u & 31, b = bh >> 3, h = bh & 7; if (bh != cur_bh) { attn_scan(F, b, h, false, AT_FL, AT_SC); cur_bh = bh; }
                attn_unit_naive(F, b * SEQ + 256 * qb, NMETA + 256 * qb, 1 + 4 * (qb + 1), b * SEQ, h, 256); }
            else { attn_scan(F, 0, u - 1024, true, AT_FL, AT_SC); cur_bh = -1; attn_unit_naive(F, TX, 0, 1, 0, u - 1024, NMETA); }
        }
    }
    __syncthreads();
}

__device__ __forceinline__ void class_tables(Frame& F, int l) {
    LAS int* base = (LAS int*)(F.lds + LC_BASE); LAS int* pcls = (LAS int*)(F.lds + LC_PCLS); LAS int* np = (LAS int*)(F.lds + LC_NP);
    const unsigned* gcnt = (const unsigned*)(WSP() + WS_CTL) + CW_GCNT + l * 64;
    __syncthreads();
    if (F.tid == 0) { int p = 0;
#pragma unroll 1
        for (int c = 0; c < NCLS; ++c) { base[c] = p * 256; int n = (int)__hip_atomic_load(gcnt + c, __ATOMIC_RELAXED, __HIP_MEMORY_SCOPE_AGENT); if (n > TR) n = TR; if (n < 0) n = 0; p += (n + 255) >> 8; }
        if (p > 160) p = 160; base[NCLS] = p * 256; np[0] = p; }
    __syncthreads();
    if (F.tid < 160) { const int mypos = F.tid * 256; int c = 0;
#pragma unroll 1
        for (int k = 1; k < NCLS; ++k) if (base[k] <= mypos) c = k;
        pcls[F.tid] = c; }
    __syncthreads();
}
constexpr int RPITCH = 1032;
__device__ __forceinline__ void phase_E1(Frame& F, int l) {
    LAS bf16* Rhi = (LAS bf16*)F.lds; LAS bf16* Rlo = Rhi + 20 * RPITCH;
    LAS int* rec = (LAS int*)(F.lds + 83968);
    LAS int* lcnt = (LAS int*)(F.lds + LC_CNT); LAS int* wgb = (LAS int*)(F.lds + LC_BASE);
    const float* rg = (const float*)(WSP() + WS_RG);
    const float* reb = INP(I_REB) + l * 16; const float* rgb = INP(I_RGB) + l * 4;
    unsigned* gcnt = (unsigned*)(WSP() + WS_CTL) + CW_GCNT + l * 64; int* route = (int*)(WSP() + WS_ROUTE);
    const int tid = F.tid, lane = F.lane, wave = F.wave, fr = lane & 15, fq = lane >> 4;
#pragma unroll 1
    for (int i = tid; i < 20 * 1024; i += 512) { const float v = rg[i]; const unsigned hw = pk2(v, 0.f) & 0xffffu; const float hf = __builtin_bit_cast(float, hw << 16);
        const int c = i >> 10, k = i & 1023; Rhi[c * RPITCH + k] = (bf16)hw; Rlo[c * RPITCH + k] = (bf16)(pk2(v - hf, 0.f) & 0xffffu); }
#pragma unroll 1
    for (int wg = F.vcu; wg < 256; wg += F.G) {
        if (tid < NCLS) lcnt[tid] = 0;
        __syncthreads();
        const int ngrp = wg == 0 ? 9 : 8;
#pragma unroll 1
        for (int grp = wave; grp < ngrp; grp += 8) {
            const int row = grp < 8 ? wg * 128 + grp * 16 + fr : TX + fr;
            const float* hsrc = l == 0 ? (row < TX ? INP(I_X) + (size_t)row * D : INP(I_META) + (size_t)(row - TX) * D) : (const float*)(WSP() + WS_H) + (size_t)row * D;
            float* hdst = (float*)(WSP() + WS_H) + (size_t)row * D; bf16* hbdst = (bf16*)(WSP() + WS_HB) + (size_t)row * D; const bf16* dsrc = (const bf16*)(WSP() + WS_X3) + (size_t)row * D;
            const LAS bf16* bh0 = Rhi + fr * RPITCH + 8 * fq; const LAS bf16* bl0 = Rlo + fr * RPITCH + 8 * fq;
            const LAS bf16* bh1 = Rhi + (16 + (fr & 3)) * RPITCH + 8 * fq; const LAS bf16* bl1 = Rlo + (16 + (fr & 3)) * RPITCH + 8 * fq;
            f32x4 acc0 = {0.f, 0.f, 0.f, 0.f}, acc1 = {0.f, 0.f, 0.f, 0.f}; float ss = 0.f;
#pragma unroll 8
            for (int s = 0; s < 32; ++s) { const int k = 32 * s + 8 * fq;
                f32x4 h0 = *(const f32x4*)(hsrc + k), h1 = *(const f32x4*)(hsrc + k + 4); const u32x4 dv = *(const u32x4*)(dsrc + k);
                h0[0] += bflo(dv.x); h0[1] += bfhi(dv.x); h0[2] += bflo(dv.y); h0[3] += bfhi(dv.y); h1[0] += bflo(dv.z); h1[1] += bfhi(dv.z); h1[2] += bflo(dv.w); h1[3] += bfhi(dv.w);
                ss += (h0[0] * h0[0] + h0[1] * h0[1]) + (h0[2] * h0[2] + h0[3] * h0[3]) + (h1[0] * h1[0] + h1[1] * h1[1]) + (h1[2] * h1[2] + h1[3] * h1[3]);
                *(f32x4*)(hdst + k) = h0; *(f32x4*)(hdst + k + 4) = h1;
                const u32x4 hw = pack8(h0, h1); *(u32x4*)(hbdst + k) = hw;
                f32x4 r0, r1; r0[0] = h0[0] - bflo(hw.x); r0[1] = h0[1] - bfhi(hw.x); r0[2] = h0[2] - bflo(hw.y); r0[3] = h0[3] - bfhi(hw.y);
                r1[0] = h1[0] - bflo(hw.z); r1[1] = h1[1] - bfhi(hw.z); r1[2] = h1[2] - bflo(hw.w); r1[3] = h1[3] - bfhi(hw.w);
                const u32x4 lw = pack8(r0, r1);
                const bf16x8 ah = __builtin_bit_cast(bf16x8, hw), al = __builtin_bit_cast(bf16x8, lw);
                const bf16x8 wh0 = *(const LAS bf16x8*)(bh0 + 32 * s), wl0 = *(const LAS bf16x8*)(bl0 + 32 * s);
                bf16x8 wh1 = *(const LAS bf16x8*)(bh1 + 32 * s), wl1 = *(const LAS bf16x8*)(bl1 + 32 * s);
                if (fr >= 4) { wh1 = (bf16x8){0, 0, 0, 0, 0, 0, 0, 0}; wl1 = wh1; }
                acc0 = __builtin_amdgcn_mfma_f32_16x16x32_bf16(wh0, ah, acc0, 0, 0, 0); acc0 = __builtin_amdgcn_mfma_f32_16x16x32_bf16(wh0, al, acc0, 0, 0, 0); acc0 = __builtin_amdgcn_mfma_f32_16x16x32_bf16(wl0, ah, acc0, 0, 0, 0);
                acc1 = __builtin_amdgcn_mfma_f32_16x16x32_bf16(wh1, ah, acc1, 0, 0, 0); acc1 = __builtin_amdgcn_mfma_f32_16x16x32_bf16(wh1, al, acc1, 0, 0, 0); acc1 = __builtin_amdgcn_mfma_f32_16x16x32_bf16(wl1, ah, acc1, 0, 0, 0);
            }
            ss += lane_xor<16>(ss); ss += lane_xor<32>(ss);
            const float rstd2 = rsqrtf(ss * (1.0f / D) + EPS);
            float gl[4];
#pragma unroll
            for (int g = 0; g < 4; ++g) gl[g] = __int_as_float(__builtin_amdgcn_ds_bpermute(fr << 2, __float_as_int(acc1[g]))) * rstd2 + rgb[g];
            int gsel = 0; float gmax = gl[0];
#pragma unroll
            for (int g = 1; g < 4; ++g) if (gl[g] > gmax) { gmax = gl[g]; gsel = g; }
            float gsum = 0.f;
#pragma unroll
            for (int g = 0; g < 4; ++g) gsum += __expf(gl[g] - gmax);
            const float gwt = 1.0f / gsum;
            if (fq == gsel) {
                float el[4];
#pragma unroll
                for (int e = 0; e < 4; ++e) el[e] = acc0[e] * rstd2 + reb[gsel * 4 + e];
                int t1 = 0; float l1 = el[0];
#pragma unroll
                for (int e = 1; e < 4; ++e) if (el[e] > l1) { l1 = el[e]; t1 = e; }
                int t2 = -1; float l2 = -3.0e38f;
#pragma unroll
                for (int e = 0; e < 4; ++e) if (e != t1 && el[e] > l2) { l2 = el[e]; t2 = e; }
                const float w1 = 1.0f / (1.0f + __expf(l2 - l1)), w2 = 1.0f - w1;
                const int ea = min(t1, t2), eb = max(t1, t2); const float cA = gwt * (t1 == ea ? w1 : w2), cB = gwt * (t1 == ea ? w2 : w1);
                const int pr = ea == 0 ? eb - 1 : (ea == 1 ? eb + 1 : 5); int cls = gsel * 6 + pr; if (!(cls >= 0 && cls < NCLS)) cls = 0;
                const int rank = __hip_atomic_fetch_add(&lcnt[cls], 1, __ATOMIC_RELAXED, __HIP_MEMORY_SCOPE_WORKGROUP); const int rr = grp * 16 + fr;
                rec[rr * 5] = cls; rec[rr * 5 + 1] = rank; rec[rr * 5 + 2] = __float_as_int(cA); rec[rr * 5 + 3] = __float_as_int(cB); rec[rr * 5 + 4] = __float_as_int(rstd2);
            }
        }
        __syncthreads();
        if (tid < NCLS) { const int n = lcnt[tid]; wgb[tid] = n > 0 ? (int)atomicAdd(gcnt + tid, (unsigned)n) : 0; }
        __syncthreads();
        const int nrw = ngrp * 16;
        for (int rr = tid; rr < nrw; rr += 512) { const int row = rr < 128 ? wg * 128 + rr : TX + (rr - 128); const int cls = rec[rr * 5];
            int* rp = route + (size_t)row * 8; rp[0] = cls; rp[1] = wgb[cls] + rec[rr * 5 + 1]; rp[2] = rec[rr * 5 + 2]; rp[3] = rec[rr * 5 + 3]; rp[4] = rec[rr * 5 + 4]; }
        __syncthreads();
    }
}
__device__ __forceinline__ void phase_E1b(Frame& F, int l) {
    class_tables(F, l);
    const LAS int* base = (const LAS int*)(F.lds + LC_BASE);
    const int* route = (const int*)(WSP() + WS_ROUTE); const bf16* HB = (const bf16*)(WSP() + WS_HB); bf16* XS = (bf16*)(WSP() + WS_XS); float* PW = (float*)(WSP() + WS_PW);
    const int gw = F.vcu * NWAVES + F.wave, NGW = F.G * NWAVES, lane = F.lane;

#pragma unroll 1
for (int row = gw; row < TR; row += NGW) { const int* rp = route + (size_t)row * 8; const int cls = rp[0]; const int pos = base[cls] + rp[1];
        if (pos < 0 || pos >= NPOSMAX) continue;
#pragma unroll
        for (int j = 0; j < 2; ++j) *(u32x4*)(XS + (size_t)pos * D + 8 * lane + 512 * j) = *(const u32x4*)(HB + (size_t)row * D + 8 * lane + 512 * j);
        if (lane == 0) { f32x4 w; w[0] = __int_as_float(rp[4]); w[1] = __int_as_float(rp[2]); w[2] = __int_as_float(rp[3]); w[3] = 0.f; *(f32x4*)(PW + (size_t)pos * 4) = w; } }
}
__device__ __forceinline__ void phase_E4(Frame& F, int l) {
    class_tables(F, l);
    const LAS int* base = (const LAS int*)(F.lds + LC_BASE);
    const int* route = (const int*)(WSP() + WS_ROUTE); float* H = (float*)(WSP() + WS_H); bf16* HB = (bf16*)(WSP() + WS_HB); const bf16* Y = (const bf16*)(WSP() + WS_Y);
    float* rstd1 = (float*)(WSP() + WS_RSTD1); const float* fg = INP(I_FG); float* out = (float*)DOP();
    const int gw = F.vcu * NWAVES + F.wave, NGW = F.G * NWAVES, lane = F.lane; const bool lastl = (l == DEPTH - 1);

#pragma unroll 1
for (int row = gw; row < TR; row += NGW) { const int* rp = route + (size_t)row * 8; const int cls = rp[0]; int pos = base[cls] + rp[1]; if (pos < 0 || pos >= NPOSMAX) pos = 0;
        f32x4 hv[2][2]; float ss = 0.f;
#pragma unroll
        for (int j = 0; j < 2; ++j) { const u32x4 yw = *(const u32x4*)(Y + (size_t)pos * D + 8 * lane + 512 * j);
            hv[j][0] = *(const f32x4*)(H + (size_t)row * D + 8 * lane + 512 * j); hv[j][1] = *(const f32x4*)(H + (size_t)row * D + 8 * lane + 512 * j + 4);
            hv[j][0][0] += bflo(yw.x); hv[j][0][1] += bfhi(yw.x); hv[j][0][2] += bflo(yw.y); hv[j][0][3] += bfhi(yw.y);
            hv[j][1][0] += bflo(yw.z); hv[j][1][1] += bfhi(yw.z); hv[j][1][2] += bflo(yw.w); hv[j][1][3] += bfhi(yw.w);
#pragma unroll
            for (int q = 0; q < 2; ++q) ss += hv[j][q][0] * hv[j][q][0] + hv[j][q][1] * hv[j][q][1] + hv[j][q][2] * hv[j][q][2] + hv[j][q][3] * hv[j][q][3]; }
        const float rs = rsqrtf(wave_sum(ss) * (1.0f / D) + EPS);
        if (!lastl) {
#pragma unroll
            for (int j = 0; j < 2; ++j) { *(f32x4*)(H + (size_t)row * D + 8 * lane + 512 * j) = hv[j][0]; *(f32x4*)(H + (size_t)row * D + 8 * lane + 512 * j + 4) = hv[j][1];
                *(u32x4*)(HB + (size_t)row * D + 8 * lane + 512 * j) = pack8(hv[j][0], hv[j][1]); }
            if (lane == 0) rstd1[row] = rs;
        } else if (row < TX) {
#pragma unroll
            for (int j = 0; j < 2; ++j) { const f32x4 g0 = *(const f32x4*)(fg + 8 * lane + 512 * j), g1 = *(const f32x4*)(fg + 8 * lane + 512 * j + 4);
                *(f32x4*)(out + (size_t)row * D + 8 * lane + 512 * j) = hv[j][0] * rs * g0; *(f32x4*)(out + (size_t)row * D + 8 * lane + 512 * j + 4) = hv[j][1] * rs * g1; }
        }
    }
}

#define RELANE() do { const int t_ = wv0 * 64 + lane_id_opaque(); F.tid = t_; F.lane = t_ & 63; F.wave = __builtin_amdgcn_readfirstlane(t_ >> 6); \
    int g_ = gridDim.x; LAUNDER_S(g_); int b_ = blockIdx.x; LAUNDER_S(b_); F.G = g_; F.bx = b_; F.vcu = (g_ % 8 == 0) ? (b_ % 8) * (g_ / 8) + b_ / 8 : b_; ll = l; LAUNDER_S(ll); } while (0)
__global__ void __launch_bounds__(NWAVES * 64, 2) fwd_kernel(Params P) {
    extern __shared__ __attribute__((aligned(16))) unsigned char lds_raw[];
    Frame F;
    F.lds = (LAS unsigned char*)lds_raw;
    F.tid = threadIdx.x; F.lane = F.tid & 63; F.wave = __builtin_amdgcn_readfirstlane(F.tid >> 6);
    F.G = gridDim.x; { const int bx = blockIdx.x; F.vcu = (F.G % 8 == 0) ? (bx % 8) * (F.G / 8) + bx / 8 : bx; }
    if (F.tid == 0) { LAS unsigned long long* pt = (LAS unsigned long long*)(F.lds + LC_PTAB);
#pragma unroll
        for (int i = 0; i < 25; ++i) pt[i] = (unsigned long long)P.in[i];
        pt[25] = (unsigned long long)P.ws; pt[26] = (unsigned long long)P.out; }
    for (int u = F.tid; u < 256; u += NWAVES * 64) ((LAS unsigned*)(F.lds + RING_BYTES))[u] = 0u;
    __syncthreads();
    const int lo = P.ph_lo, hi = P.ph_hi;
    const bool use_bar = (hi - lo) > 1;
    unsigned* barw = (unsigned*)(P.ws + WS_CTL) + CW_BAR;
    XcdBarrier bar; bar.bar = barw; bar.x = 0; bar.st = (volatile LAS unsigned*)(F.lds + LC_BAR);
    if (use_bar) bar = xcd_barrier_post(barw, (volatile LAS unsigned*)(F.lds + LC_BAR));
#ifndef PHASE_MASK
#define PHASE_MASK 0x7ff
#endif
#define EN(j) (((PHASE_MASK) >> (j)) & 1)
#ifndef DUP_MASK
#define DUP_MASK 0
#endif
#define NREP(j) ((((DUP_MASK) >> (j)) & 1) ? 2 : 1)
#define IN(k) (lo <= (k) && (k) < hi)
#define SEAM(k) do { if (IN(k) && IN((k) + 1)) xcd_barrier(bar); } while (0)

    int l = 0, ll = 0; const int wv0 = __builtin_amdgcn_readfirstlane((int)threadIdx.x >> 6);
    if (EN(0) && IN(0)) { RELANE(); convert_weights(F, 0); RELANE(); init_rows(F); }
    SEAM(0);
    for (l = 0; l < DEPTH; ++l) {
        const int pb = 1 + 10 * l;
        for (int rep = 0; rep < NREP(1); ++rep)
        if (EN(1) && IN(pb + 0)) {
            RELANE();
            unsigned char* wsl = WSP(); unsigned char* dol = DOP();
            pg8::Gemm g{(const bf16*)(wsl + WS_HB), 1024, 1024, 1 << 20};
            pg8::StaticOrder S; S.init(TX, N1, F.G, F.bx, (const bf16*)(wsl + WS_W1T), 1024);
            Epi1 E{(const float*)(wsl + WS_RSTD1), (bf16*)(wsl + WS_A), (bf16*)(wsl + WS_GLU), (bf16*)(dol + DO_Q), (bf16*)(wsl + WS_G)};
            pg8::gemm_phase<Epi1, pg8::StaticOrder>(F.lds, g, S, E, F.wave);
            if (F.bx >= 128 && F.bx < 128 + 21 && F.wave < 4) {
                const int pn = F.bx - 128, l2 = lane_id_opaque(); AccT acc; skinny_zero(acc);
                skinny_k<true>(acc, (const bf16*)(wsl + WS_HB) + (size_t)TX * 1024, 1024, (const bf16*)(wsl + WS_W1T) + (size_t)pn * 256 * 1024, 1024, 1024, F.wave, l2 & 15, l2 >> 4);
                E.run<true>(acc, pg8::Unit{128, pn, 0}, 0, F.wave, l2 & 15, l2 >> 4);
            }
        }
        SEAM(pb + 0);
        for (int rep = 0; rep < NREP(2); ++rep)
        if (EN(2) && IN(pb + 1)) { RELANE(); phase_S(F, ll); }
        SEAM(pb + 1);
        for (int rep = 0; rep < NREP(3); ++rep)
        if (EN(3) && IN(pb + 2)) { RELANE(); phase_B(F); }
        SEAM(pb + 2);
        for (int rep = 0; rep < NREP(4); ++rep)
        if (EN(4) && IN(pb + 3)) {
            RELANE(); unsigned char* wsl = WSP(); unsigned char* dol = DOP();
            pg8::Gemm g{(const bf16*)(wsl + WS_X3), 1024, 1024, 1 << 20}; pg8::SegOrder S; S.init(TX, 1024, F.G, F.bx, (const bf16*)(wsl + WS_W3CT), 1024);
            EpiCS E{(const bf16*)(wsl + WS_G), (bf16*)(dol + DO_MERGED), (const float*)(wsl + WS_BIASA)}; pg8::gemm_phase<EpiCS, pg8::SegOrder>(F.lds, g, S, E, F.wave);
            if (F.bx >= 16 && F.bx < 20 && F.wave < 4) {
                const int pn = F.bx - 16, l2 = lane_id_opaque(); AccT acc; skinny_zero(acc);
#pragma unroll 1
                for (int seg = 0; seg < 3; ++seg) { const size_t ko = seg == 0 ? 0 : (seg == 1 ? 256 : 512);
                    skinny_k<true>(acc, (const bf16*)(wsl + WS_X3) + (size_t)TX * 1024 + ko, 1024, (const bf16*)(wsl + WS_W3CT) + (size_t)pn * 256 * 1024 + ko, 1024, seg == 2 ? 512 : 256, F.wave, l2 & 15, l2 >> 4);
                    E.run<true>(acc, pg8::Unit{128, pn, seg}, 0, F.wave, l2 & 15, l2 >> 4); }
            }
        }
        SEAM(pb + 3);
        if (EN(5) && IN(pb + 4)) {
            RELANE();
            unsigned char* wsl = WSP(); unsigned char* dol = DOP();
            pg8::Gemm g{(const bf16*)(dol + DO_MERGED), 1024, 1024, 1 << 20}; pg8::StaticOrder S; S.init(TX, 1024, F.G, F.bx, (const bf16*)(wsl + WS_WOT), 1024);
            EpiB2 E{(bf16*)(wsl + WS_X3)}; pg8::gemm_phase<EpiB2, pg8::StaticOrder>(F.lds, g, S, E, F.wave);
            if (F.bx >= 16 && F.bx < 20 && F.wave < 4) {
                const int pn = F.bx - 16, l2 = lane_id_opaque(); AccT acc; skinny_zero(acc);
                skinny_k<true>(acc, (const bf16*)(dol + DO_MERGED) + (size_t)TX * 1024, 1024, (const bf16*)(wsl + WS_WOT) + (size_t)pn * 256 * 1024, 1024, 1024, F.wave, l2 & 15, l2 >> 4);
                E.run<true>(acc, pg8::Unit{128, pn, 0}, 0, F.wave, l2 & 15, l2 >> 4);
            }
        }
        SEAM(pb + 4);
        if (EN(6) && IN(pb + 5)) { RELANE(); phase_E1(F, ll); }
        SEAM(pb + 5);
        for (int rep = 0; rep < NREP(7); ++rep)
        if (EN(7) && IN(pb + 6)) { RELANE(); phase_E1b(F, ll); }
        SEAM(pb + 6);
        for (int rep = 0; rep < NREP(8); ++rep)
        if (EN(8) && IN(pb + 7)) {
            RELANE(); class_tables(F, ll);
            unsigned char* wsl = WSP();
            const int NP = __builtin_amdgcn_readfirstlane(*(const LAS int*)(F.lds + LC_NP));
            pg8::Gemm g{(const bf16*)(wsl + WS_XS), 1024, 1024, 1 << 20};
            MoeOrder S{NP, F.G, F.vcu, 0, (const LAS int*)(F.lds + LC_PCLS), (const bf16*)(DOP() + DO_W13T)};
            EpiA2 E{(const float*)(wsl + WS_PW), (bf16*)(wsl + WS_HH)}; pg8::gemm_phase<EpiA2, MoeOrder>(F.lds, g, S, E, F.wave);
        }
        SEAM(pb + 7);
        for (int rep = 0; rep < NREP(9); ++rep)
        if (EN(9) && IN(pb + 8)) {
            RELANE(); class_tables(F, ll);
            unsigned char* wsl = WSP();
            const int NP = __builtin_amdgcn_readfirstlane(*(const LAS int*)(F.lds + LC_NP));
            pg8::Gemm g{(const bf16*)(wsl + WS_HH), 512, 256, 4};
            MoeOrder S{NP, F.G, F.vcu, 1, (const LAS int*)(F.lds + LC_PCLS), (const bf16*)(DOP() + DO_W2T)};
            EpiB2 E{(bf16*)(wsl + WS_Y)}; pg8::gemm_phase<EpiB2, MoeOrder>(F.lds, g, S, E, F.wave);
        }
        SEAM(pb + 8);
        if (EN(10) && IN(pb + 9)) { RELANE(); phase_E4(F, ll); if (l + 1 < DEPTH) { RELANE(); convert_weights(F, ll + 1); } }
        SEAM(pb + 9);
    }
#undef IN
#undef SEAM
}

constexpr int N_PHASES = 1 + 10 * DEPTH;

extern "C" void kernel_launch(void* const* d_in, const int* in_sizes, int n_in, void* d_out, int out_size, void* d_ws, size_t ws_size, hipStream_t stream) {
    static int grid = 0;
    if (grid == 0) {
        if (n_in != 25 || out_size != TX * D || ws_size < WS_END) { fprintf(stderr, "kernel_launch: unexpected shapes: n_in %d out %d ws %zu (need %zu)\n", n_in, out_size, ws_size, (size_t)WS_END); grid = -1; return; }
        int dev = 0, cus = 0, per_cu = 0;
        if (hipGetDevice(&dev) != hipSuccess || hipDeviceGetAttribute(&cus, hipDeviceAttributeMultiprocessorCount, dev) != hipSuccess) { grid = -1; return; }
        if (hipFuncSetAttribute((const void*)fwd_kernel, hipFuncAttributeMaxDynamicSharedMemorySize, LDS_BYTES) != hipSuccess) { fprintf(stderr, "kernel_launch: hipFuncSetAttribute failed\n"); grid = -1; return; }
        if (hipOccupancyMaxActiveBlocksPerMultiprocessor(&per_cu, (const void*)fwd_kernel, NWAVES * 64, LDS_BYTES) != hipSuccess || per_cu < 1) fprintf(stderr, "kernel_launch: occupancy query reports %d\n", per_cu);
        (void)hipGetLastError();
        grid = cus;
    }
    if (grid < 0) return;
    (void)hipMemsetAsync((char*)d_ws + WS_CTL, 0, CTL_BYTES, stream);
    Params p{};
    for (int i = 0; i < 25; ++i) p.in[i] = (const float*)d_in[i];
    p.out = (float*)d_out; p.ws = (unsigned char*)d_ws;
#if N_LAUNCH_MODE == 1
    p.ph_lo = 0; p.ph_hi = N_PHASES;
    hipLaunchKernelGGL(fwd_kernel, dim3(grid), dim3(NWAVES * 64), LDS_BYTES, stream, p);
#else
    for (int ph = 0; ph < N_PHASES; ++ph) { p.ph_lo = ph; p.ph_hi = ph + 1; hipLaunchKernelGGL(fwd_kernel, dim3(grid), dim3(NWAVES * 64), LDS_BYTES, stream, p); }
#endif
}
```

```cpp
#include <hip/hip_runtime.h>
#include <cstdio>
#include <cstdint>

#ifndef N_LAUNCH_MODE
#define N_LAUNCH_MODE 1
#endif

#define GAS __attribute__((address_space(1)))
#define LAS __attribute__((address_space(3)))
typedef unsigned short bf16;
typedef float f32x4 __attribute__((ext_vector_type(4)));
typedef float f32x2 __attribute__((ext_vector_type(2)));
typedef unsigned u32x4 __attribute__((ext_vector_type(4)));
typedef unsigned u32x2 __attribute__((ext_vector_type(2)));
typedef short bf16x8 __attribute__((ext_vector_type(8)));
typedef __bf16 bf16x2v __attribute__((ext_vector_type(2)));

constexpr int D = 1024, NB = 4, SEQ = 8192, NMETA = 16, DEPTH = 2;
constexpr int TX = NB * SEQ;
constexpr int TM = TX + 64;
constexpr int TR = TX + NMETA;
constexpr int NIN = 5384, N1 = 5376;
constexpr int NHEAD = 8;
constexpr int NCLS = 24;
constexpr int NPOSMAX = TX + 256 + NCLS * 256;
constexpr float EPS = 1e-6f;
constexpr float LOG2E = 1.4426950408889634f;
constexpr float C2 = 0.125f * LOG2E;
constexpr int NWAVES = 8;

constexpr size_t U = (size_t)TM * 1024 * 2;
constexpr size_t WS_CTL = 0, CTL_BYTES = 1u << 20;
constexpr size_t WS_H = CTL_BYTES;
constexpr size_t WS_HB = WS_H + 2 * U;
constexpr size_t WS_G = WS_HB + U;
constexpr size_t WS_XS = WS_G;
constexpr size_t WS_Y = WS_XS + (size_t)NPOSMAX * 2048;
constexpr size_t WS_HH = WS_Y + (size_t)NPOSMAX * 2048;
static_assert(WS_HH + (size_t)NPOSMAX * 1024 <= WS_G + 3 * U, "MoE overlay fits the gates region");
constexpr size_t WS_A = WS_G + 3 * U;
constexpr size_t WS_GLU = WS_A + U / 4;
constexpr size_t WS_X3 = WS_GLU + U / 4;
constexpr size_t WS_W1T = WS_X3 + U;
constexpr size_t WS_W3CT = WS_W1T + (size_t)N1 * 1024 * 2;
constexpr size_t WS_WOT = WS_W3CT + 1024 * 1024 * 2;
constexpr size_t WS_WFG = WS_WOT + 1024 * 1024 * 2;
constexpr size_t WS_RG = WS_WFG + 8 * 1024 * 4;
constexpr size_t WS_BIASA = WS_RG + 20 * 1024 * 4;
constexpr size_t WS_RSTD1 = WS_BIASA + 4096;
constexpr size_t WS_ROUTE = WS_RSTD1 + (size_t)TM * 4;
constexpr size_t WS_PW = WS_ROUTE + (size_t)TM * 32;
constexpr size_t WS_LFT = WS_PW + (size_t)NPOSMAX * 16;
constexpr size_t WS_LFTM = WS_LFT + (size_t)32 * 8192 * 4;
constexpr size_t WS_END = WS_LFTM + 8 * 256 * 4;
static_assert(WS_END <= (size_t)512 * 1024 * 1024, "d_ws map fits 512 MiB");
constexpr size_t DO_Q = 0, DO_K = U / 2, DO_V = U, DO_MERGED = U / 2;
constexpr size_t DO_W13T = 3 * U / 2;
constexpr size_t DO_W2T = DO_W13T + (size_t)16 * 512 * 1024 * 2;
static_assert(DO_W2T + (size_t)16 * 1024 * 256 * 2 <= (size_t)TX * 1024 * 4, "d_out scratch");
constexpr int CW_BAR = 4096, CW_GCNT = 16384;

constexpr int RING_BYTES = 131072;
constexpr int LC_BAR = RING_BYTES, LC_CNT = RING_BYTES + 64, LC_BASE = RING_BYTES + 192, LC_PCLS = RING_BYTES + 320, LC_NP = RING_BYTES + 960;
constexpr int LC_PTAB = RING_BYTES + 1024;
constexpr int LDS_BYTES = RING_BYTES + 1024 + 7168;

#define LDS_WAIT() asm volatile("s_waitcnt lgkmcnt(0)" ::: "memory")
#define VM_WAIT() asm volatile("s_waitcnt vmcnt(0)" ::: "memory")
#define LAUNDER_S(p) asm volatile("" : "+s"(p))
#define LAUNDER_V(x) asm volatile("" : "+v"(x))
__device__ __forceinline__ int lane_id_opaque() { int x; asm volatile("v_mbcnt_lo_u32_b32 %0, -1, 0\n\tv_mbcnt_hi_u32_b32 %0, -1, %0" : "=v"(x)); return x; }

__device__ __forceinline__ unsigned f2bf(float f) { unsigned u = __builtin_bit_cast(unsigned, f); return (u + 0x7fffu + ((u >> 16) & 1u)) >> 16; }
__device__ __forceinline__ unsigned pk2(float lo, float hi) { f32x2 v = {lo, hi}; bf16x2v b = __builtin_convertvector(v, bf16x2v); return __builtin_bit_cast(unsigned, b); }
__device__ __forceinline__ float bflo(unsigned w) { return __builtin_bit_cast(float, w << 16); }
__device__ __forceinline__ float bfhi(unsigned w) { return __builtin_bit_cast(float, w & 0xffff0000u); }
template <int O> __device__ __forceinline__ float lane_xor(float v) {
    if constexpr (O < 32) return __int_as_float(__builtin_amdgcn_ds_swizzle(__float_as_int(v), (O << 10) | 0x1f));
    else { auto rr = __builtin_amdgcn_permlane32_swap(__float_as_uint(v), __float_as_uint(v), false, false); return __uint_as_float(rr[0]) + __uint_as_float(rr[1]) - v; }
}
__device__ __forceinline__ float wave_sum(float v) {
    v += lane_xor<1>(v); v += lane_xor<2>(v); v += lane_xor<4>(v); v += lane_xor<8>(v); v += lane_xor<16>(v);
    auto rr = __builtin_amdgcn_permlane32_swap(__float_as_uint(v), __float_as_uint(v), false, false);
    return __uint_as_float(rr[0]) + __uint_as_float(rr[1]);
}
__device__ __forceinline__ float sigmoidf_(float x) { return __builtin_amdgcn_rcpf(1.0f + __builtin_amdgcn_exp2f(-LOG2E * x)); }
__device__ __forceinline__ float dot2bf(unsigned a, unsigned b, float acc) { return __builtin_amdgcn_fdot2_f32_bf16(__builtin_bit_cast(bf16x2v, a), __builtin_bit_cast(bf16x2v, b), acc, false); }

namespace pg8 {
constexpr int BM = 256, BK = 64, HALF = 128, HTB = HALF * BK * 2, STAGE_BYTES = 8 * HTB, NXCD = 8, WGM = 8;
__host__ __device__ __forceinline__ int lds_byte(int r, int c) { const int st = (r >> 4) * 2 + (c >> 5), rr = r & 15, cc = c & 31, ob = rr * 64 + cc * 2; return st * 1024 + (ob ^ (((ob >> 9) & 1) << 5)); }
__host__ __device__ __forceinline__ void stage_rc(int b, int& R, int& C) { const int st = b / 1024, sb = b % 1024, swz = sb ^ (((sb >> 9) & 1) << 5); R = (st >> 1) * 16 + swz / 64; C = (st & 1) * 32 + (swz % 64) / 2; }
__host__ __device__ __forceinline__ int perm32(int rho) { const int n = rho >> 4, i = rho & 15; return 8 * (i >> 2) + 4 * n + (i & 3); }

struct Unit { int pm, pn, seg; };
struct Gemm { const bf16* A; int K; int ldb; int ksplit; };

struct StaticOrder {
    int nM, nN, nwg, G, c; const bf16* Bt; size_t btile;
    __device__ void init(int M, int N, int G_, int c_, const bf16* Bt_, int ldb) { nM = M / BM; nN = N / BM; nwg = nM * nN; G = G_; c = c_; Bt = Bt_; btile = (size_t)BM * ldb * 2; }
    __device__ bool next(int i, Unit& u) const {
        const long L = (long)i * G + c; if (L >= nwg) return false;
        int wgid = (int)L; { const int q = nwg / NXCD, r = nwg % NXCD, xcd = wgid % NXCD, off = wgid / NXCD; wgid = (xcd < r ? xcd * (q + 1) : r * (q + 1) + (xcd - r) * q) + off; }
        const int nig = WGM * nN, gid = wgid / nig, fm = gid * WGM, gsz = (nM - fm) < WGM ? (nM - fm) : WGM;
        u.pm = fm + ((wgid % nig) % gsz); u.pn = (wgid % nig) / gsz; u.seg = 0; return true;
    }
    __device__ __forceinline__ const char* bptr(const Unit& u, int) const { return (const char*)Bt + (size_t)u.pn * btile; }
    __device__ __forceinline__ int nt(const Unit&, int ntd) const { return ntd; }
    __device__ __forceinline__ size_t aoff(const Unit&) const { return 0; }
};
struct SegOrder : StaticOrder {
    __device__ bool next(int i, Unit& u) const { const int q = i / 3; if (!StaticOrder::next(q, u)) return false; u.seg = i - 3 * q; return true; }
    __device__ __forceinline__ size_t koff(const Unit& u) const { return u.seg == 0 ? 0 : (u.seg == 1 ? 512 : 1024); }
    __device__ __forceinline__ const char* bptr(const Unit& u, int) const { return (const char*)Bt + (size_t)u.pn * btile + koff(u); }
    __device__ __forceinline__ int nt(const Unit& u, int) const { return u.seg == 2 ? 8 : 4; }
    __device__ __forceinline__ size_t aoff(const Unit& u) const { return koff(u); }
};

template <class Epi, class Sched, bool ALIGN_EPI = true, bool SP2 = true>
__device__ __forceinline__ void gemm_phase(LAS unsigned char* lds, const Gemm g, const Sched& S, const Epi& E, const int wave_id) {
    const int tid = wave_id * 64 + lane_id_opaque();
    const int wid = __builtin_amdgcn_readfirstlane(tid >> 6), lane = tid & 63, wr = wid >> 2, wc = wid & 3, fr = lane & 15, fq = lane >> 4;
    const int K = g.K, nt = K / BK, ldb = g.ldb, ks = g.ksplit;
    unsigned voffA[2], voffB[2];
#pragma unroll
    for (int i = 0; i < 2; ++i) { int R, C; stage_rc(tid * 16 + i * 8192, R, C); const int Rb = Epi::PERM ? ((R & ~31) + perm32(R & 31)) : R;
        voffA[i] = (unsigned)(R * K + C) * 2u; voffB[i] = (unsigned)(Rb * ldb + C) * 2u; }
    const size_t kstep = (size_t)(BK * 2);
    const size_t hstep = (size_t)HALF * K * 2;
    const size_t hstepB = (size_t)HALF * ldb * 2;
    const size_t tstep = 2 * hstep;
    const unsigned ldsw = (unsigned)wid * 1024u;
    const int aoff = lds_byte(wr * 64 + fr, fq * 8), boff = lds_byte(wc * 32 + fr, fq * 8);
#define PG8_SA(b, h) (((b) * 2 + (h)) * HTB)
#define PG8_SB(b, h) ((4 + (b) * 2 + (h)) * HTB)
#define PG8_STAGE(bufoff, gbase, voff) do { _Pragma("unroll") for (int _i = 0; _i < 2; ++_i) \
        __builtin_amdgcn_global_load_lds((const unsigned*)((const char*)(gbase) + (voff)[_i]), (LAS unsigned*)(lds + (bufoff) + ldsw + _i * 8192), 16, 0, 0); } while (0)
#define PG8_LDA(dst, b, h) do { _Pragma("unroll") for (int m = 0; m < 4; ++m) _Pragma("unroll") for (int k = 0; k < 2; ++k) dst[m][k] = *(const LAS bf16x8*)(lds + PG8_SA(b, h) + aoff + m * 2048 + k * 1024); } while (0)
#define PG8_LDB(dst, b, h) do { _Pragma("unroll") for (int n = 0; n < 2; ++n) _Pragma("unroll") for (int k = 0; k < 2; ++k) dst[n][k] = *(const LAS bf16x8*)(lds + PG8_SB(b, h) + boff + n * 2048 + k * 1024); } while (0)
#define PG8_MMA(ai, bj, At, Bt) do { __builtin_amdgcn_s_setprio(1); _Pragma("unroll") for (int m = 0; m < 4; ++m) _Pragma("unroll") for (int n = 0; n < 2; ++n) _Pragma("unroll") for (int k = 0; k < 2; ++k) \
        acc[ai][bj][m][n] = __builtin_amdgcn_mfma_f32_16x16x32_bf16(Bt[n][k], At[m][k], acc[ai][bj][m][n], 0, 0, 0); __builtin_amdgcn_s_setprio(0); } while (0)
#define PG8_WAIT_V(n) asm volatile("s_waitcnt vmcnt(" #n ")" ::: "memory")
#define PG8_WAIT_L(n) asm volatile("s_waitcnt lgkmcnt(" #n ")" ::: "memory")
#define PG8_BAR __builtin_amdgcn_s_barrier()
#define PG8_SCHED __builtin_amdgcn_sched_barrier(0)
    Unit cur, nxt; int ui = 0;
    if (!S.next(0, cur)) return;
    f32x4 acc[2][2][4][2];
    { float z_ = 0.f; LAUNDER_V(z_);
#pragma unroll
    for (int a = 0; a < 2; ++a)
#pragma unroll
        for (int b = 0; b < 2; ++b)
#pragma unroll
            for (int m = 0; m < 4; ++m)
#pragma unroll
                for (int n = 0; n < 2; ++n) acc[a][b][m][n] = (f32x4){z_, z_, z_, z_}; }
    bf16x8 At[4][2], B0[2][2], B1[2][2];
    int ntc = S.nt(cur, nt);
    const char* cA = (const char*)g.A + (size_t)cur.pm * tstep + S.aoff(cur); const char* cB = S.bptr(cur, 0); const char* cB1 = S.bptr(cur, 1) - (size_t)ks * kstep;
    if constexpr (SP2) {
        PG8_STAGE(PG8_SB(0, 0), cB, voffB); PG8_STAGE(PG8_SB(0, 1), cB + hstepB, voffB); PG8_STAGE(PG8_SA(0, 0), cA, voffA); PG8_STAGE(PG8_SA(0, 1), cA + hstep, voffA);
        if (wr == 1) PG8_BAR;
        PG8_WAIT_V(2); PG8_BAR;
        PG8_STAGE(PG8_SB(1, 0), cB + kstep, voffB); PG8_STAGE(PG8_SA(1, 0), cA + kstep, voffA); PG8_STAGE(PG8_SB(1, 1), cB + hstepB + kstep, voffB);
        PG8_WAIT_V(6); PG8_BAR;
    } else {
        PG8_STAGE(PG8_SB(0, 0), cB, voffB); PG8_STAGE(PG8_SA(0, 0), cA, voffA); PG8_STAGE(PG8_SB(0, 1), cB + hstepB, voffB); PG8_STAGE(PG8_SA(0, 1), cA + hstep, voffA);
        if (wr == 1) PG8_BAR;
        PG8_WAIT_V(4); PG8_BAR;
        PG8_STAGE(PG8_SB(1, 0), cB + kstep, voffB); PG8_STAGE(PG8_SA(1, 0), cA + kstep, voffA); PG8_STAGE(PG8_SB(1, 1), cB + hstepB + kstep, voffB);
        PG8_WAIT_V(6); PG8_BAR;
    }
    for (;;) {
        const bool has_next = S.next(ui + 1, nxt);
        const char* nA = has_next ? (const char*)g.A + (size_t)nxt.pm * tstep + S.aoff(nxt) : cA; const char* nB = has_next ? S.bptr(nxt, 0) : cB;
        const char* nB1 = has_next ? S.bptr(nxt, 1) - (size_t)ks * kstep : cB1;
#pragma unroll 1
        for (int t = 0; t < ntc; t += 2) {
            const bool last = (t == ntc - 2);
            const char* a1 = cA + (size_t)(t + 1) * kstep;
            const char* bside = (t + 2 < ks) ? cB : cB1;
            const char* a2 = last ? nA : cA + (size_t)(t + 2) * kstep; const char* b2 = last ? nB : bside + (size_t)(t + 2) * kstep;
            const char* a3 = a2 + kstep; const char* b3 = b2 + kstep;
            if constexpr (SP2) {
            PG8_LDB(B0, 0, 0); PG8_LDB(B1, 0, 1); PG8_SCHED; PG8_LDA(At, 0, 0); PG8_STAGE(PG8_SA(1, 1), a1 + hstep, voffA);
            PG8_WAIT_V(8); PG8_WAIT_L(0); PG8_BAR; PG8_MMA(0, 0, At, B0); PG8_MMA(0, 1, At, B1); PG8_BAR; PG8_SCHED;
            PG8_LDA(At, 0, 1); PG8_STAGE(PG8_SB(0, 0), b2, voffB); PG8_STAGE(PG8_SB(0, 1), b2 + hstepB, voffB); PG8_STAGE(PG8_SA(0, 0), a2, voffA);
            PG8_WAIT_V(8); PG8_WAIT_L(0); PG8_BAR; PG8_MMA(1, 0, At, B0); PG8_MMA(1, 1, At, B1); PG8_BAR; PG8_SCHED;
            PG8_LDB(B0, 1, 0); PG8_LDB(B1, 1, 1); PG8_SCHED; PG8_LDA(At, 1, 0); PG8_STAGE(PG8_SA(0, 1), a2 + hstep, voffA);
            PG8_WAIT_V(8); PG8_WAIT_L(0); PG8_BAR; PG8_MMA(0, 0, At, B0); PG8_MMA(0, 1, At, B1); PG8_BAR; PG8_SCHED;
            PG8_LDA(At, 1, 1); PG8_STAGE(PG8_SB(1, 0), b3, voffB); PG8_STAGE(PG8_SB(1, 1), b3 + hstepB, voffB); PG8_STAGE(PG8_SA(1, 0), a3, voffA);
            PG8_WAIT_V(8); PG8_WAIT_L(0); PG8_BAR; PG8_MMA(1, 0, At, B0); PG8_MMA(1, 1, At, B1); PG8_BAR; PG8_SCHED;
            } else {
            PG8_LDB(B0, 0, 0); PG8_SCHED; PG8_LDA(At, 0, 0); PG8_STAGE(PG8_SA(1, 1), a1 + hstep, voffA);
            PG8_WAIT_L(8); PG8_BAR; PG8_WAIT_L(0); PG8_MMA(0, 0, At, B0); PG8_BAR; PG8_SCHED;
            PG8_LDB(B1, 0, 1); PG8_STAGE(PG8_SB(0, 0), b2, voffB);
            PG8_BAR; PG8_WAIT_L(0); PG8_MMA(0, 1, At, B1); PG8_BAR;
            PG8_LDA(At, 0, 1); PG8_STAGE(PG8_SA(0, 0), a2, voffA);
            PG8_BAR; PG8_WAIT_L(0); PG8_MMA(1, 0, At, B0); PG8_BAR; PG8_SCHED;
            PG8_STAGE(PG8_SB(0, 1), b2 + hstepB, voffB);
            PG8_WAIT_V(6); PG8_BAR; PG8_MMA(1, 1, At, B1); PG8_BAR;
            PG8_LDB(B0, 1, 0); PG8_SCHED; PG8_LDA(At, 1, 0); PG8_STAGE(PG8_SA(0, 1), a2 + hstep, voffA);
            PG8_WAIT_L(8); PG8_BAR; PG8_WAIT_L(0); PG8_MMA(0, 0, At, B0); PG8_BAR; PG8_SCHED;
            PG8_LDB(B1, 1, 1); PG8_STAGE(PG8_SB(1, 0), b3, voffB);
            PG8_BAR; PG8_WAIT_L(0); PG8_MMA(0, 1, At, B1); PG8_BAR;
            PG8_LDA(At, 1, 1); PG8_STAGE(PG8_SA(1, 0), a3, voffA);
            PG8_BAR; PG8_WAIT_L(0); PG8_MMA(1, 0, At, B0); PG8_BAR; PG8_SCHED;
            PG8_STAGE(PG8_SB(1, 1), b3 + hstepB, voffB);
            PG8_WAIT_V(6); PG8_BAR; PG8_MMA(1, 1, At, B1); PG8_BAR;
            }
        }
        if constexpr (ALIGN_EPI) { if (wr == 0) PG8_BAR; }
        { const int l2 = lane_id_opaque(); E(acc, cur, wr, wc, l2 & 15, l2 >> 4); }
        if (!has_next) break;
        if (!E.keep(cur)) { float z_ = 0.f; LAUNDER_V(z_);
#pragma unroll
        for (int a = 0; a < 2; ++a)
#pragma unroll
            for (int b = 0; b < 2; ++b)
#pragma unroll
                for (int m = 0; m < 4; ++m)
#pragma unroll
                    for (int n = 0; n < 2; ++n) acc[a][b][m][n] = (f32x4){z_, z_, z_, z_}; }
        cur = nxt; cA = nA; cB = nB; cB1 = nB1; ++ui; ntc = S.nt(cur, nt);
        if constexpr (ALIGN_EPI) { if (wr == 1) PG8_BAR; }
    }
    PG8_WAIT_V(0);
    if constexpr (!ALIGN_EPI) { if (wr == 0) PG8_BAR; }
    PG8_BAR;
#undef PG8_SA
#undef PG8_SB
#undef PG8_STAGE
#undef PG8_LDA
#undef PG8_LDB
#undef PG8_MMA
#undef PG8_WAIT_V
#undef PG8_WAIT_L
#undef PG8_BAR
#undef PG8_SCHED
}
}

typedef f32x4 AccT[2][2][4][2];
__device__ __forceinline__ u32x4 pack8(const f32x4 a, const f32x4 b) { u32x4 w; w.x = pk2(a[0], a[1]); w.y = pk2(a[2], a[3]); w.z = pk2(b[0], b[1]); w.w = pk2(b[2], b[3]); return w; }

struct Epi1 {
    static constexpr bool PERM = true;
    __device__ __forceinline__ bool keep(const pg8::Unit&) const { return false; }
    const float* rstd; bf16* A; bf16* GLU; bf16* QKV; bf16* G;
    __device__ __forceinline__ void operator()(AccT& acc, const pg8::Unit& u, int wr, int wc, int fr, int fq) const { run<false>(acc, u, wr, wc, fr, fq); }
    template <bool SK> __device__ __forceinline__ void run(AccT& acc, const pg8::Unit& u, int wr, int wc, int fr, int fq) const {
        const int row0 = u.pm * 256 + wr * 64 + fr, lc0 = wc * 32 + 8 * fq, pn = u.pn;
#pragma unroll
        for (int ai = 0; ai < (SK ? 1 : 2); ++ai)
#pragma unroll
            for (int m = 0; m < (SK ? 1 : 4); ++m) {
                const int row = row0 + ai * 128 + m * 16; const float rs = rstd[row];
                f32x4 v[2][2];
#pragma unroll
                for (int bj = 0; bj < 2; ++bj)
#pragma unroll
                    for (int n = 0; n < 2; ++n) v[bj][n] = acc[ai][bj][m][n] * rs;
                if (pn == 0) {
#pragma unroll
                    for (int bj = 0; bj < 2; ++bj) *(u32x4*)(A + (size_t)row * 256 + bj * 128 + lc0) = pack8(v[bj][0], v[bj][1]);
                } else if (pn <= 2) {
                    f32x4 o[2];
#pragma unroll
                    for (int n = 0; n < 2; ++n)
#pragma unroll
                        for (int j = 0; j < 4; ++j) o[n][j] = v[0][n][j] * sigmoidf_(v[1][n][j]);
                    *(u32x4*)(GLU + (size_t)row * 256 + (pn - 1) * 128 + lc0) = pack8(o[0], o[1]);
                } else if (pn <= 8) {
                    const int t = (pn - 3) >> 1; bf16* base = QKV + (size_t)t * (U / 4); const float sc = t == 0 ? C2 : 1.0f;
#pragma unroll
                    for (int bj = 0; bj < 2; ++bj) *(u32x4*)(base + (size_t)row * 512 + ((pn - 3) & 1) * 256 + bj * 128 + lc0) = pack8(v[bj][0] * sc, v[bj][1] * sc);
                } else {
#pragma unroll
                    for (int bj = 0; bj < 2; ++bj) { f32x4 o[2];
#pragma unroll
                        for (int n = 0; n < 2; ++n)
#pragma unroll
                            for (int j = 0; j < 4; ++j) o[n][j] = fmaxf(sigmoidf_(v[bj][n][j]), 1e-30f);
                        *(u32x4*)(G + (size_t)row * 3072 + (pn - 9) * 256 + bj * 128 + lc0) = pack8(o[0], o[1]); }
                }
            }
    }
};
struct EpiCS {
    static constexpr bool PERM = true;
    const bf16* G; bf16* Mg; const float* bias;
    __device__ __forceinline__ bool keep(const pg8::Unit& u) const { return u.seg != 2; }
    __device__ __forceinline__ void operator()(AccT& acc, const pg8::Unit& u, int wr, int wc, int fr, int fq) const { run<false>(acc, u, wr, wc, fr, fq); }
    template <bool SK> __device__ __forceinline__ void run(AccT& acc, const pg8::Unit& u, int wr, int wc, int fr, int fq) const {
        const int row0 = u.pm * 256 + wr * 64 + fr, col0 = u.pn * 256 + wc * 32 + 8 * fq;
        const bool lastseg = u.seg == 2; const int w = u.seg, wd = lastseg ? 2 : u.seg + 1; const float bsc = u.seg == 0 ? 1.f : 0.f;
        f32x4 bv[2][2];
#pragma unroll
        for (int bj = 0; bj < 2; ++bj) { bv[bj][0] = *(const f32x4*)(bias + col0 + bj * 128) * bsc; bv[bj][1] = *(const f32x4*)(bias + col0 + bj * 128 + 4) * bsc; }
#pragma unroll
        for (int ai = 0; ai < (SK ? 1 : 2); ++ai) {
            u32x4 gn[4][2], gd[4][2];
#pragma unroll
            for (int m = 0; m < (SK ? 1 : 4); ++m) { const bf16* gp = G + (size_t)(row0 + ai * 128 + m * 16) * 3072 + col0;
#pragma unroll
                for (int bj = 0; bj < 2; ++bj) { gn[m][bj] = *(const u32x4*)(gp + w * 1024 + bj * 128); gd[m][bj] = *(const u32x4*)(gp + wd * 1024 + bj * 128); } }
#pragma unroll
            for (int m = 0; m < (SK ? 1 : 4); ++m) { const int row = row0 + ai * 128 + m * 16;
#pragma unroll
                for (int bj = 0; bj < 2; ++bj) {
                    const u32x4 n4 = gn[m][bj], d4 = gd[m][bj];
                    f32x4 a0 = acc[ai][bj][m][0] + bv[bj][0], a1 = acc[ai][bj][m][1] + bv[bj][1];
#define RAT(gnv, gdv) ((gnv) * (lastseg ? 1.0f : __builtin_amdgcn_rcpf(gdv)))
                    a0[0] *= RAT(bflo(n4.x), bflo(d4.x)); a0[1] *= RAT(bfhi(n4.x), bfhi(d4.x)); a0[2] *= RAT(bflo(n4.y), bflo(d4.y)); a0[3] *= RAT(bfhi(n4.y), bfhi(d4.y));
                    a1[0] *= RAT(bflo(n4.z), bflo(d4.z)); a1[1] *= RAT(bfhi(n4.z), bfhi(d4.z)); a1[2] *= RAT(bflo(n4.w), bflo(d4.w)); a1[3] *= RAT(bfhi(n4.w), bfhi(d4.w));
#undef RAT
                    acc[ai][bj][m][0] = a0; acc[ai][bj][m][1] = a1;
                    asm volatile("" : "+v"(acc[ai][bj][m][0]), "+v"(acc[ai][bj][m][1]));
                    if (lastseg) *(u32x4*)(Mg + (size_t)row * 1024 + col0 + bj * 128) = pack8(a0, a1);
                } }
            asm volatile("" ::: "memory");
        }
    }
};
struct EpiD {
    static constexpr bool PERM = false;
    __device__ __forceinline__ bool keep(const pg8::Unit&) const { return false; }
    float* H; bf16* HB;
    __device__ __forceinline__ void operator()(AccT& acc, const pg8::Unit& u, int wr, int wc, int fr, int fq) const { run<false>(acc, u, wr, wc, fr, fq); }
    template <bool SK> __device__ __forceinline__ void run(AccT& acc, const pg8::Unit& u, int wr, int wc, int fr, int fq) const {
        const int row0 = u.pm * 256 + wr * 64 + fr, col0 = u.pn * 256 + wc * 32 + 4 * fq;
#pragma unroll
        for (int ai = 0; ai < (SK ? 1 : 2); ++ai)
#pragma unroll
            for (int m = 0; m < (SK ? 1 : 4); ++m) {
                const size_t off = (size_t)(row0 + ai * 128 + m * 16) * 1024 + col0;
#pragma unroll
                for (int bj = 0; bj < 2; ++bj)
#pragma unroll
                    for (int n = 0; n < 2; ++n) { const size_t o = off + bj * 128 + n * 16; const f32x4 hv = *(const f32x4*)(H + o) + acc[ai][bj][m][n];
                        *(f32x4*)(H + o) = hv; u32x2 w; w.x = pk2(hv[0], hv[1]); w.y = pk2(hv[2], hv[3]); *(u32x2*)(HB + o) = w; }
            }
    }
};
struct EpiA2 {
    static constexpr bool PERM = true;
    __device__ __forceinline__ bool keep(const pg8::Unit&) const { return false; }
    const float* PW; bf16* HH;
    __device__ __forceinline__ void operator()(AccT& acc, const pg8::Unit& u, int wr, int wc, int fr, int fq) const {
        const int row0 = u.pm * 256 + wr * 64 + fr, lc0 = wc * 32 + 8 * fq, side = u.pn >> 1;
#pragma unroll
        for (int ai = 0; ai < 2; ++ai)
#pragma unroll
            for (int m = 0; m < 4; ++m) {
                const int row = row0 + ai * 128 + m * 16; const f32x4 pw = *(const f32x4*)(PW + (size_t)row * 4);
                const float rs = pw[0], cw = side ? pw[2] : pw[1];
                f32x4 o[2];
#pragma unroll
                for (int n = 0; n < 2; ++n)
#pragma unroll
                    for (int j = 0; j < 4; ++j) { const float a1 = acc[ai][0][m][n][j] * rs, a3 = acc[ai][1][m][n][j] * rs; o[n][j] = cw * a1 * sigmoidf_(a1) * a3; }
                *(u32x4*)(HH + (size_t)row * 512 + side * 256 + (u.pn & 1) * 128 + lc0) = pack8(o[0], o[1]);
            }
    }
};
struct EpiB2 {
    static constexpr bool PERM = true;
    __device__ __forceinline__ bool keep(const pg8::Unit&) const { return false; }
    bf16* Y;
    __device__ __forceinline__ void operator()(AccT& acc, const pg8::Unit& u, int wr, int wc, int fr, int fq) const { run<false>(acc, u, wr, wc, fr, fq); }
    template <bool SK> __device__ __forceinline__ void run(AccT& acc, const pg8::Unit& u, int wr, int wc, int fr, int fq) const {
        const int row0 = u.pm * 256 + wr * 64 + fr, col0 = u.pn * 256 + wc * 32 + 8 * fq;
#pragma unroll
        for (int ai = 0; ai < (SK ? 1 : 2); ++ai)
#pragma unroll
            for (int m = 0; m < (SK ? 1 : 4); ++m) {
                bf16* rp = Y + (size_t)(row0 + ai * 128 + m * 16) * 1024 + col0;
#pragma unroll
                for (int bj = 0; bj < 2; ++bj) *(u32x4*)(rp + bj * 128) = pack8(acc[ai][bj][m][0], acc[ai][bj][m][1]);
            }
    }
};
struct MoeOrder {
    int NP, G, c, mode; const LAS int* pcls; const bf16* W;
    __device__ bool next(int i, pg8::Unit& u) const { const long L = (long)i * G + c; if (L >= (long)NP * 4) return false; u.pm = (int)(L >> 2); u.pn = (int)(L & 3); u.seg = 0; return true; }
    __device__ __forceinline__ int nt(const pg8::Unit&, int ntd) const { return ntd; }
    __device__ __forceinline__ size_t aoff(const pg8::Unit&) const { return 0; }
    __device__ __forceinline__ const char* bptr(const pg8::Unit& u, int side) const {
        const int cls = __builtin_amdgcn_readfirstlane(pcls[u.pm]); const int grp = cls / 6, pr = cls % 6;
        const int ea = pr < 3 ? 0 : (pr < 5 ? 1 : 2), eb = pr < 3 ? pr + 1 : (pr < 5 ? pr - 1 : 3);
        if (mode == 0) { const int e = grp * 4 + (u.pn < 2 ? ea : eb); return (const char*)W + ((size_t)e * 512 + (size_t)(u.pn & 1) * 256) * 1024 * 2; }
        const int e = grp * 4 + (side ? eb : ea); return (const char*)W + ((size_t)e * 1024 + (size_t)u.pn * 256) * 256 * 2;
    }
};

template <bool PERM> __device__ __forceinline__ void skinny_k(AccT& acc, const bf16* A, int lda, const bf16* Bt, int ldb, int K, int wc, int fr, int fq) {
    const bf16* ap = A + (size_t)fr * lda + 8 * fq;
    const bf16* bp[2][2];
#pragma unroll
    for (int bj = 0; bj < 2; ++bj)
#pragma unroll
        for (int n = 0; n < 2; ++n) { const int col = 128 * bj + 32 * wc + (PERM ? 8 * (fr >> 2) + 4 * n + (fr & 3) : 16 * n + fr); bp[bj][n] = Bt + (size_t)col * ldb + 8 * fq; }
#pragma unroll 4
    for (int k0 = 0; k0 < K; k0 += 32) {
        const bf16x8 a = *(const bf16x8*)(ap + k0);
#pragma unroll
        for (int bj = 0; bj < 2; ++bj)
#pragma unroll
            for (int n = 0; n < 2; ++n) { const bf16x8 b = *(const bf16x8*)(bp[bj][n] + k0); acc[0][bj][0][n] = __builtin_amdgcn_mfma_f32_16x16x32_bf16(b, a, acc[0][bj][0][n], 0, 0, 0); }
    }
}
__device__ __forceinline__ void skinny_zero(AccT& acc) {
#pragma unroll
    for (int bj = 0; bj < 2; ++bj)
#pragma unroll
        for (int n = 0; n < 2; ++n) acc[0][bj][0][n] = (f32x4){0.f, 0.f, 0.f, 0.f};
}

#define XB_TMO      128
#define XB_XCNT(j)  (256  + 64 * (j))
#define XB_XSUB(j)  (1280 + 64 * (j))
#define XB_XGEN(j)  (2304 + 64 * (j))
#define XB_TOP      3328
#define XB_TOPGEN   3392
#define XCD_BAR_WORDS 3456
#define XB_SPIN_CAP (1u << 24)
__device__ __forceinline__ unsigned xb_ld(unsigned* p)              { return __hip_atomic_load(p, __ATOMIC_RELAXED, __HIP_MEMORY_SCOPE_AGENT); }
__device__ __forceinline__ unsigned xb_add(unsigned* p, unsigned v) { return __hip_atomic_fetch_add(p, v, __ATOMIC_RELAXED, __HIP_MEMORY_SCOPE_AGENT); }
__device__ __forceinline__ unsigned xb_xcc_id() { return (unsigned)__builtin_amdgcn_s_getreg((3 << 11) | 20) & 0xFu; }
#define XB_SPIN(cond, bar) do { unsigned _sp = 0; while (cond) { __builtin_amdgcn_s_sleep(1); \
    if ((++_sp & 255u) == 0u) { if (xb_ld(&(bar)[XB_TMO])) break; if (_sp > XB_SPIN_CAP) { atomicAdd(&(bar)[XB_TMO], 1u); break; } } } } while (0)
struct XcdBarrier { unsigned* bar; unsigned x; volatile LAS unsigned* st; };
__device__ __forceinline__ XcdBarrier xcd_barrier_post(unsigned* bar, volatile LAS unsigned* st) {
    XcdBarrier b; b.bar = bar; b.x = xb_xcc_id(); b.st = st;
    if (threadIdx.x == 0) (void)xb_add(&bar[XB_XCNT(b.x)], 1u);
    return b;
}
__device__ __forceinline__ void xcd_barrier_complete(unsigned* bar, unsigned x, unsigned& nloc, unsigned& nx) {
    const unsigned G = gridDim.x * gridDim.y * gridDim.z;
    unsigned sum, cnt, mine, sp = 0u;
    for (;;) {
        sum = 0u; cnt = 0u; mine = 0u;
#pragma unroll
        for (unsigned j = 0; j < 16; ++j) { const unsigned c = xb_ld(&bar[XB_XCNT(j)]); sum += c; cnt += (c > 0u) ? 1u : 0u; mine = (j == x) ? c : mine; }
        if (sum == G) break;
        __builtin_amdgcn_s_sleep(1);
        if ((++sp & 255u) == 0u) { if (xb_ld(&bar[XB_TMO])) break; if (sp > XB_SPIN_CAP) { atomicAdd(&bar[XB_TMO], 1u); break; } }
    }
    nloc = mine > 0u ? mine : 1u; nx = cnt > 0u ? cnt : 1u;
}
__device__ __forceinline__ void xcd_barrier(const XcdBarrier& b) {
    asm volatile("s_waitcnt vmcnt(0)" ::: "memory");
    __syncthreads();
    if (threadIdx.x == 0) {
        unsigned* bar = b.bar;
        __builtin_amdgcn_s_waitcnt(0);
        unsigned nloc = b.st[0], nx = b.st[1];
        if (nloc == 0u) { xcd_barrier_complete(bar, b.x, nloc, nx); b.st[0] = nloc; b.st[1] = nx; }
        const unsigned old = xb_add(&bar[XB_XSUB(b.x)], 1u);
        const unsigned gen = old / nloc;
        if (old + 1u == (gen + 1u) * nloc) {
            __builtin_amdgcn_fence(__ATOMIC_RELEASE, "agent");
            asm volatile("s_waitcnt vmcnt(0)" ::: "memory");
            const unsigned og = xb_add(&bar[XB_TOP], 1u);
            const unsigned tg = og / nx;
            if (og + 1u == (tg + 1u) * nx) xb_add(&bar[XB_TOPGEN], 1u);
            else XB_SPIN(xb_ld(&bar[XB_TOPGEN]) == tg, bar);
            __builtin_amdgcn_fence(__ATOMIC_ACQUIRE, "agent");
            xb_add(&bar[XB_XGEN(b.x)], 1u);
            asm volatile("s_waitcnt vmcnt(0)" ::: "memory");
        } else {
            XB_SPIN(xb_ld(&bar[XB_XGEN(b.x)]) == gen, bar);
            __builtin_amdgcn_fence(__ATOMIC_ACQUIRE, "agent");
            asm volatile("s_waitcnt vmcnt(0)" ::: "memory");
        }
    }
    __syncthreads();
}

struct Params { const float* in[25]; float* out; unsigned char* ws; int ph_lo, ph_hi; };
enum { I_X = 0, I_META, I_N1G, I_WIN, I_BF, I_PW, I_PB, I_PS, I_CW, I_CB, I_LNG, I_LNB, I_WOA, I_WOB, I_WOC, I_WO, I_N2G, I_RGW, I_RGB, I_REW, I_REB, I_W1, I_W3, I_W2, I_FG };

struct Frame {
    LAS unsigned char* lds;
    int tid, lane, wave, vcu, G, bx;
};
__device__ __forceinline__ unsigned long long ptab_get(const Frame& F, int i) { const LAS unsigned* t = (const LAS unsigned*)(F.lds + LC_PTAB) + 2 * i; const unsigned lo = __builtin_amdgcn_readfirstlane(t[0]), hi = __builtin_amdgcn_readfirstlane(t[1]); return ((unsigned long long)hi << 32) | lo; }
#define INP(i) ((const float*)(const GAS float*)ptab_get(F, (i)))
#define WSP() ((unsigned char*)(GAS unsigned char*)ptab_get(F, 25))
#define DOP() ((unsigned char*)(GAS unsigned char*)ptab_get(F, 26))

__device__ __forceinline__ void tr_item(const float* W, int ldw, int scol0, const float* gk, bf16* WT, int ldt, int drow0, int k0, LAS float* scr, int lane) {
    const int n4 = (lane & 7) * 4, kr = lane >> 3;
    f32x4 v[8];
#pragma unroll
    for (int i = 0; i < 8; ++i) v[i] = *(const f32x4*)(W + (size_t)(k0 + 8 * i + kr) * ldw + scol0 + n4);
#pragma unroll
    for (int i = 0; i < 8; ++i) { const int kk = 8 * i + kr; const float g = gk ? gk[k0 + kk] : 1.0f; LAS float* d = scr + kk * 33 + n4; d[0] = v[i][0] * g; d[1] = v[i][1] * g; d[2] = v[i][2] * g; d[3] = v[i][3] * g; }
    LDS_WAIT(); asm volatile("" ::: "memory");
    const int c = lane & 7;
#pragma unroll
    for (int j = 0; j < 4; ++j) { const int n = (lane >> 3) + 8 * j; const LAS float* s = scr + (8 * c) * 33 + n;
        u32x4 o; o.x = pk2(s[0 * 33], s[1 * 33]); o.y = pk2(s[2 * 33], s[3 * 33]); o.z = pk2(s[4 * 33], s[5 * 33]); o.w = pk2(s[6 * 33], s[7 * 33]);
        *(u32x4*)(WT + (size_t)(drow0 + n) * ldt + k0 + 8 * c) = o; }
    LDS_WAIT(); asm volatile("" ::: "memory");
}
__device__ __forceinline__ int map1(int n) {
    const int tile = n >> 8, r = n & 255;
    if (tile == 0) return n;
    if (tile <= 2) { const int c = (tile - 1) * 128 + (r & 127); return (r < 128 ? 256 : 512) + c; }
    if (tile <= 8) return n;
    return n + 8;
}
__device__ __forceinline__ void convert_weights(Frame& F, int l) {
    LAS float* scr = (LAS float*)(F.lds + F.wave * 16384);
    const int gw = F.vcu * NWAVES + F.wave, NGW = F.G * NWAVES, lane = F.lane;
    const float* g1 = INP(I_N1G) + (size_t)l * D; const float* g2 = INP(I_N2G) + (size_t)l * D;
    unsigned char* ws = WSP();
#pragma unroll 1
    for (int it0 = gw; it0 < 9728; it0 += NGW) { int it = it0;
        if (it < 2688) { const int kb = it / 168, nb = it % 168; tr_item(INP(I_WIN) + (size_t)l * D * NIN, NIN, map1(nb * 32), g1, (bf16*)(ws + WS_W1T), 1024, nb * 32, kb * 64, scr, lane); continue; } it -= 2688;
        if (it < 128) { const int kb = it / 32, nb = it % 32; tr_item(INP(I_WOB) + (size_t)l * 256 * D, 1024, nb * 32, nullptr, (bf16*)(ws + WS_W3CT) + 256, 1024, nb * 32, kb * 64, scr, lane); continue; } it -= 128;
        if (it < 256) { const int kb = it / 32, nb = it % 32; tr_item(INP(I_WOC) + (size_t)l * 512 * D, 1024, nb * 32, nullptr, (bf16*)(ws + WS_W3CT) + 512, 1024, nb * 32, kb * 64, scr, lane); continue; } it -= 256;
        if (it < 512) { const int kb = it / 32, nb = it % 32; tr_item(INP(I_WO) + (size_t)l * D * D, 1024, nb * 32, nullptr, (bf16*)(ws + WS_WOT), 1024, nb * 32, kb * 64, scr, lane); continue; } it -= 512;
        if (it < 4096) { const int e = it >> 8, r = it & 255, kb = r >> 4, nb = r & 15, n0 = nb * 32, jt = n0 >> 8, rr = n0 & 255;
            const float* W = (rr < 128 ? INP(I_W1) : INP(I_W3)) + ((size_t)l * 16 + e) * D * 256;
            tr_item(W, 256, jt * 128 + (rr & 127), g2, (bf16*)(DOP() + DO_W13T) + (size_t)e * 512 * 1024, 1024, n0, kb * 64, scr, lane); continue; } it -= 4096;
        { const int e = it >> 7, r = it & 127, kb = r >> 5, nb = r & 31;
            tr_item(INP(I_W2) + ((size_t)l * 16 + e) * 256 * D, 1024, nb * 32, nullptr, (bf16*)(DOP() + DO_W2T) + (size_t)e * 1024 * 256, 256, nb * 32, kb * 64, scr, lane); }
    }
    { const float* pw = INP(I_PW) + (size_t)l * 4 * 64 * 64; const float* ps = INP(I_PS) + (size_t)l * 256; const float* pb = INP(I_PB) + (size_t)l * 256;
      const float* wa = INP(I_WOA) + (size_t)l * 256 * D; bf16* WT = (bf16*)(ws + WS_W3CT); float* bias = (float*)(ws + WS_BIASA);
      const int gt = F.vcu * 512 + F.tid, NT = F.G * 512;
      for (int idx = gt; idx < 256 * 1024; idx += NT) { const int n = idx & 1023, kk = idx >> 10, grp = kk >> 6, c = kk & 63; float s = 0.f;
#pragma unroll 16
        for (int d = 0; d < 64; ++d) s += pw[(grp * 64 + c) * 64 + d] * ps[grp * 64 + d] * wa[(size_t)(grp * 64 + d) * D + n];
        WT[(size_t)n * 1024 + kk] = (bf16)f2bf(s); }
      for (int n = gw; n < 1024; n += NGW) { float s = 0.f;
#pragma unroll
        for (int j = 0; j < 4; ++j) { const int d = lane + 64 * j; s += pb[d] * ps[d] * wa[(size_t)d * D + n]; }
        s = wave_sum(s); if (lane == 0) bias[n] = s; }
      float* wfg = (float*)(ws + WS_WFG); const float* win = INP(I_WIN) + (size_t)l * D * NIN;
      for (int idx = gt; idx < 8 * 1024; idx += NT) { const int c = idx >> 10, k = idx & 1023; wfg[idx] = g1[k] * win[(size_t)k * NIN + 2304 + c]; }
      float* rg = (float*)(ws + WS_RG); const float* re = INP(I_REW) + (size_t)l * D * 16; const float* rgw = INP(I_RGW) + (size_t)l * D * 4;
      for (int idx = gt; idx < 20 * 1024; idx += NT) { const int c = idx >> 10, k = idx & 1023; rg[idx] = g2[k] * (c < 16 ? re[(size_t)k * 16 + c] : rgw[(size_t)k * 4 + (c - 16)]); } }
}
__device__ __forceinline__ void init_rows(Frame& F) {
    const int gw = F.vcu * NWAVES + F.wave, NGW = F.G * NWAVES, lane = F.lane;
    bf16* HB = (bf16*)(WSP() + WS_HB); float* rstd1 = (float*)(WSP() + WS_RSTD1);
    constexpr int R = 4;
#pragma unroll 1
    for (int row0 = gw; row0 < TR; row0 += R * NGW) {
        f32x4 v[R][4];
#pragma unroll
        for (int r = 0; r < R; ++r) { int row = row0 + r * NGW; if (row >= TR) row = TR - 1;
            const float* src = row < TX ? INP(I_X) + (size_t)row * D : INP(I_META) + (size_t)(row - TX) * D;
#pragma unroll
            for (int j = 0; j < 4; ++j) v[r][j] = *(const f32x4*)(src + 4 * lane + 256 * j); }
#pragma unroll
        for (int r = 0; r < R; ++r) { const int row = row0 + r * NGW; float ss = 0.f;
#pragma unroll
            for (int j = 0; j < 4; ++j) ss += v[r][j][0] * v[r][j][0] + v[r][j][1] * v[r][j][1] + v[r][j][2] * v[r][j][2] + v[r][j][3] * v[r][j][3];
            ss = wave_sum(ss);
            if (row < TR) {
#pragma unroll
                for (int j = 0; j < 4; ++j) { u32x2 w; w.x = pk2(v[r][j][0], v[r][j][1]); w.y = pk2(v[r][j][2], v[r][j][3]); *(u32x2*)(HB + (size_t)row * D + 4 * lane + 256 * j) = w; }
                if (lane == 0) rstd1[row] = rsqrtf(ss * (1.0f / D) + EPS); } }
    }
    { bf16* Kb = (bf16*)(DOP() + DO_K) + (size_t)TR * 512; bf16* Vb = (bf16*)(DOP() + DO_V) + (size_t)TR * 512; const int gt = F.vcu * 512 + F.tid;
      if (gt < 48 * 64) { *(u32x4*)(Kb + (size_t)gt * 8) = (u32x4){0u, 0u, 0u, 0u}; *(u32x4*)(Vb + (size_t)gt * 8) = (u32x4){0u, 0u, 0u, 0u}; } }
}

__device__ __forceinline__ int srcrow(bool isx, int b, int t) {
    if (t >= 0) return (isx ? b * SEQ : TX) + t;
    if (isx) { const int mm = NMETA + t; return mm >= 0 ? TX + mm : -1; }
    return -1;
}
__device__ __forceinline__ void phase_S(Frame& F, int l) {
    LAS unsigned char* lds = F.lds; const int wave = F.wave;
#pragma unroll 1
    for (int item = F.vcu; item < 513; item += F.G) {
        const bool isx = item < 512; const int row0 = isx ? item * 64 : TX + (item - 512) * 64; const int b = isx ? (item * 64) / SEQ : 0; const int t0 = isx ? (item * 64) % SEQ : (item - 512) * 64; const int nrows = isx ? 64 : NMETA;
        { unsigned char* ws = WSP(); int tid = F.tid; LAUNDER_V(tid); const int lane = tid & 63;
          const bf16* HB = (const bf16*)(ws + WS_HB); const float* rstd1 = (const float*)(ws + WS_RSTD1); const float* wfg = (const float*)(ws + WS_WFG);
          float* LFT = (float*)(ws + WS_LFT); float* LFTM = (float*)(ws + WS_LFTM); const float* bfg = INP(I_BF) + l * 8;
          LAS float* W = (LAS float*)lds;
          { f32x4 wv_[4];
#pragma unroll
            for (int j = 0; j < 4; ++j) wv_[j] = *(const f32x4*)(wfg + 4 * (tid + 512 * j));
#pragma unroll
            for (int j = 0; j < 4; ++j) *(LAS f32x4*)(W + 4 * (tid + 512 * j)) = wv_[j]; }
          __syncthreads();
          { u32x4 xw[8][2]; float rsv[8];
#pragma unroll
            for (int i8 = 0; i8 < 8; ++i8) { const int rr = wave + 8 * i8; const int row = row0 + (rr < nrows ? rr : 0);
#pragma unroll
                for (int j = 0; j < 2; ++j) xw[i8][j] = *(const u32x4*)(HB + (size_t)row * D + 8 * lane + 512 * j);
                rsv[i8] = rstd1[row]; }
#pragma unroll
            for (int i8 = 0; i8 < 8; ++i8) { const int rr = wave + 8 * i8; const int row = row0 + rr; float xv[16];
#pragma unroll
              for (int j = 0; j < 2; ++j) { const u32x4 w = xw[i8][j];
                xv[8 * j + 0] = bflo(w.x); xv[8 * j + 1] = bfhi(w.x); xv[8 * j + 2] = bflo(w.y); xv[8 * j + 3] = bfhi(w.y); xv[8 * j + 4] = bflo(w.z); xv[8 * j + 5] = bfhi(w.z); xv[8 * j + 6] = bflo(w.w); xv[8 * j + 7] = bfhi(w.w); }
              float mine = 0.f;
#pragma unroll
              for (int c = 0; c < 8; ++c) { float sm = 0.f;
#pragma unroll
                for (int j = 0; j < 2; ++j) { const f32x4 w0 = *(const LAS f32x4*)(W + c * 1024 + 8 * lane + 512 * j), w1 = *(const LAS f32x4*)(W + c * 1024 + 8 * lane + 512 * j + 4);
                    sm += xv[8 * j] * w0[0] + xv[8 * j + 1] * w0[1] + xv[8 * j + 2] * w0[2] + xv[8 * j + 3] * w0[3] + xv[8 * j + 4] * w1[0] + xv[8 * j + 5] * w1[1] + xv[8 * j + 6] * w1[2] + xv[8 * j + 7] * w1[3]; }
                sm = wave_sum(sm); if (lane == c) mine = sm; }
              if (lane < 8 && rr < nrows && row < TR) { const float xg = mine * rsv[i8] + bfg[lane]; const float lf = fminf(xg, 0.f) - 0.69314718056f * __builtin_amdgcn_logf(1.0f + __expf(-fabsf(xg)));
                if (isx) LFT[(size_t)(b * 8 + lane) * SEQ + t0 + rr] = lf; else LFTM[lane * 256 + t0 + rr] = lf; } } }
          __syncthreads(); }
        { unsigned char* ws = WSP(); int tid = F.tid; LAUNDER_V(tid);
          const bf16* Ab = (const bf16*)(ws + WS_A); bf16* DIFF = (bf16*)(ws + WS_X3);
          LAS unsigned char* T = lds;
          { u32x4 tv[5]; const int nld = (15 + nrows) * 32;
#pragma unroll
            for (int j = 0; j < 5; ++j) { const int i = tid + 512 * j; const int sl = i >> 5, ch = i & 31; const int r = i < nld ? srcrow(isx, b, t0 + sl - 15) : -1; unsigned z_ = 0u; LAUNDER_V(z_);
                tv[j] = r >= 0 ? *(const u32x4*)(Ab + (size_t)r * 256 + ch * 8) : (u32x4){z_, z_, z_, z_}; }
#pragma unroll
            for (int j = 0; j < 5; ++j) { const int i = tid + 512 * j; if (i < nld) *(LAS u32x4*)(T + (i >> 5) * 512 + (i & 31) * 16) = tv[j]; } }
          __syncthreads();
#pragma unroll 1
          for (int i = tid; i < nrows * 32; i += 512) { const int r = i >> 5, ch = i & 31, grp = ch >> 3, w = 2 << grp; const int cnt = isx ? w : min(t0 + r + 1, w);
              float s[8];
#pragma unroll
              for (int j = 0; j < 8; ++j) s[j] = 0.f;
#pragma unroll 1
              for (int d = 0; d < cnt; ++d) { const u32x4 v = *(const LAS u32x4*)(T + (15 + r - d) * 512 + ch * 16);
                  s[0] += bflo(v.x); s[1] += bfhi(v.x); s[2] += bflo(v.y); s[3] += bfhi(v.y); s[4] += bflo(v.z); s[5] += bfhi(v.z); s[6] += bflo(v.w); s[7] += bfhi(v.w); }
              const u32x4 a = *(const LAS u32x4*)(T + (15 + r) * 512 + ch * 16); const float ic = 1.0f / (float)cnt;
              u32x4 o; o.x = pk2(s[0] * ic - bflo(a.x), s[1] * ic - bfhi(a.x)); o.y = pk2(s[2] * ic - bflo(a.y), s[3] * ic - bfhi(a.y));
              o.z = pk2(s[4] * ic - bflo(a.z), s[5] * ic - bfhi(a.z)); o.w = pk2(s[6] * ic - bflo(a.w), s[7] * ic - bfhi(a.w));
              if (row0 + r < TR) *(u32x4*)(DIFF + (size_t)(row0 + r) * 1024 + ch * 8) = o; }
          __syncthreads(); }
        { unsigned char* ws = WSP(); int tid = F.tid; LAUNDER_V(tid);
          const bf16* GLU = (const bf16*)(ws + WS_GLU);
          LAS unsigned char* T = lds;
          LAS float* Yt = (LAS float*)(lds + 49152);
          { u32x4 tv[6]; const int nld = (isx ? 94 : 62) * 32;
#pragma unroll
            for (int j = 0; j < 6; ++j) { const int i = tid + 512 * j; const int sl = i >> 5, ch = i & 31; const int r = i < nld ? srcrow(isx, b, t0 + sl - 30) : -1; unsigned z_ = 0u; LAUNDER_V(z_);
                tv[j] = r >= 0 ? *(const u32x4*)(GLU + (size_t)r * 256 + ch * 8) : (u32x4){z_, z_, z_, z_}; }
#pragma unroll
            for (int j = 0; j < 6; ++j) { const int i = tid + 512 * j; if (i < nld) *(LAS u32x4*)(T + (i >> 5) * 512 + (i & 31) * 16) = tv[j]; } }
          __syncthreads();
          { const float* cw = INP(I_CW) + (size_t)l * 31 * 256; const float* cb = INP(I_CB) + l * 256;
            const int cp = tid & 127, strip = tid >> 7; f32x2 wv[31];
#pragma unroll
            for (int j = 0; j < 31; ++j) wv[j] = *(const f32x2*)(cw + j * 256 + 2 * cp);
            const f32x2 bias = *(const f32x2*)(cb + 2 * cp);
#pragma unroll 1
            for (int hh = 0; hh < (isx ? 2 : 1); ++hh) { const int rb = 32 * hh + 8 * strip; f32x2 acc[8];
#pragma unroll
                for (int r = 0; r < 8; ++r) acc[r] = bias;
#pragma unroll
                for (int i = 0; i < 38; ++i) { const unsigned xw = *(const LAS unsigned*)(T + (rb + i) * 512 + cp * 4); const f32x2 xx = {bflo(xw), bfhi(xw)};
#pragma unroll
                    for (int r = 0; r < 8; ++r) { const int j = i - r; if (j >= 0 && j <= 30) acc[r] += wv[j] * xx; } }
#pragma unroll
                for (int r = 0; r < 8; ++r) *(LAS f32x2*)(Yt + (rb + r) * 256 + 2 * cp) = acc[r]; } }
          __syncthreads();
          { unsigned char* ws2 = WSP(); int tid2 = F.tid; LAUNDER_V(tid2); const int lane = tid2 & 63;
            bf16* BP = (bf16*)(ws2 + WS_X3) + 256; const float* lng = INP(I_LNG) + l * 256; const float* lnb = INP(I_LNB) + l * 256;
            const f32x4 gg = *(const f32x4*)(lng + 4 * lane), bb = *(const f32x4*)(lnb + 4 * lane);
#pragma unroll 1
            for (int rr = wave; rr < nrows; rr += 8) { const f32x4 v = *(const LAS f32x4*)(Yt + rr * 256 + 4 * lane);
              const float mean = wave_sum(v[0] + v[1] + v[2] + v[3]) * (1.0f / 256.0f); const f32x4 dv = v - mean;
              const float var = wave_sum(dv[0] * dv[0] + dv[1] * dv[1] + dv[2] * dv[2] + dv[3] * dv[3]) * (1.0f / 256.0f); const float rs = rsqrtf(var + EPS);
              f32x4 o = dv * rs * gg + bb;
#pragma unroll
              for (int j = 0; j < 4; ++j) o[j] = o[j] * sigmoidf_(o[j]);
              u32x2 w; w.x = pk2(o[0], o[1]); w.y = pk2(o[2], o[3]); if (row0 + rr < TR) *(u32x2*)(BP + (size_t)(row0 + rr) * 1024 + 4 * lane) = w; } }
          __syncthreads(); }
    }
}

constexpr int AT_FL = 0, AT_K = 34816, AT_VT = AT_K + 8192, AT_SC = AT_VT + 8192;
__device__ __forceinline__ void attn_scan(Frame& F, int b, int h, bool meta_only, int fl_off, int sc_off) {
    LAS float* Fl = (LAS float*)(F.lds + fl_off); LAS float* sc = (LAS float*)(F.lds + sc_off);
    const float* LFT = (const float*)(WSP() + WS_LFT); const float* LFTM = (const float*)(WSP() + WS_LFTM);
    const int tid = F.tid, lane = F.lane, wave = F.wave;
    __syncthreads();
    if (tid == 0) { float s = 0.f; for (int m = 0; m < 64; ++m) { if (m < NMETA) { s += LFTM[h * 256 + m]; Fl[m] = s * LOG2E; } else Fl[m] = 1e30f; if (m == NMETA - 1) sc[16] = s; } }
    if (meta_only) { for (int i = tid; i < 256; i += 512) Fl[64 + i] = 0.f; __syncthreads(); return; }
    float v[16]; const float* src = LFT + (size_t)(b * 8 + h) * SEQ + 16 * tid;
#pragma unroll
    for (int j = 0; j < 4; ++j) { const f32x4 q = *(const f32x4*)(src + 4 * j); v[4 * j] = q[0]; v[4 * j + 1] = q[1]; v[4 * j + 2] = q[2]; v[4 * j + 3] = q[3]; }
#pragma unroll
    for (int j = 1; j < 16; ++j) v[j] += v[j - 1];
    float incl = v[15];
#pragma unroll
    for (int o = 1; o < 64; o <<= 1) { const float up = __int_as_float(__builtin_amdgcn_ds_bpermute((lane - o) << 2, __float_as_int(incl))); if (lane >= o) incl += up; }
    if (lane == 63) sc[wave] = incl;
    __syncthreads();
    float off = sc[16];
    for (int w = 0; w < wave; ++w) off += sc[w];
    off += incl - v[15];
#pragma unroll
    for (int j = 0; j < 16; ++j) Fl[64 + 16 * tid + j] = (off + v[j]) * LOG2E;
    __syncthreads();
}
__device__ __forceinline__ void attn_unit_naive(Frame& F, int qrow0, int qpos0, int ntiles, int kvx0, int h, int nq) {
    const int tid = F.tid; const int hf = tid & 1; const bool live = (tid >> 1) < nq; const int r = live ? (tid >> 1) : 0;
    const bf16* Q = (const bf16*)(DOP() + DO_Q); const bf16* Kg = (const bf16*)(DOP() + DO_K); const bf16* Vg = (const bf16*)(DOP() + DO_V); bf16* O = (bf16*)(WSP() + WS_X3) + 512;
    LAS float* Fl = (LAS float*)(F.lds + AT_FL); LAS unsigned char* Ks = F.lds + AT_K; LAS bf16* VT = (LAS bf16*)(F.lds + AT_VT);
    const int grow = qrow0 + r, qpos = qpos0 + r;
    unsigned qp[16];
#pragma unroll
    for (int j = 0; j < 4; ++j) { const u32x4 w = *(const u32x4*)(Q + (size_t)grow * 512 + h * 64 + hf * 32 + 8 * j); qp[4 * j] = w.x; qp[4 * j + 1] = w.y; qp[4 * j + 2] = w.z; qp[4 * j + 3] = w.w; }
    const float Fq = Fl[qpos < NMETA ? qpos : qpos + 48];
    float mrun = -1e30f, lrun = 0.f, o[32];
#pragma unroll
    for (int d = 0; d < 32; ++d) o[d] = 0.f;
    const int lrow = tid >> 3, lch = tid & 7;

#pragma unroll 1
for (int i = 0; i < ntiles; ++i) {
        const int krow = (i == 0 ? TX : kvx0 + 64 * (i - 1)) + lrow;
        const u32x4 kw = *(const u32x4*)(Kg + (size_t)krow * 512 + h * 64 + lch * 8);
        const u32x4 vw = *(const u32x4*)(Vg + (size_t)krow * 512 + h * 64 + lch * 8);
        __syncthreads();
        *(LAS u32x4*)(Ks + lrow * 128 + lch * 16) = kw;
        { const unsigned vv[4] = {vw.x, vw.y, vw.z, vw.w};
#pragma unroll
          for (int e = 0; e < 4; ++e) { VT[(lch * 8 + 2 * e) * 64 + lrow] = (bf16)(vv[e] & 0xffffu); VT[(lch * 8 + 2 * e + 1) * 64 + lrow] = (bf16)(vv[e] >> 16); } }
        __syncthreads();
        const int kp0 = i == 0 ? 0 : NMETA + 64 * (i - 1);
        if (kp0 > qpos0 + 255) continue;
#pragma unroll 1
        for (int jg = 0; jg < 4; ++jg) {
            float s[16]; float gmax = -1e30f;
#pragma unroll
            for (int jj = 0; jj < 16; ++jj) { const int j = jg * 16 + jj; float d = 0.f;
#pragma unroll
                for (int c = 0; c < 4; ++c) { const u32x4 kk = *(const LAS u32x4*)(Ks + j * 128 + hf * 64 + c * 16);
                    d = dot2bf(kk.x, qp[4 * c], d); d = dot2bf(kk.y, qp[4 * c + 1], d); d = dot2bf(kk.z, qp[4 * c + 2], d); d = dot2bf(kk.w, qp[4 * c + 3], d); }
                d += lane_xor<1>(d);
                const bool valid = (i == 0 ? j < NMETA : true) && (kp0 + j <= qpos);
                s[jj] = valid ? d + Fq - Fl[64 * i + j] : -1e30f; gmax = fmaxf(gmax, s[jj]); }
            const float mn = fmaxf(mrun, gmax), alpha = exp2f(mrun - mn); mrun = mn;
            float ps = 0.f; unsigned pp[8];
#pragma unroll
            for (int jj = 0; jj < 16; jj += 2) { const float p0 = exp2f(s[jj] - mn), p1 = exp2f(s[jj + 1] - mn); ps += p0 + p1; pp[jj >> 1] = pk2(p0, p1); }
            lrun = lrun * alpha + ps;
#pragma unroll
            for (int d = 0; d < 32; ++d) { const u32x4 v0 = *(const LAS u32x4*)(VT + (hf * 32 + d) * 64 + jg * 16), v1 = *(const LAS u32x4*)(VT + (hf * 32 + d) * 64 + jg * 16 + 8);
                float a = o[d] * alpha; a = dot2bf(pp[0], v0.x, a); a = dot2bf(pp[1], v0.y, a); a = dot2bf(pp[2], v0.z, a); a = dot2bf(pp[3], v0.w, a);
                a = dot2bf(pp[4], v1.x, a); a = dot2bf(pp[5], v1.y, a); a = dot2bf(pp[6], v1.z, a); a = dot2bf(pp[7], v1.w, a); o[d] = a; }
        }
    }
    const float il = 1.0f / lrun;
    if (live)
#pragma unroll
    for (int j = 0; j < 4; ++j) { u32x4 w; w.x = pk2(o[8 * j] * il, o[8 * j + 1] * il); w.y = pk2(o[8 * j + 2] * il, o[8 * j + 3] * il); w.z = pk2(o[8 * j + 4] * il, o[8 * j + 5] * il); w.w = pk2(o[8 * j + 6] * il, o[8 * j + 7] * il);
        *(u32x4*)(O + (size_t)grow * 1024 + h * 64 + hf * 32 + 8 * j) = w; }
}
namespace fa {
using bf16x8v = __attribute__((ext_vector_type(8))) short;
using s16x4 = __attribute__((ext_vector_type(4))) short;
using f32x16 = __attribute__((ext_vector_type(16))) float;
constexpr int DMA = 512, DMO = 1024;
constexpr int NW = 8, QBLK = 32, QB = 256, KVBLK = 64;
constexpr int NSLOT = 3, SLOTB = 8192;
constexpr int LDS_K = 0, LDS_V = NSLOT * SLOTB, LDS_WS = 2 * NSLOT * SLOTB, LDS_OST = LDS_WS + NW * 64 * 4, LDS_BYTES = LDS_OST + NW * 4096;
constexpr int LDS_FL = 84992;
constexpr int LDS_SCAN = LDS_FL + (64 + 8192) * 4;
static_assert(LDS_SCAN + 128 <= RING_BYTES, "attention LDS");
__device__ __forceinline__ int crow(int r, int hi) { return (r & 3) + 8 * (r >> 2) + 4 * hi; }
#define SBAR() __builtin_amdgcn_sched_barrier(0)
__device__ __forceinline__ void cmask(f32x16& p0, f32x16& p1, int jb, int qrel, int hi) {
    const float NEG = -INFINITY; int kb = 64 * jb + 4 * hi;
#pragma unroll
    for (int r = 0; r < 16; ++r) { int kv = kb + (r & 3) + 8 * (r >> 2); if (kv > qrel) p0[r] = NEG; if (kv + 32 > qrel) p1[r] = NEG; }
}
__device__ __forceinline__ void glds16(const void* gsrc, unsigned lds_dst) { unsigned keep;
    asm volatile("s_mov_b32 %0, m0\n\ts_mov_b32 m0, %2\n\ts_nop 0\n\tglobal_load_lds_dwordx4 %1, off\n\ts_mov_b32 m0, %0" : "=&s"(keep) : "v"(gsrc), "s"(lds_dst) : "memory"); }
__device__ __forceinline__ float max3f(float a, float b, float c) { float r; asm("v_max3_f32 %0, %1, %2, %3" : "=v"(r) : "v"(a), "v"(b), "v"(c)); return r; }
__device__ __forceinline__ float max2f(float a, float b) { float r; asm("v_max_f32_e32 %0, %1, %2" : "=v"(r) : "v"(a), "v"(b)); return r; }
__device__ __forceinline__ float fsub_s(float a, float b) { float r; asm("v_sub_f32_e32 %0, %1, %2" : "=v"(r) : "v"(a), "v"(b)); return r; }
typedef float f32x2_t __attribute__((ext_vector_type(2))); typedef __bf16 bf16x2_t __attribute__((ext_vector_type(2)));
__device__ __forceinline__ unsigned cvtpk_s(float lo, float hi) { f32x2_t v = {lo, hi}; bf16x2_t b = __builtin_convertvector(v, bf16x2_t); return __builtin_bit_cast(unsigned, b); }
#define WAIT_BAR(N) asm volatile("s_waitcnt vmcnt(" #N ") lgkmcnt(0)\n\ts_barrier" ::: "memory")
typedef __attribute__((address_space(3))) const char* lds_cptr;
typedef short v4i16_t __attribute__((ext_vector_type(4)));
__device__ __forceinline__ void cinit(f32x16& p0, f32x16& p1, const LAS float* fk, float a) {
#pragma unroll
    for (int g = 0; g < 4; ++g) { const f32x4 f0 = *(const LAS f32x4*)(fk + 8 * g), f1 = *(const LAS f32x4*)(fk + 32 + 8 * g);
#pragma unroll
        for (int i = 0; i < 4; ++i) { p0[4 * g + i] = a - f0[i]; p1[4 * g + i] = a - f1[i]; } }
}
__device__ __forceinline__ void qkt(f32x16& p0, f32x16& p1, const char* Kslot, const bf16x8v* qr, int r32, int hi) {
    const char* kb = Kslot + hi * 1024 + r32 * 16;
#pragma unroll
    for (int d0 = 0; d0 < 4; ++d0) {
        const bf16x8v b0 = *reinterpret_cast<const bf16x8v*>(kb + d0 * 2048);
        const bf16x8v b1 = *reinterpret_cast<const bf16x8v*>(kb + d0 * 2048 + 512);
        p0 = __builtin_amdgcn_mfma_f32_32x32x16_bf16(b0, qr[d0], p0, 0, 0, 0); p1 = __builtin_amdgcn_mfma_f32_32x32x16_bf16(b1, qr[d0], p1, 0, 0, 0); }
}
__device__ __forceinline__ void kload8(bf16x8v* kf, lds_cptr kp) {
    kf[0] = *(const LAS bf16x8v*)(kp);        kf[1] = *(const LAS bf16x8v*)(kp + 512);
    kf[2] = *(const LAS bf16x8v*)(kp + 2048); kf[3] = *(const LAS bf16x8v*)(kp + 2560);
    kf[4] = *(const LAS bf16x8v*)(kp + 4096); kf[5] = *(const LAS bf16x8v*)(kp + 4608);
    kf[6] = *(const LAS bf16x8v*)(kp + 6144); kf[7] = *(const LAS bf16x8v*)(kp + 6656);
}
__device__ __forceinline__ void kload2(bf16x8v* kf, lds_cptr kp, int j) { kf[2 * j] = *(const LAS bf16x8v*)(kp + j * 2048); kf[2 * j + 1] = *(const LAS bf16x8v*)(kp + j * 2048 + 512); }
__device__ __forceinline__ s16x4 vtr(lds_cptr p) { return __builtin_bit_cast(s16x4, __builtin_amdgcn_ds_read_tr16_b64_v4i16((LAS v4i16_t*)p)); }
__device__ __forceinline__ float rowmax(const f32x16& p0, const f32x16& p1) {
    float a = max3f(p0[0], p0[1], p1[0]), b = max3f(p0[2], p0[3], p1[1]); a = max3f(a, p1[2], p1[3]);
#pragma unroll
    for (int r = 4; r < 16; r += 4) { a = max3f(a, p0[r], p0[r + 1]); b = max3f(b, p0[r + 2], p0[r + 3]); a = max3f(a, p1[r], p1[r + 1]); b = max3f(b, p1[r + 2], p1[r + 3]); }
    const float m = max2f(a, b);
    auto rr = __builtin_amdgcn_permlane32_swap(__float_as_uint(m), __float_as_uint(m), false, false);
    return max2f(__uint_as_float(rr[0]), __uint_as_float(rr[1]));
}
__device__ __forceinline__ void pv(f32x16* o, int vb, bf16x8v pa0, bf16x8v pa1, bf16x8v pa2, bf16x8v pa3) {
#pragma unroll
    for (int d0 = 0; d0 < 2; ++d0) { s16x4 lo[4], hi[4];
#pragma unroll
        for (int ks = 0; ks < 4; ++ks) {
            asm volatile("ds_read_b64_tr_b16 %0,%1 offset:%c2" : "=&v"(lo[ks]) : "v"(vb), "i"(d0 * 4096 + ks * 1024) : "memory");
            asm volatile("ds_read_b64_tr_b16 %0,%1 offset:%c2" : "=&v"(hi[ks]) : "v"(vb), "i"(d0 * 4096 + ks * 1024 + 512) : "memory"); }
        asm volatile("s_waitcnt lgkmcnt(0)" ::: "memory"); SBAR();
#define PK(k) (bf16x8v){lo[k][0], lo[k][1], lo[k][2], lo[k][3], hi[k][0], hi[k][1], hi[k][2], hi[k][3]}
        o[d0] = __builtin_amdgcn_mfma_f32_32x32x16_bf16(pa0, PK(0), o[d0], 0, 0, 0);
        o[d0] = __builtin_amdgcn_mfma_f32_32x32x16_bf16(pa1, PK(1), o[d0], 0, 0, 0);
        o[d0] = __builtin_amdgcn_mfma_f32_32x32x16_bf16(pa2, PK(2), o[d0], 0, 0, 0);
        o[d0] = __builtin_amdgcn_mfma_f32_32x32x16_bf16(pa3, PK(3), o[d0], 0, 0, 0);
#undef PK
    }
}
template <int THRL> __device__ __forceinline__ void attn_unit(int b, int h, int qb, const bf16* Q, const bf16* __restrict__ K, const bf16* __restrict__ V, bf16* O, char* shm, int wid) {
    const int lane = lane_id_opaque(), r32 = lane & 31, hi = lane >> 5;
    const long rowbase = (long)b * SEQ; const int q0 = qb * QB;
    const bf16* Qw = Q + (rowbase + q0 + wid * QBLK) * DMA + h * 64;
    const bf16* Kh = K + rowbase * DMA + h * 64, *Vh = V + rowbase * DMA + h * 64;
    const bf16* Km = K + (long)TX * DMA + h * 64, *Vm = V + (long)TX * DMA + h * 64;
    const unsigned lds0 = (unsigned)(uintptr_t)shm;
    float* wsf = (float*)(shm + LDS_WS) + wid * 64;
    const bf16* ksrc = Kh + (long)lane * DMA + wid * 8;
    const bf16* vsrc = Vh + (long)(16 * (wid & 3) + (lane >> 2)) * DMA + (wid >> 2) * 32 + (lane & 3) * 8;
    const bf16* ksrcm = Km + (long)lane * DMA + wid * 8;
    const bf16* vsrcm = Vm + (long)(16 * (wid & 3) + (lane >> 2)) * DMA + (wid >> 2) * 32 + (lane & 3) * 8;
    const unsigned kdst = lds0 + LDS_K + wid * 1024, vdst = lds0 + LDS_V + wid * 1024;
#define DMA_K(t, slot) glds16(ksrc + (long)((t) - 1) * KVBLK * DMA, (unsigned)__builtin_amdgcn_readfirstlane(kdst + (slot)))
#define DMA_V(t, slot) glds16(vsrc + (long)((t) - 1) * KVBLK * DMA, (unsigned)__builtin_amdgcn_readfirstlane(vdst + (slot)))
    const int vb0 = (int)(lds0 + LDS_V) + ((lane >> 4) & 1) * 32 + (lane & 3) * 8 + (4 * hi + ((lane & 15) >> 2)) * 64;
    const char* Kbase = shm + LDS_K; bf16x8v kf[8];
    const lds_cptr shm3 = (lds_cptr)shm; const lds_cptr kp0 = shm3 + LDS_K + hi * 1024 + r32 * 16; const lds_cptr vp0 = shm3 + LDS_V + ((lane >> 4) & 1) * 32 + (lane & 3) * 8 + (4 * hi + ((lane & 15) >> 2)) * 64;
    const LAS float* Flp = (const LAS float*)(shm3 + LDS_FL) + 4 * hi;
    const int NT = 4 * qb + 5;
    glds16(ksrcm, (unsigned)__builtin_amdgcn_readfirstlane(kdst)); glds16(vsrcm, (unsigned)__builtin_amdgcn_readfirstlane(vdst)); DMA_K(1, SLOTB);
    bf16x8v qr[4];
#pragma unroll
    for (int d0 = 0; d0 < 4; ++d0) qr[d0] = *reinterpret_cast<const bf16x8v*>(&Qw[(long)r32 * DMA + d0 * 16 + hi * 8]);
    float aq = ((const LAS float*)(shm3 + LDS_FL))[64 + q0 + wid * QBLK + r32];
    float l_reg = 0.f; f32x16 o[2]; o[0] = f32x16{}; o[1] = f32x16{};
    const int qrel = wid * QBLK + r32;
#define CMASK(P0, P1, t) do { int jb_ = (t) - (NT - 4); if (jb_ >= 0) cmask(P0, P1, jb_, qrel, hi); } while (0)
    bool resc = false;
#define START(P0, P1) do { const float rm = rowmax(P0, P1); resc = false; \
    { const float dl = max2f(rm, 0.f); aq = fsub_s(aq, dl);        \
      _Pragma("unroll") for (int r = 0; r < 16; ++r) { P0[r] = fsub_s(P0[r], dl); P1[r] = fsub_s(P1[r], dl); } } \
    _Pragma("unroll") for (int r = 0; r < 16; ++r) P0[r] = __builtin_amdgcn_exp2f(P0[r]); } while (0)
#define RESC() do { if (resc) { asm volatile("s_waitcnt lgkmcnt(0)" ::: "memory"); \
      _Pragma("unroll") for (int d_ = 0; d_ < 2; ++d_) _Pragma("unroll") for (int r = 0; r < 16; ++r) o[d_][r] *= wsf[crow(r, hi)]; } } while (0)
    f32x16 pA0, pA1, pB0, pB1;
    int sl_prev = 0, sl_cur = 0, sl_next = SLOTB;
#define ROT() do { sl_prev = sl_cur; sl_cur = sl_next; sl_next = (sl_next == (NSLOT - 1) * SLOTB) ? 0 : sl_next + SLOTB; } while (0)
    DMA_K(2, 2 * SLOTB);
    cinit(pA0, pA1, Flp, aq);
    WAIT_BAR(3);
    qkt(pA0, pA1, Kbase, qr, r32, hi); asm volatile("s_nop 15\n\ts_nop 7" : "+v"(pA0), "+v"(pA1));
    START(pA0, pA1);
    _Pragma("unroll") for (int r = 0; r < 16; ++r) pA1[r] = __builtin_amdgcn_exp2f(pA1[r]);
    WAIT_BAR(0);
    DMA_K(3, 0); DMA_V(1, SLOTB);
    ROT();
    kload8(kf, kp0 + sl_cur);
    WAIT_BAR(2);
    s16x4 vlo[8], vhi[8]; u32x4 pw0, pw1, pw2, pw3;
#define PKW(P, B) cvtpk_s(P[B], P[B + 1])
#define PAF(k) __builtin_bit_cast(bf16x8v, pw##k)
#define VFR(i) (bf16x8v){vlo[i][0], vlo[i][1], vlo[i][2], vlo[i][3], vhi[i][0], vhi[i][1], vhi[i][2], vhi[i][3]}
#define PIN(x) asm volatile("" : "+v"(x))
#define MX3(a, b, c) __builtin_fmaxf(__builtin_fmaxf((a), (b)), (c))
#define GAPA(MF, A0, A1, A2, A3, W0, W1, PW) do { MF; sacc += A0; sacc += A1; sacc += A2; sacc += A3; PIN(sacc); W0; W1; PIN(PW); SBAR(); } while (0)
#define EX(v) __builtin_amdgcn_exp2f(v)
#define GAPB(MF, X, B) do { MF; X[B] = EX(X[B]); X[B + 1] = EX(X[B + 1]); X[B + 2] = EX(X[B + 2]); X[B + 3] = EX(X[B + 3]); PIN(X); SBAR(); } while (0)
#define VRD(i) do { vlo[i] = vtr(vp_ + (((i) >> 2) * 4096 + ((i) & 3) * 1024)); vhi[i] = vtr(vp_ + (((i) >> 2) * 4096 + ((i) & 3) * 1024 + 512)); } while (0)
#define KRD(G, j) do { if (G) { kload2(kf, kp0 + sl_next, j); SBAR(); } } while (0)
#define STEP(C0, C1, P0, P1, t, GK, GV, GL) do { SBAR(); \
    cinit(C0, C1, Flp + 64 * (t), aq); SBAR(); \
    const lds_cptr vp_ = vp0 + sl_prev; \
    VRD(0); SBAR(); float sacc = (P0[0] + P0[1]); \
    GAPA(C0 = __builtin_amdgcn_mfma_f32_32x32x16_bf16(kf[0], qr[0], C0, 0, 0, 0), P0[2], P0[3], P0[4], P0[5],     pw0[0] = PKW(P0, 0), pw0[1] = PKW(P0, 2), pw0); \
    VRD(4); SBAR(); GAPA(C1 = __builtin_amdgcn_mfma_f32_32x32x16_bf16(kf[1], qr[0], C1, 0, 0, 0), P0[6], P0[7], P0[8], P0[9],     pw0[2] = PKW(P0, 4), pw0[3] = PKW(P0, 6), pw0); \
    VRD(1); SBAR(); GAPA(C0 = __builtin_amdgcn_mfma_f32_32x32x16_bf16(kf[2], qr[1], C0, 0, 0, 0),   P0[10], P0[11], P0[12], P0[13], pw1[0] = PKW(P0, 8), pw1[1] = PKW(P0, 10), pw1); \
    VRD(5); SBAR(); GAPA(C1 = __builtin_amdgcn_mfma_f32_32x32x16_bf16(kf[3], qr[1], C1, 0, 0, 0),   P0[14], P0[15], P1[0], P1[1],   pw1[2] = PKW(P0, 12), pw1[3] = PKW(P0, 14), pw1); \
    VRD(2); SBAR(); GAPA(C0 = __builtin_amdgcn_mfma_f32_32x32x16_bf16(kf[4], qr[2], C0, 0, 0, 0),   P1[2], P1[3], P1[4], P1[5],     pw2[0] = PKW(P1, 0), pw2[1] = PKW(P1, 2), pw2); \
    VRD(6); SBAR(); GAPA(C1 = __builtin_amdgcn_mfma_f32_32x32x16_bf16(kf[5], qr[2], C1, 0, 0, 0),   P1[6], P1[7], P1[8], P1[9],     pw2[2] = PKW(P1, 4), pw2[3] = PKW(P1, 6), pw2); \
    VRD(3); SBAR(); GAPA(C0 = __builtin_amdgcn_mfma_f32_32x32x16_bf16(kf[6], qr[3], C0, 0, 0, 0),   P1[10], P1[11], P1[12], P1[13], pw3[0] = PKW(P1, 8), pw3[1] = PKW(P1, 10), pw3); \
    VRD(7); SBAR(); GAPA(C1 = __builtin_amdgcn_mfma_f32_32x32x16_bf16(kf[7], qr[3], C1, 0, 0, 0),   P1[14], P1[15], 0.f, 0.f,       pw3[2] = PKW(P1, 12), pw3[3] = PKW(P1, 14), pw3); \
    l_reg += sacc; \
    if (GK) { DMA_K((t) + 3, sl_cur); } if (GV) { DMA_V((t) + 1, sl_next); } \
    CMASK(C0, C1, t); \
    { float a = MX3(C0[0], C0[1], C1[0]), b_ = MX3(C0[2], C0[3], C1[1]); a = MX3(a, C1[2], C1[3]); \
      _Pragma("unroll") for (int r = 4; r < 16; r += 4) { a = MX3(a, C0[r], C0[r + 1]); b_ = MX3(b_, C0[r + 2], C0[r + 3]); a = MX3(a, C1[r], C1[r + 1]); b_ = MX3(b_, C1[r + 2], C1[r + 3]); } \
      float rm = __builtin_fmaxf(a, b_); { auto rr = __builtin_amdgcn_permlane32_swap(__float_as_uint(rm), __float_as_uint(rm), false, false); rm = __builtin_fmaxf(__uint_as_float(rr[0]), __uint_as_float(rr[1])); } \
      resc = false; \
      if (__builtin_expect(__any(rm > (float)THRL), 0)) { const float dl = __builtin_fmaxf(rm, 0.f); aq -= dl; \
        _Pragma("unroll") for (int r = 0; r < 16; ++r) { C0[r] -= dl; C1[r] -= dl; } \
        const float f = __builtin_amdgcn_exp2f(-dl); l_reg *= f; if (hi == 0) wsf[r32] = f; resc = true; } } \
    SBAR(); \
    GAPB(o[0] = __builtin_amdgcn_mfma_f32_32x32x16_bf16(PAF(0), VFR(0), o[0], 0, 0, 0), C0, 0); \
    GAPB(o[1] = __builtin_amdgcn_mfma_f32_32x32x16_bf16(PAF(0), VFR(4), o[1], 0, 0, 0), C0, 4); \
    KRD(GL, 0); GAPB(o[0] = __builtin_amdgcn_mfma_f32_32x32x16_bf16(PAF(1), VFR(1), o[0], 0, 0, 0), C0, 8); \
    KRD(GL, 1); GAPB(o[1] = __builtin_amdgcn_mfma_f32_32x32x16_bf16(PAF(1), VFR(5), o[1], 0, 0, 0), C0, 12); \
    KRD(GL, 2); GAPB(o[0] = __builtin_amdgcn_mfma_f32_32x32x16_bf16(PAF(2), VFR(2), o[0], 0, 0, 0), C1, 0); \
    KRD(GL, 3); GAPB(o[1] = __builtin_amdgcn_mfma_f32_32x32x16_bf16(PAF(2), VFR(6), o[1], 0, 0, 0), C1, 4); \
    GAPB(o[0] = __builtin_amdgcn_mfma_f32_32x32x16_bf16(PAF(3), VFR(3), o[0], 0, 0, 0), C1, 8); \
    GAPB(o[1] = __builtin_amdgcn_mfma_f32_32x32x16_bf16(PAF(3), VFR(7), o[1], 0, 0, 0), C1, 12); \
    } while (0)
    int t = 1;
#undef CMASK
#define CMASK(P0, P1, t) do { } while (0)
    for (; t + 5 < NT; t += 2) {
        STEP(pB0, pB1, pA0, pA1, t, true, true, true);     WAIT_BAR(2); RESC(); ROT();
        STEP(pA0, pA1, pB0, pB1, t + 1, true, true, true); WAIT_BAR(2); RESC(); ROT();
    }
#undef CMASK
#define CMASK(P0, P1, t) do { int jb_ = (t) - (NT - 4); if (jb_ >= 0) cmask(P0, P1, jb_, qrel, hi); } while (0)
#define ENDW(tt) do { if ((tt) + 3 < NT) { WAIT_BAR(2); } else if ((tt) + 2 < NT) { WAIT_BAR(1); } else { WAIT_BAR(0); } } while (0)
    for (; t + 1 < NT; t += 2) {
        STEP(pB0, pB1, pA0, pA1, t, (t + 3 < NT), (t + 1 < NT), (t + 1 < NT));         ENDW(t);     RESC(); ROT();
        STEP(pA0, pA1, pB0, pB1, t + 1, (t + 4 < NT), (t + 2 < NT), (t + 2 < NT));     ENDW(t + 1); RESC(); ROT();
    }
    { float sacc = pA0[0] + pA0[1]; _Pragma("unroll") for (int r = 2; r < 16; ++r) sacc += pA0[r]; _Pragma("unroll") for (int r = 0; r < 16; ++r) sacc += pA1[r]; l_reg += sacc;
      pw0 = (u32x4){PKW(pA0, 0), PKW(pA0, 2), PKW(pA0, 4), PKW(pA0, 6)}; pw1 = (u32x4){PKW(pA0, 8), PKW(pA0, 10), PKW(pA0, 12), PKW(pA0, 14)}; pw2 = (u32x4){PKW(pA1, 0), PKW(pA1, 2), PKW(pA1, 4), PKW(pA1, 6)}; pw3 = (u32x4){PKW(pA1, 8), PKW(pA1, 10), PKW(pA1, 12), PKW(pA1, 14)};
      SBAR(); pv(o, vb0 + sl_prev, PAF(0), PAF(1), PAF(2), PAF(3)); }
#undef PKW
#undef PAF
#undef VFR
#undef PIN
#undef MX3
#undef GAPA
#undef GAPB
#undef EX
#undef VRD
#undef KRD
#undef STEP
#undef ENDW
    { auto rr = __builtin_amdgcn_permlane32_swap(__float_as_uint(l_reg), __float_as_uint(l_reg), false, false); l_reg = __uint_as_float(rr[0]) + __uint_as_float(rr[1]); }
    if (hi == 0) wsf[32 + r32] = l_reg; asm volatile("s_waitcnt lgkmcnt(0)" ::: "memory");
    float rli[16];
#pragma unroll
    for (int r = 0; r < 16; ++r) rli[r] = __builtin_amdgcn_rcpf(wsf[32 + crow(r, hi)]);
    bf16* Ow = O + (rowbase + q0 + wid * QBLK) * DMO + h * 64;
    { bf16* stg = (bf16*)(shm + LDS_OST) + wid * 2048;
#pragma unroll
      for (int r = 0; r < 16; ++r) { const int orow = crow(r, hi);
#pragma unroll
          for (int d0 = 0; d0 < 2; ++d0) stg[orow * 64 + d0 * 32 + r32] = (bf16)f2bf(o[d0][r] * rli[r]); }
      asm volatile("s_waitcnt lgkmcnt(0)" ::: "memory");
#pragma unroll
      for (int i = 0; i < 4; ++i) { const int row = i * 8 + (lane >> 3), ch = lane & 7; const u32x4 v = *(const u32x4*)(stg + row * 64 + ch * 8); *(u32x4*)(Ow + (long)row * DMO + ch * 8) = v; } }
    asm volatile("s_waitcnt lgkmcnt(0)\n\ts_barrier" ::: "memory");
#undef DMA_K
#undef DMA_V
#undef CMASK
#undef START
#undef RESC
#undef ROT
}
#undef SBAR
#undef WAIT_BAR
}
__device__ __forceinline__ void phase_B(Frame& F) {
    if (F.G == 256) {
        const int v = F.vcu, bh = v >> 3, s = v & 7, b = bh >> 3, h = bh & 7;
        attn_scan(F, b, h, false, fa::LDS_FL, fa::LDS_SCAN);
        { unsigned char* dol = DOP(); const bf16* Q = (const bf16*)(dol + DO_Q); const bf16* Kg = (const bf16*)(dol + DO_K); const bf16* Vg = (const bf16*)(dol + DO_V);
#pragma unroll 1
          for (int i = 0; i < 4; ++i) { const int qb = i == 0 ? s : (i == 1 ? 15 - s : (i == 2 ? 16 + s : 31 - s));
              fa::attn_unit<8>(b, h, qb, Q, Kg, Vg, (bf16*)(WSP() + WS_X3) + 512, (char*)F.lds, F.wave); } }
        if (v < 8) { attn_scan(F, 0, v, true, AT_FL, AT_SC); attn_unit_naive(F, TX, 0, 1, 0, v, NMETA); }
    } else {
        int cur_bh = -1;
        for (int u = F.vcu; u < 1032; u += F.G) {
            if (u < 1024) { const int bh = u >> 5, qb = u & 31, b = bh >> 3, h = bh & 7; if (bh != cur_bh) { attn_scan(F, b, h, false, AT_FL, AT_SC); cur_bh = bh; }
                attn_unit_naive(F, b * SEQ + 256 * qb, NMETA + 256 * qb, 1 + 4 * (qb + 1), b * SEQ, h, 256); }
            else { attn_scan(F, 0, u - 1024, true, AT_FL, AT_SC); cur_bh = -1; attn_unit_naive(F, TX, 0, 1, 0, u - 1024, NMETA); }
        }
    }
    __syncthreads();
}

__device__ __forceinline__ void class_tables(Frame& F, int l) {
    LAS int* base = (LAS int*)(F.lds + LC_BASE); LAS int* pcls = (LAS int*)(F.lds + LC_PCLS); LAS int* np = (LAS int*)(F.lds + LC_NP);
    const unsigned* gcnt = (const unsigned*)(WSP() + WS_CTL) + CW_GCNT + l * 64;
    __syncthreads();
    if (F.tid == 0) { int p = 0;
#pragma unroll 1
        for (int c = 0; c < NCLS; ++c) { base[c] = p * 256; int n = (int)__hip_atomic_load(gcnt + c, __ATOMIC_RELAXED, __HIP_MEMORY_SCOPE_AGENT); if (n > TR) n = TR; if (n < 0) n = 0; p += (n + 255) >> 8; }
        if (p > 160) p = 160; base[NCLS] = p * 256; np[0] = p; }
    __syncthreads();
    if (F.tid < 160) { const int mypos = F.tid * 256; int c = 0;
#pragma unroll 1
        for (int k = 1; k < NCLS; ++k) if (base[k] <= mypos) c = k;
        pcls[F.tid] = c; }
    __syncthreads();
}
constexpr int RPITCH = 1032;
__device__ __forceinline__ void phase_E1(Frame& F, int l) {
    LAS bf16* Rhi = (LAS bf16*)F.lds; LAS bf16* Rlo = Rhi + 20 * RPITCH;
    LAS int* rec = (LAS int*)(F.lds + 83968);
    LAS int* lcnt = (LAS int*)(F.lds + LC_CNT); LAS int* wgb = (LAS int*)(F.lds + LC_BASE);
    const float* rg = (const float*)(WSP() + WS_RG);
    const float* reb = INP(I_REB) + l * 16; const float* rgb = INP(I_RGB) + l * 4;
    unsigned* gcnt = (unsigned*)(WSP() + WS_CTL) + CW_GCNT + l * 64; int* route = (int*)(WSP() + WS_ROUTE);
    const int tid = F.tid, lane = F.lane, wave = F.wave, fr = lane & 15, fq = lane >> 4;
    { f32x4 rv[10];
#pragma unroll
      for (int j = 0; j < 10; ++j) rv[j] = *(const f32x4*)(rg + 4 * (tid + 512 * j));
#pragma unroll
      for (int j = 0; j < 10; ++j) { const int i = 4 * (tid + 512 * j), c = i >> 10, k = i & 1023; u32x2 hw, lw; float hf[4];
#pragma unroll
          for (int e = 0; e < 4; ++e) hf[e] = __builtin_bit_cast(float, (pk2(rv[j][e], 0.f) & 0xffffu) << 16);
          hw.x = pk2(rv[j][0], rv[j][1]); hw.y = pk2(rv[j][2], rv[j][3]); lw.x = pk2(rv[j][0] - hf[0], rv[j][1] - hf[1]); lw.y = pk2(rv[j][2] - hf[2], rv[j][3] - hf[3]);
          *(LAS u32x2*)(Rhi + c * RPITCH + k) = hw; *(LAS u32x2*)(Rlo + c * RPITCH + k) = lw; } }
#pragma unroll 1
    for (int wg = F.vcu; wg < 256; wg += F.G) {
        if (tid < NCLS) lcnt[tid] = 0;
        __syncthreads();
        const int ngrp = wg == 0 ? 9 : 8;
#pragma unroll 1
        for (int grp = wave; grp < ngrp; grp += 8) {
            const int row = grp < 8 ? wg * 128 + grp * 16 + fr : TX + fr;
            const float* hsrc = l == 0 ? (row < TX ? INP(I_X) + (size_t)row * D : INP(I_META) + (size_t)(row - TX) * D) : (const float*)(WSP() + WS_H) + (size_t)row * D;
            float* hdst = (float*)(WSP() + WS_H) + (size_t)row * D; bf16* hbdst = (bf16*)(WSP() + WS_HB) + (size_t)row * D; const bf16* dsrc = (const bf16*)(WSP() + WS_X3) + (size_t)row * D;
            const LAS bf16* bh0 = Rhi + fr * RPITCH + 8 * fq; const LAS bf16* bl0 = Rlo + fr * RPITCH + 8 * fq;
            const LAS bf16* bh1 = Rhi + (16 + (fr & 3)) * RPITCH + 8 * fq; const LAS bf16* bl1 = Rlo + (16 + (fr & 3)) * RPITCH + 8 * fq;
            f32x4 acc0 = {0.f, 0.f, 0.f, 0.f}, acc1 = {0.f, 0.f, 0.f, 0.f}; float ss = 0.f;
#pragma unroll 8
            for (int s = 0; s < 32; ++s) { const int k = 32 * s + 8 * fq;
                f32x4 h0 = *(const f32x4*)(hsrc + k), h1 = *(const f32x4*)(hsrc + k + 4); const u32x4 dv = *(const u32x4*)(dsrc + k);
                h0[0] += bflo(dv.x); h0[1] += bfhi(dv.x); h0[2] += bflo(dv.y); h0[3] += bfhi(dv.y); h1[0] += bflo(dv.z); h1[1] += bfhi(dv.z); h1[2] += bflo(dv.w); h1[3] += bfhi(dv.w);
                ss += (h0[0] * h0[0] + h0[1] * h0[1]) + (h0[2] * h0[2] + h0[3] * h0[3]) + (h1[0] * h1[0] + h1[1] * h1[1]) + (h1[2] * h1[2] + h1[3] * h1[3]);
                *(f32x4*)(hdst + k) = h0; *(f32x4*)(hdst + k + 4) = h1;
                const u32x4 hw = pack8(h0, h1); *(u32x4*)(hbdst + k) = hw;
                f32x4 r0, r1; r0[0] = h0[0] - bflo(hw.x); r0[1] = h0[1] - bfhi(hw.x); r0[2] = h0[2] - bflo(hw.y); r0[3] = h0[3] - bfhi(hw.y);
                r1[0] = h1[0] - bflo(hw.z); r1[1] = h1[1] - bfhi(hw.z); r1[2] = h1[2] - bflo(hw.w); r1[3] = h1[3] - bfhi(hw.w);
                const u32x4 lw = pack8(r0, r1);
                const bf16x8 ah = __builtin_bit_cast(bf16x8, hw), al = __builtin_bit_cast(bf16x8, lw);
                const bf16x8 wh0 = *(const LAS bf16x8*)(bh0 + 32 * s), wl0 = *(const LAS bf16x8*)(bl0 + 32 * s);
                bf16x8 wh1 = *(const LAS bf16x8*)(bh1 + 32 * s), wl1 = *(const LAS bf16x8*)(bl1 + 32 * s);
                if (fr >= 4) { wh1 = (bf16x8){0, 0, 0, 0, 0, 0, 0, 0}; wl1 = wh1; }
                acc0 = __builtin_amdgcn_mfma_f32_16x16x32_bf16(wh0, ah, acc0, 0, 0, 0); acc0 = __builtin_amdgcn_mfma_f32_16x16x32_bf16(wh0, al, acc0, 0, 0, 0); acc0 = __builtin_amdgcn_mfma_f32_16x16x32_bf16(wl0, ah, acc0, 0, 0, 0);
                acc1 = __builtin_amdgcn_mfma_f32_16x16x32_bf16(wh1, ah, acc1, 0, 0, 0); acc1 = __builtin_amdgcn_mfma_f32_16x16x32_bf16(wh1, al, acc1, 0, 0, 0); acc1 = __builtin_amdgcn_mfma_f32_16x16x32_bf16(wl1, ah, acc1, 0, 0, 0);
            }
            ss += lane_xor<16>(ss); ss += lane_xor<32>(ss);
            const float rstd2 = rsqrtf(ss * (1.0f / D) + EPS);
            float gl[4];
#pragma unroll
            for (int g = 0; g < 4; ++g) gl[g] = __int_as_float(__builtin_amdgcn_ds_bpermute(fr << 2, __float_as_int(acc1[g]))) * rstd2 + rgb[g];
            int gsel = 0; float gmax = gl[0];
#pragma unroll
            for (int g = 1; g < 4; ++g) if (gl[g] > gmax) { gmax = gl[g]; gsel = g; }
            float gsum = 0.f;
#pragma unroll
            for (int g = 0; g < 4; ++g) gsum += __expf(gl[g] - gmax);
            const float gwt = 1.0f / gsum;
            if (fq == gsel) {
                float el[4];
#pragma unroll
                for (int e = 0; e < 4; ++e) el[e] = acc0[e] * rstd2 + reb[gsel * 4 + e];
                int t1 = 0; float l1 = el[0];
#pragma unroll
                for (int e = 1; e < 4; ++e) if (el[e] > l1) { l1 = el[e]; t1 = e; }
                int t2 = -1; float l2 = -3.0e38f;
#pragma unroll
                for (int e = 0; e < 4; ++e) if (e != t1 && el[e] > l2) { l2 = el[e]; t2 = e; }
                const float w1 = 1.0f / (1.0f + __expf(l2 - l1)), w2 = 1.0f - w1;
                const int ea = min(t1, t2), eb = max(t1, t2); const float cA = gwt * (t1 == ea ? w1 : w2), cB = gwt * (t1 == ea ? w2 : w1);
                const int pr = ea == 0 ? eb - 1 : (ea == 1 ? eb + 1 : 5); int cls = gsel * 6 + pr; if (!(cls >= 0 && cls < NCLS)) cls = 0;
                const int rank = __hip_atomic_fetch_add(&lcnt[cls], 1, __ATOMIC_RELAXED, __HIP_MEMORY_SCOPE_WORKGROUP); const int rr = grp * 16 + fr;
                rec[rr * 5] = cls; rec[rr * 5 + 1] = rank; rec[rr * 5 + 2] = __float_as_int(cA); rec[rr * 5 + 3] = __float_as_int(cB); rec[rr * 5 + 4] = __float_as_int(rstd2);
            }
        }
        __syncthreads();
        if (tid < NCLS) { const int n = lcnt[tid]; wgb[tid] = n > 0 ? (int)atomicAdd(gcnt + tid, (unsigned)n) : 0; }
        __syncthreads();
        const int nrw = ngrp * 16;
        for (int rr = tid; rr < nrw; rr += 512) { const int row = rr < 128 ? wg * 128 + rr : TX + (rr - 128); const int cls = rec[rr * 5];
            int* rp = route + (size_t)row * 8; rp[0] = cls; rp[1] = wgb[cls] + rec[rr * 5 + 1]; rp[2] = rec[rr * 5 + 2]; rp[3] = rec[rr * 5 + 3]; rp[4] = rec[rr * 5 + 4]; }
        __syncthreads();
    }
}
__device__ __forceinline__ void phase_E1b(Frame& F, int l) {
    class_tables(F, l);
    const LAS int* base = (const LAS int*)(F.lds + LC_BASE);
    const int* route = (const int*)(WSP() + WS_ROUTE); const bf16* HB = (const bf16*)(WSP() + WS_HB); bf16* XS = (bf16*)(WSP() + WS_XS); float* PW = (float*)(WSP() + WS_PW);
    const int gw = F.vcu * NWAVES + F.wave, NGW = F.G * NWAVES, lane = F.lane;
    constexpr int R = 4;
#pragma unroll 1
    for (int row0 = gw; row0 < TR; row0 += R * NGW) {
        int rowv[R], pos[R]; u32x4 hw[R][2];
#pragma unroll
        for (int r = 0; r < R; ++r) { const int row = row0 + r * NGW; rowv[r] = row < TR ? row : TR - 1; const int* rp = route + (size_t)rowv[r] * 8; pos[r] = base[rp[0]] + rp[1];
#pragma unroll
            for (int j = 0; j < 2; ++j) hw[r][j] = *(const u32x4*)(HB + (size_t)rowv[r] * D + 8 * lane + 512 * j); }
#pragma unroll
        for (int r = 0; r < R; ++r) { const int row = row0 + r * NGW; if (row >= TR || pos[r] < 0 || pos[r] >= NPOSMAX) continue;
#pragma unroll
            for (int j = 0; j < 2; ++j) *(u32x4*)(XS + (size_t)pos[r] * D + 8 * lane + 512 * j) = hw[r][j];
            if (lane == 0) { const int* rp = route + (size_t)row * 8; f32x4 w; w[0] = __int_as_float(rp[4]); w[1] = __int_as_float(rp[2]); w[2] = __int_as_float(rp[3]); w[3] = 0.f; *(f32x4*)(PW + (size_t)pos[r] * 4) = w; } }
    }
}
__device__ __forceinline__ void phase_E4(Frame& F, int l) {
    class_tables(F, l);
    const LAS int* base = (const LAS int*)(F.lds + LC_BASE);
    const int* route = (const int*)(WSP() + WS_ROUTE); float* H = (float*)(WSP() + WS_H); bf16* HB = (bf16*)(WSP() + WS_HB); const bf16* Y = (const bf16*)(WSP() + WS_Y);
    float* rstd1 = (float*)(WSP() + WS_RSTD1); const float* fg = INP(I_FG); float* out = (float*)DOP();
    const int gw = F.vcu * NWAVES + F.wave, NGW = F.G * NWAVES, lane = F.lane; const bool lastl = (l == DEPTH - 1);
    constexpr int R = 4;
#pragma unroll 1
    for (int row0 = gw; row0 < TR; row0 += R * NGW) {
        int rowv[R], pos[R];
#pragma unroll
        for (int r = 0; r < R; ++r) { const int row = row0 + r * NGW; rowv[r] = row < TR ? row : TR - 1; const int* rp = route + (size_t)rowv[r] * 8; int p = base[rp[0]] + rp[1]; if (p < 0 || p >= NPOSMAX) p = 0; pos[r] = p; }
        u32x4 yw[R][2]; f32x4 hv[R][2][2];
#pragma unroll
        for (int r = 0; r < R; ++r)
#pragma unroll
            for (int j = 0; j < 2; ++j) { yw[r][j] = *(const u32x4*)(Y + (size_t)pos[r] * D + 8 * lane + 512 * j);
                hv[r][j][0] = *(const f32x4*)(H + (size_t)rowv[r] * D + 8 * lane + 512 * j); hv[r][j][1] = *(const f32x4*)(H + (size_t)rowv[r] * D + 8 * lane + 512 * j + 4); }
#pragma unroll
        for (int r = 0; r < R; ++r) { const int row = row0 + r * NGW; float ss = 0.f;
#pragma unroll
            for (int j = 0; j < 2; ++j) { const u32x4 w = yw[r][j];
                hv[r][j][0][0] += bflo(w.x); hv[r][j][0][1] += bfhi(w.x); hv[r][j][0][2] += bflo(w.y); hv[r][j][0][3] += bfhi(w.y);
                hv[r][j][1][0] += bflo(w.z); hv[r][j][1][1] += bfhi(w.z); hv[r][j][1][2] += bflo(w.w); hv[r][j][1][3] += bfhi(w.w);
#pragma unroll
                for (int q = 0; q < 2; ++q) ss += hv[r][j][q][0] * hv[r][j][q][0] + hv[r][j][q][1] * hv[r][j][q][1] + hv[r][j][q][2] * hv[r][j][q][2] + hv[r][j][q][3] * hv[r][j][q][3]; }
            const float rs = rsqrtf(wave_sum(ss) * (1.0f / D) + EPS);
            if (row < TR) {
                if (!lastl) {
#pragma unroll
                    for (int j = 0; j < 2; ++j) { *(f32x4*)(H + (size_t)row * D + 8 * lane + 512 * j) = hv[r][j][0]; *(f32x4*)(H + (size_t)row * D + 8 * lane + 512 * j + 4) = hv[r][j][1];
                        *(u32x4*)(HB + (size_t)row * D + 8 * lane + 512 * j) = pack8(hv[r][j][0], hv[r][j][1]); }
                    if (lane == 0) rstd1[row] = rs;
                } else if (row < TX) {
#pragma unroll
                    for (int j = 0; j < 2; ++j) { const f32x4 g0 = *(const f32x4*)(fg + 8 * lane + 512 * j), g1 = *(const f32x4*)(fg + 8 * lane + 512 * j + 4);
                        *(f32x4*)(out + (size_t)row * D + 8 * lane + 512 * j) = hv[r][j][0] * rs * g0; *(f32x4*)(out + (size_t)row * D + 8 * lane + 512 * j + 4) = hv[r][j][1] * rs * g1; }
                }
            }
        }
    }
}
#define RELANE() do { const int t_ = wv0 * 64 + lane_id_opaque(); F.tid = t_; F.lane = t_ & 63; F.wave = __builtin_amdgcn_readfirstlane(t_ >> 6); \
    int g_ = gridDim.x; LAUNDER_S(g_); int b_ = blockIdx.x; LAUNDER_S(b_); F.G = g_; F.bx = b_; F.vcu = (g_ % 8 == 0) ? (b_ % 8) * (g_ / 8) + b_ / 8 : b_; ll = l; LAUNDER_S(ll); } while (0)
__global__ void __launch_bounds__(NWAVES * 64, 2) fwd_kernel(Params P) {
    extern __shared__ __attribute__((aligned(16))) unsigned char lds_raw[];
    Frame F;
    F.lds = (LAS unsigned char*)lds_raw;
    F.tid = threadIdx.x; F.lane = F.tid & 63; F.wave = __builtin_amdgcn_readfirstlane(F.tid >> 6);
    F.G = gridDim.x; { const int bx = blockIdx.x; F.vcu = (F.G % 8 == 0) ? (bx % 8) * (F.G / 8) + bx / 8 : bx; }
    if (F.tid == 0) { LAS unsigned long long* pt = (LAS unsigned long long*)(F.lds + LC_PTAB);
#pragma unroll
        for (int i = 0; i < 25; ++i) pt[i] = (unsigned long long)P.in[i];
        pt[25] = (unsigned long long)P.ws; pt[26] = (unsigned long long)P.out; }
    for (int u = F.tid; u < 256; u += NWAVES * 64) ((LAS unsigned*)(F.lds + RING_BYTES))[u] = 0u;
    __syncthreads();
    const int lo = P.ph_lo, hi = P.ph_hi;
    const bool use_bar = (hi - lo) > 1;
    unsigned* barw = (unsigned*)(P.ws + WS_CTL) + CW_BAR;
    XcdBarrier bar; bar.bar = barw; bar.x = 0; bar.st = (volatile LAS unsigned*)(F.lds + LC_BAR);
    if (use_bar) bar = xcd_barrier_post(barw, (volatile LAS unsigned*)(F.lds + LC_BAR));
#ifndef PHASE_MASK
#define PHASE_MASK 0x7ff
#endif
#define EN(j) (((PHASE_MASK) >> (j)) & 1)
#ifndef DUP_MASK
#define DUP_MASK 0
#endif
#define NREP(j) ((((DUP_MASK) >> (j)) & 1) ? 2 : 1)
#define IN(k) (lo <= (k) && (k) < hi)
#define SEAM(k) do { if (IN(k) && IN((k) + 1)) xcd_barrier(bar); } while (0)

    int l = 0, ll = 0; const int wv0 = __builtin_amdgcn_readfirstlane((int)threadIdx.x >> 6);
    if (EN(0) && IN(0)) { RELANE(); convert_weights(F, 0); RELANE(); init_rows(F); }
    SEAM(0);
    for (l = 0; l < DEPTH; ++l) {
        const int pb = 1 + 10 * l;
        for (int rep = 0; rep < NREP(1); ++rep)
        if (EN(1) && IN(pb + 0)) {
            RELANE();
            unsigned char* wsl = WSP(); unsigned char* dol = DOP();
            pg8::Gemm g{(const bf16*)(wsl + WS_HB), 1024, 1024, 1 << 20};
            pg8::StaticOrder S; S.init(TX, N1, F.G, F.bx, (const bf16*)(wsl + WS_W1T), 1024);
            Epi1 E{(const float*)(wsl + WS_RSTD1), (bf16*)(wsl + WS_A), (bf16*)(wsl + WS_GLU), (bf16*)(dol + DO_Q), (bf16*)(wsl + WS_G)};
            pg8::gemm_phase<Epi1, pg8::StaticOrder>(F.lds, g, S, E, F.wave);
            if (F.bx >= 128 && F.bx < 128 + 21 && F.wave < 4) {
                const int pn = F.bx - 128, l2 = lane_id_opaque(); AccT acc; skinny_zero(acc);
                skinny_k<true>(acc, (const bf16*)(wsl + WS_HB) + (size_t)TX * 1024, 1024, (const bf16*)(wsl + WS_W1T) + (size_t)pn * 256 * 1024, 1024, 1024, F.wave, l2 & 15, l2 >> 4);
                E.run<true>(acc, pg8::Unit{128, pn, 0}, 0, F.wave, l2 & 15, l2 >> 4);
            }
        }
        SEAM(pb + 0);
        for (int rep = 0; rep < NREP(2); ++rep)
        if (EN(2) && IN(pb + 1)) { RELANE(); phase_S(F, ll); }
        SEAM(pb + 1);
        for (int rep = 0; rep < NREP(3); ++rep)
        if (EN(3) && IN(pb + 2)) { RELANE(); phase_B(F); }
        SEAM(pb + 2);
        for (int rep = 0; rep < NREP(4); ++rep)
        if (EN(4) && IN(pb + 3)) {
            RELANE(); unsigned char* wsl = WSP(); unsigned char* dol = DOP();
            pg8::Gemm g{(const bf16*)(wsl + WS_X3), 1024, 1024, 1 << 20}; pg8::SegOrder S; S.init(TX, 1024, F.G, F.bx, (const bf16*)(wsl + WS_W3CT), 1024);
            EpiCS E{(const bf16*)(wsl + WS_G), (bf16*)(dol + DO_MERGED), (const float*)(wsl + WS_BIASA)}; pg8::gemm_phase<EpiCS, pg8::SegOrder>(F.lds, g, S, E, F.wave);
            if (F.bx >= 16 && F.bx < 20 && F.wave < 4) {
                const int pn = F.bx - 16, l2 = lane_id_opaque(); AccT acc; skinny_zero(acc);
#pragma unroll 1
                for (int seg = 0; seg < 3; ++seg) { const size_t ko = seg == 0 ? 0 : (seg == 1 ? 256 : 512);
                    skinny_k<true>(acc, (const bf16*)(wsl + WS_X3) + (size_t)TX * 1024 + ko, 1024, (const bf16*)(wsl + WS_W3CT) + (size_t)pn * 256 * 1024 + ko, 1024, seg == 2 ? 512 : 256, F.wave, l2 & 15, l2 >> 4);
                    E.run<true>(acc, pg8::Unit{128, pn, seg}, 0, F.wave, l2 & 15, l2 >> 4); }
            }
        }
        SEAM(pb + 3);
        if (EN(5) && IN(pb + 4)) {
            RELANE();
            unsigned char* wsl = WSP(); unsigned char* dol = DOP();
            pg8::Gemm g{(const bf16*)(dol + DO_MERGED), 1024, 1024, 1 << 20}; pg8::StaticOrder S; S.init(TX, 1024, F.G, F.bx, (const bf16*)(wsl + WS_WOT), 1024);
            EpiB2 E{(bf16*)(wsl + WS_X3)}; pg8::gemm_phase<EpiB2, pg8::StaticOrder>(F.lds, g, S, E, F.wave);
            if (F.bx >= 16 && F.bx < 20 && F.wave < 4) {
                const int pn = F.bx - 16, l2 = lane_id_opaque(); AccT acc; skinny_zero(acc);
                skinny_k<true>(acc, (const bf16*)(dol + DO_MERGED) + (size_t)TX * 1024, 1024, (const bf16*)(wsl + WS_WOT) + (size_t)pn * 256 * 1024, 1024, 1024, F.wave, l2 & 15, l2 >> 4);
                E.run<true>(acc, pg8::Unit{128, pn, 0}, 0, F.wave, l2 & 15, l2 >> 4);
            }
        }
        SEAM(pb + 4);
        if (EN(6) && IN(pb + 5)) { RELANE(); phase_E1(F, ll); }
        SEAM(pb + 5);
        for (int rep = 0; rep < NREP(7); ++rep)
        if (EN(7) && IN(pb + 6)) { RELANE(); phase_E1b(F, ll); }
        SEAM(pb + 6);
        for (int rep = 0; rep < NREP(8); ++rep)
        if (EN(8) && IN(pb + 7)) {
            RELANE(); class_tables(F, ll);
            unsigned char* wsl = WSP();
            const int NP = __builtin_amdgcn_readfirstlane(*(const LAS int*)(F.lds + LC_NP));
            pg8::Gemm g{(const bf16*)(wsl + WS_XS), 1024, 1024, 1 << 20};
            MoeOrder S{NP, F.G, F.vcu, 0, (const LAS int*)(F.lds + LC_PCLS), (const bf16*)(DOP() + DO_W13T)};
            EpiA2 E{(const float*)(wsl + WS_PW), (bf16*)(wsl + WS_HH)}; pg8::gemm_phase<EpiA2, MoeOrder>(F.lds, g, S, E, F.wave);
        }
        SEAM(pb + 7);
        for (int rep = 0; rep < NREP(9); ++rep)
        if (EN(9) && IN(pb + 8)) {
            RELANE(); class_tables(F, ll);
            unsigned char* wsl = WSP();
            const int NP = __builtin_amdgcn_readfirstlane(*(const LAS int*)(F.lds + LC_NP));
            pg8::Gemm g{(const bf16*)(wsl + WS_HH), 512, 256, 4};
            MoeOrder S{NP, F.G, F.vcu, 1, (const LAS int*)(F.lds + LC_PCLS), (const bf16*)(DOP() + DO_W2T)};
            EpiB2 E{(bf16*)(wsl + WS_Y)}; pg8::gemm_phase<EpiB2, MoeOrder>(F.lds, g, S, E, F.wave);
        }
        SEAM(pb + 8);
        if (EN(10) && IN(pb + 9)) { RELANE(); phase_E4(F, ll); if (l + 1 < DEPTH) { RELANE(); convert_weights(F, ll + 1); } }
        SEAM(pb + 9);
    }
#undef IN
#undef SEAM
}

constexpr int N_PHASES = 1 + 10 * DEPTH;

extern "C" void kernel_launch(void* const* d_in, const int* in_sizes, int n_in, void* d_out, int out_size, void* d_ws, size_t ws_size, hipStream_t stream) {
    static int grid = 0;
    if (grid == 0) {
        if (n_in != 25 || out_size != TX * D || ws_size < WS_END) { fprintf(stderr, "kernel_launch: unexpected shapes: n_in %d out %d ws %zu (need %zu)\n", n_in, out_size, ws_size, (size_t)WS_END); grid = -1; return; }
        int dev = 0, cus = 0, per_cu = 0;
        if (hipGetDevice(&dev) != hipSuccess || hipDeviceGetAttribute(&cus, hipDeviceAttributeMultiprocessorCount, dev) != hipSuccess) { grid = -1; return; }
        if (hipFuncSetAttribute((const void*)fwd_kernel, hipFuncAttributeMaxDynamicSharedMemorySize, LDS_BYTES) != hipSuccess) { fprintf(stderr, "kernel_launch: hipFuncSetAttribute failed\n"); grid = -1; return; }
        if (hipOccupancyMaxActiveBlocksPerMultiprocessor(&per_cu, (const void*)fwd_kernel, NWAVES * 64, LDS_BYTES) != hipSuccess || per_cu < 1) fprintf(stderr, "kernel_launch: occupancy query reports %d\n", per_cu);
        (void)hipGetLastError();
        grid = cus;
    }
    if (grid < 0) return;
    (void)hipMemsetAsync((char*)d_ws + WS_CTL, 0, CTL_BYTES, stream);
    Params p{};
    for (int i = 0; i < 25; ++i) p.in[i] = (const float*)d_in[i];
    p.out = (float*)d_out; p.ws = (unsigned char*)d_ws;
#if N_LAUNCH_MODE == 1
    p.ph_lo = 0; p.ph_hi = N_PHASES;
    hipLaunchKernelGGL(fwd_kernel, dim3(grid), dim3(NWAVES * 64), LDS_BYTES, stream, p);
#else
    for (int ph = 0; ph < N_PHASES; ++ph) { p.ph_lo = ph; p.ph_hi = ph + 1; hipLaunchKernelGGL(fwd_kernel, dim3(grid), dim3(NWAVES * 64), LDS_BYTES, stream, p); }
#endif
}
```

```cpp
#include <hip/hip_runtime.h>
#include <cstdio>
#include <cstdint>

#ifndef N_LAUNCH_MODE
#define N_LAUNCH_MODE 1
#endif

#define GAS __attribute__((address_space(1)))
#define LAS __attribute__((address_space(3)))
typedef unsigned short bf16;
typedef float f32x4 __attribute__((ext_vector_type(4)));
typedef float f32x2 __attribute__((ext_vector_type(2)));
typedef unsigned u32x4 __attribute__((ext_vector_type(4)));
typedef unsigned u32x2 __attribute__((ext_vector_type(2)));
typedef short bf16x8 __attribute__((ext_vector_type(8)));
typedef __bf16 bf16x2v __attribute__((ext_vector_type(2)));

constexpr int D = 1024, NB = 4, SEQ = 8192, NMETA = 16, DEPTH = 2;
constexpr int TX = NB * SEQ;
constexpr int TM = TX + 64;
constexpr int TR = TX + NMETA;
constexpr int NIN = 5384, N1 = 5376;
constexpr int NHEAD = 8;
constexpr int NCLS = 24;
constexpr int NPOSMAX = TX + 256 + NCLS * 256;
constexpr float EPS = 1e-6f;
constexpr float LOG2E = 1.4426950408889634f;
constexpr float C2 = 0.125f * LOG2E;
constexpr int NWAVES = 8;

constexpr size_t U = (size_t)TM * 1024 * 2;
constexpr size_t WS_CTL = 0, CTL_BYTES = 1u << 20;
constexpr size_t WS_H = CTL_BYTES;
constexpr size_t WS_HB = WS_H + 2 * U;
constexpr size_t WS_G = WS_HB + U;
constexpr size_t WS_XS = WS_G;
constexpr size_t WS_Y = WS_XS + (size_t)NPOSMAX * 2048;
constexpr size_t WS_HH = WS_Y + (size_t)NPOSMAX * 2048;
static_assert(WS_HH + (size_t)NPOSMAX * 1024 <= WS_G + 3 * U, "MoE overlay fits the gates region");
constexpr size_t WS_A = WS_G + 3 * U;
constexpr size_t WS_GLU = WS_A + U / 4;
constexpr size_t WS_X3 = WS_GLU + U / 4;
constexpr size_t WS_W1T = WS_X3 + U;
constexpr size_t WS_W3CT = WS_W1T + (size_t)N1 * 1024 * 2;
constexpr size_t WS_WOT = WS_W3CT + 1024 * 1024 * 2;
constexpr size_t WS_WFG = WS_WOT + 1024 * 1024 * 2;
constexpr size_t WS_RG = WS_WFG + 8 * 1024 * 4;
constexpr size_t WS_BIASA = WS_RG + 20 * 1024 * 4;
constexpr size_t WS_RSTD1 = WS_BIASA + 4096;
constexpr size_t WS_ROUTE = WS_RSTD1 + (size_t)TM * 4;
constexpr size_t WS_PW = WS_ROUTE + (size_t)TM * 32;
constexpr size_t WS_LFT = WS_PW + (size_t)NPOSMAX * 16;
constexpr size_t WS_LFTM = WS_LFT + (size_t)32 * 8192 * 4;
constexpr size_t WS_FL = WS_LFTM + 8 * 256 * 4;
constexpr int FLN = 64 + SEQ;
constexpr size_t WS_END = WS_FL + (size_t)32 * FLN * 4;
static_assert(WS_END <= (size_t)512 * 1024 * 1024, "d_ws map fits 512 MiB");
constexpr size_t DO_Q = 0, DO_K = U / 2, DO_V = U, DO_MERGED = U / 2;
constexpr size_t DO_W13T = 3 * U / 2;
constexpr size_t DO_W2T = DO_W13T + (size_t)16 * 512 * 1024 * 2;
static_assert(DO_W2T + (size_t)16 * 1024 * 256 * 2 <= (size_t)TX * 1024 * 4, "d_out scratch");
constexpr int CW_BAR = 4096, CW_GCNT = 16384, CW_NRM = 20480  , CW_AQ = 24576  ;

constexpr int RING_BYTES = 131072;
constexpr int LC_BAR = RING_BYTES, LC_CNT = RING_BYTES + 64, LC_BASE = RING_BYTES + 192, LC_PCLS = RING_BYTES + 320, LC_NP = RING_BYTES + 960;
constexpr int LC_QS = RING_BYTES + 976;
constexpr int LC_PTAB = RING_BYTES + 1024;
constexpr int LDS_BYTES = RING_BYTES + 1024 + 7168;

#define LDS_WAIT() asm volatile("s_waitcnt lgkmcnt(0)" ::: "memory")
#define VM_WAIT() asm volatile("s_waitcnt vmcnt(0)" ::: "memory")
#define LAUNDER_S(p) asm volatile("" : "+s"(p))
#define LAUNDER_V(x) asm volatile("" : "+v"(x))
__device__ __forceinline__ int lane_id_opaque() { int x; asm volatile("v_mbcnt_lo_u32_b32 %0, -1, 0\n\tv_mbcnt_hi_u32_b32 %0, -1, %0" : "=v"(x)); return x; }

__device__ __forceinline__ unsigned f2bf(float f) { unsigned u = __builtin_bit_cast(unsigned, f); return (u + 0x7fffu + ((u >> 16) & 1u)) >> 16; }
__device__ __forceinline__ unsigned pk2(float lo, float hi) { f32x2 v = {lo, hi}; bf16x2v b = __builtin_convertvector(v, bf16x2v); return __builtin_bit_cast(unsigned, b); }
__device__ __forceinline__ float bflo(unsigned w) { return __builtin_bit_cast(float, w << 16); }
__device__ __forceinline__ float bfhi(unsigned w) { return __builtin_bit_cast(float, w & 0xffff0000u); }
template <int O> __device__ __forceinline__ float lane_xor(float v) {
    if constexpr (O < 32) return __int_as_float(__builtin_amdgcn_ds_swizzle(__float_as_int(v), (O << 10) | 0x1f));
    else { auto rr = __builtin_amdgcn_permlane32_swap(__float_as_uint(v), __float_as_uint(v), false, false); return __uint_as_float(rr[0]) + __uint_as_float(rr[1]) - v; }
}
__device__ __forceinline__ float wave_sum(float v) {
    v += lane_xor<1>(v); v += lane_xor<2>(v); v += lane_xor<4>(v); v += lane_xor<8>(v); v += lane_xor<16>(v);
    auto rr = __builtin_amdgcn_permlane32_swap(__float_as_uint(v), __float_as_uint(v), false, false);
    return __uint_as_float(rr[0]) + __uint_as_float(rr[1]);
}
__device__ __forceinline__ float sigmoidf_(float x) { return __builtin_amdgcn_rcpf(1.0f + __builtin_amdgcn_exp2f(-LOG2E * x)); }
__device__ __forceinline__ float dot2bf(unsigned a, unsigned b, float acc) { return __builtin_amdgcn_fdot2_f32_bf16(__builtin_bit_cast(bf16x2v, a), __builtin_bit_cast(bf16x2v, b), acc, false); }

namespace pg8 {
constexpr int BM = 256, BK = 64, HALF = 128, HTB = HALF * BK * 2, STAGE_BYTES = 8 * HTB, NXCD = 8, WGM = 8;
__host__ __device__ __forceinline__ int lds_byte(int r, int c) { const int st = (r >> 4) * 2 + (c >> 5), rr = r & 15, cc = c & 31, ob = rr * 64 + cc * 2; return st * 1024 + (ob ^ (((ob >> 9) & 1) << 5)); }
__host__ __device__ __forceinline__ void stage_rc(int b, int& R, int& C) { const int st = b / 1024, sb = b % 1024, swz = sb ^ (((sb >> 9) & 1) << 5); R = (st >> 1) * 16 + swz / 64; C = (st & 1) * 32 + (swz % 64) / 2; }
__host__ __device__ __forceinline__ int perm32(int rho) { const int n = rho >> 4, i = rho & 15; return 8 * (i >> 2) + 4 * n + (i & 3); }

struct Unit { int pm, pn, seg; };
struct Gemm { const bf16* A; int K; int ldb; int ksplit; };

struct StaticOrder {
    int nM, nN, nwg, G, c; const bf16* Bt; size_t btile;
    __device__ void init(int M, int N, int G_, int c_, const bf16* Bt_, int ldb) { nM = M / BM; nN = N / BM; nwg = nM * nN; G = G_; c = c_; Bt = Bt_; btile = (size_t)BM * ldb * 2; }
    __device__ bool next(int i, Unit& u) const {
        const long L = (long)i * G + c; if (L >= nwg) return false;
        int wgid = (int)L; { const int q = nwg / NXCD, r = nwg % NXCD, xcd = wgid % NXCD, off = wgid / NXCD; wgid = (xcd < r ? xcd * (q + 1) : r * (q + 1) + (xcd - r) * q) + off; }
        const int nig = WGM * nN, gid = wgid / nig, fm = gid * WGM, gsz = (nM - fm) < WGM ? (nM - fm) : WGM;
        u.pm = fm + ((wgid % nig) % gsz); u.pn = (wgid % nig) / gsz; u.seg = 0; return true;
    }
    __device__ __forceinline__ const char* bptr(const Unit& u, int) const { return (const char*)Bt + (size_t)u.pn * btile; }
    __device__ __forceinline__ int nt(const Unit&, int ntd) const { return ntd; }
    __device__ __forceinline__ size_t aoff(const Unit&) const { return 0; }
};
struct SegOrder : StaticOrder {
    __device__ bool next(int i, Unit& u) const { const int q = i / 3; if (!StaticOrder::next(q, u)) return false; u.seg = i - 3 * q; return true; }
    __device__ __forceinline__ size_t koff(const Unit& u) const { return u.seg == 0 ? 0 : (u.seg == 1 ? 512 : 1024); }
    __device__ __forceinline__ const char* bptr(const Unit& u, int) const { return (const char*)Bt + (size_t)u.pn * btile + koff(u); }
    __device__ __forceinline__ int nt(const Unit& u, int) const { return u.seg == 2 ? 8 : 4; }
    __device__ __forceinline__ size_t aoff(const Unit& u) const { return koff(u); }
};

template <class Epi, class Sched, bool ALIGN_EPI = true, bool SP2 = true>
__device__ __forceinline__ void gemm_phase(LAS unsigned char* lds, const Gemm g, const Sched& S, const Epi& E, const int wave_id) {
    const int tid = wave_id * 64 + lane_id_opaque();
    const int wid = __builtin_amdgcn_readfirstlane(tid >> 6), lane = tid & 63, wr = wid >> 2, wc = wid & 3, fr = lane & 15, fq = lane >> 4;
    const int K = g.K, nt = K / BK, ldb = g.ldb, ks = g.ksplit;
    unsigned voffA[2], voffB[2];
#pragma unroll
    for (int i = 0; i < 2; ++i) { int R, C; stage_rc(tid * 16 + i * 8192, R, C); const int Rb = Epi::PERM ? ((R & ~31) + perm32(R & 31)) : R;
        voffA[i] = (unsigned)(R * K + C) * 2u; voffB[i] = (unsigned)(Rb * ldb + C) * 2u; }
    const size_t kstep = (size_t)(BK * 2);
    const size_t hstep = (size_t)HALF * K * 2;
    const size_t hstepB = (size_t)HALF * ldb * 2;
    const size_t tstep = 2 * hstep;
    const unsigned ldsw = (unsigned)wid * 1024u;
    const int aoff = lds_byte(wr * 64 + fr, fq * 8), boff = lds_byte(wc * 32 + fr, fq * 8);
#define PG8_SA(b, h) (((b) * 2 + (h)) * HTB)
#define PG8_SB(b, h) ((4 + (b) * 2 + (h)) * HTB)
#define PG8_STAGE(bufoff, gbase, voff) do { _Pragma("unroll") for (int _i = 0; _i < 2; ++_i) \
        __builtin_amdgcn_global_load_lds((const unsigned*)((const char*)(gbase) + (voff)[_i]), (LAS unsigned*)(lds + (bufoff) + ldsw + _i * 8192), 16, 0, 0); } while (0)
#define PG8_LDA(dst, b, h) do { _Pragma("unroll") for (int m = 0; m < 4; ++m) _Pragma("unroll") for (int k = 0; k < 2; ++k) dst[m][k] = *(const LAS bf16x8*)(lds + PG8_SA(b, h) + aoff + m * 2048 + k * 1024); } while (0)
#define PG8_LDB(dst, b, h) do { _Pragma("unroll") for (int n = 0; n < 2; ++n) _Pragma("unroll") for (int k = 0; k < 2; ++k) dst[n][k] = *(const LAS bf16x8*)(lds + PG8_SB(b, h) + boff + n * 2048 + k * 1024); } while (0)
#define PG8_MMA(ai, bj, At, Bt) do { __builtin_amdgcn_s_setprio(1); _Pragma("unroll") for (int m = 0; m < 4; ++m) _Pragma("unroll") for (int n = 0; n < 2; ++n) _Pragma("unroll") for (int k = 0; k < 2; ++k) \
        acc[ai][bj][m][n] = __builtin_amdgcn_mfma_f32_16x16x32_bf16(Bt[n][k], At[m][k], acc[ai][bj][m][n], 0, 0, 0); __builtin_amdgcn_s_setprio(0); } while (0)
#define PG8_WAIT_V(n) asm volatile("s_waitcnt vmcnt(" #n ")" ::: "memory")
#define PG8_WAIT_L(n) asm volatile("s_waitcnt lgkmcnt(" #n ")" ::: "memory")
#define PG8_BAR __builtin_amdgcn_s_barrier()
#define PG8_SCHED __builtin_amdgcn_sched_barrier(0)
    Unit cur, nxt; int ui = 0;
    if (!S.next(0, cur)) return;
    f32x4 acc[2][2][4][2];
    { float z_ = 0.f; LAUNDER_V(z_);
#pragma unroll
    for (int a = 0; a < 2; ++a)
#pragma unroll
        for (int b = 0; b < 2; ++b)
#pragma unroll
            for (int m = 0; m < 4; ++m)
#pragma unroll
                for (int n = 0; n < 2; ++n) acc[a][b][m][n] = (f32x4){z_, z_, z_, z_}; }
    bf16x8 At[4][2], B0[2][2], B1[2][2];
    int ntc = S.nt(cur, nt);
    const char* cA = (const char*)g.A + (size_t)cur.pm * tstep + S.aoff(cur); const char* cB = S.bptr(cur, 0); const char* cB1 = S.bptr(cur, 1) - (size_t)ks * kstep;
    if constexpr (SP2) {
        PG8_STAGE(PG8_SB(0, 0), cB, voffB); PG8_STAGE(PG8_SB(0, 1), cB + hstepB, voffB); PG8_STAGE(PG8_SA(0, 0), cA, voffA); PG8_STAGE(PG8_SA(0, 1), cA + hstep, voffA);
        if (wr == 1) PG8_BAR;
        PG8_WAIT_V(2); PG8_BAR;
        PG8_STAGE(PG8_SB(1, 0), cB + kstep, voffB); PG8_STAGE(PG8_SA(1, 0), cA + kstep, voffA); PG8_STAGE(PG8_SB(1, 1), cB + hstepB + kstep, voffB);
        PG8_WAIT_V(6); PG8_BAR;
    } else {
        PG8_STAGE(PG8_SB(0, 0), cB, voffB); PG8_STAGE(PG8_SA(0, 0), cA, voffA); PG8_STAGE(PG8_SB(0, 1), cB + hstepB, voffB); PG8_STAGE(PG8_SA(0, 1), cA + hstep, voffA);
        if (wr == 1) PG8_BAR;
        PG8_WAIT_V(4); PG8_BAR;
        PG8_STAGE(PG8_SB(1, 0), cB + kstep, voffB); PG8_STAGE(PG8_SA(1, 0), cA + kstep, voffA); PG8_STAGE(PG8_SB(1, 1), cB + hstepB + kstep, voffB);
        PG8_WAIT_V(6); PG8_BAR;
    }
    for (;;) {
        const bool has_next = S.next(ui + 1, nxt);
        const char* nA = has_next ? (const char*)g.A + (size_t)nxt.pm * tstep + S.aoff(nxt) : cA; const char* nB = has_next ? S.bptr(nxt, 0) : cB;
        const char* nB1 = has_next ? S.bptr(nxt, 1) - (size_t)ks * kstep : cB1;
#pragma unroll 1
        for (int t = 0; t < ntc; t += 2) {
            const bool last = (t == ntc - 2);
            const char* a1 = cA + (size_t)(t + 1) * kstep;
            const char* bside = (t + 2 < ks) ? cB : cB1;
            const char* a2 = last ? nA : cA + (size_t)(t + 2) * kstep; const char* b2 = last ? nB : bside + (size_t)(t + 2) * kstep;
            const char* a3 = a2 + kstep; const char* b3 = b2 + kstep;
            if constexpr (SP2) {
            PG8_LDB(B0, 0, 0); PG8_LDB(B1, 0, 1); PG8_SCHED; PG8_LDA(At, 0, 0); PG8_STAGE(PG8_SA(1, 1), a1 + hstep, voffA);
            PG8_WAIT_V(8); PG8_WAIT_L(0); PG8_BAR; PG8_MMA(0, 0, At, B0); PG8_MMA(0, 1, At, B1); PG8_BAR; PG8_SCHED;
            PG8_LDA(At, 0, 1); PG8_STAGE(PG8_SB(0, 0), b2, voffB); PG8_STAGE(PG8_SB(0, 1), b2 + hstepB, voffB); PG8_STAGE(PG8_SA(0, 0), a2, voffA);
            PG8_WAIT_V(8); PG8_WAIT_L(0); PG8_BAR; PG8_MMA(1, 0, At, B0); PG8_MMA(1, 1, At, B1); PG8_BAR; PG8_SCHED;
            PG8_LDB(B0, 1, 0); PG8_LDB(B1, 1, 1); PG8_SCHED; PG8_LDA(At, 1, 0); PG8_STAGE(PG8_SA(0, 1), a2 + hstep, voffA);
            PG8_WAIT_V(8); PG8_WAIT_L(0); PG8_BAR; PG8_MMA(0, 0, At, B0); PG8_MMA(0, 1, At, B1); PG8_BAR; PG8_SCHED;
            PG8_LDA(At, 1, 1); PG8_STAGE(PG8_SB(1, 0), b3, voffB); PG8_STAGE(PG8_SB(1, 1), b3 + hstepB, voffB); PG8_STAGE(PG8_SA(1, 0), a3, voffA);
            PG8_WAIT_V(8); PG8_WAIT_L(0); PG8_BAR; PG8_MMA(1, 0, At, B0); PG8_MMA(1, 1, At, B1); PG8_BAR; PG8_SCHED;
            } else {
            PG8_LDB(B0, 0, 0); PG8_SCHED; PG8_LDA(At, 0, 0); PG8_STAGE(PG8_SA(1, 1), a1 + hstep, voffA);
            PG8_WAIT_L(8); PG8_BAR; PG8_WAIT_L(0); PG8_MMA(0, 0, At, B0); PG8_BAR; PG8_SCHED;
            PG8_LDB(B1, 0, 1); PG8_STAGE(PG8_SB(0, 0), b2, voffB);
            PG8_BAR; PG8_WAIT_L(0); PG8_MMA(0, 1, At, B1); PG8_BAR;
            PG8_LDA(At, 0, 1); PG8_STAGE(PG8_SA(0, 0), a2, voffA);
            PG8_BAR; PG8_WAIT_L(0); PG8_MMA(1, 0, At, B0); PG8_BAR; PG8_SCHED;
            PG8_STAGE(PG8_SB(0, 1), b2 + hstepB, voffB);
            PG8_WAIT_V(6); PG8_BAR; PG8_MMA(1, 1, At, B1); PG8_BAR;
            PG8_LDB(B0, 1, 0); PG8_SCHED; PG8_LDA(At, 1, 0); PG8_STAGE(PG8_SA(0, 1), a2 + hstep, voffA);
            PG8_WAIT_L(8); PG8_BAR; PG8_WAIT_L(0); PG8_MMA(0, 0, At, B0); PG8_BAR; PG8_SCHED;
            PG8_LDB(B1, 1, 1); PG8_STAGE(PG8_SB(1, 0), b3, voffB);
            PG8_BAR; PG8_WAIT_L(0); PG8_MMA(0, 1, At, B1); PG8_BAR;
            PG8_LDA(At, 1, 1); PG8_STAGE(PG8_SA(1, 0), a3, voffA);
            PG8_BAR; PG8_WAIT_L(0); PG8_MMA(1, 0, At, B0); PG8_BAR; PG8_SCHED;
            PG8_STAGE(PG8_SB(1, 1), b3 + hstepB, voffB);
            PG8_WAIT_V(6); PG8_BAR; PG8_MMA(1, 1, At, B1); PG8_BAR;
            }
        }
        if constexpr (ALIGN_EPI) { if (wr == 0) PG8_BAR; }
        { const int l2 = lane_id_opaque(); E(acc, cur, wr, wc, l2 & 15, l2 >> 4); }
        if (!has_next) break;
        if (!E.keep(cur)) { float z_ = 0.f; LAUNDER_V(z_);
#pragma unroll
        for (int a = 0; a < 2; ++a)
#pragma unroll
            for (int b = 0; b < 2; ++b)
#pragma unroll
                for (int m = 0; m < 4; ++m)
#pragma unroll
                    for (int n = 0; n < 2; ++n) acc[a][b][m][n] = (f32x4){z_, z_, z_, z_}; }
        cur = nxt; cA = nA; cB = nB; cB1 = nB1; ++ui; ntc = S.nt(cur, nt);
        if constexpr (ALIGN_EPI) { if (wr == 1) PG8_BAR; }
    }
    PG8_WAIT_V(0);
    if constexpr (!ALIGN_EPI) { if (wr == 0) PG8_BAR; }
    PG8_BAR;
#undef PG8_SA
#undef PG8_SB
#undef PG8_STAGE
#undef PG8_LDA
#undef PG8_LDB
#undef PG8_MMA
#undef PG8_WAIT_V
#undef PG8_WAIT_L
#undef PG8_BAR
#undef PG8_SCHED
}
}

typedef f32x4 AccT[2][2][4][2];
__device__ __forceinline__ u32x4 pack8(const f32x4 a, const f32x4 b) { u32x4 w; w.x = pk2(a[0], a[1]); w.y = pk2(a[2], a[3]); w.z = pk2(b[0], b[1]); w.w = pk2(b[2], b[3]); return w; }

struct Epi1 {
    static constexpr bool PERM = true;
    __device__ __forceinline__ bool keep(const pg8::Unit&) const { return false; }
    const float* rstd; bf16* A; bf16* GLU; bf16* QKV; bf16* G;
    __device__ __forceinline__ void operator()(AccT& acc, const pg8::Unit& u, int wr, int wc, int fr, int fq) const { run<false>(acc, u, wr, wc, fr, fq); }
    template <bool SK> __device__ __forceinline__ void run(AccT& acc, const pg8::Unit& u, int wr, int wc, int fr, int fq) const {
        const int row0 = u.pm * 256 + wr * 64 + fr, lc0 = wc * 32 + 8 * fq, pn = u.pn;
#pragma unroll
        for (int ai = 0; ai < (SK ? 1 : 2); ++ai)
#pragma unroll
            for (int m = 0; m < (SK ? 1 : 4); ++m) {
                const int row = row0 + ai * 128 + m * 16; const float rs = rstd[row];
                f32x4 v[2][2];
#pragma unroll
                for (int bj = 0; bj < 2; ++bj)
#pragma unroll
                    for (int n = 0; n < 2; ++n) v[bj][n] = acc[ai][bj][m][n] * rs;
                if (pn == 0) {
#pragma unroll
                    for (int bj = 0; bj < 2; ++bj) *(u32x4*)(A + (size_t)row * 256 + bj * 128 + lc0) = pack8(v[bj][0], v[bj][1]);
                } else if (pn <= 2) {
                    f32x4 o[2];
#pragma unroll
                    for (int n = 0; n < 2; ++n)
#pragma unroll
                        for (int j = 0; j < 4; ++j) o[n][j] = v[0][n][j] * sigmoidf_(v[1][n][j]);
                    *(u32x4*)(GLU + (size_t)row * 256 + (pn - 1) * 128 + lc0) = pack8(o[0], o[1]);
                } else if (pn <= 8) {
                    const int t = (pn - 3) >> 1; bf16* base = QKV + (size_t)t * (U / 4); const float sc = t == 0 ? C2 : 1.0f;
#pragma unroll
                    for (int bj = 0; bj < 2; ++bj) *(u32x4*)(base + (size_t)row * 512 + ((pn - 3) & 1) * 256 + bj * 128 + lc0) = pack8(v[bj][0] * sc, v[bj][1] * sc);
                } else {
#pragma unroll
                    for (int bj = 0; bj < 2; ++bj) { f32x4 o[2];
#pragma unroll
                        for (int n = 0; n < 2; ++n)
#pragma unroll
                            for (int j = 0; j < 4; ++j) o[n][j] = fmaxf(sigmoidf_(v[bj][n][j]), 1e-30f);
                        *(u32x4*)(G + (size_t)row * 3072 + (pn - 9) * 256 + bj * 128 + lc0) = pack8(o[0], o[1]); }
                }
            }
    }
};
struct EpiCS {
    static constexpr bool PERM = true;
    const bf16* G; bf16* Mg; const float* bias;
    __device__ __forceinline__ bool keep(const pg8::Unit& u) const { return u.seg != 2; }
    __device__ __forceinline__ void operator()(AccT& acc, const pg8::Unit& u, int wr, int wc, int fr, int fq) const { run<false>(acc, u, wr, wc, fr, fq); }
    template <bool SK> __device__ __forceinline__ void run(AccT& acc, const pg8::Unit& u, int wr, int wc, int fr, int fq) const {
        const int row0 = u.pm * 256 + wr * 64 + fr, col0 = u.pn * 256 + wc * 32 + 8 * fq;
        const bool lastseg = u.seg == 2; const int w = u.seg, wd = lastseg ? 2 : u.seg + 1; const float bsc = u.seg == 0 ? 1.f : 0.f;
        f32x4 bv[2][2];
#pragma unroll
        for (int bj = 0; bj < 2; ++bj) { bv[bj][0] = *(const f32x4*)(bias + col0 + bj * 128) * bsc; bv[bj][1] = *(const f32x4*)(bias + col0 + bj * 128 + 4) * bsc; }
#pragma unroll
        for (int ai = 0; ai < (SK ? 1 : 2); ++ai) {
            u32x4 gn[4][2], gd[4][2];
#pragma unroll
            for (int m = 0; m < (SK ? 1 : 4); ++m) { const bf16* gp = G + (size_t)(row0 + ai * 128 + m * 16) * 3072 + col0;
#pragma unroll
                for (int bj = 0; bj < 2; ++bj) { gn[m][bj] = *(const u32x4*)(gp + w * 1024 + bj * 128); gd[m][bj] = *(const u32x4*)(gp + wd * 1024 + bj * 128); } }
#pragma unroll
            for (int m = 0; m < (SK ? 1 : 4); ++m) { const int row = row0 + ai * 128 + m * 16;
#pragma unroll
                for (int bj = 0; bj < 2; ++bj) {
                    const u32x4 n4 = gn[m][bj], d4 = gd[m][bj];
                    f32x4 a0 = acc[ai][bj][m][0] + bv[bj][0], a1 = acc[ai][bj][m][1] + bv[bj][1];
#define RAT(gnv, gdv) ((gnv) * (lastseg ? 1.0f : __builtin_amdgcn_rcpf(gdv)))
                    a0[0] *= RAT(bflo(n4.x), bflo(d4.x)); a0[1] *= RAT(bfhi(n4.x), bfhi(d4.x)); a0[2] *= RAT(bflo(n4.y), bflo(d4.y)); a0[3] *= RAT(bfhi(n4.y), bfhi(d4.y));
                    a1[0] *= RAT(bflo(n4.z), bflo(d4.z)); a1[1] *= RAT(bfhi(n4.z), bfhi(d4.z)); a1[2] *= RAT(bflo(n4.w), bflo(d4.w)); a1[3] *= RAT(bfhi(n4.w), bfhi(d4.w));
#undef RAT
                    acc[ai][bj][m][0] = a0; acc[ai][bj][m][1] = a1;
                    asm volatile("" : "+v"(acc[ai][bj][m][0]), "+v"(acc[ai][bj][m][1]));
                    if (lastseg) *(u32x4*)(Mg + (size_t)row * 1024 + col0 + bj * 128) = pack8(a0, a1);
                } }
            asm volatile("" ::: "memory");
        }
    }
};
struct EpiD {
    static constexpr bool PERM = false;
    __device__ __forceinline__ bool keep(const pg8::Unit&) const { return false; }
    float* H; bf16* HB;
    __device__ __forceinline__ void operator()(AccT& acc, const pg8::Unit& u, int wr, int wc, int fr, int fq) const { run<false>(acc, u, wr, wc, fr, fq); }
    template <bool SK> __device__ __forceinline__ void run(AccT& acc, const pg8::Unit& u, int wr, int wc, int fr, int fq) const {
        const int row0 = u.pm * 256 + wr * 64 + fr, col0 = u.pn * 256 + wc * 32 + 4 * fq;
#pragma unroll
        for (int ai = 0; ai < (SK ? 1 : 2); ++ai)
#pragma unroll
            for (int m = 0; m < (SK ? 1 : 4); ++m) {
                const size_t off = (size_t)(row0 + ai * 128 + m * 16) * 1024 + col0;
#pragma unroll
                for (int bj = 0; bj < 2; ++bj)
#pragma unroll
                    for (int n = 0; n < 2; ++n) { const size_t o = off + bj * 128 + n * 16; const f32x4 hv = *(const f32x4*)(H + o) + acc[ai][bj][m][n];
                        *(f32x4*)(H + o) = hv; u32x2 w; w.x = pk2(hv[0], hv[1]); w.y = pk2(hv[2], hv[3]); *(u32x2*)(HB + o) = w; }
            }
    }
};
struct EpiA2 {
    static constexpr bool PERM = true;
    __device__ __forceinline__ bool keep(const pg8::Unit&) const { return false; }
    const float* PW; bf16* HH;
    __device__ __forceinline__ void operator()(AccT& acc, const pg8::Unit& u, int wr, int wc, int fr, int fq) const {
        const int row0 = u.pm * 256 + wr * 64 + fr, lc0 = wc * 32 + 8 * fq, side = u.pn >> 1;
#pragma unroll
        for (int ai = 0; ai < 2; ++ai)
#pragma unroll
            for (int m = 0; m < 4; ++m) {
                const int row = row0 + ai * 128 + m * 16; const f32x4 pw = *(const f32x4*)(PW + (size_t)row * 4);
                const float rs = pw[0], cw = side ? pw[2] : pw[1];
                f32x4 o[2];
#pragma unroll
                for (int n = 0; n < 2; ++n)
#pragma unroll
                    for (int j = 0; j < 4; ++j) { const float a1 = acc[ai][0][m][n][j] * rs, a3 = acc[ai][1][m][n][j] * rs; o[n][j] = cw * a1 * sigmoidf_(a1) * a3; }
                *(u32x4*)(HH + (size_t)row * 512 + side * 256 + (u.pn & 1) * 128 + lc0) = pack8(o[0], o[1]);
            }
    }
};
struct EpiB2 {
    static constexpr bool PERM = true;
    __device__ __forceinline__ bool keep(const pg8::Unit&) const { return false; }
    bf16* Y;
    __device__ __forceinline__ void operator()(AccT& acc, const pg8::Unit& u, int wr, int wc, int fr, int fq) const { run<false>(acc, u, wr, wc, fr, fq); }
    template <bool SK> __device__ __forceinline__ void run(AccT& acc, const pg8::Unit& u, int wr, int wc, int fr, int fq) const {
        const int row0 = u.pm * 256 + wr * 64 + fr, col0 = u.pn * 256 + wc * 32 + 8 * fq;
#pragma unroll
        for (int ai = 0; ai < (SK ? 1 : 2); ++ai)
#pragma unroll
            for (int m = 0; m < (SK ? 1 : 4); ++m) {
                bf16* rp = Y + (size_t)(row0 + ai * 128 + m * 16) * 1024 + col0;
#pragma unroll
                for (int bj = 0; bj < 2; ++bj) *(u32x4*)(rp + bj * 128) = pack8(acc[ai][bj][m][0], acc[ai][bj][m][1]);
            }
    }
};
struct MoeOrder {
    int NP, G, c, mode; const LAS int* pcls; const bf16* W;
    __device__ bool next(int i, pg8::Unit& u) const { const long L = (long)i * G + c; if (L >= (long)NP * 4) return false; u.pm = (int)(L >> 2); u.pn = (int)(L & 3); u.seg = 0; return true; }
    __device__ __forceinline__ int nt(const pg8::Unit&, int ntd) const { return ntd; }
    __device__ __forceinline__ size_t aoff(const pg8::Unit&) const { return 0; }
    __device__ __forceinline__ const char* bptr(const pg8::Unit& u, int side) const {
        const int cls = __builtin_amdgcn_readfirstlane(pcls[u.pm]); const int grp = cls / 6, pr = cls % 6;
        const int ea = pr < 3 ? 0 : (pr < 5 ? 1 : 2), eb = pr < 3 ? pr + 1 : (pr < 5 ? pr - 1 : 3);
        if (mode == 0) { const int e = grp * 4 + (u.pn < 2 ? ea : eb); return (const char*)W + ((size_t)e * 512 + (size_t)(u.pn & 1) * 256) * 1024 * 2; }
        const int e = grp * 4 + (side ? eb : ea); return (const char*)W + ((size_t)e * 1024 + (size_t)u.pn * 256) * 256 * 2;
    }
};

template <bool PERM> __device__ __forceinline__ void skinny_k(AccT& acc, const bf16* A, int lda, const bf16* Bt, int ldb, int K, int wc, int fr, int fq) {
    const bf16* ap = A + (size_t)fr * lda + 8 * fq;
    const bf16* bp[2][2];
#pragma unroll
    for (int bj = 0; bj < 2; ++bj)
#pragma unroll
        for (int n = 0; n < 2; ++n) { const int col = 128 * bj + 32 * wc + (PERM ? 8 * (fr >> 2) + 4 * n + (fr & 3) : 16 * n + fr); bp[bj][n] = Bt + (size_t)col * ldb + 8 * fq; }
#pragma unroll 4
    for (int k0 = 0; k0 < K; k0 += 32) {
        const bf16x8 a = *(const bf16x8*)(ap + k0);
#pragma unroll
        for (int bj = 0; bj < 2; ++bj)
#pragma unroll
            for (int n = 0; n < 2; ++n) { const bf16x8 b = *(const bf16x8*)(bp[bj][n] + k0); acc[0][bj][0][n] = __builtin_amdgcn_mfma_f32_16x16x32_bf16(b, a, acc[0][bj][0][n], 0, 0, 0); }
    }
}
__device__ __forceinline__ void skinny_zero(AccT& acc) {
#pragma unroll
    for (int bj = 0; bj < 2; ++bj)
#pragma unroll
        for (int n = 0; n < 2; ++n) acc[0][bj][0][n] = (f32x4){0.f, 0.f, 0.f, 0.f};
}

#define XB_TMO      128
#define XB_XCNT(j)  (256  + 64 * (j))
#define XB_XSUB(j)  (1280 + 64 * (j))
#define XB_XGEN(j)  (2304 + 64 * (j))
#define XB_TOP      3328
#define XB_TOPGEN   3392
#define XCD_BAR_WORDS 3456
#define XB_SPIN_CAP (1u << 24)
__device__ __forceinline__ unsigned xb_ld(unsigned* p)              { return __hip_atomic_load(p, __ATOMIC_RELAXED, __HIP_MEMORY_SCOPE_AGENT); }
__device__ __forceinline__ unsigned xb_add(unsigned* p, unsigned v) { return __hip_atomic_fetch_add(p, v, __ATOMIC_RELAXED, __HIP_MEMORY_SCOPE_AGENT); }
__device__ __forceinline__ unsigned xb_xcc_id() { return (unsigned)__builtin_amdgcn_s_getreg((3 << 11) | 20) & 0xFu; }
#define XB_SPIN(cond, bar) do { unsigned _sp = 0; while (cond) { __builtin_amdgcn_s_sleep(1); \
    if ((++_sp & 255u) == 0u) { if (xb_ld(&(bar)[XB_TMO])) break; if (_sp > XB_SPIN_CAP) { atomicAdd(&(bar)[XB_TMO], 1u); break; } } } } while (0)
struct XcdBarrier { unsigned* bar; unsigned x; volatile LAS unsigned* st; };
__device__ __forceinline__ XcdBarrier xcd_barrier_post(unsigned* bar, volatile LAS unsigned* st) {
    XcdBarrier b; b.bar = bar; b.x = xb_xcc_id(); b.st = st;
    if (threadIdx.x == 0) (void)xb_add(&bar[XB_XCNT(b.x)], 1u);
    return b;
}
__device__ __forceinline__ void xcd_barrier_complete(unsigned* bar, unsigned x, unsigned& nloc, unsigned& nx) {
    const unsigned G = gridDim.x * gridDim.y * gridDim.z;
    unsigned sum, cnt, mine, sp = 0u;
    for (;;) {
        sum = 0u; cnt = 0u; mine = 0u;
#pragma unroll
        for (unsigned j = 0; j < 16; ++j) { const unsigned c = xb_ld(&bar[XB_XCNT(j)]); sum += c; cnt += (c > 0u) ? 1u : 0u; mine = (j == x) ? c : mine; }
        if (sum == G) break;
        __builtin_amdgcn_s_sleep(1);
        if ((++sp & 255u) == 0u) { if (xb_ld(&bar[XB_TMO])) break; if (sp > XB_SPIN_CAP) { atomicAdd(&bar[XB_TMO], 1u); break; } }
    }
    nloc = mine > 0u ? mine : 1u; nx = cnt > 0u ? cnt : 1u;
}
__device__ __forceinline__ void xcd_barrier(const XcdBarrier& b) {
    asm volatile("s_waitcnt vmcnt(0)" ::: "memory");
    __syncthreads();
    if (threadIdx.x == 0) {
        unsigned* bar = b.bar;
        __builtin_amdgcn_s_waitcnt(0);
        unsigned nloc = b.st[0], nx = b.st[1];
        if (nloc == 0u) { xcd_barrier_complete(bar, b.x, nloc, nx); b.st[0] = nloc; b.st[1] = nx; }
        const unsigned old = xb_add(&bar[XB_XSUB(b.x)], 1u);
        const unsigned gen = old / nloc;
        if (old + 1u == (gen + 1u) * nloc) {
            __builtin_amdgcn_fence(__ATOMIC_RELEASE, "agent");
            asm volatile("s_waitcnt vmcnt(0)" ::: "memory");
            const unsigned og = xb_add(&bar[XB_TOP], 1u);
            const unsigned tg = og / nx;
            if (og + 1u == (tg + 1u) * nx) xb_add(&bar[XB_TOPGEN], 1u);
            else XB_SPIN(xb_ld(&bar[XB_TOPGEN]) == tg, bar);
            __builtin_amdgcn_fence(__ATOMIC_ACQUIRE, "agent");
            xb_add(&bar[XB_XGEN(b.x)], 1u);
            asm volatile("s_waitcnt vmcnt(0)" ::: "memory");
        } else {
            XB_SPIN(xb_ld(&bar[XB_XGEN(b.x)]) == gen, bar);
            __builtin_amdgcn_fence(__ATOMIC_ACQUIRE, "agent");
            asm volatile("s_waitcnt vmcnt(0)" ::: "memory");
        }
    }
    __syncthreads();
}

struct Params { const float* in[25]; float* out; unsigned char* ws; int ph_lo, ph_hi; };
enum { I_X = 0, I_META, I_N1G, I_WIN, I_BF, I_PW, I_PB, I_PS, I_CW, I_CB, I_LNG, I_LNB, I_WOA, I_WOB, I_WOC, I_WO, I_N2G, I_RGW, I_RGB, I_REW, I_REB, I_W1, I_W3, I_W2, I_FG };

struct Frame {
    LAS unsigned char* lds;
    int tid, lane, wave, vcu, G, bx;
};
__device__ __forceinline__ unsigned long long ptab_get(const Frame& F, int i) { const LAS unsigned* t = (const LAS unsigned*)(F.lds + LC_PTAB) + 2 * i; const unsigned lo = __builtin_amdgcn_readfirstlane(t[0]), hi = __builtin_amdgcn_readfirstlane(t[1]); return ((unsigned long long)hi << 32) | lo; }
#define INP(i) ((const float*)(const GAS float*)ptab_get(F, (i)))
#define WSP() ((unsigned char*)(GAS unsigned char*)ptab_get(F, 25))
#define DOP() ((unsigned char*)(GAS unsigned char*)ptab_get(F, 26))

__device__ __forceinline__ void tr_item(const float* W, int ldw, int scol0, const float* gk, bf16* WT, int ldt, int drow0, int k0, LAS float* scr, int lane) {
    const int n4 = (lane & 7) * 4, kr = lane >> 3;
    f32x4 v[8];
#pragma unroll
    for (int i = 0; i < 8; ++i) v[i] = *(const f32x4*)(W + (size_t)(k0 + 8 * i + kr) * ldw + scol0 + n4);
#pragma unroll
    for (int i = 0; i < 8; ++i) { const int kk = 8 * i + kr; const float g = gk ? gk[k0 + kk] : 1.0f; LAS float* d = scr + kk * 33 + n4; d[0] = v[i][0] * g; d[1] = v[i][1] * g; d[2] = v[i][2] * g; d[3] = v[i][3] * g; }
    LDS_WAIT(); asm volatile("" ::: "memory");
    const int c = lane & 7;
#pragma unroll
    for (int j = 0; j < 4; ++j) { const int n = (lane >> 3) + 8 * j; const LAS float* s = scr + (8 * c) * 33 + n;
        u32x4 o; o.x = pk2(s[0 * 33], s[1 * 33]); o.y = pk2(s[2 * 33], s[3 * 33]); o.z = pk2(s[4 * 33], s[5 * 33]); o.w = pk2(s[6 * 33], s[7 * 33]);
        *(u32x4*)(WT + (size_t)(drow0 + n) * ldt + k0 + 8 * c) = o; }
    LDS_WAIT(); asm volatile("" ::: "memory");
}
__device__ __forceinline__ int map1(int n) {
    const int tile = n >> 8, r = n & 255;
    if (tile == 0) return n;
    if (tile <= 2) { const int c = (tile - 1) * 128 + (r & 127); return (r < 128 ? 256 : 512) + c; }
    if (tile <= 8) return n;
    return n + 8;
}
__device__ __forceinline__ void convert_weights(Frame& F, int l) {
    LAS float* scr = (LAS float*)(F.lds + F.wave * 16384);
    const int gw = F.vcu * NWAVES + F.wave, NGW = F.G * NWAVES, lane = F.lane;
    const float* g1 = INP(I_N1G) + (size_t)l * D; const float* g2 = INP(I_N2G) + (size_t)l * D;
    unsigned char* ws = WSP();
#pragma unroll 1
    for (int it0 = gw; it0 < 9728; it0 += NGW) { int it = it0;
        if (it < 2688) { const int kb = it / 168, nb = it % 168; tr_item(INP(I_WIN) + (size_t)l * D * NIN, NIN, map1(nb * 32), g1, (bf16*)(ws + WS_W1T), 1024, nb * 32, kb * 64, scr, lane); continue; } it -= 2688;
        if (it < 128) { const int kb = it / 32, nb = it % 32; tr_item(INP(I_WOB) + (size_t)l * 256 * D, 1024, nb * 32, nullptr, (bf16*)(ws + WS_W3CT) + 256, 1024, nb * 32, kb * 64, scr, lane); continue; } it -= 128;
        if (it < 256) { const int kb = it / 32, nb = it % 32; tr_item(INP(I_WOC) + (size_t)l * 512 * D, 1024, nb * 32, nullptr, (bf16*)(ws + WS_W3CT) + 512, 1024, nb * 32, kb * 64, scr, lane); continue; } it -= 256;
        if (it < 512) { const int kb = it / 32, nb = it % 32; tr_item(INP(I_WO) + (size_t)l * D * D, 1024, nb * 32, nullptr, (bf16*)(ws + WS_WOT), 1024, nb * 32, kb * 64, scr, lane); continue; } it -= 512;
        if (it < 4096) { const int e = it >> 8, r = it & 255, kb = r >> 4, nb = r & 15, n0 = nb * 32, jt = n0 >> 8, rr = n0 & 255;
            const float* W = (rr < 128 ? INP(I_W1) : INP(I_W3)) + ((size_t)l * 16 + e) * D * 256;
            tr_item(W, 256, jt * 128 + (rr & 127), g2, (bf16*)(DOP() + DO_W13T) + (size_t)e * 512 * 1024, 1024, n0, kb * 64, scr, lane); continue; } it -= 4096;
        { const int e = it >> 7, r = it & 127, kb = r >> 5, nb = r & 31;
            tr_item(INP(I_W2) + ((size_t)l * 16 + e) * 256 * D, 1024, nb * 32, nullptr, (bf16*)(DOP() + DO_W2T) + (size_t)e * 1024 * 256, 256, nb * 32, kb * 64, scr, lane); }
    }
    { const float* pw = INP(I_PW) + (size_t)l * 4 * 64 * 64; const float* ps = INP(I_PS) + (size_t)l * 256; const float* pb = INP(I_PB) + (size_t)l * 256;
      const float* wa = INP(I_WOA) + (size_t)l * 256 * D; bf16* WT = (bf16*)(ws + WS_W3CT); float* bias = (float*)(ws + WS_BIASA);
      const int gt = F.vcu * 512 + F.tid, NT = F.G * 512;
      for (int idx = gt; idx < 256 * 1024; idx += NT) { const int n = idx & 1023, kk = idx >> 10, grp = kk >> 6, c = kk & 63; float s = 0.f;
#pragma unroll 16
        for (int d = 0; d < 64; ++d) s += pw[(grp * 64 + c) * 64 + d] * ps[grp * 64 + d] * wa[(size_t)(grp * 64 + d) * D + n];
        WT[(size_t)n * 1024 + kk] = (bf16)f2bf(s); }
      for (int n = gw; n < 1024; n += NGW) { float s = 0.f;
#pragma unroll
        for (int j = 0; j < 4; ++j) { const int d = lane + 64 * j; s += pb[d] * ps[d] * wa[(size_t)d * D + n]; }
        s = wave_sum(s); if (lane == 0) bias[n] = s; }
      float* wfg = (float*)(ws + WS_WFG); const float* win = INP(I_WIN) + (size_t)l * D * NIN;
      for (int idx = gt; idx < 8 * 1024; idx += NT) { const int c = idx >> 10, k = idx & 1023; wfg[idx] = g1[k] * win[(size_t)k * NIN + 2304 + c]; }
      float* rg = (float*)(ws + WS_RG); const float* re = INP(I_REW) + (size_t)l * D * 16; const float* rgw = INP(I_RGW) + (size_t)l * D * 4;
      for (int idx = gt; idx < 20 * 1024; idx += NT) { const int c = idx >> 10, k = idx & 1023; rg[idx] = g2[k] * (c < 16 ? re[(size_t)k * 16 + c] : rgw[(size_t)k * 4 + (c - 16)]); } }
}
__device__ __forceinline__ void init_rows(Frame& F) {
    const int gw = F.vcu * NWAVES + F.wave, NGW = F.G * NWAVES, lane = F.lane;
    bf16* HB = (bf16*)(WSP() + WS_HB); float* rstd1 = (float*)(WSP() + WS_RSTD1);
    constexpr int R = 4;
#pragma unroll 1
    for (int row0 = gw; row0 < TR; row0 += R * NGW) {
        f32x4 v[R][4];
#pragma unroll
        for (int r = 0; r < R; ++r) { int row = row0 + r * NGW; if (row >= TR) row = TR - 1;
            const float* src = row < TX ? INP(I_X) + (size_t)row * D : INP(I_META) + (size_t)(row - TX) * D;
#pragma unroll
            for (int j = 0; j < 4; ++j) v[r][j] = *(const f32x4*)(src + 4 * lane + 256 * j); }
#pragma unroll
        for (int r = 0; r < R; ++r) { const int row = row0 + r * NGW; float ss = 0.f;
#pragma unroll
            for (int j = 0; j < 4; ++j) ss += v[r][j][0] * v[r][j][0] + v[r][j][1] * v[r][j][1] + v[r][j][2] * v[r][j][2] + v[r][j][3] * v[r][j][3];
            ss = wave_sum(ss);
            if (row < TR) {
#pragma unroll
                for (int j = 0; j < 4; ++j) { u32x2 w; w.x = pk2(v[r][j][0], v[r][j][1]); w.y = pk2(v[r][j][2], v[r][j][3]); *(u32x2*)(HB + (size_t)row * D + 4 * lane + 256 * j) = w; }
                if (lane == 0) rstd1[row] = rsqrtf(ss * (1.0f / D) + EPS); } }
    }
    { bf16* Kb = (bf16*)(DOP() + DO_K) + (size_t)TR * 512; bf16* Vb = (bf16*)(DOP() + DO_V) + (size_t)TR * 512; const int gt = F.vcu * 512 + F.tid;
      if (gt < 48 * 64) { *(u32x4*)(Kb + (size_t)gt * 8) = (u32x4){0u, 0u, 0u, 0u}; *(u32x4*)(Vb + (size_t)gt * 8) = (u32x4){0u, 0u, 0u, 0u}; } }
}

__device__ __forceinline__ int srcrow(bool isx, int b, int t) {
    if (t >= 0) return (isx ? b * SEQ : TX) + t;
    if (isx) { const int mm = NMETA + t; return mm >= 0 ? TX + mm : -1; }
    return -1;
}
__device__ __forceinline__ void phase_S(Frame& F, int l) {
    LAS unsigned char* lds = F.lds; const int wave = F.wave;
#pragma unroll 1
    for (int item = F.vcu; item < 513; item += F.G) {
        const bool isx = item < 512; const int row0 = isx ? item * 64 : TX + (item - 512) * 64; const int b = isx ? (item * 64) / SEQ : 0; const int t0 = isx ? (item * 64) % SEQ : (item - 512) * 64; const int nrows = isx ? 64 : NMETA;
        { unsigned char* ws = WSP(); int tid = F.tid; LAUNDER_V(tid); const int lane = tid & 63;
          const bf16* HB = (const bf16*)(ws + WS_HB); const float* rstd1 = (const float*)(ws + WS_RSTD1); const float* wfg = (const float*)(ws + WS_WFG);
          float* LFT = (float*)(ws + WS_LFT); float* LFTM = (float*)(ws + WS_LFTM); const float* bfg = INP(I_BF) + l * 8;
          LAS float* W = (LAS float*)lds;
          { f32x4 wv_[4];
#pragma unroll
            for (int j = 0; j < 4; ++j) wv_[j] = *(const f32x4*)(wfg + 4 * (tid + 512 * j));
#pragma unroll
            for (int j = 0; j < 4; ++j) *(LAS f32x4*)(W + 4 * (tid + 512 * j)) = wv_[j]; }
          __syncthreads();
          { u32x4 xw[8][2]; float rsv[8];
#pragma unroll
            for (int i8 = 0; i8 < 8; ++i8) { const int rr = wave + 8 * i8; const int row = row0 + (rr < nrows ? rr : 0);
#pragma unroll
                for (int j = 0; j < 2; ++j) xw[i8][j] = *(const u32x4*)(HB + (size_t)row * D + 8 * lane + 512 * j);
                rsv[i8] = rstd1[row]; }
#pragma unroll
            for (int i8 = 0; i8 < 8; ++i8) { const int rr = wave + 8 * i8; const int row = row0 + rr; float xv[16];
#pragma unroll
              for (int j = 0; j < 2; ++j) { const u32x4 w = xw[i8][j];
                xv[8 * j + 0] = bflo(w.x); xv[8 * j + 1] = bfhi(w.x); xv[8 * j + 2] = bflo(w.y); xv[8 * j + 3] = bfhi(w.y); xv[8 * j + 4] = bflo(w.z); xv[8 * j + 5] = bfhi(w.z); xv[8 * j + 6] = bflo(w.w); xv[8 * j + 7] = bfhi(w.w); }
              float mine = 0.f;
#pragma unroll
              for (int c = 0; c < 8; ++c) { float sm = 0.f;
#pragma unroll
                for (int j = 0; j < 2; ++j) { const f32x4 w0 = *(const LAS f32x4*)(W + c * 1024 + 8 * lane + 512 * j), w1 = *(const LAS f32x4*)(W + c * 1024 + 8 * lane + 512 * j + 4);
                    sm += xv[8 * j] * w0[0] + xv[8 * j + 1] * w0[1] + xv[8 * j + 2] * w0[2] + xv[8 * j + 3] * w0[3] + xv[8 * j + 4] * w1[0] + xv[8 * j + 5] * w1[1] + xv[8 * j + 6] * w1[2] + xv[8 * j + 7] * w1[3]; }
                sm = wave_sum(sm); if (lane == c) mine = sm; }
              if (lane < 8 && rr < nrows && row < TR) { const float xg = mine * rsv[i8] + bfg[lane]; const float lf = fminf(xg, 0.f) - 0.69314718056f * __builtin_amdgcn_logf(1.0f + __expf(-fabsf(xg)));
                if (isx) LFT[(size_t)(b * 8 + lane) * SEQ + t0 + rr] = lf; else LFTM[lane * 256 + t0 + rr] = lf; } } }
          {
            const bf16* Qg = (const bf16*)(DOP() + DO_Q); const bf16* Kg = (const bf16*)(DOP() + DO_K); float kmx = 0.f, qmx = 0.f;
            u32x4 kw[8], qw[8];
#pragma unroll
            for (int i8 = 0; i8 < 8; ++i8) { const int rr = wave + 8 * i8; const int row = row0 + (rr < nrows ? rr : 0); kw[i8] = *(const u32x4*)(Kg + (size_t)row * 512 + 8 * lane); qw[i8] = *(const u32x4*)(Qg + (size_t)row * 512 + 8 * lane); }
#pragma unroll
            for (int i8 = 0; i8 < 8; ++i8) { const u32x4 a = kw[i8], c = qw[i8];
                float sk = (bflo(a.x) * bflo(a.x) + bfhi(a.x) * bfhi(a.x)) + (bflo(a.y) * bflo(a.y) + bfhi(a.y) * bfhi(a.y)) + (bflo(a.z) * bflo(a.z) + bfhi(a.z) * bfhi(a.z)) + (bflo(a.w) * bflo(a.w) + bfhi(a.w) * bfhi(a.w));
                float sq = (bflo(c.x) * bflo(c.x) + bfhi(c.x) * bfhi(c.x)) + (bflo(c.y) * bflo(c.y) + bfhi(c.y) * bfhi(c.y)) + (bflo(c.z) * bflo(c.z) + bfhi(c.z) * bfhi(c.z)) + (bflo(c.w) * bflo(c.w) + bfhi(c.w) * bfhi(c.w));
                sk += lane_xor<1>(sk); sk += lane_xor<2>(sk); sk += lane_xor<4>(sk); sq += lane_xor<1>(sq); sq += lane_xor<2>(sq); sq += lane_xor<4>(sq);
                kmx = fmaxf(kmx, sk); qmx = fmaxf(qmx, sq); }
            if ((lane & 7) == 0) { unsigned* nrm = (unsigned*)(WSP() + WS_CTL) + CW_NRM + l * 64; const int hd = lane >> 3;
                if (isx) { atomicMax(nrm + b * 8 + hd, __float_as_uint(kmx)); atomicMax(nrm + 32 + b * 8 + hd, __float_as_uint(qmx)); }
                else { for (int bb = 0; bb < NB; ++bb) atomicMax(nrm + bb * 8 + hd, __float_as_uint(kmx)); } } }
          __syncthreads(); }
        { unsigned char* ws = WSP(); int tid = F.tid; LAUNDER_V(tid);
          const bf16* Ab = (const bf16*)(ws + WS_A); bf16* DIFF = (bf16*)(ws + WS_X3);
          LAS unsigned char* T = lds;
          { u32x4 tv[5]; const int nld = (15 + nrows) * 32;
#pragma unroll
            for (int j = 0; j < 5; ++j) { const int i = tid + 512 * j; const int sl = i >> 5, ch = i & 31; const int r = i < nld ? srcrow(isx, b, t0 + sl - 15) : -1; unsigned z_ = 0u; LAUNDER_V(z_);
                tv[j] = r >= 0 ? *(const u32x4*)(Ab + (size_t)r * 256 + ch * 8) : (u32x4){z_, z_, z_, z_}; }
#pragma unroll
            for (int j = 0; j < 5; ++j) { const int i = tid + 512 * j; if (i < nld) *(LAS u32x4*)(T + (i >> 5) * 512 + (i & 31) * 16) = tv[j]; } }
          __syncthreads();
#pragma unroll 1
          for (int i = tid; i < nrows * 32; i += 512) { const int r = i >> 5, ch = i & 31, grp = ch >> 3, w = 2 << grp; const int cnt = isx ? w : min(t0 + r + 1, w);
              float s[8];
#pragma unroll
              for (int j = 0; j < 8; ++j) s[j] = 0.f;
#pragma unroll 1
              for (int d = 0; d < cnt; ++d) { const u32x4 v = *(const LAS u32x4*)(T + (15 + r - d) * 512 + ch * 16);
                  s[0] += bflo(v.x); s[1] += bfhi(v.x); s[2] += bflo(v.y); s[3] += bfhi(v.y); s[4] += bflo(v.z); s[5] += bfhi(v.z); s[6] += bflo(v.w); s[7] += bfhi(v.w); }
              const u32x4 a = *(const LAS u32x4*)(T + (15 + r) * 512 + ch * 16); const float ic = 1.0f / (float)cnt;
              u32x4 o; o.x = pk2(s[0] * ic - bflo(a.x), s[1] * ic - bfhi(a.x)); o.y = pk2(s[2] * ic - bflo(a.y), s[3] * ic - bfhi(a.y));
              o.z = pk2(s[4] * ic - bflo(a.z), s[5] * ic - bfhi(a.z)); o.w = pk2(s[6] * ic - bflo(a.w), s[7] * ic - bfhi(a.w));
              if (row0 + r < TR) *(u32x4*)(DIFF + (size_t)(row0 + r) * 1024 + ch * 8) = o; }
          __syncthreads(); }
        { unsigned char* ws = WSP(); int tid = F.tid; LAUNDER_V(tid);
          const bf16* GLU = (const bf16*)(ws + WS_GLU);
          LAS unsigned char* T = lds;
          LAS float* Yt = (LAS float*)(lds + 49152);
          { u32x4 tv[6]; const int nld = (isx ? 94 : 62) * 32;
#pragma unroll
            for (int j = 0; j < 6; ++j) { const int i = tid + 512 * j; const int sl = i >> 5, ch = i & 31; const int r = i < nld ? srcrow(isx, b, t0 + sl - 30) : -1; unsigned z_ = 0u; LAUNDER_V(z_);
                tv[j] = r >= 0 ? *(const u32x4*)(GLU + (size_t)r * 256 + ch * 8) : (u32x4){z_, z_, z_, z_}; }
#pragma unroll
            for (int j = 0; j < 6; ++j) { const int i = tid + 512 * j; if (i < nld) *(LAS u32x4*)(T + (i >> 5) * 512 + (i & 31) * 16) = tv[j]; } }
          __syncthreads();
          { const float* cw = INP(I_CW) + (size_t)l * 31 * 256; const float* cb = INP(I_CB) + l * 256;
            const int cp = tid & 127, strip = tid >> 7; f32x2 wv[31];
#pragma unroll
            for (int j = 0; j < 31; ++j) wv[j] = *(const f32x2*)(cw + j * 256 + 2 * cp);
            const f32x2 bias = *(const f32x2*)(cb + 2 * cp);
#pragma unroll 1
            for (int hh = 0; hh < (isx ? 2 : 1); ++hh) { const int rb = 32 * hh + 8 * strip; f32x2 acc[8];
#pragma unroll
                for (int r = 0; r < 8; ++r) acc[r] = bias;
#pragma unroll
                for (int i = 0; i < 38; ++i) { const unsigned xw = *(const LAS unsigned*)(T + (rb + i) * 512 + cp * 4); const f32x2 xx = {bflo(xw), bfhi(xw)};
#pragma unroll
                    for (int r = 0; r < 8; ++r) { const int j = i - r; if (j >= 0 && j <= 30) acc[r] += wv[j] * xx; } }
#pragma unroll
                for (int r = 0; r < 8; ++r) *(LAS f32x2*)(Yt + (rb + r) * 256 + 2 * cp) = acc[r]; } }
          __syncthreads();
          { unsigned char* ws2 = WSP(); int tid2 = F.tid; LAUNDER_V(tid2); const int lane = tid2 & 63;
            bf16* BP = (bf16*)(ws2 + WS_X3) + 256; const float* lng = INP(I_LNG) + l * 256; const float* lnb = INP(I_LNB) + l * 256;
            const f32x4 gg = *(const f32x4*)(lng + 4 * lane), bb = *(const f32x4*)(lnb + 4 * lane);
#pragma unroll 1
            for (int rr = wave; rr < nrows; rr += 8) { const f32x4 v = *(const LAS f32x4*)(Yt + rr * 256 + 4 * lane);
              const float mean = wave_sum(v[0] + v[1] + v[2] + v[3]) * (1.0f / 256.0f); const f32x4 dv = v - mean;
              const float var = wave_sum(dv[0] * dv[0] + dv[1] * dv[1] + dv[2] * dv[2] + dv[3] * dv[3]) * (1.0f / 256.0f); const float rs = rsqrtf(var + EPS);
              f32x4 o = dv * rs * gg + bb;
#pragma unroll
              for (int j = 0; j < 4; ++j) o[j] = o[j] * sigmoidf_(o[j]);
              u32x2 w; w.x = pk2(o[0], o[1]); w.y = pk2(o[2], o[3]); if (row0 + rr < TR) *(u32x2*)(BP + (size_t)(row0 + rr) * 1024 + 4 * lane) = w; } }
          __syncthreads(); }
    }
}

constexpr int AT_FL = 0, AT_K = 34816, AT_VT = AT_K + 8192, AT_SC = AT_VT + 8192;
__device__ __forceinline__ void attn_scan(Frame& F, int b, int h, bool meta_only, int fl_off, int sc_off) {
    LAS float* Fl = (LAS float*)(F.lds + fl_off); LAS float* sc = (LAS float*)(F.lds + sc_off);
    const float* LFT = (const float*)(WSP() + WS_LFT); const float* LFTM = (const float*)(WSP() + WS_LFTM);
    const int tid = F.tid, lane = F.lane, wave = F.wave;
    __syncthreads();
    if (tid == 0) { float s = 0.f; for (int m = 0; m < 64; ++m) { if (m < NMETA) { s += LFTM[h * 256 + m]; Fl[m] = s * LOG2E; } else Fl[m] = 1e30f; if (m == NMETA - 1) sc[16] = s; } }
    if (meta_only) { for (int i = tid; i < 256; i += 512) Fl[64 + i] = 0.f; __syncthreads(); return; }
    float v[16]; const float* src = LFT + (size_t)(b * 8 + h) * SEQ + 16 * tid;
#pragma unroll
    for (int j = 0; j < 4; ++j) { const f32x4 q = *(const f32x4*)(src + 4 * j); v[4 * j] = q[0]; v[4 * j + 1] = q[1]; v[4 * j + 2] = q[2]; v[4 * j + 3] = q[3]; }
#pragma unroll
    for (int j = 1; j < 16; ++j) v[j] += v[j - 1];
    float incl = v[15];
#pragma unroll
    for (int o = 1; o < 64; o <<= 1) { const float up = __int_as_float(__builtin_amdgcn_ds_bpermute((lane - o) << 2, __float_as_int(incl))); if (lane >= o) incl += up; }
    if (lane == 63) sc[wave] = incl;
    __syncthreads();
    float off = sc[16];
    for (int w = 0; w < wave; ++w) off += sc[w];
    off += incl - v[15];
#pragma unroll
    for (int j = 0; j < 16; ++j) Fl[64 + 16 * tid + j] = (off + v[j]) * LOG2E;
    __syncthreads();
}
__device__ __forceinline__ void attn_unit_naive(Frame& F, int qrow0, int qpos0, int ntiles, int kvx0, int h, int nq) {
    const int tid = F.tid; const int hf = tid & 1; const bool live = (tid >> 1) < nq; const int r = live ? (tid >> 1) : 0;
    const bf16* Q = (const bf16*)(DOP() + DO_Q); const bf16* Kg = (const bf16*)(DOP() + DO_K); const bf16* Vg = (const bf16*)(DOP() + DO_V); bf16* O = (bf16*)(WSP() + WS_X3) + 512;
    LAS float* Fl = (LAS float*)(F.lds + AT_FL); LAS unsigned char* Ks = F.lds + AT_K; LAS bf16* VT = (LAS bf16*)(F.lds + AT_VT);
    const int grow = qrow0 + r, qpos = qpos0 + r;
    unsigned qp[16];
#pragma unroll
    for (int j = 0; j < 4; ++j) { const u32x4 w = *(const u32x4*)(Q + (size_t)grow * 512 + h * 64 + hf * 32 + 8 * j); qp[4 * j] = w.x; qp[4 * j + 1] = w.y; qp[4 * j + 2] = w.z; qp[4 * j + 3] = w.w; }
    const float Fq = Fl[qpos < NMETA ? qpos : qpos + 48];
    float mrun = -1e30f, lrun = 0.f, o[32];
#pragma unroll
    for (int d = 0; d < 32; ++d) o[d] = 0.f;
    const int lrow = tid >> 3, lch = tid & 7;

#pragma unroll 1
for (int i = 0; i < ntiles; ++i) {
        const int krow = (i == 0 ? TX : kvx0 + 64 * (i - 1)) + lrow;
        const u32x4 kw = *(const u32x4*)(Kg + (size_t)krow * 512 + h * 64 + lch * 8);
        const u32x4 vw = *(const u32x4*)(Vg + (size_t)krow * 512 + h * 64 + lch * 8);
        __syncthreads();
        *(LAS u32x4*)(Ks + lrow * 128 + lch * 16) = kw;
        { const unsigned vv[4] = {vw.x, vw.y, vw.z, vw.w};
#pragma unroll
          for (int e = 0; e < 4; ++e) { VT[(lch * 8 + 2 * e) * 64 + lrow] = (bf16)(vv[e] & 0xffffu); VT[(lch * 8 + 2 * e + 1) * 64 + lrow] = (bf16)(vv[e] >> 16); } }
        __syncthreads();
        const int kp0 = i == 0 ? 0 : NMETA + 64 * (i - 1);
        if (kp0 > qpos0 + 255) continue;
#pragma unroll 1
        for (int jg = 0; jg < 4; ++jg) {
            float s[16]; float gmax = -1e30f;
#pragma unroll
            for (int jj = 0; jj < 16; ++jj) { const int j = jg * 16 + jj; float d = 0.f;
#pragma unroll
                for (int c = 0; c < 4; ++c) { const u32x4 kk = *(const LAS u32x4*)(Ks + j * 128 + hf * 64 + c * 16);
                    d = dot2bf(kk.x, qp[4 * c], d); d = dot2bf(kk.y, qp[4 * c + 1], d); d = dot2bf(kk.z, qp[4 * c + 2], d); d = dot2bf(kk.w, qp[4 * c + 3], d); }
                d += lane_xor<1>(d);
                const bool valid = (i == 0 ? j < NMETA : true) && (kp0 + j <= qpos);
                s[jj] = valid ? d + Fq - Fl[64 * i + j] : -1e30f; gmax = fmaxf(gmax, s[jj]); }
            const float mn = fmaxf(mrun, gmax), alpha = exp2f(mrun - mn); mrun = mn;
            float ps = 0.f; unsigned pp[8];
#pragma unroll
            for (int jj = 0; jj < 16; jj += 2) { const float p0 = exp2f(s[jj] - mn), p1 = exp2f(s[jj + 1] - mn); ps += p0 + p1; pp[jj >> 1] = pk2(p0, p1); }
            lrun = lrun * alpha + ps;
#pragma unroll
            for (int d = 0; d < 32; ++d) { const u32x4 v0 = *(const LAS u32x4*)(VT + (hf * 32 + d) * 64 + jg * 16), v1 = *(const LAS u32x4*)(VT + (hf * 32 + d) * 64 + jg * 16 + 8);
                float a = o[d] * alpha; a = dot2bf(pp[0], v0.x, a); a = dot2bf(pp[1], v0.y, a); a = dot2bf(pp[2], v0.z, a); a = dot2bf(pp[3], v0.w, a);
                a = dot2bf(pp[4], v1.x, a); a = dot2bf(pp[5], v1.y, a); a = dot2bf(pp[6], v1.z, a); a = dot2bf(pp[7], v1.w, a); o[d] = a; }
        }
    }
    const float il = 1.0f / lrun;
    if (live)
#pragma unroll
    for (int j = 0; j < 4; ++j) { u32x4 w; w.x = pk2(o[8 * j] * il, o[8 * j + 1] * il); w.y = pk2(o[8 * j + 2] * il, o[8 * j + 3] * il); w.z = pk2(o[8 * j + 4] * il, o[8 * j + 5] * il); w.w = pk2(o[8 * j + 6] * il, o[8 * j + 7] * il);
        *(u32x4*)(O + (size_t)grow * 1024 + h * 64 + hf * 32 + 8 * j) = w; }
}
namespace fa {
using bf16x8v = __attribute__((ext_vector_type(8))) short;
using s16x4 = __attribute__((ext_vector_type(4))) short;
using f32x16 = __attribute__((ext_vector_type(16))) float;
constexpr int DMA = 512, DMO = 1024;
constexpr int NW = 8, QBLK = 32, QB = 256, KVBLK = 64;
constexpr int NSLOT = 3, SLOTB = 8192;
constexpr int LDS_K = 0, LDS_V = NSLOT * SLOTB, LDS_WS = 2 * NSLOT * SLOTB, LDS_OST = LDS_WS + NW * 64 * 4, LDS_BYTES = LDS_OST + NW * 4096;
constexpr int LDS_FL = 84992;
constexpr int LDS_SCAN = LDS_FL + (64 + 8192) * 4;
static_assert(LDS_SCAN + 128 <= RING_BYTES, "attention LDS");
__device__ __forceinline__ int crow(int r, int hi) { return (r & 3) + 8 * (r >> 2) + 4 * hi; }
#define SBAR() __builtin_amdgcn_sched_barrier(0)
__device__ __forceinline__ void cmask(f32x16& p0, f32x16& p1, int jb, int qrel, int hi) {
    const float NEG = -INFINITY; int kb = 64 * jb + 4 * hi;
#pragma unroll
    for (int r = 0; r < 16; ++r) { int kv = kb + (r & 3) + 8 * (r >> 2); if (kv > qrel) p0[r] = NEG; if (kv + 32 > qrel) p1[r] = NEG; }
}
__device__ __forceinline__ void glds16(const void* gsrc, unsigned lds_dst) { unsigned keep;
    asm volatile("s_mov_b32 %0, m0\n\ts_mov_b32 m0, %2\n\ts_nop 0\n\tglobal_load_lds_dwordx4 %1, off\n\ts_mov_b32 m0, %0" : "=&s"(keep) : "v"(gsrc), "s"(lds_dst) : "memory"); }
__device__ __forceinline__ float max3f(float a, float b, float c) { float r; asm("v_max3_f32 %0, %1, %2, %3" : "=v"(r) : "v"(a), "v"(b), "v"(c)); return r; }
__device__ __forceinline__ float max2f(float a, float b) { float r; asm("v_max_f32_e32 %0, %1, %2" : "=v"(r) : "v"(a), "v"(b)); return r; }
__device__ __forceinline__ float fsub_s(float a, float b) { float r; asm("v_sub_f32_e32 %0, %1, %2" : "=v"(r) : "v"(a), "v"(b)); return r; }
typedef float f32x2_t __attribute__((ext_vector_type(2))); typedef __bf16 bf16x2_t __attribute__((ext_vector_type(2)));
__device__ __forceinline__ unsigned cvtpk_s(float lo, float hi) { f32x2_t v = {lo, hi}; bf16x2_t b = __builtin_convertvector(v, bf16x2_t); return __builtin_bit_cast(unsigned, b); }
#define WAIT_BAR(N) asm volatile("s_waitcnt vmcnt(" #N ") lgkmcnt(0)\n\ts_barrier" ::: "memory")
typedef __attribute__((address_space(3))) const char* lds_cptr;
typedef short v4i16_t __attribute__((ext_vector_type(4)));
__device__ __forceinline__ void cinit(f32x16& p0, f32x16& p1, const LAS float* fk, float a) {
#pragma unroll
    for (int g = 0; g < 4; ++g) { const f32x4 f0 = *(const LAS f32x4*)(fk + 8 * g), f1 = *(const LAS f32x4*)(fk + 32 + 8 * g);
#pragma unroll
        for (int i = 0; i < 4; ++i) { p0[4 * g + i] = a - f0[i]; p1[4 * g + i] = a - f1[i]; } }
}
__device__ __forceinline__ void qkt(f32x16& p0, f32x16& p1, const char* Kslot, const bf16x8v* qr, int r32, int hi) {
    const char* kb = Kslot + hi * 1024 + r32 * 16;
#pragma unroll
    for (int d0 = 0; d0 < 4; ++d0) {
        const bf16x8v b0 = *reinterpret_cast<const bf16x8v*>(kb + d0 * 2048);
        const bf16x8v b1 = *reinterpret_cast<const bf16x8v*>(kb + d0 * 2048 + 512);
        p0 = __builtin_amdgcn_mfma_f32_32x32x16_bf16(b0, qr[d0], p0, 0, 0, 0); p1 = __builtin_amdgcn_mfma_f32_32x32x16_bf16(b1, qr[d0], p1, 0, 0, 0); }
}
__device__ __forceinline__ void kload8(bf16x8v* kf, lds_cptr kp) {
    kf[0] = *(const LAS bf16x8v*)(kp);        kf[1] = *(const LAS bf16x8v*)(kp + 512);
    kf[2] = *(const LAS bf16x8v*)(kp + 2048); kf[3] = *(const LAS bf16x8v*)(kp + 2560);
    kf[4] = *(const LAS bf16x8v*)(kp + 4096); kf[5] = *(const LAS bf16x8v*)(kp + 4608);
    kf[6] = *(const LAS bf16x8v*)(kp + 6144); kf[7] = *(const LAS bf16x8v*)(kp + 6656);
}
__device__ __forceinline__ void kload2(bf16x8v* kf, lds_cptr kp, int j) { kf[2 * j] = *(const LAS bf16x8v*)(kp + j * 2048); kf[2 * j + 1] = *(const LAS bf16x8v*)(kp + j * 2048 + 512); }
__device__ __forceinline__ s16x4 vtr(lds_cptr p) { return __builtin_bit_cast(s16x4, __builtin_amdgcn_ds_read_tr16_b64_v4i16((LAS v4i16_t*)p)); }
__device__ __forceinline__ float rowmax(const f32x16& p0, const f32x16& p1) {
    float a = max3f(p0[0], p0[1], p1[0]), b = max3f(p0[2], p0[3], p1[1]); a = max3f(a, p1[2], p1[3]);
#pragma unroll
    for (int r = 4; r < 16; r += 4) { a = max3f(a, p0[r], p0[r + 1]); b = max3f(b, p0[r + 2], p0[r + 3]); a = max3f(a, p1[r], p1[r + 1]); b = max3f(b, p1[r + 2], p1[r + 3]); }
    const float m = max2f(a, b);
    auto rr = __builtin_amdgcn_permlane32_swap(__float_as_uint(m), __float_as_uint(m), false, false);
    return max2f(__uint_as_float(rr[0]), __uint_as_float(rr[1]));
}
__device__ __forceinline__ void pv(f32x16* o, int vb, bf16x8v pa0, bf16x8v pa1, bf16x8v pa2, bf16x8v pa3) {
#pragma unroll
    for (int d0 = 0; d0 < 2; ++d0) { s16x4 lo[4], hi[4];
#pragma unroll
        for (int ks = 0; ks < 4; ++ks) {
            asm volatile("ds_read_b64_tr_b16 %0,%1 offset:%c2" : "=&v"(lo[ks]) : "v"(vb), "i"(d0 * 4096 + ks * 1024) : "memory");
            asm volatile("ds_read_b64_tr_b16 %0,%1 offset:%c2" : "=&v"(hi[ks]) : "v"(vb), "i"(d0 * 4096 + ks * 1024 + 512) : "memory"); }
        asm volatile("s_waitcnt lgkmcnt(0)" ::: "memory"); SBAR();
#define PK(k) (bf16x8v){lo[k][0], lo[k][1], lo[k][2], lo[k][3], hi[k][0], hi[k][1], hi[k][2], hi[k][3]}
        o[d0] = __builtin_amdgcn_mfma_f32_32x32x16_bf16(pa0, PK(0), o[d0], 0, 0, 0);
        o[d0] = __builtin_amdgcn_mfma_f32_32x32x16_bf16(pa1, PK(1), o[d0], 0, 0, 0);
        o[d0] = __builtin_amdgcn_mfma_f32_32x32x16_bf16(pa2, PK(2), o[d0], 0, 0, 0);
        o[d0] = __builtin_amdgcn_mfma_f32_32x32x16_bf16(pa3, PK(3), o[d0], 0, 0, 0);
#undef PK
    }
}
template <int THRL> __device__ __forceinline__ void attn_unit(int b, int h, int qb, int tf, const bf16* Q, const bf16* __restrict__ K, const bf16* __restrict__ V, bf16* O, char* shm, int wid) {
    const int lane = lane_id_opaque(), r32 = lane & 31, hi = lane >> 5;
    const long rowbase = (long)b * SEQ; const int q0 = qb * QB;
    const bf16* Qw = Q + (rowbase + q0 + wid * QBLK) * DMA + h * 64;
    const bf16* Kh = K + rowbase * DMA + h * 64, *Vh = V + rowbase * DMA + h * 64;
    const bf16* Km = K + (long)TX * DMA + h * 64, *Vm = V + (long)TX * DMA + h * 64;
    const unsigned lds0 = (unsigned)(uintptr_t)shm;
    float* wsf = (float*)(shm + LDS_WS) + wid * 64;
    const bf16* ksrc = Kh + (long)lane * DMA + wid * 8;
    const bf16* vsrc = Vh + (long)(16 * (wid & 3) + (lane >> 2)) * DMA + (wid >> 2) * 32 + (lane & 3) * 8;
    const bf16* ksrcm = Km + (long)lane * DMA + wid * 8;
    const bf16* vsrcm = Vm + (long)(16 * (wid & 3) + (lane >> 2)) * DMA + (wid >> 2) * 32 + (lane & 3) * 8;
    const unsigned kdst = lds0 + LDS_K + wid * 1024, vdst = lds0 + LDS_V + wid * 1024;
#define DMA_K(t, slot) glds16(ksrc + (long)((t) - 1) * KVBLK * DMA, (unsigned)__builtin_amdgcn_readfirstlane(kdst + (slot)))
#define DMA_V(t, slot) glds16(vsrc + (long)((t) - 1) * KVBLK * DMA, (unsigned)__builtin_amdgcn_readfirstlane(vdst + (slot)))
    const int vb0 = (int)(lds0 + LDS_V) + ((lane >> 4) & 1) * 32 + (lane & 3) * 8 + (4 * hi + ((lane & 15) >> 2)) * 64;
    const char* Kbase = shm + LDS_K; bf16x8v kf[8];
    const lds_cptr shm3 = (lds_cptr)shm; const lds_cptr kp0 = shm3 + LDS_K + hi * 1024 + r32 * 16; const lds_cptr vp0 = shm3 + LDS_V + ((lane >> 4) & 1) * 32 + (lane & 3) * 8 + (4 * hi + ((lane & 15) >> 2)) * 64;
    const LAS float* Flp = (const LAS float*)(shm3 + LDS_FL) + 4 * hi;
    const int NT = 4 * qb + 5;
    glds16(tf == 0 ? ksrcm : ksrc + (long)(tf - 1) * KVBLK * DMA, (unsigned)__builtin_amdgcn_readfirstlane(kdst)); glds16(tf == 0 ? vsrcm : vsrc + (long)(tf - 1) * KVBLK * DMA, (unsigned)__builtin_amdgcn_readfirstlane(vdst)); DMA_K(tf + 1, SLOTB);
    bf16x8v qr[4];
#pragma unroll
    for (int d0 = 0; d0 < 4; ++d0) qr[d0] = *reinterpret_cast<const bf16x8v*>(&Qw[(long)r32 * DMA + d0 * 16 + hi * 8]);
    float aq = ((const LAS float*)(shm3 + LDS_FL))[64 + q0 + wid * QBLK + r32 - 64 * tf];
    float l_reg = 0.f; f32x16 o[2]; o[0] = f32x16{}; o[1] = f32x16{};
    const int qrel = wid * QBLK + r32;
#define CMASK(P0, P1, t) do { int jb_ = (t) - (NT - 4); if (jb_ >= 0) cmask(P0, P1, jb_, qrel, hi); } while (0)
    bool resc = false;
#define START(P0, P1) do { const float rm = rowmax(P0, P1); resc = false; \
    { const float dl = max2f(rm, 0.f); aq = fsub_s(aq, dl);        \
      _Pragma("unroll") for (int r = 0; r < 16; ++r) { P0[r] = fsub_s(P0[r], dl); P1[r] = fsub_s(P1[r], dl); } } \
    _Pragma("unroll") for (int r = 0; r < 16; ++r) P0[r] = __builtin_amdgcn_exp2f(P0[r]); } while (0)
#define RESC() do { if (resc) { asm volatile("s_waitcnt lgkmcnt(0)" ::: "memory"); \
      _Pragma("unroll") for (int d_ = 0; d_ < 2; ++d_) _Pragma("unroll") for (int r = 0; r < 16; ++r) o[d_][r] *= wsf[crow(r, hi)]; } } while (0)
    f32x16 pA0, pA1, pB0, pB1;
    int sl_prev = 0, sl_cur = 0, sl_next = SLOTB;
#define ROT() do { sl_prev = sl_cur; sl_cur = sl_next; sl_next = (sl_next == (NSLOT - 1) * SLOTB) ? 0 : sl_next + SLOTB; } while (0)
    DMA_K(tf + 2, 2 * SLOTB);
    cinit(pA0, pA1, Flp, aq);
    WAIT_BAR(3);
    qkt(pA0, pA1, Kbase, qr, r32, hi); asm volatile("s_nop 15\n\ts_nop 7" : "+v"(pA0), "+v"(pA1));
    START(pA0, pA1);
    _Pragma("unroll") for (int r = 0; r < 16; ++r) pA1[r] = __builtin_amdgcn_exp2f(pA1[r]);
    WAIT_BAR(0);
    DMA_K(tf + 3, 0); DMA_V(tf + 1, SLOTB);
    ROT();
    kload8(kf, kp0 + sl_cur);
    WAIT_BAR(2);
    s16x4 vlo[8], vhi[8]; u32x4 pw0, pw1, pw2, pw3;
#define PKW(P, B) cvtpk_s(P[B], P[B + 1])
#define PAF(k) __builtin_bit_cast(bf16x8v, pw##k)
#define VFR(i) (bf16x8v){vlo[i][0], vlo[i][1], vlo[i][2], vlo[i][3], vhi[i][0], vhi[i][1], vhi[i][2], vhi[i][3]}
#define PIN(x) asm volatile("" : "+v"(x))
#define MX3(a, b, c) __builtin_fmaxf(__builtin_fmaxf((a), (b)), (c))
#define GAPA(MF, A0, A1, A2, A3, W0, W1, PW) do { MF; sacc += A0; sacc += A1; sacc += A2; sacc += A3; PIN(sacc); W0; W1; PIN(PW); SBAR(); } while (0)
#define EX(v) __builtin_amdgcn_exp2f(v)
#define GAPB(MF, X, B) do { MF; X[B] = EX(X[B]); X[B + 1] = EX(X[B + 1]); X[B + 2] = EX(X[B + 2]); X[B + 3] = EX(X[B + 3]); PIN(X); SBAR(); } while (0)
#define VRD(i) do { vlo[i] = vtr(vp_ + (((i) >> 2) * 4096 + ((i) & 3) * 1024)); vhi[i] = vtr(vp_ + (((i) >> 2) * 4096 + ((i) & 3) * 1024 + 512)); } while (0)
#define KRD(G, j) do { if (G) { kload2(kf, kp0 + sl_next, j); SBAR(); } } while (0)
#define STEP(C0, C1, P0, P1, t, GK, GV, GL) do { SBAR(); \
    cinit(C0, C1, Flp + 64 * ((t) - tf), aq); SBAR(); \
    const lds_cptr vp_ = vp0 + sl_prev; \
    VRD(0); SBAR(); float sacc = (P0[0] + P0[1]); \
    GAPA(C0 = __builtin_amdgcn_mfma_f32_32x32x16_bf16(kf[0], qr[0], C0, 0, 0, 0), P0[2], P0[3], P0[4], P0[5],     pw0[0] = PKW(P0, 0), pw0[1] = PKW(P0, 2), pw0); \
    VRD(4); SBAR(); GAPA(C1 = __builtin_amdgcn_mfma_f32_32x32x16_bf16(kf[1], qr[0], C1, 0, 0, 0), P0[6], P0[7], P0[8], P0[9],     pw0[2] = PKW(P0, 4), pw0[3] = PKW(P0, 6), pw0); \
    VRD(1); SBAR(); GAPA(C0 = __builtin_amdgcn_mfma_f32_32x32x16_bf16(kf[2], qr[1], C0, 0, 0, 0),   P0[10], P0[11], P0[12], P0[13], pw1[0] = PKW(P0, 8), pw1[1] = PKW(P0, 10), pw1); \
    VRD(5); SBAR(); GAPA(C1 = __builtin_amdgcn_mfma_f32_32x32x16_bf16(kf[3], qr[1], C1, 0, 0, 0),   P0[14], P0[15], P1[0], P1[1],   pw1[2] = PKW(P0, 12), pw1[3] = PKW(P0, 14), pw1); \
    VRD(2); SBAR(); GAPA(C0 = __builtin_amdgcn_mfma_f32_32x32x16_bf16(kf[4], qr[2], C0, 0, 0, 0),   P1[2], P1[3], P1[4], P1[5],     pw2[0] = PKW(P1, 0), pw2[1] = PKW(P1, 2), pw2); \
    VRD(6); SBAR(); GAPA(C1 = __builtin_amdgcn_mfma_f32_32x32x16_bf16(kf[5], qr[2], C1, 0, 0, 0),   P1[6], P1[7], P1[8], P1[9],     pw2[2] = PKW(P1, 4), pw2[3] = PKW(P1, 6), pw2); \
    VRD(3); SBAR(); GAPA(C0 = __builtin_amdgcn_mfma_f32_32x32x16_bf16(kf[6], qr[3], C0, 0, 0, 0),   P1[10], P1[11], P1[12], P1[13], pw3[0] = PKW(P1, 8), pw3[1] = PKW(P1, 10), pw3); \
    VRD(7); SBAR(); GAPA(C1 = __builtin_amdgcn_mfma_f32_32x32x16_bf16(kf[7], qr[3], C1, 0, 0, 0),   P1[14], P1[15], 0.f, 0.f,       pw3[2] = PKW(P1, 12), pw3[3] = PKW(P1, 14), pw3); \
    l_reg += sacc; \
    if (GK) { DMA_K((t) + 3, sl_cur); } if (GV) { DMA_V((t) + 1, sl_next); } \
    CMASK(C0, C1, t); \
    { float a = MX3(C0[0], C0[1], C1[0]), b_ = MX3(C0[2], C0[3], C1[1]); a = MX3(a, C1[2], C1[3]); \
      _Pragma("unroll") for (int r = 4; r < 16; r += 4) { a = MX3(a, C0[r], C0[r + 1]); b_ = MX3(b_, C0[r + 2], C0[r + 3]); a = MX3(a, C1[r], C1[r + 1]); b_ = MX3(b_, C1[r + 2], C1[r + 3]); } \
      float rm = __builtin_fmaxf(a, b_); { auto rr = __builtin_amdgcn_permlane32_swap(__float_as_uint(rm), __float_as_uint(rm), false, false); rm = __builtin_fmaxf(__uint_as_float(rr[0]), __uint_as_float(rr[1])); } \
      resc = false; \
      if (__builtin_expect(__any(rm > (float)THRL), 0)) { const float dl = __builtin_fmaxf(rm, 0.f); aq -= dl; \
        _Pragma("unroll") for (int r = 0; r < 16; ++r) { C0[r] -= dl; C1[r] -= dl; } \
        const float f = __builtin_amdgcn_exp2f(-dl); l_reg *= f; if (hi == 0) wsf[r32] = f; resc = true; } } \
    SBAR(); \
    GAPB(o[0] = __builtin_amdgcn_mfma_f32_32x32x16_bf16(PAF(0), VFR(0), o[0], 0, 0, 0), C0, 0); \
    GAPB(o[1] = __builtin_amdgcn_mfma_f32_32x32x16_bf16(PAF(0), VFR(4), o[1], 0, 0, 0), C0, 4); \
    KRD(GL, 0); GAPB(o[0] = __builtin_amdgcn_mfma_f32_32x32x16_bf16(PAF(1), VFR(1), o[0], 0, 0, 0), C0, 8); \
    KRD(GL, 1); GAPB(o[1] = __builtin_amdgcn_mfma_f32_32x32x16_bf16(PAF(1), VFR(5), o[1], 0, 0, 0), C0, 12); \
    KRD(GL, 2); GAPB(o[0] = __builtin_amdgcn_mfma_f32_32x32x16_bf16(PAF(2), VFR(2), o[0], 0, 0, 0), C1, 0); \
    KRD(GL, 3); GAPB(o[1] = __builtin_amdgcn_mfma_f32_32x32x16_bf16(PAF(2), VFR(6), o[1], 0, 0, 0), C1, 4); \
    GAPB(o[0] = __builtin_amdgcn_mfma_f32_32x32x16_bf16(PAF(3), VFR(3), o[0], 0, 0, 0), C1, 8); \
    GAPB(o[1] = __builtin_amdgcn_mfma_f32_32x32x16_bf16(PAF(3), VFR(7), o[1], 0, 0, 0), C1, 12); \
    } while (0)
    int t = tf + 1;
#undef CMASK
#define CMASK(P0, P1, t) do { } while (0)
    for (; t + 5 < NT; t += 2) {
        STEP(pB0, pB1, pA0, pA1, t, true, true, true);     WAIT_BAR(2); RESC(); ROT();
        STEP(pA0, pA1, pB0, pB1, t + 1, true, true, true); WAIT_BAR(2); RESC(); ROT();
    }
#undef CMASK
#define CMASK(P0, P1, t) do { int jb_ = (t) - (NT - 4); if (jb_ >= 0) cmask(P0, P1, jb_, qrel, hi); } while (0)
#define ENDW(tt) do { if ((tt) + 3 < NT) { WAIT_BAR(2); } else if ((tt) + 2 < NT) { WAIT_BAR(1); } else { WAIT_BAR(0); } } while (0)
    for (; t + 1 < NT; t += 2) {
        STEP(pB0, pB1, pA0, pA1, t, (t + 3 < NT), (t + 1 < NT), (t + 1 < NT));         ENDW(t);     RESC(); ROT();
        STEP(pA0, pA1, pB0, pB1, t + 1, (t + 4 < NT), (t + 2 < NT), (t + 2 < NT));     ENDW(t + 1); RESC(); ROT();
    }
    { float sacc = pA0[0] + pA0[1]; _Pragma("unroll") for (int r = 2; r < 16; ++r) sacc += pA0[r]; _Pragma("unroll") for (int r = 0; r < 16; ++r) sacc += pA1[r]; l_reg += sacc;
      pw0 = (u32x4){PKW(pA0, 0), PKW(pA0, 2), PKW(pA0, 4), PKW(pA0, 6)}; pw1 = (u32x4){PKW(pA0, 8), PKW(pA0, 10), PKW(pA0, 12), PKW(pA0, 14)}; pw2 = (u32x4){PKW(pA1, 0), PKW(pA1, 2), PKW(pA1, 4), PKW(pA1, 6)}; pw3 = (u32x4){PKW(pA1, 8), PKW(pA1, 10), PKW(pA1, 12), PKW(pA1, 14)};
      SBAR(); pv(o, vb0 + sl_prev, PAF(0), PAF(1), PAF(2), PAF(3)); }
#undef PKW
#undef PAF
#undef VFR
#undef PIN
#undef MX3
#undef GAPA
#undef GAPB
#undef EX
#undef VRD
#undef KRD
#undef STEP
#undef ENDW
    { auto rr = __builtin_amdgcn_permlane32_swap(__float_as_uint(l_reg), __float_as_uint(l_reg), false, false); l_reg = __uint_as_float(rr[0]) + __uint_as_float(rr[1]); }
    if (hi == 0) wsf[32 + r32] = l_reg; asm volatile("s_waitcnt lgkmcnt(0)" ::: "memory");
    float rli[16];
#pragma unroll
    for (int r = 0; r < 16; ++r) rli[r] = __builtin_amdgcn_rcpf(wsf[32 + crow(r, hi)]);
    bf16* Ow = O + (rowbase + q0 + wid * QBLK) * DMO + h * 64;
    { bf16* stg = (bf16*)(shm + LDS_OST) + wid * 2048;
#pragma unroll
      for (int r = 0; r < 16; ++r) { const int orow = crow(r, hi);
#pragma unroll
          for (int d0 = 0; d0 < 2; ++d0) stg[orow * 64 + d0 * 32 + r32] = (bf16)f2bf(o[d0][r] * rli[r]); }
      asm volatile("s_waitcnt lgkmcnt(0)" ::: "memory");
#pragma unroll
      for (int i = 0; i < 4; ++i) { const int row = i * 8 + (lane >> 3), ch = lane & 7; const u32x4 v = *(const u32x4*)(stg + row * 64 + ch * 8); *(u32x4*)(Ow + (long)row * DMO + ch * 8) = v; } }
    asm volatile("s_waitcnt lgkmcnt(0)\n\ts_barrier" ::: "memory");
#undef DMA_K
#undef DMA_V
#undef CMASK
#undef START
#undef RESC
#undef ROT
}
#undef SBAR
#undef WAIT_BAR
}
__device__ __forceinline__ void phase_scan(Frame& F) {
#pragma unroll 1
    for (int bh = F.vcu; bh < 32; bh += F.G) {
        attn_scan(F, bh >> 3, bh & 7, false, fa::LDS_FL, fa::LDS_SCAN);
        const LAS float* Fl = (const LAS float*)(F.lds + fa::LDS_FL); float* FLg = (float*)(WSP() + WS_FL) + (size_t)bh * FLN;
#pragma unroll 1
        for (int i = F.tid; i < FLN / 4; i += 512) *(f32x4*)(FLg + 4 * i) = *(const LAS f32x4*)(Fl + 4 * i);
    }
    __syncthreads();
}
__device__ __forceinline__ void phase_B(Frame& F, int l) {
    LAS int* qs = (LAS int*)(F.lds + LC_QS);
    unsigned* ctl = (unsigned*)(WSP() + WS_CTL); unsigned* head = ctl + CW_AQ + l * 64; const unsigned* nrm = ctl + CW_NRM + l * 64;
    const float* FLg = (const float*)(WSP() + WS_FL);
#pragma unroll 1
    for (;;) {
        __syncthreads();
        if (F.tid == 0) { qs[0] = (int)atomicAdd(head, 1u); qs[1] = 0; }
        __syncthreads();
        const int u = __builtin_amdgcn_readfirstlane(qs[0]);
        if (u >= 1032) break;
        if (u < 1024) {
            const int qb = 31 - (u >> 5), bh = u & 31, b = bh >> 3, h = bh & 7, NT = 4 * qb + 5;
            const float kn = __uint_as_float(__hip_atomic_load(nrm + bh, __ATOMIC_RELAXED, __HIP_MEMORY_SCOPE_AGENT)), qn = __uint_as_float(__hip_atomic_load(nrm + 32 + bh, __ATOMIC_RELAXED, __HIP_MEMORY_SCOPE_AGENT));
            const float T = 50.0f + sqrtf(kn * qn);
            const float* FLb = FLg + (size_t)bh * FLN; const float Fq0 = FLb[64 + 256 * qb];
            { const int t = F.tid; const bool skip = (t <= NT - 5) && (FLb[t == 0 ? 15 : 64 * t + 63] > Fq0 + T);
              const int c = __builtin_popcountll(__ballot(skip)); if (F.lane == 0 && c) __hip_atomic_fetch_add(&qs[1], c, __ATOMIC_RELAXED, __HIP_MEMORY_SCOPE_WORKGROUP); }
            __syncthreads();
            int tf = __builtin_amdgcn_readfirstlane(qs[1]); if (((NT - tf) & 1) == 0) tf -= 1;
            { LAS float* Fl = (LAS float*)(F.lds + fa::LDS_FL); const int n4 = (NT - tf) * 16;
#pragma unroll 1
              for (int i = F.tid; i < n4; i += 512) *(LAS f32x4*)(Fl + 4 * i) = *(const f32x4*)(FLb + 64 * tf + 4 * i); }
            __syncthreads();
            unsigned char* dol = DOP();
            fa::attn_unit<8>(b, h, qb, tf, (const bf16*)(dol + DO_Q), (const bf16*)(dol + DO_K), (const bf16*)(dol + DO_V), (bf16*)(WSP() + WS_X3) + 512, (char*)F.lds, F.wave);
        } else {
            const int t_ = F.wave * 64 + lane_id_opaque(); F.tid = t_; F.lane = t_ & 63;
            attn_scan(F, 0, u - 1024, true, AT_FL, AT_SC); attn_unit_naive(F, TX, 0, 1, 0, u - 1024, NMETA);
        }
    }
    __syncthreads();
}

__device__ __forceinline__ void class_tables(Frame& F, int l) {
    LAS int* base = (LAS int*)(F.lds + LC_BASE); LAS int* pcls = (LAS int*)(F.lds + LC_PCLS); LAS int* np = (LAS int*)(F.lds + LC_NP);
    const unsigned* gcnt = (const unsigned*)(WSP() + WS_CTL) + CW_GCNT + l * 64;
    __syncthreads();
    if (F.tid == 0) { int p = 0;
#pragma unroll 1
        for (int c = 0; c < NCLS; ++c) { base[c] = p * 256; int n = (int)__hip_atomic_load(gcnt + c, __ATOMIC_RELAXED, __HIP_MEMORY_SCOPE_AGENT); if (n > TR) n = TR; if (n < 0) n = 0; p += (n + 255) >> 8; }
        if (p > 160) p = 160; base[NCLS] = p * 256; np[0] = p; }
    __syncthreads();
    if (F.tid < 160) { const int mypos = F.tid * 256; int c = 0;
#pragma unroll 1
        for (int k = 1; k < NCLS; ++k) if (base[k] <= mypos) c = k;
        pcls[F.tid] = c; }
    __syncthreads();
}
constexpr int RPITCH = 1032;
__device__ __forceinline__ void phase_E1(Frame& F, int l) {
    LAS bf16* Rhi = (LAS bf16*)F.lds; LAS bf16* Rlo = Rhi + 20 * RPITCH;
    LAS int* rec = (LAS int*)(F.lds + 83968);
    LAS int* lcnt = (LAS int*)(F.lds + LC_CNT); LAS int* wgb = (LAS int*)(F.lds + LC_BASE);
    const float* rg = (const float*)(WSP() + WS_RG);
    const float* reb = INP(I_REB) + l * 16; const float* rgb = INP(I_RGB) + l * 4;
    unsigned* gcnt = (unsigned*)(WSP() + WS_CTL) + CW_GCNT + l * 64; int* route = (int*)(WSP() + WS_ROUTE);
    const int tid = F.tid, lane = F.lane, wave = F.wave, fr = lane & 15, fq = lane >> 4;
    { f32x4 rv[10];
#pragma unroll
      for (int j = 0; j < 10; ++j) rv[j] = *(const f32x4*)(rg + 4 * (tid + 512 * j));
#pragma unroll
      for (int j = 0; j < 10; ++j) { const int i = 4 * (tid + 512 * j), c = i >> 10, k = i & 1023; u32x2 hw, lw; float hf[4];
#pragma unroll
          for (int e = 0; e < 4; ++e) hf[e] = __builtin_bit_cast(float, (pk2(rv[j][e], 0.f) & 0xffffu) << 16);
          hw.x = pk2(rv[j][0], rv[j][1]); hw.y = pk2(rv[j][2], rv[j][3]); lw.x = pk2(rv[j][0] - hf[0], rv[j][1] - hf[1]); lw.y = pk2(rv[j][2] - hf[2], rv[j][3] - hf[3]);
          *(LAS u32x2*)(Rhi + c * RPITCH + k) = hw; *(LAS u32x2*)(Rlo + c * RPITCH + k) = lw; } }
#pragma unroll 1
    for (int wg = F.vcu; wg < 256; wg += F.G) {
        if (tid < NCLS) lcnt[tid] = 0;
        __syncthreads();
        const int ngrp = wg == 0 ? 9 : 8;
#pragma unroll 1
        for (int grp = wave; grp < ngrp; grp += 8) {
            const int row = grp < 8 ? wg * 128 + grp * 16 + fr : TX + fr;
            const float* hsrc = l == 0 ? (row < TX ? INP(I_X) + (size_t)row * D : INP(I_META) + (size_t)(row - TX) * D) : (const float*)(WSP() + WS_H) + (size_t)row * D;
            float* hdst = (float*)(WSP() + WS_H) + (size_t)row * D; bf16* hbdst = (bf16*)(WSP() + WS_HB) + (size_t)row * D; const bf16* dsrc = (const bf16*)(WSP() + WS_X3) + (size_t)row * D;
            const LAS bf16* bh0 = Rhi + fr * RPITCH + 8 * fq; const LAS bf16* bl0 = Rlo + fr * RPITCH + 8 * fq;
            const LAS bf16* bh1 = Rhi + (16 + (fr & 3)) * RPITCH + 8 * fq; const LAS bf16* bl1 = Rlo + (16 + (fr & 3)) * RPITCH + 8 * fq;
            f32x4 acc0 = {0.f, 0.f, 0.f, 0.f}, acc1 = {0.f, 0.f, 0.f, 0.f}; float ss = 0.f;
#pragma unroll 8
            for (int s = 0; s < 32; ++s) { const int k = 32 * s + 8 * fq;
                f32x4 h0 = *(const f32x4*)(hsrc + k), h1 = *(const f32x4*)(hsrc + k + 4); const u32x4 dv = *(const u32x4*)(dsrc + k);
                h0[0] += bflo(dv.x); h0[1] += bfhi(dv.x); h0[2] += bflo(dv.y); h0[3] += bfhi(dv.y); h1[0] += bflo(dv.z); h1[1] += bfhi(dv.z); h1[2] += bflo(dv.w); h1[3] += bfhi(dv.w);
                ss += (h0[0] * h0[0] + h0[1] * h0[1]) + (h0[2] * h0[2] + h0[3] * h0[3]) + (h1[0] * h1[0] + h1[1] * h1[1]) + (h1[2] * h1[2] + h1[3] * h1[3]);
                *(f32x4*)(hdst + k) = h0; *(f32x4*)(hdst + k + 4) = h1;
                const u32x4 hw = pack8(h0, h1); *(u32x4*)(hbdst + k) = hw;
                f32x4 r0, r1; r0[0] = h0[0] - bflo(hw.x); r0[1] = h0[1] - bfhi(hw.x); r0[2] = h0[2] - bflo(hw.y); r0[3] = h0[3] - bfhi(hw.y);
                r1[0] = h1[0] - bflo(hw.z); r1[1] = h1[1] - bfhi(hw.z); r1[2] = h1[2] - bflo(hw.w); r1[3] = h1[3] - bfhi(hw.w);
                const u32x4 lw = pack8(r0, r1);
                const bf16x8 ah = __builtin_bit_cast(bf16x8, hw), al = __builtin_bit_cast(bf16x8, lw);
                const bf16x8 wh0 = *(const LAS bf16x8*)(bh0 + 32 * s), wl0 = *(const LAS bf16x8*)(bl0 + 32 * s);
                bf16x8 wh1 = *(const LAS bf16x8*)(bh1 + 32 * s), wl1 = *(const LAS bf16x8*)(bl1 + 32 * s);
                if (fr >= 4) { wh1 = (bf16x8){0, 0, 0, 0, 0, 0, 0, 0}; wl1 = wh1; }
                acc0 = __builtin_amdgcn_mfma_f32_16x16x32_bf16(wh0, ah, acc0, 0, 0, 0); acc0 = __builtin_amdgcn_mfma_f32_16x16x32_bf16(wh0, al, acc0, 0, 0, 0); acc0 = __builtin_amdgcn_mfma_f32_16x16x32_bf16(wl0, ah, acc0, 0, 0, 0);
                acc1 = __builtin_amdgcn_mfma_f32_16x16x32_bf16(wh1, ah, acc1, 0, 0, 0); acc1 = __builtin_amdgcn_mfma_f32_16x16x32_bf16(wh1, al, acc1, 0, 0, 0); acc1 = __builtin_amdgcn_mfma_f32_16x16x32_bf16(wl1, ah, acc1, 0, 0, 0);
            }
            ss += lane_xor<16>(ss); ss += lane_xor<32>(ss);
            const float rstd2 = rsqrtf(ss * (1.0f / D) + EPS);
            float gl[4];
#pragma unroll
            for (int g = 0; g < 4; ++g) gl[g] = __int_as_float(__builtin_amdgcn_ds_bpermute(fr << 2, __float_as_int(acc1[g]))) * rstd2 + rgb[g];
            int gsel = 0; float gmax = gl[0];
#pragma unroll
            for (int g = 1; g < 4; ++g) if (gl[g] > gmax) { gmax = gl[g]; gsel = g; }
            float gsum = 0.f;
#pragma unroll
            for (int g = 0; g < 4; ++g) gsum += __expf(gl[g] - gmax);
            const float gwt = 1.0f / gsum;
            if (fq == gsel) {
                float el[4];
#pragma unroll
                for (int e = 0; e < 4; ++e) el[e] = acc0[e] * rstd2 + reb[gsel * 4 + e];
                int t1 = 0; float l1 = el[0];
#pragma unroll
                for (int e = 1; e < 4; ++e) if (el[e] > l1) { l1 = el[e]; t1 = e; }
                int t2 = -1; float l2 = -3.0e38f;
#pragma unroll
                for (int e = 0; e < 4; ++e) if (e != t1 && el[e] > l2) { l2 = el[e]; t2 = e; }
                const float w1 = 1.0f / (1.0f + __expf(l2 - l1)), w2 = 1.0f - w1;
                const int ea = min(t1, t2), eb = max(t1, t2); const float cA = gwt * (t1 == ea ? w1 : w2), cB = gwt * (t1 == ea ? w2 : w1);
                const int pr = ea == 0 ? eb - 1 : (ea == 1 ? eb + 1 : 5); int cls = gsel * 6 + pr; if (!(cls >= 0 && cls < NCLS)) cls = 0;
                const int rank = __hip_atomic_fetch_add(&lcnt[cls], 1, __ATOMIC_RELAXED, __HIP_MEMORY_SCOPE_WORKGROUP); const int rr = grp * 16 + fr;
                rec[rr * 5] = cls; rec[rr * 5 + 1] = rank; rec[rr * 5 + 2] = __float_as_int(cA); rec[rr * 5 + 3] = __float_as_int(cB); rec[rr * 5 + 4] = __float_as_int(rstd2);
            }
        }
        __syncthreads();
        if (tid < NCLS) { const int n = lcnt[tid]; wgb[tid] = n > 0 ? (int)atomicAdd(gcnt + tid, (unsigned)n) : 0; }
        __syncthreads();
        const int nrw = ngrp * 16;
        for (int rr = tid; rr < nrw; rr += 512) { const int row = rr < 128 ? wg * 128 + rr : TX + (rr - 128); const int cls = rec[rr * 5];
            int* rp = route + (size_t)row * 8; rp[0] = cls; rp[1] = wgb[cls] + rec[rr * 5 + 1]; rp[2] = rec[rr * 5 + 2]; rp[3] = rec[rr * 5 + 3]; rp[4] = rec[rr * 5 + 4]; }
        __syncthreads();
    }
}
__device__ __forceinline__ void phase_E1b(Frame& F, int l) {
    class_tables(F, l);
    const LAS int* base = (const LAS int*)(F.lds + LC_BASE);
    const int* route = (const int*)(WSP() + WS_ROUTE); const bf16* HB = (const bf16*)(WSP() + WS_HB); bf16* XS = (bf16*)(WSP() + WS_XS); float* PW = (float*)(WSP() + WS_PW);
    const int gw = F.vcu * NWAVES + F.wave, NGW = F.G * NWAVES, lane = F.lane;
    constexpr int R = 4;
#pragma unroll 1
    for (int row0 = gw; row0 < TR; row0 += R * NGW) {
        int rowv[R], pos[R]; u32x4 hw[R][2];
#pragma unroll
        for (int r = 0; r < R; ++r) { const int row = row0 + r * NGW; rowv[r] = row < TR ? row : TR - 1; const int* rp = route + (size_t)rowv[r] * 8; pos[r] = base[rp[0]] + rp[1];
#pragma unroll
            for (int j = 0; j < 2; ++j) hw[r][j] = *(const u32x4*)(HB + (size_t)rowv[r] * D + 8 * lane + 512 * j); }
#pragma unroll
        for (int r = 0; r < R; ++r) { const int row = row0 + r * NGW; if (row >= TR || pos[r] < 0 || pos[r] >= NPOSMAX) continue;
#pragma unroll
            for (int j = 0; j < 2; ++j) *(u32x4*)(XS + (size_t)pos[r] * D + 8 * lane + 512 * j) = hw[r][j];
            if (lane == 0) { const int* rp = route + (size_t)row * 8; f32x4 w; w[0] = __int_as_float(rp[4]); w[1] = __int_as_float(rp[2]); w[2] = __int_as_float(rp[3]); w[3] = 0.f; *(f32x4*)(PW + (size_t)pos[r] * 4) = w; } }
    }
}
__device__ __forceinline__ void phase_E4(Frame& F, int l) {
    class_tables(F, l);
    const LAS int* base = (const LAS int*)(F.lds + LC_BASE);
    const int* route = (const int*)(WSP() + WS_ROUTE); float* H = (float*)(WSP() + WS_H); bf16* HB = (bf16*)(WSP() + WS_HB); const bf16* Y = (const bf16*)(WSP() + WS_Y);
    float* rstd1 = (float*)(WSP() + WS_RSTD1); const float* fg = INP(I_FG); float* out = (float*)DOP();
    const int gw = F.vcu * NWAVES + F.wave, NGW = F.G * NWAVES, lane = F.lane; const bool lastl = (l == DEPTH - 1);
    constexpr int R = 4;
#pragma unroll 1
    for (int row0 = gw; row0 < TR; row0 += R * NGW) {
        int rowv[R], pos[R];
#pragma unroll
        for (int r = 0; r < R; ++r) { const int row = row0 + r * NGW; rowv[r] = row < TR ? row : TR - 1; const int* rp = route + (size_t)rowv[r] * 8; int p = base[rp[0]] + rp[1]; if (p < 0 || p >= NPOSMAX) p = 0; pos[r] = p; }
        u32x4 yw[R][2]; f32x4 hv[R][2][2];
#pragma unroll
        for (int r = 0; r < R; ++r)
#pragma unroll
            for (int j = 0; j < 2; ++j) { yw[r][j] = *(const u32x4*)(Y + (size_t)pos[r] * D + 8 * lane + 512 * j);
                hv[r][j][0] = *(const f32x4*)(H + (size_t)rowv[r] * D + 8 * lane + 512 * j); hv[r][j][1] = *(const f32x4*)(H + (size_t)rowv[r] * D + 8 * lane + 512 * j + 4); }
#pragma unroll
        for (int r = 0; r < R; ++r) { const int row = row0 + r * NGW; float ss = 0.f;
#pragma unroll
            for (int j = 0; j < 2; ++j) { const u32x4 w = yw[r][j];
                hv[r][j][0][0] += bflo(w.x); hv[r][j][0][1] += bfhi(w.x); hv[r][j][0][2] += bflo(w.y); hv[r][j][0][3] += bfhi(w.y);
                hv[r][j][1][0] += bflo(w.z); hv[r][j][1][1] += bfhi(w.z); hv[r][j][1][2] += bflo(w.w); hv[r][j][1][3] += bfhi(w.w);
#pragma unroll
                for (int q = 0; q < 2; ++q) ss += hv[r][j][q][0] * hv[r][j][q][0] + hv[r][j][q][1] * hv[r][j][q][1] + hv[r][j][q][2] * hv[r][j][q][2] + hv[r][j][q][3] * hv[r][j][q][3]; }
            const float rs = rsqrtf(wave_sum(ss) * (1.0f / D) + EPS);
            if (row < TR) {
                if (!lastl) {
#pragma unroll
                    for (int j = 0; j < 2; ++j) { *(f32x4*)(H + (size_t)row * D + 8 * lane + 512 * j) = hv[r][j][0]; *(f32x4*)(H + (size_t)row * D + 8 * lane + 512 * j + 4) = hv[r][j][1];
                        *(u32x4*)(HB + (size_t)row * D + 8 * lane + 512 * j) = pack8(hv[r][j][0], hv[r][j][1]); }
                    if (lane == 0) rstd1[row] = rs;
                } else if (row < TX) {
#pragma unroll
                    for (int j = 0; j < 2; ++j) { const f32x4 g0 = *(const f32x4*)(fg + 8 * lane + 512 * j), g1 = *(const f32x4*)(fg + 8 * lane + 512 * j + 4);
                        *(f32x4*)(out + (size_t)row * D + 8 * lane + 512 * j) = hv[r][j][0] * rs * g0; *(f32x4*)(out + (size_t)row * D + 8 * lane + 512 * j + 4) = hv[r][j][1] * rs * g1; }
                }
            }
        }
    }
}
#define RELANE() do { const int t_ = wv0 * 64 + lane_id_opaque(); F.tid = t_; F.lane = t_ & 63; F.wave = __builtin_amdgcn_readfirstlane(t_ >> 6); \
    int g_ = gridDim.x; LAUNDER_S(g_); int b_ = blockIdx.x; LAUNDER_S(b_); F.G = g_; F.bx = b_; F.vcu = (g_ % 8 == 0) ? (b_ % 8) * (g_ / 8) + b_ / 8 : b_; ll = l; LAUNDER_S(ll); } while (0)
__global__ void __launch_bounds__(NWAVES * 64, 2) fwd_kernel(Params P) {
    extern __shared__ __attribute__((aligned(16))) unsigned char lds_raw[];
    Frame F;
    F.lds = (LAS unsigned char*)lds_raw;
    F.tid = threadIdx.x; F.lane = F.tid & 63; F.wave = __builtin_amdgcn_readfirstlane(F.tid >> 6);
    F.G = gridDim.x; { const int bx = blockIdx.x; F.vcu = (F.G % 8 == 0) ? (bx % 8) * (F.G / 8) + bx / 8 : bx; }
    if (F.tid == 0) { LAS unsigned long long* pt = (LAS unsigned long long*)(F.lds + LC_PTAB);
#pragma unroll
        for (int i = 0; i < 25; ++i) pt[i] = (unsigned long long)P.in[i];
        pt[25] = (unsigned long long)P.ws; pt[26] = (unsigned long long)P.out; }
    for (int u = F.tid; u < 256; u += NWAVES * 64) ((LAS unsigned*)(F.lds + RING_BYTES))[u] = 0u;
    __syncthreads();
    const int lo = P.ph_lo, hi = P.ph_hi;
    const bool use_bar = (hi - lo) > 1;
    unsigned* barw = (unsigned*)(P.ws + WS_CTL) + CW_BAR;
    XcdBarrier bar; bar.bar = barw; bar.x = 0; bar.st = (volatile LAS unsigned*)(F.lds + LC_BAR);
    if (use_bar) bar = xcd_barrier_post(barw, (volatile LAS unsigned*)(F.lds + LC_BAR));
#ifndef PHASE_MASK
#define PHASE_MASK 0xfff
#endif
#define EN(j) (((PHASE_MASK) >> (j)) & 1)
#ifndef DUP_MASK
#define DUP_MASK 0
#endif
#define NREP(j) ((((DUP_MASK) >> (j)) & 1) ? 2 : 1)
#define IN(k) (lo <= (k) && (k) < hi)
#define SEAM(k) do { if (IN(k) && IN((k) + 1)) xcd_barrier(bar); } while (0)

    int l = 0, ll = 0; const int wv0 = __builtin_amdgcn_readfirstlane((int)threadIdx.x >> 6);
    if (EN(0) && IN(0)) { RELANE(); convert_weights(F, 0); RELANE(); init_rows(F); }
    SEAM(0);
    for (l = 0; l < DEPTH; ++l) {
        const int pb = 1 + 11 * l;
        for (int rep = 0; rep < NREP(1); ++rep)
        if (EN(1) && IN(pb + 0)) {
            RELANE();
            unsigned char* wsl = WSP(); unsigned char* dol = DOP();
            pg8::Gemm g{(const bf16*)(wsl + WS_HB), 1024, 1024, 1 << 20};
            pg8::StaticOrder S; S.init(TX, N1, F.G, F.bx, (const bf16*)(wsl + WS_W1T), 1024);
            Epi1 E{(const float*)(wsl + WS_RSTD1), (bf16*)(wsl + WS_A), (bf16*)(wsl + WS_GLU), (bf16*)(dol + DO_Q), (bf16*)(wsl + WS_G)};
            pg8::gemm_phase<Epi1, pg8::StaticOrder>(F.lds, g, S, E, F.wave);
            if (F.bx >= 128 && F.bx < 128 + 21 && F.wave < 4) {
                const int pn = F.bx - 128, l2 = lane_id_opaque(); AccT acc; skinny_zero(acc);
                skinny_k<true>(acc, (const bf16*)(wsl + WS_HB) + (size_t)TX * 1024, 1024, (const bf16*)(wsl + WS_W1T) + (size_t)pn * 256 * 1024, 1024, 1024, F.wave, l2 & 15, l2 >> 4);
                E.run<true>(acc, pg8::Unit{128, pn, 0}, 0, F.wave, l2 & 15, l2 >> 4);
            }
        }
        SEAM(pb + 0);
        for (int rep = 0; rep < NREP(2); ++rep)
        if (EN(2) && IN(pb + 1)) { RELANE(); phase_S(F, ll); }
        SEAM(pb + 1);
        if (EN(3) && IN(pb + 2)) { RELANE(); phase_scan(F); }
        SEAM(pb + 2);
        for (int rep = 0; rep < NREP(3); ++rep)
        if (EN(4) && IN(pb + 3)) { RELANE(); phase_B(F, ll); }
        SEAM(pb + 3);
        for (int rep = 0; rep < NREP(4); ++rep)
        if (EN(5) && IN(pb + 4)) {
            RELANE(); unsigned char* wsl = WSP(); unsigned char* dol = DOP();
            pg8::Gemm g{(const bf16*)(wsl + WS_X3), 1024, 1024, 1 << 20}; pg8::SegOrder S; S.init(TX, 1024, F.G, F.bx, (const bf16*)(wsl + WS_W3CT), 1024);
            EpiCS E{(const bf16*)(wsl + WS_G), (bf16*)(dol + DO_MERGED), (const float*)(wsl + WS_BIASA)}; pg8::gemm_phase<EpiCS, pg8::SegOrder>(F.lds, g, S, E, F.wave);
            if (F.bx >= 16 && F.bx < 20 && F.wave < 4) {
                const int pn = F.bx - 16, l2 = lane_id_opaque(); AccT acc; skinny_zero(acc);
#pragma unroll 1
                for (int seg = 0; seg < 3; ++seg) { const size_t ko = seg == 0 ? 0 : (seg == 1 ? 256 : 512);
                    skinny_k<true>(acc, (const bf16*)(wsl + WS_X3) + (size_t)TX * 1024 + ko, 1024, (const bf16*)(wsl + WS_W3CT) + (size_t)pn * 256 * 1024 + ko, 1024, seg == 2 ? 512 : 256, F.wave, l2 & 15, l2 >> 4);
                    E.run<true>(acc, pg8::Unit{128, pn, seg}, 0, F.wave, l2 & 15, l2 >> 4); }
            }
        }
        SEAM(pb + 4);
        if (EN(6) && IN(pb + 5)) {
            RELANE();
            unsigned char* wsl = WSP(); unsigned char* dol = DOP();
            pg8::Gemm g{(const bf16*)(dol + DO_MERGED), 1024, 1024, 1 << 20}; pg8::StaticOrder S; S.init(TX, 1024, F.G, F.bx, (const bf16*)(wsl + WS_WOT), 1024);
            EpiB2 E{(bf16*)(wsl + WS_X3)}; pg8::gemm_phase<EpiB2, pg8::StaticOrder>(F.lds, g, S, E, F.wave);
            if (F.bx >= 16 && F.bx < 20 && F.wave < 4) {
                const int pn = F.bx - 16, l2 = lane_id_opaque(); AccT acc; skinny_zero(acc);
                skinny_k<true>(acc, (const bf16*)(dol + DO_MERGED) + (size_t)TX * 1024, 1024, (const bf16*)(wsl + WS_WOT) + (size_t)pn * 256 * 1024, 1024, 1024, F.wave, l2 & 15, l2 >> 4);
                E.run<true>(acc, pg8::Unit{128, pn, 0}, 0, F.wave, l2 & 15, l2 >> 4);
            }
        }
        SEAM(pb + 5);
        if (EN(7) && IN(pb + 6)) { RELANE(); phase_E1(F, ll); }
        SEAM(pb + 6);
        for (int rep = 0; rep < NREP(7); ++rep)
        if (EN(8) && IN(pb + 7)) { RELANE(); phase_E1b(F, ll); }
        SEAM(pb + 7);
        for (int rep = 0; rep < NREP(8); ++rep)
        if (EN(9) && IN(pb + 8)) {
            RELANE(); class_tables(F, ll);
            unsigned char* wsl = WSP();
            const int NP = __builtin_amdgcn_readfirstlane(*(const LAS int*)(F.lds + LC_NP));
            pg8::Gemm g{(const bf16*)(wsl + WS_XS), 1024, 1024, 1 << 20};
            MoeOrder S{NP, F.G, F.vcu, 0, (const LAS int*)(F.lds + LC_PCLS), (const bf16*)(DOP() + DO_W13T)};
            EpiA2 E{(const float*)(wsl + WS_PW), (bf16*)(wsl + WS_HH)}; pg8::gemm_phase<EpiA2, MoeOrder>(F.lds, g, S, E, F.wave);
        }
        SEAM(pb + 8);
        for (int rep = 0; rep < NREP(9); ++rep)
        if (EN(10) && IN(pb + 9)) {
            RELANE(); class_tables(F, ll);
            unsigned char* wsl = WSP();
            const int NP = __builtin_amdgcn_readfirstlane(*(const LAS int*)(F.lds + LC_NP));
            pg8::Gemm g{(const bf16*)(wsl + WS_HH), 512, 256, 4};
            MoeOrder S{NP, F.G, F.vcu, 1, (const LAS int*)(F.lds + LC_PCLS), (const bf16*)(DOP() + DO_W2T)};
            EpiB2 E{(bf16*)(wsl + WS_Y)}; pg8::gemm_phase<EpiB2, MoeOrder>(F.lds, g, S, E, F.wave);
        }
        SEAM(pb + 9);
        if (EN(11) && IN(pb + 10)) { RELANE(); phase_E4(F, ll); if (l + 1 < DEPTH) { RELANE(); convert_weights(F, ll + 1); } }
        SEAM(pb + 10);
    }
#undef IN
#undef SEAM
}

constexpr int N_PHASES = 1 + 11 * DEPTH;

extern "C" void kernel_launch(void* const* d_in, const int* in_sizes, int n_in, void* d_out, int out_size, void* d_ws, size_t ws_size, hipStream_t stream) {
    static int grid = 0;
    if (grid == 0) {
        if (n_in != 25 || out_size != TX * D || ws_size < WS_END) { fprintf(stderr, "kernel_launch: unexpected shapes: n_in %d out %d ws %zu (need %zu)\n", n_in, out_size, ws_size, (size_t)WS_END); grid = -1; return; }
        int dev = 0, cus = 0, per_cu = 0;
        if (hipGetDevice(&dev) != hipSuccess || hipDeviceGetAttribute(&cus, hipDeviceAttributeMultiprocessorCount, dev) != hipSuccess) { grid = -1; return; }
        if (hipFuncSetAttribute((const void*)fwd_kernel, hipFuncAttributeMaxDynamicSharedMemorySize, LDS_BYTES) != hipSuccess) { fprintf(stderr, "kernel_launch: hipFuncSetAttribute failed\n"); grid = -1; return; }
        if (hipOccupancyMaxActiveBlocksPerMultiprocessor(&per_cu, (const void*)fwd_kernel, NWAVES * 64, LDS_BYTES) != hipSuccess || per_cu < 1) fprintf(stderr, "kernel_launch: occupancy query reports %d\n", per_cu);
        (void)hipGetLastError();
        grid = cus;
    }
    if (grid < 0) return;
    (void)hipMemsetAsync((char*)d_ws + WS_CTL, 0, CTL_BYTES, stream);
    Params p{};
    for (int i = 0; i < 25; ++i) p.in[i] = (const float*)d_in[i];
    p.out = (float*)d_out; p.ws = (unsigned char*)d_ws;
#if N_LAUNCH_MODE == 1
    p.ph_lo = 0; p.ph_hi = N_PHASES;
    hipLaunchKernelGGL(fwd_kernel, dim3(grid), dim3(NWAVES * 64), LDS_BYTES, stream, p);
#else
    for (int ph = 0; ph < N_PHASES; ++ph) { p.ph_lo = ph; p.ph_hi = ph + 1; hipLaunchKernelGGL(fwd_kernel, dim3(grid), dim3(NWAVES * 64), LDS_BYTES, stream, p); }
#endif
}
```

```cpp
#include <hip/hip_runtime.h>
#include <cstdio>
#include <cstdint>

#ifndef N_LAUNCH_MODE
#define N_LAUNCH_MODE 1
#endif

#define GAS __attribute__((address_space(1)))
#define LAS __attribute__((address_space(3)))
typedef unsigned short bf16;
typedef float f32x4 __attribute__((ext_vector_type(4)));
typedef float f32x2 __attribute__((ext_vector_type(2)));
typedef unsigned u32x4 __attribute__((ext_vector_type(4)));
typedef unsigned u32x2 __attribute__((ext_vector_type(2)));
typedef short bf16x8 __attribute__((ext_vector_type(8)));
typedef __bf16 bf16x2v __attribute__((ext_vector_type(2)));

constexpr int D = 1024, NB = 4, SEQ = 8192, NMETA = 16, DEPTH = 2;
constexpr int TX = NB * SEQ;
constexpr int TM = TX + 64;
constexpr int TR = TX + NMETA;
constexpr int NIN = 5384, N1 = 5376;
constexpr int NHEAD = 8;
constexpr int NCLS = 24;
constexpr int NPOSMAX = TX + 256 + NCLS * 256;
constexpr float EPS = 1e-6f;
constexpr float LOG2E = 1.4426950408889634f;
constexpr float C2 = 0.125f * LOG2E;
constexpr int NWAVES = 8;

constexpr size_t U = (size_t)TM * 1024 * 2;
constexpr size_t WS_CTL = 0, CTL_BYTES = 1u << 20;
constexpr size_t WS_H = CTL_BYTES;
constexpr size_t WS_HB = WS_H + 2 * U;
constexpr size_t WS_G = WS_HB + U;
constexpr size_t WS_XS = WS_G;
constexpr size_t WS_Y = WS_XS + (size_t)NPOSMAX * 2048;
constexpr size_t WS_HH = WS_Y + (size_t)NPOSMAX * 2048;
static_assert(WS_HH + (size_t)NPOSMAX * 1024 <= WS_G + 3 * U, "MoE overlay fits the gates region");
constexpr size_t WS_A = WS_G + 3 * U;
constexpr size_t WS_GLU = WS_A + U / 4;
constexpr size_t WS_X3 = WS_GLU + U / 4;
constexpr size_t WS_W1T = WS_X3 + U;
constexpr size_t WS_W3CT = WS_W1T + (size_t)N1 * 1024 * 2;
constexpr size_t WS_WOT = WS_W3CT + 1024 * 1024 * 2;
constexpr size_t WS_WFG = WS_WOT + 1024 * 1024 * 2;
constexpr size_t WS_RG = WS_WFG + 8 * 1024 * 4;
constexpr size_t WS_BIASA = WS_RG + 20 * 1024 * 4;
constexpr size_t WS_RSTD1 = WS_BIASA + 4096;
constexpr size_t WS_ROUTE = WS_RSTD1 + (size_t)TM * 4;
constexpr size_t WS_PW = WS_ROUTE + (size_t)TM * 32;
constexpr size_t WS_LFT = WS_PW + (size_t)NPOSMAX * 16;
constexpr size_t WS_LFTM = WS_LFT + (size_t)32 * 8192 * 4;
constexpr size_t WS_FL = WS_LFTM + 8 * 256 * 4;
constexpr int FLN = 64 + SEQ;
constexpr size_t WS_END = WS_FL + (size_t)32 * FLN * 4;
static_assert(WS_END <= (size_t)512 * 1024 * 1024, "d_ws map fits 512 MiB");
constexpr size_t DO_Q = 0, DO_K = U / 2, DO_V = U, DO_MERGED = U / 2;
constexpr size_t DO_W13T = 3 * U / 2;
constexpr size_t DO_W2T = DO_W13T + (size_t)16 * 512 * 1024 * 2;
static_assert(DO_W2T + (size_t)16 * 1024 * 256 * 2 <= (size_t)TX * 1024 * 4, "d_out scratch");
constexpr int CW_BAR = 4096, CW_GCNT = 16384, CW_NRM = 20480  , CW_AQ = 24576  ;

constexpr int RPITCH = 1032;
constexpr int RING_BYTES = 131072;
constexpr int LC_BAR = RING_BYTES, LC_CNT = RING_BYTES + 64, LC_BASE = RING_BYTES + 192, LC_PCLS = RING_BYTES + 320, LC_NP = RING_BYTES + 960;
constexpr int LC_QS = RING_BYTES + 976;
constexpr int LC_NMX = RING_BYTES + 1280;
constexpr int LC_PTAB = RING_BYTES + 1024;
constexpr int LDS_BYTES = RING_BYTES + 1024 + 7168;

#define LDS_WAIT() asm volatile("s_waitcnt lgkmcnt(0)" ::: "memory")
#define VM_WAIT() asm volatile("s_waitcnt vmcnt(0)" ::: "memory")
#define LAUNDER_S(p) asm volatile("" : "+s"(p))
#define LAUNDER_V(x) asm volatile("" : "+v"(x))
__device__ __forceinline__ int lane_id_opaque() { int x; asm volatile("v_mbcnt_lo_u32_b32 %0, -1, 0\n\tv_mbcnt_hi_u32_b32 %0, -1, %0" : "=v"(x)); return x; }

__device__ __forceinline__ unsigned f2bf(float f) { unsigned u = __builtin_bit_cast(unsigned, f); return (u + 0x7fffu + ((u >> 16) & 1u)) >> 16; }
__device__ __forceinline__ unsigned pk2(float lo, float hi) { f32x2 v = {lo, hi}; bf16x2v b = __builtin_convertvector(v, bf16x2v); return __builtin_bit_cast(unsigned, b); }
__device__ __forceinline__ float bflo(unsigned w) { return __builtin_bit_cast(float, w << 16); }
__device__ __forceinline__ float bfhi(unsigned w) { return __builtin_bit_cast(float, w & 0xffff0000u); }
template <int O> __device__ __forceinline__ float lane_xor(float v) {
    if constexpr (O < 32) return __int_as_float(__builtin_amdgcn_ds_swizzle(__float_as_int(v), (O << 10) | 0x1f));
    else { auto rr = __builtin_amdgcn_permlane32_swap(__float_as_uint(v), __float_as_uint(v), false, false); return __uint_as_float(rr[0]) + __uint_as_float(rr[1]) - v; }
}
__device__ __forceinline__ float wave_sum(float v) {
    v += lane_xor<1>(v); v += lane_xor<2>(v); v += lane_xor<4>(v); v += lane_xor<8>(v); v += lane_xor<16>(v);
    auto rr = __builtin_amdgcn_permlane32_swap(__float_as_uint(v), __float_as_uint(v), false, false);
    return __uint_as_float(rr[0]) + __uint_as_float(rr[1]);
}
__device__ __forceinline__ float sigmoidf_(float x) { return __builtin_amdgcn_rcpf(1.0f + __builtin_amdgcn_exp2f(-LOG2E * x)); }
__device__ __forceinline__ float dot2bf(unsigned a, unsigned b, float acc) { return __builtin_amdgcn_fdot2_f32_bf16(__builtin_bit_cast(bf16x2v, a), __builtin_bit_cast(bf16x2v, b), acc, false); }

namespace pg8 {
constexpr int BM = 256, BK = 64, HALF = 128, HTB = HALF * BK * 2, STAGE_BYTES = 8 * HTB, NXCD = 8, WGM = 8;
__host__ __device__ __forceinline__ int lds_byte(int r, int c) { const int st = (r >> 4) * 2 + (c >> 5), rr = r & 15, cc = c & 31, ob = rr * 64 + cc * 2; return st * 1024 + (ob ^ (((ob >> 9) & 1) << 5)); }
__host__ __device__ __forceinline__ void stage_rc(int b, int& R, int& C) { const int st = b / 1024, sb = b % 1024, swz = sb ^ (((sb >> 9) & 1) << 5); R = (st >> 1) * 16 + swz / 64; C = (st & 1) * 32 + (swz % 64) / 2; }
__host__ __device__ __forceinline__ int perm32(int rho) { const int n = rho >> 4, i = rho & 15; return 8 * (i >> 2) + 4 * n + (i & 3); }

struct Unit { int pm, pn, seg; };
struct Gemm { const bf16* A; int K; int ldb; int ksplit; };

struct StaticOrder {
    int nM, nN, nwg, G, c; const bf16* Bt; size_t btile;
    __device__ void init(int M, int N, int G_, int c_, const bf16* Bt_, int ldb) { nM = M / BM; nN = N / BM; nwg = nM * nN; G = G_; c = c_; Bt = Bt_; btile = (size_t)BM * ldb * 2; }
    __device__ bool next(int i, Unit& u) const {
        const long L = (long)i * G + c; if (L >= nwg) return false;
        int wgid = (int)L; { const int q = nwg / NXCD, r = nwg % NXCD, xcd = wgid % NXCD, off = wgid / NXCD; wgid = (xcd < r ? xcd * (q + 1) : r * (q + 1) + (xcd - r) * q) + off; }
        const int nig = WGM * nN, gid = wgid / nig, fm = gid * WGM, gsz = (nM - fm) < WGM ? (nM - fm) : WGM;
        u.pm = fm + ((wgid % nig) % gsz); u.pn = (wgid % nig) / gsz; u.seg = 0; return true;
    }
    __device__ __forceinline__ const char* bptr(const Unit& u, int) const { return (const char*)Bt + (size_t)u.pn * btile; }
    __device__ __forceinline__ int nt(const Unit&, int ntd) const { return ntd; }
    __device__ __forceinline__ size_t aoff(const Unit&) const { return 0; }
};
struct SegOrder : StaticOrder {
    __device__ bool next(int i, Unit& u) const { const int q = i / 3; if (!StaticOrder::next(q, u)) return false; u.seg = i - 3 * q; return true; }
    __device__ __forceinline__ size_t koff(const Unit& u) const { return u.seg == 0 ? 0 : (u.seg == 1 ? 512 : 1024); }
    __device__ __forceinline__ const char* bptr(const Unit& u, int) const { return (const char*)Bt + (size_t)u.pn * btile + koff(u); }
    __device__ __forceinline__ int nt(const Unit& u, int) const { return u.seg == 2 ? 8 : 4; }
    __device__ __forceinline__ size_t aoff(const Unit& u) const { return koff(u); }
};

template <class Epi, class Sched, bool ALIGN_EPI = true, bool SP2 = true>
__device__ __forceinline__ void gemm_phase(LAS unsigned char* lds, const Gemm g, const Sched& S, const Epi& E, const int wave_id) {
    const int tid = wave_id * 64 + lane_id_opaque();
    const int wid = __builtin_amdgcn_readfirstlane(tid >> 6), lane = tid & 63, wr = wid >> 2, wc = wid & 3, fr = lane & 15, fq = lane >> 4;
    const int K = g.K, nt = K / BK, ldb = g.ldb, ks = g.ksplit;
    unsigned voffA[2], voffB[2];
#pragma unroll
    for (int i = 0; i < 2; ++i) { int R, C; stage_rc(tid * 16 + i * 8192, R, C); const int Rb = Epi::PERM ? ((R & ~31) + perm32(R & 31)) : R;
        voffA[i] = (unsigned)(R * K + C) * 2u; voffB[i] = (unsigned)(Rb * ldb + C) * 2u; }
    const size_t kstep = (size_t)(BK * 2);
    const size_t hstep = (size_t)HALF * K * 2;
    const size_t hstepB = (size_t)HALF * ldb * 2;
    const size_t tstep = 2 * hstep;
    const unsigned ldsw = (unsigned)wid * 1024u;
    const int aoff = lds_byte(wr * 64 + fr, fq * 8), boff = lds_byte(wc * 32 + fr, fq * 8);
#define PG8_SA(b, h) (((b) * 2 + (h)) * HTB)
#define PG8_SB(b, h) ((4 + (b) * 2 + (h)) * HTB)
#define PG8_STAGE(bufoff, gbase, voff) do { _Pragma("unroll") for (int _i = 0; _i < 2; ++_i) \
        __builtin_amdgcn_global_load_lds((const unsigned*)((const char*)(gbase) + (voff)[_i]), (LAS unsigned*)(lds + (bufoff) + ldsw + _i * 8192), 16, 0, 0); } while (0)
#define PG8_LDA(dst, b, h) do { _Pragma("unroll") for (int m = 0; m < 4; ++m) _Pragma("unroll") for (int k = 0; k < 2; ++k) dst[m][k] = *(const LAS bf16x8*)(lds + PG8_SA(b, h) + aoff + m * 2048 + k * 1024); } while (0)
#define PG8_LDB(dst, b, h) do { _Pragma("unroll") for (int n = 0; n < 2; ++n) _Pragma("unroll") for (int k = 0; k < 2; ++k) dst[n][k] = *(const LAS bf16x8*)(lds + PG8_SB(b, h) + boff + n * 2048 + k * 1024); } while (0)
#define PG8_MMA(ai, bj, At, Bt) do { __builtin_amdgcn_s_setprio(1); _Pragma("unroll") for (int m = 0; m < 4; ++m) _Pragma("unroll") for (int n = 0; n < 2; ++n) _Pragma("unroll") for (int k = 0; k < 2; ++k) \
        acc[ai][bj][m][n] = __builtin_amdgcn_mfma_f32_16x16x32_bf16(Bt[n][k], At[m][k], acc[ai][bj][m][n], 0, 0, 0); __builtin_amdgcn_s_setprio(0); } while (0)
#define PG8_WAIT_V(n) asm volatile("s_waitcnt vmcnt(" #n ")" ::: "memory")
#define PG8_WAIT_L(n) asm volatile("s_waitcnt lgkmcnt(" #n ")" ::: "memory")
#define PG8_BAR __builtin_amdgcn_s_barrier()
#define PG8_SCHED __builtin_amdgcn_sched_barrier(0)
    Unit cur, nxt; int ui = 0;
    if (!S.next(0, cur)) return;
    f32x4 acc[2][2][4][2];
    { float z_ = 0.f; LAUNDER_V(z_);
#pragma unroll
    for (int a = 0; a < 2; ++a)
#pragma unroll
        for (int b = 0; b < 2; ++b)
#pragma unroll
            for (int m = 0; m < 4; ++m)
#pragma unroll
                for (int n = 0; n < 2; ++n) acc[a][b][m][n] = (f32x4){z_, z_, z_, z_}; }
    bf16x8 At[4][2], B0[2][2], B1[2][2];
    int ntc = S.nt(cur, nt);
    const char* cA = (const char*)g.A + (size_t)cur.pm * tstep + S.aoff(cur); const char* cB = S.bptr(cur, 0); const char* cB1 = S.bptr(cur, 1) - (size_t)ks * kstep;
    if constexpr (SP2) {
        PG8_STAGE(PG8_SB(0, 0), cB, voffB); PG8_STAGE(PG8_SB(0, 1), cB + hstepB, voffB); PG8_STAGE(PG8_SA(0, 0), cA, voffA); PG8_STAGE(PG8_SA(0, 1), cA + hstep, voffA);
        if (wr == 1) PG8_BAR;
        PG8_WAIT_V(2); PG8_BAR;
        PG8_STAGE(PG8_SB(1, 0), cB + kstep, voffB); PG8_STAGE(PG8_SA(1, 0), cA + kstep, voffA); PG8_STAGE(PG8_SB(1, 1), cB + hstepB + kstep, voffB);
        PG8_WAIT_V(6); PG8_BAR;
    } else {
        PG8_STAGE(PG8_SB(0, 0), cB, voffB); PG8_STAGE(PG8_SA(0, 0), cA, voffA); PG8_STAGE(PG8_SB(0, 1), cB + hstepB, voffB); PG8_STAGE(PG8_SA(0, 1), cA + hstep, voffA);
        if (wr == 1) PG8_BAR;
        PG8_WAIT_V(4); PG8_BAR;
        PG8_STAGE(PG8_SB(1, 0), cB + kstep, voffB); PG8_STAGE(PG8_SA(1, 0), cA + kstep, voffA); PG8_STAGE(PG8_SB(1, 1), cB + hstepB + kstep, voffB);
        PG8_WAIT_V(6); PG8_BAR;
    }
    for (;;) {
        const bool has_next = S.next(ui + 1, nxt);
        const char* nA = has_next ? (const char*)g.A + (size_t)nxt.pm * tstep + S.aoff(nxt) : cA; const char* nB = has_next ? S.bptr(nxt, 0) : cB;
        const char* nB1 = has_next ? S.bptr(nxt, 1) - (size_t)ks * kstep : cB1;
#pragma unroll 1
        for (int t = 0; t < ntc; t += 2) {
            const bool last = (t == ntc - 2);
            const char* a1 = cA + (size_t)(t + 1) * kstep;
            const char* bside = (t + 2 < ks) ? cB : cB1;
            const char* a2 = last ? nA : cA + (size_t)(t + 2) * kstep; const char* b2 = last ? nB : bside + (size_t)(t + 2) * kstep;
            const char* a3 = a2 + kstep; const char* b3 = b2 + kstep;
            if constexpr (SP2) {
            PG8_LDB(B0, 0, 0); PG8_LDB(B1, 0, 1); PG8_SCHED; PG8_LDA(At, 0, 0); PG8_STAGE(PG8_SA(1, 1), a1 + hstep, voffA);
            PG8_WAIT_V(8); PG8_WAIT_L(0); PG8_BAR; PG8_MMA(0, 0, At, B0); PG8_MMA(0, 1, At, B1); PG8_BAR; PG8_SCHED;
            PG8_LDA(At, 0, 1); PG8_STAGE(PG8_SB(0, 0), b2, voffB); PG8_STAGE(PG8_SB(0, 1), b2 + hstepB, voffB); PG8_STAGE(PG8_SA(0, 0), a2, voffA);
            PG8_WAIT_V(8); PG8_WAIT_L(0); PG8_BAR; PG8_MMA(1, 0, At, B0); PG8_MMA(1, 1, At, B1); PG8_BAR; PG8_SCHED;
            PG8_LDB(B0, 1, 0); PG8_LDB(B1, 1, 1); PG8_SCHED; PG8_LDA(At, 1, 0); PG8_STAGE(PG8_SA(0, 1), a2 + hstep, voffA);
            PG8_WAIT_V(8); PG8_WAIT_L(0); PG8_BAR; PG8_MMA(0, 0, At, B0); PG8_MMA(0, 1, At, B1); PG8_BAR; PG8_SCHED;
            PG8_LDA(At, 1, 1); PG8_STAGE(PG8_SB(1, 0), b3, voffB); PG8_STAGE(PG8_SB(1, 1), b3 + hstepB, voffB); PG8_STAGE(PG8_SA(1, 0), a3, voffA);
            PG8_WAIT_V(8); PG8_WAIT_L(0); PG8_BAR; PG8_MMA(1, 0, At, B0); PG8_MMA(1, 1, At, B1); PG8_BAR; PG8_SCHED;
            } else {
            PG8_LDB(B0, 0, 0); PG8_SCHED; PG8_LDA(At, 0, 0); PG8_STAGE(PG8_SA(1, 1), a1 + hstep, voffA);
            PG8_WAIT_L(8); PG8_BAR; PG8_WAIT_L(0); PG8_MMA(0, 0, At, B0); PG8_BAR; PG8_SCHED;
            PG8_LDB(B1, 0, 1); PG8_STAGE(PG8_SB(0, 0), b2, voffB);
            PG8_BAR; PG8_WAIT_L(0); PG8_MMA(0, 1, At, B1); PG8_BAR;
            PG8_LDA(At, 0, 1); PG8_STAGE(PG8_SA(0, 0), a2, voffA);
            PG8_BAR; PG8_WAIT_L(0); PG8_MMA(1, 0, At, B0); PG8_BAR; PG8_SCHED;
            PG8_STAGE(PG8_SB(0, 1), b2 + hstepB, voffB);
            PG8_WAIT_V(6); PG8_BAR; PG8_MMA(1, 1, At, B1); PG8_BAR;
            PG8_LDB(B0, 1, 0); PG8_SCHED; PG8_LDA(At, 1, 0); PG8_STAGE(PG8_SA(0, 1), a2 + hstep, voffA);
            PG8_WAIT_L(8); PG8_BAR; PG8_WAIT_L(0); PG8_MMA(0, 0, At, B0); PG8_BAR; PG8_SCHED;
            PG8_LDB(B1, 1, 1); PG8_STAGE(PG8_SB(1, 0), b3, voffB);
            PG8_BAR; PG8_WAIT_L(0); PG8_MMA(0, 1, At, B1); PG8_BAR;
            PG8_LDA(At, 1, 1); PG8_STAGE(PG8_SA(1, 0), a3, voffA);
            PG8_BAR; PG8_WAIT_L(0); PG8_MMA(1, 0, At, B0); PG8_BAR; PG8_SCHED;
            PG8_STAGE(PG8_SB(1, 1), b3 + hstepB, voffB);
            PG8_WAIT_V(6); PG8_BAR; PG8_MMA(1, 1, At, B1); PG8_BAR;
            }
        }
        if constexpr (ALIGN_EPI) { if (wr == 0) PG8_BAR; }
        { const int l2 = lane_id_opaque(); E(acc, cur, wr, wc, l2 & 15, l2 >> 4); }
        if (!has_next) break;
        if (!E.keep(cur)) { float z_ = 0.f; LAUNDER_V(z_);
#pragma unroll
        for (int a = 0; a < 2; ++a)
#pragma unroll
            for (int b = 0; b < 2; ++b)
#pragma unroll
                for (int m = 0; m < 4; ++m)
#pragma unroll
                    for (int n = 0; n < 2; ++n) acc[a][b][m][n] = (f32x4){z_, z_, z_, z_}; }
        cur = nxt; cA = nA; cB = nB; cB1 = nB1; ++ui; ntc = S.nt(cur, nt);
        if constexpr (ALIGN_EPI) { if (wr == 1) PG8_BAR; }
    }
    PG8_WAIT_V(0);
    if constexpr (!ALIGN_EPI) { if (wr == 0) PG8_BAR; }
    PG8_BAR;
#undef PG8_SA
#undef PG8_SB
#undef PG8_STAGE
#undef PG8_LDA
#undef PG8_LDB
#undef PG8_MMA
#undef PG8_WAIT_V
#undef PG8_WAIT_L
#undef PG8_BAR
#undef PG8_SCHED
}
}

typedef f32x4 AccT[2][2][4][2];
__device__ __forceinline__ u32x4 pack8(const f32x4 a, const f32x4 b) { u32x4 w; w.x = pk2(a[0], a[1]); w.y = pk2(a[2], a[3]); w.z = pk2(b[0], b[1]); w.w = pk2(b[2], b[3]); return w; }

struct Epi1 {
    static constexpr bool PERM = true;
    __device__ __forceinline__ bool keep(const pg8::Unit&) const { return false; }
    const float* rstd; bf16* A; bf16* GLU; bf16* QKV; bf16* G;
    __device__ __forceinline__ void operator()(AccT& acc, const pg8::Unit& u, int wr, int wc, int fr, int fq) const { run<false>(acc, u, wr, wc, fr, fq); }
    template <bool SK> __device__ __forceinline__ void run(AccT& acc, const pg8::Unit& u, int wr, int wc, int fr, int fq) const {
        const int row0 = u.pm * 256 + wr * 64 + fr, lc0 = wc * 32 + 8 * fq, pn = u.pn;
#pragma unroll
        for (int ai = 0; ai < (SK ? 1 : 2); ++ai)
#pragma unroll
            for (int m = 0; m < (SK ? 1 : 4); ++m) {
                const int row = row0 + ai * 128 + m * 16; const float rs = rstd[row];
                f32x4 v[2][2];
#pragma unroll
                for (int bj = 0; bj < 2; ++bj)
#pragma unroll
                    for (int n = 0; n < 2; ++n) v[bj][n] = acc[ai][bj][m][n] * rs;
                if (pn == 0) {
#pragma unroll
                    for (int bj = 0; bj < 2; ++bj) *(u32x4*)(A + (size_t)row * 256 + bj * 128 + lc0) = pack8(v[bj][0], v[bj][1]);
                } else if (pn <= 2) {
                    f32x4 o[2];
#pragma unroll
                    for (int n = 0; n < 2; ++n)
#pragma unroll
                        for (int j = 0; j < 4; ++j) o[n][j] = v[0][n][j] * sigmoidf_(v[1][n][j]);
                    *(u32x4*)(GLU + (size_t)row * 256 + (pn - 1) * 128 + lc0) = pack8(o[0], o[1]);
                } else if (pn <= 8) {
                    const int t = (pn - 3) >> 1; bf16* base = QKV + (size_t)t * (U / 4); const float sc = t == 0 ? C2 : 1.0f;
#pragma unroll
                    for (int bj = 0; bj < 2; ++bj) *(u32x4*)(base + (size_t)row * 512 + ((pn - 3) & 1) * 256 + bj * 128 + lc0) = pack8(v[bj][0] * sc, v[bj][1] * sc);
                } else {
#pragma unroll
                    for (int bj = 0; bj < 2; ++bj) { f32x4 o[2];
#pragma unroll
                        for (int n = 0; n < 2; ++n)
#pragma unroll
                            for (int j = 0; j < 4; ++j) o[n][j] = fmaxf(sigmoidf_(v[bj][n][j]), 1e-30f);
                        *(u32x4*)(G + (size_t)row * 3072 + (pn - 9) * 256 + bj * 128 + lc0) = pack8(o[0], o[1]); }
                }
            }
    }
};
struct EpiCS {
    static constexpr bool PERM = true;
    const bf16* G; bf16* Mg; const float* bias;
    __device__ __forceinline__ bool keep(const pg8::Unit& u) const { return u.seg != 2; }
    __device__ __forceinline__ void operator()(AccT& acc, const pg8::Unit& u, int wr, int wc, int fr, int fq) const { run<false>(acc, u, wr, wc, fr, fq); }
    template <bool SK> __device__ __forceinline__ void run(AccT& acc, const pg8::Unit& u, int wr, int wc, int fr, int fq) const {
        const int row0 = u.pm * 256 + wr * 64 + fr, col0 = u.pn * 256 + wc * 32 + 8 * fq;
        const bool lastseg = u.seg == 2; const int w = u.seg, wd = lastseg ? 2 : u.seg + 1; const float bsc = u.seg == 0 ? 1.f : 0.f;
        f32x4 bv[2][2];
#pragma unroll
        for (int bj = 0; bj < 2; ++bj) { bv[bj][0] = *(const f32x4*)(bias + col0 + bj * 128) * bsc; bv[bj][1] = *(const f32x4*)(bias + col0 + bj * 128 + 4) * bsc; }
#pragma unroll
        for (int ai = 0; ai < (SK ? 1 : 2); ++ai) {
            u32x4 gn[4][2], gd[4][2];
#pragma unroll
            for (int m = 0; m < (SK ? 1 : 4); ++m) { const bf16* gp = G + (size_t)(row0 + ai * 128 + m * 16) * 3072 + col0;
#pragma unroll
                for (int bj = 0; bj < 2; ++bj) { gn[m][bj] = *(const u32x4*)(gp + w * 1024 + bj * 128); gd[m][bj] = *(const u32x4*)(gp + wd * 1024 + bj * 128); } }
#pragma unroll
            for (int m = 0; m < (SK ? 1 : 4); ++m) { const int row = row0 + ai * 128 + m * 16;
#pragma unroll
                for (int bj = 0; bj < 2; ++bj) {
                    const u32x4 n4 = gn[m][bj], d4 = gd[m][bj];
                    f32x4 a0 = acc[ai][bj][m][0] + bv[bj][0], a1 = acc[ai][bj][m][1] + bv[bj][1];
#define RAT(gnv, gdv) ((gnv) * (lastseg ? 1.0f : __builtin_amdgcn_rcpf(gdv)))
                    a0[0] *= RAT(bflo(n4.x), bflo(d4.x)); a0[1] *= RAT(bfhi(n4.x), bfhi(d4.x)); a0[2] *= RAT(bflo(n4.y), bflo(d4.y)); a0[3] *= RAT(bfhi(n4.y), bfhi(d4.y));
                    a1[0] *= RAT(bflo(n4.z), bflo(d4.z)); a1[1] *= RAT(bfhi(n4.z), bfhi(d4.z)); a1[2] *= RAT(bflo(n4.w), bflo(d4.w)); a1[3] *= RAT(bfhi(n4.w), bfhi(d4.w));
#undef RAT
                    acc[ai][bj][m][0] = a0; acc[ai][bj][m][1] = a1;
                    asm volatile("" : "+v"(acc[ai][bj][m][0]), "+v"(acc[ai][bj][m][1]));
                    if (lastseg) *(u32x4*)(Mg + (size_t)row * 1024 + col0 + bj * 128) = pack8(a0, a1);
                } }
            asm volatile("" ::: "memory");
        }
    }
};
struct EpiD {
    static constexpr bool PERM = false;
    __device__ __forceinline__ bool keep(const pg8::Unit&) const { return false; }
    float* H; bf16* HB;
    __device__ __forceinline__ void operator()(AccT& acc, const pg8::Unit& u, int wr, int wc, int fr, int fq) const { run<false>(acc, u, wr, wc, fr, fq); }
    template <bool SK> __device__ __forceinline__ void run(AccT& acc, const pg8::Unit& u, int wr, int wc, int fr, int fq) const {
        const int row0 = u.pm * 256 + wr * 64 + fr, col0 = u.pn * 256 + wc * 32 + 4 * fq;
#pragma unroll
        for (int ai = 0; ai < (SK ? 1 : 2); ++ai)
#pragma unroll
            for (int m = 0; m < (SK ? 1 : 4); ++m) {
                const size_t off = (size_t)(row0 + ai * 128 + m * 16) * 1024 + col0;
#pragma unroll
                for (int bj = 0; bj < 2; ++bj)
#pragma unroll
                    for (int n = 0; n < 2; ++n) { const size_t o = off + bj * 128 + n * 16; const f32x4 hv = *(const f32x4*)(H + o) + acc[ai][bj][m][n];
                        *(f32x4*)(H + o) = hv; u32x2 w; w.x = pk2(hv[0], hv[1]); w.y = pk2(hv[2], hv[3]); *(u32x2*)(HB + o) = w; }
            }
    }
};
struct EpiA2 {
    static constexpr bool PERM = true;
    __device__ __forceinline__ bool keep(const pg8::Unit&) const { return false; }
    const float* PW; bf16* HH;
    __device__ __forceinline__ void operator()(AccT& acc, const pg8::Unit& u, int wr, int wc, int fr, int fq) const {
        const int row0 = u.pm * 256 + wr * 64 + fr, lc0 = wc * 32 + 8 * fq, side = u.pn >> 1;
#pragma unroll
        for (int ai = 0; ai < 2; ++ai)
#pragma unroll
            for (int m = 0; m < 4; ++m) {
                const int row = row0 + ai * 128 + m * 16; const f32x4 pw = *(const f32x4*)(PW + (size_t)row * 4);
                const float rs = pw[0], cw = side ? pw[2] : pw[1];
                f32x4 o[2];
#pragma unroll
                for (int n = 0; n < 2; ++n)
#pragma unroll
                    for (int j = 0; j < 4; ++j) { const float a1 = acc[ai][0][m][n][j] * rs, a3 = acc[ai][1][m][n][j] * rs; o[n][j] = cw * a1 * sigmoidf_(a1) * a3; }
                *(u32x4*)(HH + (size_t)row * 512 + side * 256 + (u.pn & 1) * 128 + lc0) = pack8(o[0], o[1]);
            }
    }
};
struct EpiB2 {
    static constexpr bool PERM = true;
    __device__ __forceinline__ bool keep(const pg8::Unit&) const { return false; }
    bf16* Y;
    __device__ __forceinline__ void operator()(AccT& acc, const pg8::Unit& u, int wr, int wc, int fr, int fq) const { run<false>(acc, u, wr, wc, fr, fq); }
    template <bool SK> __device__ __forceinline__ void run(AccT& acc, const pg8::Unit& u, int wr, int wc, int fr, int fq) const {
        const int row0 = u.pm * 256 + wr * 64 + fr, col0 = u.pn * 256 + wc * 32 + 8 * fq;
#pragma unroll
        for (int ai = 0; ai < (SK ? 1 : 2); ++ai)
#pragma unroll
            for (int m = 0; m < (SK ? 1 : 4); ++m) {
                bf16* rp = Y + (size_t)(row0 + ai * 128 + m * 16) * 1024 + col0;
#pragma unroll
                for (int bj = 0; bj < 2; ++bj) *(u32x4*)(rp + bj * 128) = pack8(acc[ai][bj][m][0], acc[ai][bj][m][1]);
            }
    }
};
struct MoeOrder {
    int NP, G, c, mode; const LAS int* pcls; const bf16* W;
    __device__ bool next(int i, pg8::Unit& u) const { const long L = (long)i * G + c; if (L >= (long)NP * 4) return false; u.pm = (int)(L >> 2); u.pn = (int)(L & 3); u.seg = 0; return true; }
    __device__ __forceinline__ int nt(const pg8::Unit&, int ntd) const { return ntd; }
    __device__ __forceinline__ size_t aoff(const pg8::Unit&) const { return 0; }
    __device__ __forceinline__ const char* bptr(const pg8::Unit& u, int side) const {
        const int cls = __builtin_amdgcn_readfirstlane(pcls[u.pm]); const int grp = cls / 6, pr = cls % 6;
        const int ea = pr < 3 ? 0 : (pr < 5 ? 1 : 2), eb = pr < 3 ? pr + 1 : (pr < 5 ? pr - 1 : 3);
        if (mode == 0) { const int e = grp * 4 + (u.pn < 2 ? ea : eb); return (const char*)W + ((size_t)e * 512 + (size_t)(u.pn & 1) * 256) * 1024 * 2; }
        const int e = grp * 4 + (side ? eb : ea); return (const char*)W + ((size_t)e * 1024 + (size_t)u.pn * 256) * 256 * 2;
    }
};

template <bool PERM> __device__ __forceinline__ void skinny_k(AccT& acc, const bf16* A, int lda, const bf16* Bt, int ldb, int K, int wc, int fr, int fq) {
    const bf16* ap = A + (size_t)fr * lda + 8 * fq;
    const bf16* bp[2][2];
#pragma unroll
    for (int bj = 0; bj < 2; ++bj)
#pragma unroll
        for (int n = 0; n < 2; ++n) { const int col = 128 * bj + 32 * wc + (PERM ? 8 * (fr >> 2) + 4 * n + (fr & 3) : 16 * n + fr); bp[bj][n] = Bt + (size_t)col * ldb + 8 * fq; }
#pragma unroll 4
    for (int k0 = 0; k0 < K; k0 += 32) {
        const bf16x8 a = *(const bf16x8*)(ap + k0);
#pragma unroll
        for (int bj = 0; bj < 2; ++bj)
#pragma unroll
            for (int n = 0; n < 2; ++n) { const bf16x8 b = *(const bf16x8*)(bp[bj][n] + k0); acc[0][bj][0][n] = __builtin_amdgcn_mfma_f32_16x16x32_bf16(b, a, acc[0][bj][0][n], 0, 0, 0); }
    }
}
__device__ __forceinline__ void skinny_zero(AccT& acc) {
#pragma unroll
    for (int bj = 0; bj < 2; ++bj)
#pragma unroll
        for (int n = 0; n < 2; ++n) acc[0][bj][0][n] = (f32x4){0.f, 0.f, 0.f, 0.f};
}

#define XB_TMO      128
#define XB_XCNT(j)  (256  + 64 * (j))
#define XB_XSUB(j)  (1280 + 64 * (j))
#define XB_XGEN(j)  (2304 + 64 * (j))
#define XB_TOP      3328
#define XB_TOPGEN   3392
#define XCD_BAR_WORDS 3456
#define XB_SPIN_CAP (1u << 24)
__device__ __forceinline__ unsigned xb_ld(unsigned* p)              { return __hip_atomic_load(p, __ATOMIC_RELAXED, __HIP_MEMORY_SCOPE_AGENT); }
__device__ __forceinline__ unsigned xb_add(unsigned* p, unsigned v) { return __hip_atomic_fetch_add(p, v, __ATOMIC_RELAXED, __HIP_MEMORY_SCOPE_AGENT); }
__device__ __forceinline__ unsigned xb_xcc_id() { return (unsigned)__builtin_amdgcn_s_getreg((3 << 11) | 20) & 0xFu; }
#define XB_SPIN(cond, bar) do { unsigned _sp = 0; while (cond) { __builtin_amdgcn_s_sleep(1); \
    if ((++_sp & 255u) == 0u) { if (xb_ld(&(bar)[XB_TMO])) break; if (_sp > XB_SPIN_CAP) { atomicAdd(&(bar)[XB_TMO], 1u); break; } } } } while (0)
struct XcdBarrier { unsigned* bar; unsigned x; volatile LAS unsigned* st; };
__device__ __forceinline__ XcdBarrier xcd_barrier_post(unsigned* bar, volatile LAS unsigned* st) {
    XcdBarrier b; b.bar = bar; b.x = xb_xcc_id(); b.st = st;
    if (threadIdx.x == 0) (void)xb_add(&bar[XB_XCNT(b.x)], 1u);
    return b;
}
__device__ __forceinline__ void xcd_barrier_complete(unsigned* bar, unsigned x, unsigned& nloc, unsigned& nx) {
    const unsigned G = gridDim.x * gridDim.y * gridDim.z;
    unsigned sum, cnt, mine, sp = 0u;
    for (;;) {
        sum = 0u; cnt = 0u; mine = 0u;
#pragma unroll
        for (unsigned j = 0; j < 16; ++j) { const unsigned c = xb_ld(&bar[XB_XCNT(j)]); sum += c; cnt += (c > 0u) ? 1u : 0u; mine = (j == x) ? c : mine; }
        if (sum == G) break;
        __builtin_amdgcn_s_sleep(1);
        if ((++sp & 255u) == 0u) { if (xb_ld(&bar[XB_TMO])) break; if (sp > XB_SPIN_CAP) { atomicAdd(&bar[XB_TMO], 1u); break; } }
    }
    nloc = mine > 0u ? mine : 1u; nx = cnt > 0u ? cnt : 1u;
}
__device__ __forceinline__ void xcd_barrier(const XcdBarrier& b) {
    asm volatile("s_waitcnt vmcnt(0)" ::: "memory");
    __syncthreads();
    if (threadIdx.x == 0) {
        unsigned* bar = b.bar;
        __builtin_amdgcn_s_waitcnt(0);
        unsigned nloc = b.st[0], nx = b.st[1];
        if (nloc == 0u) { xcd_barrier_complete(bar, b.x, nloc, nx); b.st[0] = nloc; b.st[1] = nx; }
        const unsigned old = xb_add(&bar[XB_XSUB(b.x)], 1u);
        const unsigned gen = old / nloc;
        if (old + 1u == (gen + 1u) * nloc) {
            __builtin_amdgcn_fence(__ATOMIC_RELEASE, "agent");
            asm volatile("s_waitcnt vmcnt(0)" ::: "memory");
            const unsigned og = xb_add(&bar[XB_TOP], 1u);
            const unsigned tg = og / nx;
            if (og + 1u == (tg + 1u) * nx) xb_add(&bar[XB_TOPGEN], 1u);
            else XB_SPIN(xb_ld(&bar[XB_TOPGEN]) == tg, bar);
            __builtin_amdgcn_fence(__ATOMIC_ACQUIRE, "agent");
            xb_add(&bar[XB_XGEN(b.x)], 1u);
            asm volatile("s_waitcnt vmcnt(0)" ::: "memory");
        } else {
            XB_SPIN(xb_ld(&bar[XB_XGEN(b.x)]) == gen, bar);
            __builtin_amdgcn_fence(__ATOMIC_ACQUIRE, "agent");
            asm volatile("s_waitcnt vmcnt(0)" ::: "memory");
        }
    }
    __syncthreads();
}

struct Params { const float* in[25]; float* out; unsigned char* ws; int ph_lo, ph_hi; };
enum { I_X = 0, I_META, I_N1G, I_WIN, I_BF, I_PW, I_PB, I_PS, I_CW, I_CB, I_LNG, I_LNB, I_WOA, I_WOB, I_WOC, I_WO, I_N2G, I_RGW, I_RGB, I_REW, I_REB, I_W1, I_W3, I_W2, I_FG };

struct Frame {
    LAS unsigned char* lds;
    int tid, lane, wave, vcu, G, bx;
};
__device__ __forceinline__ unsigned long long ptab_get(const Frame& F, int i) { const LAS unsigned* t = (const LAS unsigned*)(F.lds + LC_PTAB) + 2 * i; const unsigned lo = __builtin_amdgcn_readfirstlane(t[0]), hi = __builtin_amdgcn_readfirstlane(t[1]); return ((unsigned long long)hi << 32) | lo; }
#define INP(i) ((const float*)(const GAS float*)ptab_get(F, (i)))
#define WSP() ((unsigned char*)(GAS unsigned char*)ptab_get(F, 25))
#define DOP() ((unsigned char*)(GAS unsigned char*)ptab_get(F, 26))

__device__ __forceinline__ void tr_item(const float* W, int ldw, int scol0, const float* gk, bf16* WT, int ldt, int drow0, int k0, LAS float* scr, int lane) {
    const int n4 = (lane & 7) * 4, kr = lane >> 3;
    f32x4 v[8];
#pragma unroll
    for (int i = 0; i < 8; ++i) v[i] = *(const f32x4*)(W + (size_t)(k0 + 8 * i + kr) * ldw + scol0 + n4);
#pragma unroll
    for (int i = 0; i < 8; ++i) { const int kk = 8 * i + kr; const float g = gk ? gk[k0 + kk] : 1.0f; LAS float* d = scr + kk * 33 + n4; d[0] = v[i][0] * g; d[1] = v[i][1] * g; d[2] = v[i][2] * g; d[3] = v[i][3] * g; }
    LDS_WAIT(); asm volatile("" ::: "memory");
    const int c = lane & 7;
#pragma unroll
    for (int j = 0; j < 4; ++j) { const int n = (lane >> 3) + 8 * j; const LAS float* s = scr + (8 * c) * 33 + n;
        u32x4 o; o.x = pk2(s[0 * 33], s[1 * 33]); o.y = pk2(s[2 * 33], s[3 * 33]); o.z = pk2(s[4 * 33], s[5 * 33]); o.w = pk2(s[6 * 33], s[7 * 33]);
        *(u32x4*)(WT + (size_t)(drow0 + n) * ldt + k0 + 8 * c) = o; }
    LDS_WAIT(); asm volatile("" ::: "memory");
}
__device__ __forceinline__ int map1(int n) {
    const int tile = n >> 8, r = n & 255;
    if (tile == 0) return n;
    if (tile <= 2) { const int c = (tile - 1) * 128 + (r & 127); return (r < 128 ? 256 : 512) + c; }
    if (tile <= 8) return n;
    return n + 8;
}
__device__ __forceinline__ void convert_weights(Frame& F, int l) {
    LAS float* scr = (LAS float*)(F.lds + F.wave * 16384);
    const int gw = F.vcu * NWAVES + F.wave, NGW = F.G * NWAVES, lane = F.lane;
    const float* g1 = INP(I_N1G) + (size_t)l * D; const float* g2 = INP(I_N2G) + (size_t)l * D;
    unsigned char* ws = WSP();
#pragma unroll 1
    for (int it0 = gw; it0 < 9728; it0 += NGW) { int it = it0;
        if (it < 2688) { const int kb = it / 168, nb = it % 168; tr_item(INP(I_WIN) + (size_t)l * D * NIN, NIN, map1(nb * 32), g1, (bf16*)(ws + WS_W1T), 1024, nb * 32, kb * 64, scr, lane); continue; } it -= 2688;
        if (it < 128) { const int kb = it / 32, nb = it % 32; tr_item(INP(I_WOB) + (size_t)l * 256 * D, 1024, nb * 32, nullptr, (bf16*)(ws + WS_W3CT) + 256, 1024, nb * 32, kb * 64, scr, lane); continue; } it -= 128;
        if (it < 256) { const int kb = it / 32, nb = it % 32; tr_item(INP(I_WOC) + (size_t)l * 512 * D, 1024, nb * 32, nullptr, (bf16*)(ws + WS_W3CT) + 512, 1024, nb * 32, kb * 64, scr, lane); continue; } it -= 256;
        if (it < 512) { const int kb = it / 32, nb = it % 32; tr_item(INP(I_WO) + (size_t)l * D * D, 1024, nb * 32, nullptr, (bf16*)(ws + WS_WOT), 1024, nb * 32, kb * 64, scr, lane); continue; } it -= 512;
        if (it < 4096) { const int e = it >> 8, r = it & 255, kb = r >> 4, nb = r & 15, n0 = nb * 32, jt = n0 >> 8, rr = n0 & 255;
            const float* W = (rr < 128 ? INP(I_W1) : INP(I_W3)) + ((size_t)l * 16 + e) * D * 256;
            tr_item(W, 256, jt * 128 + (rr & 127), g2, (bf16*)(DOP() + DO_W13T) + (size_t)e * 512 * 1024, 1024, n0, kb * 64, scr, lane); continue; } it -= 4096;
        { const int e = it >> 7, r = it & 127, kb = r >> 5, nb = r & 31;
            tr_item(INP(I_W2) + ((size_t)l * 16 + e) * 256 * D, 1024, nb * 32, nullptr, (bf16*)(DOP() + DO_W2T) + (size_t)e * 1024 * 256, 256, nb * 32, kb * 64, scr, lane); }
    }
    { const float* pw = INP(I_PW) + (size_t)l * 4 * 64 * 64; const float* ps = INP(I_PS) + (size_t)l * 256; const float* pb = INP(I_PB) + (size_t)l * 256;
      const float* wa = INP(I_WOA) + (size_t)l * 256 * D; bf16* WT = (bf16*)(ws + WS_W3CT); float* bias = (float*)(ws + WS_BIASA);
      const int gt = F.vcu * 512 + F.tid, NT = F.G * 512;
      for (int idx = gt; idx < 256 * 1024; idx += NT) { const int n = idx & 1023, kk = idx >> 10, grp = kk >> 6, c = kk & 63; float s = 0.f;
#pragma unroll 16
        for (int d = 0; d < 64; ++d) s += pw[(grp * 64 + c) * 64 + d] * ps[grp * 64 + d] * wa[(size_t)(grp * 64 + d) * D + n];
        WT[(size_t)n * 1024 + kk] = (bf16)f2bf(s); }
      for (int n = gw; n < 1024; n += NGW) { float s = 0.f;
#pragma unroll
        for (int j = 0; j < 4; ++j) { const int d = lane + 64 * j; s += pb[d] * ps[d] * wa[(size_t)d * D + n]; }
        s = wave_sum(s); if (lane == 0) bias[n] = s; }
      float* wfg = (float*)(ws + WS_WFG); const float* win = INP(I_WIN) + (size_t)l * D * NIN;
      for (int idx = gt; idx < 8 * 1024; idx += NT) { const int c = idx >> 10, k = idx & 1023; wfg[idx] = g1[k] * win[(size_t)k * NIN + 2304 + c]; }
      float* rg = (float*)(ws + WS_RG); const float* re = INP(I_REW) + (size_t)l * D * 16; const float* rgw = INP(I_RGW) + (size_t)l * D * 4;
      for (int idx = gt; idx < 20 * 1024; idx += NT) { const int c = idx >> 10, k = idx & 1023; rg[idx] = g2[k] * (c < 16 ? re[(size_t)k * 16 + c] : rgw[(size_t)k * 4 + (c - 16)]); } }
}
__device__ __forceinline__ void init_rows(Frame& F) {
    const int gw = F.vcu * NWAVES + F.wave, NGW = F.G * NWAVES, lane = F.lane;
    bf16* HB = (bf16*)(WSP() + WS_HB); float* rstd1 = (float*)(WSP() + WS_RSTD1);
    constexpr int R = 4;
#pragma unroll 1
    for (int row0 = gw; row0 < TR; row0 += R * NGW) {
        f32x4 v[R][4];
#pragma unroll
        for (int r = 0; r < R; ++r) { int row = row0 + r * NGW; if (row >= TR) row = TR - 1;
            const float* src = row < TX ? INP(I_X) + (size_t)row * D : INP(I_META) + (size_t)(row - TX) * D;
#pragma unroll
            for (int j = 0; j < 4; ++j) v[r][j] = *(const f32x4*)(src + 4 * lane + 256 * j); }
#pragma unroll
        for (int r = 0; r < R; ++r) { const int row = row0 + r * NGW; float ss = 0.f;
#pragma unroll
            for (int j = 0; j < 4; ++j) ss += v[r][j][0] * v[r][j][0] + v[r][j][1] * v[r][j][1] + v[r][j][2] * v[r][j][2] + v[r][j][3] * v[r][j][3];
            ss = wave_sum(ss);
            if (row < TR) {
#pragma unroll
                for (int j = 0; j < 4; ++j) { u32x2 w; w.x = pk2(v[r][j][0], v[r][j][1]); w.y = pk2(v[r][j][2], v[r][j][3]); *(u32x2*)(HB + (size_t)row * D + 4 * lane + 256 * j) = w; }
                if (lane == 0) rstd1[row] = rsqrtf(ss * (1.0f / D) + EPS); } }
    }
    { bf16* Kb = (bf16*)(DOP() + DO_K) + (size_t)TR * 512; bf16* Vb = (bf16*)(DOP() + DO_V) + (size_t)TR * 512; const int gt = F.vcu * 512 + F.tid;
      if (gt < 48 * 64) { *(u32x4*)(Kb + (size_t)gt * 8) = (u32x4){0u, 0u, 0u, 0u}; *(u32x4*)(Vb + (size_t)gt * 8) = (u32x4){0u, 0u, 0u, 0u}; } }
}

__device__ __forceinline__ int srcrow(bool isx, int b, int t) {
    if (t >= 0) return (isx ? b * SEQ : TX) + t;
    if (isx) { const int mm = NMETA + t; return mm >= 0 ? TX + mm : -1; }
    return -1;
}
__device__ __forceinline__ void phase_S(Frame& F, int l) {
    LAS unsigned char* lds = F.lds; const int wave = F.wave;
#pragma unroll 1
    for (int item = F.vcu; item < 513; item += F.G) {
        const bool isx = item < 512; const int row0 = isx ? item * 64 : TX + (item - 512) * 64; const int b = isx ? (item * 64) / SEQ : 0; const int t0 = isx ? (item * 64) % SEQ : (item - 512) * 64; const int nrows = isx ? 64 : NMETA;
        { unsigned char* ws = WSP(); int tid = F.tid; LAUNDER_V(tid); const int lane = tid & 63, fr = lane & 15, fq = lane >> 4;
          const bf16* HB = (const bf16*)(ws + WS_HB); const float* rstd1 = (const float*)(ws + WS_RSTD1); const float* wfg = (const float*)(ws + WS_WFG);
          float* LFT = (float*)(ws + WS_LFT); float* LFTM = (float*)(ws + WS_LFTM); const float* bfg = INP(I_BF) + l * 8;
          LAS bf16* Whi = (LAS bf16*)lds; LAS bf16* Wlo = Whi + 8 * RPITCH; LAS float* Pex = (LAS float*)(lds + 2 * 8 * RPITCH * 2); LAS unsigned* nmx = (LAS unsigned*)(lds + LC_NMX);
          { f32x4 wv_[4];
#pragma unroll
            for (int j = 0; j < 4; ++j) wv_[j] = *(const f32x4*)(wfg + 4 * (tid + 512 * j));
#pragma unroll
            for (int j = 0; j < 4; ++j) { const int i = 4 * (tid + 512 * j), c = i >> 10, k = i & 1023; u32x2 hw, lw; float hf[4];
#pragma unroll
                for (int e = 0; e < 4; ++e) hf[e] = __builtin_bit_cast(float, (pk2(wv_[j][e], 0.f) & 0xffffu) << 16);
                hw.x = pk2(wv_[j][0], wv_[j][1]); hw.y = pk2(wv_[j][2], wv_[j][3]); lw.x = pk2(wv_[j][0] - hf[0], wv_[j][1] - hf[1]); lw.y = pk2(wv_[j][2] - hf[2], wv_[j][3] - hf[3]);
                *(LAS u32x2*)(Whi + c * RPITCH + k) = hw; *(LAS u32x2*)(Wlo + c * RPITCH + k) = lw; } }
          if (tid < 16) nmx[tid] = 0u;
          const int g = wave & 3, kh = wave >> 2, rr = 16 * g + fr, row = row0 + rr;
          bf16x8 af[16];
#pragma unroll
          for (int s2 = 0; s2 < 16; ++s2) af[s2] = *(const bf16x8*)(HB + (size_t)row * D + 32 * (16 * kh + s2) + 8 * fq);
          const float rs1 = rstd1[row];
          __syncthreads();
          f32x4 acc = {0.f, 0.f, 0.f, 0.f};
#pragma unroll
          for (int s2 = 0; s2 < 16; ++s2) { const int k = 32 * (16 * kh + s2) + 8 * fq;
              bf16x8 wh = *(const LAS bf16x8*)(Whi + (fr & 7) * RPITCH + k), wl = *(const LAS bf16x8*)(Wlo + (fr & 7) * RPITCH + k);
              if (fr >= 8) { wh = (bf16x8){0, 0, 0, 0, 0, 0, 0, 0}; wl = wh; }
              acc = __builtin_amdgcn_mfma_f32_16x16x32_bf16(wh, af[s2], acc, 0, 0, 0); acc = __builtin_amdgcn_mfma_f32_16x16x32_bf16(wl, af[s2], acc, 0, 0, 0); }
          if (kh == 1) *(LAS f32x4*)(Pex + (g * 64 + lane) * 4) = acc;
          { const bf16* Qg = (const bf16*)(DOP() + DO_Q); const bf16* Kg = (const bf16*)(DOP() + DO_K); float kmx = 0.f, qmx = 0.f;
            u32x4 kw[8], qw[8];
#pragma unroll
            for (int i8 = 0; i8 < 8; ++i8) { const int r2 = wave + 8 * i8; const int rw = row0 + (r2 < nrows ? r2 : 0); kw[i8] = *(const u32x4*)(Kg + (size_t)rw * 512 + 8 * lane); qw[i8] = *(const u32x4*)(Qg + (size_t)rw * 512 + 8 * lane); }
#pragma unroll
            for (int i8 = 0; i8 < 8; ++i8) { const u32x4 a = kw[i8], c = qw[i8];
                float sk = (bflo(a.x) * bflo(a.x) + bfhi(a.x) * bfhi(a.x)) + (bflo(a.y) * bflo(a.y) + bfhi(a.y) * bfhi(a.y)) + (bflo(a.z) * bflo(a.z) + bfhi(a.z) * bfhi(a.z)) + (bflo(a.w) * bflo(a.w) + bfhi(a.w) * bfhi(a.w));
                float sq = (bflo(c.x) * bflo(c.x) + bfhi(c.x) * bfhi(c.x)) + (bflo(c.y) * bflo(c.y) + bfhi(c.y) * bfhi(c.y)) + (bflo(c.z) * bflo(c.z) + bfhi(c.z) * bfhi(c.z)) + (bflo(c.w) * bflo(c.w) + bfhi(c.w) * bfhi(c.w));
                sk += lane_xor<1>(sk); sk += lane_xor<2>(sk); sk += lane_xor<4>(sk); sq += lane_xor<1>(sq); sq += lane_xor<2>(sq); sq += lane_xor<4>(sq);
                kmx = fmaxf(kmx, sk); qmx = fmaxf(qmx, sq); }
            if ((lane & 7) == 0) { const int hd = lane >> 3; __hip_atomic_fetch_max(&nmx[hd], __float_as_uint(kmx), __ATOMIC_RELAXED, __HIP_MEMORY_SCOPE_WORKGROUP); __hip_atomic_fetch_max(&nmx[8 + hd], __float_as_uint(qmx), __ATOMIC_RELAXED, __HIP_MEMORY_SCOPE_WORKGROUP); } }
          __syncthreads();
          if (kh == 0) { const f32x4 o4 = *(const LAS f32x4*)(Pex + (g * 64 + lane) * 4); acc += o4;
              if (fq < 2 && rr < nrows && row < TR) {
#pragma unroll
                  for (int i = 0; i < 4; ++i) { const int hd = 4 * fq + i; const float xg = acc[i] * rs1 + bfg[hd]; const float lf = fminf(xg, 0.f) - 0.69314718056f * __builtin_amdgcn_logf(1.0f + __expf(-fabsf(xg)));
                      if (isx) LFT[(size_t)(b * 8 + hd) * SEQ + t0 + rr] = lf; else LFTM[hd * 256 + t0 + rr] = lf; } } }
          if (tid < 16) { unsigned* nrm = (unsigned*)(WSP() + WS_CTL) + CW_NRM + l * 64; const unsigned v = nmx[tid];
              if (isx) __hip_atomic_fetch_max(nrm + (tid >> 3) * 32 + b * 8 + (tid & 7), v, __ATOMIC_RELAXED, __HIP_MEMORY_SCOPE_AGENT);
              else if (tid < 8) { for (int bb = 0; bb < NB; ++bb) __hip_atomic_fetch_max(nrm + bb * 8 + tid, v, __ATOMIC_RELAXED, __HIP_MEMORY_SCOPE_AGENT); } }
          __syncthreads(); }
        { unsigned char* ws = WSP(); int tid = F.tid; LAUNDER_V(tid);
          const bf16* Ab = (const bf16*)(ws + WS_A); bf16* DIFF = (bf16*)(ws + WS_X3);
          LAS unsigned char* T = lds;
          { u32x4 tv[5]; const int nld = (15 + nrows) * 32;
#pragma unroll
            for (int j = 0; j < 5; ++j) { const int i = tid + 512 * j; const int sl = i >> 5, ch = i & 31; const int r = i < nld ? srcrow(isx, b, t0 + sl - 15) : -1; unsigned z_ = 0u; LAUNDER_V(z_);
                tv[j] = r >= 0 ? *(const u32x4*)(Ab + (size_t)r * 256 + ch * 8) : (u32x4){z_, z_, z_, z_}; }
#pragma unroll
            for (int j = 0; j < 5; ++j) { const int i = tid + 512 * j; if (i < nld) *(LAS u32x4*)(T + (i >> 5) * 512 + (i & 31) * 16) = tv[j]; } }
          __syncthreads();
#pragma unroll 1
          for (int i = tid; i < nrows * 32; i += 512) { const int r = i >> 5, ch = i & 31, grp = ch >> 3, w = 2 << grp; const int cnt = isx ? w : min(t0 + r + 1, w);
              float s[8];
#pragma unroll
              for (int j = 0; j < 8; ++j) s[j] = 0.f;
#pragma unroll 1
              for (int d = 0; d < cnt; ++d) { const u32x4 v = *(const LAS u32x4*)(T + (15 + r - d) * 512 + ch * 16);
                  s[0] += bflo(v.x); s[1] += bfhi(v.x); s[2] += bflo(v.y); s[3] += bfhi(v.y); s[4] += bflo(v.z); s[5] += bfhi(v.z); s[6] += bflo(v.w); s[7] += bfhi(v.w); }
              const u32x4 a = *(const LAS u32x4*)(T + (15 + r) * 512 + ch * 16); const float ic = 1.0f / (float)cnt;
              u32x4 o; o.x = pk2(s[0] * ic - bflo(a.x), s[1] * ic - bfhi(a.x)); o.y = pk2(s[2] * ic - bflo(a.y), s[3] * ic - bfhi(a.y));
              o.z = pk2(s[4] * ic - bflo(a.z), s[5] * ic - bfhi(a.z)); o.w = pk2(s[6] * ic - bflo(a.w), s[7] * ic - bfhi(a.w));
              if (row0 + r < TR) *(u32x4*)(DIFF + (size_t)(row0 + r) * 1024 + ch * 8) = o; }
          __syncthreads(); }
        { unsigned char* ws = WSP(); int tid = F.tid; LAUNDER_V(tid);
          const bf16* GLU = (const bf16*)(ws + WS_GLU);
          LAS unsigned char* T = lds;
          LAS float* Yt = (LAS float*)(lds + 49152);
          { u32x4 tv[6]; const int nld = (isx ? 94 : 62) * 32;
#pragma unroll
            for (int j = 0; j < 6; ++j) { const int i = tid + 512 * j; const int sl = i >> 5, ch = i & 31; const int r = i < nld ? srcrow(isx, b, t0 + sl - 30) : -1; unsigned z_ = 0u; LAUNDER_V(z_);
                tv[j] = r >= 0 ? *(const u32x4*)(GLU + (size_t)r * 256 + ch * 8) : (u32x4){z_, z_, z_, z_}; }
#pragma unroll
            for (int j = 0; j < 6; ++j) { const int i = tid + 512 * j; if (i < nld) *(LAS u32x4*)(T + (i >> 5) * 512 + (i & 31) * 16) = tv[j]; } }
          __syncthreads();
          { const float* cw = INP(I_CW) + (size_t)l * 31 * 256; const float* cb = INP(I_CB) + l * 256;
            const int cp = tid & 127, strip = tid >> 7; f32x2 wv[31];
#pragma unroll
            for (int j = 0; j < 31; ++j) wv[j] = *(const f32x2*)(cw + j * 256 + 2 * cp);
            const f32x2 bias = *(const f32x2*)(cb + 2 * cp);
#pragma unroll 1
            for (int hh = 0; hh < (isx ? 2 : 1); ++hh) { const int rb = 32 * hh + 8 * strip; f32x2 acc[8];
#pragma unroll
                for (int r = 0; r < 8; ++r) acc[r] = bias;
#pragma unroll
                for (int i = 0; i < 38; ++i) { const unsigned xw = *(const LAS unsigned*)(T + (rb + i) * 512 + cp * 4); const f32x2 xx = {bflo(xw), bfhi(xw)};
#pragma unroll
                    for (int r = 0; r < 8; ++r) { const int j = i - r; if (j >= 0 && j <= 30) acc[r] += wv[j] * xx; } }
#pragma unroll
                for (int r = 0; r < 8; ++r) *(LAS f32x2*)(Yt + (rb + r) * 256 + 2 * cp) = acc[r]; } }
          __syncthreads();
          { unsigned char* ws2 = WSP(); int tid2 = F.tid; LAUNDER_V(tid2); const int lane = tid2 & 63;
            bf16* BP = (bf16*)(ws2 + WS_X3) + 256; const float* lng = INP(I_LNG) + l * 256; const float* lnb = INP(I_LNB) + l * 256;
            const f32x4 gg = *(const f32x4*)(lng + 4 * lane), bb = *(const f32x4*)(lnb + 4 * lane);
#pragma unroll 1
            for (int rr = wave; rr < nrows; rr += 8) { const f32x4 v = *(const LAS f32x4*)(Yt + rr * 256 + 4 * lane);
              const float mean = wave_sum(v[0] + v[1] + v[2] + v[3]) * (1.0f / 256.0f); const f32x4 dv = v - mean;
              const float var = wave_sum(dv[0] * dv[0] + dv[1] * dv[1] + dv[2] * dv[2] + dv[3] * dv[3]) * (1.0f / 256.0f); const float rs = rsqrtf(var + EPS);
              f32x4 o = dv * rs * gg + bb;
#pragma unroll
              for (int j = 0; j < 4; ++j) o[j] = o[j] * sigmoidf_(o[j]);
              u32x2 w; w.x = pk2(o[0], o[1]); w.y = pk2(o[2], o[3]); if (row0 + rr < TR) *(u32x2*)(BP + (size_t)(row0 + rr) * 1024 + 4 * lane) = w; } }
          __syncthreads(); }
    }
}

constexpr int AT_FL = 0, AT_K = 34816, AT_VT = AT_K + 8192, AT_SC = AT_VT + 8192;
__device__ __forceinline__ void attn_scan(Frame& F, int b, int h, bool meta_only, int fl_off, int sc_off) {
    LAS float* Fl = (LAS float*)(F.lds + fl_off); LAS float* sc = (LAS float*)(F.lds + sc_off);
    const float* LFT = (const float*)(WSP() + WS_LFT); const float* LFTM = (const float*)(WSP() + WS_LFTM);
    const int tid = F.tid, lane = F.lane, wave = F.wave;
    __syncthreads();
    if (tid == 0) { float s = 0.f; for (int m = 0; m < 64; ++m) { if (m < NMETA) { s += LFTM[h * 256 + m]; Fl[m] = s * LOG2E; } else Fl[m] = 1e30f; if (m == NMETA - 1) sc[16] = s; } }
    if (meta_only) { for (int i = tid; i < 256; i += 512) Fl[64 + i] = 0.f; __syncthreads(); return; }
    float v[16]; const float* src = LFT + (size_t)(b * 8 + h) * SEQ + 16 * tid;
#pragma unroll
    for (int j = 0; j < 4; ++j) { const f32x4 q = *(const f32x4*)(src + 4 * j); v[4 * j] = q[0]; v[4 * j + 1] = q[1]; v[4 * j + 2] = q[2]; v[4 * j + 3] = q[3]; }
#pragma unroll
    for (int j = 1; j < 16; ++j) v[j] += v[j - 1];
    float incl = v[15];
#pragma unroll
    for (int o = 1; o < 64; o <<= 1) { const float up = __int_as_float(__builtin_amdgcn_ds_bpermute((lane - o) << 2, __float_as_int(incl))); if (lane >= o) incl += up; }
    if (lane == 63) sc[wave] = incl;
    __syncthreads();
    float off = sc[16];
    for (int w = 0; w < wave; ++w) off += sc[w];
    off += incl - v[15];
#pragma unroll
    for (int j = 0; j < 16; ++j) Fl[64 + 16 * tid + j] = (off + v[j]) * LOG2E;
    __syncthreads();
}
__device__ __forceinline__ void attn_unit_naive(Frame& F, int qrow0, int qpos0, int ntiles, int kvx0, int h, int nq) {
    const int tid = F.tid; const int hf = tid & 1; const bool live = (tid >> 1) < nq; const int r = live ? (tid >> 1) : 0;
    const bf16* Q = (const bf16*)(DOP() + DO_Q); const bf16* Kg = (const bf16*)(DOP() + DO_K); const bf16* Vg = (const bf16*)(DOP() + DO_V); bf16* O = (bf16*)(WSP() + WS_X3) + 512;
    LAS float* Fl = (LAS float*)(F.lds + AT_FL); LAS unsigned char* Ks = F.lds + AT_K; LAS bf16* VT = (LAS bf16*)(F.lds + AT_VT);
    const int grow = qrow0 + r, qpos = qpos0 + r;
    unsigned qp[16];
#pragma unroll
    for (int j = 0; j < 4; ++j) { const u32x4 w = *(const u32x4*)(Q + (size_t)grow * 512 + h * 64 + hf * 32 + 8 * j); qp[4 * j] = w.x; qp[4 * j + 1] = w.y; qp[4 * j + 2] = w.z; qp[4 * j + 3] = w.w; }
    const float Fq = Fl[qpos < NMETA ? qpos : qpos + 48];
    float mrun = -1e30f, lrun = 0.f, o[32];
#pragma unroll
    for (int d = 0; d < 32; ++d) o[d] = 0.f;
    const int lrow = tid >> 3, lch = tid & 7;

#pragma unroll 1
for (int i = 0; i < ntiles; ++i) {
        const int krow = (i == 0 ? TX : kvx0 + 64 * (i - 1)) + lrow;
        const u32x4 kw = *(const u32x4*)(Kg + (size_t)krow * 512 + h * 64 + lch * 8);
        const u32x4 vw = *(const u32x4*)(Vg + (size_t)krow * 512 + h * 64 + lch * 8);
        __syncthreads();
        *(LAS u32x4*)(Ks + lrow * 128 + lch * 16) = kw;
        { const unsigned vv[4] = {vw.x, vw.y, vw.z, vw.w};
#pragma unroll
          for (int e = 0; e < 4; ++e) { VT[(lch * 8 + 2 * e) * 64 + lrow] = (bf16)(vv[e] & 0xffffu); VT[(lch * 8 + 2 * e + 1) * 64 + lrow] = (bf16)(vv[e] >> 16); } }
        __syncthreads();
        const int kp0 = i == 0 ? 0 : NMETA + 64 * (i - 1);
        if (kp0 > qpos0 + 255) continue;
#pragma unroll 1
        for (int jg = 0; jg < 4; ++jg) {
            float s[16]; float gmax = -1e30f;
#pragma unroll
            for (int jj = 0; jj < 16; ++jj) { const int j = jg * 16 + jj; float d = 0.f;
#pragma unroll
                for (int c = 0; c < 4; ++c) { const u32x4 kk = *(const LAS u32x4*)(Ks + j * 128 + hf * 64 + c * 16);
                    d = dot2bf(kk.x, qp[4 * c], d); d = dot2bf(kk.y, qp[4 * c + 1], d); d = dot2bf(kk.z, qp[4 * c + 2], d); d = dot2bf(kk.w, qp[4 * c + 3], d); }
                d += lane_xor<1>(d);
                const bool valid = (i == 0 ? j < NMETA : true) && (kp0 + j <= qpos);
                s[jj] = valid ? d + Fq - Fl[64 * i + j] : -1e30f; gmax = fmaxf(gmax, s[jj]); }
            const float mn = fmaxf(mrun, gmax), alpha = exp2f(mrun - mn); mrun = mn;
            float ps = 0.f; unsigned pp[8];
#pragma unroll
            for (int jj = 0; jj < 16; jj += 2) { const float p0 = exp2f(s[jj] - mn), p1 = exp2f(s[jj + 1] - mn); ps += p0 + p1; pp[jj >> 1] = pk2(p0, p1); }
            lrun = lrun * alpha + ps;
#pragma unroll
            for (int d = 0; d < 32; ++d) { const u32x4 v0 = *(const LAS u32x4*)(VT + (hf * 32 + d) * 64 + jg * 16), v1 = *(const LAS u32x4*)(VT + (hf * 32 + d) * 64 + jg * 16 + 8);
                float a = o[d] * alpha; a = dot2bf(pp[0], v0.x, a); a = dot2bf(pp[1], v0.y, a); a = dot2bf(pp[2], v0.z, a); a = dot2bf(pp[3], v0.w, a);
                a = dot2bf(pp[4], v1.x, a); a = dot2bf(pp[5], v1.y, a); a = dot2bf(pp[6], v1.z, a); a = dot2bf(pp[7], v1.w, a); o[d] = a; }
        }
    }
    const float il = 1.0f / lrun;
    if (live)
#pragma unroll
    for (int j = 0; j < 4; ++j) { u32x4 w; w.x = pk2(o[8 * j] * il, o[8 * j + 1] * il); w.y = pk2(o[8 * j + 2] * il, o[8 * j + 3] * il); w.z = pk2(o[8 * j + 4] * il, o[8 * j + 5] * il); w.w = pk2(o[8 * j + 6] * il, o[8 * j + 7] * il);
        *(u32x4*)(O + (size_t)grow * 1024 + h * 64 + hf * 32 + 8 * j) = w; }
}
namespace fa {
using bf16x8v = __attribute__((ext_vector_type(8))) short;
using s16x4 = __attribute__((ext_vector_type(4))) short;
using f32x16 = __attribute__((ext_vector_type(16))) float;
constexpr int DMA = 512, DMO = 1024;
constexpr int NW = 8, QBLK = 32, QB = 256, KVBLK = 64;
constexpr int NSLOT = 3, SLOTB = 8192;
constexpr int LDS_K = 0, LDS_V = NSLOT * SLOTB, LDS_WS = 2 * NSLOT * SLOTB, LDS_OST = LDS_WS + NW * 64 * 4, LDS_BYTES = LDS_OST + NW * 4096;
constexpr int LDS_FL = 84992;
constexpr int LDS_SCAN = LDS_FL + (64 + 8192) * 4;
static_assert(LDS_SCAN + 128 <= RING_BYTES, "attention LDS");
__device__ __forceinline__ int crow(int r, int hi) { return (r & 3) + 8 * (r >> 2) + 4 * hi; }
#define SBAR() __builtin_amdgcn_sched_barrier(0)
__device__ __forceinline__ void cmask(f32x16& p0, f32x16& p1, int jb, int qrel, int hi) {
    const float NEG = -INFINITY; int kb = 64 * jb + 4 * hi;
#pragma unroll
    for (int r = 0; r < 16; ++r) { int kv = kb + (r & 3) + 8 * (r >> 2); if (kv > qrel) p0[r] = NEG; if (kv + 32 > qrel) p1[r] = NEG; }
}
__device__ __forceinline__ void glds16(const void* gsrc, unsigned lds_dst) { unsigned keep;
    asm volatile("s_mov_b32 %0, m0\n\ts_mov_b32 m0, %2\n\ts_nop 0\n\tglobal_load_lds_dwordx4 %1, off\n\ts_mov_b32 m0, %0" : "=&s"(keep) : "v"(gsrc), "s"(lds_dst) : "memory"); }
__device__ __forceinline__ float max3f(float a, float b, float c) { float r; asm("v_max3_f32 %0, %1, %2, %3" : "=v"(r) : "v"(a), "v"(b), "v"(c)); return r; }
__device__ __forceinline__ float max2f(float a, float b) { float r; asm("v_max_f32_e32 %0, %1, %2" : "=v"(r) : "v"(a), "v"(b)); return r; }
__device__ __forceinline__ float fsub_s(float a, float b) { float r; asm("v_sub_f32_e32 %0, %1, %2" : "=v"(r) : "v"(a), "v"(b)); return r; }
typedef float f32x2_t __attribute__((ext_vector_type(2))); typedef __bf16 bf16x2_t __attribute__((ext_vector_type(2)));
__device__ __forceinline__ unsigned cvtpk_s(float lo, float hi) { f32x2_t v = {lo, hi}; bf16x2_t b = __builtin_convertvector(v, bf16x2_t); return __builtin_bit_cast(unsigned, b); }
#define WAIT_BAR(N) asm volatile("s_waitcnt vmcnt(" #N ") lgkmcnt(0)\n\ts_barrier" ::: "memory")
typedef __attribute__((address_space(3))) const char* lds_cptr;
typedef short v4i16_t __attribute__((ext_vector_type(4)));
__device__ __forceinline__ void cinit(f32x16& p0, f32x16& p1, const LAS float* fk, float a) {
#pragma unroll
    for (int g = 0; g < 4; ++g) { const f32x4 f0 = *(const LAS f32x4*)(fk + 8 * g), f1 = *(const LAS f32x4*)(fk + 32 + 8 * g);
#pragma unroll
        for (int i = 0; i < 4; ++i) { p0[4 * g + i] = a - f0[i]; p1[4 * g + i] = a - f1[i]; } }
}
__device__ __forceinline__ void qkt(f32x16& p0, f32x16& p1, const char* Kslot, const bf16x8v* qr, int r32, int hi) {
    const char* kb = Kslot + hi * 1024 + r32 * 16;
#pragma unroll
    for (int d0 = 0; d0 < 4; ++d0) {
        const bf16x8v b0 = *reinterpret_cast<const bf16x8v*>(kb + d0 * 2048);
        const bf16x8v b1 = *reinterpret_cast<const bf16x8v*>(kb + d0 * 2048 + 512);
        p0 = __builtin_amdgcn_mfma_f32_32x32x16_bf16(b0, qr[d0], p0, 0, 0, 0); p1 = __builtin_amdgcn_mfma_f32_32x32x16_bf16(b1, qr[d0], p1, 0, 0, 0); }
}
__device__ __forceinline__ void kload8(bf16x8v* kf, lds_cptr kp) {
    kf[0] = *(const LAS bf16x8v*)(kp);        kf[1] = *(const LAS bf16x8v*)(kp + 512);
    kf[2] = *(const LAS bf16x8v*)(kp + 2048); kf[3] = *(const LAS bf16x8v*)(kp + 2560);
    kf[4] = *(const LAS bf16x8v*)(kp + 4096); kf[5] = *(const LAS bf16x8v*)(kp + 4608);
    kf[6] = *(const LAS bf16x8v*)(kp + 6144); kf[7] = *(const LAS bf16x8v*)(kp + 6656);
}
__device__ __forceinline__ void kload2(bf16x8v* kf, lds_cptr kp, int j) { kf[2 * j] = *(const LAS bf16x8v*)(kp + j * 2048); kf[2 * j + 1] = *(const LAS bf16x8v*)(kp + j * 2048 + 512); }
__device__ __forceinline__ s16x4 vtr(lds_cptr p) { return __builtin_bit_cast(s16x4, __builtin_amdgcn_ds_read_tr16_b64_v4i16((LAS v4i16_t*)p)); }
__device__ __forceinline__ float rowmax(const f32x16& p0, const f32x16& p1) {
    float a = max3f(p0[0], p0[1], p1[0]), b = max3f(p0[2], p0[3], p1[1]); a = max3f(a, p1[2], p1[3]);
#pragma unroll
    for (int r = 4; r < 16; r += 4) { a = max3f(a, p0[r], p0[r + 1]); b = max3f(b, p0[r + 2], p0[r + 3]); a = max3f(a, p1[r], p1[r + 1]); b = max3f(b, p1[r + 2], p1[r + 3]); }
    const float m = max2f(a, b);
    auto rr = __builtin_amdgcn_permlane32_swap(__float_as_uint(m), __float_as_uint(m), false, false);
    return max2f(__uint_as_float(rr[0]), __uint_as_float(rr[1]));
}
__device__ __forceinline__ void pv(f32x16* o, int vb, bf16x8v pa0, bf16x8v pa1, bf16x8v pa2, bf16x8v pa3) {
#pragma unroll
    for (int d0 = 0; d0 < 2; ++d0) { s16x4 lo[4], hi[4];
#pragma unroll
        for (int ks = 0; ks < 4; ++ks) {
            asm volatile("ds_read_b64_tr_b16 %0,%1 offset:%c2" : "=&v"(lo[ks]) : "v"(vb), "i"(d0 * 4096 + ks * 1024) : "memory");
            asm volatile("ds_read_b64_tr_b16 %0,%1 offset:%c2" : "=&v"(hi[ks]) : "v"(vb), "i"(d0 * 4096 + ks * 1024 + 512) : "memory"); }
        asm volatile("s_waitcnt lgkmcnt(0)" ::: "memory"); SBAR();
#define PK(k) (bf16x8v){lo[k][0], lo[k][1], lo[k][2], lo[k][3], hi[k][0], hi[k][1], hi[k][2], hi[k][3]}
        o[d0] = __builtin_amdgcn_mfma_f32_32x32x16_bf16(pa0, PK(0), o[d0], 0, 0, 0);
        o[d0] = __builtin_amdgcn_mfma_f32_32x32x16_bf16(pa1, PK(1), o[d0], 0, 0, 0);
        o[d0] = __builtin_amdgcn_mfma_f32_32x32x16_bf16(pa2, PK(2), o[d0], 0, 0, 0);
        o[d0] = __builtin_amdgcn_mfma_f32_32x32x16_bf16(pa3, PK(3), o[d0], 0, 0, 0);
#undef PK
    }
}
template <int THRL> __device__ __forceinline__ void attn_unit(int b, int h, int qb, int tf, const bf16* Q, const bf16* __restrict__ K, const bf16* __restrict__ V, bf16* O, char* shm, int wid) {
    const int lane = lane_id_opaque(), r32 = lane & 31, hi = lane >> 5;
    const long rowbase = (long)b * SEQ; const int q0 = qb * QB;
    const bf16* Qw = Q + (rowbase + q0 + wid * QBLK) * DMA + h * 64;
    const bf16* Kh = K + rowbase * DMA + h * 64, *Vh = V + rowbase * DMA + h * 64;
    const bf16* Km = K + (long)TX * DMA + h * 64, *Vm = V + (long)TX * DMA + h * 64;
    const unsigned lds0 = (unsigned)(uintptr_t)shm;
    float* wsf = (float*)(shm + LDS_WS) + wid * 64;
    const bf16* ksrc = Kh + (long)lane * DMA + wid * 8;
    const bf16* vsrc = Vh + (long)(16 * (wid & 3) + (lane >> 2)) * DMA + (wid >> 2) * 32 + (lane & 3) * 8;
    const bf16* ksrcm = Km + (long)lane * DMA + wid * 8;
    const bf16* vsrcm = Vm + (long)(16 * (wid & 3) + (lane >> 2)) * DMA + (wid >> 2) * 32 + (lane & 3) * 8;
    const unsigned kdst = lds0 + LDS_K + wid * 1024, vdst = lds0 + LDS_V + wid * 1024;
#define DMA_K(t, slot) glds16(ksrc + (long)((t) - 1) * KVBLK * DMA, (unsigned)__builtin_amdgcn_readfirstlane(kdst + (slot)))
#define DMA_V(t, slot) glds16(vsrc + (long)((t) - 1) * KVBLK * DMA, (unsigned)__builtin_amdgcn_readfirstlane(vdst + (slot)))
    const int vb0 = (int)(lds0 + LDS_V) + ((lane >> 4) & 1) * 32 + (lane & 3) * 8 + (4 * hi + ((lane & 15) >> 2)) * 64;
    const char* Kbase = shm + LDS_K; bf16x8v kf[8];
    const lds_cptr shm3 = (lds_cptr)shm; const lds_cptr kp0 = shm3 + LDS_K + hi * 1024 + r32 * 16; const lds_cptr vp0 = shm3 + LDS_V + ((lane >> 4) & 1) * 32 + (lane & 3) * 8 + (4 * hi + ((lane & 15) >> 2)) * 64;
    const LAS float* Flp = (const LAS float*)(shm3 + LDS_FL) + 4 * hi;
    const int NT = 4 * qb + 5;
    glds16(tf == 0 ? ksrcm : ksrc + (long)(tf - 1) * KVBLK * DMA, (unsigned)__builtin_amdgcn_readfirstlane(kdst)); glds16(tf == 0 ? vsrcm : vsrc + (long)(tf - 1) * KVBLK * DMA, (unsigned)__builtin_amdgcn_readfirstlane(vdst)); DMA_K(tf + 1, SLOTB);
    bf16x8v qr[4];
#pragma unroll
    for (int d0 = 0; d0 < 4; ++d0) qr[d0] = *reinterpret_cast<const bf16x8v*>(&Qw[(long)r32 * DMA + d0 * 16 + hi * 8]);
    float aq = ((const LAS float*)(shm3 + LDS_FL))[64 + q0 + wid * QBLK + r32 - 64 * tf];
    float l_reg = 0.f; f32x16 o[2]; o[0] = f32x16{}; o[1] = f32x16{};
    const int qrel = wid * QBLK + r32;
#define CMASK(P0, P1, t) do { int jb_ = (t) - (NT - 4); if (jb_ >= 0) cmask(P0, P1, jb_, qrel, hi); } while (0)
    bool resc = false;
#define START(P0, P1) do { const float rm = rowmax(P0, P1); resc = false; \
    { const float dl = max2f(rm, 0.f); aq = fsub_s(aq, dl);        \
      _Pragma("unroll") for (int r = 0; r < 16; ++r) { P0[r] = fsub_s(P0[r], dl); P1[r] = fsub_s(P1[r], dl); } } \
    _Pragma("unroll") for (int r = 0; r < 16; ++r) P0[r] = __builtin_amdgcn_exp2f(P0[r]); } while (0)
#define RESC() do { if (resc) { asm volatile("s_waitcnt lgkmcnt(0)" ::: "memory"); \
      _Pragma("unroll") for (int d_ = 0; d_ < 2; ++d_) _Pragma("unroll") for (int r = 0; r < 16; ++r) o[d_][r] *= wsf[crow(r, hi)]; } } while (0)
    f32x16 pA0, pA1, pB0, pB1;
    int sl_prev = 0, sl_cur = 0, sl_next = SLOTB;
#define ROT() do { sl_prev = sl_cur; sl_cur = sl_next; sl_next = (sl_next == (NSLOT - 1) * SLOTB) ? 0 : sl_next + SLOTB; } while (0)
    DMA_K(tf + 2, 2 * SLOTB);
    cinit(pA0, pA1, Flp, aq);
    WAIT_BAR(3);
    qkt(pA0, pA1, Kbase, qr, r32, hi); asm volatile("s_nop 15\n\ts_nop 7" : "+v"(pA0), "+v"(pA1));
    START(pA0, pA1);
    _Pragma("unroll") for (int r = 0; r < 16; ++r) pA1[r] = __builtin_amdgcn_exp2f(pA1[r]);
    WAIT_BAR(0);
    DMA_K(tf + 3, 0); DMA_V(tf + 1, SLOTB);
    ROT();
    kload8(kf, kp0 + sl_cur);
    WAIT_BAR(2);
    s16x4 vlo[8], vhi[8]; u32x4 pw0, pw1, pw2, pw3;
#define PKW(P, B) cvtpk_s(P[B], P[B + 1])
#define PAF(k) __builtin_bit_cast(bf16x8v, pw##k)
#define VFR(i) (bf16x8v){vlo[i][0], vlo[i][1], vlo[i][2], vlo[i][3], vhi[i][0], vhi[i][1], vhi[i][2], vhi[i][3]}
#define PIN(x) asm volatile("" : "+v"(x))
#define MX3(a, b, c) __builtin_fmaxf(__builtin_fmaxf((a), (b)), (c))
#define GAPA(MF, A0, A1, A2, A3, W0, W1, PW) do { MF; sacc += A0; sacc += A1; sacc += A2; sacc += A3; PIN(sacc); W0; W1; PIN(PW); SBAR(); } while (0)
#define EX(v) __builtin_amdgcn_exp2f(v)
#define GAPB(MF, X, B) do { MF; X[B] = EX(X[B]); X[B + 1] = EX(X[B + 1]); X[B + 2] = EX(X[B + 2]); X[B + 3] = EX(X[B + 3]); PIN(X); SBAR(); } while (0)
#define VRD(i) do { vlo[i] = vtr(vp_ + (((i) >> 2) * 4096 + ((i) & 3) * 1024)); vhi[i] = vtr(vp_ + (((i) >> 2) * 4096 + ((i) & 3) * 1024 + 512)); } while (0)
#define KRD(G, j) do { if (G) { kload2(kf, kp0 + sl_next, j); SBAR(); } } while (0)
#define STEP(C0, C1, P0, P1, t, GK, GV, GL) do { SBAR(); \
    cinit(C0, C1, Flp + 64 * ((t) - tf), aq); SBAR(); \
    const lds_cptr vp_ = vp0 + sl_prev; \
    VRD(0); SBAR(); float sacc = (P0[0] + P0[1]); \
    GAPA(C0 = __builtin_amdgcn_mfma_f32_32x32x16_bf16(kf[0], qr[0], C0, 0, 0, 0), P0[2], P0[3], P0[4], P0[5],     pw0[0] = PKW(P0, 0), pw0[1] = PKW(P0, 2), pw0); \
    VRD(4); SBAR(); GAPA(C1 = __builtin_amdgcn_mfma_f32_32x32x16_bf16(kf[1], qr[0], C1, 0, 0, 0), P0[6], P0[7], P0[8], P0[9],     pw0[2] = PKW(P0, 4), pw0[3] = PKW(P0, 6), pw0); \
    VRD(1); SBAR(); GAPA(C0 = __builtin_amdgcn_mfma_f32_32x32x16_bf16(kf[2], qr[1], C0, 0, 0, 0),   P0[10], P0[11], P0[12], P0[13], pw1[0] = PKW(P0, 8), pw1[1] = PKW(P0, 10), pw1); \
    VRD(5); SBAR(); GAPA(C1 = __builtin_amdgcn_mfma_f32_32x32x16_bf16(kf[3], qr[1], C1, 0, 0, 0),   P0[14], P0[15], P1[0], P1[1],   pw1[2] = PKW(P0, 12), pw1[3] = PKW(P0, 14), pw1); \
    VRD(2); SBAR(); GAPA(C0 = __builtin_amdgcn_mfma_f32_32x32x16_bf16(kf[4], qr[2], C0, 0, 0, 0),   P1[2], P1[3], P1[4], P1[5],     pw2[0] = PKW(P1, 0), pw2[1] = PKW(P1, 2), pw2); \
    VRD(6); SBAR(); GAPA(C1 = __builtin_amdgcn_mfma_f32_32x32x16_bf16(kf[5], qr[2], C1, 0, 0, 0),   P1[6], P1[7], P1[8], P1[9],     pw2[2] = PKW(P1, 4), pw2[3] = PKW(P1, 6), pw2); \
    VRD(3); SBAR(); GAPA(C0 = __builtin_amdgcn_mfma_f32_32x32x16_bf16(kf[6], qr[3], C0, 0, 0, 0),   P1[10], P1[11], P1[12], P1[13], pw3[0] = PKW(P1, 8), pw3[1] = PKW(P1, 10), pw3); \
    VRD(7); SBAR(); GAPA(C1 = __builtin_amdgcn_mfma_f32_32x32x16_bf16(kf[7], qr[3], C1, 0, 0, 0),   P1[14], P1[15], 0.f, 0.f,       pw3[2] = PKW(P1, 12), pw3[3] = PKW(P1, 14), pw3); \
    l_reg += sacc; \
    if (GK) { DMA_K((t) + 3, sl_cur); } if (GV) { DMA_V((t) + 1, sl_next); } \
    CMASK(C0, C1, t); \
    { float a = MX3(C0[0], C0[1], C1[0]), b_ = MX3(C0[2], C0[3], C1[1]); a = MX3(a, C1[2], C1[3]); \
      _Pragma("unroll") for (int r = 4; r < 16; r += 4) { a = MX3(a, C0[r], C0[r + 1]); b_ = MX3(b_, C0[r + 2], C0[r + 3]); a = MX3(a, C1[r], C1[r + 1]); b_ = MX3(b_, C1[r + 2], C1[r + 3]); } \
      float rm = __builtin_fmaxf(a, b_); { auto rr = __builtin_amdgcn_permlane32_swap(__float_as_uint(rm), __float_as_uint(rm), false, false); rm = __builtin_fmaxf(__uint_as_float(rr[0]), __uint_as_float(rr[1])); } \
      resc = false; \
      if (__builtin_expect(__any(rm > (float)THRL), 0)) { const float dl = __builtin_fmaxf(rm, 0.f); aq -= dl; \
        _Pragma("unroll") for (int r = 0; r < 16; ++r) { C0[r] -= dl; C1[r] -= dl; } \
        const float f = __builtin_amdgcn_exp2f(-dl); l_reg *= f; if (hi == 0) wsf[r32] = f; resc = true; } } \
    SBAR(); \
    GAPB(o[0] = __builtin_amdgcn_mfma_f32_32x32x16_bf16(PAF(0), VFR(0), o[0], 0, 0, 0), C0, 0); \
    GAPB(o[1] = __builtin_amdgcn_mfma_f32_32x32x16_bf16(PAF(0), VFR(4), o[1], 0, 0, 0), C0, 4); \
    KRD(GL, 0); GAPB(o[0] = __builtin_amdgcn_mfma_f32_32x32x16_bf16(PAF(1), VFR(1), o[0], 0, 0, 0), C0, 8); \
    KRD(GL, 1); GAPB(o[1] = __builtin_amdgcn_mfma_f32_32x32x16_bf16(PAF(1), VFR(5), o[1], 0, 0, 0), C0, 12); \
    KRD(GL, 2); GAPB(o[0] = __builtin_amdgcn_mfma_f32_32x32x16_bf16(PAF(2), VFR(2), o[0], 0, 0, 0), C1, 0); \
    KRD(GL, 3); GAPB(o[1] = __builtin_amdgcn_mfma_f32_32x32x16_bf16(PAF(2), VFR(6), o[1], 0, 0, 0), C1, 4); \
    GAPB(o[0] = __builtin_amdgcn_mfma_f32_32x32x16_bf16(PAF(3), VFR(3), o[0], 0, 0, 0), C1, 8); \
    GAPB(o[1] = __builtin_amdgcn_mfma_f32_32x32x16_bf16(PAF(3), VFR(7), o[1], 0, 0, 0), C1, 12); \
    } while (0)
    int t = tf + 1;
#undef CMASK
#define CMASK(P0, P1, t) do { } while (0)
    for (; t + 5 < NT; t += 2) {
        STEP(pB0, pB1, pA0, pA1, t, true, true, true);     WAIT_BAR(2); RESC(); ROT();
        STEP(pA0, pA1, pB0, pB1, t + 1, true, true, true); WAIT_BAR(2); RESC(); ROT();
    }
#undef CMASK
#define CMASK(P0, P1, t) do { int jb_ = (t) - (NT - 4); if (jb_ >= 0) cmask(P0, P1, jb_, qrel, hi); } while (0)
#define ENDW(tt) do { if ((tt) + 3 < NT) { WAIT_BAR(2); } else if ((tt) + 2 < NT) { WAIT_BAR(1); } else { WAIT_BAR(0); } } while (0)
    for (; t + 1 < NT; t += 2) {
        STEP(pB0, pB1, pA0, pA1, t, (t + 3 < NT), (t + 1 < NT), (t + 1 < NT));         ENDW(t);     RESC(); ROT();
        STEP(pA0, pA1, pB0, pB1, t + 1, (t + 4 < NT), (t + 2 < NT), (t + 2 < NT));     ENDW(t + 1); RESC(); ROT();
    }
    { float sacc = pA0[0] + pA0[1]; _Pragma("unroll") for (int r = 2; r < 16; ++r) sacc += pA0[r]; _Pragma("unroll") for (int r = 0; r < 16; ++r) sacc += pA1[r]; l_reg += sacc;
      pw0 = (u32x4){PKW(pA0, 0), PKW(pA0, 2), PKW(pA0, 4), PKW(pA0, 6)}; pw1 = (u32x4){PKW(pA0, 8), PKW(pA0, 10), PKW(pA0, 12), PKW(pA0, 14)}; pw2 = (u32x4){PKW(pA1, 0), PKW(pA1, 2), PKW(pA1, 4), PKW(pA1, 6)}; pw3 = (u32x4){PKW(pA1, 8), PKW(pA1, 10), PKW(pA1, 12), PKW(pA1, 14)};
      SBAR(); pv(o, vb0 + sl_prev, PAF(0), PAF(1), PAF(2), PAF(3)); }
#undef PKW
#undef PAF
#undef VFR
#undef PIN
#undef MX3
#undef GAPA
#undef GAPB
#undef EX
#undef VRD
#undef KRD
#undef STEP
#undef ENDW
    { auto rr = __builtin_amdgcn_permlane32_swap(__float_as_uint(l_reg), __float_as_uint(l_reg), false, false); l_reg = __uint_as_float(rr[0]) + __uint_as_float(rr[1]); }
    if (hi == 0) wsf[32 + r32] = l_reg; asm volatile("s_waitcnt lgkmcnt(0)" ::: "memory");
    float rli[16];
#pragma unroll
    for (int r = 0; r < 16; ++r) rli[r] = __builtin_amdgcn_rcpf(wsf[32 + crow(r, hi)]);
    bf16* Ow = O + (rowbase + q0 + wid * QBLK) * DMO + h * 64;
    { bf16* stg = (bf16*)(shm + LDS_OST) + wid * 2048;
#pragma unroll
      for (int r = 0; r < 16; ++r) { const int orow = crow(r, hi);
#pragma unroll
          for (int d0 = 0; d0 < 2; ++d0) stg[orow * 64 + d0 * 32 + r32] = (bf16)f2bf(o[d0][r] * rli[r]); }
      asm volatile("s_waitcnt lgkmcnt(0)" ::: "memory");
#pragma unroll
      for (int i = 0; i < 4; ++i) { const int row = i * 8 + (lane >> 3), ch = lane & 7; const u32x4 v = *(const u32x4*)(stg + row * 64 + ch * 8); *(u32x4*)(Ow + (long)row * DMO + ch * 8) = v; } }
    asm volatile("s_waitcnt lgkmcnt(0)\n\ts_barrier" ::: "memory");
#undef DMA_K
#undef DMA_V
#undef CMASK
#undef START
#undef RESC
#undef ROT
}
#undef SBAR
#undef WAIT_BAR
}
__device__ __forceinline__ void phase_scan(Frame& F) {
#pragma unroll 1
    for (int bh = F.vcu; bh < 32; bh += F.G) {
        attn_scan(F, bh >> 3, bh & 7, false, fa::LDS_FL, fa::LDS_SCAN);
        const LAS float* Fl = (const LAS float*)(F.lds + fa::LDS_FL); float* FLg = (float*)(WSP() + WS_FL) + (size_t)bh * FLN;
#pragma unroll 1
        for (int i = F.tid; i < FLN / 4; i += 512) *(f32x4*)(FLg + 4 * i) = *(const LAS f32x4*)(Fl + 4 * i);
    }
    __syncthreads();
}
__device__ __forceinline__ void phase_B(Frame& F, int l) {
    LAS int* qs = (LAS int*)(F.lds + LC_QS);
    unsigned* ctl = (unsigned*)(WSP() + WS_CTL); unsigned* head = ctl + CW_AQ + l * 64; const unsigned* nrm = ctl + CW_NRM + l * 64;
    const float* FLg = (const float*)(WSP() + WS_FL);
#pragma unroll 1
    for (;;) {
        __syncthreads();
        if (F.tid == 0) { qs[0] = (int)atomicAdd(head, 1u); qs[1] = 0; }
        __syncthreads();
        const int u = __builtin_amdgcn_readfirstlane(qs[0]);
        if (u >= 1032) break;
        if (u < 1024) {
            const int qb = 31 - (u >> 5), bh = u & 31, b = bh >> 3, h = bh & 7, NT = 4 * qb + 5;
            const float kn = __uint_as_float(__hip_atomic_load(nrm + bh, __ATOMIC_RELAXED, __HIP_MEMORY_SCOPE_AGENT)), qn = __uint_as_float(__hip_atomic_load(nrm + 32 + bh, __ATOMIC_RELAXED, __HIP_MEMORY_SCOPE_AGENT));
            const float T = 50.0f + sqrtf(kn * qn);
            const float* FLb = FLg + (size_t)bh * FLN; const float Fq0 = FLb[64 + 256 * qb];
            { const int t = F.tid; const bool skip = (t <= NT - 5) && (FLb[t == 0 ? 15 : 64 * t + 63] > Fq0 + T);
              const int c = __builtin_popcountll(__ballot(skip)); if (F.lane == 0 && c) __hip_atomic_fetch_add(&qs[1], c, __ATOMIC_RELAXED, __HIP_MEMORY_SCOPE_WORKGROUP); }
            __syncthreads();
            int tf = __builtin_amdgcn_readfirstlane(qs[1]); if (((NT - tf) & 1) == 0) tf -= 1;
            { LAS float* Fl = (LAS float*)(F.lds + fa::LDS_FL); const int n4 = (NT - tf) * 16;
#pragma unroll 1
              for (int i = F.tid; i < n4; i += 512) *(LAS f32x4*)(Fl + 4 * i) = *(const f32x4*)(FLb + 64 * tf + 4 * i); }
            __syncthreads();
            unsigned char* dol = DOP();
            fa::attn_unit<8>(b, h, qb, tf, (const bf16*)(dol + DO_Q), (const bf16*)(dol + DO_K), (const bf16*)(dol + DO_V), (bf16*)(WSP() + WS_X3) + 512, (char*)F.lds, F.wave);
        } else {
            const int t_ = F.wave * 64 + lane_id_opaque(); F.tid = t_; F.lane = t_ & 63;
            attn_scan(F, 0, u - 1024, true, AT_FL, AT_SC); attn_unit_naive(F, TX, 0, 1, 0, u - 1024, NMETA);
        }
    }
    __syncthreads();
}

__device__ __forceinline__ void class_tables(Frame& F, int l) {
    LAS int* base = (LAS int*)(F.lds + LC_BASE); LAS int* pcls = (LAS int*)(F.lds + LC_PCLS); LAS int* np = (LAS int*)(F.lds + LC_NP);
    const unsigned* gcnt = (const unsigned*)(WSP() + WS_CTL) + CW_GCNT + l * 64;
    __syncthreads();
    if (F.tid == 0) { int p = 0;
#pragma unroll 1
        for (int c = 0; c < NCLS; ++c) { base[c] = p * 256; int n = (int)__hip_atomic_load(gcnt + c, __ATOMIC_RELAXED, __HIP_MEMORY_SCOPE_AGENT); if (n > TR) n = TR; if (n < 0) n = 0; p += (n + 255) >> 8; }
        if (p > 160) p = 160; base[NCLS] = p * 256; np[0] = p; }
    __syncthreads();
    if (F.tid < 160) { const int mypos = F.tid * 256; int c = 0;
#pragma unroll 1
        for (int k = 1; k < NCLS; ++k) if (base[k] <= mypos) c = k;
        pcls[F.tid] = c; }
    __syncthreads();
}
template <int NG, int CH> __device__ __forceinline__ void e1_groups(Frame& F, int l, const int (&rowv)[NG], const int (&grpv)[NG], const LAS bf16* Rhi, const LAS bf16* Rlo, LAS int* rec, LAS int* lcnt,
                                                                   const float* reb, const float* rgb, int fr, int fq) {
    const float* hsrc[NG]; bf16* hbdst[NG]; const bf16* dsrc[NG];
#pragma unroll
    for (int g = 0; g < NG; ++g) { const int row = rowv[g];
        hsrc[g] = l == 0 ? (row < TX ? INP(I_X) + (size_t)row * D : INP(I_META) + (size_t)(row - TX) * D) : (const float*)(WSP() + WS_H) + (size_t)row * D;
        hbdst[g] = (bf16*)(WSP() + WS_HB) + (size_t)row * D; dsrc[g] = (const bf16*)(WSP() + WS_X3) + (size_t)row * D; }
    const LAS bf16* bh0 = Rhi + fr * RPITCH + 8 * fq; const LAS bf16* bl0 = Rlo + fr * RPITCH + 8 * fq;
    const LAS bf16* bh1 = Rhi + (16 + (fr & 3)) * RPITCH + 8 * fq; const LAS bf16* bl1 = Rlo + (16 + (fr & 3)) * RPITCH + 8 * fq;
    f32x4 acc0[NG], acc1[NG]; float ss[NG];
#pragma unroll
    for (int g = 0; g < NG; ++g) { acc0[g] = (f32x4){0.f, 0.f, 0.f, 0.f}; acc1[g] = acc0[g]; ss[g] = 0.f; }
    f32x4 ch0[NG][CH], ch1[NG][CH]; u32x4 cd[NG][CH];
#pragma unroll
    for (int g = 0; g < NG; ++g)
#pragma unroll
        for (int c = 0; c < CH; ++c) { const int k = 32 * c + 8 * fq; ch0[g][c] = *(const f32x4*)(hsrc[g] + k); ch1[g][c] = *(const f32x4*)(hsrc[g] + k + 4); cd[g][c] = *(const u32x4*)(dsrc[g] + k); }
#pragma unroll 1
    for (int s0 = 0; s0 < 32; s0 += CH) {
        f32x4 nh0[NG][CH], nh1[NG][CH]; u32x4 nd[NG][CH];
        if (s0 + CH < 32) {
#pragma unroll
            for (int g = 0; g < NG; ++g)
#pragma unroll
                for (int c = 0; c < CH; ++c) { const int k = 32 * (s0 + CH + c) + 8 * fq; nh0[g][c] = *(const f32x4*)(hsrc[g] + k); nh1[g][c] = *(const f32x4*)(hsrc[g] + k + 4); nd[g][c] = *(const u32x4*)(dsrc[g] + k); }
        }
#pragma unroll
        for (int c = 0; c < CH; ++c) { const int s = s0 + c, k = 32 * s + 8 * fq;
            const bf16x8 wh0 = *(const LAS bf16x8*)(bh0 + 32 * s), wl0 = *(const LAS bf16x8*)(bl0 + 32 * s);
            bf16x8 wh1 = *(const LAS bf16x8*)(bh1 + 32 * s), wl1 = *(const LAS bf16x8*)(bl1 + 32 * s);
            if (fr >= 4) { wh1 = (bf16x8){0, 0, 0, 0, 0, 0, 0, 0}; wl1 = wh1; }
#pragma unroll
            for (int g = 0; g < NG; ++g) { f32x4 h0 = ch0[g][c], h1 = ch1[g][c]; const u32x4 dv = cd[g][c];
                h0[0] += bflo(dv.x); h0[1] += bfhi(dv.x); h0[2] += bflo(dv.y); h0[3] += bfhi(dv.y); h1[0] += bflo(dv.z); h1[1] += bfhi(dv.z); h1[2] += bflo(dv.w); h1[3] += bfhi(dv.w);
                ss[g] += (h0[0] * h0[0] + h0[1] * h0[1]) + (h0[2] * h0[2] + h0[3] * h0[3]) + (h1[0] * h1[0] + h1[1] * h1[1]) + (h1[2] * h1[2] + h1[3] * h1[3]);
                const u32x4 hw = pack8(h0, h1); *(u32x4*)(hbdst[g] + k) = hw;
                f32x4 r0, r1; r0[0] = h0[0] - bflo(hw.x); r0[1] = h0[1] - bfhi(hw.x); r0[2] = h0[2] - bflo(hw.y); r0[3] = h0[3] - bfhi(hw.y);
                r1[0] = h1[0] - bflo(hw.z); r1[1] = h1[1] - bfhi(hw.z); r1[2] = h1[2] - bflo(hw.w); r1[3] = h1[3] - bfhi(hw.w);
                const u32x4 lw = pack8(r0, r1);
                const bf16x8 ah = __builtin_bit_cast(bf16x8, hw), al = __builtin_bit_cast(bf16x8, lw);
                acc0[g] = __builtin_amdgcn_mfma_f32_16x16x32_bf16(wh0, ah, acc0[g], 0, 0, 0); acc0[g] = __builtin_amdgcn_mfma_f32_16x16x32_bf16(wh0, al, acc0[g], 0, 0, 0); acc0[g] = __builtin_amdgcn_mfma_f32_16x16x32_bf16(wl0, ah, acc0[g], 0, 0, 0);
                acc1[g] = __builtin_amdgcn_mfma_f32_16x16x32_bf16(wh1, ah, acc1[g], 0, 0, 0); acc1[g] = __builtin_amdgcn_mfma_f32_16x16x32_bf16(wh1, al, acc1[g], 0, 0, 0); acc1[g] = __builtin_amdgcn_mfma_f32_16x16x32_bf16(wl1, ah, acc1[g], 0, 0, 0); } }
        if (s0 + CH < 32) {
#pragma unroll
            for (int g = 0; g < NG; ++g)
#pragma unroll
                for (int c = 0; c < CH; ++c) { ch0[g][c] = nh0[g][c]; ch1[g][c] = nh1[g][c]; cd[g][c] = nd[g][c]; }
        }
    }
#pragma unroll
    for (int g = 0; g < NG; ++g) {
        float sg = ss[g]; sg += lane_xor<16>(sg); sg += lane_xor<32>(sg);
        const float rstd2 = rsqrtf(sg * (1.0f / D) + EPS);
        float gl[4];
#pragma unroll
        for (int q = 0; q < 4; ++q) gl[q] = __int_as_float(__builtin_amdgcn_ds_bpermute(fr << 2, __float_as_int(acc1[g][q]))) * rstd2 + rgb[q];
        int gsel = 0; float gmax = gl[0];
#pragma unroll
        for (int q = 1; q < 4; ++q) if (gl[q] > gmax) { gmax = gl[q]; gsel = q; }
        float gsum = 0.f;
#pragma unroll
        for (int q = 0; q < 4; ++q) gsum += __expf(gl[q] - gmax);
        const float gwt = 1.0f / gsum;
        if (fq == gsel) {
            float el[4];
#pragma unroll
            for (int e = 0; e < 4; ++e) el[e] = acc0[g][e] * rstd2 + reb[gsel * 4 + e];
            int t1 = 0; float l1 = el[0];
#pragma unroll
            for (int e = 1; e < 4; ++e) if (el[e] > l1) { l1 = el[e]; t1 = e; }
            int t2 = -1; float l2 = -3.0e38f;
#pragma unroll
            for (int e = 0; e < 4; ++e) if (e != t1 && el[e] > l2) { l2 = el[e]; t2 = e; }
            const float w1 = 1.0f / (1.0f + __expf(l2 - l1)), w2 = 1.0f - w1;
            const int ea = min(t1, t2), eb = max(t1, t2); const float cA = gwt * (t1 == ea ? w1 : w2), cB = gwt * (t1 == ea ? w2 : w1);
            const int pr = ea == 0 ? eb - 1 : (ea == 1 ? eb + 1 : 5); int cls = gsel * 6 + pr; if (!(cls >= 0 && cls < NCLS)) cls = 0;
            const int rank = __hip_atomic_fetch_add(&lcnt[cls], 1, __ATOMIC_RELAXED, __HIP_MEMORY_SCOPE_WORKGROUP); const int rr = grpv[g] * 16 + fr;
            rec[rr * 5] = cls; rec[rr * 5 + 1] = rank; rec[rr * 5 + 2] = __float_as_int(cA); rec[rr * 5 + 3] = __float_as_int(cB); rec[rr * 5 + 4] = __float_as_int(rstd2);
        }
    }
}
__device__ __forceinline__ void phase_E1(Frame& F, int l) {
    LAS bf16* Rhi = (LAS bf16*)F.lds; LAS bf16* Rlo = Rhi + 20 * RPITCH;
    LAS int* rec = (LAS int*)(F.lds + 83968);
    LAS int* lcnt = (LAS int*)(F.lds + LC_CNT); LAS int* wgb = (LAS int*)(F.lds + LC_BASE);
    const float* rg = (const float*)(WSP() + WS_RG);
    const float* reb = INP(I_REB) + l * 16; const float* rgb = INP(I_RGB) + l * 4;
    unsigned* gcnt = (unsigned*)(WSP() + WS_CTL) + CW_GCNT + l * 64; int* route = (int*)(WSP() + WS_ROUTE);
    const int tid = F.tid, lane = F.lane, wave = F.wave, fr = lane & 15, fq = lane >> 4;
    { f32x4 rv[10];
#pragma unroll
      for (int j = 0; j < 10; ++j) rv[j] = *(const f32x4*)(rg + 4 * (tid + 512 * j));
#pragma unroll
      for (int j = 0; j < 10; ++j) { const int i = 4 * (tid + 512 * j), c = i >> 10, k = i & 1023; u32x2 hw, lw; float hf[4];
#pragma unroll
          for (int e = 0; e < 4; ++e) hf[e] = __builtin_bit_cast(float, (pk2(rv[j][e], 0.f) & 0xffffu) << 16);
          hw.x = pk2(rv[j][0], rv[j][1]); hw.y = pk2(rv[j][2], rv[j][3]); lw.x = pk2(rv[j][0] - hf[0], rv[j][1] - hf[1]); lw.y = pk2(rv[j][2] - hf[2], rv[j][3] - hf[3]);
          *(LAS u32x2*)(Rhi + c * RPITCH + k) = hw; *(LAS u32x2*)(Rlo + c * RPITCH + k) = lw; } }
#pragma unroll 1
    for (int wg = F.vcu; wg < 256; wg += F.G) {
        if (tid < NCLS) lcnt[tid] = 0;
        __syncthreads();
        const int ngrp = wg == 0 ? 9 : 8;
        if (wg == 0 && wave == 0) { const int rows2[2] = {fr, TX + fr}; const int grps2[2] = {0, 8}; e1_groups<2, 2>(F, l, rows2, grps2, Rhi, Rlo, rec, lcnt, reb, rgb, fr, fq); }
        else { const int rows1[1] = {wg * 128 + wave * 16 + fr}; const int grps1[1] = {wave}; e1_groups<1, 4>(F, l, rows1, grps1, Rhi, Rlo, rec, lcnt, reb, rgb, fr, fq); }
        __syncthreads();
        if (tid < NCLS) { const int n = lcnt[tid]; wgb[tid] = n > 0 ? (int)atomicAdd(gcnt + tid, (unsigned)n) : 0; }
        __syncthreads();
        const int nrw = ngrp * 16;
        for (int rr = tid; rr < nrw; rr += 512) { const int row = rr < 128 ? wg * 128 + rr : TX + (rr - 128); const int cls = rec[rr * 5];
            int* rp = route + (size_t)row * 8; rp[0] = cls; rp[1] = wgb[cls] + rec[rr * 5 + 1]; rp[2] = rec[rr * 5 + 2]; rp[3] = rec[rr * 5 + 3]; rp[4] = rec[rr * 5 + 4]; }
        __syncthreads();
    }
}
__device__ __forceinline__ void phase_E1b(Frame& F, int l) {
    class_tables(F, l);
    const LAS int* base = (const LAS int*)(F.lds + LC_BASE);
    const int* route = (const int*)(WSP() + WS_ROUTE); const bf16* HB = (const bf16*)(WSP() + WS_HB); bf16* XS = (bf16*)(WSP() + WS_XS); float* PW = (float*)(WSP() + WS_PW);
    const int gw = F.vcu * NWAVES + F.wave, NGW = F.G * NWAVES, lane = F.lane;
    constexpr int R = 4;
#pragma unroll 1
    for (int row0 = gw; row0 < TR; row0 += R * NGW) {
        int rowv[R], pos[R]; u32x4 hw[R][2];
#pragma unroll
        for (int r = 0; r < R; ++r) { const int row = row0 + r * NGW; rowv[r] = row < TR ? row : TR - 1; const int* rp = route + (size_t)rowv[r] * 8; pos[r] = base[rp[0]] + rp[1];
#pragma unroll
            for (int j = 0; j < 2; ++j) hw[r][j] = *(const u32x4*)(HB + (size_t)rowv[r] * D + 8 * lane + 512 * j); }
#pragma unroll
        for (int r = 0; r < R; ++r) { const int row = row0 + r * NGW; if (row >= TR || pos[r] < 0 || pos[r] >= NPOSMAX) continue;
#pragma unroll
            for (int j = 0; j < 2; ++j) *(u32x4*)(XS + (size_t)pos[r] * D + 8 * lane + 512 * j) = hw[r][j];
            if (lane == 0) { const int* rp = route + (size_t)row * 8; f32x4 w; w[0] = __int_as_float(rp[4]); w[1] = __int_as_float(rp[2]); w[2] = __int_as_float(rp[3]); w[3] = 0.f; *(f32x4*)(PW + (size_t)pos[r] * 4) = w; } }
    }
}
__device__ __forceinline__ void phase_E4(Frame& F, int l) {
    class_tables(F, l);
    const LAS int* base = (const LAS int*)(F.lds + LC_BASE);
    const int* route = (const int*)(WSP() + WS_ROUTE); float* H = (float*)(WSP() + WS_H); bf16* HB = (bf16*)(WSP() + WS_HB); const bf16* Y = (const bf16*)(WSP() + WS_Y);
    float* rstd1 = (float*)(WSP() + WS_RSTD1); const float* fg = INP(I_FG); float* out = (float*)DOP(); const bf16* DL = (const bf16*)(WSP() + WS_X3);
    const int gw = F.vcu * NWAVES + F.wave, NGW = F.G * NWAVES, lane = F.lane; const bool lastl = (l == DEPTH - 1);
    constexpr int R = 4;
#pragma unroll 1
    for (int row0 = gw; row0 < TR; row0 += R * NGW) {
        int rowv[R], pos[R];
#pragma unroll
        for (int r = 0; r < R; ++r) { const int row = row0 + r * NGW; rowv[r] = row < TR ? row : TR - 1; const int* rp = route + (size_t)rowv[r] * 8; int p = base[rp[0]] + rp[1]; if (p < 0 || p >= NPOSMAX) p = 0; pos[r] = p; }
        u32x4 yw[R][2], dw[R][2]; f32x4 hv[R][2][2];
#pragma unroll
        for (int r = 0; r < R; ++r)
#pragma unroll
            for (int j = 0; j < 2; ++j) { yw[r][j] = *(const u32x4*)(Y + (size_t)pos[r] * D + 8 * lane + 512 * j);
                const float* hs = l == 0 ? (rowv[r] < TX ? INP(I_X) + (size_t)rowv[r] * D : INP(I_META) + (size_t)(rowv[r] - TX) * D) : H + (size_t)rowv[r] * D;
                hv[r][j][0] = *(const f32x4*)(hs + 8 * lane + 512 * j); hv[r][j][1] = *(const f32x4*)(hs + 8 * lane + 512 * j + 4); dw[r][j] = *(const u32x4*)(DL + (size_t)rowv[r] * D + 8 * lane + 512 * j); }
#pragma unroll
        for (int r = 0; r < R; ++r) { const int row = row0 + r * NGW; float ss = 0.f;
#pragma unroll
            for (int j = 0; j < 2; ++j) { const u32x4 w = yw[r][j], d4 = dw[r][j];
                hv[r][j][0][0] += bflo(d4.x); hv[r][j][0][1] += bfhi(d4.x); hv[r][j][0][2] += bflo(d4.y); hv[r][j][0][3] += bfhi(d4.y); hv[r][j][1][0] += bflo(d4.z); hv[r][j][1][1] += bfhi(d4.z); hv[r][j][1][2] += bflo(d4.w); hv[r][j][1][3] += bfhi(d4.w);
                hv[r][j][0][0] += bflo(w.x); hv[r][j][0][1] += bfhi(w.x); hv[r][j][0][2] += bflo(w.y); hv[r][j][0][3] += bfhi(w.y);
                hv[r][j][1][0] += bflo(w.z); hv[r][j][1][1] += bfhi(w.z); hv[r][j][1][2] += bflo(w.w); hv[r][j][1][3] += bfhi(w.w);
#pragma unroll
                for (int q = 0; q < 2; ++q) ss += hv[r][j][q][0] * hv[r][j][q][0] + hv[r][j][q][1] * hv[r][j][q][1] + hv[r][j][q][2] * hv[r][j][q][2] + hv[r][j][q][3] * hv[r][j][q][3]; }
            const float rs = rsqrtf(wave_sum(ss) * (1.0f / D) + EPS);
            if (row < TR) {
                if (!lastl) {
#pragma unroll
                    for (int j = 0; j < 2; ++j) { *(f32x4*)(H + (size_t)row * D + 8 * lane + 512 * j) = hv[r][j][0]; *(f32x4*)(H + (size_t)row * D + 8 * lane + 512 * j + 4) = hv[r][j][1];
                        *(u32x4*)(HB + (size_t)row * D + 8 * lane + 512 * j) = pack8(hv[r][j][0], hv[r][j][1]); }
                    if (lane == 0) rstd1[row] = rs;
                } else if (row < TX) {
#pragma unroll
                    for (int j = 0; j < 2; ++j) { const f32x4 g0 = *(const f32x4*)(fg + 8 * lane + 512 * j), g1 = *(const f32x4*)(fg + 8 * lane + 512 * j + 4);
                        *(f32x4*)(out + (size_t)row * D + 8 * lane + 512 * j) = hv[r][j][0] * rs * g0; *(f32x4*)(out + (size_t)row * D + 8 * lane + 512 * j + 4) = hv[r][j][1] * rs * g1; }
                }
            }
        }
    }
}
#define RELANE() do { const int t_ = wv0 * 64 + lane_id_opaque(); F.tid = t_; F.lane = t_ & 63; F.wave = __builtin_amdgcn_readfirstlane(t_ >> 6); \
    int g_ = gridDim.x; LAUNDER_S(g_); int b_ = blockIdx.x; LAUNDER_S(b_); F.G = g_; F.bx = b_; F.vcu = (g_ % 8 == 0) ? (b_ % 8) * (g_ / 8) + b_ / 8 : b_; ll = l; LAUNDER_S(ll); } while (0)
__global__ void __launch_bounds__(NWAVES * 64, 2) fwd_kernel(Params P) {
    extern __shared__ __attribute__((aligned(16))) unsigned char lds_raw[];
    Frame F;
    F.lds = (LAS unsigned char*)lds_raw;
    F.tid = threadIdx.x; F.lane = F.tid & 63; F.wave = __builtin_amdgcn_readfirstlane(F.tid >> 6);
    F.G = gridDim.x; { const int bx = blockIdx.x; F.vcu = (F.G % 8 == 0) ? (bx % 8) * (F.G / 8) + bx / 8 : bx; }
    if (F.tid == 0) { LAS unsigned long long* pt = (LAS unsigned long long*)(F.lds + LC_PTAB);
#pragma unroll
        for (int i = 0; i < 25; ++i) pt[i] = (unsigned long long)P.in[i];
        pt[25] = (unsigned long long)P.ws; pt[26] = (unsigned long long)P.out; }
    for (int u = F.tid; u < 256; u += NWAVES * 64) ((LAS unsigned*)(F.lds + RING_BYTES))[u] = 0u;
    __syncthreads();
    const int lo = P.ph_lo, hi = P.ph_hi;
    const bool use_bar = (hi - lo) > 1;
    unsigned* barw = (unsigned*)(P.ws + WS_CTL) + CW_BAR;
    XcdBarrier bar; bar.bar = barw; bar.x = 0; bar.st = (volatile LAS unsigned*)(F.lds + LC_BAR);
    if (use_bar) bar = xcd_barrier_post(barw, (volatile LAS unsigned*)(F.lds + LC_BAR));
#ifndef PHASE_MASK
#define PHASE_MASK 0xfff
#endif
#define EN(j) (((PHASE_MASK) >> (j)) & 1)
#ifndef DUP_MASK
#define DUP_MASK 0
#endif
#define NREP(j) ((((DUP_MASK) >> (j)) & 1) ? 2 : 1)
#define IN(k) (lo <= (k) && (k) < hi)
#define SEAM(k) do { if (IN(k) && IN((k) + 1)) xcd_barrier(bar); } while (0)

    int l = 0, ll = 0; const int wv0 = __builtin_amdgcn_readfirstlane((int)threadIdx.x >> 6);
    if (EN(0) && IN(0)) { RELANE(); convert_weights(F, 0); RELANE(); init_rows(F); }
    SEAM(0);
    for (l = 0; l < DEPTH; ++l) {
        const int pb = 1 + 11 * l;
        for (int rep = 0; rep < NREP(1); ++rep)
        if (EN(1) && IN(pb + 0)) {
            RELANE();
            unsigned char* wsl = WSP(); unsigned char* dol = DOP();
            pg8::Gemm g{(const bf16*)(wsl + WS_HB), 1024, 1024, 1 << 20};
            pg8::StaticOrder S; S.init(TX, N1, F.G, F.bx, (const bf16*)(wsl + WS_W1T), 1024);
            Epi1 E{(const float*)(wsl + WS_RSTD1), (bf16*)(wsl + WS_A), (bf16*)(wsl + WS_GLU), (bf16*)(dol + DO_Q), (bf16*)(wsl + WS_G)};
            pg8::gemm_phase<Epi1, pg8::StaticOrder>(F.lds, g, S, E, F.wave);
            if (F.bx >= 128 && F.bx < 128 + 21 && F.wave < 4) {
                const int pn = F.bx - 128, l2 = lane_id_opaque(); AccT acc; skinny_zero(acc);
                skinny_k<true>(acc, (const bf16*)(wsl + WS_HB) + (size_t)TX * 1024, 1024, (const bf16*)(wsl + WS_W1T) + (size_t)pn * 256 * 1024, 1024, 1024, F.wave, l2 & 15, l2 >> 4);
                E.run<true>(acc, pg8::Unit{128, pn, 0}, 0, F.wave, l2 & 15, l2 >> 4);
            }
        }
        SEAM(pb + 0);
        for (int rep = 0; rep < NREP(2); ++rep)
        if (EN(2) && IN(pb + 1)) { RELANE(); phase_S(F, ll); }
        SEAM(pb + 1);
        if (EN(3) && IN(pb + 2)) { RELANE(); phase_scan(F); }
        SEAM(pb + 2);
        for (int rep = 0; rep < NREP(3); ++rep)
        if (EN(4) && IN(pb + 3)) { RELANE(); phase_B(F, ll); }
        SEAM(pb + 3);
        for (int rep = 0; rep < NREP(4); ++rep)
        if (EN(5) && IN(pb + 4)) {
            RELANE(); unsigned char* wsl = WSP(); unsigned char* dol = DOP();
            pg8::Gemm g{(const bf16*)(wsl + WS_X3), 1024, 1024, 1 << 20}; pg8::SegOrder S; S.init(TX, 1024, F.G, F.bx, (const bf16*)(wsl + WS_W3CT), 1024);
            EpiCS E{(const bf16*)(wsl + WS_G), (bf16*)(dol + DO_MERGED), (const float*)(wsl + WS_BIASA)}; pg8::gemm_phase<EpiCS, pg8::SegOrder>(F.lds, g, S, E, F.wave);
            if (F.bx >= 16 && F.bx < 20 && F.wave < 4) {
                const int pn = F.bx - 16, l2 = lane_id_opaque(); AccT acc; skinny_zero(acc);
#pragma unroll 1
                for (int seg = 0; seg < 3; ++seg) { const size_t ko = seg == 0 ? 0 : (seg == 1 ? 256 : 512);
                    skinny_k<true>(acc, (const bf16*)(wsl + WS_X3) + (size_t)TX * 1024 + ko, 1024, (const bf16*)(wsl + WS_W3CT) + (size_t)pn * 256 * 1024 + ko, 1024, seg == 2 ? 512 : 256, F.wave, l2 & 15, l2 >> 4);
                    E.run<true>(acc, pg8::Unit{128, pn, seg}, 0, F.wave, l2 & 15, l2 >> 4); }
            }
        }
        SEAM(pb + 4);
        if (EN(6) && IN(pb + 5)) {
            RELANE();
            unsigned char* wsl = WSP(); unsigned char* dol = DOP();
            pg8::Gemm g{(const bf16*)(dol + DO_MERGED), 1024, 1024, 1 << 20}; pg8::StaticOrder S; S.init(TX, 1024, F.G, F.bx, (const bf16*)(wsl + WS_WOT), 1024);
            EpiB2 E{(bf16*)(wsl + WS_X3)}; pg8::gemm_phase<EpiB2, pg8::StaticOrder>(F.lds, g, S, E, F.wave);
            if (F.bx >= 16 && F.bx < 20 && F.wave < 4) {
                const int pn = F.bx - 16, l2 = lane_id_opaque(); AccT acc; skinny_zero(acc);
                skinny_k<true>(acc, (const bf16*)(dol + DO_MERGED) + (size_t)TX * 1024, 1024, (const bf16*)(wsl + WS_WOT) + (size_t)pn * 256 * 1024, 1024, 1024, F.wave, l2 & 15, l2 >> 4);
                E.run<true>(acc, pg8::Unit{128, pn, 0}, 0, F.wave, l2 & 15, l2 >> 4);
            }
        }
        SEAM(pb + 5);
        if (EN(7) && IN(pb + 6)) { RELANE(); phase_E1(F, ll); }
        SEAM(pb + 6);
        for (int rep = 0; rep < NREP(7); ++rep)
        if (EN(8) && IN(pb + 7)) { RELANE(); phase_E1b(F, ll); }
        SEAM(pb + 7);
        for (int rep = 0; rep < NREP(8); ++rep)
        if (EN(9) && IN(pb + 8)) {
            RELANE(); class_tables(F, ll);
            unsigned char* wsl = WSP();
            const int NP = __builtin_amdgcn_readfirstlane(*(const LAS int*)(F.lds + LC_NP));
            pg8::Gemm g{(const bf16*)(wsl + WS_XS), 1024, 1024, 1 << 20};
            MoeOrder S{NP, F.G, F.vcu, 0, (const LAS int*)(F.lds + LC_PCLS), (const bf16*)(DOP() + DO_W13T)};
            EpiA2 E{(const float*)(wsl + WS_PW), (bf16*)(wsl + WS_HH)}; pg8::gemm_phase<EpiA2, MoeOrder>(F.lds, g, S, E, F.wave);
        }
        SEAM(pb + 8);
        for (int rep = 0; rep < NREP(9); ++rep)
        if (EN(10) && IN(pb + 9)) {
            RELANE(); class_tables(F, ll);
            unsigned char* wsl = WSP();
            const int NP = __builtin_amdgcn_readfirstlane(*(const LAS int*)(F.lds + LC_NP));
            pg8::Gemm g{(const bf16*)(wsl + WS_HH), 512, 256, 4};
            MoeOrder S{NP, F.G, F.vcu, 1, (const LAS int*)(F.lds + LC_PCLS), (const bf16*)(DOP() + DO_W2T)};
            EpiB2 E{(bf16*)(wsl + WS_Y)}; pg8::gemm_phase<EpiB2, MoeOrder>(F.lds, g, S, E, F.wave);
        }
        SEAM(pb + 9);
        if (EN(11) && IN(pb + 10)) { RELANE(); phase_E4(F, ll); if (l + 1 < DEPTH) { RELANE(); convert_weights(F, ll + 1); } }
        SEAM(pb + 10);
    }
#undef IN
#undef SEAM
}

constexpr int N_PHASES = 1 + 11 * DEPTH;

extern "C" void kernel_launch(void* const* d_in, const int* in_sizes, int n_in, void* d_out, int out_size, void* d_ws, size_t ws_size, hipStream_t stream) {
    static int grid = 0;
    if (grid == 0) {
        if (n_in != 25 || out_size != TX * D || ws_size < WS_END) { fprintf(stderr, "kernel_launch: unexpected shapes: n_in %d out %d ws %zu (need %zu)\n", n_in, out_size, ws_size, (size_t)WS_END); grid = -1; return; }
        int dev = 0, cus = 0, per_cu = 0;
        if (hipGetDevice(&dev) != hipSuccess || hipDeviceGetAttribute(&cus, hipDeviceAttributeMultiprocessorCount, dev) != hipSuccess) { grid = -1; return; }
        if (hipFuncSetAttribute((const void*)fwd_kernel, hipFuncAttributeMaxDynamicSharedMemorySize, LDS_BYTES) != hipSuccess) { fprintf(stderr, "kernel_launch: hipFuncSetAttribute failed\n"); grid = -1; return; }
        if (hipOccupancyMaxActiveBlocksPerMultiprocessor(&per_cu, (const void*)fwd_kernel, NWAVES * 64, LDS_BYTES) != hipSuccess || per_cu < 1) fprintf(stderr, "kernel_launch: occupancy query reports %d\n", per_cu);
        (void)hipGetLastError();
        grid = cus;
    }
    if (grid < 0) return;
    (void)hipMemsetAsync((char*)d_ws + WS_CTL, 0, CTL_BYTES, stream);
    Params p{};
    for (int i = 0; i < 25; ++i) p.in[i] = (const float*)d_in[i];
    p.out = (float*)d_out; p.ws = (unsigned char*)d_ws;
#if N_LAUNCH_MODE == 1
    p.ph_lo = 0; p.ph_hi = N_PHASES;
    hipLaunchKernelGGL(fwd_kernel, dim3(grid), dim3(NWAVES * 64), LDS_BYTES, stream, p);
#else
    for (int ph = 0; ph < N_PHASES; ++ph) { p.ph_lo = ph; p.ph_hi = ph + 1; hipLaunchKernelGGL(fwd_kernel, dim3(grid), dim3(NWAVES * 64), LDS_BYTES, stream, p); }
#endif
}
```

```cpp
#include <hip/hip_runtime.h>
#include <cstdio>
#include <cstdint>

#ifndef N_LAUNCH_MODE
#define N_LAUNCH_MODE 1
#endif

#define GAS __attribute__((address_space(1)))
#define LAS __attribute__((address_space(3)))
typedef unsigned short bf16;
typedef float f32x4 __attribute__((ext_vector_type(4)));
typedef float f32x2 __attribute__((ext_vector_type(2)));
typedef unsigned u32x4 __attribute__((ext_vector_type(4)));
typedef unsigned u32x2 __attribute__((ext_vector_type(2)));
typedef short bf16x8 __attribute__((ext_vector_type(8)));
typedef __bf16 bf16x2v __attribute__((ext_vector_type(2)));

constexpr int D = 1024, NB = 4, SEQ = 8192, NMETA = 16, DEPTH = 2;
constexpr int TX = NB * SEQ;
constexpr int TM = TX + 64;
constexpr int TR = TX + NMETA;
constexpr int NIN = 5384, N1 = 5376;
constexpr int NHEAD = 8;
constexpr int NCLS = 24;
constexpr int NPOSMAX = TX + 256 + NCLS * 256;
constexpr float EPS = 1e-6f;
constexpr float LOG2E = 1.4426950408889634f;
constexpr float C2 = 0.125f * LOG2E;
constexpr int NWAVES = 8;

constexpr size_t U = (size_t)TM * 1024 * 2;
constexpr size_t WS_CTL = 0, CTL_BYTES = 1u << 20;
constexpr size_t WS_H = CTL_BYTES;
constexpr size_t WS_HB = WS_H + 2 * U;
constexpr size_t WS_G = WS_HB + U;
constexpr size_t WS_XS = WS_G;
constexpr size_t WS_Y = WS_XS + (size_t)NPOSMAX * 2048;
constexpr size_t WS_HH = WS_Y + (size_t)NPOSMAX * 2048;
static_assert(WS_HH + (size_t)NPOSMAX * 1024 <= WS_G + (size_t)3 * 129 * 4 * 65536 * 2, "MoE overlay fits the gates region");
constexpr size_t GT_TILE = 65536;
constexpr size_t WS_A = WS_G + (size_t)3 * 129 * 4 * GT_TILE * 2;
constexpr size_t WS_GLU = WS_A + U / 4;
constexpr size_t WS_X3 = WS_GLU + U / 4;
constexpr size_t WS_W1T = WS_X3 + U;
constexpr size_t WS_W3CT = WS_W1T + (size_t)N1 * 1024 * 2;
constexpr size_t WS_WOT = WS_W3CT + 1024 * 1024 * 2;
constexpr size_t WS_WFG = WS_WOT + 1024 * 1024 * 2;
constexpr size_t WS_RG = WS_WFG + 8 * 1024 * 4;
constexpr size_t WS_BIASA = WS_RG + 20 * 1024 * 4;
constexpr size_t WS_RSTD1 = WS_BIASA + 4096;
constexpr size_t WS_ROUTE = WS_RSTD1 + (size_t)TM * 4;
constexpr size_t WS_PW = WS_ROUTE + (size_t)TM * 32;
constexpr size_t WS_LFT = WS_PW + (size_t)NPOSMAX * 16;
constexpr size_t WS_LFTM = WS_LFT + (size_t)32 * 8192 * 4;
constexpr size_t WS_TOK = WS_LFTM + 8 * 256 * 4;
constexpr size_t WS_FL = WS_TOK + (size_t)NPOSMAX * 4;
constexpr int FLN = 64 + SEQ;
constexpr size_t WS_END = WS_FL + (size_t)32 * FLN * 4;
static_assert(WS_END <= (size_t)512 * 1024 * 1024, "d_ws map fits 512 MiB");
constexpr size_t DO_Q = 0, DO_K = U / 2, DO_V = U, DO_MERGED = U / 2;
constexpr size_t DO_W13T = 3 * U / 2;
constexpr size_t DO_W2T = DO_W13T + (size_t)16 * 512 * 1024 * 2;
static_assert(DO_W2T + (size_t)16 * 1024 * 256 * 2 <= (size_t)TX * 1024 * 4, "d_out scratch");
constexpr int CW_BAR = 4096, CW_GCNT = 16384, CW_NRM = 20480  , CW_AQ = 24576  ;

constexpr int RPITCH = 1032;
constexpr int RING_BYTES = 131072;
constexpr int LC_BAR = RING_BYTES, LC_CNT = RING_BYTES + 64, LC_BASE = RING_BYTES + 192, LC_PCLS = RING_BYTES + 320, LC_NP = RING_BYTES + 960;
constexpr int LC_QS = RING_BYTES + 976;
constexpr int LC_TOK = RING_BYTES + 2048;
constexpr int LC_NMX = RING_BYTES + 1280;
constexpr int LC_PTAB = RING_BYTES + 1024;
constexpr int LDS_BYTES = RING_BYTES + 1024 + 7168;

#define LDS_WAIT() asm volatile("s_waitcnt lgkmcnt(0)" ::: "memory")
#define VM_WAIT() asm volatile("s_waitcnt vmcnt(0)" ::: "memory")
#define LAUNDER_S(p) asm volatile("" : "+s"(p))
#define LAUNDER_V(x) asm volatile("" : "+v"(x))
__device__ __forceinline__ int lane_id_opaque() { int x; asm volatile("v_mbcnt_lo_u32_b32 %0, -1, 0\n\tv_mbcnt_hi_u32_b32 %0, -1, %0" : "=v"(x)); return x; }

__device__ __forceinline__ unsigned f2bf(float f) { unsigned u = __builtin_bit_cast(unsigned, f); return (u + 0x7fffu + ((u >> 16) & 1u)) >> 16; }
__device__ __forceinline__ unsigned pk2(float lo, float hi) { f32x2 v = {lo, hi}; bf16x2v b = __builtin_convertvector(v, bf16x2v); return __builtin_bit_cast(unsigned, b); }
__device__ __forceinline__ float bflo(unsigned w) { return __builtin_bit_cast(float, w << 16); }
__device__ __forceinline__ float bfhi(unsigned w) { return __builtin_bit_cast(float, w & 0xffff0000u); }
template <int O> __device__ __forceinline__ float lane_xor(float v) {
    if constexpr (O < 32) return __int_as_float(__builtin_amdgcn_ds_swizzle(__float_as_int(v), (O << 10) | 0x1f));
    else { auto rr = __builtin_amdgcn_permlane32_swap(__float_as_uint(v), __float_as_uint(v), false, false); return __uint_as_float(rr[0]) + __uint_as_float(rr[1]) - v; }
}
__device__ __forceinline__ float wave_sum(float v) {
    v += lane_xor<1>(v); v += lane_xor<2>(v); v += lane_xor<4>(v); v += lane_xor<8>(v); v += lane_xor<16>(v);
    auto rr = __builtin_amdgcn_permlane32_swap(__float_as_uint(v), __float_as_uint(v), false, false);
    return __uint_as_float(rr[0]) + __uint_as_float(rr[1]);
}
__device__ __forceinline__ float sigmoidf_(float x) { return __builtin_amdgcn_rcpf(1.0f + __builtin_amdgcn_exp2f(-LOG2E * x)); }
__device__ __forceinline__ float dot2bf(unsigned a, unsigned b, float acc) { return __builtin_amdgcn_fdot2_f32_bf16(__builtin_bit_cast(bf16x2v, a), __builtin_bit_cast(bf16x2v, b), acc, false); }

namespace pg8 {
constexpr int BM = 256, BK = 64, HALF = 128, HTB = HALF * BK * 2, STAGE_BYTES = 8 * HTB, NXCD = 8, WGM = 8;
__host__ __device__ __forceinline__ int lds_byte(int r, int c) { const int st = (r >> 4) * 2 + (c >> 5), rr = r & 15, cc = c & 31, ob = rr * 64 + cc * 2; return st * 1024 + (ob ^ (((ob >> 9) & 1) << 5)); }
__host__ __device__ __forceinline__ void stage_rc(int b, int& R, int& C) { const int st = b / 1024, sb = b % 1024, swz = sb ^ (((sb >> 9) & 1) << 5); R = (st >> 1) * 16 + swz / 64; C = (st & 1) * 32 + (swz % 64) / 2; }
__host__ __device__ __forceinline__ int perm32(int rho) { const int n = rho >> 4, i = rho & 15; return 8 * (i >> 2) + 4 * n + (i & 3); }

struct Unit { int pm, pn, seg; };
struct Gemm { const bf16* A; int K; int ldb; int ksplit; };

struct StaticOrder {
    static constexpr bool GATHER = false; const LAS int* tokl = nullptr;
    int nM, nN, nwg, G, c; const bf16* Bt; size_t btile;
    __device__ void init(int M, int N, int G_, int c_, const bf16* Bt_, int ldb) { nM = M / BM; nN = N / BM; nwg = nM * nN; G = G_; c = c_; Bt = Bt_; btile = (size_t)BM * ldb * 2; }
    __device__ bool next(int i, Unit& u) const {
        const long L = (long)i * G + c; if (L >= nwg) return false;
        int wgid = (int)L; { const int q = nwg / NXCD, r = nwg % NXCD, xcd = wgid % NXCD, off = wgid / NXCD; wgid = (xcd < r ? xcd * (q + 1) : r * (q + 1) + (xcd - r) * q) + off; }
        const int nig = WGM * nN, gid = wgid / nig, fm = gid * WGM, gsz = (nM - fm) < WGM ? (nM - fm) : WGM;
        u.pm = fm + ((wgid % nig) % gsz); u.pn = (wgid % nig) / gsz; u.seg = 0; return true;
    }
    __device__ __forceinline__ const char* bptr(const Unit& u, int) const { return (const char*)Bt + (size_t)u.pn * btile; }
    __device__ __forceinline__ int nt(const Unit&, int ntd) const { return ntd; }
    __device__ __forceinline__ size_t aoff(const Unit&) const { return 0; }
};
struct SegOrder : StaticOrder {
    __device__ bool next(int i, Unit& u) const { const int q = i / 3; if (!StaticOrder::next(q, u)) return false; u.seg = i - 3 * q; return true; }
    __device__ __forceinline__ size_t koff(const Unit& u) const { return u.seg == 0 ? 0 : (u.seg == 1 ? 512 : 1024); }
    __device__ __forceinline__ const char* bptr(const Unit& u, int) const { return (const char*)Bt + (size_t)u.pn * btile + koff(u); }
    __device__ __forceinline__ int nt(const Unit& u, int) const { return u.seg == 2 ? 8 : 4; }
    __device__ __forceinline__ size_t aoff(const Unit& u) const { return koff(u); }
};

template <class Epi, class Sched, bool ALIGN_EPI = true, bool SP2 = true>
__device__ __forceinline__ void gemm_phase(LAS unsigned char* lds, const Gemm g, const Sched& S, const Epi& E, const int wave_id) {
    const int tid = wave_id * 64 + lane_id_opaque();
    const int wid = __builtin_amdgcn_readfirstlane(tid >> 6), lane = tid & 63, wr = wid >> 2, wc = wid & 3, fr = lane & 15, fq = lane >> 4;
    const int K = g.K, nt = K / BK, ldb = g.ldb, ks = g.ksplit;
    unsigned voffA[2], voffB[2];
#pragma unroll
    for (int i = 0; i < 2; ++i) { int R, C; stage_rc(tid * 16 + i * 8192, R, C); const int Rb = Epi::PERM ? ((R & ~31) + perm32(R & 31)) : R;
        voffA[i] = (unsigned)(R * K + C) * 2u; voffB[i] = (unsigned)(Rb * ldb + C) * 2u; }
    constexpr bool GATHER = Sched::GATHER;
    unsigned vC0[2], vC1[2];
    const size_t kstep = (size_t)(BK * 2);
    const size_t hstep = (size_t)HALF * K * 2;
    const size_t hstepB = (size_t)HALF * ldb * 2;
    const size_t tstep = 2 * hstep;
#define PG8_GOFF(ui_) do { _Pragma("unroll") for (int _i = 0; _i < 2; ++_i) { const int R_ = (int)(voffA[_i] >> 11); const unsigned C_ = voffA[_i] & 2047u; \
        vC0[_i] = (unsigned)S.tokl[(ui_) * 256 + R_] * 2048u + C_; vC1[_i] = (unsigned)S.tokl[(ui_) * 256 + 128 + R_] * 2048u + C_; } } while (0)
    const unsigned ldsw = (unsigned)wid * 1024u;
    const int aoff = lds_byte(wr * 64 + fr, fq * 8), boff = lds_byte(wc * 32 + fr, fq * 8);
#define PG8_SA(b, h) (((b) * 2 + (h)) * HTB)
#define PG8_SB(b, h) ((4 + (b) * 2 + (h)) * HTB)
#define PG8_STAGE(bufoff, gbase, voff) do { _Pragma("unroll") for (int _i = 0; _i < 2; ++_i) \
        __builtin_amdgcn_global_load_lds((const unsigned*)((const char*)(gbase) + (voff)[_i]), (LAS unsigned*)(lds + (bufoff) + ldsw + _i * 8192), 16, 0, 0); } while (0)
#define PG8_LDA(dst, b, h) do { _Pragma("unroll") for (int m = 0; m < 4; ++m) _Pragma("unroll") for (int k = 0; k < 2; ++k) dst[m][k] = *(const LAS bf16x8*)(lds + PG8_SA(b, h) + aoff + m * 2048 + k * 1024); } while (0)
#define PG8_LDB(dst, b, h) do { _Pragma("unroll") for (int n = 0; n < 2; ++n) _Pragma("unroll") for (int k = 0; k < 2; ++k) dst[n][k] = *(const LAS bf16x8*)(lds + PG8_SB(b, h) + boff + n * 2048 + k * 1024); } while (0)
#define PG8_MMA(ai, bj, At, Bt) do { __builtin_amdgcn_s_setprio(1); _Pragma("unroll") for (int m = 0; m < 4; ++m) _Pragma("unroll") for (int n = 0; n < 2; ++n) _Pragma("unroll") for (int k = 0; k < 2; ++k) \
        acc[ai][bj][m][n] = __builtin_amdgcn_mfma_f32_16x16x32_bf16(Bt[n][k], At[m][k], acc[ai][bj][m][n], 0, 0, 0); __builtin_amdgcn_s_setprio(0); } while (0)
#define PG8_WAIT_V(n) asm volatile("s_waitcnt vmcnt(" #n ")" ::: "memory")
#define PG8_WAIT_L(n) asm volatile("s_waitcnt lgkmcnt(" #n ")" ::: "memory")
#define PG8_BAR __builtin_amdgcn_s_barrier()
#define PG8_SCHED __builtin_amdgcn_sched_barrier(0)
    Unit cur, nxt; int ui = 0;
    if (!S.next(0, cur)) return;
    if constexpr (GATHER) { PG8_GOFF(0); } else { vC0[0] = voffA[0]; vC0[1] = voffA[1]; vC1[0] = voffA[0] + (unsigned)hstep; vC1[1] = voffA[1] + (unsigned)hstep; }
    f32x4 acc[2][2][4][2];
    { float z_ = 0.f; LAUNDER_V(z_);
#pragma unroll
    for (int a = 0; a < 2; ++a)
#pragma unroll
        for (int b = 0; b < 2; ++b)
#pragma unroll
            for (int m = 0; m < 4; ++m)
#pragma unroll
                for (int n = 0; n < 2; ++n) acc[a][b][m][n] = (f32x4){z_, z_, z_, z_}; }
    bf16x8 At[4][2], B0[2][2], B1[2][2];
    int ntc = S.nt(cur, nt);
    const char* cA = GATHER ? (const char*)g.A : (const char*)g.A + (size_t)cur.pm * tstep + S.aoff(cur); const char* cB = S.bptr(cur, 0); const char* cB1 = S.bptr(cur, 1) - (size_t)ks * kstep;
    if constexpr (SP2) {
        PG8_STAGE(PG8_SB(0, 0), cB, voffB); PG8_STAGE(PG8_SB(0, 1), cB + hstepB, voffB); PG8_STAGE(PG8_SA(0, 0), cA, vC0); PG8_STAGE(PG8_SA(0, 1), cA, vC1);
        if (wr == 1) PG8_BAR;
        PG8_WAIT_V(2); PG8_BAR;
        PG8_STAGE(PG8_SB(1, 0), cB + kstep, voffB); PG8_STAGE(PG8_SA(1, 0), cA + kstep, vC0); PG8_STAGE(PG8_SB(1, 1), cB + hstepB + kstep, voffB);
        PG8_WAIT_V(6); PG8_BAR;
    } else {
        PG8_STAGE(PG8_SB(0, 0), cB, voffB); PG8_STAGE(PG8_SA(0, 0), cA, vC0); PG8_STAGE(PG8_SB(0, 1), cB + hstepB, voffB); PG8_STAGE(PG8_SA(0, 1), cA, vC1);
        if (wr == 1) PG8_BAR;
        PG8_WAIT_V(4); PG8_BAR;
        PG8_STAGE(PG8_SB(1, 0), cB + kstep, voffB); PG8_STAGE(PG8_SA(1, 0), cA + kstep, vC0); PG8_STAGE(PG8_SB(1, 1), cB + hstepB + kstep, voffB);
        PG8_WAIT_V(6); PG8_BAR;
    }
    for (;;) {
        const bool has_next = S.next(ui + 1, nxt);
        const char* nA = GATHER ? (const char*)g.A : (has_next ? (const char*)g.A + (size_t)nxt.pm * tstep + S.aoff(nxt) : cA); const char* nB = has_next ? S.bptr(nxt, 0) : cB;
        const char* nB1 = has_next ? S.bptr(nxt, 1) - (size_t)ks * kstep : cB1;
#pragma unroll 1
        for (int t = 0; t < ntc; t += 2) {
            const bool last = (t == ntc - 2);
            const char* a1 = cA + (size_t)(t + 1) * kstep;
            const char* bside = (t + 2 < ks) ? cB : cB1;
            const char* a2 = last ? nA : cA + (size_t)(t + 2) * kstep; const char* b2 = last ? nB : bside + (size_t)(t + 2) * kstep;
            const char* a3 = a2 + kstep; const char* b3 = b2 + kstep;
            unsigned x0[2] = {vC0[0], vC0[1]}, x1[2] = {vC1[0], vC1[1]};
            if constexpr (GATHER) { if (last && has_next) { _Pragma("unroll") for (int _i = 0; _i < 2; ++_i) { const int R_ = (int)(voffA[_i] >> 11); const unsigned C_ = voffA[_i] & 2047u;
                x0[_i] = (unsigned)S.tokl[(ui + 1) * 256 + R_] * 2048u + C_; x1[_i] = (unsigned)S.tokl[(ui + 1) * 256 + 128 + R_] * 2048u + C_; } } }
            if constexpr (SP2) {
            PG8_LDB(B0, 0, 0); PG8_LDB(B1, 0, 1); PG8_SCHED; PG8_LDA(At, 0, 0); PG8_STAGE(PG8_SA(1, 1), a1, vC1);
            PG8_WAIT_V(8); PG8_WAIT_L(0); PG8_BAR; PG8_MMA(0, 0, At, B0); PG8_MMA(0, 1, At, B1); PG8_BAR; PG8_SCHED;
            PG8_LDA(At, 0, 1); PG8_STAGE(PG8_SB(0, 0), b2, voffB); PG8_STAGE(PG8_SB(0, 1), b2 + hstepB, voffB); PG8_STAGE(PG8_SA(0, 0), a2, x0);
            PG8_WAIT_V(8); PG8_WAIT_L(0); PG8_BAR; PG8_MMA(1, 0, At, B0); PG8_MMA(1, 1, At, B1); PG8_BAR; PG8_SCHED;
            PG8_LDB(B0, 1, 0); PG8_LDB(B1, 1, 1); PG8_SCHED; PG8_LDA(At, 1, 0); PG8_STAGE(PG8_SA(0, 1), a2, x1);
            PG8_WAIT_V(8); PG8_WAIT_L(0); PG8_BAR; PG8_MMA(0, 0, At, B0); PG8_MMA(0, 1, At, B1); PG8_BAR; PG8_SCHED;
            PG8_LDA(At, 1, 1); PG8_STAGE(PG8_SB(1, 0), b3, voffB); PG8_STAGE(PG8_SB(1, 1), b3 + hstepB, voffB); PG8_STAGE(PG8_SA(1, 0), a3, x0);
            PG8_WAIT_V(8); PG8_WAIT_L(0); PG8_BAR; PG8_MMA(1, 0, At, B0); PG8_MMA(1, 1, At, B1); PG8_BAR; PG8_SCHED;
            } else {
            PG8_LDB(B0, 0, 0); PG8_SCHED; PG8_LDA(At, 0, 0); PG8_STAGE(PG8_SA(1, 1), a1, vC1);
            PG8_WAIT_L(8); PG8_BAR; PG8_WAIT_L(0); PG8_MMA(0, 0, At, B0); PG8_BAR; PG8_SCHED;
            PG8_LDB(B1, 0, 1); PG8_STAGE(PG8_SB(0, 0), b2, voffB);
            PG8_BAR; PG8_WAIT_L(0); PG8_MMA(0, 1, At, B1); PG8_BAR;
            PG8_LDA(At, 0, 1); PG8_STAGE(PG8_SA(0, 0), a2, x0);
            PG8_BAR; PG8_WAIT_L(0); PG8_MMA(1, 0, At, B0); PG8_BAR; PG8_SCHED;
            PG8_STAGE(PG8_SB(0, 1), b2 + hstepB, voffB);
            PG8_WAIT_V(6); PG8_BAR; PG8_MMA(1, 1, At, B1); PG8_BAR;
            PG8_LDB(B0, 1, 0); PG8_SCHED; PG8_LDA(At, 1, 0); PG8_STAGE(PG8_SA(0, 1), a2, x1);
            PG8_WAIT_L(8); PG8_BAR; PG8_WAIT_L(0); PG8_MMA(0, 0, At, B0); PG8_BAR; PG8_SCHED;
            PG8_LDB(B1, 1, 1); PG8_STAGE(PG8_SB(1, 0), b3, voffB);
            PG8_BAR; PG8_WAIT_L(0); PG8_MMA(0, 1, At, B1); PG8_BAR;
            PG8_LDA(At, 1, 1); PG8_STAGE(PG8_SA(1, 0), a3, x0);
            PG8_BAR; PG8_WAIT_L(0); PG8_MMA(1, 0, At, B0); PG8_BAR; PG8_SCHED;
            PG8_STAGE(PG8_SB(1, 1), b3 + hstepB, voffB);
            PG8_WAIT_V(6); PG8_BAR; PG8_MMA(1, 1, At, B1); PG8_BAR;
            }
        }
        if constexpr (ALIGN_EPI) { if (wr == 0) PG8_BAR; }
        { const int l2 = lane_id_opaque(); E(acc, cur, wr, wc, l2 & 15, l2 >> 4); }
        if (!has_next) break;
        if (!E.keep(cur)) { float z_ = 0.f; LAUNDER_V(z_);
#pragma unroll
        for (int a = 0; a < 2; ++a)
#pragma unroll
            for (int b = 0; b < 2; ++b)
#pragma unroll
                for (int m = 0; m < 4; ++m)
#pragma unroll
                    for (int n = 0; n < 2; ++n) acc[a][b][m][n] = (f32x4){z_, z_, z_, z_}; }
        cur = nxt; cA = nA; cB = nB; cB1 = nB1; ++ui; ntc = S.nt(cur, nt);
        if constexpr (GATHER) { PG8_GOFF(ui); }
        if constexpr (ALIGN_EPI) { if (wr == 1) PG8_BAR; }
    }
    PG8_WAIT_V(0);
    if constexpr (!ALIGN_EPI) { if (wr == 0) PG8_BAR; }
    PG8_BAR;
#undef PG8_GOFF
#undef PG8_SA
#undef PG8_SB
#undef PG8_STAGE
#undef PG8_LDA
#undef PG8_LDB
#undef PG8_MMA
#undef PG8_WAIT_V
#undef PG8_WAIT_L
#undef PG8_BAR
#undef PG8_SCHED
}
}

typedef f32x4 AccT[2][2][4][2];
__device__ __forceinline__ u32x4 pack8(const f32x4 a, const f32x4 b) { u32x4 w; w.x = pk2(a[0], a[1]); w.y = pk2(a[2], a[3]); w.z = pk2(b[0], b[1]); w.w = pk2(b[2], b[3]); return w; }

struct Epi1 {
    static constexpr bool PERM = true;
    __device__ __forceinline__ bool keep(const pg8::Unit&) const { return false; }
    const float* rstd; bf16* A; bf16* GLU; bf16* QKV; bf16* G;
    __device__ __forceinline__ void operator()(AccT& acc, const pg8::Unit& u, int wr, int wc, int fr, int fq) const { run<false>(acc, u, wr, wc, fr, fq); }
    template <bool SK> __device__ __forceinline__ void run(AccT& acc, const pg8::Unit& u, int wr, int wc, int fr, int fq) const {
        const int row0 = u.pm * 256 + wr * 64 + fr, lc0 = wc * 32 + 8 * fq, pn = u.pn;
#pragma unroll
        for (int ai = 0; ai < (SK ? 1 : 2); ++ai)
#pragma unroll
            for (int m = 0; m < (SK ? 1 : 4); ++m) {
                const int row = row0 + ai * 128 + m * 16; const float rs = rstd[row];
                f32x4 v[2][2];
#pragma unroll
                for (int bj = 0; bj < 2; ++bj)
#pragma unroll
                    for (int n = 0; n < 2; ++n) v[bj][n] = acc[ai][bj][m][n] * rs;
                if (pn == 0) {
#pragma unroll
                    for (int bj = 0; bj < 2; ++bj) *(u32x4*)(A + (size_t)row * 256 + bj * 128 + lc0) = pack8(v[bj][0], v[bj][1]);
                } else if (pn <= 2) {
                    f32x4 o[2];
#pragma unroll
                    for (int n = 0; n < 2; ++n)
#pragma unroll
                        for (int j = 0; j < 4; ++j) o[n][j] = v[0][n][j] * sigmoidf_(v[1][n][j]);
                    *(u32x4*)(GLU + (size_t)row * 256 + (pn - 1) * 128 + lc0) = pack8(o[0], o[1]);
                } else if (pn <= 4) {
#pragma unroll
                    for (int bj = 0; bj < 2; ++bj) *(u32x4*)(QKV + (size_t)2 * (U / 4) + (size_t)row * 512 + (pn - 3) * 256 + bj * 128 + lc0) = pack8(v[bj][0], v[bj][1]);
                } else {
                    const int d = 64 * (pn - 5) + 16 * wc + 4 * fq; f32x4 r01, r12, g2;
#pragma unroll
                    for (int j = 0; j < 4; ++j) { const float a0 = 1.0f + fminf(__builtin_amdgcn_exp2f(-LOG2E * v[0][0][j]), 1e30f), a1 = 1.0f + fminf(__builtin_amdgcn_exp2f(-LOG2E * v[0][1][j]), 1e30f), a2 = 1.0f + fminf(__builtin_amdgcn_exp2f(-LOG2E * v[1][0][j]), 1e30f);
                        const float i0 = __builtin_amdgcn_rcpf(a0), i1 = __builtin_amdgcn_rcpf(a1), i2 = __builtin_amdgcn_rcpf(a2);
                        r01[j] = i0 * a1; r12[j] = i1 * a2; g2[j] = i2; }
                    bf16* gp = G + (size_t)row * 1024 + d; u32x2 w;
                    w.x = pk2(r01[0], r01[1]); w.y = pk2(r01[2], r01[3]); *(u32x2*)gp = w;
                    w.x = pk2(r12[0], r12[1]); w.y = pk2(r12[2], r12[3]); *(u32x2*)(gp + U / 2) = w;
                    w.x = pk2(g2[0], g2[1]); w.y = pk2(g2[2], g2[3]); *(u32x2*)(gp + U) = w;
                    const float sc = d < 512 ? C2 : 1.0f; const f32x4 sp = v[1][1] * sc;
                    w.x = pk2(sp[0], sp[1]); w.y = pk2(sp[2], sp[3]); *(u32x2*)(QKV + (size_t)(d < 512 ? 0 : 1) * (U / 4) + (size_t)row * 512 + (d & 511)) = w;
                }
            }
    }
};
struct EpiCS {
    static constexpr bool PERM = true;
    const bf16* G; bf16* Mg; const float* bias;
    __device__ __forceinline__ bool keep(const pg8::Unit& u) const { return u.seg != 2; }
    __device__ __forceinline__ void operator()(AccT& acc, const pg8::Unit& u, int wr, int wc, int fr, int fq) const { run<false>(acc, u, wr, wc, fr, fq); }
    template <bool SK> __device__ __forceinline__ void run(AccT& acc, const pg8::Unit& u, int wr, int wc, int fr, int fq) const {
        const int row0 = u.pm * 256 + wr * 64 + fr, col0 = u.pn * 256 + wc * 32 + 8 * fq;
        const bool lastseg = u.seg == 2; const float bsc = u.seg == 0 ? 1.f : 0.f; const bf16* Gs = G + (size_t)u.seg * (U / 2);
        f32x4 bv[2][2];
#pragma unroll
        for (int bj = 0; bj < 2; ++bj) { bv[bj][0] = *(const f32x4*)(bias + col0 + bj * 128) * bsc; bv[bj][1] = *(const f32x4*)(bias + col0 + bj * 128 + 4) * bsc; }
        u32x4 gr[2][4][2];
#pragma unroll
        for (int ai = 0; ai < (SK ? 1 : 2); ++ai)
#pragma unroll
            for (int m = 0; m < (SK ? 1 : 4); ++m)
#pragma unroll
                for (int bj = 0; bj < 2; ++bj) gr[ai][m][bj] = *(const u32x4*)(Gs + (size_t)(row0 + ai * 128 + m * 16) * 1024 + col0 + bj * 128);
#pragma unroll
        for (int ai = 0; ai < (SK ? 1 : 2); ++ai)
#pragma unroll
            for (int m = 0; m < (SK ? 1 : 4); ++m) { const int row = row0 + ai * 128 + m * 16;
#pragma unroll
                for (int bj = 0; bj < 2; ++bj) {
                    const u32x4 n4 = gr[ai][m][bj];
                    f32x4 a0 = acc[ai][bj][m][0] + bv[bj][0], a1 = acc[ai][bj][m][1] + bv[bj][1];
                    a0[0] *= bflo(n4.x); a0[1] *= bfhi(n4.x); a0[2] *= bflo(n4.y); a0[3] *= bfhi(n4.y); a1[0] *= bflo(n4.z); a1[1] *= bfhi(n4.z); a1[2] *= bflo(n4.w); a1[3] *= bfhi(n4.w);
                    acc[ai][bj][m][0] = a0; acc[ai][bj][m][1] = a1;
                    asm volatile("" : "+v"(acc[ai][bj][m][0]), "+v"(acc[ai][bj][m][1]));
                    if (lastseg) *(u32x4*)(Mg + (size_t)row * 1024 + col0 + bj * 128) = pack8(a0, a1);
                } }
    }
};
struct EpiD {
    static constexpr bool PERM = false;
    __device__ __forceinline__ bool keep(const pg8::Unit&) const { return false; }
    float* H; bf16* HB;
    __device__ __forceinline__ void operator()(AccT& acc, const pg8::Unit& u, int wr, int wc, int fr, int fq) const { run<false>(acc, u, wr, wc, fr, fq); }
    template <bool SK> __device__ __forceinline__ void run(AccT& acc, const pg8::Unit& u, int wr, int wc, int fr, int fq) const {
        const int row0 = u.pm * 256 + wr * 64 + fr, col0 = u.pn * 256 + wc * 32 + 4 * fq;
#pragma unroll
        for (int ai = 0; ai < (SK ? 1 : 2); ++ai)
#pragma unroll
            for (int m = 0; m < (SK ? 1 : 4); ++m) {
                const size_t off = (size_t)(row0 + ai * 128 + m * 16) * 1024 + col0;
#pragma unroll
                for (int bj = 0; bj < 2; ++bj)
#pragma unroll
                    for (int n = 0; n < 2; ++n) { const size_t o = off + bj * 128 + n * 16; const f32x4 hv = *(const f32x4*)(H + o) + acc[ai][bj][m][n];
                        *(f32x4*)(H + o) = hv; u32x2 w; w.x = pk2(hv[0], hv[1]); w.y = pk2(hv[2], hv[3]); *(u32x2*)(HB + o) = w; }
            }
    }
};
struct EpiA2 {
    static constexpr bool PERM = true;
    __device__ __forceinline__ bool keep(const pg8::Unit&) const { return false; }
    const float* PW; bf16* HH;
    __device__ __forceinline__ void operator()(AccT& acc, const pg8::Unit& u, int wr, int wc, int fr, int fq) const {
        const int row0 = u.pm * 256 + wr * 64 + fr, lc0 = wc * 32 + 8 * fq, side = u.pn >> 1;
#pragma unroll
        for (int ai = 0; ai < 2; ++ai)
#pragma unroll
            for (int m = 0; m < 4; ++m) {
                const int row = row0 + ai * 128 + m * 16; const f32x4 pw = *(const f32x4*)(PW + (size_t)row * 4);
                const float rs = pw[0], cw = side ? pw[2] : pw[1];
                f32x4 o[2];
#pragma unroll
                for (int n = 0; n < 2; ++n)
#pragma unroll
                    for (int j = 0; j < 4; ++j) { const float a1 = acc[ai][0][m][n][j] * rs, a3 = acc[ai][1][m][n][j] * rs; o[n][j] = cw * a1 * sigmoidf_(a1) * a3; }
                *(u32x4*)(HH + (size_t)row * 512 + side * 256 + (u.pn & 1) * 128 + lc0) = pack8(o[0], o[1]);
            }
    }
};
struct EpiB2 {
    static constexpr bool PERM = true;
    __device__ __forceinline__ bool keep(const pg8::Unit&) const { return false; }
    bf16* Y;
    __device__ __forceinline__ void operator()(AccT& acc, const pg8::Unit& u, int wr, int wc, int fr, int fq) const { run<false>(acc, u, wr, wc, fr, fq); }
    template <bool SK> __device__ __forceinline__ void run(AccT& acc, const pg8::Unit& u, int wr, int wc, int fr, int fq) const {
        const int row0 = u.pm * 256 + wr * 64 + fr, col0 = u.pn * 256 + wc * 32 + 8 * fq;
#pragma unroll
        for (int ai = 0; ai < (SK ? 1 : 2); ++ai)
#pragma unroll
            for (int m = 0; m < (SK ? 1 : 4); ++m) {
                bf16* rp = Y + (size_t)(row0 + ai * 128 + m * 16) * 1024 + col0;
#pragma unroll
                for (int bj = 0; bj < 2; ++bj) *(u32x4*)(rp + bj * 128) = pack8(acc[ai][bj][m][0], acc[ai][bj][m][1]);
            }
    }
};
template <bool GA> struct MoeOrderT {
    static constexpr bool GATHER = GA; const LAS int* tokl;
    int NP, G, c, mode; const LAS int* pcls; const bf16* W;
    __device__ bool next(int i, pg8::Unit& u) const { const long L = (long)i * G + c; if (L >= (long)NP * 4) return false; u.pm = (int)(L >> 2); u.pn = (int)(L & 3); u.seg = 0; return true; }
    __device__ __forceinline__ int nt(const pg8::Unit&, int ntd) const { return ntd; }
    __device__ __forceinline__ size_t aoff(const pg8::Unit&) const { return 0; }
    __device__ __forceinline__ const char* bptr(const pg8::Unit& u, int side) const {
        const int cls = __builtin_amdgcn_readfirstlane(pcls[u.pm]); const int grp = cls / 6, pr = cls % 6;
        const int ea = pr < 3 ? 0 : (pr < 5 ? 1 : 2), eb = pr < 3 ? pr + 1 : (pr < 5 ? pr - 1 : 3);
        if (mode == 0) { const int e = grp * 4 + (u.pn < 2 ? ea : eb); return (const char*)W + ((size_t)e * 512 + (size_t)(u.pn & 1) * 256) * 1024 * 2; }
        const int e = grp * 4 + (side ? eb : ea); return (const char*)W + ((size_t)e * 1024 + (size_t)u.pn * 256) * 256 * 2;
    }
};

template <bool PERM> __device__ __forceinline__ void skinny_k(AccT& acc, const bf16* A, int lda, const bf16* Bt, int ldb, int K, int wc, int fr, int fq) {
    const bf16* ap = A + (size_t)fr * lda + 8 * fq;
    const bf16* bp[2][2];
#pragma unroll
    for (int bj = 0; bj < 2; ++bj)
#pragma unroll
        for (int n = 0; n < 2; ++n) { const int col = 128 * bj + 32 * wc + (PERM ? 8 * (fr >> 2) + 4 * n + (fr & 3) : 16 * n + fr); bp[bj][n] = Bt + (size_t)col * ldb + 8 * fq; }
#pragma unroll 4
    for (int k0 = 0; k0 < K; k0 += 32) {
        const bf16x8 a = *(const bf16x8*)(ap + k0);
#pragma unroll
        for (int bj = 0; bj < 2; ++bj)
#pragma unroll
            for (int n = 0; n < 2; ++n) { const bf16x8 b = *(const bf16x8*)(bp[bj][n] + k0); acc[0][bj][0][n] = __builtin_amdgcn_mfma_f32_16x16x32_bf16(b, a, acc[0][bj][0][n], 0, 0, 0); }
    }
}
__device__ __forceinline__ void skinny_zero(AccT& acc) {
#pragma unroll
    for (int bj = 0; bj < 2; ++bj)
#pragma unroll
        for (int n = 0; n < 2; ++n) acc[0][bj][0][n] = (f32x4){0.f, 0.f, 0.f, 0.f};
}

#define XB_TMO      128
#define XB_XCNT(j)  (256  + 64 * (j))
#define XB_XSUB(j)  (1280 + 64 * (j))
#define XB_XGEN(j)  (2304 + 64 * (j))
#define XB_TOP      3328
#define XB_TOPGEN   3392
#define XCD_BAR_WORDS 3456
#define XB_SPIN_CAP (1u << 24)
__device__ __forceinline__ unsigned xb_ld(unsigned* p)              { return __hip_atomic_load(p, __ATOMIC_RELAXED, __HIP_MEMORY_SCOPE_AGENT); }
__device__ __forceinline__ unsigned xb_add(unsigned* p, unsigned v) { return __hip_atomic_fetch_add(p, v, __ATOMIC_RELAXED, __HIP_MEMORY_SCOPE_AGENT); }
__device__ __forceinline__ unsigned xb_xcc_id() { return (unsigned)__builtin_amdgcn_s_getreg((3 << 11) | 20) & 0xFu; }
#define XB_SPIN(cond, bar) do { unsigned _sp = 0; while (cond) { __builtin_amdgcn_s_sleep(1); \
    if ((++_sp & 255u) == 0u) { if (xb_ld(&(bar)[XB_TMO])) break; if (_sp > XB_SPIN_CAP) { atomicAdd(&(bar)[XB_TMO], 1u); break; } } } } while (0)
struct XcdBarrier { unsigned* bar; unsigned x; volatile LAS unsigned* st; };
__device__ __forceinline__ XcdBarrier xcd_barrier_post(unsigned* bar, volatile LAS unsigned* st) {
    XcdBarrier b; b.bar = bar; b.x = xb_xcc_id(); b.st = st;
    if (threadIdx.x == 0) (void)xb_add(&bar[XB_XCNT(b.x)], 1u);
    return b;
}
__device__ __forceinline__ void xcd_barrier_complete(unsigned* bar, unsigned x, unsigned& nloc, unsigned& nx) {
    const unsigned G = gridDim.x * gridDim.y * gridDim.z;
    unsigned sum, cnt, mine, sp = 0u;
    for (;;) {
        sum = 0u; cnt = 0u; mine = 0u;
#pragma unroll
        for (unsigned j = 0; j < 16; ++j) { const unsigned c = xb_ld(&bar[XB_XCNT(j)]); sum += c; cnt += (c > 0u) ? 1u : 0u; mine = (j == x) ? c : mine; }
        if (sum == G) break;
        __builtin_amdgcn_s_sleep(1);
        if ((++sp & 255u) == 0u) { if (xb_ld(&bar[XB_TMO])) break; if (sp > XB_SPIN_CAP) { atomicAdd(&bar[XB_TMO], 1u); break; } }
    }
    nloc = mine > 0u ? mine : 1u; nx = cnt > 0u ? cnt : 1u;
}
__device__ __forceinline__ void xcd_barrier(const XcdBarrier& b) {
    asm volatile("s_waitcnt vmcnt(0)" ::: "memory");
    __syncthreads();
    if (threadIdx.x == 0) {
        unsigned* bar = b.bar;
        __builtin_amdgcn_s_waitcnt(0);
        unsigned nloc = b.st[0], nx = b.st[1];
        if (nloc == 0u) { xcd_barrier_complete(bar, b.x, nloc, nx); b.st[0] = nloc; b.st[1] = nx; }
        const unsigned old = xb_add(&bar[XB_XSUB(b.x)], 1u);
        const unsigned gen = old / nloc;
        if (old + 1u == (gen + 1u) * nloc) {
            __builtin_amdgcn_fence(__ATOMIC_RELEASE, "agent");
            asm volatile("s_waitcnt vmcnt(0)" ::: "memory");
            const unsigned og = xb_add(&bar[XB_TOP], 1u);
            const unsigned tg = og / nx;
            if (og + 1u == (tg + 1u) * nx) xb_add(&bar[XB_TOPGEN], 1u);
            else XB_SPIN(xb_ld(&bar[XB_TOPGEN]) == tg, bar);
            __builtin_amdgcn_fence(__ATOMIC_ACQUIRE, "agent");
            xb_add(&bar[XB_XGEN(b.x)], 1u);
            asm volatile("s_waitcnt vmcnt(0)" ::: "memory");
        } else {
            XB_SPIN(xb_ld(&bar[XB_XGEN(b.x)]) == gen, bar);
            __builtin_amdgcn_fence(__ATOMIC_ACQUIRE, "agent");
            asm volatile("s_waitcnt vmcnt(0)" ::: "memory");
        }
    }
    __syncthreads();
}

struct Params { const float* in[25]; float* out; unsigned char* ws; int ph_lo, ph_hi; };
enum { I_X = 0, I_META, I_N1G, I_WIN, I_BF, I_PW, I_PB, I_PS, I_CW, I_CB, I_LNG, I_LNB, I_WOA, I_WOB, I_WOC, I_WO, I_N2G, I_RGW, I_RGB, I_REW, I_REB, I_W1, I_W3, I_W2, I_FG };

struct Frame {
    LAS unsigned char* lds;
    int tid, lane, wave, vcu, G, bx;
};
__device__ __forceinline__ unsigned long long ptab_get(const Frame& F, int i) { const LAS unsigned* t = (const LAS unsigned*)(F.lds + LC_PTAB) + 2 * i; const unsigned lo = __builtin_amdgcn_readfirstlane(t[0]), hi = __builtin_amdgcn_readfirstlane(t[1]); return ((unsigned long long)hi << 32) | lo; }
#define INP(i) ((const float*)(const GAS float*)ptab_get(F, (i)))
#define WSP() ((unsigned char*)(GAS unsigned char*)ptab_get(F, 25))
#define DOP() ((unsigned char*)(GAS unsigned char*)ptab_get(F, 26))

__device__ __forceinline__ void tr_item(const float* W, int ldw, int scol_lane  , const float* gk, bf16* WT, int ldt, int drow0, int k0, LAS float* scr, int lane) {
    const int n4 = (lane & 7) * 4, kr = lane >> 3;
    f32x4 v[8];
#pragma unroll
    for (int i = 0; i < 8; ++i) v[i] = *(const f32x4*)(W + (size_t)(k0 + 8 * i + kr) * ldw + scol_lane);
#pragma unroll
    for (int i = 0; i < 8; ++i) { const int kk = 8 * i + kr; const float g = gk ? gk[k0 + kk] : 1.0f; LAS float* d = scr + kk * 33 + n4; d[0] = v[i][0] * g; d[1] = v[i][1] * g; d[2] = v[i][2] * g; d[3] = v[i][3] * g; }
    LDS_WAIT(); asm volatile("" ::: "memory");
    const int c = lane & 7;
#pragma unroll
    for (int j = 0; j < 4; ++j) { const int n = (lane >> 3) + 8 * j; const LAS float* s = scr + (8 * c) * 33 + n;
        u32x4 o; o.x = pk2(s[0 * 33], s[1 * 33]); o.y = pk2(s[2 * 33], s[3 * 33]); o.z = pk2(s[4 * 33], s[5 * 33]); o.w = pk2(s[6 * 33], s[7 * 33]);
        *(u32x4*)(WT + (size_t)(drow0 + n) * ldt + k0 + 8 * c) = o; }
    LDS_WAIT(); asm volatile("" ::: "memory");
}
__device__ __forceinline__ int map1(int n) {
    const int tile = n >> 8, c = n & 255;
    if (tile == 0) return n;
    if (tile <= 2) { const int cc = (tile - 1) * 128 + (c & 127); return (c < 128 ? 256 : 512) + cc; }
    if (tile <= 4) return 1792 + (n - 768);
    const int t = tile - 5, bj = c >> 7, wc = (c >> 5) & 3, fq = (c >> 3) & 3, nn = (c >> 2) & 1, d = 64 * t + 16 * wc + 4 * fq + (c & 3), kind = 2 * bj + nn;
    return kind == 3 ? 768 + d : 2312 + 1024 * kind + d;
}
__device__ __forceinline__ void convert_weights(Frame& F, int l) {
    LAS float* scr = (LAS float*)(F.lds + F.wave * 16384);
    const int gw = F.vcu * NWAVES + F.wave, NGW = F.G * NWAVES, lane = F.lane;
    const float* g1 = INP(I_N1G) + (size_t)l * D; const float* g2 = INP(I_N2G) + (size_t)l * D;
    unsigned char* ws = WSP();
    const int n4l = (lane & 7) * 4;
#pragma unroll 1
    for (int it0 = gw; it0 < 9728; it0 += NGW) { int it = it0;
        if (it < 2688) { const int kb = it / 168, nb = it % 168; tr_item(INP(I_WIN) + (size_t)l * D * NIN, NIN, map1(nb * 32 + n4l), g1, (bf16*)(ws + WS_W1T), 1024, nb * 32, kb * 64, scr, lane); continue; } it -= 2688;
        if (it < 128) { const int kb = it / 32, nb = it % 32; tr_item(INP(I_WOB) + (size_t)l * 256 * D, 1024, nb * 32 + n4l, nullptr, (bf16*)(ws + WS_W3CT) + 256, 1024, nb * 32, kb * 64, scr, lane); continue; } it -= 128;
        if (it < 256) { const int kb = it / 32, nb = it % 32; tr_item(INP(I_WOC) + (size_t)l * 512 * D, 1024, nb * 32 + n4l, nullptr, (bf16*)(ws + WS_W3CT) + 512, 1024, nb * 32, kb * 64, scr, lane); continue; } it -= 256;
        if (it < 512) { const int kb = it / 32, nb = it % 32; tr_item(INP(I_WO) + (size_t)l * D * D, 1024, nb * 32 + n4l, nullptr, (bf16*)(ws + WS_WOT), 1024, nb * 32, kb * 64, scr, lane); continue; } it -= 512;
        if (it < 4096) { const int e = it >> 8, r = it & 255, kb = r >> 4, nb = r & 15, n0 = nb * 32, jt = n0 >> 8, rr = n0 & 255;
            const float* W = (rr < 128 ? INP(I_W1) : INP(I_W3)) + ((size_t)l * 16 + e) * D * 256;
            tr_item(W, 256, jt * 128 + (rr & 127) + n4l, g2, (bf16*)(DOP() + DO_W13T) + (size_t)e * 512 * 1024, 1024, n0, kb * 64, scr, lane); continue; } it -= 4096;
        { const int e = it >> 7, r = it & 127, kb = r >> 5, nb = r & 31;
            tr_item(INP(I_W2) + ((size_t)l * 16 + e) * 256 * D, 1024, nb * 32 + n4l, nullptr, (bf16*)(DOP() + DO_W2T) + (size_t)e * 1024 * 256, 256, nb * 32, kb * 64, scr, lane); }
    }
    { const float* pw = INP(I_PW) + (size_t)l * 4 * 64 * 64; const float* ps = INP(I_PS) + (size_t)l * 256; const float* pb = INP(I_PB) + (size_t)l * 256;
      const float* wa = INP(I_WOA) + (size_t)l * 256 * D; bf16* WT = (bf16*)(ws + WS_W3CT); float* bias = (float*)(ws + WS_BIASA);
      const int gt = F.vcu * 512 + F.tid, NT = F.G * 512;
      for (int idx = gt; idx < 256 * 1024; idx += NT) { const int n = idx & 1023, kk = idx >> 10, grp = kk >> 6, c = kk & 63; float s = 0.f;
#pragma unroll 16
        for (int d = 0; d < 64; ++d) s += pw[(grp * 64 + c) * 64 + d] * ps[grp * 64 + d] * wa[(size_t)(grp * 64 + d) * D + n];
        WT[(size_t)n * 1024 + kk] = (bf16)f2bf(s); }
      for (int n = gw; n < 1024; n += NGW) { float s = 0.f;
#pragma unroll
        for (int j = 0; j < 4; ++j) { const int d = lane + 64 * j; s += pb[d] * ps[d] * wa[(size_t)d * D + n]; }
        s = wave_sum(s); if (lane == 0) bias[n] = s; }
      float* wfg = (float*)(ws + WS_WFG); const float* win = INP(I_WIN) + (size_t)l * D * NIN;
      for (int idx = gt; idx < 8 * 1024; idx += NT) { const int c = idx >> 10, k = idx & 1023; wfg[idx] = g1[k] * win[(size_t)k * NIN + 2304 + c]; }
      float* rg = (float*)(ws + WS_RG); const float* re = INP(I_REW) + (size_t)l * D * 16; const float* rgw = INP(I_RGW) + (size_t)l * D * 4;
      for (int idx = gt; idx < 20 * 1024; idx += NT) { const int c = idx >> 10, k = idx & 1023; rg[idx] = g2[k] * (c < 16 ? re[(size_t)k * 16 + c] : rgw[(size_t)k * 4 + (c - 16)]); } }
}
__device__ __forceinline__ void init_rows(Frame& F) {
    const int gw = F.vcu * NWAVES + F.wave, NGW = F.G * NWAVES, lane = F.lane;
    bf16* HB = (bf16*)(WSP() + WS_HB); float* rstd1 = (float*)(WSP() + WS_RSTD1);
    constexpr int R = 4;
#pragma unroll 1
    for (int row0 = gw; row0 < TR; row0 += R * NGW) {
        f32x4 v[R][4];
#pragma unroll
        for (int r = 0; r < R; ++r) { int row = row0 + r * NGW; if (row >= TR) row = TR - 1;
            const float* src = row < TX ? INP(I_X) + (size_t)row * D : INP(I_META) + (size_t)(row - TX) * D;
#pragma unroll
            for (int j = 0; j < 4; ++j) v[r][j] = *(const f32x4*)(src + 4 * lane + 256 * j); }
#pragma unroll
        for (int r = 0; r < R; ++r) { const int row = row0 + r * NGW; float ss = 0.f;
#pragma unroll
            for (int j = 0; j < 4; ++j) ss += v[r][j][0] * v[r][j][0] + v[r][j][1] * v[r][j][1] + v[r][j][2] * v[r][j][2] + v[r][j][3] * v[r][j][3];
            ss = wave_sum(ss);
            if (row < TR) {
#pragma unroll
                for (int j = 0; j < 4; ++j) { u32x2 w; w.x = pk2(v[r][j][0], v[r][j][1]); w.y = pk2(v[r][j][2], v[r][j][3]); *(u32x2*)(HB + (size_t)row * D + 4 * lane + 256 * j) = w; }
                if (lane == 0) rstd1[row] = rsqrtf(ss * (1.0f / D) + EPS); } }
    }
    { bf16* Kb = (bf16*)(DOP() + DO_K) + (size_t)TR * 512; bf16* Vb = (bf16*)(DOP() + DO_V) + (size_t)TR * 512; const int gt = F.vcu * 512 + F.tid;
      if (gt < 48 * 64) { *(u32x4*)(Kb + (size_t)gt * 8) = (u32x4){0u, 0u, 0u, 0u}; *(u32x4*)(Vb + (size_t)gt * 8) = (u32x4){0u, 0u, 0u, 0u}; } }
}

__device__ __forceinline__ int srcrow(bool isx, int b, int t) {
    if (t >= 0) return (isx ? b * SEQ : TX) + t;
    if (isx) { const int mm = NMETA + t; return mm >= 0 ? TX + mm : -1; }
    return -1;
}
__device__ __forceinline__ void phase_S(Frame& F, int l) {
    LAS unsigned char* lds = F.lds; const int wave = F.wave;
#pragma unroll 1
    for (int item = F.vcu; item < 513; item += F.G) {
        const bool isx = item < 512; const int row0 = isx ? item * 64 : TX + (item - 512) * 64; const int b = isx ? (item * 64) / SEQ : 0; const int t0 = isx ? (item * 64) % SEQ : (item - 512) * 64; const int nrows = isx ? 64 : NMETA;
        { unsigned char* ws = WSP(); int tid = F.tid; LAUNDER_V(tid); const int lane = tid & 63, fr = lane & 15, fq = lane >> 4;
          const bf16* HB = (const bf16*)(ws + WS_HB); const float* rstd1 = (const float*)(ws + WS_RSTD1); const float* wfg = (const float*)(ws + WS_WFG);
          float* LFT = (float*)(ws + WS_LFT); float* LFTM = (float*)(ws + WS_LFTM); const float* bfg = INP(I_BF) + l * 8;
          LAS bf16* Whi = (LAS bf16*)lds; LAS bf16* Wlo = Whi + 8 * RPITCH; LAS float* Pex = (LAS float*)(lds + 2 * 8 * RPITCH * 2); LAS unsigned* nmx = (LAS unsigned*)(lds + LC_NMX);
          { f32x4 wv_[4];
#pragma unroll
            for (int j = 0; j < 4; ++j) wv_[j] = *(const f32x4*)(wfg + 4 * (tid + 512 * j));
#pragma unroll
            for (int j = 0; j < 4; ++j) { const int i = 4 * (tid + 512 * j), c = i >> 10, k = i & 1023; u32x2 hw, lw; float hf[4];
#pragma unroll
                for (int e = 0; e < 4; ++e) hf[e] = __builtin_bit_cast(float, (pk2(wv_[j][e], 0.f) & 0xffffu) << 16);
                hw.x = pk2(wv_[j][0], wv_[j][1]); hw.y = pk2(wv_[j][2], wv_[j][3]); lw.x = pk2(wv_[j][0] - hf[0], wv_[j][1] - hf[1]); lw.y = pk2(wv_[j][2] - hf[2], wv_[j][3] - hf[3]);
                *(LAS u32x2*)(Whi + c * RPITCH + k) = hw; *(LAS u32x2*)(Wlo + c * RPITCH + k) = lw; } }
          if (tid < 16) nmx[tid] = 0u;
          const int g = wave & 3, kh = wave >> 2, rr = 16 * g + fr, row = row0 + rr;
          bf16x8 af[16];
#pragma unroll
          for (int s2 = 0; s2 < 16; ++s2) af[s2] = *(const bf16x8*)(HB + (size_t)row * D + 32 * (16 * kh + s2) + 8 * fq);
          const float rs1 = rstd1[row];
          __syncthreads();
          f32x4 acc = {0.f, 0.f, 0.f, 0.f};
#pragma unroll
          for (int s2 = 0; s2 < 16; ++s2) { const int k = 32 * (16 * kh + s2) + 8 * fq;
              bf16x8 wh = *(const LAS bf16x8*)(Whi + (fr & 7) * RPITCH + k), wl = *(const LAS bf16x8*)(Wlo + (fr & 7) * RPITCH + k);
              if (fr >= 8) { wh = (bf16x8){0, 0, 0, 0, 0, 0, 0, 0}; wl = wh; }
              acc = __builtin_amdgcn_mfma_f32_16x16x32_bf16(wh, af[s2], acc, 0, 0, 0); acc = __builtin_amdgcn_mfma_f32_16x16x32_bf16(wl, af[s2], acc, 0, 0, 0); }
          if (kh == 1) *(LAS f32x4*)(Pex + (g * 64 + lane) * 4) = acc;
          { const bf16* Qg = (const bf16*)(DOP() + DO_Q); const bf16* Kg = (const bf16*)(DOP() + DO_K); float kmx = 0.f, qmx = 0.f;
            u32x4 kw[8], qw[8];
#pragma unroll
            for (int i8 = 0; i8 < 8; ++i8) { const int r2 = wave + 8 * i8; const int rw = row0 + (r2 < nrows ? r2 : 0); kw[i8] = *(const u32x4*)(Kg + (size_t)rw * 512 + 8 * lane); qw[i8] = *(const u32x4*)(Qg + (size_t)rw * 512 + 8 * lane); }
#pragma unroll
            for (int i8 = 0; i8 < 8; ++i8) { const u32x4 a = kw[i8], c = qw[i8];
                float sk = (bflo(a.x) * bflo(a.x) + bfhi(a.x) * bfhi(a.x)) + (bflo(a.y) * bflo(a.y) + bfhi(a.y) * bfhi(a.y)) + (bflo(a.z) * bflo(a.z) + bfhi(a.z) * bfhi(a.z)) + (bflo(a.w) * bflo(a.w) + bfhi(a.w) * bfhi(a.w));
                float sq = (bflo(c.x) * bflo(c.x) + bfhi(c.x) * bfhi(c.x)) + (bflo(c.y) * bflo(c.y) + bfhi(c.y) * bfhi(c.y)) + (bflo(c.z) * bflo(c.z) + bfhi(c.z) * bfhi(c.z)) + (bflo(c.w) * bflo(c.w) + bfhi(c.w) * bfhi(c.w));
                sk += lane_xor<1>(sk); sk += lane_xor<2>(sk); sk += lane_xor<4>(sk); sq += lane_xor<1>(sq); sq += lane_xor<2>(sq); sq += lane_xor<4>(sq);
                kmx = fmaxf(kmx, sk); qmx = fmaxf(qmx, sq); }
            if ((lane & 7) == 0) { const int hd = lane >> 3; __hip_atomic_fetch_max(&nmx[hd], __float_as_uint(kmx), __ATOMIC_RELAXED, __HIP_MEMORY_SCOPE_WORKGROUP); __hip_atomic_fetch_max(&nmx[8 + hd], __float_as_uint(qmx), __ATOMIC_RELAXED, __HIP_MEMORY_SCOPE_WORKGROUP); } }
          __syncthreads();
          if (kh == 0) { const f32x4 o4 = *(const LAS f32x4*)(Pex + (g * 64 + lane) * 4); acc += o4;
              if (fq < 2 && rr < nrows && row < TR) {
#pragma unroll
                  for (int i = 0; i < 4; ++i) { const int hd = 4 * fq + i; const float xg = acc[i] * rs1 + bfg[hd]; const float lf = fminf(xg, 0.f) - 0.69314718056f * __builtin_amdgcn_logf(1.0f + __expf(-fabsf(xg)));
                      if (isx) LFT[(size_t)(b * 8 + hd) * SEQ + t0 + rr] = lf; else LFTM[hd * 256 + t0 + rr] = lf; } } }
          if (tid < 16) { unsigned* nrm = (unsigned*)(WSP() + WS_CTL) + CW_NRM + l * 64; const unsigned v = nmx[tid];
              if (isx) __hip_atomic_fetch_max(nrm + (tid >> 3) * 32 + b * 8 + (tid & 7), v, __ATOMIC_RELAXED, __HIP_MEMORY_SCOPE_AGENT);
              else if (tid < 8) { for (int bb = 0; bb < NB; ++bb) __hip_atomic_fetch_max(nrm + bb * 8 + tid, v, __ATOMIC_RELAXED, __HIP_MEMORY_SCOPE_AGENT); } }
          __syncthreads(); }
        { unsigned char* ws = WSP(); int tid = F.tid; LAUNDER_V(tid);
          const bf16* Ab = (const bf16*)(ws + WS_A); bf16* DIFF = (bf16*)(ws + WS_X3);
          LAS unsigned char* T = lds;
          { u32x4 tv[5]; const int nld = (15 + nrows) * 32;
#pragma unroll
            for (int j = 0; j < 5; ++j) { const int i = tid + 512 * j; const int sl = i >> 5, ch = i & 31; const int r = i < nld ? srcrow(isx, b, t0 + sl - 15) : -1; unsigned z_ = 0u; LAUNDER_V(z_);
                tv[j] = r >= 0 ? *(const u32x4*)(Ab + (size_t)r * 256 + ch * 8) : (u32x4){z_, z_, z_, z_}; }
#pragma unroll
            for (int j = 0; j < 5; ++j) { const int i = tid + 512 * j; if (i < nld) *(LAS u32x4*)(T + (i >> 5) * 512 + (i & 31) * 16) = tv[j]; } }
          __syncthreads();
#pragma unroll 1
          for (int i = tid; i < nrows * 32; i += 512) { const int r = i >> 5, ch = i & 31, grp = ch >> 3, w = 2 << grp; const int cnt = isx ? w : min(t0 + r + 1, w);
              float s[8];
#pragma unroll
              for (int j = 0; j < 8; ++j) s[j] = 0.f;
#pragma unroll 1
              for (int d = 0; d < cnt; ++d) { const u32x4 v = *(const LAS u32x4*)(T + (15 + r - d) * 512 + ch * 16);
                  s[0] += bflo(v.x); s[1] += bfhi(v.x); s[2] += bflo(v.y); s[3] += bfhi(v.y); s[4] += bflo(v.z); s[5] += bfhi(v.z); s[6] += bflo(v.w); s[7] += bfhi(v.w); }
              const u32x4 a = *(const LAS u32x4*)(T + (15 + r) * 512 + ch * 16); const float ic = 1.0f / (float)cnt;
              u32x4 o; o.x = pk2(s[0] * ic - bflo(a.x), s[1] * ic - bfhi(a.x)); o.y = pk2(s[2] * ic - bflo(a.y), s[3] * ic - bfhi(a.y));
              o.z = pk2(s[4] * ic - bflo(a.z), s[5] * ic - bfhi(a.z)); o.w = pk2(s[6] * ic - bflo(a.w), s[7] * ic - bfhi(a.w));
              if (row0 + r < TR) *(u32x4*)(DIFF + (size_t)(row0 + r) * 1024 + ch * 8) = o; }
          __syncthreads(); }
        { unsigned char* ws = WSP(); int tid = F.tid; LAUNDER_V(tid);
          const bf16* GLU = (const bf16*)(ws + WS_GLU);
          LAS unsigned char* T = lds;
          LAS float* Yt = (LAS float*)(lds + 49152);
          { u32x4 tv[6]; const int nld = (isx ? 94 : 62) * 32;
#pragma unroll
            for (int j = 0; j < 6; ++j) { const int i = tid + 512 * j; const int sl = i >> 5, ch = i & 31; const int r = i < nld ? srcrow(isx, b, t0 + sl - 30) : -1; unsigned z_ = 0u; LAUNDER_V(z_);
                tv[j] = r >= 0 ? *(const u32x4*)(GLU + (size_t)r * 256 + ch * 8) : (u32x4){z_, z_, z_, z_}; }
#pragma unroll
            for (int j = 0; j < 6; ++j) { const int i = tid + 512 * j; if (i < nld) *(LAS u32x4*)(T + (i >> 5) * 512 + (i & 31) * 16) = tv[j]; } }
          __syncthreads();
          { const float* cw = INP(I_CW) + (size_t)l * 31 * 256; const float* cb = INP(I_CB) + l * 256;
            const int cp = tid & 127, strip = tid >> 7; f32x2 wv[31];
#pragma unroll
            for (int j = 0; j < 31; ++j) wv[j] = *(const f32x2*)(cw + j * 256 + 2 * cp);
            const f32x2 bias = *(const f32x2*)(cb + 2 * cp);
#pragma unroll 1
            for (int hh = 0; hh < (isx ? 2 : 1); ++hh) { const int rb = 32 * hh + 8 * strip; f32x2 acc[8];
#pragma unroll
                for (int r = 0; r < 8; ++r) acc[r] = bias;
#pragma unroll
                for (int i = 0; i < 38; ++i) { const unsigned xw = *(const LAS unsigned*)(T + (rb + i) * 512 + cp * 4); const f32x2 xx = {bflo(xw), bfhi(xw)};
#pragma unroll
                    for (int r = 0; r < 8; ++r) { const int j = i - r; if (j >= 0 && j <= 30) acc[r] += wv[j] * xx; } }
#pragma unroll
                for (int r = 0; r < 8; ++r) *(LAS f32x2*)(Yt + (rb + r) * 256 + 2 * cp) = acc[r]; } }
          __syncthreads();
          { unsigned char* ws2 = WSP(); int tid2 = F.tid; LAUNDER_V(tid2); const int lane = tid2 & 63;
            bf16* BP = (bf16*)(ws2 + WS_X3) + 256; const float* lng = INP(I_LNG) + l * 256; const float* lnb = INP(I_LNB) + l * 256;
            const f32x4 gg = *(const f32x4*)(lng + 4 * lane), bb = *(const f32x4*)(lnb + 4 * lane);
#pragma unroll 1
            for (int rr = wave; rr < nrows; rr += 8) { const f32x4 v = *(const LAS f32x4*)(Yt + rr * 256 + 4 * lane);
              const float mean = wave_sum(v[0] + v[1] + v[2] + v[3]) * (1.0f / 256.0f); const f32x4 dv = v - mean;
              const float var = wave_sum(dv[0] * dv[0] + dv[1] * dv[1] + dv[2] * dv[2] + dv[3] * dv[3]) * (1.0f / 256.0f); const float rs = rsqrtf(var + EPS);
              f32x4 o = dv * rs * gg + bb;
#pragma unroll
              for (int j = 0; j < 4; ++j) o[j] = o[j] * sigmoidf_(o[j]);
              u32x2 w; w.x = pk2(o[0], o[1]); w.y = pk2(o[2], o[3]); if (row0 + rr < TR) *(u32x2*)(BP + (size_t)(row0 + rr) * 1024 + 4 * lane) = w; } }
          __syncthreads(); }
    }
}

constexpr int AT_FL = 0, AT_K = 34816, AT_VT = AT_K + 8192, AT_SC = AT_VT + 8192;
__device__ __forceinline__ void attn_scan(Frame& F, int b, int h, bool meta_only, int fl_off, int sc_off) {
    LAS float* Fl = (LAS float*)(F.lds + fl_off); LAS float* sc = (LAS float*)(F.lds + sc_off);
    const float* LFT = (const float*)(WSP() + WS_LFT); const float* LFTM = (const float*)(WSP() + WS_LFTM);
    const int tid = F.tid, lane = F.lane, wave = F.wave;
    __syncthreads();
    if (tid == 0) { float s = 0.f; for (int m = 0; m < 64; ++m) { if (m < NMETA) { s += LFTM[h * 256 + m]; Fl[m] = s * LOG2E; } else Fl[m] = 1e30f; if (m == NMETA - 1) sc[16] = s; } }
    if (meta_only) { for (int i = tid; i < 256; i += 512) Fl[64 + i] = 0.f; __syncthreads(); return; }
    float v[16]; const float* src = LFT + (size_t)(b * 8 + h) * SEQ + 16 * tid;
#pragma unroll
    for (int j = 0; j < 4; ++j) { const f32x4 q = *(const f32x4*)(src + 4 * j); v[4 * j] = q[0]; v[4 * j + 1] = q[1]; v[4 * j + 2] = q[2]; v[4 * j + 3] = q[3]; }
#pragma unroll
    for (int j = 1; j < 16; ++j) v[j] += v[j - 1];
    float incl = v[15];
#pragma unroll
    for (int o = 1; o < 64; o <<= 1) { const float up = __int_as_float(__builtin_amdgcn_ds_bpermute((lane - o) << 2, __float_as_int(incl))); if (lane >= o) incl += up; }
    if (lane == 63) sc[wave] = incl;
    __syncthreads();
    float off = sc[16];
    for (int w = 0; w < wave; ++w) off += sc[w];
    off += incl - v[15];
#pragma unroll
    for (int j = 0; j < 16; ++j) Fl[64 + 16 * tid + j] = (off + v[j]) * LOG2E;
    __syncthreads();
}
__device__ __forceinline__ void attn_unit_naive(Frame& F, int qrow0, int qpos0, int ntiles, int kvx0, int h, int nq) {
    const int tid = F.tid; const int hf = tid & 1; const bool live = (tid >> 1) < nq; const int r = live ? (tid >> 1) : 0;
    const bf16* Q = (const bf16*)(DOP() + DO_Q); const bf16* Kg = (const bf16*)(DOP() + DO_K); const bf16* Vg = (const bf16*)(DOP() + DO_V); bf16* O = (bf16*)(WSP() + WS_X3) + 512;
    LAS float* Fl = (LAS float*)(F.lds + AT_FL); LAS unsigned char* Ks = F.lds + AT_K; LAS bf16* VT = (LAS bf16*)(F.lds + AT_VT);
    const int grow = qrow0 + r, qpos = qpos0 + r;
    unsigned qp[16];
#pragma unroll
    for (int j = 0; j < 4; ++j) { const u32x4 w = *(const u32x4*)(Q + (size_t)grow * 512 + h * 64 + hf * 32 + 8 * j); qp[4 * j] = w.x; qp[4 * j + 1] = w.y; qp[4 * j + 2] = w.z; qp[4 * j + 3] = w.w; }
    const float Fq = Fl[qpos < NMETA ? qpos : qpos + 48];
    float mrun = -1e30f, lrun = 0.f, o[32];
#pragma unroll
    for (int d = 0; d < 32; ++d) o[d] = 0.f;
    const int lrow = tid >> 3, lch = tid & 7;

#pragma unroll 1
for (int i = 0; i < ntiles; ++i) {
        const int krow = (i == 0 ? TX : kvx0 + 64 * (i - 1)) + lrow;
        const u32x4 kw = *(const u32x4*)(Kg + (size_t)krow * 512 + h * 64 + lch * 8);
        const u32x4 vw = *(const u32x4*)(Vg + (size_t)krow * 512 + h * 64 + lch * 8);
        __syncthreads();
        *(LAS u32x4*)(Ks + lrow * 128 + lch * 16) = kw;
        { const unsigned vv[4] = {vw.x, vw.y, vw.z, vw.w};
#pragma unroll
          for (int e = 0; e < 4; ++e) { VT[(lch * 8 + 2 * e) * 64 + lrow] = (bf16)(vv[e] & 0xffffu); VT[(lch * 8 + 2 * e + 1) * 64 + lrow] = (bf16)(vv[e] >> 16); } }
        __syncthreads();
        const int kp0 = i == 0 ? 0 : NMETA + 64 * (i - 1);
        if (kp0 > qpos0 + 255) continue;
#pragma unroll 1
        for (int jg = 0; jg < 4; ++jg) {
            float s[16]; float gmax = -1e30f;
#pragma unroll
            for (int jj = 0; jj < 16; ++jj) { const int j = jg * 16 + jj; float d = 0.f;
#pragma unroll
                for (int c = 0; c < 4; ++c) { const u32x4 kk = *(const LAS u32x4*)(Ks + j * 128 + hf * 64 + c * 16);
                    d = dot2bf(kk.x, qp[4 * c], d); d = dot2bf(kk.y, qp[4 * c + 1], d); d = dot2bf(kk.z, qp[4 * c + 2], d); d = dot2bf(kk.w, qp[4 * c + 3], d); }
                d += lane_xor<1>(d);
                const bool valid = (i == 0 ? j < NMETA : true) && (kp0 + j <= qpos);
                s[jj] = valid ? d + Fq - Fl[64 * i + j] : -1e30f; gmax = fmaxf(gmax, s[jj]); }
            const float mn = fmaxf(mrun, gmax), alpha = exp2f(mrun - mn); mrun = mn;
            float ps = 0.f; unsigned pp[8];
#pragma unroll
            for (int jj = 0; jj < 16; jj += 2) { const float p0 = exp2f(s[jj] - mn), p1 = exp2f(s[jj + 1] - mn); ps += p0 + p1; pp[jj >> 1] = pk2(p0, p1); }
            lrun = lrun * alpha + ps;
#pragma unroll
            for (int d = 0; d < 32; ++d) { const u32x4 v0 = *(const LAS u32x4*)(VT + (hf * 32 + d) * 64 + jg * 16), v1 = *(const LAS u32x4*)(VT + (hf * 32 + d) * 64 + jg * 16 + 8);
                float a = o[d] * alpha; a = dot2bf(pp[0], v0.x, a); a = dot2bf(pp[1], v0.y, a); a = dot2bf(pp[2], v0.z, a); a = dot2bf(pp[3], v0.w, a);
                a = dot2bf(pp[4], v1.x, a); a = dot2bf(pp[5], v1.y, a); a = dot2bf(pp[6], v1.z, a); a = dot2bf(pp[7], v1.w, a); o[d] = a; }
        }
    }
    const float il = 1.0f / lrun;
    if (live)
#pragma unroll
    for (int j = 0; j < 4; ++j) { u32x4 w; w.x = pk2(o[8 * j] * il, o[8 * j + 1] * il); w.y = pk2(o[8 * j + 2] * il, o[8 * j + 3] * il); w.z = pk2(o[8 * j + 4] * il, o[8 * j + 5] * il); w.w = pk2(o[8 * j + 6] * il, o[8 * j + 7] * il);
        *(u32x4*)(O + (size_t)grow * 1024 + h * 64 + hf * 32 + 8 * j) = w; }
}
namespace fa {
using bf16x8v = __attribute__((ext_vector_type(8))) short;
using s16x4 = __attribute__((ext_vector_type(4))) short;
using f32x16 = __attribute__((ext_vector_type(16))) float;
constexpr int DMA = 512, DMO = 1024;
constexpr int NW = 8, QBLK = 32, QB = 256, KVBLK = 64;
constexpr int NSLOT = 3, SLOTB = 8192;
constexpr int LDS_K = 0, LDS_V = NSLOT * SLOTB, LDS_WS = 2 * NSLOT * SLOTB, LDS_OST = LDS_WS + NW * 64 * 4, LDS_BYTES = LDS_OST + NW * 4096;
constexpr int LDS_FL = 84992;
constexpr int LDS_SCAN = LDS_FL + (64 + 8192) * 4;
static_assert(LDS_SCAN + 128 <= RING_BYTES, "attention LDS");
__device__ __forceinline__ int crow(int r, int hi) { return (r & 3) + 8 * (r >> 2) + 4 * hi; }
#define SBAR() __builtin_amdgcn_sched_barrier(0)
__device__ __forceinline__ void cmask(f32x16& p0, f32x16& p1, int jb, int qrel, int hi) {
    const float NEG = -INFINITY; int kb = 64 * jb + 4 * hi;
#pragma unroll
    for (int r = 0; r < 16; ++r) { int kv = kb + (r & 3) + 8 * (r >> 2); if (kv > qrel) p0[r] = NEG; if (kv + 32 > qrel) p1[r] = NEG; }
}
__device__ __forceinline__ void glds16(const void* gsrc, unsigned lds_dst) { unsigned keep;
    asm volatile("s_mov_b32 %0, m0\n\ts_mov_b32 m0, %2\n\ts_nop 0\n\tglobal_load_lds_dwordx4 %1, off\n\ts_mov_b32 m0, %0" : "=&s"(keep) : "v"(gsrc), "s"(lds_dst) : "memory"); }
__device__ __forceinline__ float max3f(float a, float b, float c) { float r; asm("v_max3_f32 %0, %1, %2, %3" : "=v"(r) : "v"(a), "v"(b), "v"(c)); return r; }
__device__ __forceinline__ float max2f(float a, float b) { float r; asm("v_max_f32_e32 %0, %1, %2" : "=v"(r) : "v"(a), "v"(b)); return r; }
__device__ __forceinline__ float fsub_s(float a, float b) { float r; asm("v_sub_f32_e32 %0, %1, %2" : "=v"(r) : "v"(a), "v"(b)); return r; }
typedef float f32x2_t __attribute__((ext_vector_type(2))); typedef __bf16 bf16x2_t __attribute__((ext_vector_type(2)));
__device__ __forceinline__ unsigned cvtpk_s(float lo, float hi) { f32x2_t v = {lo, hi}; bf16x2_t b = __builtin_convertvector(v, bf16x2_t); return __builtin_bit_cast(unsigned, b); }
#define WAIT_BAR(N) asm volatile("s_waitcnt vmcnt(" #N ") lgkmcnt(0)\n\ts_barrier" ::: "memory")
typedef __attribute__((address_space(3))) const char* lds_cptr;
typedef short v4i16_t __attribute__((ext_vector_type(4)));
__device__ __forceinline__ void cinit(f32x16& p0, f32x16& p1, const LAS float* fk, float a) {
#pragma unroll
    for (int g = 0; g < 4; ++g) { const f32x4 f0 = *(const LAS f32x4*)(fk + 8 * g), f1 = *(const LAS f32x4*)(fk + 32 + 8 * g);
#pragma unroll
        for (int i = 0; i < 4; ++i) { p0[4 * g + i] = a - f0[i]; p1[4 * g + i] = a - f1[i]; } }
}
__device__ __forceinline__ void qkt(f32x16& p0, f32x16& p1, const char* Kslot, const bf16x8v* qr, int r32, int hi) {
    const char* kb = Kslot + hi * 1024 + r32 * 16;
#pragma unroll
    for (int d0 = 0; d0 < 4; ++d0) {
        const bf16x8v b0 = *reinterpret_cast<const bf16x8v*>(kb + d0 * 2048);
        const bf16x8v b1 = *reinterpret_cast<const bf16x8v*>(kb + d0 * 2048 + 512);
        p0 = __builtin_amdgcn_mfma_f32_32x32x16_bf16(b0, qr[d0], p0, 0, 0, 0); p1 = __builtin_amdgcn_mfma_f32_32x32x16_bf16(b1, qr[d0], p1, 0, 0, 0); }
}
__device__ __forceinline__ void kload8(bf16x8v* kf, lds_cptr kp) {
    kf[0] = *(const LAS bf16x8v*)(kp);        kf[1] = *(const LAS bf16x8v*)(kp + 512);
    kf[2] = *(const LAS bf16x8v*)(kp + 2048); kf[3] = *(const LAS bf16x8v*)(kp + 2560);
    kf[4] = *(const LAS bf16x8v*)(kp + 4096); kf[5] = *(const LAS bf16x8v*)(kp + 4608);
    kf[6] = *(const LAS bf16x8v*)(kp + 6144); kf[7] = *(const LAS bf16x8v*)(kp + 6656);
}
__device__ __forceinline__ void kload2(bf16x8v* kf, lds_cptr kp, int j) { kf[2 * j] = *(const LAS bf16x8v*)(kp + j * 2048); kf[2 * j + 1] = *(const LAS bf16x8v*)(kp + j * 2048 + 512); }
__device__ __forceinline__ s16x4 vtr(lds_cptr p) { return __builtin_bit_cast(s16x4, __builtin_amdgcn_ds_read_tr16_b64_v4i16((LAS v4i16_t*)p)); }
__device__ __forceinline__ float rowmax(const f32x16& p0, const f32x16& p1) {
    float a = max3f(p0[0], p0[1], p1[0]), b = max3f(p0[2], p0[3], p1[1]); a = max3f(a, p1[2], p1[3]);
#pragma unroll
    for (int r = 4; r < 16; r += 4) { a = max3f(a, p0[r], p0[r + 1]); b = max3f(b, p0[r + 2], p0[r + 3]); a = max3f(a, p1[r], p1[r + 1]); b = max3f(b, p1[r + 2], p1[r + 3]); }
    const float m = max2f(a, b);
    auto rr = __builtin_amdgcn_permlane32_swap(__float_as_uint(m), __float_as_uint(m), false, false);
    return max2f(__uint_as_float(rr[0]), __uint_as_float(rr[1]));
}
__device__ __forceinline__ void pv(f32x16* o, int vb, bf16x8v pa0, bf16x8v pa1, bf16x8v pa2, bf16x8v pa3) {
#pragma unroll
    for (int d0 = 0; d0 < 2; ++d0) { s16x4 lo[4], hi[4];
#pragma unroll
        for (int ks = 0; ks < 4; ++ks) {
            asm volatile("ds_read_b64_tr_b16 %0,%1 offset:%c2" : "=&v"(lo[ks]) : "v"(vb), "i"(d0 * 4096 + ks * 1024) : "memory");
            asm volatile("ds_read_b64_tr_b16 %0,%1 offset:%c2" : "=&v"(hi[ks]) : "v"(vb), "i"(d0 * 4096 + ks * 1024 + 512) : "memory"); }
        asm volatile("s_waitcnt lgkmcnt(0)" ::: "memory"); SBAR();
#define PK(k) (bf16x8v){lo[k][0], lo[k][1], lo[k][2], lo[k][3], hi[k][0], hi[k][1], hi[k][2], hi[k][3]}
        o[d0] = __builtin_amdgcn_mfma_f32_32x32x16_bf16(pa0, PK(0), o[d0], 0, 0, 0);
        o[d0] = __builtin_amdgcn_mfma_f32_32x32x16_bf16(pa1, PK(1), o[d0], 0, 0, 0);
        o[d0] = __builtin_amdgcn_mfma_f32_32x32x16_bf16(pa2, PK(2), o[d0], 0, 0, 0);
        o[d0] = __builtin_amdgcn_mfma_f32_32x32x16_bf16(pa3, PK(3), o[d0], 0, 0, 0);
#undef PK
    }
}
template <int THRL> __device__ __forceinline__ void attn_unit(int b, int h, int qb, int tf, const bf16* Q, const bf16* __restrict__ K, const bf16* __restrict__ V, bf16* O, char* shm, int wid) {
    const int lane = lane_id_opaque(), r32 = lane & 31, hi = lane >> 5;
    const long rowbase = (long)b * SEQ; const int q0 = qb * QB;
    const bf16* Qw = Q + (rowbase + q0 + wid * QBLK) * DMA + h * 64;
    const bf16* Kh = K + rowbase * DMA + h * 64, *Vh = V + rowbase * DMA + h * 64;
    const bf16* Km = K + (long)TX * DMA + h * 64, *Vm = V + (long)TX * DMA + h * 64;
    const unsigned lds0 = (unsigned)(uintptr_t)shm;
    float* wsf = (float*)(shm + LDS_WS) + wid * 64;
    const bf16* ksrc = Kh + (long)lane * DMA + wid * 8;
    const bf16* vsrc = Vh + (long)(16 * (wid & 3) + (lane >> 2)) * DMA + (wid >> 2) * 32 + (lane & 3) * 8;
    const bf16* ksrcm = Km + (long)lane * DMA + wid * 8;
    const bf16* vsrcm = Vm + (long)(16 * (wid & 3) + (lane >> 2)) * DMA + (wid >> 2) * 32 + (lane & 3) * 8;
    const unsigned kdst = lds0 + LDS_K + wid * 1024, vdst = lds0 + LDS_V + wid * 1024;
#define DMA_K(t, slot) glds16(ksrc + (long)((t) - 1) * KVBLK * DMA, (unsigned)__builtin_amdgcn_readfirstlane(kdst + (slot)))
#define DMA_V(t, slot) glds16(vsrc + (long)((t) - 1) * KVBLK * DMA, (unsigned)__builtin_amdgcn_readfirstlane(vdst + (slot)))
    const int vb0 = (int)(lds0 + LDS_V) + ((lane >> 4) & 1) * 32 + (lane & 3) * 8 + (4 * hi + ((lane & 15) >> 2)) * 64;
    const char* Kbase = shm + LDS_K; bf16x8v kf[8];
    const lds_cptr shm3 = (lds_cptr)shm; const lds_cptr kp0 = shm3 + LDS_K + hi * 1024 + r32 * 16; const lds_cptr vp0 = shm3 + LDS_V + ((lane >> 4) & 1) * 32 + (lane & 3) * 8 + (4 * hi + ((lane & 15) >> 2)) * 64;
    const LAS float* Flp = (const LAS float*)(shm3 + LDS_FL) + 4 * hi;
    const int NT = 4 * qb + 5;
    glds16(tf == 0 ? ksrcm : ksrc + (long)(tf - 1) * KVBLK * DMA, (unsigned)__builtin_amdgcn_readfirstlane(kdst)); glds16(tf == 0 ? vsrcm : vsrc + (long)(tf - 1) * KVBLK * DMA, (unsigned)__builtin_amdgcn_readfirstlane(vdst)); DMA_K(tf + 1, SLOTB);
    bf16x8v qr[4];
#pragma unroll
    for (int d0 = 0; d0 < 4; ++d0) qr[d0] = *reinterpret_cast<const bf16x8v*>(&Qw[(long)r32 * DMA + d0 * 16 + hi * 8]);
    float aq = ((const LAS float*)(shm3 + LDS_FL))[64 + q0 + wid * QBLK + r32 - 64 * tf];
    float l_reg = 0.f; f32x16 o[2]; o[0] = f32x16{}; o[1] = f32x16{};
    const int qrel = wid * QBLK + r32;
#define CMASK(P0, P1, t) do { int jb_ = (t) - (NT - 4); if (jb_ >= 0) cmask(P0, P1, jb_, qrel, hi); } while (0)
    bool resc = false;
#define START(P0, P1) do { const float rm = rowmax(P0, P1); resc = false; \
    { const float dl = max2f(rm, 0.f); aq = fsub_s(aq, dl);        \
      _Pragma("unroll") for (int r = 0; r < 16; ++r) { P0[r] = fsub_s(P0[r], dl); P1[r] = fsub_s(P1[r], dl); } } \
    _Pragma("unroll") for (int r = 0; r < 16; ++r) P0[r] = __builtin_amdgcn_exp2f(P0[r]); } while (0)
#define RESC() do { if (resc) { asm volatile("s_waitcnt lgkmcnt(0)" ::: "memory"); \
      _Pragma("unroll") for (int d_ = 0; d_ < 2; ++d_) _Pragma("unroll") for (int r = 0; r < 16; ++r) o[d_][r] *= wsf[crow(r, hi)]; } } while (0)
    f32x16 pA0, pA1, pB0, pB1;
    int sl_prev = 0, sl_cur = 0, sl_next = SLOTB;
#define ROT() do { sl_prev = sl_cur; sl_cur = sl_next; sl_next = (sl_next == (NSLOT - 1) * SLOTB) ? 0 : sl_next + SLOTB; } while (0)
    DMA_K(tf + 2, 2 * SLOTB);
    cinit(pA0, pA1, Flp, aq);
    WAIT_BAR(3);
    qkt(pA0, pA1, Kbase, qr, r32, hi); asm volatile("s_nop 15\n\ts_nop 7" : "+v"(pA0), "+v"(pA1));
    START(pA0, pA1);
    _Pragma("unroll") for (int r = 0; r < 16; ++r) pA1[r] = __builtin_amdgcn_exp2f(pA1[r]);
    WAIT_BAR(0);
    DMA_K(tf + 3, 0); DMA_V(tf + 1, SLOTB);
    ROT();
    kload8(kf, kp0 + sl_cur);
    WAIT_BAR(2);
    s16x4 vlo[8], vhi[8]; u32x4 pw0, pw1, pw2, pw3;
#define PKW(P, B) cvtpk_s(P[B], P[B + 1])
#define PAF(k) __builtin_bit_cast(bf16x8v, pw##k)
#define VFR(i) (bf16x8v){vlo[i][0], vlo[i][1], vlo[i][2], vlo[i][3], vhi[i][0], vhi[i][1], vhi[i][2], vhi[i][3]}
#define PIN(x) asm volatile("" : "+v"(x))
#define MX3(a, b, c) __builtin_fmaxf(__builtin_fmaxf((a), (b)), (c))
#define GAPA(MF, A0, A1, A2, A3, W0, W1, PW) do { MF; sacc += A0; sacc += A1; sacc += A2; sacc += A3; PIN(sacc); W0; W1; PIN(PW); SBAR(); } while (0)
#define EX(v) __builtin_amdgcn_exp2f(v)
#define GAPB(MF, X, B) do { MF; X[B] = EX(X[B]); X[B + 1] = EX(X[B + 1]); X[B + 2] = EX(X[B + 2]); X[B + 3] = EX(X[B + 3]); PIN(X); SBAR(); } while (0)
#define VRD(i) do { vlo[i] = vtr(vp_ + (((i) >> 2) * 4096 + ((i) & 3) * 1024)); vhi[i] = vtr(vp_ + (((i) >> 2) * 4096 + ((i) & 3) * 1024 + 512)); } while (0)
#define KRD(G, j) do { if (G) { kload2(kf, kp0 + sl_next, j); SBAR(); } } while (0)
#define STEP(C0, C1, P0, P1, t, GK, GV, GL) do { SBAR(); \
    cinit(C0, C1, Flp + 64 * ((t) - tf), aq); SBAR(); \
    const lds_cptr vp_ = vp0 + sl_prev; \
    VRD(0); SBAR(); float sacc = (P0[0] + P0[1]); \
    GAPA(C0 = __builtin_amdgcn_mfma_f32_32x32x16_bf16(kf[0], qr[0], C0, 0, 0, 0), P0[2], P0[3], P0[4], P0[5],     pw0[0] = PKW(P0, 0), pw0[1] = PKW(P0, 2), pw0); \
    VRD(4); SBAR(); GAPA(C1 = __builtin_amdgcn_mfma_f32_32x32x16_bf16(kf[1], qr[0], C1, 0, 0, 0), P0[6], P0[7], P0[8], P0[9],     pw0[2] = PKW(P0, 4), pw0[3] = PKW(P0, 6), pw0); \
    VRD(1); SBAR(); GAPA(C0 = __builtin_amdgcn_mfma_f32_32x32x16_bf16(kf[2], qr[1], C0, 0, 0, 0),   P0[10], P0[11], P0[12], P0[13], pw1[0] = PKW(P0, 8), pw1[1] = PKW(P0, 10), pw1); \
    VRD(5); SBAR(); GAPA(C1 = __builtin_amdgcn_mfma_f32_32x32x16_bf16(kf[3], qr[1], C1, 0, 0, 0),   P0[14], P0[15], P1[0], P1[1],   pw1[2] = PKW(P0, 12), pw1[3] = PKW(P0, 14), pw1); \
    VRD(2); SBAR(); GAPA(C0 = __builtin_amdgcn_mfma_f32_32x32x16_bf16(kf[4], qr[2], C0, 0, 0, 0),   P1[2], P1[3], P1[4], P1[5],     pw2[0] = PKW(P1, 0), pw2[1] = PKW(P1, 2), pw2); \
    VRD(6); SBAR(); GAPA(C1 = __builtin_amdgcn_mfma_f32_32x32x16_bf16(kf[5], qr[2], C1, 0, 0, 0),   P1[6], P1[7], P1[8], P1[9],     pw2[2] = PKW(P1, 4), pw2[3] = PKW(P1, 6), pw2); \
    VRD(3); SBAR(); GAPA(C0 = __builtin_amdgcn_mfma_f32_32x32x16_bf16(kf[6], qr[3], C0, 0, 0, 0),   P1[10], P1[11], P1[12], P1[13], pw3[0] = PKW(P1, 8), pw3[1] = PKW(P1, 10), pw3); \
    VRD(7); SBAR(); GAPA(C1 = __builtin_amdgcn_mfma_f32_32x32x16_bf16(kf[7], qr[3], C1, 0, 0, 0),   P1[14], P1[15], 0.f, 0.f,       pw3[2] = PKW(P1, 12), pw3[3] = PKW(P1, 14), pw3); \
    l_reg += sacc; \
    if (GK) { DMA_K((t) + 3, sl_cur); } if (GV) { DMA_V((t) + 1, sl_next); } \
    CMASK(C0, C1, t); \
    { float a = MX3(C0[0], C0[1], C1[0]), b_ = MX3(C0[2], C0[3], C1[1]); a = MX3(a, C1[2], C1[3]); \
      _Pragma("unroll") for (int r = 4; r < 16; r += 4) { a = MX3(a, C0[r], C0[r + 1]); b_ = MX3(b_, C0[r + 2], C0[r + 3]); a = MX3(a, C1[r], C1[r + 1]); b_ = MX3(b_, C1[r + 2], C1[r + 3]); } \
      float rm = __builtin_fmaxf(a, b_); { auto rr = __builtin_amdgcn_permlane32_swap(__float_as_uint(rm), __float_as_uint(rm), false, false); rm = __builtin_fmaxf(__uint_as_float(rr[0]), __uint_as_float(rr[1])); } \
      resc = false; \
      if (__builtin_expect(__any(rm > (float)THRL), 0)) { const float dl = __builtin_fmaxf(rm, 0.f); aq -= dl; \
        _Pragma("unroll") for (int r = 0; r < 16; ++r) { C0[r] -= dl; C1[r] -= dl; } \
        const float f = __builtin_amdgcn_exp2f(-dl); l_reg *= f; if (hi == 0) wsf[r32] = f; resc = true; } } \
    SBAR(); \
    GAPB(o[0] = __builtin_amdgcn_mfma_f32_32x32x16_bf16(PAF(0), VFR(0), o[0], 0, 0, 0), C0, 0); \
    GAPB(o[1] = __builtin_amdgcn_mfma_f32_32x32x16_bf16(PAF(0), VFR(4), o[1], 0, 0, 0), C0, 4); \
    KRD(GL, 0); GAPB(o[0] = __builtin_amdgcn_mfma_f32_32x32x16_bf16(PAF(1), VFR(1), o[0], 0, 0, 0), C0, 8); \
    KRD(GL, 1); GAPB(o[1] = __builtin_amdgcn_mfma_f32_32x32x16_bf16(PAF(1), VFR(5), o[1], 0, 0, 0), C0, 12); \
    KRD(GL, 2); GAPB(o[0] = __builtin_amdgcn_mfma_f32_32x32x16_bf16(PAF(2), VFR(2), o[0], 0, 0, 0), C1, 0); \
    KRD(GL, 3); GAPB(o[1] = __builtin_amdgcn_mfma_f32_32x32x16_bf16(PAF(2), VFR(6), o[1], 0, 0, 0), C1, 4); \
    GAPB(o[0] = __builtin_amdgcn_mfma_f32_32x32x16_bf16(PAF(3), VFR(3), o[0], 0, 0, 0), C1, 8); \
    GAPB(o[1] = __builtin_amdgcn_mfma_f32_32x32x16_bf16(PAF(3), VFR(7), o[1], 0, 0, 0), C1, 12); \
    } while (0)
    int t = tf + 1;
#undef CMASK
#define CMASK(P0, P1, t) do { } while (0)
    for (; t + 5 < NT; t += 2) {
        STEP(pB0, pB1, pA0, pA1, t, true, true, true);     WAIT_BAR(2); RESC(); ROT();
        STEP(pA0, pA1, pB0, pB1, t + 1, true, true, true); WAIT_BAR(2); RESC(); ROT();
    }
#undef CMASK
#define CMASK(P0, P1, t) do { int jb_ = (t) - (NT - 4); if (jb_ >= 0) cmask(P0, P1, jb_, qrel, hi); } while (0)
#define ENDW(tt) do { if ((tt) + 3 < NT) { WAIT_BAR(2); } else if ((tt) + 2 < NT) { WAIT_BAR(1); } else { WAIT_BAR(0); } } while (0)
    for (; t + 1 < NT; t += 2) {
        STEP(pB0, pB1, pA0, pA1, t, (t + 3 < NT), (t + 1 < NT), (t + 1 < NT));         ENDW(t);     RESC(); ROT();
        STEP(pA0, pA1, pB0, pB1, t + 1, (t + 4 < NT), (t + 2 < NT), (t + 2 < NT));     ENDW(t + 1); RESC(); ROT();
    }
    { float sacc = pA0[0] + pA0[1]; _Pragma("unroll") for (int r = 2; r < 16; ++r) sacc += pA0[r]; _Pragma("unroll") for (int r = 0; r < 16; ++r) sacc += pA1[r]; l_reg += sacc;
      pw0 = (u32x4){PKW(pA0, 0), PKW(pA0, 2), PKW(pA0, 4), PKW(pA0, 6)}; pw1 = (u32x4){PKW(pA0, 8), PKW(pA0, 10), PKW(pA0, 12), PKW(pA0, 14)}; pw2 = (u32x4){PKW(pA1, 0), PKW(pA1, 2), PKW(pA1, 4), PKW(pA1, 6)}; pw3 = (u32x4){PKW(pA1, 8), PKW(pA1, 10), PKW(pA1, 12), PKW(pA1, 14)};
      SBAR(); pv(o, vb0 + sl_prev, PAF(0), PAF(1), PAF(2), PAF(3)); }
#undef PKW
#undef PAF
#undef VFR
#undef PIN
#undef MX3
#undef GAPA
#undef GAPB
#undef EX
#undef VRD
#undef KRD
#undef STEP
#undef ENDW
    { auto rr = __builtin_amdgcn_permlane32_swap(__float_as_uint(l_reg), __float_as_uint(l_reg), false, false); l_reg = __uint_as_float(rr[0]) + __uint_as_float(rr[1]); }
    if (hi == 0) wsf[32 + r32] = l_reg; asm volatile("s_waitcnt lgkmcnt(0)" ::: "memory");
    float rli[16];
#pragma unroll
    for (int r = 0; r < 16; ++r) rli[r] = __builtin_amdgcn_rcpf(wsf[32 + crow(r, hi)]);
    bf16* Ow = O + (rowbase + q0 + wid * QBLK) * DMO + h * 64;
    { bf16* stg = (bf16*)(shm + LDS_OST) + wid * 2048;
#pragma unroll
      for (int r = 0; r < 16; ++r) { const int orow = crow(r, hi);
#pragma unroll
          for (int d0 = 0; d0 < 2; ++d0) stg[orow * 64 + d0 * 32 + r32] = (bf16)f2bf(o[d0][r] * rli[r]); }
      asm volatile("s_waitcnt lgkmcnt(0)" ::: "memory");
#pragma unroll
      for (int i = 0; i < 4; ++i) { const int row = i * 8 + (lane >> 3), ch = lane & 7; const u32x4 v = *(const u32x4*)(stg + row * 64 + ch * 8); *(u32x4*)(Ow + (long)row * DMO + ch * 8) = v; } }
    asm volatile("s_waitcnt lgkmcnt(0)\n\ts_barrier" ::: "memory");
#undef DMA_K
#undef DMA_V
#undef CMASK
#undef START
#undef RESC
#undef ROT
}
#undef SBAR
#undef WAIT_BAR
}
__device__ __forceinline__ void phase_scan(Frame& F) {
#pragma unroll 1
    for (int bh = F.vcu; bh < 32; bh += F.G) {
        attn_scan(F, bh >> 3, bh & 7, false, fa::LDS_FL, fa::LDS_SCAN);
        const LAS float* Fl = (const LAS float*)(F.lds + fa::LDS_FL); float* FLg = (float*)(WSP() + WS_FL) + (size_t)bh * FLN;
#pragma unroll 1
        for (int i = F.tid; i < FLN / 4; i += 512) *(f32x4*)(FLg + 4 * i) = *(const LAS f32x4*)(Fl + 4 * i);
    }
    __syncthreads();
}
__device__ __forceinline__ void phase_B(Frame& F, int l) {
    LAS int* qs = (LAS int*)(F.lds + LC_QS);
    unsigned* ctl = (unsigned*)(WSP() + WS_CTL); unsigned* head = ctl + CW_AQ + l * 64; const unsigned* nrm = ctl + CW_NRM + l * 64;
    const float* FLg = (const float*)(WSP() + WS_FL);
#pragma unroll 1
    for (;;) {
        __syncthreads();
        if (F.tid == 0) { qs[0] = (int)atomicAdd(head, 1u); qs[1] = 0; }
        __syncthreads();
        const int u = __builtin_amdgcn_readfirstlane(qs[0]);
        if (u >= 1032) break;
        if (u < 1024) {
            const int qb = 31 - (u >> 5), bh = u & 31, b = bh >> 3, h = bh & 7, NT = 4 * qb + 5;
            const float kn = __uint_as_float(__hip_atomic_load(nrm + bh, __ATOMIC_RELAXED, __HIP_MEMORY_SCOPE_AGENT)), qn = __uint_as_float(__hip_atomic_load(nrm + 32 + bh, __ATOMIC_RELAXED, __HIP_MEMORY_SCOPE_AGENT));
            const float T = 50.0f + sqrtf(kn * qn);
            const float* FLb = FLg + (size_t)bh * FLN; const float Fq0 = FLb[64 + 256 * qb];
            { const int t = F.tid; const bool skip = (t <= NT - 5) && (FLb[t == 0 ? 15 : 64 * t + 63] > Fq0 + T);
              const int c = __builtin_popcountll(__ballot(skip)); if (F.lane == 0 && c) __hip_atomic_fetch_add(&qs[1], c, __ATOMIC_RELAXED, __HIP_MEMORY_SCOPE_WORKGROUP); }
            __syncthreads();
            int tf = __builtin_amdgcn_readfirstlane(qs[1]); if (((NT - tf) & 1) == 0) tf -= 1;
            { LAS float* Fl = (LAS float*)(F.lds + fa::LDS_FL); const int n4 = (NT - tf) * 16;
#pragma unroll 1
              for (int i = F.tid; i < n4; i += 512) *(LAS f32x4*)(Fl + 4 * i) = *(const f32x4*)(FLb + 64 * tf + 4 * i); }
            __syncthreads();
            unsigned char* dol = DOP();
            fa::attn_unit<8>(b, h, qb, tf, (const bf16*)(dol + DO_Q), (const bf16*)(dol + DO_K), (const bf16*)(dol + DO_V), (bf16*)(WSP() + WS_X3) + 512, (char*)F.lds, F.wave);
        } else {
            const int t_ = F.wave * 64 + lane_id_opaque(); F.tid = t_; F.lane = t_ & 63;
            attn_scan(F, 0, u - 1024, true, AT_FL, AT_SC); attn_unit_naive(F, TX, 0, 1, 0, u - 1024, NMETA);
        }
    }
    __syncthreads();
}

__device__ __forceinline__ void class_tables(Frame& F, int l) {
    LAS int* base = (LAS int*)(F.lds + LC_BASE); LAS int* pcls = (LAS int*)(F.lds + LC_PCLS); LAS int* np = (LAS int*)(F.lds + LC_NP);
    const unsigned* gcnt = (const unsigned*)(WSP() + WS_CTL) + CW_GCNT + l * 64;
    __syncthreads();
    if (F.tid == 0) { int p = 0;
#pragma unroll 1
        for (int c = 0; c < NCLS; ++c) { base[c] = p * 256; int n = (int)__hip_atomic_load(gcnt + c, __ATOMIC_RELAXED, __HIP_MEMORY_SCOPE_AGENT); if (n > TR) n = TR; if (n < 0) n = 0; p += (n + 255) >> 8; }
        if (p > 160) p = 160; base[NCLS] = p * 256; np[0] = p; }
    __syncthreads();
    if (F.tid < 160) { const int mypos = F.tid * 256; int c = 0;
#pragma unroll 1
        for (int k = 1; k < NCLS; ++k) if (base[k] <= mypos) c = k;
        pcls[F.tid] = c; }
    __syncthreads();
}
template <int NG, int CH> __device__ __forceinline__ void e1_groups(Frame& F, int l, const int (&rowv)[NG], const int (&grpv)[NG], const LAS bf16* Rhi, const LAS bf16* Rlo, LAS int* rec, LAS int* lcnt,
                                                                   const float* reb, const float* rgb, int fr, int fq) {
    const float* hsrc[NG]; bf16* hbdst[NG]; const bf16* dsrc[NG];
#pragma unroll
    for (int g = 0; g < NG; ++g) { const int row = rowv[g];
        hsrc[g] = l == 0 ? (row < TX ? INP(I_X) + (size_t)row * D : INP(I_META) + (size_t)(row - TX) * D) : (const float*)(WSP() + WS_H) + (size_t)row * D;
        hbdst[g] = (bf16*)(WSP() + WS_HB) + (size_t)row * D; dsrc[g] = (const bf16*)(WSP() + WS_X3) + (size_t)row * D; }
    const LAS bf16* bh0 = Rhi + fr * RPITCH + 8 * fq; const LAS bf16* bl0 = Rlo + fr * RPITCH + 8 * fq;
    const LAS bf16* bh1 = Rhi + (16 + (fr & 3)) * RPITCH + 8 * fq; const LAS bf16* bl1 = Rlo + (16 + (fr & 3)) * RPITCH + 8 * fq;
    f32x4 acc0[NG], acc1[NG]; float ss[NG];
#pragma unroll
    for (int g = 0; g < NG; ++g) { acc0[g] = (f32x4){0.f, 0.f, 0.f, 0.f}; acc1[g] = acc0[g]; ss[g] = 0.f; }
    f32x4 ch0[NG][CH], ch1[NG][CH]; u32x4 cd[NG][CH];
#pragma unroll
    for (int g = 0; g < NG; ++g)
#pragma unroll
        for (int c = 0; c < CH; ++c) { const int k = 32 * c + 8 * fq; ch0[g][c] = *(const f32x4*)(hsrc[g] + k); ch1[g][c] = *(const f32x4*)(hsrc[g] + k + 4); cd[g][c] = *(const u32x4*)(dsrc[g] + k); }
#pragma unroll 1
    for (int s0 = 0; s0 < 32; s0 += CH) {
        f32x4 nh0[NG][CH], nh1[NG][CH]; u32x4 nd[NG][CH];
        if (s0 + CH < 32) {
#pragma unroll
            for (int g = 0; g < NG; ++g)
#pragma unroll
                for (int c = 0; c < CH; ++c) { const int k = 32 * (s0 + CH + c) + 8 * fq; nh0[g][c] = *(const f32x4*)(hsrc[g] + k); nh1[g][c] = *(const f32x4*)(hsrc[g] + k + 4); nd[g][c] = *(const u32x4*)(dsrc[g] + k); }
        }
#pragma unroll
        for (int c = 0; c < CH; ++c) { const int s = s0 + c, k = 32 * s + 8 * fq;
            const bf16x8 wh0 = *(const LAS bf16x8*)(bh0 + 32 * s), wl0 = *(const LAS bf16x8*)(bl0 + 32 * s);
            bf16x8 wh1 = *(const LAS bf16x8*)(bh1 + 32 * s), wl1 = *(const LAS bf16x8*)(bl1 + 32 * s);
            if (fr >= 4) { wh1 = (bf16x8){0, 0, 0, 0, 0, 0, 0, 0}; wl1 = wh1; }
#pragma unroll
            for (int g = 0; g < NG; ++g) { f32x4 h0 = ch0[g][c], h1 = ch1[g][c]; const u32x4 dv = cd[g][c];
                h0[0] += bflo(dv.x); h0[1] += bfhi(dv.x); h0[2] += bflo(dv.y); h0[3] += bfhi(dv.y); h1[0] += bflo(dv.z); h1[1] += bfhi(dv.z); h1[2] += bflo(dv.w); h1[3] += bfhi(dv.w);
                ss[g] += (h0[0] * h0[0] + h0[1] * h0[1]) + (h0[2] * h0[2] + h0[3] * h0[3]) + (h1[0] * h1[0] + h1[1] * h1[1]) + (h1[2] * h1[2] + h1[3] * h1[3]);
                const u32x4 hw = pack8(h0, h1); *(u32x4*)(hbdst[g] + k) = hw;
                f32x4 r0, r1; r0[0] = h0[0] - bflo(hw.x); r0[1] = h0[1] - bfhi(hw.x); r0[2] = h0[2] - bflo(hw.y); r0[3] = h0[3] - bfhi(hw.y);
                r1[0] = h1[0] - bflo(hw.z); r1[1] = h1[1] - bfhi(hw.z); r1[2] = h1[2] - bflo(hw.w); r1[3] = h1[3] - bfhi(hw.w);
                const u32x4 lw = pack8(r0, r1);
                const bf16x8 ah = __builtin_bit_cast(bf16x8, hw), al = __builtin_bit_cast(bf16x8, lw);
                acc0[g] = __builtin_amdgcn_mfma_f32_16x16x32_bf16(wh0, ah, acc0[g], 0, 0, 0); acc0[g] = __builtin_amdgcn_mfma_f32_16x16x32_bf16(wh0, al, acc0[g], 0, 0, 0); acc0[g] = __builtin_amdgcn_mfma_f32_16x16x32_bf16(wl0, ah, acc0[g], 0, 0, 0);
                acc1[g] = __builtin_amdgcn_mfma_f32_16x16x32_bf16(wh1, ah, acc1[g], 0, 0, 0); acc1[g] = __builtin_amdgcn_mfma_f32_16x16x32_bf16(wh1, al, acc1[g], 0, 0, 0); acc1[g] = __builtin_amdgcn_mfma_f32_16x16x32_bf16(wl1, ah, acc1[g], 0, 0, 0); } }
        if (s0 + CH < 32) {
#pragma unroll
            for (int g = 0; g < NG; ++g)
#pragma unroll
                for (int c = 0; c < CH; ++c) { ch0[g][c] = nh0[g][c]; ch1[g][c] = nh1[g][c]; cd[g][c] = nd[g][c]; }
        }
    }
#pragma unroll
    for (int g = 0; g < NG; ++g) {
        float sg = ss[g]; sg += lane_xor<16>(sg); sg += lane_xor<32>(sg);
        const float rstd2 = rsqrtf(sg * (1.0f / D) + EPS);
        float gl[4];
#pragma unroll
        for (int q = 0; q < 4; ++q) gl[q] = __int_as_float(__builtin_amdgcn_ds_bpermute(fr << 2, __float_as_int(acc1[g][q]))) * rstd2 + rgb[q];
        int gsel = 0; float gmax = gl[0];
#pragma unroll
        for (int q = 1; q < 4; ++q) if (gl[q] > gmax) { gmax = gl[q]; gsel = q; }
        float gsum = 0.f;
#pragma unroll
        for (int q = 0; q < 4; ++q) gsum += __expf(gl[q] - gmax);
        const float gwt = 1.0f / gsum;
        if (fq == gsel) {
            float el[4];
#pragma unroll
            for (int e = 0; e < 4; ++e) el[e] = acc0[g][e] * rstd2 + reb[gsel * 4 + e];
            int t1 = 0; float l1 = el[0];
#pragma unroll
            for (int e = 1; e < 4; ++e) if (el[e] > l1) { l1 = el[e]; t1 = e; }
            int t2 = -1; float l2 = -3.0e38f;
#pragma unroll
            for (int e = 0; e < 4; ++e) if (e != t1 && el[e] > l2) { l2 = el[e]; t2 = e; }
            const float w1 = 1.0f / (1.0f + __expf(l2 - l1)), w2 = 1.0f - w1;
            const int ea = min(t1, t2), eb = max(t1, t2); const float cA = gwt * (t1 == ea ? w1 : w2), cB = gwt * (t1 == ea ? w2 : w1);
            const int pr = ea == 0 ? eb - 1 : (ea == 1 ? eb + 1 : 5); int cls = gsel * 6 + pr; if (!(cls >= 0 && cls < NCLS)) cls = 0;
            const int rank = __hip_atomic_fetch_add(&lcnt[cls], 1, __ATOMIC_RELAXED, __HIP_MEMORY_SCOPE_WORKGROUP); const int rr = grpv[g] * 16 + fr;
            rec[rr * 5] = cls; rec[rr * 5 + 1] = rank; rec[rr * 5 + 2] = __float_as_int(cA); rec[rr * 5 + 3] = __float_as_int(cB); rec[rr * 5 + 4] = __float_as_int(rstd2);
        }
    }
}
__device__ __forceinline__ void phase_E1(Frame& F, int l) {
    LAS bf16* Rhi = (LAS bf16*)F.lds; LAS bf16* Rlo = Rhi + 20 * RPITCH;
    LAS int* rec = (LAS int*)(F.lds + 83968);
    LAS int* lcnt = (LAS int*)(F.lds + LC_CNT); LAS int* wgb = (LAS int*)(F.lds + LC_BASE);
    const float* rg = (const float*)(WSP() + WS_RG);
    const float* reb = INP(I_REB) + l * 16; const float* rgb = INP(I_RGB) + l * 4;
    unsigned* gcnt = (unsigned*)(WSP() + WS_CTL) + CW_GCNT + l * 64; int* route = (int*)(WSP() + WS_ROUTE);
    const int tid = F.tid, lane = F.lane, wave = F.wave, fr = lane & 15, fq = lane >> 4;
    { f32x4 rv[10];
#pragma unroll
      for (int j = 0; j < 10; ++j) rv[j] = *(const f32x4*)(rg + 4 * (tid + 512 * j));
#pragma unroll
      for (int j = 0; j < 10; ++j) { const int i = 4 * (tid + 512 * j), c = i >> 10, k = i & 1023; u32x2 hw, lw; float hf[4];
#pragma unroll
          for (int e = 0; e < 4; ++e) hf[e] = __builtin_bit_cast(float, (pk2(rv[j][e], 0.f) & 0xffffu) << 16);
          hw.x = pk2(rv[j][0], rv[j][1]); hw.y = pk2(rv[j][2], rv[j][3]); lw.x = pk2(rv[j][0] - hf[0], rv[j][1] - hf[1]); lw.y = pk2(rv[j][2] - hf[2], rv[j][3] - hf[3]);
          *(LAS u32x2*)(Rhi + c * RPITCH + k) = hw; *(LAS u32x2*)(Rlo + c * RPITCH + k) = lw; } }
    { int* TOK = (int*)(WSP() + WS_TOK);
#pragma unroll 1
      for (int p = F.vcu * 512 + tid; p < NPOSMAX; p += F.G * 512) TOK[p] = -1; }
#pragma unroll 1
    for (int wg = F.vcu; wg < 256; wg += F.G) {
        if (tid < NCLS) lcnt[tid] = 0;
        __syncthreads();
        const int ngrp = wg == 0 ? 9 : 8;
        if (wg == 0 && wave == 0) { const int rows2[2] = {fr, TX + fr}; const int grps2[2] = {0, 8}; e1_groups<2, 2>(F, l, rows2, grps2, Rhi, Rlo, rec, lcnt, reb, rgb, fr, fq); }
        else { const int rows1[1] = {wg * 128 + wave * 16 + fr}; const int grps1[1] = {wave}; e1_groups<1, 4>(F, l, rows1, grps1, Rhi, Rlo, rec, lcnt, reb, rgb, fr, fq); }
        __syncthreads();
        if (tid < NCLS) { const int n = lcnt[tid]; wgb[tid] = n > 0 ? (int)atomicAdd(gcnt + tid, (unsigned)n) : 0; }
        __syncthreads();
        const int nrw = ngrp * 16;
        for (int rr = tid; rr < nrw; rr += 512) { const int row = rr < 128 ? wg * 128 + rr : TX + (rr - 128); const int cls = rec[rr * 5];
            int* rp = route + (size_t)row * 8; rp[0] = cls; rp[1] = wgb[cls] + rec[rr * 5 + 1]; rp[2] = rec[rr * 5 + 2]; rp[3] = rec[rr * 5 + 3]; rp[4] = rec[rr * 5 + 4]; }
        __syncthreads();
    }
}
__device__ __forceinline__ void phase_E1b(Frame& F, int l) {
    class_tables(F, l);
    const LAS int* base = (const LAS int*)(F.lds + LC_BASE);
    const int* route = (const int*)(WSP() + WS_ROUTE); int* TOK = (int*)(WSP() + WS_TOK); float* PW = (float*)(WSP() + WS_PW);
#pragma unroll 1
    for (int row = F.vcu * 512 + F.tid; row < TR; row += F.G * 512) { const int* rp = route + (size_t)row * 8; const int pos = base[rp[0]] + rp[1];
        if (pos < 0 || pos >= NPOSMAX) continue;
        TOK[pos] = row; f32x4 w; w[0] = __int_as_float(rp[4]); w[1] = __int_as_float(rp[2]); w[2] = __int_as_float(rp[3]); w[3] = 0.f; *(f32x4*)(PW + (size_t)pos * 4) = w; }
}
__device__ __forceinline__ void phase_E4(Frame& F, int l) {
    class_tables(F, l);
    const LAS int* base = (const LAS int*)(F.lds + LC_BASE);
    const int* route = (const int*)(WSP() + WS_ROUTE); float* H = (float*)(WSP() + WS_H); bf16* HB = (bf16*)(WSP() + WS_HB); const bf16* Y = (const bf16*)(WSP() + WS_Y);
    float* rstd1 = (float*)(WSP() + WS_RSTD1); const float* fg = INP(I_FG); float* out = (float*)DOP(); const bf16* DL = (const bf16*)(WSP() + WS_X3);
    const int gw = F.vcu * NWAVES + F.wave, NGW = F.G * NWAVES, lane = F.lane; const bool lastl = (l == DEPTH - 1);
    constexpr int R = 4;
#pragma unroll 1
    for (int row0 = gw; row0 < TR; row0 += R * NGW) {
        int rowv[R], pos[R];
#pragma unroll
        for (int r = 0; r < R; ++r) { const int row = row0 + r * NGW; rowv[r] = row < TR ? row : TR - 1; const int* rp = route + (size_t)rowv[r] * 8; int p = base[rp[0]] + rp[1]; if (p < 0 || p >= NPOSMAX) p = 0; pos[r] = p; }
        u32x4 yw[R][2], dw[R][2]; f32x4 hv[R][2][2];
#pragma unroll
        for (int r = 0; r < R; ++r)
#pragma unroll
            for (int j = 0; j < 2; ++j) { yw[r][j] = *(const u32x4*)(Y + (size_t)pos[r] * D + 8 * lane + 512 * j);
                const float* hs = l == 0 ? (rowv[r] < TX ? INP(I_X) + (size_t)rowv[r] * D : INP(I_META) + (size_t)(rowv[r] - TX) * D) : H + (size_t)rowv[r] * D;
                hv[r][j][0] = *(const f32x4*)(hs + 8 * lane + 512 * j); hv[r][j][1] = *(const f32x4*)(hs + 8 * lane + 512 * j + 4); dw[r][j] = *(const u32x4*)(DL + (size_t)rowv[r] * D + 8 * lane + 512 * j); }
#pragma unroll
        for (int r = 0; r < R; ++r) { const int row = row0 + r * NGW; float ss = 0.f;
#pragma unroll
            for (int j = 0; j < 2; ++j) { const u32x4 w = yw[r][j], d4 = dw[r][j];
                hv[r][j][0][0] += bflo(d4.x); hv[r][j][0][1] += bfhi(d4.x); hv[r][j][0][2] += bflo(d4.y); hv[r][j][0][3] += bfhi(d4.y); hv[r][j][1][0] += bflo(d4.z); hv[r][j][1][1] += bfhi(d4.z); hv[r][j][1][2] += bflo(d4.w); hv[r][j][1][3] += bfhi(d4.w);
                hv[r][j][0][0] += bflo(w.x); hv[r][j][0][1] += bfhi(w.x); hv[r][j][0][2] += bflo(w.y); hv[r][j][0][3] += bfhi(w.y);
                hv[r][j][1][0] += bflo(w.z); hv[r][j][1][1] += bfhi(w.z); hv[r][j][1][2] += bflo(w.w); hv[r][j][1][3] += bfhi(w.w);
#pragma unroll
                for (int q = 0; q < 2; ++q) ss += hv[r][j][q][0] * hv[r][j][q][0] + hv[r][j][q][1] * hv[r][j][q][1] + hv[r][j][q][2] * hv[r][j][q][2] + hv[r][j][q][3] * hv[r][j][q][3]; }
            const float rs = rsqrtf(wave_sum(ss) * (1.0f / D) + EPS);
            if (row < TR) {
                if (!lastl) {
#pragma unroll
                    for (int j = 0; j < 2; ++j) { *(f32x4*)(H + (size_t)row * D + 8 * lane + 512 * j) = hv[r][j][0]; *(f32x4*)(H + (size_t)row * D + 8 * lane + 512 * j + 4) = hv[r][j][1];
                        *(u32x4*)(HB + (size_t)row * D + 8 * lane + 512 * j) = pack8(hv[r][j][0], hv[r][j][1]); }
                    if (lane == 0) rstd1[row] = rs;
                } else if (row < TX) {
#pragma unroll
                    for (int j = 0; j < 2; ++j) { const f32x4 g0 = *(const f32x4*)(fg + 8 * lane + 512 * j), g1 = *(const f32x4*)(fg + 8 * lane + 512 * j + 4);
                        *(f32x4*)(out + (size_t)row * D + 8 * lane + 512 * j) = hv[r][j][0] * rs * g0; *(f32x4*)(out + (size_t)row * D + 8 * lane + 512 * j + 4) = hv[r][j][1] * rs * g1; }
                }
            }
        }
    }
}
#define RELANE() do { const int t_ = wv0 * 64 + lane_id_opaque(); F.tid = t_; F.lane = t_ & 63; F.wave = __builtin_amdgcn_readfirstlane(t_ >> 6); \
    int g_ = gridDim.x; LAUNDER_S(g_); int b_ = blockIdx.x; LAUNDER_S(b_); F.G = g_; F.bx = b_; F.vcu = (g_ % 8 == 0) ? (b_ % 8) * (g_ / 8) + b_ / 8 : b_; ll = l; LAUNDER_S(ll); } while (0)
__global__ void __launch_bounds__(NWAVES * 64, 2) fwd_kernel(Params P) {
    extern __shared__ __attribute__((aligned(16))) unsigned char lds_raw[];
    Frame F;
    F.lds = (LAS unsigned char*)lds_raw;
    F.tid = threadIdx.x; F.lane = F.tid & 63; F.wave = __builtin_amdgcn_readfirstlane(F.tid >> 6);
    F.G = gridDim.x; { const int bx = blockIdx.x; F.vcu = (F.G % 8 == 0) ? (bx % 8) * (F.G / 8) + bx / 8 : bx; }
    if (F.tid == 0) { LAS unsigned long long* pt = (LAS unsigned long long*)(F.lds + LC_PTAB);
#pragma unroll
        for (int i = 0; i < 25; ++i) pt[i] = (unsigned long long)P.in[i];
        pt[25] = (unsigned long long)P.ws; pt[26] = (unsigned long long)P.out; }
    for (int u = F.tid; u < 256; u += NWAVES * 64) ((LAS unsigned*)(F.lds + RING_BYTES))[u] = 0u;
    __syncthreads();
    const int lo = P.ph_lo, hi = P.ph_hi;
    const bool use_bar = (hi - lo) > 1;
    unsigned* barw = (unsigned*)(P.ws + WS_CTL) + CW_BAR;
    XcdBarrier bar; bar.bar = barw; bar.x = 0; bar.st = (volatile LAS unsigned*)(F.lds + LC_BAR);
    if (use_bar) bar = xcd_barrier_post(barw, (volatile LAS unsigned*)(F.lds + LC_BAR));
#ifndef PHASE_MASK
#define PHASE_MASK 0xfff
#endif
#define EN(j) (((PHASE_MASK) >> (j)) & 1)
#ifndef DUP_MASK
#define DUP_MASK 0
#endif
#define NREP(j) ((((DUP_MASK) >> (j)) & 1) ? 2 : 1)
#define IN(k) (lo <= (k) && (k) < hi)
#define SEAM(k) do { if (IN(k) && IN((k) + 1)) xcd_barrier(bar); } while (0)

    int l = 0, ll = 0; const int wv0 = __builtin_amdgcn_readfirstlane((int)threadIdx.x >> 6);
    if (EN(0) && IN(0)) { RELANE(); convert_weights(F, 0); RELANE(); init_rows(F); }
    SEAM(0);
    for (l = 0; l < DEPTH; ++l) {
        const int pb = 1 + 11 * l;
        for (int rep = 0; rep < NREP(1); ++rep)
        if (EN(1) && IN(pb + 0)) {
            RELANE();
            unsigned char* wsl = WSP(); unsigned char* dol = DOP();
            pg8::Gemm g{(const bf16*)(wsl + WS_HB), 1024, 1024, 1 << 20};
            pg8::StaticOrder S; S.init(TX, N1, F.G, F.bx, (const bf16*)(wsl + WS_W1T), 1024);
            Epi1 E{(const float*)(wsl + WS_RSTD1), (bf16*)(wsl + WS_A), (bf16*)(wsl + WS_GLU), (bf16*)(dol + DO_Q), (bf16*)(wsl + WS_G)};
            pg8::gemm_phase<Epi1, pg8::StaticOrder>(F.lds, g, S, E, F.wave);
            if (F.bx >= 128 && F.bx < 128 + 21 && F.wave < 4) {
                const int pn = F.bx - 128, l2 = lane_id_opaque(); AccT acc; skinny_zero(acc);
                skinny_k<true>(acc, (const bf16*)(wsl + WS_HB) + (size_t)TX * 1024, 1024, (const bf16*)(wsl + WS_W1T) + (size_t)pn * 256 * 1024, 1024, 1024, F.wave, l2 & 15, l2 >> 4);
                E.run<true>(acc, pg8::Unit{128, pn, 0}, 0, F.wave, l2 & 15, l2 >> 4);
            }
        }
        SEAM(pb + 0);
        for (int rep = 0; rep < NREP(2); ++rep)
        if (EN(2) && IN(pb + 1)) { RELANE(); phase_S(F, ll); }
        SEAM(pb + 1);
        if (EN(3) && IN(pb + 2)) { RELANE(); phase_scan(F); }
        SEAM(pb + 2);
        for (int rep = 0; rep < NREP(3); ++rep)
        if (EN(4) && IN(pb + 3)) { RELANE(); phase_B(F, ll); }
        SEAM(pb + 3);
        for (int rep = 0; rep < NREP(4); ++rep)
        if (EN(5) && IN(pb + 4)) {
            RELANE(); unsigned char* wsl = WSP(); unsigned char* dol = DOP();
            pg8::Gemm g{(const bf16*)(wsl + WS_X3), 1024, 1024, 1 << 20}; pg8::SegOrder S; S.init(TX, 1024, F.G, F.bx, (const bf16*)(wsl + WS_W3CT), 1024);
            EpiCS E{(const bf16*)(wsl + WS_G), (bf16*)(dol + DO_MERGED), (const float*)(wsl + WS_BIASA)}; pg8::gemm_phase<EpiCS, pg8::SegOrder>(F.lds, g, S, E, F.wave);
            if (F.bx >= 16 && F.bx < 20 && F.wave < 4) {
                const int pn = F.bx - 16, l2 = lane_id_opaque(); AccT acc; skinny_zero(acc);
#pragma unroll 1
                for (int seg = 0; seg < 3; ++seg) { const size_t ko = seg == 0 ? 0 : (seg == 1 ? 256 : 512);
                    skinny_k<true>(acc, (const bf16*)(wsl + WS_X3) + (size_t)TX * 1024 + ko, 1024, (const bf16*)(wsl + WS_W3CT) + (size_t)pn * 256 * 1024 + ko, 1024, seg == 2 ? 512 : 256, F.wave, l2 & 15, l2 >> 4);
                    E.run<true>(acc, pg8::Unit{128, pn, seg}, 0, F.wave, l2 & 15, l2 >> 4); }
            }
        }
        SEAM(pb + 4);
        if (EN(6) && IN(pb + 5)) {
            RELANE();
            unsigned char* wsl = WSP(); unsigned char* dol = DOP();
            pg8::Gemm g{(const bf16*)(dol + DO_MERGED), 1024, 1024, 1 << 20}; pg8::StaticOrder S; S.init(TX, 1024, F.G, F.bx, (const bf16*)(wsl + WS_WOT), 1024);
            EpiB2 E{(bf16*)(wsl + WS_X3)}; pg8::gemm_phase<EpiB2, pg8::StaticOrder>(F.lds, g, S, E, F.wave);
            if (F.bx >= 16 && F.bx < 20 && F.wave < 4) {
                const int pn = F.bx - 16, l2 = lane_id_opaque(); AccT acc; skinny_zero(acc);
                skinny_k<true>(acc, (const bf16*)(dol + DO_MERGED) + (size_t)TX * 1024, 1024, (const bf16*)(wsl + WS_WOT) + (size_t)pn * 256 * 1024, 1024, 1024, F.wave, l2 & 15, l2 >> 4);
                E.run<true>(acc, pg8::Unit{128, pn, 0}, 0, F.wave, l2 & 15, l2 >> 4);
            }
        }
        SEAM(pb + 5);
        if (EN(7) && IN(pb + 6)) { RELANE(); phase_E1(F, ll); }
        SEAM(pb + 6);
        for (int rep = 0; rep < NREP(7); ++rep)
        if (EN(8) && IN(pb + 7)) { RELANE(); phase_E1b(F, ll); }
        SEAM(pb + 7);
        for (int rep = 0; rep < NREP(8); ++rep)
        if (EN(9) && IN(pb + 8)) {
            RELANE(); class_tables(F, ll);
            unsigned char* wsl = WSP();
            const int NP = __builtin_amdgcn_readfirstlane(*(const LAS int*)(F.lds + LC_NP));
            pg8::Gemm g{(const bf16*)(wsl + WS_XS), 1024, 1024, 1 << 20};
            { const int* TOK = (const int*)(wsl + WS_TOK); LAS int* tl = (LAS int*)(F.lds + LC_TOK);
#pragma unroll 1
              for (int i = F.tid; i < 1024; i += 512) { const long L = (long)(i >> 8) * F.G + F.vcu; int tk = 0; if (L < (long)NP * 4) { tk = TOK[(int)(L >> 2) * 256 + (i & 255)]; if (tk < 0 || tk >= TR) tk = 0; } tl[i] = tk; }
              __syncthreads(); }
            pg8::Gemm g2{(const bf16*)(wsl + WS_HB), 1024, 1024, 1 << 20};
            MoeOrderT<true> S{(const LAS int*)(F.lds + LC_TOK), NP, F.G, F.vcu, 0, (const LAS int*)(F.lds + LC_PCLS), (const bf16*)(DOP() + DO_W13T)};
            EpiA2 E{(const float*)(wsl + WS_PW), (bf16*)(wsl + WS_HH)}; pg8::gemm_phase<EpiA2, MoeOrderT<true>>(F.lds, g2, S, E, F.wave);
        }
        SEAM(pb + 8);
        for (int rep = 0; rep < NREP(9); ++rep)
        if (EN(10) && IN(pb + 9)) {
            RELANE(); class_tables(F, ll);
            unsigned char* wsl = WSP();
            const int NP = __builtin_amdgcn_readfirstlane(*(const LAS int*)(F.lds + LC_NP));
            pg8::Gemm g{(const bf16*)(wsl + WS_HH), 512, 256, 4};
            MoeOrderT<false> S{nullptr, NP, F.G, F.vcu, 1, (const LAS int*)(F.lds + LC_PCLS), (const bf16*)(DOP() + DO_W2T)};
            EpiB2 E{(bf16*)(wsl + WS_Y)}; pg8::gemm_phase<EpiB2, MoeOrderT<false>>(F.lds, g, S, E, F.wave);
        }
        SEAM(pb + 9);
        if (EN(11) && IN(pb + 10)) { RELANE(); phase_E4(F, ll); if (l + 1 < DEPTH) { RELANE(); convert_weights(F, ll + 1); } }
        SEAM(pb + 10);
    }
#undef IN
#undef SEAM
}

constexpr int N_PHASES = 1 + 11 * DEPTH;

extern "C" void kernel_launch(void* const* d_in, const int* in_sizes, int n_in, void* d_out, int out_size, void* d_ws, size_t ws_size, hipStream_t stream) {
    static int grid = 0;
    if (grid == 0) {
        if (n_in != 25 || out_size != TX * D || ws_size < WS_END) { fprintf(stderr, "kernel_launch: unexpected shapes: n_in %d out %d ws %zu (need %zu)\n", n_in, out_size, ws_size, (size_t)WS_END); grid = -1; return; }
        int dev = 0, cus = 0, per_cu = 0;
        if (hipGetDevice(&dev) != hipSuccess || hipDeviceGetAttribute(&cus, hipDeviceAttributeMultiprocessorCount, dev) != hipSuccess) { grid = -1; return; }
        if (hipFuncSetAttribute((const void*)fwd_kernel, hipFuncAttributeMaxDynamicSharedMemorySize, LDS_BYTES) != hipSuccess) { fprintf(stderr, "kernel_launch: hipFuncSetAttribute failed\n"); grid = -1; return; }
        if (hipOccupancyMaxActiveBlocksPerMultiprocessor(&per_cu, (const void*)fwd_kernel, NWAVES * 64, LDS_BYTES) != hipSuccess || per_cu < 1) fprintf(stderr, "kernel_launch: occupancy query reports %d\n", per_cu);
        (void)hipGetLastError();
        grid = cus;
    }
    if (grid < 0) return;
    (void)hipMemsetAsync((char*)d_ws + WS_CTL, 0, CTL_BYTES, stream);
    Params p{};
    for (int i = 0; i < 25; ++i) p.in[i] = (const float*)d_in[i];
    p.out = (float*)d_out; p.ws = (unsigned char*)d_ws;
#if N_LAUNCH_MODE == 1
    p.ph_lo = 0; p.ph_hi = N_PHASES;
    hipLaunchKernelGGL(fwd_kernel, dim3(grid), dim3(NWAVES * 64), LDS_BYTES, stream, p);
#else
    for (int ph = 0; ph < N_PHASES; ++ph) { p.ph_lo = ph; p.ph_hi = ph + 1; hipLaunchKernelGGL(fwd_kernel, dim3(grid), dim3(NWAVES * 64), LDS_BYTES, stream, p); }
#endif
}
```

```cpp
#include <hip/hip_runtime.h>
#include <cstdio>
#include <cstdint>

#ifndef N_LAUNCH_MODE
#define N_LAUNCH_MODE 1
#endif

#define GAS __attribute__((address_space(1)))
#define LAS __attribute__((address_space(3)))
typedef unsigned short bf16;
typedef float f32x4 __attribute__((ext_vector_type(4)));
typedef float f32x2 __attribute__((ext_vector_type(2)));
typedef unsigned u32x4 __attribute__((ext_vector_type(4)));
typedef unsigned u32x2 __attribute__((ext_vector_type(2)));
typedef short bf16x8 __attribute__((ext_vector_type(8)));
typedef __bf16 bf16x2v __attribute__((ext_vector_type(2)));

constexpr int D = 1024, NB = 4, SEQ = 8192, NMETA = 16, DEPTH = 2;
constexpr int TX = NB * SEQ;
constexpr int TM = TX + 64;
constexpr int TR = TX + NMETA;
constexpr int NIN = 5384, N1 = 5376;
constexpr int NHEAD = 8;
constexpr int NCLS = 24;
constexpr int NPOSMAX = TX + 256 + NCLS * 256;
constexpr float EPS = 1e-6f;
constexpr float LOG2E = 1.4426950408889634f;
constexpr float C2 = 0.125f * LOG2E;
constexpr int NWAVES = 8;

constexpr size_t U = (size_t)TM * 1024 * 2;
constexpr size_t WS_CTL = 0, CTL_BYTES = 1u << 20;
constexpr size_t WS_H = CTL_BYTES;
constexpr size_t WS_HB = WS_H + 2 * U;
constexpr size_t WS_G = WS_HB + U;
constexpr size_t WS_XS = WS_G;
constexpr size_t WS_Y = WS_XS + (size_t)NPOSMAX * 2048;
constexpr size_t WS_HH = WS_Y + (size_t)NPOSMAX * 2048;
static_assert(WS_HH + (size_t)NPOSMAX * 1024 <= WS_G + (size_t)3 * 129 * 4 * 65536 * 2, "MoE overlay fits the gates region");
constexpr size_t GT_TILE = 65536;
constexpr size_t WS_A = WS_G + (size_t)3 * 129 * 4 * GT_TILE * 2;
constexpr size_t WS_GLU = WS_A + U / 4;
constexpr size_t WS_X3 = WS_GLU + U / 4;
constexpr size_t WS_W1T = WS_X3 + U;
constexpr size_t WS_W3CT = WS_W1T + (size_t)N1 * 1024 * 2;
constexpr size_t WS_WOT = WS_W3CT + 1024 * 1024 * 2;
constexpr size_t WS_WFG = WS_WOT + 1024 * 1024 * 2;
constexpr size_t WS_RG = WS_WFG + 8 * 1024 * 4;
constexpr size_t WS_BIASA = WS_RG + 20 * 1024 * 4;
constexpr size_t WS_RSTD1 = WS_BIASA + 4096;
constexpr size_t WS_ROUTE = WS_RSTD1 + (size_t)TM * 4;
constexpr size_t WS_PW = WS_ROUTE + (size_t)TM * 32;
constexpr size_t WS_LFT = WS_PW + (size_t)NPOSMAX * 16;
constexpr size_t WS_LFTM = WS_LFT + (size_t)32 * 8192 * 4;
constexpr size_t WS_TOK = WS_LFTM + 8 * 256 * 4;
constexpr size_t WS_FL = WS_TOK + (size_t)NPOSMAX * 4;
constexpr int FLN = 64 + SEQ;
constexpr size_t WS_END = WS_FL + (size_t)32 * FLN * 4;
static_assert(WS_END <= (size_t)512 * 1024 * 1024, "d_ws map fits 512 MiB");
constexpr size_t DO_Q = 0, DO_K = U / 2, DO_V = U, DO_MERGED = U / 2;
constexpr size_t DO_W13T = 3 * U / 2;
constexpr size_t DO_W2T = DO_W13T + (size_t)16 * 512 * 1024 * 2;
static_assert(DO_W2T + (size_t)16 * 1024 * 256 * 2 <= (size_t)TX * 1024 * 4, "d_out scratch");
constexpr int CW_BAR = 4096, CW_GCNT = 16384, CW_NRM = 20480  , CW_AQ = 24576  ;

constexpr int RPITCH = 1032;
constexpr int RING_BYTES = 131072;
constexpr int LC_BAR = RING_BYTES, LC_CNT = RING_BYTES + 64, LC_BASE = RING_BYTES + 192, LC_PCLS = RING_BYTES + 320, LC_NP = RING_BYTES + 960;
constexpr int LC_QS = RING_BYTES + 976;
constexpr int LC_TOK = RING_BYTES + 2048;
constexpr int LC_NMX = RING_BYTES + 1280;
constexpr int LC_PTAB = RING_BYTES + 1024;
constexpr int LDS_BYTES = RING_BYTES + 1024 + 7168;

#define LDS_WAIT() asm volatile("s_waitcnt lgkmcnt(0)" ::: "memory")
#define VM_WAIT() asm volatile("s_waitcnt vmcnt(0)" ::: "memory")
#define LAUNDER_S(p) asm volatile("" : "+s"(p))
#define LAUNDER_V(x) asm volatile("" : "+v"(x))
__device__ __forceinline__ int lane_id_opaque() { int x; asm volatile("v_mbcnt_lo_u32_b32 %0, -1, 0\n\tv_mbcnt_hi_u32_b32 %0, -1, %0" : "=v"(x)); return x; }

__device__ __forceinline__ unsigned f2bf(float f) { unsigned u = __builtin_bit_cast(unsigned, f); return (u + 0x7fffu + ((u >> 16) & 1u)) >> 16; }
__device__ __forceinline__ unsigned pk2(float lo, float hi) { f32x2 v = {lo, hi}; bf16x2v b = __builtin_convertvector(v, bf16x2v); return __builtin_bit_cast(unsigned, b); }
__device__ __forceinline__ float bflo(unsigned w) { return __builtin_bit_cast(float, w << 16); }
__device__ __forceinline__ float bfhi(unsigned w) { return __builtin_bit_cast(float, w & 0xffff0000u); }
template <int O> __device__ __forceinline__ float lane_xor(float v) {
    if constexpr (O < 32) return __int_as_float(__builtin_amdgcn_ds_swizzle(__float_as_int(v), (O << 10) | 0x1f));
    else { auto rr = __builtin_amdgcn_permlane32_swap(__float_as_uint(v), __float_as_uint(v), false, false); return __uint_as_float(rr[0]) + __uint_as_float(rr[1]) - v; }
}
__device__ __forceinline__ float wave_sum(float v) {
    v += lane_xor<1>(v); v += lane_xor<2>(v); v += lane_xor<4>(v); v += lane_xor<8>(v); v += lane_xor<16>(v);
    auto rr = __builtin_amdgcn_permlane32_swap(__float_as_uint(v), __float_as_uint(v), false, false);
    return __uint_as_float(rr[0]) + __uint_as_float(rr[1]);
}
__device__ __forceinline__ float sigmoidf_(float x) { return __builtin_amdgcn_rcpf(1.0f + __builtin_amdgcn_exp2f(-LOG2E * x)); }
__device__ __forceinline__ float dot2bf(unsigned a, unsigned b, float acc) { return __builtin_amdgcn_fdot2_f32_bf16(__builtin_bit_cast(bf16x2v, a), __builtin_bit_cast(bf16x2v, b), acc, false); }

namespace pg8 {
constexpr int BM = 256, BK = 64, HALF = 128, HTB = HALF * BK * 2, STAGE_BYTES = 8 * HTB, NXCD = 8, WGM = 8;
__host__ __device__ __forceinline__ int lds_byte(int r, int c) { const int st = (r >> 4) * 2 + (c >> 5), rr = r & 15, cc = c & 31, ob = rr * 64 + cc * 2; return st * 1024 + (ob ^ (((ob >> 9) & 1) << 5)); }
__host__ __device__ __forceinline__ void stage_rc(int b, int& R, int& C) { const int st = b / 1024, sb = b % 1024, swz = sb ^ (((sb >> 9) & 1) << 5); R = (st >> 1) * 16 + swz / 64; C = (st & 1) * 32 + (swz % 64) / 2; }
__host__ __device__ __forceinline__ int perm32(int rho) { const int n = rho >> 4, i = rho & 15; return 8 * (i >> 2) + 4 * n + (i & 3); }

struct Unit { int pm, pn, seg; };
struct Gemm { const bf16* A; int K; int ldb; int ksplit; };

struct StaticOrder {
    static constexpr bool GATHER = false; const LAS int* tokl = nullptr;
    int nM, nN, nwg, G, c; const bf16* Bt; size_t btile;
    __device__ void init(int M, int N, int G_, int c_, const bf16* Bt_, int ldb) { nM = M / BM; nN = N / BM; nwg = nM * nN; G = G_; c = c_; Bt = Bt_; btile = (size_t)BM * ldb * 2; }
    __device__ bool next(int i, Unit& u) const {
        const long L = (long)i * G + c; if (L >= nwg) return false;
        int wgid = (int)L; { const int q = nwg / NXCD, r = nwg % NXCD, xcd = wgid % NXCD, off = wgid / NXCD; wgid = (xcd < r ? xcd * (q + 1) : r * (q + 1) + (xcd - r) * q) + off; }
        const int nig = WGM * nN, gid = wgid / nig, fm = gid * WGM, gsz = (nM - fm) < WGM ? (nM - fm) : WGM;
        u.pm = fm + ((wgid % nig) % gsz); u.pn = (wgid % nig) / gsz; u.seg = 0; return true;
    }
    __device__ __forceinline__ const char* bptr(const Unit& u, int) const { return (const char*)Bt + (size_t)u.pn * btile; }
    __device__ __forceinline__ int nt(const Unit&, int ntd) const { return ntd; }
    __device__ __forceinline__ size_t aoff(const Unit&) const { return 0; }
};
struct SegOrder : StaticOrder {
    __device__ bool next(int i, Unit& u) const { const int q = i / 3; if (!StaticOrder::next(q, u)) return false; u.seg = i - 3 * q; return true; }
    __device__ __forceinline__ size_t koff(const Unit& u) const { return u.seg == 0 ? 0 : (u.seg == 1 ? 512 : 1024); }
    __device__ __forceinline__ const char* bptr(const Unit& u, int) const { return (const char*)Bt + (size_t)u.pn * btile + koff(u); }
    __device__ __forceinline__ int nt(const Unit& u, int) const { return u.seg == 2 ? 8 : 4; }
    __device__ __forceinline__ size_t aoff(const Unit& u) const { return koff(u); }
};

template <class Epi, class Sched, bool ALIGN_EPI = true, bool SP2 = true>
__device__ __forceinline__ void gemm_phase(LAS unsigned char* lds, const Gemm g, const Sched& S, const Epi& E, const int wave_id) {
    const int tid = wave_id * 64 + lane_id_opaque();
    const int wid = __builtin_amdgcn_readfirstlane(tid >> 6), lane = tid & 63, wr = wid >> 2, wc = wid & 3, fr = lane & 15, fq = lane >> 4;
    const int K = g.K, nt = K / BK, ldb = g.ldb, ks = g.ksplit;
    unsigned voffA[2], voffB[2];
#pragma unroll
    for (int i = 0; i < 2; ++i) { int R, C; stage_rc(tid * 16 + i * 8192, R, C); const int Rb = Epi::PERM ? ((R & ~31) + perm32(R & 31)) : R;
        voffA[i] = (unsigned)(R * K + C) * 2u; voffB[i] = (unsigned)(Rb * ldb + C) * 2u; }
    constexpr bool GATHER = Sched::GATHER;
    unsigned vC0[2], vC1[2];
    const size_t kstep = (size_t)(BK * 2);
    const size_t hstep = (size_t)HALF * K * 2;
    const size_t hstepB = (size_t)HALF * ldb * 2;
    const size_t tstep = 2 * hstep;
#define PG8_GOFF(ui_) do { _Pragma("unroll") for (int _i = 0; _i < 2; ++_i) { const int R_ = (int)(voffA[_i] >> 11); const unsigned C_ = voffA[_i] & 2047u; \
        vC0[_i] = (unsigned)S.tokl[(ui_) * 256 + R_] * 2048u + C_; vC1[_i] = (unsigned)S.tokl[(ui_) * 256 + 128 + R_] * 2048u + C_; } } while (0)
    const unsigned ldsw = (unsigned)wid * 1024u;
    const int aoff = lds_byte(wr * 64 + fr, fq * 8), boff = lds_byte(wc * 32 + fr, fq * 8);
#define PG8_SA(b, h) (((b) * 2 + (h)) * HTB)
#define PG8_SB(b, h) ((4 + (b) * 2 + (h)) * HTB)
#define PG8_STAGE(bufoff, gbase, voff) do { _Pragma("unroll") for (int _i = 0; _i < 2; ++_i) \
        __builtin_amdgcn_global_load_lds((const unsigned*)((const char*)(gbase) + (voff)[_i]), (LAS unsigned*)(lds + (bufoff) + ldsw + _i * 8192), 16, 0, 0); } while (0)
#define PG8_LDA(dst, b, h) do { _Pragma("unroll") for (int m = 0; m < 4; ++m) _Pragma("unroll") for (int k = 0; k < 2; ++k) dst[m][k] = *(const LAS bf16x8*)(lds + PG8_SA(b, h) + aoff + m * 2048 + k * 1024); } while (0)
#define PG8_LDB(dst, b, h) do { _Pragma("unroll") for (int n = 0; n < 2; ++n) _Pragma("unroll") for (int k = 0; k < 2; ++k) dst[n][k] = *(const LAS bf16x8*)(lds + PG8_SB(b, h) + boff + n * 2048 + k * 1024); } while (0)
#define PG8_MMA(ai, bj, At, Bt) do { __builtin_amdgcn_s_setprio(1); _Pragma("unroll") for (int m = 0; m < 4; ++m) _Pragma("unroll") for (int n = 0; n < 2; ++n) _Pragma("unroll") for (int k = 0; k < 2; ++k) \
        acc[ai][bj][m][n] = __builtin_amdgcn_mfma_f32_16x16x32_bf16(Bt[n][k], At[m][k], acc[ai][bj][m][n], 0, 0, 0); __builtin_amdgcn_s_setprio(0); } while (0)
#define PG8_WAIT_V(n) asm volatile("s_waitcnt vmcnt(" #n ")" ::: "memory")
#define PG8_WAIT_L(n) asm volatile("s_waitcnt lgkmcnt(" #n ")" ::: "memory")
#define PG8_BAR __builtin_amdgcn_s_barrier()
#define PG8_SCHED __builtin_amdgcn_sched_barrier(0)
    Unit cur, nxt; int ui = 0;
    if (!S.next(0, cur)) return;
    if constexpr (GATHER) { PG8_GOFF(0); } else { vC0[0] = voffA[0]; vC0[1] = voffA[1]; vC1[0] = voffA[0] + (unsigned)hstep; vC1[1] = voffA[1] + (unsigned)hstep; }
    f32x4 acc[2][2][4][2];
    { float z_ = 0.f; LAUNDER_V(z_);
#pragma unroll
    for (int a = 0; a < 2; ++a)
#pragma unroll
        for (int b = 0; b < 2; ++b)
#pragma unroll
            for (int m = 0; m < 4; ++m)
#pragma unroll
                for (int n = 0; n < 2; ++n) acc[a][b][m][n] = (f32x4){z_, z_, z_, z_}; }
    bf16x8 At[4][2], B0[2][2], B1[2][2];
    int ntc = S.nt(cur, nt);
    const char* cA = GATHER ? (const char*)g.A : (const char*)g.A + (size_t)cur.pm * tstep + S.aoff(cur); const char* cB = S.bptr(cur, 0); const char* cB1 = S.bptr(cur, 1) - (size_t)ks * kstep;
    if constexpr (SP2) {
        PG8_STAGE(PG8_SB(0, 0), cB, voffB); PG8_STAGE(PG8_SB(0, 1), cB + hstepB, voffB); PG8_STAGE(PG8_SA(0, 0), cA, vC0); PG8_STAGE(PG8_SA(0, 1), cA, vC1);
        if (wr == 1) PG8_BAR;
        PG8_WAIT_V(2); PG8_BAR;
        PG8_STAGE(PG8_SB(1, 0), cB + kstep, voffB); PG8_STAGE(PG8_SA(1, 0), cA + kstep, vC0); PG8_STAGE(PG8_SB(1, 1), cB + hstepB + kstep, voffB);
        PG8_WAIT_V(6); PG8_BAR;
    } else {
        PG8_STAGE(PG8_SB(0, 0), cB, voffB); PG8_STAGE(PG8_SA(0, 0), cA, vC0); PG8_STAGE(PG8_SB(0, 1), cB + hstepB, voffB); PG8_STAGE(PG8_SA(0, 1), cA, vC1);
        if (wr == 1) PG8_BAR;
        PG8_WAIT_V(4); PG8_BAR;
        PG8_STAGE(PG8_SB(1, 0), cB + kstep, voffB); PG8_STAGE(PG8_SA(1, 0), cA + kstep, vC0); PG8_STAGE(PG8_SB(1, 1), cB + hstepB + kstep, voffB);
        PG8_WAIT_V(6); PG8_BAR;
    }
    for (;;) {
        const bool has_next = S.next(ui + 1, nxt);
        const char* nA = GATHER ? (const char*)g.A : (has_next ? (const char*)g.A + (size_t)nxt.pm * tstep + S.aoff(nxt) : cA); const char* nB = has_next ? S.bptr(nxt, 0) : cB;
        const char* nB1 = has_next ? S.bptr(nxt, 1) - (size_t)ks * kstep : cB1;
#pragma unroll 1
        for (int t = 0; t < ntc; t += 2) {
            const bool last = (t == ntc - 2);
            const char* a1 = cA + (size_t)(t + 1) * kstep;
            const char* bside = (t + 2 < ks) ? cB : cB1;
            const char* a2 = last ? nA : cA + (size_t)(t + 2) * kstep; const char* b2 = last ? nB : bside + (size_t)(t + 2) * kstep;
            const char* a3 = a2 + kstep; const char* b3 = b2 + kstep;
            unsigned x0[2] = {vC0[0], vC0[1]}, x1[2] = {vC1[0], vC1[1]};
            if constexpr (GATHER) { if (last && has_next) { _Pragma("unroll") for (int _i = 0; _i < 2; ++_i) { const int R_ = (int)(voffA[_i] >> 11); const unsigned C_ = voffA[_i] & 2047u;
                x0[_i] = (unsigned)S.tokl[(ui + 1) * 256 + R_] * 2048u + C_; x1[_i] = (unsigned)S.tokl[(ui + 1) * 256 + 128 + R_] * 2048u + C_; } } }
            if constexpr (SP2) {
            PG8_LDB(B0, 0, 0); PG8_LDB(B1, 0, 1); PG8_SCHED; PG8_LDA(At, 0, 0); PG8_STAGE(PG8_SA(1, 1), a1, vC1);
            PG8_WAIT_V(8); PG8_WAIT_L(0); PG8_BAR; PG8_MMA(0, 0, At, B0); PG8_MMA(0, 1, At, B1); PG8_BAR; PG8_SCHED;
            PG8_LDA(At, 0, 1); PG8_STAGE(PG8_SB(0, 0), b2, voffB); PG8_STAGE(PG8_SB(0, 1), b2 + hstepB, voffB); PG8_STAGE(PG8_SA(0, 0), a2, x0);
            PG8_WAIT_V(8); PG8_WAIT_L(0); PG8_BAR; PG8_MMA(1, 0, At, B0); PG8_MMA(1, 1, At, B1); PG8_BAR; PG8_SCHED;
            PG8_LDB(B0, 1, 0); PG8_LDB(B1, 1, 1); PG8_SCHED; PG8_LDA(At, 1, 0); PG8_STAGE(PG8_SA(0, 1), a2, x1);
            PG8_WAIT_V(8); PG8_WAIT_L(0); PG8_BAR; PG8_MMA(0, 0, At, B0); PG8_MMA(0, 1, At, B1); PG8_BAR; PG8_SCHED;
            PG8_LDA(At, 1, 1); PG8_STAGE(PG8_SB(1, 0), b3, voffB); PG8_STAGE(PG8_SB(1, 1), b3 + hstepB, voffB); PG8_STAGE(PG8_SA(1, 0), a3, x0);
            PG8_WAIT_V(8); PG8_WAIT_L(0); PG8_BAR; PG8_MMA(1, 0, At, B0); PG8_MMA(1, 1, At, B1); PG8_BAR; PG8_SCHED;
            } else {
            PG8_LDB(B0, 0, 0); PG8_SCHED; PG8_LDA(At, 0, 0); PG8_STAGE(PG8_SA(1, 1), a1, vC1);
            PG8_WAIT_L(8); PG8_BAR; PG8_WAIT_L(0); PG8_MMA(0, 0, At, B0); PG8_BAR; PG8_SCHED;
            PG8_LDB(B1, 0, 1); PG8_STAGE(PG8_SB(0, 0), b2, voffB);
            PG8_BAR; PG8_WAIT_L(0); PG8_MMA(0, 1, At, B1); PG8_BAR;
            PG8_LDA(At, 0, 1); PG8_STAGE(PG8_SA(0, 0), a2, x0);
            PG8_BAR; PG8_WAIT_L(0); PG8_MMA(1, 0, At, B0); PG8_BAR; PG8_SCHED;
            PG8_STAGE(PG8_SB(0, 1), b2 + hstepB, voffB);
            PG8_WAIT_V(6); PG8_BAR; PG8_MMA(1, 1, At, B1); PG8_BAR;
            PG8_LDB(B0, 1, 0); PG8_SCHED; PG8_LDA(At, 1, 0); PG8_STAGE(PG8_SA(0, 1), a2, x1);
            PG8_WAIT_L(8); PG8_BAR; PG8_WAIT_L(0); PG8_MMA(0, 0, At, B0); PG8_BAR; PG8_SCHED;
            PG8_LDB(B1, 1, 1); PG8_STAGE(PG8_SB(1, 0), b3, voffB);
            PG8_BAR; PG8_WAIT_L(0); PG8_MMA(0, 1, At, B1); PG8_BAR;
            PG8_LDA(At, 1, 1); PG8_STAGE(PG8_SA(1, 0), a3, x0);
            PG8_BAR; PG8_WAIT_L(0); PG8_MMA(1, 0, At, B0); PG8_BAR; PG8_SCHED;
            PG8_STAGE(PG8_SB(1, 1), b3 + hstepB, voffB);
            PG8_WAIT_V(6); PG8_BAR; PG8_MMA(1, 1, At, B1); PG8_BAR;
            }
        }
        if constexpr (ALIGN_EPI) { if (wr == 0) PG8_BAR; }
        { const int l2 = lane_id_opaque(); E(acc, cur, wr, wc, l2 & 15, l2 >> 4); }
        if (!has_next) break;
        if (!E.keep(cur)) { float z_ = 0.f; LAUNDER_V(z_);
#pragma unroll
        for (int a = 0; a < 2; ++a)
#pragma unroll
            for (int b = 0; b < 2; ++b)
#pragma unroll
                for (int m = 0; m < 4; ++m)
#pragma unroll
                    for (int n = 0; n < 2; ++n) acc[a][b][m][n] = (f32x4){z_, z_, z_, z_}; }
        cur = nxt; cA = nA; cB = nB; cB1 = nB1; ++ui; ntc = S.nt(cur, nt);
        if constexpr (GATHER) { PG8_GOFF(ui); }
        if constexpr (ALIGN_EPI) { if (wr == 1) PG8_BAR; }
    }
    PG8_WAIT_V(0);
    if constexpr (!ALIGN_EPI) { if (wr == 0) PG8_BAR; }
    PG8_BAR;
#undef PG8_GOFF
#undef PG8_SA
#undef PG8_SB
#undef PG8_STAGE
#undef PG8_LDA
#undef PG8_LDB
#undef PG8_MMA
#undef PG8_WAIT_V
#undef PG8_WAIT_L
#undef PG8_BAR
#undef PG8_SCHED
}
}

typedef f32x4 AccT[2][2][4][2];
__device__ __forceinline__ u32x4 pack8(const f32x4 a, const f32x4 b) { u32x4 w; w.x = pk2(a[0], a[1]); w.y = pk2(a[2], a[3]); w.z = pk2(b[0], b[1]); w.w = pk2(b[2], b[3]); return w; }

struct Epi1 {
    static constexpr bool PERM = true;
    __device__ __forceinline__ bool keep(const pg8::Unit&) const { return false; }
    const float* rstd; bf16* A; bf16* GLU; bf16* QKV; bf16* G;
    __device__ __forceinline__ void operator()(AccT& acc, const pg8::Unit& u, int wr, int wc, int fr, int fq) const { run<false>(acc, u, wr, wc, fr, fq); }
    template <bool SK> __device__ __forceinline__ void run(AccT& acc, const pg8::Unit& u, int wr, int wc, int fr, int fq) const {
        const int row0 = u.pm * 256 + wr * 64 + fr, lc0 = wc * 32 + 8 * fq, pn = u.pn;
#pragma unroll
        for (int ai = 0; ai < (SK ? 1 : 2); ++ai)
#pragma unroll
            for (int m = 0; m < (SK ? 1 : 4); ++m) {
                const int row = row0 + ai * 128 + m * 16; const float rs = rstd[row];
                f32x4 v[2][2];
#pragma unroll
                for (int bj = 0; bj < 2; ++bj)
#pragma unroll
                    for (int n = 0; n < 2; ++n) v[bj][n] = acc[ai][bj][m][n] * rs;
                if (pn == 0) {
#pragma unroll
                    for (int bj = 0; bj < 2; ++bj) *(u32x4*)(A + (size_t)row * 256 + bj * 128 + lc0) = pack8(v[bj][0], v[bj][1]);
                } else if (pn <= 2) {
                    f32x4 o[2];
#pragma unroll
                    for (int n = 0; n < 2; ++n)
#pragma unroll
                        for (int j = 0; j < 4; ++j) o[n][j] = v[0][n][j] * sigmoidf_(v[1][n][j]);
                    *(u32x4*)(GLU + (size_t)row * 256 + (pn - 1) * 128 + lc0) = pack8(o[0], o[1]);
                } else if (pn <= 4) {
#pragma unroll
                    for (int bj = 0; bj < 2; ++bj) *(u32x4*)(QKV + (size_t)2 * (U / 4) + (size_t)row * 512 + (pn - 3) * 256 + bj * 128 + lc0) = pack8(v[bj][0], v[bj][1]);
                } else {
                    const int d = 64 * (pn - 5) + 16 * wc + 4 * fq; f32x4 r01, r12, g2;
#pragma unroll
                    for (int j = 0; j < 4; ++j) { const float a0 = 1.0f + fminf(__builtin_amdgcn_exp2f(-LOG2E * v[0][0][j]), 1e30f), a1 = 1.0f + fminf(__builtin_amdgcn_exp2f(-LOG2E * v[0][1][j]), 1e30f), a2 = 1.0f + fminf(__builtin_amdgcn_exp2f(-LOG2E * v[1][0][j]), 1e30f);
                        const float i0 = __builtin_amdgcn_rcpf(a0), i1 = __builtin_amdgcn_rcpf(a1), i2 = __builtin_amdgcn_rcpf(a2);
                        r01[j] = i0 * a1; r12[j] = i1 * a2; g2[j] = i2; }
                    bf16* gp = G + (size_t)row * 1024 + d; u32x2 w;
                    w.x = pk2(r01[0], r01[1]); w.y = pk2(r01[2], r01[3]); *(u32x2*)gp = w;
                    w.x = pk2(r12[0], r12[1]); w.y = pk2(r12[2], r12[3]); *(u32x2*)(gp + U / 2) = w;
                    w.x = pk2(g2[0], g2[1]); w.y = pk2(g2[2], g2[3]); *(u32x2*)(gp + U) = w;
                    const float sc = d < 512 ? C2 : 1.0f; const f32x4 sp = v[1][1] * sc;
                    w.x = pk2(sp[0], sp[1]); w.y = pk2(sp[2], sp[3]); *(u32x2*)(QKV + (size_t)(d < 512 ? 0 : 1) * (U / 4) + (size_t)row * 512 + (d & 511)) = w;
                }
            }
    }
};
struct EpiCS {
    static constexpr bool PERM = true;
    const bf16* G; bf16* Mg; const float* bias;
    __device__ __forceinline__ bool keep(const pg8::Unit& u) const { return u.seg != 2; }
    __device__ __forceinline__ void operator()(AccT& acc, const pg8::Unit& u, int wr, int wc, int fr, int fq) const { run<false>(acc, u, wr, wc, fr, fq); }
    template <bool SK> __device__ __forceinline__ void run(AccT& acc, const pg8::Unit& u, int wr, int wc, int fr, int fq) const {
        const int row0 = u.pm * 256 + wr * 64 + fr, col0 = u.pn * 256 + wc * 32 + 8 * fq;
        const bool lastseg = u.seg == 2; const float bsc = u.seg == 0 ? 1.f : 0.f; const bf16* Gs = G + (size_t)u.seg * (U / 2);
        f32x4 bv[2][2];
#pragma unroll
        for (int bj = 0; bj < 2; ++bj) { bv[bj][0] = *(const f32x4*)(bias + col0 + bj * 128) * bsc; bv[bj][1] = *(const f32x4*)(bias + col0 + bj * 128 + 4) * bsc; }
        u32x4 gr[2][4][2];
#pragma unroll
        for (int ai = 0; ai < (SK ? 1 : 2); ++ai)
#pragma unroll
            for (int m = 0; m < (SK ? 1 : 4); ++m)
#pragma unroll
                for (int bj = 0; bj < 2; ++bj) gr[ai][m][bj] = *(const u32x4*)(Gs + (size_t)(row0 + ai * 128 + m * 16) * 1024 + col0 + bj * 128);
#pragma unroll
        for (int ai = 0; ai < (SK ? 1 : 2); ++ai)
#pragma unroll
            for (int m = 0; m < (SK ? 1 : 4); ++m) { const int row = row0 + ai * 128 + m * 16;
#pragma unroll
                for (int bj = 0; bj < 2; ++bj) {
                    const u32x4 n4 = gr[ai][m][bj];
                    f32x4 a0 = acc[ai][bj][m][0] + bv[bj][0], a1 = acc[ai][bj][m][1] + bv[bj][1];
                    a0[0] *= bflo(n4.x); a0[1] *= bfhi(n4.x); a0[2] *= bflo(n4.y); a0[3] *= bfhi(n4.y); a1[0] *= bflo(n4.z); a1[1] *= bfhi(n4.z); a1[2] *= bflo(n4.w); a1[3] *= bfhi(n4.w);
                    acc[ai][bj][m][0] = a0; acc[ai][bj][m][1] = a1;
                    asm volatile("" : "+v"(acc[ai][bj][m][0]), "+v"(acc[ai][bj][m][1]));
                    if (lastseg) *(u32x4*)(Mg + (size_t)row * 1024 + col0 + bj * 128) = pack8(a0, a1);
                } }
    }
};
struct EpiD {
    static constexpr bool PERM = false;
    __device__ __forceinline__ bool keep(const pg8::Unit&) const { return false; }
    float* H; bf16* HB;
    __device__ __forceinline__ void operator()(AccT& acc, const pg8::Unit& u, int wr, int wc, int fr, int fq) const { run<false>(acc, u, wr, wc, fr, fq); }
    template <bool SK> __device__ __forceinline__ void run(AccT& acc, const pg8::Unit& u, int wr, int wc, int fr, int fq) const {
        const int row0 = u.pm * 256 + wr * 64 + fr, col0 = u.pn * 256 + wc * 32 + 4 * fq;
#pragma unroll
        for (int ai = 0; ai < (SK ? 1 : 2); ++ai)
#pragma unroll
            for (int m = 0; m < (SK ? 1 : 4); ++m) {
                const size_t off = (size_t)(row0 + ai * 128 + m * 16) * 1024 + col0;
#pragma unroll
                for (int bj = 0; bj < 2; ++bj)
#pragma unroll
                    for (int n = 0; n < 2; ++n) { const size_t o = off + bj * 128 + n * 16; const f32x4 hv = *(const f32x4*)(H + o) + acc[ai][bj][m][n];
                        *(f32x4*)(H + o) = hv; u32x2 w; w.x = pk2(hv[0], hv[1]); w.y = pk2(hv[2], hv[3]); *(u32x2*)(HB + o) = w; }
            }
    }
};
struct EpiA2 {
    static constexpr bool PERM = true;
    __device__ __forceinline__ bool keep(const pg8::Unit&) const { return false; }
    const float* PW; bf16* HH;
    __device__ __forceinline__ void operator()(AccT& acc, const pg8::Unit& u, int wr, int wc, int fr, int fq) const {
        const int row0 = u.pm * 256 + wr * 64 + fr, lc0 = wc * 32 + 8 * fq, side = u.pn >> 1;
#pragma unroll
        for (int ai = 0; ai < 2; ++ai)
#pragma unroll
            for (int m = 0; m < 4; ++m) {
                const int row = row0 + ai * 128 + m * 16; const f32x4 pw = *(const f32x4*)(PW + (size_t)row * 4);
                const float rs = pw[0], cw = side ? pw[2] : pw[1];
                f32x4 o[2];
#pragma unroll
                for (int n = 0; n < 2; ++n)
#pragma unroll
                    for (int j = 0; j < 4; ++j) { const float a1 = acc[ai][0][m][n][j] * rs, a3 = acc[ai][1][m][n][j] * rs; o[n][j] = cw * a1 * sigmoidf_(a1) * a3; }
                *(u32x4*)(HH + (size_t)row * 512 + side * 256 + (u.pn & 1) * 128 + lc0) = pack8(o[0], o[1]);
            }
    }
};
struct EpiB2 {
    static constexpr bool PERM = true;
    __device__ __forceinline__ bool keep(const pg8::Unit&) const { return false; }
    bf16* Y;
    __device__ __forceinline__ void operator()(AccT& acc, const pg8::Unit& u, int wr, int wc, int fr, int fq) const { run<false>(acc, u, wr, wc, fr, fq); }
    template <bool SK> __device__ __forceinline__ void run(AccT& acc, const pg8::Unit& u, int wr, int wc, int fr, int fq) const {
        const int row0 = u.pm * 256 + wr * 64 + fr, col0 = u.pn * 256 + wc * 32 + 8 * fq;
#pragma unroll
        for (int ai = 0; ai < (SK ? 1 : 2); ++ai)
#pragma unroll
            for (int m = 0; m < (SK ? 1 : 4); ++m) {
                bf16* rp = Y + (size_t)(row0 + ai * 128 + m * 16) * 1024 + col0;
#pragma unroll
                for (int bj = 0; bj < 2; ++bj) *(u32x4*)(rp + bj * 128) = pack8(acc[ai][bj][m][0], acc[ai][bj][m][1]);
            }
    }
};
template <bool GA> struct MoeOrderT {
    static constexpr bool GATHER = GA; const LAS int* tokl;
    int NP, G, c, mode; const LAS int* pcls; const bf16* W;
    __device__ bool next(int i, pg8::Unit& u) const { const long L = (long)i * G + c; if (L >= (long)NP * 4) return false; u.pm = (int)(L >> 2); u.pn = (int)(L & 3); u.seg = 0; return true; }
    __device__ __forceinline__ int nt(const pg8::Unit&, int ntd) const { return ntd; }
    __device__ __forceinline__ size_t aoff(const pg8::Unit&) const { return 0; }
    __device__ __forceinline__ const char* bptr(const pg8::Unit& u, int side) const {
        const int cls = __builtin_amdgcn_readfirstlane(pcls[u.pm]); const int grp = cls / 6, pr = cls % 6;
        const int ea = pr < 3 ? 0 : (pr < 5 ? 1 : 2), eb = pr < 3 ? pr + 1 : (pr < 5 ? pr - 1 : 3);
        if (mode == 0) { const int e = grp * 4 + (u.pn < 2 ? ea : eb); return (const char*)W + ((size_t)e * 512 + (size_t)(u.pn & 1) * 256) * 1024 * 2; }
        const int e = grp * 4 + (side ? eb : ea); return (const char*)W + ((size_t)e * 1024 + (size_t)u.pn * 256) * 256 * 2;
    }
};

template <bool PERM> __device__ __forceinline__ void skinny_k(AccT& acc, const bf16* A, int lda, const bf16* Bt, int ldb, int K, int wc, int fr, int fq) {
    const bf16* ap = A + (size_t)fr * lda + 8 * fq;
    const bf16* bp[2][2];
#pragma unroll
    for (int bj = 0; bj < 2; ++bj)
#pragma unroll
        for (int n = 0; n < 2; ++n) { const int col = 128 * bj + 32 * wc + (PERM ? 8 * (fr >> 2) + 4 * n + (fr & 3) : 16 * n + fr); bp[bj][n] = Bt + (size_t)col * ldb + 8 * fq; }
#pragma unroll 8
    for (int k0 = 0; k0 < K; k0 += 32) {
        const bf16x8 a = *(const bf16x8*)(ap + k0);
#pragma unroll
        for (int bj = 0; bj < 2; ++bj)
#pragma unroll
            for (int n = 0; n < 2; ++n) { const bf16x8 b = *(const bf16x8*)(bp[bj][n] + k0); acc[0][bj][0][n] = __builtin_amdgcn_mfma_f32_16x16x32_bf16(b, a, acc[0][bj][0][n], 0, 0, 0); }
    }
}
__device__ __forceinline__ void skinny_zero(AccT& acc) {
#pragma unroll
    for (int bj = 0; bj < 2; ++bj)
#pragma unroll
        for (int n = 0; n < 2; ++n) acc[0][bj][0][n] = (f32x4){0.f, 0.f, 0.f, 0.f};
}
__device__ __forceinline__ void skinny_combine(AccT& acc, LAS unsigned char* lds, int wave, int lane) {
    LAS f32x4* X = (LAS f32x4*)lds;
    if (wave >= 4) {
#pragma unroll
        for (int bj = 0; bj < 2; ++bj)
#pragma unroll
            for (int n = 0; n < 2; ++n) X[((wave - 4) * 64 + lane) * 4 + bj * 2 + n] = acc[0][bj][0][n]; }
    __syncthreads();
    if (wave < 4) {
#pragma unroll
        for (int bj = 0; bj < 2; ++bj)
#pragma unroll
            for (int n = 0; n < 2; ++n) acc[0][bj][0][n] += X[(wave * 64 + lane) * 4 + bj * 2 + n]; }
    __syncthreads();
}

#define XB_TMO      128
#define XB_XCNT(j)  (256  + 64 * (j))
#define XB_XSUB(j)  (1280 + 64 * (j))
#define XB_XGEN(j)  (2304 + 64 * (j))
#define XB_TOP      3328
#define XB_TOPGEN   3392
#define XCD_BAR_WORDS 3456
#define XB_SPIN_CAP (1u << 24)
__device__ __forceinline__ unsigned xb_ld(unsigned* p)              { return __hip_atomic_load(p, __ATOMIC_RELAXED, __HIP_MEMORY_SCOPE_AGENT); }
__device__ __forceinline__ unsigned xb_add(unsigned* p, unsigned v) { return __hip_atomic_fetch_add(p, v, __ATOMIC_RELAXED, __HIP_MEMORY_SCOPE_AGENT); }
__device__ __forceinline__ unsigned xb_xcc_id() { return (unsigned)__builtin_amdgcn_s_getreg((3 << 11) | 20) & 0xFu; }
#define XB_SPIN(cond, bar) do { unsigned _sp = 0; while (cond) { __builtin_amdgcn_s_sleep(1); \
    if ((++_sp & 255u) == 0u) { if (xb_ld(&(bar)[XB_TMO])) break; if (_sp > XB_SPIN_CAP) { atomicAdd(&(bar)[XB_TMO], 1u); break; } } } } while (0)
struct XcdBarrier { unsigned* bar; unsigned x; volatile LAS unsigned* st; };
__device__ __forceinline__ XcdBarrier xcd_barrier_post(unsigned* bar, volatile LAS unsigned* st) {
    XcdBarrier b; b.bar = bar; b.x = xb_xcc_id(); b.st = st;
    if (threadIdx.x == 0) (void)xb_add(&bar[XB_XCNT(b.x)], 1u);
    return b;
}
__device__ __forceinline__ void xcd_barrier_complete(unsigned* bar, unsigned x, unsigned& nloc, unsigned& nx) {
    const unsigned G = gridDim.x * gridDim.y * gridDim.z;
    unsigned sum, cnt, mine, sp = 0u;
    for (;;) {
        sum = 0u; cnt = 0u; mine = 0u;
#pragma unroll
        for (unsigned j = 0; j < 16; ++j) { const unsigned c = xb_ld(&bar[XB_XCNT(j)]); sum += c; cnt += (c > 0u) ? 1u : 0u; mine = (j == x) ? c : mine; }
        if (sum == G) break;
        __builtin_amdgcn_s_sleep(1);
        if ((++sp & 255u) == 0u) { if (xb_ld(&bar[XB_TMO])) break; if (sp > XB_SPIN_CAP) { atomicAdd(&bar[XB_TMO], 1u); break; } }
    }
    nloc = mine > 0u ? mine : 1u; nx = cnt > 0u ? cnt : 1u;
}
__device__ __forceinline__ void xcd_barrier(const XcdBarrier& b) {
    asm volatile("s_waitcnt vmcnt(0)" ::: "memory");
    __syncthreads();
    if (threadIdx.x == 0) {
        unsigned* bar = b.bar;
        __builtin_amdgcn_s_waitcnt(0);
        unsigned nloc = b.st[0], nx = b.st[1];
        if (nloc == 0u) { xcd_barrier_complete(bar, b.x, nloc, nx); b.st[0] = nloc; b.st[1] = nx; }
        const unsigned old = xb_add(&bar[XB_XSUB(b.x)], 1u);
        const unsigned gen = old / nloc;
        if (old + 1u == (gen + 1u) * nloc) {
            __builtin_amdgcn_fence(__ATOMIC_RELEASE, "agent");
            asm volatile("s_waitcnt vmcnt(0)" ::: "memory");
            const unsigned og = xb_add(&bar[XB_TOP], 1u);
            const unsigned tg = og / nx;
            if (og + 1u == (tg + 1u) * nx) xb_add(&bar[XB_TOPGEN], 1u);
            else XB_SPIN(xb_ld(&bar[XB_TOPGEN]) == tg, bar);
            __builtin_amdgcn_fence(__ATOMIC_ACQUIRE, "agent");
            xb_add(&bar[XB_XGEN(b.x)], 1u);
            asm volatile("s_waitcnt vmcnt(0)" ::: "memory");
        } else {
            XB_SPIN(xb_ld(&bar[XB_XGEN(b.x)]) == gen, bar);
            __builtin_amdgcn_fence(__ATOMIC_ACQUIRE, "agent");
            asm volatile("s_waitcnt vmcnt(0)" ::: "memory");
        }
    }
    __syncthreads();
}

struct Params { const float* in[25]; float* out; unsigned char* ws; int ph_lo, ph_hi; };
enum { I_X = 0, I_META, I_N1G, I_WIN, I_BF, I_PW, I_PB, I_PS, I_CW, I_CB, I_LNG, I_LNB, I_WOA, I_WOB, I_WOC, I_WO, I_N2G, I_RGW, I_RGB, I_REW, I_REB, I_W1, I_W3, I_W2, I_FG };

struct Frame {
    LAS unsigned char* lds;
    int tid, lane, wave, vcu, G, bx;
};
__device__ __forceinline__ unsigned long long ptab_get(const Frame& F, int i) { const LAS unsigned* t = (const LAS unsigned*)(F.lds + LC_PTAB) + 2 * i; const unsigned lo = __builtin_amdgcn_readfirstlane(t[0]), hi = __builtin_amdgcn_readfirstlane(t[1]); return ((unsigned long long)hi << 32) | lo; }
#define INP(i) ((const float*)(const GAS float*)ptab_get(F, (i)))
#define WSP() ((unsigned char*)(GAS unsigned char*)ptab_get(F, 25))
#define DOP() ((unsigned char*)(GAS unsigned char*)ptab_get(F, 26))

__device__ __forceinline__ void tr_item(const float* W, int ldw, int scol_lane  , const float* gk, bf16* WT, int ldt, int drow0, int k0, LAS float* scr, int lane) {
    const int n4 = (lane & 7) * 4, kr = lane >> 3;
    f32x4 v[8];
#pragma unroll
    for (int i = 0; i < 8; ++i) v[i] = *(const f32x4*)(W + (size_t)(k0 + 8 * i + kr) * ldw + scol_lane);
#pragma unroll
    for (int i = 0; i < 8; ++i) { const int kk = 8 * i + kr; const float g = gk ? gk[k0 + kk] : 1.0f; LAS float* d = scr + kk * 33 + n4; d[0] = v[i][0] * g; d[1] = v[i][1] * g; d[2] = v[i][2] * g; d[3] = v[i][3] * g; }
    LDS_WAIT(); asm volatile("" ::: "memory");
    const int c = lane & 7;
#pragma unroll
    for (int j = 0; j < 4; ++j) { const int n = (lane >> 3) + 8 * j; const LAS float* s = scr + (8 * c) * 33 + n;
        u32x4 o; o.x = pk2(s[0 * 33], s[1 * 33]); o.y = pk2(s[2 * 33], s[3 * 33]); o.z = pk2(s[4 * 33], s[5 * 33]); o.w = pk2(s[6 * 33], s[7 * 33]);
        *(u32x4*)(WT + (size_t)(drow0 + n) * ldt + k0 + 8 * c) = o; }
    LDS_WAIT(); asm volatile("" ::: "memory");
}
__device__ __forceinline__ int map1(int n) {
    const int tile = n >> 8, c = n & 255;
    if (tile == 0) return n;
    if (tile <= 2) { const int cc = (tile - 1) * 128 + (c & 127); return (c < 128 ? 256 : 512) + cc; }
    if (tile <= 4) return 1792 + (n - 768);
    const int t = tile - 5, bj = c >> 7, wc = (c >> 5) & 3, fq = (c >> 3) & 3, nn = (c >> 2) & 1, d = 64 * t + 16 * wc + 4 * fq + (c & 3), kind = 2 * bj + nn;
    return kind == 3 ? 768 + d : 2312 + 1024 * kind + d;
}
__device__ __forceinline__ void convert_weights(Frame& F, int l) {
    LAS float* scr = (LAS float*)(F.lds + F.wave * 16384);
    const int gw = F.vcu * NWAVES + F.wave, NGW = F.G * NWAVES, lane = F.lane;
    const float* g1 = INP(I_N1G) + (size_t)l * D; const float* g2 = INP(I_N2G) + (size_t)l * D;
    unsigned char* ws = WSP();
    const int n4l = (lane & 7) * 4;
#pragma unroll 1
    for (int it0 = gw; it0 < 9728; it0 += NGW) { int it = it0;
        if (it < 2688) { const int kb = it / 168, nb = it % 168; tr_item(INP(I_WIN) + (size_t)l * D * NIN, NIN, map1(nb * 32 + n4l), g1, (bf16*)(ws + WS_W1T), 1024, nb * 32, kb * 64, scr, lane); continue; } it -= 2688;
        if (it < 128) { const int kb = it / 32, nb = it % 32; tr_item(INP(I_WOB) + (size_t)l * 256 * D, 1024, nb * 32 + n4l, nullptr, (bf16*)(ws + WS_W3CT) + 256, 1024, nb * 32, kb * 64, scr, lane); continue; } it -= 128;
        if (it < 256) { const int kb = it / 32, nb = it % 32; tr_item(INP(I_WOC) + (size_t)l * 512 * D, 1024, nb * 32 + n4l, nullptr, (bf16*)(ws + WS_W3CT) + 512, 1024, nb * 32, kb * 64, scr, lane); continue; } it -= 256;
        if (it < 512) { const int kb = it / 32, nb = it % 32; tr_item(INP(I_WO) + (size_t)l * D * D, 1024, nb * 32 + n4l, nullptr, (bf16*)(ws + WS_WOT), 1024, nb * 32, kb * 64, scr, lane); continue; } it -= 512;
        if (it < 4096) { const int e = it >> 8, r = it & 255, kb = r >> 4, nb = r & 15, n0 = nb * 32, jt = n0 >> 8, rr = n0 & 255;
            const float* W = (rr < 128 ? INP(I_W1) : INP(I_W3)) + ((size_t)l * 16 + e) * D * 256;
            tr_item(W, 256, jt * 128 + (rr & 127) + n4l, g2, (bf16*)(DOP() + DO_W13T) + (size_t)e * 512 * 1024, 1024, n0, kb * 64, scr, lane); continue; } it -= 4096;
        { const int e = it >> 7, r = it & 127, kb = r >> 5, nb = r & 31;
            tr_item(INP(I_W2) + ((size_t)l * 16 + e) * 256 * D, 1024, nb * 32 + n4l, nullptr, (bf16*)(DOP() + DO_W2T) + (size_t)e * 1024 * 256, 256, nb * 32, kb * 64, scr, lane); }
    }
    { const float* pw = INP(I_PW) + (size_t)l * 4 * 64 * 64; const float* ps = INP(I_PS) + (size_t)l * 256; const float* pb = INP(I_PB) + (size_t)l * 256;
      const float* wa = INP(I_WOA) + (size_t)l * 256 * D; bf16* WT = (bf16*)(ws + WS_W3CT); float* bias = (float*)(ws + WS_BIASA);
      const int gt = F.vcu * 512 + F.tid, NT = F.G * 512;
      for (int idx = gt; idx < 256 * 1024; idx += NT) { const int n = idx & 1023, kk = idx >> 10, grp = kk >> 6, c = kk & 63; float s = 0.f;
#pragma unroll 16
        for (int d = 0; d < 64; ++d) s += pw[(grp * 64 + c) * 64 + d] * ps[grp * 64 + d] * wa[(size_t)(grp * 64 + d) * D + n];
        WT[(size_t)n * 1024 + kk] = (bf16)f2bf(s); }
      for (int n = gw; n < 1024; n += NGW) { float s = 0.f;
#pragma unroll
        for (int j = 0; j < 4; ++j) { const int d = lane + 64 * j; s += pb[d] * ps[d] * wa[(size_t)d * D + n]; }
        s = wave_sum(s); if (lane == 0) bias[n] = s; }
      float* wfg = (float*)(ws + WS_WFG); const float* win = INP(I_WIN) + (size_t)l * D * NIN;
      for (int idx = gt; idx < 8 * 1024; idx += NT) { const int c = idx >> 10, k = idx & 1023; wfg[idx] = g1[k] * win[(size_t)k * NIN + 2304 + c]; }
      float* rg = (float*)(ws + WS_RG); const float* re = INP(I_REW) + (size_t)l * D * 16; const float* rgw = INP(I_RGW) + (size_t)l * D * 4;
      for (int idx = gt; idx < 20 * 1024; idx += NT) { const int c = idx >> 10, k = idx & 1023; rg[idx] = g2[k] * (c < 16 ? re[(size_t)k * 16 + c] : rgw[(size_t)k * 4 + (c - 16)]); } }
}
__device__ __forceinline__ void init_rows(Frame& F) {
    const int gw = F.vcu * NWAVES + F.wave, NGW = F.G * NWAVES, lane = F.lane;
    bf16* HB = (bf16*)(WSP() + WS_HB); float* rstd1 = (float*)(WSP() + WS_RSTD1);
    constexpr int R = 4;
#pragma unroll 1
    for (int row0 = gw; row0 < TR; row0 += R * NGW) {
        f32x4 v[R][4];
#pragma unroll
        for (int r = 0; r < R; ++r) { int row = row0 + r * NGW; if (row >= TR) row = TR - 1;
            const float* src = row < TX ? INP(I_X) + (size_t)row * D : INP(I_META) + (size_t)(row - TX) * D;
#pragma unroll
            for (int j = 0; j < 4; ++j) v[r][j] = *(const f32x4*)(src + 4 * lane + 256 * j); }
#pragma unroll
        for (int r = 0; r < R; ++r) { const int row = row0 + r * NGW; float ss = 0.f;
#pragma unroll
            for (int j = 0; j < 4; ++j) ss += v[r][j][0] * v[r][j][0] + v[r][j][1] * v[r][j][1] + v[r][j][2] * v[r][j][2] + v[r][j][3] * v[r][j][3];
            ss = wave_sum(ss);
            if (row < TR) {
#pragma unroll
                for (int j = 0; j < 4; ++j) { u32x2 w; w.x = pk2(v[r][j][0], v[r][j][1]); w.y = pk2(v[r][j][2], v[r][j][3]); *(u32x2*)(HB + (size_t)row * D + 4 * lane + 256 * j) = w; }
                if (lane == 0) rstd1[row] = rsqrtf(ss * (1.0f / D) + EPS); } }
    }
    { bf16* Kb = (bf16*)(DOP() + DO_K) + (size_t)TR * 512; bf16* Vb = (bf16*)(DOP() + DO_V) + (size_t)TR * 512; const int gt = F.vcu * 512 + F.tid;
      if (gt < 48 * 64) { *(u32x4*)(Kb + (size_t)gt * 8) = (u32x4){0u, 0u, 0u, 0u}; *(u32x4*)(Vb + (size_t)gt * 8) = (u32x4){0u, 0u, 0u, 0u}; } }
}

__device__ __forceinline__ int srcrow(bool isx, int b, int t) {
    if (t >= 0) return (isx ? b * SEQ : TX) + t;
    if (isx) { const int mm = NMETA + t; return mm >= 0 ? TX + mm : -1; }
    return -1;
}
__device__ __forceinline__ void phase_S(Frame& F, int l) {
    LAS unsigned char* lds = F.lds; const int wave = F.wave;
#pragma unroll 1
    for (int item = F.vcu; item < 513; item += F.G) {
        const bool isx = item < 512; const int row0 = isx ? item * 64 : TX + (item - 512) * 64; const int b = isx ? (item * 64) / SEQ : 0; const int t0 = isx ? (item * 64) % SEQ : (item - 512) * 64; const int nrows = isx ? 64 : NMETA;
        { unsigned char* ws = WSP(); int tid = F.tid; LAUNDER_V(tid); const int lane = tid & 63, fr = lane & 15, fq = lane >> 4;
          const bf16* HB = (const bf16*)(ws + WS_HB); const float* rstd1 = (const float*)(ws + WS_RSTD1); const float* wfg = (const float*)(ws + WS_WFG);
          float* LFT = (float*)(ws + WS_LFT); float* LFTM = (float*)(ws + WS_LFTM); const float* bfg = INP(I_BF) + l * 8;
          LAS bf16* Whi = (LAS bf16*)lds; LAS bf16* Wlo = Whi + 8 * RPITCH; LAS float* Pex = (LAS float*)(lds + 2 * 8 * RPITCH * 2); LAS unsigned* nmx = (LAS unsigned*)(lds + LC_NMX);
          { f32x4 wv_[4];
#pragma unroll
            for (int j = 0; j < 4; ++j) wv_[j] = *(const f32x4*)(wfg + 4 * (tid + 512 * j));
#pragma unroll
            for (int j = 0; j < 4; ++j) { const int i = 4 * (tid + 512 * j), c = i >> 10, k = i & 1023; u32x2 hw, lw; float hf[4];
#pragma unroll
                for (int e = 0; e < 4; ++e) hf[e] = __builtin_bit_cast(float, (pk2(wv_[j][e], 0.f) & 0xffffu) << 16);
                hw.x = pk2(wv_[j][0], wv_[j][1]); hw.y = pk2(wv_[j][2], wv_[j][3]); lw.x = pk2(wv_[j][0] - hf[0], wv_[j][1] - hf[1]); lw.y = pk2(wv_[j][2] - hf[2], wv_[j][3] - hf[3]);
                *(LAS u32x2*)(Whi + c * RPITCH + k) = hw; *(LAS u32x2*)(Wlo + c * RPITCH + k) = lw; } }
          if (tid < 16) nmx[tid] = 0u;
          const int g = wave & 3, kh = wave >> 2, rr = 16 * g + fr, row = row0 + rr;
          bf16x8 af[16];
#pragma unroll
          for (int s2 = 0; s2 < 16; ++s2) af[s2] = *(const bf16x8*)(HB + (size_t)row * D + 32 * (16 * kh + s2) + 8 * fq);
          const float rs1 = rstd1[row];
          __syncthreads();
          f32x4 acc = {0.f, 0.f, 0.f, 0.f};
#pragma unroll
          for (int s2 = 0; s2 < 16; ++s2) { const int k = 32 * (16 * kh + s2) + 8 * fq;
              bf16x8 wh = *(const LAS bf16x8*)(Whi + (fr & 7) * RPITCH + k), wl = *(const LAS bf16x8*)(Wlo + (fr & 7) * RPITCH + k);
              if (fr >= 8) { wh = (bf16x8){0, 0, 0, 0, 0, 0, 0, 0}; wl = wh; }
              acc = __builtin_amdgcn_mfma_f32_16x16x32_bf16(wh, af[s2], acc, 0, 0, 0); acc = __builtin_amdgcn_mfma_f32_16x16x32_bf16(wl, af[s2], acc, 0, 0, 0); }
          if (kh == 1) *(LAS f32x4*)(Pex + (g * 64 + lane) * 4) = acc;
          { const bf16* Qg = (const bf16*)(DOP() + DO_Q); const bf16* Kg = (const bf16*)(DOP() + DO_K); float kmx = 0.f, qmx = 0.f;
            u32x4 kw[8], qw[8];
#pragma unroll
            for (int i8 = 0; i8 < 8; ++i8) { const int r2 = wave + 8 * i8; const int rw = row0 + (r2 < nrows ? r2 : 0); kw[i8] = *(const u32x4*)(Kg + (size_t)rw * 512 + 8 * lane); qw[i8] = *(const u32x4*)(Qg + (size_t)rw * 512 + 8 * lane); }
#pragma unroll
            for (int i8 = 0; i8 < 8; ++i8) { const u32x4 a = kw[i8], c = qw[i8];
                float sk = (bflo(a.x) * bflo(a.x) + bfhi(a.x) * bfhi(a.x)) + (bflo(a.y) * bflo(a.y) + bfhi(a.y) * bfhi(a.y)) + (bflo(a.z) * bflo(a.z) + bfhi(a.z) * bfhi(a.z)) + (bflo(a.w) * bflo(a.w) + bfhi(a.w) * bfhi(a.w));
                float sq = (bflo(c.x) * bflo(c.x) + bfhi(c.x) * bfhi(c.x)) + (bflo(c.y) * bflo(c.y) + bfhi(c.y) * bfhi(c.y)) + (bflo(c.z) * bflo(c.z) + bfhi(c.z) * bfhi(c.z)) + (bflo(c.w) * bflo(c.w) + bfhi(c.w) * bfhi(c.w));
                sk += lane_xor<1>(sk); sk += lane_xor<2>(sk); sk += lane_xor<4>(sk); sq += lane_xor<1>(sq); sq += lane_xor<2>(sq); sq += lane_xor<4>(sq);
                kmx = fmaxf(kmx, sk); qmx = fmaxf(qmx, sq); }
            if ((lane & 7) == 0) { const int hd = lane >> 3; __hip_atomic_fetch_max(&nmx[hd], __float_as_uint(kmx), __ATOMIC_RELAXED, __HIP_MEMORY_SCOPE_WORKGROUP); __hip_atomic_fetch_max(&nmx[8 + hd], __float_as_uint(qmx), __ATOMIC_RELAXED, __HIP_MEMORY_SCOPE_WORKGROUP); } }
          __syncthreads();
          if (kh == 0) { const f32x4 o4 = *(const LAS f32x4*)(Pex + (g * 64 + lane) * 4); acc += o4;
              if (fq < 2 && rr < nrows && row < TR) {
#pragma unroll
                  for (int i = 0; i < 4; ++i) { const int hd = 4 * fq + i; const float xg = acc[i] * rs1 + bfg[hd]; const float lf = fminf(xg, 0.f) - 0.69314718056f * __builtin_amdgcn_logf(1.0f + __expf(-fabsf(xg)));
                      if (isx) LFT[(size_t)(b * 8 + hd) * SEQ + t0 + rr] = lf; else LFTM[hd * 256 + t0 + rr] = lf; } } }
          if (tid < 16) { unsigned* nrm = (unsigned*)(WSP() + WS_CTL) + CW_NRM + l * 64; const unsigned v = nmx[tid];
              if (isx) __hip_atomic_fetch_max(nrm + (tid >> 3) * 32 + b * 8 + (tid & 7), v, __ATOMIC_RELAXED, __HIP_MEMORY_SCOPE_AGENT);
              else if (tid < 8) { for (int bb = 0; bb < NB; ++bb) __hip_atomic_fetch_max(nrm + bb * 8 + tid, v, __ATOMIC_RELAXED, __HIP_MEMORY_SCOPE_AGENT); } }
          __syncthreads(); }
        { unsigned char* ws = WSP(); int tid = F.tid; LAUNDER_V(tid);
          const bf16* Ab = (const bf16*)(ws + WS_A); bf16* DIFF = (bf16*)(ws + WS_X3);
          LAS unsigned char* T = lds;
          { u32x4 tv[5]; const int nld = (15 + nrows) * 32;
#pragma unroll
            for (int j = 0; j < 5; ++j) { const int i = tid + 512 * j; const int sl = i >> 5, ch = i & 31; const int r = i < nld ? srcrow(isx, b, t0 + sl - 15) : -1; unsigned z_ = 0u; LAUNDER_V(z_);
                tv[j] = r >= 0 ? *(const u32x4*)(Ab + (size_t)r * 256 + ch * 8) : (u32x4){z_, z_, z_, z_}; }
#pragma unroll
            for (int j = 0; j < 5; ++j) { const int i = tid + 512 * j; if (i < nld) *(LAS u32x4*)(T + (i >> 5) * 512 + (i & 31) * 16) = tv[j]; } }
          __syncthreads();
#pragma unroll 1
          for (int i = tid; i < nrows * 32; i += 512) { const int r = i >> 5, ch = i & 31, grp = ch >> 3, w = 2 << grp; const int cnt = isx ? w : min(t0 + r + 1, w);
              float s[8];
#pragma unroll
              for (int j = 0; j < 8; ++j) s[j] = 0.f;
#pragma unroll 4
              for (int d = 0; d < cnt; ++d) { const u32x4 v = *(const LAS u32x4*)(T + (15 + r - d) * 512 + ch * 16);
                  s[0] += bflo(v.x); s[1] += bfhi(v.x); s[2] += bflo(v.y); s[3] += bfhi(v.y); s[4] += bflo(v.z); s[5] += bfhi(v.z); s[6] += bflo(v.w); s[7] += bfhi(v.w); }
              const u32x4 a = *(const LAS u32x4*)(T + (15 + r) * 512 + ch * 16); const float ic = 1.0f / (float)cnt;
              u32x4 o; o.x = pk2(s[0] * ic - bflo(a.x), s[1] * ic - bfhi(a.x)); o.y = pk2(s[2] * ic - bflo(a.y), s[3] * ic - bfhi(a.y));
              o.z = pk2(s[4] * ic - bflo(a.z), s[5] * ic - bfhi(a.z)); o.w = pk2(s[6] * ic - bflo(a.w), s[7] * ic - bfhi(a.w));
              if (row0 + r < TR) *(u32x4*)(DIFF + (size_t)(row0 + r) * 1024 + ch * 8) = o; }
          __syncthreads(); }
        { unsigned char* ws = WSP(); int tid = F.tid; LAUNDER_V(tid);
          const bf16* GLU = (const bf16*)(ws + WS_GLU);
          LAS unsigned char* T = lds;
          LAS float* Yt = (LAS float*)(lds + 49152);
          { u32x4 tv[6]; const int nld = (isx ? 94 : 62) * 32;
#pragma unroll
            for (int j = 0; j < 6; ++j) { const int i = tid + 512 * j; const int sl = i >> 5, ch = i & 31; const int r = i < nld ? srcrow(isx, b, t0 + sl - 30) : -1; unsigned z_ = 0u; LAUNDER_V(z_);
                tv[j] = r >= 0 ? *(const u32x4*)(GLU + (size_t)r * 256 + ch * 8) : (u32x4){z_, z_, z_, z_}; }
#pragma unroll
            for (int j = 0; j < 6; ++j) { const int i = tid + 512 * j; if (i < nld) *(LAS u32x4*)(T + (i >> 5) * 512 + (i & 31) * 16) = tv[j]; } }
          __syncthreads();
          { const float* cw = INP(I_CW) + (size_t)l * 31 * 256; const float* cb = INP(I_CB) + l * 256;
            const int cp = tid & 127, strip = tid >> 7; f32x2 wv[31];
#pragma unroll
            for (int j = 0; j < 31; ++j) wv[j] = *(const f32x2*)(cw + j * 256 + 2 * cp);
            const f32x2 bias = *(const f32x2*)(cb + 2 * cp);
#pragma unroll 1
            for (int hh = 0; hh < (isx ? 2 : 1); ++hh) { const int rb = 32 * hh + 8 * strip; f32x2 acc[8];
#pragma unroll
                for (int r = 0; r < 8; ++r) acc[r] = bias;
#pragma unroll
                for (int i = 0; i < 38; ++i) { const unsigned xw = *(const LAS unsigned*)(T + (rb + i) * 512 + cp * 4); const f32x2 xx = {bflo(xw), bfhi(xw)};
#pragma unroll
                    for (int r = 0; r < 8; ++r) { const int j = i - r; if (j >= 0 && j <= 30) acc[r] += wv[j] * xx; } }
#pragma unroll
                for (int r = 0; r < 8; ++r) *(LAS f32x2*)(Yt + (rb + r) * 256 + 2 * cp) = acc[r]; } }
          __syncthreads();
          { unsigned char* ws2 = WSP(); int tid2 = F.tid; LAUNDER_V(tid2); const int lane = tid2 & 63;
            bf16* BP = (bf16*)(ws2 + WS_X3) + 256; const float* lng = INP(I_LNG) + l * 256; const float* lnb = INP(I_LNB) + l * 256;
            const f32x4 gg = *(const f32x4*)(lng + 4 * lane), bb = *(const f32x4*)(lnb + 4 * lane);
#pragma unroll
            for (int i8 = 0; i8 < 8; ++i8) { const int rr = wave + 8 * i8; if (rr >= nrows) continue; const f32x4 v = *(const LAS f32x4*)(Yt + rr * 256 + 4 * lane);
              const float mean = wave_sum(v[0] + v[1] + v[2] + v[3]) * (1.0f / 256.0f); const f32x4 dv = v - mean;
              const float var = wave_sum(dv[0] * dv[0] + dv[1] * dv[1] + dv[2] * dv[2] + dv[3] * dv[3]) * (1.0f / 256.0f); const float rs = rsqrtf(var + EPS);
              f32x4 o = dv * rs * gg + bb;
#pragma unroll
              for (int j = 0; j < 4; ++j) o[j] = o[j] * sigmoidf_(o[j]);
              u32x2 w; w.x = pk2(o[0], o[1]); w.y = pk2(o[2], o[3]); if (row0 + rr < TR) *(u32x2*)(BP + (size_t)(row0 + rr) * 1024 + 4 * lane) = w; } }
          __syncthreads(); }
    }
}

constexpr int AT_FL = 0, AT_K = 34816, AT_VT = AT_K + 8192, AT_SC = AT_VT + 8192;
__device__ __forceinline__ void attn_scan(Frame& F, int b, int h, bool meta_only, int fl_off, int sc_off) {
    LAS float* Fl = (LAS float*)(F.lds + fl_off); LAS float* sc = (LAS float*)(F.lds + sc_off);
    const float* LFT = (const float*)(WSP() + WS_LFT); const float* LFTM = (const float*)(WSP() + WS_LFTM);
    const int tid = F.tid, lane = F.lane, wave = F.wave;
    __syncthreads();
    if (tid == 0) { float s = 0.f; for (int m = 0; m < 64; ++m) { if (m < NMETA) { s += LFTM[h * 256 + m]; Fl[m] = s * LOG2E; } else Fl[m] = 1e30f; if (m == NMETA - 1) sc[16] = s; } }
    if (meta_only) { for (int i = tid; i < 256; i += 512) Fl[64 + i] = 0.f; __syncthreads(); return; }
    float v[16]; const float* src = LFT + (size_t)(b * 8 + h) * SEQ + 16 * tid;
#pragma unroll
    for (int j = 0; j < 4; ++j) { const f32x4 q = *(const f32x4*)(src + 4 * j); v[4 * j] = q[0]; v[4 * j + 1] = q[1]; v[4 * j + 2] = q[2]; v[4 * j + 3] = q[3]; }
#pragma unroll
    for (int j = 1; j < 16; ++j) v[j] += v[j - 1];
    float incl = v[15];
#pragma unroll
    for (int o = 1; o < 64; o <<= 1) { const float up = __int_as_float(__builtin_amdgcn_ds_bpermute((lane - o) << 2, __float_as_int(incl))); if (lane >= o) incl += up; }
    if (lane == 63) sc[wave] = incl;
    __syncthreads();
    float off = sc[16];
    for (int w = 0; w < wave; ++w) off += sc[w];
    off += incl - v[15];
#pragma unroll
    for (int j = 0; j < 16; ++j) Fl[64 + 16 * tid + j] = (off + v[j]) * LOG2E;
    __syncthreads();
}
__device__ __forceinline__ void attn_unit_naive(Frame& F, int qrow0, int qpos0, int ntiles, int kvx0, int h, int nq) {
    const int tid = F.tid; const int hf = tid & 1; const bool live = (tid >> 1) < nq; const int r = live ? (tid >> 1) : 0;
    const bf16* Q = (const bf16*)(DOP() + DO_Q); const bf16* Kg = (const bf16*)(DOP() + DO_K); const bf16* Vg = (const bf16*)(DOP() + DO_V); bf16* O = (bf16*)(WSP() + WS_X3) + 512;
    LAS float* Fl = (LAS float*)(F.lds + AT_FL); LAS unsigned char* Ks = F.lds + AT_K; LAS bf16* VT = (LAS bf16*)(F.lds + AT_VT);
    const int grow = qrow0 + r, qpos = qpos0 + r;
    unsigned qp[16];
#pragma unroll
    for (int j = 0; j < 4; ++j) { const u32x4 w = *(const u32x4*)(Q + (size_t)grow * 512 + h * 64 + hf * 32 + 8 * j); qp[4 * j] = w.x; qp[4 * j + 1] = w.y; qp[4 * j + 2] = w.z; qp[4 * j + 3] = w.w; }
    const float Fq = Fl[qpos < NMETA ? qpos : qpos + 48];
    float mrun = -1e30f, lrun = 0.f, o[32];
#pragma unroll
    for (int d = 0; d < 32; ++d) o[d] = 0.f;
    const int lrow = tid >> 3, lch = tid & 7;

#pragma unroll 1
for (int i = 0; i < ntiles; ++i) {
        const int krow = (i == 0 ? TX : kvx0 + 64 * (i - 1)) + lrow;
        const u32x4 kw = *(const u32x4*)(Kg + (size_t)krow * 512 + h * 64 + lch * 8);
        const u32x4 vw = *(const u32x4*)(Vg + (size_t)krow * 512 + h * 64 + lch * 8);
        __syncthreads();
        *(LAS u32x4*)(Ks + lrow * 128 + lch * 16) = kw;
        { const unsigned vv[4] = {vw.x, vw.y, vw.z, vw.w};
#pragma unroll
          for (int e = 0; e < 4; ++e) { VT[(lch * 8 + 2 * e) * 64 + lrow] = (bf16)(vv[e] & 0xffffu); VT[(lch * 8 + 2 * e + 1) * 64 + lrow] = (bf16)(vv[e] >> 16); } }
        __syncthreads();
        const int kp0 = i == 0 ? 0 : NMETA + 64 * (i - 1);
        if (kp0 > qpos0 + 255) continue;
#pragma unroll 1
        for (int jg = 0; jg < 4; ++jg) {
            float s[16]; float gmax = -1e30f;
#pragma unroll
            for (int jj = 0; jj < 16; ++jj) { const int j = jg * 16 + jj; float d = 0.f;
#pragma unroll
                for (int c = 0; c < 4; ++c) { const u32x4 kk = *(const LAS u32x4*)(Ks + j * 128 + hf * 64 + c * 16);
                    d = dot2bf(kk.x, qp[4 * c], d); d = dot2bf(kk.y, qp[4 * c + 1], d); d = dot2bf(kk.z, qp[4 * c + 2], d); d = dot2bf(kk.w, qp[4 * c + 3], d); }
                d += lane_xor<1>(d);
                const bool valid = (i == 0 ? j < NMETA : true) && (kp0 + j <= qpos);
                s[jj] = valid ? d + Fq - Fl[64 * i + j] : -1e30f; gmax = fmaxf(gmax, s[jj]); }
            const float mn = fmaxf(mrun, gmax), alpha = exp2f(mrun - mn); mrun = mn;
            float ps = 0.f; unsigned pp[8];
#pragma unroll
            for (int jj = 0; jj < 16; jj += 2) { const float p0 = exp2f(s[jj] - mn), p1 = exp2f(s[jj + 1] - mn); ps += p0 + p1; pp[jj >> 1] = pk2(p0, p1); }
            lrun = lrun * alpha + ps;
#pragma unroll
            for (int d = 0; d < 32; ++d) { const u32x4 v0 = *(const LAS u32x4*)(VT + (hf * 32 + d) * 64 + jg * 16), v1 = *(const LAS u32x4*)(VT + (hf * 32 + d) * 64 + jg * 16 + 8);
                float a = o[d] * alpha; a = dot2bf(pp[0], v0.x, a); a = dot2bf(pp[1], v0.y, a); a = dot2bf(pp[2], v0.z, a); a = dot2bf(pp[3], v0.w, a);
                a = dot2bf(pp[4], v1.x, a); a = dot2bf(pp[5], v1.y, a); a = dot2bf(pp[6], v1.z, a); a = dot2bf(pp[7], v1.w, a); o[d] = a; }
        }
    }
    const float il = 1.0f / lrun;
    if (live)
#pragma unroll
    for (int j = 0; j < 4; ++j) { u32x4 w; w.x = pk2(o[8 * j] * il, o[8 * j + 1] * il); w.y = pk2(o[8 * j + 2] * il, o[8 * j + 3] * il); w.z = pk2(o[8 * j + 4] * il, o[8 * j + 5] * il); w.w = pk2(o[8 * j + 6] * il, o[8 * j + 7] * il);
        *(u32x4*)(O + (size_t)grow * 1024 + h * 64 + hf * 32 + 8 * j) = w; }
}
namespace fa {
using bf16x8v = __attribute__((ext_vector_type(8))) short;
using s16x4 = __attribute__((ext_vector_type(4))) short;
using f32x16 = __attribute__((ext_vector_type(16))) float;
constexpr int DMA = 512, DMO = 1024;
constexpr int NW = 8, QBLK = 32, QB = 256, KVBLK = 64;
constexpr int NSLOT = 3, SLOTB = 8192;
constexpr int LDS_K = 0, LDS_V = NSLOT * SLOTB, LDS_WS = 2 * NSLOT * SLOTB, LDS_OST = LDS_WS + NW * 64 * 4, LDS_BYTES = LDS_OST + NW * 4096;
constexpr int LDS_FL = 84992;
constexpr int LDS_SCAN = LDS_FL + (64 + 8192) * 4;
static_assert(LDS_SCAN + 128 <= RING_BYTES, "attention LDS");
__device__ __forceinline__ int crow(int r, int hi) { return (r & 3) + 8 * (r >> 2) + 4 * hi; }
#define SBAR() __builtin_amdgcn_sched_barrier(0)
__device__ __forceinline__ void cmask(f32x16& p0, f32x16& p1, int jb, int qrel, int hi) {
    const float NEG = -INFINITY; int kb = 64 * jb + 4 * hi;
#pragma unroll
    for (int r = 0; r < 16; ++r) { int kv = kb + (r & 3) + 8 * (r >> 2); if (kv > qrel) p0[r] = NEG; if (kv + 32 > qrel) p1[r] = NEG; }
}
__device__ __forceinline__ void glds16(const void* gsrc, unsigned lds_dst) { unsigned keep;
    asm volatile("s_mov_b32 %0, m0\n\ts_mov_b32 m0, %2\n\ts_nop 0\n\tglobal_load_lds_dwordx4 %1, off\n\ts_mov_b32 m0, %0" : "=&s"(keep) : "v"(gsrc), "s"(lds_dst) : "memory"); }
__device__ __forceinline__ float max3f(float a, float b, float c) { float r; asm("v_max3_f32 %0, %1, %2, %3" : "=v"(r) : "v"(a), "v"(b), "v"(c)); return r; }
__device__ __forceinline__ float max2f(float a, float b) { float r; asm("v_max_f32_e32 %0, %1, %2" : "=v"(r) : "v"(a), "v"(b)); return r; }
__device__ __forceinline__ float fsub_s(float a, float b) { float r; asm("v_sub_f32_e32 %0, %1, %2" : "=v"(r) : "v"(a), "v"(b)); return r; }
typedef float f32x2_t __attribute__((ext_vector_type(2))); typedef __bf16 bf16x2_t __attribute__((ext_vector_type(2)));
__device__ __forceinline__ unsigned cvtpk_s(float lo, float hi) { f32x2_t v = {lo, hi}; bf16x2_t b = __builtin_convertvector(v, bf16x2_t); return __builtin_bit_cast(unsigned, b); }
#define WAIT_BAR(N) asm volatile("s_waitcnt vmcnt(" #N ") lgkmcnt(0)\n\ts_barrier" ::: "memory")
typedef __attribute__((address_space(3))) const char* lds_cptr;
typedef short v4i16_t __attribute__((ext_vector_type(4)));
__device__ __forceinline__ void cinit(f32x16& p0, f32x16& p1, const LAS float* fk, float a) {
#pragma unroll
    for (int g = 0; g < 4; ++g) { const f32x4 f0 = *(const LAS f32x4*)(fk + 8 * g), f1 = *(const LAS f32x4*)(fk + 32 + 8 * g);
#pragma unroll
        for (int i = 0; i < 4; ++i) { p0[4 * g + i] = a - f0[i]; p1[4 * g + i] = a - f1[i]; } }
}
__device__ __forceinline__ void qkt(f32x16& p0, f32x16& p1, const char* Kslot, const bf16x8v* qr, int r32, int hi) {
    const char* kb = Kslot + hi * 1024 + r32 * 16;
#pragma unroll
    for (int d0 = 0; d0 < 4; ++d0) {
        const bf16x8v b0 = *reinterpret_cast<const bf16x8v*>(kb + d0 * 2048);
        const bf16x8v b1 = *reinterpret_cast<const bf16x8v*>(kb + d0 * 2048 + 512);
        p0 = __builtin_amdgcn_mfma_f32_32x32x16_bf16(b0, qr[d0], p0, 0, 0, 0); p1 = __builtin_amdgcn_mfma_f32_32x32x16_bf16(b1, qr[d0], p1, 0, 0, 0); }
}
__device__ __forceinline__ void kload8(bf16x8v* kf, lds_cptr kp) {
    kf[0] = *(const LAS bf16x8v*)(kp);        kf[1] = *(const LAS bf16x8v*)(kp + 512);
    kf[2] = *(const LAS bf16x8v*)(kp + 2048); kf[3] = *(const LAS bf16x8v*)(kp + 2560);
    kf[4] = *(const LAS bf16x8v*)(kp + 4096); kf[5] = *(const LAS bf16x8v*)(kp + 4608);
    kf[6] = *(const LAS bf16x8v*)(kp + 6144); kf[7] = *(const LAS bf16x8v*)(kp + 6656);
}
__device__ __forceinline__ void kload2(bf16x8v* kf, lds_cptr kp, int j) { kf[2 * j] = *(const LAS bf16x8v*)(kp + j * 2048); kf[2 * j + 1] = *(const LAS bf16x8v*)(kp + j * 2048 + 512); }
__device__ __forceinline__ s16x4 vtr(lds_cptr p) { return __builtin_bit_cast(s16x4, __builtin_amdgcn_ds_read_tr16_b64_v4i16((LAS v4i16_t*)p)); }
__device__ __forceinline__ float rowmax(const f32x16& p0, const f32x16& p1) {
    float a = max3f(p0[0], p0[1], p1[0]), b = max3f(p0[2], p0[3], p1[1]); a = max3f(a, p1[2], p1[3]);
#pragma unroll
    for (int r = 4; r < 16; r += 4) { a = max3f(a, p0[r], p0[r + 1]); b = max3f(b, p0[r + 2], p0[r + 3]); a = max3f(a, p1[r], p1[r + 1]); b = max3f(b, p1[r + 2], p1[r + 3]); }
    const float m = max2f(a, b);
    auto rr = __builtin_amdgcn_permlane32_swap(__float_as_uint(m), __float_as_uint(m), false, false);
    return max2f(__uint_as_float(rr[0]), __uint_as_float(rr[1]));
}
__device__ __forceinline__ void pv(f32x16* o, int vb, bf16x8v pa0, bf16x8v pa1, bf16x8v pa2, bf16x8v pa3) {
#pragma unroll
    for (int d0 = 0; d0 < 2; ++d0) { s16x4 lo[4], hi[4];
#pragma unroll
        for (int ks = 0; ks < 4; ++ks) {
            asm volatile("ds_read_b64_tr_b16 %0,%1 offset:%c2" : "=&v"(lo[ks]) : "v"(vb), "i"(d0 * 4096 + ks * 1024) : "memory");
            asm volatile("ds_read_b64_tr_b16 %0,%1 offset:%c2" : "=&v"(hi[ks]) : "v"(vb), "i"(d0 * 4096 + ks * 1024 + 512) : "memory"); }
        asm volatile("s_waitcnt lgkmcnt(0)" ::: "memory"); SBAR();
#define PK(k) (bf16x8v){lo[k][0], lo[k][1], lo[k][2], lo[k][3], hi[k][0], hi[k][1], hi[k][2], hi[k][3]}
        o[d0] = __builtin_amdgcn_mfma_f32_32x32x16_bf16(pa0, PK(0), o[d0], 0, 0, 0);
        o[d0] = __builtin_amdgcn_mfma_f32_32x32x16_bf16(pa1, PK(1), o[d0], 0, 0, 0);
        o[d0] = __builtin_amdgcn_mfma_f32_32x32x16_bf16(pa2, PK(2), o[d0], 0, 0, 0);
        o[d0] = __builtin_amdgcn_mfma_f32_32x32x16_bf16(pa3, PK(3), o[d0], 0, 0, 0);
#undef PK
    }
}
template <int THRL> __device__ __forceinline__ void attn_unit(int b, int h, int qb, int tf, const bf16* Q, const bf16* __restrict__ K, const bf16* __restrict__ V, bf16* O, char* shm, int wid) {
    const int lane = lane_id_opaque(), r32 = lane & 31, hi = lane >> 5;
    const long rowbase = (long)b * SEQ; const int q0 = qb * QB;
    const bf16* Qw = Q + (rowbase + q0 + wid * QBLK) * DMA + h * 64;
    const bf16* Kh = K + rowbase * DMA + h * 64, *Vh = V + rowbase * DMA + h * 64;
    const bf16* Km = K + (long)TX * DMA + h * 64, *Vm = V + (long)TX * DMA + h * 64;
    const unsigned lds0 = (unsigned)(uintptr_t)shm;
    float* wsf = (float*)(shm + LDS_WS) + wid * 64;
    const bf16* ksrc = Kh + (long)lane * DMA + wid * 8;
    const bf16* vsrc = Vh + (long)(16 * (wid & 3) + (lane >> 2)) * DMA + (wid >> 2) * 32 + (lane & 3) * 8;
    const bf16* ksrcm = Km + (long)lane * DMA + wid * 8;
    const bf16* vsrcm = Vm + (long)(16 * (wid & 3) + (lane >> 2)) * DMA + (wid >> 2) * 32 + (lane & 3) * 8;
    const unsigned kdst = lds0 + LDS_K + wid * 1024, vdst = lds0 + LDS_V + wid * 1024;
#define DMA_K(t, slot) glds16(ksrc + (long)((t) - 1) * KVBLK * DMA, (unsigned)__builtin_amdgcn_readfirstlane(kdst + (slot)))
#define DMA_V(t, slot) glds16(vsrc + (long)((t) - 1) * KVBLK * DMA, (unsigned)__builtin_amdgcn_readfirstlane(vdst + (slot)))
    const int vb0 = (int)(lds0 + LDS_V) + ((lane >> 4) & 1) * 32 + (lane & 3) * 8 + (4 * hi + ((lane & 15) >> 2)) * 64;
    const char* Kbase = shm + LDS_K; bf16x8v kf[8];
    const lds_cptr shm3 = (lds_cptr)shm; const lds_cptr kp0 = shm3 + LDS_K + hi * 1024 + r32 * 16; const lds_cptr vp0 = shm3 + LDS_V + ((lane >> 4) & 1) * 32 + (lane & 3) * 8 + (4 * hi + ((lane & 15) >> 2)) * 64;
    const LAS float* Flp = (const LAS float*)(shm3 + LDS_FL) + 4 * hi;
    const int NT = 4 * qb + 5;
    glds16(tf == 0 ? ksrcm : ksrc + (long)(tf - 1) * KVBLK * DMA, (unsigned)__builtin_amdgcn_readfirstlane(kdst)); glds16(tf == 0 ? vsrcm : vsrc + (long)(tf - 1) * KVBLK * DMA, (unsigned)__builtin_amdgcn_readfirstlane(vdst)); DMA_K(tf + 1, SLOTB);
    bf16x8v qr[4];
#pragma unroll
    for (int d0 = 0; d0 < 4; ++d0) qr[d0] = *reinterpret_cast<const bf16x8v*>(&Qw[(long)r32 * DMA + d0 * 16 + hi * 8]);
    float aq = ((const LAS float*)(shm3 + LDS_FL))[64 + q0 + wid * QBLK + r32 - 64 * tf];
    float l_reg = 0.f; f32x16 o[2]; o[0] = f32x16{}; o[1] = f32x16{};
    const int qrel = wid * QBLK + r32;
#define CMASK(P0, P1, t) do { int jb_ = (t) - (NT - 4); if (jb_ >= 0) cmask(P0, P1, jb_, qrel, hi); } while (0)
    bool resc = false;
#define START(P0, P1) do { const float rm = rowmax(P0, P1); resc = false; \
    { const float dl = max2f(rm, 0.f); aq = fsub_s(aq, dl);        \
      _Pragma("unroll") for (int r = 0; r < 16; ++r) { P0[r] = fsub_s(P0[r], dl); P1[r] = fsub_s(P1[r], dl); } } \
    _Pragma("unroll") for (int r = 0; r < 16; ++r) P0[r] = __builtin_amdgcn_exp2f(P0[r]); } while (0)
#define RESC() do { if (resc) { asm volatile("s_waitcnt lgkmcnt(0)" ::: "memory"); \
      _Pragma("unroll") for (int d_ = 0; d_ < 2; ++d_) _Pragma("unroll") for (int r = 0; r < 16; ++r) o[d_][r] *= wsf[crow(r, hi)]; } } while (0)
    f32x16 pA0, pA1, pB0, pB1;
    int sl_prev = 0, sl_cur = 0, sl_next = SLOTB;
#define ROT() do { sl_prev = sl_cur; sl_cur = sl_next; sl_next = (sl_next == (NSLOT - 1) * SLOTB) ? 0 : sl_next + SLOTB; } while (0)
    DMA_K(tf + 2, 2 * SLOTB);
    cinit(pA0, pA1, Flp, aq);
    WAIT_BAR(3);
    qkt(pA0, pA1, Kbase, qr, r32, hi); asm volatile("s_nop 15\n\ts_nop 7" : "+v"(pA0), "+v"(pA1));
    START(pA0, pA1);
    _Pragma("unroll") for (int r = 0; r < 16; ++r) pA1[r] = __builtin_amdgcn_exp2f(pA1[r]);
    WAIT_BAR(0);
    DMA_K(tf + 3, 0); DMA_V(tf + 1, SLOTB);
    ROT();
    kload8(kf, kp0 + sl_cur);
    WAIT_BAR(2);
    s16x4 vlo[8], vhi[8]; u32x4 pw0, pw1, pw2, pw3;
#define PKW(P, B) cvtpk_s(P[B], P[B + 1])
#define PAF(k) __builtin_bit_cast(bf16x8v, pw##k)
#define VFR(i) (bf16x8v){vlo[i][0], vlo[i][1], vlo[i][2], vlo[i][3], vhi[i][0], vhi[i][1], vhi[i][2], vhi[i][3]}
#define PIN(x) asm volatile("" : "+v"(x))
#define MX3(a, b, c) __builtin_fmaxf(__builtin_fmaxf((a), (b)), (c))
#define GAPA(MF, A0, A1, A2, A3, W0, W1, PW) do { MF; sacc += A0; sacc += A1; sacc += A2; sacc += A3; PIN(sacc); W0; W1; PIN(PW); SBAR(); } while (0)
#define EX(v) __builtin_amdgcn_exp2f(v)
#define GAPB(MF, X, B) do { MF; X[B] = EX(X[B]); X[B + 1] = EX(X[B + 1]); X[B + 2] = EX(X[B + 2]); X[B + 3] = EX(X[B + 3]); PIN(X); SBAR(); } while (0)
#define VRD(i) do { vlo[i] = vtr(vp_ + (((i) >> 2) * 4096 + ((i) & 3) * 1024)); vhi[i] = vtr(vp_ + (((i) >> 2) * 4096 + ((i) & 3) * 1024 + 512)); } while (0)
#define KRD(G, j) do { if (G) { kload2(kf, kp0 + sl_next, j); SBAR(); } } while (0)
#define STEP(C0, C1, P0, P1, t, GK, GV, GL) do { SBAR(); \
    cinit(C0, C1, Flp + 64 * ((t) - tf), aq); SBAR(); \
    const lds_cptr vp_ = vp0 + sl_prev; \
    VRD(0); SBAR(); float sacc = (P0[0] + P0[1]); \
    GAPA(C0 = __builtin_amdgcn_mfma_f32_32x32x16_bf16(kf[0], qr[0], C0, 0, 0, 0), P0[2], P0[3], P0[4], P0[5],     pw0[0] = PKW(P0, 0), pw0[1] = PKW(P0, 2), pw0); \
    VRD(4); SBAR(); GAPA(C1 = __builtin_amdgcn_mfma_f32_32x32x16_bf16(kf[1], qr[0], C1, 0, 0, 0), P0[6], P0[7], P0[8], P0[9],     pw0[2] = PKW(P0, 4), pw0[3] = PKW(P0, 6), pw0); \
    VRD(1); SBAR(); GAPA(C0 = __builtin_amdgcn_mfma_f32_32x32x16_bf16(kf[2], qr[1], C0, 0, 0, 0),   P0[10], P0[11], P0[12], P0[13], pw1[0] = PKW(P0, 8), pw1[1] = PKW(P0, 10), pw1); \
    VRD(5); SBAR(); GAPA(C1 = __builtin_amdgcn_mfma_f32_32x32x16_bf16(kf[3], qr[1], C1, 0, 0, 0),   P0[14], P0[15], P1[0], P1[1],   pw1[2] = PKW(P0, 12), pw1[3] = PKW(P0, 14), pw1); \
    VRD(2); SBAR(); GAPA(C0 = __builtin_amdgcn_mfma_f32_32x32x16_bf16(kf[4], qr[2], C0, 0, 0, 0),   P1[2], P1[3], P1[4], P1[5],     pw2[0] = PKW(P1, 0), pw2[1] = PKW(P1, 2), pw2); \
    VRD(6); SBAR(); GAPA(C1 = __builtin_amdgcn_mfma_f32_32x32x16_bf16(kf[5], qr[2], C1, 0, 0, 0),   P1[6], P1[7], P1[8], P1[9],     pw2[2] = PKW(P1, 4), pw2[3] = PKW(P1, 6), pw2); \
    VRD(3); SBAR(); GAPA(C0 = __builtin_amdgcn_mfma_f32_32x32x16_bf16(kf[6], qr[3], C0, 0, 0, 0),   P1[10], P1[11], P1[12], P1[13], pw3[0] = PKW(P1, 8), pw3[1] = PKW(P1, 10), pw3); \
    VRD(7); SBAR(); GAPA(C1 = __builtin_amdgcn_mfma_f32_32x32x16_bf16(kf[7], qr[3], C1, 0, 0, 0),   P1[14], P1[15], 0.f, 0.f,       pw3[2] = PKW(P1, 12), pw3[3] = PKW(P1, 14), pw3); \
    l_reg += sacc; \
    if (GK) { DMA_K((t) + 3, sl_cur); } if (GV) { DMA_V((t) + 1, sl_next); } \
    CMASK(C0, C1, t); \
    { float a = MX3(C0[0], C0[1], C1[0]), b_ = MX3(C0[2], C0[3], C1[1]); a = MX3(a, C1[2], C1[3]); \
      _Pragma("unroll") for (int r = 4; r < 16; r += 4) { a = MX3(a, C0[r], C0[r + 1]); b_ = MX3(b_, C0[r + 2], C0[r + 3]); a = MX3(a, C1[r], C1[r + 1]); b_ = MX3(b_, C1[r + 2], C1[r + 3]); } \
      float rm = __builtin_fmaxf(a, b_); { auto rr = __builtin_amdgcn_permlane32_swap(__float_as_uint(rm), __float_as_uint(rm), false, false); rm = __builtin_fmaxf(__uint_as_float(rr[0]), __uint_as_float(rr[1])); } \
      resc = false; \
      if (__builtin_expect(__any(rm > (float)THRL), 0)) { const float dl = __builtin_fmaxf(rm, 0.f); aq -= dl; \
        _Pragma("unroll") for (int r = 0; r < 16; ++r) { C0[r] -= dl; C1[r] -= dl; } \
        const float f = __builtin_amdgcn_exp2f(-dl); l_reg *= f; if (hi == 0) wsf[r32] = f; resc = true; } } \
    SBAR(); \
    GAPB(o[0] = __builtin_amdgcn_mfma_f32_32x32x16_bf16(PAF(0), VFR(0), o[0], 0, 0, 0), C0, 0); \
    GAPB(o[1] = __builtin_amdgcn_mfma_f32_32x32x16_bf16(PAF(0), VFR(4), o[1], 0, 0, 0), C0, 4); \
    KRD(GL, 0); GAPB(o[0] = __builtin_amdgcn_mfma_f32_32x32x16_bf16(PAF(1), VFR(1), o[0], 0, 0, 0), C0, 8); \
    KRD(GL, 1); GAPB(o[1] = __builtin_amdgcn_mfma_f32_32x32x16_bf16(PAF(1), VFR(5), o[1], 0, 0, 0), C0, 12); \
    KRD(GL, 2); GAPB(o[0] = __builtin_amdgcn_mfma_f32_32x32x16_bf16(PAF(2), VFR(2), o[0], 0, 0, 0), C1, 0); \
    KRD(GL, 3); GAPB(o[1] = __builtin_amdgcn_mfma_f32_32x32x16_bf16(PAF(2), VFR(6), o[1], 0, 0, 0), C1, 4); \
    GAPB(o[0] = __builtin_amdgcn_mfma_f32_32x32x16_bf16(PAF(3), VFR(3), o[0], 0, 0, 0), C1, 8); \
    GAPB(o[1] = __builtin_amdgcn_mfma_f32_32x32x16_bf16(PAF(3), VFR(7), o[1], 0, 0, 0), C1, 12); \
    } while (0)
    int t = tf + 1;
#undef CMASK
#define CMASK(P0, P1, t) do { } while (0)
    for (; t + 5 < NT; t += 2) {
        STEP(pB0, pB1, pA0, pA1, t, true, true, true);     WAIT_BAR(2); RESC(); ROT();
        STEP(pA0, pA1, pB0, pB1, t + 1, true, true, true); WAIT_BAR(2); RESC(); ROT();
    }
#undef CMASK
#define CMASK(P0, P1, t) do { int jb_ = (t) - (NT - 4); if (jb_ >= 0) cmask(P0, P1, jb_, qrel, hi); } while (0)
#define ENDW(tt) do { if ((tt) + 3 < NT) { WAIT_BAR(2); } else if ((tt) + 2 < NT) { WAIT_BAR(1); } else { WAIT_BAR(0); } } while (0)
    for (; t + 1 < NT; t += 2) {
        STEP(pB0, pB1, pA0, pA1, t, (t + 3 < NT), (t + 1 < NT), (t + 1 < NT));         ENDW(t);     RESC(); ROT();
        STEP(pA0, pA1, pB0, pB1, t + 1, (t + 4 < NT), (t + 2 < NT), (t + 2 < NT));     ENDW(t + 1); RESC(); ROT();
    }
    { float sacc = pA0[0] + pA0[1]; _Pragma("unroll") for (int r = 2; r < 16; ++r) sacc += pA0[r]; _Pragma("unroll") for (int r = 0; r < 16; ++r) sacc += pA1[r]; l_reg += sacc;
      pw0 = (u32x4){PKW(pA0, 0), PKW(pA0, 2), PKW(pA0, 4), PKW(pA0, 6)}; pw1 = (u32x4){PKW(pA0, 8), PKW(pA0, 10), PKW(pA0, 12), PKW(pA0, 14)}; pw2 = (u32x4){PKW(pA1, 0), PKW(pA1, 2), PKW(pA1, 4), PKW(pA1, 6)}; pw3 = (u32x4){PKW(pA1, 8), PKW(pA1, 10), PKW(pA1, 12), PKW(pA1, 14)};
      SBAR(); pv(o, vb0 + sl_prev, PAF(0), PAF(1), PAF(2), PAF(3)); }
#undef PKW
#undef PAF
#undef VFR
#undef PIN
#undef MX3
#undef GAPA
#undef GAPB
#undef EX
#undef VRD
#undef KRD
#undef STEP
#undef ENDW
    { auto rr = __builtin_amdgcn_permlane32_swap(__float_as_uint(l_reg), __float_as_uint(l_reg), false, false); l_reg = __uint_as_float(rr[0]) + __uint_as_float(rr[1]); }
    if (hi == 0) wsf[32 + r32] = l_reg; asm volatile("s_waitcnt lgkmcnt(0)" ::: "memory");
    float rli[16];
#pragma unroll
    for (int r = 0; r < 16; ++r) rli[r] = __builtin_amdgcn_rcpf(wsf[32 + crow(r, hi)]);
    bf16* Ow = O + (rowbase + q0 + wid * QBLK) * DMO + h * 64;
    { bf16* stg = (bf16*)(shm + LDS_OST) + wid * 2048;
#pragma unroll
      for (int r = 0; r < 16; ++r) { const int orow = crow(r, hi);
#pragma unroll
          for (int d0 = 0; d0 < 2; ++d0) stg[orow * 64 + d0 * 32 + r32] = (bf16)f2bf(o[d0][r] * rli[r]); }
      asm volatile("s_waitcnt lgkmcnt(0)" ::: "memory");
#pragma unroll
      for (int i = 0; i < 4; ++i) { const int row = i * 8 + (lane >> 3), ch = lane & 7; const u32x4 v = *(const u32x4*)(stg + row * 64 + ch * 8); *(u32x4*)(Ow + (long)row * DMO + ch * 8) = v; } }
    asm volatile("s_waitcnt lgkmcnt(0)\n\ts_barrier" ::: "memory");
#undef DMA_K
#undef DMA_V
#undef CMASK
#undef START
#undef RESC
#undef ROT
}
#undef SBAR
#undef WAIT_BAR
}
__device__ __forceinline__ void phase_scan(Frame& F) {
#pragma unroll 1
    for (int bh = F.vcu; bh < 32; bh += F.G) {
        attn_scan(F, bh >> 3, bh & 7, false, fa::LDS_FL, fa::LDS_SCAN);
        const LAS float* Fl = (const LAS float*)(F.lds + fa::LDS_FL); float* FLg = (float*)(WSP() + WS_FL) + (size_t)bh * FLN;
#pragma unroll 1
        for (int i = F.tid; i < FLN / 4; i += 512) *(f32x4*)(FLg + 4 * i) = *(const LAS f32x4*)(Fl + 4 * i);
    }
    __syncthreads();
}
__device__ __forceinline__ void phase_B(Frame& F, int l) {
    LAS int* qs = (LAS int*)(F.lds + LC_QS);
    unsigned* ctl = (unsigned*)(WSP() + WS_CTL); unsigned* head = ctl + CW_AQ + l * 64; const unsigned* nrm = ctl + CW_NRM + l * 64;
    const float* FLg = (const float*)(WSP() + WS_FL);
#pragma unroll 1
    for (;;) {
        __syncthreads();
        if (F.tid == 0) { qs[0] = (int)atomicAdd(head, 1u); qs[1] = 0; }
        __syncthreads();
        const int u = __builtin_amdgcn_readfirstlane(qs[0]);
        if (u >= 1032) break;
        if (u < 1024) {
            const int qb = 31 - (u >> 5), bh = u & 31, b = bh >> 3, h = bh & 7, NT = 4 * qb + 5;
            const float kn = __uint_as_float(__hip_atomic_load(nrm + bh, __ATOMIC_RELAXED, __HIP_MEMORY_SCOPE_AGENT)), qn = __uint_as_float(__hip_atomic_load(nrm + 32 + bh, __ATOMIC_RELAXED, __HIP_MEMORY_SCOPE_AGENT));
            const float T = 36.0f + sqrtf(kn * qn);
            const float* FLb = FLg + (size_t)bh * FLN; const float Fq0 = FLb[64 + 256 * qb];
            { const int t = F.tid; const bool skip = (t <= NT - 5) && (FLb[t == 0 ? 15 : 64 * t + 63] > Fq0 + T);
              const int c = __builtin_popcountll(__ballot(skip)); if (F.lane == 0 && c) __hip_atomic_fetch_add(&qs[1], c, __ATOMIC_RELAXED, __HIP_MEMORY_SCOPE_WORKGROUP); }
            __syncthreads();
            int tf = __builtin_amdgcn_readfirstlane(qs[1]); if (((NT - tf) & 1) == 0) tf -= 1;
            { LAS float* Fl = (LAS float*)(F.lds + fa::LDS_FL); const int n4 = (NT - tf) * 16;
#pragma unroll 1
              for (int i = F.tid; i < n4; i += 512) *(LAS f32x4*)(Fl + 4 * i) = *(const f32x4*)(FLb + 64 * tf + 4 * i); }
            __syncthreads();
            unsigned char* dol = DOP();
            fa::attn_unit<8>(b, h, qb, tf, (const bf16*)(dol + DO_Q), (const bf16*)(dol + DO_K), (const bf16*)(dol + DO_V), (bf16*)(WSP() + WS_X3) + 512, (char*)F.lds, F.wave);
        } else {
            const int t_ = F.wave * 64 + lane_id_opaque(); F.tid = t_; F.lane = t_ & 63;
            attn_scan(F, 0, u - 1024, true, AT_FL, AT_SC); attn_unit_naive(F, TX, 0, 1, 0, u - 1024, NMETA);
        }
    }
    __syncthreads();
}

__device__ __forceinline__ void class_tables(Frame& F, int l) {
    LAS int* base = (LAS int*)(F.lds + LC_BASE); LAS int* pcls = (LAS int*)(F.lds + LC_PCLS); LAS int* np = (LAS int*)(F.lds + LC_NP);
    const unsigned* gcnt = (const unsigned*)(WSP() + WS_CTL) + CW_GCNT + l * 64;
    __syncthreads();
    if (F.tid == 0) { int p = 0;
#pragma unroll 1
        for (int c = 0; c < NCLS; ++c) { base[c] = p * 256; int n = (int)__hip_atomic_load(gcnt + c, __ATOMIC_RELAXED, __HIP_MEMORY_SCOPE_AGENT); if (n > TR) n = TR; if (n < 0) n = 0; p += (n + 255) >> 8; }
        if (p > 160) p = 160; base[NCLS] = p * 256; np[0] = p; }
    __syncthreads();
    if (F.tid < 160) { const int mypos = F.tid * 256; int c = 0;
#pragma unroll 1
        for (int k = 1; k < NCLS; ++k) if (base[k] <= mypos) c = k;
        pcls[F.tid] = c; }
    __syncthreads();
}
template <int NG, int CH> __device__ __forceinline__ void e1_groups(Frame& F, int l, const int (&rowv)[NG], const int (&grpv)[NG], const LAS bf16* Rhi, const LAS bf16* Rlo, LAS int* rec, LAS int* lcnt,
                                                                   const float* reb, const float* rgb, int fr, int fq) {
    const float* hsrc[NG]; bf16* hbdst[NG]; const bf16* dsrc[NG];
#pragma unroll
    for (int g = 0; g < NG; ++g) { const int row = rowv[g];
        hsrc[g] = l == 0 ? (row < TX ? INP(I_X) + (size_t)row * D : INP(I_META) + (size_t)(row - TX) * D) : (const float*)(WSP() + WS_H) + (size_t)row * D;
        hbdst[g] = (bf16*)(WSP() + WS_HB) + (size_t)row * D; dsrc[g] = (const bf16*)(WSP() + WS_X3) + (size_t)row * D; }
    const LAS bf16* bh0 = Rhi + fr * RPITCH + 8 * fq; const LAS bf16* bl0 = Rlo + fr * RPITCH + 8 * fq;
    const LAS bf16* bh1 = Rhi + (16 + (fr & 3)) * RPITCH + 8 * fq; const LAS bf16* bl1 = Rlo + (16 + (fr & 3)) * RPITCH + 8 * fq;
    f32x4 acc0[NG], acc1[NG]; float ss[NG];
#pragma unroll
    for (int g = 0; g < NG; ++g) { acc0[g] = (f32x4){0.f, 0.f, 0.f, 0.f}; acc1[g] = acc0[g]; ss[g] = 0.f; }
    f32x4 ch0[NG][CH], ch1[NG][CH]; u32x4 cd[NG][CH];
#pragma unroll
    for (int g = 0; g < NG; ++g)
#pragma unroll
        for (int c = 0; c < CH; ++c) { const int k = 32 * c + 8 * fq; ch0[g][c] = *(const f32x4*)(hsrc[g] + k); ch1[g][c] = *(const f32x4*)(hsrc[g] + k + 4); cd[g][c] = *(const u32x4*)(dsrc[g] + k); }
#pragma unroll 1
    for (int s0 = 0; s0 < 32; s0 += CH) {
        f32x4 nh0[NG][CH], nh1[NG][CH]; u32x4 nd[NG][CH];
        if (s0 + CH < 32) {
#pragma unroll
            for (int g = 0; g < NG; ++g)
#pragma unroll
                for (int c = 0; c < CH; ++c) { const int k = 32 * (s0 + CH + c) + 8 * fq; nh0[g][c] = *(const f32x4*)(hsrc[g] + k); nh1[g][c] = *(const f32x4*)(hsrc[g] + k + 4); nd[g][c] = *(const u32x4*)(dsrc[g] + k); }
        }
#pragma unroll
        for (int c = 0; c < CH; ++c) { const int s = s0 + c, k = 32 * s + 8 * fq;
            const bf16x8 wh0 = *(const LAS bf16x8*)(bh0 + 32 * s), wl0 = *(const LAS bf16x8*)(bl0 + 32 * s);
            bf16x8 wh1 = *(const LAS bf16x8*)(bh1 + 32 * s), wl1 = *(const LAS bf16x8*)(bl1 + 32 * s);
            if (fr >= 4) { wh1 = (bf16x8){0, 0, 0, 0, 0, 0, 0, 0}; wl1 = wh1; }
#pragma unroll
            for (int g = 0; g < NG; ++g) { f32x4 h0 = ch0[g][c], h1 = ch1[g][c]; const u32x4 dv = cd[g][c];
                h0[0] += bflo(dv.x); h0[1] += bfhi(dv.x); h0[2] += bflo(dv.y); h0[3] += bfhi(dv.y); h1[0] += bflo(dv.z); h1[1] += bfhi(dv.z); h1[2] += bflo(dv.w); h1[3] += bfhi(dv.w);
                ss[g] += (h0[0] * h0[0] + h0[1] * h0[1]) + (h0[2] * h0[2] + h0[3] * h0[3]) + (h1[0] * h1[0] + h1[1] * h1[1]) + (h1[2] * h1[2] + h1[3] * h1[3]);
                const u32x4 hw = pack8(h0, h1); *(u32x4*)(hbdst[g] + k) = hw;
                f32x4 r0, r1; r0[0] = h0[0] - bflo(hw.x); r0[1] = h0[1] - bfhi(hw.x); r0[2] = h0[2] - bflo(hw.y); r0[3] = h0[3] - bfhi(hw.y);
                r1[0] = h1[0] - bflo(hw.z); r1[1] = h1[1] - bfhi(hw.z); r1[2] = h1[2] - bflo(hw.w); r1[3] = h1[3] - bfhi(hw.w);
                const u32x4 lw = pack8(r0, r1);
                const bf16x8 ah = __builtin_bit_cast(bf16x8, hw), al = __builtin_bit_cast(bf16x8, lw);
                acc0[g] = __builtin_amdgcn_mfma_f32_16x16x32_bf16(wh0, ah, acc0[g], 0, 0, 0); acc0[g] = __builtin_amdgcn_mfma_f32_16x16x32_bf16(wh0, al, acc0[g], 0, 0, 0); acc0[g] = __builtin_amdgcn_mfma_f32_16x16x32_bf16(wl0, ah, acc0[g], 0, 0, 0);
                acc1[g] = __builtin_amdgcn_mfma_f32_16x16x32_bf16(wh1, ah, acc1[g], 0, 0, 0); acc1[g] = __builtin_amdgcn_mfma_f32_16x16x32_bf16(wh1, al, acc1[g], 0, 0, 0); acc1[g] = __builtin_amdgcn_mfma_f32_16x16x32_bf16(wl1, ah, acc1[g], 0, 0, 0); } }
        if (s0 + CH < 32) {
#pragma unroll
            for (int g = 0; g < NG; ++g)
#pragma unroll
                for (int c = 0; c < CH; ++c) { ch0[g][c] = nh0[g][c]; ch1[g][c] = nh1[g][c]; cd[g][c] = nd[g][c]; }
        }
    }
#pragma unroll
    for (int g = 0; g < NG; ++g) {
        float sg = ss[g]; sg += lane_xor<16>(sg); sg += lane_xor<32>(sg);
        const float rstd2 = rsqrtf(sg * (1.0f / D) + EPS);
        float gl[4];
#pragma unroll
        for (int q = 0; q < 4; ++q) gl[q] = __int_as_float(__builtin_amdgcn_ds_bpermute(fr << 2, __float_as_int(acc1[g][q]))) * rstd2 + rgb[q];
        int gsel = 0; float gmax = gl[0];
#pragma unroll
        for (int q = 1; q < 4; ++q) if (gl[q] > gmax) { gmax = gl[q]; gsel = q; }
        float gsum = 0.f;
#pragma unroll
        for (int q = 0; q < 4; ++q) gsum += __expf(gl[q] - gmax);
        const float gwt = 1.0f / gsum;
        if (fq == gsel) {
            float el[4];
#pragma unroll
            for (int e = 0; e < 4; ++e) el[e] = acc0[g][e] * rstd2 + reb[gsel * 4 + e];
            int t1 = 0; float l1 = el[0];
#pragma unroll
            for (int e = 1; e < 4; ++e) if (el[e] > l1) { l1 = el[e]; t1 = e; }
            int t2 = -1; float l2 = -3.0e38f;
#pragma unroll
            for (int e = 0; e < 4; ++e) if (e != t1 && el[e] > l2) { l2 = el[e]; t2 = e; }
            const float w1 = 1.0f / (1.0f + __expf(l2 - l1)), w2 = 1.0f - w1;
            const int ea = min(t1, t2), eb = max(t1, t2); const float cA = gwt * (t1 == ea ? w1 : w2), cB = gwt * (t1 == ea ? w2 : w1);
            const int pr = ea == 0 ? eb - 1 : (ea == 1 ? eb + 1 : 5); int cls = gsel * 6 + pr; if (!(cls >= 0 && cls < NCLS)) cls = 0;
            const int rank = __hip_atomic_fetch_add(&lcnt[cls], 1, __ATOMIC_RELAXED, __HIP_MEMORY_SCOPE_WORKGROUP); const int rr = grpv[g] * 16 + fr;
            rec[rr * 5] = cls; rec[rr * 5 + 1] = rank; rec[rr * 5 + 2] = __float_as_int(cA); rec[rr * 5 + 3] = __float_as_int(cB); rec[rr * 5 + 4] = __float_as_int(rstd2);
        }
    }
}
__device__ __forceinline__ void phase_E1(Frame& F, int l) {
    LAS bf16* Rhi = (LAS bf16*)F.lds; LAS bf16* Rlo = Rhi + 20 * RPITCH;
    LAS int* rec = (LAS int*)(F.lds + 83968);
    LAS int* lcnt = (LAS int*)(F.lds + LC_CNT); LAS int* wgb = (LAS int*)(F.lds + LC_BASE);
    const float* rg = (const float*)(WSP() + WS_RG);
    const float* reb = INP(I_REB) + l * 16; const float* rgb = INP(I_RGB) + l * 4;
    unsigned* gcnt = (unsigned*)(WSP() + WS_CTL) + CW_GCNT + l * 64; int* route = (int*)(WSP() + WS_ROUTE);
    const int tid = F.tid, lane = F.lane, wave = F.wave, fr = lane & 15, fq = lane >> 4;
    { f32x4 rv[10];
#pragma unroll
      for (int j = 0; j < 10; ++j) rv[j] = *(const f32x4*)(rg + 4 * (tid + 512 * j));
#pragma unroll
      for (int j = 0; j < 10; ++j) { const int i = 4 * (tid + 512 * j), c = i >> 10, k = i & 1023; u32x2 hw, lw; float hf[4];
#pragma unroll
          for (int e = 0; e < 4; ++e) hf[e] = __builtin_bit_cast(float, (pk2(rv[j][e], 0.f) & 0xffffu) << 16);
          hw.x = pk2(rv[j][0], rv[j][1]); hw.y = pk2(rv[j][2], rv[j][3]); lw.x = pk2(rv[j][0] - hf[0], rv[j][1] - hf[1]); lw.y = pk2(rv[j][2] - hf[2], rv[j][3] - hf[3]);
          *(LAS u32x2*)(Rhi + c * RPITCH + k) = hw; *(LAS u32x2*)(Rlo + c * RPITCH + k) = lw; } }
    { int* TOK = (int*)(WSP() + WS_TOK);
#pragma unroll 1
      for (int p = F.vcu * 512 + tid; p < NPOSMAX; p += F.G * 512) TOK[p] = -1; }
#pragma unroll 1
    for (int wg = F.vcu; wg < 256; wg += F.G) {
        if (tid < NCLS) lcnt[tid] = 0;
        __syncthreads();
        const int ngrp = wg == 0 ? 9 : 8;
        if (wg == 0 && wave == 0) { const int rows2[2] = {fr, TX + fr}; const int grps2[2] = {0, 8}; e1_groups<2, 2>(F, l, rows2, grps2, Rhi, Rlo, rec, lcnt, reb, rgb, fr, fq); }
        else { const int rows1[1] = {wg * 128 + wave * 16 + fr}; const int grps1[1] = {wave}; e1_groups<1, 4>(F, l, rows1, grps1, Rhi, Rlo, rec, lcnt, reb, rgb, fr, fq); }
        __syncthreads();
        if (tid < NCLS) { const int n = lcnt[tid]; wgb[tid] = n > 0 ? (int)atomicAdd(gcnt + tid, (unsigned)n) : 0; }
        __syncthreads();
        const int nrw = ngrp * 16;
        for (int rr = tid; rr < nrw; rr += 512) { const int row = rr < 128 ? wg * 128 + rr : TX + (rr - 128); const int cls = rec[rr * 5];
            int* rp = route + (size_t)row * 8; rp[0] = cls; rp[1] = wgb[cls] + rec[rr * 5 + 1]; rp[2] = rec[rr * 5 + 2]; rp[3] = rec[rr * 5 + 3]; rp[4] = rec[rr * 5 + 4]; }
        __syncthreads();
    }
}
__device__ __forceinline__ void phase_E1b(Frame& F, int l) {
    class_tables(F, l);
    const LAS int* base = (const LAS int*)(F.lds + LC_BASE);
    const int* route = (const int*)(WSP() + WS_ROUTE); int* TOK = (int*)(WSP() + WS_TOK); float* PW = (float*)(WSP() + WS_PW);
#pragma unroll 1
    for (int row = F.vcu * 512 + F.tid; row < TR; row += F.G * 512) { const int* rp = route + (size_t)row * 8; const int pos = base[rp[0]] + rp[1];
        if (pos < 0 || pos >= NPOSMAX) continue;
        TOK[pos] = row; f32x4 w; w[0] = __int_as_float(rp[4]); w[1] = __int_as_float(rp[2]); w[2] = __int_as_float(rp[3]); w[3] = 0.f; *(f32x4*)(PW + (size_t)pos * 4) = w; }
}
__device__ __forceinline__ void phase_E4(Frame& F, int l) {
    class_tables(F, l);
    const LAS int* base = (const LAS int*)(F.lds + LC_BASE);
    const int* route = (const int*)(WSP() + WS_ROUTE); float* H = (float*)(WSP() + WS_H); bf16* HB = (bf16*)(WSP() + WS_HB); const bf16* Y = (const bf16*)(WSP() + WS_Y);
    float* rstd1 = (float*)(WSP() + WS_RSTD1); const float* fg = INP(I_FG); float* out = (float*)DOP(); const bf16* DL = (const bf16*)(WSP() + WS_X3);
    const int gw = F.vcu * NWAVES + F.wave, NGW = F.G * NWAVES, lane = F.lane; const bool lastl = (l == DEPTH - 1);
    constexpr int R = 4;
#pragma unroll 1
    for (int row0 = gw; row0 < TR; row0 += R * NGW) {
        int rowv[R], pos[R];
#pragma unroll
        for (int r = 0; r < R; ++r) { const int row = row0 + r * NGW; rowv[r] = row < TR ? row : TR - 1; const int* rp = route + (size_t)rowv[r] * 8; int p = base[rp[0]] + rp[1]; if (p < 0 || p >= NPOSMAX) p = 0; pos[r] = p; }
        u32x4 yw[R][2], dw[R][2]; f32x4 hv[R][2][2];
#pragma unroll
        for (int r = 0; r < R; ++r)
#pragma unroll
            for (int j = 0; j < 2; ++j) { yw[r][j] = *(const u32x4*)(Y + (size_t)pos[r] * D + 8 * lane + 512 * j);
                const float* hs = l == 0 ? (rowv[r] < TX ? INP(I_X) + (size_t)rowv[r] * D : INP(I_META) + (size_t)(rowv[r] - TX) * D) : H + (size_t)rowv[r] * D;
                hv[r][j][0] = *(const f32x4*)(hs + 8 * lane + 512 * j); hv[r][j][1] = *(const f32x4*)(hs + 8 * lane + 512 * j + 4); dw[r][j] = *(const u32x4*)(DL + (size_t)rowv[r] * D + 8 * lane + 512 * j); }
#pragma unroll
        for (int r = 0; r < R; ++r) { const int row = row0 + r * NGW; float ss = 0.f;
#pragma unroll
            for (int j = 0; j < 2; ++j) { const u32x4 w = yw[r][j], d4 = dw[r][j];
                hv[r][j][0][0] += bflo(d4.x); hv[r][j][0][1] += bfhi(d4.x); hv[r][j][0][2] += bflo(d4.y); hv[r][j][0][3] += bfhi(d4.y); hv[r][j][1][0] += bflo(d4.z); hv[r][j][1][1] += bfhi(d4.z); hv[r][j][1][2] += bflo(d4.w); hv[r][j][1][3] += bfhi(d4.w);
                hv[r][j][0][0] += bflo(w.x); hv[r][j][0][1] += bfhi(w.x); hv[r][j][0][2] += bflo(w.y); hv[r][j][0][3] += bfhi(w.y);
                hv[r][j][1][0] += bflo(w.z); hv[r][j][1][1] += bfhi(w.z); hv[r][j][1][2] += bflo(w.w); hv[r][j][1][3] += bfhi(w.w);
#pragma unroll
                for (int q = 0; q < 2; ++q) ss += hv[r][j][q][0] * hv[r][j][q][0] + hv[r][j][q][1] * hv[r][j][q][1] + hv[r][j][q][2] * hv[r][j][q][2] + hv[r][j][q][3] * hv[r][j][q][3]; }
            const float rs = rsqrtf(wave_sum(ss) * (1.0f / D) + EPS);
            if (row < TR) {
                if (!lastl) {
#pragma unroll
                    for (int j = 0; j < 2; ++j) { *(f32x4*)(H + (size_t)row * D + 8 * lane + 512 * j) = hv[r][j][0]; *(f32x4*)(H + (size_t)row * D + 8 * lane + 512 * j + 4) = hv[r][j][1];
                        *(u32x4*)(HB + (size_t)row * D + 8 * lane + 512 * j) = pack8(hv[r][j][0], hv[r][j][1]); }
                    if (lane == 0) rstd1[row] = rs;
                } else if (row < TX) {
#pragma unroll
                    for (int j = 0; j < 2; ++j) { const f32x4 g0 = *(const f32x4*)(fg + 8 * lane + 512 * j), g1 = *(const f32x4*)(fg + 8 * lane + 512 * j + 4);
                        *(f32x4*)(out + (size_t)row * D + 8 * lane + 512 * j) = hv[r][j][0] * rs * g0; *(f32x4*)(out + (size_t)row * D + 8 * lane + 512 * j + 4) = hv[r][j][1] * rs * g1; }
                }
            }
        }
    }
}
#define RELANE() do { const int t_ = wv0 * 64 + lane_id_opaque(); F.tid = t_; F.lane = t_ & 63; F.wave = __builtin_amdgcn_readfirstlane(t_ >> 6); \
    int g_ = gridDim.x; LAUNDER_S(g_); int b_ = blockIdx.x; LAUNDER_S(b_); F.G = g_; F.bx = b_; F.vcu = (g_ % 8 == 0) ? (b_ % 8) * (g_ / 8) + b_ / 8 : b_; ll = l; LAUNDER_S(ll); } while (0)
__global__ void __launch_bounds__(NWAVES * 64, 2) fwd_kernel(Params P) {
    extern __shared__ __attribute__((aligned(16))) unsigned char lds_raw[];
    Frame F;
    F.lds = (LAS unsigned char*)lds_raw;
    F.tid = threadIdx.x; F.lane = F.tid & 63; F.wave = __builtin_amdgcn_readfirstlane(F.tid >> 6);
    F.G = gridDim.x; { const int bx = blockIdx.x; F.vcu = (F.G % 8 == 0) ? (bx % 8) * (F.G / 8) + bx / 8 : bx; }
    if (F.tid == 0) { LAS unsigned long long* pt = (LAS unsigned long long*)(F.lds + LC_PTAB);
#pragma unroll
        for (int i = 0; i < 25; ++i) pt[i] = (unsigned long long)P.in[i];
        pt[25] = (unsigned long long)P.ws; pt[26] = (unsigned long long)P.out; }
    for (int u = F.tid; u < 256; u += NWAVES * 64) ((LAS unsigned*)(F.lds + RING_BYTES))[u] = 0u;
    __syncthreads();
    const int lo = P.ph_lo, hi = P.ph_hi;
    const bool use_bar = (hi - lo) > 1;
    unsigned* barw = (unsigned*)(P.ws + WS_CTL) + CW_BAR;
    XcdBarrier bar; bar.bar = barw; bar.x = 0; bar.st = (volatile LAS unsigned*)(F.lds + LC_BAR);
    if (use_bar) bar = xcd_barrier_post(barw, (volatile LAS unsigned*)(F.lds + LC_BAR));
#ifndef PHASE_MASK
#define PHASE_MASK 0xfff
#endif
#define EN(j) (((PHASE_MASK) >> (j)) & 1)
#ifndef DUP_MASK
#define DUP_MASK 0
#endif
#define NREP(j) ((((DUP_MASK) >> (j)) & 1) ? 2 : 1)
#define IN(k) (lo <= (k) && (k) < hi)
#define SEAM(k) do { if (IN(k) && IN((k) + 1)) xcd_barrier(bar); } while (0)

    int l = 0, ll = 0; const int wv0 = __builtin_amdgcn_readfirstlane((int)threadIdx.x >> 6);
    if (EN(0) && IN(0)) { RELANE(); convert_weights(F, 0); RELANE(); init_rows(F); }
    SEAM(0);
    for (l = 0; l < DEPTH; ++l) {
        const int pb = 1 + 11 * l;
        for (int rep = 0; rep < NREP(1); ++rep)
        if (EN(1) && IN(pb + 0)) {
            RELANE();
            unsigned char* wsl = WSP(); unsigned char* dol = DOP();
            pg8::Gemm g{(const bf16*)(wsl + WS_HB), 1024, 1024, 1 << 20};
            pg8::StaticOrder S; S.init(TX, N1, F.G, F.bx, (const bf16*)(wsl + WS_W1T), 1024);
            Epi1 E{(const float*)(wsl + WS_RSTD1), (bf16*)(wsl + WS_A), (bf16*)(wsl + WS_GLU), (bf16*)(dol + DO_Q), (bf16*)(wsl + WS_G)};
            pg8::gemm_phase<Epi1, pg8::StaticOrder>(F.lds, g, S, E, F.wave);
            if (F.bx >= 128 && F.bx < 128 + 21 && F.wave < 4) {
                const int pn = F.bx - 128, l2 = lane_id_opaque(); AccT acc; skinny_zero(acc);
                skinny_k<true>(acc, (const bf16*)(wsl + WS_HB) + (size_t)TX * 1024, 1024, (const bf16*)(wsl + WS_W1T) + (size_t)pn * 256 * 1024, 1024, 1024, F.wave, l2 & 15, l2 >> 4);
                E.run<true>(acc, pg8::Unit{128, pn, 0}, 0, F.wave, l2 & 15, l2 >> 4);
            }
        }
        SEAM(pb + 0);
        for (int rep = 0; rep < NREP(2); ++rep)
        if (EN(2) && IN(pb + 1)) { RELANE(); phase_S(F, ll); }
        SEAM(pb + 1);
        if (EN(3) && IN(pb + 2)) { RELANE(); phase_scan(F); }
        SEAM(pb + 2);
        for (int rep = 0; rep < NREP(3); ++rep)
        if (EN(4) && IN(pb + 3)) { RELANE(); phase_B(F, ll); }
        SEAM(pb + 3);
        for (int rep = 0; rep < NREP(4); ++rep)
        if (EN(5) && IN(pb + 4)) {
            RELANE(); unsigned char* wsl = WSP(); unsigned char* dol = DOP();
            pg8::Gemm g{(const bf16*)(wsl + WS_X3), 1024, 1024, 1 << 20}; pg8::SegOrder S; S.init(TX, 1024, F.G, F.bx, (const bf16*)(wsl + WS_W3CT), 1024);
            EpiCS E{(const bf16*)(wsl + WS_G), (bf16*)(dol + DO_MERGED), (const float*)(wsl + WS_BIASA)}; pg8::gemm_phase<EpiCS, pg8::SegOrder>(F.lds, g, S, E, F.wave);
            if (F.bx >= 16 && F.bx < 20) {
                const int pn = F.bx - 16, l2 = lane_id_opaque(), kh = F.wave >> 2, wc4 = F.wave & 3; AccT acc; skinny_zero(acc);
#pragma unroll 1
                for (int seg = 0; seg < 3; ++seg) { const int Ks = seg == 2 ? 512 : 256; const size_t ko = (seg == 0 ? 0 : (seg == 1 ? 256 : 512)) + (size_t)kh * (Ks / 2);
                    if (kh == 1) skinny_zero(acc);
                    skinny_k<true>(acc, (const bf16*)(wsl + WS_X3) + (size_t)TX * 1024 + ko, 1024, (const bf16*)(wsl + WS_W3CT) + (size_t)pn * 256 * 1024 + ko, 1024, Ks / 2, wc4, l2 & 15, l2 >> 4);
                    skinny_combine(acc, F.lds, F.wave, l2);
                    if (kh == 0) E.run<true>(acc, pg8::Unit{128, pn, seg}, 0, wc4, l2 & 15, l2 >> 4); }
            }
        }
        SEAM(pb + 4);
        if (EN(6) && IN(pb + 5)) {
            RELANE();
            unsigned char* wsl = WSP(); unsigned char* dol = DOP();
            pg8::Gemm g{(const bf16*)(dol + DO_MERGED), 1024, 1024, 1 << 20}; pg8::StaticOrder S; S.init(TX, 1024, F.G, F.bx, (const bf16*)(wsl + WS_WOT), 1024);
            EpiB2 E{(bf16*)(wsl + WS_X3)}; pg8::gemm_phase<EpiB2, pg8::StaticOrder>(F.lds, g, S, E, F.wave);
            if (F.bx >= 16 && F.bx < 20) {
                const int pn = F.bx - 16, l2 = lane_id_opaque(), kh = F.wave >> 2, wc4 = F.wave & 3; AccT acc; skinny_zero(acc);
                skinny_k<true>(acc, (const bf16*)(dol + DO_MERGED) + (size_t)TX * 1024 + kh * 512, 1024, (const bf16*)(wsl + WS_WOT) + (size_t)pn * 256 * 1024 + kh * 512, 1024, 512, wc4, l2 & 15, l2 >> 4);
                skinny_combine(acc, F.lds, F.wave, l2);
                if (kh == 0) E.run<true>(acc, pg8::Unit{128, pn, 0}, 0, wc4, l2 & 15, l2 >> 4);
            }
        }
        SEAM(pb + 5);
        if (EN(7) && IN(pb + 6)) { RELANE(); phase_E1(F, ll); }
        SEAM(pb + 6);
        for (int rep = 0; rep < NREP(7); ++rep)
        if (EN(8) && IN(pb + 7)) { RELANE(); phase_E1b(F, ll); }
        SEAM(pb + 7);
        for (int rep = 0; rep < NREP(8); ++rep)
        if (EN(9) && IN(pb + 8)) {
            RELANE(); class_tables(F, ll);
            unsigned char* wsl = WSP();
            const int NP = __builtin_amdgcn_readfirstlane(*(const LAS int*)(F.lds + LC_NP));
            pg8::Gemm g{(const bf16*)(wsl + WS_XS), 1024, 1024, 1 << 20};
            { const int* TOK = (const int*)(wsl + WS_TOK); LAS int* tl = (LAS int*)(F.lds + LC_TOK);
#pragma unroll 1
              for (int i = F.tid; i < 1024; i += 512) { const long L = (long)(i >> 8) * F.G + F.vcu; int tk = 0; if (L < (long)NP * 4) { tk = TOK[(int)(L >> 2) * 256 + (i & 255)]; if (tk < 0 || tk >= TR) tk = 0; } tl[i] = tk; }
              __syncthreads(); }
            pg8::Gemm g2{(const bf16*)(wsl + WS_HB), 1024, 1024, 1 << 20};
            MoeOrderT<true> S{(const LAS int*)(F.lds + LC_TOK), NP, F.G, F.vcu, 0, (const LAS int*)(F.lds + LC_PCLS), (const bf16*)(DOP() + DO_W13T)};
            EpiA2 E{(const float*)(wsl + WS_PW), (bf16*)(wsl + WS_HH)}; pg8::gemm_phase<EpiA2, MoeOrderT<true>>(F.lds, g2, S, E, F.wave);
        }
        SEAM(pb + 8);
        for (int rep = 0; rep < NREP(9); ++rep)
        if (EN(10) && IN(pb + 9)) {
            RELANE(); class_tables(F, ll);
            unsigned char* wsl = WSP();
            const int NP = __builtin_amdgcn_readfirstlane(*(const LAS int*)(F.lds + LC_NP));
            pg8::Gemm g{(const bf16*)(wsl + WS_HH), 512, 256, 4};
            MoeOrderT<false> S{nullptr, NP, F.G, F.vcu, 1, (const LAS int*)(F.lds + LC_PCLS), (const bf16*)(DOP() + DO_W2T)};
            EpiB2 E{(bf16*)(wsl + WS_Y)}; pg8::gemm_phase<EpiB2, MoeOrderT<false>>(F.lds, g, S, E, F.wave);
        }
        SEAM(pb + 9);
        if (EN(11) && IN(pb + 10)) { RELANE(); phase_E4(F, ll); if (l + 1 < DEPTH) { RELANE(); convert_weights(F, ll + 1); } }
        SEAM(pb + 10);
    }
#undef IN
#undef SEAM
}

constexpr int N_PHASES = 1 + 11 * DEPTH;

extern "C" void kernel_launch(void* const* d_in, const int* in_sizes, int n_in, void* d_out, int out_size, void* d_ws, size_t ws_size, hipStream_t stream) {
    static int grid = 0;
    if (grid == 0) {
        if (n_in != 25 || out_size != TX * D || ws_size < WS_END) { fprintf(stderr, "kernel_launch: unexpected shapes: n_in %d out %d ws %zu (need %zu)\n", n_in, out_size, ws_size, (size_t)WS_END); grid = -1; return; }
        int dev = 0, cus = 0, per_cu = 0;
        if (hipGetDevice(&dev) != hipSuccess || hipDeviceGetAttribute(&cus, hipDeviceAttributeMultiprocessorCount, dev) != hipSuccess) { grid = -1; return; }
        if (hipFuncSetAttribute((const void*)fwd_kernel, hipFuncAttributeMaxDynamicSharedMemorySize, LDS_BYTES) != hipSuccess) { fprintf(stderr, "kernel_launch: hipFuncSetAttribute failed\n"); grid = -1; return; }
        if (hipOccupancyMaxActiveBlocksPerMultiprocessor(&per_cu, (const void*)fwd_kernel, NWAVES * 64, LDS_BYTES) != hipSuccess || per_cu < 1) fprintf(stderr, "kernel_launch: occupancy query reports %d\n", per_cu);
        (void)hipGetLastError();
        grid = cus;
    }
    if (grid < 0) return;
    (void)hipMemsetAsync((char*)d_ws + WS_CTL, 0, CTL_BYTES, stream);
    Params p{};
    for (int i = 0; i < 25; ++i) p.in[i] = (const float*)d_in[i];
    p.out = (float*)d_out; p.ws = (unsigned char*)d_ws;
#if N_LAUNCH_MODE == 1
    p.ph_lo = 0; p.ph_hi = N_PHASES;
    hipLaunchKernelGGL(fwd_kernel, dim3(grid), dim3(NWAVES * 64), LDS_BYTES, stream, p);
#else
    for (int ph = 0; ph < N_PHASES; ++ph) { p.ph_lo = ph; p.ph_hi = ph + 1; hipLaunchKernelGGL(fwd_kernel, dim3(grid), dim3(NWAVES * 64), LDS_BYTES, stream, p); }
#endif
}
```

```cpp
#include <hip/hip_runtime.h>
#include <cstdio>
#include <cstdint>

#ifndef N_LAUNCH_MODE
#define N_LAUNCH_MODE 1
#endif

#define GAS __attribute__((address_space(1)))
#define LAS __attribute__((address_space(3)))
typedef unsigned short bf16;
typedef float f32x4 __attribute__((ext_vector_type(4)));
typedef float f32x2 __attribute__((ext_vector_type(2)));
typedef unsigned u32x4 __attribute__((ext_vector_type(4)));
typedef unsigned u32x2 __attribute__((ext_vector_type(2)));
typedef short bf16x8 __attribute__((ext_vector_type(8)));
typedef __bf16 bf16x2v __attribute__((ext_vector_type(2)));

constexpr int D = 1024, NB = 4, SEQ = 8192, NMETA = 16, DEPTH = 2;
constexpr int TX = NB * SEQ;
constexpr int TM = TX + 64;
constexpr int TR = TX + NMETA;
constexpr int NIN = 5384, N1 = 5376;
constexpr int NHEAD = 8;
constexpr int NCLS = 24;
constexpr int NPOSMAX = TX + 256 + NCLS * 256;
constexpr float EPS = 1e-6f;
constexpr float LOG2E = 1.4426950408889634f;
constexpr float C2 = 0.125f * LOG2E;
constexpr int NWAVES = 8;

constexpr size_t U = (size_t)TM * 1024 * 2;
constexpr size_t WS_CTL = 0, CTL_BYTES = 128u << 10;
constexpr size_t WS_H = CTL_BYTES;
constexpr size_t WS_HB = WS_H + 2 * U;
constexpr size_t WS_G = WS_HB + U;
constexpr size_t WS_XS = WS_G;
constexpr size_t WS_Y = WS_XS + (size_t)NPOSMAX * 2048;
constexpr size_t WS_HH = WS_Y + (size_t)NPOSMAX * 2048;
static_assert(WS_HH + (size_t)NPOSMAX * 1024 <= WS_G + (size_t)3 * 129 * 4 * 65536 * 2, "MoE overlay fits the gates region");
constexpr size_t GT_TILE = 65536;
constexpr size_t WS_A = WS_G + (size_t)3 * 129 * 4 * GT_TILE * 2;
constexpr size_t WS_GLU = WS_A + U / 4;
constexpr size_t WS_X3 = WS_GLU + U / 4;
constexpr size_t WS_W1T = WS_X3 + U;
constexpr size_t WS_W3CT = WS_W1T + (size_t)N1 * 1024 * 2;
constexpr size_t WS_WOT = WS_W3CT + 1024 * 1024 * 2;
constexpr size_t WS_WFG = WS_WOT + 1024 * 1024 * 2;
constexpr size_t WS_RG = WS_WFG + 8 * 1024 * 4;
constexpr size_t WS_BIASA = WS_RG + 20 * 1024 * 4;
constexpr size_t WS_RSTD1 = WS_BIASA + 4096;
constexpr size_t WS_ROUTE = WS_RSTD1 + (size_t)TM * 4;
constexpr size_t WS_PW = WS_ROUTE + (size_t)TM * 32;
constexpr size_t WS_LFT = WS_PW + (size_t)NPOSMAX * 16;
constexpr size_t WS_LFTM = WS_LFT + (size_t)32 * 8192 * 4;
constexpr size_t WS_TOK = WS_LFTM + 8 * 256 * 4;
constexpr size_t WS_FL = WS_TOK + (size_t)NPOSMAX * 4;
constexpr int FLN = 64 + SEQ;
constexpr size_t WS_END = WS_FL + (size_t)32 * FLN * 4;
static_assert(WS_END <= (size_t)512 * 1024 * 1024, "d_ws map fits 512 MiB");
constexpr size_t DO_Q = 0, DO_K = U / 2, DO_V = U, DO_MERGED = U / 2;
constexpr size_t DO_W13T = 3 * U / 2;
constexpr size_t DO_W2T = DO_W13T + (size_t)16 * 512 * 1024 * 2;
static_assert(DO_W2T + (size_t)16 * 1024 * 256 * 2 <= (size_t)TX * 1024 * 4, "d_out scratch");
static_assert((24576 + 128) * 4 <= 128 * 1024, "control words inside the memset");
constexpr int CW_BAR = 4096, CW_GCNT = 16384, CW_NRM = 20480  , CW_AQ = 24576  ;

constexpr int RPITCH = 1032;
constexpr int RING_BYTES = 131072;
constexpr int LC_BAR = RING_BYTES, LC_CNT = RING_BYTES + 64, LC_BASE = RING_BYTES + 192, LC_PCLS = RING_BYTES + 320, LC_NP = RING_BYTES + 960;
constexpr int LC_QS = RING_BYTES + 976;
constexpr int LC_TOK = RING_BYTES + 2048;
constexpr int LC_NMX = RING_BYTES + 1280;
constexpr int LC_PTAB = RING_BYTES + 1024;
constexpr int LDS_BYTES = RING_BYTES + 1024 + 7168;

#define LDS_WAIT() asm volatile("s_waitcnt lgkmcnt(0)" ::: "memory")
#define VM_WAIT() asm volatile("s_waitcnt vmcnt(0)" ::: "memory")
#define LAUNDER_S(p) asm volatile("" : "+s"(p))
#define LAUNDER_V(x) asm volatile("" : "+v"(x))
__device__ __forceinline__ int lane_id_opaque() { int x; asm volatile("v_mbcnt_lo_u32_b32 %0, -1, 0\n\tv_mbcnt_hi_u32_b32 %0, -1, %0" : "=v"(x)); return x; }

__device__ __forceinline__ unsigned f2bf(float f) { unsigned u = __builtin_bit_cast(unsigned, f); return (u + 0x7fffu + ((u >> 16) & 1u)) >> 16; }
__device__ __forceinline__ unsigned pk2(float lo, float hi) { f32x2 v = {lo, hi}; bf16x2v b = __builtin_convertvector(v, bf16x2v); return __builtin_bit_cast(unsigned, b); }
__device__ __forceinline__ float bflo(unsigned w) { return __builtin_bit_cast(float, w << 16); }
__device__ __forceinline__ float bfhi(unsigned w) { return __builtin_bit_cast(float, w & 0xffff0000u); }
template <int O> __device__ __forceinline__ float lane_xor(float v) {
    if constexpr (O < 32) return __int_as_float(__builtin_amdgcn_ds_swizzle(__float_as_int(v), (O << 10) | 0x1f));
    else { auto rr = __builtin_amdgcn_permlane32_swap(__float_as_uint(v), __float_as_uint(v), false, false); return __uint_as_float(rr[0]) + __uint_as_float(rr[1]) - v; }
}
__device__ __forceinline__ float wave_sum(float v) {
    v += lane_xor<1>(v); v += lane_xor<2>(v); v += lane_xor<4>(v); v += lane_xor<8>(v); v += lane_xor<16>(v);
    auto rr = __builtin_amdgcn_permlane32_swap(__float_as_uint(v), __float_as_uint(v), false, false);
    return __uint_as_float(rr[0]) + __uint_as_float(rr[1]);
}
__device__ __forceinline__ float sigmoidf_(float x) { return __builtin_amdgcn_rcpf(1.0f + __builtin_amdgcn_exp2f(-LOG2E * x)); }
__device__ __forceinline__ float dot2bf(unsigned a, unsigned b, float acc) { return __builtin_amdgcn_fdot2_f32_bf16(__builtin_bit_cast(bf16x2v, a), __builtin_bit_cast(bf16x2v, b), acc, false); }

namespace pg8 {
constexpr int BM = 256, BK = 64, HALF = 128, HTB = HALF * BK * 2, STAGE_BYTES = 8 * HTB, NXCD = 8, WGM = 8;
__host__ __device__ __forceinline__ int lds_byte(int r, int c) { const int st = (r >> 4) * 2 + (c >> 5), rr = r & 15, cc = c & 31, ob = rr * 64 + cc * 2; return st * 1024 + (ob ^ (((ob >> 9) & 1) << 5)); }
__host__ __device__ __forceinline__ void stage_rc(int b, int& R, int& C) { const int st = b / 1024, sb = b % 1024, swz = sb ^ (((sb >> 9) & 1) << 5); R = (st >> 1) * 16 + swz / 64; C = (st & 1) * 32 + (swz % 64) / 2; }
__host__ __device__ __forceinline__ int perm32(int rho) { const int n = rho >> 4, i = rho & 15; return 8 * (i >> 2) + 4 * n + (i & 3); }

struct Unit { int pm, pn, seg; };
struct Gemm { const bf16* A; int K; int ldb; int ksplit; };

struct StaticOrder {
    static constexpr bool GATHER = false; const LAS int* tokl = nullptr;
    int nM, nN, nwg, G, c; const bf16* Bt; size_t btile;
    __device__ void init(int M, int N, int G_, int c_, const bf16* Bt_, int ldb) { nM = M / BM; nN = N / BM; nwg = nM * nN; G = G_; c = c_; Bt = Bt_; btile = (size_t)BM * ldb * 2; }
    __device__ bool next(int i, Unit& u) const {
        const long L = (long)i * G + c; if (L >= nwg) return false;
        int wgid = (int)L; { const int q = nwg / NXCD, r = nwg % NXCD, xcd = wgid % NXCD, off = wgid / NXCD; wgid = (xcd < r ? xcd * (q + 1) : r * (q + 1) + (xcd - r) * q) + off; }
        const int nig = WGM * nN, gid = wgid / nig, fm = gid * WGM, gsz = (nM - fm) < WGM ? (nM - fm) : WGM;
        u.pm = fm + ((wgid % nig) % gsz); u.pn = (wgid % nig) / gsz; u.seg = 0; return true;
    }
    __device__ __forceinline__ const char* bptr(const Unit& u, int) const { return (const char*)Bt + (size_t)u.pn * btile; }
    __device__ __forceinline__ int nt(const Unit&, int ntd) const { return ntd; }
    __device__ __forceinline__ size_t aoff(const Unit&) const { return 0; }
};
struct SegOrder : StaticOrder {
    __device__ bool next(int i, Unit& u) const { const int q = i / 3; if (!StaticOrder::next(q, u)) return false; u.seg = i - 3 * q; return true; }
    __device__ __forceinline__ size_t koff(const Unit& u) const { return u.seg == 0 ? 0 : (u.seg == 1 ? 512 : 1024); }
    __device__ __forceinline__ const char* bptr(const Unit& u, int) const { return (const char*)Bt + (size_t)u.pn * btile + koff(u); }
    __device__ __forceinline__ int nt(const Unit& u, int) const { return u.seg == 2 ? 8 : 4; }
    __device__ __forceinline__ size_t aoff(const Unit& u) const { return koff(u); }
};

template <class Epi, class Sched, bool ALIGN_EPI = true, bool SP2 = true>
__device__ __forceinline__ void gemm_phase(LAS unsigned char* lds, const Gemm g, const Sched& S, const Epi& E, const int wave_id) {
    const int tid = wave_id * 64 + lane_id_opaque();
    const int wid = __builtin_amdgcn_readfirstlane(tid >> 6), lane = tid & 63, wr = wid >> 2, wc = wid & 3, fr = lane & 15, fq = lane >> 4;
    const int K = g.K, nt = K / BK, ldb = g.ldb, ks = g.ksplit;
    unsigned voffA[2], voffB[2];
#pragma unroll
    for (int i = 0; i < 2; ++i) { int R, C; stage_rc(tid * 16 + i * 8192, R, C); const int Rb = Epi::PERM ? ((R & ~31) + perm32(R & 31)) : R;
        voffA[i] = (unsigned)(R * K + C) * 2u; voffB[i] = (unsigned)(Rb * ldb + C) * 2u; }
    constexpr bool GATHER = Sched::GATHER;
    unsigned vC0[2], vC1[2];
    const size_t kstep = (size_t)(BK * 2);
    const size_t hstep = (size_t)HALF * K * 2;
    const size_t hstepB = (size_t)HALF * ldb * 2;
    const size_t tstep = 2 * hstep;
#define PG8_GOFF(ui_) do { _Pragma("unroll") for (int _i = 0; _i < 2; ++_i) { const int R_ = (int)(voffA[_i] >> 11); const unsigned C_ = voffA[_i] & 2047u; \
        vC0[_i] = (unsigned)S.tokl[(ui_) * 256 + R_] * 2048u + C_; vC1[_i] = (unsigned)S.tokl[(ui_) * 256 + 128 + R_] * 2048u + C_; } } while (0)
    const unsigned ldsw = (unsigned)wid * 1024u;
    const int aoff = lds_byte(wr * 64 + fr, fq * 8), boff = lds_byte(wc * 32 + fr, fq * 8);
#define PG8_SA(b, h) (((b) * 2 + (h)) * HTB)
#define PG8_SB(b, h) ((4 + (b) * 2 + (h)) * HTB)
#define PG8_STAGE(bufoff, gbase, voff) do { _Pragma("unroll") for (int _i = 0; _i < 2; ++_i) \
        __builtin_amdgcn_global_load_lds((const unsigned*)((const char*)(gbase) + (voff)[_i]), (LAS unsigned*)(lds + (bufoff) + ldsw + _i * 8192), 16, 0, 0); } while (0)
#define PG8_LDA(dst, b, h) do { _Pragma("unroll") for (int m = 0; m < 4; ++m) _Pragma("unroll") for (int k = 0; k < 2; ++k) dst[m][k] = *(const LAS bf16x8*)(lds + PG8_SA(b, h) + aoff + m * 2048 + k * 1024); } while (0)
#define PG8_LDB(dst, b, h) do { _Pragma("unroll") for (int n = 0; n < 2; ++n) _Pragma("unroll") for (int k = 0; k < 2; ++k) dst[n][k] = *(const LAS bf16x8*)(lds + PG8_SB(b, h) + boff + n * 2048 + k * 1024); } while (0)
#define PG8_MMA(ai, bj, At, Bt) do { __builtin_amdgcn_s_setprio(1); _Pragma("unroll") for (int m = 0; m < 4; ++m) _Pragma("unroll") for (int n = 0; n < 2; ++n) _Pragma("unroll") for (int k = 0; k < 2; ++k) \
        acc[ai][bj][m][n] = __builtin_amdgcn_mfma_f32_16x16x32_bf16(Bt[n][k], At[m][k], acc[ai][bj][m][n], 0, 0, 0); __builtin_amdgcn_s_setprio(0); } while (0)
#define PG8_WAIT_V(n) asm volatile("s_waitcnt vmcnt(" #n ")" ::: "memory")
#define PG8_WAIT_L(n) asm volatile("s_waitcnt lgkmcnt(" #n ")" ::: "memory")
#define PG8_BAR __builtin_amdgcn_s_barrier()
#define PG8_SCHED __builtin_amdgcn_sched_barrier(0)
    Unit cur, nxt; int ui = 0;
    if (!S.next(0, cur)) return;
    if constexpr (GATHER) { PG8_GOFF(0); } else { vC0[0] = voffA[0]; vC0[1] = voffA[1]; vC1[0] = voffA[0] + (unsigned)hstep; vC1[1] = voffA[1] + (unsigned)hstep; }
    f32x4 acc[2][2][4][2];
    { float z_ = 0.f; LAUNDER_V(z_);
#pragma unroll
    for (int a = 0; a < 2; ++a)
#pragma unroll
        for (int b = 0; b < 2; ++b)
#pragma unroll
            for (int m = 0; m < 4; ++m)
#pragma unroll
                for (int n = 0; n < 2; ++n) acc[a][b][m][n] = (f32x4){z_, z_, z_, z_}; }
    bf16x8 At[4][2], B0[2][2], B1[2][2];
    int ntc = S.nt(cur, nt);
    const char* cA = GATHER ? (const char*)g.A : (const char*)g.A + (size_t)cur.pm * tstep + S.aoff(cur); const char* cB = S.bptr(cur, 0); const char* cB1 = S.bptr(cur, 1) - (size_t)ks * kstep;
    if constexpr (SP2) {
        PG8_STAGE(PG8_SB(0, 0), cB, voffB); PG8_STAGE(PG8_SB(0, 1), cB + hstepB, voffB); PG8_STAGE(PG8_SA(0, 0), cA, vC0); PG8_STAGE(PG8_SA(0, 1), cA, vC1);
        if (wr == 1) PG8_BAR;
        PG8_WAIT_V(2); PG8_BAR;
        PG8_STAGE(PG8_SB(1, 0), cB + kstep, voffB); PG8_STAGE(PG8_SA(1, 0), cA + kstep, vC0); PG8_STAGE(PG8_SB(1, 1), cB + hstepB + kstep, voffB);
        PG8_WAIT_V(6); PG8_BAR;
    } else {
        PG8_STAGE(PG8_SB(0, 0), cB, voffB); PG8_STAGE(PG8_SA(0, 0), cA, vC0); PG8_STAGE(PG8_SB(0, 1), cB + hstepB, voffB); PG8_STAGE(PG8_SA(0, 1), cA, vC1);
        if (wr == 1) PG8_BAR;
        PG8_WAIT_V(4); PG8_BAR;
        PG8_STAGE(PG8_SB(1, 0), cB + kstep, voffB); PG8_STAGE(PG8_SA(1, 0), cA + kstep, vC0); PG8_STAGE(PG8_SB(1, 1), cB + hstepB + kstep, voffB);
        PG8_WAIT_V(6); PG8_BAR;
    }
    for (;;) {
        const bool has_next = S.next(ui + 1, nxt);
        const char* nA = GATHER ? (const char*)g.A : (has_next ? (const char*)g.A + (size_t)nxt.pm * tstep + S.aoff(nxt) : cA); const char* nB = has_next ? S.bptr(nxt, 0) : cB;
        const char* nB1 = has_next ? S.bptr(nxt, 1) - (size_t)ks * kstep : cB1;
#pragma unroll 1
        for (int t = 0; t < ntc; t += 2) {
            const bool last = (t == ntc - 2);
            const char* a1 = cA + (size_t)(t + 1) * kstep;
            const char* bside = (t + 2 < ks) ? cB : cB1;
            const char* a2 = last ? nA : cA + (size_t)(t + 2) * kstep; const char* b2 = last ? nB : bside + (size_t)(t + 2) * kstep;
            const char* a3 = a2 + kstep; const char* b3 = b2 + kstep;
            unsigned x0[2] = {vC0[0], vC0[1]}, x1[2] = {vC1[0], vC1[1]};
            if constexpr (GATHER) { if (last && has_next) { _Pragma("unroll") for (int _i = 0; _i < 2; ++_i) { const int R_ = (int)(voffA[_i] >> 11); const unsigned C_ = voffA[_i] & 2047u;
                x0[_i] = (unsigned)S.tokl[(ui + 1) * 256 + R_] * 2048u + C_; x1[_i] = (unsigned)S.tokl[(ui + 1) * 256 + 128 + R_] * 2048u + C_; } } }
            if constexpr (SP2) {
            PG8_LDB(B0, 0, 0); PG8_LDB(B1, 0, 1); PG8_SCHED; PG8_LDA(At, 0, 0); PG8_STAGE(PG8_SA(1, 1), a1, vC1);
            PG8_WAIT_V(8); PG8_WAIT_L(0); PG8_BAR; PG8_MMA(0, 0, At, B0); PG8_MMA(0, 1, At, B1); PG8_BAR; PG8_SCHED;
            PG8_LDA(At, 0, 1); PG8_STAGE(PG8_SB(0, 0), b2, voffB); PG8_STAGE(PG8_SB(0, 1), b2 + hstepB, voffB); PG8_STAGE(PG8_SA(0, 0), a2, x0);
            PG8_WAIT_V(8); PG8_WAIT_L(0); PG8_BAR; PG8_MMA(1, 0, At, B0); PG8_MMA(1, 1, At, B1); PG8_BAR; PG8_SCHED;
            PG8_LDB(B0, 1, 0); PG8_LDB(B1, 1, 1); PG8_SCHED; PG8_LDA(At, 1, 0); PG8_STAGE(PG8_SA(0, 1), a2, x1);
            PG8_WAIT_V(8); PG8_WAIT_L(0); PG8_BAR; PG8_MMA(0, 0, At, B0); PG8_MMA(0, 1, At, B1); PG8_BAR; PG8_SCHED;
            PG8_LDA(At, 1, 1); PG8_STAGE(PG8_SB(1, 0), b3, voffB); PG8_STAGE(PG8_SB(1, 1), b3 + hstepB, voffB); PG8_STAGE(PG8_SA(1, 0), a3, x0);
            PG8_WAIT_V(8); PG8_WAIT_L(0); PG8_BAR; PG8_MMA(1, 0, At, B0); PG8_MMA(1, 1, At, B1); PG8_BAR; PG8_SCHED;
            } else {
            PG8_LDB(B0, 0, 0); PG8_SCHED; PG8_LDA(At, 0, 0); PG8_STAGE(PG8_SA(1, 1), a1, vC1);
            PG8_WAIT_L(8); PG8_BAR; PG8_WAIT_L(0); PG8_MMA(0, 0, At, B0); PG8_BAR; PG8_SCHED;
            PG8_LDB(B1, 0, 1); PG8_STAGE(PG8_SB(0, 0), b2, voffB);
            PG8_BAR; PG8_WAIT_L(0); PG8_MMA(0, 1, At, B1); PG8_BAR;
            PG8_LDA(At, 0, 1); PG8_STAGE(PG8_SA(0, 0), a2, x0);
            PG8_BAR; PG8_WAIT_L(0); PG8_MMA(1, 0, At, B0); PG8_BAR; PG8_SCHED;
            PG8_STAGE(PG8_SB(0, 1), b2 + hstepB, voffB);
            PG8_WAIT_V(6); PG8_BAR; PG8_MMA(1, 1, At, B1); PG8_BAR;
            PG8_LDB(B0, 1, 0); PG8_SCHED; PG8_LDA(At, 1, 0); PG8_STAGE(PG8_SA(0, 1), a2, x1);
            PG8_WAIT_L(8); PG8_BAR; PG8_WAIT_L(0); PG8_MMA(0, 0, At, B0); PG8_BAR; PG8_SCHED;
            PG8_LDB(B1, 1, 1); PG8_STAGE(PG8_SB(1, 0), b3, voffB);
            PG8_BAR; PG8_WAIT_L(0); PG8_MMA(0, 1, At, B1); PG8_BAR;
            PG8_LDA(At, 1, 1); PG8_STAGE(PG8_SA(1, 0), a3, x0);
            PG8_BAR; PG8_WAIT_L(0); PG8_MMA(1, 0, At, B0); PG8_BAR; PG8_SCHED;
            PG8_STAGE(PG8_SB(1, 1), b3 + hstepB, voffB);
            PG8_WAIT_V(6); PG8_BAR; PG8_MMA(1, 1, At, B1); PG8_BAR;
            }
        }
        if constexpr (ALIGN_EPI) { if (wr == 0) PG8_BAR; }
        { const int l2 = lane_id_opaque(); E(acc, cur, wr, wc, l2 & 15, l2 >> 4); }
        if (!has_next) break;
        if (!E.keep(cur)) { float z_ = 0.f; LAUNDER_V(z_);
#pragma unroll
        for (int a = 0; a < 2; ++a)
#pragma unroll
            for (int b = 0; b < 2; ++b)
#pragma unroll
                for (int m = 0; m < 4; ++m)
#pragma unroll
                    for (int n = 0; n < 2; ++n) acc[a][b][m][n] = (f32x4){z_, z_, z_, z_}; }
        cur = nxt; cA = nA; cB = nB; cB1 = nB1; ++ui; ntc = S.nt(cur, nt);
        if constexpr (GATHER) { PG8_GOFF(ui); }
        if constexpr (ALIGN_EPI) { if (wr == 1) PG8_BAR; }
    }
    PG8_WAIT_V(0);
    if constexpr (!ALIGN_EPI) { if (wr == 0) PG8_BAR; }
    PG8_BAR;
#undef PG8_GOFF
#undef PG8_SA
#undef PG8_SB
#undef PG8_STAGE
#undef PG8_LDA
#undef PG8_LDB
#undef PG8_MMA
#undef PG8_WAIT_V
#undef PG8_WAIT_L
#undef PG8_BAR
#undef PG8_SCHED
}
}

typedef f32x4 AccT[2][2][4][2];
__device__ __forceinline__ u32x4 pack8(const f32x4 a, const f32x4 b) { u32x4 w; w.x = pk2(a[0], a[1]); w.y = pk2(a[2], a[3]); w.z = pk2(b[0], b[1]); w.w = pk2(b[2], b[3]); return w; }

struct Epi1 {
    static constexpr bool PERM = true;
    __device__ __forceinline__ bool keep(const pg8::Unit&) const { return false; }
    const float* rstd; bf16* A; bf16* GLU; bf16* QKV; bf16* G;
    __device__ __forceinline__ void operator()(AccT& acc, const pg8::Unit& u, int wr, int wc, int fr, int fq) const { run<false>(acc, u, wr, wc, fr, fq); }
    template <bool SK> __device__ __forceinline__ void run(AccT& acc, const pg8::Unit& u, int wr, int wc, int fr, int fq) const {
        const int row0 = u.pm * 256 + wr * 64 + fr, lc0 = wc * 32 + 8 * fq, pn = u.pn;
#pragma unroll
        for (int ai = 0; ai < (SK ? 1 : 2); ++ai)
#pragma unroll
            for (int m = 0; m < (SK ? 1 : 4); ++m) {
                const int row = row0 + ai * 128 + m * 16; const float rs = rstd[row];
                f32x4 v[2][2];
#pragma unroll
                for (int bj = 0; bj < 2; ++bj)
#pragma unroll
                    for (int n = 0; n < 2; ++n) v[bj][n] = acc[ai][bj][m][n] * rs;
                if (pn == 0) {
#pragma unroll
                    for (int bj = 0; bj < 2; ++bj) *(u32x4*)(A + (size_t)row * 256 + bj * 128 + lc0) = pack8(v[bj][0], v[bj][1]);
                } else if (pn <= 2) {
                    f32x4 o[2];
#pragma unroll
                    for (int n = 0; n < 2; ++n)
#pragma unroll
                        for (int j = 0; j < 4; ++j) o[n][j] = v[0][n][j] * sigmoidf_(v[1][n][j]);
                    *(u32x4*)(GLU + (size_t)row * 256 + (pn - 1) * 128 + lc0) = pack8(o[0], o[1]);
                } else if (pn <= 4) {
#pragma unroll
                    for (int bj = 0; bj < 2; ++bj) *(u32x4*)(QKV + (size_t)2 * (U / 4) + (size_t)row * 512 + (pn - 3) * 256 + bj * 128 + lc0) = pack8(v[bj][0], v[bj][1]);
                } else {
                    const int d = 64 * (pn - 5) + 16 * wc + 4 * fq; f32x4 r01, r12, g2;
#pragma unroll
                    for (int j = 0; j < 4; ++j) { const float a0 = 1.0f + fminf(__builtin_amdgcn_exp2f(-LOG2E * v[0][0][j]), 1e30f), a1 = 1.0f + fminf(__builtin_amdgcn_exp2f(-LOG2E * v[0][1][j]), 1e30f), a2 = 1.0f + fminf(__builtin_amdgcn_exp2f(-LOG2E * v[1][0][j]), 1e30f);
                        const float i0 = __builtin_amdgcn_rcpf(a0), i1 = __builtin_amdgcn_rcpf(a1), i2 = __builtin_amdgcn_rcpf(a2);
                        r01[j] = i0 * a1; r12[j] = i1 * a2; g2[j] = i2; }
                    bf16* gp = G + (size_t)row * 1024 + d; u32x2 w;
                    w.x = pk2(r01[0], r01[1]); w.y = pk2(r01[2], r01[3]); *(u32x2*)gp = w;
                    w.x = pk2(r12[0], r12[1]); w.y = pk2(r12[2], r12[3]); *(u32x2*)(gp + U / 2) = w;
                    w.x = pk2(g2[0], g2[1]); w.y = pk2(g2[2], g2[3]); *(u32x2*)(gp + U) = w;
                    const float sc = d < 512 ? C2 : 1.0f; const f32x4 sp = v[1][1] * sc;
                    w.x = pk2(sp[0], sp[1]); w.y = pk2(sp[2], sp[3]); *(u32x2*)(QKV + (size_t)(d < 512 ? 0 : 1) * (U / 4) + (size_t)row * 512 + (d & 511)) = w;
                }
            }
    }
};
struct EpiCS {
    static constexpr bool PERM = true;
    const bf16* G; bf16* Mg; const float* bias;
    __device__ __forceinline__ bool keep(const pg8::Unit& u) const { return u.seg != 2; }
    __device__ __forceinline__ void operator()(AccT& acc, const pg8::Unit& u, int wr, int wc, int fr, int fq) const { run<false>(acc, u, wr, wc, fr, fq); }
    template <bool SK> __device__ __forceinline__ void run(AccT& acc, const pg8::Unit& u, int wr, int wc, int fr, int fq) const {
        const int row0 = u.pm * 256 + wr * 64 + fr, col0 = u.pn * 256 + wc * 32 + 8 * fq;
        const bool lastseg = u.seg == 2; const float bsc = u.seg == 0 ? 1.f : 0.f; const bf16* Gs = G + (size_t)u.seg * (U / 2);
        f32x4 bv[2][2];
#pragma unroll
        for (int bj = 0; bj < 2; ++bj) { bv[bj][0] = *(const f32x4*)(bias + col0 + bj * 128) * bsc; bv[bj][1] = *(const f32x4*)(bias + col0 + bj * 128 + 4) * bsc; }
        u32x4 gr[2][4][2];
#pragma unroll
        for (int ai = 0; ai < (SK ? 1 : 2); ++ai)
#pragma unroll
            for (int m = 0; m < (SK ? 1 : 4); ++m)
#pragma unroll
                for (int bj = 0; bj < 2; ++bj) gr[ai][m][bj] = *(const u32x4*)(Gs + (size_t)(row0 + ai * 128 + m * 16) * 1024 + col0 + bj * 128);
#pragma unroll
        for (int ai = 0; ai < (SK ? 1 : 2); ++ai)
#pragma unroll
            for (int m = 0; m < (SK ? 1 : 4); ++m) { const int row = row0 + ai * 128 + m * 16;
#pragma unroll
                for (int bj = 0; bj < 2; ++bj) {
                    const u32x4 n4 = gr[ai][m][bj];
                    f32x4 a0 = acc[ai][bj][m][0] + bv[bj][0], a1 = acc[ai][bj][m][1] + bv[bj][1];
                    a0[0] *= bflo(n4.x); a0[1] *= bfhi(n4.x); a0[2] *= bflo(n4.y); a0[3] *= bfhi(n4.y); a1[0] *= bflo(n4.z); a1[1] *= bfhi(n4.z); a1[2] *= bflo(n4.w); a1[3] *= bfhi(n4.w);
                    acc[ai][bj][m][0] = a0; acc[ai][bj][m][1] = a1;
                    asm volatile("" : "+v"(acc[ai][bj][m][0]), "+v"(acc[ai][bj][m][1]));
                    if (lastseg) *(u32x4*)(Mg + (size_t)row * 1024 + col0 + bj * 128) = pack8(a0, a1);
                } }
    }
};
struct EpiD {
    static constexpr bool PERM = false;
    __device__ __forceinline__ bool keep(const pg8::Unit&) const { return false; }
    float* H; bf16* HB;
    __device__ __forceinline__ void operator()(AccT& acc, const pg8::Unit& u, int wr, int wc, int fr, int fq) const { run<false>(acc, u, wr, wc, fr, fq); }
    template <bool SK> __device__ __forceinline__ void run(AccT& acc, const pg8::Unit& u, int wr, int wc, int fr, int fq) const {
        const int row0 = u.pm * 256 + wr * 64 + fr, col0 = u.pn * 256 + wc * 32 + 4 * fq;
#pragma unroll
        for (int ai = 0; ai < (SK ? 1 : 2); ++ai)
#pragma unroll
            for (int m = 0; m < (SK ? 1 : 4); ++m) {
                const size_t off = (size_t)(row0 + ai * 128 + m * 16) * 1024 + col0;
#pragma unroll
                for (int bj = 0; bj < 2; ++bj)
#pragma unroll
                    for (int n = 0; n < 2; ++n) { const size_t o = off + bj * 128 + n * 16; const f32x4 hv = *(const f32x4*)(H + o) + acc[ai][bj][m][n];
                        *(f32x4*)(H + o) = hv; u32x2 w; w.x = pk2(hv[0], hv[1]); w.y = pk2(hv[2], hv[3]); *(u32x2*)(HB + o) = w; }
            }
    }
};
struct EpiA2 {
    static constexpr bool PERM = true;
    __device__ __forceinline__ bool keep(const pg8::Unit&) const { return false; }
    const float* PW; bf16* HH;
    __device__ __forceinline__ void operator()(AccT& acc, const pg8::Unit& u, int wr, int wc, int fr, int fq) const {
        const int row0 = u.pm * 256 + wr * 64 + fr, lc0 = wc * 32 + 8 * fq, side = u.pn >> 1;
#pragma unroll
        for (int ai = 0; ai < 2; ++ai)
#pragma unroll
            for (int m = 0; m < 4; ++m) {
                const int row = row0 + ai * 128 + m * 16; const f32x4 pw = *(const f32x4*)(PW + (size_t)row * 4);
                const float rs = pw[0], cw = side ? pw[2] : pw[1];
                f32x4 o[2];
#pragma unroll
                for (int n = 0; n < 2; ++n)
#pragma unroll
                    for (int j = 0; j < 4; ++j) { const float a1 = acc[ai][0][m][n][j] * rs, a3 = acc[ai][1][m][n][j] * rs; o[n][j] = cw * a1 * sigmoidf_(a1) * a3; }
                *(u32x4*)(HH + (size_t)row * 512 + side * 256 + (u.pn & 1) * 128 + lc0) = pack8(o[0], o[1]);
            }
    }
};
struct EpiB2 {
    static constexpr bool PERM = true;
    __device__ __forceinline__ bool keep(const pg8::Unit&) const { return false; }
    bf16* Y;
    __device__ __forceinline__ void operator()(AccT& acc, const pg8::Unit& u, int wr, int wc, int fr, int fq) const { run<false>(acc, u, wr, wc, fr, fq); }
    template <bool SK> __device__ __forceinline__ void run(AccT& acc, const pg8::Unit& u, int wr, int wc, int fr, int fq) const {
        const int row0 = u.pm * 256 + wr * 64 + fr, col0 = u.pn * 256 + wc * 32 + 8 * fq;
#pragma unroll
        for (int ai = 0; ai < (SK ? 1 : 2); ++ai)
#pragma unroll
            for (int m = 0; m < (SK ? 1 : 4); ++m) {
                bf16* rp = Y + (size_t)(row0 + ai * 128 + m * 16) * 1024 + col0;
#pragma unroll
                for (int bj = 0; bj < 2; ++bj) *(u32x4*)(rp + bj * 128) = pack8(acc[ai][bj][m][0], acc[ai][bj][m][1]);
            }
    }
};
template <bool GA> struct MoeOrderT {
    static constexpr bool GATHER = GA; const LAS int* tokl;
    int NP, G, c, mode; const LAS int* pcls; const bf16* W;
    __device__ bool next(int i, pg8::Unit& u) const { const long L = (long)i * G + c; if (L >= (long)NP * 4) return false; u.pm = (int)(L >> 2); u.pn = (int)(L & 3); u.seg = 0; return true; }
    __device__ __forceinline__ int nt(const pg8::Unit&, int ntd) const { return ntd; }
    __device__ __forceinline__ size_t aoff(const pg8::Unit&) const { return 0; }
    __device__ __forceinline__ const char* bptr(const pg8::Unit& u, int side) const {
        const int cls = __builtin_amdgcn_readfirstlane(pcls[u.pm]); const int grp = cls / 6, pr = cls % 6;
        const int ea = pr < 3 ? 0 : (pr < 5 ? 1 : 2), eb = pr < 3 ? pr + 1 : (pr < 5 ? pr - 1 : 3);
        if (mode == 0) { const int e = grp * 4 + (u.pn < 2 ? ea : eb); return (const char*)W + ((size_t)e * 512 + (size_t)(u.pn & 1) * 256) * 1024 * 2; }
        const int e = grp * 4 + (side ? eb : ea); return (const char*)W + ((size_t)e * 1024 + (size_t)u.pn * 256) * 256 * 2;
    }
};

template <bool PERM> __device__ __forceinline__ void skinny_k(AccT& acc, const bf16* A, int lda, const bf16* Bt, int ldb, int K, int wc, int fr, int fq) {
    const bf16* ap = A + (size_t)fr * lda + 8 * fq;
    const bf16* bp[2][2];
#pragma unroll
    for (int bj = 0; bj < 2; ++bj)
#pragma unroll
        for (int n = 0; n < 2; ++n) { const int col = 128 * bj + 32 * wc + (PERM ? 8 * (fr >> 2) + 4 * n + (fr & 3) : 16 * n + fr); bp[bj][n] = Bt + (size_t)col * ldb + 8 * fq; }
#pragma unroll 8
    for (int k0 = 0; k0 < K; k0 += 32) {
        const bf16x8 a = *(const bf16x8*)(ap + k0);
#pragma unroll
        for (int bj = 0; bj < 2; ++bj)
#pragma unroll
            for (int n = 0; n < 2; ++n) { const bf16x8 b = *(const bf16x8*)(bp[bj][n] + k0); acc[0][bj][0][n] = __builtin_amdgcn_mfma_f32_16x16x32_bf16(b, a, acc[0][bj][0][n], 0, 0, 0); }
    }
}
__device__ __forceinline__ void skinny_zero(AccT& acc) {
#pragma unroll
    for (int bj = 0; bj < 2; ++bj)
#pragma unroll
        for (int n = 0; n < 2; ++n) acc[0][bj][0][n] = (f32x4){0.f, 0.f, 0.f, 0.f};
}
__device__ __forceinline__ void skinny_combine(AccT& acc, LAS unsigned char* lds, int wave, int lane) {
    LAS f32x4* X = (LAS f32x4*)lds;
    if (wave >= 4) {
#pragma unroll
        for (int bj = 0; bj < 2; ++bj)
#pragma unroll
            for (int n = 0; n < 2; ++n) X[((wave - 4) * 64 + lane) * 4 + bj * 2 + n] = acc[0][bj][0][n]; }
    __syncthreads();
    if (wave < 4) {
#pragma unroll
        for (int bj = 0; bj < 2; ++bj)
#pragma unroll
            for (int n = 0; n < 2; ++n) acc[0][bj][0][n] += X[(wave * 64 + lane) * 4 + bj * 2 + n]; }
    __syncthreads();
}

#define XB_TMO      128
#define XB_XCNT(j)  (256  + 64 * (j))
#define XB_XSUB(j)  (1280 + 64 * (j))
#define XB_XGEN(j)  (2304 + 64 * (j))
#define XB_TOP      3328
#define XB_TOPGEN   3392
#define XCD_BAR_WORDS 3456
#define XB_SPIN_CAP (1u << 24)
__device__ __forceinline__ unsigned xb_ld(unsigned* p)              { return __hip_atomic_load(p, __ATOMIC_RELAXED, __HIP_MEMORY_SCOPE_AGENT); }
__device__ __forceinline__ unsigned xb_add(unsigned* p, unsigned v) { return __hip_atomic_fetch_add(p, v, __ATOMIC_RELAXED, __HIP_MEMORY_SCOPE_AGENT); }
__device__ __forceinline__ unsigned xb_xcc_id() { return (unsigned)__builtin_amdgcn_s_getreg((3 << 11) | 20) & 0xFu; }
#define XB_SPIN(cond, bar) do { unsigned _sp = 0; while (cond) { __builtin_amdgcn_s_sleep(1); \
    if ((++_sp & 255u) == 0u) { if (xb_ld(&(bar)[XB_TMO])) break; if (_sp > XB_SPIN_CAP) { atomicAdd(&(bar)[XB_TMO], 1u); break; } } } } while (0)
struct XcdBarrier { unsigned* bar; unsigned x; volatile LAS unsigned* st; };
__device__ __forceinline__ XcdBarrier xcd_barrier_post(unsigned* bar, volatile LAS unsigned* st) {
    XcdBarrier b; b.bar = bar; b.x = xb_xcc_id(); b.st = st;
    if (threadIdx.x == 0) (void)xb_add(&bar[XB_XCNT(b.x)], 1u);
    return b;
}
__device__ __forceinline__ void xcd_barrier_complete(unsigned* bar, unsigned x, unsigned& nloc, unsigned& nx) {
    const unsigned G = gridDim.x * gridDim.y * gridDim.z;
    unsigned sum, cnt, mine, sp = 0u;
    for (;;) {
        sum = 0u; cnt = 0u; mine = 0u;
#pragma unroll
        for (unsigned j = 0; j < 16; ++j) { const unsigned c = xb_ld(&bar[XB_XCNT(j)]); sum += c; cnt += (c > 0u) ? 1u : 0u; mine = (j == x) ? c : mine; }
        if (sum == G) break;
        __builtin_amdgcn_s_sleep(1);
        if ((++sp & 255u) == 0u) { if (xb_ld(&bar[XB_TMO])) break; if (sp > XB_SPIN_CAP) { atomicAdd(&bar[XB_TMO], 1u); break; } }
    }
    nloc = mine > 0u ? mine : 1u; nx = cnt > 0u ? cnt : 1u;
}
__device__ __forceinline__ void xcd_barrier(const XcdBarrier& b) {
    asm volatile("s_waitcnt vmcnt(0)" ::: "memory");
    __syncthreads();
    if (threadIdx.x == 0) {
        unsigned* bar = b.bar;
        __builtin_amdgcn_s_waitcnt(0);
        unsigned nloc = b.st[0], nx = b.st[1];
        if (nloc == 0u) { xcd_barrier_complete(bar, b.x, nloc, nx); b.st[0] = nloc; b.st[1] = nx; }
        const unsigned old = xb_add(&bar[XB_XSUB(b.x)], 1u);
        const unsigned gen = old / nloc;
        if (old + 1u == (gen + 1u) * nloc) {
            __builtin_amdgcn_fence(__ATOMIC_RELEASE, "agent");
            asm volatile("s_waitcnt vmcnt(0)" ::: "memory");
            const unsigned og = xb_add(&bar[XB_TOP], 1u);
            const unsigned tg = og / nx;
            if (og + 1u == (tg + 1u) * nx) xb_add(&bar[XB_TOPGEN], 1u);
            else XB_SPIN(xb_ld(&bar[XB_TOPGEN]) == tg, bar);
            __builtin_amdgcn_fence(__ATOMIC_ACQUIRE, "agent");
            xb_add(&bar[XB_XGEN(b.x)], 1u);
            asm volatile("s_waitcnt vmcnt(0)" ::: "memory");
        } else {
            XB_SPIN(xb_ld(&bar[XB_XGEN(b.x)]) == gen, bar);
            __builtin_amdgcn_fence(__ATOMIC_ACQUIRE, "agent");
            asm volatile("s_waitcnt vmcnt(0)" ::: "memory");
        }
    }
    __syncthreads();
}

struct Params { const float* in[25]; float* out; unsigned char* ws; int ph_lo, ph_hi; };
enum { I_X = 0, I_META, I_N1G, I_WIN, I_BF, I_PW, I_PB, I_PS, I_CW, I_CB, I_LNG, I_LNB, I_WOA, I_WOB, I_WOC, I_WO, I_N2G, I_RGW, I_RGB, I_REW, I_REB, I_W1, I_W3, I_W2, I_FG };

struct Frame {
    LAS unsigned char* lds;
    int tid, lane, wave, vcu, G, bx;
};
__device__ __forceinline__ unsigned long long ptab_get(const Frame& F, int i) { const LAS unsigned* t = (const LAS unsigned*)(F.lds + LC_PTAB) + 2 * i; const unsigned lo = __builtin_amdgcn_readfirstlane(t[0]), hi = __builtin_amdgcn_readfirstlane(t[1]); return ((unsigned long long)hi << 32) | lo; }
#define INP(i) ((const float*)(const GAS float*)ptab_get(F, (i)))
#define WSP() ((unsigned char*)(GAS unsigned char*)ptab_get(F, 25))
#define DOP() ((unsigned char*)(GAS unsigned char*)ptab_get(F, 26))

__device__ __forceinline__ void tr_item(const float* W, int ldw, int scol_lane  , const float* gk, bf16* WT, int ldt, int drow0, int k0, LAS float* scr, int lane) {
    const int n4 = (lane & 7) * 4, kr = lane >> 3;
    f32x4 v[8];
#pragma unroll
    for (int i = 0; i < 8; ++i) v[i] = *(const f32x4*)(W + (size_t)(k0 + 8 * i + kr) * ldw + scol_lane);
#pragma unroll
    for (int i = 0; i < 8; ++i) { const int kk = 8 * i + kr; const float g = gk ? gk[k0 + kk] : 1.0f; LAS float* d = scr + kk * 33 + n4; d[0] = v[i][0] * g; d[1] = v[i][1] * g; d[2] = v[i][2] * g; d[3] = v[i][3] * g; }
    LDS_WAIT(); asm volatile("" ::: "memory");
    const int c = lane & 7;
#pragma unroll
    for (int j = 0; j < 4; ++j) { const int n = (lane >> 3) + 8 * j; const LAS float* s = scr + (8 * c) * 33 + n;
        u32x4 o; o.x = pk2(s[0 * 33], s[1 * 33]); o.y = pk2(s[2 * 33], s[3 * 33]); o.z = pk2(s[4 * 33], s[5 * 33]); o.w = pk2(s[6 * 33], s[7 * 33]);
        *(u32x4*)(WT + (size_t)(drow0 + n) * ldt + k0 + 8 * c) = o; }
    LDS_WAIT(); asm volatile("" ::: "memory");
}
__device__ __forceinline__ int map1(int n) {
    const int tile = n >> 8, c = n & 255;
    if (tile == 0) return n;
    if (tile <= 2) { const int cc = (tile - 1) * 128 + (c & 127); return (c < 128 ? 256 : 512) + cc; }
    if (tile <= 4) return 1792 + (n - 768);
    const int t = tile - 5, bj = c >> 7, wc = (c >> 5) & 3, fq = (c >> 3) & 3, nn = (c >> 2) & 1, d = 64 * t + 16 * wc + 4 * fq + (c & 3), kind = 2 * bj + nn;
    return kind == 3 ? 768 + d : 2312 + 1024 * kind + d;
}
__device__ __forceinline__ void convert_item(Frame& F, int l, int it, LAS float* scr, int lane) {
    const float* g1 = INP(I_N1G) + (size_t)l * D; const float* g2 = INP(I_N2G) + (size_t)l * D; unsigned char* ws = WSP(); const int n4l = (lane & 7) * 4;
    if (it < 2688) { const int kb = it / 168, nb = it % 168; tr_item(INP(I_WIN) + (size_t)l * D * NIN, NIN, map1(nb * 32 + n4l), g1, (bf16*)(ws + WS_W1T), 1024, nb * 32, kb * 64, scr, lane); return; } it -= 2688;
    if (it < 128) { const int kb = it / 32, nb = it % 32; tr_item(INP(I_WOB) + (size_t)l * 256 * D, 1024, nb * 32 + n4l, nullptr, (bf16*)(ws + WS_W3CT) + 256, 1024, nb * 32, kb * 64, scr, lane); return; } it -= 128;
    if (it < 256) { const int kb = it / 32, nb = it % 32; tr_item(INP(I_WOC) + (size_t)l * 512 * D, 1024, nb * 32 + n4l, nullptr, (bf16*)(ws + WS_W3CT) + 512, 1024, nb * 32, kb * 64, scr, lane); return; } it -= 256;
    if (it < 512) { const int kb = it / 32, nb = it % 32; tr_item(INP(I_WO) + (size_t)l * D * D, 1024, nb * 32 + n4l, nullptr, (bf16*)(ws + WS_WOT), 1024, nb * 32, kb * 64, scr, lane); return; } it -= 512;
    if (it < 4096) { const int e = it >> 8, r = it & 255, kb = r >> 4, nb = r & 15, n0 = nb * 32, jt = n0 >> 8, rr = n0 & 255;
        const float* W = (rr < 128 ? INP(I_W1) : INP(I_W3)) + ((size_t)l * 16 + e) * D * 256;
        tr_item(W, 256, jt * 128 + (rr & 127) + n4l, g2, (bf16*)(DOP() + DO_W13T) + (size_t)e * 512 * 1024, 1024, n0, kb * 64, scr, lane); return; } it -= 4096;
    { const int e = it >> 7, r = it & 127, kb = r >> 5, nb = r & 31;
        tr_item(INP(I_W2) + ((size_t)l * 16 + e) * 256 * D, 1024, nb * 32 + n4l, nullptr, (bf16*)(DOP() + DO_W2T) + (size_t)e * 1024 * 256, 256, nb * 32, kb * 64, scr, lane); }
}
__device__ __forceinline__ void convert_weights(Frame& F, int l) {
    LAS float* scr = (LAS float*)(F.lds + F.wave * 16384);
    const int gw = F.vcu * NWAVES + F.wave, NGW = F.G * NWAVES, lane = F.lane;
    const float* g1 = INP(I_N1G) + (size_t)l * D; const float* g2 = INP(I_N2G) + (size_t)l * D;
    unsigned char* ws = WSP();
#pragma unroll 1
    for (int it0 = gw; it0 < 3584; it0 += NGW) convert_item(F, l, it0, scr, lane);
    { const float* pw = INP(I_PW) + (size_t)l * 4 * 64 * 64; const float* ps = INP(I_PS) + (size_t)l * 256; const float* pb = INP(I_PB) + (size_t)l * 256;
      const float* wa = INP(I_WOA) + (size_t)l * 256 * D; bf16* WT = (bf16*)(ws + WS_W3CT); float* bias = (float*)(ws + WS_BIASA);
      const int gt = F.vcu * 512 + F.tid, NT = F.G * 512;
      for (int idx = gt; idx < 256 * 1024; idx += NT) { const int n = idx & 1023, kk = idx >> 10, grp = kk >> 6, c = kk & 63; float s = 0.f;
#pragma unroll 16
        for (int d = 0; d < 64; ++d) s += pw[(grp * 64 + c) * 64 + d] * ps[grp * 64 + d] * wa[(size_t)(grp * 64 + d) * D + n];
        WT[(size_t)n * 1024 + kk] = (bf16)f2bf(s); }
      for (int n = gw; n < 1024; n += NGW) { float s = 0.f;
#pragma unroll
        for (int j = 0; j < 4; ++j) { const int d = lane + 64 * j; s += pb[d] * ps[d] * wa[(size_t)d * D + n]; }
        s = wave_sum(s); if (lane == 0) bias[n] = s; }
      float* wfg = (float*)(ws + WS_WFG); const float* win = INP(I_WIN) + (size_t)l * D * NIN;
      for (int idx = gt; idx < 8 * 1024; idx += NT) { const int c = idx >> 10, k = idx & 1023; wfg[idx] = g1[k] * win[(size_t)k * NIN + 2304 + c]; }
      float* rg = (float*)(ws + WS_RG); const float* re = INP(I_REW) + (size_t)l * D * 16; const float* rgw = INP(I_RGW) + (size_t)l * D * 4;
      for (int idx = gt; idx < 20 * 1024; idx += NT) { const int c = idx >> 10, k = idx & 1023; rg[idx] = g2[k] * (c < 16 ? re[(size_t)k * 16 + c] : rgw[(size_t)k * 4 + (c - 16)]); } }
}
__device__ __forceinline__ void init_rows(Frame& F) {
    const int gw = F.vcu * NWAVES + F.wave, NGW = F.G * NWAVES, lane = F.lane;
    bf16* HB = (bf16*)(WSP() + WS_HB); float* rstd1 = (float*)(WSP() + WS_RSTD1);
    constexpr int R = 4;
#pragma unroll 1
    for (int row0 = gw; row0 < TR; row0 += R * NGW) {
        f32x4 v[R][4];
#pragma unroll
        for (int r = 0; r < R; ++r) { int row = row0 + r * NGW; if (row >= TR) row = TR - 1;
            const float* src = row < TX ? INP(I_X) + (size_t)row * D : INP(I_META) + (size_t)(row - TX) * D;
#pragma unroll
            for (int j = 0; j < 4; ++j) v[r][j] = *(const f32x4*)(src + 4 * lane + 256 * j); }
#pragma unroll
        for (int r = 0; r < R; ++r) { const int row = row0 + r * NGW; float ss = 0.f;
#pragma unroll
            for (int j = 0; j < 4; ++j) ss += v[r][j][0] * v[r][j][0] + v[r][j][1] * v[r][j][1] + v[r][j][2] * v[r][j][2] + v[r][j][3] * v[r][j][3];
            ss = wave_sum(ss);
            if (row < TR) {
#pragma unroll
                for (int j = 0; j < 4; ++j) { u32x2 w; w.x = pk2(v[r][j][0], v[r][j][1]); w.y = pk2(v[r][j][2], v[r][j][3]); *(u32x2*)(HB + (size_t)row * D + 4 * lane + 256 * j) = w; }
                if (lane == 0) rstd1[row] = rsqrtf(ss * (1.0f / D) + EPS); } }
    }
    { bf16* Kb = (bf16*)(DOP() + DO_K) + (size_t)TR * 512; bf16* Vb = (bf16*)(DOP() + DO_V) + (size_t)TR * 512; const int gt = F.vcu * 512 + F.tid;
      if (gt < 48 * 64) { *(u32x4*)(Kb + (size_t)gt * 8) = (u32x4){0u, 0u, 0u, 0u}; *(u32x4*)(Vb + (size_t)gt * 8) = (u32x4){0u, 0u, 0u, 0u}; } }
}

__device__ __forceinline__ int srcrow(bool isx, int b, int t) {
    if (t >= 0) return (isx ? b * SEQ : TX) + t;
    if (isx) { const int mm = NMETA + t; return mm >= 0 ? TX + mm : -1; }
    return -1;
}
__device__ __forceinline__ void phase_S(Frame& F, int l) {
    LAS unsigned char* lds = F.lds; const int wave = F.wave;
#pragma unroll 1
    for (int item = F.vcu; item < 513; item += F.G) {
        const bool isx = item < 512; const int row0 = isx ? item * 64 : TX + (item - 512) * 64; const int b = isx ? (item * 64) / SEQ : 0; const int t0 = isx ? (item * 64) % SEQ : (item - 512) * 64; const int nrows = isx ? 64 : NMETA;
        { unsigned char* ws = WSP(); int tid = F.tid; LAUNDER_V(tid); const int lane = tid & 63, fr = lane & 15, fq = lane >> 4;
          const bf16* HB = (const bf16*)(ws + WS_HB); const float* rstd1 = (const float*)(ws + WS_RSTD1); const float* wfg = (const float*)(ws + WS_WFG);
          float* LFT = (float*)(ws + WS_LFT); float* LFTM = (float*)(ws + WS_LFTM); const float* bfg = INP(I_BF) + l * 8;
          LAS bf16* Whi = (LAS bf16*)lds; LAS bf16* Wlo = Whi + 8 * RPITCH; LAS float* Pex = (LAS float*)(lds + 2 * 8 * RPITCH * 2); LAS unsigned* nmx = (LAS unsigned*)(lds + LC_NMX);
          { f32x4 wv_[4];
#pragma unroll
            for (int j = 0; j < 4; ++j) wv_[j] = *(const f32x4*)(wfg + 4 * (tid + 512 * j));
#pragma unroll
            for (int j = 0; j < 4; ++j) { const int i = 4 * (tid + 512 * j), c = i >> 10, k = i & 1023; u32x2 hw, lw; float hf[4];
#pragma unroll
                for (int e = 0; e < 4; ++e) hf[e] = __builtin_bit_cast(float, (pk2(wv_[j][e], 0.f) & 0xffffu) << 16);
                hw.x = pk2(wv_[j][0], wv_[j][1]); hw.y = pk2(wv_[j][2], wv_[j][3]); lw.x = pk2(wv_[j][0] - hf[0], wv_[j][1] - hf[1]); lw.y = pk2(wv_[j][2] - hf[2], wv_[j][3] - hf[3]);
                *(LAS u32x2*)(Whi + c * RPITCH + k) = hw; *(LAS u32x2*)(Wlo + c * RPITCH + k) = lw; } }
          if (tid < 16) nmx[tid] = 0u;
          const int g = wave & 3, kh = wave >> 2, rr = 16 * g + fr, row = row0 + rr;
          bf16x8 af[16];
#pragma unroll
          for (int s2 = 0; s2 < 16; ++s2) af[s2] = *(const bf16x8*)(HB + (size_t)row * D + 32 * (16 * kh + s2) + 8 * fq);
          const float rs1 = rstd1[row];
          __syncthreads();
          f32x4 acc = {0.f, 0.f, 0.f, 0.f};
#pragma unroll
          for (int s2 = 0; s2 < 16; ++s2) { const int k = 32 * (16 * kh + s2) + 8 * fq;
              bf16x8 wh = *(const LAS bf16x8*)(Whi + (fr & 7) * RPITCH + k), wl = *(const LAS bf16x8*)(Wlo + (fr & 7) * RPITCH + k);
              if (fr >= 8) { wh = (bf16x8){0, 0, 0, 0, 0, 0, 0, 0}; wl = wh; }
              acc = __builtin_amdgcn_mfma_f32_16x16x32_bf16(wh, af[s2], acc, 0, 0, 0); acc = __builtin_amdgcn_mfma_f32_16x16x32_bf16(wl, af[s2], acc, 0, 0, 0); }
          if (kh == 1) *(LAS f32x4*)(Pex + (g * 64 + lane) * 4) = acc;
          { const bf16* Qg = (const bf16*)(DOP() + DO_Q); const bf16* Kg = (const bf16*)(DOP() + DO_K); float kmx = 0.f, qmx = 0.f;
            u32x4 kw[8], qw[8];
#pragma unroll
            for (int i8 = 0; i8 < 8; ++i8) { const int r2 = wave + 8 * i8; const int rw = row0 + (r2 < nrows ? r2 : 0); kw[i8] = *(const u32x4*)(Kg + (size_t)rw * 512 + 8 * lane); qw[i8] = *(const u32x4*)(Qg + (size_t)rw * 512 + 8 * lane); }
#pragma unroll
            for (int i8 = 0; i8 < 8; ++i8) { const u32x4 a = kw[i8], c = qw[i8];
                float sk = (bflo(a.x) * bflo(a.x) + bfhi(a.x) * bfhi(a.x)) + (bflo(a.y) * bflo(a.y) + bfhi(a.y) * bfhi(a.y)) + (bflo(a.z) * bflo(a.z) + bfhi(a.z) * bfhi(a.z)) + (bflo(a.w) * bflo(a.w) + bfhi(a.w) * bfhi(a.w));
                float sq = (bflo(c.x) * bflo(c.x) + bfhi(c.x) * bfhi(c.x)) + (bflo(c.y) * bflo(c.y) + bfhi(c.y) * bfhi(c.y)) + (bflo(c.z) * bflo(c.z) + bfhi(c.z) * bfhi(c.z)) + (bflo(c.w) * bflo(c.w) + bfhi(c.w) * bfhi(c.w));
                sk += lane_xor<1>(sk); sk += lane_xor<2>(sk); sk += lane_xor<4>(sk); sq += lane_xor<1>(sq); sq += lane_xor<2>(sq); sq += lane_xor<4>(sq);
                kmx = fmaxf(kmx, sk); qmx = fmaxf(qmx, sq); }
            if ((lane & 7) == 0) { const int hd = lane >> 3; __hip_atomic_fetch_max(&nmx[hd], __float_as_uint(kmx), __ATOMIC_RELAXED, __HIP_MEMORY_SCOPE_WORKGROUP); __hip_atomic_fetch_max(&nmx[8 + hd], __float_as_uint(qmx), __ATOMIC_RELAXED, __HIP_MEMORY_SCOPE_WORKGROUP); } }
          __syncthreads();
          if (kh == 0) { const f32x4 o4 = *(const LAS f32x4*)(Pex + (g * 64 + lane) * 4); acc += o4;
              if (fq < 2 && rr < nrows && row < TR) {
#pragma unroll
                  for (int i = 0; i < 4; ++i) { const int hd = 4 * fq + i; const float xg = acc[i] * rs1 + bfg[hd]; const float lf = fminf(xg, 0.f) - 0.69314718056f * __builtin_amdgcn_logf(1.0f + __expf(-fabsf(xg)));
                      if (isx) LFT[(size_t)(b * 8 + hd) * SEQ + t0 + rr] = lf; else LFTM[hd * 256 + t0 + rr] = lf; } } }
          if (tid < 16) { unsigned* nrm = (unsigned*)(WSP() + WS_CTL) + CW_NRM + l * 64; const unsigned v = nmx[tid];
              if (isx) __hip_atomic_fetch_max(nrm + (tid >> 3) * 32 + b * 8 + (tid & 7), v, __ATOMIC_RELAXED, __HIP_MEMORY_SCOPE_AGENT);
              else if (tid < 8) { for (int bb = 0; bb < NB; ++bb) __hip_atomic_fetch_max(nrm + bb * 8 + tid, v, __ATOMIC_RELAXED, __HIP_MEMORY_SCOPE_AGENT); } }
          __syncthreads(); }
    }
}
__device__ __forceinline__ void s_item_poolconv(Frame& F, int l, int it32) {
    const int hw = F.wave >> 2, hwave = F.wave & 3; LAS unsigned char* lds = F.lds + hw * 64512;
    const bool isx = it32 < 1024; const int row0 = isx ? it32 * 32 : TX; const int b = isx ? (it32 * 32) / SEQ : 0; const int t0 = isx ? (it32 * 32) % SEQ : 0; const int nrows = isx ? 32 : NMETA;
    { unsigned char* ws = WSP(); int tid = F.tid & 255; LAUNDER_V(tid);
      const bf16* Ab = (const bf16*)(ws + WS_A); bf16* DIFF = (bf16*)(ws + WS_X3);
      LAS unsigned char* T = lds;
      { u32x4 tv[6]; const int nld = (15 + nrows) * 32;
#pragma unroll
        for (int j = 0; j < 6; ++j) { const int i = tid + 256 * j; const int sl = i >> 5, ch = i & 31; const int r = i < nld ? srcrow(isx, b, t0 + sl - 15) : -1; unsigned z_ = 0u; LAUNDER_V(z_);
            tv[j] = r >= 0 ? *(const u32x4*)(Ab + (size_t)r * 256 + ch * 8) : (u32x4){z_, z_, z_, z_}; }
#pragma unroll
        for (int j = 0; j < 6; ++j) { const int i = tid + 256 * j; if (i < nld) *(LAS u32x4*)(T + (i >> 5) * 512 + (i & 31) * 16) = tv[j]; } }
      __syncthreads();
#pragma unroll 1
      for (int i = tid; i < nrows * 32; i += 256) { const int r = i >> 5, ch = i & 31, grp = ch >> 3, w = 2 << grp; const int cnt = isx ? w : min(t0 + r + 1, w);
          float s[8];
#pragma unroll
          for (int j = 0; j < 8; ++j) s[j] = 0.f;
#pragma unroll 4
          for (int d = 0; d < cnt; ++d) { const u32x4 v = *(const LAS u32x4*)(T + (15 + r - d) * 512 + ch * 16);
              s[0] += bflo(v.x); s[1] += bfhi(v.x); s[2] += bflo(v.y); s[3] += bfhi(v.y); s[4] += bflo(v.z); s[5] += bfhi(v.z); s[6] += bflo(v.w); s[7] += bfhi(v.w); }
          const u32x4 a = *(const LAS u32x4*)(T + (15 + r) * 512 + ch * 16); const float ic = 1.0f / (float)cnt;
          u32x4 o; o.x = pk2(s[0] * ic - bflo(a.x), s[1] * ic - bfhi(a.x)); o.y = pk2(s[2] * ic - bflo(a.y), s[3] * ic - bfhi(a.y));
          o.z = pk2(s[4] * ic - bflo(a.z), s[5] * ic - bfhi(a.z)); o.w = pk2(s[6] * ic - bflo(a.w), s[7] * ic - bfhi(a.w));
          if (row0 + r < TR) *(u32x4*)(DIFF + (size_t)(row0 + r) * 1024 + ch * 8) = o; }
      __syncthreads(); }
    { unsigned char* ws = WSP(); int tid = F.tid & 255; LAUNDER_V(tid);
      const bf16* GLU = (const bf16*)(ws + WS_GLU);
      LAS unsigned char* T = lds;
      LAS float* Yt = (LAS float*)(lds + 31744);
      { u32x4 tv[8]; const int nld = (isx ? 62 : 46) * 32;
#pragma unroll
        for (int j = 0; j < 8; ++j) { const int i = tid + 256 * j; const int sl = i >> 5, ch = i & 31; const int r = i < nld ? srcrow(isx, b, t0 + sl - 30) : -1; unsigned z_ = 0u; LAUNDER_V(z_);
            tv[j] = r >= 0 ? *(const u32x4*)(GLU + (size_t)r * 256 + ch * 8) : (u32x4){z_, z_, z_, z_}; }
#pragma unroll
        for (int j = 0; j < 8; ++j) { const int i = tid + 256 * j; if (i < 62 * 32) *(LAS u32x4*)(T + (i >> 5) * 512 + (i & 31) * 16) = tv[j]; } }
      __syncthreads();
      { const float* cw = INP(I_CW) + (size_t)l * 31 * 256; const float* cb = INP(I_CB) + l * 256;
        const int cp = tid & 127, strip = tid >> 7; f32x2 wv[31];
#pragma unroll
        for (int j = 0; j < 31; ++j) wv[j] = *(const f32x2*)(cw + j * 256 + 2 * cp);
        const f32x2 bias = *(const f32x2*)(cb + 2 * cp);
#pragma unroll 1
        for (int hh = 0; hh < 2; ++hh) { const int rb = 16 * strip + 8 * hh; f32x2 acc[8];
#pragma unroll
            for (int r = 0; r < 8; ++r) acc[r] = bias;
#pragma unroll
            for (int i = 0; i < 38; ++i) { const unsigned xw = *(const LAS unsigned*)(T + (rb + i) * 512 + cp * 4); const f32x2 xx = {bflo(xw), bfhi(xw)};
#pragma unroll
                for (int r = 0; r < 8; ++r) { const int j = i - r; if (j >= 0 && j <= 30) acc[r] += wv[j] * xx; } }
#pragma unroll
            for (int r = 0; r < 8; ++r) *(LAS f32x2*)(Yt + (rb + r) * 256 + 2 * cp) = acc[r]; } }
      __syncthreads();
      { unsigned char* ws2 = WSP(); int tid2 = F.tid; LAUNDER_V(tid2); const int lane = tid2 & 63;
        bf16* BP = (bf16*)(ws2 + WS_X3) + 256; const float* lng = INP(I_LNG) + l * 256; const float* lnb = INP(I_LNB) + l * 256;
        const f32x4 gg = *(const f32x4*)(lng + 4 * lane), bb = *(const f32x4*)(lnb + 4 * lane);
#pragma unroll
        for (int i8 = 0; i8 < 8; ++i8) { const int rr = hwave + 4 * i8; if (rr >= nrows) continue; const f32x4 v = *(const LAS f32x4*)(Yt + rr * 256 + 4 * lane);
          const float mean = wave_sum(v[0] + v[1] + v[2] + v[3]) * (1.0f / 256.0f); const f32x4 dv = v - mean;
          const float var = wave_sum(dv[0] * dv[0] + dv[1] * dv[1] + dv[2] * dv[2] + dv[3] * dv[3]) * (1.0f / 256.0f); const float rs = rsqrtf(var + EPS);
          f32x4 o = dv * rs * gg + bb;
#pragma unroll
          for (int j = 0; j < 4; ++j) o[j] = o[j] * sigmoidf_(o[j]);
          u32x2 w; w.x = pk2(o[0], o[1]); w.y = pk2(o[2], o[3]); if (row0 + rr < TR) *(u32x2*)(BP + (size_t)(row0 + rr) * 1024 + 4 * lane) = w; } }
      __syncthreads(); }
}
constexpr int AT_FL = 0, AT_K = 34816, AT_VT = AT_K + 8192, AT_SC = AT_VT + 8192;
__device__ __forceinline__ void attn_scan(Frame& F, int b, int h, bool meta_only, int fl_off, int sc_off) {
    LAS float* Fl = (LAS float*)(F.lds + fl_off); LAS float* sc = (LAS float*)(F.lds + sc_off);
    const float* LFT = (const float*)(WSP() + WS_LFT); const float* LFTM = (const float*)(WSP() + WS_LFTM);
    const int tid = F.tid, lane = F.lane, wave = F.wave;
    __syncthreads();
    if (tid == 0) { float s = 0.f; for (int m = 0; m < 64; ++m) { if (m < NMETA) { s += LFTM[h * 256 + m]; Fl[m] = s * LOG2E; } else Fl[m] = 1e30f; if (m == NMETA - 1) sc[16] = s; } }
    if (meta_only) { for (int i = tid; i < 256; i += 512) Fl[64 + i] = 0.f; __syncthreads(); return; }
    float v[16]; const float* src = LFT + (size_t)(b * 8 + h) * SEQ + 16 * tid;
#pragma unroll
    for (int j = 0; j < 4; ++j) { const f32x4 q = *(const f32x4*)(src + 4 * j); v[4 * j] = q[0]; v[4 * j + 1] = q[1]; v[4 * j + 2] = q[2]; v[4 * j + 3] = q[3]; }
#pragma unroll
    for (int j = 1; j < 16; ++j) v[j] += v[j - 1];
    float incl = v[15];
#pragma unroll
    for (int o = 1; o < 64; o <<= 1) { const float up = __int_as_float(__builtin_amdgcn_ds_bpermute((lane - o) << 2, __float_as_int(incl))); if (lane >= o) incl += up; }
    if (lane == 63) sc[wave] = incl;
    __syncthreads();
    float off = sc[16];
    for (int w = 0; w < wave; ++w) off += sc[w];
    off += incl - v[15];
#pragma unroll
    for (int j = 0; j < 16; ++j) Fl[64 + 16 * tid + j] = (off + v[j]) * LOG2E;
    __syncthreads();
}
__device__ __forceinline__ void attn_unit_naive(Frame& F, int qrow0, int qpos0, int ntiles, int kvx0, int h, int nq) {
    const int tid = F.tid; const int hf = tid & 1; const bool live = (tid >> 1) < nq; const int r = live ? (tid >> 1) : 0;
    const bf16* Q = (const bf16*)(DOP() + DO_Q); const bf16* Kg = (const bf16*)(DOP() + DO_K); const bf16* Vg = (const bf16*)(DOP() + DO_V); bf16* O = (bf16*)(WSP() + WS_X3) + 512;
    LAS float* Fl = (LAS float*)(F.lds + AT_FL); LAS unsigned char* Ks = F.lds + AT_K; LAS bf16* VT = (LAS bf16*)(F.lds + AT_VT);
    const int grow = qrow0 + r, qpos = qpos0 + r;
    unsigned qp[16];
#pragma unroll
    for (int j = 0; j < 4; ++j) { const u32x4 w = *(const u32x4*)(Q + (size_t)grow * 512 + h * 64 + hf * 32 + 8 * j); qp[4 * j] = w.x; qp[4 * j + 1] = w.y; qp[4 * j + 2] = w.z; qp[4 * j + 3] = w.w; }
    const float Fq = Fl[qpos < NMETA ? qpos : qpos + 48];
    float mrun = -1e30f, lrun = 0.f, o[32];
#pragma unroll
    for (int d = 0; d < 32; ++d) o[d] = 0.f;
    const int lrow = tid >> 3, lch = tid & 7;

#pragma unroll 1
for (int i = 0; i < ntiles; ++i) {
        const int krow = (i == 0 ? TX : kvx0 + 64 * (i - 1)) + lrow;
        const u32x4 kw = *(const u32x4*)(Kg + (size_t)krow * 512 + h * 64 + lch * 8);
        const u32x4 vw = *(const u32x4*)(Vg + (size_t)krow * 512 + h * 64 + lch * 8);
        __syncthreads();
        *(LAS u32x4*)(Ks + lrow * 128 + lch * 16) = kw;
        { const unsigned vv[4] = {vw.x, vw.y, vw.z, vw.w};
#pragma unroll
          for (int e = 0; e < 4; ++e) { VT[(lch * 8 + 2 * e) * 64 + lrow] = (bf16)(vv[e] & 0xffffu); VT[(lch * 8 + 2 * e + 1) * 64 + lrow] = (bf16)(vv[e] >> 16); } }
        __syncthreads();
        const int kp0 = i == 0 ? 0 : NMETA + 64 * (i - 1);
        if (kp0 > qpos0 + 255) continue;
#pragma unroll 1
        for (int jg = 0; jg < 4; ++jg) {
            float s[16]; float gmax = -1e30f;
#pragma unroll
            for (int jj = 0; jj < 16; ++jj) { const int j = jg * 16 + jj; float d = 0.f;
#pragma unroll
                for (int c = 0; c < 4; ++c) { const u32x4 kk = *(const LAS u32x4*)(Ks + j * 128 + hf * 64 + c * 16);
                    d = dot2bf(kk.x, qp[4 * c], d); d = dot2bf(kk.y, qp[4 * c + 1], d); d = dot2bf(kk.z, qp[4 * c + 2], d); d = dot2bf(kk.w, qp[4 * c + 3], d); }
                d += lane_xor<1>(d);
                const bool valid = (i == 0 ? j < NMETA : true) && (kp0 + j <= qpos);
                s[jj] = valid ? d + Fq - Fl[64 * i + j] : -1e30f; gmax = fmaxf(gmax, s[jj]); }
            const float mn = fmaxf(mrun, gmax), alpha = exp2f(mrun - mn); mrun = mn;
            float ps = 0.f; unsigned pp[8];
#pragma unroll
            for (int jj = 0; jj < 16; jj += 2) { const float p0 = exp2f(s[jj] - mn), p1 = exp2f(s[jj + 1] - mn); ps += p0 + p1; pp[jj >> 1] = pk2(p0, p1); }
            lrun = lrun * alpha + ps;
#pragma unroll
            for (int d = 0; d < 32; ++d) { const u32x4 v0 = *(const LAS u32x4*)(VT + (hf * 32 + d) * 64 + jg * 16), v1 = *(const LAS u32x4*)(VT + (hf * 32 + d) * 64 + jg * 16 + 8);
                float a = o[d] * alpha; a = dot2bf(pp[0], v0.x, a); a = dot2bf(pp[1], v0.y, a); a = dot2bf(pp[2], v0.z, a); a = dot2bf(pp[3], v0.w, a);
                a = dot2bf(pp[4], v1.x, a); a = dot2bf(pp[5], v1.y, a); a = dot2bf(pp[6], v1.z, a); a = dot2bf(pp[7], v1.w, a); o[d] = a; }
        }
    }
    const float il = 1.0f / lrun;
    if (live)
#pragma unroll
    for (int j = 0; j < 4; ++j) { u32x4 w; w.x = pk2(o[8 * j] * il, o[8 * j + 1] * il); w.y = pk2(o[8 * j + 2] * il, o[8 * j + 3] * il); w.z = pk2(o[8 * j + 4] * il, o[8 * j + 5] * il); w.w = pk2(o[8 * j + 6] * il, o[8 * j + 7] * il);
        *(u32x4*)(O + (size_t)grow * 1024 + h * 64 + hf * 32 + 8 * j) = w; }
}
namespace fa {
using bf16x8v = __attribute__((ext_vector_type(8))) short;
using s16x4 = __attribute__((ext_vector_type(4))) short;
using f32x16 = __attribute__((ext_vector_type(16))) float;
constexpr int DMA = 512, DMO = 1024;
constexpr int NW = 8, QBLK = 32, QB = 256, KVBLK = 64;
constexpr int NSLOT = 3, SLOTB = 8192;
constexpr int LDS_K = 0, LDS_V = NSLOT * SLOTB, LDS_WS = 2 * NSLOT * SLOTB, LDS_OST = LDS_WS + NW * 64 * 4, LDS_BYTES = LDS_OST + NW * 4096;
constexpr int LDS_FL = 84992;
constexpr int LDS_SCAN = LDS_FL + (64 + 8192) * 4;
static_assert(LDS_SCAN + 128 <= RING_BYTES, "attention LDS");
__device__ __forceinline__ int crow(int r, int hi) { return (r & 3) + 8 * (r >> 2) + 4 * hi; }
#define SBAR() __builtin_amdgcn_sched_barrier(0)
__device__ __forceinline__ void cmask(f32x16& p0, f32x16& p1, int jb, int qrel, int hi) {
    const float NEG = -INFINITY; int kb = 64 * jb + 4 * hi;
#pragma unroll
    for (int r = 0; r < 16; ++r) { int kv = kb + (r & 3) + 8 * (r >> 2); if (kv > qrel) p0[r] = NEG; if (kv + 32 > qrel) p1[r] = NEG; }
}
__device__ __forceinline__ void glds16(const void* gsrc, unsigned lds_dst) { unsigned keep;
    asm volatile("s_mov_b32 %0, m0\n\ts_mov_b32 m0, %2\n\ts_nop 0\n\tglobal_load_lds_dwordx4 %1, off\n\ts_mov_b32 m0, %0" : "=&s"(keep) : "v"(gsrc), "s"(lds_dst) : "memory"); }
__device__ __forceinline__ float max3f(float a, float b, float c) { float r; asm("v_max3_f32 %0, %1, %2, %3" : "=v"(r) : "v"(a), "v"(b), "v"(c)); return r; }
__device__ __forceinline__ float max2f(float a, float b) { float r; asm("v_max_f32_e32 %0, %1, %2" : "=v"(r) : "v"(a), "v"(b)); return r; }
__device__ __forceinline__ float fsub_s(float a, float b) { float r; asm("v_sub_f32_e32 %0, %1, %2" : "=v"(r) : "v"(a), "v"(b)); return r; }
typedef float f32x2_t __attribute__((ext_vector_type(2))); typedef __bf16 bf16x2_t __attribute__((ext_vector_type(2)));
__device__ __forceinline__ unsigned cvtpk_s(float lo, float hi) { f32x2_t v = {lo, hi}; bf16x2_t b = __builtin_convertvector(v, bf16x2_t); return __builtin_bit_cast(unsigned, b); }
#define WAIT_BAR(N) asm volatile("s_waitcnt vmcnt(" #N ") lgkmcnt(0)\n\ts_barrier" ::: "memory")
typedef __attribute__((address_space(3))) const char* lds_cptr;
typedef short v4i16_t __attribute__((ext_vector_type(4)));
__device__ __forceinline__ void cinit(f32x16& p0, f32x16& p1, const LAS float* fk, float a) {
#pragma unroll
    for (int g = 0; g < 4; ++g) { const f32x4 f0 = *(const LAS f32x4*)(fk + 8 * g), f1 = *(const LAS f32x4*)(fk + 32 + 8 * g);
#pragma unroll
        for (int i = 0; i < 4; ++i) { p0[4 * g + i] = a - f0[i]; p1[4 * g + i] = a - f1[i]; } }
}
__device__ __forceinline__ void qkt(f32x16& p0, f32x16& p1, const char* Kslot, const bf16x8v* qr, int r32, int hi) {
    const char* kb = Kslot + hi * 1024 + r32 * 16;
#pragma unroll
    for (int d0 = 0; d0 < 4; ++d0) {
        const bf16x8v b0 = *reinterpret_cast<const bf16x8v*>(kb + d0 * 2048);
        const bf16x8v b1 = *reinterpret_cast<const bf16x8v*>(kb + d0 * 2048 + 512);
        p0 = __builtin_amdgcn_mfma_f32_32x32x16_bf16(b0, qr[d0], p0, 0, 0, 0); p1 = __builtin_amdgcn_mfma_f32_32x32x16_bf16(b1, qr[d0], p1, 0, 0, 0); }
}
__device__ __forceinline__ void kload8(bf16x8v* kf, lds_cptr kp) {
    kf[0] = *(const LAS bf16x8v*)(kp);        kf[1] = *(const LAS bf16x8v*)(kp + 512);
    kf[2] = *(const LAS bf16x8v*)(kp + 2048); kf[3] = *(const LAS bf16x8v*)(kp + 2560);
    kf[4] = *(const LAS bf16x8v*)(kp + 4096); kf[5] = *(const LAS bf16x8v*)(kp + 4608);
    kf[6] = *(const LAS bf16x8v*)(kp + 6144); kf[7] = *(const LAS bf16x8v*)(kp + 6656);
}
__device__ __forceinline__ void kload2(bf16x8v* kf, lds_cptr kp, int j) { kf[2 * j] = *(const LAS bf16x8v*)(kp + j * 2048); kf[2 * j + 1] = *(const LAS bf16x8v*)(kp + j * 2048 + 512); }
__device__ __forceinline__ s16x4 vtr(lds_cptr p) { return __builtin_bit_cast(s16x4, __builtin_amdgcn_ds_read_tr16_b64_v4i16((LAS v4i16_t*)p)); }
__device__ __forceinline__ float rowmax(const f32x16& p0, const f32x16& p1) {
    float a = max3f(p0[0], p0[1], p1[0]), b = max3f(p0[2], p0[3], p1[1]); a = max3f(a, p1[2], p1[3]);
#pragma unroll
    for (int r = 4; r < 16; r += 4) { a = max3f(a, p0[r], p0[r + 1]); b = max3f(b, p0[r + 2], p0[r + 3]); a = max3f(a, p1[r], p1[r + 1]); b = max3f(b, p1[r + 2], p1[r + 3]); }
    const float m = max2f(a, b);
    auto rr = __builtin_amdgcn_permlane32_swap(__float_as_uint(m), __float_as_uint(m), false, false);
    return max2f(__uint_as_float(rr[0]), __uint_as_float(rr[1]));
}
__device__ __forceinline__ void pv(f32x16* o, int vb, bf16x8v pa0, bf16x8v pa1, bf16x8v pa2, bf16x8v pa3) {
#pragma unroll
    for (int d0 = 0; d0 < 2; ++d0) { s16x4 lo[4], hi[4];
#pragma unroll
        for (int ks = 0; ks < 4; ++ks) {
            asm volatile("ds_read_b64_tr_b16 %0,%1 offset:%c2" : "=&v"(lo[ks]) : "v"(vb), "i"(d0 * 4096 + ks * 1024) : "memory");
            asm volatile("ds_read_b64_tr_b16 %0,%1 offset:%c2" : "=&v"(hi[ks]) : "v"(vb), "i"(d0 * 4096 + ks * 1024 + 512) : "memory"); }
        asm volatile("s_waitcnt lgkmcnt(0)" ::: "memory"); SBAR();
#define PK(k) (bf16x8v){lo[k][0], lo[k][1], lo[k][2], lo[k][3], hi[k][0], hi[k][1], hi[k][2], hi[k][3]}
        o[d0] = __builtin_amdgcn_mfma_f32_32x32x16_bf16(pa0, PK(0), o[d0], 0, 0, 0);
        o[d0] = __builtin_amdgcn_mfma_f32_32x32x16_bf16(pa1, PK(1), o[d0], 0, 0, 0);
        o[d0] = __builtin_amdgcn_mfma_f32_32x32x16_bf16(pa2, PK(2), o[d0], 0, 0, 0);
        o[d0] = __builtin_amdgcn_mfma_f32_32x32x16_bf16(pa3, PK(3), o[d0], 0, 0, 0);
#undef PK
    }
}
template <int THRL> __device__ __forceinline__ void attn_unit(int b, int h, int qb, int tf, const bf16* Q, const bf16* __restrict__ K, const bf16* __restrict__ V, bf16* O, char* shm, int wid) {
    const int lane = lane_id_opaque(), r32 = lane & 31, hi = lane >> 5;
    const long rowbase = (long)b * SEQ; const int q0 = qb * QB;
    const bf16* Qw = Q + (rowbase + q0 + wid * QBLK) * DMA + h * 64;
    const bf16* Kh = K + rowbase * DMA + h * 64, *Vh = V + rowbase * DMA + h * 64;
    const bf16* Km = K + (long)TX * DMA + h * 64, *Vm = V + (long)TX * DMA + h * 64;
    const unsigned lds0 = (unsigned)(uintptr_t)shm;
    float* wsf = (float*)(shm + LDS_WS) + wid * 64;
    const bf16* ksrc = Kh + (long)lane * DMA + wid * 8;
    const bf16* vsrc = Vh + (long)(16 * (wid & 3) + (lane >> 2)) * DMA + (wid >> 2) * 32 + (lane & 3) * 8;
    const bf16* ksrcm = Km + (long)lane * DMA + wid * 8;
    const bf16* vsrcm = Vm + (long)(16 * (wid & 3) + (lane >> 2)) * DMA + (wid >> 2) * 32 + (lane & 3) * 8;
    const unsigned kdst = lds0 + LDS_K + wid * 1024, vdst = lds0 + LDS_V + wid * 1024;
#define DMA_K(t, slot) glds16(ksrc + (long)((t) - 1) * KVBLK * DMA, (unsigned)__builtin_amdgcn_readfirstlane(kdst + (slot)))
#define DMA_V(t, slot) glds16(vsrc + (long)((t) - 1) * KVBLK * DMA, (unsigned)__builtin_amdgcn_readfirstlane(vdst + (slot)))
    const int vb0 = (int)(lds0 + LDS_V) + ((lane >> 4) & 1) * 32 + (lane & 3) * 8 + (4 * hi + ((lane & 15) >> 2)) * 64;
    const char* Kbase = shm + LDS_K; bf16x8v kf[8];
    const lds_cptr shm3 = (lds_cptr)shm; const lds_cptr kp0 = shm3 + LDS_K + hi * 1024 + r32 * 16; const lds_cptr vp0 = shm3 + LDS_V + ((lane >> 4) & 1) * 32 + (lane & 3) * 8 + (4 * hi + ((lane & 15) >> 2)) * 64;
    const LAS float* Flp = (const LAS float*)(shm3 + LDS_FL) + 4 * hi;
    const int NT = 4 * qb + 5;
    glds16(tf == 0 ? ksrcm : ksrc + (long)(tf - 1) * KVBLK * DMA, (unsigned)__builtin_amdgcn_readfirstlane(kdst)); glds16(tf == 0 ? vsrcm : vsrc + (long)(tf - 1) * KVBLK * DMA, (unsigned)__builtin_amdgcn_readfirstlane(vdst)); DMA_K(tf + 1, SLOTB);
    bf16x8v qr[4];
#pragma unroll
    for (int d0 = 0; d0 < 4; ++d0) qr[d0] = *reinterpret_cast<const bf16x8v*>(&Qw[(long)r32 * DMA + d0 * 16 + hi * 8]);
    float aq = ((const LAS float*)(shm3 + LDS_FL))[64 + q0 + wid * QBLK + r32 - 64 * tf];
    float l_reg = 0.f; f32x16 o[2]; o[0] = f32x16{}; o[1] = f32x16{};
    const int qrel = wid * QBLK + r32;
#define CMASK(P0, P1, t) do { int jb_ = (t) - (NT - 4); if (jb_ >= 0) cmask(P0, P1, jb_, qrel, hi); } while (0)
    bool resc = false;
#define START(P0, P1) do { const float rm = rowmax(P0, P1); resc = false; \
    { const float dl = max2f(rm, 0.f); aq = fsub_s(aq, dl);        \
      _Pragma("unroll") for (int r = 0; r < 16; ++r) { P0[r] = fsub_s(P0[r], dl); P1[r] = fsub_s(P1[r], dl); } } \
    _Pragma("unroll") for (int r = 0; r < 16; ++r) P0[r] = __builtin_amdgcn_exp2f(P0[r]); } while (0)
#define RESC() do { if (resc) { asm volatile("s_waitcnt lgkmcnt(0)" ::: "memory"); \
      _Pragma("unroll") for (int d_ = 0; d_ < 2; ++d_) _Pragma("unroll") for (int r = 0; r < 16; ++r) o[d_][r] *= wsf[crow(r, hi)]; } } while (0)
    f32x16 pA0, pA1, pB0, pB1;
    int sl_prev = 0, sl_cur = 0, sl_next = SLOTB;
#define ROT() do { sl_prev = sl_cur; sl_cur = sl_next; sl_next = (sl_next == (NSLOT - 1) * SLOTB) ? 0 : sl_next + SLOTB; } while (0)
    DMA_K(tf + 2, 2 * SLOTB);
    cinit(pA0, pA1, Flp, aq);
    WAIT_BAR(3);
    qkt(pA0, pA1, Kbase, qr, r32, hi); asm volatile("s_nop 15\n\ts_nop 7" : "+v"(pA0), "+v"(pA1));
    START(pA0, pA1);
    _Pragma("unroll") for (int r = 0; r < 16; ++r) pA1[r] = __builtin_amdgcn_exp2f(pA1[r]);
    WAIT_BAR(0);
    DMA_K(tf + 3, 0); DMA_V(tf + 1, SLOTB);
    ROT();
    kload8(kf, kp0 + sl_cur);
    WAIT_BAR(2);
    s16x4 vlo[8], vhi[8]; u32x4 pw0, pw1, pw2, pw3;
#define PKW(P, B) cvtpk_s(P[B], P[B + 1])
#define PAF(k) __builtin_bit_cast(bf16x8v, pw##k)
#define VFR(i) (bf16x8v){vlo[i][0], vlo[i][1], vlo[i][2], vlo[i][3], vhi[i][0], vhi[i][1], vhi[i][2], vhi[i][3]}
#define PIN(x) asm volatile("" : "+v"(x))
#define MX3(a, b, c) __builtin_fmaxf(__builtin_fmaxf((a), (b)), (c))
#define GAPA(MF, A0, A1, A2, A3, W0, W1, PW) do { MF; sacc += A0; sacc += A1; sacc += A2; sacc += A3; PIN(sacc); W0; W1; PIN(PW); SBAR(); } while (0)
#define EX(v) __builtin_amdgcn_exp2f(v)
#define GAPB(MF, X, B) do { MF; X[B] = EX(X[B]); X[B + 1] = EX(X[B + 1]); X[B + 2] = EX(X[B + 2]); X[B + 3] = EX(X[B + 3]); PIN(X); SBAR(); } while (0)
#define VRD(i) do { vlo[i] = vtr(vp_ + (((i) >> 2) * 4096 + ((i) & 3) * 1024)); vhi[i] = vtr(vp_ + (((i) >> 2) * 4096 + ((i) & 3) * 1024 + 512)); } while (0)
#define KRD(G, j) do { if (G) { kload2(kf, kp0 + sl_next, j); SBAR(); } } while (0)
#define STEP(C0, C1, P0, P1, t, GK, GV, GL) do { SBAR(); \
    cinit(C0, C1, Flp + 64 * ((t) - tf), aq); SBAR(); \
    const lds_cptr vp_ = vp0 + sl_prev; \
    VRD(0); SBAR(); float sacc = (P0[0] + P0[1]); \
    GAPA(C0 = __builtin_amdgcn_mfma_f32_32x32x16_bf16(kf[0], qr[0], C0, 0, 0, 0), P0[2], P0[3], P0[4], P0[5],     pw0[0] = PKW(P0, 0), pw0[1] = PKW(P0, 2), pw0); \
    VRD(4); SBAR(); GAPA(C1 = __builtin_amdgcn_mfma_f32_32x32x16_bf16(kf[1], qr[0], C1, 0, 0, 0), P0[6], P0[7], P0[8], P0[9],     pw0[2] = PKW(P0, 4), pw0[3] = PKW(P0, 6), pw0); \
    VRD(1); SBAR(); GAPA(C0 = __builtin_amdgcn_mfma_f32_32x32x16_bf16(kf[2], qr[1], C0, 0, 0, 0),   P0[10], P0[11], P0[12], P0[13], pw1[0] = PKW(P0, 8), pw1[1] = PKW(P0, 10), pw1); \
    VRD(5); SBAR(); GAPA(C1 = __builtin_amdgcn_mfma_f32_32x32x16_bf16(kf[3], qr[1], C1, 0, 0, 0),   P0[14], P0[15], P1[0], P1[1],   pw1[2] = PKW(P0, 12), pw1[3] = PKW(P0, 14), pw1); \
    VRD(2); SBAR(); GAPA(C0 = __builtin_amdgcn_mfma_f32_32x32x16_bf16(kf[4], qr[2], C0, 0, 0, 0),   P1[2], P1[3], P1[4], P1[5],     pw2[0] = PKW(P1, 0), pw2[1] = PKW(P1, 2), pw2); \
    VRD(6); SBAR(); GAPA(C1 = __builtin_amdgcn_mfma_f32_32x32x16_bf16(kf[5], qr[2], C1, 0, 0, 0),   P1[6], P1[7], P1[8], P1[9],     pw2[2] = PKW(P1, 4), pw2[3] = PKW(P1, 6), pw2); \
    VRD(3); SBAR(); GAPA(C0 = __builtin_amdgcn_mfma_f32_32x32x16_bf16(kf[6], qr[3], C0, 0, 0, 0),   P1[10], P1[11], P1[12], P1[13], pw3[0] = PKW(P1, 8), pw3[1] = PKW(P1, 10), pw3); \
    VRD(7); SBAR(); GAPA(C1 = __builtin_amdgcn_mfma_f32_32x32x16_bf16(kf[7], qr[3], C1, 0, 0, 0),   P1[14], P1[15], 0.f, 0.f,       pw3[2] = PKW(P1, 12), pw3[3] = PKW(P1, 14), pw3); \
    l_reg += sacc; \
    if (GK) { DMA_K((t) + 3, sl_cur); } if (GV) { DMA_V((t) + 1, sl_next); } \
    CMASK(C0, C1, t); \
    { float a = MX3(C0[0], C0[1], C1[0]), b_ = MX3(C0[2], C0[3], C1[1]); a = MX3(a, C1[2], C1[3]); \
      _Pragma("unroll") for (int r = 4; r < 16; r += 4) { a = MX3(a, C0[r], C0[r + 1]); b_ = MX3(b_, C0[r + 2], C0[r + 3]); a = MX3(a, C1[r], C1[r + 1]); b_ = MX3(b_, C1[r + 2], C1[r + 3]); } \
      float rm = __builtin_fmaxf(a, b_); { auto rr = __builtin_amdgcn_permlane32_swap(__float_as_uint(rm), __float_as_uint(rm), false, false); rm = __builtin_fmaxf(__uint_as_float(rr[0]), __uint_as_float(rr[1])); } \
      resc = false; \
      if (__builtin_expect(__any(rm > (float)THRL), 0)) { const float dl = __builtin_fmaxf(rm, 0.f); aq -= dl; \
        _Pragma("unroll") for (int r = 0; r < 16; ++r) { C0[r] -= dl; C1[r] -= dl; } \
        const float f = __builtin_amdgcn_exp2f(-dl); l_reg *= f; if (hi == 0) wsf[r32] = f; resc = true; } } \
    SBAR(); \
    GAPB(o[0] = __builtin_amdgcn_mfma_f32_32x32x16_bf16(PAF(0), VFR(0), o[0], 0, 0, 0), C0, 0); \
    GAPB(o[1] = __builtin_amdgcn_mfma_f32_32x32x16_bf16(PAF(0), VFR(4), o[1], 0, 0, 0), C0, 4); \
    KRD(GL, 0); GAPB(o[0] = __builtin_amdgcn_mfma_f32_32x32x16_bf16(PAF(1), VFR(1), o[0], 0, 0, 0), C0, 8); \
    KRD(GL, 1); GAPB(o[1] = __builtin_amdgcn_mfma_f32_32x32x16_bf16(PAF(1), VFR(5), o[1], 0, 0, 0), C0, 12); \
    KRD(GL, 2); GAPB(o[0] = __builtin_amdgcn_mfma_f32_32x32x16_bf16(PAF(2), VFR(2), o[0], 0, 0, 0), C1, 0); \
    KRD(GL, 3); GAPB(o[1] = __builtin_amdgcn_mfma_f32_32x32x16_bf16(PAF(2), VFR(6), o[1], 0, 0, 0), C1, 4); \
    GAPB(o[0] = __builtin_amdgcn_mfma_f32_32x32x16_bf16(PAF(3), VFR(3), o[0], 0, 0, 0), C1, 8); \
    GAPB(o[1] = __builtin_amdgcn_mfma_f32_32x32x16_bf16(PAF(3), VFR(7), o[1], 0, 0, 0), C1, 12); \
    } while (0)
    int t = tf + 1;
#undef CMASK
#define CMASK(P0, P1, t) do { } while (0)
    for (; t + 5 < NT; t += 2) {
        STEP(pB0, pB1, pA0, pA1, t, true, true, true);     WAIT_BAR(2); RESC(); ROT();
        STEP(pA0, pA1, pB0, pB1, t + 1, true, true, true); WAIT_BAR(2); RESC(); ROT();
    }
#undef CMASK
#define CMASK(P0, P1, t) do { int jb_ = (t) - (NT - 4); if (jb_ >= 0) cmask(P0, P1, jb_, qrel, hi); } while (0)
#define ENDW(tt) do { if ((tt) + 3 < NT) { WAIT_BAR(2); } else if ((tt) + 2 < NT) { WAIT_BAR(1); } else { WAIT_BAR(0); } } while (0)
    for (; t + 1 < NT; t += 2) {
        STEP(pB0, pB1, pA0, pA1, t, (t + 3 < NT), (t + 1 < NT), (t + 1 < NT));         ENDW(t);     RESC(); ROT();
        STEP(pA0, pA1, pB0, pB1, t + 1, (t + 4 < NT), (t + 2 < NT), (t + 2 < NT));     ENDW(t + 1); RESC(); ROT();
    }
    { float sacc = pA0[0] + pA0[1]; _Pragma("unroll") for (int r = 2; r < 16; ++r) sacc += pA0[r]; _Pragma("unroll") for (int r = 0; r < 16; ++r) sacc += pA1[r]; l_reg += sacc;
      pw0 = (u32x4){PKW(pA0, 0), PKW(pA0, 2), PKW(pA0, 4), PKW(pA0, 6)}; pw1 = (u32x4){PKW(pA0, 8), PKW(pA0, 10), PKW(pA0, 12), PKW(pA0, 14)}; pw2 = (u32x4){PKW(pA1, 0), PKW(pA1, 2), PKW(pA1, 4), PKW(pA1, 6)}; pw3 = (u32x4){PKW(pA1, 8), PKW(pA1, 10), PKW(pA1, 12), PKW(pA1, 14)};
      SBAR(); pv(o, vb0 + sl_prev, PAF(0), PAF(1), PAF(2), PAF(3)); }
#undef PKW
#undef PAF
#undef VFR
#undef PIN
#undef MX3
#undef GAPA
#undef GAPB
#undef EX
#undef VRD
#undef KRD
#undef STEP
#undef ENDW
    { auto rr = __builtin_amdgcn_permlane32_swap(__float_as_uint(l_reg), __float_as_uint(l_reg), false, false); l_reg = __uint_as_float(rr[0]) + __uint_as_float(rr[1]); }
    if (hi == 0) wsf[32 + r32] = l_reg; asm volatile("s_waitcnt lgkmcnt(0)" ::: "memory");
    float rli[16];
#pragma unroll
    for (int r = 0; r < 16; ++r) rli[r] = __builtin_amdgcn_rcpf(wsf[32 + crow(r, hi)]);
    bf16* Ow = O + (rowbase + q0 + wid * QBLK) * DMO + h * 64;
    { bf16* stg = (bf16*)(shm + LDS_OST) + wid * 2048;
#pragma unroll
      for (int r = 0; r < 16; ++r) { const int orow = crow(r, hi);
#pragma unroll
          for (int d0 = 0; d0 < 2; ++d0) stg[orow * 64 + d0 * 32 + r32] = (bf16)f2bf(o[d0][r] * rli[r]); }
      asm volatile("s_waitcnt lgkmcnt(0)" ::: "memory");
#pragma unroll
      for (int i = 0; i < 4; ++i) { const int row = i * 8 + (lane >> 3), ch = lane & 7; const u32x4 v = *(const u32x4*)(stg + row * 64 + ch * 8); *(u32x4*)(Ow + (long)row * DMO + ch * 8) = v; } }
    asm volatile("s_waitcnt lgkmcnt(0)\n\ts_barrier" ::: "memory");
#undef DMA_K
#undef DMA_V
#undef CMASK
#undef START
#undef RESC
#undef ROT
}
#undef SBAR
#undef WAIT_BAR
}
__device__ __forceinline__ void phase_scan(Frame& F) {
#pragma unroll 1
    for (int bh = F.vcu; bh < 32; bh += F.G) {
        attn_scan(F, bh >> 3, bh & 7, false, fa::LDS_FL, fa::LDS_SCAN);
        const LAS float* Fl = (const LAS float*)(F.lds + fa::LDS_FL); float* FLg = (float*)(WSP() + WS_FL) + (size_t)bh * FLN;
#pragma unroll 1
        for (int i = F.tid; i < FLN / 4; i += 512) *(f32x4*)(FLg + 4 * i) = *(const LAS f32x4*)(Fl + 4 * i);
    }
    __syncthreads();
}
__device__ __forceinline__ void phase_B(Frame& F, int l) {
    LAS int* qs = (LAS int*)(F.lds + LC_QS);
    unsigned* ctl = (unsigned*)(WSP() + WS_CTL); unsigned* head = ctl + CW_AQ + l * 64; const unsigned* nrm = ctl + CW_NRM + l * 64;
    const float* FLg = (const float*)(WSP() + WS_FL);
#pragma unroll 1
    for (;;) {
        __syncthreads();
        if (F.tid == 0) { qs[0] = (int)atomicAdd(head, 1u); qs[1] = 0; }
        __syncthreads();
        const int u = __builtin_amdgcn_readfirstlane(qs[0]);
        if (u >= 1032) break;
        if (u < 1024) {
            const int qb = 31 - (u >> 5), bh = u & 31, b = bh >> 3, h = bh & 7, NT = 4 * qb + 5;
            const float kn = __uint_as_float(__hip_atomic_load(nrm + bh, __ATOMIC_RELAXED, __HIP_MEMORY_SCOPE_AGENT)), qn = __uint_as_float(__hip_atomic_load(nrm + 32 + bh, __ATOMIC_RELAXED, __HIP_MEMORY_SCOPE_AGENT));
            const float T = 36.0f + sqrtf(kn * qn);
            const float* FLb = FLg + (size_t)bh * FLN; const float Fq0 = FLb[64 + 256 * qb];
            { const int t = F.tid; const bool skip = (t <= NT - 5) && (FLb[t == 0 ? 15 : 64 * t + 63] > Fq0 + T);
              const int c = __builtin_popcountll(__ballot(skip)); if (F.lane == 0 && c) __hip_atomic_fetch_add(&qs[1], c, __ATOMIC_RELAXED, __HIP_MEMORY_SCOPE_WORKGROUP); }
            __syncthreads();
            int tf = __builtin_amdgcn_readfirstlane(qs[1]); if (((NT - tf) & 1) == 0) tf -= 1;
            { LAS float* Fl = (LAS float*)(F.lds + fa::LDS_FL); const int n4 = (NT - tf) * 16;
#pragma unroll 1
              for (int i = F.tid; i < n4; i += 512) *(LAS f32x4*)(Fl + 4 * i) = *(const f32x4*)(FLb + 64 * tf + 4 * i); }
            __syncthreads();
            unsigned char* dol = DOP();
            fa::attn_unit<8>(b, h, qb, tf, (const bf16*)(dol + DO_Q), (const bf16*)(dol + DO_K), (const bf16*)(dol + DO_V), (bf16*)(WSP() + WS_X3) + 512, (char*)F.lds, F.wave);
        } else {
            const int t_ = F.wave * 64 + lane_id_opaque(); F.tid = t_; F.lane = t_ & 63;
            attn_scan(F, 0, u - 1024, true, AT_FL, AT_SC); attn_unit_naive(F, TX, 0, 1, 0, u - 1024, NMETA);
        }
    }
    __syncthreads();
    { unsigned* head3 = ctl + CW_AQ + 48 + l * 64;
#pragma unroll 1
      for (;;) { __syncthreads(); if (F.tid == 0) qs[0] = (int)atomicAdd(head3, 1u); __syncthreads();
          const int it = __builtin_amdgcn_readfirstlane(qs[0]); if (it >= 513) break;
          { const int t_ = F.wave * 64 + lane_id_opaque(); F.tid = t_; F.lane = t_ & 63; }
          { const int i32 = 2 * it + (F.wave >> 2); s_item_poolconv(F, l, i32 < 1024 ? i32 : 1024); } } }
    { unsigned* head2 = ctl + CW_AQ + 32 + l * 64; LAS float* scr = (LAS float*)(F.lds + F.wave * 16384);
#pragma unroll 1
      for (;;) { __syncthreads(); if (F.tid == 0) qs[0] = (int)atomicAdd(head2, 1u); __syncthreads();
          const int c = __builtin_amdgcn_readfirstlane(qs[0]); if (c >= 768) break;
          convert_item(F, l, 3584 + 8 * c + F.wave, scr, lane_id_opaque()); } }
    __syncthreads();
}

__device__ __forceinline__ void class_tables(Frame& F, int l) {
    LAS int* base = (LAS int*)(F.lds + LC_BASE); LAS int* pcls = (LAS int*)(F.lds + LC_PCLS); LAS int* np = (LAS int*)(F.lds + LC_NP);
    const unsigned* gcnt = (const unsigned*)(WSP() + WS_CTL) + CW_GCNT + l * 64;
    __syncthreads();
    if (F.tid == 0) { int p = 0;
#pragma unroll 1
        for (int c = 0; c < NCLS; ++c) { base[c] = p * 256; int n = (int)__hip_atomic_load(gcnt + c, __ATOMIC_RELAXED, __HIP_MEMORY_SCOPE_AGENT); if (n > TR) n = TR; if (n < 0) n = 0; p += (n + 255) >> 8; }
        if (p > 160) p = 160; base[NCLS] = p * 256; np[0] = p; }
    __syncthreads();
    if (F.tid < 160) { const int mypos = F.tid * 256; int c = 0;
#pragma unroll 1
        for (int k = 1; k < NCLS; ++k) if (base[k] <= mypos) c = k;
        pcls[F.tid] = c; }
    __syncthreads();
}
template <int NG, int CH> __device__ __forceinline__ void e1_groups(Frame& F, int l, const int (&rowv)[NG], const int (&grpv)[NG], const LAS bf16* Rhi, const LAS bf16* Rlo, LAS int* rec, LAS int* lcnt,
                                                                   const float* reb, const float* rgb, int fr, int fq) {
    const float* hsrc[NG]; bf16* hbdst[NG]; const bf16* dsrc[NG];
#pragma unroll
    for (int g = 0; g < NG; ++g) { const int row = rowv[g];
        hsrc[g] = l == 0 ? (row < TX ? INP(I_X) + (size_t)row * D : INP(I_META) + (size_t)(row - TX) * D) : (const float*)(WSP() + WS_H) + (size_t)row * D;
        hbdst[g] = (bf16*)(WSP() + WS_HB) + (size_t)row * D; dsrc[g] = (const bf16*)(WSP() + WS_X3) + (size_t)row * D; }
    const LAS bf16* bh0 = Rhi + fr * RPITCH + 8 * fq; const LAS bf16* bl0 = Rlo + fr * RPITCH + 8 * fq;
    const LAS bf16* bh1 = Rhi + (16 + (fr & 3)) * RPITCH + 8 * fq; const LAS bf16* bl1 = Rlo + (16 + (fr & 3)) * RPITCH + 8 * fq;
    f32x4 acc0[NG], acc1[NG]; float ss[NG];
#pragma unroll
    for (int g = 0; g < NG; ++g) { acc0[g] = (f32x4){0.f, 0.f, 0.f, 0.f}; acc1[g] = acc0[g]; ss[g] = 0.f; }
    f32x4 ch0[NG][CH], ch1[NG][CH]; u32x4 cd[NG][CH];
#pragma unroll
    for (int g = 0; g < NG; ++g)
#pragma unroll
        for (int c = 0; c < CH; ++c) { const int k = 32 * c + 8 * fq; ch0[g][c] = *(const f32x4*)(hsrc[g] + k); ch1[g][c] = *(const f32x4*)(hsrc[g] + k + 4); cd[g][c] = *(const u32x4*)(dsrc[g] + k); }
#pragma unroll 1
    for (int s0 = 0; s0 < 32; s0 += CH) {
        f32x4 nh0[NG][CH], nh1[NG][CH]; u32x4 nd[NG][CH];
        if (s0 + CH < 32) {
#pragma unroll
            for (int g = 0; g < NG; ++g)
#pragma unroll
                for (int c = 0; c < CH; ++c) { const int k = 32 * (s0 + CH + c) + 8 * fq; nh0[g][c] = *(const f32x4*)(hsrc[g] + k); nh1[g][c] = *(const f32x4*)(hsrc[g] + k + 4); nd[g][c] = *(const u32x4*)(dsrc[g] + k); }
        }
#pragma unroll
        for (int c = 0; c < CH; ++c) { const int s = s0 + c, k = 32 * s + 8 * fq;
            const bf16x8 wh0 = *(const LAS bf16x8*)(bh0 + 32 * s), wl0 = *(const LAS bf16x8*)(bl0 + 32 * s);
            bf16x8 wh1 = *(const LAS bf16x8*)(bh1 + 32 * s), wl1 = *(const LAS bf16x8*)(bl1 + 32 * s);
            if (fr >= 4) { wh1 = (bf16x8){0, 0, 0, 0, 0, 0, 0, 0}; wl1 = wh1; }
#pragma unroll
            for (int g = 0; g < NG; ++g) { f32x4 h0 = ch0[g][c], h1 = ch1[g][c]; const u32x4 dv = cd[g][c];
                h0[0] += bflo(dv.x); h0[1] += bfhi(dv.x); h0[2] += bflo(dv.y); h0[3] += bfhi(dv.y); h1[0] += bflo(dv.z); h1[1] += bfhi(dv.z); h1[2] += bflo(dv.w); h1[3] += bfhi(dv.w);
                ss[g] += (h0[0] * h0[0] + h0[1] * h0[1]) + (h0[2] * h0[2] + h0[3] * h0[3]) + (h1[0] * h1[0] + h1[1] * h1[1]) + (h1[2] * h1[2] + h1[3] * h1[3]);
                const u32x4 hw = pack8(h0, h1); *(u32x4*)(hbdst[g] + k) = hw;
                f32x4 r0, r1; r0[0] = h0[0] - bflo(hw.x); r0[1] = h0[1] - bfhi(hw.x); r0[2] = h0[2] - bflo(hw.y); r0[3] = h0[3] - bfhi(hw.y);
                r1[0] = h1[0] - bflo(hw.z); r1[1] = h1[1] - bfhi(hw.z); r1[2] = h1[2] - bflo(hw.w); r1[3] = h1[3] - bfhi(hw.w);
                const u32x4 lw = pack8(r0, r1);
                const bf16x8 ah = __builtin_bit_cast(bf16x8, hw), al = __builtin_bit_cast(bf16x8, lw);
                acc0[g] = __builtin_amdgcn_mfma_f32_16x16x32_bf16(wh0, ah, acc0[g], 0, 0, 0); acc0[g] = __builtin_amdgcn_mfma_f32_16x16x32_bf16(wh0, al, acc0[g], 0, 0, 0); acc0[g] = __builtin_amdgcn_mfma_f32_16x16x32_bf16(wl0, ah, acc0[g], 0, 0, 0);
                acc1[g] = __builtin_amdgcn_mfma_f32_16x16x32_bf16(wh1, ah, acc1[g], 0, 0, 0); acc1[g] = __builtin_amdgcn_mfma_f32_16x16x32_bf16(wh1, al, acc1[g], 0, 0, 0); acc1[g] = __builtin_amdgcn_mfma_f32_16x16x32_bf16(wl1, ah, acc1[g], 0, 0, 0); } }
        if (s0 + CH < 32) {
#pragma unroll
            for (int g = 0; g < NG; ++g)
#pragma unroll
                for (int c = 0; c < CH; ++c) { ch0[g][c] = nh0[g][c]; ch1[g][c] = nh1[g][c]; cd[g][c] = nd[g][c]; }
        }
    }
#pragma unroll
    for (int g = 0; g < NG; ++g) {
        float sg = ss[g]; sg += lane_xor<16>(sg); sg += lane_xor<32>(sg);
        const float rstd2 = rsqrtf(sg * (1.0f / D) + EPS);
        float gl[4];
#pragma unroll
        for (int q = 0; q < 4; ++q) gl[q] = __int_as_float(__builtin_amdgcn_ds_bpermute(fr << 2, __float_as_int(acc1[g][q]))) * rstd2 + rgb[q];
        int gsel = 0; float gmax = gl[0];
#pragma unroll
        for (int q = 1; q < 4; ++q) if (gl[q] > gmax) { gmax = gl[q]; gsel = q; }
        float gsum = 0.f;
#pragma unroll
        for (int q = 0; q < 4; ++q) gsum += __expf(gl[q] - gmax);
        const float gwt = 1.0f / gsum;
        if (fq == gsel) {
            float el[4];
#pragma unroll
            for (int e = 0; e < 4; ++e) el[e] = acc0[g][e] * rstd2 + reb[gsel * 4 + e];
            int t1 = 0; float l1 = el[0];
#pragma unroll
            for (int e = 1; e < 4; ++e) if (el[e] > l1) { l1 = el[e]; t1 = e; }
            int t2 = -1; float l2 = -3.0e38f;
#pragma unroll
            for (int e = 0; e < 4; ++e) if (e != t1 && el[e] > l2) { l2 = el[e]; t2 = e; }
            const float w1 = 1.0f / (1.0f + __expf(l2 - l1)), w2 = 1.0f - w1;
            const int ea = min(t1, t2), eb = max(t1, t2); const float cA = gwt * (t1 == ea ? w1 : w2), cB = gwt * (t1 == ea ? w2 : w1);
            const int pr = ea == 0 ? eb - 1 : (ea == 1 ? eb + 1 : 5); int cls = gsel * 6 + pr; if (!(cls >= 0 && cls < NCLS)) cls = 0;
            const int rank = __hip_atomic_fetch_add(&lcnt[cls], 1, __ATOMIC_RELAXED, __HIP_MEMORY_SCOPE_WORKGROUP); const int rr = grpv[g] * 16 + fr;
            rec[rr * 5] = cls; rec[rr * 5 + 1] = rank; rec[rr * 5 + 2] = __float_as_int(cA); rec[rr * 5 + 3] = __float_as_int(cB); rec[rr * 5 + 4] = __float_as_int(rstd2);
        }
    }
}
__device__ __forceinline__ void phase_E1(Frame& F, int l) {
    LAS bf16* Rhi = (LAS bf16*)F.lds; LAS bf16* Rlo = Rhi + 20 * RPITCH;
    LAS int* rec = (LAS int*)(F.lds + 83968);
    LAS int* lcnt = (LAS int*)(F.lds + LC_CNT); LAS int* wgb = (LAS int*)(F.lds + LC_BASE);
    const float* rg = (const float*)(WSP() + WS_RG);
    const float* reb = INP(I_REB) + l * 16; const float* rgb = INP(I_RGB) + l * 4;
    unsigned* gcnt = (unsigned*)(WSP() + WS_CTL) + CW_GCNT + l * 64; int* route = (int*)(WSP() + WS_ROUTE);
    const int tid = F.tid, lane = F.lane, wave = F.wave, fr = lane & 15, fq = lane >> 4;
    { f32x4 rv[10];
#pragma unroll
      for (int j = 0; j < 10; ++j) rv[j] = *(const f32x4*)(rg + 4 * (tid + 512 * j));
#pragma unroll
      for (int j = 0; j < 10; ++j) { const int i = 4 * (tid + 512 * j), c = i >> 10, k = i & 1023; u32x2 hw, lw; float hf[4];
#pragma unroll
          for (int e = 0; e < 4; ++e) hf[e] = __builtin_bit_cast(float, (pk2(rv[j][e], 0.f) & 0xffffu) << 16);
          hw.x = pk2(rv[j][0], rv[j][1]); hw.y = pk2(rv[j][2], rv[j][3]); lw.x = pk2(rv[j][0] - hf[0], rv[j][1] - hf[1]); lw.y = pk2(rv[j][2] - hf[2], rv[j][3] - hf[3]);
          *(LAS u32x2*)(Rhi + c * RPITCH + k) = hw; *(LAS u32x2*)(Rlo + c * RPITCH + k) = lw; } }
    { int* TOK = (int*)(WSP() + WS_TOK);
#pragma unroll 1
      for (int p = F.vcu * 512 + tid; p < NPOSMAX; p += F.G * 512) TOK[p] = -1; }
#pragma unroll 1
    for (int wg = F.vcu; wg < 256; wg += F.G) {
        if (tid < NCLS) lcnt[tid] = 0;
        __syncthreads();
        const int ngrp = wg == 0 ? 9 : 8;
        if (wg == 0 && wave == 0) { const int rows2[2] = {fr, TX + fr}; const int grps2[2] = {0, 8}; e1_groups<2, 2>(F, l, rows2, grps2, Rhi, Rlo, rec, lcnt, reb, rgb, fr, fq); }
        else { const int rows1[1] = {wg * 128 + wave * 16 + fr}; const int grps1[1] = {wave}; e1_groups<1, 4>(F, l, rows1, grps1, Rhi, Rlo, rec, lcnt, reb, rgb, fr, fq); }
        __syncthreads();
        if (tid < NCLS) { const int n = lcnt[tid]; wgb[tid] = n > 0 ? (int)atomicAdd(gcnt + tid, (unsigned)n) : 0; }
        __syncthreads();
        const int nrw = ngrp * 16;
        for (int rr = tid; rr < nrw; rr += 512) { const int row = rr < 128 ? wg * 128 + rr : TX + (rr - 128); const int cls = rec[rr * 5];
            int* rp = route + (size_t)row * 8; rp[0] = cls; rp[1] = wgb[cls] + rec[rr * 5 + 1]; rp[2] = rec[rr * 5 + 2]; rp[3] = rec[rr * 5 + 3]; rp[4] = rec[rr * 5 + 4]; }
        __syncthreads();
    }
}
__device__ __forceinline__ void phase_E1b(Frame& F, int l) {
    class_tables(F, l);
    const LAS int* base = (const LAS int*)(F.lds + LC_BASE);
    const int* route = (const int*)(WSP() + WS_ROUTE); int* TOK = (int*)(WSP() + WS_TOK); float* PW = (float*)(WSP() + WS_PW);
#pragma unroll 1
    for (int row = F.vcu * 512 + F.tid; row < TR; row += F.G * 512) { const int* rp = route + (size_t)row * 8; const int pos = base[rp[0]] + rp[1];
        if (pos < 0 || pos >= NPOSMAX) continue;
        TOK[pos] = row; f32x4 w; w[0] = __int_as_float(rp[4]); w[1] = __int_as_float(rp[2]); w[2] = __int_as_float(rp[3]); w[3] = 0.f; *(f32x4*)(PW + (size_t)pos * 4) = w; }
}
__device__ __forceinline__ void phase_E4(Frame& F, int l) {
    class_tables(F, l);
    const LAS int* base = (const LAS int*)(F.lds + LC_BASE);
    const int* route = (const int*)(WSP() + WS_ROUTE); float* H = (float*)(WSP() + WS_H); bf16* HB = (bf16*)(WSP() + WS_HB); const bf16* Y = (const bf16*)(WSP() + WS_Y);
    float* rstd1 = (float*)(WSP() + WS_RSTD1); const float* fg = INP(I_FG); float* out = (float*)DOP(); const bf16* DL = (const bf16*)(WSP() + WS_X3);
    const int gw = F.vcu * NWAVES + F.wave, NGW = F.G * NWAVES, lane = F.lane; const bool lastl = (l == DEPTH - 1);
    constexpr int R = 4;
#pragma unroll 1
    for (int row0 = gw; row0 < TR; row0 += R * NGW) {
        int rowv[R], pos[R];
#pragma unroll
        for (int r = 0; r < R; ++r) { const int row = row0 + r * NGW; rowv[r] = row < TR ? row : TR - 1; const int* rp = route + (size_t)rowv[r] * 8; int p = base[rp[0]] + rp[1]; if (p < 0 || p >= NPOSMAX) p = 0; pos[r] = p; }
        u32x4 yw[R][2], dw[R][2]; f32x4 hv[R][2][2];
#pragma unroll
        for (int r = 0; r < R; ++r)
#pragma unroll
            for (int j = 0; j < 2; ++j) { yw[r][j] = *(const u32x4*)(Y + (size_t)pos[r] * D + 8 * lane + 512 * j);
                const float* hs = l == 0 ? (rowv[r] < TX ? INP(I_X) + (size_t)rowv[r] * D : INP(I_META) + (size_t)(rowv[r] - TX) * D) : H + (size_t)rowv[r] * D;
                hv[r][j][0] = *(const f32x4*)(hs + 8 * lane + 512 * j); hv[r][j][1] = *(const f32x4*)(hs + 8 * lane + 512 * j + 4); dw[r][j] = *(const u32x4*)(DL + (size_t)rowv[r] * D + 8 * lane + 512 * j); }
#pragma unroll
        for (int r = 0; r < R; ++r) { const int row = row0 + r * NGW; float ss = 0.f;
#pragma unroll
            for (int j = 0; j < 2; ++j) { const u32x4 w = yw[r][j], d4 = dw[r][j];
                hv[r][j][0][0] += bflo(d4.x); hv[r][j][0][1] += bfhi(d4.x); hv[r][j][0][2] += bflo(d4.y); hv[r][j][0][3] += bfhi(d4.y); hv[r][j][1][0] += bflo(d4.z); hv[r][j][1][1] += bfhi(d4.z); hv[r][j][1][2] += bflo(d4.w); hv[r][j][1][3] += bfhi(d4.w);
                hv[r][j][0][0] += bflo(w.x); hv[r][j][0][1] += bfhi(w.x); hv[r][j][0][2] += bflo(w.y); hv[r][j][0][3] += bfhi(w.y);
                hv[r][j][1][0] += bflo(w.z); hv[r][j][1][1] += bfhi(w.z); hv[r][j][1][2] += bflo(w.w); hv[r][j][1][3] += bfhi(w.w);
#pragma unroll
                for (int q = 0; q < 2; ++q) ss += hv[r][j][q][0] * hv[r][j][q][0] + hv[r][j][q][1] * hv[r][j][q][1] + hv[r][j][q][2] * hv[r][j][q][2] + hv[r][j][q][3] * hv[r][j][q][3]; }
            const float rs = rsqrtf(wave_sum(ss) * (1.0f / D) + EPS);
            if (row < TR) {
                if (!lastl) {
#pragma unroll
                    for (int j = 0; j < 2; ++j) { *(f32x4*)(H + (size_t)row * D + 8 * lane + 512 * j) = hv[r][j][0]; *(f32x4*)(H + (size_t)row * D + 8 * lane + 512 * j + 4) = hv[r][j][1];
                        *(u32x4*)(HB + (size_t)row * D + 8 * lane + 512 * j) = pack8(hv[r][j][0], hv[r][j][1]); }
                    if (lane == 0) rstd1[row] = rs;
                } else if (row < TX) {
#pragma unroll
                    for (int j = 0; j < 2; ++j) { const f32x4 g0 = *(const f32x4*)(fg + 8 * lane + 512 * j), g1 = *(const f32x4*)(fg + 8 * lane + 512 * j + 4);
                        *(f32x4*)(out + (size_t)row * D + 8 * lane + 512 * j) = hv[r][j][0] * rs * g0; *(f32x4*)(out + (size_t)row * D + 8 * lane + 512 * j + 4) = hv[r][j][1] * rs * g1; }
                }
            }
        }
    }
}
#define RELANE() do { const int t_ = wv0 * 64 + lane_id_opaque(); F.tid = t_; F.lane = t_ & 63; F.wave = __builtin_amdgcn_readfirstlane(t_ >> 6); \
    int g_ = gridDim.x; LAUNDER_S(g_); int b_ = blockIdx.x; LAUNDER_S(b_); F.G = g_; F.bx = b_; F.vcu = (g_ % 8 == 0) ? (b_ % 8) * (g_ / 8) + b_ / 8 : b_; ll = l; LAUNDER_S(ll); } while (0)
__global__ void __launch_bounds__(NWAVES * 64, 2) fwd_kernel(Params P) {
    extern __shared__ __attribute__((aligned(16))) unsigned char lds_raw[];
    Frame F;
    F.lds = (LAS unsigned char*)lds_raw;
    F.tid = threadIdx.x; F.lane = F.tid & 63; F.wave = __builtin_amdgcn_readfirstlane(F.tid >> 6);
    F.G = gridDim.x; { const int bx = blockIdx.x; F.vcu = (F.G % 8 == 0) ? (bx % 8) * (F.G / 8) + bx / 8 : bx; }
    if (F.tid == 0) { LAS unsigned long long* pt = (LAS unsigned long long*)(F.lds + LC_PTAB);
#pragma unroll
        for (int i = 0; i < 25; ++i) pt[i] = (unsigned long long)P.in[i];
        pt[25] = (unsigned long long)P.ws; pt[26] = (unsigned long long)P.out; }
    for (int u = F.tid; u < 256; u += NWAVES * 64) ((LAS unsigned*)(F.lds + RING_BYTES))[u] = 0u;
    __syncthreads();
    const int lo = P.ph_lo, hi = P.ph_hi;
    const bool use_bar = (hi - lo) > 1;
    unsigned* barw = (unsigned*)(P.ws + WS_CTL) + CW_BAR;
    XcdBarrier bar; bar.bar = barw; bar.x = 0; bar.st = (volatile LAS unsigned*)(F.lds + LC_BAR);
    if (use_bar) bar = xcd_barrier_post(barw, (volatile LAS unsigned*)(F.lds + LC_BAR));
#ifndef PHASE_MASK
#define PHASE_MASK 0xfff
#endif
#define EN(j) (((PHASE_MASK) >> (j)) & 1)
#ifndef DUP_MASK
#define DUP_MASK 0
#endif
#define NREP(j) ((((DUP_MASK) >> (j)) & 1) ? 2 : 1)
#define IN(k) (lo <= (k) && (k) < hi)
#define SEAM(k) do { if (IN(k) && IN((k) + 1)) xcd_barrier(bar); } while (0)

    int l = 0, ll = 0; const int wv0 = __builtin_amdgcn_readfirstlane((int)threadIdx.x >> 6);
    if (EN(0) && IN(0)) { RELANE(); convert_weights(F, 0); RELANE(); init_rows(F); }
    SEAM(0);
    for (l = 0; l < DEPTH; ++l) {
        const int pb = 1 + 11 * l;
        for (int rep = 0; rep < NREP(1); ++rep)
        if (EN(1) && IN(pb + 0)) {
            RELANE();
            unsigned char* wsl = WSP(); unsigned char* dol = DOP();
            pg8::Gemm g{(const bf16*)(wsl + WS_HB), 1024, 1024, 1 << 20};
            pg8::StaticOrder S; S.init(TX, N1, F.G, F.bx, (const bf16*)(wsl + WS_W1T), 1024);
            Epi1 E{(const float*)(wsl + WS_RSTD1), (bf16*)(wsl + WS_A), (bf16*)(wsl + WS_GLU), (bf16*)(dol + DO_Q), (bf16*)(wsl + WS_G)};
            pg8::gemm_phase<Epi1, pg8::StaticOrder>(F.lds, g, S, E, F.wave);
            if (F.bx >= 128 && F.bx < 128 + 21 && F.wave < 4) {
                const int pn = F.bx - 128, l2 = lane_id_opaque(); AccT acc; skinny_zero(acc);
                skinny_k<true>(acc, (const bf16*)(wsl + WS_HB) + (size_t)TX * 1024, 1024, (const bf16*)(wsl + WS_W1T) + (size_t)pn * 256 * 1024, 1024, 1024, F.wave, l2 & 15, l2 >> 4);
                E.run<true>(acc, pg8::Unit{128, pn, 0}, 0, F.wave, l2 & 15, l2 >> 4);
            }
        }
        SEAM(pb + 0);
        for (int rep = 0; rep < NREP(2); ++rep)
        if (EN(2) && IN(pb + 1)) { RELANE(); phase_S(F, ll); }
        SEAM(pb + 1);
        if (EN(3) && IN(pb + 2)) { RELANE(); phase_scan(F); }
        SEAM(pb + 2);
        for (int rep = 0; rep < NREP(3); ++rep)
        if (EN(4) && IN(pb + 3)) { RELANE(); phase_B(F, ll); }
        SEAM(pb + 3);
        for (int rep = 0; rep < NREP(4); ++rep)
        if (EN(5) && IN(pb + 4)) {
            RELANE(); unsigned char* wsl = WSP(); unsigned char* dol = DOP();
            pg8::Gemm g{(const bf16*)(wsl + WS_X3), 1024, 1024, 1 << 20}; pg8::SegOrder S; S.init(TX, 1024, F.G, F.bx, (const bf16*)(wsl + WS_W3CT), 1024);
            EpiCS E{(const bf16*)(wsl + WS_G), (bf16*)(dol + DO_MERGED), (const float*)(wsl + WS_BIASA)}; pg8::gemm_phase<EpiCS, pg8::SegOrder>(F.lds, g, S, E, F.wave);
            if (F.bx >= 16 && F.bx < 20) {
                const int pn = F.bx - 16, l2 = lane_id_opaque(), kh = F.wave >> 2, wc4 = F.wave & 3; AccT acc; skinny_zero(acc);
#pragma unroll 1
                for (int seg = 0; seg < 3; ++seg) { const int Ks = seg == 2 ? 512 : 256; const size_t ko = (seg == 0 ? 0 : (seg == 1 ? 256 : 512)) + (size_t)kh * (Ks / 2);
                    if (kh == 1) skinny_zero(acc);
                    skinny_k<true>(acc, (const bf16*)(wsl + WS_X3) + (size_t)TX * 1024 + ko, 1024, (const bf16*)(wsl + WS_W3CT) + (size_t)pn * 256 * 1024 + ko, 1024, Ks / 2, wc4, l2 & 15, l2 >> 4);
                    skinny_combine(acc, F.lds, F.wave, l2);
                    if (kh == 0) E.run<true>(acc, pg8::Unit{128, pn, seg}, 0, wc4, l2 & 15, l2 >> 4); }
            }
        }
        SEAM(pb + 4);
        if (EN(6) && IN(pb + 5)) {
            RELANE();
            unsigned char* wsl = WSP(); unsigned char* dol = DOP();
            pg8::Gemm g{(const bf16*)(dol + DO_MERGED), 1024, 1024, 1 << 20}; pg8::StaticOrder S; S.init(TX, 1024, F.G, F.bx, (const bf16*)(wsl + WS_WOT), 1024);
            EpiB2 E{(bf16*)(wsl + WS_X3)}; pg8::gemm_phase<EpiB2, pg8::StaticOrder>(F.lds, g, S, E, F.wave);
            if (F.bx >= 16 && F.bx < 20) {
                const int pn = F.bx - 16, l2 = lane_id_opaque(), kh = F.wave >> 2, wc4 = F.wave & 3; AccT acc; skinny_zero(acc);
                skinny_k<true>(acc, (const bf16*)(dol + DO_MERGED) + (size_t)TX * 1024 + kh * 512, 1024, (const bf16*)(wsl + WS_WOT) + (size_t)pn * 256 * 1024 + kh * 512, 1024, 512, wc4, l2 & 15, l2 >> 4);
                skinny_combine(acc, F.lds, F.wave, l2);
                if (kh == 0) E.run<true>(acc, pg8::Unit{128, pn, 0}, 0, wc4, l2 & 15, l2 >> 4);
            }
        }
        SEAM(pb + 5);
        if (EN(7) && IN(pb + 6)) { RELANE(); phase_E1(F, ll); }
        SEAM(pb + 6);
        for (int rep = 0; rep < NREP(7); ++rep)
        if (EN(8) && IN(pb + 7)) { RELANE(); phase_E1b(F, ll); }
        SEAM(pb + 7);
        for (int rep = 0; rep < NREP(8); ++rep)
        if (EN(9) && IN(pb + 8)) {
            RELANE(); class_tables(F, ll);
            unsigned char* wsl = WSP();
            const int NP = __builtin_amdgcn_readfirstlane(*(const LAS int*)(F.lds + LC_NP));
            pg8::Gemm g{(const bf16*)(wsl + WS_XS), 1024, 1024, 1 << 20};
            { const int* TOK = (const int*)(wsl + WS_TOK); LAS int* tl = (LAS int*)(F.lds + LC_TOK);
#pragma unroll 1
              for (int i = F.tid; i < 1024; i += 512) { const long L = (long)(i >> 8) * F.G + F.vcu; int tk = 0; if (L < (long)NP * 4) { tk = TOK[(int)(L >> 2) * 256 + (i & 255)]; if (tk < 0 || tk >= TR) tk = 0; } tl[i] = tk; }
              __syncthreads(); }
            pg8::Gemm g2{(const bf16*)(wsl + WS_HB), 1024, 1024, 1 << 20};
            MoeOrderT<true> S{(const LAS int*)(F.lds + LC_TOK), NP, F.G, F.vcu, 0, (const LAS int*)(F.lds + LC_PCLS), (const bf16*)(DOP() + DO_W13T)};
            EpiA2 E{(const float*)(wsl + WS_PW), (bf16*)(wsl + WS_HH)}; pg8::gemm_phase<EpiA2, MoeOrderT<true>>(F.lds, g2, S, E, F.wave);
        }
        SEAM(pb + 8);
        for (int rep = 0; rep < NREP(9); ++rep)
        if (EN(10) && IN(pb + 9)) {
            RELANE(); class_tables(F, ll);
            unsigned char* wsl = WSP();
            const int NP = __builtin_amdgcn_readfirstlane(*(const LAS int*)(F.lds + LC_NP));
            pg8::Gemm g{(const bf16*)(wsl + WS_HH), 512, 256, 4};
            MoeOrderT<false> S{nullptr, NP, F.G, F.vcu, 1, (const LAS int*)(F.lds + LC_PCLS), (const bf16*)(DOP() + DO_W2T)};
            EpiB2 E{(bf16*)(wsl + WS_Y)}; pg8::gemm_phase<EpiB2, MoeOrderT<false>>(F.lds, g, S, E, F.wave);
        }
        SEAM(pb + 9);
        if (EN(11) && IN(pb + 10)) { RELANE(); phase_E4(F, ll); if (l + 1 < DEPTH) { RELANE(); convert_weights(F, ll + 1); } }
        SEAM(pb + 10);
    }
#undef IN
#undef SEAM
}

constexpr int N_PHASES = 1 + 11 * DEPTH;

extern "C" void kernel_launch(void* const* d_in, const int* in_sizes, int n_in, void* d_out, int out_size, void* d_ws, size_t ws_size, hipStream_t stream) {
    static int grid = 0;
    if (grid == 0) {
        if (n_in != 25 || out_size != TX * D || ws_size < WS_END) { fprintf(stderr, "kernel_launch: unexpected shapes: n_in %d out %d ws %zu (need %zu)\n", n_in, out_size, ws_size, (size_t)WS_END); grid = -1; return; }
        int dev = 0, cus = 0, per_cu = 0;
        if (hipGetDevice(&dev) != hipSuccess || hipDeviceGetAttribute(&cus, hipDeviceAttributeMultiprocessorCount, dev) != hipSuccess) { grid = -1; return; }
        if (hipFuncSetAttribute((const void*)fwd_kernel, hipFuncAttributeMaxDynamicSharedMemorySize, LDS_BYTES) != hipSuccess) { fprintf(stderr, "kernel_launch: hipFuncSetAttribute failed\n"); grid = -1; return; }
        if (hipOccupancyMaxActiveBlocksPerMultiprocessor(&per_cu, (const void*)fwd_kernel, NWAVES * 64, LDS_BYTES) != hipSuccess || per_cu < 1) fprintf(stderr, "kernel_launch: occupancy query reports %d\n", per_cu);
        (void)hipGetLastError();
        grid = cus;
    }
    if (grid < 0) return;
    (void)hipMemsetAsync((char*)d_ws + WS_CTL, 0, CTL_BYTES, stream);
    Params p{};
    for (int i = 0; i < 25; ++i) p.in[i] = (const float*)d_in[i];
    p.out = (float*)d_out; p.ws = (unsigned char*)d_ws;
#if N_LAUNCH_MODE == 1
    p.ph_lo = 0; p.ph_hi = N_PHASES;
    hipLaunchKernelGGL(fwd_kernel, dim3(grid), dim3(NWAVES * 64), LDS_BYTES, stream, p);
#else
    for (int ph = 0; ph < N_PHASES; ++ph) { p.ph_lo = ph; p.ph_hi = ph + 1; hipLaunchKernelGGL(fwd_kernel, dim3(grid), dim3(NWAVES * 64), LDS_BYTES, stream, p); }
#endif
}
```

```cpp
#include <hip/hip_runtime.h>
#include <cstdio>
#include <cstdint>

#ifndef N_LAUNCH_MODE
#define N_LAUNCH_MODE 1
#endif

#define GAS __attribute__((address_space(1)))
#define LAS __attribute__((address_space(3)))
typedef unsigned short bf16;
typedef float f32x4 __attribute__((ext_vector_type(4)));
typedef float f32x2 __attribute__((ext_vector_type(2)));
typedef unsigned u32x4 __attribute__((ext_vector_type(4)));
typedef unsigned u32x2 __attribute__((ext_vector_type(2)));
typedef short bf16x8 __attribute__((ext_vector_type(8)));
typedef __bf16 bf16x2v __attribute__((ext_vector_type(2)));

constexpr int D = 1024, NB = 4, SEQ = 8192, NMETA = 16, DEPTH = 2;
constexpr int TX = NB * SEQ;
constexpr int TM = TX + 64;
constexpr int TR = TX + NMETA;
constexpr int NIN = 5384, N1 = 5376;
constexpr int NHEAD = 8;
constexpr int NCLS = 24;
constexpr int NPOSMAX = TX + 256 + NCLS * 256;
constexpr float EPS = 1e-6f;
constexpr float LOG2E = 1.4426950408889634f;
constexpr float C2 = 0.125f * LOG2E;
constexpr int NWAVES = 8;

constexpr size_t U = (size_t)TM * 1024 * 2;
constexpr size_t WS_CTL = 0, CTL_BYTES = 128u << 10;
constexpr size_t WS_H = CTL_BYTES;
constexpr size_t WS_HB = WS_H + 2 * U;
constexpr size_t WS_G = WS_HB + U;
constexpr size_t WS_XS = WS_G;
constexpr size_t WS_Y = WS_XS + (size_t)NPOSMAX * 2048;
constexpr size_t WS_HH = WS_Y + (size_t)NPOSMAX * 2048;
static_assert(WS_HH + (size_t)NPOSMAX * 1024 <= WS_G + (size_t)3 * 129 * 4 * 65536 * 2, "MoE overlay fits the gates region");
constexpr size_t GT_TILE = 65536;
constexpr size_t WS_A = WS_G + (size_t)3 * 129 * 4 * GT_TILE * 2;
constexpr size_t WS_GLU = WS_A + U / 4;
constexpr size_t WS_X3 = WS_GLU + U / 4;
constexpr size_t WS_W1T = WS_X3 + U;
constexpr size_t WS_W3CT = WS_W1T + (size_t)N1 * 1024 * 2;
constexpr size_t WS_WOT = WS_W3CT + 1024 * 1024 * 2;
constexpr size_t WS_WFG = WS_WOT + 1024 * 1024 * 2;
constexpr size_t WS_RG = WS_WFG + 8 * 1024 * 4;
constexpr size_t WS_BIASA = WS_RG + 20 * 1024 * 4;
constexpr size_t WS_RSTD1 = WS_BIASA + 4096;
constexpr size_t WS_ROUTE = WS_RSTD1 + (size_t)TM * 4;
constexpr size_t WS_PW = WS_ROUTE + (size_t)TM * 32;
constexpr size_t WS_LFT = WS_PW + (size_t)NPOSMAX * 16;
constexpr size_t WS_LFTM = WS_LFT + (size_t)32 * 8192 * 4;
constexpr size_t WS_TOK = WS_LFTM + 8 * 256 * 4;
constexpr size_t WS_FL = WS_TOK + (size_t)NPOSMAX * 4;
constexpr int FLN = 64 + SEQ;
constexpr size_t WS_END = WS_FL + (size_t)32 * FLN * 4;
static_assert(WS_END <= (size_t)512 * 1024 * 1024, "d_ws map fits 512 MiB");
constexpr size_t DO_Q = 0, DO_K = U / 2, DO_V = U, DO_MERGED = U / 2;
constexpr size_t DO_W13T = 3 * U / 2;
constexpr size_t DO_W2T = DO_W13T + (size_t)16 * 512 * 1024 * 2;
static_assert(DO_W2T + (size_t)16 * 1024 * 256 * 2 <= (size_t)TX * 1024 * 4, "d_out scratch");
static_assert((24576 + 128) * 4 <= 128 * 1024, "control words inside the memset");
constexpr int CW_BAR = 4096, CW_GCNT = 16384, CW_NRM = 20480  , CW_AQ = 24576  ;

constexpr int RPITCH = 1032;
constexpr int RING_BYTES = 131072;
constexpr int LC_BAR = RING_BYTES, LC_CNT = RING_BYTES + 64, LC_BASE = RING_BYTES + 192, LC_PCLS = RING_BYTES + 320, LC_NP = RING_BYTES + 960;
constexpr int LC_QS = RING_BYTES + 976;
constexpr int LC_TOK = RING_BYTES + 2048;
constexpr int LC_NMX = RING_BYTES + 1280;
constexpr int LC_PTAB = RING_BYTES + 1024;
constexpr int LDS_BYTES = RING_BYTES + 1024 + 7168;

#define LDS_WAIT() asm volatile("s_waitcnt lgkmcnt(0)" ::: "memory")
#define VM_WAIT() asm volatile("s_waitcnt vmcnt(0)" ::: "memory")
#define LAUNDER_S(p) asm volatile("" : "+s"(p))
#define LAUNDER_V(x) asm volatile("" : "+v"(x))
__device__ __forceinline__ int lane_id_opaque() { int x; asm volatile("v_mbcnt_lo_u32_b32 %0, -1, 0\n\tv_mbcnt_hi_u32_b32 %0, -1, %0" : "=v"(x)); return x; }

__device__ __forceinline__ unsigned f2bf(float f) { unsigned u = __builtin_bit_cast(unsigned, f); return (u + 0x7fffu + ((u >> 16) & 1u)) >> 16; }
__device__ __forceinline__ unsigned pk2(float lo, float hi) { f32x2 v = {lo, hi}; bf16x2v b = __builtin_convertvector(v, bf16x2v); return __builtin_bit_cast(unsigned, b); }
__device__ __forceinline__ float bflo(unsigned w) { return __builtin_bit_cast(float, w << 16); }
__device__ __forceinline__ float bfhi(unsigned w) { return __builtin_bit_cast(float, w & 0xffff0000u); }
template <int O> __device__ __forceinline__ float lane_xor(float v) {
    if constexpr (O < 32) return __int_as_float(__builtin_amdgcn_ds_swizzle(__float_as_int(v), (O << 10) | 0x1f));
    else { auto rr = __builtin_amdgcn_permlane32_swap(__float_as_uint(v), __float_as_uint(v), false, false); return __uint_as_float(rr[0]) + __uint_as_float(rr[1]) - v; }
}
__device__ __forceinline__ float wave_sum(float v) {
    v += lane_xor<1>(v); v += lane_xor<2>(v); v += lane_xor<4>(v); v += lane_xor<8>(v); v += lane_xor<16>(v);
    auto rr = __builtin_amdgcn_permlane32_swap(__float_as_uint(v), __float_as_uint(v), false, false);
    return __uint_as_float(rr[0]) + __uint_as_float(rr[1]);
}
__device__ __forceinline__ float sigmoidf_(float x) { return __builtin_amdgcn_rcpf(1.0f + __builtin_amdgcn_exp2f(-LOG2E * x)); }
__device__ __forceinline__ float dot2bf(unsigned a, unsigned b, float acc) { return __builtin_amdgcn_fdot2_f32_bf16(__builtin_bit_cast(bf16x2v, a), __builtin_bit_cast(bf16x2v, b), acc, false); }

namespace pg8 {
constexpr int BM = 256, BK = 64, HALF = 128, HTB = HALF * BK * 2, STAGE_BYTES = 8 * HTB, NXCD = 8, WGM = 8;
__host__ __device__ __forceinline__ int lds_byte(int r, int c) { const int st = (r >> 4) * 2 + (c >> 5), rr = r & 15, cc = c & 31, ob = rr * 64 + cc * 2; return st * 1024 + (ob ^ (((ob >> 9) & 1) << 5)); }
__host__ __device__ __forceinline__ void stage_rc(int b, int& R, int& C) { const int st = b / 1024, sb = b % 1024, swz = sb ^ (((sb >> 9) & 1) << 5); R = (st >> 1) * 16 + swz / 64; C = (st & 1) * 32 + (swz % 64) / 2; }
__host__ __device__ __forceinline__ int perm32(int rho) { const int n = rho >> 4, i = rho & 15; return 8 * (i >> 2) + 4 * n + (i & 3); }

struct Unit { int pm, pn, seg; };
struct Gemm { const bf16* A; int K; int ldb; int ksplit; };

struct StaticOrder {
    static constexpr bool GATHER = false; const LAS int* tokl = nullptr;
    int nM, nN, nwg, G, c; const bf16* Bt; size_t btile;
    __device__ void init(int M, int N, int G_, int c_, const bf16* Bt_, int ldb) { nM = M / BM; nN = N / BM; nwg = nM * nN; G = G_; c = c_; Bt = Bt_; btile = (size_t)BM * ldb * 2; }
    __device__ bool next(int i, Unit& u) const {
        const long L = (long)i * G + c; if (L >= nwg) return false;
        int wgid = (int)L; { const int q = nwg / NXCD, r = nwg % NXCD, xcd = wgid % NXCD, off = wgid / NXCD; wgid = (xcd < r ? xcd * (q + 1) : r * (q + 1) + (xcd - r) * q) + off; }
        const int nig = WGM * nN, gid = wgid / nig, fm = gid * WGM, gsz = (nM - fm) < WGM ? (nM - fm) : WGM;
        u.pm = fm + ((wgid % nig) % gsz); u.pn = (wgid % nig) / gsz; u.seg = 0; return true;
    }
    __device__ __forceinline__ const char* bptr(const Unit& u, int) const { return (const char*)Bt + (size_t)u.pn * btile; }
    __device__ __forceinline__ int nt(const Unit&, int ntd) const { return ntd; }
    __device__ __forceinline__ size_t aoff(const Unit&) const { return 0; }
};
struct SegOrder : StaticOrder {
    __device__ bool next(int i, Unit& u) const { const int q = i / 3; if (!StaticOrder::next(q, u)) return false; u.seg = i - 3 * q; return true; }
    __device__ __forceinline__ size_t koff(const Unit& u) const { return u.seg == 0 ? 0 : (u.seg == 1 ? 512 : 1024); }
    __device__ __forceinline__ const char* bptr(const Unit& u, int) const { return (const char*)Bt + (size_t)u.pn * btile + koff(u); }
    __device__ __forceinline__ int nt(const Unit& u, int) const { return u.seg == 2 ? 8 : 4; }
    __device__ __forceinline__ size_t aoff(const Unit& u) const { return koff(u); }
};

template <class Epi, class Sched, bool ALIGN_EPI = true, bool SP2 = true>
__device__ __forceinline__ void gemm_phase(LAS unsigned char* lds, const Gemm g, const Sched& S, const Epi& E, const int wave_id) {
    const int tid = wave_id * 64 + lane_id_opaque();
    const int wid = __builtin_amdgcn_readfirstlane(tid >> 6), lane = tid & 63, wr = wid >> 2, wc = wid & 3, fr = lane & 15, fq = lane >> 4;
    const int K = g.K, nt = K / BK, ldb = g.ldb, ks = g.ksplit;
    unsigned voffA[2], voffB[2];
#pragma unroll
    for (int i = 0; i < 2; ++i) { int R, C; stage_rc(tid * 16 + i * 8192, R, C); const int Rb = Epi::PERM ? ((R & ~31) + perm32(R & 31)) : R;
        voffA[i] = (unsigned)(R * K + C) * 2u; voffB[i] = (unsigned)(Rb * ldb + C) * 2u; }
    constexpr bool GATHER = Sched::GATHER;
    unsigned vC0[2], vC1[2];
    const size_t kstep = (size_t)(BK * 2);
    const size_t hstep = (size_t)HALF * K * 2;
    const size_t hstepB = (size_t)HALF * ldb * 2;
    const size_t tstep = 2 * hstep;
#define PG8_GOFF(ui_) do { _Pragma("unroll") for (int _i = 0; _i < 2; ++_i) { const int R_ = (int)(voffA[_i] >> 11); const unsigned C_ = voffA[_i] & 2047u; \
        vC0[_i] = (unsigned)S.tokl[(ui_) * 256 + R_] * 2048u + C_; vC1[_i] = (unsigned)S.tokl[(ui_) * 256 + 128 + R_] * 2048u + C_; } } while (0)
    const unsigned ldsw = (unsigned)wid * 1024u;
    const int aoff = lds_byte(wr * 64 + fr, fq * 8), boff = lds_byte(wc * 32 + fr, fq * 8);
#define PG8_SA(b, h) (((b) * 2 + (h)) * HTB)
#define PG8_SB(b, h) ((4 + (b) * 2 + (h)) * HTB)
#define PG8_STAGE(bufoff, gbase, voff) do { _Pragma("unroll") for (int _i = 0; _i < 2; ++_i) \
        __builtin_amdgcn_global_load_lds((const unsigned*)((const char*)(gbase) + (voff)[_i]), (LAS unsigned*)(lds + (bufoff) + ldsw + _i * 8192), 16, 0, 0); } while (0)
#define PG8_LDA(dst, b, h) do { _Pragma("unroll") for (int m = 0; m < 4; ++m) _Pragma("unroll") for (int k = 0; k < 2; ++k) dst[m][k] = *(const LAS bf16x8*)(lds + PG8_SA(b, h) + aoff + m * 2048 + k * 1024); } while (0)
#define PG8_LDB(dst, b, h) do { _Pragma("unroll") for (int n = 0; n < 2; ++n) _Pragma("unroll") for (int k = 0; k < 2; ++k) dst[n][k] = *(const LAS bf16x8*)(lds + PG8_SB(b, h) + boff + n * 2048 + k * 1024); } while (0)
#define PG8_MMA(ai, bj, At, Bt) do { __builtin_amdgcn_s_setprio(1); _Pragma("unroll") for (int m = 0; m < 4; ++m) _Pragma("unroll") for (int n = 0; n < 2; ++n) _Pragma("unroll") for (int k = 0; k < 2; ++k) \
        acc[ai][bj][m][n] = __builtin_amdgcn_mfma_f32_16x16x32_bf16(Bt[n][k], At[m][k], acc[ai][bj][m][n], 0, 0, 0); __builtin_amdgcn_s_setprio(0); } while (0)
#define PG8_WAIT_V(n) asm volatile("s_waitcnt vmcnt(" #n ")" ::: "memory")
#define PG8_WAIT_L(n) asm volatile("s_waitcnt lgkmcnt(" #n ")" ::: "memory")
#define PG8_BAR __builtin_amdgcn_s_barrier()
#define PG8_SCHED __builtin_amdgcn_sched_barrier(0)
    Unit cur, nxt; int ui = 0;
    if (!S.next(0, cur)) return;
    if constexpr (GATHER) { PG8_GOFF(0); } else { vC0[0] = voffA[0]; vC0[1] = voffA[1]; vC1[0] = voffA[0] + (unsigned)hstep; vC1[1] = voffA[1] + (unsigned)hstep; }
    f32x4 acc[2][2][4][2];
    { float z_ = 0.f; LAUNDER_V(z_);
#pragma unroll
    for (int a = 0; a < 2; ++a)
#pragma unroll
        for (int b = 0; b < 2; ++b)
#pragma unroll
            for (int m = 0; m < 4; ++m)
#pragma unroll
                for (int n = 0; n < 2; ++n) acc[a][b][m][n] = (f32x4){z_, z_, z_, z_}; }
    bf16x8 At[4][2], B0[2][2], B1[2][2];
    int ntc = S.nt(cur, nt);
    const char* cA = GATHER ? (const char*)g.A : (const char*)g.A + (size_t)cur.pm * tstep + S.aoff(cur); const char* cB = S.bptr(cur, 0); const char* cB1 = S.bptr(cur, 1) - (size_t)ks * kstep;
    if constexpr (SP2) {
        PG8_STAGE(PG8_SB(0, 0), cB, voffB); PG8_STAGE(PG8_SB(0, 1), cB + hstepB, voffB); PG8_STAGE(PG8_SA(0, 0), cA, vC0); PG8_STAGE(PG8_SA(0, 1), cA, vC1);
        if (wr == 1) PG8_BAR;
        PG8_WAIT_V(2); PG8_BAR;
        PG8_STAGE(PG8_SB(1, 0), cB + kstep, voffB); PG8_STAGE(PG8_SA(1, 0), cA + kstep, vC0); PG8_STAGE(PG8_SB(1, 1), cB + hstepB + kstep, voffB);
        PG8_WAIT_V(6); PG8_BAR;
    } else {
        PG8_STAGE(PG8_SB(0, 0), cB, voffB); PG8_STAGE(PG8_SA(0, 0), cA, vC0); PG8_STAGE(PG8_SB(0, 1), cB + hstepB, voffB); PG8_STAGE(PG8_SA(0, 1), cA, vC1);
        if (wr == 1) PG8_BAR;
        PG8_WAIT_V(4); PG8_BAR;
        PG8_STAGE(PG8_SB(1, 0), cB + kstep, voffB); PG8_STAGE(PG8_SA(1, 0), cA + kstep, vC0); PG8_STAGE(PG8_SB(1, 1), cB + hstepB + kstep, voffB);
        PG8_WAIT_V(6); PG8_BAR;
    }
    for (;;) {
        const bool has_next = S.next(ui + 1, nxt);
        const char* nA = GATHER ? (const char*)g.A : (has_next ? (const char*)g.A + (size_t)nxt.pm * tstep + S.aoff(nxt) : cA); const char* nB = has_next ? S.bptr(nxt, 0) : cB;
        const char* nB1 = has_next ? S.bptr(nxt, 1) - (size_t)ks * kstep : cB1;
#pragma unroll 1
        for (int t = 0; t < ntc; t += 2) {
            const bool last = (t == ntc - 2);
            const char* a1 = cA + (size_t)(t + 1) * kstep;
            const char* bside = (t + 2 < ks) ? cB : cB1;
            const char* a2 = last ? nA : cA + (size_t)(t + 2) * kstep; const char* b2 = last ? nB : bside + (size_t)(t + 2) * kstep;
            const char* a3 = a2 + kstep; const char* b3 = b2 + kstep;
            unsigned x0[2] = {vC0[0], vC0[1]}, x1[2] = {vC1[0], vC1[1]};
            if constexpr (GATHER) { if (last && has_next) { _Pragma("unroll") for (int _i = 0; _i < 2; ++_i) { const int R_ = (int)(voffA[_i] >> 11); const unsigned C_ = voffA[_i] & 2047u;
                x0[_i] = (unsigned)S.tokl[(ui + 1) * 256 + R_] * 2048u + C_; x1[_i] = (unsigned)S.tokl[(ui + 1) * 256 + 128 + R_] * 2048u + C_; } } }
            if constexpr (SP2) {
            PG8_LDB(B0, 0, 0); PG8_LDB(B1, 0, 1); PG8_SCHED; PG8_LDA(At, 0, 0); PG8_STAGE(PG8_SA(1, 1), a1, vC1);
            PG8_WAIT_V(8); PG8_WAIT_L(0); PG8_BAR; PG8_MMA(0, 0, At, B0); PG8_MMA(0, 1, At, B1); PG8_BAR; PG8_SCHED;
            PG8_LDA(At, 0, 1); PG8_STAGE(PG8_SB(0, 0), b2, voffB); PG8_STAGE(PG8_SB(0, 1), b2 + hstepB, voffB); PG8_STAGE(PG8_SA(0, 0), a2, x0);
            PG8_WAIT_V(8); PG8_WAIT_L(0); PG8_BAR; PG8_MMA(1, 0, At, B0); PG8_MMA(1, 1, At, B1); PG8_BAR; PG8_SCHED;
            PG8_LDB(B0, 1, 0); PG8_LDB(B1, 1, 1); PG8_SCHED; PG8_LDA(At, 1, 0); PG8_STAGE(PG8_SA(0, 1), a2, x1);
            PG8_WAIT_V(8); PG8_WAIT_L(0); PG8_BAR; PG8_MMA(0, 0, At, B0); PG8_MMA(0, 1, At, B1); PG8_BAR; PG8_SCHED;
            PG8_LDA(At, 1, 1); PG8_STAGE(PG8_SB(1, 0), b3, voffB); PG8_STAGE(PG8_SB(1, 1), b3 + hstepB, voffB); PG8_STAGE(PG8_SA(1, 0), a3, x0);
            PG8_WAIT_V(8); PG8_WAIT_L(0); PG8_BAR; PG8_MMA(1, 0, At, B0); PG8_MMA(1, 1, At, B1); PG8_BAR; PG8_SCHED;
            } else {
            PG8_LDB(B0, 0, 0); PG8_SCHED; PG8_LDA(At, 0, 0); PG8_STAGE(PG8_SA(1, 1), a1, vC1);
            PG8_WAIT_L(8); PG8_BAR; PG8_WAIT_L(0); PG8_MMA(0, 0, At, B0); PG8_BAR; PG8_SCHED;
            PG8_LDB(B1, 0, 1); PG8_STAGE(PG8_SB(0, 0), b2, voffB);
            PG8_BAR; PG8_WAIT_L(0); PG8_MMA(0, 1, At, B1); PG8_BAR;
            PG8_LDA(At, 0, 1); PG8_STAGE(PG8_SA(0, 0), a2, x0);
            PG8_BAR; PG8_WAIT_L(0); PG8_MMA(1, 0, At, B0); PG8_BAR; PG8_SCHED;
            PG8_STAGE(PG8_SB(0, 1), b2 + hstepB, voffB);
            PG8_WAIT_V(6); PG8_BAR; PG8_MMA(1, 1, At, B1); PG8_BAR;
            PG8_LDB(B0, 1, 0); PG8_SCHED; PG8_LDA(At, 1, 0); PG8_STAGE(PG8_SA(0, 1), a2, x1);
            PG8_WAIT_L(8); PG8_BAR; PG8_WAIT_L(0); PG8_MMA(0, 0, At, B0); PG8_BAR; PG8_SCHED;
            PG8_LDB(B1, 1, 1); PG8_STAGE(PG8_SB(1, 0), b3, voffB);
            PG8_BAR; PG8_WAIT_L(0); PG8_MMA(0, 1, At, B1); PG8_BAR;
            PG8_LDA(At, 1, 1); PG8_STAGE(PG8_SA(1, 0), a3, x0);
            PG8_BAR; PG8_WAIT_L(0); PG8_MMA(1, 0, At, B0); PG8_BAR; PG8_SCHED;
            PG8_STAGE(PG8_SB(1, 1), b3 + hstepB, voffB);
            PG8_WAIT_V(6); PG8_BAR; PG8_MMA(1, 1, At, B1); PG8_BAR;
            }
        }
        if constexpr (ALIGN_EPI) { if (wr == 0) PG8_BAR; }
        { const int l2 = lane_id_opaque(); E(acc, cur, wr, wc, l2 & 15, l2 >> 4); }
        if (!has_next) break;
        if (!E.keep(cur)) { float z_ = 0.f; LAUNDER_V(z_);
#pragma unroll
        for (int a = 0; a < 2; ++a)
#pragma unroll
            for (int b = 0; b < 2; ++b)
#pragma unroll
                for (int m = 0; m < 4; ++m)
#pragma unroll
                    for (int n = 0; n < 2; ++n) acc[a][b][m][n] = (f32x4){z_, z_, z_, z_}; }
        cur = nxt; cA = nA; cB = nB; cB1 = nB1; ++ui; ntc = S.nt(cur, nt);
        if constexpr (GATHER) { PG8_GOFF(ui); }
        if constexpr (ALIGN_EPI) { if (wr == 1) PG8_BAR; }
    }
    PG8_WAIT_V(0);
    if constexpr (!ALIGN_EPI) { if (wr == 0) PG8_BAR; }
    PG8_BAR;
#undef PG8_GOFF
#undef PG8_SA
#undef PG8_SB
#undef PG8_STAGE
#undef PG8_LDA
#undef PG8_LDB
#undef PG8_MMA
#undef PG8_WAIT_V
#undef PG8_WAIT_L
#undef PG8_BAR
#undef PG8_SCHED
}
}

typedef f32x4 AccT[2][2][4][2];
__device__ __forceinline__ u32x4 pack8(const f32x4 a, const f32x4 b) { u32x4 w; w.x = pk2(a[0], a[1]); w.y = pk2(a[2], a[3]); w.z = pk2(b[0], b[1]); w.w = pk2(b[2], b[3]); return w; }

struct Epi1 {
    static constexpr bool PERM = true;
    __device__ __forceinline__ bool keep(const pg8::Unit&) const { return false; }
    const float* rstd; bf16* A; bf16* GLU; bf16* QKV; bf16* G;
    __device__ __forceinline__ void operator()(AccT& acc, const pg8::Unit& u, int wr, int wc, int fr, int fq) const { run<false>(acc, u, wr, wc, fr, fq); }
    template <bool SK> __device__ __forceinline__ void run(AccT& acc, const pg8::Unit& u, int wr, int wc, int fr, int fq) const {
        const int row0 = u.pm * 256 + wr * 64 + fr, lc0 = wc * 32 + 8 * fq, pn = u.pn;
#pragma unroll
        for (int ai = 0; ai < (SK ? 1 : 2); ++ai)
#pragma unroll
            for (int m = 0; m < (SK ? 1 : 4); ++m) {
                const int row = row0 + ai * 128 + m * 16; const float rs = rstd[row];
                f32x4 v[2][2];
#pragma unroll
                for (int bj = 0; bj < 2; ++bj)
#pragma unroll
                    for (int n = 0; n < 2; ++n) v[bj][n] = acc[ai][bj][m][n] * rs;
                if (pn == 0) {
#pragma unroll
                    for (int bj = 0; bj < 2; ++bj) *(u32x4*)(A + (size_t)row * 256 + bj * 128 + lc0) = pack8(v[bj][0], v[bj][1]);
                } else if (pn <= 2) {
                    f32x4 o[2];
#pragma unroll
                    for (int n = 0; n < 2; ++n)
#pragma unroll
                        for (int j = 0; j < 4; ++j) o[n][j] = v[0][n][j] * sigmoidf_(v[1][n][j]);
                    *(u32x4*)(GLU + (size_t)row * 256 + (pn - 1) * 128 + lc0) = pack8(o[0], o[1]);
                } else if (pn <= 4) {
#pragma unroll
                    for (int bj = 0; bj < 2; ++bj) *(u32x4*)(QKV + (size_t)2 * (U / 4) + (size_t)row * 512 + (pn - 3) * 256 + bj * 128 + lc0) = pack8(v[bj][0], v[bj][1]);
                } else {
                    const int d = 64 * (pn - 5) + 16 * wc + 4 * fq; f32x4 r01, r12, g2;
#pragma unroll
                    for (int j = 0; j < 4; ++j) { const float a0 = 1.0f + fminf(__builtin_amdgcn_exp2f(-LOG2E * v[0][0][j]), 1e30f), a1 = 1.0f + fminf(__builtin_amdgcn_exp2f(-LOG2E * v[0][1][j]), 1e30f), a2 = 1.0f + fminf(__builtin_amdgcn_exp2f(-LOG2E * v[1][0][j]), 1e30f);
                        const float i0 = __builtin_amdgcn_rcpf(a0), i1 = __builtin_amdgcn_rcpf(a1), i2 = __builtin_amdgcn_rcpf(a2);
                        r01[j] = i0 * a1; r12[j] = i1 * a2; g2[j] = i2; }
                    bf16* gp = G + (size_t)row * 1024 + d; u32x2 w;
                    w.x = pk2(r01[0], r01[1]); w.y = pk2(r01[2], r01[3]); *(u32x2*)gp = w;
                    w.x = pk2(r12[0], r12[1]); w.y = pk2(r12[2], r12[3]); *(u32x2*)(gp + U / 2) = w;
                    w.x = pk2(g2[0], g2[1]); w.y = pk2(g2[2], g2[3]); *(u32x2*)(gp + U) = w;
                    const float sc = d < 512 ? C2 : 1.0f; const f32x4 sp = v[1][1] * sc;
                    w.x = pk2(sp[0], sp[1]); w.y = pk2(sp[2], sp[3]); *(u32x2*)(QKV + (size_t)(d < 512 ? 0 : 1) * (U / 4) + (size_t)row * 512 + (d & 511)) = w;
                }
            }
    }
};
struct EpiCS {
    static constexpr bool PERM = true;
    const bf16* G; bf16* Mg; const float* bias;
    __device__ __forceinline__ bool keep(const pg8::Unit& u) const { return u.seg != 2; }
    __device__ __forceinline__ void operator()(AccT& acc, const pg8::Unit& u, int wr, int wc, int fr, int fq) const { run<false>(acc, u, wr, wc, fr, fq); }
    template <bool SK> __device__ __forceinline__ void run(AccT& acc, const pg8::Unit& u, int wr, int wc, int fr, int fq) const {
        const int row0 = u.pm * 256 + wr * 64 + fr, col0 = u.pn * 256 + wc * 32 + 8 * fq;
        const bool lastseg = u.seg == 2; const float bsc = u.seg == 0 ? 1.f : 0.f; const bf16* Gs = G + (size_t)u.seg * (U / 2);
        f32x4 bv[2][2];
#pragma unroll
        for (int bj = 0; bj < 2; ++bj) { bv[bj][0] = *(const f32x4*)(bias + col0 + bj * 128) * bsc; bv[bj][1] = *(const f32x4*)(bias + col0 + bj * 128 + 4) * bsc; }
        u32x4 gr[2][4][2];
#pragma unroll
        for (int ai = 0; ai < (SK ? 1 : 2); ++ai)
#pragma unroll
            for (int m = 0; m < (SK ? 1 : 4); ++m)
#pragma unroll
                for (int bj = 0; bj < 2; ++bj) gr[ai][m][bj] = *(const u32x4*)(Gs + (size_t)(row0 + ai * 128 + m * 16) * 1024 + col0 + bj * 128);
#pragma unroll
        for (int ai = 0; ai < (SK ? 1 : 2); ++ai)
#pragma unroll
            for (int m = 0; m < (SK ? 1 : 4); ++m) { const int row = row0 + ai * 128 + m * 16;
#pragma unroll
                for (int bj = 0; bj < 2; ++bj) {
                    const u32x4 n4 = gr[ai][m][bj];
                    f32x4 a0 = acc[ai][bj][m][0] + bv[bj][0], a1 = acc[ai][bj][m][1] + bv[bj][1];
                    a0[0] *= bflo(n4.x); a0[1] *= bfhi(n4.x); a0[2] *= bflo(n4.y); a0[3] *= bfhi(n4.y); a1[0] *= bflo(n4.z); a1[1] *= bfhi(n4.z); a1[2] *= bflo(n4.w); a1[3] *= bfhi(n4.w);
                    acc[ai][bj][m][0] = a0; acc[ai][bj][m][1] = a1;
                    asm volatile("" : "+v"(acc[ai][bj][m][0]), "+v"(acc[ai][bj][m][1]));
                    if (lastseg) *(u32x4*)(Mg + (size_t)row * 1024 + col0 + bj * 128) = pack8(a0, a1);
                } }
    }
};
struct EpiD {
    static constexpr bool PERM = false;
    __device__ __forceinline__ bool keep(const pg8::Unit&) const { return false; }
    float* H; bf16* HB;
    __device__ __forceinline__ void operator()(AccT& acc, const pg8::Unit& u, int wr, int wc, int fr, int fq) const { run<false>(acc, u, wr, wc, fr, fq); }
    template <bool SK> __device__ __forceinline__ void run(AccT& acc, const pg8::Unit& u, int wr, int wc, int fr, int fq) const {
        const int row0 = u.pm * 256 + wr * 64 + fr, col0 = u.pn * 256 + wc * 32 + 4 * fq;
#pragma unroll
        for (int ai = 0; ai < (SK ? 1 : 2); ++ai)
#pragma unroll
            for (int m = 0; m < (SK ? 1 : 4); ++m) {
                const size_t off = (size_t)(row0 + ai * 128 + m * 16) * 1024 + col0;
#pragma unroll
                for (int bj = 0; bj < 2; ++bj)
#pragma unroll
                    for (int n = 0; n < 2; ++n) { const size_t o = off + bj * 128 + n * 16; const f32x4 hv = *(const f32x4*)(H + o) + acc[ai][bj][m][n];
                        *(f32x4*)(H + o) = hv; u32x2 w; w.x = pk2(hv[0], hv[1]); w.y = pk2(hv[2], hv[3]); *(u32x2*)(HB + o) = w; }
            }
    }
};
struct EpiA2 {
    static constexpr bool PERM = true;
    __device__ __forceinline__ bool keep(const pg8::Unit&) const { return false; }
    const float* PW; bf16* HH;
    __device__ __forceinline__ void operator()(AccT& acc, const pg8::Unit& u, int wr, int wc, int fr, int fq) const {
        const int row0 = u.pm * 256 + wr * 64 + fr, lc0 = wc * 32 + 8 * fq, side = u.pn >> 1;
#pragma unroll
        for (int ai = 0; ai < 2; ++ai)
#pragma unroll
            for (int m = 0; m < 4; ++m) {
                const int row = row0 + ai * 128 + m * 16; const f32x4 pw = *(const f32x4*)(PW + (size_t)row * 4);
                const float rs = pw[0], cw = side ? pw[2] : pw[1];
                f32x4 o[2];
#pragma unroll
                for (int n = 0; n < 2; ++n)
#pragma unroll
                    for (int j = 0; j < 4; ++j) { const float a1 = acc[ai][0][m][n][j] * rs, a3 = acc[ai][1][m][n][j] * rs; o[n][j] = cw * a1 * sigmoidf_(a1) * a3; }
                *(u32x4*)(HH + (size_t)row * 512 + side * 256 + (u.pn & 1) * 128 + lc0) = pack8(o[0], o[1]);
            }
    }
};
struct EpiB2 {
    static constexpr bool PERM = true;
    __device__ __forceinline__ bool keep(const pg8::Unit&) const { return false; }
    bf16* Y;
    __device__ __forceinline__ void operator()(AccT& acc, const pg8::Unit& u, int wr, int wc, int fr, int fq) const { run<false>(acc, u, wr, wc, fr, fq); }
    template <bool SK> __device__ __forceinline__ void run(AccT& acc, const pg8::Unit& u, int wr, int wc, int fr, int fq) const {
        const int row0 = u.pm * 256 + wr * 64 + fr, col0 = u.pn * 256 + wc * 32 + 8 * fq;
#pragma unroll
        for (int ai = 0; ai < (SK ? 1 : 2); ++ai)
#pragma unroll
            for (int m = 0; m < (SK ? 1 : 4); ++m) {
                bf16* rp = Y + (size_t)(row0 + ai * 128 + m * 16) * 1024 + col0;
#pragma unroll
                for (int bj = 0; bj < 2; ++bj) *(u32x4*)(rp + bj * 128) = pack8(acc[ai][bj][m][0], acc[ai][bj][m][1]);
            }
    }
};
template <bool GA> struct MoeOrderT {
    static constexpr bool GATHER = GA; const LAS int* tokl;
    int NP, G, c, mode; const LAS int* pcls; const bf16* W;
    __device__ bool next(int i, pg8::Unit& u) const { const long L = (long)i * G + c; if (L >= (long)NP * 4) return false; u.pm = (int)(L >> 2); u.pn = (int)(L & 3); u.seg = 0; return true; }
    __device__ __forceinline__ int nt(const pg8::Unit&, int ntd) const { return ntd; }
    __device__ __forceinline__ size_t aoff(const pg8::Unit&) const { return 0; }
    __device__ __forceinline__ const char* bptr(const pg8::Unit& u, int side) const {
        const int cls = __builtin_amdgcn_readfirstlane(pcls[u.pm]); const int grp = cls / 6, pr = cls % 6;
        const int ea = pr < 3 ? 0 : (pr < 5 ? 1 : 2), eb = pr < 3 ? pr + 1 : (pr < 5 ? pr - 1 : 3);
        if (mode == 0) { const int e = grp * 4 + (u.pn < 2 ? ea : eb); return (const char*)W + ((size_t)e * 512 + (size_t)(u.pn & 1) * 256) * 1024 * 2; }
        const int e = grp * 4 + (side ? eb : ea); return (const char*)W + ((size_t)e * 1024 + (size_t)u.pn * 256) * 256 * 2;
    }
};

template <bool PERM> __device__ __forceinline__ void skinny_k(AccT& acc, const bf16* A, int lda, const bf16* Bt, int ldb, int K, int wc, int fr, int fq) {
    const bf16* ap = A + (size_t)fr * lda + 8 * fq;
    const bf16* bp[2][2];
#pragma unroll
    for (int bj = 0; bj < 2; ++bj)
#pragma unroll
        for (int n = 0; n < 2; ++n) { const int col = 128 * bj + 32 * wc + (PERM ? 8 * (fr >> 2) + 4 * n + (fr & 3) : 16 * n + fr); bp[bj][n] = Bt + (size_t)col * ldb + 8 * fq; }
#pragma unroll 8
    for (int k0 = 0; k0 < K; k0 += 32) {
        const bf16x8 a = *(const bf16x8*)(ap + k0);
#pragma unroll
        for (int bj = 0; bj < 2; ++bj)
#pragma unroll
            for (int n = 0; n < 2; ++n) { const bf16x8 b = *(const bf16x8*)(bp[bj][n] + k0); acc[0][bj][0][n] = __builtin_amdgcn_mfma_f32_16x16x32_bf16(b, a, acc[0][bj][0][n], 0, 0, 0); }
    }
}
__device__ __forceinline__ void skinny_zero(AccT& acc) {
#pragma unroll
    for (int bj = 0; bj < 2; ++bj)
#pragma unroll
        for (int n = 0; n < 2; ++n) acc[0][bj][0][n] = (f32x4){0.f, 0.f, 0.f, 0.f};
}
__device__ __forceinline__ void skinny_combine(AccT& acc, LAS unsigned char* lds, int wave, int lane) {
    LAS f32x4* X = (LAS f32x4*)lds;
    if (wave >= 4) {
#pragma unroll
        for (int bj = 0; bj < 2; ++bj)
#pragma unroll
            for (int n = 0; n < 2; ++n) X[((wave - 4) * 64 + lane) * 4 + bj * 2 + n] = acc[0][bj][0][n]; }
    __syncthreads();
    if (wave < 4) {
#pragma unroll
        for (int bj = 0; bj < 2; ++bj)
#pragma unroll
            for (int n = 0; n < 2; ++n) acc[0][bj][0][n] += X[(wave * 64 + lane) * 4 + bj * 2 + n]; }
    __syncthreads();
}

#define XB_TMO      128
#define XB_XCNT(j)  (256  + 64 * (j))
#define XB_XSUB(j)  (1280 + 64 * (j))
#define XB_XGEN(j)  (2304 + 64 * (j))
#define XB_TOP      3328
#define XB_TOPGEN   3392
#define XCD_BAR_WORDS 3456
#define XB_SPIN_CAP (1u << 24)
__device__ __forceinline__ unsigned xb_ld(unsigned* p)              { return __hip_atomic_load(p, __ATOMIC_RELAXED, __HIP_MEMORY_SCOPE_AGENT); }
__device__ __forceinline__ unsigned xb_add(unsigned* p, unsigned v) { return __hip_atomic_fetch_add(p, v, __ATOMIC_RELAXED, __HIP_MEMORY_SCOPE_AGENT); }
__device__ __forceinline__ unsigned xb_xcc_id() { return (unsigned)__builtin_amdgcn_s_getreg((3 << 11) | 20) & 0xFu; }
#define XB_SPIN(cond, bar) do { unsigned _sp = 0; while (cond) { __builtin_amdgcn_s_sleep(1); \
    if ((++_sp & 255u) == 0u) { if (xb_ld(&(bar)[XB_TMO])) break; if (_sp > XB_SPIN_CAP) { atomicAdd(&(bar)[XB_TMO], 1u); break; } } } } while (0)
struct XcdBarrier { unsigned* bar; unsigned x; volatile LAS unsigned* st; };
__device__ __forceinline__ XcdBarrier xcd_barrier_post(unsigned* bar, volatile LAS unsigned* st) {
    XcdBarrier b; b.bar = bar; b.x = xb_xcc_id(); b.st = st;
    if (threadIdx.x == 0) (void)xb_add(&bar[XB_XCNT(b.x)], 1u);
    return b;
}
__device__ __forceinline__ void xcd_barrier_complete(unsigned* bar, unsigned x, unsigned& nloc, unsigned& nx) {
    const unsigned G = gridDim.x * gridDim.y * gridDim.z;
    unsigned sum, cnt, mine, sp = 0u;
    for (;;) {
        sum = 0u; cnt = 0u; mine = 0u;
#pragma unroll
        for (unsigned j = 0; j < 16; ++j) { const unsigned c = xb_ld(&bar[XB_XCNT(j)]); sum += c; cnt += (c > 0u) ? 1u : 0u; mine = (j == x) ? c : mine; }
        if (sum == G) break;
        __builtin_amdgcn_s_sleep(1);
        if ((++sp & 255u) == 0u) { if (xb_ld(&bar[XB_TMO])) break; if (sp > XB_SPIN_CAP) { atomicAdd(&bar[XB_TMO], 1u); break; } }
    }
    nloc = mine > 0u ? mine : 1u; nx = cnt > 0u ? cnt : 1u;
}
__device__ __forceinline__ void xcd_barrier(const XcdBarrier& b) {
    asm volatile("s_waitcnt vmcnt(0)" ::: "memory");
    __syncthreads();
    if (threadIdx.x == 0) {
        unsigned* bar = b.bar;
        __builtin_amdgcn_s_waitcnt(0);
        unsigned nloc = b.st[0], nx = b.st[1];
        if (nloc == 0u) { xcd_barrier_complete(bar, b.x, nloc, nx); b.st[0] = nloc; b.st[1] = nx; }
        const unsigned old = xb_add(&bar[XB_XSUB(b.x)], 1u);
        const unsigned gen = old / nloc;
        if (old + 1u == (gen + 1u) * nloc) {
            __builtin_amdgcn_fence(__ATOMIC_RELEASE, "agent");
            asm volatile("s_waitcnt vmcnt(0)" ::: "memory");
            const unsigned og = xb_add(&bar[XB_TOP], 1u);
            const unsigned tg = og / nx;
            if (og + 1u == (tg + 1u) * nx) xb_add(&bar[XB_TOPGEN], 1u);
            else XB_SPIN(xb_ld(&bar[XB_TOPGEN]) == tg, bar);
            __builtin_amdgcn_fence(__ATOMIC_ACQUIRE, "agent");
            xb_add(&bar[XB_XGEN(b.x)], 1u);
            asm volatile("s_waitcnt vmcnt(0)" ::: "memory");
        } else {
            XB_SPIN(xb_ld(&bar[XB_XGEN(b.x)]) == gen, bar);
            __builtin_amdgcn_fence(__ATOMIC_ACQUIRE, "agent");
            asm volatile("s_waitcnt vmcnt(0)" ::: "memory");
        }
    }
    __syncthreads();
}

struct Params { const float* in[25]; float* out; unsigned char* ws; int ph_lo, ph_hi; };
enum { I_X = 0, I_META, I_N1G, I_WIN, I_BF, I_PW, I_PB, I_PS, I_CW, I_CB, I_LNG, I_LNB, I_WOA, I_WOB, I_WOC, I_WO, I_N2G, I_RGW, I_RGB, I_REW, I_REB, I_W1, I_W3, I_W2, I_FG };

struct Frame {
    LAS unsigned char* lds;
    int tid, lane, wave, vcu, G, bx;
};
__device__ __forceinline__ unsigned long long ptab_get(const Frame& F, int i) { const LAS unsigned* t = (const LAS unsigned*)(F.lds + LC_PTAB) + 2 * i; const unsigned lo = __builtin_amdgcn_readfirstlane(t[0]), hi = __builtin_amdgcn_readfirstlane(t[1]); return ((unsigned long long)hi << 32) | lo; }
#define INP(i) ((const float*)(const GAS float*)ptab_get(F, (i)))
#define WSP() ((unsigned char*)(GAS unsigned char*)ptab_get(F, 25))
#define DOP() ((unsigned char*)(GAS unsigned char*)ptab_get(F, 26))

__device__ __forceinline__ void tr_item(const float* W, int ldw, int scol_lane  , const float* gk, bf16* WT, int ldt, int drow0, int k0, LAS float* scr, int lane) {
    const int n4 = (lane & 7) * 4, kr = lane >> 3;
    f32x4 v[8];
#pragma unroll
    for (int i = 0; i < 8; ++i) v[i] = *(const f32x4*)(W + (size_t)(k0 + 8 * i + kr) * ldw + scol_lane);
#pragma unroll
    for (int i = 0; i < 8; ++i) { const int kk = 8 * i + kr; const float g = gk ? gk[k0 + kk] : 1.0f; LAS float* d = scr + kk * 33 + n4; d[0] = v[i][0] * g; d[1] = v[i][1] * g; d[2] = v[i][2] * g; d[3] = v[i][3] * g; }
    LDS_WAIT(); asm volatile("" ::: "memory");
    const int c = lane & 7;
#pragma unroll
    for (int j = 0; j < 4; ++j) { const int n = (lane >> 3) + 8 * j; const LAS float* s = scr + (8 * c) * 33 + n;
        u32x4 o; o.x = pk2(s[0 * 33], s[1 * 33]); o.y = pk2(s[2 * 33], s[3 * 33]); o.z = pk2(s[4 * 33], s[5 * 33]); o.w = pk2(s[6 * 33], s[7 * 33]);
        *(u32x4*)(WT + (size_t)(drow0 + n) * ldt + k0 + 8 * c) = o; }
    LDS_WAIT(); asm volatile("" ::: "memory");
}
__device__ __forceinline__ int map1(int n) {
    const int tile = n >> 8, c = n & 255;
    if (tile == 0) return n;
    if (tile <= 2) { const int cc = (tile - 1) * 128 + (c & 127); return (c < 128 ? 256 : 512) + cc; }
    if (tile <= 4) return 1792 + (n - 768);
    const int t = tile - 5, bj = c >> 7, wc = (c >> 5) & 3, fq = (c >> 3) & 3, nn = (c >> 2) & 1, d = 64 * t + 16 * wc + 4 * fq + (c & 3), kind = 2 * bj + nn;
    return kind == 3 ? 768 + d : 2312 + 1024 * kind + d;
}
__device__ __forceinline__ void convert_item(Frame& F, int l, int it, LAS float* scr, int lane) {
    const float* g1 = INP(I_N1G) + (size_t)l * D; const float* g2 = INP(I_N2G) + (size_t)l * D; unsigned char* ws = WSP(); const int n4l = (lane & 7) * 4;
    if (it < 2688) { const int kb = it / 168, nb = it % 168; tr_item(INP(I_WIN) + (size_t)l * D * NIN, NIN, map1(nb * 32 + n4l), g1, (bf16*)(ws + WS_W1T), 1024, nb * 32, kb * 64, scr, lane); return; } it -= 2688;
    if (it < 128) { const int kb = it / 32, nb = it % 32; tr_item(INP(I_WOB) + (size_t)l * 256 * D, 1024, nb * 32 + n4l, nullptr, (bf16*)(ws + WS_W3CT) + 256, 1024, nb * 32, kb * 64, scr, lane); return; } it -= 128;
    if (it < 256) { const int kb = it / 32, nb = it % 32; tr_item(INP(I_WOC) + (size_t)l * 512 * D, 1024, nb * 32 + n4l, nullptr, (bf16*)(ws + WS_W3CT) + 512, 1024, nb * 32, kb * 64, scr, lane); return; } it -= 256;
    if (it < 512) { const int kb = it / 32, nb = it % 32; tr_item(INP(I_WO) + (size_t)l * D * D, 1024, nb * 32 + n4l, nullptr, (bf16*)(ws + WS_WOT), 1024, nb * 32, kb * 64, scr, lane); return; } it -= 512;
    if (it < 4096) { const int e = it >> 8, r = it & 255, kb = r >> 4, nb = r & 15, n0 = nb * 32, jt = n0 >> 8, rr = n0 & 255;
        const float* W = (rr < 128 ? INP(I_W1) : INP(I_W3)) + ((size_t)l * 16 + e) * D * 256;
        tr_item(W, 256, jt * 128 + (rr & 127) + n4l, g2, (bf16*)(DOP() + DO_W13T) + (size_t)e * 512 * 1024, 1024, n0, kb * 64, scr, lane); return; } it -= 4096;
    { const int e = it >> 7, r = it & 127, kb = r >> 5, nb = r & 31;
        tr_item(INP(I_W2) + ((size_t)l * 16 + e) * 256 * D, 1024, nb * 32 + n4l, nullptr, (bf16*)(DOP() + DO_W2T) + (size_t)e * 1024 * 256, 256, nb * 32, kb * 64, scr, lane); }
}
__device__ __forceinline__ void convert_weights(Frame& F, int l) {
    LAS float* scr = (LAS float*)(F.lds + F.wave * 16384);
    const int gw = F.vcu * NWAVES + F.wave, NGW = F.G * NWAVES, lane = F.lane;
    const float* g1 = INP(I_N1G) + (size_t)l * D; const float* g2 = INP(I_N2G) + (size_t)l * D;
    unsigned char* ws = WSP();
#pragma unroll 1
    for (int it0 = gw; it0 < 3584; it0 += NGW) convert_item(F, l, it0, scr, lane);
    { const float* pw = INP(I_PW) + (size_t)l * 4 * 64 * 64; const float* ps = INP(I_PS) + (size_t)l * 256; const float* pb = INP(I_PB) + (size_t)l * 256;
      const float* wa = INP(I_WOA) + (size_t)l * 256 * D; bf16* WT = (bf16*)(ws + WS_W3CT); float* bias = (float*)(ws + WS_BIASA);
      const int gt = F.vcu * 512 + F.tid, NT = F.G * 512;
      for (int idx = gt; idx < 256 * 1024; idx += NT) { const int n = idx & 1023, kk = idx >> 10, grp = kk >> 6, c = kk & 63; float s = 0.f;
#pragma unroll 16
        for (int d = 0; d < 64; ++d) s += pw[(grp * 64 + c) * 64 + d] * ps[grp * 64 + d] * wa[(size_t)(grp * 64 + d) * D + n];
        WT[(size_t)n * 1024 + kk] = (bf16)f2bf(s); }
      for (int n = gw; n < 1024; n += NGW) { float s = 0.f;
#pragma unroll
        for (int j = 0; j < 4; ++j) { const int d = lane + 64 * j; s += pb[d] * ps[d] * wa[(size_t)d * D + n]; }
        s = wave_sum(s); if (lane == 0) bias[n] = s; }
      float* wfg = (float*)(ws + WS_WFG); const float* win = INP(I_WIN) + (size_t)l * D * NIN;
      for (int idx = gt; idx < 8 * 1024; idx += NT) { const int c = idx >> 10, k = idx & 1023; wfg[idx] = g1[k] * win[(size_t)k * NIN + 2304 + c]; }
      float* rg = (float*)(ws + WS_RG); const float* re = INP(I_REW) + (size_t)l * D * 16; const float* rgw = INP(I_RGW) + (size_t)l * D * 4;
      for (int idx = gt; idx < 20 * 1024; idx += NT) { const int c = idx >> 10, k = idx & 1023; rg[idx] = g2[k] * (c < 16 ? re[(size_t)k * 16 + c] : rgw[(size_t)k * 4 + (c - 16)]); } }
}
__device__ __forceinline__ void init_rows(Frame& F) {
    const int gw = F.vcu * NWAVES + F.wave, NGW = F.G * NWAVES, lane = F.lane;
    bf16* HB = (bf16*)(WSP() + WS_HB); float* rstd1 = (float*)(WSP() + WS_RSTD1);
    constexpr int R = 4;
#pragma unroll 1
    for (int row0 = gw; row0 < TR; row0 += R * NGW) {
        f32x4 v[R][4];
#pragma unroll
        for (int r = 0; r < R; ++r) { int row = row0 + r * NGW; if (row >= TR) row = TR - 1;
            const float* src = row < TX ? INP(I_X) + (size_t)row * D : INP(I_META) + (size_t)(row - TX) * D;
#pragma unroll
            for (int j = 0; j < 4; ++j) v[r][j] = *(const f32x4*)(src + 4 * lane + 256 * j); }
#pragma unroll
        for (int r = 0; r < R; ++r) { const int row = row0 + r * NGW; float ss = 0.f;
#pragma unroll
            for (int j = 0; j < 4; ++j) ss += v[r][j][0] * v[r][j][0] + v[r][j][1] * v[r][j][1] + v[r][j][2] * v[r][j][2] + v[r][j][3] * v[r][j][3];
            ss = wave_sum(ss);
            if (row < TR) {
#pragma unroll
                for (int j = 0; j < 4; ++j) { u32x2 w; w.x = pk2(v[r][j][0], v[r][j][1]); w.y = pk2(v[r][j][2], v[r][j][3]); *(u32x2*)(HB + (size_t)row * D + 4 * lane + 256 * j) = w; }
                if (lane == 0) rstd1[row] = rsqrtf(ss * (1.0f / D) + EPS); } }
    }
    { bf16* Kb = (bf16*)(DOP() + DO_K) + (size_t)TR * 512; bf16* Vb = (bf16*)(DOP() + DO_V) + (size_t)TR * 512; const int gt = F.vcu * 512 + F.tid;
      if (gt < 48 * 64) { *(u32x4*)(Kb + (size_t)gt * 8) = (u32x4){0u, 0u, 0u, 0u}; *(u32x4*)(Vb + (size_t)gt * 8) = (u32x4){0u, 0u, 0u, 0u}; } }
}

__device__ __forceinline__ int srcrow(bool isx, int b, int t) {
    if (t >= 0) return (isx ? b * SEQ : TX) + t;
    if (isx) { const int mm = NMETA + t; return mm >= 0 ? TX + mm : -1; }
    return -1;
}
__device__ __forceinline__ void s_item_logf(Frame& F, int l, int item) {
    LAS unsigned char* lds = F.lds; const int wave = F.wave;
    {
        const bool isx = item < 512; const int row0 = isx ? item * 64 : TX + (item - 512) * 64; const int b = isx ? (item * 64) / SEQ : 0; const int t0 = isx ? (item * 64) % SEQ : (item - 512) * 64; const int nrows = isx ? 64 : NMETA;
        { unsigned char* ws = WSP(); int tid = F.tid; LAUNDER_V(tid); const int lane = tid & 63, fr = lane & 15, fq = lane >> 4;
          const bf16* HB = (const bf16*)(ws + WS_HB); const float* rstd1 = (const float*)(ws + WS_RSTD1); const float* wfg = (const float*)(ws + WS_WFG);
          float* LFT = (float*)(ws + WS_LFT); float* LFTM = (float*)(ws + WS_LFTM); const float* bfg = INP(I_BF) + l * 8;
          LAS bf16* Whi = (LAS bf16*)lds; LAS bf16* Wlo = Whi + 8 * RPITCH; LAS float* Pex = (LAS float*)(lds + 2 * 8 * RPITCH * 2);
          { f32x4 wv_[4];
#pragma unroll
            for (int j = 0; j < 4; ++j) wv_[j] = *(const f32x4*)(wfg + 4 * (tid + 512 * j));
#pragma unroll
            for (int j = 0; j < 4; ++j) { const int i = 4 * (tid + 512 * j), c = i >> 10, k = i & 1023; u32x2 hw, lw; float hf[4];
#pragma unroll
                for (int e = 0; e < 4; ++e) hf[e] = __builtin_bit_cast(float, (pk2(wv_[j][e], 0.f) & 0xffffu) << 16);
                hw.x = pk2(wv_[j][0], wv_[j][1]); hw.y = pk2(wv_[j][2], wv_[j][3]); lw.x = pk2(wv_[j][0] - hf[0], wv_[j][1] - hf[1]); lw.y = pk2(wv_[j][2] - hf[2], wv_[j][3] - hf[3]);
                *(LAS u32x2*)(Whi + c * RPITCH + k) = hw; *(LAS u32x2*)(Wlo + c * RPITCH + k) = lw; } }
          const int g = wave & 3, kh = wave >> 2, rr = 16 * g + fr, row = row0 + rr;
          bf16x8 af[16];
#pragma unroll
          for (int s2 = 0; s2 < 16; ++s2) af[s2] = *(const bf16x8*)(HB + (size_t)row * D + 32 * (16 * kh + s2) + 8 * fq);
          const float rs1 = rstd1[row];
          __syncthreads();
          f32x4 acc = {0.f, 0.f, 0.f, 0.f};
#pragma unroll
          for (int s2 = 0; s2 < 16; ++s2) { const int k = 32 * (16 * kh + s2) + 8 * fq;
              bf16x8 wh = *(const LAS bf16x8*)(Whi + (fr & 7) * RPITCH + k), wl = *(const LAS bf16x8*)(Wlo + (fr & 7) * RPITCH + k);
              if (fr >= 8) { wh = (bf16x8){0, 0, 0, 0, 0, 0, 0, 0}; wl = wh; }
              acc = __builtin_amdgcn_mfma_f32_16x16x32_bf16(wh, af[s2], acc, 0, 0, 0); acc = __builtin_amdgcn_mfma_f32_16x16x32_bf16(wl, af[s2], acc, 0, 0, 0); }
          if (kh == 1) *(LAS f32x4*)(Pex + (g * 64 + lane) * 4) = acc;
          __syncthreads();
          if (kh == 0) { const f32x4 o4 = *(const LAS f32x4*)(Pex + (g * 64 + lane) * 4); acc += o4;
              if (fq < 2 && rr < nrows && row < TR) {
#pragma unroll
                  for (int i = 0; i < 4; ++i) { const int hd = 4 * fq + i; const float xg = acc[i] * rs1 + bfg[hd]; const float lf = fminf(xg, 0.f) - 0.69314718056f * __builtin_amdgcn_logf(1.0f + __expf(-fabsf(xg)));
                      if (isx) LFT[(size_t)(b * 8 + hd) * SEQ + t0 + rr] = lf; else LFTM[hd * 256 + t0 + rr] = lf; } } }
          __syncthreads(); }
    }
}
__device__ __forceinline__ void norm_items(Frame& F, int l, int wsub, int nsub) {
    LAS unsigned* nmx = (LAS unsigned*)(F.lds + LC_NMX); const int wave = F.wave;
#pragma unroll 1
    for (int item = wsub; item < 513; item += nsub) {
        const bool isx = item < 512; const int row0 = isx ? item * 64 : TX; const int b = isx ? (item * 64) / SEQ : 0; const int nrows = isx ? 64 : NMETA;
        int tid = F.tid; LAUNDER_V(tid); const int lane = tid & 63;
        if (tid < 16) nmx[tid] = 0u;
        __syncthreads();
        {
          { const bf16* Qg = (const bf16*)(DOP() + DO_Q); const bf16* Kg = (const bf16*)(DOP() + DO_K); float kmx = 0.f, qmx = 0.f;
            u32x4 kw[8], qw[8];
#pragma unroll
            for (int i8 = 0; i8 < 8; ++i8) { const int r2 = wave + 8 * i8; const int rw = row0 + (r2 < nrows ? r2 : 0); kw[i8] = *(const u32x4*)(Kg + (size_t)rw * 512 + 8 * lane); qw[i8] = *(const u32x4*)(Qg + (size_t)rw * 512 + 8 * lane); }
#pragma unroll
            for (int i8 = 0; i8 < 8; ++i8) { const u32x4 a = kw[i8], c = qw[i8];
                float sk = (bflo(a.x) * bflo(a.x) + bfhi(a.x) * bfhi(a.x)) + (bflo(a.y) * bflo(a.y) + bfhi(a.y) * bfhi(a.y)) + (bflo(a.z) * bflo(a.z) + bfhi(a.z) * bfhi(a.z)) + (bflo(a.w) * bflo(a.w) + bfhi(a.w) * bfhi(a.w));
                float sq = (bflo(c.x) * bflo(c.x) + bfhi(c.x) * bfhi(c.x)) + (bflo(c.y) * bflo(c.y) + bfhi(c.y) * bfhi(c.y)) + (bflo(c.z) * bflo(c.z) + bfhi(c.z) * bfhi(c.z)) + (bflo(c.w) * bflo(c.w) + bfhi(c.w) * bfhi(c.w));
                sk += lane_xor<1>(sk); sk += lane_xor<2>(sk); sk += lane_xor<4>(sk); sq += lane_xor<1>(sq); sq += lane_xor<2>(sq); sq += lane_xor<4>(sq);
                kmx = fmaxf(kmx, sk); qmx = fmaxf(qmx, sq); }
            if ((lane & 7) == 0) { const int hd = lane >> 3; __hip_atomic_fetch_max(&nmx[hd], __float_as_uint(kmx), __ATOMIC_RELAXED, __HIP_MEMORY_SCOPE_WORKGROUP); __hip_atomic_fetch_max(&nmx[8 + hd], __float_as_uint(qmx), __ATOMIC_RELAXED, __HIP_MEMORY_SCOPE_WORKGROUP); } }
        }
        __syncthreads();
        if (tid < 16) { unsigned* nrm = (unsigned*)(WSP() + WS_CTL) + CW_NRM + l * 64; const unsigned v = nmx[tid];
            if (isx) __hip_atomic_fetch_max(nrm + (tid >> 3) * 32 + b * 8 + (tid & 7), v, __ATOMIC_RELAXED, __HIP_MEMORY_SCOPE_AGENT);
            else if (tid < 8) { for (int bb = 0; bb < NB; ++bb) __hip_atomic_fetch_max(nrm + bb * 8 + tid, v, __ATOMIC_RELAXED, __HIP_MEMORY_SCOPE_AGENT); } }
        __syncthreads();
    }
}
__device__ __forceinline__ void s_item_poolconv(Frame& F, int l, int it32) {
    const int hw = F.wave >> 2, hwave = F.wave & 3; LAS unsigned char* lds = F.lds + hw * 64512;
    const bool isx = it32 < 1024; const int row0 = isx ? it32 * 32 : TX; const int b = isx ? (it32 * 32) / SEQ : 0; const int t0 = isx ? (it32 * 32) % SEQ : 0; const int nrows = isx ? 32 : NMETA;
    { unsigned char* ws = WSP(); int tid = F.tid & 255; LAUNDER_V(tid);
      const bf16* Ab = (const bf16*)(ws + WS_A); bf16* DIFF = (bf16*)(ws + WS_X3);
      LAS unsigned char* T = lds;
      { u32x4 tv[6]; const int nld = (15 + nrows) * 32;
#pragma unroll
        for (int j = 0; j < 6; ++j) { const int i = tid + 256 * j; const int sl = i >> 5, ch = i & 31; const int r = i < nld ? srcrow(isx, b, t0 + sl - 15) : -1; unsigned z_ = 0u; LAUNDER_V(z_);
            tv[j] = r >= 0 ? *(const u32x4*)(Ab + (size_t)r * 256 + ch * 8) : (u32x4){z_, z_, z_, z_}; }
#pragma unroll
        for (int j = 0; j < 6; ++j) { const int i = tid + 256 * j; if (i < nld) *(LAS u32x4*)(T + (i >> 5) * 512 + (i & 31) * 16) = tv[j]; } }
      __syncthreads();
#pragma unroll 1
      for (int i = tid; i < nrows * 32; i += 256) { const int r = i >> 5, ch = i & 31, grp = ch >> 3, w = 2 << grp; const int cnt = isx ? w : min(t0 + r + 1, w);
          float s[8];
#pragma unroll
          for (int j = 0; j < 8; ++j) s[j] = 0.f;
#pragma unroll 4
          for (int d = 0; d < cnt; ++d) { const u32x4 v = *(const LAS u32x4*)(T + (15 + r - d) * 512 + ch * 16);
              s[0] += bflo(v.x); s[1] += bfhi(v.x); s[2] += bflo(v.y); s[3] += bfhi(v.y); s[4] += bflo(v.z); s[5] += bfhi(v.z); s[6] += bflo(v.w); s[7] += bfhi(v.w); }
          const u32x4 a = *(const LAS u32x4*)(T + (15 + r) * 512 + ch * 16); const float ic = 1.0f / (float)cnt;
          u32x4 o; o.x = pk2(s[0] * ic - bflo(a.x), s[1] * ic - bfhi(a.x)); o.y = pk2(s[2] * ic - bflo(a.y), s[3] * ic - bfhi(a.y));
          o.z = pk2(s[4] * ic - bflo(a.z), s[5] * ic - bfhi(a.z)); o.w = pk2(s[6] * ic - bflo(a.w), s[7] * ic - bfhi(a.w));
          if (row0 + r < TR) *(u32x4*)(DIFF + (size_t)(row0 + r) * 1024 + ch * 8) = o; }
      __syncthreads(); }
    { unsigned char* ws = WSP(); int tid = F.tid & 255; LAUNDER_V(tid);
      const bf16* GLU = (const bf16*)(ws + WS_GLU);
      LAS unsigned char* T = lds;
      LAS float* Yt = (LAS float*)(lds + 31744);
      { u32x4 tv[8]; const int nld = (isx ? 62 : 46) * 32;
#pragma unroll
        for (int j = 0; j < 8; ++j) { const int i = tid + 256 * j; const int sl = i >> 5, ch = i & 31; const int r = i < nld ? srcrow(isx, b, t0 + sl - 30) : -1; unsigned z_ = 0u; LAUNDER_V(z_);
            tv[j] = r >= 0 ? *(const u32x4*)(GLU + (size_t)r * 256 + ch * 8) : (u32x4){z_, z_, z_, z_}; }
#pragma unroll
        for (int j = 0; j < 8; ++j) { const int i = tid + 256 * j; if (i < 62 * 32) *(LAS u32x4*)(T + (i >> 5) * 512 + (i & 31) * 16) = tv[j]; } }
      __syncthreads();
      { const float* cw = INP(I_CW) + (size_t)l * 31 * 256; const float* cb = INP(I_CB) + l * 256;
        const int cp = tid & 127, strip = tid >> 7; f32x2 wv[31];
#pragma unroll
        for (int j = 0; j < 31; ++j) wv[j] = *(const f32x2*)(cw + j * 256 + 2 * cp);
        const f32x2 bias = *(const f32x2*)(cb + 2 * cp);
#pragma unroll 1
        for (int hh = 0; hh < 2; ++hh) { const int rb = 16 * strip + 8 * hh; f32x2 acc[8];
#pragma unroll
            for (int r = 0; r < 8; ++r) acc[r] = bias;
#pragma unroll
            for (int i = 0; i < 38; ++i) { const unsigned xw = *(const LAS unsigned*)(T + (rb + i) * 512 + cp * 4); const f32x2 xx = {bflo(xw), bfhi(xw)};
#pragma unroll
                for (int r = 0; r < 8; ++r) { const int j = i - r; if (j >= 0 && j <= 30) acc[r] += wv[j] * xx; } }
#pragma unroll
            for (int r = 0; r < 8; ++r) *(LAS f32x2*)(Yt + (rb + r) * 256 + 2 * cp) = acc[r]; } }
      __syncthreads();
      { unsigned char* ws2 = WSP(); int tid2 = F.tid; LAUNDER_V(tid2); const int lane = tid2 & 63;
        bf16* BP = (bf16*)(ws2 + WS_X3) + 256; const float* lng = INP(I_LNG) + l * 256; const float* lnb = INP(I_LNB) + l * 256;
        const f32x4 gg = *(const f32x4*)(lng + 4 * lane), bb = *(const f32x4*)(lnb + 4 * lane);
#pragma unroll
        for (int i8 = 0; i8 < 8; ++i8) { const int rr = hwave + 4 * i8; if (rr >= nrows) continue; const f32x4 v = *(const LAS f32x4*)(Yt + rr * 256 + 4 * lane);
          const float mean = wave_sum(v[0] + v[1] + v[2] + v[3]) * (1.0f / 256.0f); const f32x4 dv = v - mean;
          const float var = wave_sum(dv[0] * dv[0] + dv[1] * dv[1] + dv[2] * dv[2] + dv[3] * dv[3]) * (1.0f / 256.0f); const float rs = rsqrtf(var + EPS);
          f32x4 o = dv * rs * gg + bb;
#pragma unroll
          for (int j = 0; j < 4; ++j) o[j] = o[j] * sigmoidf_(o[j]);
          u32x2 w; w.x = pk2(o[0], o[1]); w.y = pk2(o[2], o[3]); if (row0 + rr < TR) *(u32x2*)(BP + (size_t)(row0 + rr) * 1024 + 4 * lane) = w; } }
      __syncthreads(); }
}
constexpr int AT_FL = 0, AT_K = 34816, AT_VT = AT_K + 8192, AT_SC = AT_VT + 8192;
__device__ __forceinline__ void attn_scan(Frame& F, int b, int h, bool meta_only, int fl_off, int sc_off) {
    LAS float* Fl = (LAS float*)(F.lds + fl_off); LAS float* sc = (LAS float*)(F.lds + sc_off);
    const float* LFT = (const float*)(WSP() + WS_LFT); const float* LFTM = (const float*)(WSP() + WS_LFTM);
    const int tid = F.tid, lane = F.lane, wave = F.wave;
    __syncthreads();
    if (tid == 0) { float s = 0.f; for (int m = 0; m < 64; ++m) { if (m < NMETA) { s += LFTM[h * 256 + m]; Fl[m] = s * LOG2E; } else Fl[m] = 1e30f; if (m == NMETA - 1) sc[16] = s; } }
    if (meta_only) { for (int i = tid; i < 256; i += 512) Fl[64 + i] = 0.f; __syncthreads(); return; }
    float v[16]; const float* src = LFT + (size_t)(b * 8 + h) * SEQ + 16 * tid;
#pragma unroll
    for (int j = 0; j < 4; ++j) { const f32x4 q = *(const f32x4*)(src + 4 * j); v[4 * j] = q[0]; v[4 * j + 1] = q[1]; v[4 * j + 2] = q[2]; v[4 * j + 3] = q[3]; }
#pragma unroll
    for (int j = 1; j < 16; ++j) v[j] += v[j - 1];
    float incl = v[15];
#pragma unroll
    for (int o = 1; o < 64; o <<= 1) { const float up = __int_as_float(__builtin_amdgcn_ds_bpermute((lane - o) << 2, __float_as_int(incl))); if (lane >= o) incl += up; }
    if (lane == 63) sc[wave] = incl;
    __syncthreads();
    float off = sc[16];
    for (int w = 0; w < wave; ++w) off += sc[w];
    off += incl - v[15];
#pragma unroll
    for (int j = 0; j < 16; ++j) Fl[64 + 16 * tid + j] = (off + v[j]) * LOG2E;
    __syncthreads();
}
__device__ __forceinline__ void attn_unit_naive(Frame& F, int qrow0, int qpos0, int ntiles, int kvx0, int h, int nq) {
    const int tid = F.tid; const int hf = tid & 1; const bool live = (tid >> 1) < nq; const int r = live ? (tid >> 1) : 0;
    const bf16* Q = (const bf16*)(DOP() + DO_Q); const bf16* Kg = (const bf16*)(DOP() + DO_K); const bf16* Vg = (const bf16*)(DOP() + DO_V); bf16* O = (bf16*)(WSP() + WS_X3) + 512;
    LAS float* Fl = (LAS float*)(F.lds + AT_FL); LAS unsigned char* Ks = F.lds + AT_K; LAS bf16* VT = (LAS bf16*)(F.lds + AT_VT);
    const int grow = qrow0 + r, qpos = qpos0 + r;
    unsigned qp[16];
#pragma unroll
    for (int j = 0; j < 4; ++j) { const u32x4 w = *(const u32x4*)(Q + (size_t)grow * 512 + h * 64 + hf * 32 + 8 * j); qp[4 * j] = w.x; qp[4 * j + 1] = w.y; qp[4 * j + 2] = w.z; qp[4 * j + 3] = w.w; }
    const float Fq = Fl[qpos < NMETA ? qpos : qpos + 48];
    float mrun = -1e30f, lrun = 0.f, o[32];
#pragma unroll
    for (int d = 0; d < 32; ++d) o[d] = 0.f;
    const int lrow = tid >> 3, lch = tid & 7;

#pragma unroll 1
for (int i = 0; i < ntiles; ++i) {
        const int krow = (i == 0 ? TX : kvx0 + 64 * (i - 1)) + lrow;
        const u32x4 kw = *(const u32x4*)(Kg + (size_t)krow * 512 + h * 64 + lch * 8);
        const u32x4 vw = *(const u32x4*)(Vg + (size_t)krow * 512 + h * 64 + lch * 8);
        __syncthreads();
        *(LAS u32x4*)(Ks + lrow * 128 + lch * 16) = kw;
        { const unsigned vv[4] = {vw.x, vw.y, vw.z, vw.w};
#pragma unroll
          for (int e = 0; e < 4; ++e) { VT[(lch * 8 + 2 * e) * 64 + lrow] = (bf16)(vv[e] & 0xffffu); VT[(lch * 8 + 2 * e + 1) * 64 + lrow] = (bf16)(vv[e] >> 16); } }
        __syncthreads();
        const int kp0 = i == 0 ? 0 : NMETA + 64 * (i - 1);
        if (kp0 > qpos0 + 255) continue;
#pragma unroll 1
        for (int jg = 0; jg < 4; ++jg) {
            float s[16]; float gmax = -1e30f;
#pragma unroll
            for (int jj = 0; jj < 16; ++jj) { const int j = jg * 16 + jj; float d = 0.f;
#pragma unroll
                for (int c = 0; c < 4; ++c) { const u32x4 kk = *(const LAS u32x4*)(Ks + j * 128 + hf * 64 + c * 16);
                    d = dot2bf(kk.x, qp[4 * c], d); d = dot2bf(kk.y, qp[4 * c + 1], d); d = dot2bf(kk.z, qp[4 * c + 2], d); d = dot2bf(kk.w, qp[4 * c + 3], d); }
                d += lane_xor<1>(d);
                const bool valid = (i == 0 ? j < NMETA : true) && (kp0 + j <= qpos);
                s[jj] = valid ? d + Fq - Fl[64 * i + j] : -1e30f; gmax = fmaxf(gmax, s[jj]); }
            const float mn = fmaxf(mrun, gmax), alpha = exp2f(mrun - mn); mrun = mn;
            float ps = 0.f; unsigned pp[8];
#pragma unroll
            for (int jj = 0; jj < 16; jj += 2) { const float p0 = exp2f(s[jj] - mn), p1 = exp2f(s[jj + 1] - mn); ps += p0 + p1; pp[jj >> 1] = pk2(p0, p1); }
            lrun = lrun * alpha + ps;
#pragma unroll
            for (int d = 0; d < 32; ++d) { const u32x4 v0 = *(const LAS u32x4*)(VT + (hf * 32 + d) * 64 + jg * 16), v1 = *(const LAS u32x4*)(VT + (hf * 32 + d) * 64 + jg * 16 + 8);
                float a = o[d] * alpha; a = dot2bf(pp[0], v0.x, a); a = dot2bf(pp[1], v0.y, a); a = dot2bf(pp[2], v0.z, a); a = dot2bf(pp[3], v0.w, a);
                a = dot2bf(pp[4], v1.x, a); a = dot2bf(pp[5], v1.y, a); a = dot2bf(pp[6], v1.z, a); a = dot2bf(pp[7], v1.w, a); o[d] = a; }
        }
    }
    const float il = 1.0f / lrun;
    if (live)
#pragma unroll
    for (int j = 0; j < 4; ++j) { u32x4 w; w.x = pk2(o[8 * j] * il, o[8 * j + 1] * il); w.y = pk2(o[8 * j + 2] * il, o[8 * j + 3] * il); w.z = pk2(o[8 * j + 4] * il, o[8 * j + 5] * il); w.w = pk2(o[8 * j + 6] * il, o[8 * j + 7] * il);
        *(u32x4*)(O + (size_t)grow * 1024 + h * 64 + hf * 32 + 8 * j) = w; }
}
namespace fa {
using bf16x8v = __attribute__((ext_vector_type(8))) short;
using s16x4 = __attribute__((ext_vector_type(4))) short;
using f32x16 = __attribute__((ext_vector_type(16))) float;
constexpr int DMA = 512, DMO = 1024;
constexpr int NW = 8, QBLK = 32, QB = 256, KVBLK = 64;
constexpr int NSLOT = 3, SLOTB = 8192;
constexpr int LDS_K = 0, LDS_V = NSLOT * SLOTB, LDS_WS = 2 * NSLOT * SLOTB, LDS_OST = LDS_WS + NW * 64 * 4, LDS_BYTES = LDS_OST + NW * 4096;
constexpr int LDS_FL = 84992;
constexpr int LDS_SCAN = LDS_FL + (64 + 8192) * 4;
static_assert(LDS_SCAN + 128 <= RING_BYTES, "attention LDS");
__device__ __forceinline__ int crow(int r, int hi) { return (r & 3) + 8 * (r >> 2) + 4 * hi; }
#define SBAR() __builtin_amdgcn_sched_barrier(0)
__device__ __forceinline__ void cmask(f32x16& p0, f32x16& p1, int jb, int qrel, int hi) {
    const float NEG = -INFINITY; int kb = 64 * jb + 4 * hi;
#pragma unroll
    for (int r = 0; r < 16; ++r) { int kv = kb + (r & 3) + 8 * (r >> 2); if (kv > qrel) p0[r] = NEG; if (kv + 32 > qrel) p1[r] = NEG; }
}
__device__ __forceinline__ void glds16(const void* gsrc, unsigned lds_dst) { unsigned keep;
    asm volatile("s_mov_b32 %0, m0\n\ts_mov_b32 m0, %2\n\ts_nop 0\n\tglobal_load_lds_dwordx4 %1, off\n\ts_mov_b32 m0, %0" : "=&s"(keep) : "v"(gsrc), "s"(lds_dst) : "memory"); }
__device__ __forceinline__ float max3f(float a, float b, float c) { float r; asm("v_max3_f32 %0, %1, %2, %3" : "=v"(r) : "v"(a), "v"(b), "v"(c)); return r; }
__device__ __forceinline__ float max2f(float a, float b) { float r; asm("v_max_f32_e32 %0, %1, %2" : "=v"(r) : "v"(a), "v"(b)); return r; }
__device__ __forceinline__ float fsub_s(float a, float b) { float r; asm("v_sub_f32_e32 %0, %1, %2" : "=v"(r) : "v"(a), "v"(b)); return r; }
typedef float f32x2_t __attribute__((ext_vector_type(2))); typedef __bf16 bf16x2_t __attribute__((ext_vector_type(2)));
__device__ __forceinline__ unsigned cvtpk_s(float lo, float hi) { f32x2_t v = {lo, hi}; bf16x2_t b = __builtin_convertvector(v, bf16x2_t); return __builtin_bit_cast(unsigned, b); }
#define WAIT_BAR(N) asm volatile("s_waitcnt vmcnt(" #N ") lgkmcnt(0)\n\ts_barrier" ::: "memory")
typedef __attribute__((address_space(3))) const char* lds_cptr;
typedef short v4i16_t __attribute__((ext_vector_type(4)));
__device__ __forceinline__ void cinit(f32x16& p0, f32x16& p1, const LAS float* fk, float a) {
#pragma unroll
    for (int g = 0; g < 4; ++g) { const f32x4 f0 = *(const LAS f32x4*)(fk + 8 * g), f1 = *(const LAS f32x4*)(fk + 32 + 8 * g);
#pragma unroll
        for (int i = 0; i < 4; ++i) { p0[4 * g + i] = a - f0[i]; p1[4 * g + i] = a - f1[i]; } }
}
__device__ __forceinline__ void qkt(f32x16& p0, f32x16& p1, const char* Kslot, const bf16x8v* qr, int r32, int hi) {
    const char* kb = Kslot + hi * 1024 + r32 * 16;
#pragma unroll
    for (int d0 = 0; d0 < 4; ++d0) {
        const bf16x8v b0 = *reinterpret_cast<const bf16x8v*>(kb + d0 * 2048);
        const bf16x8v b1 = *reinterpret_cast<const bf16x8v*>(kb + d0 * 2048 + 512);
        p0 = __builtin_amdgcn_mfma_f32_32x32x16_bf16(b0, qr[d0], p0, 0, 0, 0); p1 = __builtin_amdgcn_mfma_f32_32x32x16_bf16(b1, qr[d0], p1, 0, 0, 0); }
}
__device__ __forceinline__ void kload8(bf16x8v* kf, lds_cptr kp) {
    kf[0] = *(const LAS bf16x8v*)(kp);        kf[1] = *(const LAS bf16x8v*)(kp + 512);
    kf[2] = *(const LAS bf16x8v*)(kp + 2048); kf[3] = *(const LAS bf16x8v*)(kp + 2560);
    kf[4] = *(const LAS bf16x8v*)(kp + 4096); kf[5] = *(const LAS bf16x8v*)(kp + 4608);
    kf[6] = *(const LAS bf16x8v*)(kp + 6144); kf[7] = *(const LAS bf16x8v*)(kp + 6656);
}
__device__ __forceinline__ void kload2(bf16x8v* kf, lds_cptr kp, int j) { kf[2 * j] = *(const LAS bf16x8v*)(kp + j * 2048); kf[2 * j + 1] = *(const LAS bf16x8v*)(kp + j * 2048 + 512); }
__device__ __forceinline__ s16x4 vtr(lds_cptr p) { return __builtin_bit_cast(s16x4, __builtin_amdgcn_ds_read_tr16_b64_v4i16((LAS v4i16_t*)p)); }
__device__ __forceinline__ float rowmax(const f32x16& p0, const f32x16& p1) {
    float a = max3f(p0[0], p0[1], p1[0]), b = max3f(p0[2], p0[3], p1[1]); a = max3f(a, p1[2], p1[3]);
#pragma unroll
    for (int r = 4; r < 16; r += 4) { a = max3f(a, p0[r], p0[r + 1]); b = max3f(b, p0[r + 2], p0[r + 3]); a = max3f(a, p1[r], p1[r + 1]); b = max3f(b, p1[r + 2], p1[r + 3]); }
    const float m = max2f(a, b);
    auto rr = __builtin_amdgcn_permlane32_swap(__float_as_uint(m), __float_as_uint(m), false, false);
    return max2f(__uint_as_float(rr[0]), __uint_as_float(rr[1]));
}
__device__ __forceinline__ void pv(f32x16* o, int vb, bf16x8v pa0, bf16x8v pa1, bf16x8v pa2, bf16x8v pa3) {
#pragma unroll
    for (int d0 = 0; d0 < 2; ++d0) { s16x4 lo[4], hi[4];
#pragma unroll
        for (int ks = 0; ks < 4; ++ks) {
            asm volatile("ds_read_b64_tr_b16 %0,%1 offset:%c2" : "=&v"(lo[ks]) : "v"(vb), "i"(d0 * 4096 + ks * 1024) : "memory");
            asm volatile("ds_read_b64_tr_b16 %0,%1 offset:%c2" : "=&v"(hi[ks]) : "v"(vb), "i"(d0 * 4096 + ks * 1024 + 512) : "memory"); }
        asm volatile("s_waitcnt lgkmcnt(0)" ::: "memory"); SBAR();
#define PK(k) (bf16x8v){lo[k][0], lo[k][1], lo[k][2], lo[k][3], hi[k][0], hi[k][1], hi[k][2], hi[k][3]}
        o[d0] = __builtin_amdgcn_mfma_f32_32x32x16_bf16(pa0, PK(0), o[d0], 0, 0, 0);
        o[d0] = __builtin_amdgcn_mfma_f32_32x32x16_bf16(pa1, PK(1), o[d0], 0, 0, 0);
        o[d0] = __builtin_amdgcn_mfma_f32_32x32x16_bf16(pa2, PK(2), o[d0], 0, 0, 0);
        o[d0] = __builtin_amdgcn_mfma_f32_32x32x16_bf16(pa3, PK(3), o[d0], 0, 0, 0);
#undef PK
    }
}
template <int THRL> __device__ __forceinline__ void attn_unit(int b, int h, int qb, int tf, const bf16* Q, const bf16* __restrict__ K, const bf16* __restrict__ V, bf16* O, char* shm, int wid) {
    const int lane = lane_id_opaque(), r32 = lane & 31, hi = lane >> 5;
    const long rowbase = (long)b * SEQ; const int q0 = qb * QB;
    const bf16* Qw = Q + (rowbase + q0 + wid * QBLK) * DMA + h * 64;
    const bf16* Kh = K + rowbase * DMA + h * 64, *Vh = V + rowbase * DMA + h * 64;
    const bf16* Km = K + (long)TX * DMA + h * 64, *Vm = V + (long)TX * DMA + h * 64;
    const unsigned lds0 = (unsigned)(uintptr_t)shm;
    float* wsf = (float*)(shm + LDS_WS) + wid * 64;
    const bf16* ksrc = Kh + (long)lane * DMA + wid * 8;
    const bf16* vsrc = Vh + (long)(16 * (wid & 3) + (lane >> 2)) * DMA + (wid >> 2) * 32 + (lane & 3) * 8;
    const bf16* ksrcm = Km + (long)lane * DMA + wid * 8;
    const bf16* vsrcm = Vm + (long)(16 * (wid & 3) + (lane >> 2)) * DMA + (wid >> 2) * 32 + (lane & 3) * 8;
    const unsigned kdst = lds0 + LDS_K + wid * 1024, vdst = lds0 + LDS_V + wid * 1024;
#define DMA_K(t, slot) glds16(ksrc + (long)((t) - 1) * KVBLK * DMA, (unsigned)__builtin_amdgcn_readfirstlane(kdst + (slot)))
#define DMA_V(t, slot) glds16(vsrc + (long)((t) - 1) * KVBLK * DMA, (unsigned)__builtin_amdgcn_readfirstlane(vdst + (slot)))
    const int vb0 = (int)(lds0 + LDS_V) + ((lane >> 4) & 1) * 32 + (lane & 3) * 8 + (4 * hi + ((lane & 15) >> 2)) * 64;
    const char* Kbase = shm + LDS_K; bf16x8v kf[8];
    const lds_cptr shm3 = (lds_cptr)shm; const lds_cptr kp0 = shm3 + LDS_K + hi * 1024 + r32 * 16; const lds_cptr vp0 = shm3 + LDS_V + ((lane >> 4) & 1) * 32 + (lane & 3) * 8 + (4 * hi + ((lane & 15) >> 2)) * 64;
    const LAS float* Flp = (const LAS float*)(shm3 + LDS_FL) + 4 * hi;
    const int NT = 4 * qb + 5;
    glds16(tf == 0 ? ksrcm : ksrc + (long)(tf - 1) * KVBLK * DMA, (unsigned)__builtin_amdgcn_readfirstlane(kdst)); glds16(tf == 0 ? vsrcm : vsrc + (long)(tf - 1) * KVBLK * DMA, (unsigned)__builtin_amdgcn_readfirstlane(vdst)); DMA_K(tf + 1, SLOTB);
    bf16x8v qr[4];
#pragma unroll
    for (int d0 = 0; d0 < 4; ++d0) qr[d0] = *reinterpret_cast<const bf16x8v*>(&Qw[(long)r32 * DMA + d0 * 16 + hi * 8]);
    float aq = ((const LAS float*)(shm3 + LDS_FL))[64 + q0 + wid * QBLK + r32 - 64 * tf];
    float l_reg = 0.f; f32x16 o[2]; o[0] = f32x16{}; o[1] = f32x16{};
    const int qrel = wid * QBLK + r32;
#define CMASK(P0, P1, t) do { int jb_ = (t) - (NT - 4); if (jb_ >= 0) cmask(P0, P1, jb_, qrel, hi); } while (0)
    bool resc = false;
#define START(P0, P1) do { const float rm = rowmax(P0, P1); resc = false; \
    { const float dl = max2f(rm, 0.f); aq = fsub_s(aq, dl);        \
      _Pragma("unroll") for (int r = 0; r < 16; ++r) { P0[r] = fsub_s(P0[r], dl); P1[r] = fsub_s(P1[r], dl); } } \
    _Pragma("unroll") for (int r = 0; r < 16; ++r) P0[r] = __builtin_amdgcn_exp2f(P0[r]); } while (0)
#define RESC() do { if (resc) { asm volatile("s_waitcnt lgkmcnt(0)" ::: "memory"); \
      _Pragma("unroll") for (int d_ = 0; d_ < 2; ++d_) _Pragma("unroll") for (int r = 0; r < 16; ++r) o[d_][r] *= wsf[crow(r, hi)]; } } while (0)
    f32x16 pA0, pA1, pB0, pB1;
    int sl_prev = 0, sl_cur = 0, sl_next = SLOTB;
#define ROT() do { sl_prev = sl_cur; sl_cur = sl_next; sl_next = (sl_next == (NSLOT - 1) * SLOTB) ? 0 : sl_next + SLOTB; } while (0)
    DMA_K(tf + 2, 2 * SLOTB);
    cinit(pA0, pA1, Flp, aq);
    WAIT_BAR(3);
    qkt(pA0, pA1, Kbase, qr, r32, hi); asm volatile("s_nop 15\n\ts_nop 7" : "+v"(pA0), "+v"(pA1));
    START(pA0, pA1);
    _Pragma("unroll") for (int r = 0; r < 16; ++r) pA1[r] = __builtin_amdgcn_exp2f(pA1[r]);
    WAIT_BAR(0);
    DMA_K(tf + 3, 0); DMA_V(tf + 1, SLOTB);
    ROT();
    kload8(kf, kp0 + sl_cur);
    WAIT_BAR(2);
    s16x4 vlo[8], vhi[8]; u32x4 pw0, pw1, pw2, pw3;
#define PKW(P, B) cvtpk_s(P[B], P[B + 1])
#define PAF(k) __builtin_bit_cast(bf16x8v, pw##k)
#define VFR(i) (bf16x8v){vlo[i][0], vlo[i][1], vlo[i][2], vlo[i][3], vhi[i][0], vhi[i][1], vhi[i][2], vhi[i][3]}
#define PIN(x) asm volatile("" : "+v"(x))
#define MX3(a, b, c) __builtin_fmaxf(__builtin_fmaxf((a), (b)), (c))
#define GAPA(MF, A0, A1, A2, A3, W0, W1, PW) do { MF; sacc += A0; sacc += A1; sacc += A2; sacc += A3; PIN(sacc); W0; W1; PIN(PW); SBAR(); } while (0)
#define EX(v) __builtin_amdgcn_exp2f(v)
#define GAPB(MF, X, B) do { MF; X[B] = EX(X[B]); X[B + 1] = EX(X[B + 1]); X[B + 2] = EX(X[B + 2]); X[B + 3] = EX(X[B + 3]); PIN(X); SBAR(); } while (0)
#define VRD(i) do { vlo[i] = vtr(vp_ + (((i) >> 2) * 4096 + ((i) & 3) * 1024)); vhi[i] = vtr(vp_ + (((i) >> 2) * 4096 + ((i) & 3) * 1024 + 512)); } while (0)
#define KRD(G, j) do { if (G) { kload2(kf, kp0 + sl_next, j); SBAR(); } } while (0)
#define STEP(C0, C1, P0, P1, t, GK, GV, GL) do { SBAR(); \
    cinit(C0, C1, Flp + 64 * ((t) - tf), aq); SBAR(); \
    const lds_cptr vp_ = vp0 + sl_prev; \
    VRD(0); SBAR(); float sacc = (P0[0] + P0[1]); \
    GAPA(C0 = __builtin_amdgcn_mfma_f32_32x32x16_bf16(kf[0], qr[0], C0, 0, 0, 0), P0[2], P0[3], P0[4], P0[5],     pw0[0] = PKW(P0, 0), pw0[1] = PKW(P0, 2), pw0); \
    VRD(4); SBAR(); GAPA(C1 = __builtin_amdgcn_mfma_f32_32x32x16_bf16(kf[1], qr[0], C1, 0, 0, 0), P0[6], P0[7], P0[8], P0[9],     pw0[2] = PKW(P0, 4), pw0[3] = PKW(P0, 6), pw0); \
    VRD(1); SBAR(); GAPA(C0 = __builtin_amdgcn_mfma_f32_32x32x16_bf16(kf[2], qr[1], C0, 0, 0, 0),   P0[10], P0[11], P0[12], P0[13], pw1[0] = PKW(P0, 8), pw1[1] = PKW(P0, 10), pw1); \
    VRD(5); SBAR(); GAPA(C1 = __builtin_amdgcn_mfma_f32_32x32x16_bf16(kf[3], qr[1], C1, 0, 0, 0),   P0[14], P0[15], P1[0], P1[1],   pw1[2] = PKW(P0, 12), pw1[3] = PKW(P0, 14), pw1); \
    VRD(2); SBAR(); GAPA(C0 = __builtin_amdgcn_mfma_f32_32x32x16_bf16(kf[4], qr[2], C0, 0, 0, 0),   P1[2], P1[3], P1[4], P1[5],     pw2[0] = PKW(P1, 0), pw2[1] = PKW(P1, 2), pw2); \
    VRD(6); SBAR(); GAPA(C1 = __builtin_amdgcn_mfma_f32_32x32x16_bf16(kf[5], qr[2], C1, 0, 0, 0),   P1[6], P1[7], P1[8], P1[9],     pw2[2] = PKW(P1, 4), pw2[3] = PKW(P1, 6), pw2); \
    VRD(3); SBAR(); GAPA(C0 = __builtin_amdgcn_mfma_f32_32x32x16_bf16(kf[6], qr[3], C0, 0, 0, 0),   P1[10], P1[11], P1[12], P1[13], pw3[0] = PKW(P1, 8), pw3[1] = PKW(P1, 10), pw3); \
    VRD(7); SBAR(); GAPA(C1 = __builtin_amdgcn_mfma_f32_32x32x16_bf16(kf[7], qr[3], C1, 0, 0, 0),   P1[14], P1[15], 0.f, 0.f,       pw3[2] = PKW(P1, 12), pw3[3] = PKW(P1, 14), pw3); \
    l_reg += sacc; \
    if (GK) { DMA_K((t) + 3, sl_cur); } if (GV) { DMA_V((t) + 1, sl_next); } \
    CMASK(C0, C1, t); \
    { float a = MX3(C0[0], C0[1], C1[0]), b_ = MX3(C0[2], C0[3], C1[1]); a = MX3(a, C1[2], C1[3]); \
      _Pragma("unroll") for (int r = 4; r < 16; r += 4) { a = MX3(a, C0[r], C0[r + 1]); b_ = MX3(b_, C0[r + 2], C0[r + 3]); a = MX3(a, C1[r], C1[r + 1]); b_ = MX3(b_, C1[r + 2], C1[r + 3]); } \
      float rm = __builtin_fmaxf(a, b_); { auto rr = __builtin_amdgcn_permlane32_swap(__float_as_uint(rm), __float_as_uint(rm), false, false); rm = __builtin_fmaxf(__uint_as_float(rr[0]), __uint_as_float(rr[1])); } \
      resc = false; \
      if (__builtin_expect(__any(rm > (float)THRL), 0)) { const float dl = __builtin_fmaxf(rm, 0.f); aq -= dl; \
        _Pragma("unroll") for (int r = 0; r < 16; ++r) { C0[r] -= dl; C1[r] -= dl; } \
        const float f = __builtin_amdgcn_exp2f(-dl); l_reg *= f; if (hi == 0) wsf[r32] = f; resc = true; } } \
    SBAR(); \
    GAPB(o[0] = __builtin_amdgcn_mfma_f32_32x32x16_bf16(PAF(0), VFR(0), o[0], 0, 0, 0), C0, 0); \
    GAPB(o[1] = __builtin_amdgcn_mfma_f32_32x32x16_bf16(PAF(0), VFR(4), o[1], 0, 0, 0), C0, 4); \
    KRD(GL, 0); GAPB(o[0] = __builtin_amdgcn_mfma_f32_32x32x16_bf16(PAF(1), VFR(1), o[0], 0, 0, 0), C0, 8); \
    KRD(GL, 1); GAPB(o[1] = __builtin_amdgcn_mfma_f32_32x32x16_bf16(PAF(1), VFR(5), o[1], 0, 0, 0), C0, 12); \
    KRD(GL, 2); GAPB(o[0] = __builtin_amdgcn_mfma_f32_32x32x16_bf16(PAF(2), VFR(2), o[0], 0, 0, 0), C1, 0); \
    KRD(GL, 3); GAPB(o[1] = __builtin_amdgcn_mfma_f32_32x32x16_bf16(PAF(2), VFR(6), o[1], 0, 0, 0), C1, 4); \
    GAPB(o[0] = __builtin_amdgcn_mfma_f32_32x32x16_bf16(PAF(3), VFR(3), o[0], 0, 0, 0), C1, 8); \
    GAPB(o[1] = __builtin_amdgcn_mfma_f32_32x32x16_bf16(PAF(3), VFR(7), o[1], 0, 0, 0), C1, 12); \
    } while (0)
    int t = tf + 1;
#undef CMASK
#define CMASK(P0, P1, t) do { } while (0)
    for (; t + 5 < NT; t += 2) {
        STEP(pB0, pB1, pA0, pA1, t, true, true, true);     WAIT_BAR(2); RESC(); ROT();
        STEP(pA0, pA1, pB0, pB1, t + 1, true, true, true); WAIT_BAR(2); RESC(); ROT();
    }
#undef CMASK
#define CMASK(P0, P1, t) do { int jb_ = (t) - (NT - 4); if (jb_ >= 0) cmask(P0, P1, jb_, qrel, hi); } while (0)
#define ENDW(tt) do { if ((tt) + 3 < NT) { WAIT_BAR(2); } else if ((tt) + 2 < NT) { WAIT_BAR(1); } else { WAIT_BAR(0); } } while (0)
    for (; t + 1 < NT; t += 2) {
        STEP(pB0, pB1, pA0, pA1, t, (t + 3 < NT), (t + 1 < NT), (t + 1 < NT));         ENDW(t);     RESC(); ROT();
        STEP(pA0, pA1, pB0, pB1, t + 1, (t + 4 < NT), (t + 2 < NT), (t + 2 < NT));     ENDW(t + 1); RESC(); ROT();
    }
    { float sacc = pA0[0] + pA0[1]; _Pragma("unroll") for (int r = 2; r < 16; ++r) sacc += pA0[r]; _Pragma("unroll") for (int r = 0; r < 16; ++r) sacc += pA1[r]; l_reg += sacc;
      pw0 = (u32x4){PKW(pA0, 0), PKW(pA0, 2), PKW(pA0, 4), PKW(pA0, 6)}; pw1 = (u32x4){PKW(pA0, 8), PKW(pA0, 10), PKW(pA0, 12), PKW(pA0, 14)}; pw2 = (u32x4){PKW(pA1, 0), PKW(pA1, 2), PKW(pA1, 4), PKW(pA1, 6)}; pw3 = (u32x4){PKW(pA1, 8), PKW(pA1, 10), PKW(pA1, 12), PKW(pA1, 14)};
      SBAR(); pv(o, vb0 + sl_prev, PAF(0), PAF(1), PAF(2), PAF(3)); }
#undef PKW
#undef PAF
#undef VFR
#undef PIN
#undef MX3
#undef GAPA
#undef GAPB
#undef EX
#undef VRD
#undef KRD
#undef STEP
#undef ENDW
    { auto rr = __builtin_amdgcn_permlane32_swap(__float_as_uint(l_reg), __float_as_uint(l_reg), false, false); l_reg = __uint_as_float(rr[0]) + __uint_as_float(rr[1]); }
    if (hi == 0) wsf[32 + r32] = l_reg; asm volatile("s_waitcnt lgkmcnt(0)" ::: "memory");
    float rli[16];
#pragma unroll
    for (int r = 0; r < 16; ++r) rli[r] = __builtin_amdgcn_rcpf(wsf[32 + crow(r, hi)]);
    bf16* Ow = O + (rowbase + q0 + wid * QBLK) * DMO + h * 64;
    { bf16* stg = (bf16*)(shm + LDS_OST) + wid * 2048;
#pragma unroll
      for (int r = 0; r < 16; ++r) { const int orow = crow(r, hi);
#pragma unroll
          for (int d0 = 0; d0 < 2; ++d0) stg[orow * 64 + d0 * 32 + r32] = (bf16)f2bf(o[d0][r] * rli[r]); }
      asm volatile("s_waitcnt lgkmcnt(0)" ::: "memory");
#pragma unroll
      for (int i = 0; i < 4; ++i) { const int row = i * 8 + (lane >> 3), ch = lane & 7; const u32x4 v = *(const u32x4*)(stg + row * 64 + ch * 8); *(u32x4*)(Ow + (long)row * DMO + ch * 8) = v; } }
    asm volatile("s_waitcnt lgkmcnt(0)\n\ts_barrier" ::: "memory");
#undef DMA_K
#undef DMA_V
#undef CMASK
#undef START
#undef RESC
#undef ROT
}
#undef SBAR
#undef WAIT_BAR
}
__device__ __forceinline__ void phase_scan(Frame& F, int l) {
    if (F.G > 32 && F.vcu >= 32) norm_items(F, l, F.vcu - 32, F.G - 32); else if (F.G <= 32) norm_items(F, l, F.vcu, F.G);
#pragma unroll 1
    for (int bh = F.vcu; bh < 32; bh += F.G) {
        attn_scan(F, bh >> 3, bh & 7, false, fa::LDS_FL, fa::LDS_SCAN);
        const LAS float* Fl = (const LAS float*)(F.lds + fa::LDS_FL); float* FLg = (float*)(WSP() + WS_FL) + (size_t)bh * FLN;
#pragma unroll 1
        for (int i = F.tid; i < FLN / 4; i += 512) *(f32x4*)(FLg + 4 * i) = *(const LAS f32x4*)(Fl + 4 * i);
    }
    __syncthreads();
}
__device__ __forceinline__ void phase_B(Frame& F, int l) {
    LAS int* qs = (LAS int*)(F.lds + LC_QS);
    unsigned* ctl = (unsigned*)(WSP() + WS_CTL); unsigned* head = ctl + CW_AQ + l * 64; const unsigned* nrm = ctl + CW_NRM + l * 64;
    const float* FLg = (const float*)(WSP() + WS_FL);
#pragma unroll 1
    for (;;) {
        __syncthreads();
        if (F.tid == 0) { qs[0] = (int)atomicAdd(head, 1u); qs[1] = 0; }
        __syncthreads();
        const int u = __builtin_amdgcn_readfirstlane(qs[0]);
        if (u >= 1032) break;
        if (u < 1024) {
            const int qb = 31 - (u >> 5), bh = u & 31, b = bh >> 3, h = bh & 7, NT = 4 * qb + 5;
            const float kn = __uint_as_float(__hip_atomic_load(nrm + bh, __ATOMIC_RELAXED, __HIP_MEMORY_SCOPE_AGENT)), qn = __uint_as_float(__hip_atomic_load(nrm + 32 + bh, __ATOMIC_RELAXED, __HIP_MEMORY_SCOPE_AGENT));
            const float T = 36.0f + sqrtf(kn * qn);
            const float* FLb = FLg + (size_t)bh * FLN; const float Fq0 = FLb[64 + 256 * qb];
            { const int t = F.tid; const bool skip = (t <= NT - 5) && (FLb[t == 0 ? 15 : 64 * t + 63] > Fq0 + T);
              const int c = __builtin_popcountll(__ballot(skip)); if (F.lane == 0 && c) __hip_atomic_fetch_add(&qs[1], c, __ATOMIC_RELAXED, __HIP_MEMORY_SCOPE_WORKGROUP); }
            __syncthreads();
            int tf = __builtin_amdgcn_readfirstlane(qs[1]); if (((NT - tf) & 1) == 0) tf -= 1;
            { LAS float* Fl = (LAS float*)(F.lds + fa::LDS_FL); const int n4 = (NT - tf) * 16;
#pragma unroll 1
              for (int i = F.tid; i < n4; i += 512) *(LAS f32x4*)(Fl + 4 * i) = *(const f32x4*)(FLb + 64 * tf + 4 * i); }
            __syncthreads();
            unsigned char* dol = DOP();
            fa::attn_unit<8>(b, h, qb, tf, (const bf16*)(dol + DO_Q), (const bf16*)(dol + DO_K), (const bf16*)(dol + DO_V), (bf16*)(WSP() + WS_X3) + 512, (char*)F.lds, F.wave);
        } else {
            const int t_ = F.wave * 64 + lane_id_opaque(); F.tid = t_; F.lane = t_ & 63;
            attn_scan(F, 0, u - 1024, true, AT_FL, AT_SC); attn_unit_naive(F, TX, 0, 1, 0, u - 1024, NMETA);
        }
    }
    __syncthreads();
    { unsigned* head3 = ctl + CW_AQ + 48 + l * 64;
#pragma unroll 1
      for (;;) { __syncthreads(); if (F.tid == 0) qs[0] = (int)atomicAdd(head3, 1u); __syncthreads();
          const int it = __builtin_amdgcn_readfirstlane(qs[0]); if (it >= 513) break;
          { const int t_ = F.wave * 64 + lane_id_opaque(); F.tid = t_; F.lane = t_ & 63; }
          { const int i32 = 2 * it + (F.wave >> 2); s_item_poolconv(F, l, i32 < 1024 ? i32 : 1024); } } }
    { unsigned* head2 = ctl + CW_AQ + 32 + l * 64; LAS float* scr = (LAS float*)(F.lds + F.wave * 16384);
#pragma unroll 1
      for (;;) { __syncthreads(); if (F.tid == 0) qs[0] = (int)atomicAdd(head2, 1u); __syncthreads();
          const int c = __builtin_amdgcn_readfirstlane(qs[0]); if (c >= 768) break;
          convert_item(F, l, 3584 + 8 * c + F.wave, scr, lane_id_opaque()); } }
    __syncthreads();
}

__device__ __forceinline__ void class_tables(Frame& F, int l) {
    LAS int* base = (LAS int*)(F.lds + LC_BASE); LAS int* pcls = (LAS int*)(F.lds + LC_PCLS); LAS int* np = (LAS int*)(F.lds + LC_NP);
    const unsigned* gcnt = (const unsigned*)(WSP() + WS_CTL) + CW_GCNT + l * 64;
    __syncthreads();
    if (F.tid == 0) { int p = 0;
#pragma unroll 1
        for (int c = 0; c < NCLS; ++c) { base[c] = p * 256; int n = (int)__hip_atomic_load(gcnt + c, __ATOMIC_RELAXED, __HIP_MEMORY_SCOPE_AGENT); if (n > TR) n = TR; if (n < 0) n = 0; p += (n + 255) >> 8; }
        if (p > 160) p = 160; base[NCLS] = p * 256; np[0] = p; }
    __syncthreads();
    if (F.tid < 160) { const int mypos = F.tid * 256; int c = 0;
#pragma unroll 1
        for (int k = 1; k < NCLS; ++k) if (base[k] <= mypos) c = k;
        pcls[F.tid] = c; }
    __syncthreads();
}
template <int NG, int CH> __device__ __forceinline__ void e1_groups(Frame& F, int l, const int (&rowv)[NG], const int (&grpv)[NG], const LAS bf16* Rhi, const LAS bf16* Rlo, LAS int* rec, LAS int* lcnt,
                                                                   const float* reb, const float* rgb, int fr, int fq) {
    const float* hsrc[NG]; bf16* hbdst[NG]; const bf16* dsrc[NG];
#pragma unroll
    for (int g = 0; g < NG; ++g) { const int row = rowv[g];
        hsrc[g] = l == 0 ? (row < TX ? INP(I_X) + (size_t)row * D : INP(I_META) + (size_t)(row - TX) * D) : (const float*)(WSP() + WS_H) + (size_t)row * D;
        hbdst[g] = (bf16*)(WSP() + WS_HB) + (size_t)row * D; dsrc[g] = (const bf16*)(WSP() + WS_X3) + (size_t)row * D; }
    const LAS bf16* bh0 = Rhi + fr * RPITCH + 8 * fq; const LAS bf16* bl0 = Rlo + fr * RPITCH + 8 * fq;
    const LAS bf16* bh1 = Rhi + (16 + (fr & 3)) * RPITCH + 8 * fq; const LAS bf16* bl1 = Rlo + (16 + (fr & 3)) * RPITCH + 8 * fq;
    f32x4 acc0[NG], acc1[NG]; float ss[NG];
#pragma unroll
    for (int g = 0; g < NG; ++g) { acc0[g] = (f32x4){0.f, 0.f, 0.f, 0.f}; acc1[g] = acc0[g]; ss[g] = 0.f; }
    f32x4 ch0[NG][CH], ch1[NG][CH]; u32x4 cd[NG][CH];
#pragma unroll
    for (int g = 0; g < NG; ++g)
#pragma unroll
        for (int c = 0; c < CH; ++c) { const int k = 32 * c + 8 * fq; ch0[g][c] = *(const f32x4*)(hsrc[g] + k); ch1[g][c] = *(const f32x4*)(hsrc[g] + k + 4); cd[g][c] = *(const u32x4*)(dsrc[g] + k); }
#pragma unroll 1
    for (int s0 = 0; s0 < 32; s0 += CH) {
        f32x4 nh0[NG][CH], nh1[NG][CH]; u32x4 nd[NG][CH];
        if (s0 + CH < 32) {
#pragma unroll
            for (int g = 0; g < NG; ++g)
#pragma unroll
                for (int c = 0; c < CH; ++c) { const int k = 32 * (s0 + CH + c) + 8 * fq; nh0[g][c] = *(const f32x4*)(hsrc[g] + k); nh1[g][c] = *(const f32x4*)(hsrc[g] + k + 4); nd[g][c] = *(const u32x4*)(dsrc[g] + k); }
        }
#pragma unroll
        for (int c = 0; c < CH; ++c) { const int s = s0 + c, k = 32 * s + 8 * fq;
            const bf16x8 wh0 = *(const LAS bf16x8*)(bh0 + 32 * s), wl0 = *(const LAS bf16x8*)(bl0 + 32 * s);
            bf16x8 wh1 = *(const LAS bf16x8*)(bh1 + 32 * s), wl1 = *(const LAS bf16x8*)(bl1 + 32 * s);
            if (fr >= 4) { wh1 = (bf16x8){0, 0, 0, 0, 0, 0, 0, 0}; wl1 = wh1; }
#pragma unroll
            for (int g = 0; g < NG; ++g) { f32x4 h0 = ch0[g][c], h1 = ch1[g][c]; const u32x4 dv = cd[g][c];
                h0[0] += bflo(dv.x); h0[1] += bfhi(dv.x); h0[2] += bflo(dv.y); h0[3] += bfhi(dv.y); h1[0] += bflo(dv.z); h1[1] += bfhi(dv.z); h1[2] += bflo(dv.w); h1[3] += bfhi(dv.w);
                ss[g] += (h0[0] * h0[0] + h0[1] * h0[1]) + (h0[2] * h0[2] + h0[3] * h0[3]) + (h1[0] * h1[0] + h1[1] * h1[1]) + (h1[2] * h1[2] + h1[3] * h1[3]);
                const u32x4 hw = pack8(h0, h1); *(u32x4*)(hbdst[g] + k) = hw;
                f32x4 r0, r1; r0[0] = h0[0] - bflo(hw.x); r0[1] = h0[1] - bfhi(hw.x); r0[2] = h0[2] - bflo(hw.y); r0[3] = h0[3] - bfhi(hw.y);
                r1[0] = h1[0] - bflo(hw.z); r1[1] = h1[1] - bfhi(hw.z); r1[2] = h1[2] - bflo(hw.w); r1[3] = h1[3] - bfhi(hw.w);
                const u32x4 lw = pack8(r0, r1);
                const bf16x8 ah = __builtin_bit_cast(bf16x8, hw), al = __builtin_bit_cast(bf16x8, lw);
                acc0[g] = __builtin_amdgcn_mfma_f32_16x16x32_bf16(wh0, ah, acc0[g], 0, 0, 0); acc0[g] = __builtin_amdgcn_mfma_f32_16x16x32_bf16(wh0, al, acc0[g], 0, 0, 0); acc0[g] = __builtin_amdgcn_mfma_f32_16x16x32_bf16(wl0, ah, acc0[g], 0, 0, 0);
                acc1[g] = __builtin_amdgcn_mfma_f32_16x16x32_bf16(wh1, ah, acc1[g], 0, 0, 0); acc1[g] = __builtin_amdgcn_mfma_f32_16x16x32_bf16(wh1, al, acc1[g], 0, 0, 0); acc1[g] = __builtin_amdgcn_mfma_f32_16x16x32_bf16(wl1, ah, acc1[g], 0, 0, 0); } }
        if (s0 + CH < 32) {
#pragma unroll
            for (int g = 0; g < NG; ++g)
#pragma unroll
                for (int c = 0; c < CH; ++c) { ch0[g][c] = nh0[g][c]; ch1[g][c] = nh1[g][c]; cd[g][c] = nd[g][c]; }
        }
    }
#pragma unroll
    for (int g = 0; g < NG; ++g) {
        float sg = ss[g]; sg += lane_xor<16>(sg); sg += lane_xor<32>(sg);
        const float rstd2 = rsqrtf(sg * (1.0f / D) + EPS);
        float gl[4];
#pragma unroll
        for (int q = 0; q < 4; ++q) gl[q] = __int_as_float(__builtin_amdgcn_ds_bpermute(fr << 2, __float_as_int(acc1[g][q]))) * rstd2 + rgb[q];
        int gsel = 0; float gmax = gl[0];
#pragma unroll
        for (int q = 1; q < 4; ++q) if (gl[q] > gmax) { gmax = gl[q]; gsel = q; }
        float gsum = 0.f;
#pragma unroll
        for (int q = 0; q < 4; ++q) gsum += __expf(gl[q] - gmax);
        const float gwt = 1.0f / gsum;
        if (fq == gsel) {
            float el[4];
#pragma unroll
            for (int e = 0; e < 4; ++e) el[e] = acc0[g][e] * rstd2 + reb[gsel * 4 + e];
            int t1 = 0; float l1 = el[0];
#pragma unroll
            for (int e = 1; e < 4; ++e) if (el[e] > l1) { l1 = el[e]; t1 = e; }
            int t2 = -1; float l2 = -3.0e38f;
#pragma unroll
            for (int e = 0; e < 4; ++e) if (e != t1 && el[e] > l2) { l2 = el[e]; t2 = e; }
            const float w1 = 1.0f / (1.0f + __expf(l2 - l1)), w2 = 1.0f - w1;
            const int ea = min(t1, t2), eb = max(t1, t2); const float cA = gwt * (t1 == ea ? w1 : w2), cB = gwt * (t1 == ea ? w2 : w1);
            const int pr = ea == 0 ? eb - 1 : (ea == 1 ? eb + 1 : 5); int cls = gsel * 6 + pr; if (!(cls >= 0 && cls < NCLS)) cls = 0;
            const int rank = __hip_atomic_fetch_add(&lcnt[cls], 1, __ATOMIC_RELAXED, __HIP_MEMORY_SCOPE_WORKGROUP); const int rr = grpv[g] * 16 + fr;
            rec[rr * 5] = cls; rec[rr * 5 + 1] = rank; rec[rr * 5 + 2] = __float_as_int(cA); rec[rr * 5 + 3] = __float_as_int(cB); rec[rr * 5 + 4] = __float_as_int(rstd2);
        }
    }
}
__device__ __forceinline__ void phase_E1(Frame& F, int l) {
    LAS bf16* Rhi = (LAS bf16*)F.lds; LAS bf16* Rlo = Rhi + 20 * RPITCH;
    LAS int* rec = (LAS int*)(F.lds + 83968);
    LAS int* lcnt = (LAS int*)(F.lds + LC_CNT); LAS int* wgb = (LAS int*)(F.lds + LC_BASE);
    const float* rg = (const float*)(WSP() + WS_RG);
    const float* reb = INP(I_REB) + l * 16; const float* rgb = INP(I_RGB) + l * 4;
    unsigned* gcnt = (unsigned*)(WSP() + WS_CTL) + CW_GCNT + l * 64; int* route = (int*)(WSP() + WS_ROUTE);
    const int tid = F.tid, lane = F.lane, wave = F.wave, fr = lane & 15, fq = lane >> 4;
    { f32x4 rv[10];
#pragma unroll
      for (int j = 0; j < 10; ++j) rv[j] = *(const f32x4*)(rg + 4 * (tid + 512 * j));
#pragma unroll
      for (int j = 0; j < 10; ++j) { const int i = 4 * (tid + 512 * j), c = i >> 10, k = i & 1023; u32x2 hw, lw; float hf[4];
#pragma unroll
          for (int e = 0; e < 4; ++e) hf[e] = __builtin_bit_cast(float, (pk2(rv[j][e], 0.f) & 0xffffu) << 16);
          hw.x = pk2(rv[j][0], rv[j][1]); hw.y = pk2(rv[j][2], rv[j][3]); lw.x = pk2(rv[j][0] - hf[0], rv[j][1] - hf[1]); lw.y = pk2(rv[j][2] - hf[2], rv[j][3] - hf[3]);
          *(LAS u32x2*)(Rhi + c * RPITCH + k) = hw; *(LAS u32x2*)(Rlo + c * RPITCH + k) = lw; } }
    { int* TOK = (int*)(WSP() + WS_TOK);
#pragma unroll 1
      for (int p = F.vcu * 512 + tid; p < NPOSMAX; p += F.G * 512) TOK[p] = -1; }
#pragma unroll 1
    for (int wg = F.vcu; wg < 256; wg += F.G) {
        if (tid < NCLS) lcnt[tid] = 0;
        __syncthreads();
        const int ngrp = wg == 0 ? 9 : 8;
        if (wg == 0 && wave == 0) { const int rows2[2] = {fr, TX + fr}; const int grps2[2] = {0, 8}; e1_groups<2, 2>(F, l, rows2, grps2, Rhi, Rlo, rec, lcnt, reb, rgb, fr, fq); }
        else { const int rows1[1] = {wg * 128 + wave * 16 + fr}; const int grps1[1] = {wave}; e1_groups<1, 4>(F, l, rows1, grps1, Rhi, Rlo, rec, lcnt, reb, rgb, fr, fq); }
        __syncthreads();
        if (tid < NCLS) { const int n = lcnt[tid]; wgb[tid] = n > 0 ? (int)atomicAdd(gcnt + tid, (unsigned)n) : 0; }
        __syncthreads();
        const int nrw = ngrp * 16;
        for (int rr = tid; rr < nrw; rr += 512) { const int row = rr < 128 ? wg * 128 + rr : TX + (rr - 128); const int cls = rec[rr * 5];
            int* rp = route + (size_t)row * 8; rp[0] = cls; rp[1] = wgb[cls] + rec[rr * 5 + 1]; rp[2] = rec[rr * 5 + 2]; rp[3] = rec[rr * 5 + 3]; rp[4] = rec[rr * 5 + 4]; }
        __syncthreads();
    }
}
__device__ __forceinline__ void phase_E1b(Frame& F, int l) {
    class_tables(F, l);
    const LAS int* base = (const LAS int*)(F.lds + LC_BASE);
    const int* route = (const int*)(WSP() + WS_ROUTE); int* TOK = (int*)(WSP() + WS_TOK); float* PW = (float*)(WSP() + WS_PW);
#pragma unroll 1
    for (int row = F.vcu * 512 + F.tid; row < TR; row += F.G * 512) { const int* rp = route + (size_t)row * 8; const int pos = base[rp[0]] + rp[1];
        if (pos < 0 || pos >= NPOSMAX) continue;
        TOK[pos] = row; f32x4 w; w[0] = __int_as_float(rp[4]); w[1] = __int_as_float(rp[2]); w[2] = __int_as_float(rp[3]); w[3] = 0.f; *(f32x4*)(PW + (size_t)pos * 4) = w; }
}
__device__ __forceinline__ void phase_E4(Frame& F, int l) {
    class_tables(F, l);
    const LAS int* base = (const LAS int*)(F.lds + LC_BASE);
    const int* route = (const int*)(WSP() + WS_ROUTE); float* H = (float*)(WSP() + WS_H); bf16* HB = (bf16*)(WSP() + WS_HB); const bf16* Y = (const bf16*)(WSP() + WS_Y);
    float* rstd1 = (float*)(WSP() + WS_RSTD1); const float* fg = INP(I_FG); float* out = (float*)DOP(); const bf16* DL = (const bf16*)(WSP() + WS_X3);
    const int gw = F.vcu * NWAVES + F.wave, NGW = F.G * NWAVES, lane = F.lane; const bool lastl = (l == DEPTH - 1);
    constexpr int R = 4;
#pragma unroll 1
    for (int row0 = gw; row0 < TR; row0 += R * NGW) {
        int rowv[R], pos[R];
#pragma unroll
        for (int r = 0; r < R; ++r) { const int row = row0 + r * NGW; rowv[r] = row < TR ? row : TR - 1; const int* rp = route + (size_t)rowv[r] * 8; int p = base[rp[0]] + rp[1]; if (p < 0 || p >= NPOSMAX) p = 0; pos[r] = p; }
        u32x4 yw[R][2], dw[R][2]; f32x4 hv[R][2][2];
#pragma unroll
        for (int r = 0; r < R; ++r)
#pragma unroll
            for (int j = 0; j < 2; ++j) { yw[r][j] = *(const u32x4*)(Y + (size_t)pos[r] * D + 8 * lane + 512 * j);
                const float* hs = l == 0 ? (rowv[r] < TX ? INP(I_X) + (size_t)rowv[r] * D : INP(I_META) + (size_t)(rowv[r] - TX) * D) : H + (size_t)rowv[r] * D;
                hv[r][j][0] = *(const f32x4*)(hs + 8 * lane + 512 * j); hv[r][j][1] = *(const f32x4*)(hs + 8 * lane + 512 * j + 4); dw[r][j] = *(const u32x4*)(DL + (size_t)rowv[r] * D + 8 * lane + 512 * j); }
#pragma unroll
        for (int r = 0; r < R; ++r) { const int row = row0 + r * NGW; float ss = 0.f;
#pragma unroll
            for (int j = 0; j < 2; ++j) { const u32x4 w = yw[r][j], d4 = dw[r][j];
                hv[r][j][0][0] += bflo(d4.x); hv[r][j][0][1] += bfhi(d4.x); hv[r][j][0][2] += bflo(d4.y); hv[r][j][0][3] += bfhi(d4.y); hv[r][j][1][0] += bflo(d4.z); hv[r][j][1][1] += bfhi(d4.z); hv[r][j][1][2] += bflo(d4.w); hv[r][j][1][3] += bfhi(d4.w);
                hv[r][j][0][0] += bflo(w.x); hv[r][j][0][1] += bfhi(w.x); hv[r][j][0][2] += bflo(w.y); hv[r][j][0][3] += bfhi(w.y);
                hv[r][j][1][0] += bflo(w.z); hv[r][j][1][1] += bfhi(w.z); hv[r][j][1][2] += bflo(w.w); hv[r][j][1][3] += bfhi(w.w);
#pragma unroll
                for (int q = 0; q < 2; ++q) ss += hv[r][j][q][0] * hv[r][j][q][0] + hv[r][j][q][1] * hv[r][j][q][1] + hv[r][j][q][2] * hv[r][j][q][2] + hv[r][j][q][3] * hv[r][j][q][3]; }
            const float rs = rsqrtf(wave_sum(ss) * (1.0f / D) + EPS);
            if (row < TR) {
                if (!lastl) {
#pragma unroll
                    for (int j = 0; j < 2; ++j) { *(f32x4*)(H + (size_t)row * D + 8 * lane + 512 * j) = hv[r][j][0]; *(f32x4*)(H + (size_t)row * D + 8 * lane + 512 * j + 4) = hv[r][j][1];
                        *(u32x4*)(HB + (size_t)row * D + 8 * lane + 512 * j) = pack8(hv[r][j][0], hv[r][j][1]); }
                    if (lane == 0) rstd1[row] = rs;
                } else if (row < TX) {
#pragma unroll
                    for (int j = 0; j < 2; ++j) { const f32x4 g0 = *(const f32x4*)(fg + 8 * lane + 512 * j), g1 = *(const f32x4*)(fg + 8 * lane + 512 * j + 4);
                        *(f32x4*)(out + (size_t)row * D + 8 * lane + 512 * j) = hv[r][j][0] * rs * g0; *(f32x4*)(out + (size_t)row * D + 8 * lane + 512 * j + 4) = hv[r][j][1] * rs * g1; }
                }
            }
        }
    }
}
#define RELANE() do { const int t_ = wv0 * 64 + lane_id_opaque(); F.tid = t_; F.lane = t_ & 63; F.wave = __builtin_amdgcn_readfirstlane(t_ >> 6); \
    int g_ = gridDim.x; LAUNDER_S(g_); int b_ = blockIdx.x; LAUNDER_S(b_); F.G = g_; F.bx = b_; F.vcu = (g_ % 8 == 0) ? (b_ % 8) * (g_ / 8) + b_ / 8 : b_; ll = l; LAUNDER_S(ll); } while (0)
__global__ void __launch_bounds__(NWAVES * 64, 2) fwd_kernel(Params P) {
    extern __shared__ __attribute__((aligned(16))) unsigned char lds_raw[];
    Frame F;
    F.lds = (LAS unsigned char*)lds_raw;
    F.tid = threadIdx.x; F.lane = F.tid & 63; F.wave = __builtin_amdgcn_readfirstlane(F.tid >> 6);
    F.G = gridDim.x; { const int bx = blockIdx.x; F.vcu = (F.G % 8 == 0) ? (bx % 8) * (F.G / 8) + bx / 8 : bx; }
    if (F.tid == 0) { LAS unsigned long long* pt = (LAS unsigned long long*)(F.lds + LC_PTAB);
#pragma unroll
        for (int i = 0; i < 25; ++i) pt[i] = (unsigned long long)P.in[i];
        pt[25] = (unsigned long long)P.ws; pt[26] = (unsigned long long)P.out; }
    for (int u = F.tid; u < 256; u += NWAVES * 64) ((LAS unsigned*)(F.lds + RING_BYTES))[u] = 0u;
    __syncthreads();
    const int lo = P.ph_lo, hi = P.ph_hi;
    const bool use_bar = (hi - lo) > 1;
    unsigned* barw = (unsigned*)(P.ws + WS_CTL) + CW_BAR;
    XcdBarrier bar; bar.bar = barw; bar.x = 0; bar.st = (volatile LAS unsigned*)(F.lds + LC_BAR);
    if (use_bar) bar = xcd_barrier_post(barw, (volatile LAS unsigned*)(F.lds + LC_BAR));
#ifndef PHASE_MASK
#define PHASE_MASK 0xfff
#endif
#define EN(j) (((PHASE_MASK) >> (j)) & 1)
#ifndef DUP_MASK
#define DUP_MASK 0
#endif
#define NREP(j) ((((DUP_MASK) >> (j)) & 1) ? 2 : 1)
#define IN(k) (lo <= (k) && (k) < hi)
#define SEAM(k) do { if (IN(k) && IN((k) + 1)) xcd_barrier(bar); } while (0)

    int l = 0, ll = 0; const int wv0 = __builtin_amdgcn_readfirstlane((int)threadIdx.x >> 6);
    if (EN(0) && IN(0)) { RELANE(); convert_weights(F, 0); RELANE(); init_rows(F); }
    SEAM(0);
    for (l = 0; l < DEPTH; ++l) {
        const int pb = 1 + 11 * l;
        for (int rep = 0; rep < NREP(1); ++rep)
        if (EN(1) && IN(pb + 0)) {
            RELANE();
            unsigned char* wsl = WSP(); unsigned char* dol = DOP();
            pg8::Gemm g{(const bf16*)(wsl + WS_HB), 1024, 1024, 1 << 20};
            pg8::StaticOrder S; S.init(TX, N1, F.G, F.bx, (const bf16*)(wsl + WS_W1T), 1024);
            Epi1 E{(const float*)(wsl + WS_RSTD1), (bf16*)(wsl + WS_A), (bf16*)(wsl + WS_GLU), (bf16*)(dol + DO_Q), (bf16*)(wsl + WS_G)};
            pg8::gemm_phase<Epi1, pg8::StaticOrder>(F.lds, g, S, E, F.wave);
            if (F.bx >= 128 && F.bx < 128 + 21 && F.wave < 4) {
                const int pn = F.bx - 128, l2 = lane_id_opaque(); AccT acc; skinny_zero(acc);
                skinny_k<true>(acc, (const bf16*)(wsl + WS_HB) + (size_t)TX * 1024, 1024, (const bf16*)(wsl + WS_W1T) + (size_t)pn * 256 * 1024, 1024, 1024, F.wave, l2 & 15, l2 >> 4);
                E.run<true>(acc, pg8::Unit{128, pn, 0}, 0, F.wave, l2 & 15, l2 >> 4);
            }
            { RELANE(); LAS int* qs = (LAS int*)(F.lds + LC_QS); unsigned* head4 = (unsigned*)(WSP() + WS_CTL) + CW_AQ + 16 + ll * 64;
#pragma unroll 1
              for (;;) { __syncthreads(); if (F.tid == 0) qs[0] = (int)atomicAdd(head4, 1u); __syncthreads();
                  const int it = __builtin_amdgcn_readfirstlane(qs[0]); if (it >= 513) break;
                  { const int t_ = F.wave * 64 + lane_id_opaque(); F.tid = t_; F.lane = t_ & 63; }
                  s_item_logf(F, ll, it); } }
        }
        SEAM(pb + 0);
        if (EN(3) && IN(pb + 2)) { RELANE(); phase_scan(F, ll); }
        SEAM(pb + 2);
        for (int rep = 0; rep < NREP(3); ++rep)
        if (EN(4) && IN(pb + 3)) { RELANE(); phase_B(F, ll); }
        SEAM(pb + 3);
        for (int rep = 0; rep < NREP(4); ++rep)
        if (EN(5) && IN(pb + 4)) {
            RELANE(); unsigned char* wsl = WSP(); unsigned char* dol = DOP();
            pg8::Gemm g{(const bf16*)(wsl + WS_X3), 1024, 1024, 1 << 20}; pg8::SegOrder S; S.init(TX, 1024, F.G, F.bx, (const bf16*)(wsl + WS_W3CT), 1024);
            EpiCS E{(const bf16*)(wsl + WS_G), (bf16*)(dol + DO_MERGED), (const float*)(wsl + WS_BIASA)}; pg8::gemm_phase<EpiCS, pg8::SegOrder>(F.lds, g, S, E, F.wave);
            if (F.bx >= 16 && F.bx < 20) {
                const int pn = F.bx - 16, l2 = lane_id_opaque(), kh = F.wave >> 2, wc4 = F.wave & 3; AccT acc; skinny_zero(acc);
#pragma unroll 1
                for (int seg = 0; seg < 3; ++seg) { const int Ks = seg == 2 ? 512 : 256; const size_t ko = (seg == 0 ? 0 : (seg == 1 ? 256 : 512)) + (size_t)kh * (Ks / 2);
                    if (kh == 1) skinny_zero(acc);
                    skinny_k<true>(acc, (const bf16*)(wsl + WS_X3) + (size_t)TX * 1024 + ko, 1024, (const bf16*)(wsl + WS_W3CT) + (size_t)pn * 256 * 1024 + ko, 1024, Ks / 2, wc4, l2 & 15, l2 >> 4);
                    skinny_combine(acc, F.lds, F.wave, l2);
                    if (kh == 0) E.run<true>(acc, pg8::Unit{128, pn, seg}, 0, wc4, l2 & 15, l2 >> 4); }
            }
        }
        SEAM(pb + 4);
        if (EN(6) && IN(pb + 5)) {
            RELANE();
            unsigned char* wsl = WSP(); unsigned char* dol = DOP();
            pg8::Gemm g{(const bf16*)(dol + DO_MERGED), 1024, 1024, 1 << 20}; pg8::StaticOrder S; S.init(TX, 1024, F.G, F.bx, (const bf16*)(wsl + WS_WOT), 1024);
            EpiB2 E{(bf16*)(wsl + WS_X3)}; pg8::gemm_phase<EpiB2, pg8::StaticOrder>(F.lds, g, S, E, F.wave);
            if (F.bx >= 16 && F.bx < 20) {
                const int pn = F.bx - 16, l2 = lane_id_opaque(), kh = F.wave >> 2, wc4 = F.wave & 3; AccT acc; skinny_zero(acc);
                skinny_k<true>(acc, (const bf16*)(dol + DO_MERGED) + (size_t)TX * 1024 + kh * 512, 1024, (const bf16*)(wsl + WS_WOT) + (size_t)pn * 256 * 1024 + kh * 512, 1024, 512, wc4, l2 & 15, l2 >> 4);
                skinny_combine(acc, F.lds, F.wave, l2);
                if (kh == 0) E.run<true>(acc, pg8::Unit{128, pn, 0}, 0, wc4, l2 & 15, l2 >> 4);
            }
        }
        SEAM(pb + 5);
        if (EN(7) && IN(pb + 6)) { RELANE(); phase_E1(F, ll); }
        SEAM(pb + 6);
        for (int rep = 0; rep < NREP(7); ++rep)
        if (EN(8) && IN(pb + 7)) { RELANE(); phase_E1b(F, ll); }
        SEAM(pb + 7);
        for (int rep = 0; rep < NREP(8); ++rep)
        if (EN(9) && IN(pb + 8)) {
            RELANE(); class_tables(F, ll);
            unsigned char* wsl = WSP();
            const int NP = __builtin_amdgcn_readfirstlane(*(const LAS int*)(F.lds + LC_NP));
            pg8::Gemm g{(const bf16*)(wsl + WS_XS), 1024, 1024, 1 << 20};
            { const int* TOK = (const int*)(wsl + WS_TOK); LAS int* tl = (LAS int*)(F.lds + LC_TOK);
#pragma unroll 1
              for (int i = F.tid; i < 1024; i += 512) { const long L = (long)(i >> 8) * F.G + F.vcu; int tk = 0; if (L < (long)NP * 4) { tk = TOK[(int)(L >> 2) * 256 + (i & 255)]; if (tk < 0 || tk >= TR) tk = 0; } tl[i] = tk; }
              __syncthreads(); }
            pg8::Gemm g2{(const bf16*)(wsl + WS_HB), 1024, 1024, 1 << 20};
            MoeOrderT<true> S{(const LAS int*)(F.lds + LC_TOK), NP, F.G, F.vcu, 0, (const LAS int*)(F.lds + LC_PCLS), (const bf16*)(DOP() + DO_W13T)};
            EpiA2 E{(const float*)(wsl + WS_PW), (bf16*)(wsl + WS_HH)}; pg8::gemm_phase<EpiA2, MoeOrderT<true>>(F.lds, g2, S, E, F.wave);
        }
        SEAM(pb + 8);
        for (int rep = 0; rep < NREP(9); ++rep)
        if (EN(10) && IN(pb + 9)) {
            RELANE(); class_tables(F, ll);
            unsigned char* wsl = WSP();
            const int NP = __builtin_amdgcn_readfirstlane(*(const LAS int*)(F.lds + LC_NP));
            pg8::Gemm g{(const bf16*)(wsl + WS_HH), 512, 256, 4};
            MoeOrderT<false> S{nullptr, NP, F.G, F.vcu, 1, (const LAS int*)(F.lds + LC_PCLS), (const bf16*)(DOP() + DO_W2T)};
            EpiB2 E{(bf16*)(wsl + WS_Y)}; pg8::gemm_phase<EpiB2, MoeOrderT<false>>(F.lds, g, S, E, F.wave);
        }
        SEAM(pb + 9);
        if (EN(11) && IN(pb + 10)) { RELANE(); phase_E4(F, ll); if (l + 1 < DEPTH) { RELANE(); convert_weights(F, ll + 1); } }
        SEAM(pb + 10);
    }
#undef IN
#undef SEAM
}

constexpr int N_PHASES = 1 + 11 * DEPTH;

extern "C" void kernel_launch(void* const* d_in, const int* in_sizes, int n_in, void* d_out, int out_size, void* d_ws, size_t ws_size, hipStream_t stream) {
    static int grid = 0;
    if (grid == 0) {
        if (n_in != 25 || out_size != TX * D || ws_size < WS_END) { fprintf(stderr, "kernel_launch: unexpected shapes: n_in %d out %d ws %zu (need %zu)\n", n_in, out_size, ws_size, (size_t)WS_END); grid = -1; return; }
        int dev = 0, cus = 0, per_cu = 0;
        if (hipGetDevice(&dev) != hipSuccess || hipDeviceGetAttribute(&cus, hipDeviceAttributeMultiprocessorCount, dev) != hipSuccess) { grid = -1; return; }
        if (hipFuncSetAttribute((const void*)fwd_kernel, hipFuncAttributeMaxDynamicSharedMemorySize, LDS_BYTES) != hipSuccess) { fprintf(stderr, "kernel_launch: hipFuncSetAttribute failed\n"); grid = -1; return; }
        if (hipOccupancyMaxActiveBlocksPerMultiprocessor(&per_cu, (const void*)fwd_kernel, NWAVES * 64, LDS_BYTES) != hipSuccess || per_cu < 1) fprintf(stderr, "kernel_launch: occupancy query reports %d\n", per_cu);
        (void)hipGetLastError();
        grid = cus;
    }
    if (grid < 0) return;
    (void)hipMemsetAsync((char*)d_ws + WS_CTL, 0, CTL_BYTES, stream);
    Params p{};
    for (int i = 0; i < 25; ++i) p.in[i] = (const float*)d_in[i];
    p.out = (float*)d_out; p.ws = (unsigned char*)d_ws;
#if N_LAUNCH_MODE == 1
    p.ph_lo = 0; p.ph_hi = N_PHASES;
    hipLaunchKernelGGL(fwd_kernel, dim3(grid), dim3(NWAVES * 64), LDS_BYTES, stream, p);
#else
    for (int ph = 0; ph < N_PHASES; ++ph) { p.ph_lo = ph; p.ph_hi = ph + 1; hipLaunchKernelGGL(fwd_kernel, dim3(grid), dim3(NWAVES * 64), LDS_BYTES, stream, p); }
#endif
}
```

```cpp
#include <hip/hip_runtime.h>
#include <cstdio>
#include <cstdint>

#ifndef N_LAUNCH_MODE
#define N_LAUNCH_MODE 1
#endif

#define GAS __attribute__((address_space(1)))
#define LAS __attribute__((address_space(3)))
typedef unsigned short bf16;
typedef float f32x4 __attribute__((ext_vector_type(4)));
typedef float f32x2 __attribute__((ext_vector_type(2)));
typedef unsigned u32x4 __attribute__((ext_vector_type(4)));
typedef unsigned u32x2 __attribute__((ext_vector_type(2)));
typedef short bf16x8 __attribute__((ext_vector_type(8)));
typedef __bf16 bf16x2v __attribute__((ext_vector_type(2)));

constexpr int D = 1024, NB = 4, SEQ = 8192, NMETA = 16, DEPTH = 2;
constexpr int TX = NB * SEQ;
constexpr int TM = TX + 64;
constexpr int TR = TX + NMETA;
constexpr int NIN = 5384, N1 = 5376;
constexpr int NHEAD = 8;
constexpr int NCLS = 24;
constexpr int NPOSMAX = TX + 256 + NCLS * 256;
constexpr float EPS = 1e-6f;
constexpr float LOG2E = 1.4426950408889634f;
constexpr float C2 = 0.125f * LOG2E;
constexpr int NWAVES = 8;

constexpr size_t U = (size_t)TM * 1024 * 2;
constexpr size_t WS_CTL = 0, CTL_BYTES = 128u << 10;
constexpr size_t WS_H = CTL_BYTES;
constexpr size_t WS_HB = WS_H + 2 * U;
constexpr size_t WS_G = WS_HB + U;
constexpr size_t WS_XS = WS_G;
constexpr size_t WS_Y = WS_XS + (size_t)NPOSMAX * 2048;
constexpr size_t WS_HH = WS_Y + (size_t)NPOSMAX * 2048;
static_assert(WS_HH + (size_t)NPOSMAX * 1024 <= WS_G + (size_t)3 * 129 * 4 * 65536 * 2, "MoE overlay fits the gates region");
constexpr size_t GT_TILE = 65536;
constexpr size_t WS_A = WS_G + (size_t)3 * 129 * 4 * GT_TILE * 2;
constexpr size_t WS_GLU = WS_A + U / 4;
constexpr size_t WS_X3 = WS_GLU + U / 4;
constexpr size_t WS_W1T = WS_X3 + U;
constexpr size_t WS_W3CT = WS_W1T + (size_t)N1 * 1024 * 2;
constexpr size_t WS_WOT = WS_W3CT + 1024 * 1024 * 2;
constexpr size_t WS_WFG = WS_WOT + 1024 * 1024 * 2;
constexpr size_t WS_RG = WS_WFG + 8 * 1024 * 4;
constexpr size_t WS_BIASA = WS_RG + 20 * 1024 * 4;
constexpr size_t WS_RSTD1 = WS_BIASA + 4096;
constexpr size_t WS_ROUTE = WS_RSTD1 + (size_t)TM * 4;
constexpr size_t WS_PW = WS_ROUTE + (size_t)TM * 32;
constexpr size_t WS_LFT = WS_PW + (size_t)NPOSMAX * 16;
constexpr size_t WS_LFTM = WS_LFT + (size_t)32 * 8192 * 4;
constexpr size_t WS_TOK = WS_LFTM + 8 * 256 * 4;
constexpr size_t WS_FL = WS_TOK + (size_t)NPOSMAX * 4;
constexpr int FLN = 64 + SEQ;
constexpr size_t WS_END = WS_FL + (size_t)32 * FLN * 4;
static_assert(WS_END <= (size_t)512 * 1024 * 1024, "d_ws map fits 512 MiB");
constexpr size_t DO_Q = 0, DO_K = U / 2, DO_V = U, DO_MERGED = U / 2;
constexpr size_t DO_W13T = 3 * U / 2;
constexpr size_t DO_W2T = DO_W13T + (size_t)16 * 512 * 1024 * 2;
static_assert(DO_W2T + (size_t)16 * 1024 * 256 * 2 <= (size_t)TX * 1024 * 4, "d_out scratch");
static_assert((24576 + 128) * 4 <= 128 * 1024, "control words inside the memset");
constexpr int CW_BAR = 4096, CW_GCNT = 16384, CW_NRM = 20480  , CW_AQ = 24576  ;

constexpr int RPITCH = 1032;
constexpr int RING_BYTES = 131072;
constexpr int LC_BAR = RING_BYTES, LC_CNT = RING_BYTES + 64, LC_BASE = RING_BYTES + 192, LC_PCLS = RING_BYTES + 320, LC_NP = RING_BYTES + 960;
constexpr int LC_QS = RING_BYTES + 976;
constexpr int LC_TOK = RING_BYTES + 2048;
constexpr int LC_NMX = RING_BYTES + 1280;
constexpr int LC_PTAB = RING_BYTES + 1024;
constexpr int LDS_BYTES = RING_BYTES + 1024 + 7168;

#define LDS_WAIT() asm volatile("s_waitcnt lgkmcnt(0)" ::: "memory")
#define VM_WAIT() asm volatile("s_waitcnt vmcnt(0)" ::: "memory")
#define LAUNDER_S(p) asm volatile("" : "+s"(p))
#define LAUNDER_V(x) asm volatile("" : "+v"(x))
__device__ __forceinline__ int lane_id_opaque() { int x; asm volatile("v_mbcnt_lo_u32_b32 %0, -1, 0\n\tv_mbcnt_hi_u32_b32 %0, -1, %0" : "=v"(x)); return x; }

__device__ __forceinline__ unsigned f2bf(float f) { unsigned u = __builtin_bit_cast(unsigned, f); return (u + 0x7fffu + ((u >> 16) & 1u)) >> 16; }
__device__ __forceinline__ unsigned pk2(float lo, float hi) { f32x2 v = {lo, hi}; bf16x2v b = __builtin_convertvector(v, bf16x2v); return __builtin_bit_cast(unsigned, b); }
__device__ __forceinline__ float bflo(unsigned w) { return __builtin_bit_cast(float, w << 16); }
__device__ __forceinline__ float bfhi(unsigned w) { return __builtin_bit_cast(float, w & 0xffff0000u); }
template <int O> __device__ __forceinline__ float lane_xor(float v) {
    if constexpr (O < 32) return __int_as_float(__builtin_amdgcn_ds_swizzle(__float_as_int(v), (O << 10) | 0x1f));
    else { auto rr = __builtin_amdgcn_permlane32_swap(__float_as_uint(v), __float_as_uint(v), false, false); return __uint_as_float(rr[0]) + __uint_as_float(rr[1]) - v; }
}
__device__ __forceinline__ float wave_sum(float v) {
    v += lane_xor<1>(v); v += lane_xor<2>(v); v += lane_xor<4>(v); v += lane_xor<8>(v); v += lane_xor<16>(v);
    auto rr = __builtin_amdgcn_permlane32_swap(__float_as_uint(v), __float_as_uint(v), false, false);
    return __uint_as_float(rr[0]) + __uint_as_float(rr[1]);
}
__device__ __forceinline__ float sigmoidf_(float x) { return __builtin_amdgcn_rcpf(1.0f + __builtin_amdgcn_exp2f(-LOG2E * x)); }
__device__ __forceinline__ float dot2bf(unsigned a, unsigned b, float acc) { return __builtin_amdgcn_fdot2_f32_bf16(__builtin_bit_cast(bf16x2v, a), __builtin_bit_cast(bf16x2v, b), acc, false); }

namespace pg8 {
constexpr int BM = 256, BK = 64, HALF = 128, HTB = HALF * BK * 2, STAGE_BYTES = 8 * HTB, NXCD = 8, WGM = 4;
__host__ __device__ __forceinline__ int lds_byte(int r, int c) { const int st = (r >> 4) * 2 + (c >> 5), rr = r & 15, cc = c & 31, ob = rr * 64 + cc * 2; return st * 1024 + (ob ^ (((ob >> 9) & 1) << 5)); }
__host__ __device__ __forceinline__ void stage_rc(int b, int& R, int& C) { const int st = b / 1024, sb = b % 1024, swz = sb ^ (((sb >> 9) & 1) << 5); R = (st >> 1) * 16 + swz / 64; C = (st & 1) * 32 + (swz % 64) / 2; }
__host__ __device__ __forceinline__ int perm32(int rho) { const int n = rho >> 4, i = rho & 15; return 8 * (i >> 2) + 4 * n + (i & 3); }

struct Unit { int pm, pn, seg; };
struct Gemm { const bf16* A; int K; int ldb; int ksplit; };

struct StaticOrder {
    static constexpr bool GATHER = false; const LAS int* tokl = nullptr;
    int nM, nN, nwg, G, c; const bf16* Bt; size_t btile;
    __device__ void init(int M, int N, int G_, int c_, const bf16* Bt_, int ldb) { nM = M / BM; nN = N / BM; nwg = nM * nN; G = G_; c = c_; Bt = Bt_; btile = (size_t)BM * ldb * 2; }
    __device__ bool next(int i, Unit& u) const {
        const long L = (long)i * G + c; if (L >= nwg) return false;
        int wgid = (int)L; { const int q = nwg / NXCD, r = nwg % NXCD, xcd = wgid % NXCD, off = wgid / NXCD; wgid = (xcd < r ? xcd * (q + 1) : r * (q + 1) + (xcd - r) * q) + off; }
        const int nig = WGM * nN, gid = wgid / nig, fm = gid * WGM, gsz = (nM - fm) < WGM ? (nM - fm) : WGM;
        u.pm = fm + ((wgid % nig) % gsz); u.pn = (wgid % nig) / gsz; u.seg = 0; return true;
    }
    __device__ __forceinline__ const char* bptr(const Unit& u, int) const { return (const char*)Bt + (size_t)u.pn * btile; }
    __device__ __forceinline__ int nt(const Unit&, int ntd) const { return ntd; }
    __device__ __forceinline__ size_t aoff(const Unit&) const { return 0; }
};
struct SegOrder : StaticOrder {
    __device__ bool next(int i, Unit& u) const { const int q = i / 3; if (!StaticOrder::next(q, u)) return false; u.seg = i - 3 * q; return true; }
    __device__ __forceinline__ size_t koff(const Unit& u) const { return u.seg == 0 ? 0 : (u.seg == 1 ? 512 : 1024); }
    __device__ __forceinline__ const char* bptr(const Unit& u, int) const { return (const char*)Bt + (size_t)u.pn * btile + koff(u); }
    __device__ __forceinline__ int nt(const Unit& u, int) const { return u.seg == 2 ? 8 : 4; }
    __device__ __forceinline__ size_t aoff(const Unit& u) const { return koff(u); }
};

template <class Epi, class Sched, bool ALIGN_EPI = true, bool SP2 = true>
__device__ __forceinline__ void gemm_phase(LAS unsigned char* lds, const Gemm g, const Sched& S, const Epi& E, const int wave_id) {
    const int tid = wave_id * 64 + lane_id_opaque();
    const int wid = __builtin_amdgcn_readfirstlane(tid >> 6), lane = tid & 63, wr = wid >> 2, wc = wid & 3, fr = lane & 15, fq = lane >> 4;
    const int K = g.K, nt = K / BK, ldb = g.ldb, ks = g.ksplit;
    unsigned voffA[2], voffB[2];
#pragma unroll
    for (int i = 0; i < 2; ++i) { int R, C; stage_rc(tid * 16 + i * 8192, R, C); const int Rb = Epi::PERM ? ((R & ~31) + perm32(R & 31)) : R;
        voffA[i] = (unsigned)(R * K + C) * 2u; voffB[i] = (unsigned)(Rb * ldb + C) * 2u; }
    constexpr bool GATHER = Sched::GATHER;
    unsigned vC0[2], vC1[2];
    const size_t kstep = (size_t)(BK * 2);
    const size_t hstep = (size_t)HALF * K * 2;
    const size_t hstepB = (size_t)HALF * ldb * 2;
    const size_t tstep = 2 * hstep;
#define PG8_GOFF(ui_) do { _Pragma("unroll") for (int _i = 0; _i < 2; ++_i) { const int R_ = (int)(voffA[_i] >> 11); const unsigned C_ = voffA[_i] & 2047u; \
        vC0[_i] = (unsigned)S.tokl[(ui_) * 256 + R_] * 2048u + C_; vC1[_i] = (unsigned)S.tokl[(ui_) * 256 + 128 + R_] * 2048u + C_; } } while (0)
    const unsigned ldsw = (unsigned)wid * 1024u;
    const int aoff = lds_byte(wr * 64 + fr, fq * 8), boff = lds_byte(wc * 32 + fr, fq * 8);
#define PG8_SA(b, h) (((b) * 2 + (h)) * HTB)
#define PG8_SB(b, h) ((4 + (b) * 2 + (h)) * HTB)
#define PG8_STAGE(bufoff, gbase, voff) do { _Pragma("unroll") for (int _i = 0; _i < 2; ++_i) \
        __builtin_amdgcn_global_load_lds((const unsigned*)((const char*)(gbase) + (voff)[_i]), (LAS unsigned*)(lds + (bufoff) + ldsw + _i * 8192), 16, 0, 0); } while (0)
#define PG8_LDA(dst, b, h) do { _Pragma("unroll") for (int m = 0; m < 4; ++m) _Pragma("unroll") for (int k = 0; k < 2; ++k) dst[m][k] = *(const LAS bf16x8*)(lds + PG8_SA(b, h) + aoff + m * 2048 + k * 1024); } while (0)
#define PG8_LDB(dst, b, h) do { _Pragma("unroll") for (int n = 0; n < 2; ++n) _Pragma("unroll") for (int k = 0; k < 2; ++k) dst[n][k] = *(const LAS bf16x8*)(lds + PG8_SB(b, h) + boff + n * 2048 + k * 1024); } while (0)
#define PG8_MMA(ai, bj, At, Bt) do { __builtin_amdgcn_s_setprio(1); _Pragma("unroll") for (int m = 0; m < 4; ++m) _Pragma("unroll") for (int n = 0; n < 2; ++n) _Pragma("unroll") for (int k = 0; k < 2; ++k) \
        acc[ai][bj][m][n] = __builtin_amdgcn_mfma_f32_16x16x32_bf16(Bt[n][k], At[m][k], acc[ai][bj][m][n], 0, 0, 0); __builtin_amdgcn_s_setprio(0); } while (0)
#define PG8_WAIT_V(n) asm volatile("s_waitcnt vmcnt(" #n ")" ::: "memory")
#define PG8_WAIT_L(n) asm volatile("s_waitcnt lgkmcnt(" #n ")" ::: "memory")
#define PG8_BAR __builtin_amdgcn_s_barrier()
#define PG8_SCHED __builtin_amdgcn_sched_barrier(0)
    Unit cur, nxt; int ui = 0;
    if (!S.next(0, cur)) return;
    if constexpr (GATHER) { PG8_GOFF(0); } else { vC0[0] = voffA[0]; vC0[1] = voffA[1]; vC1[0] = voffA[0] + (unsigned)hstep; vC1[1] = voffA[1] + (unsigned)hstep; }
    f32x4 acc[2][2][4][2];
    { float z_ = 0.f; LAUNDER_V(z_);
#pragma unroll
    for (int a = 0; a < 2; ++a)
#pragma unroll
        for (int b = 0; b < 2; ++b)
#pragma unroll
            for (int m = 0; m < 4; ++m)
#pragma unroll
                for (int n = 0; n < 2; ++n) acc[a][b][m][n] = (f32x4){z_, z_, z_, z_}; }
    bf16x8 At[4][2], B0[2][2], B1[2][2];
    int ntc = S.nt(cur, nt);
    const char* cA = GATHER ? (const char*)g.A : (const char*)g.A + (size_t)cur.pm * tstep + S.aoff(cur); const char* cB = S.bptr(cur, 0); const char* cB1 = S.bptr(cur, 1) - (size_t)ks * kstep;
    if constexpr (SP2) {
        PG8_STAGE(PG8_SB(0, 0), cB, voffB); PG8_STAGE(PG8_SB(0, 1), cB + hstepB, voffB); PG8_STAGE(PG8_SA(0, 0), cA, vC0); PG8_STAGE(PG8_SA(0, 1), cA, vC1);
        if (wr == 1) PG8_BAR;
        PG8_WAIT_V(2); PG8_BAR;
        PG8_STAGE(PG8_SB(1, 0), cB + kstep, voffB); PG8_STAGE(PG8_SA(1, 0), cA + kstep, vC0); PG8_STAGE(PG8_SB(1, 1), cB + hstepB + kstep, voffB);
        PG8_WAIT_V(6); PG8_BAR;
    } else {
        PG8_STAGE(PG8_SB(0, 0), cB, voffB); PG8_STAGE(PG8_SA(0, 0), cA, vC0); PG8_STAGE(PG8_SB(0, 1), cB + hstepB, voffB); PG8_STAGE(PG8_SA(0, 1), cA, vC1);
        if (wr == 1) PG8_BAR;
        PG8_WAIT_V(4); PG8_BAR;
        PG8_STAGE(PG8_SB(1, 0), cB + kstep, voffB); PG8_STAGE(PG8_SA(1, 0), cA + kstep, vC0); PG8_STAGE(PG8_SB(1, 1), cB + hstepB + kstep, voffB);
        PG8_WAIT_V(6); PG8_BAR;
    }
    for (;;) {
        const bool has_next = S.next(ui + 1, nxt);
        const char* nA = GATHER ? (const char*)g.A : (has_next ? (const char*)g.A + (size_t)nxt.pm * tstep + S.aoff(nxt) : cA); const char* nB = has_next ? S.bptr(nxt, 0) : cB;
        const char* nB1 = has_next ? S.bptr(nxt, 1) - (size_t)ks * kstep : cB1;
#pragma unroll 1
        for (int t = 0; t < ntc; t += 2) {
            const bool last = (t == ntc - 2);
            const char* a1 = cA + (size_t)(t + 1) * kstep;
            const char* bside = (t + 2 < ks) ? cB : cB1;
            const char* a2 = last ? nA : cA + (size_t)(t + 2) * kstep; const char* b2 = last ? nB : bside + (size_t)(t + 2) * kstep;
            const char* a3 = a2 + kstep; const char* b3 = b2 + kstep;
            unsigned x0[2] = {vC0[0], vC0[1]}, x1[2] = {vC1[0], vC1[1]};
            if constexpr (GATHER) { if (last && has_next) { _Pragma("unroll") for (int _i = 0; _i < 2; ++_i) { const int R_ = (int)(voffA[_i] >> 11); const unsigned C_ = voffA[_i] & 2047u;
                x0[_i] = (unsigned)S.tokl[(ui + 1) * 256 + R_] * 2048u + C_; x1[_i] = (unsigned)S.tokl[(ui + 1) * 256 + 128 + R_] * 2048u + C_; } } }
            if constexpr (SP2) {
            PG8_LDB(B0, 0, 0); PG8_LDB(B1, 0, 1); PG8_SCHED; PG8_LDA(At, 0, 0); PG8_STAGE(PG8_SA(1, 1), a1, vC1);
            PG8_WAIT_V(8); PG8_WAIT_L(0); PG8_BAR; PG8_MMA(0, 0, At, B0); PG8_MMA(0, 1, At, B1); PG8_BAR; PG8_SCHED;
            PG8_LDA(At, 0, 1); PG8_STAGE(PG8_SB(0, 0), b2, voffB); PG8_STAGE(PG8_SB(0, 1), b2 + hstepB, voffB); PG8_STAGE(PG8_SA(0, 0), a2, x0);
            PG8_WAIT_V(8); PG8_WAIT_L(0); PG8_BAR; PG8_MMA(1, 0, At, B0); PG8_MMA(1, 1, At, B1); PG8_BAR; PG8_SCHED;
            PG8_LDB(B0, 1, 0); PG8_LDB(B1, 1, 1); PG8_SCHED; PG8_LDA(At, 1, 0); PG8_STAGE(PG8_SA(0, 1), a2, x1);
            PG8_WAIT_V(8); PG8_WAIT_L(0); PG8_BAR; PG8_MMA(0, 0, At, B0); PG8_MMA(0, 1, At, B1); PG8_BAR; PG8_SCHED;
            PG8_LDA(At, 1, 1); PG8_STAGE(PG8_SB(1, 0), b3, voffB); PG8_STAGE(PG8_SB(1, 1), b3 + hstepB, voffB); PG8_STAGE(PG8_SA(1, 0), a3, x0);
            PG8_WAIT_V(8); PG8_WAIT_L(0); PG8_BAR; PG8_MMA(1, 0, At, B0); PG8_MMA(1, 1, At, B1); PG8_BAR; PG8_SCHED;
            } else {
            PG8_LDB(B0, 0, 0); PG8_SCHED; PG8_LDA(At, 0, 0); PG8_STAGE(PG8_SA(1, 1), a1, vC1);
            PG8_WAIT_L(8); PG8_BAR; PG8_WAIT_L(0); PG8_MMA(0, 0, At, B0); PG8_BAR; PG8_SCHED;
            PG8_LDB(B1, 0, 1); PG8_STAGE(PG8_SB(0, 0), b2, voffB);
            PG8_BAR; PG8_WAIT_L(0); PG8_MMA(0, 1, At, B1); PG8_BAR;
            PG8_LDA(At, 0, 1); PG8_STAGE(PG8_SA(0, 0), a2, x0);
            PG8_BAR; PG8_WAIT_L(0); PG8_MMA(1, 0, At, B0); PG8_BAR; PG8_SCHED;
            PG8_STAGE(PG8_SB(0, 1), b2 + hstepB, voffB);
            PG8_WAIT_V(6); PG8_BAR; PG8_MMA(1, 1, At, B1); PG8_BAR;
            PG8_LDB(B0, 1, 0); PG8_SCHED; PG8_LDA(At, 1, 0); PG8_STAGE(PG8_SA(0, 1), a2, x1);
            PG8_WAIT_L(8); PG8_BAR; PG8_WAIT_L(0); PG8_MMA(0, 0, At, B0); PG8_BAR; PG8_SCHED;
            PG8_LDB(B1, 1, 1); PG8_STAGE(PG8_SB(1, 0), b3, voffB);
            PG8_BAR; PG8_WAIT_L(0); PG8_MMA(0, 1, At, B1); PG8_BAR;
            PG8_LDA(At, 1, 1); PG8_STAGE(PG8_SA(1, 0), a3, x0);
            PG8_BAR; PG8_WAIT_L(0); PG8_MMA(1, 0, At, B0); PG8_BAR; PG8_SCHED;
            PG8_STAGE(PG8_SB(1, 1), b3 + hstepB, voffB);
            PG8_WAIT_V(6); PG8_BAR; PG8_MMA(1, 1, At, B1); PG8_BAR;
            }
        }
        if constexpr (ALIGN_EPI) { if (wr == 0) PG8_BAR; }
        { const int l2 = lane_id_opaque(); E(acc, cur, wr, wc, l2 & 15, l2 >> 4); }
        if (!has_next) break;
        if (!E.keep(cur)) { float z_ = 0.f; LAUNDER_V(z_);
#pragma unroll
        for (int a = 0; a < 2; ++a)
#pragma unroll
            for (int b = 0; b < 2; ++b)
#pragma unroll
                for (int m = 0; m < 4; ++m)
#pragma unroll
                    for (int n = 0; n < 2; ++n) acc[a][b][m][n] = (f32x4){z_, z_, z_, z_}; }
        cur = nxt; cA = nA; cB = nB; cB1 = nB1; ++ui; ntc = S.nt(cur, nt);
        if constexpr (GATHER) { PG8_GOFF(ui); }
        if constexpr (ALIGN_EPI) { if (wr == 1) PG8_BAR; }
    }
    PG8_WAIT_V(0);
    if constexpr (!ALIGN_EPI) { if (wr == 0) PG8_BAR; }
    PG8_BAR;
#undef PG8_GOFF
#undef PG8_SA
#undef PG8_SB
#undef PG8_STAGE
#undef PG8_LDA
#undef PG8_LDB
#undef PG8_MMA
#undef PG8_WAIT_V
#undef PG8_WAIT_L
#undef PG8_BAR
#undef PG8_SCHED
}
}

typedef f32x4 AccT[2][2][4][2];
__device__ __forceinline__ u32x4 pack8(const f32x4 a, const f32x4 b) { u32x4 w; w.x = pk2(a[0], a[1]); w.y = pk2(a[2], a[3]); w.z = pk2(b[0], b[1]); w.w = pk2(b[2], b[3]); return w; }

struct Epi1 {
    static constexpr bool PERM = true;
    __device__ __forceinline__ bool keep(const pg8::Unit&) const { return false; }
    const float* rstd; bf16* A; bf16* GLU; bf16* QKV; bf16* G;
    __device__ __forceinline__ void operator()(AccT& acc, const pg8::Unit& u, int wr, int wc, int fr, int fq) const { run<false>(acc, u, wr, wc, fr, fq); }
    template <bool SK> __device__ __forceinline__ void run(AccT& acc, const pg8::Unit& u, int wr, int wc, int fr, int fq) const {
        const int row0 = u.pm * 256 + wr * 64 + fr, lc0 = wc * 32 + 8 * fq, pn = u.pn;
#pragma unroll
        for (int ai = 0; ai < (SK ? 1 : 2); ++ai)
#pragma unroll
            for (int m = 0; m < (SK ? 1 : 4); ++m) {
                const int row = row0 + ai * 128 + m * 16; const float rs = rstd[row];
                f32x4 v[2][2];
#pragma unroll
                for (int bj = 0; bj < 2; ++bj)
#pragma unroll
                    for (int n = 0; n < 2; ++n) v[bj][n] = acc[ai][bj][m][n] * rs;
                if (pn == 0) {
#pragma unroll
                    for (int bj = 0; bj < 2; ++bj) *(u32x4*)(A + (size_t)row * 256 + bj * 128 + lc0) = pack8(v[bj][0], v[bj][1]);
                } else if (pn <= 2) {
                    f32x4 o[2];
#pragma unroll
                    for (int n = 0; n < 2; ++n)
#pragma unroll
                        for (int j = 0; j < 4; ++j) o[n][j] = v[0][n][j] * sigmoidf_(v[1][n][j]);
                    *(u32x4*)(GLU + (size_t)row * 256 + (pn - 1) * 128 + lc0) = pack8(o[0], o[1]);
                } else if (pn <= 4) {
#pragma unroll
                    for (int bj = 0; bj < 2; ++bj) *(u32x4*)(QKV + (size_t)2 * (U / 4) + (size_t)row * 512 + (pn - 3) * 256 + bj * 128 + lc0) = pack8(v[bj][0], v[bj][1]);
                } else {
                    const int d = 64 * (pn - 5) + 16 * wc + 4 * fq; f32x4 r01, r12, g2;
#pragma unroll
                    for (int j = 0; j < 4; ++j) { const float a0 = 1.0f + fminf(__builtin_amdgcn_exp2f(-LOG2E * v[0][0][j]), 1e30f), a1 = 1.0f + fminf(__builtin_amdgcn_exp2f(-LOG2E * v[0][1][j]), 1e30f), a2 = 1.0f + fminf(__builtin_amdgcn_exp2f(-LOG2E * v[1][0][j]), 1e30f);
                        const float i0 = __builtin_amdgcn_rcpf(a0), i1 = __builtin_amdgcn_rcpf(a1), i2 = __builtin_amdgcn_rcpf(a2);
                        r01[j] = i0 * a1; r12[j] = i1 * a2; g2[j] = i2; }
                    bf16* gp = G + (size_t)row * 1024 + d; u32x2 w;
                    w.x = pk2(r01[0], r01[1]); w.y = pk2(r01[2], r01[3]); *(u32x2*)gp = w;
                    w.x = pk2(r12[0], r12[1]); w.y = pk2(r12[2], r12[3]); *(u32x2*)(gp + U / 2) = w;
                    w.x = pk2(g2[0], g2[1]); w.y = pk2(g2[2], g2[3]); *(u32x2*)(gp + U) = w;
                    const float sc = d < 512 ? C2 : 1.0f; const f32x4 sp = v[1][1] * sc;
                    w.x = pk2(sp[0], sp[1]); w.y = pk2(sp[2], sp[3]); *(u32x2*)(QKV + (size_t)(d < 512 ? 0 : 1) * (U / 4) + (size_t)row * 512 + (d & 511)) = w;
                }
            }
    }
};
struct EpiCS {
    static constexpr bool PERM = true;
    const bf16* G; bf16* Mg; const float* bias;
    __device__ __forceinline__ bool keep(const pg8::Unit& u) const { return u.seg != 2; }
    __device__ __forceinline__ void operator()(AccT& acc, const pg8::Unit& u, int wr, int wc, int fr, int fq) const { run<false>(acc, u, wr, wc, fr, fq); }
    template <bool SK> __device__ __forceinline__ void run(AccT& acc, const pg8::Unit& u, int wr, int wc, int fr, int fq) const {
        const int row0 = u.pm * 256 + wr * 64 + fr, col0 = u.pn * 256 + wc * 32 + 8 * fq;
        const bool lastseg = u.seg == 2; const float bsc = u.seg == 0 ? 1.f : 0.f; const bf16* Gs = G + (size_t)u.seg * (U / 2);
        f32x4 bv[2][2];
#pragma unroll
        for (int bj = 0; bj < 2; ++bj) { bv[bj][0] = *(const f32x4*)(bias + col0 + bj * 128) * bsc; bv[bj][1] = *(const f32x4*)(bias + col0 + bj * 128 + 4) * bsc; }
        u32x4 gr[2][4][2];
#pragma unroll
        for (int ai = 0; ai < (SK ? 1 : 2); ++ai)
#pragma unroll
            for (int m = 0; m < (SK ? 1 : 4); ++m)
#pragma unroll
                for (int bj = 0; bj < 2; ++bj) gr[ai][m][bj] = *(const u32x4*)(Gs + (size_t)(row0 + ai * 128 + m * 16) * 1024 + col0 + bj * 128);
#pragma unroll
        for (int ai = 0; ai < (SK ? 1 : 2); ++ai)
#pragma unroll
            for (int m = 0; m < (SK ? 1 : 4); ++m) { const int row = row0 + ai * 128 + m * 16;
#pragma unroll
                for (int bj = 0; bj < 2; ++bj) {
                    const u32x4 n4 = gr[ai][m][bj];
                    f32x4 a0 = acc[ai][bj][m][0] + bv[bj][0], a1 = acc[ai][bj][m][1] + bv[bj][1];
                    a0[0] *= bflo(n4.x); a0[1] *= bfhi(n4.x); a0[2] *= bflo(n4.y); a0[3] *= bfhi(n4.y); a1[0] *= bflo(n4.z); a1[1] *= bfhi(n4.z); a1[2] *= bflo(n4.w); a1[3] *= bfhi(n4.w);
                    acc[ai][bj][m][0] = a0; acc[ai][bj][m][1] = a1;
                    asm volatile("" : "+v"(acc[ai][bj][m][0]), "+v"(acc[ai][bj][m][1]));
                    if (lastseg) *(u32x4*)(Mg + (size_t)row * 1024 + col0 + bj * 128) = pack8(a0, a1);
                } }
    }
};
struct EpiD {
    static constexpr bool PERM = false;
    __device__ __forceinline__ bool keep(const pg8::Unit&) const { return false; }
    float* H; bf16* HB;
    __device__ __forceinline__ void operator()(AccT& acc, const pg8::Unit& u, int wr, int wc, int fr, int fq) const { run<false>(acc, u, wr, wc, fr, fq); }
    template <bool SK> __device__ __forceinline__ void run(AccT& acc, const pg8::Unit& u, int wr, int wc, int fr, int fq) const {
        const int row0 = u.pm * 256 + wr * 64 + fr, col0 = u.pn * 256 + wc * 32 + 4 * fq;
#pragma unroll
        for (int ai = 0; ai < (SK ? 1 : 2); ++ai)
#pragma unroll
            for (int m = 0; m < (SK ? 1 : 4); ++m) {
                const size_t off = (size_t)(row0 + ai * 128 + m * 16) * 1024 + col0;
#pragma unroll
                for (int bj = 0; bj < 2; ++bj)
#pragma unroll
                    for (int n = 0; n < 2; ++n) { const size_t o = off + bj * 128 + n * 16; const f32x4 hv = *(const f32x4*)(H + o) + acc[ai][bj][m][n];
                        *(f32x4*)(H + o) = hv; u32x2 w; w.x = pk2(hv[0], hv[1]); w.y = pk2(hv[2], hv[3]); *(u32x2*)(HB + o) = w; }
            }
    }
};
struct EpiA2 {
    static constexpr bool PERM = true;
    __device__ __forceinline__ bool keep(const pg8::Unit&) const { return false; }
    const float* PW; bf16* HH;
    __device__ __forceinline__ void operator()(AccT& acc, const pg8::Unit& u, int wr, int wc, int fr, int fq) const {
        const int row0 = u.pm * 256 + wr * 64 + fr, lc0 = wc * 32 + 8 * fq, side = u.pn >> 1;
#pragma unroll
        for (int ai = 0; ai < 2; ++ai)
#pragma unroll
            for (int m = 0; m < 4; ++m) {
                const int row = row0 + ai * 128 + m * 16; const f32x4 pw = *(const f32x4*)(PW + (size_t)row * 4);
                const float rs = pw[0], cw = side ? pw[2] : pw[1];
                f32x4 o[2];
#pragma unroll
                for (int n = 0; n < 2; ++n)
#pragma unroll
                    for (int j = 0; j < 4; ++j) { const float a1 = acc[ai][0][m][n][j] * rs, a3 = acc[ai][1][m][n][j] * rs; o[n][j] = cw * a1 * sigmoidf_(a1) * a3; }
                *(u32x4*)(HH + (size_t)row * 512 + side * 256 + (u.pn & 1) * 128 + lc0) = pack8(o[0], o[1]);
            }
    }
};
struct EpiB2 {
    static constexpr bool PERM = true;
    __device__ __forceinline__ bool keep(const pg8::Unit&) const { return false; }
    bf16* Y;
    __device__ __forceinline__ void operator()(AccT& acc, const pg8::Unit& u, int wr, int wc, int fr, int fq) const { run<false>(acc, u, wr, wc, fr, fq); }
    template <bool SK> __device__ __forceinline__ void run(AccT& acc, const pg8::Unit& u, int wr, int wc, int fr, int fq) const {
        const int row0 = u.pm * 256 + wr * 64 + fr, col0 = u.pn * 256 + wc * 32 + 8 * fq;
#pragma unroll
        for (int ai = 0; ai < (SK ? 1 : 2); ++ai)
#pragma unroll
            for (int m = 0; m < (SK ? 1 : 4); ++m) {
                bf16* rp = Y + (size_t)(row0 + ai * 128 + m * 16) * 1024 + col0;
#pragma unroll
                for (int bj = 0; bj < 2; ++bj) *(u32x4*)(rp + bj * 128) = pack8(acc[ai][bj][m][0], acc[ai][bj][m][1]);
            }
    }
};
template <bool GA> struct MoeOrderT {
    static constexpr bool GATHER = GA; const LAS int* tokl;
    int NP, G, c, mode; const LAS int* pcls; const bf16* W;
    __device__ bool next(int i, pg8::Unit& u) const { const long L = (long)i * G + c; if (L >= (long)NP * 4) return false; u.pm = (int)(L >> 2); u.pn = (int)(L & 3); u.seg = 0; return true; }
    __device__ __forceinline__ int nt(const pg8::Unit&, int ntd) const { return ntd; }
    __device__ __forceinline__ size_t aoff(const pg8::Unit&) const { return 0; }
    __device__ __forceinline__ const char* bptr(const pg8::Unit& u, int side) const {
        const int cls = __builtin_amdgcn_readfirstlane(pcls[u.pm]); const int grp = cls / 6, pr = cls % 6;
        const int ea = pr < 3 ? 0 : (pr < 5 ? 1 : 2), eb = pr < 3 ? pr + 1 : (pr < 5 ? pr - 1 : 3);
        if (mode == 0) { const int e = grp * 4 + (u.pn < 2 ? ea : eb); return (const char*)W + ((size_t)e * 512 + (size_t)(u.pn & 1) * 256) * 1024 * 2; }
        const int e = grp * 4 + (side ? eb : ea); return (const char*)W + ((size_t)e * 1024 + (size_t)u.pn * 256) * 256 * 2;
    }
};

template <bool PERM> __device__ __forceinline__ void skinny_k(AccT& acc, const bf16* A, int lda, const bf16* Bt, int ldb, int K, int wc, int fr, int fq) {
    const bf16* ap = A + (size_t)fr * lda + 8 * fq;
    const bf16* bp[2][2];
#pragma unroll
    for (int bj = 0; bj < 2; ++bj)
#pragma unroll
        for (int n = 0; n < 2; ++n) { const int col = 128 * bj + 32 * wc + (PERM ? 8 * (fr >> 2) + 4 * n + (fr & 3) : 16 * n + fr); bp[bj][n] = Bt + (size_t)col * ldb + 8 * fq; }
#pragma unroll 8
    for (int k0 = 0; k0 < K; k0 += 32) {
        const bf16x8 a = *(const bf16x8*)(ap + k0);
#pragma unroll
        for (int bj = 0; bj < 2; ++bj)
#pragma unroll
            for (int n = 0; n < 2; ++n) { const bf16x8 b = *(const bf16x8*)(bp[bj][n] + k0); acc[0][bj][0][n] = __builtin_amdgcn_mfma_f32_16x16x32_bf16(b, a, acc[0][bj][0][n], 0, 0, 0); }
    }
}
__device__ __forceinline__ void skinny_zero(AccT& acc) {
#pragma unroll
    for (int bj = 0; bj < 2; ++bj)
#pragma unroll
        for (int n = 0; n < 2; ++n) acc[0][bj][0][n] = (f32x4){0.f, 0.f, 0.f, 0.f};
}
__device__ __forceinline__ void skinny_combine(AccT& acc, LAS unsigned char* lds, int wave, int lane) {
    LAS f32x4* X = (LAS f32x4*)lds;
    if (wave >= 4) {
#pragma unroll
        for (int bj = 0; bj < 2; ++bj)
#pragma unroll
            for (int n = 0; n < 2; ++n) X[((wave - 4) * 64 + lane) * 4 + bj * 2 + n] = acc[0][bj][0][n]; }
    __syncthreads();
    if (wave < 4) {
#pragma unroll
        for (int bj = 0; bj < 2; ++bj)
#pragma unroll
            for (int n = 0; n < 2; ++n) acc[0][bj][0][n] += X[(wave * 64 + lane) * 4 + bj * 2 + n]; }
    __syncthreads();
}

#define XB_TMO      128
#define XB_XCNT(j)  (256  + 64 * (j))
#define XB_XSUB(j)  (1280 + 64 * (j))
#define XB_XGEN(j)  (2304 + 64 * (j))
#define XB_TOP      3328
#define XB_TOPGEN   3392
#define XCD_BAR_WORDS 3456
#define XB_SPIN_CAP (1u << 24)
__device__ __forceinline__ unsigned xb_ld(unsigned* p)              { return __hip_atomic_load(p, __ATOMIC_RELAXED, __HIP_MEMORY_SCOPE_AGENT); }
__device__ __forceinline__ unsigned xb_add(unsigned* p, unsigned v) { return __hip_atomic_fetch_add(p, v, __ATOMIC_RELAXED, __HIP_MEMORY_SCOPE_AGENT); }
__device__ __forceinline__ unsigned xb_xcc_id() { return (unsigned)__builtin_amdgcn_s_getreg((3 << 11) | 20) & 0xFu; }
#define XB_SPIN(cond, bar) do { unsigned _sp = 0; while (cond) { __builtin_amdgcn_s_sleep(1); \
    if ((++_sp & 255u) == 0u) { if (xb_ld(&(bar)[XB_TMO])) break; if (_sp > XB_SPIN_CAP) { atomicAdd(&(bar)[XB_TMO], 1u); break; } } } } while (0)
struct XcdBarrier { unsigned* bar; unsigned x; volatile LAS unsigned* st; };
__device__ __forceinline__ XcdBarrier xcd_barrier_post(unsigned* bar, volatile LAS unsigned* st) {
    XcdBarrier b; b.bar = bar; b.x = xb_xcc_id(); b.st = st;
    if (threadIdx.x == 0) (void)xb_add(&bar[XB_XCNT(b.x)], 1u);
    return b;
}
__device__ __forceinline__ void xcd_barrier_complete(unsigned* bar, unsigned x, unsigned& nloc, unsigned& nx) {
    const unsigned G = gridDim.x * gridDim.y * gridDim.z;
    unsigned sum, cnt, mine, sp = 0u;
    for (;;) {
        sum = 0u; cnt = 0u; mine = 0u;
#pragma unroll
        for (unsigned j = 0; j < 16; ++j) { const unsigned c = xb_ld(&bar[XB_XCNT(j)]); sum += c; cnt += (c > 0u) ? 1u : 0u; mine = (j == x) ? c : mine; }
        if (sum == G) break;
        __builtin_amdgcn_s_sleep(1);
        if ((++sp & 255u) == 0u) { if (xb_ld(&bar[XB_TMO])) break; if (sp > XB_SPIN_CAP) { atomicAdd(&bar[XB_TMO], 1u); break; } }
    }
    nloc = mine > 0u ? mine : 1u; nx = cnt > 0u ? cnt : 1u;
}
__device__ __forceinline__ void xcd_barrier(const XcdBarrier& b) {
    asm volatile("s_waitcnt vmcnt(0)" ::: "memory");
    __syncthreads();
    if (threadIdx.x == 0) {
        unsigned* bar = b.bar;
        __builtin_amdgcn_s_waitcnt(0);
        unsigned nloc = b.st[0], nx = b.st[1];
        if (nloc == 0u) { xcd_barrier_complete(bar, b.x, nloc, nx); b.st[0] = nloc; b.st[1] = nx; }
        const unsigned old = xb_add(&bar[XB_XSUB(b.x)], 1u);
        const unsigned gen = old / nloc;
        if (old + 1u == (gen + 1u) * nloc) {
            __builtin_amdgcn_fence(__ATOMIC_RELEASE, "agent");
            asm volatile("s_waitcnt vmcnt(0)" ::: "memory");
            const unsigned og = xb_add(&bar[XB_TOP], 1u);
            const unsigned tg = og / nx;
            if (og + 1u == (tg + 1u) * nx) xb_add(&bar[XB_TOPGEN], 1u);
            else XB_SPIN(xb_ld(&bar[XB_TOPGEN]) == tg, bar);
            __builtin_amdgcn_fence(__ATOMIC_ACQUIRE, "agent");
            xb_add(&bar[XB_XGEN(b.x)], 1u);
            asm volatile("s_waitcnt vmcnt(0)" ::: "memory");
        } else {
            XB_SPIN(xb_ld(&bar[XB_XGEN(b.x)]) == gen, bar);
            __builtin_amdgcn_fence(__ATOMIC_ACQUIRE, "agent");
            asm volatile("s_waitcnt vmcnt(0)" ::: "memory");
        }
    }
    __syncthreads();
}

struct Params { const float* in[25]; float* out; unsigned char* ws; int ph_lo, ph_hi; };
enum { I_X = 0, I_META, I_N1G, I_WIN, I_BF, I_PW, I_PB, I_PS, I_CW, I_CB, I_LNG, I_LNB, I_WOA, I_WOB, I_WOC, I_WO, I_N2G, I_RGW, I_RGB, I_REW, I_REB, I_W1, I_W3, I_W2, I_FG };

struct Frame {
    LAS unsigned char* lds;
    int tid, lane, wave, vcu, G, bx;
};
__device__ __forceinline__ unsigned long long ptab_get(const Frame& F, int i) { const LAS unsigned* t = (const LAS unsigned*)(F.lds + LC_PTAB) + 2 * i; const unsigned lo = __builtin_amdgcn_readfirstlane(t[0]), hi = __builtin_amdgcn_readfirstlane(t[1]); return ((unsigned long long)hi << 32) | lo; }
#define INP(i) ((const float*)(const GAS float*)ptab_get(F, (i)))
#define WSP() ((unsigned char*)(GAS unsigned char*)ptab_get(F, 25))
#define DOP() ((unsigned char*)(GAS unsigned char*)ptab_get(F, 26))

__device__ __forceinline__ void tr_item(const float* W, int ldw, int scol_lane  , const float* gk, bf16* WT, int ldt, int drow0, int k0, LAS float* scr, int lane) {
    const int n4 = (lane & 7) * 4, kr = lane >> 3;
    f32x4 v[8];
#pragma unroll
    for (int i = 0; i < 8; ++i) v[i] = *(const f32x4*)(W + (size_t)(k0 + 8 * i + kr) * ldw + scol_lane);
#pragma unroll
    for (int i = 0; i < 8; ++i) { const int kk = 8 * i + kr; const float g = gk ? gk[k0 + kk] : 1.0f; LAS float* d = scr + kk * 33 + n4; d[0] = v[i][0] * g; d[1] = v[i][1] * g; d[2] = v[i][2] * g; d[3] = v[i][3] * g; }
    LDS_WAIT(); asm volatile("" ::: "memory");
    const int c = lane & 7;
#pragma unroll
    for (int j = 0; j < 4; ++j) { const int n = (lane >> 3) + 8 * j; const LAS float* s = scr + (8 * c) * 33 + n;
        u32x4 o; o.x = pk2(s[0 * 33], s[1 * 33]); o.y = pk2(s[2 * 33], s[3 * 33]); o.z = pk2(s[4 * 33], s[5 * 33]); o.w = pk2(s[6 * 33], s[7 * 33]);
        *(u32x4*)(WT + (size_t)(drow0 + n) * ldt + k0 + 8 * c) = o; }
    LDS_WAIT(); asm volatile("" ::: "memory");
}
__device__ __forceinline__ int map1(int n) {
    const int tile = n >> 8, c = n & 255;
    if (tile == 0) return n;
    if (tile <= 2) { const int cc = (tile - 1) * 128 + (c & 127); return (c < 128 ? 256 : 512) + cc; }
    if (tile <= 4) return 1792 + (n - 768);
    const int t = tile - 5, bj = c >> 7, wc = (c >> 5) & 3, fq = (c >> 3) & 3, nn = (c >> 2) & 1, d = 64 * t + 16 * wc + 4 * fq + (c & 3), kind = 2 * bj + nn;
    return kind == 3 ? 768 + d : 2312 + 1024 * kind + d;
}
__device__ __forceinline__ void convert_item(Frame& F, int l, int it, LAS float* scr, int lane) {
    const float* g1 = INP(I_N1G) + (size_t)l * D; const float* g2 = INP(I_N2G) + (size_t)l * D; unsigned char* ws = WSP(); const int n4l = (lane & 7) * 4;
    if (it < 2688) { const int kb = it / 168, nb = it % 168; tr_item(INP(I_WIN) + (size_t)l * D * NIN, NIN, map1(nb * 32 + n4l), g1, (bf16*)(ws + WS_W1T), 1024, nb * 32, kb * 64, scr, lane); return; } it -= 2688;
    if (it < 128) { const int kb = it / 32, nb = it % 32; tr_item(INP(I_WOB) + (size_t)l * 256 * D, 1024, nb * 32 + n4l, nullptr, (bf16*)(ws + WS_W3CT) + 256, 1024, nb * 32, kb * 64, scr, lane); return; } it -= 128;
    if (it < 256) { const int kb = it / 32, nb = it % 32; tr_item(INP(I_WOC) + (size_t)l * 512 * D, 1024, nb * 32 + n4l, nullptr, (bf16*)(ws + WS_W3CT) + 512, 1024, nb * 32, kb * 64, scr, lane); return; } it -= 256;
    if (it < 512) { const int kb = it / 32, nb = it % 32; tr_item(INP(I_WO) + (size_t)l * D * D, 1024, nb * 32 + n4l, nullptr, (bf16*)(ws + WS_WOT), 1024, nb * 32, kb * 64, scr, lane); return; } it -= 512;
    if (it < 4096) { const int e = it >> 8, r = it & 255, kb = r >> 4, nb = r & 15, n0 = nb * 32, jt = n0 >> 8, rr = n0 & 255;
        const float* W = (rr < 128 ? INP(I_W1) : INP(I_W3)) + ((size_t)l * 16 + e) * D * 256;
        tr_item(W, 256, jt * 128 + (rr & 127) + n4l, g2, (bf16*)(DOP() + DO_W13T) + (size_t)e * 512 * 1024, 1024, n0, kb * 64, scr, lane); return; } it -= 4096;
    { const int e = it >> 7, r = it & 127, kb = r >> 5, nb = r & 31;
        tr_item(INP(I_W2) + ((size_t)l * 16 + e) * 256 * D, 1024, nb * 32 + n4l, nullptr, (bf16*)(DOP() + DO_W2T) + (size_t)e * 1024 * 256, 256, nb * 32, kb * 64, scr, lane); }
}
__device__ __forceinline__ void convert_weights(Frame& F, int l) {
    LAS float* scr = (LAS float*)(F.lds + F.wave * 16384);
    const int gw = F.vcu * NWAVES + F.wave, NGW = F.G * NWAVES, lane = F.lane;
    const float* g1 = INP(I_N1G) + (size_t)l * D; const float* g2 = INP(I_N2G) + (size_t)l * D;
    unsigned char* ws = WSP();
#pragma unroll 1
    for (int it0 = gw; it0 < 3584; it0 += NGW) convert_item(F, l, it0, scr, lane);
    { const float* pw = INP(I_PW) + (size_t)l * 4 * 64 * 64; const float* ps = INP(I_PS) + (size_t)l * 256; const float* pb = INP(I_PB) + (size_t)l * 256;
      const float* wa = INP(I_WOA) + (size_t)l * 256 * D; bf16* WT = (bf16*)(ws + WS_W3CT); float* bias = (float*)(ws + WS_BIASA);
      const int gt = F.vcu * 512 + F.tid, NT = F.G * 512;
      for (int idx = gt; idx < 256 * 1024; idx += NT) { const int n = idx & 1023, kk = idx >> 10, grp = kk >> 6, c = kk & 63; float s = 0.f;
#pragma unroll 16
        for (int d = 0; d < 64; ++d) s += pw[(grp * 64 + c) * 64 + d] * ps[grp * 64 + d] * wa[(size_t)(grp * 64 + d) * D + n];
        WT[(size_t)n * 1024 + kk] = (bf16)f2bf(s); }
      for (int n = gw; n < 1024; n += NGW) { float s = 0.f;
#pragma unroll
        for (int j = 0; j < 4; ++j) { const int d = lane + 64 * j; s += pb[d] * ps[d] * wa[(size_t)d * D + n]; }
        s = wave_sum(s); if (lane == 0) bias[n] = s; }
      float* wfg = (float*)(ws + WS_WFG); const float* win = INP(I_WIN) + (size_t)l * D * NIN;
      for (int idx = gt; idx < 8 * 1024; idx += NT) { const int c = idx >> 10, k = idx & 1023; wfg[idx] = g1[k] * win[(size_t)k * NIN + 2304 + c]; }
      float* rg = (float*)(ws + WS_RG); const float* re = INP(I_REW) + (size_t)l * D * 16; const float* rgw = INP(I_RGW) + (size_t)l * D * 4;
      for (int idx = gt; idx < 20 * 1024; idx += NT) { const int c = idx >> 10, k = idx & 1023; rg[idx] = g2[k] * (c < 16 ? re[(size_t)k * 16 + c] : rgw[(size_t)k * 4 + (c - 16)]); } }
}
__device__ __forceinline__ void init_rows(Frame& F) {
    const int gw = F.vcu * NWAVES + F.wave, NGW = F.G * NWAVES, lane = F.lane;
    bf16* HB = (bf16*)(WSP() + WS_HB); float* rstd1 = (float*)(WSP() + WS_RSTD1);
    constexpr int R = 4;
#pragma unroll 1
    for (int row0 = gw; row0 < TR; row0 += R * NGW) {
        f32x4 v[R][4];
#pragma unroll
        for (int r = 0; r < R; ++r) { int row = row0 + r * NGW; if (row >= TR) row = TR - 1;
            const float* src = row < TX ? INP(I_X) + (size_t)row * D : INP(I_META) + (size_t)(row - TX) * D;
#pragma unroll
            for (int j = 0; j < 4; ++j) v[r][j] = *(const f32x4*)(src + 4 * lane + 256 * j); }
#pragma unroll
        for (int r = 0; r < R; ++r) { const int row = row0 + r * NGW; float ss = 0.f;
#pragma unroll
            for (int j = 0; j < 4; ++j) ss += v[r][j][0] * v[r][j][0] + v[r][j][1] * v[r][j][1] + v[r][j][2] * v[r][j][2] + v[r][j][3] * v[r][j][3];
            ss = wave_sum(ss);
            if (row < TR) {
#pragma unroll
                for (int j = 0; j < 4; ++j) { u32x2 w; w.x = pk2(v[r][j][0], v[r][j][1]); w.y = pk2(v[r][j][2], v[r][j][3]); *(u32x2*)(HB + (size_t)row * D + 4 * lane + 256 * j) = w; }
                if (lane == 0) rstd1[row] = rsqrtf(ss * (1.0f / D) + EPS); } }
    }
    { bf16* Kb = (bf16*)(DOP() + DO_K) + (size_t)TR * 512; bf16* Vb = (bf16*)(DOP() + DO_V) + (size_t)TR * 512; const int gt = F.vcu * 512 + F.tid;
      if (gt < 48 * 64) { *(u32x4*)(Kb + (size_t)gt * 8) = (u32x4){0u, 0u, 0u, 0u}; *(u32x4*)(Vb + (size_t)gt * 8) = (u32x4){0u, 0u, 0u, 0u}; } }
}

__device__ __forceinline__ int srcrow(bool isx, int b, int t) {
    if (t >= 0) return (isx ? b * SEQ : TX) + t;
    if (isx) { const int mm = NMETA + t; return mm >= 0 ? TX + mm : -1; }
    return -1;
}
__device__ __forceinline__ void s_item_logf(Frame& F, int l, int item) {
    LAS unsigned char* lds = F.lds; const int wave = F.wave;
    {
        const bool isx = item < 512; const int row0 = isx ? item * 64 : TX + (item - 512) * 64; const int b = isx ? (item * 64) / SEQ : 0; const int t0 = isx ? (item * 64) % SEQ : (item - 512) * 64; const int nrows = isx ? 64 : NMETA;
        { unsigned char* ws = WSP(); int tid = F.tid; LAUNDER_V(tid); const int lane = tid & 63, fr = lane & 15, fq = lane >> 4;
          const bf16* HB = (const bf16*)(ws + WS_HB); const float* rstd1 = (const float*)(ws + WS_RSTD1); const float* wfg = (const float*)(ws + WS_WFG);
          float* LFT = (float*)(ws + WS_LFT); float* LFTM = (float*)(ws + WS_LFTM); const float* bfg = INP(I_BF) + l * 8;
          LAS bf16* Whi = (LAS bf16*)lds; LAS bf16* Wlo = Whi + 8 * RPITCH; LAS float* Pex = (LAS float*)(lds + 2 * 8 * RPITCH * 2);
          { f32x4 wv_[4];
#pragma unroll
            for (int j = 0; j < 4; ++j) wv_[j] = *(const f32x4*)(wfg + 4 * (tid + 512 * j));
#pragma unroll
            for (int j = 0; j < 4; ++j) { const int i = 4 * (tid + 512 * j), c = i >> 10, k = i & 1023; u32x2 hw, lw; float hf[4];
#pragma unroll
                for (int e = 0; e < 4; ++e) hf[e] = __builtin_bit_cast(float, (pk2(wv_[j][e], 0.f) & 0xffffu) << 16);
                hw.x = pk2(wv_[j][0], wv_[j][1]); hw.y = pk2(wv_[j][2], wv_[j][3]); lw.x = pk2(wv_[j][0] - hf[0], wv_[j][1] - hf[1]); lw.y = pk2(wv_[j][2] - hf[2], wv_[j][3] - hf[3]);
                *(LAS u32x2*)(Whi + c * RPITCH + k) = hw; *(LAS u32x2*)(Wlo + c * RPITCH + k) = lw; } }
          const int g = wave & 3, kh = wave >> 2, rr = 16 * g + fr, row = row0 + rr;
          bf16x8 af[16];
#pragma unroll
          for (int s2 = 0; s2 < 16; ++s2) af[s2] = *(const bf16x8*)(HB + (size_t)row * D + 32 * (16 * kh + s2) + 8 * fq);
          const float rs1 = rstd1[row];
          __syncthreads();
          f32x4 acc = {0.f, 0.f, 0.f, 0.f};
#pragma unroll
          for (int s2 = 0; s2 < 16; ++s2) { const int k = 32 * (16 * kh + s2) + 8 * fq;
              bf16x8 wh = *(const LAS bf16x8*)(Whi + (fr & 7) * RPITCH + k), wl = *(const LAS bf16x8*)(Wlo + (fr & 7) * RPITCH + k);
              if (fr >= 8) { wh = (bf16x8){0, 0, 0, 0, 0, 0, 0, 0}; wl = wh; }
              acc = __builtin_amdgcn_mfma_f32_16x16x32_bf16(wh, af[s2], acc, 0, 0, 0); acc = __builtin_amdgcn_mfma_f32_16x16x32_bf16(wl, af[s2], acc, 0, 0, 0); }
          if (kh == 1) *(LAS f32x4*)(Pex + (g * 64 + lane) * 4) = acc;
          __syncthreads();
          if (kh == 0) { const f32x4 o4 = *(const LAS f32x4*)(Pex + (g * 64 + lane) * 4); acc += o4;
              if (fq < 2 && rr < nrows && row < TR) {
#pragma unroll
                  for (int i = 0; i < 4; ++i) { const int hd = 4 * fq + i; const float xg = acc[i] * rs1 + bfg[hd]; const float lf = fminf(xg, 0.f) - 0.69314718056f * __builtin_amdgcn_logf(1.0f + __expf(-fabsf(xg)));
                      if (isx) LFT[(size_t)(b * 8 + hd) * SEQ + t0 + rr] = lf; else LFTM[hd * 256 + t0 + rr] = lf; } } }
          __syncthreads(); }
    }
}
__device__ __forceinline__ void norm_items(Frame& F, int l, int wsub, int nsub) {
    LAS unsigned* nmx = (LAS unsigned*)(F.lds + LC_NMX); const int wave = F.wave;
#pragma unroll 1
    for (int item = wsub; item < 513; item += nsub) {
        const bool isx = item < 512; const int row0 = isx ? item * 64 : TX; const int b = isx ? (item * 64) / SEQ : 0; const int nrows = isx ? 64 : NMETA;
        int tid = F.tid; LAUNDER_V(tid); const int lane = tid & 63;
        if (tid < 16) nmx[tid] = 0u;
        __syncthreads();
        {
          { const bf16* Qg = (const bf16*)(DOP() + DO_Q); const bf16* Kg = (const bf16*)(DOP() + DO_K); float kmx = 0.f, qmx = 0.f;
            u32x4 kw[8], qw[8];
#pragma unroll
            for (int i8 = 0; i8 < 8; ++i8) { const int r2 = wave + 8 * i8; const int rw = row0 + (r2 < nrows ? r2 : 0); kw[i8] = *(const u32x4*)(Kg + (size_t)rw * 512 + 8 * lane); qw[i8] = *(const u32x4*)(Qg + (size_t)rw * 512 + 8 * lane); }
#pragma unroll
            for (int i8 = 0; i8 < 8; ++i8) { const u32x4 a = kw[i8], c = qw[i8];
                float sk = (bflo(a.x) * bflo(a.x) + bfhi(a.x) * bfhi(a.x)) + (bflo(a.y) * bflo(a.y) + bfhi(a.y) * bfhi(a.y)) + (bflo(a.z) * bflo(a.z) + bfhi(a.z) * bfhi(a.z)) + (bflo(a.w) * bflo(a.w) + bfhi(a.w) * bfhi(a.w));
                float sq = (bflo(c.x) * bflo(c.x) + bfhi(c.x) * bfhi(c.x)) + (bflo(c.y) * bflo(c.y) + bfhi(c.y) * bfhi(c.y)) + (bflo(c.z) * bflo(c.z) + bfhi(c.z) * bfhi(c.z)) + (bflo(c.w) * bflo(c.w) + bfhi(c.w) * bfhi(c.w));
                sk += lane_xor<1>(sk); sk += lane_xor<2>(sk); sk += lane_xor<4>(sk); sq += lane_xor<1>(sq); sq += lane_xor<2>(sq); sq += lane_xor<4>(sq);
                kmx = fmaxf(kmx, sk); qmx = fmaxf(qmx, sq); }
            if ((lane & 7) == 0) { const int hd = lane >> 3; __hip_atomic_fetch_max(&nmx[hd], __float_as_uint(kmx), __ATOMIC_RELAXED, __HIP_MEMORY_SCOPE_WORKGROUP); __hip_atomic_fetch_max(&nmx[8 + hd], __float_as_uint(qmx), __ATOMIC_RELAXED, __HIP_MEMORY_SCOPE_WORKGROUP); } }
        }
        __syncthreads();
        if (tid < 16) { unsigned* nrm = (unsigned*)(WSP() + WS_CTL) + CW_NRM + l * 64; const unsigned v = nmx[tid];
            if (isx) __hip_atomic_fetch_max(nrm + (tid >> 3) * 32 + b * 8 + (tid & 7), v, __ATOMIC_RELAXED, __HIP_MEMORY_SCOPE_AGENT);
            else if (tid < 8) { for (int bb = 0; bb < NB; ++bb) __hip_atomic_fetch_max(nrm + bb * 8 + tid, v, __ATOMIC_RELAXED, __HIP_MEMORY_SCOPE_AGENT); } }
        __syncthreads();
    }
}
__device__ __forceinline__ void s_item_poolconv(Frame& F, int l, int it32) {
    const int hw = F.wave >> 2, hwave = F.wave & 3; LAS unsigned char* lds = F.lds + hw * 64512;
    const bool isx = it32 < 1024; const int row0 = isx ? it32 * 32 : TX; const int b = isx ? (it32 * 32) / SEQ : 0; const int t0 = isx ? (it32 * 32) % SEQ : 0; const int nrows = isx ? 32 : NMETA;
    { unsigned char* ws = WSP(); int tid = F.tid & 255; LAUNDER_V(tid);
      const bf16* Ab = (const bf16*)(ws + WS_A); bf16* DIFF = (bf16*)(ws + WS_X3);
      LAS unsigned char* T = lds;
      { u32x4 tv[6]; const int nld = (15 + nrows) * 32;
#pragma unroll
        for (int j = 0; j < 6; ++j) { const int i = tid + 256 * j; const int sl = i >> 5, ch = i & 31; const int r = i < nld ? srcrow(isx, b, t0 + sl - 15) : -1; unsigned z_ = 0u; LAUNDER_V(z_);
            tv[j] = r >= 0 ? *(const u32x4*)(Ab + (size_t)r * 256 + ch * 8) : (u32x4){z_, z_, z_, z_}; }
#pragma unroll
        for (int j = 0; j < 6; ++j) { const int i = tid + 256 * j; if (i < nld) *(LAS u32x4*)(T + (i >> 5) * 512 + (i & 31) * 16) = tv[j]; } }
      __syncthreads();
#pragma unroll 1
      for (int i = tid; i < nrows * 32; i += 256) { const int r = i >> 5, ch = i & 31, grp = ch >> 3, w = 2 << grp; const int cnt = isx ? w : min(t0 + r + 1, w);
          float s[8];
#pragma unroll
          for (int j = 0; j < 8; ++j) s[j] = 0.f;
#pragma unroll 4
          for (int d = 0; d < cnt; ++d) { const u32x4 v = *(const LAS u32x4*)(T + (15 + r - d) * 512 + ch * 16);
              s[0] += bflo(v.x); s[1] += bfhi(v.x); s[2] += bflo(v.y); s[3] += bfhi(v.y); s[4] += bflo(v.z); s[5] += bfhi(v.z); s[6] += bflo(v.w); s[7] += bfhi(v.w); }
          const u32x4 a = *(const LAS u32x4*)(T + (15 + r) * 512 + ch * 16); const float ic = 1.0f / (float)cnt;
          u32x4 o; o.x = pk2(s[0] * ic - bflo(a.x), s[1] * ic - bfhi(a.x)); o.y = pk2(s[2] * ic - bflo(a.y), s[3] * ic - bfhi(a.y));
          o.z = pk2(s[4] * ic - bflo(a.z), s[5] * ic - bfhi(a.z)); o.w = pk2(s[6] * ic - bflo(a.w), s[7] * ic - bfhi(a.w));
          if (row0 + r < TR) *(u32x4*)(DIFF + (size_t)(row0 + r) * 1024 + ch * 8) = o; }
      __syncthreads(); }
    { unsigned char* ws = WSP(); int tid = F.tid & 255; LAUNDER_V(tid);
      const bf16* GLU = (const bf16*)(ws + WS_GLU);
      LAS unsigned char* T = lds;
      LAS float* Yt = (LAS float*)(lds + 31744);
      { u32x4 tv[8]; const int nld = (isx ? 62 : 46) * 32;
#pragma unroll
        for (int j = 0; j < 8; ++j) { const int i = tid + 256 * j; const int sl = i >> 5, ch = i & 31; const int r = i < nld ? srcrow(isx, b, t0 + sl - 30) : -1; unsigned z_ = 0u; LAUNDER_V(z_);
            tv[j] = r >= 0 ? *(const u32x4*)(GLU + (size_t)r * 256 + ch * 8) : (u32x4){z_, z_, z_, z_}; }
#pragma unroll
        for (int j = 0; j < 8; ++j) { const int i = tid + 256 * j; if (i < 62 * 32) *(LAS u32x4*)(T + (i >> 5) * 512 + (i & 31) * 16) = tv[j]; } }
      __syncthreads();
      { const float* cw = INP(I_CW) + (size_t)l * 31 * 256; const float* cb = INP(I_CB) + l * 256;
        const int cp = tid & 127, strip = tid >> 7; f32x2 wv[31];
#pragma unroll
        for (int j = 0; j < 31; ++j) wv[j] = *(const f32x2*)(cw + j * 256 + 2 * cp);
        const f32x2 bias = *(const f32x2*)(cb + 2 * cp);
#pragma unroll 1
        for (int hh = 0; hh < 2; ++hh) { const int rb = 16 * strip + 8 * hh; f32x2 acc[8];
#pragma unroll
            for (int r = 0; r < 8; ++r) acc[r] = bias;
#pragma unroll
            for (int i = 0; i < 38; ++i) { const unsigned xw = *(const LAS unsigned*)(T + (rb + i) * 512 + cp * 4); const f32x2 xx = {bflo(xw), bfhi(xw)};
#pragma unroll
                for (int r = 0; r < 8; ++r) { const int j = i - r; if (j >= 0 && j <= 30) acc[r] += wv[j] * xx; } }
#pragma unroll
            for (int r = 0; r < 8; ++r) *(LAS f32x2*)(Yt + (rb + r) * 256 + 2 * cp) = acc[r]; } }
      __syncthreads();
      { unsigned char* ws2 = WSP(); int tid2 = F.tid; LAUNDER_V(tid2); const int lane = tid2 & 63;
        bf16* BP = (bf16*)(ws2 + WS_X3) + 256; const float* lng = INP(I_LNG) + l * 256; const float* lnb = INP(I_LNB) + l * 256;
        const f32x4 gg = *(const f32x4*)(lng + 4 * lane), bb = *(const f32x4*)(lnb + 4 * lane);
#pragma unroll
        for (int i8 = 0; i8 < 8; ++i8) { const int rr = hwave + 4 * i8; if (rr >= nrows) continue; const f32x4 v = *(const LAS f32x4*)(Yt + rr * 256 + 4 * lane);
          const float mean = wave_sum(v[0] + v[1] + v[2] + v[3]) * (1.0f / 256.0f); const f32x4 dv = v - mean;
          const float var = wave_sum(dv[0] * dv[0] + dv[1] * dv[1] + dv[2] * dv[2] + dv[3] * dv[3]) * (1.0f / 256.0f); const float rs = rsqrtf(var + EPS);
          f32x4 o = dv * rs * gg + bb;
#pragma unroll
          for (int j = 0; j < 4; ++j) o[j] = o[j] * sigmoidf_(o[j]);
          u32x2 w; w.x = pk2(o[0], o[1]); w.y = pk2(o[2], o[3]); if (row0 + rr < TR) *(u32x2*)(BP + (size_t)(row0 + rr) * 1024 + 4 * lane) = w; } }
      __syncthreads(); }
}
constexpr int AT_FL = 0, AT_K = 34816, AT_VT = AT_K + 8192, AT_SC = AT_VT + 8192;
__device__ __forceinline__ void attn_scan(Frame& F, int b, int h, bool meta_only, int fl_off, int sc_off) {
    LAS float* Fl = (LAS float*)(F.lds + fl_off); LAS float* sc = (LAS float*)(F.lds + sc_off);
    const float* LFT = (const float*)(WSP() + WS_LFT); const float* LFTM = (const float*)(WSP() + WS_LFTM);
    const int tid = F.tid, lane = F.lane, wave = F.wave;
    __syncthreads();
    if (tid == 0) { float s = 0.f; for (int m = 0; m < 64; ++m) { if (m < NMETA) { s += LFTM[h * 256 + m]; Fl[m] = s * LOG2E; } else Fl[m] = 1e30f; if (m == NMETA - 1) sc[16] = s; } }
    if (meta_only) { for (int i = tid; i < 256; i += 512) Fl[64 + i] = 0.f; __syncthreads(); return; }
    float v[16]; const float* src = LFT + (size_t)(b * 8 + h) * SEQ + 16 * tid;
#pragma unroll
    for (int j = 0; j < 4; ++j) { const f32x4 q = *(const f32x4*)(src + 4 * j); v[4 * j] = q[0]; v[4 * j + 1] = q[1]; v[4 * j + 2] = q[2]; v[4 * j + 3] = q[3]; }
#pragma unroll
    for (int j = 1; j < 16; ++j) v[j] += v[j - 1];
    float incl = v[15];
#pragma unroll
    for (int o = 1; o < 64; o <<= 1) { const float up = __int_as_float(__builtin_amdgcn_ds_bpermute((lane - o) << 2, __float_as_int(incl))); if (lane >= o) incl += up; }
    if (lane == 63) sc[wave] = incl;
    __syncthreads();
    float off = sc[16];
    for (int w = 0; w < wave; ++w) off += sc[w];
    off += incl - v[15];
#pragma unroll
    for (int j = 0; j < 16; ++j) Fl[64 + 16 * tid + j] = (off + v[j]) * LOG2E;
    __syncthreads();
}
__device__ __forceinline__ void attn_unit_naive(Frame& F, int qrow0, int qpos0, int ntiles, int kvx0, int h, int nq) {
    const int tid = F.tid; const int hf = tid & 1; const bool live = (tid >> 1) < nq; const int r = live ? (tid >> 1) : 0;
    const bf16* Q = (const bf16*)(DOP() + DO_Q); const bf16* Kg = (const bf16*)(DOP() + DO_K); const bf16* Vg = (const bf16*)(DOP() + DO_V); bf16* O = (bf16*)(WSP() + WS_X3) + 512;
    LAS float* Fl = (LAS float*)(F.lds + AT_FL); LAS unsigned char* Ks = F.lds + AT_K; LAS bf16* VT = (LAS bf16*)(F.lds + AT_VT);
    const int grow = qrow0 + r, qpos = qpos0 + r;
    unsigned qp[16];
#pragma unroll
    for (int j = 0; j < 4; ++j) { const u32x4 w = *(const u32x4*)(Q + (size_t)grow * 512 + h * 64 + hf * 32 + 8 * j); qp[4 * j] = w.x; qp[4 * j + 1] = w.y; qp[4 * j + 2] = w.z; qp[4 * j + 3] = w.w; }
    const float Fq = Fl[qpos < NMETA ? qpos : qpos + 48];
    float mrun = -1e30f, lrun = 0.f, o[32];
#pragma unroll
    for (int d = 0; d < 32; ++d) o[d] = 0.f;
    const int lrow = tid >> 3, lch = tid & 7;

#pragma unroll 1
for (int i = 0; i < ntiles; ++i) {
        const int krow = (i == 0 ? TX : kvx0 + 64 * (i - 1)) + lrow;
        const u32x4 kw = *(const u32x4*)(Kg + (size_t)krow * 512 + h * 64 + lch * 8);
        const u32x4 vw = *(const u32x4*)(Vg + (size_t)krow * 512 + h * 64 + lch * 8);
        __syncthreads();
        *(LAS u32x4*)(Ks + lrow * 128 + lch * 16) = kw;
        { const unsigned vv[4] = {vw.x, vw.y, vw.z, vw.w};
#pragma unroll
          for (int e = 0; e < 4; ++e) { VT[(lch * 8 + 2 * e) * 64 + lrow] = (bf16)(vv[e] & 0xffffu); VT[(lch * 8 + 2 * e + 1) * 64 + lrow] = (bf16)(vv[e] >> 16); } }
        __syncthreads();
        const int kp0 = i == 0 ? 0 : NMETA + 64 * (i - 1);
        if (kp0 > qpos0 + 255) continue;
#pragma unroll 1
        for (int jg = 0; jg < 4; ++jg) {
            float s[16]; float gmax = -1e30f;
#pragma unroll
            for (int jj = 0; jj < 16; ++jj) { const int j = jg * 16 + jj; float d = 0.f;
#pragma unroll
                for (int c = 0; c < 4; ++c) { const u32x4 kk = *(const LAS u32x4*)(Ks + j * 128 + hf * 64 + c * 16);
                    d = dot2bf(kk.x, qp[4 * c], d); d = dot2bf(kk.y, qp[4 * c + 1], d); d = dot2bf(kk.z, qp[4 * c + 2], d); d = dot2bf(kk.w, qp[4 * c + 3], d); }
                d += lane_xor<1>(d);
                const bool valid = (i == 0 ? j < NMETA : true) && (kp0 + j <= qpos);
                s[jj] = valid ? d + Fq - Fl[64 * i + j] : -1e30f; gmax = fmaxf(gmax, s[jj]); }
            const float mn = fmaxf(mrun, gmax), alpha = exp2f(mrun - mn); mrun = mn;
            float ps = 0.f; unsigned pp[8];
#pragma unroll
            for (int jj = 0; jj < 16; jj += 2) { const float p0 = exp2f(s[jj] - mn), p1 = exp2f(s[jj + 1] - mn); ps += p0 + p1; pp[jj >> 1] = pk2(p0, p1); }
            lrun = lrun * alpha + ps;
#pragma unroll
            for (int d = 0; d < 32; ++d) { const u32x4 v0 = *(const LAS u32x4*)(VT + (hf * 32 + d) * 64 + jg * 16), v1 = *(const LAS u32x4*)(VT + (hf * 32 + d) * 64 + jg * 16 + 8);
                float a = o[d] * alpha; a = dot2bf(pp[0], v0.x, a); a = dot2bf(pp[1], v0.y, a); a = dot2bf(pp[2], v0.z, a); a = dot2bf(pp[3], v0.w, a);
                a = dot2bf(pp[4], v1.x, a); a = dot2bf(pp[5], v1.y, a); a = dot2bf(pp[6], v1.z, a); a = dot2bf(pp[7], v1.w, a); o[d] = a; }
        }
    }
    const float il = 1.0f / lrun;
    if (live)
#pragma unroll
    for (int j = 0; j < 4; ++j) { u32x4 w; w.x = pk2(o[8 * j] * il, o[8 * j + 1] * il); w.y = pk2(o[8 * j + 2] * il, o[8 * j + 3] * il); w.z = pk2(o[8 * j + 4] * il, o[8 * j + 5] * il); w.w = pk2(o[8 * j + 6] * il, o[8 * j + 7] * il);
        *(u32x4*)(O + (size_t)grow * 1024 + h * 64 + hf * 32 + 8 * j) = w; }
}
namespace fa {
using bf16x8v = __attribute__((ext_vector_type(8))) short;
using s16x4 = __attribute__((ext_vector_type(4))) short;
using f32x16 = __attribute__((ext_vector_type(16))) float;
constexpr int DMA = 512, DMO = 1024;
constexpr int NW = 8, QBLK = 32, QB = 256, KVBLK = 64;
constexpr int NSLOT = 3, SLOTB = 8192;
constexpr int LDS_K = 0, LDS_V = NSLOT * SLOTB, LDS_WS = 2 * NSLOT * SLOTB, LDS_OST = LDS_WS + NW * 64 * 4, LDS_BYTES = LDS_OST + NW * 4096;
constexpr int LDS_FL = 84992;
constexpr int LDS_SCAN = LDS_FL + (64 + 8192) * 4;
static_assert(LDS_SCAN + 128 <= RING_BYTES, "attention LDS");
__device__ __forceinline__ int crow(int r, int hi) { return (r & 3) + 8 * (r >> 2) + 4 * hi; }
#define SBAR() __builtin_amdgcn_sched_barrier(0)
__device__ __forceinline__ void cmask(f32x16& p0, f32x16& p1, int jb, int qrel, int hi) {
    const float NEG = -INFINITY; int kb = 64 * jb + 4 * hi;
#pragma unroll
    for (int r = 0; r < 16; ++r) { int kv = kb + (r & 3) + 8 * (r >> 2); if (kv > qrel) p0[r] = NEG; if (kv + 32 > qrel) p1[r] = NEG; }
}
__device__ __forceinline__ void glds16(const void* gsrc, unsigned lds_dst) { unsigned keep;
    asm volatile("s_mov_b32 %0, m0\n\ts_mov_b32 m0, %2\n\ts_nop 0\n\tglobal_load_lds_dwordx4 %1, off\n\ts_mov_b32 m0, %0" : "=&s"(keep) : "v"(gsrc), "s"(lds_dst) : "memory"); }
__device__ __forceinline__ float max3f(float a, float b, float c) { float r; asm("v_max3_f32 %0, %1, %2, %3" : "=v"(r) : "v"(a), "v"(b), "v"(c)); return r; }
__device__ __forceinline__ float max2f(float a, float b) { float r; asm("v_max_f32_e32 %0, %1, %2" : "=v"(r) : "v"(a), "v"(b)); return r; }
__device__ __forceinline__ float fsub_s(float a, float b) { float r; asm("v_sub_f32_e32 %0, %1, %2" : "=v"(r) : "v"(a), "v"(b)); return r; }
typedef float f32x2_t __attribute__((ext_vector_type(2))); typedef __bf16 bf16x2_t __attribute__((ext_vector_type(2)));
__device__ __forceinline__ unsigned cvtpk_s(float lo, float hi) { f32x2_t v = {lo, hi}; bf16x2_t b = __builtin_convertvector(v, bf16x2_t); return __builtin_bit_cast(unsigned, b); }
#define WAIT_BAR(N) asm volatile("s_waitcnt vmcnt(" #N ") lgkmcnt(0)\n\ts_barrier" ::: "memory")
typedef __attribute__((address_space(3))) const char* lds_cptr;
typedef short v4i16_t __attribute__((ext_vector_type(4)));
__device__ __forceinline__ void cinit(f32x16& p0, f32x16& p1, const LAS float* fk, float a) {
#pragma unroll
    for (int g = 0; g < 4; ++g) { const f32x4 f0 = *(const LAS f32x4*)(fk + 8 * g), f1 = *(const LAS f32x4*)(fk + 32 + 8 * g);
#pragma unroll
        for (int i = 0; i < 4; ++i) { p0[4 * g + i] = a - f0[i]; p1[4 * g + i] = a - f1[i]; } }
}
__device__ __forceinline__ void qkt(f32x16& p0, f32x16& p1, const char* Kslot, const bf16x8v* qr, int r32, int hi) {
    const char* kb = Kslot + hi * 1024 + r32 * 16;
#pragma unroll
    for (int d0 = 0; d0 < 4; ++d0) {
        const bf16x8v b0 = *reinterpret_cast<const bf16x8v*>(kb + d0 * 2048);
        const bf16x8v b1 = *reinterpret_cast<const bf16x8v*>(kb + d0 * 2048 + 512);
        p0 = __builtin_amdgcn_mfma_f32_32x32x16_bf16(b0, qr[d0], p0, 0, 0, 0); p1 = __builtin_amdgcn_mfma_f32_32x32x16_bf16(b1, qr[d0], p1, 0, 0, 0); }
}
__device__ __forceinline__ void kload8(bf16x8v* kf, lds_cptr kp) {
    kf[0] = *(const LAS bf16x8v*)(kp);        kf[1] = *(const LAS bf16x8v*)(kp + 512);
    kf[2] = *(const LAS bf16x8v*)(kp + 2048); kf[3] = *(const LAS bf16x8v*)(kp + 2560);
    kf[4] = *(const LAS bf16x8v*)(kp + 4096); kf[5] = *(const LAS bf16x8v*)(kp + 4608);
    kf[6] = *(const LAS bf16x8v*)(kp + 6144); kf[7] = *(const LAS bf16x8v*)(kp + 6656);
}
__device__ __forceinline__ void kload2(bf16x8v* kf, lds_cptr kp, int j) { kf[2 * j] = *(const LAS bf16x8v*)(kp + j * 2048); kf[2 * j + 1] = *(const LAS bf16x8v*)(kp + j * 2048 + 512); }
__device__ __forceinline__ s16x4 vtr(lds_cptr p) { return __builtin_bit_cast(s16x4, __builtin_amdgcn_ds_read_tr16_b64_v4i16((LAS v4i16_t*)p)); }
__device__ __forceinline__ float rowmax(const f32x16& p0, const f32x16& p1) {
    float a = max3f(p0[0], p0[1], p1[0]), b = max3f(p0[2], p0[3], p1[1]); a = max3f(a, p1[2], p1[3]);
#pragma unroll
    for (int r = 4; r < 16; r += 4) { a = max3f(a, p0[r], p0[r + 1]); b = max3f(b, p0[r + 2], p0[r + 3]); a = max3f(a, p1[r], p1[r + 1]); b = max3f(b, p1[r + 2], p1[r + 3]); }
    const float m = max2f(a, b);
    auto rr = __builtin_amdgcn_permlane32_swap(__float_as_uint(m), __float_as_uint(m), false, false);
    return max2f(__uint_as_float(rr[0]), __uint_as_float(rr[1]));
}
__device__ __forceinline__ void pv(f32x16* o, int vb, bf16x8v pa0, bf16x8v pa1, bf16x8v pa2, bf16x8v pa3) {
#pragma unroll
    for (int d0 = 0; d0 < 2; ++d0) { s16x4 lo[4], hi[4];
#pragma unroll
        for (int ks = 0; ks < 4; ++ks) {
            asm volatile("ds_read_b64_tr_b16 %0,%1 offset:%c2" : "=&v"(lo[ks]) : "v"(vb), "i"(d0 * 4096 + ks * 1024) : "memory");
            asm volatile("ds_read_b64_tr_b16 %0,%1 offset:%c2" : "=&v"(hi[ks]) : "v"(vb), "i"(d0 * 4096 + ks * 1024 + 512) : "memory"); }
        asm volatile("s_waitcnt lgkmcnt(0)" ::: "memory"); SBAR();
#define PK(k) (bf16x8v){lo[k][0], lo[k][1], lo[k][2], lo[k][3], hi[k][0], hi[k][1], hi[k][2], hi[k][3]}
        o[d0] = __builtin_amdgcn_mfma_f32_32x32x16_bf16(pa0, PK(0), o[d0], 0, 0, 0);
        o[d0] = __builtin_amdgcn_mfma_f32_32x32x16_bf16(pa1, PK(1), o[d0], 0, 0, 0);
        o[d0] = __builtin_amdgcn_mfma_f32_32x32x16_bf16(pa2, PK(2), o[d0], 0, 0, 0);
        o[d0] = __builtin_amdgcn_mfma_f32_32x32x16_bf16(pa3, PK(3), o[d0], 0, 0, 0);
#undef PK
    }
}
template <int THRL> __device__ __forceinline__ void attn_unit(int b, int h, int qb, int tf, const bf16* Q, const bf16* __restrict__ K, const bf16* __restrict__ V, bf16* O, char* shm, int wid) {
    const int lane = lane_id_opaque(), r32 = lane & 31, hi = lane >> 5;
    const long rowbase = (long)b * SEQ; const int q0 = qb * QB;
    const bf16* Qw = Q + (rowbase + q0 + wid * QBLK) * DMA + h * 64;
    const bf16* Kh = K + rowbase * DMA + h * 64, *Vh = V + rowbase * DMA + h * 64;
    const bf16* Km = K + (long)TX * DMA + h * 64, *Vm = V + (long)TX * DMA + h * 64;
    const unsigned lds0 = (unsigned)(uintptr_t)shm;
    float* wsf = (float*)(shm + LDS_WS) + wid * 64;
    const bf16* ksrc = Kh + (long)lane * DMA + wid * 8;
    const bf16* vsrc = Vh + (long)(16 * (wid & 3) + (lane >> 2)) * DMA + (wid >> 2) * 32 + (lane & 3) * 8;
    const bf16* ksrcm = Km + (long)lane * DMA + wid * 8;
    const bf16* vsrcm = Vm + (long)(16 * (wid & 3) + (lane >> 2)) * DMA + (wid >> 2) * 32 + (lane & 3) * 8;
    const unsigned kdst = lds0 + LDS_K + wid * 1024, vdst = lds0 + LDS_V + wid * 1024;
#define DMA_K(t, slot) glds16(ksrc + (long)((t) - 1) * KVBLK * DMA, (unsigned)__builtin_amdgcn_readfirstlane(kdst + (slot)))
#define DMA_V(t, slot) glds16(vsrc + (long)((t) - 1) * KVBLK * DMA, (unsigned)__builtin_amdgcn_readfirstlane(vdst + (slot)))
    const int vb0 = (int)(lds0 + LDS_V) + ((lane >> 4) & 1) * 32 + (lane & 3) * 8 + (4 * hi + ((lane & 15) >> 2)) * 64;
    const char* Kbase = shm + LDS_K; bf16x8v kf[8];
    const lds_cptr shm3 = (lds_cptr)shm; const lds_cptr kp0 = shm3 + LDS_K + hi * 1024 + r32 * 16; const lds_cptr vp0 = shm3 + LDS_V + ((lane >> 4) & 1) * 32 + (lane & 3) * 8 + (4 * hi + ((lane & 15) >> 2)) * 64;
    const LAS float* Flp = (const LAS float*)(shm3 + LDS_FL) + 4 * hi;
    const int NT = 4 * qb + 5;
    glds16(tf == 0 ? ksrcm : ksrc + (long)(tf - 1) * KVBLK * DMA, (unsigned)__builtin_amdgcn_readfirstlane(kdst)); glds16(tf == 0 ? vsrcm : vsrc + (long)(tf - 1) * KVBLK * DMA, (unsigned)__builtin_amdgcn_readfirstlane(vdst)); DMA_K(tf + 1, SLOTB);
    bf16x8v qr[4];
#pragma unroll
    for (int d0 = 0; d0 < 4; ++d0) qr[d0] = *reinterpret_cast<const bf16x8v*>(&Qw[(long)r32 * DMA + d0 * 16 + hi * 8]);
    float aq = ((const LAS float*)(shm3 + LDS_FL))[64 + q0 + wid * QBLK + r32 - 64 * tf];
    float l_reg = 0.f; f32x16 o[2]; o[0] = f32x16{}; o[1] = f32x16{};
    const int qrel = wid * QBLK + r32;
#define CMASK(P0, P1, t) do { int jb_ = (t) - (NT - 4); if (jb_ >= 0) cmask(P0, P1, jb_, qrel, hi); } while (0)
    bool resc = false;
#define START(P0, P1) do { const float rm = rowmax(P0, P1); resc = false; \
    { const float dl = max2f(rm, 0.f); aq = fsub_s(aq, dl);        \
      _Pragma("unroll") for (int r = 0; r < 16; ++r) { P0[r] = fsub_s(P0[r], dl); P1[r] = fsub_s(P1[r], dl); } } \
    _Pragma("unroll") for (int r = 0; r < 16; ++r) P0[r] = __builtin_amdgcn_exp2f(P0[r]); } while (0)
#define RESC() do { if (resc) { asm volatile("s_waitcnt lgkmcnt(0)" ::: "memory"); \
      _Pragma("unroll") for (int d_ = 0; d_ < 2; ++d_) _Pragma("unroll") for (int r = 0; r < 16; ++r) o[d_][r] *= wsf[crow(r, hi)]; } } while (0)
    f32x16 pA0, pA1, pB0, pB1;
    int sl_prev = 0, sl_cur = 0, sl_next = SLOTB;
#define ROT() do { sl_prev = sl_cur; sl_cur = sl_next; sl_next = (sl_next == (NSLOT - 1) * SLOTB) ? 0 : sl_next + SLOTB; } while (0)
    DMA_K(tf + 2, 2 * SLOTB);
    cinit(pA0, pA1, Flp, aq);
    WAIT_BAR(3);
    qkt(pA0, pA1, Kbase, qr, r32, hi); asm volatile("s_nop 15\n\ts_nop 7" : "+v"(pA0), "+v"(pA1));
    START(pA0, pA1);
    _Pragma("unroll") for (int r = 0; r < 16; ++r) pA1[r] = __builtin_amdgcn_exp2f(pA1[r]);
    WAIT_BAR(0);
    DMA_K(tf + 3, 0); DMA_V(tf + 1, SLOTB);
    ROT();
    kload8(kf, kp0 + sl_cur);
    WAIT_BAR(2);
    s16x4 vlo[8], vhi[8]; u32x4 pw0, pw1, pw2, pw3;
#define PKW(P, B) cvtpk_s(P[B], P[B + 1])
#define PAF(k) __builtin_bit_cast(bf16x8v, pw##k)
#define VFR(i) (bf16x8v){vlo[i][0], vlo[i][1], vlo[i][2], vlo[i][3], vhi[i][0], vhi[i][1], vhi[i][2], vhi[i][3]}
#define PIN(x) asm volatile("" : "+v"(x))
#define MX3(a, b, c) __builtin_fmaxf(__builtin_fmaxf((a), (b)), (c))
#define GAPA(MF, A0, A1, A2, A3, W0, W1, PW) do { MF; sacc += A0; sacc += A1; sacc += A2; sacc += A3; PIN(sacc); W0; W1; PIN(PW); SBAR(); } while (0)
#define EX(v) __builtin_amdgcn_exp2f(v)
#define GAPB(MF, X, B) do { MF; X[B] = EX(X[B]); X[B + 1] = EX(X[B + 1]); X[B + 2] = EX(X[B + 2]); X[B + 3] = EX(X[B + 3]); PIN(X); SBAR(); } while (0)
#define VRD(i) do { vlo[i] = vtr(vp_ + (((i) >> 2) * 4096 + ((i) & 3) * 1024)); vhi[i] = vtr(vp_ + (((i) >> 2) * 4096 + ((i) & 3) * 1024 + 512)); } while (0)
#define KRD(G, j) do { if (G) { kload2(kf, kp0 + sl_next, j); SBAR(); } } while (0)
#define STEP(C0, C1, P0, P1, t, GK, GV, GL) do { SBAR(); \
    cinit(C0, C1, Flp + 64 * ((t) - tf), aq); SBAR(); \
    const lds_cptr vp_ = vp0 + sl_prev; \
    VRD(0); SBAR(); float sacc = (P0[0] + P0[1]); \
    GAPA(C0 = __builtin_amdgcn_mfma_f32_32x32x16_bf16(kf[0], qr[0], C0, 0, 0, 0), P0[2], P0[3], P0[4], P0[5],     pw0[0] = PKW(P0, 0), pw0[1] = PKW(P0, 2), pw0); \
    VRD(4); SBAR(); GAPA(C1 = __builtin_amdgcn_mfma_f32_32x32x16_bf16(kf[1], qr[0], C1, 0, 0, 0), P0[6], P0[7], P0[8], P0[9],     pw0[2] = PKW(P0, 4), pw0[3] = PKW(P0, 6), pw0); \
    VRD(1); SBAR(); GAPA(C0 = __builtin_amdgcn_mfma_f32_32x32x16_bf16(kf[2], qr[1], C0, 0, 0, 0),   P0[10], P0[11], P0[12], P0[13], pw1[0] = PKW(P0, 8), pw1[1] = PKW(P0, 10), pw1); \
    VRD(5); SBAR(); GAPA(C1 = __builtin_amdgcn_mfma_f32_32x32x16_bf16(kf[3], qr[1], C1, 0, 0, 0),   P0[14], P0[15], P1[0], P1[1],   pw1[2] = PKW(P0, 12), pw1[3] = PKW(P0, 14), pw1); \
    VRD(2); SBAR(); GAPA(C0 = __builtin_amdgcn_mfma_f32_32x32x16_bf16(kf[4], qr[2], C0, 0, 0, 0),   P1[2], P1[3], P1[4], P1[5],     pw2[0] = PKW(P1, 0), pw2[1] = PKW(P1, 2), pw2); \
    VRD(6); SBAR(); GAPA(C1 = __builtin_amdgcn_mfma_f32_32x32x16_bf16(kf[5], qr[2], C1, 0, 0, 0),   P1[6], P1[7], P1[8], P1[9],     pw2[2] = PKW(P1, 4), pw2[3] = PKW(P1, 6), pw2); \
    VRD(3); SBAR(); GAPA(C0 = __builtin_amdgcn_mfma_f32_32x32x16_bf16(kf[6], qr[3], C0, 0, 0, 0),   P1[10], P1[11], P1[12], P1[13], pw3[0] = PKW(P1, 8), pw3[1] = PKW(P1, 10), pw3); \
    VRD(7); SBAR(); GAPA(C1 = __builtin_amdgcn_mfma_f32_32x32x16_bf16(kf[7], qr[3], C1, 0, 0, 0),   P1[14], P1[15], 0.f, 0.f,       pw3[2] = PKW(P1, 12), pw3[3] = PKW(P1, 14), pw3); \
    l_reg += sacc; \
    if (GK) { DMA_K((t) + 3, sl_cur); } if (GV) { DMA_V((t) + 1, sl_next); } \
    CMASK(C0, C1, t); \
    { float a = MX3(C0[0], C0[1], C1[0]), b_ = MX3(C0[2], C0[3], C1[1]); a = MX3(a, C1[2], C1[3]); \
      _Pragma("unroll") for (int r = 4; r < 16; r += 4) { a = MX3(a, C0[r], C0[r + 1]); b_ = MX3(b_, C0[r + 2], C0[r + 3]); a = MX3(a, C1[r], C1[r + 1]); b_ = MX3(b_, C1[r + 2], C1[r + 3]); } \
      float rm = __builtin_fmaxf(a, b_); { auto rr = __builtin_amdgcn_permlane32_swap(__float_as_uint(rm), __float_as_uint(rm), false, false); rm = __builtin_fmaxf(__uint_as_float(rr[0]), __uint_as_float(rr[1])); } \
      resc = false; \
      if (__builtin_expect(__any(rm > (float)THRL), 0)) { const float dl = __builtin_fmaxf(rm, 0.f); aq -= dl; \
        _Pragma("unroll") for (int r = 0; r < 16; ++r) { C0[r] -= dl; C1[r] -= dl; } \
        const float f = __builtin_amdgcn_exp2f(-dl); l_reg *= f; if (hi == 0) wsf[r32] = f; resc = true; } } \
    SBAR(); \
    GAPB(o[0] = __builtin_amdgcn_mfma_f32_32x32x16_bf16(PAF(0), VFR(0), o[0], 0, 0, 0), C0, 0); \
    GAPB(o[1] = __builtin_amdgcn_mfma_f32_32x32x16_bf16(PAF(0), VFR(4), o[1], 0, 0, 0), C0, 4); \
    KRD(GL, 0); GAPB(o[0] = __builtin_amdgcn_mfma_f32_32x32x16_bf16(PAF(1), VFR(1), o[0], 0, 0, 0), C0, 8); \
    KRD(GL, 1); GAPB(o[1] = __builtin_amdgcn_mfma_f32_32x32x16_bf16(PAF(1), VFR(5), o[1], 0, 0, 0), C0, 12); \
    KRD(GL, 2); GAPB(o[0] = __builtin_amdgcn_mfma_f32_32x32x16_bf16(PAF(2), VFR(2), o[0], 0, 0, 0), C1, 0); \
    KRD(GL, 3); GAPB(o[1] = __builtin_amdgcn_mfma_f32_32x32x16_bf16(PAF(2), VFR(6), o[1], 0, 0, 0), C1, 4); \
    GAPB(o[0] = __builtin_amdgcn_mfma_f32_32x32x16_bf16(PAF(3), VFR(3), o[0], 0, 0, 0), C1, 8); \
    GAPB(o[1] = __builtin_amdgcn_mfma_f32_32x32x16_bf16(PAF(3), VFR(7), o[1], 0, 0, 0), C1, 12); \
    } while (0)
    int t = tf + 1;
#undef CMASK
#define CMASK(P0, P1, t) do { } while (0)
    for (; t + 5 < NT; t += 2) {
        STEP(pB0, pB1, pA0, pA1, t, true, true, true);     WAIT_BAR(2); RESC(); ROT();
        STEP(pA0, pA1, pB0, pB1, t + 1, true, true, true); WAIT_BAR(2); RESC(); ROT();
    }
#undef CMASK
#define CMASK(P0, P1, t) do { int jb_ = (t) - (NT - 4); if (jb_ >= 0) cmask(P0, P1, jb_, qrel, hi); } while (0)
#define ENDW(tt) do { if ((tt) + 3 < NT) { WAIT_BAR(2); } else if ((tt) + 2 < NT) { WAIT_BAR(1); } else { WAIT_BAR(0); } } while (0)
    for (; t + 1 < NT; t += 2) {
        STEP(pB0, pB1, pA0, pA1, t, (t + 3 < NT), (t + 1 < NT), (t + 1 < NT));         ENDW(t);     RESC(); ROT();
        STEP(pA0, pA1, pB0, pB1, t + 1, (t + 4 < NT), (t + 2 < NT), (t + 2 < NT));     ENDW(t + 1); RESC(); ROT();
    }
    { float sacc = pA0[0] + pA0[1]; _Pragma("unroll") for (int r = 2; r < 16; ++r) sacc += pA0[r]; _Pragma("unroll") for (int r = 0; r < 16; ++r) sacc += pA1[r]; l_reg += sacc;
      pw0 = (u32x4){PKW(pA0, 0), PKW(pA0, 2), PKW(pA0, 4), PKW(pA0, 6)}; pw1 = (u32x4){PKW(pA0, 8), PKW(pA0, 10), PKW(pA0, 12), PKW(pA0, 14)}; pw2 = (u32x4){PKW(pA1, 0), PKW(pA1, 2), PKW(pA1, 4), PKW(pA1, 6)}; pw3 = (u32x4){PKW(pA1, 8), PKW(pA1, 10), PKW(pA1, 12), PKW(pA1, 14)};
      SBAR(); pv(o, vb0 + sl_prev, PAF(0), PAF(1), PAF(2), PAF(3)); }
#undef PKW
#undef PAF
#undef VFR
#undef PIN
#undef MX3
#undef GAPA
#undef GAPB
#undef EX
#undef VRD
#undef KRD
#undef STEP
#undef ENDW
    { auto rr = __builtin_amdgcn_permlane32_swap(__float_as_uint(l_reg), __float_as_uint(l_reg), false, false); l_reg = __uint_as_float(rr[0]) + __uint_as_float(rr[1]); }
    if (hi == 0) wsf[32 + r32] = l_reg; asm volatile("s_waitcnt lgkmcnt(0)" ::: "memory");
    float rli[16];
#pragma unroll
    for (int r = 0; r < 16; ++r) rli[r] = __builtin_amdgcn_rcpf(wsf[32 + crow(r, hi)]);
    bf16* Ow = O + (rowbase + q0 + wid * QBLK) * DMO + h * 64;
    { bf16* stg = (bf16*)(shm + LDS_OST) + wid * 2048;
#pragma unroll
      for (int r = 0; r < 16; ++r) { const int orow = crow(r, hi);
#pragma unroll
          for (int d0 = 0; d0 < 2; ++d0) stg[orow * 64 + d0 * 32 + r32] = (bf16)f2bf(o[d0][r] * rli[r]); }
      asm volatile("s_waitcnt lgkmcnt(0)" ::: "memory");
#pragma unroll
      for (int i = 0; i < 4; ++i) { const int row = i * 8 + (lane >> 3), ch = lane & 7; const u32x4 v = *(const u32x4*)(stg + row * 64 + ch * 8); *(u32x4*)(Ow + (long)row * DMO + ch * 8) = v; } }
    asm volatile("s_waitcnt lgkmcnt(0)\n\ts_barrier" ::: "memory");
#undef DMA_K
#undef DMA_V
#undef CMASK
#undef START
#undef RESC
#undef ROT
}
#undef SBAR
#undef WAIT_BAR
}
__device__ __forceinline__ void phase_scan(Frame& F, int l) {
    if (F.G > 32 && F.vcu >= 32) norm_items(F, l, F.vcu - 32, F.G - 32); else if (F.G <= 32) norm_items(F, l, F.vcu, F.G);
#pragma unroll 1
    for (int bh = F.vcu; bh < 32; bh += F.G) {
        attn_scan(F, bh >> 3, bh & 7, false, fa::LDS_FL, fa::LDS_SCAN);
        const LAS float* Fl = (const LAS float*)(F.lds + fa::LDS_FL); float* FLg = (float*)(WSP() + WS_FL) + (size_t)bh * FLN;
#pragma unroll 1
        for (int i = F.tid; i < FLN / 4; i += 512) *(f32x4*)(FLg + 4 * i) = *(const LAS f32x4*)(Fl + 4 * i);
    }
    __syncthreads();
}
__device__ __forceinline__ void phase_B(Frame& F, int l) {
    LAS int* qs = (LAS int*)(F.lds + LC_QS);
    unsigned* ctl = (unsigned*)(WSP() + WS_CTL); unsigned* head = ctl + CW_AQ + l * 64; const unsigned* nrm = ctl + CW_NRM + l * 64;
    const float* FLg = (const float*)(WSP() + WS_FL);
#pragma unroll 1
    for (;;) {
        __syncthreads();
        if (F.tid == 0) { qs[0] = (int)atomicAdd(head, 1u); qs[1] = 0; }
        __syncthreads();
        const int u = __builtin_amdgcn_readfirstlane(qs[0]);
        if (u >= 1032) break;
        if (u < 1024) {
            const int qb = 31 - (u >> 5), bh = u & 31, b = bh >> 3, h = bh & 7, NT = 4 * qb + 5;
            const float kn = __uint_as_float(__hip_atomic_load(nrm + bh, __ATOMIC_RELAXED, __HIP_MEMORY_SCOPE_AGENT)), qn = __uint_as_float(__hip_atomic_load(nrm + 32 + bh, __ATOMIC_RELAXED, __HIP_MEMORY_SCOPE_AGENT));
            const float T = 36.0f + sqrtf(kn * qn);
            const float* FLb = FLg + (size_t)bh * FLN; const float Fq0 = FLb[64 + 256 * qb];
            { const int t = F.tid; const bool skip = (t <= NT - 5) && (FLb[t == 0 ? 15 : 64 * t + 63] > Fq0 + T);
              const int c = __builtin_popcountll(__ballot(skip)); if (F.lane == 0 && c) __hip_atomic_fetch_add(&qs[1], c, __ATOMIC_RELAXED, __HIP_MEMORY_SCOPE_WORKGROUP); }
            __syncthreads();
            int tf = __builtin_amdgcn_readfirstlane(qs[1]); if (((NT - tf) & 1) == 0) tf -= 1;
            { LAS float* Fl = (LAS float*)(F.lds + fa::LDS_FL); const int n4 = (NT - tf) * 16;
#pragma unroll 1
              for (int i = F.tid; i < n4; i += 512) *(LAS f32x4*)(Fl + 4 * i) = *(const f32x4*)(FLb + 64 * tf + 4 * i); }
            __syncthreads();
            unsigned char* dol = DOP();
            fa::attn_unit<8>(b, h, qb, tf, (const bf16*)(dol + DO_Q), (const bf16*)(dol + DO_K), (const bf16*)(dol + DO_V), (bf16*)(WSP() + WS_X3) + 512, (char*)F.lds, F.wave);
        } else {
            const int t_ = F.wave * 64 + lane_id_opaque(); F.tid = t_; F.lane = t_ & 63;
            attn_scan(F, 0, u - 1024, true, AT_FL, AT_SC); attn_unit_naive(F, TX, 0, 1, 0, u - 1024, NMETA);
        }
    }
    __syncthreads();
    { unsigned* head3 = ctl + CW_AQ + 48 + l * 64;
#pragma unroll 1
      for (;;) { __syncthreads(); if (F.tid == 0) qs[0] = (int)atomicAdd(head3, 1u); __syncthreads();
          const int it = __builtin_amdgcn_readfirstlane(qs[0]); if (it >= 513) break;
          { const int t_ = F.wave * 64 + lane_id_opaque(); F.tid = t_; F.lane = t_ & 63; }
          { const int i32 = 2 * it + (F.wave >> 2); s_item_poolconv(F, l, i32 < 1024 ? i32 : 1024); } } }
    { unsigned* head2 = ctl + CW_AQ + 32 + l * 64; LAS float* scr = (LAS float*)(F.lds + F.wave * 16384);
#pragma unroll 1
      for (;;) { __syncthreads(); if (F.tid == 0) qs[0] = (int)atomicAdd(head2, 1u); __syncthreads();
          const int c = __builtin_amdgcn_readfirstlane(qs[0]); if (c >= 768) break;
          convert_item(F, l, 3584 + 8 * c + F.wave, scr, lane_id_opaque()); } }
    __syncthreads();
}

__device__ __forceinline__ void class_tables(Frame& F, int l) {
    LAS int* base = (LAS int*)(F.lds + LC_BASE); LAS int* pcls = (LAS int*)(F.lds + LC_PCLS); LAS int* np = (LAS int*)(F.lds + LC_NP);
    const unsigned* gcnt = (const unsigned*)(WSP() + WS_CTL) + CW_GCNT + l * 64;
    __syncthreads();
    if (F.tid == 0) { int p = 0;
#pragma unroll 1
        for (int c = 0; c < NCLS; ++c) { base[c] = p * 256; int n = (int)__hip_atomic_load(gcnt + c, __ATOMIC_RELAXED, __HIP_MEMORY_SCOPE_AGENT); if (n > TR) n = TR; if (n < 0) n = 0; p += (n + 255) >> 8; }
        if (p > 160) p = 160; base[NCLS] = p * 256; np[0] = p; }
    __syncthreads();
    if (F.tid < 160) { const int mypos = F.tid * 256; int c = 0;
#pragma unroll 1
        for (int k = 1; k < NCLS; ++k) if (base[k] <= mypos) c = k;
        pcls[F.tid] = c; }
    __syncthreads();
}
template <int NG, int CH> __device__ __forceinline__ void e1_groups(Frame& F, int l, const int (&rowv)[NG], const int (&grpv)[NG], const LAS bf16* Rhi, const LAS bf16* Rlo, LAS int* rec, LAS int* lcnt,
                                                                   const float* reb, const float* rgb, int fr, int fq) {
    const float* hsrc[NG]; bf16* hbdst[NG]; const bf16* dsrc[NG];
#pragma unroll
    for (int g = 0; g < NG; ++g) { const int row = rowv[g];
        hsrc[g] = l == 0 ? (row < TX ? INP(I_X) + (size_t)row * D : INP(I_META) + (size_t)(row - TX) * D) : (const float*)(WSP() + WS_H) + (size_t)row * D;
        hbdst[g] = (bf16*)(WSP() + WS_HB) + (size_t)row * D; dsrc[g] = (const bf16*)(WSP() + WS_X3) + (size_t)row * D; }
    const LAS bf16* bh0 = Rhi + fr * RPITCH + 8 * fq; const LAS bf16* bl0 = Rlo + fr * RPITCH + 8 * fq;
    const LAS bf16* bh1 = Rhi + (16 + (fr & 3)) * RPITCH + 8 * fq; const LAS bf16* bl1 = Rlo + (16 + (fr & 3)) * RPITCH + 8 * fq;
    f32x4 acc0[NG], acc1[NG]; float ss[NG];
#pragma unroll
    for (int g = 0; g < NG; ++g) { acc0[g] = (f32x4){0.f, 0.f, 0.f, 0.f}; acc1[g] = acc0[g]; ss[g] = 0.f; }
    f32x4 ch0[NG][CH], ch1[NG][CH]; u32x4 cd[NG][CH];
#pragma unroll
    for (int g = 0; g < NG; ++g)
#pragma unroll
        for (int c = 0; c < CH; ++c) { const int k = 32 * c + 8 * fq; ch0[g][c] = *(const f32x4*)(hsrc[g] + k); ch1[g][c] = *(const f32x4*)(hsrc[g] + k + 4); cd[g][c] = *(const u32x4*)(dsrc[g] + k); }
#pragma unroll 1
    for (int s0 = 0; s0 < 32; s0 += CH) {
        f32x4 nh0[NG][CH], nh1[NG][CH]; u32x4 nd[NG][CH];
        if (s0 + CH < 32) {
#pragma unroll
            for (int g = 0; g < NG; ++g)
#pragma unroll
                for (int c = 0; c < CH; ++c) { const int k = 32 * (s0 + CH + c) + 8 * fq; nh0[g][c] = *(const f32x4*)(hsrc[g] + k); nh1[g][c] = *(const f32x4*)(hsrc[g] + k + 4); nd[g][c] = *(const u32x4*)(dsrc[g] + k); }
        }
#pragma unroll
        for (int c = 0; c < CH; ++c) { const int s = s0 + c, k = 32 * s + 8 * fq;
            const bf16x8 wh0 = *(const LAS bf16x8*)(bh0 + 32 * s), wl0 = *(const LAS bf16x8*)(bl0 + 32 * s);
            bf16x8 wh1 = *(const LAS bf16x8*)(bh1 + 32 * s), wl1 = *(const LAS bf16x8*)(bl1 + 32 * s);
            if (fr >= 4) { wh1 = (bf16x8){0, 0, 0, 0, 0, 0, 0, 0}; wl1 = wh1; }
#pragma unroll
            for (int g = 0; g < NG; ++g) { f32x4 h0 = ch0[g][c], h1 = ch1[g][c]; const u32x4 dv = cd[g][c];
                h0[0] += bflo(dv.x); h0[1] += bfhi(dv.x); h0[2] += bflo(dv.y); h0[3] += bfhi(dv.y); h1[0] += bflo(dv.z); h1[1] += bfhi(dv.z); h1[2] += bflo(dv.w); h1[3] += bfhi(dv.w);
                ss[g] += (h0[0] * h0[0] + h0[1] * h0[1]) + (h0[2] * h0[2] + h0[3] * h0[3]) + (h1[0] * h1[0] + h1[1] * h1[1]) + (h1[2] * h1[2] + h1[3] * h1[3]);
                const u32x4 hw = pack8(h0, h1); *(u32x4*)(hbdst[g] + k) = hw;
                f32x4 r0, r1; r0[0] = h0[0] - bflo(hw.x); r0[1] = h0[1] - bfhi(hw.x); r0[2] = h0[2] - bflo(hw.y); r0[3] = h0[3] - bfhi(hw.y);
                r1[0] = h1[0] - bflo(hw.z); r1[1] = h1[1] - bfhi(hw.z); r1[2] = h1[2] - bflo(hw.w); r1[3] = h1[3] - bfhi(hw.w);
                const u32x4 lw = pack8(r0, r1);
                const bf16x8 ah = __builtin_bit_cast(bf16x8, hw), al = __builtin_bit_cast(bf16x8, lw);
                acc0[g] = __builtin_amdgcn_mfma_f32_16x16x32_bf16(wh0, ah, acc0[g], 0, 0, 0); acc0[g] = __builtin_amdgcn_mfma_f32_16x16x32_bf16(wh0, al, acc0[g], 0, 0, 0); acc0[g] = __builtin_amdgcn_mfma_f32_16x16x32_bf16(wl0, ah, acc0[g], 0, 0, 0);
                acc1[g] = __builtin_amdgcn_mfma_f32_16x16x32_bf16(wh1, ah, acc1[g], 0, 0, 0); acc1[g] = __builtin_amdgcn_mfma_f32_16x16x32_bf16(wh1, al, acc1[g], 0, 0, 0); acc1[g] = __builtin_amdgcn_mfma_f32_16x16x32_bf16(wl1, ah, acc1[g], 0, 0, 0); } }
        if (s0 + CH < 32) {
#pragma unroll
            for (int g = 0; g < NG; ++g)
#pragma unroll
                for (int c = 0; c < CH; ++c) { ch0[g][c] = nh0[g][c]; ch1[g][c] = nh1[g][c]; cd[g][c] = nd[g][c]; }
        }
    }
#pragma unroll
    for (int g = 0; g < NG; ++g) {
        float sg = ss[g]; sg += lane_xor<16>(sg); sg += lane_xor<32>(sg);
        const float rstd2 = rsqrtf(sg * (1.0f / D) + EPS);
        float gl[4];
#pragma unroll
        for (int q = 0; q < 4; ++q) gl[q] = __int_as_float(__builtin_amdgcn_ds_bpermute(fr << 2, __float_as_int(acc1[g][q]))) * rstd2 + rgb[q];
        int gsel = 0; float gmax = gl[0];
#pragma unroll
        for (int q = 1; q < 4; ++q) if (gl[q] > gmax) { gmax = gl[q]; gsel = q; }
        float gsum = 0.f;
#pragma unroll
        for (int q = 0; q < 4; ++q) gsum += __expf(gl[q] - gmax);
        const float gwt = 1.0f / gsum;
        if (fq == gsel) {
            float el[4];
#pragma unroll
            for (int e = 0; e < 4; ++e) el[e] = acc0[g][e] * rstd2 + reb[gsel * 4 + e];
            int t1 = 0; float l1 = el[0];
#pragma unroll
            for (int e = 1; e < 4; ++e) if (el[e] > l1) { l1 = el[e]; t1 = e; }
            int t2 = -1; float l2 = -3.0e38f;
#pragma unroll
            for (int e = 0; e < 4; ++e) if (e != t1 && el[e] > l2) { l2 = el[e]; t2 = e; }
            const float w1 = 1.0f / (1.0f + __expf(l2 - l1)), w2 = 1.0f - w1;
            const int ea = min(t1, t2), eb = max(t1, t2); const float cA = gwt * (t1 == ea ? w1 : w2), cB = gwt * (t1 == ea ? w2 : w1);
            const int pr = ea == 0 ? eb - 1 : (ea == 1 ? eb + 1 : 5); int cls = gsel * 6 + pr; if (!(cls >= 0 && cls < NCLS)) cls = 0;
            const int rank = __hip_atomic_fetch_add(&lcnt[cls], 1, __ATOMIC_RELAXED, __HIP_MEMORY_SCOPE_WORKGROUP); const int rr = grpv[g] * 16 + fr;
            rec[rr * 5] = cls; rec[rr * 5 + 1] = rank; rec[rr * 5 + 2] = __float_as_int(cA); rec[rr * 5 + 3] = __float_as_int(cB); rec[rr * 5 + 4] = __float_as_int(rstd2);
        }
    }
}
__device__ __forceinline__ void phase_E1(Frame& F, int l) {
    LAS bf16* Rhi = (LAS bf16*)F.lds; LAS bf16* Rlo = Rhi + 20 * RPITCH;
    LAS int* rec = (LAS int*)(F.lds + 83968);
    LAS int* lcnt = (LAS int*)(F.lds + LC_CNT); LAS int* wgb = (LAS int*)(F.lds + LC_BASE);
    const float* rg = (const float*)(WSP() + WS_RG);
    const float* reb = INP(I_REB) + l * 16; const float* rgb = INP(I_RGB) + l * 4;
    unsigned* gcnt = (unsigned*)(WSP() + WS_CTL) + CW_GCNT + l * 64; int* route = (int*)(WSP() + WS_ROUTE);
    const int tid = F.tid, lane = F.lane, wave = F.wave, fr = lane & 15, fq = lane >> 4;
    { f32x4 rv[10];
#pragma unroll
      for (int j = 0; j < 10; ++j) rv[j] = *(const f32x4*)(rg + 4 * (tid + 512 * j));
#pragma unroll
      for (int j = 0; j < 10; ++j) { const int i = 4 * (tid + 512 * j), c = i >> 10, k = i & 1023; u32x2 hw, lw; float hf[4];
#pragma unroll
          for (int e = 0; e < 4; ++e) hf[e] = __builtin_bit_cast(float, (pk2(rv[j][e], 0.f) & 0xffffu) << 16);
          hw.x = pk2(rv[j][0], rv[j][1]); hw.y = pk2(rv[j][2], rv[j][3]); lw.x = pk2(rv[j][0] - hf[0], rv[j][1] - hf[1]); lw.y = pk2(rv[j][2] - hf[2], rv[j][3] - hf[3]);
          *(LAS u32x2*)(Rhi + c * RPITCH + k) = hw; *(LAS u32x2*)(Rlo + c * RPITCH + k) = lw; } }
    { int* TOK = (int*)(WSP() + WS_TOK);
#pragma unroll 1
      for (int p = F.vcu * 512 + tid; p < NPOSMAX; p += F.G * 512) TOK[p] = -1; }
#pragma unroll 1
    for (int wg = F.vcu; wg < 256; wg += F.G) {
        if (tid < NCLS) lcnt[tid] = 0;
        __syncthreads();
        const int ngrp = wg == 0 ? 9 : 8;
        if (wg == 0 && wave == 0) { const int rows2[2] = {fr, TX + fr}; const int grps2[2] = {0, 8}; e1_groups<2, 2>(F, l, rows2, grps2, Rhi, Rlo, rec, lcnt, reb, rgb, fr, fq); }
        else { const int rows1[1] = {wg * 128 + wave * 16 + fr}; const int grps1[1] = {wave}; e1_groups<1, 4>(F, l, rows1, grps1, Rhi, Rlo, rec, lcnt, reb, rgb, fr, fq); }
        __syncthreads();
        if (tid < NCLS) { const int n = lcnt[tid]; wgb[tid] = n > 0 ? (int)atomicAdd(gcnt + tid, (unsigned)n) : 0; }
        __syncthreads();
        const int nrw = ngrp * 16;
        for (int rr = tid; rr < nrw; rr += 512) { const int row = rr < 128 ? wg * 128 + rr : TX + (rr - 128); const int cls = rec[rr * 5];
            int* rp = route + (size_t)row * 8; rp[0] = cls; rp[1] = wgb[cls] + rec[rr * 5 + 1]; rp[2] = rec[rr * 5 + 2]; rp[3] = rec[rr * 5 + 3]; rp[4] = rec[rr * 5 + 4]; }
        __syncthreads();
    }
}
__device__ __forceinline__ void phase_E1b(Frame& F, int l) {
    class_tables(F, l);
    const LAS int* base = (const LAS int*)(F.lds + LC_BASE);
    const int* route = (const int*)(WSP() + WS_ROUTE); int* TOK = (int*)(WSP() + WS_TOK); float* PW = (float*)(WSP() + WS_PW);
#pragma unroll 1
    for (int row = F.vcu * 512 + F.tid; row < TR; row += F.G * 512) { const int* rp = route + (size_t)row * 8; const int pos = base[rp[0]] + rp[1];
        if (pos < 0 || pos >= NPOSMAX) continue;
        TOK[pos] = row; f32x4 w; w[0] = __int_as_float(rp[4]); w[1] = __int_as_float(rp[2]); w[2] = __int_as_float(rp[3]); w[3] = 0.f; *(f32x4*)(PW + (size_t)pos * 4) = w; }
}
__device__ __forceinline__ void phase_E4(Frame& F, int l) {
    class_tables(F, l);
    const LAS int* base = (const LAS int*)(F.lds + LC_BASE);
    const int* route = (const int*)(WSP() + WS_ROUTE); float* H = (float*)(WSP() + WS_H); bf16* HB = (bf16*)(WSP() + WS_HB); const bf16* Y = (const bf16*)(WSP() + WS_Y);
    float* rstd1 = (float*)(WSP() + WS_RSTD1); const float* fg = INP(I_FG); float* out = (float*)DOP(); const bf16* DL = (const bf16*)(WSP() + WS_X3);
    const int gw = F.vcu * NWAVES + F.wave, NGW = F.G * NWAVES, lane = F.lane; const bool lastl = (l == DEPTH - 1);
    constexpr int R = 4;
#pragma unroll 1
    for (int row0 = gw; row0 < TR; row0 += R * NGW) {
        int rowv[R], pos[R];
#pragma unroll
        for (int r = 0; r < R; ++r) { const int row = row0 + r * NGW; rowv[r] = row < TR ? row : TR - 1; const int* rp = route + (size_t)rowv[r] * 8; int p = base[rp[0]] + rp[1]; if (p < 0 || p >= NPOSMAX) p = 0; pos[r] = p; }
        u32x4 yw[R][2], dw[R][2]; f32x4 hv[R][2][2];
#pragma unroll
        for (int r = 0; r < R; ++r)
#pragma unroll
            for (int j = 0; j < 2; ++j) { yw[r][j] = *(const u32x4*)(Y + (size_t)pos[r] * D + 8 * lane + 512 * j);
                const float* hs = l == 0 ? (rowv[r] < TX ? INP(I_X) + (size_t)rowv[r] * D : INP(I_META) + (size_t)(rowv[r] - TX) * D) : H + (size_t)rowv[r] * D;
                hv[r][j][0] = *(const f32x4*)(hs + 8 * lane + 512 * j); hv[r][j][1] = *(const f32x4*)(hs + 8 * lane + 512 * j + 4); dw[r][j] = *(const u32x4*)(DL + (size_t)rowv[r] * D + 8 * lane + 512 * j); }
#pragma unroll
        for (int r = 0; r < R; ++r) { const int row = row0 + r * NGW; float ss = 0.f;
#pragma unroll
            for (int j = 0; j < 2; ++j) { const u32x4 w = yw[r][j], d4 = dw[r][j];
                hv[r][j][0][0] += bflo(d4.x); hv[r][j][0][1] += bfhi(d4.x); hv[r][j][0][2] += bflo(d4.y); hv[r][j][0][3] += bfhi(d4.y); hv[r][j][1][0] += bflo(d4.z); hv[r][j][1][1] += bfhi(d4.z); hv[r][j][1][2] += bflo(d4.w); hv[r][j][1][3] += bfhi(d4.w);
                hv[r][j][0][0] += bflo(w.x); hv[r][j][0][1] += bfhi(w.x); hv[r][j][0][2] += bflo(w.y); hv[r][j][0][3] += bfhi(w.y);
                hv[r][j][1][0] += bflo(w.z); hv[r][j][1][1] += bfhi(w.z); hv[r][j][1][2] += bflo(w.w); hv[r][j][1][3] += bfhi(w.w);
#pragma unroll
                for (int q = 0; q < 2; ++q) ss += hv[r][j][q][0] * hv[r][j][q][0] + hv[r][j][q][1] * hv[r][j][q][1] + hv[r][j][q][2] * hv[r][j][q][2] + hv[r][j][q][3] * hv[r][j][q][3]; }
            const float rs = rsqrtf(wave_sum(ss) * (1.0f / D) + EPS);
            if (row < TR) {
                if (!lastl) {
#pragma unroll
                    for (int j = 0; j < 2; ++j) { *(f32x4*)(H + (size_t)row * D + 8 * lane + 512 * j) = hv[r][j][0]; *(f32x4*)(H + (size_t)row * D + 8 * lane + 512 * j + 4) = hv[r][j][1];
                        *(u32x4*)(HB + (size_t)row * D + 8 * lane + 512 * j) = pack8(hv[r][j][0], hv[r][j][1]); }
                    if (lane == 0) rstd1[row] = rs;
                } else if (row < TX) {
#pragma unroll
                    for (int j = 0; j < 2; ++j) { const f32x4 g0 = *(const f32x4*)(fg + 8 * lane + 512 * j), g1 = *(const f32x4*)(fg + 8 * lane + 512 * j + 4);
                        *(f32x4*)(out + (size_t)row * D + 8 * lane + 512 * j) = hv[r][j][0] * rs * g0; *(f32x4*)(out + (size_t)row * D + 8 * lane + 512 * j + 4) = hv[r][j][1] * rs * g1; }
                }
            }
        }
    }
}
#define RELANE() do { const int t_ = wv0 * 64 + lane_id_opaque(); F.tid = t_; F.lane = t_ & 63; F.wave = __builtin_amdgcn_readfirstlane(t_ >> 6); \
    int g_ = gridDim.x; LAUNDER_S(g_); int b_ = blockIdx.x; LAUNDER_S(b_); F.G = g_; F.bx = b_; F.vcu = (g_ % 8 == 0) ? (b_ % 8) * (g_ / 8) + b_ / 8 : b_; ll = l; LAUNDER_S(ll); } while (0)
__global__ void __launch_bounds__(NWAVES * 64, 2) fwd_kernel(Params P) {
    extern __shared__ __attribute__((aligned(16))) unsigned char lds_raw[];
    Frame F;
    F.lds = (LAS unsigned char*)lds_raw;
    F.tid = threadIdx.x; F.lane = F.tid & 63; F.wave = __builtin_amdgcn_readfirstlane(F.tid >> 6);
    F.G = gridDim.x; { const int bx = blockIdx.x; F.vcu = (F.G % 8 == 0) ? (bx % 8) * (F.G / 8) + bx / 8 : bx; }
    if (F.tid == 0) { LAS unsigned long long* pt = (LAS unsigned long long*)(F.lds + LC_PTAB);
#pragma unroll
        for (int i = 0; i < 25; ++i) pt[i] = (unsigned long long)P.in[i];
        pt[25] = (unsigned long long)P.ws; pt[26] = (unsigned long long)P.out; }
    for (int u = F.tid; u < 256; u += NWAVES * 64) ((LAS unsigned*)(F.lds + RING_BYTES))[u] = 0u;
    __syncthreads();
    const int lo = P.ph_lo, hi = P.ph_hi;
    const bool use_bar = (hi - lo) > 1;
    unsigned* barw = (unsigned*)(P.ws + WS_CTL) + CW_BAR;
    XcdBarrier bar; bar.bar = barw; bar.x = 0; bar.st = (volatile LAS unsigned*)(F.lds + LC_BAR);
    if (use_bar) bar = xcd_barrier_post(barw, (volatile LAS unsigned*)(F.lds + LC_BAR));
#ifndef PHASE_MASK
#define PHASE_MASK 0xfff
#endif
#define EN(j) (((PHASE_MASK) >> (j)) & 1)
#ifndef DUP_MASK
#define DUP_MASK 0
#endif
#define NREP(j) ((((DUP_MASK) >> (j)) & 1) ? 2 : 1)
#define IN(k) (lo <= (k) && (k) < hi)
#define SEAM(k) do { if (IN(k) && IN((k) + 1)) xcd_barrier(bar); } while (0)

    int l = 0, ll = 0; const int wv0 = __builtin_amdgcn_readfirstlane((int)threadIdx.x >> 6);
    if (EN(0) && IN(0)) { RELANE(); convert_weights(F, 0); RELANE(); init_rows(F); }
    SEAM(0);
    for (l = 0; l < DEPTH; ++l) {
        const int pb = 1 + 11 * l;
        for (int rep = 0; rep < NREP(1); ++rep)
        if (EN(1) && IN(pb + 0)) {
            RELANE();
            unsigned char* wsl = WSP(); unsigned char* dol = DOP();
            pg8::Gemm g{(const bf16*)(wsl + WS_HB), 1024, 1024, 1 << 20};
            pg8::StaticOrder S; S.init(TX, N1, F.G, F.bx, (const bf16*)(wsl + WS_W1T), 1024);
            Epi1 E{(const float*)(wsl + WS_RSTD1), (bf16*)(wsl + WS_A), (bf16*)(wsl + WS_GLU), (bf16*)(dol + DO_Q), (bf16*)(wsl + WS_G)};
            pg8::gemm_phase<Epi1, pg8::StaticOrder>(F.lds, g, S, E, F.wave);
            if (F.bx >= 128 && F.bx < 128 + 21 && F.wave < 4) {
                const int pn = F.bx - 128, l2 = lane_id_opaque(); AccT acc; skinny_zero(acc);
                skinny_k<true>(acc, (const bf16*)(wsl + WS_HB) + (size_t)TX * 1024, 1024, (const bf16*)(wsl + WS_W1T) + (size_t)pn * 256 * 1024, 1024, 1024, F.wave, l2 & 15, l2 >> 4);
                E.run<true>(acc, pg8::Unit{128, pn, 0}, 0, F.wave, l2 & 15, l2 >> 4);
            }
            { RELANE(); LAS int* qs = (LAS int*)(F.lds + LC_QS); unsigned* head4 = (unsigned*)(WSP() + WS_CTL) + CW_AQ + 16 + ll * 64;
#pragma unroll 1
              for (;;) { __syncthreads(); if (F.tid == 0) qs[0] = (int)atomicAdd(head4, 1u); __syncthreads();
                  const int it = __builtin_amdgcn_readfirstlane(qs[0]); if (it >= 513) break;
                  { const int t_ = F.wave * 64 + lane_id_opaque(); F.tid = t_; F.lane = t_ & 63; }
                  s_item_logf(F, ll, it); } }
        }
        SEAM(pb + 0);
        if (EN(3) && IN(pb + 2)) { RELANE(); phase_scan(F, ll); }
        SEAM(pb + 2);
        for (int rep = 0; rep < NREP(3); ++rep)
        if (EN(4) && IN(pb + 3)) { RELANE(); phase_B(F, ll); }
        SEAM(pb + 3);
        for (int rep = 0; rep < NREP(4); ++rep)
        if (EN(5) && IN(pb + 4)) {
            RELANE(); unsigned char* wsl = WSP(); unsigned char* dol = DOP();
            pg8::Gemm g{(const bf16*)(wsl + WS_X3), 1024, 1024, 1 << 20}; pg8::SegOrder S; S.init(TX, 1024, F.G, F.bx, (const bf16*)(wsl + WS_W3CT), 1024);
            EpiCS E{(const bf16*)(wsl + WS_G), (bf16*)(dol + DO_MERGED), (const float*)(wsl + WS_BIASA)}; pg8::gemm_phase<EpiCS, pg8::SegOrder>(F.lds, g, S, E, F.wave);
            if (F.bx >= 16 && F.bx < 20) {
                const int pn = F.bx - 16, l2 = lane_id_opaque(), kh = F.wave >> 2, wc4 = F.wave & 3; AccT acc; skinny_zero(acc);
#pragma unroll 1
                for (int seg = 0; seg < 3; ++seg) { const int Ks = seg == 2 ? 512 : 256; const size_t ko = (seg == 0 ? 0 : (seg == 1 ? 256 : 512)) + (size_t)kh * (Ks / 2);
                    if (kh == 1) skinny_zero(acc);
                    skinny_k<true>(acc, (const bf16*)(wsl + WS_X3) + (size_t)TX * 1024 + ko, 1024, (const bf16*)(wsl + WS_W3CT) + (size_t)pn * 256 * 1024 + ko, 1024, Ks / 2, wc4, l2 & 15, l2 >> 4);
                    skinny_combine(acc, F.lds, F.wave, l2);
                    if (kh == 0) E.run<true>(acc, pg8::Unit{128, pn, seg}, 0, wc4, l2 & 15, l2 >> 4); }
            }
        }
        SEAM(pb + 4);
        if (EN(6) && IN(pb + 5)) {
            RELANE();
            unsigned char* wsl = WSP(); unsigned char* dol = DOP();
            pg8::Gemm g{(const bf16*)(dol + DO_MERGED), 1024, 1024, 1 << 20}; pg8::StaticOrder S; S.init(TX, 1024, F.G, F.bx, (const bf16*)(wsl + WS_WOT), 1024);
            EpiB2 E{(bf16*)(wsl + WS_X3)}; pg8::gemm_phase<EpiB2, pg8::StaticOrder>(F.lds, g, S, E, F.wave);
            if (F.bx >= 16 && F.bx < 20) {
                const int pn = F.bx - 16, l2 = lane_id_opaque(), kh = F.wave >> 2, wc4 = F.wave & 3; AccT acc; skinny_zero(acc);
                skinny_k<true>(acc, (const bf16*)(dol + DO_MERGED) + (size_t)TX * 1024 + kh * 512, 1024, (const bf16*)(wsl + WS_WOT) + (size_t)pn * 256 * 1024 + kh * 512, 1024, 512, wc4, l2 & 15, l2 >> 4);
                skinny_combine(acc, F.lds, F.wave, l2);
                if (kh == 0) E.run<true>(acc, pg8::Unit{128, pn, 0}, 0, wc4, l2 & 15, l2 >> 4);
            }
        }
        SEAM(pb + 5);
        if (EN(7) && IN(pb + 6)) { RELANE(); phase_E1(F, ll); }
        SEAM(pb + 6);
        for (int rep = 0; rep < NREP(7); ++rep)
        if (EN(8) && IN(pb + 7)) { RELANE(); phase_E1b(F, ll); }
        SEAM(pb + 7);
        for (int rep = 0; rep < NREP(8); ++rep)
        if (EN(9) && IN(pb + 8)) {
            RELANE(); class_tables(F, ll);
            unsigned char* wsl = WSP();
            const int NP = __builtin_amdgcn_readfirstlane(*(const LAS int*)(F.lds + LC_NP));
            pg8::Gemm g{(const bf16*)(wsl + WS_XS), 1024, 1024, 1 << 20};
            { const int* TOK = (const int*)(wsl + WS_TOK); LAS int* tl = (LAS int*)(F.lds + LC_TOK);
#pragma unroll 1
              for (int i = F.tid; i < 1024; i += 512) { const long L = (long)(i >> 8) * F.G + F.vcu; int tk = 0; if (L < (long)NP * 4) { tk = TOK[(int)(L >> 2) * 256 + (i & 255)]; if (tk < 0 || tk >= TR) tk = 0; } tl[i] = tk; }
              __syncthreads(); }
            pg8::Gemm g2{(const bf16*)(wsl + WS_HB), 1024, 1024, 1 << 20};
            MoeOrderT<true> S{(const LAS int*)(F.lds + LC_TOK), NP, F.G, F.vcu, 0, (const LAS int*)(F.lds + LC_PCLS), (const bf16*)(DOP() + DO_W13T)};
            EpiA2 E{(const float*)(wsl + WS_PW), (bf16*)(wsl + WS_HH)}; pg8::gemm_phase<EpiA2, MoeOrderT<true>>(F.lds, g2, S, E, F.wave);
        }
        SEAM(pb + 8);
        for (int rep = 0; rep < NREP(9); ++rep)
        if (EN(10) && IN(pb + 9)) {
            RELANE(); class_tables(F, ll);
            unsigned char* wsl = WSP();
            const int NP = __builtin_amdgcn_readfirstlane(*(const LAS int*)(F.lds + LC_NP));
            pg8::Gemm g{(const bf16*)(wsl + WS_HH), 512, 256, 4};
            MoeOrderT<false> S{nullptr, NP, F.G, F.vcu, 1, (const LAS int*)(F.lds + LC_PCLS), (const bf16*)(DOP() + DO_W2T)};
            EpiB2 E{(bf16*)(wsl + WS_Y)}; pg8::gemm_phase<EpiB2, MoeOrderT<false>>(F.lds, g, S, E, F.wave);
        }
        SEAM(pb + 9);
        if (EN(11) && IN(pb + 10)) { RELANE(); phase_E4(F, ll); if (l + 1 < DEPTH) { RELANE(); convert_weights(F, ll + 1); } }
        SEAM(pb + 10);
    }
#undef IN
#undef SEAM
}

constexpr int N_PHASES = 1 + 11 * DEPTH;

extern "C" void kernel_launch(void* const* d_in, const int* in_sizes, int n_in, void* d_out, int out_size, void* d_ws, size_t ws_size, hipStream_t stream) {
    static int grid = 0;
    if (grid == 0) {
        if (n_in != 25 || out_size != TX * D || ws_size < WS_END) { fprintf(stderr, "kernel_launch: unexpected shapes: n_in %d out %d ws %zu (need %zu)\n", n_in, out_size, ws_size, (size_t)WS_END); grid = -1; return; }
        int dev = 0, cus = 0, per_cu = 0;
        if (hipGetDevice(&dev) != hipSuccess || hipDeviceGetAttribute(&cus, hipDeviceAttributeMultiprocessorCount, dev) != hipSuccess) { grid = -1; return; }
        if (hipFuncSetAttribute((const void*)fwd_kernel, hipFuncAttributeMaxDynamicSharedMemorySize, LDS_BYTES) != hipSuccess) { fprintf(stderr, "kernel_launch: hipFuncSetAttribute failed\n"); grid = -1; return; }
        if (hipOccupancyMaxActiveBlocksPerMultiprocessor(&per_cu, (const void*)fwd_kernel, NWAVES * 64, LDS_BYTES) != hipSuccess || per_cu < 1) fprintf(stderr, "kernel_launch: occupancy query reports %d\n", per_cu);
        (void)hipGetLastError();
        grid = cus;
    }
    if (grid < 0) return;
    (void)hipMemsetAsync((char*)d_ws + WS_CTL, 0, CTL_BYTES, stream);
    Params p{};
    for (int i = 0; i < 25; ++i) p.in[i] = (const float*)d_in[i];
    p.out = (float*)d_out; p.ws = (unsigned char*)d_ws;
#if N_LAUNCH_MODE == 1
    p.ph_lo = 0; p.ph_hi = N_PHASES;
    hipLaunchKernelGGL(fwd_kernel, dim3(grid), dim3(NWAVES * 64), LDS_BYTES, stream, p);
#else
    for (int ph = 0; ph < N_PHASES; ++ph) { p.ph_lo = ph; p.ph_hi = ph + 1; hipLaunchKernelGGL(fwd_kernel, dim3(grid), dim3(NWAVES * 64), LDS_BYTES, stream, p); }
#endif
}
```

```cpp
#include <hip/hip_runtime.h>
#include <cstdio>
#include <cstdint>

#ifndef N_LAUNCH_MODE
#define N_LAUNCH_MODE 1
#endif

#define GAS __attribute__((address_space(1)))
#define LAS __attribute__((address_space(3)))
typedef unsigned short bf16;
typedef float f32x4 __attribute__((ext_vector_type(4)));
typedef float f32x2 __attribute__((ext_vector_type(2)));
typedef unsigned u32x4 __attribute__((ext_vector_type(4)));
typedef unsigned u32x2 __attribute__((ext_vector_type(2)));
typedef short bf16x8 __attribute__((ext_vector_type(8)));
typedef __bf16 bf16x2v __attribute__((ext_vector_type(2)));

constexpr int D = 1024, NB = 4, SEQ = 8192, NMETA = 16, DEPTH = 2;
constexpr int TX = NB * SEQ;
constexpr int TM = TX + 64;
constexpr int TR = TX + NMETA;
constexpr int NIN = 5384, N1 = 5376;
constexpr int NHEAD = 8;
constexpr int NCLS = 24;
constexpr int NPOSMAX = TX + 256 + NCLS * 256;
constexpr float EPS = 1e-6f;
constexpr float LOG2E = 1.4426950408889634f;
constexpr float C2 = 0.125f * LOG2E;
constexpr int NWAVES = 8;

constexpr size_t U = (size_t)TM * 1024 * 2;
constexpr size_t WS_CTL = 0, CTL_BYTES = 128u << 10;
constexpr size_t WS_H = CTL_BYTES;
constexpr size_t WS_HB = WS_H + 2 * U;
constexpr size_t WS_G = WS_HB + U;
constexpr size_t WS_XS = WS_G;
constexpr size_t WS_Y = WS_XS + (size_t)NPOSMAX * 2048;
constexpr size_t WS_HH = WS_Y + (size_t)NPOSMAX * 2048;
static_assert(WS_HH + (size_t)NPOSMAX * 1024 <= WS_G + (size_t)3 * 129 * 4 * 65536 * 2, "MoE overlay fits the gates region");
constexpr size_t GT_TILE = 65536;
constexpr size_t WS_A = WS_G + (size_t)3 * 129 * 4 * GT_TILE * 2;
constexpr size_t WS_GLU = WS_A + U / 4;
constexpr size_t WS_X3 = WS_GLU + U / 4;
constexpr size_t WS_W1T = WS_X3 + U;
constexpr size_t WS_W3CT = WS_W1T + (size_t)N1 * 1024 * 2;
constexpr size_t WS_WOT = WS_W3CT + 1024 * 1024 * 2;
constexpr size_t WS_WFG = WS_WOT + 1024 * 1024 * 2;
constexpr size_t WS_RG = WS_WFG + 8 * 1024 * 4;
constexpr size_t WS_BIASA = WS_RG + 20 * 1024 * 4;
constexpr size_t WS_RSTD1 = WS_BIASA + 4096;
constexpr size_t WS_ROUTE = WS_RSTD1 + (size_t)TM * 4;
constexpr size_t WS_PW = WS_ROUTE + (size_t)TM * 32;
constexpr size_t WS_LFT = WS_PW + (size_t)NPOSMAX * 16;
constexpr size_t WS_LFTM = WS_LFT + (size_t)32 * 8192 * 4;
constexpr size_t WS_TOK = WS_LFTM + 8 * 256 * 4;
constexpr size_t WS_FL = WS_TOK + (size_t)NPOSMAX * 4;
constexpr int FLN = 64 + SEQ;
constexpr size_t WS_END = WS_FL + (size_t)32 * FLN * 4;
static_assert(WS_END <= (size_t)512 * 1024 * 1024, "d_ws map fits 512 MiB");
constexpr size_t DO_Q = 0, DO_K = U / 2, DO_V = U, DO_MERGED = U / 2;
constexpr size_t DO_W13T = 3 * U / 2;
constexpr size_t DO_W2T = DO_W13T + (size_t)16 * 512 * 1024 * 2;
static_assert(DO_W2T + (size_t)16 * 1024 * 256 * 2 <= (size_t)TX * 1024 * 4, "d_out scratch");
static_assert((24576 + 128) * 4 <= 128 * 1024, "control words inside the memset");
constexpr int CW_BAR = 4096, CW_GCNT = 16384, CW_NRM = 20480  , CW_AQ = 24576  ;

constexpr int RPITCH = 1032;
constexpr int RING_BYTES = 131072;
constexpr int LC_BAR = RING_BYTES, LC_CNT = RING_BYTES + 64, LC_BASE = RING_BYTES + 192, LC_PCLS = RING_BYTES + 320, LC_NP = RING_BYTES + 960;
constexpr int LC_QS = RING_BYTES + 976;
constexpr int LC_TOK = RING_BYTES + 2048;
constexpr int LC_NMX = RING_BYTES + 1280;
constexpr int LC_PTAB = RING_BYTES + 1024;
constexpr int LDS_BYTES = RING_BYTES + 1024 + 7168;

#define LDS_WAIT() asm volatile("s_waitcnt lgkmcnt(0)" ::: "memory")
#define VM_WAIT() asm volatile("s_waitcnt vmcnt(0)" ::: "memory")
#define LAUNDER_S(p) asm volatile("" : "+s"(p))
#define LAUNDER_V(x) asm volatile("" : "+v"(x))
__device__ __forceinline__ int lane_id_opaque() { int x; asm volatile("v_mbcnt_lo_u32_b32 %0, -1, 0\n\tv_mbcnt_hi_u32_b32 %0, -1, %0" : "=v"(x)); return x; }

__device__ __forceinline__ unsigned f2bf(float f) { unsigned u = __builtin_bit_cast(unsigned, f); return (u + 0x7fffu + ((u >> 16) & 1u)) >> 16; }
__device__ __forceinline__ unsigned pk2(float lo, float hi) { f32x2 v = {lo, hi}; bf16x2v b = __builtin_convertvector(v, bf16x2v); return __builtin_bit_cast(unsigned, b); }
__device__ __forceinline__ float bflo(unsigned w) { return __builtin_bit_cast(float, w << 16); }
__device__ __forceinline__ float bfhi(unsigned w) { return __builtin_bit_cast(float, w & 0xffff0000u); }
template <int O> __device__ __forceinline__ float lane_xor(float v) {
    if constexpr (O < 32) return __int_as_float(__builtin_amdgcn_ds_swizzle(__float_as_int(v), (O << 10) | 0x1f));
    else { auto rr = __builtin_amdgcn_permlane32_swap(__float_as_uint(v), __float_as_uint(v), false, false); return __uint_as_float(rr[0]) + __uint_as_float(rr[1]) - v; }
}
__device__ __forceinline__ float wave_sum(float v) {
    v += lane_xor<1>(v); v += lane_xor<2>(v); v += lane_xor<4>(v); v += lane_xor<8>(v); v += lane_xor<16>(v);
    auto rr = __builtin_amdgcn_permlane32_swap(__float_as_uint(v), __float_as_uint(v), false, false);
    return __uint_as_float(rr[0]) + __uint_as_float(rr[1]);
}
__device__ __forceinline__ float sigmoidf_(float x) { return __builtin_amdgcn_rcpf(1.0f + __builtin_amdgcn_exp2f(-LOG2E * x)); }
__device__ __forceinline__ float dot2bf(unsigned a, unsigned b, float acc) { return __builtin_amdgcn_fdot2_f32_bf16(__builtin_bit_cast(bf16x2v, a), __builtin_bit_cast(bf16x2v, b), acc, false); }

namespace pg8 {
constexpr int BM = 256, BK = 64, HALF = 128, HTB = HALF * BK * 2, STAGE_BYTES = 8 * HTB, NXCD = 8, WGM = 4;
__host__ __device__ __forceinline__ int lds_byte(int r, int c) { const int st = (r >> 4) * 2 + (c >> 5), rr = r & 15, cc = c & 31, ob = rr * 64 + cc * 2; return st * 1024 + (ob ^ (((ob >> 9) & 1) << 5)); }
__host__ __device__ __forceinline__ void stage_rc(int b, int& R, int& C) { const int st = b / 1024, sb = b % 1024, swz = sb ^ (((sb >> 9) & 1) << 5); R = (st >> 1) * 16 + swz / 64; C = (st & 1) * 32 + (swz % 64) / 2; }
__host__ __device__ __forceinline__ int perm32(int rho) { const int n = rho >> 4, i = rho & 15; return 8 * (i >> 2) + 4 * n + (i & 3); }

struct Unit { int pm, pn, seg; };
struct Gemm { const bf16* A; int K; int ldb; int ksplit; };

struct StaticOrder {
    static constexpr bool GATHER = false; const LAS int* tokl = nullptr;
    int nM, nN, nwg, G, c; const bf16* Bt; size_t btile;
    __device__ void init(int M, int N, int G_, int c_, const bf16* Bt_, int ldb) { nM = M / BM; nN = N / BM; nwg = nM * nN; G = G_; c = c_; Bt = Bt_; btile = (size_t)BM * ldb * 2; }
    __device__ bool next(int i, Unit& u) const {
        const long L = (long)i * G + c; if (L >= nwg) return false;
        int wgid = (int)L; { const int q = nwg / NXCD, r = nwg % NXCD, xcd = wgid % NXCD, off = wgid / NXCD; wgid = (xcd < r ? xcd * (q + 1) : r * (q + 1) + (xcd - r) * q) + off; }
        const int nig = WGM * nN, gid = wgid / nig, fm = gid * WGM, gsz = (nM - fm) < WGM ? (nM - fm) : WGM;
        u.pm = fm + ((wgid % nig) % gsz); u.pn = (wgid % nig) / gsz; u.seg = 0; return true;
    }
    __device__ __forceinline__ const char* bptr(const Unit& u, int) const { return (const char*)Bt + (size_t)u.pn * btile; }
    __device__ __forceinline__ int nt(const Unit&, int ntd) const { return ntd; }
    __device__ __forceinline__ size_t aoff(const Unit&) const { return 0; }
};
struct SegOrder : StaticOrder {
    __device__ bool next(int i, Unit& u) const { const int q = i / 3; if (!StaticOrder::next(q, u)) return false; u.seg = i - 3 * q; return true; }
    __device__ __forceinline__ size_t koff(const Unit& u) const { return u.seg == 0 ? 0 : (u.seg == 1 ? 512 : 1024); }
    __device__ __forceinline__ const char* bptr(const Unit& u, int) const { return (const char*)Bt + (size_t)u.pn * btile + koff(u); }
    __device__ __forceinline__ int nt(const Unit& u, int) const { return u.seg == 2 ? 8 : 4; }
    __device__ __forceinline__ size_t aoff(const Unit& u) const { return koff(u); }
};

template <class Epi, class Sched, bool ALIGN_EPI = true, bool SP2 = true>
__device__ __forceinline__ void gemm_phase(LAS unsigned char* lds, const Gemm g, const Sched& S, const Epi& E, const int wave_id) {
    const int tid = wave_id * 64 + lane_id_opaque();
    const int wid = __builtin_amdgcn_readfirstlane(tid >> 6), lane = tid & 63, wr = wid >> 2, wc = wid & 3, fr = lane & 15, fq = lane >> 4;
    const int K = g.K, nt = K / BK, ldb = g.ldb, ks = g.ksplit;
    unsigned voffA[2], voffB[2];
#pragma unroll
    for (int i = 0; i < 2; ++i) { int R, C; stage_rc(tid * 16 + i * 8192, R, C); const int Rb = Epi::PERM ? ((R & ~31) + perm32(R & 31)) : R;
        voffA[i] = (unsigned)(R * K + C) * 2u; voffB[i] = (unsigned)(Rb * ldb + C) * 2u; }
    constexpr bool GATHER = Sched::GATHER;
    unsigned vC0[2], vC1[2];
    const size_t kstep = (size_t)(BK * 2);
    const size_t hstep = (size_t)HALF * K * 2;
    const size_t hstepB = (size_t)HALF * ldb * 2;
    const size_t tstep = 2 * hstep;
#define PG8_GOFF(ui_) do { _Pragma("unroll") for (int _i = 0; _i < 2; ++_i) { const int R_ = (int)(voffA[_i] >> 11); const unsigned C_ = voffA[_i] & 2047u; \
        vC0[_i] = (unsigned)S.tokl[(ui_) * 256 + R_] * 2048u + C_; vC1[_i] = (unsigned)S.tokl[(ui_) * 256 + 128 + R_] * 2048u + C_; } } while (0)
    const unsigned ldsw = (unsigned)wid * 1024u;
    const int aoff = lds_byte(wr * 64 + fr, fq * 8), boff = lds_byte(wc * 32 + fr, fq * 8);
#define PG8_SA(b, h) (((b) * 2 + (h)) * HTB)
#define PG8_SB(b, h) ((4 + (b) * 2 + (h)) * HTB)
#define PG8_STAGE(bufoff, gbase, voff) do { _Pragma("unroll") for (int _i = 0; _i < 2; ++_i) \
        __builtin_amdgcn_global_load_lds((const unsigned*)((const char*)(gbase) + (voff)[_i]), (LAS unsigned*)(lds + (bufoff) + ldsw + _i * 8192), 16, 0, 0); } while (0)
#define PG8_LDA(dst, b, h) do { _Pragma("unroll") for (int m = 0; m < 4; ++m) _Pragma("unroll") for (int k = 0; k < 2; ++k) dst[m][k] = *(const LAS bf16x8*)(lds + PG8_SA(b, h) + aoff + m * 2048 + k * 1024); } while (0)
#define PG8_LDB(dst, b, h) do { _Pragma("unroll") for (int n = 0; n < 2; ++n) _Pragma("unroll") for (int k = 0; k < 2; ++k) dst[n][k] = *(const LAS bf16x8*)(lds + PG8_SB(b, h) + boff + n * 2048 + k * 1024); } while (0)
#define PG8_MMA(ai, bj, At, Bt) do { __builtin_amdgcn_s_setprio(1); _Pragma("unroll") for (int m = 0; m < 4; ++m) _Pragma("unroll") for (int n = 0; n < 2; ++n) _Pragma("unroll") for (int k = 0; k < 2; ++k) \
        acc[ai][bj][m][n] = __builtin_amdgcn_mfma_f32_16x16x32_bf16(Bt[n][k], At[m][k], acc[ai][bj][m][n], 0, 0, 0); __builtin_amdgcn_s_setprio(0); } while (0)
#define PG8_WAIT_V(n) asm volatile("s_waitcnt vmcnt(" #n ")" ::: "memory")
#define PG8_WAIT_L(n) asm volatile("s_waitcnt lgkmcnt(" #n ")" ::: "memory")
#define PG8_BAR __builtin_amdgcn_s_barrier()
#define PG8_SCHED __builtin_amdgcn_sched_barrier(0)
    Unit cur, nxt; int ui = 0;
    if (!S.next(0, cur)) return;
    if constexpr (GATHER) { PG8_GOFF(0); } else { vC0[0] = voffA[0]; vC0[1] = voffA[1]; vC1[0] = voffA[0] + (unsigned)hstep; vC1[1] = voffA[1] + (unsigned)hstep; }
    f32x4 acc[2][2][4][2];
    { float z_ = 0.f; LAUNDER_V(z_);
#pragma unroll
    for (int a = 0; a < 2; ++a)
#pragma unroll
        for (int b = 0; b < 2; ++b)
#pragma unroll
            for (int m = 0; m < 4; ++m)
#pragma unroll
                for (int n = 0; n < 2; ++n) acc[a][b][m][n] = (f32x4){z_, z_, z_, z_}; }
    bf16x8 At[4][2], B0[2][2], B1[2][2];
    int ntc = S.nt(cur, nt);
    const char* cA = GATHER ? (const char*)g.A : (const char*)g.A + (size_t)cur.pm * tstep + S.aoff(cur); const char* cB = S.bptr(cur, 0); const char* cB1 = S.bptr(cur, 1) - (size_t)ks * kstep;
    if constexpr (SP2) {
        PG8_STAGE(PG8_SB(0, 0), cB, voffB); PG8_STAGE(PG8_SB(0, 1), cB + hstepB, voffB); PG8_STAGE(PG8_SA(0, 0), cA, vC0); PG8_STAGE(PG8_SA(0, 1), cA, vC1);
        if (wr == 1) PG8_BAR;
        PG8_WAIT_V(2); PG8_BAR;
        PG8_STAGE(PG8_SB(1, 0), cB + kstep, voffB); PG8_STAGE(PG8_SA(1, 0), cA + kstep, vC0); PG8_STAGE(PG8_SB(1, 1), cB + hstepB + kstep, voffB);
        PG8_WAIT_V(6); PG8_BAR;
    } else {
        PG8_STAGE(PG8_SB(0, 0), cB, voffB); PG8_STAGE(PG8_SA(0, 0), cA, vC0); PG8_STAGE(PG8_SB(0, 1), cB + hstepB, voffB); PG8_STAGE(PG8_SA(0, 1), cA, vC1);
        if (wr == 1) PG8_BAR;
        PG8_WAIT_V(4); PG8_BAR;
        PG8_STAGE(PG8_SB(1, 0), cB + kstep, voffB); PG8_STAGE(PG8_SA(1, 0), cA + kstep, vC0); PG8_STAGE(PG8_SB(1, 1), cB + hstepB + kstep, voffB);
        PG8_WAIT_V(6); PG8_BAR;
    }
    for (;;) {
        const bool has_next = S.next(ui + 1, nxt);
        const char* nA = GATHER ? (const char*)g.A : (has_next ? (const char*)g.A + (size_t)nxt.pm * tstep + S.aoff(nxt) : cA); const char* nB = has_next ? S.bptr(nxt, 0) : cB;
        const char* nB1 = has_next ? S.bptr(nxt, 1) - (size_t)ks * kstep : cB1;
#pragma unroll 1
        for (int t = 0; t < ntc; t += 2) {
            const bool last = (t == ntc - 2);
            const char* a1 = cA + (size_t)(t + 1) * kstep;
            const char* bside = (t + 2 < ks) ? cB : cB1;
            const char* a2 = last ? nA : cA + (size_t)(t + 2) * kstep; const char* b2 = last ? nB : bside + (size_t)(t + 2) * kstep;
            const char* a3 = a2 + kstep; const char* b3 = b2 + kstep;
            unsigned x0[2] = {vC0[0], vC0[1]}, x1[2] = {vC1[0], vC1[1]};
            if constexpr (GATHER) { if (last && has_next) { _Pragma("unroll") for (int _i = 0; _i < 2; ++_i) { const int R_ = (int)(voffA[_i] >> 11); const unsigned C_ = voffA[_i] & 2047u;
                x0[_i] = (unsigned)S.tokl[(ui + 1) * 256 + R_] * 2048u + C_; x1[_i] = (unsigned)S.tokl[(ui + 1) * 256 + 128 + R_] * 2048u + C_; } } }
            if constexpr (SP2) {
            PG8_LDB(B0, 0, 0); PG8_LDB(B1, 0, 1); PG8_SCHED; PG8_LDA(At, 0, 0); PG8_STAGE(PG8_SA(1, 1), a1, vC1);
            PG8_WAIT_V(8); PG8_WAIT_L(0); PG8_BAR; PG8_MMA(0, 0, At, B0); PG8_MMA(0, 1, At, B1); PG8_BAR; PG8_SCHED;
            PG8_LDA(At, 0, 1); PG8_STAGE(PG8_SB(0, 0), b2, voffB); PG8_STAGE(PG8_SB(0, 1), b2 + hstepB, voffB); PG8_STAGE(PG8_SA(0, 0), a2, x0);
            PG8_WAIT_V(8); PG8_WAIT_L(0); PG8_BAR; PG8_MMA(1, 0, At, B0); PG8_MMA(1, 1, At, B1); PG8_BAR; PG8_SCHED;
            PG8_LDB(B0, 1, 0); PG8_LDB(B1, 1, 1); PG8_SCHED; PG8_LDA(At, 1, 0); PG8_STAGE(PG8_SA(0, 1), a2, x1);
            PG8_WAIT_V(8); PG8_WAIT_L(0); PG8_BAR; PG8_MMA(0, 0, At, B0); PG8_MMA(0, 1, At, B1); PG8_BAR; PG8_SCHED;
            PG8_LDA(At, 1, 1); PG8_STAGE(PG8_SB(1, 0), b3, voffB); PG8_STAGE(PG8_SB(1, 1), b3 + hstepB, voffB); PG8_STAGE(PG8_SA(1, 0), a3, x0);
            PG8_WAIT_V(8); PG8_WAIT_L(0); PG8_BAR; PG8_MMA(1, 0, At, B0); PG8_MMA(1, 1, At, B1); PG8_BAR; PG8_SCHED;
            } else {
            PG8_LDB(B0, 0, 0); PG8_SCHED; PG8_LDA(At, 0, 0); PG8_STAGE(PG8_SA(1, 1), a1, vC1);
            PG8_WAIT_L(8); PG8_BAR; PG8_WAIT_L(0); PG8_MMA(0, 0, At, B0); PG8_BAR; PG8_SCHED;
            PG8_LDB(B1, 0, 1); PG8_STAGE(PG8_SB(0, 0), b2, voffB);
            PG8_BAR; PG8_WAIT_L(0); PG8_MMA(0, 1, At, B1); PG8_BAR;
            PG8_LDA(At, 0, 1); PG8_STAGE(PG8_SA(0, 0), a2, x0);
            PG8_BAR; PG8_WAIT_L(0); PG8_MMA(1, 0, At, B0); PG8_BAR; PG8_SCHED;
            PG8_STAGE(PG8_SB(0, 1), b2 + hstepB, voffB);
            PG8_WAIT_V(6); PG8_BAR; PG8_MMA(1, 1, At, B1); PG8_BAR;
            PG8_LDB(B0, 1, 0); PG8_SCHED; PG8_LDA(At, 1, 0); PG8_STAGE(PG8_SA(0, 1), a2, x1);
            PG8_WAIT_L(8); PG8_BAR; PG8_WAIT_L(0); PG8_MMA(0, 0, At, B0); PG8_BAR; PG8_SCHED;
            PG8_LDB(B1, 1, 1); PG8_STAGE(PG8_SB(1, 0), b3, voffB);
            PG8_BAR; PG8_WAIT_L(0); PG8_MMA(0, 1, At, B1); PG8_BAR;
            PG8_LDA(At, 1, 1); PG8_STAGE(PG8_SA(1, 0), a3, x0);
            PG8_BAR; PG8_WAIT_L(0); PG8_MMA(1, 0, At, B0); PG8_BAR; PG8_SCHED;
            PG8_STAGE(PG8_SB(1, 1), b3 + hstepB, voffB);
            PG8_WAIT_V(6); PG8_BAR; PG8_MMA(1, 1, At, B1); PG8_BAR;
            }
        }
        if constexpr (ALIGN_EPI) { if (wr == 0) PG8_BAR; }
        { const int l2 = lane_id_opaque(); E(acc, cur, wr, wc, l2 & 15, l2 >> 4); }
        if (!has_next) break;
        if (!E.keep(cur)) { float z_ = 0.f; LAUNDER_V(z_);
#pragma unroll
        for (int a = 0; a < 2; ++a)
#pragma unroll
            for (int b = 0; b < 2; ++b)
#pragma unroll
                for (int m = 0; m < 4; ++m)
#pragma unroll
                    for (int n = 0; n < 2; ++n) acc[a][b][m][n] = (f32x4){z_, z_, z_, z_}; }
        cur = nxt; cA = nA; cB = nB; cB1 = nB1; ++ui; ntc = S.nt(cur, nt);
        if constexpr (GATHER) { PG8_GOFF(ui); }
        if constexpr (ALIGN_EPI) { if (wr == 1) PG8_BAR; }
    }
    PG8_WAIT_V(0);
    if constexpr (!ALIGN_EPI) { if (wr == 0) PG8_BAR; }
    PG8_BAR;
#undef PG8_GOFF
#undef PG8_SA
#undef PG8_SB
#undef PG8_STAGE
#undef PG8_LDA
#undef PG8_LDB
#undef PG8_MMA
#undef PG8_WAIT_V
#undef PG8_WAIT_L
#undef PG8_BAR
#undef PG8_SCHED
}
}

typedef f32x4 AccT[2][2][4][2];
__device__ __forceinline__ u32x4 pack8(const f32x4 a, const f32x4 b) { u32x4 w; w.x = pk2(a[0], a[1]); w.y = pk2(a[2], a[3]); w.z = pk2(b[0], b[1]); w.w = pk2(b[2], b[3]); return w; }

struct Epi1 {
    static constexpr bool PERM = true;
    __device__ __forceinline__ bool keep(const pg8::Unit&) const { return false; }
    const float* rstd; bf16* A; bf16* GLU; bf16* QKV; bf16* G;
    __device__ __forceinline__ void operator()(AccT& acc, const pg8::Unit& u, int wr, int wc, int fr, int fq) const { run<false>(acc, u, wr, wc, fr, fq); }
    template <bool SK> __device__ __forceinline__ void run(AccT& acc, const pg8::Unit& u, int wr, int wc, int fr, int fq) const {
        const int row0 = u.pm * 256 + wr * 64 + fr, lc0 = wc * 32 + 8 * fq, pn = u.pn;
#pragma unroll
        for (int ai = 0; ai < (SK ? 1 : 2); ++ai)
#pragma unroll
            for (int m = 0; m < (SK ? 1 : 4); ++m) {
                const int row = row0 + ai * 128 + m * 16; const float rs = rstd[row];
                f32x4 v[2][2];
#pragma unroll
                for (int bj = 0; bj < 2; ++bj)
#pragma unroll
                    for (int n = 0; n < 2; ++n) v[bj][n] = acc[ai][bj][m][n] * rs;
                if (pn == 0) {
#pragma unroll
                    for (int bj = 0; bj < 2; ++bj) *(u32x4*)(A + (size_t)row * 256 + bj * 128 + lc0) = pack8(v[bj][0], v[bj][1]);
                } else if (pn <= 2) {
                    f32x4 o[2];
#pragma unroll
                    for (int n = 0; n < 2; ++n)
#pragma unroll
                        for (int j = 0; j < 4; ++j) o[n][j] = v[0][n][j] * sigmoidf_(v[1][n][j]);
                    *(u32x4*)(GLU + (size_t)row * 256 + (pn - 1) * 128 + lc0) = pack8(o[0], o[1]);
                } else if (pn <= 4) {
#pragma unroll
                    for (int bj = 0; bj < 2; ++bj) *(u32x4*)(QKV + (size_t)2 * (U / 4) + (size_t)row * 512 + (pn - 3) * 256 + bj * 128 + lc0) = pack8(v[bj][0], v[bj][1]);
                } else {
                    const int d = 64 * (pn - 5) + 16 * wc + 4 * fq; f32x4 r01, r12, g2;
#pragma unroll
                    for (int j = 0; j < 4; ++j) { const float a0 = 1.0f + fminf(__builtin_amdgcn_exp2f(-LOG2E * v[0][0][j]), 1e30f), a1 = 1.0f + fminf(__builtin_amdgcn_exp2f(-LOG2E * v[0][1][j]), 1e30f), a2 = 1.0f + fminf(__builtin_amdgcn_exp2f(-LOG2E * v[1][0][j]), 1e30f);
                        const float i0 = __builtin_amdgcn_rcpf(a0), i1 = __builtin_amdgcn_rcpf(a1), i2 = __builtin_amdgcn_rcpf(a2);
                        r01[j] = i0 * a1; r12[j] = i1 * a2; g2[j] = i2; }
                    bf16* gp = G + (size_t)row * 1024 + d; u32x2 w;
                    w.x = pk2(r01[0], r01[1]); w.y = pk2(r01[2], r01[3]); *(u32x2*)gp = w;
                    w.x = pk2(r12[0], r12[1]); w.y = pk2(r12[2], r12[3]); *(u32x2*)(gp + U / 2) = w;
                    w.x = pk2(g2[0], g2[1]); w.y = pk2(g2[2], g2[3]); *(u32x2*)(gp + U) = w;
                    const float sc = d < 512 ? C2 : 1.0f; const f32x4 sp = v[1][1] * sc;
                    w.x = pk2(sp[0], sp[1]); w.y = pk2(sp[2], sp[3]); *(u32x2*)(QKV + (size_t)(d < 512 ? 0 : 1) * (U / 4) + (size_t)row * 512 + (d & 511)) = w;
                }
            }
    }
};
struct EpiCS {
    static constexpr bool PERM = true;
    const bf16* G; bf16* Mg; const float* bias;
    __device__ __forceinline__ bool keep(const pg8::Unit& u) const { return u.seg != 2; }
    __device__ __forceinline__ void operator()(AccT& acc, const pg8::Unit& u, int wr, int wc, int fr, int fq) const { run<false>(acc, u, wr, wc, fr, fq); }
    template <bool SK> __device__ __forceinline__ void run(AccT& acc, const pg8::Unit& u, int wr, int wc, int fr, int fq) const {
        const int row0 = u.pm * 256 + wr * 64 + fr, col0 = u.pn * 256 + wc * 32 + 8 * fq;
        const bool lastseg = u.seg == 2; const float bsc = u.seg == 0 ? 1.f : 0.f; const bf16* Gs = G + (size_t)u.seg * (U / 2);
        f32x4 bv[2][2];
#pragma unroll
        for (int bj = 0; bj < 2; ++bj) { bv[bj][0] = *(const f32x4*)(bias + col0 + bj * 128) * bsc; bv[bj][1] = *(const f32x4*)(bias + col0 + bj * 128 + 4) * bsc; }
        u32x4 gr[2][4][2];
#pragma unroll
        for (int ai = 0; ai < (SK ? 1 : 2); ++ai)
#pragma unroll
            for (int m = 0; m < (SK ? 1 : 4); ++m)
#pragma unroll
                for (int bj = 0; bj < 2; ++bj) gr[ai][m][bj] = *(const u32x4*)(Gs + (size_t)(row0 + ai * 128 + m * 16) * 1024 + col0 + bj * 128);
#pragma unroll
        for (int ai = 0; ai < (SK ? 1 : 2); ++ai)
#pragma unroll
            for (int m = 0; m < (SK ? 1 : 4); ++m) { const int row = row0 + ai * 128 + m * 16;
#pragma unroll
                for (int bj = 0; bj < 2; ++bj) {
                    const u32x4 n4 = gr[ai][m][bj];
                    f32x4 a0 = acc[ai][bj][m][0] + bv[bj][0], a1 = acc[ai][bj][m][1] + bv[bj][1];
                    a0[0] *= bflo(n4.x); a0[1] *= bfhi(n4.x); a0[2] *= bflo(n4.y); a0[3] *= bfhi(n4.y); a1[0] *= bflo(n4.z); a1[1] *= bfhi(n4.z); a1[2] *= bflo(n4.w); a1[3] *= bfhi(n4.w);
                    acc[ai][bj][m][0] = a0; acc[ai][bj][m][1] = a1;
                    asm volatile("" : "+v"(acc[ai][bj][m][0]), "+v"(acc[ai][bj][m][1]));
                    if (lastseg) *(u32x4*)(Mg + (size_t)row * 1024 + col0 + bj * 128) = pack8(a0, a1);
                } }
    }
};
struct EpiD {
    static constexpr bool PERM = false;
    __device__ __forceinline__ bool keep(const pg8::Unit&) const { return false; }
    float* H; bf16* HB;
    __device__ __forceinline__ void operator()(AccT& acc, const pg8::Unit& u, int wr, int wc, int fr, int fq) const { run<false>(acc, u, wr, wc, fr, fq); }
    template <bool SK> __device__ __forceinline__ void run(AccT& acc, const pg8::Unit& u, int wr, int wc, int fr, int fq) const {
        const int row0 = u.pm * 256 + wr * 64 + fr, col0 = u.pn * 256 + wc * 32 + 4 * fq;
#pragma unroll
        for (int ai = 0; ai < (SK ? 1 : 2); ++ai)
#pragma unroll
            for (int m = 0; m < (SK ? 1 : 4); ++m) {
                const size_t off = (size_t)(row0 + ai * 128 + m * 16) * 1024 + col0;
#pragma unroll
                for (int bj = 0; bj < 2; ++bj)
#pragma unroll
                    for (int n = 0; n < 2; ++n) { const size_t o = off + bj * 128 + n * 16; const f32x4 hv = *(const f32x4*)(H + o) + acc[ai][bj][m][n];
                        *(f32x4*)(H + o) = hv; u32x2 w; w.x = pk2(hv[0], hv[1]); w.y = pk2(hv[2], hv[3]); *(u32x2*)(HB + o) = w; }
            }
    }
};
struct EpiA2 {
    static constexpr bool PERM = true;
    __device__ __forceinline__ bool keep(const pg8::Unit&) const { return false; }
    const float* PW; bf16* HH;
    __device__ __forceinline__ void operator()(AccT& acc, const pg8::Unit& u, int wr, int wc, int fr, int fq) const {
        const int row0 = u.pm * 256 + wr * 64 + fr, lc0 = wc * 32 + 8 * fq, side = u.pn >> 1;
#pragma unroll
        for (int ai = 0; ai < 2; ++ai)
#pragma unroll
            for (int m = 0; m < 4; ++m) {
                const int row = row0 + ai * 128 + m * 16; const f32x4 pw = *(const f32x4*)(PW + (size_t)row * 4);
                const float rs = pw[0], cw = side ? pw[2] : pw[1];
                f32x4 o[2];
#pragma unroll
                for (int n = 0; n < 2; ++n)
#pragma unroll
                    for (int j = 0; j < 4; ++j) { const float a1 = acc[ai][0][m][n][j] * rs, a3 = acc[ai][1][m][n][j] * rs; o[n][j] = cw * a1 * sigmoidf_(a1) * a3; }
                *(u32x4*)(HH + (size_t)row * 512 + side * 256 + (u.pn & 1) * 128 + lc0) = pack8(o[0], o[1]);
            }
    }
};
struct EpiB2 {
    static constexpr bool PERM = true;
    __device__ __forceinline__ bool keep(const pg8::Unit&) const { return false; }
    bf16* Y;
    __device__ __forceinline__ void operator()(AccT& acc, const pg8::Unit& u, int wr, int wc, int fr, int fq) const { run<false>(acc, u, wr, wc, fr, fq); }
    template <bool SK> __device__ __forceinline__ void run(AccT& acc, const pg8::Unit& u, int wr, int wc, int fr, int fq) const {
        const int row0 = u.pm * 256 + wr * 64 + fr, col0 = u.pn * 256 + wc * 32 + 8 * fq;
#pragma unroll
        for (int ai = 0; ai < (SK ? 1 : 2); ++ai)
#pragma unroll
            for (int m = 0; m < (SK ? 1 : 4); ++m) {
                bf16* rp = Y + (size_t)(row0 + ai * 128 + m * 16) * 1024 + col0;
#pragma unroll
                for (int bj = 0; bj < 2; ++bj) *(u32x4*)(rp + bj * 128) = pack8(acc[ai][bj][m][0], acc[ai][bj][m][1]);
            }
    }
};
template <bool TOK> struct EpiRes {
    static constexpr bool PERM = true;
    __device__ __forceinline__ bool keep(const pg8::Unit&) const { return false; }
    bf16* HB; const LAS int* tokl;
    __device__ __forceinline__ void operator()(AccT& acc, const pg8::Unit& u, int wr, int wc, int fr, int fq) const { run<false>(acc, u, wr, wc, fr, fq); }
    template <bool SK> __device__ __forceinline__ void run(AccT& acc, const pg8::Unit& u, int wr, int wc, int fr, int fq) const {
        const int col0 = u.pn * 256 + wc * 32 + 8 * fq;
        int rowv[2][4]; u32x4 hr[2][4][2];
#pragma unroll
        for (int ai = 0; ai < (SK ? 1 : 2); ++ai)
#pragma unroll
            for (int m = 0; m < (SK ? 1 : 4); ++m) {
                const int p = wr * 64 + fr + ai * 128 + m * 16; int row;
                if constexpr (TOK) row = tokl[u.seg * 256 + p]; else row = u.pm * 256 + p;
                rowv[ai][m] = row; const int rl = row < 0 ? 0 : row;
#pragma unroll
                for (int bj = 0; bj < 2; ++bj) hr[ai][m][bj] = *(const u32x4*)(HB + (size_t)rl * 1024 + col0 + bj * 128);
            }
#pragma unroll
        for (int ai = 0; ai < (SK ? 1 : 2); ++ai)
#pragma unroll
            for (int m = 0; m < (SK ? 1 : 4); ++m) { const int row = rowv[ai][m];
#pragma unroll
                for (int bj = 0; bj < 2; ++bj) { const u32x4 n4 = hr[ai][m][bj];
                    f32x4 a0 = acc[ai][bj][m][0], a1 = acc[ai][bj][m][1];
                    a0[0] += bflo(n4.x); a0[1] += bfhi(n4.x); a0[2] += bflo(n4.y); a0[3] += bfhi(n4.y); a1[0] += bflo(n4.z); a1[1] += bfhi(n4.z); a1[2] += bflo(n4.w); a1[3] += bfhi(n4.w);
                    if (!TOK || row >= 0) *(u32x4*)(HB + (size_t)row * 1024 + col0 + bj * 128) = pack8(a0, a1); } }
    }
};
template <bool GA> struct MoeOrderT {
    static constexpr bool GATHER = GA; const LAS int* tokl;
    int NP, G, c, mode; const LAS int* pcls; const bf16* W;
    __device__ bool next(int i, pg8::Unit& u) const { const long L = (long)i * G + c; if (L >= (long)NP * 4) return false; u.pm = (int)(L >> 2); u.pn = (int)(L & 3); u.seg = i; return true; }
    __device__ __forceinline__ int nt(const pg8::Unit&, int ntd) const { return ntd; }
    __device__ __forceinline__ size_t aoff(const pg8::Unit&) const { return 0; }
    __device__ __forceinline__ const char* bptr(const pg8::Unit& u, int side) const {
        const int cls = __builtin_amdgcn_readfirstlane(pcls[u.pm]); const int grp = cls / 6, pr = cls % 6;
        const int ea = pr < 3 ? 0 : (pr < 5 ? 1 : 2), eb = pr < 3 ? pr + 1 : (pr < 5 ? pr - 1 : 3);
        if (mode == 0) { const int e = grp * 4 + (u.pn < 2 ? ea : eb); return (const char*)W + ((size_t)e * 512 + (size_t)(u.pn & 1) * 256) * 1024 * 2; }
        const int e = grp * 4 + (side ? eb : ea); return (const char*)W + ((size_t)e * 1024 + (size_t)u.pn * 256) * 256 * 2;
    }
};

template <bool PERM> __device__ __forceinline__ void skinny_k(AccT& acc, const bf16* A, int lda, const bf16* Bt, int ldb, int K, int wc, int fr, int fq) {
    const bf16* ap = A + (size_t)fr * lda + 8 * fq;
    const bf16* bp[2][2];
#pragma unroll
    for (int bj = 0; bj < 2; ++bj)
#pragma unroll
        for (int n = 0; n < 2; ++n) { const int col = 128 * bj + 32 * wc + (PERM ? 8 * (fr >> 2) + 4 * n + (fr & 3) : 16 * n + fr); bp[bj][n] = Bt + (size_t)col * ldb + 8 * fq; }
#pragma unroll 8
    for (int k0 = 0; k0 < K; k0 += 32) {
        const bf16x8 a = *(const bf16x8*)(ap + k0);
#pragma unroll
        for (int bj = 0; bj < 2; ++bj)
#pragma unroll
            for (int n = 0; n < 2; ++n) { const bf16x8 b = *(const bf16x8*)(bp[bj][n] + k0); acc[0][bj][0][n] = __builtin_amdgcn_mfma_f32_16x16x32_bf16(b, a, acc[0][bj][0][n], 0, 0, 0); }
    }
}
__device__ __forceinline__ void skinny_zero(AccT& acc) {
#pragma unroll
    for (int bj = 0; bj < 2; ++bj)
#pragma unroll
        for (int n = 0; n < 2; ++n) acc[0][bj][0][n] = (f32x4){0.f, 0.f, 0.f, 0.f};
}
__device__ __forceinline__ void skinny_combine(AccT& acc, LAS unsigned char* lds, int wave, int lane) {
    LAS f32x4* X = (LAS f32x4*)lds;
    if (wave >= 4) {
#pragma unroll
        for (int bj = 0; bj < 2; ++bj)
#pragma unroll
            for (int n = 0; n < 2; ++n) X[((wave - 4) * 64 + lane) * 4 + bj * 2 + n] = acc[0][bj][0][n]; }
    __syncthreads();
    if (wave < 4) {
#pragma unroll
        for (int bj = 0; bj < 2; ++bj)
#pragma unroll
            for (int n = 0; n < 2; ++n) acc[0][bj][0][n] += X[(wave * 64 + lane) * 4 + bj * 2 + n]; }
    __syncthreads();
}

#define XB_TMO      128
#define XB_XCNT(j)  (256  + 64 * (j))
#define XB_XSUB(j)  (1280 + 64 * (j))
#define XB_XGEN(j)  (2304 + 64 * (j))
#define XB_TOP      3328
#define XB_TOPGEN   3392
#define XCD_BAR_WORDS 3456
#define XB_SPIN_CAP (1u << 24)
__device__ __forceinline__ unsigned xb_ld(unsigned* p)              { return __hip_atomic_load(p, __ATOMIC_RELAXED, __HIP_MEMORY_SCOPE_AGENT); }
__device__ __forceinline__ unsigned xb_add(unsigned* p, unsigned v) { return __hip_atomic_fetch_add(p, v, __ATOMIC_RELAXED, __HIP_MEMORY_SCOPE_AGENT); }
__device__ __forceinline__ unsigned xb_xcc_id() { return (unsigned)__builtin_amdgcn_s_getreg((3 << 11) | 20) & 0xFu; }
#define XB_SPIN(cond, bar) do { unsigned _sp = 0; while (cond) { __builtin_amdgcn_s_sleep(1); \
    if ((++_sp & 255u) == 0u) { if (xb_ld(&(bar)[XB_TMO])) break; if (_sp > XB_SPIN_CAP) { atomicAdd(&(bar)[XB_TMO], 1u); break; } } } } while (0)
struct XcdBarrier { unsigned* bar; unsigned x; volatile LAS unsigned* st; };
__device__ __forceinline__ XcdBarrier xcd_barrier_post(unsigned* bar, volatile LAS unsigned* st) {
    XcdBarrier b; b.bar = bar; b.x = xb_xcc_id(); b.st = st;
    if (threadIdx.x == 0) (void)xb_add(&bar[XB_XCNT(b.x)], 1u);
    return b;
}
__device__ __forceinline__ void xcd_barrier_complete(unsigned* bar, unsigned x, unsigned& nloc, unsigned& nx) {
    const unsigned G = gridDim.x * gridDim.y * gridDim.z;
    unsigned sum, cnt, mine, sp = 0u;
    for (;;) {
        sum = 0u; cnt = 0u; mine = 0u;
#pragma unroll
        for (unsigned j = 0; j < 16; ++j) { const unsigned c = xb_ld(&bar[XB_XCNT(j)]); sum += c; cnt += (c > 0u) ? 1u : 0u; mine = (j == x) ? c : mine; }
        if (sum == G) break;
        __builtin_amdgcn_s_sleep(1);
        if ((++sp & 255u) == 0u) { if (xb_ld(&bar[XB_TMO])) break; if (sp > XB_SPIN_CAP) { atomicAdd(&bar[XB_TMO], 1u); break; } }
    }
    nloc = mine > 0u ? mine : 1u; nx = cnt > 0u ? cnt : 1u;
}
__device__ __forceinline__ void xcd_barrier(const XcdBarrier& b) {
    asm volatile("s_waitcnt vmcnt(0)" ::: "memory");
    __syncthreads();
    if (threadIdx.x == 0) {
        unsigned* bar = b.bar;
        __builtin_amdgcn_s_waitcnt(0);
        unsigned nloc = b.st[0], nx = b.st[1];
        if (nloc == 0u) { xcd_barrier_complete(bar, b.x, nloc, nx); b.st[0] = nloc; b.st[1] = nx; }
        const unsigned old = xb_add(&bar[XB_XSUB(b.x)], 1u);
        const unsigned gen = old / nloc;
        if (old + 1u == (gen + 1u) * nloc) {
            __builtin_amdgcn_fence(__ATOMIC_RELEASE, "agent");
            asm volatile("s_waitcnt vmcnt(0)" ::: "memory");
            const unsigned og = xb_add(&bar[XB_TOP], 1u);
            const unsigned tg = og / nx;
            if (og + 1u == (tg + 1u) * nx) xb_add(&bar[XB_TOPGEN], 1u);
            else XB_SPIN(xb_ld(&bar[XB_TOPGEN]) == tg, bar);
            __builtin_amdgcn_fence(__ATOMIC_ACQUIRE, "agent");
            xb_add(&bar[XB_XGEN(b.x)], 1u);
            asm volatile("s_waitcnt vmcnt(0)" ::: "memory");
        } else {
            XB_SPIN(xb_ld(&bar[XB_XGEN(b.x)]) == gen, bar);
            __builtin_amdgcn_fence(__ATOMIC_ACQUIRE, "agent");
            asm volatile("s_waitcnt vmcnt(0)" ::: "memory");
        }
    }
    __syncthreads();
}

struct Params { const float* in[25]; float* out; unsigned char* ws; int ph_lo, ph_hi; };
enum { I_X = 0, I_META, I_N1G, I_WIN, I_BF, I_PW, I_PB, I_PS, I_CW, I_CB, I_LNG, I_LNB, I_WOA, I_WOB, I_WOC, I_WO, I_N2G, I_RGW, I_RGB, I_REW, I_REB, I_W1, I_W3, I_W2, I_FG };

struct Frame {
    LAS unsigned char* lds;
    int tid, lane, wave, vcu, G, bx;
};
__device__ __forceinline__ unsigned long long ptab_get(const Frame& F, int i) { const LAS unsigned* t = (const LAS unsigned*)(F.lds + LC_PTAB) + 2 * i; const unsigned lo = __builtin_amdgcn_readfirstlane(t[0]), hi = __builtin_amdgcn_readfirstlane(t[1]); return ((unsigned long long)hi << 32) | lo; }
#define INP(i) ((const float*)(const GAS float*)ptab_get(F, (i)))
#define WSP() ((unsigned char*)(GAS unsigned char*)ptab_get(F, 25))
#define DOP() ((unsigned char*)(GAS unsigned char*)ptab_get(F, 26))

__device__ __forceinline__ void tr_item(const float* W, int ldw, int scol_lane  , const float* gk, bf16* WT, int ldt, int drow0, int k0, LAS float* scr, int lane) {
    const int n4 = (lane & 7) * 4, kr = lane >> 3;
    f32x4 v[8];
#pragma unroll
    for (int i = 0; i < 8; ++i) v[i] = *(const f32x4*)(W + (size_t)(k0 + 8 * i + kr) * ldw + scol_lane);
#pragma unroll
    for (int i = 0; i < 8; ++i) { const int kk = 8 * i + kr; const float g = gk ? gk[k0 + kk] : 1.0f; LAS float* d = scr + kk * 33 + n4; d[0] = v[i][0] * g; d[1] = v[i][1] * g; d[2] = v[i][2] * g; d[3] = v[i][3] * g; }
    LDS_WAIT(); asm volatile("" ::: "memory");
    const int c = lane & 7;
#pragma unroll
    for (int j = 0; j < 4; ++j) { const int n = (lane >> 3) + 8 * j; const LAS float* s = scr + (8 * c) * 33 + n;
        u32x4 o; o.x = pk2(s[0 * 33], s[1 * 33]); o.y = pk2(s[2 * 33], s[3 * 33]); o.z = pk2(s[4 * 33], s[5 * 33]); o.w = pk2(s[6 * 33], s[7 * 33]);
        *(u32x4*)(WT + (size_t)(drow0 + n) * ldt + k0 + 8 * c) = o; }
    LDS_WAIT(); asm volatile("" ::: "memory");
}
__device__ __forceinline__ int map1(int n) {
    const int tile = n >> 8, c = n & 255;
    if (tile == 0) return n;
    if (tile <= 2) { const int cc = (tile - 1) * 128 + (c & 127); return (c < 128 ? 256 : 512) + cc; }
    if (tile <= 4) return 1792 + (n - 768);
    const int t = tile - 5, bj = c >> 7, wc = (c >> 5) & 3, fq = (c >> 3) & 3, nn = (c >> 2) & 1, d = 64 * t + 16 * wc + 4 * fq + (c & 3), kind = 2 * bj + nn;
    return kind == 3 ? 768 + d : 2312 + 1024 * kind + d;
}
__device__ __forceinline__ void convert_item(Frame& F, int l, int it, LAS float* scr, int lane) {
    const float* g1 = INP(I_N1G) + (size_t)l * D; const float* g2 = INP(I_N2G) + (size_t)l * D; unsigned char* ws = WSP(); const int n4l = (lane & 7) * 4;
    if (it < 2688) { const int kb = it / 168, nb = it % 168; tr_item(INP(I_WIN) + (size_t)l * D * NIN, NIN, map1(nb * 32 + n4l), g1, (bf16*)(ws + WS_W1T), 1024, nb * 32, kb * 64, scr, lane); return; } it -= 2688;
    if (it < 128) { const int kb = it / 32, nb = it % 32; tr_item(INP(I_WOB) + (size_t)l * 256 * D, 1024, nb * 32 + n4l, nullptr, (bf16*)(ws + WS_W3CT) + 256, 1024, nb * 32, kb * 64, scr, lane); return; } it -= 128;
    if (it < 256) { const int kb = it / 32, nb = it % 32; tr_item(INP(I_WOC) + (size_t)l * 512 * D, 1024, nb * 32 + n4l, nullptr, (bf16*)(ws + WS_W3CT) + 512, 1024, nb * 32, kb * 64, scr, lane); return; } it -= 256;
    if (it < 512) { const int kb = it / 32, nb = it % 32; tr_item(INP(I_WO) + (size_t)l * D * D, 1024, nb * 32 + n4l, nullptr, (bf16*)(ws + WS_WOT), 1024, nb * 32, kb * 64, scr, lane); return; } it -= 512;
    if (it < 4096) { const int e = it >> 8, r = it & 255, kb = r >> 4, nb = r & 15, n0 = nb * 32, jt = n0 >> 8, rr = n0 & 255;
        const float* W = (rr < 128 ? INP(I_W1) : INP(I_W3)) + ((size_t)l * 16 + e) * D * 256;
        tr_item(W, 256, jt * 128 + (rr & 127) + n4l, g2, (bf16*)(DOP() + DO_W13T) + (size_t)e * 512 * 1024, 1024, n0, kb * 64, scr, lane); return; } it -= 4096;
    { const int e = it >> 7, r = it & 127, kb = r >> 5, nb = r & 31;
        tr_item(INP(I_W2) + ((size_t)l * 16 + e) * 256 * D, 1024, nb * 32 + n4l, nullptr, (bf16*)(DOP() + DO_W2T) + (size_t)e * 1024 * 256, 256, nb * 32, kb * 64, scr, lane); }
}
__device__ __forceinline__ void convert_weights(Frame& F, int l) {
    LAS float* scr = (LAS float*)(F.lds + F.wave * 16384);
    const int gw = F.vcu * NWAVES + F.wave, NGW = F.G * NWAVES, lane = F.lane;
    const float* g1 = INP(I_N1G) + (size_t)l * D; const float* g2 = INP(I_N2G) + (size_t)l * D;
    unsigned char* ws = WSP();
#pragma unroll 1
    for (int it0 = gw; it0 < 3584; it0 += NGW) convert_item(F, l, it0, scr, lane);
    { const float* pw = INP(I_PW) + (size_t)l * 4 * 64 * 64; const float* ps = INP(I_PS) + (size_t)l * 256; const float* pb = INP(I_PB) + (size_t)l * 256;
      const float* wa = INP(I_WOA) + (size_t)l * 256 * D; bf16* WT = (bf16*)(ws + WS_W3CT); float* bias = (float*)(ws + WS_BIASA);
      const int gt = F.vcu * 512 + F.tid, NT = F.G * 512;
      for (int idx = gt; idx < 256 * 1024; idx += NT) { const int n = idx & 1023, kk = idx >> 10, grp = kk >> 6, c = kk & 63; float s = 0.f;
#pragma unroll 16
        for (int d = 0; d < 64; ++d) s += pw[(grp * 64 + c) * 64 + d] * ps[grp * 64 + d] * wa[(size_t)(grp * 64 + d) * D + n];
        WT[(size_t)n * 1024 + kk] = (bf16)f2bf(s); }
      for (int n = gw; n < 1024; n += NGW) { float s = 0.f;
#pragma unroll
        for (int j = 0; j < 4; ++j) { const int d = lane + 64 * j; s += pb[d] * ps[d] * wa[(size_t)d * D + n]; }
        s = wave_sum(s); if (lane == 0) bias[n] = s; }
      float* wfg = (float*)(ws + WS_WFG); const float* win = INP(I_WIN) + (size_t)l * D * NIN;
      for (int idx = gt; idx < 8 * 1024; idx += NT) { const int c = idx >> 10, k = idx & 1023; wfg[idx] = g1[k] * win[(size_t)k * NIN + 2304 + c]; }
      float* rg = (float*)(ws + WS_RG); const float* re = INP(I_REW) + (size_t)l * D * 16; const float* rgw = INP(I_RGW) + (size_t)l * D * 4;
      for (int idx = gt; idx < 20 * 1024; idx += NT) { const int c = idx >> 10, k = idx & 1023; rg[idx] = g2[k] * (c < 16 ? re[(size_t)k * 16 + c] : rgw[(size_t)k * 4 + (c - 16)]); } }
}
__device__ __forceinline__ void init_rows(Frame& F) {
    const int gw = F.vcu * NWAVES + F.wave, NGW = F.G * NWAVES, lane = F.lane;
    bf16* HB = (bf16*)(WSP() + WS_HB); float* rstd1 = (float*)(WSP() + WS_RSTD1);
    constexpr int R = 4;
#pragma unroll 1
    for (int row0 = gw; row0 < TR; row0 += R * NGW) {
        f32x4 v[R][4];
#pragma unroll
        for (int r = 0; r < R; ++r) { int row = row0 + r * NGW; if (row >= TR) row = TR - 1;
            const float* src = row < TX ? INP(I_X) + (size_t)row * D : INP(I_META) + (size_t)(row - TX) * D;
#pragma unroll
            for (int j = 0; j < 4; ++j) v[r][j] = *(const f32x4*)(src + 4 * lane + 256 * j); }
#pragma unroll
        for (int r = 0; r < R; ++r) { const int row = row0 + r * NGW; float ss = 0.f;
#pragma unroll
            for (int j = 0; j < 4; ++j) ss += v[r][j][0] * v[r][j][0] + v[r][j][1] * v[r][j][1] + v[r][j][2] * v[r][j][2] + v[r][j][3] * v[r][j][3];
            ss = wave_sum(ss);
            if (row < TR) {
#pragma unroll
                for (int j = 0; j < 4; ++j) { u32x2 w; w.x = pk2(v[r][j][0], v[r][j][1]); w.y = pk2(v[r][j][2], v[r][j][3]); *(u32x2*)(HB + (size_t)row * D + 4 * lane + 256 * j) = w; }
                if (lane == 0) rstd1[row] = rsqrtf(ss * (1.0f / D) + EPS); } }
    }
    { bf16* Kb = (bf16*)(DOP() + DO_K) + (size_t)TR * 512; bf16* Vb = (bf16*)(DOP() + DO_V) + (size_t)TR * 512; const int gt = F.vcu * 512 + F.tid;
      if (gt < 48 * 64) { *(u32x4*)(Kb + (size_t)gt * 8) = (u32x4){0u, 0u, 0u, 0u}; *(u32x4*)(Vb + (size_t)gt * 8) = (u32x4){0u, 0u, 0u, 0u}; } }
}

__device__ __forceinline__ int srcrow(bool isx, int b, int t) {
    if (t >= 0) return (isx ? b * SEQ : TX) + t;
    if (isx) { const int mm = NMETA + t; return mm >= 0 ? TX + mm : -1; }
    return -1;
}
__device__ __forceinline__ void s_item_logf(Frame& F, int l, int item) {
    LAS unsigned char* lds = F.lds; const int wave = F.wave;
    {
        const bool isx = item < 512; const int row0 = isx ? item * 64 : TX + (item - 512) * 64; const int b = isx ? (item * 64) / SEQ : 0; const int t0 = isx ? (item * 64) % SEQ : (item - 512) * 64; const int nrows = isx ? 64 : NMETA;
        { unsigned char* ws = WSP(); int tid = F.tid; LAUNDER_V(tid); const int lane = tid & 63, fr = lane & 15, fq = lane >> 4;
          const bf16* HB = (const bf16*)(ws + WS_HB); const float* rstd1 = (const float*)(ws + WS_RSTD1); const float* wfg = (const float*)(ws + WS_WFG);
          float* LFT = (float*)(ws + WS_LFT); float* LFTM = (float*)(ws + WS_LFTM); const float* bfg = INP(I_BF) + l * 8;
          LAS bf16* Whi = (LAS bf16*)lds; LAS bf16* Wlo = Whi + 8 * RPITCH; LAS float* Pex = (LAS float*)(lds + 2 * 8 * RPITCH * 2);
          { f32x4 wv_[4];
#pragma unroll
            for (int j = 0; j < 4; ++j) wv_[j] = *(const f32x4*)(wfg + 4 * (tid + 512 * j));
#pragma unroll
            for (int j = 0; j < 4; ++j) { const int i = 4 * (tid + 512 * j), c = i >> 10, k = i & 1023; u32x2 hw, lw; float hf[4];
#pragma unroll
                for (int e = 0; e < 4; ++e) hf[e] = __builtin_bit_cast(float, (pk2(wv_[j][e], 0.f) & 0xffffu) << 16);
                hw.x = pk2(wv_[j][0], wv_[j][1]); hw.y = pk2(wv_[j][2], wv_[j][3]); lw.x = pk2(wv_[j][0] - hf[0], wv_[j][1] - hf[1]); lw.y = pk2(wv_[j][2] - hf[2], wv_[j][3] - hf[3]);
                *(LAS u32x2*)(Whi + c * RPITCH + k) = hw; *(LAS u32x2*)(Wlo + c * RPITCH + k) = lw; } }
          const int g = wave & 3, kh = wave >> 2, rr = 16 * g + fr, row = row0 + rr;
          bf16x8 af[16];
#pragma unroll
          for (int s2 = 0; s2 < 16; ++s2) af[s2] = *(const bf16x8*)(HB + (size_t)row * D + 32 * (16 * kh + s2) + 8 * fq);
          const float rs1 = rstd1[row];
          __syncthreads();
          f32x4 acc = {0.f, 0.f, 0.f, 0.f};
#pragma unroll
          for (int s2 = 0; s2 < 16; ++s2) { const int k = 32 * (16 * kh + s2) + 8 * fq;
              bf16x8 wh = *(const LAS bf16x8*)(Whi + (fr & 7) * RPITCH + k), wl = *(const LAS bf16x8*)(Wlo + (fr & 7) * RPITCH + k);
              if (fr >= 8) { wh = (bf16x8){0, 0, 0, 0, 0, 0, 0, 0}; wl = wh; }
              acc = __builtin_amdgcn_mfma_f32_16x16x32_bf16(wh, af[s2], acc, 0, 0, 0); acc = __builtin_amdgcn_mfma_f32_16x16x32_bf16(wl, af[s2], acc, 0, 0, 0); }
          if (kh == 1) *(LAS f32x4*)(Pex + (g * 64 + lane) * 4) = acc;
          __syncthreads();
          if (kh == 0) { const f32x4 o4 = *(const LAS f32x4*)(Pex + (g * 64 + lane) * 4); acc += o4;
              if (fq < 2 && rr < nrows && row < TR) {
#pragma unroll
                  for (int i = 0; i < 4; ++i) { const int hd = 4 * fq + i; const float xg = acc[i] * rs1 + bfg[hd]; const float lf = fminf(xg, 0.f) - 0.69314718056f * __builtin_amdgcn_logf(1.0f + __expf(-fabsf(xg)));
                      if (isx) LFT[(size_t)(b * 8 + hd) * SEQ + t0 + rr] = lf; else LFTM[hd * 256 + t0 + rr] = lf; } } }
          __syncthreads(); }
    }
}
__device__ __forceinline__ void norm_items(Frame& F, int l, int wsub, int nsub) {
    LAS unsigned* nmx = (LAS unsigned*)(F.lds + LC_NMX); const int wave = F.wave;
#pragma unroll 1
    for (int item = wsub; item < 513; item += nsub) {
        const bool isx = item < 512; const int row0 = isx ? item * 64 : TX; const int b = isx ? (item * 64) / SEQ : 0; const int nrows = isx ? 64 : NMETA;
        int tid = F.tid; LAUNDER_V(tid); const int lane = tid & 63;
        if (tid < 16) nmx[tid] = 0u;
        __syncthreads();
        {
          { const bf16* Qg = (const bf16*)(DOP() + DO_Q); const bf16* Kg = (const bf16*)(DOP() + DO_K); float kmx = 0.f, qmx = 0.f;
            u32x4 kw[8], qw[8];
#pragma unroll
            for (int i8 = 0; i8 < 8; ++i8) { const int r2 = wave + 8 * i8; const int rw = row0 + (r2 < nrows ? r2 : 0); kw[i8] = *(const u32x4*)(Kg + (size_t)rw * 512 + 8 * lane); qw[i8] = *(const u32x4*)(Qg + (size_t)rw * 512 + 8 * lane); }
#pragma unroll
            for (int i8 = 0; i8 < 8; ++i8) { const u32x4 a = kw[i8], c = qw[i8];
                float sk = (bflo(a.x) * bflo(a.x) + bfhi(a.x) * bfhi(a.x)) + (bflo(a.y) * bflo(a.y) + bfhi(a.y) * bfhi(a.y)) + (bflo(a.z) * bflo(a.z) + bfhi(a.z) * bfhi(a.z)) + (bflo(a.w) * bflo(a.w) + bfhi(a.w) * bfhi(a.w));
                float sq = (bflo(c.x) * bflo(c.x) + bfhi(c.x) * bfhi(c.x)) + (bflo(c.y) * bflo(c.y) + bfhi(c.y) * bfhi(c.y)) + (bflo(c.z) * bflo(c.z) + bfhi(c.z) * bfhi(c.z)) + (bflo(c.w) * bflo(c.w) + bfhi(c.w) * bfhi(c.w));
                sk += lane_xor<1>(sk); sk += lane_xor<2>(sk); sk += lane_xor<4>(sk); sq += lane_xor<1>(sq); sq += lane_xor<2>(sq); sq += lane_xor<4>(sq);
                kmx = fmaxf(kmx, sk); qmx = fmaxf(qmx, sq); }
            if ((lane & 7) == 0) { const int hd = lane >> 3; __hip_atomic_fetch_max(&nmx[hd], __float_as_uint(kmx), __ATOMIC_RELAXED, __HIP_MEMORY_SCOPE_WORKGROUP); __hip_atomic_fetch_max(&nmx[8 + hd], __float_as_uint(qmx), __ATOMIC_RELAXED, __HIP_MEMORY_SCOPE_WORKGROUP); } }
        }
        __syncthreads();
        if (tid < 16) { unsigned* nrm = (unsigned*)(WSP() + WS_CTL) + CW_NRM + l * 64; const unsigned v = nmx[tid];
            if (isx) __hip_atomic_fetch_max(nrm + (tid >> 3) * 32 + b * 8 + (tid & 7), v, __ATOMIC_RELAXED, __HIP_MEMORY_SCOPE_AGENT);
            else if (tid < 8) { for (int bb = 0; bb < NB; ++bb) __hip_atomic_fetch_max(nrm + bb * 8 + tid, v, __ATOMIC_RELAXED, __HIP_MEMORY_SCOPE_AGENT); } }
        __syncthreads();
    }
}
__device__ __forceinline__ void s_item_poolconv(Frame& F, int l, int it32) {
    const int hw = F.wave >> 2, hwave = F.wave & 3; LAS unsigned char* lds = F.lds + hw * 64512;
    const bool isx = it32 < 1024; const int row0 = isx ? it32 * 32 : TX; const int b = isx ? (it32 * 32) / SEQ : 0; const int t0 = isx ? (it32 * 32) % SEQ : 0; const int nrows = isx ? 32 : NMETA;
    { unsigned char* ws = WSP(); int tid = F.tid & 255; LAUNDER_V(tid);
      const bf16* Ab = (const bf16*)(ws + WS_A); bf16* DIFF = (bf16*)(ws + WS_X3);
      LAS unsigned char* T = lds;
      { u32x4 tv[6]; const int nld = (15 + nrows) * 32;
#pragma unroll
        for (int j = 0; j < 6; ++j) { const int i = tid + 256 * j; const int sl = i >> 5, ch = i & 31; const int r = i < nld ? srcrow(isx, b, t0 + sl - 15) : -1; unsigned z_ = 0u; LAUNDER_V(z_);
            tv[j] = r >= 0 ? *(const u32x4*)(Ab + (size_t)r * 256 + ch * 8) : (u32x4){z_, z_, z_, z_}; }
#pragma unroll
        for (int j = 0; j < 6; ++j) { const int i = tid + 256 * j; if (i < nld) *(LAS u32x4*)(T + (i >> 5) * 512 + (i & 31) * 16) = tv[j]; } }
      __syncthreads();
#pragma unroll 1
      for (int i = tid; i < nrows * 32; i += 256) { const int r = i >> 5, ch = i & 31, grp = ch >> 3, w = 2 << grp; const int cnt = isx ? w : min(t0 + r + 1, w);
          float s[8];
#pragma unroll
          for (int j = 0; j < 8; ++j) s[j] = 0.f;
#pragma unroll 4
          for (int d = 0; d < cnt; ++d) { const u32x4 v = *(const LAS u32x4*)(T + (15 + r - d) * 512 + ch * 16);
              s[0] += bflo(v.x); s[1] += bfhi(v.x); s[2] += bflo(v.y); s[3] += bfhi(v.y); s[4] += bflo(v.z); s[5] += bfhi(v.z); s[6] += bflo(v.w); s[7] += bfhi(v.w); }
          const u32x4 a = *(const LAS u32x4*)(T + (15 + r) * 512 + ch * 16); const float ic = 1.0f / (float)cnt;
          u32x4 o; o.x = pk2(s[0] * ic - bflo(a.x), s[1] * ic - bfhi(a.x)); o.y = pk2(s[2] * ic - bflo(a.y), s[3] * ic - bfhi(a.y));
          o.z = pk2(s[4] * ic - bflo(a.z), s[5] * ic - bfhi(a.z)); o.w = pk2(s[6] * ic - bflo(a.w), s[7] * ic - bfhi(a.w));
          if (row0 + r < TR) *(u32x4*)(DIFF + (size_t)(row0 + r) * 1024 + ch * 8) = o; }
      __syncthreads(); }
    { unsigned char* ws = WSP(); int tid = F.tid & 255; LAUNDER_V(tid);
      const bf16* GLU = (const bf16*)(ws + WS_GLU);
      LAS unsigned char* T = lds;
      LAS float* Yt = (LAS float*)(lds + 31744);
      { u32x4 tv[8]; const int nld = (isx ? 62 : 46) * 32;
#pragma unroll
        for (int j = 0; j < 8; ++j) { const int i = tid + 256 * j; const int sl = i >> 5, ch = i & 31; const int r = i < nld ? srcrow(isx, b, t0 + sl - 30) : -1; unsigned z_ = 0u; LAUNDER_V(z_);
            tv[j] = r >= 0 ? *(const u32x4*)(GLU + (size_t)r * 256 + ch * 8) : (u32x4){z_, z_, z_, z_}; }
#pragma unroll
        for (int j = 0; j < 8; ++j) { const int i = tid + 256 * j; if (i < 62 * 32) *(LAS u32x4*)(T + (i >> 5) * 512 + (i & 31) * 16) = tv[j]; } }
      __syncthreads();
      { const float* cw = INP(I_CW) + (size_t)l * 31 * 256; const float* cb = INP(I_CB) + l * 256;
        const int cp = tid & 127, strip = tid >> 7; f32x2 wv[31];
#pragma unroll
        for (int j = 0; j < 31; ++j) wv[j] = *(const f32x2*)(cw + j * 256 + 2 * cp);
        const f32x2 bias = *(const f32x2*)(cb + 2 * cp);
#pragma unroll 1
        for (int hh = 0; hh < 2; ++hh) { const int rb = 16 * strip + 8 * hh; f32x2 acc[8];
#pragma unroll
            for (int r = 0; r < 8; ++r) acc[r] = bias;
#pragma unroll
            for (int i = 0; i < 38; ++i) { const unsigned xw = *(const LAS unsigned*)(T + (rb + i) * 512 + cp * 4); const f32x2 xx = {bflo(xw), bfhi(xw)};
#pragma unroll
                for (int r = 0; r < 8; ++r) { const int j = i - r; if (j >= 0 && j <= 30) acc[r] += wv[j] * xx; } }
#pragma unroll
            for (int r = 0; r < 8; ++r) *(LAS f32x2*)(Yt + (rb + r) * 256 + 2 * cp) = acc[r]; } }
      __syncthreads();
      { unsigned char* ws2 = WSP(); int tid2 = F.tid; LAUNDER_V(tid2); const int lane = tid2 & 63;
        bf16* BP = (bf16*)(ws2 + WS_X3) + 256; const float* lng = INP(I_LNG) + l * 256; const float* lnb = INP(I_LNB) + l * 256;
        const f32x4 gg = *(const f32x4*)(lng + 4 * lane), bb = *(const f32x4*)(lnb + 4 * lane);
#pragma unroll
        for (int i8 = 0; i8 < 8; ++i8) { const int rr = hwave + 4 * i8; if (rr >= nrows) continue; const f32x4 v = *(const LAS f32x4*)(Yt + rr * 256 + 4 * lane);
          const float mean = wave_sum(v[0] + v[1] + v[2] + v[3]) * (1.0f / 256.0f); const f32x4 dv = v - mean;
          const float var = wave_sum(dv[0] * dv[0] + dv[1] * dv[1] + dv[2] * dv[2] + dv[3] * dv[3]) * (1.0f / 256.0f); const float rs = rsqrtf(var + EPS);
          f32x4 o = dv * rs * gg + bb;
#pragma unroll
          for (int j = 0; j < 4; ++j) o[j] = o[j] * sigmoidf_(o[j]);
          u32x2 w; w.x = pk2(o[0], o[1]); w.y = pk2(o[2], o[3]); if (row0 + rr < TR) *(u32x2*)(BP + (size_t)(row0 + rr) * 1024 + 4 * lane) = w; } }
      __syncthreads(); }
}
constexpr int AT_FL = 0, AT_K = 34816, AT_VT = AT_K + 8192, AT_SC = AT_VT + 8192;
__device__ __forceinline__ void attn_scan(Frame& F, int b, int h, bool meta_only, int fl_off, int sc_off) {
    LAS float* Fl = (LAS float*)(F.lds + fl_off); LAS float* sc = (LAS float*)(F.lds + sc_off);
    const float* LFT = (const float*)(WSP() + WS_LFT); const float* LFTM = (const float*)(WSP() + WS_LFTM);
    const int tid = F.tid, lane = F.lane, wave = F.wave;
    __syncthreads();
    if (tid == 0) { float s = 0.f; for (int m = 0; m < 64; ++m) { if (m < NMETA) { s += LFTM[h * 256 + m]; Fl[m] = s * LOG2E; } else Fl[m] = 1e30f; if (m == NMETA - 1) sc[16] = s; } }
    if (meta_only) { for (int i = tid; i < 256; i += 512) Fl[64 + i] = 0.f; __syncthreads(); return; }
    float v[16]; const float* src = LFT + (size_t)(b * 8 + h) * SEQ + 16 * tid;
#pragma unroll
    for (int j = 0; j < 4; ++j) { const f32x4 q = *(const f32x4*)(src + 4 * j); v[4 * j] = q[0]; v[4 * j + 1] = q[1]; v[4 * j + 2] = q[2]; v[4 * j + 3] = q[3]; }
#pragma unroll
    for (int j = 1; j < 16; ++j) v[j] += v[j - 1];
    float incl = v[15];
#pragma unroll
    for (int o = 1; o < 64; o <<= 1) { const float up = __int_as_float(__builtin_amdgcn_ds_bpermute((lane - o) << 2, __float_as_int(incl))); if (lane >= o) incl += up; }
    if (lane == 63) sc[wave] = incl;
    __syncthreads();
    float off = sc[16];
    for (int w = 0; w < wave; ++w) off += sc[w];
    off += incl - v[15];
#pragma unroll
    for (int j = 0; j < 16; ++j) Fl[64 + 16 * tid + j] = (off + v[j]) * LOG2E;
    __syncthreads();
}
__device__ __forceinline__ void attn_unit_naive(Frame& F, int qrow0, int qpos0, int ntiles, int kvx0, int h, int nq) {
    const int tid = F.tid; const int hf = tid & 1; const bool live = (tid >> 1) < nq; const int r = live ? (tid >> 1) : 0;
    const bf16* Q = (const bf16*)(DOP() + DO_Q); const bf16* Kg = (const bf16*)(DOP() + DO_K); const bf16* Vg = (const bf16*)(DOP() + DO_V); bf16* O = (bf16*)(WSP() + WS_X3) + 512;
    LAS float* Fl = (LAS float*)(F.lds + AT_FL); LAS unsigned char* Ks = F.lds + AT_K; LAS bf16* VT = (LAS bf16*)(F.lds + AT_VT);
    const int grow = qrow0 + r, qpos = qpos0 + r;
    unsigned qp[16];
#pragma unroll
    for (int j = 0; j < 4; ++j) { const u32x4 w = *(const u32x4*)(Q + (size_t)grow * 512 + h * 64 + hf * 32 + 8 * j); qp[4 * j] = w.x; qp[4 * j + 1] = w.y; qp[4 * j + 2] = w.z; qp[4 * j + 3] = w.w; }
    const float Fq = Fl[qpos < NMETA ? qpos : qpos + 48];
    float mrun = -1e30f, lrun = 0.f, o[32];
#pragma unroll
    for (int d = 0; d < 32; ++d) o[d] = 0.f;
    const int lrow = tid >> 3, lch = tid & 7;

#pragma unroll 1
for (int i = 0; i < ntiles; ++i) {
        const int krow = (i == 0 ? TX : kvx0 + 64 * (i - 1)) + lrow;
        const u32x4 kw = *(const u32x4*)(Kg + (size_t)krow * 512 + h * 64 + lch * 8);
        const u32x4 vw = *(const u32x4*)(Vg + (size_t)krow * 512 + h * 64 + lch * 8);
        __syncthreads();
        *(LAS u32x4*)(Ks + lrow * 128 + lch * 16) = kw;
        { const unsigned vv[4] = {vw.x, vw.y, vw.z, vw.w};
#pragma unroll
          for (int e = 0; e < 4; ++e) { VT[(lch * 8 + 2 * e) * 64 + lrow] = (bf16)(vv[e] & 0xffffu); VT[(lch * 8 + 2 * e + 1) * 64 + lrow] = (bf16)(vv[e] >> 16); } }
        __syncthreads();
        const int kp0 = i == 0 ? 0 : NMETA + 64 * (i - 1);
        if (kp0 > qpos0 + 255) continue;
#pragma unroll 1
        for (int jg = 0; jg < 4; ++jg) {
            float s[16]; float gmax = -1e30f;
#pragma unroll
            for (int jj = 0; jj < 16; ++jj) { const int j = jg * 16 + jj; float d = 0.f;
#pragma unroll
                for (int c = 0; c < 4; ++c) { const u32x4 kk = *(const LAS u32x4*)(Ks + j * 128 + hf * 64 + c * 16);
                    d = dot2bf(kk.x, qp[4 * c], d); d = dot2bf(kk.y, qp[4 * c + 1], d); d = dot2bf(kk.z, qp[4 * c + 2], d); d = dot2bf(kk.w, qp[4 * c + 3], d); }
                d += lane_xor<1>(d);
                const bool valid = (i == 0 ? j < NMETA : true) && (kp0 + j <= qpos);
                s[jj] = valid ? d + Fq - Fl[64 * i + j] : -1e30f; gmax = fmaxf(gmax, s[jj]); }
            const float mn = fmaxf(mrun, gmax), alpha = exp2f(mrun - mn); mrun = mn;
            float ps = 0.f; unsigned pp[8];
#pragma unroll
            for (int jj = 0; jj < 16; jj += 2) { const float p0 = exp2f(s[jj] - mn), p1 = exp2f(s[jj + 1] - mn); ps += p0 + p1; pp[jj >> 1] = pk2(p0, p1); }
            lrun = lrun * alpha + ps;
#pragma unroll
            for (int d = 0; d < 32; ++d) { const u32x4 v0 = *(const LAS u32x4*)(VT + (hf * 32 + d) * 64 + jg * 16), v1 = *(const LAS u32x4*)(VT + (hf * 32 + d) * 64 + jg * 16 + 8);
                float a = o[d] * alpha; a = dot2bf(pp[0], v0.x, a); a = dot2bf(pp[1], v0.y, a); a = dot2bf(pp[2], v0.z, a); a = dot2bf(pp[3], v0.w, a);
                a = dot2bf(pp[4], v1.x, a); a = dot2bf(pp[5], v1.y, a); a = dot2bf(pp[6], v1.z, a); a = dot2bf(pp[7], v1.w, a); o[d] = a; }
        }
    }
    const float il = 1.0f / lrun;
    if (live)
#pragma unroll
    for (int j = 0; j < 4; ++j) { u32x4 w; w.x = pk2(o[8 * j] * il, o[8 * j + 1] * il); w.y = pk2(o[8 * j + 2] * il, o[8 * j + 3] * il); w.z = pk2(o[8 * j + 4] * il, o[8 * j + 5] * il); w.w = pk2(o[8 * j + 6] * il, o[8 * j + 7] * il);
        *(u32x4*)(O + (size_t)grow * 1024 + h * 64 + hf * 32 + 8 * j) = w; }
}
namespace fa {
using bf16x8v = __attribute__((ext_vector_type(8))) short;
using s16x4 = __attribute__((ext_vector_type(4))) short;
using f32x16 = __attribute__((ext_vector_type(16))) float;
constexpr int DMA = 512, DMO = 1024;
constexpr int NW = 8, QBLK = 32, QB = 256, KVBLK = 64;
constexpr int NSLOT = 3, SLOTB = 8192;
constexpr int LDS_K = 0, LDS_V = NSLOT * SLOTB, LDS_WS = 2 * NSLOT * SLOTB, LDS_OST = LDS_WS + NW * 64 * 4, LDS_BYTES = LDS_OST + NW * 4096;
constexpr int LDS_FL = 84992;
constexpr int LDS_SCAN = LDS_FL + (64 + 8192) * 4;
static_assert(LDS_SCAN + 128 <= RING_BYTES, "attention LDS");
__device__ __forceinline__ int crow(int r, int hi) { return (r & 3) + 8 * (r >> 2) + 4 * hi; }
#define SBAR() __builtin_amdgcn_sched_barrier(0)
__device__ __forceinline__ void cmask(f32x16& p0, f32x16& p1, int jb, int qrel, int hi) {
    const float NEG = -INFINITY; int kb = 64 * jb + 4 * hi;
#pragma unroll
    for (int r = 0; r < 16; ++r) { int kv = kb + (r & 3) + 8 * (r >> 2); if (kv > qrel) p0[r] = NEG; if (kv + 32 > qrel) p1[r] = NEG; }
}
__device__ __forceinline__ void glds16(const void* gsrc, unsigned lds_dst) { unsigned keep;
    asm volatile("s_mov_b32 %0, m0\n\ts_mov_b32 m0, %2\n\ts_nop 0\n\tglobal_load_lds_dwordx4 %1, off\n\ts_mov_b32 m0, %0" : "=&s"(keep) : "v"(gsrc), "s"(lds_dst) : "memory"); }
__device__ __forceinline__ float max3f(float a, float b, float c) { float r; asm("v_max3_f32 %0, %1, %2, %3" : "=v"(r) : "v"(a), "v"(b), "v"(c)); return r; }
__device__ __forceinline__ float max2f(float a, float b) { float r; asm("v_max_f32_e32 %0, %1, %2" : "=v"(r) : "v"(a), "v"(b)); return r; }
__device__ __forceinline__ float fsub_s(float a, float b) { float r; asm("v_sub_f32_e32 %0, %1, %2" : "=v"(r) : "v"(a), "v"(b)); return r; }
typedef float f32x2_t __attribute__((ext_vector_type(2))); typedef __bf16 bf16x2_t __attribute__((ext_vector_type(2)));
__device__ __forceinline__ unsigned cvtpk_s(float lo, float hi) { f32x2_t v = {lo, hi}; bf16x2_t b = __builtin_convertvector(v, bf16x2_t); return __builtin_bit_cast(unsigned, b); }
#define WAIT_BAR(N) asm volatile("s_waitcnt vmcnt(" #N ") lgkmcnt(0)\n\ts_barrier" ::: "memory")
typedef __attribute__((address_space(3))) const char* lds_cptr;
typedef short v4i16_t __attribute__((ext_vector_type(4)));
__device__ __forceinline__ void cinit(f32x16& p0, f32x16& p1, const LAS float* fk, float a) {
#pragma unroll
    for (int g = 0; g < 4; ++g) { const f32x4 f0 = *(const LAS f32x4*)(fk + 8 * g), f1 = *(const LAS f32x4*)(fk + 32 + 8 * g);
#pragma unroll
        for (int i = 0; i < 4; ++i) { p0[4 * g + i] = a - f0[i]; p1[4 * g + i] = a - f1[i]; } }
}
__device__ __forceinline__ void qkt(f32x16& p0, f32x16& p1, const char* Kslot, const bf16x8v* qr, int r32, int hi) {
    const char* kb = Kslot + hi * 1024 + r32 * 16;
#pragma unroll
    for (int d0 = 0; d0 < 4; ++d0) {
        const bf16x8v b0 = *reinterpret_cast<const bf16x8v*>(kb + d0 * 2048);
        const bf16x8v b1 = *reinterpret_cast<const bf16x8v*>(kb + d0 * 2048 + 512);
        p0 = __builtin_amdgcn_mfma_f32_32x32x16_bf16(b0, qr[d0], p0, 0, 0, 0); p1 = __builtin_amdgcn_mfma_f32_32x32x16_bf16(b1, qr[d0], p1, 0, 0, 0); }
}
__device__ __forceinline__ void kload8(bf16x8v* kf, lds_cptr kp) {
    kf[0] = *(const LAS bf16x8v*)(kp);        kf[1] = *(const LAS bf16x8v*)(kp + 512);
    kf[2] = *(const LAS bf16x8v*)(kp + 2048); kf[3] = *(const LAS bf16x8v*)(kp + 2560);
    kf[4] = *(const LAS bf16x8v*)(kp + 4096); kf[5] = *(const LAS bf16x8v*)(kp + 4608);
    kf[6] = *(const LAS bf16x8v*)(kp + 6144); kf[7] = *(const LAS bf16x8v*)(kp + 6656);
}
__device__ __forceinline__ void kload2(bf16x8v* kf, lds_cptr kp, int j) { kf[2 * j] = *(const LAS bf16x8v*)(kp + j * 2048); kf[2 * j + 1] = *(const LAS bf16x8v*)(kp + j * 2048 + 512); }
__device__ __forceinline__ s16x4 vtr(lds_cptr p) { return __builtin_bit_cast(s16x4, __builtin_amdgcn_ds_read_tr16_b64_v4i16((LAS v4i16_t*)p)); }
__device__ __forceinline__ float rowmax(const f32x16& p0, const f32x16& p1) {
    float a = max3f(p0[0], p0[1], p1[0]), b = max3f(p0[2], p0[3], p1[1]); a = max3f(a, p1[2], p1[3]);
#pragma unroll
    for (int r = 4; r < 16; r += 4) { a = max3f(a, p0[r], p0[r + 1]); b = max3f(b, p0[r + 2], p0[r + 3]); a = max3f(a, p1[r], p1[r + 1]); b = max3f(b, p1[r + 2], p1[r + 3]); }
    const float m = max2f(a, b);
    auto rr = __builtin_amdgcn_permlane32_swap(__float_as_uint(m), __float_as_uint(m), false, false);
    return max2f(__uint_as_float(rr[0]), __uint_as_float(rr[1]));
}
__device__ __forceinline__ void pv(f32x16* o, int vb, bf16x8v pa0, bf16x8v pa1, bf16x8v pa2, bf16x8v pa3) {
#pragma unroll
    for (int d0 = 0; d0 < 2; ++d0) { s16x4 lo[4], hi[4];
#pragma unroll
        for (int ks = 0; ks < 4; ++ks) {
            asm volatile("ds_read_b64_tr_b16 %0,%1 offset:%c2" : "=&v"(lo[ks]) : "v"(vb), "i"(d0 * 4096 + ks * 1024) : "memory");
            asm volatile("ds_read_b64_tr_b16 %0,%1 offset:%c2" : "=&v"(hi[ks]) : "v"(vb), "i"(d0 * 4096 + ks * 1024 + 512) : "memory"); }
        asm volatile("s_waitcnt lgkmcnt(0)" ::: "memory"); SBAR();
#define PK(k) (bf16x8v){lo[k][0], lo[k][1], lo[k][2], lo[k][3], hi[k][0], hi[k][1], hi[k][2], hi[k][3]}
        o[d0] = __builtin_amdgcn_mfma_f32_32x32x16_bf16(pa0, PK(0), o[d0], 0, 0, 0);
        o[d0] = __builtin_amdgcn_mfma_f32_32x32x16_bf16(pa1, PK(1), o[d0], 0, 0, 0);
        o[d0] = __builtin_amdgcn_mfma_f32_32x32x16_bf16(pa2, PK(2), o[d0], 0, 0, 0);
        o[d0] = __builtin_amdgcn_mfma_f32_32x32x16_bf16(pa3, PK(3), o[d0], 0, 0, 0);
#undef PK
    }
}
template <int THRL> __device__ __forceinline__ void attn_unit(int b, int h, int qb, int tf, const bf16* Q, const bf16* __restrict__ K, const bf16* __restrict__ V, bf16* O, char* shm, int wid) {
    const int lane = lane_id_opaque(), r32 = lane & 31, hi = lane >> 5;
    const long rowbase = (long)b * SEQ; const int q0 = qb * QB;
    const bf16* Qw = Q + (rowbase + q0 + wid * QBLK) * DMA + h * 64;
    const bf16* Kh = K + rowbase * DMA + h * 64, *Vh = V + rowbase * DMA + h * 64;
    const bf16* Km = K + (long)TX * DMA + h * 64, *Vm = V + (long)TX * DMA + h * 64;
    const unsigned lds0 = (unsigned)(uintptr_t)shm;
    float* wsf = (float*)(shm + LDS_WS) + wid * 64;
    const bf16* ksrc = Kh + (long)lane * DMA + wid * 8;
    const bf16* vsrc = Vh + (long)(16 * (wid & 3) + (lane >> 2)) * DMA + (wid >> 2) * 32 + (lane & 3) * 8;
    const bf16* ksrcm = Km + (long)lane * DMA + wid * 8;
    const bf16* vsrcm = Vm + (long)(16 * (wid & 3) + (lane >> 2)) * DMA + (wid >> 2) * 32 + (lane & 3) * 8;
    const unsigned kdst = lds0 + LDS_K + wid * 1024, vdst = lds0 + LDS_V + wid * 1024;
#define DMA_K(t, slot) glds16(ksrc + (long)((t) - 1) * KVBLK * DMA, (unsigned)__builtin_amdgcn_readfirstlane(kdst + (slot)))
#define DMA_V(t, slot) glds16(vsrc + (long)((t) - 1) * KVBLK * DMA, (unsigned)__builtin_amdgcn_readfirstlane(vdst + (slot)))
    const int vb0 = (int)(lds0 + LDS_V) + ((lane >> 4) & 1) * 32 + (lane & 3) * 8 + (4 * hi + ((lane & 15) >> 2)) * 64;
    const char* Kbase = shm + LDS_K; bf16x8v kf[8];
    const lds_cptr shm3 = (lds_cptr)shm; const lds_cptr kp0 = shm3 + LDS_K + hi * 1024 + r32 * 16; const lds_cptr vp0 = shm3 + LDS_V + ((lane >> 4) & 1) * 32 + (lane & 3) * 8 + (4 * hi + ((lane & 15) >> 2)) * 64;
    const LAS float* Flp = (const LAS float*)(shm3 + LDS_FL) + 4 * hi;
    const int NT = 4 * qb + 5;
    glds16(tf == 0 ? ksrcm : ksrc + (long)(tf - 1) * KVBLK * DMA, (unsigned)__builtin_amdgcn_readfirstlane(kdst)); glds16(tf == 0 ? vsrcm : vsrc + (long)(tf - 1) * KVBLK * DMA, (unsigned)__builtin_amdgcn_readfirstlane(vdst)); DMA_K(tf + 1, SLOTB);
    bf16x8v qr[4];
#pragma unroll
    for (int d0 = 0; d0 < 4; ++d0) qr[d0] = *reinterpret_cast<const bf16x8v*>(&Qw[(long)r32 * DMA + d0 * 16 + hi * 8]);
    float aq = ((const LAS float*)(shm3 + LDS_FL))[64 + q0 + wid * QBLK + r32 - 64 * tf];
    float l_reg = 0.f; f32x16 o[2]; o[0] = f32x16{}; o[1] = f32x16{};
    const int qrel = wid * QBLK + r32;
#define CMASK(P0, P1, t) do { int jb_ = (t) - (NT - 4); if (jb_ >= 0) cmask(P0, P1, jb_, qrel, hi); } while (0)
    bool resc = false;
#define START(P0, P1) do { const float rm = rowmax(P0, P1); resc = false; \
    { const float dl = max2f(rm, 0.f); aq = fsub_s(aq, dl);        \
      _Pragma("unroll") for (int r = 0; r < 16; ++r) { P0[r] = fsub_s(P0[r], dl); P1[r] = fsub_s(P1[r], dl); } } \
    _Pragma("unroll") for (int r = 0; r < 16; ++r) P0[r] = __builtin_amdgcn_exp2f(P0[r]); } while (0)
#define RESC() do { if (resc) { asm volatile("s_waitcnt lgkmcnt(0)" ::: "memory"); \
      _Pragma("unroll") for (int d_ = 0; d_ < 2; ++d_) _Pragma("unroll") for (int r = 0; r < 16; ++r) o[d_][r] *= wsf[crow(r, hi)]; } } while (0)
    f32x16 pA0, pA1, pB0, pB1;
    int sl_prev = 0, sl_cur = 0, sl_next = SLOTB;
#define ROT() do { sl_prev = sl_cur; sl_cur = sl_next; sl_next = (sl_next == (NSLOT - 1) * SLOTB) ? 0 : sl_next + SLOTB; } while (0)
    DMA_K(tf + 2, 2 * SLOTB);
    cinit(pA0, pA1, Flp, aq);
    WAIT_BAR(3);
    qkt(pA0, pA1, Kbase, qr, r32, hi); asm volatile("s_nop 15\n\ts_nop 7" : "+v"(pA0), "+v"(pA1));
    START(pA0, pA1);
    _Pragma("unroll") for (int r = 0; r < 16; ++r) pA1[r] = __builtin_amdgcn_exp2f(pA1[r]);
    WAIT_BAR(0);
    DMA_K(tf + 3, 0); DMA_V(tf + 1, SLOTB);
    ROT();
    kload8(kf, kp0 + sl_cur);
    WAIT_BAR(2);
    s16x4 vlo[8], vhi[8]; u32x4 pw0, pw1, pw2, pw3;
#define PKW(P, B) cvtpk_s(P[B], P[B + 1])
#define PAF(k) __builtin_bit_cast(bf16x8v, pw##k)
#define VFR(i) (bf16x8v){vlo[i][0], vlo[i][1], vlo[i][2], vlo[i][3], vhi[i][0], vhi[i][1], vhi[i][2], vhi[i][3]}
#define PIN(x) asm volatile("" : "+v"(x))
#define MX3(a, b, c) __builtin_fmaxf(__builtin_fmaxf((a), (b)), (c))
#define GAPA(MF, A0, A1, A2, A3, W0, W1, PW) do { MF; sacc += A0; sacc += A1; sacc += A2; sacc += A3; PIN(sacc); W0; W1; PIN(PW); SBAR(); } while (0)
#define EX(v) __builtin_amdgcn_exp2f(v)
#define GAPB(MF, X, B) do { MF; X[B] = EX(X[B]); X[B + 1] = EX(X[B + 1]); X[B + 2] = EX(X[B + 2]); X[B + 3] = EX(X[B + 3]); PIN(X); SBAR(); } while (0)
#define VRD(i) do { vlo[i] = vtr(vp_ + (((i) >> 2) * 4096 + ((i) & 3) * 1024)); vhi[i] = vtr(vp_ + (((i) >> 2) * 4096 + ((i) & 3) * 1024 + 512)); } while (0)
#define KRD(G, j) do { if (G) { kload2(kf, kp0 + sl_next, j); SBAR(); } } while (0)
#define STEP(C0, C1, P0, P1, t, GK, GV, GL) do { SBAR(); \
    cinit(C0, C1, Flp + 64 * ((t) - tf), aq); SBAR(); \
    const lds_cptr vp_ = vp0 + sl_prev; \
    VRD(0); SBAR(); float sacc = (P0[0] + P0[1]); \
    GAPA(C0 = __builtin_amdgcn_mfma_f32_32x32x16_bf16(kf[0], qr[0], C0, 0, 0, 0), P0[2], P0[3], P0[4], P0[5],     pw0[0] = PKW(P0, 0), pw0[1] = PKW(P0, 2), pw0); \
    VRD(4); SBAR(); GAPA(C1 = __builtin_amdgcn_mfma_f32_32x32x16_bf16(kf[1], qr[0], C1, 0, 0, 0), P0[6], P0[7], P0[8], P0[9],     pw0[2] = PKW(P0, 4), pw0[3] = PKW(P0, 6), pw0); \
    VRD(1); SBAR(); GAPA(C0 = __builtin_amdgcn_mfma_f32_32x32x16_bf16(kf[2], qr[1], C0, 0, 0, 0),   P0[10], P0[11], P0[12], P0[13], pw1[0] = PKW(P0, 8), pw1[1] = PKW(P0, 10), pw1); \
    VRD(5); SBAR(); GAPA(C1 = __builtin_amdgcn_mfma_f32_32x32x16_bf16(kf[3], qr[1], C1, 0, 0, 0),   P0[14], P0[15], P1[0], P1[1],   pw1[2] = PKW(P0, 12), pw1[3] = PKW(P0, 14), pw1); \
    VRD(2); SBAR(); GAPA(C0 = __builtin_amdgcn_mfma_f32_32x32x16_bf16(kf[4], qr[2], C0, 0, 0, 0),   P1[2], P1[3], P1[4], P1[5],     pw2[0] = PKW(P1, 0), pw2[1] = PKW(P1, 2), pw2); \
    VRD(6); SBAR(); GAPA(C1 = __builtin_amdgcn_mfma_f32_32x32x16_bf16(kf[5], qr[2], C1, 0, 0, 0),   P1[6], P1[7], P1[8], P1[9],     pw2[2] = PKW(P1, 4), pw2[3] = PKW(P1, 6), pw2); \
    VRD(3); SBAR(); GAPA(C0 = __builtin_amdgcn_mfma_f32_32x32x16_bf16(kf[6], qr[3], C0, 0, 0, 0),   P1[10], P1[11], P1[12], P1[13], pw3[0] = PKW(P1, 8), pw3[1] = PKW(P1, 10), pw3); \
    VRD(7); SBAR(); GAPA(C1 = __builtin_amdgcn_mfma_f32_32x32x16_bf16(kf[7], qr[3], C1, 0, 0, 0),   P1[14], P1[15], 0.f, 0.f,       pw3[2] = PKW(P1, 12), pw3[3] = PKW(P1, 14), pw3); \
    l_reg += sacc; \
    if (GK) { DMA_K((t) + 3, sl_cur); } if (GV) { DMA_V((t) + 1, sl_next); } \
    CMASK(C0, C1, t); \
    { float a = MX3(C0[0], C0[1], C1[0]), b_ = MX3(C0[2], C0[3], C1[1]); a = MX3(a, C1[2], C1[3]); \
      _Pragma("unroll") for (int r = 4; r < 16; r += 4) { a = MX3(a, C0[r], C0[r + 1]); b_ = MX3(b_, C0[r + 2], C0[r + 3]); a = MX3(a, C1[r], C1[r + 1]); b_ = MX3(b_, C1[r + 2], C1[r + 3]); } \
      float rm = __builtin_fmaxf(a, b_); { auto rr = __builtin_amdgcn_permlane32_swap(__float_as_uint(rm), __float_as_uint(rm), false, false); rm = __builtin_fmaxf(__uint_as_float(rr[0]), __uint_as_float(rr[1])); } \
      resc = false; \
      if (__builtin_expect(__any(rm > (float)THRL), 0)) { const float dl = __builtin_fmaxf(rm, 0.f); aq -= dl; \
        _Pragma("unroll") for (int r = 0; r < 16; ++r) { C0[r] -= dl; C1[r] -= dl; } \
        const float f = __builtin_amdgcn_exp2f(-dl); l_reg *= f; if (hi == 0) wsf[r32] = f; resc = true; } } \
    SBAR(); \
    GAPB(o[0] = __builtin_amdgcn_mfma_f32_32x32x16_bf16(PAF(0), VFR(0), o[0], 0, 0, 0), C0, 0); \
    GAPB(o[1] = __builtin_amdgcn_mfma_f32_32x32x16_bf16(PAF(0), VFR(4), o[1], 0, 0, 0), C0, 4); \
    KRD(GL, 0); GAPB(o[0] = __builtin_amdgcn_mfma_f32_32x32x16_bf16(PAF(1), VFR(1), o[0], 0, 0, 0), C0, 8); \
    KRD(GL, 1); GAPB(o[1] = __builtin_amdgcn_mfma_f32_32x32x16_bf16(PAF(1), VFR(5), o[1], 0, 0, 0), C0, 12); \
    KRD(GL, 2); GAPB(o[0] = __builtin_amdgcn_mfma_f32_32x32x16_bf16(PAF(2), VFR(2), o[0], 0, 0, 0), C1, 0); \
    KRD(GL, 3); GAPB(o[1] = __builtin_amdgcn_mfma_f32_32x32x16_bf16(PAF(2), VFR(6), o[1], 0, 0, 0), C1, 4); \
    GAPB(o[0] = __builtin_amdgcn_mfma_f32_32x32x16_bf16(PAF(3), VFR(3), o[0], 0, 0, 0), C1, 8); \
    GAPB(o[1] = __builtin_amdgcn_mfma_f32_32x32x16_bf16(PAF(3), VFR(7), o[1], 0, 0, 0), C1, 12); \
    } while (0)
    int t = tf + 1;
#undef CMASK
#define CMASK(P0, P1, t) do { } while (0)
    for (; t + 5 < NT; t += 2) {
        STEP(pB0, pB1, pA0, pA1, t, true, true, true);     WAIT_BAR(2); RESC(); ROT();
        STEP(pA0, pA1, pB0, pB1, t + 1, true, true, true); WAIT_BAR(2); RESC(); ROT();
    }
#undef CMASK
#define CMASK(P0, P1, t) do { int jb_ = (t) - (NT - 4); if (jb_ >= 0) cmask(P0, P1, jb_, qrel, hi); } while (0)
#define ENDW(tt) do { if ((tt) + 3 < NT) { WAIT_BAR(2); } else if ((tt) + 2 < NT) { WAIT_BAR(1); } else { WAIT_BAR(0); } } while (0)
    for (; t + 1 < NT; t += 2) {
        STEP(pB0, pB1, pA0, pA1, t, (t + 3 < NT), (t + 1 < NT), (t + 1 < NT));         ENDW(t);     RESC(); ROT();
        STEP(pA0, pA1, pB0, pB1, t + 1, (t + 4 < NT), (t + 2 < NT), (t + 2 < NT));     ENDW(t + 1); RESC(); ROT();
    }
    { float sacc = pA0[0] + pA0[1]; _Pragma("unroll") for (int r = 2; r < 16; ++r) sacc += pA0[r]; _Pragma("unroll") for (int r = 0; r < 16; ++r) sacc += pA1[r]; l_reg += sacc;
      pw0 = (u32x4){PKW(pA0, 0), PKW(pA0, 2), PKW(pA0, 4), PKW(pA0, 6)}; pw1 = (u32x4){PKW(pA0, 8), PKW(pA0, 10), PKW(pA0, 12), PKW(pA0, 14)}; pw2 = (u32x4){PKW(pA1, 0), PKW(pA1, 2), PKW(pA1, 4), PKW(pA1, 6)}; pw3 = (u32x4){PKW(pA1, 8), PKW(pA1, 10), PKW(pA1, 12), PKW(pA1, 14)};
      SBAR(); pv(o, vb0 + sl_prev, PAF(0), PAF(1), PAF(2), PAF(3)); }
#undef PKW
#undef PAF
#undef VFR
#undef PIN
#undef MX3
#undef GAPA
#undef GAPB
#undef EX
#undef VRD
#undef KRD
#undef STEP
#undef ENDW
    { auto rr = __builtin_amdgcn_permlane32_swap(__float_as_uint(l_reg), __float_as_uint(l_reg), false, false); l_reg = __uint_as_float(rr[0]) + __uint_as_float(rr[1]); }
    if (hi == 0) wsf[32 + r32] = l_reg; asm volatile("s_waitcnt lgkmcnt(0)" ::: "memory");
    float rli[16];
#pragma unroll
    for (int r = 0; r < 16; ++r) rli[r] = __builtin_amdgcn_rcpf(wsf[32 + crow(r, hi)]);
    bf16* Ow = O + (rowbase + q0 + wid * QBLK) * DMO + h * 64;
    { bf16* stg = (bf16*)(shm + LDS_OST) + wid * 2048;
#pragma unroll
      for (int r = 0; r < 16; ++r) { const int orow = crow(r, hi);
#pragma unroll
          for (int d0 = 0; d0 < 2; ++d0) stg[orow * 64 + d0 * 32 + r32] = (bf16)f2bf(o[d0][r] * rli[r]); }
      asm volatile("s_waitcnt lgkmcnt(0)" ::: "memory");
#pragma unroll
      for (int i = 0; i < 4; ++i) { const int row = i * 8 + (lane >> 3), ch = lane & 7; const u32x4 v = *(const u32x4*)(stg + row * 64 + ch * 8); *(u32x4*)(Ow + (long)row * DMO + ch * 8) = v; } }
    asm volatile("s_waitcnt lgkmcnt(0)\n\ts_barrier" ::: "memory");
#undef DMA_K
#undef DMA_V
#undef CMASK
#undef START
#undef RESC
#undef ROT
}
#undef SBAR
#undef WAIT_BAR
}
__device__ __forceinline__ void phase_scan(Frame& F, int l) {
    if (F.G > 32 && F.vcu >= 32) norm_items(F, l, F.vcu - 32, F.G - 32); else if (F.G <= 32) norm_items(F, l, F.vcu, F.G);
#pragma unroll 1
    for (int bh = F.vcu; bh < 32; bh += F.G) {
        attn_scan(F, bh >> 3, bh & 7, false, fa::LDS_FL, fa::LDS_SCAN);
        const LAS float* Fl = (const LAS float*)(F.lds + fa::LDS_FL); float* FLg = (float*)(WSP() + WS_FL) + (size_t)bh * FLN;
#pragma unroll 1
        for (int i = F.tid; i < FLN / 4; i += 512) *(f32x4*)(FLg + 4 * i) = *(const LAS f32x4*)(Fl + 4 * i);
    }
    __syncthreads();
}
__device__ __forceinline__ void phase_B(Frame& F, int l) {
    LAS int* qs = (LAS int*)(F.lds + LC_QS);
    unsigned* ctl = (unsigned*)(WSP() + WS_CTL); unsigned* head = ctl + CW_AQ + l * 64; const unsigned* nrm = ctl + CW_NRM + l * 64;
    const float* FLg = (const float*)(WSP() + WS_FL);
#pragma unroll 1
    for (;;) {
        __syncthreads();
        if (F.tid == 0) { qs[0] = (int)atomicAdd(head, 1u); qs[1] = 0; }
        __syncthreads();
        const int u = __builtin_amdgcn_readfirstlane(qs[0]);
        if (u >= 1032) break;
        if (u < 1024) {
            const int qb = 31 - (u >> 5), bh = u & 31, b = bh >> 3, h = bh & 7, NT = 4 * qb + 5;
            const float kn = __uint_as_float(__hip_atomic_load(nrm + bh, __ATOMIC_RELAXED, __HIP_MEMORY_SCOPE_AGENT)), qn = __uint_as_float(__hip_atomic_load(nrm + 32 + bh, __ATOMIC_RELAXED, __HIP_MEMORY_SCOPE_AGENT));
            const float T = 36.0f + sqrtf(kn * qn);
            const float* FLb = FLg + (size_t)bh * FLN; const float Fq0 = FLb[64 + 256 * qb];
            { const int t = F.tid; const bool skip = (t <= NT - 5) && (FLb[t == 0 ? 15 : 64 * t + 63] > Fq0 + T);
              const int c = __builtin_popcountll(__ballot(skip)); if (F.lane == 0 && c) __hip_atomic_fetch_add(&qs[1], c, __ATOMIC_RELAXED, __HIP_MEMORY_SCOPE_WORKGROUP); }
            __syncthreads();
            int tf = __builtin_amdgcn_readfirstlane(qs[1]); if (((NT - tf) & 1) == 0) tf -= 1;
            { LAS float* Fl = (LAS float*)(F.lds + fa::LDS_FL); const int n4 = (NT - tf) * 16;
#pragma unroll 1
              for (int i = F.tid; i < n4; i += 512) *(LAS f32x4*)(Fl + 4 * i) = *(const f32x4*)(FLb + 64 * tf + 4 * i); }
            __syncthreads();
            unsigned char* dol = DOP();
            fa::attn_unit<8>(b, h, qb, tf, (const bf16*)(dol + DO_Q), (const bf16*)(dol + DO_K), (const bf16*)(dol + DO_V), (bf16*)(WSP() + WS_X3) + 512, (char*)F.lds, F.wave);
        } else {
            const int t_ = F.wave * 64 + lane_id_opaque(); F.tid = t_; F.lane = t_ & 63;
            attn_scan(F, 0, u - 1024, true, AT_FL, AT_SC); attn_unit_naive(F, TX, 0, 1, 0, u - 1024, NMETA);
        }
    }
    __syncthreads();
    { unsigned* head3 = ctl + CW_AQ + 48 + l * 64;
#pragma unroll 1
      for (;;) { __syncthreads(); if (F.tid == 0) qs[0] = (int)atomicAdd(head3, 1u); __syncthreads();
          const int it = __builtin_amdgcn_readfirstlane(qs[0]); if (it >= 513) break;
          { const int t_ = F.wave * 64 + lane_id_opaque(); F.tid = t_; F.lane = t_ & 63; }
          { const int i32 = 2 * it + (F.wave >> 2); s_item_poolconv(F, l, i32 < 1024 ? i32 : 1024); } } }
    { unsigned* head2 = ctl + CW_AQ + 32 + l * 64; LAS float* scr = (LAS float*)(F.lds + F.wave * 16384);
#pragma unroll 1
      for (;;) { __syncthreads(); if (F.tid == 0) qs[0] = (int)atomicAdd(head2, 1u); __syncthreads();
          const int c = __builtin_amdgcn_readfirstlane(qs[0]); if (c >= 768) break;
          convert_item(F, l, 3584 + 8 * c + F.wave, scr, lane_id_opaque()); } }
    __syncthreads();
}

__device__ __forceinline__ void class_tables(Frame& F, int l) {
    LAS int* base = (LAS int*)(F.lds + LC_BASE); LAS int* pcls = (LAS int*)(F.lds + LC_PCLS); LAS int* np = (LAS int*)(F.lds + LC_NP);
    const unsigned* gcnt = (const unsigned*)(WSP() + WS_CTL) + CW_GCNT + l * 64;
    __syncthreads();
    if (F.tid == 0) { int p = 0;
#pragma unroll 1
        for (int c = 0; c < NCLS; ++c) { base[c] = p * 256; int n = (int)__hip_atomic_load(gcnt + c, __ATOMIC_RELAXED, __HIP_MEMORY_SCOPE_AGENT); if (n > TR) n = TR; if (n < 0) n = 0; p += (n + 255) >> 8; }
        if (p > 160) p = 160; base[NCLS] = p * 256; np[0] = p; }
    __syncthreads();
    if (F.tid < 160) { const int mypos = F.tid * 256; int c = 0;
#pragma unroll 1
        for (int k = 1; k < NCLS; ++k) if (base[k] <= mypos) c = k;
        pcls[F.tid] = c; }
    __syncthreads();
}
template <int NG, int CH> __device__ __forceinline__ void e1_groups(Frame& F, int l, const int (&rowv)[NG], const int (&grpv)[NG], const LAS bf16* Rhi, const LAS bf16* Rlo, LAS int* rec, LAS int* lcnt,
                                                                   const float* reb, const float* rgb, int fr, int fq) {
    const bf16* hsrc[NG];
#pragma unroll
    for (int g = 0; g < NG; ++g) hsrc[g] = (const bf16*)(WSP() + WS_HB) + (size_t)rowv[g] * D + 8 * fq;
    const LAS bf16* bh0 = Rhi + fr * RPITCH + 8 * fq; const LAS bf16* bl0 = Rlo + fr * RPITCH + 8 * fq;
    const LAS bf16* bh1 = Rhi + (16 + (fr & 3)) * RPITCH + 8 * fq; const LAS bf16* bl1 = Rlo + (16 + (fr & 3)) * RPITCH + 8 * fq;
    f32x4 acc0[NG], acc1[NG]; float ss[NG];
#pragma unroll
    for (int g = 0; g < NG; ++g) { acc0[g] = (f32x4){0.f, 0.f, 0.f, 0.f}; acc1[g] = acc0[g]; ss[g] = 0.f; }
    u32x4 ch[NG][CH];
#pragma unroll
    for (int g = 0; g < NG; ++g)
#pragma unroll
        for (int c = 0; c < CH; ++c) ch[g][c] = *(const u32x4*)(hsrc[g] + 32 * c);
#pragma unroll 1
    for (int s0 = 0; s0 < 32; s0 += CH) {
        u32x4 nh[NG][CH];
        if (s0 + CH < 32) {
#pragma unroll
            for (int g = 0; g < NG; ++g)
#pragma unroll
                for (int c = 0; c < CH; ++c) nh[g][c] = *(const u32x4*)(hsrc[g] + 32 * (s0 + CH + c));
        }
#pragma unroll
        for (int c = 0; c < CH; ++c) { const int s = s0 + c;
            const bf16x8 wh0 = *(const LAS bf16x8*)(bh0 + 32 * s), wl0 = *(const LAS bf16x8*)(bl0 + 32 * s);
            bf16x8 wh1 = *(const LAS bf16x8*)(bh1 + 32 * s), wl1 = *(const LAS bf16x8*)(bl1 + 32 * s);
            if (fr >= 4) { wh1 = (bf16x8){0, 0, 0, 0, 0, 0, 0, 0}; wl1 = wh1; }
#pragma unroll
            for (int g = 0; g < NG; ++g) { const u32x4 hw = ch[g][c];
                ss[g] = dot2bf(hw.x, hw.x, ss[g]); ss[g] = dot2bf(hw.y, hw.y, ss[g]); ss[g] = dot2bf(hw.z, hw.z, ss[g]); ss[g] = dot2bf(hw.w, hw.w, ss[g]);
                const bf16x8 ah = __builtin_bit_cast(bf16x8, hw);
                acc0[g] = __builtin_amdgcn_mfma_f32_16x16x32_bf16(wh0, ah, acc0[g], 0, 0, 0); acc0[g] = __builtin_amdgcn_mfma_f32_16x16x32_bf16(wl0, ah, acc0[g], 0, 0, 0);
                acc1[g] = __builtin_amdgcn_mfma_f32_16x16x32_bf16(wh1, ah, acc1[g], 0, 0, 0); acc1[g] = __builtin_amdgcn_mfma_f32_16x16x32_bf16(wl1, ah, acc1[g], 0, 0, 0); } }
        if (s0 + CH < 32) {
#pragma unroll
            for (int g = 0; g < NG; ++g)
#pragma unroll
                for (int c = 0; c < CH; ++c) ch[g][c] = nh[g][c];
        }
    }
#pragma unroll
    for (int g = 0; g < NG; ++g) {
        float sg = ss[g]; sg += lane_xor<16>(sg); sg += lane_xor<32>(sg);
        const float rstd2 = rsqrtf(sg * (1.0f / D) + EPS);
        float gl[4];
#pragma unroll
        for (int q = 0; q < 4; ++q) gl[q] = __int_as_float(__builtin_amdgcn_ds_bpermute(fr << 2, __float_as_int(acc1[g][q]))) * rstd2 + rgb[q];
        int gsel = 0; float gmax = gl[0];
#pragma unroll
        for (int q = 1; q < 4; ++q) if (gl[q] > gmax) { gmax = gl[q]; gsel = q; }
        float gsum = 0.f;
#pragma unroll
        for (int q = 0; q < 4; ++q) gsum += __expf(gl[q] - gmax);
        const float gwt = 1.0f / gsum;
        if (fq == gsel) {
            float el[4];
#pragma unroll
            for (int e = 0; e < 4; ++e) el[e] = acc0[g][e] * rstd2 + reb[gsel * 4 + e];
            int t1 = 0; float l1 = el[0];
#pragma unroll
            for (int e = 1; e < 4; ++e) if (el[e] > l1) { l1 = el[e]; t1 = e; }
            int t2 = -1; float l2 = -3.0e38f;
#pragma unroll
            for (int e = 0; e < 4; ++e) if (e != t1 && el[e] > l2) { l2 = el[e]; t2 = e; }
            const float w1 = 1.0f / (1.0f + __expf(l2 - l1)), w2 = 1.0f - w1;
            const int ea = min(t1, t2), eb = max(t1, t2); const float cA = gwt * (t1 == ea ? w1 : w2), cB = gwt * (t1 == ea ? w2 : w1);
            const int pr = ea == 0 ? eb - 1 : (ea == 1 ? eb + 1 : 5); int cls = gsel * 6 + pr; if (!(cls >= 0 && cls < NCLS)) cls = 0;
            const int rank = __hip_atomic_fetch_add(&lcnt[cls], 1, __ATOMIC_RELAXED, __HIP_MEMORY_SCOPE_WORKGROUP); const int rr = grpv[g] * 16 + fr;
            rec[rr * 5] = cls; rec[rr * 5 + 1] = rank; rec[rr * 5 + 2] = __float_as_int(cA); rec[rr * 5 + 3] = __float_as_int(cB); rec[rr * 5 + 4] = __float_as_int(rstd2);
        }
    }
}
__device__ __forceinline__ void phase_E1(Frame& F, int l) {
    LAS bf16* Rhi = (LAS bf16*)F.lds; LAS bf16* Rlo = Rhi + 20 * RPITCH;
    LAS int* rec = (LAS int*)(F.lds + 83968);
    LAS int* lcnt = (LAS int*)(F.lds + LC_CNT); LAS int* wgb = (LAS int*)(F.lds + LC_BASE);
    const float* rg = (const float*)(WSP() + WS_RG);
    const float* reb = INP(I_REB) + l * 16; const float* rgb = INP(I_RGB) + l * 4;
    unsigned* gcnt = (unsigned*)(WSP() + WS_CTL) + CW_GCNT + l * 64; int* route = (int*)(WSP() + WS_ROUTE);
    const int tid = F.tid, lane = F.lane, wave = F.wave, fr = lane & 15, fq = lane >> 4;
    { f32x4 rv[10];
#pragma unroll
      for (int j = 0; j < 10; ++j) rv[j] = *(const f32x4*)(rg + 4 * (tid + 512 * j));
#pragma unroll
      for (int j = 0; j < 10; ++j) { const int i = 4 * (tid + 512 * j), c = i >> 10, k = i & 1023; u32x2 hw, lw; float hf[4];
#pragma unroll
          for (int e = 0; e < 4; ++e) hf[e] = __builtin_bit_cast(float, (pk2(rv[j][e], 0.f) & 0xffffu) << 16);
          hw.x = pk2(rv[j][0], rv[j][1]); hw.y = pk2(rv[j][2], rv[j][3]); lw.x = pk2(rv[j][0] - hf[0], rv[j][1] - hf[1]); lw.y = pk2(rv[j][2] - hf[2], rv[j][3] - hf[3]);
          *(LAS u32x2*)(Rhi + c * RPITCH + k) = hw; *(LAS u32x2*)(Rlo + c * RPITCH + k) = lw; } }
    { int* TOK = (int*)(WSP() + WS_TOK);
#pragma unroll 1
      for (int p = F.vcu * 512 + tid; p < NPOSMAX; p += F.G * 512) TOK[p] = -1; }
#pragma unroll 1
    for (int wg = F.vcu; wg < 256; wg += F.G) {
        if (tid < NCLS) lcnt[tid] = 0;
        __syncthreads();
        const int ngrp = wg == 0 ? 9 : 8;
        if (wg == 0 && wave == 0) { const int rows2[2] = {fr, TX + fr}; const int grps2[2] = {0, 8}; e1_groups<2, 4>(F, l, rows2, grps2, Rhi, Rlo, rec, lcnt, reb, rgb, fr, fq); }
        else { const int rows1[1] = {wg * 128 + wave * 16 + fr}; const int grps1[1] = {wave}; e1_groups<1, 8>(F, l, rows1, grps1, Rhi, Rlo, rec, lcnt, reb, rgb, fr, fq); }
        __syncthreads();
        if (tid < NCLS) { const int n = lcnt[tid]; wgb[tid] = n > 0 ? (int)atomicAdd(gcnt + tid, (unsigned)n) : 0; }
        __syncthreads();
        const int nrw = ngrp * 16;
        for (int rr = tid; rr < nrw; rr += 512) { const int row = rr < 128 ? wg * 128 + rr : TX + (rr - 128); const int cls = rec[rr * 5];
            int* rp = route + (size_t)row * 8; rp[0] = cls; rp[1] = wgb[cls] + rec[rr * 5 + 1]; rp[2] = rec[rr * 5 + 2]; rp[3] = rec[rr * 5 + 3]; rp[4] = rec[rr * 5 + 4]; }
        __syncthreads();
    }
}
__device__ __forceinline__ void phase_E1b(Frame& F, int l) {
    class_tables(F, l);
    const LAS int* base = (const LAS int*)(F.lds + LC_BASE);
    const int* route = (const int*)(WSP() + WS_ROUTE); int* TOK = (int*)(WSP() + WS_TOK); float* PW = (float*)(WSP() + WS_PW);
#pragma unroll 1
    for (int row = F.vcu * 512 + F.tid; row < TR; row += F.G * 512) { const int* rp = route + (size_t)row * 8; const int pos = base[rp[0]] + rp[1];
        if (pos < 0 || pos >= NPOSMAX) continue;
        TOK[pos] = row; f32x4 w; w[0] = __int_as_float(rp[4]); w[1] = __int_as_float(rp[2]); w[2] = __int_as_float(rp[3]); w[3] = 0.f; *(f32x4*)(PW + (size_t)pos * 4) = w; }
}
__device__ __forceinline__ void phase_E4(Frame& F, int l) {
    const bf16* HB = (const bf16*)(WSP() + WS_HB); float* rstd1 = (float*)(WSP() + WS_RSTD1); const float* fg = INP(I_FG); float* out = (float*)DOP();
    const int gw = F.vcu * NWAVES + F.wave, NGW = F.G * NWAVES, lane = F.lane; const bool lastl = (l == DEPTH - 1); const int lim = lastl ? TX : TR;
    constexpr int R = 8;
#pragma unroll 1
    for (int row0 = gw; row0 < lim; row0 += R * NGW) {
        u32x4 hw[R][2];
#pragma unroll
        for (int r = 0; r < R; ++r) { int row = row0 + r * NGW; if (row >= lim) row = lim - 1;
#pragma unroll
            for (int j = 0; j < 2; ++j) hw[r][j] = *(const u32x4*)(HB + (size_t)row * D + 8 * lane + 512 * j); }
#pragma unroll
        for (int r = 0; r < R; ++r) { const int row = row0 + r * NGW; float ss = 0.f;
#pragma unroll
            for (int j = 0; j < 2; ++j) { const u32x4 w = hw[r][j]; ss = dot2bf(w.x, w.x, ss); ss = dot2bf(w.y, w.y, ss); ss = dot2bf(w.z, w.z, ss); ss = dot2bf(w.w, w.w, ss); }
            const float rs = rsqrtf(wave_sum(ss) * (1.0f / D) + EPS);
            if (row < lim) {
                if (!lastl) { if (lane == 0) rstd1[row] = rs; }
                else {
#pragma unroll
                    for (int j = 0; j < 2; ++j) { const u32x4 w = hw[r][j]; const f32x4 g0 = *(const f32x4*)(fg + 8 * lane + 512 * j), g1 = *(const f32x4*)(fg + 8 * lane + 512 * j + 4);
                        const f32x4 v0 = {bflo(w.x), bfhi(w.x), bflo(w.y), bfhi(w.y)}, v1 = {bflo(w.z), bfhi(w.z), bflo(w.w), bfhi(w.w)};
                        *(f32x4*)(out + (size_t)row * D + 8 * lane + 512 * j) = v0 * rs * g0; *(f32x4*)(out + (size_t)row * D + 8 * lane + 512 * j + 4) = v1 * rs * g1; }
                }
            }
        }
    }
}
#define RELANE() do { const int t_ = wv0 * 64 + lane_id_opaque(); F.tid = t_; F.lane = t_ & 63; F.wave = __builtin_amdgcn_readfirstlane(t_ >> 6); \
    int g_ = gridDim.x; LAUNDER_S(g_); int b_ = blockIdx.x; LAUNDER_S(b_); F.G = g_; F.bx = b_; F.vcu = (g_ % 8 == 0) ? (b_ % 8) * (g_ / 8) + b_ / 8 : b_; ll = l; LAUNDER_S(ll); } while (0)
__global__ void __launch_bounds__(NWAVES * 64, 2) fwd_kernel(Params P) {
    extern __shared__ __attribute__((aligned(16))) unsigned char lds_raw[];
    Frame F;
    F.lds = (LAS unsigned char*)lds_raw;
    F.tid = threadIdx.x; F.lane = F.tid & 63; F.wave = __builtin_amdgcn_readfirstlane(F.tid >> 6);
    F.G = gridDim.x; { const int bx = blockIdx.x; F.vcu = (F.G % 8 == 0) ? (bx % 8) * (F.G / 8) + bx / 8 : bx; }
    if (F.tid == 0) { LAS unsigned long long* pt = (LAS unsigned long long*)(F.lds + LC_PTAB);
#pragma unroll
        for (int i = 0; i < 25; ++i) pt[i] = (unsigned long long)P.in[i];
        pt[25] = (unsigned long long)P.ws; pt[26] = (unsigned long long)P.out; }
    for (int u = F.tid; u < 256; u += NWAVES * 64) ((LAS unsigned*)(F.lds + RING_BYTES))[u] = 0u;
    __syncthreads();
    const int lo = P.ph_lo, hi = P.ph_hi;
    const bool use_bar = (hi - lo) > 1;
    unsigned* barw = (unsigned*)(P.ws + WS_CTL) + CW_BAR;
    XcdBarrier bar; bar.bar = barw; bar.x = 0; bar.st = (volatile LAS unsigned*)(F.lds + LC_BAR);
    if (use_bar) bar = xcd_barrier_post(barw, (volatile LAS unsigned*)(F.lds + LC_BAR));
#ifndef PHASE_MASK
#define PHASE_MASK 0xfff
#endif
#define EN(j) (((PHASE_MASK) >> (j)) & 1)
#ifndef DUP_MASK
#define DUP_MASK 0
#endif
#define NREP(j) ((((DUP_MASK) >> (j)) & 1) ? 2 : 1)
#define IN(k) (lo <= (k) && (k) < hi)
#define SEAM(k) do { if (IN(k) && IN((k) + 1)) xcd_barrier(bar); } while (0)

    int l = 0, ll = 0; const int wv0 = __builtin_amdgcn_readfirstlane((int)threadIdx.x >> 6);
    if (EN(0) && IN(0)) { RELANE(); convert_weights(F, 0); RELANE(); init_rows(F); }
    SEAM(0);
    for (l = 0; l < DEPTH; ++l) {
        const int pb = 1 + 11 * l;
        for (int rep = 0; rep < NREP(1); ++rep)
        if (EN(1) && IN(pb + 0)) {
            RELANE();
            unsigned char* wsl = WSP(); unsigned char* dol = DOP();
            pg8::Gemm g{(const bf16*)(wsl + WS_HB), 1024, 1024, 1 << 20};
            pg8::StaticOrder S; S.init(TX, N1, F.G, F.bx, (const bf16*)(wsl + WS_W1T), 1024);
            Epi1 E{(const float*)(wsl + WS_RSTD1), (bf16*)(wsl + WS_A), (bf16*)(wsl + WS_GLU), (bf16*)(dol + DO_Q), (bf16*)(wsl + WS_G)};
            pg8::gemm_phase<Epi1, pg8::StaticOrder>(F.lds, g, S, E, F.wave);
            if (F.bx >= 128 && F.bx < 128 + 21 && F.wave < 4) {
                const int pn = F.bx - 128, l2 = lane_id_opaque(); AccT acc; skinny_zero(acc);
                skinny_k<true>(acc, (const bf16*)(wsl + WS_HB) + (size_t)TX * 1024, 1024, (const bf16*)(wsl + WS_W1T) + (size_t)pn * 256 * 1024, 1024, 1024, F.wave, l2 & 15, l2 >> 4);
                E.run<true>(acc, pg8::Unit{128, pn, 0}, 0, F.wave, l2 & 15, l2 >> 4);
            }
            { RELANE(); LAS int* qs = (LAS int*)(F.lds + LC_QS); unsigned* head4 = (unsigned*)(WSP() + WS_CTL) + CW_AQ + 16 + ll * 64;
#pragma unroll 1
              for (;;) { __syncthreads(); if (F.tid == 0) qs[0] = (int)atomicAdd(head4, 1u); __syncthreads();
                  const int it = __builtin_amdgcn_readfirstlane(qs[0]); if (it >= 513) break;
                  { const int t_ = F.wave * 64 + lane_id_opaque(); F.tid = t_; F.lane = t_ & 63; }
                  s_item_logf(F, ll, it); } }
        }
        SEAM(pb + 0);
        if (EN(3) && IN(pb + 2)) { RELANE(); phase_scan(F, ll); }
        SEAM(pb + 2);
        for (int rep = 0; rep < NREP(3); ++rep)
        if (EN(4) && IN(pb + 3)) { RELANE(); phase_B(F, ll); }
        SEAM(pb + 3);
        for (int rep = 0; rep < NREP(4); ++rep)
        if (EN(5) && IN(pb + 4)) {
            RELANE(); unsigned char* wsl = WSP(); unsigned char* dol = DOP();
            pg8::Gemm g{(const bf16*)(wsl + WS_X3), 1024, 1024, 1 << 20}; pg8::SegOrder S; S.init(TX, 1024, F.G, F.bx, (const bf16*)(wsl + WS_W3CT), 1024);
            EpiCS E{(const bf16*)(wsl + WS_G), (bf16*)(dol + DO_MERGED), (const float*)(wsl + WS_BIASA)}; pg8::gemm_phase<EpiCS, pg8::SegOrder>(F.lds, g, S, E, F.wave);
            if (F.bx >= 16 && F.bx < 20) {
                const int pn = F.bx - 16, l2 = lane_id_opaque(), kh = F.wave >> 2, wc4 = F.wave & 3; AccT acc; skinny_zero(acc);
#pragma unroll 1
                for (int seg = 0; seg < 3; ++seg) { const int Ks = seg == 2 ? 512 : 256; const size_t ko = (seg == 0 ? 0 : (seg == 1 ? 256 : 512)) + (size_t)kh * (Ks / 2);
                    if (kh == 1) skinny_zero(acc);
                    skinny_k<true>(acc, (const bf16*)(wsl + WS_X3) + (size_t)TX * 1024 + ko, 1024, (const bf16*)(wsl + WS_W3CT) + (size_t)pn * 256 * 1024 + ko, 1024, Ks / 2, wc4, l2 & 15, l2 >> 4);
                    skinny_combine(acc, F.lds, F.wave, l2);
                    if (kh == 0) E.run<true>(acc, pg8::Unit{128, pn, seg}, 0, wc4, l2 & 15, l2 >> 4); }
            }
        }
        SEAM(pb + 4);
        if (EN(6) && IN(pb + 5)) {
            RELANE();
            unsigned char* wsl = WSP(); unsigned char* dol = DOP();
            pg8::Gemm g{(const bf16*)(dol + DO_MERGED), 1024, 1024, 1 << 20}; pg8::StaticOrder S; S.init(TX, 1024, F.G, F.bx, (const bf16*)(wsl + WS_WOT), 1024);
            EpiRes<false> E{(bf16*)(wsl + WS_HB), nullptr}; pg8::gemm_phase<EpiRes<false>, pg8::StaticOrder>(F.lds, g, S, E, F.wave);
            if (F.bx >= 16 && F.bx < 20) {
                const int pn = F.bx - 16, l2 = lane_id_opaque(), kh = F.wave >> 2, wc4 = F.wave & 3; AccT acc; skinny_zero(acc);
                skinny_k<true>(acc, (const bf16*)(dol + DO_MERGED) + (size_t)TX * 1024 + kh * 512, 1024, (const bf16*)(wsl + WS_WOT) + (size_t)pn * 256 * 1024 + kh * 512, 1024, 512, wc4, l2 & 15, l2 >> 4);
                skinny_combine(acc, F.lds, F.wave, l2);
                if (kh == 0) E.run<true>(acc, pg8::Unit{128, pn, 0}, 0, wc4, l2 & 15, l2 >> 4);
            }
        }
        SEAM(pb + 5);
        if (EN(7) && IN(pb + 6)) { RELANE(); phase_E1(F, ll); }
        SEAM(pb + 6);
        for (int rep = 0; rep < NREP(7); ++rep)
        if (EN(8) && IN(pb + 7)) { RELANE(); phase_E1b(F, ll); }
        SEAM(pb + 7);
        for (int rep = 0; rep < NREP(8); ++rep)
        if (EN(9) && IN(pb + 8)) {
            RELANE(); class_tables(F, ll);
            unsigned char* wsl = WSP();
            const int NP = __builtin_amdgcn_readfirstlane(*(const LAS int*)(F.lds + LC_NP));
            pg8::Gemm g{(const bf16*)(wsl + WS_XS), 1024, 1024, 1 << 20};
            { const int* TOK = (const int*)(wsl + WS_TOK); LAS int* tl = (LAS int*)(F.lds + LC_TOK);
#pragma unroll 1
              for (int i = F.tid; i < 1024; i += 512) { const long L = (long)(i >> 8) * F.G + F.vcu; int tk = 0; if (L < (long)NP * 4) { tk = TOK[(int)(L >> 2) * 256 + (i & 255)]; if (tk < 0 || tk >= TR) tk = 0; } tl[i] = tk; }
              __syncthreads(); }
            pg8::Gemm g2{(const bf16*)(wsl + WS_HB), 1024, 1024, 1 << 20};
            MoeOrderT<true> S{(const LAS int*)(F.lds + LC_TOK), NP, F.G, F.vcu, 0, (const LAS int*)(F.lds + LC_PCLS), (const bf16*)(DOP() + DO_W13T)};
            EpiA2 E{(const float*)(wsl + WS_PW), (bf16*)(wsl + WS_HH)}; pg8::gemm_phase<EpiA2, MoeOrderT<true>>(F.lds, g2, S, E, F.wave);
        }
        SEAM(pb + 8);
        for (int rep = 0; rep < NREP(9); ++rep)
        if (EN(10) && IN(pb + 9)) {
            RELANE(); class_tables(F, ll);
            unsigned char* wsl = WSP();
            const int NP = __builtin_amdgcn_readfirstlane(*(const LAS int*)(F.lds + LC_NP));
            pg8::Gemm g{(const bf16*)(wsl + WS_HH), 512, 256, 4};
            { const int* TOK = (const int*)(wsl + WS_TOK); LAS int* tl = (LAS int*)(F.lds + LC_TOK);
#pragma unroll 1
              for (int i = F.tid; i < 1024; i += 512) { const int L = (i >> 8) * F.G + F.vcu; int tk = -1; if (L < NP * 4) { tk = TOK[(L >> 2) * 256 + (i & 255)]; if (tk >= TR) tk = -1; } tl[i] = tk; }
              __syncthreads(); }
            MoeOrderT<false> S{nullptr, NP, F.G, F.vcu, 1, (const LAS int*)(F.lds + LC_PCLS), (const bf16*)(DOP() + DO_W2T)};
            EpiRes<true> E{(bf16*)(wsl + WS_HB), (const LAS int*)(F.lds + LC_TOK)}; pg8::gemm_phase<EpiRes<true>, MoeOrderT<false>>(F.lds, g, S, E, F.wave);
        }
        SEAM(pb + 9);
        if (EN(11) && IN(pb + 10)) { RELANE(); phase_E4(F, ll); if (l + 1 < DEPTH) { RELANE(); convert_weights(F, ll + 1); } }
        SEAM(pb + 10);
    }
#undef IN
#undef SEAM
}

constexpr int N_PHASES = 1 + 11 * DEPTH;

extern "C" void kernel_launch(void* const* d_in, const int* in_sizes, int n_in, void* d_out, int out_size, void* d_ws, size_t ws_size, hipStream_t stream) {
    static int grid = 0;
    if (grid == 0) {
        if (n_in != 25 || out_size != TX * D || ws_size < WS_END) { fprintf(stderr, "kernel_launch: unexpected shapes: n_in %d out %d ws %zu (need %zu)\n", n_in, out_size, ws_size, (size_t)WS_END); grid = -1; return; }
        int dev = 0, cus = 0, per_cu = 0;
        if (hipGetDevice(&dev) != hipSuccess || hipDeviceGetAttribute(&cus, hipDeviceAttributeMultiprocessorCount, dev) != hipSuccess) { grid = -1; return; }
        if (hipFuncSetAttribute((const void*)fwd_kernel, hipFuncAttributeMaxDynamicSharedMemorySize, LDS_BYTES) != hipSuccess) { fprintf(stderr, "kernel_launch: hipFuncSetAttribute failed\n"); grid = -1; return; }
        if (hipOccupancyMaxActiveBlocksPerMultiprocessor(&per_cu, (const void*)fwd_kernel, NWAVES * 64, LDS_BYTES) != hipSuccess || per_cu < 1) fprintf(stderr, "kernel_launch: occupancy query reports %d\n", per_cu);
        (void)hipGetLastError();
        grid = cus;
    }
    if (grid < 0) return;
    (void)hipMemsetAsync((char*)d_ws + WS_CTL, 0, CTL_BYTES, stream);
    Params p{};
    for (int i = 0; i < 25; ++i) p.in[i] = (const float*)d_in[i];
    p.out = (float*)d_out; p.ws = (unsigned char*)d_ws;
#if N_LAUNCH_MODE == 1
    p.ph_lo = 0; p.ph_hi = N_PHASES;
    hipLaunchKernelGGL(fwd_kernel, dim3(grid), dim3(NWAVES * 64), LDS_BYTES, stream, p);
#else
    for (int ph = 0; ph < N_PHASES; ++ph) { p.ph_lo = ph; p.ph_hi = ph + 1; hipLaunchKernelGGL(fwd_kernel, dim3(grid), dim3(NWAVES * 64), LDS_BYTES, stream, p); }
#endif
}
```

```cpp
#include <hip/hip_runtime.h>
#include <cstdio>
#include <cstdint>

#ifndef N_LAUNCH_MODE
#define N_LAUNCH_MODE 1
#endif

#define GAS __attribute__((address_space(1)))
#define LAS __attribute__((address_space(3)))
typedef unsigned short bf16;
typedef float f32x4 __attribute__((ext_vector_type(4)));
typedef float f32x2 __attribute__((ext_vector_type(2)));
typedef unsigned u32x4 __attribute__((ext_vector_type(4)));
typedef unsigned u32x2 __attribute__((ext_vector_type(2)));
typedef short bf16x8 __attribute__((ext_vector_type(8)));
typedef __bf16 bf16x2v __attribute__((ext_vector_type(2)));

constexpr int D = 1024, NB = 4, SEQ = 8192, NMETA = 16, DEPTH = 2;
constexpr int TX = NB * SEQ;
constexpr int TM = TX + 64;
constexpr int TR = TX + NMETA;
constexpr int NIN = 5384, N1 = 5376;
constexpr int NHEAD = 8;
constexpr int NCLS = 24;
constexpr int NPOSMAX = TX + 256 + NCLS * 256;
constexpr float EPS = 1e-6f;
constexpr float LOG2E = 1.4426950408889634f;
constexpr float C2 = 0.125f * LOG2E;
constexpr int NWAVES = 8;

constexpr size_t U = (size_t)TM * 1024 * 2;
constexpr size_t WS_CTL = 0, CTL_BYTES = 128u << 10;
constexpr size_t WS_H = CTL_BYTES;
constexpr int TRC = 32800;
constexpr size_t WS_TOKC = WS_H;
constexpr size_t WS_PWC = WS_TOKC + (size_t)NCLS * TRC * 4;
static_assert(WS_PWC + (size_t)NCLS * TRC * 16 <= WS_H + 2 * U, "class lists fit the old f32 residual region");
constexpr size_t WS_HB = WS_H + 2 * U;
constexpr size_t WS_G = WS_HB + U;
constexpr size_t WS_XS = WS_G;
constexpr size_t WS_Y = WS_XS + (size_t)NPOSMAX * 2048;
constexpr size_t WS_HH = WS_Y + (size_t)NPOSMAX * 2048;
static_assert(WS_HH + (size_t)NPOSMAX * 1024 <= WS_G + (size_t)3 * 129 * 4 * 65536 * 2, "MoE overlay fits the gates region");
constexpr size_t GT_TILE = 65536;
constexpr size_t WS_A = WS_G + (size_t)3 * 129 * 4 * GT_TILE * 2;
constexpr size_t WS_GLU = WS_A + U / 4;
constexpr size_t WS_X3 = WS_GLU + U / 4;
constexpr size_t WS_W1T = WS_X3 + U;
constexpr size_t WS_W3CT = WS_W1T + (size_t)N1 * 1024 * 2;
constexpr size_t WS_WOT = WS_W3CT + 1024 * 1024 * 2;
constexpr size_t WS_WFG = WS_WOT + 1024 * 1024 * 2;
constexpr size_t WS_RG = WS_WFG + 8 * 1024 * 4;
constexpr size_t WS_BIASA = WS_RG + 20 * 1024 * 4;
constexpr size_t WS_RSTD1 = WS_BIASA + 4096;
constexpr size_t WS_ROUTE = WS_RSTD1 + (size_t)TM * 4;
constexpr size_t WS_PW = WS_ROUTE + (size_t)TM * 32;
constexpr size_t WS_LFT = WS_PW + (size_t)NPOSMAX * 16;
constexpr size_t WS_LFTM = WS_LFT + (size_t)32 * 8192 * 4;
constexpr size_t WS_TOK = WS_LFTM + 8 * 256 * 4;
constexpr size_t WS_FL = WS_TOK + (size_t)NPOSMAX * 4;
constexpr int FLN = 64 + SEQ;
constexpr size_t WS_END = WS_FL + (size_t)32 * FLN * 4;
static_assert(WS_END <= (size_t)512 * 1024 * 1024, "d_ws map fits 512 MiB");
constexpr size_t DO_Q = 0, DO_K = U / 2, DO_V = U, DO_MERGED = U / 2;
constexpr size_t DO_W13T = 3 * U / 2;
constexpr size_t DO_W2T = DO_W13T + (size_t)16 * 512 * 1024 * 2;
static_assert(DO_W2T + (size_t)16 * 1024 * 256 * 2 <= (size_t)TX * 1024 * 4, "d_out scratch");
static_assert((29952 + 2 * 1024) * 4 <= 128 * 1024, "control words inside the memset");
constexpr int CW_BAR = 4096, CW_GCNT = 16384, CW_NRM = 20480  , CW_AQ = 24576  , CW_NQB = 29952  , CW_UPC = 24832  ;

constexpr int RPITCH = 1032;
constexpr int RING_BYTES = 131072;
constexpr int LC_BAR = RING_BYTES, LC_CNT = RING_BYTES + 64, LC_BASE = RING_BYTES + 192, LC_PCLS = RING_BYTES + 320, LC_NP = RING_BYTES + 960;
constexpr int LC_QS = RING_BYTES + 976;
constexpr int LC_TOK = RING_BYTES + 2048;
constexpr int LC_NMX = RING_BYTES + 1280;
constexpr int LC_CCNT = RING_BYTES + 1664;
constexpr int LC_TB = RING_BYTES + 1408;
constexpr int LC_PTAB = RING_BYTES + 1024;
constexpr int LDS_BYTES = RING_BYTES + 1024 + 7168;

#define LDS_WAIT() asm volatile("s_waitcnt lgkmcnt(0)" ::: "memory")
#define VM_WAIT() asm volatile("s_waitcnt vmcnt(0)" ::: "memory")
#define LAUNDER_S(p) asm volatile("" : "+s"(p))
#define LAUNDER_V(x) asm volatile("" : "+v"(x))
__device__ __forceinline__ int lane_id_opaque() { int x; asm volatile("v_mbcnt_lo_u32_b32 %0, -1, 0\n\tv_mbcnt_hi_u32_b32 %0, -1, %0" : "=v"(x)); return x; }

__device__ __forceinline__ unsigned f2bf(float f) { unsigned u = __builtin_bit_cast(unsigned, f); return (u + 0x7fffu + ((u >> 16) & 1u)) >> 16; }
__device__ __forceinline__ unsigned pk2(float lo, float hi) { f32x2 v = {lo, hi}; bf16x2v b = __builtin_convertvector(v, bf16x2v); return __builtin_bit_cast(unsigned, b); }
__device__ __forceinline__ float bflo(unsigned w) { return __builtin_bit_cast(float, w << 16); }
__device__ __forceinline__ float bfhi(unsigned w) { return __builtin_bit_cast(float, w & 0xffff0000u); }
template <int CTRL> __device__ __forceinline__ float dpp_mov(float v) { return __int_as_float(__builtin_amdgcn_update_dpp(__float_as_int(v), __float_as_int(v), CTRL, 0xf, 0xf, false)); }
template <int O> __device__ __forceinline__ float lane_xor(float v) {
    if constexpr (O == 1) return dpp_mov<0xB1>(v);
    else if constexpr (O == 2) return dpp_mov<0x4E>(v);
    else if constexpr (O == 4) return dpp_mov<0x141>(v);
    else if constexpr (O == 8) return dpp_mov<0x140>(v);
    else if constexpr (O == 16) { auto rr = __builtin_amdgcn_permlane16_swap(__float_as_uint(v), __float_as_uint(v), false, false); return __uint_as_float(rr[0] == __float_as_uint(v) ? rr[1] : rr[0]); }
    else { auto rr = __builtin_amdgcn_permlane32_swap(__float_as_uint(v), __float_as_uint(v), false, false); return __uint_as_float(rr[0] == __float_as_uint(v) ? rr[1] : rr[0]); }
}
__device__ __forceinline__ float sum_x16(float v) { auto r = __builtin_amdgcn_permlane16_swap(__float_as_uint(v), __float_as_uint(v), false, false); return __uint_as_float(r[0]) + __uint_as_float(r[1]); }
__device__ __forceinline__ float wave_sum(float v) {
    v += lane_xor<1>(v); v += lane_xor<2>(v); v += lane_xor<4>(v); v += lane_xor<8>(v);
    auto r16 = __builtin_amdgcn_permlane16_swap(__float_as_uint(v), __float_as_uint(v), false, false); v = __uint_as_float(r16[0]) + __uint_as_float(r16[1]);
    auto rr = __builtin_amdgcn_permlane32_swap(__float_as_uint(v), __float_as_uint(v), false, false);
    return __uint_as_float(rr[0]) + __uint_as_float(rr[1]);
}
__device__ __forceinline__ float sigmoidf_(float x) { return __builtin_amdgcn_rcpf(1.0f + __builtin_amdgcn_exp2f(-LOG2E * x)); }
__device__ __forceinline__ float dot2bf(unsigned a, unsigned b, float acc) { return __builtin_amdgcn_fdot2_f32_bf16(__builtin_bit_cast(bf16x2v, a), __builtin_bit_cast(bf16x2v, b), acc, false); }

__host__ __device__ __forceinline__ int lcol(int c) { return (c & ~255) | (c & 128) | (((c >> 2) & 1) << 6) | (((c >> 5) & 3) << 4) | (((c >> 3) & 3) << 2) | (c & 3); }
__host__ __device__ __forceinline__ size_t gidx(int kind, int pm, int t, int aim, int wave8, int lane) { return ((((((size_t)kind * 129 + pm) * 16 + t) * 8 + aim) * 8 + wave8) * 64 + lane) * 4; }
namespace pg8 {
constexpr int BM = 256, BK = 64, HALF = 128, HTB = HALF * BK * 2, STAGE_BYTES = 8 * HTB, NXCD = 8, WGM = 4;
__host__ __device__ __forceinline__ int lds_byte(int r, int c) { const int st = (r >> 4) * 2 + (c >> 5), rr = r & 15, cc = c & 31, ob = rr * 64 + cc * 2; return st * 1024 + (ob ^ (((ob >> 9) & 1) << 5)); }
__host__ __device__ __forceinline__ void stage_rc(int b, int& R, int& C) { const int st = b / 1024, sb = b % 1024, swz = sb ^ (((sb >> 9) & 1) << 5); R = (st >> 1) * 16 + swz / 64; C = (st & 1) * 32 + (swz % 64) / 2; }
__host__ __device__ __forceinline__ int perm32(int rho) { const int n = rho >> 4, i = rho & 15; return 8 * (i >> 2) + 4 * n + (i & 3); }

struct Unit { int pm, pn, seg; };
struct Gemm { const bf16* A; int K; int ldb; int ksplit; };

struct StaticOrder {
    static constexpr bool GATHER = false; const LAS int* tokl = nullptr;
    int nM, nN, nwg, G, c; const bf16* Bt; size_t btile;
    __device__ void init(int M, int N, int G_, int c_, const bf16* Bt_, int ldb) { nM = M / BM; nN = N / BM; nwg = nM * nN; G = G_; c = c_; Bt = Bt_; btile = (size_t)BM * ldb * 2; }
    __device__ bool next(int i, Unit& u) const {
        const long L = (long)i * G + c; if (L >= nwg) return false;
        int wgid = (int)L; { const int q = nwg / NXCD, r = nwg % NXCD, xcd = wgid % NXCD, off = wgid / NXCD; wgid = (xcd < r ? xcd * (q + 1) : r * (q + 1) + (xcd - r) * q) + off; }
        const int nig = WGM * nN, gid = wgid / nig, fm = gid * WGM, gsz = (nM - fm) < WGM ? (nM - fm) : WGM;
        u.pm = fm + ((wgid % nig) % gsz); u.pn = (wgid % nig) / gsz; u.seg = 0; return true;
    }
    __device__ __forceinline__ const char* bptr(const Unit& u, int) const { return (const char*)Bt + (size_t)u.pn * btile; }
    __device__ __forceinline__ int nt(const Unit&, int ntd) const { return ntd; }
    __device__ __forceinline__ size_t aoff(const Unit&) const { return 0; }
};
struct SegOrder : StaticOrder {
    __device__ bool next(int i, Unit& u) const { const int q = i / 3; if (!StaticOrder::next(q, u)) return false; u.seg = i - 3 * q; return true; }
    __device__ __forceinline__ size_t koff(const Unit& u) const { return u.seg == 0 ? 0 : (u.seg == 1 ? 512 : 1024); }
    __device__ __forceinline__ const char* bptr(const Unit& u, int) const { return (const char*)Bt + (size_t)u.pn * btile + koff(u); }
    __device__ __forceinline__ int nt(const Unit& u, int) const { return u.seg == 2 ? 8 : 4; }
    __device__ __forceinline__ size_t aoff(const Unit& u) const { return koff(u); }
};

template <class Epi, class Sched, bool ALIGN_EPI = true, bool SP2 = true>
__device__ __forceinline__ void gemm_phase(LAS unsigned char* lds, const Gemm g, const Sched& S, const Epi& E, const int wave_id) {
    const int tid = wave_id * 64 + lane_id_opaque();
    const int wid = __builtin_amdgcn_readfirstlane(tid >> 6), lane = tid & 63, wr = wid >> 2, wc = wid & 3, fr = lane & 15, fq = lane >> 4;
    const int K = g.K, nt = K / BK, ldb = g.ldb, ks = g.ksplit;
    unsigned voffA[2], voffB[2];
#pragma unroll
    for (int i = 0; i < 2; ++i) { int R, C; stage_rc(tid * 16 + i * 8192, R, C); const int Rb = Epi::PERM ? ((R & ~31) + perm32(R & 31)) : R;
        voffA[i] = (unsigned)(R * K + C) * 2u; voffB[i] = (unsigned)(Rb * ldb + C) * 2u; }
    constexpr bool GATHER = Sched::GATHER;
    unsigned vC0[2], vC1[2];
    const size_t kstep = (size_t)(BK * 2);
    const size_t hstep = (size_t)HALF * K * 2;
    const size_t hstepB = (size_t)HALF * ldb * 2;
    const size_t tstep = 2 * hstep;
#define PG8_GOFF(ui_) do { _Pragma("unroll") for (int _i = 0; _i < 2; ++_i) { const int R_ = (int)(voffA[_i] >> 11); const unsigned C_ = voffA[_i] & 2047u; \
        vC0[_i] = (unsigned)S.tokl[(ui_) * 256 + R_] * 2048u + C_; vC1[_i] = (unsigned)S.tokl[(ui_) * 256 + 128 + R_] * 2048u + C_; } } while (0)
    const unsigned ldsw = (unsigned)wid * 1024u;
    const int aoff = lds_byte(wr * 64 + fr, fq * 8), boff = lds_byte(wc * 32 + fr, fq * 8);
#define PG8_SA(b, h) (((b) * 2 + (h)) * HTB)
#define PG8_SB(b, h) ((4 + (b) * 2 + (h)) * HTB)
#define PG8_STAGE(bufoff, gbase, voff) do { _Pragma("unroll") for (int _i = 0; _i < 2; ++_i) \
        __builtin_amdgcn_global_load_lds((const unsigned*)((const char*)(gbase) + (voff)[_i]), (LAS unsigned*)(lds + (bufoff) + ldsw + _i * 8192), 16, 0, 0); } while (0)
#define PG8_LDA(dst, b, h) do { _Pragma("unroll") for (int m = 0; m < 4; ++m) _Pragma("unroll") for (int k = 0; k < 2; ++k) dst[m][k] = *(const LAS bf16x8*)(lds + PG8_SA(b, h) + aoff + m * 2048 + k * 1024); } while (0)
#define PG8_LDB(dst, b, h) do { _Pragma("unroll") for (int n = 0; n < 2; ++n) _Pragma("unroll") for (int k = 0; k < 2; ++k) dst[n][k] = *(const LAS bf16x8*)(lds + PG8_SB(b, h) + boff + n * 2048 + k * 1024); } while (0)
#define PG8_MMA(ai, bj, At, Bt) do { __builtin_amdgcn_s_setprio(1); _Pragma("unroll") for (int m = 0; m < 4; ++m) _Pragma("unroll") for (int n = 0; n < 2; ++n) _Pragma("unroll") for (int k = 0; k < 2; ++k) \
        acc[ai][bj][m][n] = __builtin_amdgcn_mfma_f32_16x16x32_bf16(Bt[n][k], At[m][k], acc[ai][bj][m][n], 0, 0, 0); __builtin_amdgcn_s_setprio(0); } while (0)
#define PG8_WAIT_V(n) asm volatile("s_waitcnt vmcnt(" #n ")" ::: "memory")
#define PG8_WAIT_L(n) asm volatile("s_waitcnt lgkmcnt(" #n ")" ::: "memory")
#define PG8_BAR __builtin_amdgcn_s_barrier()
#define PG8_SCHED __builtin_amdgcn_sched_barrier(0)
    Unit cur, nxt; int ui = 0;
    if (!S.next(0, cur)) return;
    if constexpr (GATHER) { PG8_GOFF(0); } else { vC0[0] = voffA[0]; vC0[1] = voffA[1]; vC1[0] = voffA[0] + (unsigned)hstep; vC1[1] = voffA[1] + (unsigned)hstep; }
    f32x4 acc[2][2][4][2];
    { float z_ = 0.f; LAUNDER_V(z_);
#pragma unroll
    for (int a = 0; a < 2; ++a)
#pragma unroll
        for (int b = 0; b < 2; ++b)
#pragma unroll
            for (int m = 0; m < 4; ++m)
#pragma unroll
                for (int n = 0; n < 2; ++n) acc[a][b][m][n] = (f32x4){z_, z_, z_, z_}; }
    bf16x8 At[4][2], B0[2][2], B1[2][2];
    int ntc = S.nt(cur, nt);
    const char* cA = GATHER ? (const char*)g.A : (const char*)g.A + (size_t)cur.pm * tstep + S.aoff(cur); const char* cB = S.bptr(cur, 0); const char* cB1 = S.bptr(cur, 1) - (size_t)ks * kstep;
    if constexpr (SP2) {
        PG8_STAGE(PG8_SB(0, 0), cB, voffB); PG8_STAGE(PG8_SB(0, 1), cB + hstepB, voffB); PG8_STAGE(PG8_SA(0, 0), cA, vC0); PG8_STAGE(PG8_SA(0, 1), cA, vC1);
        if (wr == 1) PG8_BAR;
        PG8_WAIT_V(2); PG8_BAR;
        PG8_STAGE(PG8_SB(1, 0), cB + kstep, voffB); PG8_STAGE(PG8_SA(1, 0), cA + kstep, vC0); PG8_STAGE(PG8_SB(1, 1), cB + hstepB + kstep, voffB);
        PG8_WAIT_V(6); PG8_BAR;
    } else {
        PG8_STAGE(PG8_SB(0, 0), cB, voffB); PG8_STAGE(PG8_SA(0, 0), cA, vC0); PG8_STAGE(PG8_SB(0, 1), cB + hstepB, voffB); PG8_STAGE(PG8_SA(0, 1), cA, vC1);
        if (wr == 1) PG8_BAR;
        PG8_WAIT_V(4); PG8_BAR;
        PG8_STAGE(PG8_SB(1, 0), cB + kstep, voffB); PG8_STAGE(PG8_SA(1, 0), cA + kstep, vC0); PG8_STAGE(PG8_SB(1, 1), cB + hstepB + kstep, voffB);
        PG8_WAIT_V(6); PG8_BAR;
    }
    for (;;) {
        const bool has_next = S.next(ui + 1, nxt);
        const char* nA = GATHER ? (const char*)g.A : (has_next ? (const char*)g.A + (size_t)nxt.pm * tstep + S.aoff(nxt) : cA); const char* nB = has_next ? S.bptr(nxt, 0) : cB;
        const char* nB1 = has_next ? S.bptr(nxt, 1) - (size_t)ks * kstep : cB1;
#pragma unroll 1
        for (int t = 0; t < ntc; t += 2) {
            const bool last = (t == ntc - 2);
            const char* a1 = cA + (size_t)(t + 1) * kstep;
            const char* bside = (t + 2 < ks) ? cB : cB1;
            const char* a2 = last ? nA : cA + (size_t)(t + 2) * kstep; const char* b2 = last ? nB : bside + (size_t)(t + 2) * kstep;
            const char* a3 = a2 + kstep; const char* b3 = b2 + kstep;
            unsigned x0[2] = {vC0[0], vC0[1]}, x1[2] = {vC1[0], vC1[1]};
            if constexpr (GATHER) { if (last && has_next) { _Pragma("unroll") for (int _i = 0; _i < 2; ++_i) { const int R_ = (int)(voffA[_i] >> 11); const unsigned C_ = voffA[_i] & 2047u;
                x0[_i] = (unsigned)S.tokl[(ui + 1) * 256 + R_] * 2048u + C_; x1[_i] = (unsigned)S.tokl[(ui + 1) * 256 + 128 + R_] * 2048u + C_; } } }
            if constexpr (SP2) {
            PG8_LDB(B0, 0, 0); PG8_LDB(B1, 0, 1); PG8_SCHED; PG8_LDA(At, 0, 0); PG8_STAGE(PG8_SA(1, 1), a1, vC1);
            PG8_WAIT_V(8); PG8_WAIT_L(0); PG8_BAR; PG8_MMA(0, 0, At, B0); PG8_MMA(0, 1, At, B1); PG8_BAR; PG8_SCHED;
            PG8_LDA(At, 0, 1); PG8_STAGE(PG8_SB(0, 0), b2, voffB); PG8_STAGE(PG8_SB(0, 1), b2 + hstepB, voffB); PG8_STAGE(PG8_SA(0, 0), a2, x0);
            PG8_WAIT_V(8); PG8_WAIT_L(0); PG8_BAR; PG8_MMA(1, 0, At, B0); PG8_MMA(1, 1, At, B1); PG8_BAR; PG8_SCHED;
            PG8_LDB(B0, 1, 0); PG8_LDB(B1, 1, 1); PG8_SCHED; PG8_LDA(At, 1, 0); PG8_STAGE(PG8_SA(0, 1), a2, x1);
            PG8_WAIT_V(8); PG8_WAIT_L(0); PG8_BAR; PG8_MMA(0, 0, At, B0); PG8_MMA(0, 1, At, B1); PG8_BAR; PG8_SCHED;
            PG8_LDA(At, 1, 1); PG8_STAGE(PG8_SB(1, 0), b3, voffB); PG8_STAGE(PG8_SB(1, 1), b3 + hstepB, voffB); PG8_STAGE(PG8_SA(1, 0), a3, x0);
            PG8_WAIT_V(8); PG8_WAIT_L(0); PG8_BAR; PG8_MMA(1, 0, At, B0); PG8_MMA(1, 1, At, B1); PG8_BAR; PG8_SCHED;
            } else {
            PG8_LDB(B0, 0, 0); PG8_SCHED; PG8_LDA(At, 0, 0); PG8_STAGE(PG8_SA(1, 1), a1, vC1);
            PG8_WAIT_L(8); PG8_BAR; PG8_WAIT_L(0); PG8_MMA(0, 0, At, B0); PG8_BAR; PG8_SCHED;
            PG8_LDB(B1, 0, 1); PG8_STAGE(PG8_SB(0, 0), b2, voffB);
            PG8_BAR; PG8_WAIT_L(0); PG8_MMA(0, 1, At, B1); PG8_BAR;
            PG8_LDA(At, 0, 1); PG8_STAGE(PG8_SA(0, 0), a2, x0);
            PG8_BAR; PG8_WAIT_L(0); PG8_MMA(1, 0, At, B0); PG8_BAR; PG8_SCHED;
            PG8_STAGE(PG8_SB(0, 1), b2 + hstepB, voffB);
            PG8_WAIT_V(6); PG8_BAR; PG8_MMA(1, 1, At, B1); PG8_BAR;
            PG8_LDB(B0, 1, 0); PG8_SCHED; PG8_LDA(At, 1, 0); PG8_STAGE(PG8_SA(0, 1), a2, x1);
            PG8_WAIT_L(8); PG8_BAR; PG8_WAIT_L(0); PG8_MMA(0, 0, At, B0); PG8_BAR; PG8_SCHED;
            PG8_LDB(B1, 1, 1); PG8_STAGE(PG8_SB(1, 0), b3, voffB);
            PG8_BAR; PG8_WAIT_L(0); PG8_MMA(0, 1, At, B1); PG8_BAR;
            PG8_LDA(At, 1, 1); PG8_STAGE(PG8_SA(1, 0), a3, x0);
            PG8_BAR; PG8_WAIT_L(0); PG8_MMA(1, 0, At, B0); PG8_BAR; PG8_SCHED;
            PG8_STAGE(PG8_SB(1, 1), b3 + hstepB, voffB);
            PG8_WAIT_V(6); PG8_BAR; PG8_MMA(1, 1, At, B1); PG8_BAR;
            }
        }
        if constexpr (ALIGN_EPI) { if (wr == 0) PG8_BAR; }
        { const int l2 = lane_id_opaque(); E(acc, cur, wr, wc, l2 & 15, l2 >> 4); }
        if (!has_next) break;
        if (!E.keep(cur)) { float z_ = 0.f; LAUNDER_V(z_);
#pragma unroll
        for (int a = 0; a < 2; ++a)
#pragma unroll
            for (int b = 0; b < 2; ++b)
#pragma unroll
                for (int m = 0; m < 4; ++m)
#pragma unroll
                    for (int n = 0; n < 2; ++n) acc[a][b][m][n] = (f32x4){z_, z_, z_, z_}; }
        cur = nxt; cA = nA; cB = nB; cB1 = nB1; ++ui; ntc = S.nt(cur, nt);
        if constexpr (GATHER) { PG8_GOFF(ui); }
        if constexpr (ALIGN_EPI) { if (wr == 1) PG8_BAR; }
    }
    PG8_WAIT_V(0);
    if constexpr (!ALIGN_EPI) { if (wr == 0) PG8_BAR; }
    PG8_BAR;
#undef PG8_GOFF
#undef PG8_SA
#undef PG8_SB
#undef PG8_STAGE
#undef PG8_LDA
#undef PG8_LDB
#undef PG8_MMA
#undef PG8_WAIT_V
#undef PG8_WAIT_L
#undef PG8_BAR
#undef PG8_SCHED
}
}

typedef f32x4 AccT[2][2][4][2];
__device__ __forceinline__ u32x4 pack8(const f32x4 a, const f32x4 b) { u32x4 w; w.x = pk2(a[0], a[1]); w.y = pk2(a[2], a[3]); w.z = pk2(b[0], b[1]); w.w = pk2(b[2], b[3]); return w; }

struct Epi1 {
    static constexpr bool PERM = true;
    __device__ __forceinline__ bool keep(const pg8::Unit&) const { return false; }
    const float* rstd; bf16* A; bf16* GLU; bf16* QKV; bf16* G; unsigned* NRM; LAS float* nsc; unsigned* NQB;
    __device__ __forceinline__ void operator()(AccT& acc, const pg8::Unit& u, int wr, int wc, int fr, int fq) const { run<false>(acc, u, wr, wc, fr, fq); }
    template <bool SK> __device__ __forceinline__ void run(AccT& acc, const pg8::Unit& u, int wr, int wc, int fr, int fq) const {
        const int row0 = u.pm * 256 + wr * 64 + fr, lc0 = wc * 32 + 8 * fq, pn = u.pn; float nmax = 0.f;
#pragma unroll
        for (int ai = 0; ai < (SK ? 1 : 2); ++ai)
#pragma unroll
            for (int m = 0; m < (SK ? 1 : 4); ++m) {
                const int row = row0 + ai * 128 + m * 16; const float rs = rstd[row];
                f32x4 v[2][2];
#pragma unroll
                for (int bj = 0; bj < 2; ++bj)
#pragma unroll
                    for (int n = 0; n < 2; ++n) v[bj][n] = acc[ai][bj][m][n] * rs;
                if (pn == 0) {
#pragma unroll
                    for (int bj = 0; bj < 2; ++bj) __builtin_nontemporal_store(pack8(v[bj][0], v[bj][1]), (u32x4*)(A + (size_t)row * 256 + bj * 128 + lc0));
                } else if (pn <= 2) {
                    f32x4 o[2];
#pragma unroll
                    for (int n = 0; n < 2; ++n)
#pragma unroll
                        for (int j = 0; j < 4; ++j) o[n][j] = v[0][n][j] * sigmoidf_(v[1][n][j]);
                    __builtin_nontemporal_store(pack8(o[0], o[1]), (u32x4*)(GLU + (size_t)row * 256 + (pn - 1) * 128 + lc0));
                } else if (pn <= 4) {
#pragma unroll
                    for (int bj = 0; bj < 2; ++bj) __builtin_nontemporal_store(pack8(v[bj][0], v[bj][1]), (u32x4*)(QKV + (size_t)2 * (U / 4) + (size_t)row * 512 + (pn - 3) * 256 + bj * 128 + lc0));
                } else {
                    const int d = 64 * (pn - 5) + 16 * wc + 4 * fq; f32x4 r01, r12, g2;
#pragma unroll
                    for (int j = 0; j < 4; ++j) { const float a0 = 1.0f + fminf(__builtin_amdgcn_exp2f(-LOG2E * v[0][0][j]), 1e30f), a1 = 1.0f + fminf(__builtin_amdgcn_exp2f(-LOG2E * v[0][1][j]), 1e30f), a2 = 1.0f + fminf(__builtin_amdgcn_exp2f(-LOG2E * v[1][0][j]), 1e30f);
                        const float i0 = __builtin_amdgcn_rcpf(a0), i1 = __builtin_amdgcn_rcpf(a1), i2 = __builtin_amdgcn_rcpf(a2);
                        r01[j] = i0 * a1; r12[j] = i1 * a2; g2[j] = i2; }
                    const int aim = ai * 4 + m, w8 = wr * 4 + wc, l64 = fq * 16 + fr; u32x2 w;
                    w.x = pk2(r01[0], r01[1]); w.y = pk2(r01[2], r01[3]); __builtin_nontemporal_store(w, (u32x2*)(G + gidx(0, u.pm, pn - 5, aim, w8, l64)));
                    w.x = pk2(r12[0], r12[1]); w.y = pk2(r12[2], r12[3]); __builtin_nontemporal_store(w, (u32x2*)(G + gidx(1, u.pm, pn - 5, aim, w8, l64)));
                    w.x = pk2(g2[0], g2[1]); w.y = pk2(g2[2], g2[3]); __builtin_nontemporal_store(w, (u32x2*)(G + gidx(2, u.pm, pn - 5, aim, w8, l64)));
                    const float sc = d < 512 ? C2 : 1.0f; const f32x4 sp = v[1][1] * sc;
                    w.x = pk2(sp[0], sp[1]); w.y = pk2(sp[2], sp[3]); __builtin_nontemporal_store(w, (u32x2*)(QKV + (size_t)(d < 512 ? 0 : 1) * (U / 4) + (size_t)row * 512 + (d & 511)));
                    float p2 = (sp[0] * sp[0] + sp[1] * sp[1]) + (sp[2] * sp[2] + sp[3] * sp[3]); p2 += lane_xor<16>(p2); p2 += lane_xor<32>(p2);
                    if constexpr (SK) nmax = fmaxf(nmax, p2); else if (fq == 0) nsc[wc * 256 + (row & 255)] = p2;
                }
            }
        if (pn >= 5) {
            const int t = pn - 5, kind = t >> 3, hd = t & 7;
            if constexpr (!SK) {
                LDS_WAIT(); __builtin_amdgcn_s_barrier(); asm volatile("" ::: "memory");
#pragma unroll
                for (int ai = 0; ai < 2; ++ai)
#pragma unroll
                    for (int m = 0; m < 4; ++m) { float t4 = nsc[fq * 256 + wr * 64 + ai * 128 + m * 16 + fr]; t4 += lane_xor<16>(t4); t4 += lane_xor<32>(t4); nmax = fmaxf(nmax, t4); }
            }
            nmax = fmaxf(nmax, lane_xor<1>(nmax)); nmax = fmaxf(nmax, lane_xor<2>(nmax)); nmax = fmaxf(nmax, lane_xor<4>(nmax)); nmax = fmaxf(nmax, lane_xor<8>(nmax));
            if (fr == 0 && fq == 0) { const unsigned vb = __float_as_uint(nmax * 1.02f);
                if (SK) { for (int bb = 0; bb < NB; ++bb) __hip_atomic_fetch_max(NRM + kind * 256 + (bb * 8 + hd) * 8 + 1 + wc, vb, __ATOMIC_RELAXED, __HIP_MEMORY_SCOPE_AGENT); }
                else { __hip_atomic_fetch_max(NRM + kind * 256 + ((u.pm >> 5) * 8 + hd) * 8, vb, __ATOMIC_RELAXED, __HIP_MEMORY_SCOPE_AGENT);
                    if (kind == 0) __hip_atomic_fetch_max(NQB + u.pm * 8 + hd, vb, __ATOMIC_RELAXED, __HIP_MEMORY_SCOPE_AGENT); } }
        }
    }
};
struct EpiCS {
    static constexpr bool PERM = true;
    const bf16* G; bf16* Mg; const float* bias;
    __device__ __forceinline__ bool keep(const pg8::Unit& u) const { return u.seg != 2; }
    __device__ __forceinline__ void operator()(AccT& acc, const pg8::Unit& u, int wr, int wc, int fr, int fq) const { run<false>(acc, u, wr, wc, fr, fq); }
    template <bool SK> __device__ __forceinline__ void run(AccT& acc, const pg8::Unit& u, int wr, int wc, int fr, int fq) const {
        const int row0 = u.pm * 256 + wr * 64 + fr, col0 = u.pn * 256 + wc * 32 + 8 * fq;
        const bool lastseg = u.seg == 2; const float bsc = u.seg == 0 ? 1.f : 0.f;
        f32x4 bv[2][2];
#pragma unroll
        for (int bj = 0; bj < 2; ++bj) { bv[bj][0] = *(const f32x4*)(bias + col0 + bj * 128) * bsc; bv[bj][1] = *(const f32x4*)(bias + col0 + bj * 128 + 4) * bsc; }
        u32x2 gr[2][4][2][2];
        { const int w8 = wr * 4 + wc, l64 = fq * 16 + fr;
#pragma unroll
        for (int ai = 0; ai < (SK ? 1 : 2); ++ai)
#pragma unroll
            for (int m = 0; m < (SK ? 1 : 4); ++m)
#pragma unroll
                for (int bj = 0; bj < 2; ++bj)
#pragma unroll
                    for (int n = 0; n < 2; ++n) gr[ai][m][bj][n] = __builtin_nontemporal_load((const u32x2*)(G + gidx(u.seg, u.pm, 4 * u.pn + 2 * bj + n, ai * 4 + m, w8, l64))); }
#pragma unroll
        for (int ai = 0; ai < (SK ? 1 : 2); ++ai)
#pragma unroll
            for (int m = 0; m < (SK ? 1 : 4); ++m) { const int row = row0 + ai * 128 + m * 16;
#pragma unroll
                for (int bj = 0; bj < 2; ++bj) {
                    const u32x2 n0 = gr[ai][m][bj][0], n1 = gr[ai][m][bj][1];
                    f32x4 a0 = acc[ai][bj][m][0] + bv[bj][0], a1 = acc[ai][bj][m][1] + bv[bj][1];
                    a0[0] *= bflo(n0.x); a0[1] *= bfhi(n0.x); a0[2] *= bflo(n0.y); a0[3] *= bfhi(n0.y); a1[0] *= bflo(n1.x); a1[1] *= bfhi(n1.x); a1[2] *= bflo(n1.y); a1[3] *= bfhi(n1.y);
                    acc[ai][bj][m][0] = a0; acc[ai][bj][m][1] = a1;
                    asm volatile("" : "+v"(acc[ai][bj][m][0]), "+v"(acc[ai][bj][m][1]));
                    if (lastseg) *(u32x4*)(Mg + (size_t)row * 1024 + col0 + bj * 128) = pack8(a0, a1);
                } }
    }
};
struct EpiD {
    static constexpr bool PERM = false;
    __device__ __forceinline__ bool keep(const pg8::Unit&) const { return false; }
    float* H; bf16* HB;
    __device__ __forceinline__ void operator()(AccT& acc, const pg8::Unit& u, int wr, int wc, int fr, int fq) const { run<false>(acc, u, wr, wc, fr, fq); }
    template <bool SK> __device__ __forceinline__ void run(AccT& acc, const pg8::Unit& u, int wr, int wc, int fr, int fq) const {
        const int row0 = u.pm * 256 + wr * 64 + fr, col0 = u.pn * 256 + wc * 32 + 4 * fq;
#pragma unroll
        for (int ai = 0; ai < (SK ? 1 : 2); ++ai)
#pragma unroll
            for (int m = 0; m < (SK ? 1 : 4); ++m) {
                const size_t off = (size_t)(row0 + ai * 128 + m * 16) * 1024 + col0;
#pragma unroll
                for (int bj = 0; bj < 2; ++bj)
#pragma unroll
                    for (int n = 0; n < 2; ++n) { const size_t o = off + bj * 128 + n * 16; const f32x4 hv = *(const f32x4*)(H + o) + acc[ai][bj][m][n];
                        *(f32x4*)(H + o) = hv; u32x2 w; w.x = pk2(hv[0], hv[1]); w.y = pk2(hv[2], hv[3]); *(u32x2*)(HB + o) = w; }
            }
    }
};
struct EpiA2 {
    static constexpr bool PERM = true;
    __device__ __forceinline__ bool keep(const pg8::Unit&) const { return false; }
    const float* PW; bf16* HH; unsigned* UPC; const LAS int* pcls; const LAS int* cbase;
    __device__ __forceinline__ void operator()(AccT& acc, const pg8::Unit& u, int wr, int wc, int fr, int fq) const {
        const int row0 = u.pm * 256 + wr * 64 + fr, lc0 = wc * 32 + 8 * fq, side = u.pn >> 1;
        const int cls = __builtin_amdgcn_readfirstlane(pcls[u.pm]); const float* PWu = PW + ((size_t)cls * TRC + (size_t)(u.pm * 256 - __builtin_amdgcn_readfirstlane(cbase[cls]))) * 4 - (size_t)u.pm * 256 * 4;
#pragma unroll
        for (int ai = 0; ai < 2; ++ai)
#pragma unroll
            for (int m = 0; m < 4; ++m) {
                const int row = row0 + ai * 128 + m * 16; const f32x4 pw = *(const f32x4*)(PWu + (size_t)row * 4);
                const float rs = pw[0], cw = side ? pw[2] : pw[1];
                f32x4 o[2];
#pragma unroll
                for (int n = 0; n < 2; ++n)
#pragma unroll
                    for (int j = 0; j < 4; ++j) { const float a1 = acc[ai][0][m][n][j] * rs, a3 = acc[ai][1][m][n][j] * rs; o[n][j] = cw * a1 * sigmoidf_(a1) * a3; }
                { bf16* hp = HH + (size_t)row * 512 + side * 256 + (u.pn & 1) * 128 + lc0; const u32x4 hv = pack8(o[0], o[1]);
                  asm volatile("global_store_dwordx4 %0, %1, off sc1\n\ts_nop 1" :: "v"(hp), "v"(hv) : "memory"); }
            }
        asm volatile("s_waitcnt vmcnt(0)" ::: "memory");
        if (fr == 0 && fq == 0) __hip_atomic_fetch_add(UPC + u.pm * 16, 1u, __ATOMIC_RELAXED, __HIP_MEMORY_SCOPE_AGENT);
    }
};
struct EpiB2 {
    static constexpr bool PERM = true;
    __device__ __forceinline__ bool keep(const pg8::Unit&) const { return false; }
    bf16* Y;
    __device__ __forceinline__ void operator()(AccT& acc, const pg8::Unit& u, int wr, int wc, int fr, int fq) const { run<false>(acc, u, wr, wc, fr, fq); }
    template <bool SK> __device__ __forceinline__ void run(AccT& acc, const pg8::Unit& u, int wr, int wc, int fr, int fq) const {
        const int row0 = u.pm * 256 + wr * 64 + fr, col0 = u.pn * 256 + wc * 32 + 8 * fq;
#pragma unroll
        for (int ai = 0; ai < (SK ? 1 : 2); ++ai)
#pragma unroll
            for (int m = 0; m < (SK ? 1 : 4); ++m) {
                bf16* rp = Y + (size_t)(row0 + ai * 128 + m * 16) * 1024 + col0;
#pragma unroll
                for (int bj = 0; bj < 2; ++bj) *(u32x4*)(rp + bj * 128) = pack8(acc[ai][bj][m][0], acc[ai][bj][m][1]);
            }
    }
};
template <bool TOK> struct EpiRes {
    static constexpr bool PERM = true;
    __device__ __forceinline__ bool keep(const pg8::Unit&) const { return false; }
    bf16* HB; const LAS int* tokl;
    __device__ __forceinline__ void operator()(AccT& acc, const pg8::Unit& u, int wr, int wc, int fr, int fq) const { run<false>(acc, u, wr, wc, fr, fq); }
    template <bool SK> __device__ __forceinline__ void run(AccT& acc, const pg8::Unit& u, int wr, int wc, int fr, int fq) const {
        const int col0 = u.pn * 256 + wc * 32 + 8 * fq;
        int rowv[2][4]; u32x4 hr[2][4][2];
#pragma unroll
        for (int ai = 0; ai < (SK ? 1 : 2); ++ai)
#pragma unroll
            for (int m = 0; m < (SK ? 1 : 4); ++m) {
                const int p = wr * 64 + fr + ai * 128 + m * 16; int row;
                if constexpr (TOK) row = tokl[u.seg * 256 + p]; else row = u.pm * 256 + p;
                rowv[ai][m] = row; const int rl = row < 0 ? 0 : row;
#pragma unroll
                for (int bj = 0; bj < 2; ++bj) hr[ai][m][bj] = *(const u32x4*)(HB + (size_t)rl * 1024 + col0 + bj * 128);
            }
#pragma unroll
        for (int ai = 0; ai < (SK ? 1 : 2); ++ai)
#pragma unroll
            for (int m = 0; m < (SK ? 1 : 4); ++m) { const int row = rowv[ai][m];
#pragma unroll
                for (int bj = 0; bj < 2; ++bj) { const u32x4 n4 = hr[ai][m][bj];
                    f32x4 a0 = acc[ai][bj][m][0], a1 = acc[ai][bj][m][1];
                    a0[0] += bflo(n4.x); a0[1] += bfhi(n4.x); a0[2] += bflo(n4.y); a0[3] += bfhi(n4.y); a1[0] += bflo(n4.z); a1[1] += bfhi(n4.z); a1[2] += bflo(n4.w); a1[3] += bfhi(n4.w);
                    if (!TOK || row >= 0) *(u32x4*)(HB + (size_t)row * 1024 + col0 + bj * 128) = pack8(a0, a1); } }
    }
};
template <bool GA> struct MoeOrderT {
    static constexpr bool GATHER = GA; const LAS int* tokl;
    int NP, G, c, mode; const LAS int* pcls; const bf16* W; int i0, i1;
    __device__ bool next(int i, pg8::Unit& u) const { const int ii = i + i0; if (ii >= i1) return false; const int L = ii * G + c; if (L >= NP * 4) return false; u.pm = L >> 2; u.pn = L & 3; u.seg = ii; return true; }
    __device__ __forceinline__ int nt(const pg8::Unit&, int ntd) const { return ntd; }
    __device__ __forceinline__ size_t aoff(const pg8::Unit&) const { return 0; }
    __device__ __forceinline__ const char* bptr(const pg8::Unit& u, int side) const {
        const int cls = __builtin_amdgcn_readfirstlane(pcls[u.pm]); const int grp = cls / 6, pr = cls % 6;
        const int ea = pr < 3 ? 0 : (pr < 5 ? 1 : 2), eb = pr < 3 ? pr + 1 : (pr < 5 ? pr - 1 : 3);
        if (mode == 0) { const int e = grp * 4 + (u.pn < 2 ? ea : eb); return (const char*)W + ((size_t)e * 512 + (size_t)(u.pn & 1) * 256) * 1024 * 2; }
        const int e = grp * 4 + (side ? eb : ea); return (const char*)W + ((size_t)e * 1024 + (size_t)u.pn * 256) * 256 * 2;
    }
};

struct MoeDownOrder : MoeOrderT<false> {
    int Ls[3];
    __device__ bool next(int i, pg8::Unit& u) const { const int ii = i + i0; if (ii >= i1) return false; const int L = ii == 0 ? Ls[0] : (ii == 1 ? Ls[1] : Ls[2]); if (L < 0) return false;
        u.pm = L >> 2; u.pn = L & 3; u.seg = ii; return true; }
};
template <bool PERM> __device__ __forceinline__ void skinny_k(AccT& acc, const bf16* A, int lda, const bf16* Bt, int ldb, int K, int wc, int fr, int fq) {
    const bf16* ap = A + (size_t)fr * lda + 8 * fq;
    const bf16* bp[2][2];
#pragma unroll
    for (int bj = 0; bj < 2; ++bj)
#pragma unroll
        for (int n = 0; n < 2; ++n) { const int col = 128 * bj + 32 * wc + (PERM ? 8 * (fr >> 2) + 4 * n + (fr & 3) : 16 * n + fr); bp[bj][n] = Bt + (size_t)col * ldb + 8 * fq; }
#pragma unroll 8
    for (int k0 = 0; k0 < K; k0 += 32) {
        const bf16x8 a = *(const bf16x8*)(ap + k0);
#pragma unroll
        for (int bj = 0; bj < 2; ++bj)
#pragma unroll
            for (int n = 0; n < 2; ++n) { const bf16x8 b = *(const bf16x8*)(bp[bj][n] + k0); acc[0][bj][0][n] = __builtin_amdgcn_mfma_f32_16x16x32_bf16(b, a, acc[0][bj][0][n], 0, 0, 0); }
    }
}
__device__ __forceinline__ void skinny_zero(AccT& acc) {
#pragma unroll
    for (int bj = 0; bj < 2; ++bj)
#pragma unroll
        for (int n = 0; n < 2; ++n) acc[0][bj][0][n] = (f32x4){0.f, 0.f, 0.f, 0.f};
}
__device__ __forceinline__ void skinny_combine(AccT& acc, LAS unsigned char* lds, int wave, int lane) {
    LAS f32x4* X = (LAS f32x4*)lds;
    if (wave >= 4) {
#pragma unroll
        for (int bj = 0; bj < 2; ++bj)
#pragma unroll
            for (int n = 0; n < 2; ++n) X[((wave - 4) * 64 + lane) * 4 + bj * 2 + n] = acc[0][bj][0][n]; }
    __syncthreads();
    if (wave < 4) {
#pragma unroll
        for (int bj = 0; bj < 2; ++bj)
#pragma unroll
            for (int n = 0; n < 2; ++n) acc[0][bj][0][n] += X[(wave * 64 + lane) * 4 + bj * 2 + n]; }
    __syncthreads();
}

__device__ __forceinline__ void skinny16(LAS unsigned char* lds, int wave, const bf16* A, const bf16* Bt, int c0, f32x4 (&p)[8]) {
    const int l2 = lane_id_opaque(), fr = l2 & 15, fq = l2 >> 4;
    const bf16* ap = A + (size_t)fr * 1024 + 128 * wave + 8 * fq; const bf16* bp = Bt + (size_t)(c0 + fr) * 1024 + 128 * wave + 8 * fq;
    bf16x8 a[4], b[4];
#pragma unroll
    for (int s2 = 0; s2 < 4; ++s2) { a[s2] = *(const bf16x8*)(ap + 32 * s2); b[s2] = *(const bf16x8*)(bp + 32 * s2); }
    f32x4 acc = {0.f, 0.f, 0.f, 0.f};
#pragma unroll
    for (int s2 = 0; s2 < 4; ++s2) acc = __builtin_amdgcn_mfma_f32_16x16x32_bf16(b[s2], a[s2], acc, 0, 0, 0);
    LAS f32x4* X = (LAS f32x4*)lds;
    X[wave * 64 + l2] = acc;
    __syncthreads();
#pragma unroll
    for (int j = 0; j < 8; ++j) p[j] = X[j * 64 + l2];
    LDS_WAIT(); asm volatile("" ::: "memory");
    __syncthreads();
}

#define XB_TMO      128
#define XB_XCNT(j)  (256  + 64 * (j))
#define XB_XSUB(j)  (1280 + 64 * (j))
#define XB_XGEN(j)  (2304 + 64 * (j))
#define XB_TOP      3328
#define XB_TOPGEN   3392
#define XCD_BAR_WORDS 3456
#define XB_SPIN_CAP (1u << 24)
__device__ __forceinline__ unsigned xb_ld(unsigned* p)              { return __hip_atomic_load(p, __ATOMIC_RELAXED, __HIP_MEMORY_SCOPE_AGENT); }
__device__ __forceinline__ unsigned xb_add(unsigned* p, unsigned v) { return __hip_atomic_fetch_add(p, v, __ATOMIC_RELAXED, __HIP_MEMORY_SCOPE_AGENT); }
__device__ __forceinline__ unsigned xb_xcc_id() { return (unsigned)__builtin_amdgcn_s_getreg((3 << 11) | 20) & 0xFu; }
#define XB_SPIN(cond, bar) do { unsigned _sp = 0; while (cond) { __builtin_amdgcn_s_sleep(1); \
    if ((++_sp & 255u) == 0u) { if (xb_ld(&(bar)[XB_TMO])) break; if (_sp > XB_SPIN_CAP) { atomicAdd(&(bar)[XB_TMO], 1u); break; } } } } while (0)
struct XcdBarrier { unsigned* bar; unsigned x; volatile LAS unsigned* st; };
__device__ __forceinline__ XcdBarrier xcd_barrier_post(unsigned* bar, volatile LAS unsigned* st) {
    XcdBarrier b; b.bar = bar; b.x = xb_xcc_id(); b.st = st;
    if (threadIdx.x == 0) (void)xb_add(&bar[XB_XCNT(b.x)], 1u);
    return b;
}
__device__ __forceinline__ void xcd_barrier_complete(unsigned* bar, unsigned x, unsigned& nloc, unsigned& nx) {
    const unsigned G = gridDim.x * gridDim.y * gridDim.z;
    unsigned sum, cnt, mine, sp = 0u;
    for (;;) {
        sum = 0u; cnt = 0u; mine = 0u;
#pragma unroll
        for (unsigned j = 0; j < 16; ++j) { const unsigned c = xb_ld(&bar[XB_XCNT(j)]); sum += c; cnt += (c > 0u) ? 1u : 0u; mine = (j == x) ? c : mine; }
        if (sum == G) break;
        __builtin_amdgcn_s_sleep(1);
        if ((++sp & 255u) == 0u) { if (xb_ld(&bar[XB_TMO])) break; if (sp > XB_SPIN_CAP) { atomicAdd(&bar[XB_TMO], 1u); break; } }
    }
    nloc = mine > 0u ? mine : 1u; nx = cnt > 0u ? cnt : 1u;
}
__device__ __forceinline__ void xcd_barrier(const XcdBarrier& b) {
    asm volatile("s_waitcnt vmcnt(0)" ::: "memory");
    __syncthreads();
    if (threadIdx.x == 0) {
        unsigned* bar = b.bar;
        __builtin_amdgcn_s_waitcnt(0);
        unsigned nloc = b.st[0], nx = b.st[1];
        if (nloc == 0u) { xcd_barrier_complete(bar, b.x, nloc, nx); b.st[0] = nloc; b.st[1] = nx; }
        const unsigned old = xb_add(&bar[XB_XSUB(b.x)], 1u);
        const unsigned gen = old / nloc;
        if (old + 1u == (gen + 1u) * nloc) {
            __builtin_amdgcn_fence(__ATOMIC_RELEASE, "agent");
            asm volatile("s_waitcnt vmcnt(0)" ::: "memory");
            const unsigned og = xb_add(&bar[XB_TOP], 1u);
            const unsigned tg = og / nx;
            if (og + 1u == (tg + 1u) * nx) xb_add(&bar[XB_TOPGEN], 1u);
            else XB_SPIN(xb_ld(&bar[XB_TOPGEN]) == tg, bar);
            __builtin_amdgcn_fence(__ATOMIC_ACQUIRE, "agent");
            xb_add(&bar[XB_XGEN(b.x)], 1u);
            asm volatile("s_waitcnt vmcnt(0)" ::: "memory");
        } else {
            XB_SPIN(xb_ld(&bar[XB_XGEN(b.x)]) == gen, bar);
            __builtin_amdgcn_fence(__ATOMIC_ACQUIRE, "agent");
            asm volatile("s_waitcnt vmcnt(0)" ::: "memory");
        }
    }
    __syncthreads();
}

struct Params { const float* in[25]; float* out; unsigned char* ws; int ph_lo, ph_hi; };
enum { I_X = 0, I_META, I_N1G, I_WIN, I_BF, I_PW, I_PB, I_PS, I_CW, I_CB, I_LNG, I_LNB, I_WOA, I_WOB, I_WOC, I_WO, I_N2G, I_RGW, I_RGB, I_REW, I_REB, I_W1, I_W3, I_W2, I_FG };

struct Frame {
    LAS unsigned char* lds;
    int tid, lane, wave, vcu, G, bx;
};
__device__ __forceinline__ unsigned long long ptab_get(const Frame& F, int i) { const LAS unsigned* t = (const LAS unsigned*)(F.lds + LC_PTAB) + 2 * i; const unsigned lo = __builtin_amdgcn_readfirstlane(t[0]), hi = __builtin_amdgcn_readfirstlane(t[1]); return ((unsigned long long)hi << 32) | lo; }
#define INP(i) ((const float*)(const GAS float*)ptab_get(F, (i)))
#define WSP() ((unsigned char*)(GAS unsigned char*)ptab_get(F, 25))
#define DOP() ((unsigned char*)(GAS unsigned char*)ptab_get(F, 26))

template <bool KPERM = false> __device__ __forceinline__ void tr_item(const float* W, int ldw, int scol_lane  , const float* gk, bf16* WT, int ldt, int drow0, int k0, LAS float* scr, int lane) {
    const int n4 = (lane & 7) * 4, kr = lane >> 3;
    f32x4 v[8];
#pragma unroll
    for (int i = 0; i < 8; ++i) { const int kd = k0 + 8 * i + kr; v[i] = __builtin_nontemporal_load((const f32x4*)(W + (size_t)(KPERM ? lcol(kd) : kd) * ldw + scol_lane)); }
#pragma unroll
    for (int i = 0; i < 8; ++i) { const int kk = 8 * i + kr; const float g = gk ? gk[k0 + kk] : 1.0f; LAS float* d = scr + kk * 33 + n4; d[0] = v[i][0] * g; d[1] = v[i][1] * g; d[2] = v[i][2] * g; d[3] = v[i][3] * g; }
    LDS_WAIT(); asm volatile("" ::: "memory");
    const int c = lane & 7;
#pragma unroll
    for (int j = 0; j < 4; ++j) { const int n = (lane >> 3) + 8 * j; const LAS float* s = scr + (8 * c) * 33 + n;
        u32x4 o; o.x = pk2(s[0 * 33], s[1 * 33]); o.y = pk2(s[2 * 33], s[3 * 33]); o.z = pk2(s[4 * 33], s[5 * 33]); o.w = pk2(s[6 * 33], s[7 * 33]);
        *(u32x4*)(WT + (size_t)(drow0 + n) * ldt + k0 + 8 * c) = o; }
    LDS_WAIT(); asm volatile("" ::: "memory");
}
__device__ __forceinline__ int map1(int n) {
    const int tile = n >> 8, c = n & 255;
    if (tile == 0) return n;
    if (tile <= 2) { const int cc = (tile - 1) * 128 + (c & 127); return (c < 128 ? 256 : 512) + cc; }
    if (tile <= 4) return 1792 + (n - 768);
    const int t = tile - 5, bj = c >> 7, wc = (c >> 5) & 3, fq = (c >> 3) & 3, nn = (c >> 2) & 1, d = 64 * t + 16 * wc + 4 * fq + (c & 3), kind = 2 * bj + nn;
    return kind == 3 ? 768 + d : 2312 + 1024 * kind + d;
}
__device__ __forceinline__ void convert_item(Frame& F, int l, int it, LAS float* scr, int lane) {
    const float* g1 = INP(I_N1G) + (size_t)l * D; const float* g2 = INP(I_N2G) + (size_t)l * D; unsigned char* ws = WSP(); const int n4l = (lane & 7) * 4;
    if (it < 2688) { const int kb = it / 168, nb = it % 168; tr_item(INP(I_WIN) + (size_t)l * D * NIN, NIN, map1(nb * 32 + n4l), g1, (bf16*)(ws + WS_W1T), 1024, nb * 32, kb * 64, scr, lane); return; } it -= 2688;
    if (it < 128) { const int kb = it / 32, nb = it % 32; tr_item(INP(I_WOB) + (size_t)l * 256 * D, 1024, lcol(nb * 32 + n4l), nullptr, (bf16*)(ws + WS_W3CT) + 256, 1024, nb * 32, kb * 64, scr, lane); return; } it -= 128;
    if (it < 256) { const int kb = it / 32, nb = it % 32; tr_item(INP(I_WOC) + (size_t)l * 512 * D, 1024, lcol(nb * 32 + n4l), nullptr, (bf16*)(ws + WS_W3CT) + 512, 1024, nb * 32, kb * 64, scr, lane); return; } it -= 256;
    if (it < 512) { const int kb = it / 32, nb = it % 32; tr_item<true>(INP(I_WO) + (size_t)l * D * D, 1024, nb * 32 + n4l, nullptr, (bf16*)(ws + WS_WOT), 1024, nb * 32, kb * 64, scr, lane); return; } it -= 512;
    if (it < 4096) { const int e = it >> 8, r = it & 255, kb = r >> 4, nb = r & 15, n0 = nb * 32, jt = n0 >> 8, rr = n0 & 255;
        const float* W = (rr < 128 ? INP(I_W1) : INP(I_W3)) + ((size_t)l * 16 + e) * D * 256;
        tr_item(W, 256, jt * 128 + (rr & 127) + n4l, g2, (bf16*)(DOP() + DO_W13T) + (size_t)e * 512 * 1024, 1024, n0, kb * 64, scr, lane); return; } it -= 4096;
    { const int e = it >> 7, r = it & 127, kb = r >> 5, nb = r & 31;
        tr_item(INP(I_W2) + ((size_t)l * 16 + e) * 256 * D, 1024, nb * 32 + n4l, nullptr, (bf16*)(DOP() + DO_W2T) + (size_t)e * 1024 * 256, 256, nb * 32, kb * 64, scr, lane); }
}
__device__ __forceinline__ void convert_weights(Frame& F, int l, int w0, int nw) {
    LAS float* scr = (LAS float*)(F.lds + F.wave * 16384);
    const int gw = F.vcu * nw + (F.wave - w0), NGW = F.G * nw, lane = F.lane;
    const float* g1 = INP(I_N1G) + (size_t)l * D; const float* g2 = INP(I_N2G) + (size_t)l * D;
    unsigned char* ws = WSP();
#pragma unroll 1
    for (int it0 = gw; it0 < 3584; it0 += NGW) convert_item(F, l, it0, scr, lane);
    { const float* pw = INP(I_PW) + (size_t)l * 4 * 64 * 64; const float* ps = INP(I_PS) + (size_t)l * 256; const float* pb = INP(I_PB) + (size_t)l * 256;
      const float* wa = INP(I_WOA) + (size_t)l * 256 * D; bf16* WT = (bf16*)(ws + WS_W3CT); float* bias = (float*)(ws + WS_BIASA);
      const int gt = gw * 64 + lane, NT = NGW * 64;
      for (int idx = gt; idx < 256 * 1024; idx += NT) { const int n = idx & 1023, kk = idx >> 10, grp = kk >> 6, c = kk & 63; float s = 0.f;
#pragma unroll 16
        for (int d = 0; d < 64; ++d) s += pw[(grp * 64 + c) * 64 + d] * ps[grp * 64 + d] * wa[(size_t)(grp * 64 + d) * D + lcol(n)];
        WT[(size_t)n * 1024 + kk] = (bf16)f2bf(s); }
      for (int n = gw; n < 1024; n += NGW) { float s = 0.f;
#pragma unroll
        for (int j = 0; j < 4; ++j) { const int d = lane + 64 * j; s += pb[d] * ps[d] * wa[(size_t)d * D + lcol(n)]; }
        s = wave_sum(s); if (lane == 0) bias[n] = s; }
      float* wfg = (float*)(ws + WS_WFG); const float* win = INP(I_WIN) + (size_t)l * D * NIN;
      for (int idx = gt; idx < 8 * 1024; idx += NT) { const int c = idx >> 10, k = idx & 1023; wfg[idx] = g1[k] * win[(size_t)k * NIN + 2304 + c]; }
      float* rg = (float*)(ws + WS_RG); const float* re = INP(I_REW) + (size_t)l * D * 16; const float* rgw = INP(I_RGW) + (size_t)l * D * 4;
      for (int idx = gt; idx < 20 * 1024; idx += NT) { const int c = idx >> 10, k = idx & 1023; rg[idx] = g2[k] * (c < 16 ? re[(size_t)k * 16 + c] : rgw[(size_t)k * 4 + (c - 16)]); } }
}
__device__ __forceinline__ void convert_small_chunk(Frame& F, int l, int j) {
    const float* g1 = INP(I_N1G) + (size_t)l * D; const float* g2 = INP(I_N2G) + (size_t)l * D; unsigned char* ws = WSP(); const int tid = F.tid, lane = F.lane, wave = F.wave;
    const float* pw = INP(I_PW) + (size_t)l * 4 * 64 * 64; const float* ps = INP(I_PS) + (size_t)l * 256; const float* pb = INP(I_PB) + (size_t)l * 256;
    const float* wa = INP(I_WOA) + (size_t)l * 256 * D; bf16* WT = (bf16*)(ws + WS_W3CT); float* bias = (float*)(ws + WS_BIASA);
    { const int kk = j, grp = kk >> 6, c = kk & 63; float sm0 = 0.f, sm1 = 0.f;
#pragma unroll 16
      for (int d = 0; d < 64; ++d) { const float cf = pw[(grp * 64 + c) * 64 + d] * ps[grp * 64 + d]; sm0 += cf * wa[(size_t)(grp * 64 + d) * D + lcol(tid)]; sm1 += cf * wa[(size_t)(grp * 64 + d) * D + lcol(512 + tid)]; }
      WT[(size_t)tid * 1024 + kk] = (bf16)f2bf(sm0); WT[(size_t)(512 + tid) * 1024 + kk] = (bf16)f2bf(sm1); }
    if (wave < 4) { const int n = 4 * j + wave; float sm = 0.f;
#pragma unroll
        for (int jj = 0; jj < 4; ++jj) { const int d = lane + 64 * jj; sm += pb[d] * ps[d] * wa[(size_t)d * D + lcol(n)]; }
        sm = wave_sum(sm); if (lane == 0) bias[n] = sm; }
    float* wfg = (float*)(ws + WS_WFG); const float* win = INP(I_WIN) + (size_t)l * D * NIN;
    if (tid < 32) { const int idx = 32 * j + tid; const int c = idx >> 10, k = idx & 1023; wfg[idx] = g1[k] * win[(size_t)k * NIN + 2304 + c]; }
    float* rg = (float*)(ws + WS_RG); const float* re = INP(I_REW) + (size_t)l * D * 16; const float* rgw = INP(I_RGW) + (size_t)l * D * 4;
    if (tid >= 64 && tid < 144) { const int idx = 80 * j + tid - 64; const int c = idx >> 10, k = idx & 1023; rg[idx] = g2[k] * (c < 16 ? re[(size_t)k * 16 + c] : rgw[(size_t)k * 4 + (c - 16)]); }
}
__device__ __forceinline__ void convert_queue(Frame& F, int l, unsigned* head) {
    LAS int* qs = (LAS int*)(F.lds + LC_QS); LAS float* scr = (LAS float*)(F.lds + F.wave * 16384);
#pragma unroll 1
    for (;;) { __syncthreads(); if (F.tid == 0) qs[0] = (int)atomicAdd(head, 1u); __syncthreads();
        const int c = __builtin_amdgcn_readfirstlane(qs[0]); if (c >= 704) break;
        if (c < 256) convert_small_chunk(F, l, c); else convert_item(F, l, 8 * (c - 256) + F.wave, scr, lane_id_opaque()); }
}
__device__ __forceinline__ void init_rows(Frame& F, int w0, int nw) {
    const int gw = F.vcu * nw + (F.wave - w0), NGW = F.G * nw, lane = F.lane;
    bf16* HB = (bf16*)(WSP() + WS_HB); float* rstd1 = (float*)(WSP() + WS_RSTD1);
    constexpr int R = 4;
#pragma unroll 1
    for (int row0 = gw; row0 < TR; row0 += R * NGW) {
        f32x4 v[R][4];
#pragma unroll
        for (int r = 0; r < R; ++r) { int row = row0 + r * NGW; if (row >= TR) row = TR - 1;
            const float* src = row < TX ? INP(I_X) + (size_t)row * D : INP(I_META) + (size_t)(row - TX) * D;
#pragma unroll
            for (int j = 0; j < 4; ++j) v[r][j] = __builtin_nontemporal_load((const f32x4*)(src + 4 * lane + 256 * j)); }
#pragma unroll
        for (int r = 0; r < R; ++r) { const int row = row0 + r * NGW; float ss = 0.f;
#pragma unroll
            for (int j = 0; j < 4; ++j) ss += v[r][j][0] * v[r][j][0] + v[r][j][1] * v[r][j][1] + v[r][j][2] * v[r][j][2] + v[r][j][3] * v[r][j][3];
            ss = wave_sum(ss);
            if (row < TR) {
#pragma unroll
                for (int j = 0; j < 4; ++j) { u32x2 w; w.x = pk2(v[r][j][0], v[r][j][1]); w.y = pk2(v[r][j][2], v[r][j][3]); *(u32x2*)(HB + (size_t)row * D + 4 * lane + 256 * j) = w; }
                if (lane == 0) rstd1[row] = rsqrtf(ss * (1.0f / D) + EPS); } }
    }
    { bf16* Kb = (bf16*)(DOP() + DO_K) + (size_t)TR * 512; bf16* Vb = (bf16*)(DOP() + DO_V) + (size_t)TR * 512; const int gt = gw * 64 + lane;
      if (gt < 48 * 64) { *(u32x4*)(Kb + (size_t)gt * 8) = (u32x4){0u, 0u, 0u, 0u}; *(u32x4*)(Vb + (size_t)gt * 8) = (u32x4){0u, 0u, 0u, 0u}; } }
}

__device__ __forceinline__ int srcrow(bool isx, int b, int t) {
    if (t >= 0) return (isx ? b * SEQ : TX) + t;
    if (isx) { const int mm = NMETA + t; return mm >= 0 ? TX + mm : -1; }
    return -1;
}
__device__ __forceinline__ void s_item_logf(Frame& F, int l, int item) {
    LAS unsigned char* lds = F.lds; const int wave = F.wave;
    {
        const bool isx = item < 512; const int row0 = isx ? item * 64 : TX + (item - 512) * 64; const int b = isx ? (item * 64) / SEQ : 0; const int t0 = isx ? (item * 64) % SEQ : (item - 512) * 64; const int nrows = isx ? 64 : NMETA;
        { unsigned char* ws = WSP(); int tid = F.tid; LAUNDER_V(tid); const int lane = tid & 63, fr = lane & 15, fq = lane >> 4;
          const bf16* HB = (const bf16*)(ws + WS_HB); const float* rstd1 = (const float*)(ws + WS_RSTD1); const float* wfg = (const float*)(ws + WS_WFG);
          float* LFT = (float*)(ws + WS_LFT); float* LFTM = (float*)(ws + WS_LFTM); const float* bfg = INP(I_BF) + l * 8;
          LAS bf16* Whi = (LAS bf16*)lds; LAS bf16* Wlo = Whi + 8 * RPITCH; LAS float* Pex = (LAS float*)(lds + 2 * 8 * RPITCH * 2);
          { f32x4 wv_[4];
#pragma unroll
            for (int j = 0; j < 4; ++j) wv_[j] = *(const f32x4*)(wfg + 4 * (tid + 512 * j));
#pragma unroll
            for (int j = 0; j < 4; ++j) { const int i = 4 * (tid + 512 * j), c = i >> 10, k = i & 1023; u32x2 hw, lw; float hf[4];
#pragma unroll
                for (int e = 0; e < 4; ++e) hf[e] = __builtin_bit_cast(float, (pk2(wv_[j][e], 0.f) & 0xffffu) << 16);
                hw.x = pk2(wv_[j][0], wv_[j][1]); hw.y = pk2(wv_[j][2], wv_[j][3]); lw.x = pk2(wv_[j][0] - hf[0], wv_[j][1] - hf[1]); lw.y = pk2(wv_[j][2] - hf[2], wv_[j][3] - hf[3]);
                *(LAS u32x2*)(Whi + c * RPITCH + k) = hw; *(LAS u32x2*)(Wlo + c * RPITCH + k) = lw; } }
          const int g = wave & 3, kh = wave >> 2, rr = 16 * g + fr, row = row0 + rr;
          bf16x8 af[16];
#pragma unroll
          for (int s2 = 0; s2 < 16; ++s2) af[s2] = *(const bf16x8*)(HB + (size_t)row * D + 32 * (16 * kh + s2) + 8 * fq);
          const float rs1 = rstd1[row];
          __syncthreads();
          f32x4 acc = {0.f, 0.f, 0.f, 0.f};
#pragma unroll
          for (int s2 = 0; s2 < 16; ++s2) { const int k = 32 * (16 * kh + s2) + 8 * fq;
              bf16x8 wh = *(const LAS bf16x8*)(Whi + (fr & 7) * RPITCH + k), wl = *(const LAS bf16x8*)(Wlo + (fr & 7) * RPITCH + k);
              if (fr >= 8) { wh = (bf16x8){0, 0, 0, 0, 0, 0, 0, 0}; wl = wh; }
              acc = __builtin_amdgcn_mfma_f32_16x16x32_bf16(wh, af[s2], acc, 0, 0, 0); acc = __builtin_amdgcn_mfma_f32_16x16x32_bf16(wl, af[s2], acc, 0, 0, 0); }
          if (kh == 1) *(LAS f32x4*)(Pex + (g * 64 + lane) * 4) = acc;
          __syncthreads();
          if (kh == 0) { const f32x4 o4 = *(const LAS f32x4*)(Pex + (g * 64 + lane) * 4); acc += o4;
              if (fq < 2 && rr < nrows && row < TR) {
#pragma unroll
                  for (int i = 0; i < 4; ++i) { const int hd = 4 * fq + i; const float xg = acc[i] * rs1 + bfg[hd]; const float lf = fminf(xg, 0.f) - 0.69314718056f * __builtin_amdgcn_logf(1.0f + __expf(-fabsf(xg)));
                      if (isx) LFT[(size_t)(b * 8 + hd) * SEQ + t0 + rr] = lf; else LFTM[hd * 256 + t0 + rr] = lf; } } }
          __syncthreads(); }
    }
}
constexpr int PC_TG = 0, PC_TA = 31744, PC_YT = 31744, PC_HALF = 64512;
__device__ __forceinline__ void pc_load(Frame& F, int it32, u32x4 (&ta)[6], u32x4 (&tg)[8]) {
    const bool isx = it32 < 1024; const int b = isx ? (it32 * 32) / SEQ : 0; const int t0 = isx ? (it32 * 32) % SEQ : 0; const int nrows = isx ? 32 : NMETA;
    unsigned char* ws = WSP(); int tid = F.tid & 255; LAUNDER_V(tid);
    const bf16* Ab = (const bf16*)(ws + WS_A); const bf16* GLU = (const bf16*)(ws + WS_GLU);
    const int nla = (15 + nrows) * 32, nlg = (isx ? 62 : 46) * 32;
#pragma unroll
    for (int j = 0; j < 6; ++j) { const int i = tid + 256 * j; const int sl = i >> 5, ch = i & 31; const int r = i < nla ? srcrow(isx, b, t0 + sl - 15) : -1; unsigned z_ = 0u; LAUNDER_V(z_);
        ta[j] = r >= 0 ? *(const u32x4*)(Ab + (size_t)r * 256 + ch * 8) : (u32x4){z_, z_, z_, z_}; }
#pragma unroll
    for (int j = 0; j < 8; ++j) { const int i = tid + 256 * j; const int sl = i >> 5, ch = i & 31; const int r = i < nlg ? srcrow(isx, b, t0 + sl - 30) : -1; unsigned z_ = 0u; LAUNDER_V(z_);
        tg[j] = r >= 0 ? *(const u32x4*)(GLU + (size_t)r * 256 + ch * 8) : (u32x4){z_, z_, z_, z_}; }
}
__device__ __forceinline__ void phase_poolconv(Frame& F, int l, const unsigned* stopc) {
    const int hw = F.wave >> 2, hwave = F.wave & 3; LAS unsigned char* lds = F.lds + hw * PC_HALF;
    LAS int* qs = (LAS int*)(F.lds + LC_QS); unsigned* head3 = (unsigned*)(WSP() + WS_CTL) + CW_AQ + 48 + l * 64;
    const int tid = F.tid & 255, cp = tid & 127, strip = tid >> 7, lane = F.tid & 63;
    f32x2 wv[31]; f32x2 bias;
    { const float* cw = INP(I_CW) + (size_t)l * 31 * 256; const float* cb = INP(I_CB) + l * 256;
#pragma unroll
      for (int j = 0; j < 31; ++j) wv[j] = *(const f32x2*)(cw + j * 256 + 2 * cp);
      bias = *(const f32x2*)(cb + 2 * cp); }
    const f32x4 gg0 = *(const f32x4*)(INP(I_LNG) + l * 256 + 8 * (lane & 31)), gg1 = *(const f32x4*)(INP(I_LNG) + l * 256 + 8 * (lane & 31) + 4), bb0 = *(const f32x4*)(INP(I_LNB) + l * 256 + 8 * (lane & 31)), bb1 = *(const f32x4*)(INP(I_LNB) + l * 256 + 8 * (lane & 31) + 4);
    __syncthreads();
    if (F.tid == 0) { const bool stop = stopc && __hip_atomic_load(stopc, __ATOMIC_RELAXED, __HIP_MEMORY_SCOPE_AGENT) >= 32u; qs[0] = stop ? 513 : (int)atomicAdd(head3, 1u); }
    __syncthreads();
    int it = __builtin_amdgcn_readfirstlane(qs[0]);
    u32x4 ta[6], tg[8];
    if (it < 513) { const int i32 = 2 * it + hw; pc_load(F, i32 < 1024 ? i32 : 1024, ta, tg); }
#pragma unroll 1
    while (it < 513) {
        const int i32 = 2 * it + hw, it32 = i32 < 1024 ? i32 : 1024;
        const bool isx = it32 < 1024; const int row0 = isx ? it32 * 32 : TX; const int t0 = isx ? (it32 * 32) % SEQ : 0; const int nrows = isx ? 32 : NMETA;
        LAS unsigned char* Ta = lds + PC_TA; LAS unsigned char* Tg = lds + PC_TG; LAS float* Yt = (LAS float*)(lds + PC_YT);
#pragma unroll
        for (int j = 0; j < 6; ++j) { const int i = tid + 256 * j; if (i < 47 * 32) *(LAS u32x4*)(Ta + (i >> 5) * 512 + (i & 31) * 16) = ta[j]; }
#pragma unroll
        for (int j = 0; j < 8; ++j) { const int i = tid + 256 * j; if (i < 62 * 32) *(LAS u32x4*)(Tg + (i >> 5) * 512 + (i & 31) * 16) = tg[j]; }
        if (F.tid == 0) { const bool stop = stopc && __hip_atomic_load(stopc, __ATOMIC_RELAXED, __HIP_MEMORY_SCOPE_AGENT) >= 32u; qs[0] = stop ? 513 : (int)atomicAdd(head3, 1u); }
        __syncthreads();
        const int nxt = __builtin_amdgcn_readfirstlane(qs[0]);
        if (nxt < 513) { const int n32 = 2 * nxt + hw; pc_load(F, n32 < 1024 ? n32 : 1024, ta, tg); }
        { bf16* DIFF = (bf16*)(WSP() + WS_X3); const int ch = tid & 31, r0 = (tid >> 5) * 4, grp = ch >> 3, w = 2 << grp;
          if (r0 < nrows) {
              float sm[8];
#pragma unroll
              for (int j = 0; j < 8; ++j) sm[j] = 0.f;
#pragma unroll 1
              for (int d = 1; d < w; ++d) { const u32x4 v = *(const LAS u32x4*)(Ta + (15 + r0 - d) * 512 + ch * 16);
                  sm[0] += bflo(v.x); sm[1] += bfhi(v.x); sm[2] += bflo(v.y); sm[3] += bfhi(v.y); sm[4] += bflo(v.z); sm[5] += bfhi(v.z); sm[6] += bflo(v.w); sm[7] += bfhi(v.w); }
#pragma unroll
              for (int rr = 0; rr < 4; ++rr) { const int r = r0 + rr;
                  const u32x4 a = *(const LAS u32x4*)(Ta + (15 + r) * 512 + ch * 16);
                  sm[0] += bflo(a.x); sm[1] += bfhi(a.x); sm[2] += bflo(a.y); sm[3] += bfhi(a.y); sm[4] += bflo(a.z); sm[5] += bfhi(a.z); sm[6] += bflo(a.w); sm[7] += bfhi(a.w);
                  const int cnt = isx ? w : min(t0 + r + 1, w); const float ic = 1.0f / (float)cnt;
                  u32x4 o; o.x = pk2(sm[0] * ic - bflo(a.x), sm[1] * ic - bfhi(a.x)); o.y = pk2(sm[2] * ic - bflo(a.y), sm[3] * ic - bfhi(a.y));
                  o.z = pk2(sm[4] * ic - bflo(a.z), sm[5] * ic - bfhi(a.z)); o.w = pk2(sm[6] * ic - bflo(a.w), sm[7] * ic - bfhi(a.w));
                  if (row0 + r < TR) *(u32x4*)(DIFF + (size_t)(row0 + r) * 1024 + ch * 8) = o;
                  const u32x4 q = *(const LAS u32x4*)(Ta + (15 + r + 1 - w) * 512 + ch * 16);
                  sm[0] -= bflo(q.x); sm[1] -= bfhi(q.x); sm[2] -= bflo(q.y); sm[3] -= bfhi(q.y); sm[4] -= bflo(q.z); sm[5] -= bfhi(q.z); sm[6] -= bflo(q.w); sm[7] -= bfhi(q.w); } } }
        { const int rb = 16 * strip; f32x2 acc[16];
#pragma unroll
          for (int r = 0; r < 16; ++r) acc[r] = bias;
#pragma unroll
          for (int i = 0; i < 46; ++i) { const unsigned xw = *(const LAS unsigned*)(Tg + (rb + i) * 512 + cp * 4); const f32x2 xx = {bflo(xw), bfhi(xw)};
#pragma unroll
              for (int r = 0; r < 16; ++r) { const int j = i - r; if (j >= 0 && j <= 30) acc[r] += wv[j] * xx; } }
          __syncthreads();
#pragma unroll
          for (int r = 0; r < 16; ++r) *(LAS f32x2*)(Yt + (rb + r) * 256 + 2 * cp) = acc[r]; }
        __syncthreads();
        { bf16* BP = (bf16*)(WSP() + WS_X3) + 256; const int half = lane >> 5, c8 = lane & 31;
#pragma unroll
          for (int i4 = 0; i4 < 4; ++i4) { const int rr = hwave + 4 * (2 * i4 + half);
            const f32x4 v0 = *(const LAS f32x4*)(Yt + rr * 256 + 8 * c8), v1 = *(const LAS f32x4*)(Yt + rr * 256 + 8 * c8 + 4);
            float sm = ((v0[0] + v0[1]) + (v0[2] + v0[3])) + ((v1[0] + v1[1]) + (v1[2] + v1[3]));
            sm += lane_xor<1>(sm); sm += lane_xor<2>(sm); sm += lane_xor<4>(sm); sm += lane_xor<8>(sm); sm = sum_x16(sm);
            const float mean = sm * (1.0f / 256.0f); const f32x4 d0 = v0 - mean, d1 = v1 - mean;
            float sq = ((d0[0] * d0[0] + d0[1] * d0[1]) + (d0[2] * d0[2] + d0[3] * d0[3])) + ((d1[0] * d1[0] + d1[1] * d1[1]) + (d1[2] * d1[2] + d1[3] * d1[3]));
            sq += lane_xor<1>(sq); sq += lane_xor<2>(sq); sq += lane_xor<4>(sq); sq += lane_xor<8>(sq); sq = sum_x16(sq);
            const float rs = rsqrtf(sq * (1.0f / 256.0f) + EPS);
            f32x4 o0 = d0 * rs * gg0 + bb0, o1 = d1 * rs * gg1 + bb1;
#pragma unroll
            for (int j = 0; j < 4; ++j) { o0[j] = o0[j] * sigmoidf_(o0[j]); o1[j] = o1[j] * sigmoidf_(o1[j]); }
            if (rr < nrows && row0 + rr < TR) *(u32x4*)(BP + (size_t)(row0 + rr) * 1024 + 8 * c8) = pack8(o0, o1); } }
        __syncthreads();
        it = nxt;
    }
}
constexpr int AT_FL = 0, AT_K = 34816, AT_VT = AT_K + 8192, AT_SC = AT_VT + 8192;
__device__ __forceinline__ void attn_scan(Frame& F, int b, int h, bool meta_only, int fl_off, int sc_off) {
    LAS float* Fl = (LAS float*)(F.lds + fl_off); LAS float* sc = (LAS float*)(F.lds + sc_off);
    const float* LFT = (const float*)(WSP() + WS_LFT); const float* LFTM = (const float*)(WSP() + WS_LFTM);
    const int tid = F.tid, lane = F.lane, wave = F.wave;
    __syncthreads();
    if (tid == 0) { float s = 0.f; for (int m = 0; m < 64; ++m) { if (m < NMETA) { s += LFTM[h * 256 + m]; Fl[m] = s * LOG2E; } else Fl[m] = 1e30f; if (m == NMETA - 1) sc[16] = s; } }
    if (meta_only) { for (int i = tid; i < 256; i += 512) Fl[64 + i] = 0.f; __syncthreads(); return; }
    float v[16]; const float* src = LFT + (size_t)(b * 8 + h) * SEQ + 16 * tid;
#pragma unroll
    for (int j = 0; j < 4; ++j) { const f32x4 q = *(const f32x4*)(src + 4 * j); v[4 * j] = q[0]; v[4 * j + 1] = q[1]; v[4 * j + 2] = q[2]; v[4 * j + 3] = q[3]; }
#pragma unroll
    for (int j = 1; j < 16; ++j) v[j] += v[j - 1];
    float incl = v[15];
#pragma unroll
    for (int o = 1; o < 64; o <<= 1) { const float up = __int_as_float(__builtin_amdgcn_ds_bpermute((lane - o) << 2, __float_as_int(incl))); if (lane >= o) incl += up; }
    if (lane == 63) sc[wave] = incl;
    __syncthreads();
    float off = sc[16];
    for (int w = 0; w < wave; ++w) off += sc[w];
    off += incl - v[15];
#pragma unroll
    for (int j = 0; j < 16; ++j) Fl[64 + 16 * tid + j] = (off + v[j]) * LOG2E;
    __syncthreads();
}
__device__ __forceinline__ void attn_unit_naive(Frame& F, int qrow0, int qpos0, int ntiles, int kvx0, int h, int nq) {
    const int tid = F.tid; const int hf = tid & 1; const bool live = (tid >> 1) < nq; const int r = live ? (tid >> 1) : 0;
    const bf16* Q = (const bf16*)(DOP() + DO_Q); const bf16* Kg = (const bf16*)(DOP() + DO_K); const bf16* Vg = (const bf16*)(DOP() + DO_V); bf16* O = (bf16*)(WSP() + WS_X3) + 512;
    LAS float* Fl = (LAS float*)(F.lds + AT_FL); LAS unsigned char* Ks = F.lds + AT_K; LAS bf16* VT = (LAS bf16*)(F.lds + AT_VT);
    const int grow = qrow0 + r, qpos = qpos0 + r;
    unsigned qp[16];
#pragma unroll
    for (int j = 0; j < 4; ++j) { const u32x4 w = *(const u32x4*)(Q + (size_t)grow * 512 + h * 64 + hf * 32 + 8 * j); qp[4 * j] = w.x; qp[4 * j + 1] = w.y; qp[4 * j + 2] = w.z; qp[4 * j + 3] = w.w; }
    const float Fq = Fl[qpos < NMETA ? qpos : qpos + 48];
    float mrun = -1e30f, lrun = 0.f, o[32];
#pragma unroll
    for (int d = 0; d < 32; ++d) o[d] = 0.f;
    const int lrow = tid >> 3, lch = tid & 7;

#pragma unroll 1
for (int i = 0; i < ntiles; ++i) {
        const int krow = (i == 0 ? TX : kvx0 + 64 * (i - 1)) + lrow;
        const u32x4 kw = *(const u32x4*)(Kg + (size_t)krow * 512 + h * 64 + lch * 8);
        const u32x4 vw = *(const u32x4*)(Vg + (size_t)krow * 512 + h * 64 + lch * 8);
        __syncthreads();
        *(LAS u32x4*)(Ks + lrow * 128 + lch * 16) = kw;
        { const unsigned vv[4] = {vw.x, vw.y, vw.z, vw.w};
#pragma unroll
          for (int e = 0; e < 4; ++e) { VT[(lch * 8 + 2 * e) * 64 + lrow] = (bf16)(vv[e] & 0xffffu); VT[(lch * 8 + 2 * e + 1) * 64 + lrow] = (bf16)(vv[e] >> 16); } }
        __syncthreads();
        const int kp0 = i == 0 ? 0 : NMETA + 64 * (i - 1);
        if (kp0 > qpos0 + 255) continue;
#pragma unroll 1
        for (int jg = 0; jg < 4; ++jg) {
            float s[16]; float gmax = -1e30f;
#pragma unroll
            for (int jj = 0; jj < 16; ++jj) { const int j = jg * 16 + jj; float d = 0.f;
#pragma unroll
                for (int c = 0; c < 4; ++c) { const u32x4 kk = *(const LAS u32x4*)(Ks + j * 128 + hf * 64 + c * 16);
                    d = dot2bf(kk.x, qp[4 * c], d); d = dot2bf(kk.y, qp[4 * c + 1], d); d = dot2bf(kk.z, qp[4 * c + 2], d); d = dot2bf(kk.w, qp[4 * c + 3], d); }
                d += lane_xor<1>(d);
                const bool valid = (i == 0 ? j < NMETA : true) && (kp0 + j <= qpos);
                s[jj] = valid ? d + Fq - Fl[64 * i + j] : -1e30f; gmax = fmaxf(gmax, s[jj]); }
            const float mn = fmaxf(mrun, gmax), alpha = exp2f(mrun - mn); mrun = mn;
            float ps = 0.f; unsigned pp[8];
#pragma unroll
            for (int jj = 0; jj < 16; jj += 2) { const float p0 = exp2f(s[jj] - mn), p1 = exp2f(s[jj + 1] - mn); ps += p0 + p1; pp[jj >> 1] = pk2(p0, p1); }
            lrun = lrun * alpha + ps;
#pragma unroll
            for (int d = 0; d < 32; ++d) { const u32x4 v0 = *(const LAS u32x4*)(VT + (hf * 32 + d) * 64 + jg * 16), v1 = *(const LAS u32x4*)(VT + (hf * 32 + d) * 64 + jg * 16 + 8);
                float a = o[d] * alpha; a = dot2bf(pp[0], v0.x, a); a = dot2bf(pp[1], v0.y, a); a = dot2bf(pp[2], v0.z, a); a = dot2bf(pp[3], v0.w, a);
                a = dot2bf(pp[4], v1.x, a); a = dot2bf(pp[5], v1.y, a); a = dot2bf(pp[6], v1.z, a); a = dot2bf(pp[7], v1.w, a); o[d] = a; }
        }
    }
    const float il = 1.0f / lrun;
    if (live)
#pragma unroll
    for (int j = 0; j < 4; ++j) { u32x4 w; w.x = pk2(o[8 * j] * il, o[8 * j + 1] * il); w.y = pk2(o[8 * j + 2] * il, o[8 * j + 3] * il); w.z = pk2(o[8 * j + 4] * il, o[8 * j + 5] * il); w.w = pk2(o[8 * j + 6] * il, o[8 * j + 7] * il);
        *(u32x4*)(O + (size_t)grow * 1024 + h * 64 + hf * 32 + 8 * j) = w; }
}
namespace fa {
using bf16x8v = __attribute__((ext_vector_type(8))) short;
using s16x4 = __attribute__((ext_vector_type(4))) short;
using f32x16 = __attribute__((ext_vector_type(16))) float;
constexpr int DMA = 512, DMO = 1024;
constexpr int NW = 8, QBLK = 32, QB = 256, KVBLK = 64;
constexpr int NSLOT = 3, SLOTB = 8192;
constexpr int LDS_K = 0, LDS_V = NSLOT * SLOTB, LDS_WS = 2 * NSLOT * SLOTB, LDS_OST = LDS_WS + NW * 64 * 4, LDS_BYTES = LDS_OST + NW * 4096;
constexpr int LDS_FL = 84992;
constexpr int LDS_SCAN = LDS_FL + (64 + 8192) * 4;
static_assert(LDS_SCAN + 128 <= RING_BYTES, "attention LDS");
__device__ __forceinline__ int crow(int r, int hi) { return (r & 3) + 8 * (r >> 2) + 4 * hi; }
#define SBAR() __builtin_amdgcn_sched_barrier(0)
__device__ __forceinline__ void cmask(f32x16& p0, f32x16& p1, int jb, int qrel, int hi) {
    const float NEG = -INFINITY; int kb = 64 * jb + 4 * hi;
#pragma unroll
    for (int r = 0; r < 16; ++r) { int kv = kb + (r & 3) + 8 * (r >> 2); if (kv > qrel) p0[r] = NEG; if (kv + 32 > qrel) p1[r] = NEG; }
}
__device__ __forceinline__ void glds16(const void* gsrc, unsigned lds_dst) { unsigned keep;
    asm volatile("s_mov_b32 %0, m0\n\ts_mov_b32 m0, %2\n\ts_nop 0\n\tglobal_load_lds_dwordx4 %1, off\n\ts_mov_b32 m0, %0" : "=&s"(keep) : "v"(gsrc), "s"(lds_dst) : "memory"); }
__device__ __forceinline__ float max3f(float a, float b, float c) { float r; asm("v_max3_f32 %0, %1, %2, %3" : "=v"(r) : "v"(a), "v"(b), "v"(c)); return r; }
__device__ __forceinline__ float max2f(float a, float b) { float r; asm("v_max_f32_e32 %0, %1, %2" : "=v"(r) : "v"(a), "v"(b)); return r; }
__device__ __forceinline__ float fsub_s(float a, float b) { float r; asm("v_sub_f32_e32 %0, %1, %2" : "=v"(r) : "v"(a), "v"(b)); return r; }
typedef float f32x2_t __attribute__((ext_vector_type(2))); typedef __bf16 bf16x2_t __attribute__((ext_vector_type(2)));
__device__ __forceinline__ unsigned cvtpk_s(float lo, float hi) { f32x2_t v = {lo, hi}; bf16x2_t b = __builtin_convertvector(v, bf16x2_t); return __builtin_bit_cast(unsigned, b); }
#define WAIT_BAR(N) asm volatile("s_waitcnt vmcnt(" #N ") lgkmcnt(0)\n\ts_barrier" ::: "memory")
typedef __attribute__((address_space(3))) const char* lds_cptr;
typedef short v4i16_t __attribute__((ext_vector_type(4)));
__device__ __forceinline__ void cinit(f32x16& p0, f32x16& p1, const LAS float* fk, float a) {
#pragma unroll
    for (int g = 0; g < 4; ++g) { const f32x4 f0 = *(const LAS f32x4*)(fk + 8 * g), f1 = *(const LAS f32x4*)(fk + 32 + 8 * g);
#pragma unroll
        for (int i = 0; i < 4; ++i) { p0[4 * g + i] = a - f0[i]; p1[4 * g + i] = a - f1[i]; } }
}
__device__ __forceinline__ void qkt(f32x16& p0, f32x16& p1, const char* Kslot, const bf16x8v* qr, int r32, int hi) {
    const char* kb = Kslot + hi * 1024 + r32 * 16;
#pragma unroll
    for (int d0 = 0; d0 < 4; ++d0) {
        const bf16x8v b0 = *reinterpret_cast<const bf16x8v*>(kb + d0 * 2048);
        const bf16x8v b1 = *reinterpret_cast<const bf16x8v*>(kb + d0 * 2048 + 512);
        p0 = __builtin_amdgcn_mfma_f32_32x32x16_bf16(b0, qr[d0], p0, 0, 0, 0); p1 = __builtin_amdgcn_mfma_f32_32x32x16_bf16(b1, qr[d0], p1, 0, 0, 0); }
}
__device__ __forceinline__ void kload8(bf16x8v* kf, lds_cptr kp) {
    kf[0] = *(const LAS bf16x8v*)(kp);        kf[1] = *(const LAS bf16x8v*)(kp + 512);
    kf[2] = *(const LAS bf16x8v*)(kp + 2048); kf[3] = *(const LAS bf16x8v*)(kp + 2560);
    kf[4] = *(const LAS bf16x8v*)(kp + 4096); kf[5] = *(const LAS bf16x8v*)(kp + 4608);
    kf[6] = *(const LAS bf16x8v*)(kp + 6144); kf[7] = *(const LAS bf16x8v*)(kp + 6656);
}
__device__ __forceinline__ void kload2(bf16x8v* kf, lds_cptr kp, int j) { kf[2 * j] = *(const LAS bf16x8v*)(kp + j * 2048); kf[2 * j + 1] = *(const LAS bf16x8v*)(kp + j * 2048 + 512); }
__device__ __forceinline__ s16x4 vtr(lds_cptr p) { return __builtin_bit_cast(s16x4, __builtin_amdgcn_ds_read_tr16_b64_v4i16((LAS v4i16_t*)p)); }
__device__ __forceinline__ float rowmax(const f32x16& p0, const f32x16& p1) {
    float a = max3f(p0[0], p0[1], p1[0]), b = max3f(p0[2], p0[3], p1[1]); a = max3f(a, p1[2], p1[3]);
#pragma unroll
    for (int r = 4; r < 16; r += 4) { a = max3f(a, p0[r], p0[r + 1]); b = max3f(b, p0[r + 2], p0[r + 3]); a = max3f(a, p1[r], p1[r + 1]); b = max3f(b, p1[r + 2], p1[r + 3]); }
    const float m = max2f(a, b);
    auto rr = __builtin_amdgcn_permlane32_swap(__float_as_uint(m), __float_as_uint(m), false, false);
    return max2f(__uint_as_float(rr[0]), __uint_as_float(rr[1]));
}
__device__ __forceinline__ void pv(f32x16* o, int vb, bf16x8v pa0, bf16x8v pa1, bf16x8v pa2, bf16x8v pa3) {
#pragma unroll
    for (int d0 = 0; d0 < 2; ++d0) { s16x4 lo[4], hi[4];
#pragma unroll
        for (int ks = 0; ks < 4; ++ks) {
            asm volatile("ds_read_b64_tr_b16 %0,%1 offset:%c2" : "=&v"(lo[ks]) : "v"(vb), "i"(d0 * 4096 + ks * 1024) : "memory");
            asm volatile("ds_read_b64_tr_b16 %0,%1 offset:%c2" : "=&v"(hi[ks]) : "v"(vb), "i"(d0 * 4096 + ks * 1024 + 512) : "memory"); }
        asm volatile("s_waitcnt lgkmcnt(0)" ::: "memory"); SBAR();
#define PK(k) (bf16x8v){lo[k][0], lo[k][1], lo[k][2], lo[k][3], hi[k][0], hi[k][1], hi[k][2], hi[k][3]}
        o[d0] = __builtin_amdgcn_mfma_f32_32x32x16_bf16(pa0, PK(0), o[d0], 0, 0, 0);
        o[d0] = __builtin_amdgcn_mfma_f32_32x32x16_bf16(pa1, PK(1), o[d0], 0, 0, 0);
        o[d0] = __builtin_amdgcn_mfma_f32_32x32x16_bf16(pa2, PK(2), o[d0], 0, 0, 0);
        o[d0] = __builtin_amdgcn_mfma_f32_32x32x16_bf16(pa3, PK(3), o[d0], 0, 0, 0);
#undef PK
    }
}
template <int THRL> __device__ __forceinline__ void attn_unit(int b, int h, int qb, int tf, const bf16* Q, const bf16* __restrict__ K, const bf16* __restrict__ V, bf16* O, char* shm, int wid) {
    const int lane = lane_id_opaque(), r32 = lane & 31, hi = lane >> 5;
    const long rowbase = (long)b * SEQ; const int q0 = qb * QB;
    const bf16* Qw = Q + (rowbase + q0 + wid * QBLK) * DMA + h * 64;
    const bf16* Kh = K + rowbase * DMA + h * 64, *Vh = V + rowbase * DMA + h * 64;
    const bf16* Km = K + (long)TX * DMA + h * 64, *Vm = V + (long)TX * DMA + h * 64;
    const unsigned lds0 = (unsigned)(uintptr_t)shm;
    float* wsf = (float*)(shm + LDS_WS) + wid * 64;
    const bf16* ksrc = Kh + (long)lane * DMA + wid * 8;
    const bf16* vsrc = Vh + (long)(16 * (wid & 3) + (lane >> 2)) * DMA + (wid >> 2) * 32 + (lane & 3) * 8;
    const bf16* ksrcm = Km + (long)lane * DMA + wid * 8;
    const bf16* vsrcm = Vm + (long)(16 * (wid & 3) + (lane >> 2)) * DMA + (wid >> 2) * 32 + (lane & 3) * 8;
    const unsigned kdst = lds0 + LDS_K + wid * 1024, vdst = lds0 + LDS_V + wid * 1024;
#define DMA_K(t, slot) glds16(ksrc + (long)((t) - 1) * KVBLK * DMA, (unsigned)__builtin_amdgcn_readfirstlane(kdst + (slot)))
#define DMA_V(t, slot) glds16(vsrc + (long)((t) - 1) * KVBLK * DMA, (unsigned)__builtin_amdgcn_readfirstlane(vdst + (slot)))
    const int vb0 = (int)(lds0 + LDS_V) + ((lane >> 4) & 1) * 32 + (lane & 3) * 8 + (4 * hi + ((lane & 15) >> 2)) * 64;
    const char* Kbase = shm + LDS_K; bf16x8v kf[8];
    const lds_cptr shm3 = (lds_cptr)shm; const lds_cptr kp0 = shm3 + LDS_K + hi * 1024 + r32 * 16; const lds_cptr vp0 = shm3 + LDS_V + ((lane >> 4) & 1) * 32 + (lane & 3) * 8 + (4 * hi + ((lane & 15) >> 2)) * 64;
    const LAS float* Flp = (const LAS float*)(shm3 + LDS_FL) + 4 * hi;
    const int NT = 4 * qb + 5;
    glds16(tf == 0 ? ksrcm : ksrc + (long)(tf - 1) * KVBLK * DMA, (unsigned)__builtin_amdgcn_readfirstlane(kdst)); glds16(tf == 0 ? vsrcm : vsrc + (long)(tf - 1) * KVBLK * DMA, (unsigned)__builtin_amdgcn_readfirstlane(vdst)); DMA_K(tf + 1, SLOTB);
    bf16x8v qr[4];
#pragma unroll
    for (int d0 = 0; d0 < 4; ++d0) qr[d0] = *reinterpret_cast<const bf16x8v*>(&Qw[(long)r32 * DMA + d0 * 16 + hi * 8]);
    float aq = ((const LAS float*)(shm3 + LDS_FL))[64 + q0 + wid * QBLK + r32 - 64 * tf];
    float l_reg = 0.f; f32x16 o[2]; o[0] = f32x16{}; o[1] = f32x16{};
    const int qrel = wid * QBLK + r32;
#define CMASK(P0, P1, t) do { int jb_ = (t) - (NT - 4); if (jb_ >= 0) cmask(P0, P1, jb_, qrel, hi); } while (0)
    bool resc = false;
#define START(P0, P1) do { const float rm = rowmax(P0, P1); resc = false; \
    { const float dl = max2f(rm, 0.f); aq = fsub_s(aq, dl);        \
      _Pragma("unroll") for (int r = 0; r < 16; ++r) { P0[r] = fsub_s(P0[r], dl); P1[r] = fsub_s(P1[r], dl); } } \
    _Pragma("unroll") for (int r = 0; r < 16; ++r) P0[r] = __builtin_amdgcn_exp2f(P0[r]); } while (0)
#define RESC() do { if (resc) { asm volatile("s_waitcnt lgkmcnt(0)" ::: "memory"); \
      _Pragma("unroll") for (int d_ = 0; d_ < 2; ++d_) _Pragma("unroll") for (int r = 0; r < 16; ++r) o[d_][r] *= wsf[crow(r, hi)]; } } while (0)
    f32x16 pA0, pA1, pB0, pB1;
    int sl_prev = 0, sl_cur = 0, sl_next = SLOTB;
#define ROT() do { sl_prev = sl_cur; sl_cur = sl_next; sl_next = (sl_next == (NSLOT - 1) * SLOTB) ? 0 : sl_next + SLOTB; } while (0)
    DMA_K(tf + 2, 2 * SLOTB);
    cinit(pA0, pA1, Flp, aq);
    WAIT_BAR(3);
    qkt(pA0, pA1, Kbase, qr, r32, hi); asm volatile("s_nop 15\n\ts_nop 7" : "+v"(pA0), "+v"(pA1));
    START(pA0, pA1);
    _Pragma("unroll") for (int r = 0; r < 16; ++r) pA1[r] = __builtin_amdgcn_exp2f(pA1[r]);
    WAIT_BAR(0);
    DMA_K(tf + 3, 0); DMA_V(tf + 1, SLOTB);
    ROT();
    kload8(kf, kp0 + sl_cur);
    WAIT_BAR(2);
    s16x4 vlo[8], vhi[8]; u32x4 pw0, pw1, pw2, pw3;
#define PKW(P, B) cvtpk_s(P[B], P[B + 1])
#define PAF(k) __builtin_bit_cast(bf16x8v, pw##k)
#define VFR(i) (bf16x8v){vlo[i][0], vlo[i][1], vlo[i][2], vlo[i][3], vhi[i][0], vhi[i][1], vhi[i][2], vhi[i][3]}
#define PIN(x) asm volatile("" : "+v"(x))
#define MX3(a, b, c) __builtin_fmaxf(__builtin_fmaxf((a), (b)), (c))
#define GAPA(MF, A0, A1, A2, A3, W0, W1, PW) do { MF; sacc += A0; sacc += A1; sacc += A2; sacc += A3; PIN(sacc); W0; W1; PIN(PW); SBAR(); } while (0)
#define EX(v) __builtin_amdgcn_exp2f(v)
#define GAPB(MF, X, B) do { MF; X[B] = EX(X[B]); X[B + 1] = EX(X[B + 1]); X[B + 2] = EX(X[B + 2]); X[B + 3] = EX(X[B + 3]); PIN(X); SBAR(); } while (0)
#define VRD(i) do { vlo[i] = vtr(vp_ + (((i) >> 2) * 4096 + ((i) & 3) * 1024)); vhi[i] = vtr(vp_ + (((i) >> 2) * 4096 + ((i) & 3) * 1024 + 512)); } while (0)
#define KRD(G, j) do { if (G) { kload2(kf, kp0 + sl_next, j); SBAR(); } } while (0)
#define STEP(C0, C1, P0, P1, t, GK, GV, GL) do { SBAR(); \
    cinit(C0, C1, Flp + 64 * ((t) - tf), aq); SBAR(); \
    const lds_cptr vp_ = vp0 + sl_prev; \
    VRD(0); SBAR(); float sacc = (P0[0] + P0[1]); \
    GAPA(C0 = __builtin_amdgcn_mfma_f32_32x32x16_bf16(kf[0], qr[0], C0, 0, 0, 0), P0[2], P0[3], P0[4], P0[5],     pw0[0] = PKW(P0, 0), pw0[1] = PKW(P0, 2), pw0); \
    VRD(4); SBAR(); GAPA(C1 = __builtin_amdgcn_mfma_f32_32x32x16_bf16(kf[1], qr[0], C1, 0, 0, 0), P0[6], P0[7], P0[8], P0[9],     pw0[2] = PKW(P0, 4), pw0[3] = PKW(P0, 6), pw0); \
    VRD(1); SBAR(); GAPA(C0 = __builtin_amdgcn_mfma_f32_32x32x16_bf16(kf[2], qr[1], C0, 0, 0, 0),   P0[10], P0[11], P0[12], P0[13], pw1[0] = PKW(P0, 8), pw1[1] = PKW(P0, 10), pw1); \
    VRD(5); SBAR(); GAPA(C1 = __builtin_amdgcn_mfma_f32_32x32x16_bf16(kf[3], qr[1], C1, 0, 0, 0),   P0[14], P0[15], P1[0], P1[1],   pw1[2] = PKW(P0, 12), pw1[3] = PKW(P0, 14), pw1); \
    VRD(2); SBAR(); GAPA(C0 = __builtin_amdgcn_mfma_f32_32x32x16_bf16(kf[4], qr[2], C0, 0, 0, 0),   P1[2], P1[3], P1[4], P1[5],     pw2[0] = PKW(P1, 0), pw2[1] = PKW(P1, 2), pw2); \
    VRD(6); SBAR(); GAPA(C1 = __builtin_amdgcn_mfma_f32_32x32x16_bf16(kf[5], qr[2], C1, 0, 0, 0),   P1[6], P1[7], P1[8], P1[9],     pw2[2] = PKW(P1, 4), pw2[3] = PKW(P1, 6), pw2); \
    VRD(3); SBAR(); GAPA(C0 = __builtin_amdgcn_mfma_f32_32x32x16_bf16(kf[6], qr[3], C0, 0, 0, 0),   P1[10], P1[11], P1[12], P1[13], pw3[0] = PKW(P1, 8), pw3[1] = PKW(P1, 10), pw3); \
    VRD(7); SBAR(); GAPA(C1 = __builtin_amdgcn_mfma_f32_32x32x16_bf16(kf[7], qr[3], C1, 0, 0, 0),   P1[14], P1[15], 0.f, 0.f,       pw3[2] = PKW(P1, 12), pw3[3] = PKW(P1, 14), pw3); \
    l_reg += sacc; \
    if (GK) { DMA_K((t) + 3, sl_cur); } if (GV) { DMA_V((t) + 1, sl_next); } \
    CMASK(C0, C1, t); \
    { float a = MX3(C0[0], C0[1], C1[0]), b_ = MX3(C0[2], C0[3], C1[1]); a = MX3(a, C1[2], C1[3]); \
      _Pragma("unroll") for (int r = 4; r < 16; r += 4) { a = MX3(a, C0[r], C0[r + 1]); b_ = MX3(b_, C0[r + 2], C0[r + 3]); a = MX3(a, C1[r], C1[r + 1]); b_ = MX3(b_, C1[r + 2], C1[r + 3]); } \
      float rm = __builtin_fmaxf(a, b_); { auto rr = __builtin_amdgcn_permlane32_swap(__float_as_uint(rm), __float_as_uint(rm), false, false); rm = __builtin_fmaxf(__uint_as_float(rr[0]), __uint_as_float(rr[1])); } \
      resc = false; \
      if (__builtin_expect(__any(rm > (float)THRL), 0)) { const float dl = __builtin_fmaxf(rm, 0.f); aq -= dl; \
        _Pragma("unroll") for (int r = 0; r < 16; ++r) { C0[r] -= dl; C1[r] -= dl; } \
        const float f = __builtin_amdgcn_exp2f(-dl); l_reg *= f; if (hi == 0) wsf[r32] = f; resc = true; } } \
    SBAR(); \
    GAPB(o[0] = __builtin_amdgcn_mfma_f32_32x32x16_bf16(PAF(0), VFR(0), o[0], 0, 0, 0), C0, 0); \
    GAPB(o[1] = __builtin_amdgcn_mfma_f32_32x32x16_bf16(PAF(0), VFR(4), o[1], 0, 0, 0), C0, 4); \
    KRD(GL, 0); GAPB(o[0] = __builtin_amdgcn_mfma_f32_32x32x16_bf16(PAF(1), VFR(1), o[0], 0, 0, 0), C0, 8); \
    KRD(GL, 1); GAPB(o[1] = __builtin_amdgcn_mfma_f32_32x32x16_bf16(PAF(1), VFR(5), o[1], 0, 0, 0), C0, 12); \
    KRD(GL, 2); GAPB(o[0] = __builtin_amdgcn_mfma_f32_32x32x16_bf16(PAF(2), VFR(2), o[0], 0, 0, 0), C1, 0); \
    KRD(GL, 3); GAPB(o[1] = __builtin_amdgcn_mfma_f32_32x32x16_bf16(PAF(2), VFR(6), o[1], 0, 0, 0), C1, 4); \
    GAPB(o[0] = __builtin_amdgcn_mfma_f32_32x32x16_bf16(PAF(3), VFR(3), o[0], 0, 0, 0), C1, 8); \
    GAPB(o[1] = __builtin_amdgcn_mfma_f32_32x32x16_bf16(PAF(3), VFR(7), o[1], 0, 0, 0), C1, 12); \
    } while (0)
    int t = tf + 1;
#undef CMASK
#define CMASK(P0, P1, t) do { } while (0)
    for (; t + 5 < NT; t += 2) {
        STEP(pB0, pB1, pA0, pA1, t, true, true, true);     WAIT_BAR(2); RESC(); ROT();
        STEP(pA0, pA1, pB0, pB1, t + 1, true, true, true); WAIT_BAR(2); RESC(); ROT();
    }
#undef CMASK
#define CMASK(P0, P1, t) do { int jb_ = (t) - (NT - 4); if (jb_ >= 0) cmask(P0, P1, jb_, qrel, hi); } while (0)
#define ENDW(tt) do { if ((tt) + 3 < NT) { WAIT_BAR(2); } else if ((tt) + 2 < NT) { WAIT_BAR(1); } else { WAIT_BAR(0); } } while (0)
    for (; t + 1 < NT; t += 2) {
        STEP(pB0, pB1, pA0, pA1, t, (t + 3 < NT), (t + 1 < NT), (t + 1 < NT));         ENDW(t);     RESC(); ROT();
        STEP(pA0, pA1, pB0, pB1, t + 1, (t + 4 < NT), (t + 2 < NT), (t + 2 < NT));     ENDW(t + 1); RESC(); ROT();
    }
    { float sacc = pA0[0] + pA0[1]; _Pragma("unroll") for (int r = 2; r < 16; ++r) sacc += pA0[r]; _Pragma("unroll") for (int r = 0; r < 16; ++r) sacc += pA1[r]; l_reg += sacc;
      pw0 = (u32x4){PKW(pA0, 0), PKW(pA0, 2), PKW(pA0, 4), PKW(pA0, 6)}; pw1 = (u32x4){PKW(pA0, 8), PKW(pA0, 10), PKW(pA0, 12), PKW(pA0, 14)}; pw2 = (u32x4){PKW(pA1, 0), PKW(pA1, 2), PKW(pA1, 4), PKW(pA1, 6)}; pw3 = (u32x4){PKW(pA1, 8), PKW(pA1, 10), PKW(pA1, 12), PKW(pA1, 14)};
      SBAR(); pv(o, vb0 + sl_prev, PAF(0), PAF(1), PAF(2), PAF(3)); }
#undef PKW
#undef PAF
#undef VFR
#undef PIN
#undef MX3
#undef GAPA
#undef GAPB
#undef EX
#undef VRD
#undef KRD
#undef STEP
#undef ENDW
    { auto rr = __builtin_amdgcn_permlane32_swap(__float_as_uint(l_reg), __float_as_uint(l_reg), false, false); l_reg = __uint_as_float(rr[0]) + __uint_as_float(rr[1]); }
    if (hi == 0) wsf[32 + r32] = l_reg; asm volatile("s_waitcnt lgkmcnt(0)" ::: "memory");
    float rli[16];
#pragma unroll
    for (int r = 0; r < 16; ++r) rli[r] = __builtin_amdgcn_rcpf(wsf[32 + crow(r, hi)]);
    bf16* Ow = O + (rowbase + q0 + wid * QBLK) * DMO + h * 64;
    { bf16* stg = (bf16*)(shm + LDS_OST) + wid * 2048;
#pragma unroll
      for (int r = 0; r < 16; ++r) { const int orow = crow(r, hi);
#pragma unroll
          for (int d0 = 0; d0 < 2; ++d0) stg[orow * 64 + d0 * 32 + r32] = (bf16)f2bf(o[d0][r] * rli[r]); }
      asm volatile("s_waitcnt lgkmcnt(0)" ::: "memory");
#pragma unroll
      for (int i = 0; i < 4; ++i) { const int row = i * 8 + (lane >> 3), ch = lane & 7; const u32x4 v = *(const u32x4*)(stg + row * 64 + ch * 8); *(u32x4*)(Ow + (long)row * DMO + ch * 8) = v; } }
    asm volatile("s_waitcnt lgkmcnt(0)\n\ts_barrier" ::: "memory");
#undef DMA_K
#undef DMA_V
#undef CMASK
#undef START
#undef RESC
#undef ROT
}
#undef SBAR
#undef WAIT_BAR
}
__device__ __forceinline__ void phase_scan(Frame& F, int l) {
    unsigned* scnt = (unsigned*)(WSP() + WS_CTL) + CW_AQ + 192 + l * 16; int nsc = 0;
#pragma unroll 1
    for (int bh = F.vcu; bh < 32; bh += F.G) {
        attn_scan(F, bh >> 3, bh & 7, false, fa::LDS_FL, fa::LDS_SCAN);
        const LAS float* Fl = (const LAS float*)(F.lds + fa::LDS_FL); float* FLg = (float*)(WSP() + WS_FL) + (size_t)bh * FLN;
#pragma unroll 1
        for (int i = F.tid; i < FLN / 4; i += 512) { const f32x4 v = *(const LAS f32x4*)(Fl + 4 * i); float* gp = FLg + 4 * i;
            asm volatile("global_store_dwordx4 %0, %1, off sc1\n\ts_nop 1" :: "v"(gp), "v"(v) : "memory"); }
        ++nsc;
    }
    asm volatile("s_waitcnt vmcnt(0)" ::: "memory");
    __syncthreads();
    if (F.tid == 0 && nsc) __hip_atomic_fetch_add(scnt, (unsigned)nsc, __ATOMIC_RELAXED, __HIP_MEMORY_SCOPE_AGENT);
    { const int t_ = F.wave * 64 + lane_id_opaque(); F.tid = t_; F.lane = t_ & 63; }
    phase_poolconv(F, l, scnt);
    if (F.wave == 0) { unsigned sp = 0;
        while ((unsigned)__builtin_amdgcn_readfirstlane(__hip_atomic_load(scnt, __ATOMIC_RELAXED, __HIP_MEMORY_SCOPE_AGENT)) < 32u) { __builtin_amdgcn_s_sleep(4); if (++sp > (1u << 22)) break; }
        __builtin_amdgcn_fence(__ATOMIC_ACQUIRE, "agent");
        asm volatile("s_waitcnt vmcnt(0)" ::: "memory"); }
    __syncthreads();
}
__device__ __forceinline__ void phase_B(Frame& F, int l) {
    LAS int* qs = (LAS int*)(F.lds + LC_QS);
    unsigned* ctl = (unsigned*)(WSP() + WS_CTL); unsigned* head = ctl + CW_AQ + l * 64; const unsigned* nrm = ctl + CW_NRM + l * 512;
    const float* FLg = (const float*)(WSP() + WS_FL);
    LAS float* tbl = (LAS float*)(F.lds + LC_TB);
    if (F.tid < 32) { float v[2][5];
#pragma unroll
        for (int kd = 0; kd < 2; ++kd)
#pragma unroll
            for (int w5 = 0; w5 < 5; ++w5) v[kd][w5] = __uint_as_float(__hip_atomic_load(nrm + kd * 256 + F.tid * 8 + w5, __ATOMIC_RELAXED, __HIP_MEMORY_SCOPE_AGENT));
        const float qn = fmaxf(v[0][0], (v[0][1] + v[0][2]) + (v[0][3] + v[0][4])), kn = fmaxf(v[1][0], (v[1][1] + v[1][2]) + (v[1][3] + v[1][4]));
        tbl[F.tid] = kn; tbl[32 + F.tid] = qn; }
#pragma unroll 1
    for (;;) {
        __syncthreads();
        if (F.tid == 0) { qs[0] = (int)atomicAdd(head, 1u); qs[1] = 0; }
        __syncthreads();
        const int u = __builtin_amdgcn_readfirstlane(qs[0]);
        if (u >= 1032) break;
        if (u < 1024) {
            const int qb = 31 - (u >> 5), bh = u & 31, b = bh >> 3, h = bh & 7, NT = 4 * qb + 5;
            const float qnb = fminf(tbl[32 + bh], __uint_as_float(__hip_atomic_load(ctl + CW_NQB + l * 1024 + (b * 32 + qb) * 8 + h, __ATOMIC_RELAXED, __HIP_MEMORY_SCOPE_AGENT)));
            const float T = 36.0f + sqrtf(tbl[bh] * qnb);
            const float* FLb = FLg + (size_t)bh * FLN; const float Fq0 = FLb[64 + 256 * qb];
            { const int t = F.tid; const bool skip = (t <= NT - 5) && (FLb[t == 0 ? 15 : 64 * t + 63] > Fq0 + T);
              const int c = __builtin_popcountll(__ballot(skip)); if (F.lane == 0 && c) __hip_atomic_fetch_add(&qs[1], c, __ATOMIC_RELAXED, __HIP_MEMORY_SCOPE_WORKGROUP); }
            __syncthreads();
            int tf = __builtin_amdgcn_readfirstlane(qs[1]); if (((NT - tf) & 1) == 0) tf -= 1;
            { LAS float* Fl = (LAS float*)(F.lds + fa::LDS_FL); const int n4 = (NT - tf) * 16;
#pragma unroll 1
              for (int i = F.tid; i < n4; i += 512) *(LAS f32x4*)(Fl + 4 * i) = *(const f32x4*)(FLb + 64 * tf + 4 * i); }
            __syncthreads();
            unsigned char* dol = DOP();
            fa::attn_unit<8>(b, h, qb, tf, (const bf16*)(dol + DO_Q), (const bf16*)(dol + DO_K), (const bf16*)(dol + DO_V), (bf16*)(WSP() + WS_X3) + 512, (char*)F.lds, F.wave);
        } else {
            const int t_ = F.wave * 64 + lane_id_opaque(); F.tid = t_; F.lane = t_ & 63;
            attn_scan(F, 0, u - 1024, true, AT_FL, AT_SC); attn_unit_naive(F, TX, 0, 1, 0, u - 1024, NMETA);
        }
    }
    __syncthreads();
    { const int t_ = F.wave * 64 + lane_id_opaque(); F.tid = t_; F.lane = t_ & 63; }
    phase_poolconv(F, l, nullptr);
    { unsigned* head2 = ctl + CW_AQ + 32 + l * 64; LAS float* scr = (LAS float*)(F.lds + F.wave * 16384);
#pragma unroll 1
      for (;;) { __syncthreads(); if (F.tid == 0) qs[0] = (int)atomicAdd(head2, 1u); __syncthreads();
          const int c = __builtin_amdgcn_readfirstlane(qs[0]); if (c >= 768) break;
          convert_item(F, l, 3584 + 8 * c + F.wave, scr, lane_id_opaque()); } }
    __syncthreads();
}

__device__ __forceinline__ void class_tables(Frame& F, int l) {
    LAS int* base = (LAS int*)(F.lds + LC_BASE); LAS int* pcls = (LAS int*)(F.lds + LC_PCLS); LAS int* np = (LAS int*)(F.lds + LC_NP);
    const unsigned* gcnt = (const unsigned*)(WSP() + WS_CTL) + CW_GCNT + l * 64;
    __syncthreads();
    if (F.tid < NCLS) { int n = (int)__hip_atomic_load(gcnt + F.tid, __ATOMIC_RELAXED, __HIP_MEMORY_SCOPE_AGENT); if (n > TR) n = TR; if (n < 0) n = 0; pcls[F.tid] = (n + 255) >> 8; ((LAS int*)(F.lds + LC_CCNT))[F.tid] = n; }
    __syncthreads();
    if (F.tid == 0) { int p = 0;
#pragma unroll 1
        for (int c = 0; c < NCLS; ++c) { base[c] = p * 256; p += pcls[c]; }
        if (p > 160) p = 160; base[NCLS] = p * 256; np[0] = p; }
    __syncthreads();
    if (F.tid < 160) { const int mypos = F.tid * 256; int c = 0;
#pragma unroll 1
        for (int k = 1; k < NCLS; ++k) if (base[k] <= mypos) c = k;
        pcls[F.tid] = c; }
    __syncthreads();
}
template <int NG, int CH> __device__ __forceinline__ void e1_groups(Frame& F, int l, const int (&rowv)[NG], const int (&grpv)[NG], const LAS bf16* Rhi, const LAS bf16* Rlo, LAS int* rec, LAS int* lcnt,
                                                                   const float* reb, const float* rgb, int fr, int fq) {
    const bf16* hsrc[NG];
#pragma unroll
    for (int g = 0; g < NG; ++g) hsrc[g] = (const bf16*)(WSP() + WS_HB) + (size_t)rowv[g] * D + 8 * fq;
    const LAS bf16* bh0 = Rhi + fr * RPITCH + 8 * fq; const LAS bf16* bl0 = Rlo + fr * RPITCH + 8 * fq;
    const LAS bf16* bh1 = Rhi + (16 + (fr & 3)) * RPITCH + 8 * fq; const LAS bf16* bl1 = Rlo + (16 + (fr & 3)) * RPITCH + 8 * fq;
    f32x4 acc0[NG], acc1[NG]; float ss[NG];
#pragma unroll
    for (int g = 0; g < NG; ++g) { acc0[g] = (f32x4){0.f, 0.f, 0.f, 0.f}; acc1[g] = acc0[g]; ss[g] = 0.f; }
    u32x4 ch[NG][CH];
#pragma unroll
    for (int g = 0; g < NG; ++g)
#pragma unroll
        for (int c = 0; c < CH; ++c) ch[g][c] = *(const u32x4*)(hsrc[g] + 32 * c);
#pragma unroll 1
    for (int s0 = 0; s0 < 32; s0 += CH) {
        u32x4 nh[NG][CH];
        if (s0 + CH < 32) {
#pragma unroll
            for (int g = 0; g < NG; ++g)
#pragma unroll
                for (int c = 0; c < CH; ++c) nh[g][c] = *(const u32x4*)(hsrc[g] + 32 * (s0 + CH + c));
        }
#pragma unroll
        for (int c = 0; c < CH; ++c) { const int s = s0 + c;
            const bf16x8 wh0 = *(const LAS bf16x8*)(bh0 + 32 * s), wl0 = *(const LAS bf16x8*)(bl0 + 32 * s);
            bf16x8 wh1 = *(const LAS bf16x8*)(bh1 + 32 * s), wl1 = *(const LAS bf16x8*)(bl1 + 32 * s);
            if (fr >= 4) { wh1 = (bf16x8){0, 0, 0, 0, 0, 0, 0, 0}; wl1 = wh1; }
#pragma unroll
            for (int g = 0; g < NG; ++g) { const u32x4 hw = ch[g][c];
                ss[g] = dot2bf(hw.x, hw.x, ss[g]); ss[g] = dot2bf(hw.y, hw.y, ss[g]); ss[g] = dot2bf(hw.z, hw.z, ss[g]); ss[g] = dot2bf(hw.w, hw.w, ss[g]);
                const bf16x8 ah = __builtin_bit_cast(bf16x8, hw);
                acc0[g] = __builtin_amdgcn_mfma_f32_16x16x32_bf16(wh0, ah, acc0[g], 0, 0, 0); acc0[g] = __builtin_amdgcn_mfma_f32_16x16x32_bf16(wl0, ah, acc0[g], 0, 0, 0);
                acc1[g] = __builtin_amdgcn_mfma_f32_16x16x32_bf16(wh1, ah, acc1[g], 0, 0, 0); acc1[g] = __builtin_amdgcn_mfma_f32_16x16x32_bf16(wl1, ah, acc1[g], 0, 0, 0); } }
        if (s0 + CH < 32) {
#pragma unroll
            for (int g = 0; g < NG; ++g)
#pragma unroll
                for (int c = 0; c < CH; ++c) ch[g][c] = nh[g][c];
        }
    }
#pragma unroll
    for (int g = 0; g < NG; ++g) {
        float sg = ss[g]; sg += lane_xor<16>(sg); sg += lane_xor<32>(sg);
        const float rstd2 = rsqrtf(sg * (1.0f / D) + EPS);
        float gl[4];
#pragma unroll
        for (int q = 0; q < 4; ++q) gl[q] = __int_as_float(__builtin_amdgcn_ds_bpermute(fr << 2, __float_as_int(acc1[g][q]))) * rstd2 + rgb[q];
        int gsel = 0; float gmax = gl[0];
#pragma unroll
        for (int q = 1; q < 4; ++q) if (gl[q] > gmax) { gmax = gl[q]; gsel = q; }
        float gsum = 0.f;
#pragma unroll
        for (int q = 0; q < 4; ++q) gsum += __expf(gl[q] - gmax);
        const float gwt = 1.0f / gsum;
        if (fq == gsel) {
            float el[4];
#pragma unroll
            for (int e = 0; e < 4; ++e) el[e] = acc0[g][e] * rstd2 + reb[gsel * 4 + e];
            int t1 = 0; float l1 = el[0];
#pragma unroll
            for (int e = 1; e < 4; ++e) if (el[e] > l1) { l1 = el[e]; t1 = e; }
            int t2 = -1; float l2 = -3.0e38f;
#pragma unroll
            for (int e = 0; e < 4; ++e) if (e != t1 && el[e] > l2) { l2 = el[e]; t2 = e; }
            const float w1 = 1.0f / (1.0f + __expf(l2 - l1)), w2 = 1.0f - w1;
            const int ea = min(t1, t2), eb = max(t1, t2); const float cA = gwt * (t1 == ea ? w1 : w2), cB = gwt * (t1 == ea ? w2 : w1);
            const int pr = ea == 0 ? eb - 1 : (ea == 1 ? eb + 1 : 5); int cls = gsel * 6 + pr; if (!(cls >= 0 && cls < NCLS)) cls = 0;
            const int rank = __hip_atomic_fetch_add(&lcnt[cls], 1, __ATOMIC_RELAXED, __HIP_MEMORY_SCOPE_WORKGROUP); const int rr = grpv[g] * 16 + fr;
            rec[rr * 5] = cls; rec[rr * 5 + 1] = rank; rec[rr * 5 + 2] = __float_as_int(cA); rec[rr * 5 + 3] = __float_as_int(cB); rec[rr * 5 + 4] = __float_as_int(rstd2);
        }
    }
}
__device__ __forceinline__ void phase_E1(Frame& F, int l) {
    LAS bf16* Rhi = (LAS bf16*)F.lds; LAS bf16* Rlo = Rhi + 20 * RPITCH;
    LAS int* rec = (LAS int*)(F.lds + 83968);
    LAS int* lcnt = (LAS int*)(F.lds + LC_CNT); LAS int* wgb = (LAS int*)(F.lds + LC_BASE);
    const float* rg = (const float*)(WSP() + WS_RG);
    const float* reb = INP(I_REB) + l * 16; const float* rgb = INP(I_RGB) + l * 4;
    unsigned* gcnt = (unsigned*)(WSP() + WS_CTL) + CW_GCNT + l * 64; int* tokc = (int*)(WSP() + WS_TOKC); float* pwc = (float*)(WSP() + WS_PWC);
    const int tid = F.tid, lane = F.lane, wave = F.wave, fr = lane & 15, fq = lane >> 4;
    { f32x4 rv[10];
#pragma unroll
      for (int j = 0; j < 10; ++j) rv[j] = *(const f32x4*)(rg + 4 * (tid + 512 * j));
#pragma unroll
      for (int j = 0; j < 10; ++j) { const int i = 4 * (tid + 512 * j), c = i >> 10, k = i & 1023; u32x2 hw, lw; float hf[4];
#pragma unroll
          for (int e = 0; e < 4; ++e) hf[e] = __builtin_bit_cast(float, (pk2(rv[j][e], 0.f) & 0xffffu) << 16);
          hw.x = pk2(rv[j][0], rv[j][1]); hw.y = pk2(rv[j][2], rv[j][3]); lw.x = pk2(rv[j][0] - hf[0], rv[j][1] - hf[1]); lw.y = pk2(rv[j][2] - hf[2], rv[j][3] - hf[3]);
          *(LAS u32x2*)(Rhi + c * RPITCH + k) = hw; *(LAS u32x2*)(Rlo + c * RPITCH + k) = lw; } }
#pragma unroll 1
    for (int wg = F.vcu; wg < 256; wg += F.G) {
        if (tid < NCLS) lcnt[tid] = 0;
        __syncthreads();
        const int ngrp = wg == 0 ? 9 : 8;
        if (wg == 0 && wave == 0) { const int rows2[2] = {fr, TX + fr}; const int grps2[2] = {0, 8}; e1_groups<2, 4>(F, l, rows2, grps2, Rhi, Rlo, rec, lcnt, reb, rgb, fr, fq); }
        else { const int rows1[1] = {wg * 128 + wave * 16 + fr}; const int grps1[1] = {wave}; e1_groups<1, 8>(F, l, rows1, grps1, Rhi, Rlo, rec, lcnt, reb, rgb, fr, fq); }
        __syncthreads();
        if (tid < NCLS) { const int n = lcnt[tid]; wgb[tid] = n > 0 ? (int)atomicAdd(gcnt + tid, (unsigned)n) : 0; }
        __syncthreads();
        const int nrw = ngrp * 16;
        for (int rr = tid; rr < nrw; rr += 512) { const int row = rr < 128 ? wg * 128 + rr : TX + (rr - 128); const int cls = rec[rr * 5];
            int q = wgb[cls] + rec[rr * 5 + 1]; if (q < 0 || q >= TRC) q = TRC - 1;
            tokc[(size_t)cls * TRC + q] = row; f32x4 w; w[0] = __int_as_float(rec[rr * 5 + 4]); w[1] = __int_as_float(rec[rr * 5 + 2]); w[2] = __int_as_float(rec[rr * 5 + 3]); w[3] = 0.f;
            *(f32x4*)(pwc + ((size_t)cls * TRC + q) * 4) = w; }
        __syncthreads();
    }
}
__device__ __forceinline__ void phase_E4(Frame& F, int l) {
    const bf16* HB = (const bf16*)(WSP() + WS_HB); float* rstd1 = (float*)(WSP() + WS_RSTD1); const float* fg = INP(I_FG); float* out = (float*)DOP();
    const int gw = F.vcu * NWAVES + F.wave, NGW = F.G * NWAVES, lane = F.lane; const bool lastl = (l == DEPTH - 1); const int lim = lastl ? TX : TR;
    constexpr int R = 8;
#pragma unroll 1
    for (int row0 = gw; row0 < lim; row0 += R * NGW) {
        u32x4 hw[R][2];
#pragma unroll
        for (int r = 0; r < R; ++r) { int row = row0 + r * NGW; if (row >= lim) row = lim - 1;
#pragma unroll
            for (int j = 0; j < 2; ++j) hw[r][j] = *(const u32x4*)(HB + (size_t)row * D + 8 * lane + 512 * j); }
#pragma unroll
        for (int r = 0; r < R; ++r) { const int row = row0 + r * NGW; float ss = 0.f;
#pragma unroll
            for (int j = 0; j < 2; ++j) { const u32x4 w = hw[r][j]; ss = dot2bf(w.x, w.x, ss); ss = dot2bf(w.y, w.y, ss); ss = dot2bf(w.z, w.z, ss); ss = dot2bf(w.w, w.w, ss); }
            const float rs = rsqrtf(wave_sum(ss) * (1.0f / D) + EPS);
            if (row < lim) {
                if (!lastl) { if (lane == 0) rstd1[row] = rs; }
                else {
#pragma unroll
                    for (int j = 0; j < 2; ++j) { const u32x4 w = hw[r][j]; const f32x4 g0 = *(const f32x4*)(fg + 8 * lane + 512 * j), g1 = *(const f32x4*)(fg + 8 * lane + 512 * j + 4);
                        const f32x4 v0 = {bflo(w.x), bfhi(w.x), bflo(w.y), bfhi(w.y)}, v1 = {bflo(w.z), bfhi(w.z), bflo(w.w), bfhi(w.w)};
                        *(f32x4*)(out + (size_t)row * D + 8 * lane + 512 * j) = v0 * rs * g0; *(f32x4*)(out + (size_t)row * D + 8 * lane + 512 * j + 4) = v1 * rs * g1; }
                }
            }
        }
    }
}
#define RELANE() do { const int t_ = wv0 * 64 + lane_id_opaque(); F.tid = t_; F.lane = t_ & 63; F.wave = __builtin_amdgcn_readfirstlane(t_ >> 6); \
    int g_ = gridDim.x; LAUNDER_S(g_); int b_ = blockIdx.x; LAUNDER_S(b_); F.G = g_; F.bx = b_; F.vcu = (g_ % 8 == 0) ? (b_ % 8) * (g_ / 8) + b_ / 8 : b_; ll = l; LAUNDER_S(ll); } while (0)
__device__ __forceinline__ void moe_wait(Frame& F, const unsigned* upc, const int (&Ls)[3], int i0, int i1) {
    if (F.wave == 0) {
#pragma unroll
        for (int i = 0; i < 3; ++i) { if (i < i0 || i >= i1 || Ls[i] < 0) continue; const unsigned* p = upc + (Ls[i] >> 2) * 16; unsigned sp = 0;
            while ((unsigned)__builtin_amdgcn_readfirstlane(__hip_atomic_load(p, __ATOMIC_RELAXED, __HIP_MEMORY_SCOPE_AGENT)) < 32u) { __builtin_amdgcn_s_sleep(4); if (++sp > (1u << 22)) break; } }
        __builtin_amdgcn_fence(__ATOMIC_ACQUIRE, "agent");
        asm volatile("s_waitcnt vmcnt(0)" ::: "memory");
    }
    __syncthreads();
}
__global__ void __launch_bounds__(NWAVES * 64, 2) fwd_kernel(Params P) {
    extern __shared__ __attribute__((aligned(16))) unsigned char lds_raw[];
    Frame F;
    F.lds = (LAS unsigned char*)lds_raw;
    F.tid = threadIdx.x; F.lane = F.tid & 63; F.wave = __builtin_amdgcn_readfirstlane(F.tid >> 6);
    F.G = gridDim.x; { const int bx = blockIdx.x; F.vcu = (F.G % 8 == 0) ? (bx % 8) * (F.G / 8) + bx / 8 : bx; }
    if (F.tid == 0) { LAS unsigned long long* pt = (LAS unsigned long long*)(F.lds + LC_PTAB);
#pragma unroll
        for (int i = 0; i < 25; ++i) pt[i] = (unsigned long long)P.in[i];
        pt[25] = (unsigned long long)P.ws; pt[26] = (unsigned long long)P.out; }
    for (int u = F.tid; u < 256; u += NWAVES * 64) ((LAS unsigned*)(F.lds + RING_BYTES))[u] = 0u;
    __syncthreads();
    const int lo = P.ph_lo, hi = P.ph_hi;
    const bool use_bar = (hi - lo) > 1;
    unsigned* barw = (unsigned*)(P.ws + WS_CTL) + CW_BAR;
    XcdBarrier bar; bar.bar = barw; bar.x = 0; bar.st = (volatile LAS unsigned*)(F.lds + LC_BAR);
    if (use_bar) bar = xcd_barrier_post(barw, (volatile LAS unsigned*)(F.lds + LC_BAR));
#ifndef PHASE_MASK
#define PHASE_MASK 0xfff
#endif
#define EN(j) (((PHASE_MASK) >> (j)) & 1)
#ifndef DUP_MASK
#define DUP_MASK 0
#endif
#define NREP(j) ((((DUP_MASK) >> (j)) & 1) ? 2 : 1)
#define IN(k) (lo <= (k) && (k) < hi)
#define SEAM(k) do { if (IN(k) && IN((k) + 1)) xcd_barrier(bar); } while (0)

    int l = 0, ll = 0; const int wv0 = __builtin_amdgcn_readfirstlane((int)threadIdx.x >> 6);
    if (EN(0) && IN(0)) { RELANE(); if (F.wave < 4) init_rows(F, 0, 4); else convert_weights(F, 0, 4, 4); }
    SEAM(0);
    for (l = 0; l < DEPTH; ++l) {
        const int pb = 1 + 11 * l;
        for (int rep = 0; rep < NREP(1); ++rep)
        if (EN(1) && IN(pb + 0)) {
            RELANE();
            unsigned char* wsl = WSP(); unsigned char* dol = DOP();
            pg8::Gemm g{(const bf16*)(wsl + WS_HB), 1024, 1024, 1 << 20};
            pg8::StaticOrder S; S.init(TX, N1, F.G, F.bx, (const bf16*)(wsl + WS_W1T), 1024);
            Epi1 E{(const float*)(wsl + WS_RSTD1), (bf16*)(wsl + WS_A), (bf16*)(wsl + WS_GLU), (bf16*)(dol + DO_Q), (bf16*)(wsl + WS_G), (unsigned*)(wsl + WS_CTL) + CW_NRM + ll * 512, (LAS float*)(F.lds + LC_TOK), (unsigned*)(wsl + WS_CTL) + CW_NQB + ll * 1024};
            pg8::gemm_phase<Epi1, pg8::StaticOrder>(F.lds, g, S, E, F.wave);
            if (F.bx >= 128 && F.bx < 128 + 21 && F.wave < 4) {
                const int pn = F.bx - 128, l2 = lane_id_opaque(); AccT acc; skinny_zero(acc);
                skinny_k<true>(acc, (const bf16*)(wsl + WS_HB) + (size_t)TX * 1024, 1024, (const bf16*)(wsl + WS_W1T) + (size_t)pn * 256 * 1024, 1024, 1024, F.wave, l2 & 15, l2 >> 4);
                E.run<true>(acc, pg8::Unit{128, pn, 0}, 0, F.wave, l2 & 15, l2 >> 4);
            }
            { RELANE(); LAS int* qs = (LAS int*)(F.lds + LC_QS); unsigned* head4 = (unsigned*)(WSP() + WS_CTL) + CW_AQ + 16 + ll * 64;
#pragma unroll 1
              for (;;) { __syncthreads(); if (F.tid == 0) qs[0] = (int)atomicAdd(head4, 1u); __syncthreads();
                  const int it = __builtin_amdgcn_readfirstlane(qs[0]); if (it >= 513) break;
                  { const int t_ = F.wave * 64 + lane_id_opaque(); F.tid = t_; F.lane = t_ & 63; }
                  s_item_logf(F, ll, it); } }
        }
        SEAM(pb + 0);
        if (EN(3) && IN(pb + 2)) { RELANE(); phase_scan(F, ll); RELANE(); phase_B(F, ll); }
        SEAM(pb + 2);
        for (int rep = 0; rep < NREP(4); ++rep)
        if (EN(5) && IN(pb + 4)) {
            RELANE(); unsigned char* wsl = WSP(); unsigned char* dol = DOP();
            pg8::Gemm g{(const bf16*)(wsl + WS_X3), 1024, 1024, 1 << 20}; pg8::SegOrder S; S.init(TX, 1024, F.G, F.bx, (const bf16*)(wsl + WS_W3CT), 1024);
            EpiCS E{(const bf16*)(wsl + WS_G), (bf16*)(dol + DO_MERGED), (const float*)(wsl + WS_BIASA)}; pg8::gemm_phase<EpiCS, pg8::SegOrder>(F.lds, g, S, E, F.wave);
            if (F.bx < 64) {
                f32x4 p[8]; const int c0 = 16 * F.bx;
                skinny16(F.lds, F.wave, (const bf16*)(wsl + WS_X3) + (size_t)TX * 1024, (const bf16*)(wsl + WS_W3CT), c0, p);
                if (F.wave == 0) { const int l2 = lane_id_opaque(), fr = l2 & 15, fq = l2 >> 4; const size_t o = (size_t)(TX + fr) * 1024 + c0 + 4 * fq;
                    const int cs = c0 + 4 * fq, gt_ = 4 * (cs >> 8) + 2 * ((cs >> 7) & 1) + ((cs >> 2) & 1), gw8 = (cs >> 5) & 3, gl = ((cs >> 3) & 3) * 16 + fr; const bf16* Gb = (const bf16*)(wsl + WS_G);
                    const u32x2 w01 = *(const u32x2*)(Gb + gidx(0, 128, gt_, 0, gw8, gl)), w12 = *(const u32x2*)(Gb + gidx(1, 128, gt_, 0, gw8, gl)), w2 = *(const u32x2*)(Gb + gidx(2, 128, gt_, 0, gw8, gl));
                    const f32x4 bv = *(const f32x4*)((const float*)(wsl + WS_BIASA) + c0 + 4 * fq);
                    const f32x4 r01 = {bflo(w01.x), bfhi(w01.x), bflo(w01.y), bfhi(w01.y)}, r12 = {bflo(w12.x), bfhi(w12.x), bflo(w12.y), bfhi(w12.y)}, g2 = {bflo(w2.x), bfhi(w2.x), bflo(w2.y), bfhi(w2.y)};
                    const f32x4 mg = ((((p[0] + p[1]) + bv) * r01 + (p[2] + p[3])) * r12 + ((p[4] + p[5]) + (p[6] + p[7]))) * g2;
                    u32x2 w; w.x = pk2(mg[0], mg[1]); w.y = pk2(mg[2], mg[3]); *(u32x2*)((bf16*)(dol + DO_MERGED) + o) = w; }
            }
        }
        SEAM(pb + 4);
        if (EN(6) && IN(pb + 5)) {
            RELANE();
            unsigned char* wsl = WSP(); unsigned char* dol = DOP();
            pg8::Gemm g{(const bf16*)(dol + DO_MERGED), 1024, 1024, 1 << 20}; pg8::StaticOrder S; S.init(TX, 1024, F.G, F.bx, (const bf16*)(wsl + WS_WOT), 1024);
            EpiRes<false> E{(bf16*)(wsl + WS_HB), nullptr}; pg8::gemm_phase<EpiRes<false>, pg8::StaticOrder>(F.lds, g, S, E, F.wave);
            if (F.bx < 64) {
                f32x4 p[8]; const int c0 = 16 * F.bx;
                skinny16(F.lds, F.wave, (const bf16*)(dol + DO_MERGED) + (size_t)TX * 1024, (const bf16*)(wsl + WS_WOT), c0, p);
                if (F.wave == 0) { const int l2 = lane_id_opaque(), fr = l2 & 15, fq = l2 >> 4; bf16* hp = (bf16*)(wsl + WS_HB) + (size_t)(TX + fr) * 1024 + c0 + 4 * fq;
                    const u32x2 hw = *(const u32x2*)hp; const f32x4 hv = {bflo(hw.x), bfhi(hw.x), bflo(hw.y), bfhi(hw.y)};
                    const f32x4 y = (((p[0] + p[1]) + (p[2] + p[3])) + ((p[4] + p[5]) + (p[6] + p[7]))) + hv;
                    u32x2 w; w.x = pk2(y[0], y[1]); w.y = pk2(y[2], y[3]); *(u32x2*)hp = w; }
            }
        }
        SEAM(pb + 5);
        if (EN(7) && IN(pb + 6)) { RELANE(); phase_E1(F, ll); }
        SEAM(pb + 6);
        for (int rep = 0; rep < NREP(8); ++rep)
        if (EN(9) && IN(pb + 8)) {
            RELANE(); class_tables(F, ll);
            unsigned char* wsl = WSP();
            const int NP = __builtin_amdgcn_readfirstlane(*(const LAS int*)(F.lds + LC_NP));
            unsigned* upc = (unsigned*)(wsl + WS_CTL) + CW_UPC + ll * 2560;
            const LAS int* pcl = (const LAS int*)(F.lds + LC_PCLS); const LAS int* cb = (const LAS int*)(F.lds + LC_BASE); const LAS int* cc = (const LAS int*)(F.lds + LC_CCNT);
            { const int* TOK = (const int*)(wsl + WS_TOKC); LAS int* tl = (LAS int*)(F.lds + LC_TOK);
#pragma unroll 1
              for (int i = F.tid; i < 1024; i += 512) { const int L = (i >> 8) * F.G + F.vcu; int tk = 0; if (L < NP * 4) { const int p = L >> 2, c = pcl[p], q = p * 256 - cb[c] + (i & 255); if (q >= 0 && q < cc[c]) { tk = TOK[(size_t)c * TRC + q]; if (tk < 0 || tk >= TR) tk = 0; } } tl[i] = tk; }
              __syncthreads(); }
            { pg8::Gemm g2{(const bf16*)(wsl + WS_HB), 1024, 1024, 1 << 20};
              MoeOrderT<true> S{(const LAS int*)(F.lds + LC_TOK), NP, F.G, F.vcu, 0, (const LAS int*)(F.lds + LC_PCLS), (const bf16*)(DOP() + DO_W13T), 0, 1 << 20};
              EpiA2 E{(const float*)(wsl + WS_PWC), (bf16*)(wsl + WS_HH), upc, (const LAS int*)(F.lds + LC_PCLS), (const LAS int*)(F.lds + LC_BASE)}; pg8::gemm_phase<EpiA2, MoeOrderT<true>>(F.lds, g2, S, E, F.wave); }
            RELANE(); wsl = WSP();
            int Ls[3];
            { const int G = F.G, NU = NP * 4, ov = NU - 2 * G, v = F.vcu, cd = G - 1 - v; int L0 = cd, L1 = G + cd, L2 = -1;
              if (ov > 0) { if (v >= G - ov) L2 = 2 * G + cd;
                  if (3 * ov <= G) { if (v < ov) L1 = -1; else if (v < 2 * ov) L2 = 2 * G - 1 - (v - ov); } }
              Ls[0] = L0 < NU ? L0 : -1; Ls[1] = (L1 >= 0 && L1 < NU) ? L1 : -1; Ls[2] = (L2 >= 0 && L2 < NU) ? L2 : -1; }
            { const int* TOK = (const int*)(wsl + WS_TOKC); LAS int* tl = (LAS int*)(F.lds + LC_TOK);
#pragma unroll 1
              for (int i = F.tid; i < 768; i += 512) { const int sl = i >> 8, L = sl == 0 ? Ls[0] : (sl == 1 ? Ls[1] : Ls[2]); int tk = -1; if (L >= 0) { const int p = L >> 2, c = pcl[p], q = p * 256 - cb[c] + (i & 255); if (q >= 0 && q < cc[c]) { tk = TOK[(size_t)c * TRC + q]; if (tk >= TR) tk = -1; } } tl[i] = tk; } }
            pg8::Gemm g{(const bf16*)(wsl + WS_HH), 512, 256, 4};
            EpiRes<true> E{(bf16*)(wsl + WS_HB), (const LAS int*)(F.lds + LC_TOK)};
            moe_wait(F, upc, Ls, 0, 2);
            { MoeDownOrder S{{nullptr, NP, F.G, 0, 1, (const LAS int*)(F.lds + LC_PCLS), (const bf16*)(DOP() + DO_W2T), 0, 2}, {Ls[0], Ls[1], Ls[2]}}; pg8::gemm_phase<EpiRes<true>, MoeDownOrder>(F.lds, g, S, E, F.wave); }
            moe_wait(F, upc, Ls, 2, 3);
            { MoeDownOrder S{{nullptr, NP, F.G, 0, 1, (const LAS int*)(F.lds + LC_PCLS), (const bf16*)(DOP() + DO_W2T), 2, 3}, {Ls[0], Ls[1], Ls[2]}}; pg8::gemm_phase<EpiRes<true>, MoeDownOrder>(F.lds, g, S, E, F.wave); }
            if (l + 1 < DEPTH) { RELANE(); convert_queue(F, ll + 1, (unsigned*)(WSP() + WS_CTL) + CW_AQ + 128 + ll * 16); }
        }
        SEAM(pb + 9);
        if (EN(11) && IN(pb + 10)) { RELANE(); phase_E4(F, ll); }
        SEAM(pb + 10);
    }
#undef IN
#undef SEAM
}

constexpr int N_PHASES = 1 + 11 * DEPTH;

extern "C" void kernel_launch(void* const* d_in, const int* in_sizes, int n_in, void* d_out, int out_size, void* d_ws, size_t ws_size, hipStream_t stream) {
    static int grid = 0;
    if (grid == 0) {
        if (n_in != 25 || out_size != TX * D || ws_size < WS_END) { fprintf(stderr, "kernel_launch: unexpected shapes: n_in %d out %d ws %zu (need %zu)\n", n_in, out_size, ws_size, (size_t)WS_END); grid = -1; return; }
        int dev = 0, cus = 0, per_cu = 0;
        if (hipGetDevice(&dev) != hipSuccess || hipDeviceGetAttribute(&cus, hipDeviceAttributeMultiprocessorCount, dev) != hipSuccess) { grid = -1; return; }
        if (hipFuncSetAttribute((const void*)fwd_kernel, hipFuncAttributeMaxDynamicSharedMemorySize, LDS_BYTES) != hipSuccess) { fprintf(stderr, "kernel_launch: hipFuncSetAttribute failed\n"); grid = -1; return; }
        if (hipOccupancyMaxActiveBlocksPerMultiprocessor(&per_cu, (const void*)fwd_kernel, NWAVES * 64, LDS_BYTES) != hipSuccess || per_cu < 1) fprintf(stderr, "kernel_launch: occupancy query reports %d\n", per_cu);
        (void)hipGetLastError();
        grid = cus;
    }
    if (grid < 0) return;
    (void)hipMemsetAsync((char*)d_ws + WS_CTL, 0, CTL_BYTES, stream);
    Params p{};
    for (int i = 0; i < 25; ++i) p.in[i] = (const float*)d_in[i];
    p.out = (float*)d_out; p.ws = (unsigned char*)d_ws;
#if N_LAUNCH_MODE == 1
    p.ph_lo = 0; p.ph_hi = N_PHASES;
    hipLaunchKernelGGL(fwd_kernel, dim3(grid), dim3(NWAVES * 64), LDS_BYTES, stream, p);
#else
    for (int ph = 0; ph < N_PHASES; ++ph) { p.ph_lo = ph; p.ph_hi = ph + 1; hipLaunchKernelGGL(fwd_kernel, dim3(grid), dim3(NWAVES * 64), LDS_BYTES, stream, p); }
#endif
}
```
